# Optimizing an MI355X kernel written in HIP

```python
import jax, jax.numpy as jnp
from jax import lax
import numpy as np


D_MODEL = 1024
BATCH = 16
SEQ = 4096
DEPTH = 1
DEC_BATCH = 8
DEC_SEQ = 16
PAST_LEN = 2048

CHUNK = 64
LEFT_CHUNKS = 8
BAND = LEFT_CHUNKS * CHUNK
N_HEADS = 16
HEAD_DIM = 64
ATTN_WIDTH = N_HEADS * HEAD_DIM
ATTN_SCALE = HEAD_DIM ** -0.5
MAX_REL = 128
LRU_WIDTH = 1024
LRU_BLOCKS = 16
LRU_BLOCK = LRU_WIDTH // LRU_BLOCKS
CONV_W = 4
LRU_C = 8.0
PEER_HEADS = 8
N_KEYS = 128
N_EXPERTS = N_KEYS * N_KEYS
D_KEY = 256
HALF_KEY = D_KEY // 2
TOPK_HALF = 16
TOPK = 16
TOKEN_BLOCK = 128
EPS = 1e-6
NEG_INF = -1e30
IN_COLS = 3 * ATTN_WIDTH + 2 * LRU_WIDTH + 2 * D_MODEL
SPLITS = (ATTN_WIDTH, 2 * ATTN_WIDTH, 3 * ATTN_WIDTH, 3 * ATTN_WIDTH + LRU_WIDTH,
          3 * ATTN_WIDTH + 2 * LRU_WIDTH, 3 * ATTN_WIDTH + 2 * LRU_WIDTH + D_MODEL)

kernel_name = 'hybrid_stream_band_rglru_peer'


def rmsnorm(x, g):
    xf = x.astype(jnp.float32)
    y = xf * lax.rsqrt(jnp.mean(xf * xf, axis=-1, keepdims=True) + EPS)
    return (y * g.astype(jnp.float32)).astype(x.dtype)


def rel_bias(rel_table, q_pos, k_pos):
    idx = jnp.clip(q_pos[:, None] - k_pos[None, :], -MAX_REL, MAX_REL) + MAX_REL
    return rel_table[:, idx].astype(jnp.float32)


def band_attention_prompt(q, k, v, rel_table):
    bsz, seq = q.shape[0], q.shape[1]
    n_chunks = seq // CHUNK
    span = BAND + CHUNK
    pad = ((0, 0), (BAND, 0), (0, 0), (0, 0))
    k_pad = jnp.pad(k, pad)
    v_pad = jnp.pad(v, pad)
    offs = jnp.arange(span)
    bias = rel_bias(rel_table, jnp.arange(CHUNK) + BAND, offs)
    q_chunks = jnp.moveaxis(q.reshape(bsz, n_chunks, CHUNK, N_HEADS, HEAD_DIM), 1, 0)

    def one_chunk(args):
        c, q_c = args
        start = c * CHUNK
        k_b = lax.dynamic_slice_in_dim(k_pad, start, span, axis=1)
        v_b = lax.dynamic_slice_in_dim(v_pad, start, span, axis=1)
        valid = (start - BAND + offs) >= 0
        s = jnp.einsum('bqhd,bkhd->bhqk', q_c, k_b).astype(jnp.float32) * ATTN_SCALE + bias
        s = jnp.where(valid[None, None, None, :], s, NEG_INF)
        p = jax.nn.softmax(s, axis=-1).astype(v_b.dtype)
        return jnp.einsum('bhqk,bkhd->bqhd', p, v_b)

    o = lax.map(one_chunk, (jnp.arange(n_chunks), q_chunks))
    return jnp.moveaxis(o, 0, 1).reshape(bsz, seq, ATTN_WIDTH)


def band_attention_sample(q, k_new, v_new, cache_k, cache_v, rel_table):
    bsz, t_new = q.shape[0], q.shape[1]
    rows = cache_k.shape[1]
    k_all = jnp.concatenate([cache_k, k_new], axis=1)
    v_all = jnp.concatenate([cache_v, v_new], axis=1)
    q_pos = PAST_LEN + jnp.arange(t_new)
    k_pos = PAST_LEN - rows + jnp.arange(rows + t_new)
    bias = rel_bias(rel_table, q_pos, k_pos)
    s = jnp.einsum('bqhd,bkhd->bhqk', q, k_all).astype(jnp.float32) * ATTN_SCALE + bias
    p = jax.nn.softmax(s, axis=-1).astype(v_all.dtype)
    return jnp.einsum('bhqk,bkhd->bqhd', p, v_all).reshape(bsz, t_new, ATTN_WIDTH)


def causal_conv(x, conv_state, conv_w, conv_b):
    t = x.shape[1]
    xp = jnp.concatenate([conv_state, x], axis=1)
    y = conv_b
    for i in range(CONV_W):
        y = y + xp[:, i:i + t] * conv_w[i]
    return y, xp[:, xp.shape[1] - (CONV_W - 1):]


def _linear_combine(c1, c2):
    a1, b1 = c1
    a2, b2 = c2
    return a1 * a2, a2 * b1 + b2


def rg_lru(x, h0, w_r, b_r, w_i, b_i, lam):
    bsz, t, width = x.shape
    xf = x.astype(jnp.float32)
    xb = xf.reshape(bsz, t, LRU_BLOCKS, LRU_BLOCK)
    r = jax.nn.sigmoid(jnp.einsum('btgi,gij->btgj', xb, w_r.astype(jnp.float32)).reshape(bsz, t, width)
                       + b_r.astype(jnp.float32))
    gi = jax.nn.sigmoid(jnp.einsum('btgi,gij->btgj', xb, w_i.astype(jnp.float32)).reshape(bsz, t, width)
                        + b_i.astype(jnp.float32))
    log_a = -LRU_C * r * jax.nn.softplus(-lam.astype(jnp.float32))
    a = jnp.exp(log_a)
    b = jnp.sqrt(-jnp.expm1(2.0 * log_a)) * (gi * xf)
    b = b.at[:, 0].add(a[:, 0] * h0.astype(jnp.float32))
    _, h = lax.associative_scan(_linear_combine, (a, b), axis=1)
    return h.astype(x.dtype), h[:, -1].astype(x.dtype)


def mixer_sublayer(x, conv_state, h0, attend, norm_g, w_in, conv_w, conv_b, w_r, b_r, w_i, b_i, lam,
                   w_ba, w_bl, w_o):
    bsz, t = x.shape[0], x.shape[1]
    xn = rmsnorm(x, norm_g)
    proj = jnp.einsum('btd,dc->btc', xn, w_in)
    q, k, v, x_r, g_branch, gate_a, gate_r = jnp.split(proj, SPLITS, axis=-1)
    q = q.reshape(bsz, t, N_HEADS, HEAD_DIM)
    k = k.reshape(bsz, t, N_HEADS, HEAD_DIM)
    v = v.reshape(bsz, t, N_HEADS, HEAD_DIM)
    o_attn = attend(q, k, v)
    x_conv, conv_new = causal_conv(x_r, conv_state, conv_w, conv_b)
    h, h_last = rg_lru(x_conv, h0, w_r, b_r, w_i, b_i, lam)
    o_lru = h * jax.nn.gelu(g_branch)
    merged = jax.nn.sigmoid(gate_a) * (o_attn @ w_ba) + jax.nn.sigmoid(gate_r) * (o_lru @ w_bl)
    return x + merged @ w_o, k, v, conv_new, h_last


def peer_tokens(xt, wq, keys1, keys2, expert_u, expert_v):
    t = xt.shape[0]
    q = (xt @ wq).reshape(t, PEER_HEADS, 2, HALF_KEY)
    s1 = jnp.einsum('thd,hnd->thn', q[:, :, 0], keys1).astype(jnp.float32)
    s2 = jnp.einsum('thd,hnd->thn', q[:, :, 1], keys2).astype(jnp.float32)
    v1, i1 = lax.top_k(s1, TOPK_HALF)
    v2, i2 = lax.top_k(s2, TOPK_HALF)
    cand_s = (v1[..., :, None] + v2[..., None, :]).reshape(t, PEER_HEADS, TOPK_HALF * TOPK_HALF)
    cand_i = (i1[..., :, None] * N_KEYS + i2[..., None, :]).reshape(t, PEER_HEADS, TOPK_HALF * TOPK_HALF)
    top_s, pos = lax.top_k(cand_s, TOPK)
    e_idx = jnp.take_along_axis(cand_i, pos, axis=-1)
    g = jax.nn.softmax(top_s, axis=-1)
    u_sel = expert_u[e_idx]
    act = jax.nn.gelu(jnp.einsum('thkd,td->thk', u_sel, xt).astype(jnp.float32))
    return jnp.einsum('thk,thkd->td', (g * act).astype(xt.dtype), expert_v[e_idx])


def peer_sublayer(x, norm_g, wq, keys1, keys2, expert_u, expert_v, blocked):
    xt = rmsnorm(x, norm_g).reshape(-1, D_MODEL)
    if blocked:
        out = lax.map(lambda xb: peer_tokens(xb, wq, keys1, keys2, expert_u, expert_v),
                      xt.reshape(-1, TOKEN_BLOCK, D_MODEL))
    else:
        out = peer_tokens(xt, wq, keys1, keys2, expert_u, expert_v)
    return x + out.reshape(x.shape)


def setup_inputs(seed: int = 0) -> dict:
    key = jax.random.key(seed)
    ks = jax.random.split(key, 26)
    kv_rows = min(BAND, PAST_LEN)

    def nrm(k, shape, scale):
        return jax.random.normal(k, shape, jnp.float32) * scale

    u = jax.random.uniform(ks[15], (DEPTH, LRU_WIDTH), jnp.float32, 0.9, 0.999)
    a_base = u ** (1.0 / LRU_C)
    lam = jnp.log(a_base) - jnp.log1p(-a_base)
    return {
        'x_prompt': nrm(ks[0], (BATCH, SEQ, D_MODEL), 1.0),
        'x_sample': nrm(ks[1], (DEC_BATCH, DEC_SEQ, D_MODEL), 1.0),
        'cache_k': nrm(ks[2], (DEPTH, DEC_BATCH, kv_rows, N_HEADS, HEAD_DIM), 1.0),
        'cache_v': nrm(ks[3], (DEPTH, DEC_BATCH, kv_rows, N_HEADS, HEAD_DIM), 1.0),
        'state_conv': nrm(ks[4], (DEPTH, DEC_BATCH, CONV_W - 1, LRU_WIDTH), 1.0),
        'state_lru': nrm(ks[5], (DEPTH, DEC_BATCH, LRU_WIDTH), 0.5),
        'norm_mix': 1.0 + nrm(ks[6], (DEPTH, D_MODEL), 0.02),
        'w_in': nrm(ks[7], (DEPTH, D_MODEL, IN_COLS), D_MODEL ** -0.5),
        'rel_table': nrm(ks[8], (DEPTH, N_HEADS, 2 * MAX_REL + 1), 0.1),
        'conv_w': nrm(ks[9], (DEPTH, CONV_W, LRU_WIDTH), CONV_W ** -0.5),
        'conv_b': nrm(ks[10], (DEPTH, LRU_WIDTH), 0.01),
        'lru_wr': nrm(ks[11], (DEPTH, LRU_BLOCKS, LRU_BLOCK, LRU_BLOCK), LRU_BLOCK ** -0.5),
        'lru_br': nrm(ks[12], (DEPTH, LRU_WIDTH), 0.01),
        'lru_wi': nrm(ks[13], (DEPTH, LRU_BLOCKS, LRU_BLOCK, LRU_BLOCK), LRU_BLOCK ** -0.5),
        'lru_bi': nrm(ks[14], (DEPTH, LRU_WIDTH), 0.01),
        'lru_lambda': lam,
        'w_branch_attn': nrm(ks[16], (DEPTH, ATTN_WIDTH, D_MODEL), ATTN_WIDTH ** -0.5),
        'w_branch_lru': nrm(ks[17], (DEPTH, LRU_WIDTH, D_MODEL), LRU_WIDTH ** -0.5),
        'w_out': nrm(ks[18], (DEPTH, D_MODEL, D_MODEL), D_MODEL ** -0.5),
        'norm_ffn': 1.0 + nrm(ks[19], (DEPTH, D_MODEL), 0.02),
        'peer_wq': nrm(ks[20], (DEPTH, D_MODEL, PEER_HEADS * D_KEY), D_MODEL ** -0.5),
        'peer_keys1': nrm(ks[21], (DEPTH, PEER_HEADS, N_KEYS, HALF_KEY), HALF_KEY ** -0.5),
        'peer_keys2': nrm(ks[22], (DEPTH, PEER_HEADS, N_KEYS, HALF_KEY), HALF_KEY ** -0.5),
        'peer_u': nrm(ks[23], (DEPTH, N_EXPERTS, D_MODEL), D_MODEL ** -0.5),
        'peer_v': nrm(ks[24], (DEPTH, N_EXPERTS, D_MODEL), D_MODEL ** -0.5),
        'norm_final': 1.0 + nrm(ks[25], (D_MODEL,), 0.02),
    }


def reference(x_prompt, x_sample, cache_k, cache_v, state_conv, state_lru, norm_mix, w_in, rel_table,
              conv_w, conv_b, lru_wr, lru_br, lru_wi, lru_bi, lru_lambda, w_branch_attn, w_branch_lru,
              w_out, norm_ffn, peer_wq, peer_keys1, peer_keys2, peer_u, peer_v, norm_final):
    xp = x_prompt
    xs = x_sample
    k_prompt_l, v_prompt_l, conv_prompt_l, lru_prompt_l = [], [], [], []
    k_sample_l, v_sample_l, conv_sample_l, lru_sample_l = [], [], [], []
    for l in range(DEPTH):
        mix_w = (norm_mix[l], w_in[l], conv_w[l], conv_b[l], lru_wr[l], lru_br[l], lru_wi[l], lru_bi[l],
                 lru_lambda[l], w_branch_attn[l], w_branch_lru[l], w_out[l])
        ffn_w = (norm_ffn[l], peer_wq[l], peer_keys1[l], peer_keys2[l], peer_u[l], peer_v[l])
        rt = rel_table[l]
        ck = cache_k[l]
        cv = cache_v[l]
        conv0 = jnp.zeros((xp.shape[0], CONV_W - 1, LRU_WIDTH), xp.dtype)
        h_zero = jnp.zeros((xp.shape[0], LRU_WIDTH), xp.dtype)
        xp, k_p, v_p, c_p, h_p = mixer_sublayer(
            xp, conv0, h_zero, lambda q, k, v: band_attention_prompt(q, k, v, rt), *mix_w)
        xp = peer_sublayer(xp, *ffn_w, True)
        xs, k_s, v_s, c_s, h_s = mixer_sublayer(
            xs, state_conv[l], state_lru[l],
            lambda q, k, v: band_attention_sample(q, k, v, ck, cv, rt), *mix_w)
        xs = peer_sublayer(xs, *ffn_w, False)
        rows_p = min(BAND, k_p.shape[1])
        k_prompt_l.append(k_p[:, k_p.shape[1] - rows_p:])
        v_prompt_l.append(v_p[:, v_p.shape[1] - rows_p:])
        conv_prompt_l.append(c_p)
        lru_prompt_l.append(h_p)
        k_sample_l.append(k_s)
        v_sample_l.append(v_s)
        conv_sample_l.append(c_s)
        lru_sample_l.append(h_s)
    y_prompt = rmsnorm(xp, norm_final)
    y_sample = rmsnorm(xs, norm_final)
    return (y_prompt, y_sample,
            jnp.stack(k_prompt_l), jnp.stack(v_prompt_l), jnp.stack(conv_prompt_l), jnp.stack(lru_prompt_l),
            jnp.stack(k_sample_l), jnp.stack(v_sample_l), jnp.stack(conv_sample_l), jnp.stack(lru_sample_l))
```

```cpp
#include <hip/hip_runtime.h>
#include <hip/hip_cooperative_groups.h>
#include <cstdint>
#include <cstdio>
namespace cg = cooperative_groups;

#define LAS __attribute__((address_space(3)))
typedef unsigned short bf16_t;
typedef short bf16x8 __attribute__((ext_vector_type(8)));
typedef float f32x4 __attribute__((ext_vector_type(4)));
typedef float f32x2 __attribute__((ext_vector_type(2)));
typedef float f32x16 __attribute__((ext_vector_type(16)));
typedef unsigned u32x4 __attribute__((ext_vector_type(4)));
typedef unsigned u32x2 __attribute__((ext_vector_type(2)));
typedef __bf16 bf16x2_t __attribute__((ext_vector_type(2)));

constexpr int DM = 1024, SEQ = 4096, NB = 16, NTP = NB * SEQ, NSB = 8, NST = 16, NTS = NSB * NST, NTOK = NTP + NTS;
constexpr int ROWS = 65792, NMT = 257;
constexpr int INC = 7168, NEXP = 16384;
constexpr float EPS = 1e-6f, LOG2E = 1.4426950408889634f;
constexpr float QSCALE = 0.125f * LOG2E;

constexpr size_t MiB = 1u << 20;
constexpr size_t BUF = (size_t)ROWS * DM * 2;
constexpr size_t WS_CTL = 0;
constexpr size_t WS_WIN = 1 * MiB;
constexpr size_t WS_WBA = 16 * MiB, WS_WBL = 18 * MiB, WS_WO = 20 * MiB, WS_WS = 22 * MiB;
constexpr size_t WS_LRUW = 26 * MiB;
constexpr size_t WS_SGA = 27 * MiB, WS_SGR = 27 * MiB + 512 * 1024;
constexpr size_t WS_UB = 28 * MiB, WS_VB = 60 * MiB;
constexpr size_t WS_Q = 92 * MiB;
constexpr size_t WS_XN = WS_Q + BUF;
constexpr size_t WS_K = WS_XN + BUF;
constexpr size_t WS_VT = WS_K + BUF;
constexpr size_t WS_XR = WS_VT + BUF;
constexpr size_t WS_G = WS_XR + BUF;
constexpr size_t WS_END = WS_G + BUF;

constexpr size_t O_YP = 0, O_YS = O_YP + (size_t)NTP * DM, O_KP = O_YS + (size_t)NTS * DM, O_VP = O_KP + (size_t)NB * 512 * DM,
                 O_CP = O_VP + (size_t)NB * 512 * DM, O_LP = O_CP + (size_t)NB * 3 * DM, O_KS = O_LP + (size_t)NB * DM, O_VS = O_KS + (size_t)NTS * DM,
                 O_CS = O_VS + (size_t)NTS * DM, O_LS = O_CS + (size_t)NSB * 3 * DM, O_END = O_LS + (size_t)NSB * DM;

constexpr int LDS_BYTES = 135168;

__device__ __forceinline__ unsigned cvtpk(float lo, float hi) { f32x2 v = {lo, hi}; bf16x2_t b = __builtin_convertvector(v, bf16x2_t); return __builtin_bit_cast(unsigned, b); }
__device__ __forceinline__ float bflo(unsigned u) { return __uint_as_float(u << 16); }
__device__ __forceinline__ float bfhi(unsigned u) { return __uint_as_float(u & 0xffff0000u); }
__device__ __forceinline__ float fast_exp2(float x) { return __builtin_amdgcn_exp2f(x); }
__device__ __forceinline__ float fast_rcp(float x) { return __builtin_amdgcn_rcpf(x); }
__device__ __forceinline__ float sigmoidf_(float z) { return fast_rcp(1.0f + fast_exp2(-z * LOG2E)); }
__device__ __forceinline__ float gelu_tanh(float x) { const float u = x + 0.044715f * x * x * x; return x * fast_rcp(1.0f + fast_exp2(-1.5957691216f * LOG2E * u)); }
__device__ __forceinline__ float wave_sum(float v) {
#pragma unroll
    for (int o = 1; o < 64; o <<= 1) v += __shfl_xor(v, o);
    return v;
}
__device__ __forceinline__ int swap23(int i) { return (i & ~12) | ((i & 4) << 1) | ((i & 8) >> 1); }
__device__ __forceinline__ float plswap_max(float m) { auto rr = __builtin_amdgcn_permlane32_swap(__float_as_uint(m), __float_as_uint(m), false, false); return fmaxf(__uint_as_float(rr[0]), __uint_as_float(rr[1])); }
__device__ __forceinline__ float plswap_add(float m) { auto rr = __builtin_amdgcn_permlane32_swap(__float_as_uint(m), __float_as_uint(m), false, false); return __uint_as_float(rr[0]) + __uint_as_float(rr[1]); }

namespace pg8 {
constexpr int BM = 256, BK = 64, HALF = 128, HTB = HALF * BK * 2, STAGE_BYTES = 8 * HTB, NXCD = 8, WGM = 8;
__host__ __device__ __forceinline__ int lds_byte(int r, int c) { const int st = (r >> 4) * 2 + (c >> 5), rr = r & 15, cc = c & 31, ob = rr * 64 + cc * 2; return st * 1024 + (ob ^ (((ob >> 9) & 1) << 5)); }
__host__ __device__ __forceinline__ void stage_rc(int b, int& R, int& C) { const int st = b / 1024, sb = b % 1024, swz = sb ^ (((sb >> 9) & 1) << 5); R = (st >> 1) * 16 + swz / 64; C = (st & 1) * 32 + (swz % 64) / 2; }
__host__ __device__ __forceinline__ int perm32(int rho) { const int n = rho >> 4, i = rho & 15; return 8 * (i >> 2) + 4 * n + (i & 3); }

struct Unit { int pm, pn, kind; };
struct Gemm { const bf16_t* A0; const bf16_t* B0; const bf16_t* A1; const bf16_t* B1; int K; };

struct TileMap {
    int nM, nN, nwg;
    __device__ __forceinline__ void init(int nM_, int nN_) { nM = nM_; nN = nN_; nwg = nM * nN; }
    __device__ __forceinline__ void map(int L, int& pm, int& pn) const {
        int wgid = L; { const int q = nwg / NXCD, r = nwg % NXCD, xcd = wgid % NXCD, off = wgid / NXCD; wgid = (xcd < r ? xcd * (q + 1) : r * (q + 1) + (xcd - r) * q) + off; }
        const int nig = WGM * nN, gid = wgid / nig, fm = gid * WGM, gsz = (nM - fm) < WGM ? (nM - fm) : WGM;
        pm = fm + ((wgid % nig) % gsz); pn = (wgid % nig) / gsz;
    }
};

template <class Epi, class Sched>
__device__ __forceinline__ void gemm_phase(LAS unsigned char* lds, const Gemm g, const Sched& S, const Epi& E) {
    const int tid = threadIdx.x, wid = __builtin_amdgcn_readfirstlane(tid >> 6), lane = tid & 63, wr = wid >> 2, wc = wid & 3, fr = lane & 15, fq = lane >> 4;
    const int K = g.K, nt = K / BK;
    unsigned voffA[2], voffB[2];
#pragma unroll
    for (int i = 0; i < 2; ++i) { int R, C; stage_rc(tid * 16 + i * 8192, R, C); const int Rb = (R & ~31) + perm32(R & 31);
        voffA[i] = (unsigned)(R * K + C) * 2u; voffB[i] = (unsigned)(Rb * K + C) * 2u; }
    const size_t kstep = (size_t)(BK * 2);
    const size_t hstep = (size_t)HALF * K * 2;
    const size_t tstep = 2 * hstep;
    const unsigned ldsw = (unsigned)wid * 1024u;
    const int aoff = lds_byte(wr * 64 + fr, fq * 8), boff = lds_byte(wc * 32 + fr, fq * 8);
#define PG8_SA(b, h) (((b) * 2 + (h)) * HTB)
#define PG8_SB(b, h) ((4 + (b) * 2 + (h)) * HTB)
#define PG8_STAGE(bufoff, gbase, voff) do { _Pragma("unroll") for (int _i = 0; _i < 2; ++_i) \
        __builtin_amdgcn_global_load_lds((const unsigned*)((const char*)(gbase) + (voff)[_i]), (LAS unsigned*)(lds + (bufoff) + ldsw + _i * 8192), 16, 0, 0); } while (0)
#define PG8_LDA(dst, b, h) do { _Pragma("unroll") for (int m = 0; m < 4; ++m) _Pragma("unroll") for (int k = 0; k < 2; ++k) dst[m][k] = *(const LAS bf16x8*)(lds + PG8_SA(b, h) + aoff + m * 2048 + k * 1024); } while (0)
#define PG8_LDB(dst, b, h) do { _Pragma("unroll") for (int n = 0; n < 2; ++n) _Pragma("unroll") for (int k = 0; k < 2; ++k) dst[n][k] = *(const LAS bf16x8*)(lds + PG8_SB(b, h) + boff + n * 2048 + k * 1024); } while (0)
#define PG8_MMA(ai, bj, At, Bt) do { __builtin_amdgcn_s_setprio(1); _Pragma("unroll") for (int m = 0; m < 4; ++m) _Pragma("unroll") for (int n = 0; n < 2; ++n) _Pragma("unroll") for (int k = 0; k < 2; ++k) \
        acc[ai][bj][m][n] = __builtin_amdgcn_mfma_f32_16x16x32_bf16(Bt[n][k], At[m][k], acc[ai][bj][m][n], 0, 0, 0); __builtin_amdgcn_s_setprio(0); } while (0)
#define PG8_WAIT_V(n) asm volatile("s_waitcnt vmcnt(" #n ")" ::: "memory")
#define PG8_WAIT_L(n) asm volatile("s_waitcnt lgkmcnt(" #n ")" ::: "memory")
#define PG8_BAR __builtin_amdgcn_s_barrier()
#define PG8_SCHED __builtin_amdgcn_sched_barrier(0)
    Unit cur, nxt; int ui = 0;
    if (!S.next(0, cur)) return;
    f32x4 acc[2][2][4][2];
#pragma unroll
    for (int a = 0; a < 2; ++a)
#pragma unroll
        for (int b = 0; b < 2; ++b)
#pragma unroll
            for (int m = 0; m < 4; ++m)
#pragma unroll
                for (int n = 0; n < 2; ++n) acc[a][b][m][n] = (f32x4){0.f, 0.f, 0.f, 0.f};
    bf16x8 At[4][2], B0[2][2], B1[2][2];
    const char* cA = (const char*)(cur.kind ? g.A1 : g.A0) + (size_t)cur.pm * tstep; const char* cB = (const char*)(cur.kind ? g.B1 : g.B0) + (size_t)cur.pn * tstep;
    PG8_STAGE(PG8_SB(0, 0), cB, voffB); PG8_STAGE(PG8_SB(0, 1), cB + hstep, voffB); PG8_STAGE(PG8_SA(0, 0), cA, voffA); PG8_STAGE(PG8_SA(0, 1), cA + hstep, voffA);
    if (wr == 1) PG8_BAR;
    PG8_WAIT_V(2); PG8_BAR;
    PG8_STAGE(PG8_SB(1, 0), cB + kstep, voffB); PG8_STAGE(PG8_SA(1, 0), cA + kstep, voffA); PG8_STAGE(PG8_SB(1, 1), cB + hstep + kstep, voffB);
    PG8_WAIT_V(6); PG8_BAR;
    for (;;) {
        const bool has_next = S.next(ui + 1, nxt);
        const char* nA = has_next ? (const char*)(nxt.kind ? g.A1 : g.A0) + (size_t)nxt.pm * tstep : cA; const char* nB = has_next ? (const char*)(nxt.kind ? g.B1 : g.B0) + (size_t)nxt.pn * tstep : cB;
        for (int t = 0; t < nt; t += 2) {
            const bool last = (t == nt - 2);
            const char* a1 = cA + (size_t)(t + 1) * kstep;
            const char* a2 = last ? nA : cA + (size_t)(t + 2) * kstep; const char* b2 = last ? nB : cB + (size_t)(t + 2) * kstep;
            const char* a3 = a2 + kstep; const char* b3 = b2 + kstep;
            PG8_LDB(B0, 0, 0); PG8_LDB(B1, 0, 1); PG8_SCHED; PG8_LDA(At, 0, 0); PG8_STAGE(PG8_SA(1, 1), a1 + hstep, voffA);
            PG8_WAIT_V(8); PG8_WAIT_L(0); PG8_BAR; PG8_MMA(0, 0, At, B0); PG8_MMA(0, 1, At, B1); PG8_BAR; PG8_SCHED;
            PG8_LDA(At, 0, 1); PG8_STAGE(PG8_SB(0, 0), b2, voffB); PG8_STAGE(PG8_SB(0, 1), b2 + hstep, voffB); PG8_STAGE(PG8_SA(0, 0), a2, voffA);
            PG8_WAIT_V(8); PG8_WAIT_L(0); PG8_BAR; PG8_MMA(1, 0, At, B0); PG8_MMA(1, 1, At, B1); PG8_BAR; PG8_SCHED;
            PG8_LDB(B0, 1, 0); PG8_LDB(B1, 1, 1); PG8_SCHED; PG8_LDA(At, 1, 0); PG8_STAGE(PG8_SA(0, 1), a2 + hstep, voffA);
            PG8_WAIT_V(8); PG8_WAIT_L(0); PG8_BAR; PG8_MMA(0, 0, At, B0); PG8_MMA(0, 1, At, B1); PG8_BAR; PG8_SCHED;
            PG8_LDA(At, 1, 1); PG8_STAGE(PG8_SB(1, 0), b3, voffB); PG8_STAGE(PG8_SB(1, 1), b3 + hstep, voffB); PG8_STAGE(PG8_SA(1, 0), a3, voffA);
            PG8_WAIT_V(8); PG8_WAIT_L(0); PG8_BAR; PG8_MMA(1, 0, At, B0); PG8_MMA(1, 1, At, B1); PG8_BAR; PG8_SCHED;
        }
        if (wr == 0) PG8_BAR;
        E(acc, cur, wr, wc, fr, fq);
        if (!has_next) break;
#pragma unroll
        for (int a = 0; a < 2; ++a)
#pragma unroll
            for (int b = 0; b < 2; ++b)
#pragma unroll
                for (int m = 0; m < 4; ++m)
#pragma unroll
                    for (int n = 0; n < 2; ++n) acc[a][b][m][n] = (f32x4){0.f, 0.f, 0.f, 0.f};
        cur = nxt; cA = nA; cB = nB; ++ui;
        if (wr == 1) PG8_BAR;
    }
    PG8_WAIT_V(0);
    PG8_BAR;
#undef PG8_SA
#undef PG8_SB
#undef PG8_STAGE
#undef PG8_LDA
#undef PG8_LDB
#undef PG8_MMA
#undef PG8_WAIT_V
#undef PG8_WAIT_L
#undef PG8_BAR
#undef PG8_SCHED
}
}
using pg8::Unit;

struct Args {
    const float* in[26];
    float* out; unsigned char* ws;
    int ph_lo, ph_hi, use_sync, pad;
};

typedef const __attribute__((address_space(4))) Args* ArgsP;
#define KA ((ArgsP)__builtin_amdgcn_kernarg_segment_ptr())
#define A_IN(k) (KA->in[k])
#define A_OUT (KA->out)
#define A_WS (KA->ws)

struct SchedG1 {
    pg8::TileMap m0, m1; int G, c;
    __device__ __forceinline__ void init(int G_, int c_) { m0.init(NMT, 24); m1.init(4, NMT); G = G_; c = c_; }
    __device__ __forceinline__ bool next(int i, Unit& u) const {
        int L = i * G + c;
        if (L < m0.nwg) { m0.map(L, u.pm, u.pn); u.pn = (u.pn < 8) ? u.pn : u.pn + 4; u.kind = 0; return true; }
        L -= m0.nwg; if (L >= m1.nwg) return false;
        m1.map(L, u.pm, u.pn); u.kind = 1; return true;
    }
};
struct SchedPair {
    pg8::TileMap m0; int G, c;
    __device__ __forceinline__ void init(int nN, int G_, int c_) { m0.init(NMT, nN); G = G_; c = c_; }
    __device__ __forceinline__ bool next(int i, Unit& u) const { const int L = (i >> 1) * G + c; if (L >= m0.nwg) return false; m0.map(L, u.pm, u.pn); u.kind = i & 1; return true; }
};
struct SchedOne {
    pg8::TileMap m0; int G, c;
    __device__ __forceinline__ void init(int nN, int G_, int c_) { m0.init(NMT, nN); G = G_; c = c_; }
    __device__ __forceinline__ bool next(int i, Unit& u) const { const int L = i * G + c; if (L >= m0.nwg) return false; m0.map(L, u.pm, u.pn); u.kind = 0; return true; }
};

#define EPI_PREP int fr_ = fr, fq_ = fq; asm volatile("" : "+v"(fr_), "+v"(fq_)); const int rl_ = wr * 64 + fr_, cl_ = wc * 32 + 8 * fq_;
#define EPI_LOOP_BEGIN \
    _Pragma("unroll") for (int ai = 0; ai < 2; ++ai) _Pragma("unroll") for (int m = 0; m < 4; ++m) { const int rit = ai * 128 + m * 16 + rl_; \
    _Pragma("unroll") for (int bj = 0; bj < 2; ++bj) { const int cit = bj * 128 + cl_; f32x4 v0 = acc[ai][bj][m][0], v1 = acc[ai][bj][m][1];
#define EPI_LOOP_END } }

struct EpiG1 {
    __device__ __forceinline__ void operator()(const f32x4 (&acc)[2][2][4][2], const Unit& u, int wr, int wc, int fr, int fq) const {
        EPI_PREP unsigned char* ws = A_WS; float* out = A_OUT;
        if (u.kind == 0) {
            const int t = u.pn >> 2, ct = (u.pn & 3) * 256;
            bf16_t* base;
            if (t == 0) base = (bf16_t*)(ws + WS_Q); else if (t == 1) base = (bf16_t*)(ws + WS_K); else if (t == 3) base = (bf16_t*)(ws + WS_XR); else if (t == 4) base = (bf16_t*)(ws + WS_G);
            else if (t == 5) base = (u.pm < 256) ? (bf16_t*)(out + O_YP) : (bf16_t*)(ws + WS_SGA) - (size_t)NTP * DM;
            else base = (u.pm < 256) ? (bf16_t*)(out + O_YP) + (size_t)NTP * DM : (bf16_t*)(ws + WS_SGR) - (size_t)NTP * DM;
            base += (size_t)u.pm * 256 * DM + ct;
            EPI_LOOP_BEGIN
                u32x4 w; w.x = cvtpk(v0[0], v0[1]); w.y = cvtpk(v0[2], v0[3]); w.z = cvtpk(v1[0], v1[1]); w.w = cvtpk(v1[2], v1[3]);
                *(u32x4*)(base + (size_t)rit * DM + cit) = w;
            EPI_LOOP_END
            if (t == 1 && u.pm < 256 && (u.pm & 15) >= 14) { float* p0 = out + O_KP + ((size_t)(u.pm >> 4) * 512 + ((u.pm & 15) - 14) * 256) * DM + ct;
                EPI_LOOP_BEGIN float* p = p0 + (size_t)rit * DM + cit; *(f32x4*)p = v0; *(f32x4*)(p + 4) = v1; EPI_LOOP_END }
            if (t == 1 && u.pm == 256) { float* p0 = out + O_KS + ct;
                EPI_LOOP_BEGIN if (rit < NTS) { float* p = p0 + (size_t)rit * DM + cit; *(f32x4*)p = v0; *(f32x4*)(p + 4) = v1; } EPI_LOOP_END }
            if (t == 3 && u.pm < 256 && (u.pm & 15) == 15) { float* p0 = out + O_CP + ((size_t)(u.pm >> 4) * 3) * DM + ct;
                EPI_LOOP_BEGIN if (rit >= 253) { float* p = p0 + (size_t)(rit - 253) * DM + cit; *(f32x4*)p = v0; *(f32x4*)(p + 4) = v1; } EPI_LOOP_END }
            if (t == 3 && u.pm == 256) { float* p0 = out + O_CS + ct;
                EPI_LOOP_BEGIN if (rit < NTS && (rit & 15) >= 13) { float* p = p0 + ((size_t)(rit >> 4) * 3 + ((rit & 15) - 13)) * DM + cit; *(f32x4*)p = v0; *(f32x4*)(p + 4) = v1; } EPI_LOOP_END }
        } else {
            bf16_t* VT = (bf16_t*)(ws + WS_VT) + (size_t)u.pm * 256 * ROWS + (size_t)u.pn * 256;
            EPI_LOOP_BEGIN
                u32x4 w; w.x = cvtpk(v0[0], v0[1]); w.y = cvtpk(v0[2], v0[3]); w.z = cvtpk(v1[0], v1[1]); w.w = cvtpk(v1[2], v1[3]);
                *(u32x4*)(VT + (size_t)rit * ROWS + cit) = w;
            EPI_LOOP_END
            if (u.pn < 256 && (u.pn & 15) >= 14) { float* p0 = out + O_VP + ((size_t)(u.pn >> 4) * 512 + ((u.pn & 15) - 14) * 256) * DM + u.pm * 256;
                EPI_LOOP_BEGIN float* p = p0 + (size_t)cit * DM + rit;
                    p[0] = v0[0]; p[DM] = v0[1]; p[2 * DM] = v0[2]; p[3 * DM] = v0[3]; p[4 * DM] = v1[0]; p[5 * DM] = v1[1]; p[6 * DM] = v1[2]; p[7 * DM] = v1[3]; EPI_LOOP_END }
            if (u.pn == 256) { float* p0 = out + O_VS + u.pm * 256;
                EPI_LOOP_BEGIN if (cit < NTS) { float* p = p0 + (size_t)cit * DM + rit;
                    p[0] = v0[0]; p[DM] = v0[1]; p[2 * DM] = v0[2]; p[3 * DM] = v0[3]; p[4 * DM] = v1[0]; p[5 * DM] = v1[1]; p[6 * DM] = v1[2]; p[7 * DM] = v1[3]; } EPI_LOOP_END }
        }
    }
};

struct EpiP3 {
    __device__ __forceinline__ void operator()(const f32x4 (&acc)[2][2][4][2], const Unit& u, int wr, int wc, int fr, int fq) const {
        EPI_PREP unsigned char* ws = A_WS; float* out = A_OUT;
        const bf16_t* gb = (u.pm < 256) ? (const bf16_t*)(out + O_YP) + (u.kind ? (size_t)NTP * DM : 0) : (const bf16_t*)(ws + (u.kind ? WS_SGR : WS_SGA)) - (size_t)NTP * DM;
        const size_t off0 = (size_t)u.pm * 256 * DM + u.pn * 256;
        gb += off0; float* T1 = (float*)(ws + WS_K) + off0; bf16_t* MG = (bf16_t*)(ws + WS_XN) + off0;
        EPI_LOOP_BEGIN
            const size_t off = (size_t)rit * DM + cit;
            const u32x4 gw = *(const u32x4*)(gb + off);
            f32x4 s0, s1;
            s0[0] = sigmoidf_(bflo(gw.x)); s0[1] = sigmoidf_(bfhi(gw.x)); s0[2] = sigmoidf_(bflo(gw.y)); s0[3] = sigmoidf_(bfhi(gw.y));
            s1[0] = sigmoidf_(bflo(gw.z)); s1[1] = sigmoidf_(bfhi(gw.z)); s1[2] = sigmoidf_(bflo(gw.w)); s1[3] = sigmoidf_(bfhi(gw.w));
            if (u.kind == 0) { *(f32x4*)(T1 + off) = s0 * v0; *(f32x4*)(T1 + off + 4) = s1 * v1; }
            else { const f32x4 a0 = *(const f32x4*)(T1 + off) + s0 * v0, a1 = *(const f32x4*)(T1 + off + 4) + s1 * v1;
                u32x4 w; w.x = cvtpk(a0[0], a0[1]); w.y = cvtpk(a0[2], a0[3]); w.z = cvtpk(a1[0], a1[1]); w.w = cvtpk(a1[2], a1[3]);
                *(u32x4*)(MG + off) = w; }
        EPI_LOOP_END
    }
};

struct EpiP4 {
    __device__ __forceinline__ void operator()(const f32x4 (&acc)[2][2][4][2], const Unit& u, int wr, int wc, int fr, int fq) const {
        EPI_PREP float* out = A_OUT;
        if (u.pm < 256) { const size_t off0 = (size_t)u.pm * 256 * DM + u.pn * 256; const float* xp = A_IN(0) + off0; float* yo = out + O_YP + off0;
            EPI_LOOP_BEGIN const size_t off = (size_t)rit * DM + cit;
                *(f32x4*)(yo + off) = *(const f32x4*)(xp + off) + v0; *(f32x4*)(yo + off + 4) = *(const f32x4*)(xp + off + 4) + v1; EPI_LOOP_END }
        else { const float* xs = A_IN(1) + u.pn * 256; float* yo = out + O_YS + u.pn * 256;
            EPI_LOOP_BEGIN if (rit < NTS) { const size_t off = (size_t)rit * DM + cit;
                *(f32x4*)(yo + off) = *(const f32x4*)(xs + off) + v0; *(f32x4*)(yo + off + 4) = *(const f32x4*)(xs + off + 4) + v1; } EPI_LOOP_END }
    }
};

struct EpiP5 {
    __device__ __forceinline__ void operator()(const f32x4 (&acc)[2][2][4][2], const Unit& u, int wr, int wc, int fr, int fq) const {
        EPI_PREP float* SC = (float*)(A_WS + WS_XN) + (size_t)u.pm * 256 * 2048 + u.pn * 256;
        EPI_LOOP_BEGIN
            float* p = SC + (size_t)rit * 2048 + cit; *(f32x4*)p = v0; *(f32x4*)(p + 4) = v1;
        EPI_LOOP_END
    }
};

__device__ __forceinline__ void p0_transpose_item(const float* W, int K, int N, bf16_t* WT, LAS float* scr, int item, int lane, int nscale = 0) {
    const int nblk = N / 32, kb = item / nblk, nb = item % nblk, k0 = 64 * kb, n0 = 32 * nb;
#pragma unroll 8
    for (int i = 0; i < 32; ++i) { const int kk = 2 * i + (lane >> 5); scr[kk * 33 + (lane & 31)] = W[(size_t)(k0 + kk) * N + n0 + (lane & 31)] * (n0 < nscale ? QSCALE : 1.0f); }
    asm volatile("s_waitcnt lgkmcnt(0)" ::: "memory");
    const int c = lane & 7;
#pragma unroll
    for (int j = 0; j < 4; ++j) { const int n = (lane >> 3) + 8 * j; const LAS float* s = scr + (8 * c) * 33 + n;
        u32x4 o; o.x = cvtpk(s[0 * 33], s[1 * 33]); o.y = cvtpk(s[2 * 33], s[3 * 33]); o.z = cvtpk(s[4 * 33], s[5 * 33]); o.w = cvtpk(s[6 * 33], s[7 * 33]);
        *(u32x4*)(WT + (size_t)(n0 + n) * K + k0 + 8 * c) = o; }
    asm volatile("s_waitcnt lgkmcnt(0)" ::: "memory");
}

__device__ __forceinline__ void p0_prologue(LAS unsigned char* lds, int G, int wave, int lane) {
    unsigned char* ws = A_WS;
    const int gw = blockIdx.x * 8 + wave, NGW = G * 8;
    LAS float* scr = (LAS float*)(lds + wave * 16384);
    constexpr int I_IN = 16 * (INC / 32), I_SQ = 16 * 32, NTR = I_IN + 3 * I_SQ;
    for (int it = gw; it < NTR; it += NGW) {
        int r = it;
        if (r < I_IN) { p0_transpose_item(A_IN(7), DM, INC, (bf16_t*)(ws + WS_WIN), scr, r, lane, 1024); continue; } r -= I_IN;
        if (r < I_SQ) { p0_transpose_item(A_IN(16), DM, DM, (bf16_t*)(ws + WS_WBA), scr, r, lane); continue; } r -= I_SQ;
        if (r < I_SQ) { p0_transpose_item(A_IN(17), DM, DM, (bf16_t*)(ws + WS_WBL), scr, r, lane); continue; } r -= I_SQ;
        p0_transpose_item(A_IN(18), DM, DM, (bf16_t*)(ws + WS_WO), scr, r, lane);
    }
    {
        const float* wq = A_IN(20); bf16_t* wst = (bf16_t*)(ws + WS_WS);
        const int r32 = lane & 31, hi = lane >> 5;
        for (int it = gw; it < 2048; it += NGW) {
            const int hj = it >> 7, kt = (it >> 5) & 3, ct = it & 31, h = hj >> 1, j = hj & 1;
            const float* ap = (j ? A_IN(22) : A_IN(21)) + ((size_t)(h * 128 + kt * 32 + r32)) * 128 + 64 * hi;
            const float* bp = wq + (size_t)(ct * 32 + r32) * 2048 + hj * 128 + 64 * hi;
            f32x16 acc = {};
#pragma unroll
            for (int s4 = 0; s4 < 16; ++s4) { const f32x4 av = *(const f32x4*)(ap + 4 * s4), bv = *(const f32x4*)(bp + 4 * s4);
                acc = __builtin_amdgcn_mfma_f32_32x32x2f32(av[0], bv[0], acc, 0, 0, 0); acc = __builtin_amdgcn_mfma_f32_32x32x2f32(av[1], bv[1], acc, 0, 0, 0);
                acc = __builtin_amdgcn_mfma_f32_32x32x2f32(av[2], bv[2], acc, 0, 0, 0); acc = __builtin_amdgcn_mfma_f32_32x32x2f32(av[3], bv[3], acc, 0, 0, 0); }
#pragma unroll
            for (int r = 0; r < 16; ++r) { const int key = kt * 32 + (r & 3) + 8 * (r >> 2) + 4 * hi;
                wst[(size_t)(hj * 128 + key) * DM + ct * 32 + r32] = (bf16_t)(cvtpk(acc[r], 0.f) & 0xffffu); }
        }
    }
    for (int it = gw; it < 2 * NEXP; it += NGW) {
        const int tb = it >= NEXP, e = it - tb * NEXP;
        const float* src = (tb ? A_IN(24) : A_IN(23)) + (size_t)e * DM; bf16_t* dst = (bf16_t*)(ws + (tb ? WS_VB : WS_UB)) + (size_t)e * DM;
#pragma unroll
        for (int hh = 0; hh < 2; ++hh) { const f32x4 p = *(const f32x4*)(src + hh * 512 + lane * 8), q = *(const f32x4*)(src + hh * 512 + lane * 8 + 4);
            u32x4 w; w.x = cvtpk(p[0], p[1]); w.y = cvtpk(p[2], p[3]); w.z = cvtpk(q[0], q[1]); w.w = cvtpk(q[2], q[3]); *(u32x4*)(dst + hh * 512 + lane * 8) = w; }
    }
    {
        const float* gm = A_IN(6); bf16_t* XN = (bf16_t*)(ws + WS_XN);
        for (int m = gw; m < ROWS; m += NGW) {
            bf16_t* orow = XN + (size_t)m * DM;
            if (m >= NTOK) {
#pragma unroll
                for (int j = 0; j < 2; ++j) *(u32x4*)(orow + j * 512 + lane * 8) = (u32x4){0u, 0u, 0u, 0u};
                continue; }
            const float* xr = (m < NTP) ? A_IN(0) + (size_t)m * DM : A_IN(1) + (size_t)(m - NTP) * DM;
            f32x4 v[4]; float s = 0.f;
#pragma unroll
            for (int j = 0; j < 4; ++j) { v[j] = *(const f32x4*)(xr + j * 256 + lane * 4); s += (v[j][0] * v[j][0] + v[j][1] * v[j][1]) + (v[j][2] * v[j][2] + v[j][3] * v[j][3]); }
            const float inv = 1.0f / sqrtf(wave_sum(s) * (1.0f / DM) + EPS);
#pragma unroll
            for (int j = 0; j < 4; ++j) { const f32x4 gg = *(const f32x4*)(gm + j * 256 + lane * 4); const f32x4 y = v[j] * inv * gg;
                u32x2 w; w.x = cvtpk(y[0], y[1]); w.y = cvtpk(y[2], y[3]); *(u32x2*)(orow + j * 256 + lane * 4) = w; }
        }
    }
    {
        bf16_t* fw = (bf16_t*)(ws + WS_LRUW);
        for (int f = gw; f < 256; f += NGW) {
            const int ks = f & 3, T = (f >> 2) & 1, gate = (f >> 3) & 1, g = f >> 4, i = lane & 31, hi = lane >> 5;
            const int outc = 32 * T + swap23(i);
            const float* W = (gate ? A_IN(13) : A_IN(11)) + (size_t)g * 4096;
            float x[8];
#pragma unroll
            for (int j = 0; j < 8; ++j) x[j] = W[(16 * ks + 8 * hi + j) * 64 + outc];
            u32x4 w; w.x = cvtpk(x[0], x[1]); w.y = cvtpk(x[2], x[3]); w.z = cvtpk(x[4], x[5]); w.w = cvtpk(x[6], x[7]);
            *(u32x4*)(fw + (size_t)f * 512 + lane * 8) = w;
        }
    }
}

constexpr int LR_WF = 0, LR_CW = 16384, LR_CB = LR_CW + 1024, LR_BR = LR_CB + 256, LR_BI = LR_BR + 256, LR_CS = LR_BI + 256, LR_CARRY = LR_CS + 256, LR_SEQ = LR_CARRY + 2048, LR_END = LR_SEQ + 64;

__device__ __forceinline__ void lru_load_consts(LAS unsigned char* lds, int g, int tid) {
    const u32x4* src = (const u32x4*)(A_WS + WS_LRUW + (size_t)g * 16384);
    for (int i = tid; i < 1024; i += 512) ((LAS u32x4*)(lds + LR_WF))[i] = src[i];
    if (tid < 256) ((LAS float*)(lds + LR_CW))[tid] = A_IN(9)[(tid >> 6) * DM + g * 64 + (tid & 63)];
    if (tid < 64) {
        const int c = g * 64 + tid;
        ((LAS float*)(lds + LR_CB))[tid] = A_IN(10)[c]; ((LAS float*)(lds + LR_BR))[tid] = A_IN(12)[c]; ((LAS float*)(lds + LR_BI))[tid] = A_IN(14)[c];
        ((LAS float*)(lds + LR_CS))[tid] = 8.0f * log1pf(expf(-A_IN(15)[c]));
    }
    if (tid < 8) ((LAS unsigned*)(lds + LR_SEQ))[tid] = 0xffffffffu;
}

template <bool SAMPLE>
__device__ __forceinline__ void lru_tile(LAS unsigned char* lds, int lane, int g, size_t rowbase, int tile, int bidx) {
    asm volatile("" : "+v"(lane));
    const int tl = lane & 31, hi = lane >> 5, t = tile * 32 + tl;
    const bf16_t* XR = (const bf16_t*)(A_WS + WS_XR); bf16_t* Gb = (bf16_t*)(A_WS + WS_G);
    const int cbase = g * 64 + 8 * hi;
    float xc[4][8];
    bf16x8 xf[4];
#pragma unroll
    for (int ks = 0; ks < 4; ++ks) {
        const f32x4 b0 = *(const LAS f32x4*)(lds + LR_CB + (16 * ks + 8 * hi) * 4), b1 = *(const LAS f32x4*)(lds + LR_CB + (16 * ks + 8 * hi) * 4 + 16);
#pragma unroll
        for (int j = 0; j < 4; ++j) { xc[ks][j] = b0[j]; xc[ks][4 + j] = b1[j]; }
#pragma unroll
        for (int tap = 0; tap < 4; ++tap) {
            const int rr = t - 3 + tap;
            float xv[8];
            {
                u32x4 w = *(const u32x4*)(XR + (rowbase + (rr < 0 ? 0 : rr)) * DM + cbase + 16 * ks);
                if (rr < 0) w = (u32x4){0u, 0u, 0u, 0u};
                xv[0] = bflo(w.x); xv[1] = bfhi(w.x); xv[2] = bflo(w.y); xv[3] = bfhi(w.y); xv[4] = bflo(w.z); xv[5] = bfhi(w.z); xv[6] = bflo(w.w); xv[7] = bfhi(w.w);
            }
            if (SAMPLE) {
                const float* sp = A_IN(4) + ((size_t)bidx * 3 + (rr < 0 ? 3 + rr : 0)) * DM + cbase + 16 * ks;
                const f32x4 p = *(const f32x4*)sp, q = *(const f32x4*)(sp + 4);
#pragma unroll
                for (int j = 0; j < 4; ++j) { xv[j] = rr < 0 ? p[j] : xv[j]; xv[4 + j] = rr < 0 ? q[j] : xv[4 + j]; }
            }
            const f32x4 w0 = *(const LAS f32x4*)(lds + LR_CW + (tap * 64 + 16 * ks + 8 * hi) * 4), w1 = *(const LAS f32x4*)(lds + LR_CW + (tap * 64 + 16 * ks + 8 * hi) * 4 + 16);
#pragma unroll
            for (int j = 0; j < 4; ++j) { xc[ks][j] += w0[j] * xv[j]; xc[ks][4 + j] += w1[j] * xv[4 + j]; }
        }
        u32x4 w; w.x = cvtpk(xc[ks][0], xc[ks][1]); w.y = cvtpk(xc[ks][2], xc[ks][3]); w.z = cvtpk(xc[ks][4], xc[ks][5]); w.w = cvtpk(xc[ks][6], xc[ks][7]);
        xf[ks] = __builtin_bit_cast(bf16x8, w);
        asm volatile("" ::: "memory");
    }
    float A[32], B[32];
#pragma unroll
    for (int T = 0; T < 2; ++T) {
        f32x16 ar = f32x16{}, ai = f32x16{};
#pragma unroll
        for (int ks = 0; ks < 4; ++ks) {
            const bf16x8 wr_ = *(const LAS bf16x8*)(lds + LR_WF + ((0 * 2 + T) * 4 + ks) * 1024 + lane * 16);
            const bf16x8 wi_ = *(const LAS bf16x8*)(lds + LR_WF + ((1 * 2 + T) * 4 + ks) * 1024 + lane * 16);
            ar = __builtin_amdgcn_mfma_f32_32x32x16_bf16(wr_, xf[ks], ar, 0, 0, 0);
            ai = __builtin_amdgcn_mfma_f32_32x32x16_bf16(wi_, xf[ks], ai, 0, 0, 0);
        }
#pragma unroll
        for (int q = 0; q < 2; ++q) {
            const int ks = 2 * T + q, lo = (16 * ks + 8 * hi) * 4;
            const f32x4 br0 = *(const LAS f32x4*)(lds + LR_BR + lo), br1 = *(const LAS f32x4*)(lds + LR_BR + lo + 16);
            const f32x4 bi0 = *(const LAS f32x4*)(lds + LR_BI + lo), bi1 = *(const LAS f32x4*)(lds + LR_BI + lo + 16);
            const f32x4 cs0 = *(const LAS f32x4*)(lds + LR_CS + lo), cs1 = *(const LAS f32x4*)(lds + LR_CS + lo + 16);
#pragma unroll
            for (int j = 0; j < 8; ++j) {
                const int r = 8 * q + j;
                const float brv = j < 4 ? br0[j & 3] : br1[j & 3], biv = j < 4 ? bi0[j & 3] : bi1[j & 3], csv = j < 4 ? cs0[j & 3] : cs1[j & 3];
                const float rg = sigmoidf_(ar[r] + brv), ig = sigmoidf_(ai[r] + biv);
                const float la = -csv * rg, av = fast_exp2(la * LOG2E);
                const float x2 = 2.0f * la;
                const float em = (x2 > -0.03f) ? -x2 * (1.0f + x2 * (0.5f + x2 * (0.16666667f + x2 * 0.041666668f))) : 1.0f - fast_exp2(x2 * LOG2E);
                A[16 * T + r] = av; B[16 * T + r] = sqrtf(em) * ig * xc[ks][j];
            }
        }
        asm volatile("" ::: "memory");
    }
#define LRU_STEP(CTRL, RM) _Pragma("unroll") for (int c = 0; c < 32; ++c) { \
        const float as_ = __builtin_bit_cast(float, __builtin_amdgcn_update_dpp(__builtin_bit_cast(int, 1.0f), __builtin_bit_cast(int, A[c]), CTRL, RM, 0xF, false)); \
        const float bs_ = __builtin_bit_cast(float, __builtin_amdgcn_update_dpp(0, __builtin_bit_cast(int, B[c]), CTRL, RM, 0xF, false)); \
        B[c] = A[c] * bs_ + B[c]; A[c] = A[c] * as_; }
    LRU_STEP(0x111, 0xF) LRU_STEP(0x112, 0xF) LRU_STEP(0x114, 0xF) LRU_STEP(0x118, 0xF) LRU_STEP(0x142, 0xA)
#undef LRU_STEP
    float hin[32];
    if (SAMPLE) {
        const float* hp = A_IN(5) + (size_t)bidx * DM + cbase;
#pragma unroll
        for (int ks = 0; ks < 4; ++ks) { const f32x4 p = *(const f32x4*)(hp + 16 * ks), q = *(const f32x4*)(hp + 16 * ks + 4);
#pragma unroll
            for (int j = 0; j < 4; ++j) { hin[8 * ks + j] = p[j]; hin[8 * ks + 4 + j] = q[j]; } }
    } else if (tile == 0) {
#pragma unroll
        for (int c = 0; c < 32; ++c) hin[c] = 0.f;
    } else {
        volatile LAS unsigned* sq = (volatile LAS unsigned*)(lds + LR_SEQ) + (tile & 7);
        while (*sq != (unsigned)tile) __builtin_amdgcn_s_sleep(1);
        asm volatile("" ::: "memory");
        const LAS float* cp = (const LAS float*)(lds + LR_CARRY) + (tile & 7) * 64 + 8 * hi;
#pragma unroll
        for (int ks = 0; ks < 4; ++ks) { const f32x4 p = *(const LAS f32x4*)(cp + 16 * ks), q = *(const LAS f32x4*)(cp + 16 * ks + 4);
#pragma unroll
            for (int j = 0; j < 4; ++j) { hin[8 * ks + j] = p[j]; hin[8 * ks + 4 + j] = q[j]; } }
    }
#pragma unroll
    for (int c = 0; c < 32; ++c) B[c] = B[c] + A[c] * hin[c];
    if (!SAMPLE) {
        if (tl == 31) {
            if (tile < 127) {
                LAS float* cp = (LAS float*)(lds + LR_CARRY) + ((tile + 1) & 7) * 64 + 8 * hi;
#pragma unroll
                for (int ks = 0; ks < 4; ++ks) { *(LAS f32x4*)(cp + 16 * ks) = (f32x4){B[8 * ks], B[8 * ks + 1], B[8 * ks + 2], B[8 * ks + 3]};
                    *(LAS f32x4*)(cp + 16 * ks + 4) = (f32x4){B[8 * ks + 4], B[8 * ks + 5], B[8 * ks + 6], B[8 * ks + 7]}; }
            } else {
                float* lp = A_OUT + O_LP + (size_t)bidx * DM + cbase;
#pragma unroll
                for (int ks = 0; ks < 4; ++ks) { *(f32x4*)(lp + 16 * ks) = (f32x4){B[8 * ks], B[8 * ks + 1], B[8 * ks + 2], B[8 * ks + 3]};
                    *(f32x4*)(lp + 16 * ks + 4) = (f32x4){B[8 * ks + 4], B[8 * ks + 5], B[8 * ks + 6], B[8 * ks + 7]}; }
            }
        }
        if (tile < 127) {
            asm volatile("s_waitcnt lgkmcnt(0)" ::: "memory");
            if (lane == 63) *((volatile LAS unsigned*)(lds + LR_SEQ) + ((tile + 1) & 7)) = (unsigned)(tile + 1);
        }
    } else if (tl == 15) {
        float* lp = A_OUT + O_LS + (size_t)bidx * DM + cbase;
#pragma unroll
        for (int ks = 0; ks < 4; ++ks) { *(f32x4*)(lp + 16 * ks) = (f32x4){B[8 * ks], B[8 * ks + 1], B[8 * ks + 2], B[8 * ks + 3]};
            *(f32x4*)(lp + 16 * ks + 4) = (f32x4){B[8 * ks + 4], B[8 * ks + 5], B[8 * ks + 6], B[8 * ks + 7]}; }
    }
    if (!SAMPLE || tl < NST) {
        bf16_t* gp = Gb + (rowbase + t) * DM + cbase;
#pragma unroll
        for (int ks = 0; ks < 4; ++ks) {
            const u32x4 w = *(const u32x4*)(gp + 16 * ks);
            float gv[8]; gv[0] = bflo(w.x); gv[1] = bfhi(w.x); gv[2] = bflo(w.y); gv[3] = bfhi(w.y); gv[4] = bflo(w.z); gv[5] = bfhi(w.z); gv[6] = bflo(w.w); gv[7] = bfhi(w.w);
            float o[8];
#pragma unroll
            for (int j = 0; j < 8; ++j) o[j] = B[8 * ks + j] * gelu_tanh(gv[j]);
            u32x4 ow; ow.x = cvtpk(o[0], o[1]); ow.y = cvtpk(o[2], o[3]); ow.z = cvtpk(o[4], o[5]); ow.w = cvtpk(o[6], o[7]);
            *(u32x4*)(gp + 16 * ks) = ow;
        }
    }
}

constexpr int AT_TAB = 24576;
__device__ __forceinline__ void attn_unit(LAS unsigned char* lds, int lane, int b, int c, int h) {
    const int r32 = lane & 31, hi = lane >> 5, kr = swap23(r32);
    const bf16_t* Q = (const bf16_t*)(A_WS + WS_Q); const bf16_t* Kb = (const bf16_t*)(A_WS + WS_K); const bf16_t* VT = (const bf16_t*)(A_WS + WS_VT); bf16_t* O = (bf16_t*)(A_WS + WS_Q);
    const size_t row0 = (size_t)b * SEQ + (size_t)c * 64;
    bf16x8 qf[2][4];
#pragma unroll
    for (int qb = 0; qb < 2; ++qb)
#pragma unroll
        for (int ks = 0; ks < 4; ++ks) qf[qb][ks] = *(const bf16x8*)(Q + (row0 + qb * 32 + r32) * DM + h * 64 + ks * 16 + hi * 8);
    f32x16 o[2][2];
#pragma unroll
    for (int i = 0; i < 2; ++i)
#pragma unroll
        for (int j = 0; j < 2; ++j) o[i][j] = f32x16{};
    float mrow[2] = {-1e30f, -1e30f}, lrow[2] = {0.f, 0.f};
    const LAS float* tab = (const LAS float*)(lds + AT_TAB) + h * 320;
    const float cfar = tab[256];
    const int sb0 = (c >= 8 ? c - 8 : 0) * 2, sb1 = c * 2 + 1;
    const bf16_t* kbase = Kb + ((size_t)b * SEQ + kr) * DM + h * 64 + hi * 8;
    const bf16_t* vbase = VT + (size_t)(h * 64 + kr) * ROWS + (size_t)b * SEQ + hi * 8;
    bf16x8 kf[4], vf[2][2];
#pragma unroll
    for (int ks = 0; ks < 4; ++ks) kf[ks] = *(const bf16x8*)(kbase + (size_t)sb0 * 32 * DM + ks * 16);
#pragma unroll
    for (int db = 0; db < 2; ++db)
#pragma unroll
        for (int s = 0; s < 2; ++s) vf[db][s] = *(const bf16x8*)(vbase + (size_t)db * 32 * ROWS + sb0 * 32 + s * 16);
    for (int sb = sb0; sb <= sb1; ++sb) {
        const int sbn = sb < sb1 ? sb + 1 : sb;
        f32x16 S[2];
#pragma unroll
        for (int qb = 0; qb < 2; ++qb) { S[qb] = f32x16{};
#pragma unroll
            for (int ks = 0; ks < 4; ++ks) S[qb] = __builtin_amdgcn_mfma_f32_32x32x16_bf16(kf[ks], qf[qb][ks], S[qb], 0, 0, 0); }
        asm volatile("" ::: "memory");
#pragma unroll
        for (int ks = 0; ks < 4; ++ks) kf[ks] = *(const bf16x8*)(kbase + (size_t)sbn * 32 * DM + ks * 16);
        const int delta = c - (sb >> 1), rb = sb & 1;
        if (delta >= 3) {
#pragma unroll
            for (int qb = 0; qb < 2; ++qb)
#pragma unroll
                for (int r = 0; r < 16; ++r) S[qb][r] += cfar;
        } else {
#pragma unroll
            for (int qb = 0; qb < 2; ++qb) {
                const LAS float* tp = tab + (64 * delta + 32 * qb + r32 + 128 - 32 * rb - 8 * hi - 23);
#pragma unroll
                for (int r = 0; r < 16; ++r) S[qb][r] += tp[23 - (16 * (r >> 3) + (r & 7))];
            }
        }
        float rm[2];
#pragma unroll
        for (int qb = 0; qb < 2; ++qb) { float mx = S[qb][0];
#pragma unroll
            for (int r = 1; r < 16; ++r) mx = fmaxf(mx, S[qb][r]);
            rm[qb] = plswap_max(mx); }
        if (__any((rm[0] > mrow[0] + 8.0f) || (rm[1] > mrow[1] + 8.0f))) {
#pragma unroll
            for (int qb = 0; qb < 2; ++qb) { const float mn = fmaxf(mrow[qb], rm[qb]); const float al = fast_exp2(mrow[qb] - mn); lrow[qb] *= al; mrow[qb] = mn;
#pragma unroll
                for (int r = 0; r < 16; ++r) { o[0][qb][r] *= al; o[1][qb][r] *= al; } }
        }
        bf16x8 pf[2][2];
#pragma unroll
        for (int qb = 0; qb < 2; ++qb) { float sum = 0.f;
#pragma unroll
            for (int r = 0; r < 16; ++r) { S[qb][r] = fast_exp2(S[qb][r] - mrow[qb]); sum += S[qb][r]; }
            lrow[qb] += sum;
#pragma unroll
            for (int s = 0; s < 2; ++s) { u32x4 w; w.x = cvtpk(S[qb][8 * s], S[qb][8 * s + 1]); w.y = cvtpk(S[qb][8 * s + 2], S[qb][8 * s + 3]); w.z = cvtpk(S[qb][8 * s + 4], S[qb][8 * s + 5]); w.w = cvtpk(S[qb][8 * s + 6], S[qb][8 * s + 7]);
                pf[qb][s] = __builtin_bit_cast(bf16x8, w); } }
#pragma unroll
        for (int db = 0; db < 2; ++db)
#pragma unroll
            for (int qb = 0; qb < 2; ++qb)
#pragma unroll
                for (int s = 0; s < 2; ++s) o[db][qb] = __builtin_amdgcn_mfma_f32_32x32x16_bf16(vf[db][s], pf[qb][s], o[db][qb], 0, 0, 0);
        asm volatile("" ::: "memory");
#pragma unroll
        for (int db = 0; db < 2; ++db)
#pragma unroll
            for (int s = 0; s < 2; ++s) vf[db][s] = *(const bf16x8*)(vbase + (size_t)db * 32 * ROWS + sbn * 32 + s * 16);
    }
#pragma unroll
    for (int qb = 0; qb < 2; ++qb) { const float inv = fast_rcp(plswap_add(lrow[qb]));
        bf16_t* op = O + (row0 + qb * 32 + r32) * DM + h * 64 + 8 * hi;
#pragma unroll
        for (int db = 0; db < 2; ++db)
#pragma unroll
            for (int s = 0; s < 2; ++s) { u32x4 w;
                w.x = cvtpk(o[db][qb][8 * s] * inv, o[db][qb][8 * s + 1] * inv); w.y = cvtpk(o[db][qb][8 * s + 2] * inv, o[db][qb][8 * s + 3] * inv);
                w.z = cvtpk(o[db][qb][8 * s + 4] * inv, o[db][qb][8 * s + 5] * inv); w.w = cvtpk(o[db][qb][8 * s + 6] * inv, o[db][qb][8 * s + 7] * inv);
                *(u32x4*)(op + 32 * db + 16 * s) = w; } }
}

constexpr int AS_P = 45056;
__device__ __forceinline__ void attn_sample_task(LAS unsigned char* lds, int wave, int lane, int task) {
    const int bs = task >> 6, h = (task >> 2) & 15, qg = task & 3;
    const bf16_t* Q = (const bf16_t*)(A_WS + WS_Q); bf16_t* O = (bf16_t*)(A_WS + WS_Q);
    const float* ck = A_IN(2); const float* cv = A_IN(3); const float* kn = A_OUT + O_KS; const float* vn = A_OUT + O_VS;
    LAS float* pb = (LAS float*)(lds + AS_P + wave * 9472);
    LAS float* qs = pb + 4 * 528;
    const LAS float* tab = (const LAS float*)(lds + AT_TAB) + h * 320;
#pragma unroll
    for (int i = 0; i < 4; ++i) qs[i * 64 + lane] = bflo((unsigned)Q[((size_t)NTP + bs * 16 + qg * 4 + i) * DM + h * 64 + lane]);
    asm volatile("s_waitcnt lgkmcnt(0)" ::: "memory");
#pragma unroll 1
    for (int it = 0; it < 9; ++it) {
        const int key = it * 64 + lane; const bool valid = key < 528;
        const float* kp = !valid ? ck : (key < 512 ? ck + (((size_t)bs * 512 + key) * 16 + h) * 64 : kn + ((size_t)bs * 16 + (key - 512)) * DM + h * 64);
        float d[4] = {0.f, 0.f, 0.f, 0.f};
#pragma unroll 4
        for (int d4 = 0; d4 < 16; ++d4) { const f32x4 kv = *(const f32x4*)(kp + 4 * d4);
#pragma unroll
            for (int i = 0; i < 4; ++i) { const f32x4 qq = *(const LAS f32x4*)(qs + i * 64 + 4 * d4); d[i] += (kv[0] * qq[0] + kv[1] * qq[1]) + (kv[2] * qq[2] + kv[3] * qq[3]); } }
        int rel = 512 + qg * 4 - key;
        if (valid) {
#pragma unroll
            for (int i = 0; i < 4; ++i) { int r = rel + i; r = r > 128 ? 128 : r; pb[i * 528 + key] = d[i] + tab[r + 128]; } }
    }
    asm volatile("s_waitcnt lgkmcnt(0)" ::: "memory");
#pragma unroll 1
    for (int i = 0; i < 4; ++i) {
        float mx = -1e30f;
#pragma unroll 1
        for (int key = lane; key < 528; key += 64) mx = fmaxf(mx, pb[i * 528 + key]);
#pragma unroll
        for (int o = 1; o < 64; o <<= 1) mx = fmaxf(mx, __shfl_xor(mx, o));
        float sum = 0.f;
#pragma unroll 1
        for (int key = lane; key < 528; key += 64) { const float pv = fast_exp2(pb[i * 528 + key] - mx); pb[i * 528 + key] = pv; sum += pv; }
        sum = wave_sum(sum); const float inv = 1.0f / sum;
#pragma unroll 1
        for (int key = lane; key < 528; key += 64) pb[i * 528 + key] *= inv;
    }
    asm volatile("s_waitcnt lgkmcnt(0)" ::: "memory");
    float acc[4] = {0.f, 0.f, 0.f, 0.f};
#pragma unroll 4
    for (int key = 0; key < 528; ++key) {
        const float v = key < 512 ? cv[(((size_t)bs * 512 + key) * 16 + h) * 64 + lane] : vn[((size_t)bs * 16 + (key - 512)) * DM + h * 64 + lane];
#pragma unroll
        for (int i = 0; i < 4; ++i) acc[i] += pb[i * 528 + key] * v;
    }
#pragma unroll
    for (int i = 0; i < 4; ++i) O[((size_t)NTP + bs * 16 + qg * 4 + i) * DM + h * 64 + lane] = (bf16_t)(cvtpk(acc[i], 0.f) & 0xffffu);
    asm volatile("s_waitcnt lgkmcnt(0)" ::: "memory");
}

__device__ __forceinline__ void p2_phase(LAS unsigned char* lds, int G, int tid, int wave, int lane) {
    for (int i = tid; i < 16 * 320; i += 512) { const int h = i / 320, j = i % 320; ((LAS float*)(lds + AT_TAB))[i] = A_IN(8)[h * 257 + (j > 256 ? 256 : j)] * LOG2E; }
    for (int u = blockIdx.x; u < 256 + 16; u += G) {
        __syncthreads();
        if (u < 256) {
            const int b = u >> 4, g = u & 15;
            lru_load_consts(lds, g, tid);
            __syncthreads();
            for (int tile = wave; tile < 128; tile += 8) lru_tile<false>(lds, lane, g, (size_t)b * SEQ, tile, b);
        } else {
            const int g = u - 256;
            lru_load_consts(lds, g, tid);
            __syncthreads();
            lru_tile<true>(lds, lane, g, (size_t)NTP + wave * 16, 0, wave);
        }
    }
    __syncthreads();
    const int gw = blockIdx.x * 8 + wave, NGW = G * 8;
    for (int u = gw; u < NB * 64 * 16; u += NGW) {
        const int c = u & 63, h = (u >> 6) & 15, b = u >> 10;
        attn_unit(lds, lane, b, c, h);
    }
    for (int t = gw; t < 512; t += NGW) attn_sample_task(lds, wave, lane, t);
}

__device__ __forceinline__ void p4b_phase(int G, int wave, int lane) {
    const int gw = blockIdx.x * 8 + wave, NGW = G * 8;
    const float* gm = A_IN(19); bf16_t* XT = (bf16_t*)(A_WS + WS_Q);
    for (int m = gw; m < NTOK; m += NGW) {
        const float* xr = (m < NTP) ? A_OUT + O_YP + (size_t)m * DM : A_OUT + O_YS + (size_t)(m - NTP) * DM;
        bf16_t* orow = XT + (size_t)m * DM;
        f32x4 v[4]; float s = 0.f;
#pragma unroll
        for (int j = 0; j < 4; ++j) { v[j] = *(const f32x4*)(xr + j * 256 + lane * 4); s += (v[j][0] * v[j][0] + v[j][1] * v[j][1]) + (v[j][2] * v[j][2] + v[j][3] * v[j][3]); }
        const float inv = 1.0f / sqrtf(wave_sum(s) * (1.0f / DM) + EPS);
#pragma unroll
        for (int j = 0; j < 4; ++j) { const f32x4 gg = *(const f32x4*)(gm + j * 256 + lane * 4); const f32x4 y = v[j] * inv * gg;
            u32x2 w; w.x = cvtpk(y[0], y[1]); w.y = cvtpk(y[2], y[3]); *(u32x2*)(orow + j * 256 + lane * 4) = w; }
    }
}

__device__ __forceinline__ int f2key(float f) { const int b = __float_as_int(f); return b ^ ((b >> 31) & 0x7fffffff); }
__device__ __forceinline__ float key2f(int k) { return __int_as_float(k ^ ((k >> 31) & 0x7fffffff)); }
#define INS16(L, x) do { int x_ = (x); _Pragma("unroll") for (int j_ = 0; j_ < 16; ++j_) { const int hi_ = max(L[j_], x_); x_ = min(L[j_], x_); L[j_] = hi_; } } while (0)

constexpr int P6_IDX = 0, P6_SELE = 32768, P6_SELG = 49152;
__device__ __forceinline__ void p6_phase(LAS unsigned char* lds, int G, int wave, int lane) {
    const int gw = blockIdx.x * 8 + wave, NGW = G * 8;
    const float* SC = (const float*)(A_WS + WS_XN);
    const bf16_t* XT = (const bf16_t*)(A_WS + WS_Q); const bf16_t* UB = (const bf16_t*)(A_WS + WS_UB); const bf16_t* VB = (const bf16_t*)(A_WS + WS_VB);
    LAS int* idxb = (LAS int*)(lds + P6_IDX + wave * 4096);
    LAS int* sele = (LAS int*)(lds + P6_SELE + wave * 2048);
    LAS float* selg = (LAS float*)(lds + P6_SELG + wave * 2048);
    const int tl = lane >> 4, hh = (lane >> 1) & 7, half = lane & 1;
    for (int grp = gw; grp < NTOK / 4; grp += NGW) {
        const int tok0 = grp * 4;
        {
            const float* sp = SC + (size_t)(tok0 + tl) * 2048 + hh * 256 + half * 128;
            int L[16];
#pragma unroll
            for (int j = 0; j < 16; ++j) L[j] = (int)0x80000000;
            for (int c4 = 0; c4 < 32; c4 += 2) {
                const f32x4 v0 = *(const f32x4*)(sp + 4 * c4), v1 = *(const f32x4*)(sp + 4 * c4 + 4);
#pragma unroll
                for (int e = 0; e < 4; ++e) INS16(L, (f2key(v0[e]) & ~127) | (4 * c4 + e));
#pragma unroll
                for (int e = 0; e < 4; ++e) INS16(L, (f2key(v1[e]) & ~127) | (4 * c4 + 4 + e));
            }
#pragma unroll
            for (int j = 0; j < 16; ++j) idxb[lane * 16 + j] = L[j] & 127;
            float va[16], vb[16];
#pragma unroll
            for (int j = 0; j < 16; ++j) { const int own = L[j] & ~127, oth = __shfl_xor(own, 1); va[j] = key2f(half ? oth : own); vb[j] = key2f(half ? own : oth); }
            int C[16];
#pragma unroll
            for (int j = 0; j < 16; ++j) C[j] = (int)0x80000000;
#pragma unroll
            for (int i = 0; i < 16; ++i)
#pragma unroll
                for (int j = 0; j < 16; ++j) if ((i + 1) * (j + 1) <= 16) INS16(C, (f2key(va[i] + vb[j]) & ~255) | (i * 16 + j));
            const float mx = key2f(C[0] & ~255);
            float ev[16], sum = 0.f;
#pragma unroll
            for (int j = 0; j < 16; ++j) { ev[j] = __expf(key2f(C[j] & ~255) - mx); sum += ev[j]; }
            const float inv = 1.0f / sum;
            asm volatile("s_waitcnt lgkmcnt(0)" ::: "memory");
#pragma unroll
            for (int s = 0; s < 8; ++s) {
                int c_lo = C[s], c_hi = C[8 + s]; float e_lo = ev[s], e_hi = ev[8 + s];
                asm volatile("" : "+v"(c_lo), "+v"(c_hi), "+v"(e_lo), "+v"(e_hi));
                const int cc = half ? c_hi : c_lo; const float gg = (half ? e_hi : e_lo) * inv;
                const int ij = cc & 255, i1 = idxb[(lane & ~1) * 16 + (ij >> 4)], i2 = idxb[(lane | 1) * 16 + (ij & 15)];
                sele[tl * 128 + hh * 16 + half * 8 + s] = i1 * 128 + i2; selg[tl * 128 + hh * 16 + half * 8 + s] = gg;
            }
            asm volatile("s_waitcnt lgkmcnt(0)" ::: "memory");
        }
        for (int ti = 0; ti < 4; ++ti) {
            const int tok = tok0 + ti;
            const u32x4 x0 = *(const u32x4*)(XT + (size_t)tok * DM + lane * 8), x1 = *(const u32x4*)(XT + (size_t)tok * DM + 512 + lane * 8);
            float acc[16];
#pragma unroll
            for (int j = 0; j < 16; ++j) acc[j] = 0.f;
            for (int k0 = 0; k0 < 128; k0 += 4) {
                int ee[4]; float gg[4]; u32x4 ua[4], ub[4], wa[4], wb[4];
#pragma unroll
                for (int q = 0; q < 4; ++q) { ee[q] = sele[ti * 128 + k0 + q]; gg[q] = selg[ti * 128 + k0 + q]; }
#pragma unroll
                for (int q = 0; q < 4; ++q) { const bf16_t* up = UB + (size_t)ee[q] * DM + lane * 8; const bf16_t* vp = VB + (size_t)ee[q] * DM + lane * 8;
                    ua[q] = *(const u32x4*)up; ub[q] = *(const u32x4*)(up + 512); wa[q] = *(const u32x4*)vp; wb[q] = *(const u32x4*)(vp + 512); }
#pragma unroll
                for (int q = 0; q < 4; ++q) {
                    float d = 0.f;
                    d += bflo(ua[q].x) * bflo(x0.x) + bfhi(ua[q].x) * bfhi(x0.x); d += bflo(ua[q].y) * bflo(x0.y) + bfhi(ua[q].y) * bfhi(x0.y);
                    d += bflo(ua[q].z) * bflo(x0.z) + bfhi(ua[q].z) * bfhi(x0.z); d += bflo(ua[q].w) * bflo(x0.w) + bfhi(ua[q].w) * bfhi(x0.w);
                    d += bflo(ub[q].x) * bflo(x1.x) + bfhi(ub[q].x) * bfhi(x1.x); d += bflo(ub[q].y) * bflo(x1.y) + bfhi(ub[q].y) * bfhi(x1.y);
                    d += bflo(ub[q].z) * bflo(x1.z) + bfhi(ub[q].z) * bfhi(x1.z); d += bflo(ub[q].w) * bflo(x1.w) + bfhi(ub[q].w) * bfhi(x1.w);
                    d = wave_sum(d);
                    const float cf = gg[q] * gelu_tanh(d);
                    acc[0] += cf * bflo(wa[q].x); acc[1] += cf * bfhi(wa[q].x); acc[2] += cf * bflo(wa[q].y); acc[3] += cf * bfhi(wa[q].y);
                    acc[4] += cf * bflo(wa[q].z); acc[5] += cf * bfhi(wa[q].z); acc[6] += cf * bflo(wa[q].w); acc[7] += cf * bfhi(wa[q].w);
                    acc[8] += cf * bflo(wb[q].x); acc[9] += cf * bfhi(wb[q].x); acc[10] += cf * bflo(wb[q].y); acc[11] += cf * bfhi(wb[q].y);
                    acc[12] += cf * bflo(wb[q].z); acc[13] += cf * bfhi(wb[q].z); acc[14] += cf * bflo(wb[q].w); acc[15] += cf * bfhi(wb[q].w);
                }
            }
            float* yr = (tok < NTP) ? A_OUT + O_YP + (size_t)tok * DM : A_OUT + O_YS + (size_t)(tok - NTP) * DM;
            const float* gf = A_IN(25);
            f32x4 z[4]; float ss = 0.f;
#pragma unroll
            for (int q = 0; q < 4; ++q) { z[q] = *(const f32x4*)(yr + (q >> 1) * 512 + lane * 8 + (q & 1) * 4);
#pragma unroll
                for (int e = 0; e < 4; ++e) { z[q][e] += acc[4 * q + e]; ss += z[q][e] * z[q][e]; } }
            const float inv = 1.0f / sqrtf(wave_sum(ss) * (1.0f / DM) + EPS);
#pragma unroll
            for (int q = 0; q < 4; ++q) { const f32x4 gv = *(const f32x4*)(gf + (q >> 1) * 512 + lane * 8 + (q & 1) * 4); *(f32x4*)(yr + (q >> 1) * 512 + lane * 8 + (q & 1) * 4) = z[q] * inv * gv; }
        }
    }
}

__global__ void __launch_bounds__(512, 2) hybrid_fwd(Args a) {
    extern __shared__ __attribute__((aligned(16))) unsigned char lds_raw[];
    LAS unsigned char* lds = (LAS unsigned char*)lds_raw;
    const int tid = threadIdx.x, lane = tid & 63, wave = __builtin_amdgcn_readfirstlane(tid >> 6), G = gridDim.x;
    cg::grid_group grid = cg::this_grid();
    unsigned char* ws = A_WS;
#define IN(k) (KA->ph_lo <= (k) && (k) < KA->ph_hi)
#define SEAM(k) do { if (KA->use_sync && IN(k) && IN((k) + 1)) grid.sync(); } while (0)
    if (IN(0)) { p0_prologue(lds, G, wave, lane); }
    SEAM(0);
    if (IN(1)) {
        pg8::Gemm g{(const bf16_t*)(ws + WS_XN), (const bf16_t*)(ws + WS_WIN), (const bf16_t*)(ws + WS_WIN) + (size_t)2048 * DM, (const bf16_t*)(ws + WS_XN), DM};
        SchedG1 S; S.init(G, blockIdx.x); EpiG1 E;
        pg8::gemm_phase(lds, g, S, E);
    }
    SEAM(1);
    if (IN(2)) { p2_phase(lds, G, tid, wave, lane); }
    SEAM(2);
    if (IN(3)) {
        pg8::Gemm g{(const bf16_t*)(ws + WS_Q), (const bf16_t*)(ws + WS_WBA), (const bf16_t*)(ws + WS_G), (const bf16_t*)(ws + WS_WBL), DM};
        SchedPair S; S.init(4, G, blockIdx.x); EpiP3 E;
        pg8::gemm_phase(lds, g, S, E);
    }
    SEAM(3);
    if (IN(4)) {
        pg8::Gemm g{(const bf16_t*)(ws + WS_XN), (const bf16_t*)(ws + WS_WO), (const bf16_t*)(ws + WS_XN), (const bf16_t*)(ws + WS_WO), DM};
        SchedOne S; S.init(4, G, blockIdx.x); EpiP4 E;
        pg8::gemm_phase(lds, g, S, E);
    }
    SEAM(4);
    if (IN(5)) { p4b_phase(G, wave, lane); }
    SEAM(5);
    if (IN(6)) {
        pg8::Gemm g{(const bf16_t*)(ws + WS_Q), (const bf16_t*)(ws + WS_WS), (const bf16_t*)(ws + WS_Q), (const bf16_t*)(ws + WS_WS), DM};
        SchedOne S; S.init(8, G, blockIdx.x); EpiP5 E;
        pg8::gemm_phase(lds, g, S, E);
    }
    SEAM(6);
    if (IN(7)) { p6_phase(lds, G, wave, lane); }
#undef IN
#undef SEAM
}

#ifndef N_LAUNCH_MODE
#define N_LAUNCH_MODE 1
#endif
constexpr int NPH = 8;
extern "C" void kernel_launch(void* const* d_in, const int* in_sizes, int n_in, void* d_out, int out_size, void* d_ws, size_t ws_size, hipStream_t stream) {
    static int grid = 0;
    if (grid == 0) {
        if (n_in != 26 || (size_t)out_size != O_END || ws_size < WS_END) { fprintf(stderr, "kernel_launch: unexpected sizes n_in %d out %d ws %zu (need %zu)\n", n_in, out_size, ws_size, (size_t)WS_END); grid = -1; return; }
        int dev = 0, cus = 0, per_cu = 0;
        hipGetDevice(&dev); hipDeviceGetAttribute(&cus, hipDeviceAttributeMultiprocessorCount, dev);
        hipFuncSetAttribute((const void*)hybrid_fwd, hipFuncAttributeMaxDynamicSharedMemorySize, LDS_BYTES);
        hipOccupancyMaxActiveBlocksPerMultiprocessor(&per_cu, (const void*)hybrid_fwd, 512, LDS_BYTES);
        if (per_cu < 1) { fprintf(stderr, "kernel_launch: occupancy query says %d blocks per CU\n", per_cu); per_cu = 1; }
        grid = cus;
        (void)hipGetLastError();
    }
    if (grid < 0) return;
    Args a{};
    for (int i = 0; i < 26; ++i) a.in[i] = (const float*)d_in[i];
    a.out = (float*)d_out; a.ws = (unsigned char*)d_ws;
    if (N_LAUNCH_MODE == 1) {
        a.ph_lo = 0; a.ph_hi = NPH; a.use_sync = 1;
        void* args[] = {&a};
        hipError_t e = hipLaunchCooperativeKernel((const void*)hybrid_fwd, dim3(grid), dim3(512), args, LDS_BYTES, stream);
        if (e != hipSuccess) fprintf(stderr, "cooperative launch failed: %s (grid %d)\n", hipGetErrorString(e), grid);
    } else {
        for (int p = 0; p < NPH; ++p) { a.ph_lo = p; a.ph_hi = p + 1; a.use_sync = 0; hipLaunchKernelGGL(hybrid_fwd, dim3(grid), dim3(512), LDS_BYTES, stream, a); }
    }
}
```

```cpp
#include <hip/hip_runtime.h>
#include <hip/hip_cooperative_groups.h>
#include <cstdint>
#include <cstdio>
namespace cg = cooperative_groups;

#define LAS __attribute__((address_space(3)))
typedef unsigned short bf16_t;
typedef short bf16x8 __attribute__((ext_vector_type(8)));
typedef float f32x4 __attribute__((ext_vector_type(4)));
typedef float f32x2 __attribute__((ext_vector_type(2)));
typedef float f32x16 __attribute__((ext_vector_type(16)));
typedef unsigned u32x4 __attribute__((ext_vector_type(4)));
typedef unsigned u32x2 __attribute__((ext_vector_type(2)));
typedef __bf16 bf16x2_t __attribute__((ext_vector_type(2)));

constexpr int DM = 1024, SEQ = 4096, NB = 16, NTP = NB * SEQ, NSB = 8, NST = 16, NTS = NSB * NST, NTOK = NTP + NTS;
constexpr int ROWS = 65792, NMT = 257;
constexpr int INC = 7168, NEXP = 16384;
constexpr float EPS = 1e-6f, LOG2E = 1.4426950408889634f;
constexpr float QSCALE = 0.125f * LOG2E;

constexpr size_t MiB = 1u << 20;
constexpr size_t BUF = (size_t)ROWS * DM * 2;
constexpr size_t WS_CTL = 0;
constexpr size_t WS_WIN = 1 * MiB;
constexpr size_t WS_WBA = 16 * MiB, WS_WBL = 18 * MiB, WS_WO = 20 * MiB, WS_WS = 22 * MiB;
constexpr size_t WS_LRUW = 26 * MiB;
constexpr size_t WS_SGA = 27 * MiB, WS_SGR = 27 * MiB + 512 * 1024;
constexpr size_t WS_UB = 28 * MiB, WS_VB = 60 * MiB;
constexpr size_t WS_Q = 92 * MiB;
constexpr size_t WS_XN = WS_Q + BUF;
constexpr size_t WS_K = WS_XN + BUF;
constexpr size_t WS_VT = WS_K + BUF;
constexpr size_t WS_XR = WS_VT + BUF;
constexpr size_t WS_G = WS_XR + BUF;
constexpr size_t WS_END = WS_G + BUF;

constexpr size_t O_YP = 0, O_YS = O_YP + (size_t)NTP * DM, O_KP = O_YS + (size_t)NTS * DM, O_VP = O_KP + (size_t)NB * 512 * DM,
                 O_CP = O_VP + (size_t)NB * 512 * DM, O_LP = O_CP + (size_t)NB * 3 * DM, O_KS = O_LP + (size_t)NB * DM, O_VS = O_KS + (size_t)NTS * DM,
                 O_CS = O_VS + (size_t)NTS * DM, O_LS = O_CS + (size_t)NSB * 3 * DM, O_END = O_LS + (size_t)NSB * DM;

constexpr int LDS_BYTES = 135168;

__device__ __forceinline__ unsigned cvtpk(float lo, float hi) { f32x2 v = {lo, hi}; bf16x2_t b = __builtin_convertvector(v, bf16x2_t); return __builtin_bit_cast(unsigned, b); }
__device__ __forceinline__ float bflo(unsigned u) { return __uint_as_float(u << 16); }
__device__ __forceinline__ float bfhi(unsigned u) { return __uint_as_float(u & 0xffff0000u); }
__device__ __forceinline__ float fast_exp2(float x) { return __builtin_amdgcn_exp2f(x); }
__device__ __forceinline__ float fast_rcp(float x) { return __builtin_amdgcn_rcpf(x); }
__device__ __forceinline__ float sigmoidf_(float z) { return fast_rcp(1.0f + fast_exp2(-z * LOG2E)); }
__device__ __forceinline__ float gelu_tanh(float x) { const float u = x + 0.044715f * x * x * x; return x * fast_rcp(1.0f + fast_exp2(-1.5957691216f * LOG2E * u)); }
__device__ __forceinline__ float wave_sum(float v) {
#pragma unroll
    for (int o = 1; o < 64; o <<= 1) v += __shfl_xor(v, o);
    return v;
}
__device__ __forceinline__ int swap23(int i) { return (i & ~12) | ((i & 4) << 1) | ((i & 8) >> 1); }
__device__ __forceinline__ float plswap_max(float m) { auto rr = __builtin_amdgcn_permlane32_swap(__float_as_uint(m), __float_as_uint(m), false, false); return fmaxf(__uint_as_float(rr[0]), __uint_as_float(rr[1])); }
__device__ __forceinline__ float plswap_add(float m) { auto rr = __builtin_amdgcn_permlane32_swap(__float_as_uint(m), __float_as_uint(m), false, false); return __uint_as_float(rr[0]) + __uint_as_float(rr[1]); }

namespace pg8 {
constexpr int BM = 256, BK = 64, HALF = 128, HTB = HALF * BK * 2, STAGE_BYTES = 8 * HTB, NXCD = 8, WGM = 8;
__host__ __device__ __forceinline__ int lds_byte(int r, int c) { const int st = (r >> 4) * 2 + (c >> 5), rr = r & 15, cc = c & 31, ob = rr * 64 + cc * 2; return st * 1024 + (ob ^ (((ob >> 9) & 1) << 5)); }
__host__ __device__ __forceinline__ void stage_rc(int b, int& R, int& C) { const int st = b / 1024, sb = b % 1024, swz = sb ^ (((sb >> 9) & 1) << 5); R = (st >> 1) * 16 + swz / 64; C = (st & 1) * 32 + (swz % 64) / 2; }
__host__ __device__ __forceinline__ int perm32(int rho) { const int n = rho >> 4, i = rho & 15; return 8 * (i >> 2) + 4 * n + (i & 3); }

struct Unit { int pm, pn, kind; };
struct Gemm { const bf16_t* A0; const bf16_t* B0; const bf16_t* A1; const bf16_t* B1; int K; };

struct TileMap {
    int nM, nN, nwg;
    __device__ __forceinline__ void init(int nM_, int nN_) { nM = nM_; nN = nN_; nwg = nM * nN; }
    __device__ __forceinline__ void map(int L, int& pm, int& pn) const {
        int wgid = L; { const int q = nwg / NXCD, r = nwg % NXCD, xcd = wgid % NXCD, off = wgid / NXCD; wgid = (xcd < r ? xcd * (q + 1) : r * (q + 1) + (xcd - r) * q) + off; }
        const int nig = WGM * nN, gid = wgid / nig, fm = gid * WGM, gsz = (nM - fm) < WGM ? (nM - fm) : WGM;
        pm = fm + ((wgid % nig) % gsz); pn = (wgid % nig) / gsz;
    }
};

template <class Epi, class Sched>
__device__ __forceinline__ void gemm_phase(LAS unsigned char* lds, const Gemm g, const Sched& S, const Epi& E) {
    const int tid = threadIdx.x, wid = __builtin_amdgcn_readfirstlane(tid >> 6), lane = tid & 63, wr = wid >> 2, wc = wid & 3, fr = lane & 15, fq = lane >> 4;
    const int K = g.K, nt = K / BK;
    unsigned voffA[2], voffB[2];
#pragma unroll
    for (int i = 0; i < 2; ++i) { int R, C; stage_rc(tid * 16 + i * 8192, R, C); const int Rb = (R & ~31) + perm32(R & 31);
        voffA[i] = (unsigned)(R * K + C) * 2u; voffB[i] = (unsigned)(Rb * K + C) * 2u; }
    const size_t kstep = (size_t)(BK * 2);
    const size_t hstep = (size_t)HALF * K * 2;
    const size_t tstep = 2 * hstep;
    const unsigned ldsw = (unsigned)wid * 1024u;
    const int aoff = lds_byte(wr * 64 + fr, fq * 8), boff = lds_byte(wc * 32 + fr, fq * 8);
#define PG8_SA(b, h) (((b) * 2 + (h)) * HTB)
#define PG8_SB(b, h) ((4 + (b) * 2 + (h)) * HTB)
#define PG8_STAGE(bufoff, gbase, voff) do { _Pragma("unroll") for (int _i = 0; _i < 2; ++_i) \
        __builtin_amdgcn_global_load_lds((const unsigned*)((const char*)(gbase) + (voff)[_i]), (LAS unsigned*)(lds + (bufoff) + ldsw + _i * 8192), 16, 0, 0); } while (0)
#define PG8_LDA(dst, b, h) do { _Pragma("unroll") for (int m = 0; m < 4; ++m) _Pragma("unroll") for (int k = 0; k < 2; ++k) dst[m][k] = *(const LAS bf16x8*)(lds + PG8_SA(b, h) + aoff + m * 2048 + k * 1024); } while (0)
#define PG8_LDB(dst, b, h) do { _Pragma("unroll") for (int n = 0; n < 2; ++n) _Pragma("unroll") for (int k = 0; k < 2; ++k) dst[n][k] = *(const LAS bf16x8*)(lds + PG8_SB(b, h) + boff + n * 2048 + k * 1024); } while (0)
#define PG8_MMA(ai, bj, At, Bt) do { __builtin_amdgcn_s_setprio(1); _Pragma("unroll") for (int m = 0; m < 4; ++m) _Pragma("unroll") for (int n = 0; n < 2; ++n) _Pragma("unroll") for (int k = 0; k < 2; ++k) \
        acc[ai][bj][m][n] = __builtin_amdgcn_mfma_f32_16x16x32_bf16(Bt[n][k], At[m][k], acc[ai][bj][m][n], 0, 0, 0); __builtin_amdgcn_s_setprio(0); } while (0)
#define PG8_WAIT_V(n) asm volatile("s_waitcnt vmcnt(" #n ")" ::: "memory")
#define PG8_WAIT_L(n) asm volatile("s_waitcnt lgkmcnt(" #n ")" ::: "memory")
#define PG8_BAR __builtin_amdgcn_s_barrier()
#define PG8_SCHED __builtin_amdgcn_sched_barrier(0)
    Unit cur, nxt; int ui = 0;
    if (!S.next(0, cur)) return;
    f32x4 acc[2][2][4][2];
#pragma unroll
    for (int a = 0; a < 2; ++a)
#pragma unroll
        for (int b = 0; b < 2; ++b)
#pragma unroll
            for (int m = 0; m < 4; ++m)
#pragma unroll
                for (int n = 0; n < 2; ++n) acc[a][b][m][n] = (f32x4){0.f, 0.f, 0.f, 0.f};
    bf16x8 At[4][2], B0[2][2], B1[2][2];
    const char* cA = (const char*)(cur.kind ? g.A1 : g.A0) + (size_t)cur.pm * tstep; const char* cB = (const char*)(cur.kind ? g.B1 : g.B0) + (size_t)cur.pn * tstep;
    PG8_STAGE(PG8_SB(0, 0), cB, voffB); PG8_STAGE(PG8_SB(0, 1), cB + hstep, voffB); PG8_STAGE(PG8_SA(0, 0), cA, voffA); PG8_STAGE(PG8_SA(0, 1), cA + hstep, voffA);
    if (wr == 1) PG8_BAR;
    PG8_WAIT_V(2); PG8_BAR;
    PG8_STAGE(PG8_SB(1, 0), cB + kstep, voffB); PG8_STAGE(PG8_SA(1, 0), cA + kstep, voffA); PG8_STAGE(PG8_SB(1, 1), cB + hstep + kstep, voffB);
    PG8_WAIT_V(6); PG8_BAR;
    for (;;) {
        const bool has_next = S.next(ui + 1, nxt);
        const char* nA = has_next ? (const char*)(nxt.kind ? g.A1 : g.A0) + (size_t)nxt.pm * tstep : cA; const char* nB = has_next ? (const char*)(nxt.kind ? g.B1 : g.B0) + (size_t)nxt.pn * tstep : cB;
        for (int t = 0; t < nt; t += 2) {
            const bool last = (t == nt - 2);
            const char* a1 = cA + (size_t)(t + 1) * kstep;
            const char* a2 = last ? nA : cA + (size_t)(t + 2) * kstep; const char* b2 = last ? nB : cB + (size_t)(t + 2) * kstep;
            const char* a3 = a2 + kstep; const char* b3 = b2 + kstep;
            PG8_LDB(B0, 0, 0); PG8_LDB(B1, 0, 1); PG8_SCHED; PG8_LDA(At, 0, 0); PG8_STAGE(PG8_SA(1, 1), a1 + hstep, voffA);
            PG8_WAIT_V(8); PG8_WAIT_L(0); PG8_BAR; PG8_MMA(0, 0, At, B0); PG8_MMA(0, 1, At, B1); PG8_BAR; PG8_SCHED;
            PG8_LDA(At, 0, 1); PG8_STAGE(PG8_SB(0, 0), b2, voffB); PG8_STAGE(PG8_SB(0, 1), b2 + hstep, voffB); PG8_STAGE(PG8_SA(0, 0), a2, voffA);
            PG8_WAIT_V(8); PG8_WAIT_L(0); PG8_BAR; PG8_MMA(1, 0, At, B0); PG8_MMA(1, 1, At, B1); PG8_BAR; PG8_SCHED;
            PG8_LDB(B0, 1, 0); PG8_LDB(B1, 1, 1); PG8_SCHED; PG8_LDA(At, 1, 0); PG8_STAGE(PG8_SA(0, 1), a2 + hstep, voffA);
            PG8_WAIT_V(8); PG8_WAIT_L(0); PG8_BAR; PG8_MMA(0, 0, At, B0); PG8_MMA(0, 1, At, B1); PG8_BAR; PG8_SCHED;
            PG8_LDA(At, 1, 1); PG8_STAGE(PG8_SB(1, 0), b3, voffB); PG8_STAGE(PG8_SB(1, 1), b3 + hstep, voffB); PG8_STAGE(PG8_SA(1, 0), a3, voffA);
            PG8_WAIT_V(8); PG8_WAIT_L(0); PG8_BAR; PG8_MMA(1, 0, At, B0); PG8_MMA(1, 1, At, B1); PG8_BAR; PG8_SCHED;
        }
        if (wr == 0) PG8_BAR;
        E(acc, cur, wr, wc, fr, fq);
        if (!has_next) break;
#pragma unroll
        for (int a = 0; a < 2; ++a)
#pragma unroll
            for (int b = 0; b < 2; ++b)
#pragma unroll
                for (int m = 0; m < 4; ++m)
#pragma unroll
                    for (int n = 0; n < 2; ++n) acc[a][b][m][n] = (f32x4){0.f, 0.f, 0.f, 0.f};
        cur = nxt; cA = nA; cB = nB; ++ui;
        if (wr == 1) PG8_BAR;
    }
    PG8_WAIT_V(0);
    PG8_BAR;
#undef PG8_SA
#undef PG8_SB
#undef PG8_STAGE
#undef PG8_LDA
#undef PG8_LDB
#undef PG8_MMA
#undef PG8_WAIT_V
#undef PG8_WAIT_L
#undef PG8_BAR
#undef PG8_SCHED
}
}
using pg8::Unit;

struct Args {
    const float* in[26];
    float* out; unsigned char* ws;
    int ph_lo, ph_hi, use_sync, pad;
};

typedef const __attribute__((address_space(4))) Args* ArgsP;
#define KA ((ArgsP)__builtin_amdgcn_kernarg_segment_ptr())
#define A_IN(k) (KA->in[k])
#define A_OUT (KA->out)
#define A_WS (KA->ws)

struct SchedG1 {
    pg8::TileMap m0, m1; int G, c;
    __device__ __forceinline__ void init(int G_, int c_) { m0.init(NMT, 24); m1.init(4, NMT); G = G_; c = c_; }
    __device__ __forceinline__ bool next(int i, Unit& u) const {
        int L = i * G + c;
        if (L < m0.nwg) { m0.map(L, u.pm, u.pn); u.pn = (u.pn < 8) ? u.pn : u.pn + 4; u.kind = 0; return true; }
        L -= m0.nwg; if (L >= m1.nwg) return false;
        m1.map(L, u.pm, u.pn); u.kind = 1; return true;
    }
};
struct SchedPair {
    pg8::TileMap m0; int G, c;
    __device__ __forceinline__ void init(int nN, int G_, int c_) { m0.init(NMT, nN); G = G_; c = c_; }
    __device__ __forceinline__ bool next(int i, Unit& u) const { const int L = (i >> 1) * G + c; if (L >= m0.nwg) return false; m0.map(L, u.pm, u.pn); u.kind = i & 1; return true; }
};
struct SchedOne {
    pg8::TileMap m0; int G, c;
    __device__ __forceinline__ void init(int nN, int G_, int c_) { m0.init(NMT, nN); G = G_; c = c_; }
    __device__ __forceinline__ bool next(int i, Unit& u) const { const int L = i * G + c; if (L >= m0.nwg) return false; m0.map(L, u.pm, u.pn); u.kind = 0; return true; }
};

#define EPI_PREP int fr_ = fr, fq_ = fq; asm volatile("" : "+v"(fr_), "+v"(fq_)); const int rl_ = wr * 64 + fr_, cl_ = wc * 32 + 8 * fq_;
#define EPI_LOOP_BEGIN \
    _Pragma("unroll") for (int ai = 0; ai < 2; ++ai) _Pragma("unroll") for (int m = 0; m < 4; ++m) { const int rit = ai * 128 + m * 16 + rl_; \
    _Pragma("unroll") for (int bj = 0; bj < 2; ++bj) { const int cit = bj * 128 + cl_; f32x4 v0 = acc[ai][bj][m][0], v1 = acc[ai][bj][m][1];
#define EPI_LOOP_END } }

struct EpiG1 {
    __device__ __forceinline__ void operator()(const f32x4 (&acc)[2][2][4][2], const Unit& u, int wr, int wc, int fr, int fq) const {
        EPI_PREP unsigned char* ws = A_WS; float* out = A_OUT;
        if (u.kind == 0) {
            const int t = u.pn >> 2, ct = (u.pn & 3) * 256;
            bf16_t* base;
            if (t == 0) base = (bf16_t*)(ws + WS_Q); else if (t == 1) base = (bf16_t*)(ws + WS_K); else if (t == 3) base = (bf16_t*)(ws + WS_XR); else if (t == 4) base = (bf16_t*)(ws + WS_G);
            else if (t == 5) base = (u.pm < 256) ? (bf16_t*)(out + O_YP) : (bf16_t*)(ws + WS_SGA) - (size_t)NTP * DM;
            else base = (u.pm < 256) ? (bf16_t*)(out + O_YP) + (size_t)NTP * DM : (bf16_t*)(ws + WS_SGR) - (size_t)NTP * DM;
            base += (size_t)u.pm * 256 * DM + ct;
            EPI_LOOP_BEGIN
                u32x4 w; w.x = cvtpk(v0[0], v0[1]); w.y = cvtpk(v0[2], v0[3]); w.z = cvtpk(v1[0], v1[1]); w.w = cvtpk(v1[2], v1[3]);
                *(u32x4*)(base + (size_t)rit * DM + cit) = w;
            EPI_LOOP_END
            if (t == 1 && u.pm < 256 && (u.pm & 15) >= 14) { float* p0 = out + O_KP + ((size_t)(u.pm >> 4) * 512 + ((u.pm & 15) - 14) * 256) * DM + ct;
                EPI_LOOP_BEGIN float* p = p0 + (size_t)rit * DM + cit; *(f32x4*)p = v0; *(f32x4*)(p + 4) = v1; EPI_LOOP_END }
            if (t == 1 && u.pm == 256) { float* p0 = out + O_KS + ct;
                EPI_LOOP_BEGIN if (rit < NTS) { float* p = p0 + (size_t)rit * DM + cit; *(f32x4*)p = v0; *(f32x4*)(p + 4) = v1; } EPI_LOOP_END }
            if (t == 3 && u.pm < 256 && (u.pm & 15) == 15) { float* p0 = out + O_CP + ((size_t)(u.pm >> 4) * 3) * DM + ct;
                EPI_LOOP_BEGIN if (rit >= 253) { float* p = p0 + (size_t)(rit - 253) * DM + cit; *(f32x4*)p = v0; *(f32x4*)(p + 4) = v1; } EPI_LOOP_END }
            if (t == 3 && u.pm == 256) { float* p0 = out + O_CS + ct;
                EPI_LOOP_BEGIN if (rit < NTS && (rit & 15) >= 13) { float* p = p0 + ((size_t)(rit >> 4) * 3 + ((rit & 15) - 13)) * DM + cit; *(f32x4*)p = v0; *(f32x4*)(p + 4) = v1; } EPI_LOOP_END }
        } else {
            bf16_t* VT = (bf16_t*)(ws + WS_VT) + (size_t)u.pm * 256 * ROWS + (size_t)u.pn * 256;
            EPI_LOOP_BEGIN
                u32x4 w; w.x = cvtpk(v0[0], v0[1]); w.y = cvtpk(v0[2], v0[3]); w.z = cvtpk(v1[0], v1[1]); w.w = cvtpk(v1[2], v1[3]);
                *(u32x4*)(VT + (size_t)rit * ROWS + cit) = w;
            EPI_LOOP_END
            if (u.pn < 256 && (u.pn & 15) >= 14) { float* p0 = out + O_VP + ((size_t)(u.pn >> 4) * 512 + ((u.pn & 15) - 14) * 256) * DM + u.pm * 256;
                EPI_LOOP_BEGIN float* p = p0 + (size_t)cit * DM + rit;
                    p[0] = v0[0]; p[DM] = v0[1]; p[2 * DM] = v0[2]; p[3 * DM] = v0[3]; p[4 * DM] = v1[0]; p[5 * DM] = v1[1]; p[6 * DM] = v1[2]; p[7 * DM] = v1[3]; EPI_LOOP_END }
            if (u.pn == 256) { float* p0 = out + O_VS + u.pm * 256;
                EPI_LOOP_BEGIN if (cit < NTS) { float* p = p0 + (size_t)cit * DM + rit;
                    p[0] = v0[0]; p[DM] = v0[1]; p[2 * DM] = v0[2]; p[3 * DM] = v0[3]; p[4 * DM] = v1[0]; p[5 * DM] = v1[1]; p[6 * DM] = v1[2]; p[7 * DM] = v1[3]; } EPI_LOOP_END }
        }
    }
};

struct EpiP3 {
    __device__ __forceinline__ void operator()(const f32x4 (&acc)[2][2][4][2], const Unit& u, int wr, int wc, int fr, int fq) const {
        EPI_PREP unsigned char* ws = A_WS; float* out = A_OUT;
        const bf16_t* gb = (u.pm < 256) ? (const bf16_t*)(out + O_YP) + (u.kind ? (size_t)NTP * DM : 0) : (const bf16_t*)(ws + (u.kind ? WS_SGR : WS_SGA)) - (size_t)NTP * DM;
        const size_t off0 = (size_t)u.pm * 256 * DM + u.pn * 256;
        gb += off0; float* T1 = (float*)(ws + WS_K) + off0; bf16_t* MG = (bf16_t*)(ws + WS_XN) + off0;
        EPI_LOOP_BEGIN
            const size_t off = (size_t)rit * DM + cit;
            const u32x4 gw = *(const u32x4*)(gb + off);
            f32x4 s0, s1;
            s0[0] = sigmoidf_(bflo(gw.x)); s0[1] = sigmoidf_(bfhi(gw.x)); s0[2] = sigmoidf_(bflo(gw.y)); s0[3] = sigmoidf_(bfhi(gw.y));
            s1[0] = sigmoidf_(bflo(gw.z)); s1[1] = sigmoidf_(bfhi(gw.z)); s1[2] = sigmoidf_(bflo(gw.w)); s1[3] = sigmoidf_(bfhi(gw.w));
            if (u.kind == 0) { *(f32x4*)(T1 + off) = s0 * v0; *(f32x4*)(T1 + off + 4) = s1 * v1; }
            else { const f32x4 a0 = *(const f32x4*)(T1 + off) + s0 * v0, a1 = *(const f32x4*)(T1 + off + 4) + s1 * v1;
                u32x4 w; w.x = cvtpk(a0[0], a0[1]); w.y = cvtpk(a0[2], a0[3]); w.z = cvtpk(a1[0], a1[1]); w.w = cvtpk(a1[2], a1[3]);
                *(u32x4*)(MG + off) = w; }
        EPI_LOOP_END
    }
};

struct EpiP4 {
    __device__ __forceinline__ void operator()(const f32x4 (&acc)[2][2][4][2], const Unit& u, int wr, int wc, int fr, int fq) const {
        EPI_PREP float* out = A_OUT;
        if (u.pm < 256) { const size_t off0 = (size_t)u.pm * 256 * DM + u.pn * 256; const float* xp = A_IN(0) + off0; float* yo = out + O_YP + off0;
            EPI_LOOP_BEGIN const size_t off = (size_t)rit * DM + cit;
                *(f32x4*)(yo + off) = *(const f32x4*)(xp + off) + v0; *(f32x4*)(yo + off + 4) = *(const f32x4*)(xp + off + 4) + v1; EPI_LOOP_END }
        else { const float* xs = A_IN(1) + u.pn * 256; float* yo = out + O_YS + u.pn * 256;
            EPI_LOOP_BEGIN if (rit < NTS) { const size_t off = (size_t)rit * DM + cit;
                *(f32x4*)(yo + off) = *(const f32x4*)(xs + off) + v0; *(f32x4*)(yo + off + 4) = *(const f32x4*)(xs + off + 4) + v1; } EPI_LOOP_END }
    }
};

struct EpiP5 {
    __device__ __forceinline__ void operator()(const f32x4 (&acc)[2][2][4][2], const Unit& u, int wr, int wc, int fr, int fq) const {
        EPI_PREP float* SC = (float*)(A_WS + WS_XN) + (size_t)u.pm * 256 * 2048 + u.pn * 256;
        EPI_LOOP_BEGIN
            float* p = SC + (size_t)rit * 2048 + cit; *(f32x4*)p = v0; *(f32x4*)(p + 4) = v1;
        EPI_LOOP_END
    }
};

__device__ __forceinline__ void p0_transpose_item(const float* W, int K, int N, bf16_t* WT, LAS float* scr, int item, int lane, int nscale = 0) {
    const int nblk = N / 32, kb = item / nblk, nb = item % nblk, k0 = 64 * kb, n0 = 32 * nb;
#pragma unroll 8
    for (int i = 0; i < 32; ++i) { const int kk = 2 * i + (lane >> 5); scr[kk * 33 + (lane & 31)] = W[(size_t)(k0 + kk) * N + n0 + (lane & 31)] * (n0 < nscale ? QSCALE : 1.0f); }
    asm volatile("s_waitcnt lgkmcnt(0)" ::: "memory");
    const int c = lane & 7;
#pragma unroll
    for (int j = 0; j < 4; ++j) { const int n = (lane >> 3) + 8 * j; const LAS float* s = scr + (8 * c) * 33 + n;
        u32x4 o; o.x = cvtpk(s[0 * 33], s[1 * 33]); o.y = cvtpk(s[2 * 33], s[3 * 33]); o.z = cvtpk(s[4 * 33], s[5 * 33]); o.w = cvtpk(s[6 * 33], s[7 * 33]);
        *(u32x4*)(WT + (size_t)(n0 + n) * K + k0 + 8 * c) = o; }
    asm volatile("s_waitcnt lgkmcnt(0)" ::: "memory");
}

__device__ __forceinline__ void p0_prologue(LAS unsigned char* lds, int G, int wave, int lane) {
    unsigned char* ws = A_WS;
    const int gw = blockIdx.x * 8 + wave, NGW = G * 8;
    LAS float* scr = (LAS float*)(lds + wave * 16384);
    constexpr int I_IN = 16 * (INC / 32), I_SQ = 16 * 32, NTR = I_IN + 3 * I_SQ;
    for (int it = gw; it < NTR; it += NGW) {
        int r = it;
        if (r < I_IN) { p0_transpose_item(A_IN(7), DM, INC, (bf16_t*)(ws + WS_WIN), scr, r, lane, 1024); continue; } r -= I_IN;
        if (r < I_SQ) { p0_transpose_item(A_IN(16), DM, DM, (bf16_t*)(ws + WS_WBA), scr, r, lane); continue; } r -= I_SQ;
        if (r < I_SQ) { p0_transpose_item(A_IN(17), DM, DM, (bf16_t*)(ws + WS_WBL), scr, r, lane); continue; } r -= I_SQ;
        p0_transpose_item(A_IN(18), DM, DM, (bf16_t*)(ws + WS_WO), scr, r, lane);
    }
    {
        const float* wq = A_IN(20); bf16_t* wst = (bf16_t*)(ws + WS_WS);
        const int r32 = lane & 31, hi = lane >> 5;
        for (int it = gw; it < 2048; it += NGW) {
            const int hj = it >> 7, kt = (it >> 5) & 3, ct = it & 31, h = hj >> 1, j = hj & 1;
            const float* ap = (j ? A_IN(22) : A_IN(21)) + ((size_t)(h * 128 + kt * 32 + r32)) * 128 + 64 * hi;
            const float* bp = wq + (size_t)(ct * 32 + r32) * 2048 + hj * 128 + 64 * hi;
            f32x16 acc = {};
#pragma unroll
            for (int s4 = 0; s4 < 16; ++s4) { const f32x4 av = *(const f32x4*)(ap + 4 * s4), bv = *(const f32x4*)(bp + 4 * s4);
                acc = __builtin_amdgcn_mfma_f32_32x32x2f32(av[0], bv[0], acc, 0, 0, 0); acc = __builtin_amdgcn_mfma_f32_32x32x2f32(av[1], bv[1], acc, 0, 0, 0);
                acc = __builtin_amdgcn_mfma_f32_32x32x2f32(av[2], bv[2], acc, 0, 0, 0); acc = __builtin_amdgcn_mfma_f32_32x32x2f32(av[3], bv[3], acc, 0, 0, 0); }
#pragma unroll
            for (int r = 0; r < 16; ++r) { const int key = kt * 32 + (r & 3) + 8 * (r >> 2) + 4 * hi;
                wst[(size_t)(hj * 128 + key) * DM + ct * 32 + r32] = (bf16_t)(cvtpk(acc[r], 0.f) & 0xffffu); }
        }
    }
    for (int it = gw; it < 2 * NEXP; it += NGW) {
        const int tb = it >= NEXP, e = it - tb * NEXP;
        const float* src = (tb ? A_IN(24) : A_IN(23)) + (size_t)e * DM; bf16_t* dst = (bf16_t*)(ws + (tb ? WS_VB : WS_UB)) + (size_t)e * DM;
#pragma unroll
        for (int hh = 0; hh < 2; ++hh) { const f32x4 p = *(const f32x4*)(src + hh * 512 + lane * 8), q = *(const f32x4*)(src + hh * 512 + lane * 8 + 4);
            u32x4 w; w.x = cvtpk(p[0], p[1]); w.y = cvtpk(p[2], p[3]); w.z = cvtpk(q[0], q[1]); w.w = cvtpk(q[2], q[3]); *(u32x4*)(dst + hh * 512 + lane * 8) = w; }
    }
    {
        const float* gm = A_IN(6); bf16_t* XN = (bf16_t*)(ws + WS_XN);
        for (int m = gw; m < ROWS; m += NGW) {
            bf16_t* orow = XN + (size_t)m * DM;
            if (m >= NTOK) {
#pragma unroll
                for (int j = 0; j < 2; ++j) *(u32x4*)(orow + j * 512 + lane * 8) = (u32x4){0u, 0u, 0u, 0u};
                continue; }
            const float* xr = (m < NTP) ? A_IN(0) + (size_t)m * DM : A_IN(1) + (size_t)(m - NTP) * DM;
            f32x4 v[4]; float s = 0.f;
#pragma unroll
            for (int j = 0; j < 4; ++j) { v[j] = *(const f32x4*)(xr + j * 256 + lane * 4); s += (v[j][0] * v[j][0] + v[j][1] * v[j][1]) + (v[j][2] * v[j][2] + v[j][3] * v[j][3]); }
            const float inv = 1.0f / sqrtf(wave_sum(s) * (1.0f / DM) + EPS);
#pragma unroll
            for (int j = 0; j < 4; ++j) { const f32x4 gg = *(const f32x4*)(gm + j * 256 + lane * 4); const f32x4 y = v[j] * inv * gg;
                u32x2 w; w.x = cvtpk(y[0], y[1]); w.y = cvtpk(y[2], y[3]); *(u32x2*)(orow + j * 256 + lane * 4) = w; }
        }
    }
    {
        bf16_t* fw = (bf16_t*)(ws + WS_LRUW);
        for (int f = gw; f < 256; f += NGW) {
            const int ks = f & 3, T = (f >> 2) & 1, gate = (f >> 3) & 1, g = f >> 4, i = lane & 31, hi = lane >> 5;
            const int outc = 32 * T + swap23(i);
            const float* W = (gate ? A_IN(13) : A_IN(11)) + (size_t)g * 4096;
            float x[8];
#pragma unroll
            for (int j = 0; j < 8; ++j) x[j] = W[(16 * ks + 8 * hi + j) * 64 + outc];
            u32x4 w; w.x = cvtpk(x[0], x[1]); w.y = cvtpk(x[2], x[3]); w.z = cvtpk(x[4], x[5]); w.w = cvtpk(x[6], x[7]);
            *(u32x4*)(fw + (size_t)f * 512 + lane * 8) = w;
        }
    }
}

constexpr int LR_WF = 0, LR_CW = 16384, LR_CB = LR_CW + 1024, LR_BR = LR_CB + 256, LR_BI = LR_BR + 256, LR_CS = LR_BI + 256, LR_CARRY = LR_CS + 256, LR_SEQ = LR_CARRY + 2048, LR_END = LR_SEQ + 64;

__device__ __forceinline__ void lru_load_consts(LAS unsigned char* lds, int g, int tid) {
    const u32x4* src = (const u32x4*)(A_WS + WS_LRUW + (size_t)g * 16384);
    for (int i = tid; i < 1024; i += 512) ((LAS u32x4*)(lds + LR_WF))[i] = src[i];
    if (tid < 256) ((LAS float*)(lds + LR_CW))[tid] = A_IN(9)[(tid >> 6) * DM + g * 64 + (tid & 63)];
    if (tid < 64) {
        const int c = g * 64 + tid;
        ((LAS float*)(lds + LR_CB))[tid] = A_IN(10)[c]; ((LAS float*)(lds + LR_BR))[tid] = A_IN(12)[c]; ((LAS float*)(lds + LR_BI))[tid] = A_IN(14)[c];
        ((LAS float*)(lds + LR_CS))[tid] = 8.0f * log1pf(expf(-A_IN(15)[c]));
    }
    if (tid < 8) ((LAS unsigned*)(lds + LR_SEQ))[tid] = 0xffffffffu;
}

template <bool SAMPLE>
__device__ __forceinline__ void lru_tile(LAS unsigned char* lds, int lane, int g, size_t rowbase, int tile, int bidx) {
    asm volatile("" : "+v"(lane));
    const int tl = lane & 31, hi = lane >> 5, t = tile * 32 + tl;
    const bf16_t* XR = (const bf16_t*)(A_WS + WS_XR); bf16_t* Gb = (bf16_t*)(A_WS + WS_G);
    const int cbase = g * 64 + 8 * hi;
    float xc[4][8];
    bf16x8 xf[4];
#pragma unroll
    for (int ks = 0; ks < 4; ++ks) {
        const f32x4 b0 = *(const LAS f32x4*)(lds + LR_CB + (16 * ks + 8 * hi) * 4), b1 = *(const LAS f32x4*)(lds + LR_CB + (16 * ks + 8 * hi) * 4 + 16);
#pragma unroll
        for (int j = 0; j < 4; ++j) { xc[ks][j] = b0[j]; xc[ks][4 + j] = b1[j]; }
#pragma unroll
        for (int tap = 0; tap < 4; ++tap) {
            const int rr = t - 3 + tap;
            float xv[8];
            {
                u32x4 w = *(const u32x4*)(XR + (rowbase + (rr < 0 ? 0 : rr)) * DM + cbase + 16 * ks);
                if (rr < 0) w = (u32x4){0u, 0u, 0u, 0u};
                xv[0] = bflo(w.x); xv[1] = bfhi(w.x); xv[2] = bflo(w.y); xv[3] = bfhi(w.y); xv[4] = bflo(w.z); xv[5] = bfhi(w.z); xv[6] = bflo(w.w); xv[7] = bfhi(w.w);
            }
            if (SAMPLE) {
                const float* sp = A_IN(4) + ((size_t)bidx * 3 + (rr < 0 ? 3 + rr : 0)) * DM + cbase + 16 * ks;
                const f32x4 p = *(const f32x4*)sp, q = *(const f32x4*)(sp + 4);
#pragma unroll
                for (int j = 0; j < 4; ++j) { xv[j] = rr < 0 ? p[j] : xv[j]; xv[4 + j] = rr < 0 ? q[j] : xv[4 + j]; }
            }
            const f32x4 w0 = *(const LAS f32x4*)(lds + LR_CW + (tap * 64 + 16 * ks + 8 * hi) * 4), w1 = *(const LAS f32x4*)(lds + LR_CW + (tap * 64 + 16 * ks + 8 * hi) * 4 + 16);
#pragma unroll
            for (int j = 0; j < 4; ++j) { xc[ks][j] += w0[j] * xv[j]; xc[ks][4 + j] += w1[j] * xv[4 + j]; }
        }
        u32x4 w; w.x = cvtpk(xc[ks][0], xc[ks][1]); w.y = cvtpk(xc[ks][2], xc[ks][3]); w.z = cvtpk(xc[ks][4], xc[ks][5]); w.w = cvtpk(xc[ks][6], xc[ks][7]);
        xf[ks] = __builtin_bit_cast(bf16x8, w);
        asm volatile("" ::: "memory");
    }
    float A[32], B[32];
#pragma unroll
    for (int T = 0; T < 2; ++T) {
        f32x16 ar = f32x16{}, ai = f32x16{};
#pragma unroll
        for (int ks = 0; ks < 4; ++ks) {
            const bf16x8 wr_ = *(const LAS bf16x8*)(lds + LR_WF + ((0 * 2 + T) * 4 + ks) * 1024 + lane * 16);
            const bf16x8 wi_ = *(const LAS bf16x8*)(lds + LR_WF + ((1 * 2 + T) * 4 + ks) * 1024 + lane * 16);
            ar = __builtin_amdgcn_mfma_f32_32x32x16_bf16(wr_, xf[ks], ar, 0, 0, 0);
            ai = __builtin_amdgcn_mfma_f32_32x32x16_bf16(wi_, xf[ks], ai, 0, 0, 0);
        }
#pragma unroll
        for (int q = 0; q < 2; ++q) {
            const int ks = 2 * T + q, lo = (16 * ks + 8 * hi) * 4;
            const f32x4 br0 = *(const LAS f32x4*)(lds + LR_BR + lo), br1 = *(const LAS f32x4*)(lds + LR_BR + lo + 16);
            const f32x4 bi0 = *(const LAS f32x4*)(lds + LR_BI + lo), bi1 = *(const LAS f32x4*)(lds + LR_BI + lo + 16);
            const f32x4 cs0 = *(const LAS f32x4*)(lds + LR_CS + lo), cs1 = *(const LAS f32x4*)(lds + LR_CS + lo + 16);
#pragma unroll
            for (int j = 0; j < 8; ++j) {
                const int r = 8 * q + j;
                const float brv = j < 4 ? br0[j & 3] : br1[j & 3], biv = j < 4 ? bi0[j & 3] : bi1[j & 3], csv = j < 4 ? cs0[j & 3] : cs1[j & 3];
                const float rg = sigmoidf_(ar[r] + brv), ig = sigmoidf_(ai[r] + biv);
                const float la = -csv * rg, av = fast_exp2(la * LOG2E);
                const float x2 = 2.0f * la;
                const float em = (x2 > -0.03f) ? -x2 * (1.0f + x2 * (0.5f + x2 * (0.16666667f + x2 * 0.041666668f))) : 1.0f - fast_exp2(x2 * LOG2E);
                A[16 * T + r] = av; B[16 * T + r] = sqrtf(em) * ig * xc[ks][j];
            }
        }
        asm volatile("" ::: "memory");
    }
#define LRU_STEP(CTRL, RM) _Pragma("unroll") for (int c = 0; c < 32; ++c) { \
        const float as_ = __builtin_bit_cast(float, __builtin_amdgcn_update_dpp(__builtin_bit_cast(int, 1.0f), __builtin_bit_cast(int, A[c]), CTRL, RM, 0xF, false)); \
        const float bs_ = __builtin_bit_cast(float, __builtin_amdgcn_update_dpp(0, __builtin_bit_cast(int, B[c]), CTRL, RM, 0xF, false)); \
        B[c] = A[c] * bs_ + B[c]; A[c] = A[c] * as_; }
    LRU_STEP(0x111, 0xF) LRU_STEP(0x112, 0xF) LRU_STEP(0x114, 0xF) LRU_STEP(0x118, 0xF) LRU_STEP(0x142, 0xA)
#undef LRU_STEP
    float hin[32];
    if (SAMPLE) {
        const float* hp = A_IN(5) + (size_t)bidx * DM + cbase;
#pragma unroll
        for (int ks = 0; ks < 4; ++ks) { const f32x4 p = *(const f32x4*)(hp + 16 * ks), q = *(const f32x4*)(hp + 16 * ks + 4);
#pragma unroll
            for (int j = 0; j < 4; ++j) { hin[8 * ks + j] = p[j]; hin[8 * ks + 4 + j] = q[j]; } }
    } else if (tile == 0) {
#pragma unroll
        for (int c = 0; c < 32; ++c) hin[c] = 0.f;
    } else {
        volatile LAS unsigned* sq = (volatile LAS unsigned*)(lds + LR_SEQ) + (tile & 7);
        while (*sq != (unsigned)tile) __builtin_amdgcn_s_sleep(1);
        asm volatile("" ::: "memory");
        const LAS float* cp = (const LAS float*)(lds + LR_CARRY) + (tile & 7) * 64 + 8 * hi;
#pragma unroll
        for (int ks = 0; ks < 4; ++ks) { const f32x4 p = *(const LAS f32x4*)(cp + 16 * ks), q = *(const LAS f32x4*)(cp + 16 * ks + 4);
#pragma unroll
            for (int j = 0; j < 4; ++j) { hin[8 * ks + j] = p[j]; hin[8 * ks + 4 + j] = q[j]; } }
    }
#pragma unroll
    for (int c = 0; c < 32; ++c) B[c] = B[c] + A[c] * hin[c];
    if (!SAMPLE) {
        if (tl == 31) {
            if (tile < 127) {
                LAS float* cp = (LAS float*)(lds + LR_CARRY) + ((tile + 1) & 7) * 64 + 8 * hi;
#pragma unroll
                for (int ks = 0; ks < 4; ++ks) { *(LAS f32x4*)(cp + 16 * ks) = (f32x4){B[8 * ks], B[8 * ks + 1], B[8 * ks + 2], B[8 * ks + 3]};
                    *(LAS f32x4*)(cp + 16 * ks + 4) = (f32x4){B[8 * ks + 4], B[8 * ks + 5], B[8 * ks + 6], B[8 * ks + 7]}; }
            } else {
                float* lp = A_OUT + O_LP + (size_t)bidx * DM + cbase;
#pragma unroll
                for (int ks = 0; ks < 4; ++ks) { *(f32x4*)(lp + 16 * ks) = (f32x4){B[8 * ks], B[8 * ks + 1], B[8 * ks + 2], B[8 * ks + 3]};
                    *(f32x4*)(lp + 16 * ks + 4) = (f32x4){B[8 * ks + 4], B[8 * ks + 5], B[8 * ks + 6], B[8 * ks + 7]}; }
            }
        }
        if (tile < 127) {
            asm volatile("s_waitcnt lgkmcnt(0)" ::: "memory");
            if (lane == 63) *((volatile LAS unsigned*)(lds + LR_SEQ) + ((tile + 1) & 7)) = (unsigned)(tile + 1);
        }
    } else if (tl == 15) {
        float* lp = A_OUT + O_LS + (size_t)bidx * DM + cbase;
#pragma unroll
        for (int ks = 0; ks < 4; ++ks) { *(f32x4*)(lp + 16 * ks) = (f32x4){B[8 * ks], B[8 * ks + 1], B[8 * ks + 2], B[8 * ks + 3]};
            *(f32x4*)(lp + 16 * ks + 4) = (f32x4){B[8 * ks + 4], B[8 * ks + 5], B[8 * ks + 6], B[8 * ks + 7]}; }
    }
    if (!SAMPLE || tl < NST) {
        bf16_t* gp = Gb + (rowbase + t) * DM + cbase;
#pragma unroll
        for (int ks = 0; ks < 4; ++ks) {
            const u32x4 w = *(const u32x4*)(gp + 16 * ks);
            float gv[8]; gv[0] = bflo(w.x); gv[1] = bfhi(w.x); gv[2] = bflo(w.y); gv[3] = bfhi(w.y); gv[4] = bflo(w.z); gv[5] = bfhi(w.z); gv[6] = bflo(w.w); gv[7] = bfhi(w.w);
            float o[8];
#pragma unroll
            for (int j = 0; j < 8; ++j) o[j] = B[8 * ks + j] * gelu_tanh(gv[j]);
            u32x4 ow; ow.x = cvtpk(o[0], o[1]); ow.y = cvtpk(o[2], o[3]); ow.z = cvtpk(o[4], o[5]); ow.w = cvtpk(o[6], o[7]);
            *(u32x4*)(gp + 16 * ks) = ow;
        }
    }
}

constexpr int AT_TAB = 24576;
__device__ __forceinline__ void attn_unit(LAS unsigned char* lds, int lane, int b, int c, int h) {
    const int r32 = lane & 31, hi = lane >> 5, kr = swap23(r32);
    const bf16_t* Q = (const bf16_t*)(A_WS + WS_Q); const bf16_t* Kb = (const bf16_t*)(A_WS + WS_K); const bf16_t* VT = (const bf16_t*)(A_WS + WS_VT); bf16_t* O = (bf16_t*)(A_WS + WS_Q);
    const size_t row0 = (size_t)b * SEQ + (size_t)c * 64;
    bf16x8 qf[2][4];
#pragma unroll
    for (int qb = 0; qb < 2; ++qb)
#pragma unroll
        for (int ks = 0; ks < 4; ++ks) qf[qb][ks] = *(const bf16x8*)(Q + (row0 + qb * 32 + r32) * DM + h * 64 + ks * 16 + hi * 8);
    f32x16 o[2][2];
#pragma unroll
    for (int i = 0; i < 2; ++i)
#pragma unroll
        for (int j = 0; j < 2; ++j) o[i][j] = f32x16{};
    float mrow[2] = {-1e30f, -1e30f}, lrow[2] = {0.f, 0.f};
    const LAS float* tab = (const LAS float*)(lds + AT_TAB) + h * 320;
    const float cfar = tab[256];
    const int sb0 = (c >= 8 ? c - 8 : 0) * 2, sb1 = c * 2 + 1;
    const bf16_t* kbase = Kb + ((size_t)b * SEQ + kr) * DM + h * 64 + hi * 8;
    const bf16_t* vbase = VT + (size_t)(h * 64 + kr) * ROWS + (size_t)b * SEQ + hi * 8;
    bf16x8 kf[4], vf[2][2];
#pragma unroll
    for (int ks = 0; ks < 4; ++ks) kf[ks] = *(const bf16x8*)(kbase + (size_t)sb0 * 32 * DM + ks * 16);
#pragma unroll
    for (int db = 0; db < 2; ++db)
#pragma unroll
        for (int s = 0; s < 2; ++s) vf[db][s] = *(const bf16x8*)(vbase + (size_t)db * 32 * ROWS + sb0 * 32 + s * 16);
    for (int sb = sb0; sb <= sb1; ++sb) {
        const int sbn = sb < sb1 ? sb + 1 : sb;
        f32x16 S[2];
#pragma unroll
        for (int qb = 0; qb < 2; ++qb) { S[qb] = f32x16{};
#pragma unroll
            for (int ks = 0; ks < 4; ++ks) S[qb] = __builtin_amdgcn_mfma_f32_32x32x16_bf16(kf[ks], qf[qb][ks], S[qb], 0, 0, 0); }
        asm volatile("" ::: "memory");
#pragma unroll
        for (int ks = 0; ks < 4; ++ks) kf[ks] = *(const bf16x8*)(kbase + (size_t)sbn * 32 * DM + ks * 16);
        const int delta = c - (sb >> 1), rb = sb & 1;
        if (delta >= 3) {
#pragma unroll
            for (int qb = 0; qb < 2; ++qb)
#pragma unroll
                for (int r = 0; r < 16; ++r) S[qb][r] += cfar;
        } else {
#pragma unroll
            for (int qb = 0; qb < 2; ++qb) {
                const LAS float* tp = tab + (64 * delta + 32 * qb + r32 + 128 - 32 * rb - 8 * hi - 23);
#pragma unroll
                for (int r = 0; r < 16; ++r) S[qb][r] += tp[23 - (16 * (r >> 3) + (r & 7))];
            }
        }
        float rm[2];
#pragma unroll
        for (int qb = 0; qb < 2; ++qb) { float mx = S[qb][0];
#pragma unroll
            for (int r = 1; r < 16; ++r) mx = fmaxf(mx, S[qb][r]);
            rm[qb] = plswap_max(mx); }
        if (__any((rm[0] > mrow[0] + 8.0f) || (rm[1] > mrow[1] + 8.0f))) {
#pragma unroll
            for (int qb = 0; qb < 2; ++qb) { const float mn = fmaxf(mrow[qb], rm[qb]); const float al = fast_exp2(mrow[qb] - mn); lrow[qb] *= al; mrow[qb] = mn;
#pragma unroll
                for (int r = 0; r < 16; ++r) { o[0][qb][r] *= al; o[1][qb][r] *= al; } }
        }
        bf16x8 pf[2][2];
#pragma unroll
        for (int qb = 0; qb < 2; ++qb) { float sum = 0.f;
#pragma unroll
            for (int r = 0; r < 16; ++r) { S[qb][r] = fast_exp2(S[qb][r] - mrow[qb]); sum += S[qb][r]; }
            lrow[qb] += sum;
#pragma unroll
            for (int s = 0; s < 2; ++s) { u32x4 w; w.x = cvtpk(S[qb][8 * s], S[qb][8 * s + 1]); w.y = cvtpk(S[qb][8 * s + 2], S[qb][8 * s + 3]); w.z = cvtpk(S[qb][8 * s + 4], S[qb][8 * s + 5]); w.w = cvtpk(S[qb][8 * s + 6], S[qb][8 * s + 7]);
                pf[qb][s] = __builtin_bit_cast(bf16x8, w); } }
#pragma unroll
        for (int db = 0; db < 2; ++db)
#pragma unroll
            for (int qb = 0; qb < 2; ++qb)
#pragma unroll
                for (int s = 0; s < 2; ++s) o[db][qb] = __builtin_amdgcn_mfma_f32_32x32x16_bf16(vf[db][s], pf[qb][s], o[db][qb], 0, 0, 0);
        asm volatile("" ::: "memory");
#pragma unroll
        for (int db = 0; db < 2; ++db)
#pragma unroll
            for (int s = 0; s < 2; ++s) vf[db][s] = *(const bf16x8*)(vbase + (size_t)db * 32 * ROWS + sbn * 32 + s * 16);
    }
#pragma unroll
    for (int qb = 0; qb < 2; ++qb) { const float inv = fast_rcp(plswap_add(lrow[qb]));
        bf16_t* op = O + (row0 + qb * 32 + r32) * DM + h * 64 + 8 * hi;
#pragma unroll
        for (int db = 0; db < 2; ++db)
#pragma unroll
            for (int s = 0; s < 2; ++s) { u32x4 w;
                w.x = cvtpk(o[db][qb][8 * s] * inv, o[db][qb][8 * s + 1] * inv); w.y = cvtpk(o[db][qb][8 * s + 2] * inv, o[db][qb][8 * s + 3] * inv);
                w.z = cvtpk(o[db][qb][8 * s + 4] * inv, o[db][qb][8 * s + 5] * inv); w.w = cvtpk(o[db][qb][8 * s + 6] * inv, o[db][qb][8 * s + 7] * inv);
                *(u32x4*)(op + 32 * db + 16 * s) = w; } }
}

constexpr int AS_P = 45056;
__device__ __forceinline__ void attn_sample_task(LAS unsigned char* lds, int wave, int lane, int task) {
    const int bs = task >> 6, h = (task >> 2) & 15, qg = task & 3;
    const bf16_t* Q = (const bf16_t*)(A_WS + WS_Q); bf16_t* O = (bf16_t*)(A_WS + WS_Q);
    const float* ck = A_IN(2); const float* cv = A_IN(3); const float* kn = A_OUT + O_KS; const float* vn = A_OUT + O_VS;
    LAS float* pb = (LAS float*)(lds + AS_P + wave * 9472);
    LAS float* qs = pb + 4 * 528;
    const LAS float* tab = (const LAS float*)(lds + AT_TAB) + h * 320;
#pragma unroll
    for (int i = 0; i < 4; ++i) qs[i * 64 + lane] = bflo((unsigned)Q[((size_t)NTP + bs * 16 + qg * 4 + i) * DM + h * 64 + lane]);
    asm volatile("s_waitcnt lgkmcnt(0)" ::: "memory");
#pragma unroll 1
    for (int it = 0; it < 9; ++it) {
        const int key = it * 64 + lane; const bool valid = key < 528;
        const float* kp = !valid ? ck : (key < 512 ? ck + (((size_t)bs * 512 + key) * 16 + h) * 64 : kn + ((size_t)bs * 16 + (key - 512)) * DM + h * 64);
        float d[4] = {0.f, 0.f, 0.f, 0.f};
#pragma unroll 4
        for (int d4 = 0; d4 < 16; ++d4) { const f32x4 kv = *(const f32x4*)(kp + 4 * d4);
#pragma unroll
            for (int i = 0; i < 4; ++i) { const f32x4 qq = *(const LAS f32x4*)(qs + i * 64 + 4 * d4); d[i] += (kv[0] * qq[0] + kv[1] * qq[1]) + (kv[2] * qq[2] + kv[3] * qq[3]); } }
        int rel = 512 + qg * 4 - key;
        if (valid) {
#pragma unroll
            for (int i = 0; i < 4; ++i) { int r = rel + i; r = r > 128 ? 128 : r; pb[i * 528 + key] = d[i] + tab[r + 128]; } }
    }
    asm volatile("s_waitcnt lgkmcnt(0)" ::: "memory");
#pragma unroll 1
    for (int i = 0; i < 4; ++i) {
        float mx = -1e30f;
#pragma unroll 1
        for (int key = lane; key < 528; key += 64) mx = fmaxf(mx, pb[i * 528 + key]);
#pragma unroll
        for (int o = 1; o < 64; o <<= 1) mx = fmaxf(mx, __shfl_xor(mx, o));
        float sum = 0.f;
#pragma unroll 1
        for (int key = lane; key < 528; key += 64) { const float pv = fast_exp2(pb[i * 528 + key] - mx); pb[i * 528 + key] = pv; sum += pv; }
        sum = wave_sum(sum); const float inv = 1.0f / sum;
#pragma unroll 1
        for (int key = lane; key < 528; key += 64) pb[i * 528 + key] *= inv;
    }
    asm volatile("s_waitcnt lgkmcnt(0)" ::: "memory");
    float acc[4] = {0.f, 0.f, 0.f, 0.f};
#pragma unroll 4
    for (int key = 0; key < 528; ++key) {
        const float v = key < 512 ? cv[(((size_t)bs * 512 + key) * 16 + h) * 64 + lane] : vn[((size_t)bs * 16 + (key - 512)) * DM + h * 64 + lane];
#pragma unroll
        for (int i = 0; i < 4; ++i) acc[i] += pb[i * 528 + key] * v;
    }
#pragma unroll
    for (int i = 0; i < 4; ++i) O[((size_t)NTP + bs * 16 + qg * 4 + i) * DM + h * 64 + lane] = (bf16_t)(cvtpk(acc[i], 0.f) & 0xffffu);
    asm volatile("s_waitcnt lgkmcnt(0)" ::: "memory");
}

__device__ __forceinline__ void p2_phase(LAS unsigned char* lds, int G, int tid, int wave, int lane) {
    for (int i = tid; i < 16 * 320; i += 512) { const int h = i / 320, j = i % 320; ((LAS float*)(lds + AT_TAB))[i] = A_IN(8)[h * 257 + (j > 256 ? 256 : j)] * LOG2E; }
    for (int u = blockIdx.x; u < 256 + 16; u += G) {
        __syncthreads();
        if (u < 256) {
            const int b = u >> 4, g = u & 15;
            lru_load_consts(lds, g, tid);
            __syncthreads();
            for (int tile = wave; tile < 128; tile += 8) lru_tile<false>(lds, lane, g, (size_t)b * SEQ, tile, b);
        } else {
            const int g = u - 256;
            lru_load_consts(lds, g, tid);
            __syncthreads();
            lru_tile<true>(lds, lane, g, (size_t)NTP + wave * 16, 0, wave);
        }
    }
    __syncthreads();
    const int gw = blockIdx.x * 8 + wave, NGW = G * 8;
    for (int u = gw; u < NB * 64 * 16; u += NGW) {
        const int c = u & 63, h = (u >> 6) & 15, b = u >> 10;
        attn_unit(lds, lane, b, c, h);
    }
    for (int t = gw; t < 512; t += NGW) attn_sample_task(lds, wave, lane, t);
}

__device__ __forceinline__ void p4b_phase(int G, int wave, int lane) {
    const int gw = blockIdx.x * 8 + wave, NGW = G * 8;
    const float* gm = A_IN(19); bf16_t* XT = (bf16_t*)(A_WS + WS_Q);
    for (int m = gw; m < NTOK; m += NGW) {
        const float* xr = (m < NTP) ? A_OUT + O_YP + (size_t)m * DM : A_OUT + O_YS + (size_t)(m - NTP) * DM;
        bf16_t* orow = XT + (size_t)m * DM;
        f32x4 v[4]; float s = 0.f;
#pragma unroll
        for (int j = 0; j < 4; ++j) { v[j] = *(const f32x4*)(xr + j * 256 + lane * 4); s += (v[j][0] * v[j][0] + v[j][1] * v[j][1]) + (v[j][2] * v[j][2] + v[j][3] * v[j][3]); }
        const float inv = 1.0f / sqrtf(wave_sum(s) * (1.0f / DM) + EPS);
#pragma unroll
        for (int j = 0; j < 4; ++j) { const f32x4 gg = *(const f32x4*)(gm + j * 256 + lane * 4); const f32x4 y = v[j] * inv * gg;
            u32x2 w; w.x = cvtpk(y[0], y[1]); w.y = cvtpk(y[2], y[3]); *(u32x2*)(orow + j * 256 + lane * 4) = w; }
    }
}

__device__ __forceinline__ int f2key(float f) { const int b = __float_as_int(f); return b ^ ((b >> 31) & 0x7fffffff); }
__device__ __forceinline__ float key2f(int k) { return __int_as_float(k ^ ((k >> 31) & 0x7fffffff)); }
#define INS16(L, x) do { int x_ = (x); _Pragma("unroll") for (int j_ = 0; j_ < 16; ++j_) { const int hi_ = max(L[j_], x_); x_ = min(L[j_], x_); L[j_] = hi_; } } while (0)

constexpr size_t WS_SELE = WS_G, WS_SELG = WS_G + 64 * MiB;
constexpr size_t WS_PART = WS_XN;
constexpr int CT_U = 64, CT_V = 64 + 8 * 64;
constexpr int P6_TOKB = 64, P6_NITEM = NTOK / P6_TOKB;
constexpr int P6_IDX = 0;
constexpr int P6_E = 0, P6_C = 8192, P6_ITEM = 16384;

__device__ __forceinline__ void p6a_phase(LAS unsigned char* lds, int G, int wave, int lane) {
    const int gw = blockIdx.x * 8 + wave, NGW = G * 8;
    const float* SC = (const float*)(A_WS + WS_XN);
    int* SELE = (int*)(A_WS + WS_SELE); float* SELG = (float*)(A_WS + WS_SELG);
    LAS int* idxb = (LAS int*)(lds + P6_IDX + wave * 4096);
    const int tl = lane >> 4, hh = (lane >> 1) & 7, half = lane & 1;
    for (int grp = gw; grp < NTOK / 4; grp += NGW) {
        const int tok = grp * 4 + tl;
        const float* sp = SC + (size_t)tok * 2048 + hh * 256 + half * 128;
        int L[16];
#pragma unroll
        for (int j = 0; j < 16; ++j) L[j] = (int)0x80000000;
        for (int c4 = 0; c4 < 32; c4 += 2) {
            const f32x4 v0 = *(const f32x4*)(sp + 4 * c4), v1 = *(const f32x4*)(sp + 4 * c4 + 4);
#pragma unroll
            for (int e = 0; e < 4; ++e) INS16(L, (f2key(v0[e]) & ~127) | (4 * c4 + e));
#pragma unroll
            for (int e = 0; e < 4; ++e) INS16(L, (f2key(v1[e]) & ~127) | (4 * c4 + 4 + e));
        }
#pragma unroll
        for (int j = 0; j < 16; ++j) idxb[lane * 16 + j] = L[j] & 127;
        float va[16], vb[16];
#pragma unroll
        for (int j = 0; j < 16; ++j) { const int own = L[j] & ~127, oth = __shfl_xor(own, 1); va[j] = key2f(half ? oth : own); vb[j] = key2f(half ? own : oth); }
        int C[16];
#pragma unroll
        for (int j = 0; j < 16; ++j) C[j] = (int)0x80000000;
#pragma unroll
        for (int i = 0; i < 16; ++i)
#pragma unroll
            for (int j = 0; j < 16; ++j) if ((i + 1) * (j + 1) <= 16) INS16(C, (f2key(va[i] + vb[j]) & ~255) | (i * 16 + j));
        const float mx = key2f(C[0] & ~255);
        float ev[16], sum = 0.f;
#pragma unroll
        for (int j = 0; j < 16; ++j) { ev[j] = __expf(key2f(C[j] & ~255) - mx); sum += ev[j]; }
        const float inv = 1.0f / sum;
        asm volatile("s_waitcnt lgkmcnt(0)" ::: "memory");
        int eo[8]; float go[8];
#pragma unroll
        for (int s = 0; s < 8; ++s) {
            int c_lo = C[s], c_hi = C[8 + s]; float e_lo = ev[s], e_hi = ev[8 + s];
            asm volatile("" : "+v"(c_lo), "+v"(c_hi), "+v"(e_lo), "+v"(e_hi));
            const int cc = half ? c_hi : c_lo; go[s] = (half ? e_hi : e_lo) * inv;
            const int ij = cc & 255, i1 = idxb[(lane & ~1) * 16 + (ij >> 4)], i2 = idxb[(lane | 1) * 16 + (ij & 15)];
            eo[s] = i1 * 128 + i2;
        }
        int* ep = SELE + (size_t)tok * 128 + hh * 16 + half * 8; float* gp = SELG + (size_t)tok * 128 + hh * 16 + half * 8;
        *(u32x4*)ep = (u32x4){(unsigned)eo[0], (unsigned)eo[1], (unsigned)eo[2], (unsigned)eo[3]}; *(u32x4*)(ep + 4) = (u32x4){(unsigned)eo[4], (unsigned)eo[5], (unsigned)eo[6], (unsigned)eo[7]};
        *(f32x4*)gp = (f32x4){go[0], go[1], go[2], go[3]}; *(f32x4*)(gp + 4) = (f32x4){go[4], go[5], go[6], go[7]};
        asm volatile("s_waitcnt lgkmcnt(0)" ::: "memory");
    }
}

__device__ __forceinline__ float dot2bf(unsigned a, unsigned b, float c) { return __builtin_amdgcn_fdot2_f32_bf16(__builtin_bit_cast(bf16x2_t, a), __builtin_bit_cast(bf16x2_t, b), c, false); }
__device__ __forceinline__ unsigned xcc_id() { return (unsigned)__builtin_amdgcn_s_getreg((3 << 11) | 20) & 0xFu; }
__device__ __forceinline__ float dpp_sum16(float v) {
    v += __builtin_bit_cast(float, __builtin_amdgcn_update_dpp(0, __builtin_bit_cast(int, v), 0xB1, 0xF, 0xF, true));
    v += __builtin_bit_cast(float, __builtin_amdgcn_update_dpp(0, __builtin_bit_cast(int, v), 0x4E, 0xF, 0xF, true));
    v += __builtin_bit_cast(float, __builtin_amdgcn_update_dpp(0, __builtin_bit_cast(int, v), 0x141, 0xF, 0xF, true));
    v += __builtin_bit_cast(float, __builtin_amdgcn_update_dpp(0, __builtin_bit_cast(int, v), 0x140, 0xF, 0xF, true));
    return v;
}
__device__ __forceinline__ bool p6_claim(LAS unsigned char* lds, unsigned* cnt, int tid, int& ring, int home, int& slice, int& item) {
    for (;;) {
        if (ring >= 8) return false;
        slice = (home + ring) & 7;
        __syncthreads();
        if (tid == 0) *(volatile LAS int*)(lds + P6_ITEM) = (int)__hip_atomic_fetch_add(cnt + 64 * slice, 1u, __ATOMIC_RELAXED, __HIP_MEMORY_SCOPE_AGENT);
        __syncthreads();
        item = *(volatile LAS int*)(lds + P6_ITEM);
        if (item < P6_NITEM) return true;
        ++ring;
    }
}

__device__ __forceinline__ void p6b_phase(LAS unsigned char* lds, int tid, int wave, int lane) {
    const bf16_t* XT = (const bf16_t*)(A_WS + WS_Q); const bf16_t* UB = (const bf16_t*)(A_WS + WS_UB);
    const int* SELE = (const int*)(A_WS + WS_SELE); float* PART = (float*)(A_WS + WS_PART);
    unsigned* cnt = (unsigned*)(A_WS + WS_CTL) + CT_U;
    const int i16 = lane & 15, grp = lane >> 4, home = (int)(xcc_id() & 7u);
    LAS int* eb = (LAS int*)(lds + P6_E + wave * 1024);
    int ring = 0, slice, item;
    while (p6_claim(lds, cnt, tid, ring, home, slice, item)) {
        const int tok0 = item * P6_TOKB + wave * 8;
        int e0 = SELE[(size_t)tok0 * 128 + lane], e1 = SELE[(size_t)tok0 * 128 + 64 + lane];
        for (int ti = 0; ti < 8; ++ti) {
            const int tok = tok0 + ti;
            LAS int* ebt = eb + (ti & 1) * 128;
            ebt[lane] = e0; ebt[64 + lane] = e1;
            if (ti < 7) { e0 = SELE[(size_t)(tok + 1) * 128 + lane]; e1 = SELE[(size_t)(tok + 1) * 128 + 64 + lane]; }
            const u32x4 xv = *(const u32x4*)(XT + (size_t)tok * DM + slice * 128 + i16 * 8);
            const bf16_t* ub = UB + slice * 128 + i16 * 8;
            asm volatile("s_waitcnt lgkmcnt(0)" ::: "memory");
            float res0 = 0.f, res1 = 0.f;
#pragma unroll
            for (int s8 = 0; s8 < 32; s8 += 8) {
                u32x4 uv[8];
#pragma unroll
                for (int q = 0; q < 8; ++q) { const int e = ebt[32 * grp + s8 + q]; uv[q] = *(const u32x4*)(ub + (size_t)e * DM); }
#pragma unroll
                for (int q = 0; q < 8; ++q) {
                    float d = dot2bf(uv[q].x, xv.x, 0.f); d = dot2bf(uv[q].y, xv.y, d); d = dot2bf(uv[q].z, xv.z, d); d = dot2bf(uv[q].w, xv.w, d);
                    d = dpp_sum16(d);
                    const int s = s8 + q;
                    if (s < 16) res0 = (i16 == (s & 15)) ? d : res0; else res1 = (i16 == (s & 15)) ? d : res1;
                }
            }
            float* pp = PART + ((size_t)slice * NTOK + tok) * 128 + 32 * grp + i16;
            pp[0] = res0; pp[16] = res1;
        }
    }
}

__device__ __forceinline__ void p6c_phase(LAS unsigned char* lds, int tid, int wave, int lane) {
    const bf16_t* VB = (const bf16_t*)(A_WS + WS_VB);
    const int* SELE = (const int*)(A_WS + WS_SELE); const float* SELG = (const float*)(A_WS + WS_SELG); const float* PART = (const float*)(A_WS + WS_PART);
    unsigned* cnt = (unsigned*)(A_WS + WS_CTL) + CT_V;
    float* out = A_OUT;
    const int i16 = lane & 15, grp = lane >> 4, home = (int)(xcc_id() & 7u);
    LAS int* eb = (LAS int*)(lds + P6_E + wave * 1024);
    LAS float* cb = (LAS float*)(lds + P6_C + wave * 512);
    int ring = 0, slice, item;
    while (p6_claim(lds, cnt, tid, ring, home, slice, item)) {
        const int tok0 = item * P6_TOKB + wave * 8;
        for (int ti = 0; ti < 8; ++ti) {
            const int tok = tok0 + ti;
            float a0 = 0.f, a1 = 0.f;
#pragma unroll
            for (int j = 0; j < 8; ++j) { const float* pp = PART + ((size_t)j * NTOK + tok) * 128; a0 += pp[lane]; a1 += pp[64 + lane]; }
            eb[lane] = SELE[(size_t)tok * 128 + lane]; eb[64 + lane] = SELE[(size_t)tok * 128 + 64 + lane];
            cb[lane] = SELG[(size_t)tok * 128 + lane] * gelu_tanh(a0); cb[64 + lane] = SELG[(size_t)tok * 128 + 64 + lane] * gelu_tanh(a1);
            const bf16_t* vb = VB + slice * 128 + i16 * 8;
            asm volatile("s_waitcnt lgkmcnt(0)" ::: "memory");
            float acc[8];
#pragma unroll
            for (int r = 0; r < 8; ++r) acc[r] = 0.f;
#pragma unroll
            for (int s8 = 0; s8 < 32; s8 += 8) {
                u32x4 vv[8]; float cf[8];
#pragma unroll
                for (int q = 0; q < 8; ++q) { const int e = eb[32 * grp + s8 + q]; cf[q] = cb[32 * grp + s8 + q]; vv[q] = *(const u32x4*)(vb + (size_t)e * DM); }
#pragma unroll
                for (int q = 0; q < 8; ++q) {
                    acc[0] += cf[q] * bflo(vv[q].x); acc[1] += cf[q] * bfhi(vv[q].x); acc[2] += cf[q] * bflo(vv[q].y); acc[3] += cf[q] * bfhi(vv[q].y);
                    acc[4] += cf[q] * bflo(vv[q].z); acc[5] += cf[q] * bfhi(vv[q].z); acc[6] += cf[q] * bflo(vv[q].w); acc[7] += cf[q] * bfhi(vv[q].w);
                }
            }
#pragma unroll
            for (int r = 0; r < 8; ++r) { acc[r] += __shfl_xor(acc[r], 16); acc[r] += __shfl_xor(acc[r], 32); }
            if (lane < 16) {
                float* yr = ((tok < NTP) ? out + O_YP + (size_t)tok * DM : out + O_YS + (size_t)(tok - NTP) * DM) + slice * 128 + i16 * 8;
                f32x4 z0 = *(const f32x4*)yr, z1 = *(const f32x4*)(yr + 4);
                z0 += (f32x4){acc[0], acc[1], acc[2], acc[3]}; z1 += (f32x4){acc[4], acc[5], acc[6], acc[7]};
                *(f32x4*)yr = z0; *(f32x4*)(yr + 4) = z1;
            }
            asm volatile("s_waitcnt lgkmcnt(0)" ::: "memory");
        }
    }
}

__device__ __forceinline__ void p6d_phase(int G, int wave, int lane) {
    const int gw = blockIdx.x * 8 + wave, NGW = G * 8;
    const float* gf = A_IN(25); float* out = A_OUT;
    for (int m = gw; m < NTOK; m += NGW) {
        float* yr = (m < NTP) ? out + O_YP + (size_t)m * DM : out + O_YS + (size_t)(m - NTP) * DM;
        f32x4 v[4]; float s = 0.f;
#pragma unroll
        for (int j = 0; j < 4; ++j) { v[j] = *(const f32x4*)(yr + j * 256 + lane * 4); s += (v[j][0] * v[j][0] + v[j][1] * v[j][1]) + (v[j][2] * v[j][2] + v[j][3] * v[j][3]); }
        const float inv = 1.0f / sqrtf(wave_sum(s) * (1.0f / DM) + EPS);
#pragma unroll
        for (int j = 0; j < 4; ++j) { const f32x4 gg = *(const f32x4*)(gf + j * 256 + lane * 4); *(f32x4*)(yr + j * 256 + lane * 4) = v[j] * inv * gg; }
    }
}

__global__ void __launch_bounds__(512, 2) hybrid_fwd(Args a) {
    extern __shared__ __attribute__((aligned(16))) unsigned char lds_raw[];
    LAS unsigned char* lds = (LAS unsigned char*)lds_raw;
    const int tid = threadIdx.x, lane = tid & 63, wave = __builtin_amdgcn_readfirstlane(tid >> 6), G = gridDim.x;
    cg::grid_group grid = cg::this_grid();
    unsigned char* ws = A_WS;
#define IN(k) (KA->ph_lo <= (k) && (k) < KA->ph_hi)
#define SEAM(k) do { if (KA->use_sync && IN(k) && IN((k) + 1)) grid.sync(); } while (0)
    if (IN(0)) { p0_prologue(lds, G, wave, lane); }
    SEAM(0);
    if (IN(1)) {
        pg8::Gemm g{(const bf16_t*)(ws + WS_XN), (const bf16_t*)(ws + WS_WIN), (const bf16_t*)(ws + WS_WIN) + (size_t)2048 * DM, (const bf16_t*)(ws + WS_XN), DM};
        SchedG1 S; S.init(G, blockIdx.x); EpiG1 E;
        pg8::gemm_phase(lds, g, S, E);
    }
    SEAM(1);
    if (IN(2)) { p2_phase(lds, G, tid, wave, lane); }
    SEAM(2);
    if (IN(3)) {
        pg8::Gemm g{(const bf16_t*)(ws + WS_Q), (const bf16_t*)(ws + WS_WBA), (const bf16_t*)(ws + WS_G), (const bf16_t*)(ws + WS_WBL), DM};
        SchedPair S; S.init(4, G, blockIdx.x); EpiP3 E;
        pg8::gemm_phase(lds, g, S, E);
    }
    SEAM(3);
    if (IN(4)) {
        pg8::Gemm g{(const bf16_t*)(ws + WS_XN), (const bf16_t*)(ws + WS_WO), (const bf16_t*)(ws + WS_XN), (const bf16_t*)(ws + WS_WO), DM};
        SchedOne S; S.init(4, G, blockIdx.x); EpiP4 E;
        pg8::gemm_phase(lds, g, S, E);
    }
    SEAM(4);
    if (IN(5)) { p4b_phase(G, wave, lane); }
    SEAM(5);
    if (IN(6)) {
        pg8::Gemm g{(const bf16_t*)(ws + WS_Q), (const bf16_t*)(ws + WS_WS), (const bf16_t*)(ws + WS_Q), (const bf16_t*)(ws + WS_WS), DM};
        SchedOne S; S.init(8, G, blockIdx.x); EpiP5 E;
        pg8::gemm_phase(lds, g, S, E);
    }
    SEAM(6);
    if (IN(7)) { p6a_phase(lds, G, wave, lane); }
    SEAM(7);
    if (IN(8)) { p6b_phase(lds, tid, wave, lane); }
    SEAM(8);
    if (IN(9)) { p6c_phase(lds, tid, wave, lane); }
    SEAM(9);
    if (IN(10)) { p6d_phase(G, wave, lane); }
#undef IN
#undef SEAM
}

#ifndef N_LAUNCH_MODE
#define N_LAUNCH_MODE 1
#endif
constexpr int NPH = 11;
extern "C" void kernel_launch(void* const* d_in, const int* in_sizes, int n_in, void* d_out, int out_size, void* d_ws, size_t ws_size, hipStream_t stream) {
    static int grid = 0;
    if (grid == 0) {
        if (n_in != 26 || (size_t)out_size != O_END || ws_size < WS_END) { fprintf(stderr, "kernel_launch: unexpected sizes n_in %d out %d ws %zu (need %zu)\n", n_in, out_size, ws_size, (size_t)WS_END); grid = -1; return; }
        int dev = 0, cus = 0, per_cu = 0;
        (void)hipGetDevice(&dev); (void)hipDeviceGetAttribute(&cus, hipDeviceAttributeMultiprocessorCount, dev);
        (void)hipFuncSetAttribute((const void*)hybrid_fwd, hipFuncAttributeMaxDynamicSharedMemorySize, LDS_BYTES);
        (void)hipOccupancyMaxActiveBlocksPerMultiprocessor(&per_cu, (const void*)hybrid_fwd, 512, LDS_BYTES);
        if (per_cu < 1) { fprintf(stderr, "kernel_launch: occupancy query says %d blocks per CU\n", per_cu); per_cu = 1; }
        grid = cus;
        (void)hipGetLastError();
    }
    if (grid < 0) return;
    (void)hipMemsetAsync((char*)d_ws + WS_CTL, 0, 8192, stream);
    Args a{};
    for (int i = 0; i < 26; ++i) a.in[i] = (const float*)d_in[i];
    a.out = (float*)d_out; a.ws = (unsigned char*)d_ws;
    if (N_LAUNCH_MODE == 1) {
        a.ph_lo = 0; a.ph_hi = NPH; a.use_sync = 1;
        void* args[] = {&a};
        hipError_t e = hipLaunchCooperativeKernel((const void*)hybrid_fwd, dim3(grid), dim3(512), args, LDS_BYTES, stream);
        if (e != hipSuccess) fprintf(stderr, "cooperative launch failed: %s (grid %d)\n", hipGetErrorString(e), grid);
    } else {
        for (int p = 0; p < NPH; ++p) { a.ph_lo = p; a.ph_hi = p + 1; a.use_sync = 0; hipLaunchKernelGGL(hybrid_fwd, dim3(grid), dim3(512), LDS_BYTES, stream, a); }
    }
}
```

```cpp
#include <hip/hip_runtime.h>
#include <hip/hip_cooperative_groups.h>
#include <cstdint>
#include <cstdio>
namespace cg = cooperative_groups;

#define LAS __attribute__((address_space(3)))
typedef unsigned short bf16_t;
typedef short bf16x8 __attribute__((ext_vector_type(8)));
typedef float f32x4 __attribute__((ext_vector_type(4)));
typedef float f32x2 __attribute__((ext_vector_type(2)));
typedef float f32x16 __attribute__((ext_vector_type(16)));
typedef unsigned u32x4 __attribute__((ext_vector_type(4)));
typedef unsigned u32x2 __attribute__((ext_vector_type(2)));
typedef __bf16 bf16x2_t __attribute__((ext_vector_type(2)));

constexpr int DM = 1024, SEQ = 4096, NB = 16, NTP = NB * SEQ, NSB = 8, NST = 16, NTS = NSB * NST, NTOK = NTP + NTS;
constexpr int ROWS = 65792, NMT = 257;
constexpr int INC = 7168, NEXP = 16384;
constexpr float EPS = 1e-6f, LOG2E = 1.4426950408889634f;
constexpr float QSCALE = 0.125f * LOG2E;

constexpr size_t MiB = 1u << 20;
constexpr size_t BUF = (size_t)ROWS * DM * 2;
constexpr size_t WS_CTL = 0;
constexpr size_t WS_WIN = 1 * MiB;
constexpr size_t WS_WBA = 16 * MiB, WS_WBL = 18 * MiB, WS_WO = 20 * MiB, WS_WS = 22 * MiB;
constexpr size_t WS_LRUW = 26 * MiB;
constexpr size_t WS_SGA = 27 * MiB, WS_SGR = 27 * MiB + 512 * 1024;
constexpr size_t WS_UB = 28 * MiB, WS_VB = 60 * MiB;
constexpr size_t WS_Q = 92 * MiB;
constexpr size_t WS_XN = WS_Q + BUF;
constexpr size_t WS_K = WS_XN + BUF;
constexpr size_t WS_VT = WS_K + BUF;
constexpr size_t WS_XR = WS_VT + BUF;
constexpr size_t WS_G = WS_XR + BUF;
constexpr size_t WS_END = WS_G + BUF;

constexpr size_t O_YP = 0, O_YS = O_YP + (size_t)NTP * DM, O_KP = O_YS + (size_t)NTS * DM, O_VP = O_KP + (size_t)NB * 512 * DM,
                 O_CP = O_VP + (size_t)NB * 512 * DM, O_LP = O_CP + (size_t)NB * 3 * DM, O_KS = O_LP + (size_t)NB * DM, O_VS = O_KS + (size_t)NTS * DM,
                 O_CS = O_VS + (size_t)NTS * DM, O_LS = O_CS + (size_t)NSB * 3 * DM, O_END = O_LS + (size_t)NSB * DM;

constexpr int LDS_BYTES = 135168;

__device__ __forceinline__ unsigned cvtpk(float lo, float hi) { f32x2 v = {lo, hi}; bf16x2_t b = __builtin_convertvector(v, bf16x2_t); return __builtin_bit_cast(unsigned, b); }
__device__ __forceinline__ float bflo(unsigned u) { return __uint_as_float(u << 16); }
__device__ __forceinline__ float bfhi(unsigned u) { return __uint_as_float(u & 0xffff0000u); }
__device__ __forceinline__ float fast_exp2(float x) { return __builtin_amdgcn_exp2f(x); }
__device__ __forceinline__ float fast_rcp(float x) { return __builtin_amdgcn_rcpf(x); }
__device__ __forceinline__ float sigmoidf_(float z) { return fast_rcp(1.0f + fast_exp2(-z * LOG2E)); }
__device__ __forceinline__ float gelu_tanh(float x) { const float u = x + 0.044715f * x * x * x; return x * fast_rcp(1.0f + fast_exp2(-1.5957691216f * LOG2E * u)); }
__device__ __forceinline__ float wave_sum(float v) {
#pragma unroll
    for (int o = 1; o < 64; o <<= 1) v += __shfl_xor(v, o);
    return v;
}
__device__ __forceinline__ int swap23(int i) { return (i & ~12) | ((i & 4) << 1) | ((i & 8) >> 1); }
__device__ __forceinline__ float plswap_max(float m) { auto rr = __builtin_amdgcn_permlane32_swap(__float_as_uint(m), __float_as_uint(m), false, false); return fmaxf(__uint_as_float(rr[0]), __uint_as_float(rr[1])); }
__device__ __forceinline__ float plswap_add(float m) { auto rr = __builtin_amdgcn_permlane32_swap(__float_as_uint(m), __float_as_uint(m), false, false); return __uint_as_float(rr[0]) + __uint_as_float(rr[1]); }

namespace pg8 {
constexpr int BM = 256, BK = 64, HALF = 128, HTB = HALF * BK * 2, STAGE_BYTES = 8 * HTB, NXCD = 8, WGM = 8;
__host__ __device__ __forceinline__ int lds_byte(int r, int c) { const int st = (r >> 4) * 2 + (c >> 5), rr = r & 15, cc = c & 31, ob = rr * 64 + cc * 2; return st * 1024 + (ob ^ (((ob >> 9) & 1) << 5)); }
__host__ __device__ __forceinline__ void stage_rc(int b, int& R, int& C) { const int st = b / 1024, sb = b % 1024, swz = sb ^ (((sb >> 9) & 1) << 5); R = (st >> 1) * 16 + swz / 64; C = (st & 1) * 32 + (swz % 64) / 2; }
__host__ __device__ __forceinline__ int perm32(int rho) { const int n = rho >> 4, i = rho & 15; return 8 * (i >> 2) + 4 * n + (i & 3); }

struct Unit { int pm, pn, kind; };
struct Gemm { const bf16_t* A0; const bf16_t* B0; const bf16_t* A1; const bf16_t* B1; int K; };

struct TileMap {
    int nM, nN, nwg;
    __device__ __forceinline__ void init(int nM_, int nN_) { nM = nM_; nN = nN_; nwg = nM * nN; }
    __device__ __forceinline__ void map(int L, int& pm, int& pn) const {
        int wgid = L; { const int q = nwg / NXCD, r = nwg % NXCD, xcd = wgid % NXCD, off = wgid / NXCD; wgid = (xcd < r ? xcd * (q + 1) : r * (q + 1) + (xcd - r) * q) + off; }
        const int nig = WGM * nN, gid = wgid / nig, fm = gid * WGM, gsz = (nM - fm) < WGM ? (nM - fm) : WGM;
        pm = fm + ((wgid % nig) % gsz); pn = (wgid % nig) / gsz;
    }
};

template <class Epi, class Sched>
__device__ __forceinline__ void gemm_phase(LAS unsigned char* lds, const Gemm g, const Sched& S, const Epi& E) {
    const int tid = threadIdx.x, wid = __builtin_amdgcn_readfirstlane(tid >> 6), lane = tid & 63, wr = wid >> 2, wc = wid & 3, fr = lane & 15, fq = lane >> 4;
    const int K = g.K, nt = K / BK;
    unsigned voffA[2], voffB[2];
#pragma unroll
    for (int i = 0; i < 2; ++i) { int R, C; stage_rc(tid * 16 + i * 8192, R, C); const int Rb = (R & ~31) + perm32(R & 31);
        voffA[i] = (unsigned)(R * K + C) * 2u; voffB[i] = (unsigned)(Rb * K + C) * 2u; }
    const size_t kstep = (size_t)(BK * 2);
    const size_t hstep = (size_t)HALF * K * 2;
    const size_t tstep = 2 * hstep;
    const unsigned ldsw = (unsigned)wid * 1024u;
    const int aoff = lds_byte(wr * 64 + fr, fq * 8), boff = lds_byte(wc * 32 + fr, fq * 8);
#define PG8_SA(b, h) (((b) * 2 + (h)) * HTB)
#define PG8_SB(b, h) ((4 + (b) * 2 + (h)) * HTB)
#define PG8_STAGE(bufoff, gbase, voff) do { _Pragma("unroll") for (int _i = 0; _i < 2; ++_i) \
        __builtin_amdgcn_global_load_lds((const unsigned*)((const char*)(gbase) + (voff)[_i]), (LAS unsigned*)(lds + (bufoff) + ldsw + _i * 8192), 16, 0, 0); } while (0)
#define PG8_LDA(dst, b, h) do { _Pragma("unroll") for (int m = 0; m < 4; ++m) _Pragma("unroll") for (int k = 0; k < 2; ++k) dst[m][k] = *(const LAS bf16x8*)(lds + PG8_SA(b, h) + aoff + m * 2048 + k * 1024); } while (0)
#define PG8_LDB(dst, b, h) do { _Pragma("unroll") for (int n = 0; n < 2; ++n) _Pragma("unroll") for (int k = 0; k < 2; ++k) dst[n][k] = *(const LAS bf16x8*)(lds + PG8_SB(b, h) + boff + n * 2048 + k * 1024); } while (0)
#define PG8_MMA(ai, bj, At, Bt) do { __builtin_amdgcn_s_setprio(1); _Pragma("unroll") for (int m = 0; m < 4; ++m) _Pragma("unroll") for (int n = 0; n < 2; ++n) _Pragma("unroll") for (int k = 0; k < 2; ++k) \
        acc[ai][bj][m][n] = __builtin_amdgcn_mfma_f32_16x16x32_bf16(Bt[n][k], At[m][k], acc[ai][bj][m][n], 0, 0, 0); __builtin_amdgcn_s_setprio(0); } while (0)
#define PG8_WAIT_V(n) asm volatile("s_waitcnt vmcnt(" #n ")" ::: "memory")
#define PG8_WAIT_L(n) asm volatile("s_waitcnt lgkmcnt(" #n ")" ::: "memory")
#define PG8_BAR __builtin_amdgcn_s_barrier()
#define PG8_SCHED __builtin_amdgcn_sched_barrier(0)
    Unit cur, nxt; int ui = 0;
    if (!S.next(0, cur)) return;
    f32x4 acc[2][2][4][2];
#pragma unroll
    for (int a = 0; a < 2; ++a)
#pragma unroll
        for (int b = 0; b < 2; ++b)
#pragma unroll
            for (int m = 0; m < 4; ++m)
#pragma unroll
                for (int n = 0; n < 2; ++n) acc[a][b][m][n] = (f32x4){0.f, 0.f, 0.f, 0.f};
    bf16x8 At[4][2], B0[2][2], B1[2][2];
    const char* cA = (const char*)(cur.kind ? g.A1 : g.A0) + (size_t)cur.pm * tstep; const char* cB = (const char*)(cur.kind ? g.B1 : g.B0) + (size_t)cur.pn * tstep;
    PG8_STAGE(PG8_SB(0, 0), cB, voffB); PG8_STAGE(PG8_SB(0, 1), cB + hstep, voffB); PG8_STAGE(PG8_SA(0, 0), cA, voffA); PG8_STAGE(PG8_SA(0, 1), cA + hstep, voffA);
    if (wr == 1) PG8_BAR;
    PG8_WAIT_V(2); PG8_BAR;
    PG8_STAGE(PG8_SB(1, 0), cB + kstep, voffB); PG8_STAGE(PG8_SA(1, 0), cA + kstep, voffA); PG8_STAGE(PG8_SB(1, 1), cB + hstep + kstep, voffB);
    PG8_WAIT_V(6); PG8_BAR;
    for (;;) {
        const bool has_next = S.next(ui + 1, nxt);
        const char* nA = has_next ? (const char*)(nxt.kind ? g.A1 : g.A0) + (size_t)nxt.pm * tstep : cA; const char* nB = has_next ? (const char*)(nxt.kind ? g.B1 : g.B0) + (size_t)nxt.pn * tstep : cB;
        for (int t = 0; t < nt; t += 2) {
            const bool last = (t == nt - 2);
            const char* a1 = cA + (size_t)(t + 1) * kstep;
            const char* a2 = last ? nA : cA + (size_t)(t + 2) * kstep; const char* b2 = last ? nB : cB + (size_t)(t + 2) * kstep;
            const char* a3 = a2 + kstep; const char* b3 = b2 + kstep;
            PG8_LDB(B0, 0, 0); PG8_LDB(B1, 0, 1); PG8_SCHED; PG8_LDA(At, 0, 0); PG8_STAGE(PG8_SA(1, 1), a1 + hstep, voffA);
            PG8_WAIT_V(8); PG8_WAIT_L(0); PG8_BAR; PG8_MMA(0, 0, At, B0); PG8_MMA(0, 1, At, B1); PG8_BAR; PG8_SCHED;
            PG8_LDA(At, 0, 1); PG8_STAGE(PG8_SB(0, 0), b2, voffB); PG8_STAGE(PG8_SB(0, 1), b2 + hstep, voffB); PG8_STAGE(PG8_SA(0, 0), a2, voffA);
            PG8_WAIT_V(8); PG8_WAIT_L(0); PG8_BAR; PG8_MMA(1, 0, At, B0); PG8_MMA(1, 1, At, B1); PG8_BAR; PG8_SCHED;
            PG8_LDB(B0, 1, 0); PG8_LDB(B1, 1, 1); PG8_SCHED; PG8_LDA(At, 1, 0); PG8_STAGE(PG8_SA(0, 1), a2 + hstep, voffA);
            PG8_WAIT_V(8); PG8_WAIT_L(0); PG8_BAR; PG8_MMA(0, 0, At, B0); PG8_MMA(0, 1, At, B1); PG8_BAR; PG8_SCHED;
            PG8_LDA(At, 1, 1); PG8_STAGE(PG8_SB(1, 0), b3, voffB); PG8_STAGE(PG8_SB(1, 1), b3 + hstep, voffB); PG8_STAGE(PG8_SA(1, 0), a3, voffA);
            PG8_WAIT_V(8); PG8_WAIT_L(0); PG8_BAR; PG8_MMA(1, 0, At, B0); PG8_MMA(1, 1, At, B1); PG8_BAR; PG8_SCHED;
        }
        if (wr == 0) PG8_BAR;
        E(acc, cur, wr, wc, fr, fq);
        if (!has_next) break;
#pragma unroll
        for (int a = 0; a < 2; ++a)
#pragma unroll
            for (int b = 0; b < 2; ++b)
#pragma unroll
                for (int m = 0; m < 4; ++m)
#pragma unroll
                    for (int n = 0; n < 2; ++n) acc[a][b][m][n] = (f32x4){0.f, 0.f, 0.f, 0.f};
        cur = nxt; cA = nA; cB = nB; ++ui;
        if (wr == 1) PG8_BAR;
    }
    PG8_WAIT_V(0);
    PG8_BAR;
#undef PG8_SA
#undef PG8_SB
#undef PG8_STAGE
#undef PG8_LDA
#undef PG8_LDB
#undef PG8_MMA
#undef PG8_WAIT_V
#undef PG8_WAIT_L
#undef PG8_BAR
#undef PG8_SCHED
}
}
using pg8::Unit;

struct Args {
    const float* in[26];
    float* out; unsigned char* ws;
    int ph_lo, ph_hi, use_sync, pad;
};

typedef const __attribute__((address_space(4))) Args* ArgsP;
#define KA ((ArgsP)__builtin_amdgcn_kernarg_segment_ptr())
#define A_IN(k) (KA->in[k])
#define A_OUT (KA->out)
#define A_WS (KA->ws)

struct SchedG1 {
    pg8::TileMap m0, m1; int G, c;
    __device__ __forceinline__ void init(int G_, int c_) { m0.init(NMT, 24); m1.init(4, NMT); G = G_; c = c_; }
    __device__ __forceinline__ bool next(int i, Unit& u) const {
        int L = i * G + c;
        if (L < m0.nwg) { m0.map(L, u.pm, u.pn); u.pn = (u.pn < 8) ? u.pn : u.pn + 4; u.kind = 0; return true; }
        L -= m0.nwg; if (L >= m1.nwg) return false;
        m1.map(L, u.pm, u.pn); u.kind = 1; return true;
    }
};
struct SchedPair {
    pg8::TileMap m0; int G, c;
    __device__ __forceinline__ void init(int nN, int G_, int c_) { m0.init(NMT, nN); G = G_; c = c_; }
    __device__ __forceinline__ bool next(int i, Unit& u) const { const int L = (i >> 1) * G + c; if (L >= m0.nwg) return false; m0.map(L, u.pm, u.pn); u.kind = i & 1; return true; }
};
struct SchedOne {
    pg8::TileMap m0; int G, c;
    __device__ __forceinline__ void init(int nN, int G_, int c_) { m0.init(NMT, nN); G = G_; c = c_; }
    __device__ __forceinline__ bool next(int i, Unit& u) const { const int L = i * G + c; if (L >= m0.nwg) return false; m0.map(L, u.pm, u.pn); u.kind = 0; return true; }
};

#define EPI_PREP int fr_ = fr, fq_ = fq; asm volatile("" : "+v"(fr_), "+v"(fq_)); const int rl_ = wr * 64 + fr_, cl_ = wc * 32 + 8 * fq_;
#define EPI_LOOP_BEGIN \
    _Pragma("unroll") for (int ai = 0; ai < 2; ++ai) _Pragma("unroll") for (int m = 0; m < 4; ++m) { const int rit = ai * 128 + m * 16 + rl_; \
    _Pragma("unroll") for (int bj = 0; bj < 2; ++bj) { const int cit = bj * 128 + cl_; f32x4 v0 = acc[ai][bj][m][0], v1 = acc[ai][bj][m][1];
#define EPI_LOOP_END } }

struct EpiG1 {
    __device__ __forceinline__ void operator()(const f32x4 (&acc)[2][2][4][2], const Unit& u, int wr, int wc, int fr, int fq) const {
        EPI_PREP unsigned char* ws = A_WS; float* out = A_OUT;
        if (u.kind == 0) {
            const int t = u.pn >> 2, ct = (u.pn & 3) * 256;
            bf16_t* base;
            if (t == 0) base = (bf16_t*)(ws + WS_Q); else if (t == 1) base = (bf16_t*)(ws + WS_K); else if (t == 3) base = (bf16_t*)(ws + WS_XR); else if (t == 4) base = (bf16_t*)(ws + WS_G);
            else if (t == 5) base = (u.pm < 256) ? (bf16_t*)(out + O_YP) : (bf16_t*)(ws + WS_SGA) - (size_t)NTP * DM;
            else base = (u.pm < 256) ? (bf16_t*)(out + O_YP) + (size_t)NTP * DM : (bf16_t*)(ws + WS_SGR) - (size_t)NTP * DM;
            base += (size_t)u.pm * 256 * DM + ct;
            EPI_LOOP_BEGIN
                u32x4 w; w.x = cvtpk(v0[0], v0[1]); w.y = cvtpk(v0[2], v0[3]); w.z = cvtpk(v1[0], v1[1]); w.w = cvtpk(v1[2], v1[3]);
                *(u32x4*)(base + (size_t)rit * DM + cit) = w;
            EPI_LOOP_END
            if (t == 1 && u.pm < 256 && (u.pm & 15) >= 14) { float* p0 = out + O_KP + ((size_t)(u.pm >> 4) * 512 + ((u.pm & 15) - 14) * 256) * DM + ct;
                EPI_LOOP_BEGIN float* p = p0 + (size_t)rit * DM + cit; *(f32x4*)p = v0; *(f32x4*)(p + 4) = v1; EPI_LOOP_END }
            if (t == 1 && u.pm == 256) { float* p0 = out + O_KS + ct;
                EPI_LOOP_BEGIN if (rit < NTS) { float* p = p0 + (size_t)rit * DM + cit; *(f32x4*)p = v0; *(f32x4*)(p + 4) = v1; } EPI_LOOP_END }
            if (t == 3 && u.pm < 256 && (u.pm & 15) == 15) { float* p0 = out + O_CP + ((size_t)(u.pm >> 4) * 3) * DM + ct;
                EPI_LOOP_BEGIN if (rit >= 253) { float* p = p0 + (size_t)(rit - 253) * DM + cit; *(f32x4*)p = v0; *(f32x4*)(p + 4) = v1; } EPI_LOOP_END }
            if (t == 3 && u.pm == 256) { float* p0 = out + O_CS + ct;
                EPI_LOOP_BEGIN if (rit < NTS && (rit & 15) >= 13) { float* p = p0 + ((size_t)(rit >> 4) * 3 + ((rit & 15) - 13)) * DM + cit; *(f32x4*)p = v0; *(f32x4*)(p + 4) = v1; } EPI_LOOP_END }
        } else {
            bf16_t* VT = (bf16_t*)(ws + WS_VT) + (size_t)u.pm * 256 * ROWS + (size_t)u.pn * 256;
            EPI_LOOP_BEGIN
                u32x4 w; w.x = cvtpk(v0[0], v0[1]); w.y = cvtpk(v0[2], v0[3]); w.z = cvtpk(v1[0], v1[1]); w.w = cvtpk(v1[2], v1[3]);
                *(u32x4*)(VT + (size_t)rit * ROWS + cit) = w;
            EPI_LOOP_END
            if (u.pn < 256 && (u.pn & 15) >= 14) { float* p0 = out + O_VP + ((size_t)(u.pn >> 4) * 512 + ((u.pn & 15) - 14) * 256) * DM + u.pm * 256;
                EPI_LOOP_BEGIN float* p = p0 + (size_t)cit * DM + rit;
                    p[0] = v0[0]; p[DM] = v0[1]; p[2 * DM] = v0[2]; p[3 * DM] = v0[3]; p[4 * DM] = v1[0]; p[5 * DM] = v1[1]; p[6 * DM] = v1[2]; p[7 * DM] = v1[3]; EPI_LOOP_END }
            if (u.pn == 256) { float* p0 = out + O_VS + u.pm * 256;
                EPI_LOOP_BEGIN if (cit < NTS) { float* p = p0 + (size_t)cit * DM + rit;
                    p[0] = v0[0]; p[DM] = v0[1]; p[2 * DM] = v0[2]; p[3 * DM] = v0[3]; p[4 * DM] = v1[0]; p[5 * DM] = v1[1]; p[6 * DM] = v1[2]; p[7 * DM] = v1[3]; } EPI_LOOP_END }
        }
    }
};

struct EpiP3 {
    __device__ __forceinline__ void operator()(const f32x4 (&acc)[2][2][4][2], const Unit& u, int wr, int wc, int fr, int fq) const {
        EPI_PREP unsigned char* ws = A_WS; float* out = A_OUT;
        const bf16_t* gb = (u.pm < 256) ? (const bf16_t*)(out + O_YP) + (u.kind ? (size_t)NTP * DM : 0) : (const bf16_t*)(ws + (u.kind ? WS_SGR : WS_SGA)) - (size_t)NTP * DM;
        const size_t off0 = (size_t)u.pm * 256 * DM + u.pn * 256;
        gb += off0; float* T1 = (float*)(ws + WS_K) + off0; bf16_t* MG = (bf16_t*)(ws + WS_XR) + off0;
        EPI_LOOP_BEGIN
            const size_t off = (size_t)rit * DM + cit;
            const u32x4 gw = *(const u32x4*)(gb + off);
            f32x4 s0, s1;
            s0[0] = sigmoidf_(bflo(gw.x)); s0[1] = sigmoidf_(bfhi(gw.x)); s0[2] = sigmoidf_(bflo(gw.y)); s0[3] = sigmoidf_(bfhi(gw.y));
            s1[0] = sigmoidf_(bflo(gw.z)); s1[1] = sigmoidf_(bfhi(gw.z)); s1[2] = sigmoidf_(bflo(gw.w)); s1[3] = sigmoidf_(bfhi(gw.w));
            if (u.kind == 0) { *(f32x4*)(T1 + off) = s0 * v0; *(f32x4*)(T1 + off + 4) = s1 * v1; }
            else { const f32x4 a0 = *(const f32x4*)(T1 + off) + s0 * v0, a1 = *(const f32x4*)(T1 + off + 4) + s1 * v1;
                u32x4 w; w.x = cvtpk(a0[0], a0[1]); w.y = cvtpk(a0[2], a0[3]); w.z = cvtpk(a1[0], a1[1]); w.w = cvtpk(a1[2], a1[3]);
                *(u32x4*)(MG + off) = w; }
        EPI_LOOP_END
    }
};

struct EpiP4 {
    __device__ __forceinline__ void operator()(const f32x4 (&acc)[2][2][4][2], const Unit& u, int wr, int wc, int fr, int fq) const {
        EPI_PREP float* out = A_OUT;
        if (u.pm < 256) { const size_t off0 = (size_t)u.pm * 256 * DM + u.pn * 256; const float* xp = A_IN(0) + off0; float* yo = out + O_YP + off0;
            EPI_LOOP_BEGIN const size_t off = (size_t)rit * DM + cit;
                *(f32x4*)(yo + off) = *(const f32x4*)(xp + off) + v0; *(f32x4*)(yo + off + 4) = *(const f32x4*)(xp + off + 4) + v1; EPI_LOOP_END }
        else { const float* xs = A_IN(1) + u.pn * 256; float* yo = out + O_YS + u.pn * 256;
            EPI_LOOP_BEGIN if (rit < NTS) { const size_t off = (size_t)rit * DM + cit;
                *(f32x4*)(yo + off) = *(const f32x4*)(xs + off) + v0; *(f32x4*)(yo + off + 4) = *(const f32x4*)(xs + off + 4) + v1; } EPI_LOOP_END }
    }
};

struct EpiP5 {
    __device__ __forceinline__ void operator()(const f32x4 (&acc)[2][2][4][2], const Unit& u, int wr, int wc, int fr, int fq) const {
        EPI_PREP float* SC = (float*)(A_WS + WS_XN) + (size_t)u.pm * 256 * 2048 + u.pn * 256;
        EPI_LOOP_BEGIN
            float* p = SC + (size_t)rit * 2048 + cit; *(f32x4*)p = v0; *(f32x4*)(p + 4) = v1;
        EPI_LOOP_END
    }
};

__device__ __forceinline__ void p0_transpose_item(const float* W, int K, int N, bf16_t* WT, LAS float* scr, int item, int lane, int nscale = 0) {
    const int nblk = N / 32, kb = item / nblk, nb = item % nblk, k0 = 64 * kb, n0 = 32 * nb;
#pragma unroll 8
    for (int i = 0; i < 32; ++i) { const int kk = 2 * i + (lane >> 5); scr[kk * 33 + (lane & 31)] = W[(size_t)(k0 + kk) * N + n0 + (lane & 31)] * (n0 < nscale ? QSCALE : 1.0f); }
    asm volatile("s_waitcnt lgkmcnt(0)" ::: "memory");
    const int c = lane & 7;
#pragma unroll
    for (int j = 0; j < 4; ++j) { const int n = (lane >> 3) + 8 * j; const LAS float* s = scr + (8 * c) * 33 + n;
        u32x4 o; o.x = cvtpk(s[0 * 33], s[1 * 33]); o.y = cvtpk(s[2 * 33], s[3 * 33]); o.z = cvtpk(s[4 * 33], s[5 * 33]); o.w = cvtpk(s[6 * 33], s[7 * 33]);
        *(u32x4*)(WT + (size_t)(n0 + n) * K + k0 + 8 * c) = o; }
    asm volatile("s_waitcnt lgkmcnt(0)" ::: "memory");
}

__device__ __forceinline__ void p0_prologue(LAS unsigned char* lds, int G, int wave, int lane) {
    unsigned char* ws = A_WS;
    const int gw = blockIdx.x * 8 + wave, NGW = G * 8;
    LAS float* scr = (LAS float*)(lds + wave * 16384);
    constexpr int I_IN = 16 * (INC / 32), I_SQ = 16 * 32, NTR = I_IN + 3 * I_SQ;
    for (int it = gw; it < NTR; it += NGW) {
        int r = it;
        if (r < I_IN) { p0_transpose_item(A_IN(7), DM, INC, (bf16_t*)(ws + WS_WIN), scr, r, lane, 1024); continue; } r -= I_IN;
        if (r < I_SQ) { p0_transpose_item(A_IN(16), DM, DM, (bf16_t*)(ws + WS_WBA), scr, r, lane); continue; } r -= I_SQ;
        if (r < I_SQ) { p0_transpose_item(A_IN(17), DM, DM, (bf16_t*)(ws + WS_WBL), scr, r, lane); continue; } r -= I_SQ;
        p0_transpose_item(A_IN(18), DM, DM, (bf16_t*)(ws + WS_WO), scr, r, lane);
    }
    {
        const float* wq = A_IN(20); bf16_t* wst = (bf16_t*)(ws + WS_WS);
        const int r32 = lane & 31, hi = lane >> 5;
        for (int it = gw; it < 2048; it += NGW) {
            const int hj = it >> 7, kt = (it >> 5) & 3, ct = it & 31, h = hj >> 1, j = hj & 1;
            const float* ap = (j ? A_IN(22) : A_IN(21)) + ((size_t)(h * 128 + kt * 32 + r32)) * 128 + 64 * hi;
            const float* bp = wq + (size_t)(ct * 32 + r32) * 2048 + hj * 128 + 64 * hi;
            f32x16 acc = {};
#pragma unroll
            for (int s4 = 0; s4 < 16; ++s4) { const f32x4 av = *(const f32x4*)(ap + 4 * s4), bv = *(const f32x4*)(bp + 4 * s4);
                acc = __builtin_amdgcn_mfma_f32_32x32x2f32(av[0], bv[0], acc, 0, 0, 0); acc = __builtin_amdgcn_mfma_f32_32x32x2f32(av[1], bv[1], acc, 0, 0, 0);
                acc = __builtin_amdgcn_mfma_f32_32x32x2f32(av[2], bv[2], acc, 0, 0, 0); acc = __builtin_amdgcn_mfma_f32_32x32x2f32(av[3], bv[3], acc, 0, 0, 0); }
#pragma unroll
            for (int r = 0; r < 16; ++r) { const int key = kt * 32 + (r & 3) + 8 * (r >> 2) + 4 * hi;
                wst[(size_t)(hj * 128 + key) * DM + ct * 32 + r32] = (bf16_t)(cvtpk(acc[r], 0.f) & 0xffffu); }
        }
    }
    for (int it = gw; it < 2 * NEXP; it += NGW) {
        const int tb = it >= NEXP, e = it - tb * NEXP;
        const float* src = (tb ? A_IN(24) : A_IN(23)) + (size_t)e * DM; bf16_t* dst = (bf16_t*)(ws + (tb ? WS_VB : WS_UB)) + (size_t)e * DM;
#pragma unroll
        for (int hh = 0; hh < 2; ++hh) { const f32x4 p = *(const f32x4*)(src + hh * 512 + lane * 8), q = *(const f32x4*)(src + hh * 512 + lane * 8 + 4);
            u32x4 w; w.x = cvtpk(p[0], p[1]); w.y = cvtpk(p[2], p[3]); w.z = cvtpk(q[0], q[1]); w.w = cvtpk(q[2], q[3]); *(u32x4*)(dst + hh * 512 + lane * 8) = w; }
    }
    {
        const float* gm = A_IN(6); bf16_t* XN = (bf16_t*)(ws + WS_XN);
        for (int m = gw; m < ROWS; m += NGW) {
            bf16_t* orow = XN + (size_t)m * DM;
            if (m >= NTOK) {
#pragma unroll
                for (int j = 0; j < 2; ++j) *(u32x4*)(orow + j * 512 + lane * 8) = (u32x4){0u, 0u, 0u, 0u};
                continue; }
            const float* xr = (m < NTP) ? A_IN(0) + (size_t)m * DM : A_IN(1) + (size_t)(m - NTP) * DM;
            f32x4 v[4]; float s = 0.f;
#pragma unroll
            for (int j = 0; j < 4; ++j) { v[j] = *(const f32x4*)(xr + j * 256 + lane * 4); s += (v[j][0] * v[j][0] + v[j][1] * v[j][1]) + (v[j][2] * v[j][2] + v[j][3] * v[j][3]); }
            const float inv = 1.0f / sqrtf(wave_sum(s) * (1.0f / DM) + EPS);
#pragma unroll
            for (int j = 0; j < 4; ++j) { const f32x4 gg = *(const f32x4*)(gm + j * 256 + lane * 4); const f32x4 y = v[j] * inv * gg;
                u32x2 w; w.x = cvtpk(y[0], y[1]); w.y = cvtpk(y[2], y[3]); *(u32x2*)(orow + j * 256 + lane * 4) = w; }
        }
    }
    {
        bf16_t* fw = (bf16_t*)(ws + WS_LRUW);
        for (int f = gw; f < 256; f += NGW) {
            const int ks = f & 3, T = (f >> 2) & 1, gate = (f >> 3) & 1, g = f >> 4, i = lane & 31, hi = lane >> 5;
            const int outc = 32 * T + swap23(i);
            const float* W = (gate ? A_IN(13) : A_IN(11)) + (size_t)g * 4096;
            float x[8];
#pragma unroll
            for (int j = 0; j < 8; ++j) x[j] = W[(16 * ks + 8 * hi + j) * 64 + outc];
            u32x4 w; w.x = cvtpk(x[0], x[1]); w.y = cvtpk(x[2], x[3]); w.z = cvtpk(x[4], x[5]); w.w = cvtpk(x[6], x[7]);
            *(u32x4*)(fw + (size_t)f * 512 + lane * 8) = w;
        }
    }
}

constexpr int LR_WF = 0, LR_CW = 16384, LR_CB = LR_CW + 1024, LR_BR = LR_CB + 256, LR_BI = LR_BR + 256, LR_CS = LR_BI + 256, LR_CARRY = LR_CS + 256, LR_SEQ = LR_CARRY + 2048, LR_END = LR_SEQ + 64;

__device__ __forceinline__ void lru_load_consts(LAS unsigned char* lds, int g, int tid) {
    const u32x4* src = (const u32x4*)(A_WS + WS_LRUW + (size_t)g * 16384);
    for (int i = tid; i < 1024; i += 512) ((LAS u32x4*)(lds + LR_WF))[i] = src[i];
    if (tid < 256) ((LAS float*)(lds + LR_CW))[tid] = A_IN(9)[(tid >> 6) * DM + g * 64 + (tid & 63)];
    if (tid < 64) {
        const int c = g * 64 + tid;
        ((LAS float*)(lds + LR_CB))[tid] = A_IN(10)[c]; ((LAS float*)(lds + LR_BR))[tid] = A_IN(12)[c]; ((LAS float*)(lds + LR_BI))[tid] = A_IN(14)[c];
        ((LAS float*)(lds + LR_CS))[tid] = 8.0f * log1pf(expf(-A_IN(15)[c]));
    }
    if (tid < 8) ((LAS unsigned*)(lds + LR_SEQ))[tid] = 0xffffffffu;
}

template <bool SAMPLE>
__device__ __forceinline__ void lru_tile(LAS unsigned char* lds, int lane, int g, size_t rowbase, int tile, int bidx) {
    asm volatile("" : "+v"(lane));
    const int tl = lane & 31, hi = lane >> 5, t = tile * 32 + tl;
    const bf16_t* XR = (const bf16_t*)(A_WS + WS_XR); bf16_t* Gb = (bf16_t*)(A_WS + WS_G);
    const int cbase = g * 64 + 8 * hi;
    float xc[4][8];
    bf16x8 xf[4];
#pragma unroll
    for (int ks = 0; ks < 4; ++ks) {
        const f32x4 b0 = *(const LAS f32x4*)(lds + LR_CB + (16 * ks + 8 * hi) * 4), b1 = *(const LAS f32x4*)(lds + LR_CB + (16 * ks + 8 * hi) * 4 + 16);
#pragma unroll
        for (int j = 0; j < 4; ++j) { xc[ks][j] = b0[j]; xc[ks][4 + j] = b1[j]; }
#pragma unroll
        for (int tap = 0; tap < 4; ++tap) {
            const int rr = t - 3 + tap;
            float xv[8];
            {
                u32x4 w = *(const u32x4*)(XR + (rowbase + (rr < 0 ? 0 : rr)) * DM + cbase + 16 * ks);
                if (rr < 0) w = (u32x4){0u, 0u, 0u, 0u};
                xv[0] = bflo(w.x); xv[1] = bfhi(w.x); xv[2] = bflo(w.y); xv[3] = bfhi(w.y); xv[4] = bflo(w.z); xv[5] = bfhi(w.z); xv[6] = bflo(w.w); xv[7] = bfhi(w.w);
            }
            if (SAMPLE) {
                const float* sp = A_IN(4) + ((size_t)bidx * 3 + (rr < 0 ? 3 + rr : 0)) * DM + cbase + 16 * ks;
                const f32x4 p = *(const f32x4*)sp, q = *(const f32x4*)(sp + 4);
#pragma unroll
                for (int j = 0; j < 4; ++j) { xv[j] = rr < 0 ? p[j] : xv[j]; xv[4 + j] = rr < 0 ? q[j] : xv[4 + j]; }
            }
            const f32x4 w0 = *(const LAS f32x4*)(lds + LR_CW + (tap * 64 + 16 * ks + 8 * hi) * 4), w1 = *(const LAS f32x4*)(lds + LR_CW + (tap * 64 + 16 * ks + 8 * hi) * 4 + 16);
#pragma unroll
            for (int j = 0; j < 4; ++j) { xc[ks][j] += w0[j] * xv[j]; xc[ks][4 + j] += w1[j] * xv[4 + j]; }
        }
        u32x4 w; w.x = cvtpk(xc[ks][0], xc[ks][1]); w.y = cvtpk(xc[ks][2], xc[ks][3]); w.z = cvtpk(xc[ks][4], xc[ks][5]); w.w = cvtpk(xc[ks][6], xc[ks][7]);
        xf[ks] = __builtin_bit_cast(bf16x8, w);
        asm volatile("" ::: "memory");
    }
    float A[32], B[32];
#pragma unroll
    for (int T = 0; T < 2; ++T) {
        f32x16 ar = f32x16{}, ai = f32x16{};
#pragma unroll
        for (int ks = 0; ks < 4; ++ks) {
            const bf16x8 wr_ = *(const LAS bf16x8*)(lds + LR_WF + ((0 * 2 + T) * 4 + ks) * 1024 + lane * 16);
            const bf16x8 wi_ = *(const LAS bf16x8*)(lds + LR_WF + ((1 * 2 + T) * 4 + ks) * 1024 + lane * 16);
            ar = __builtin_amdgcn_mfma_f32_32x32x16_bf16(wr_, xf[ks], ar, 0, 0, 0);
            ai = __builtin_amdgcn_mfma_f32_32x32x16_bf16(wi_, xf[ks], ai, 0, 0, 0);
        }
#pragma unroll
        for (int q = 0; q < 2; ++q) {
            const int ks = 2 * T + q, lo = (16 * ks + 8 * hi) * 4;
            const f32x4 br0 = *(const LAS f32x4*)(lds + LR_BR + lo), br1 = *(const LAS f32x4*)(lds + LR_BR + lo + 16);
            const f32x4 bi0 = *(const LAS f32x4*)(lds + LR_BI + lo), bi1 = *(const LAS f32x4*)(lds + LR_BI + lo + 16);
            const f32x4 cs0 = *(const LAS f32x4*)(lds + LR_CS + lo), cs1 = *(const LAS f32x4*)(lds + LR_CS + lo + 16);
#pragma unroll
            for (int j = 0; j < 8; ++j) {
                const int r = 8 * q + j;
                const float brv = j < 4 ? br0[j & 3] : br1[j & 3], biv = j < 4 ? bi0[j & 3] : bi1[j & 3], csv = j < 4 ? cs0[j & 3] : cs1[j & 3];
                const float rg = sigmoidf_(ar[r] + brv), ig = sigmoidf_(ai[r] + biv);
                const float la = -csv * rg, av = fast_exp2(la * LOG2E);
                const float x2 = 2.0f * la;
                const float em = (x2 > -0.03f) ? -x2 * (1.0f + x2 * (0.5f + x2 * (0.16666667f + x2 * 0.041666668f))) : 1.0f - fast_exp2(x2 * LOG2E);
                A[16 * T + r] = av; B[16 * T + r] = sqrtf(em) * ig * xc[ks][j];
            }
        }
        asm volatile("" ::: "memory");
    }
#define LRU_STEP(CTRL, RM) _Pragma("unroll") for (int c = 0; c < 32; ++c) { \
        const float as_ = __builtin_bit_cast(float, __builtin_amdgcn_update_dpp(__builtin_bit_cast(int, 1.0f), __builtin_bit_cast(int, A[c]), CTRL, RM, 0xF, false)); \
        const float bs_ = __builtin_bit_cast(float, __builtin_amdgcn_update_dpp(0, __builtin_bit_cast(int, B[c]), CTRL, RM, 0xF, false)); \
        B[c] = A[c] * bs_ + B[c]; A[c] = A[c] * as_; }
    LRU_STEP(0x111, 0xF) LRU_STEP(0x112, 0xF) LRU_STEP(0x114, 0xF) LRU_STEP(0x118, 0xF) LRU_STEP(0x142, 0xA)
#undef LRU_STEP
    float hin[32];
    if (SAMPLE) {
        const float* hp = A_IN(5) + (size_t)bidx * DM + cbase;
#pragma unroll
        for (int ks = 0; ks < 4; ++ks) { const f32x4 p = *(const f32x4*)(hp + 16 * ks), q = *(const f32x4*)(hp + 16 * ks + 4);
#pragma unroll
            for (int j = 0; j < 4; ++j) { hin[8 * ks + j] = p[j]; hin[8 * ks + 4 + j] = q[j]; } }
    } else if (tile == 0) {
#pragma unroll
        for (int c = 0; c < 32; ++c) hin[c] = 0.f;
    } else {
        volatile LAS unsigned* sq = (volatile LAS unsigned*)(lds + LR_SEQ) + (tile & 7);
        while (*sq != (unsigned)tile) __builtin_amdgcn_s_sleep(1);
        asm volatile("" ::: "memory");
        const LAS float* cp = (const LAS float*)(lds + LR_CARRY) + (tile & 7) * 64 + 8 * hi;
#pragma unroll
        for (int ks = 0; ks < 4; ++ks) { const f32x4 p = *(const LAS f32x4*)(cp + 16 * ks), q = *(const LAS f32x4*)(cp + 16 * ks + 4);
#pragma unroll
            for (int j = 0; j < 4; ++j) { hin[8 * ks + j] = p[j]; hin[8 * ks + 4 + j] = q[j]; } }
    }
#pragma unroll
    for (int c = 0; c < 32; ++c) B[c] = B[c] + A[c] * hin[c];
    if (!SAMPLE) {
        if (tl == 31) {
            if (tile < 127) {
                LAS float* cp = (LAS float*)(lds + LR_CARRY) + ((tile + 1) & 7) * 64 + 8 * hi;
#pragma unroll
                for (int ks = 0; ks < 4; ++ks) { *(LAS f32x4*)(cp + 16 * ks) = (f32x4){B[8 * ks], B[8 * ks + 1], B[8 * ks + 2], B[8 * ks + 3]};
                    *(LAS f32x4*)(cp + 16 * ks + 4) = (f32x4){B[8 * ks + 4], B[8 * ks + 5], B[8 * ks + 6], B[8 * ks + 7]}; }
            } else {
                float* lp = A_OUT + O_LP + (size_t)bidx * DM + cbase;
#pragma unroll
                for (int ks = 0; ks < 4; ++ks) { *(f32x4*)(lp + 16 * ks) = (f32x4){B[8 * ks], B[8 * ks + 1], B[8 * ks + 2], B[8 * ks + 3]};
                    *(f32x4*)(lp + 16 * ks + 4) = (f32x4){B[8 * ks + 4], B[8 * ks + 5], B[8 * ks + 6], B[8 * ks + 7]}; }
            }
        }
        if (tile < 127) {
            asm volatile("s_waitcnt lgkmcnt(0)" ::: "memory");
            if (lane == 63) *((volatile LAS unsigned*)(lds + LR_SEQ) + ((tile + 1) & 7)) = (unsigned)(tile + 1);
        }
    } else if (tl == 15) {
        float* lp = A_OUT + O_LS + (size_t)bidx * DM + cbase;
#pragma unroll
        for (int ks = 0; ks < 4; ++ks) { *(f32x4*)(lp + 16 * ks) = (f32x4){B[8 * ks], B[8 * ks + 1], B[8 * ks + 2], B[8 * ks + 3]};
            *(f32x4*)(lp + 16 * ks + 4) = (f32x4){B[8 * ks + 4], B[8 * ks + 5], B[8 * ks + 6], B[8 * ks + 7]}; }
    }
    if (!SAMPLE || tl < NST) {
        bf16_t* gp = Gb + (rowbase + t) * DM + cbase;
#pragma unroll
        for (int ks = 0; ks < 4; ++ks) {
            const u32x4 w = *(const u32x4*)(gp + 16 * ks);
            float gv[8]; gv[0] = bflo(w.x); gv[1] = bfhi(w.x); gv[2] = bflo(w.y); gv[3] = bfhi(w.y); gv[4] = bflo(w.z); gv[5] = bfhi(w.z); gv[6] = bflo(w.w); gv[7] = bfhi(w.w);
            float o[8];
#pragma unroll
            for (int j = 0; j < 8; ++j) o[j] = B[8 * ks + j] * gelu_tanh(gv[j]);
            u32x4 ow; ow.x = cvtpk(o[0], o[1]); ow.y = cvtpk(o[2], o[3]); ow.z = cvtpk(o[4], o[5]); ow.w = cvtpk(o[6], o[7]);
            *(u32x4*)(gp + 16 * ks) = ow;
        }
    }
}

constexpr int AT_TAB = 24576;
__device__ __forceinline__ void attn_unit(LAS unsigned char* lds, int lane, int b, int c, int h) {
    const int r32 = lane & 31, hi = lane >> 5, kr = swap23(r32);
    const bf16_t* Q = (const bf16_t*)(A_WS + WS_Q); const bf16_t* Kb = (const bf16_t*)(A_WS + WS_K); const bf16_t* VT = (const bf16_t*)(A_WS + WS_VT); bf16_t* O = (bf16_t*)(A_WS + WS_XN);
    const size_t row0 = (size_t)b * SEQ + (size_t)c * 64;
    bf16x8 qf[2][4];
#pragma unroll
    for (int qb = 0; qb < 2; ++qb)
#pragma unroll
        for (int ks = 0; ks < 4; ++ks) qf[qb][ks] = *(const bf16x8*)(Q + (row0 + qb * 32 + r32) * DM + h * 64 + ks * 16 + hi * 8);
    f32x16 o[2][2];
#pragma unroll
    for (int i = 0; i < 2; ++i)
#pragma unroll
        for (int j = 0; j < 2; ++j) o[i][j] = f32x16{};
    float mrow[2] = {-1e30f, -1e30f}, lrow[2] = {0.f, 0.f};
    const LAS float* tab = (const LAS float*)(lds + AT_TAB) + h * 320;
    const float cfar = tab[256];
    const int sb0 = (c >= 8 ? c - 8 : 0) * 2, sb1 = c * 2 + 1;
    const bf16_t* kbase = Kb + ((size_t)b * SEQ + kr) * DM + h * 64 + hi * 8;
    const bf16_t* vbase = VT + (size_t)(h * 64 + kr) * ROWS + (size_t)b * SEQ + hi * 8;
    bf16x8 kf[4], vf[2][2];
#pragma unroll
    for (int ks = 0; ks < 4; ++ks) kf[ks] = *(const bf16x8*)(kbase + (size_t)sb0 * 32 * DM + ks * 16);
#pragma unroll
    for (int db = 0; db < 2; ++db)
#pragma unroll
        for (int s = 0; s < 2; ++s) vf[db][s] = *(const bf16x8*)(vbase + (size_t)db * 32 * ROWS + sb0 * 32 + s * 16);
    for (int sb = sb0; sb <= sb1; ++sb) {
        const int sbn = sb < sb1 ? sb + 1 : sb;
        f32x16 S[2];
#pragma unroll
        for (int qb = 0; qb < 2; ++qb) { S[qb] = f32x16{};
#pragma unroll
            for (int ks = 0; ks < 4; ++ks) S[qb] = __builtin_amdgcn_mfma_f32_32x32x16_bf16(kf[ks], qf[qb][ks], S[qb], 0, 0, 0); }
        asm volatile("" ::: "memory");
#pragma unroll
        for (int ks = 0; ks < 4; ++ks) kf[ks] = *(const bf16x8*)(kbase + (size_t)sbn * 32 * DM + ks * 16);
        const int delta = c - (sb >> 1), rb = sb & 1;
        if (delta >= 3) {
#pragma unroll
            for (int qb = 0; qb < 2; ++qb)
#pragma unroll
                for (int r = 0; r < 16; ++r) S[qb][r] += cfar;
        } else {
#pragma unroll
            for (int qb = 0; qb < 2; ++qb) {
                const LAS float* tp = tab + (64 * delta + 32 * qb + r32 + 128 - 32 * rb - 8 * hi - 23);
#pragma unroll
                for (int r = 0; r < 16; ++r) S[qb][r] += tp[23 - (16 * (r >> 3) + (r & 7))];
            }
        }
        float rm[2];
#pragma unroll
        for (int qb = 0; qb < 2; ++qb) { float mx = S[qb][0];
#pragma unroll
            for (int r = 1; r < 16; ++r) mx = fmaxf(mx, S[qb][r]);
            rm[qb] = plswap_max(mx); }
        if (__any((rm[0] > mrow[0] + 8.0f) || (rm[1] > mrow[1] + 8.0f))) {
#pragma unroll
            for (int qb = 0; qb < 2; ++qb) { const float mn = fmaxf(mrow[qb], rm[qb]); const float al = fast_exp2(mrow[qb] - mn); lrow[qb] *= al; mrow[qb] = mn;
#pragma unroll
                for (int r = 0; r < 16; ++r) { o[0][qb][r] *= al; o[1][qb][r] *= al; } }
        }
        bf16x8 pf[2][2];
#pragma unroll
        for (int qb = 0; qb < 2; ++qb) { float sum = 0.f;
#pragma unroll
            for (int r = 0; r < 16; ++r) { S[qb][r] = fast_exp2(S[qb][r] - mrow[qb]); sum += S[qb][r]; }
            lrow[qb] += sum;
#pragma unroll
            for (int s = 0; s < 2; ++s) { u32x4 w; w.x = cvtpk(S[qb][8 * s], S[qb][8 * s + 1]); w.y = cvtpk(S[qb][8 * s + 2], S[qb][8 * s + 3]); w.z = cvtpk(S[qb][8 * s + 4], S[qb][8 * s + 5]); w.w = cvtpk(S[qb][8 * s + 6], S[qb][8 * s + 7]);
                pf[qb][s] = __builtin_bit_cast(bf16x8, w); } }
#pragma unroll
        for (int db = 0; db < 2; ++db)
#pragma unroll
            for (int qb = 0; qb < 2; ++qb)
#pragma unroll
                for (int s = 0; s < 2; ++s) o[db][qb] = __builtin_amdgcn_mfma_f32_32x32x16_bf16(vf[db][s], pf[qb][s], o[db][qb], 0, 0, 0);
        asm volatile("" ::: "memory");
#pragma unroll
        for (int db = 0; db < 2; ++db)
#pragma unroll
            for (int s = 0; s < 2; ++s) vf[db][s] = *(const bf16x8*)(vbase + (size_t)db * 32 * ROWS + sbn * 32 + s * 16);
    }
#pragma unroll
    for (int qb = 0; qb < 2; ++qb) { const float inv = fast_rcp(plswap_add(lrow[qb]));
        bf16_t* op = O + (row0 + qb * 32 + r32) * DM + h * 64 + 8 * hi;
#pragma unroll
        for (int db = 0; db < 2; ++db)
#pragma unroll
            for (int s = 0; s < 2; ++s) { u32x4 w;
                w.x = cvtpk(o[db][qb][8 * s] * inv, o[db][qb][8 * s + 1] * inv); w.y = cvtpk(o[db][qb][8 * s + 2] * inv, o[db][qb][8 * s + 3] * inv);
                w.z = cvtpk(o[db][qb][8 * s + 4] * inv, o[db][qb][8 * s + 5] * inv); w.w = cvtpk(o[db][qb][8 * s + 6] * inv, o[db][qb][8 * s + 7] * inv);
                *(u32x4*)(op + 32 * db + 16 * s) = w; } }
}

constexpr int AS_P = 45056;
__device__ __forceinline__ void attn_sample_task(LAS unsigned char* lds, int wave, int lane, int task) {
    const int bs = task >> 6, h = (task >> 2) & 15, qg = task & 3;
    const bf16_t* Q = (const bf16_t*)(A_WS + WS_Q); bf16_t* O = (bf16_t*)(A_WS + WS_XN);
    const float* ck = A_IN(2); const float* cv = A_IN(3); const float* kn = A_OUT + O_KS; const float* vn = A_OUT + O_VS;
    LAS float* pb = (LAS float*)(lds + AS_P + wave * 9472);
    LAS float* qs = pb + 4 * 528;
    const LAS float* tab = (const LAS float*)(lds + AT_TAB) + h * 320;
#pragma unroll
    for (int i = 0; i < 4; ++i) qs[i * 64 + lane] = bflo((unsigned)Q[((size_t)NTP + bs * 16 + qg * 4 + i) * DM + h * 64 + lane]);
    asm volatile("s_waitcnt lgkmcnt(0)" ::: "memory");
#pragma unroll 1
    for (int it = 0; it < 9; ++it) {
        const int key = it * 64 + lane; const bool valid = key < 528;
        const float* kp = !valid ? ck : (key < 512 ? ck + (((size_t)bs * 512 + key) * 16 + h) * 64 : kn + ((size_t)bs * 16 + (key - 512)) * DM + h * 64);
        float d[4] = {0.f, 0.f, 0.f, 0.f};
#pragma unroll 4
        for (int d4 = 0; d4 < 16; ++d4) { const f32x4 kv = *(const f32x4*)(kp + 4 * d4);
#pragma unroll
            for (int i = 0; i < 4; ++i) { const f32x4 qq = *(const LAS f32x4*)(qs + i * 64 + 4 * d4); d[i] += (kv[0] * qq[0] + kv[1] * qq[1]) + (kv[2] * qq[2] + kv[3] * qq[3]); } }
        int rel = 512 + qg * 4 - key;
        if (valid) {
#pragma unroll
            for (int i = 0; i < 4; ++i) { int r = rel + i; r = r > 128 ? 128 : r; pb[i * 528 + key] = d[i] + tab[r + 128]; } }
    }
    asm volatile("s_waitcnt lgkmcnt(0)" ::: "memory");
#pragma unroll 1
    for (int i = 0; i < 4; ++i) {
        float mx = -1e30f;
#pragma unroll 1
        for (int key = lane; key < 528; key += 64) mx = fmaxf(mx, pb[i * 528 + key]);
#pragma unroll
        for (int o = 1; o < 64; o <<= 1) mx = fmaxf(mx, __shfl_xor(mx, o));
        float sum = 0.f;
#pragma unroll 1
        for (int key = lane; key < 528; key += 64) { const float pv = fast_exp2(pb[i * 528 + key] - mx); pb[i * 528 + key] = pv; sum += pv; }
        sum = wave_sum(sum); const float inv = 1.0f / sum;
#pragma unroll 1
        for (int key = lane; key < 528; key += 64) pb[i * 528 + key] *= inv;
    }
    asm volatile("s_waitcnt lgkmcnt(0)" ::: "memory");
    float acc[4] = {0.f, 0.f, 0.f, 0.f};
#pragma unroll 4
    for (int key = 0; key < 528; ++key) {
        const float v = key < 512 ? cv[(((size_t)bs * 512 + key) * 16 + h) * 64 + lane] : vn[((size_t)bs * 16 + (key - 512)) * DM + h * 64 + lane];
#pragma unroll
        for (int i = 0; i < 4; ++i) acc[i] += pb[i * 528 + key] * v;
    }
#pragma unroll
    for (int i = 0; i < 4; ++i) O[((size_t)NTP + bs * 16 + qg * 4 + i) * DM + h * 64 + lane] = (bf16_t)(cvtpk(acc[i], 0.f) & 0xffffu);
    asm volatile("s_waitcnt lgkmcnt(0)" ::: "memory");
}

__device__ __forceinline__ void p2_phase(LAS unsigned char* lds, int G, int tid, int wave, int lane) {
    for (int i = tid; i < 16 * 320; i += 512) { const int h = i / 320, j = i % 320; ((LAS float*)(lds + AT_TAB))[i] = A_IN(8)[h * 257 + (j > 256 ? 256 : j)] * LOG2E; }
    for (int u = blockIdx.x; u < 256 + 16; u += G) {
        __syncthreads();
        if (u < 256) {
            const int b = u >> 4, g = u & 15;
            lru_load_consts(lds, g, tid);
            __syncthreads();
            for (int tile = wave; tile < 128; tile += 8) lru_tile<false>(lds, lane, g, (size_t)b * SEQ, tile, b);
        } else {
            const int g = u - 256;
            lru_load_consts(lds, g, tid);
            __syncthreads();
            lru_tile<true>(lds, lane, g, (size_t)NTP + wave * 16, 0, wave);
        }
    }
    __syncthreads();
    const int gw = blockIdx.x * 8 + wave, NGW = G * 8;
    for (int u = gw; u < NB * 64 * 16; u += NGW) {
        const int c = u & 63, h = (u >> 6) & 15, b = u >> 10;
        attn_unit(lds, lane, b, c, h);
    }
    for (int t = gw; t < 512; t += NGW) attn_sample_task(lds, wave, lane, t);
}

__device__ __forceinline__ void p4b_phase(int G, int wave, int lane) {
    const int gw = blockIdx.x * 8 + wave, NGW = G * 8;
    const float* gm = A_IN(19); bf16_t* XT = (bf16_t*)(A_WS + WS_Q);
    for (int m = gw; m < NTOK; m += NGW) {
        const float* xr = (m < NTP) ? A_OUT + O_YP + (size_t)m * DM : A_OUT + O_YS + (size_t)(m - NTP) * DM;
        bf16_t* orow = XT + (size_t)m * DM;
        f32x4 v[4]; float s = 0.f;
#pragma unroll
        for (int j = 0; j < 4; ++j) { v[j] = *(const f32x4*)(xr + j * 256 + lane * 4); s += (v[j][0] * v[j][0] + v[j][1] * v[j][1]) + (v[j][2] * v[j][2] + v[j][3] * v[j][3]); }
        const float inv = 1.0f / sqrtf(wave_sum(s) * (1.0f / DM) + EPS);
#pragma unroll
        for (int j = 0; j < 4; ++j) { const f32x4 gg = *(const f32x4*)(gm + j * 256 + lane * 4); const f32x4 y = v[j] * inv * gg;
            u32x2 w; w.x = cvtpk(y[0], y[1]); w.y = cvtpk(y[2], y[3]); *(u32x2*)(orow + j * 256 + lane * 4) = w; }
    }
}

__device__ __forceinline__ int f2key(float f) { const int b = __float_as_int(f); return b ^ ((b >> 31) & 0x7fffffff); }
__device__ __forceinline__ float key2f(int k) { return __int_as_float(k ^ ((k >> 31) & 0x7fffffff)); }
#define INS16(L, x) do { int x_ = (x); _Pragma("unroll") for (int j_ = 0; j_ < 16; ++j_) { const int hi_ = max(L[j_], x_); x_ = min(L[j_], x_); L[j_] = hi_; } } while (0)

constexpr size_t WS_SELE = WS_G, WS_SELG = WS_G + 64 * MiB;
constexpr size_t WS_PART = WS_XN;
constexpr int CT_U = 64, CT_V = 64 + 8 * 64;
constexpr int P6_TOKB = 64, P6_NITEM = NTOK / P6_TOKB;
constexpr int P6_IDX = 0;
constexpr int P6_E = 0, P6_C = 8192, P6_ITEM = 16384;

__device__ __forceinline__ void p6a_phase(LAS unsigned char* lds, int G, int wave, int lane) {
    const int gw = blockIdx.x * 8 + wave, NGW = G * 8;
    const float* SC = (const float*)(A_WS + WS_XN);
    int* SELE = (int*)(A_WS + WS_SELE); float* SELG = (float*)(A_WS + WS_SELG);
    LAS int* idxb = (LAS int*)(lds + P6_IDX + wave * 4096);
    const int tl = lane >> 4, hh = (lane >> 1) & 7, half = lane & 1;
    for (int grp = gw; grp < NTOK / 4; grp += NGW) {
        const int tok = grp * 4 + tl;
        const float* sp = SC + (size_t)tok * 2048 + hh * 256 + half * 128;
        int L[16];
#pragma unroll
        for (int j = 0; j < 16; ++j) L[j] = (int)0x80000000;
        for (int c4 = 0; c4 < 32; c4 += 2) {
            const f32x4 v0 = *(const f32x4*)(sp + 4 * c4), v1 = *(const f32x4*)(sp + 4 * c4 + 4);
#pragma unroll
            for (int e = 0; e < 4; ++e) INS16(L, (f2key(v0[e]) & ~127) | (4 * c4 + e));
#pragma unroll
            for (int e = 0; e < 4; ++e) INS16(L, (f2key(v1[e]) & ~127) | (4 * c4 + 4 + e));
        }
#pragma unroll
        for (int j = 0; j < 16; ++j) idxb[lane * 16 + j] = L[j] & 127;
        float va[16], vb[16];
#pragma unroll
        for (int j = 0; j < 16; ++j) { const int own = L[j] & ~127, oth = __shfl_xor(own, 1); va[j] = key2f(half ? oth : own); vb[j] = key2f(half ? own : oth); }
        int C[16];
#pragma unroll
        for (int j = 0; j < 16; ++j) C[j] = (int)0x80000000;
#pragma unroll
        for (int i = 0; i < 16; ++i)
#pragma unroll
            for (int j = 0; j < 16; ++j) if ((i + 1) * (j + 1) <= 16) INS16(C, (f2key(va[i] + vb[j]) & ~255) | (i * 16 + j));
        const float mx = key2f(C[0] & ~255);
        float ev[16], sum = 0.f;
#pragma unroll
        for (int j = 0; j < 16; ++j) { ev[j] = __expf(key2f(C[j] & ~255) - mx); sum += ev[j]; }
        const float inv = 1.0f / sum;
        asm volatile("s_waitcnt lgkmcnt(0)" ::: "memory");
        int eo[8]; float go[8];
#pragma unroll
        for (int s = 0; s < 8; ++s) {
            int c_lo = C[s], c_hi = C[8 + s]; float e_lo = ev[s], e_hi = ev[8 + s];
            asm volatile("" : "+v"(c_lo), "+v"(c_hi), "+v"(e_lo), "+v"(e_hi));
            const int cc = half ? c_hi : c_lo; go[s] = (half ? e_hi : e_lo) * inv;
            const int ij = cc & 255, i1 = idxb[(lane & ~1) * 16 + (ij >> 4)], i2 = idxb[(lane | 1) * 16 + (ij & 15)];
            eo[s] = i1 * 128 + i2;
        }
        int* ep = SELE + (size_t)tok * 128 + hh * 16 + half * 8; float* gp = SELG + (size_t)tok * 128 + hh * 16 + half * 8;
        *(u32x4*)ep = (u32x4){(unsigned)eo[0], (unsigned)eo[1], (unsigned)eo[2], (unsigned)eo[3]}; *(u32x4*)(ep + 4) = (u32x4){(unsigned)eo[4], (unsigned)eo[5], (unsigned)eo[6], (unsigned)eo[7]};
        *(f32x4*)gp = (f32x4){go[0], go[1], go[2], go[3]}; *(f32x4*)(gp + 4) = (f32x4){go[4], go[5], go[6], go[7]};
        asm volatile("s_waitcnt lgkmcnt(0)" ::: "memory");
    }
}

__device__ __forceinline__ float dot2bf(unsigned a, unsigned b, float c) { return __builtin_amdgcn_fdot2_f32_bf16(__builtin_bit_cast(bf16x2_t, a), __builtin_bit_cast(bf16x2_t, b), c, false); }
__device__ __forceinline__ unsigned xcc_id() { return (unsigned)__builtin_amdgcn_s_getreg((3 << 11) | 20) & 0xFu; }
__device__ __forceinline__ float dpp_sum16(float v) {
    v += __builtin_bit_cast(float, __builtin_amdgcn_update_dpp(0, __builtin_bit_cast(int, v), 0xB1, 0xF, 0xF, true));
    v += __builtin_bit_cast(float, __builtin_amdgcn_update_dpp(0, __builtin_bit_cast(int, v), 0x4E, 0xF, 0xF, true));
    v += __builtin_bit_cast(float, __builtin_amdgcn_update_dpp(0, __builtin_bit_cast(int, v), 0x141, 0xF, 0xF, true));
    v += __builtin_bit_cast(float, __builtin_amdgcn_update_dpp(0, __builtin_bit_cast(int, v), 0x140, 0xF, 0xF, true));
    return v;
}
__device__ __forceinline__ bool p6_claim(LAS unsigned char* lds, unsigned* cnt, int tid, int& ring, int home, int& slice, int& item) {
    for (;;) {
        if (ring >= 8) return false;
        slice = (home + ring) & 7;
        __syncthreads();
        if (tid == 0) *(volatile LAS int*)(lds + P6_ITEM) = (int)__hip_atomic_fetch_add(cnt + 64 * slice, 1u, __ATOMIC_RELAXED, __HIP_MEMORY_SCOPE_AGENT);
        __syncthreads();
        item = *(volatile LAS int*)(lds + P6_ITEM);
        if (item < P6_NITEM) return true;
        ++ring;
    }
}

__device__ __forceinline__ void p6b_phase(LAS unsigned char* lds, int tid, int wave, int lane) {
    const bf16_t* XT = (const bf16_t*)(A_WS + WS_Q); const bf16_t* UB = (const bf16_t*)(A_WS + WS_UB);
    const int* SELE = (const int*)(A_WS + WS_SELE); float* PART = (float*)(A_WS + WS_PART);
    unsigned* cnt = (unsigned*)(A_WS + WS_CTL) + CT_U;
    const int i16 = lane & 15, grp = lane >> 4, home = (int)(xcc_id() & 7u);
    LAS int* eb = (LAS int*)(lds + P6_E + wave * 1024);
    int ring = 0, slice, item;
    while (p6_claim(lds, cnt, tid, ring, home, slice, item)) {
        const int tok0 = item * P6_TOKB + wave * 8;
        int e0 = SELE[(size_t)tok0 * 128 + lane], e1 = SELE[(size_t)tok0 * 128 + 64 + lane];
        for (int ti = 0; ti < 8; ++ti) {
            const int tok = tok0 + ti;
            LAS int* ebt = eb + (ti & 1) * 128;
            ebt[lane] = e0; ebt[64 + lane] = e1;
            if (ti < 7) { e0 = SELE[(size_t)(tok + 1) * 128 + lane]; e1 = SELE[(size_t)(tok + 1) * 128 + 64 + lane]; }
            const u32x4 xv = *(const u32x4*)(XT + (size_t)tok * DM + slice * 128 + i16 * 8);
            const bf16_t* ub = UB + slice * 128 + i16 * 8;
            asm volatile("s_waitcnt lgkmcnt(0)" ::: "memory");
            float res0 = 0.f, res1 = 0.f;
#pragma unroll
            for (int s8 = 0; s8 < 32; s8 += 8) {
                u32x4 uv[8];
#pragma unroll
                for (int q = 0; q < 8; ++q) { const int e = ebt[32 * grp + s8 + q]; uv[q] = *(const u32x4*)(ub + (size_t)e * DM); }
#pragma unroll
                for (int q = 0; q < 8; ++q) {
                    float d = dot2bf(uv[q].x, xv.x, 0.f); d = dot2bf(uv[q].y, xv.y, d); d = dot2bf(uv[q].z, xv.z, d); d = dot2bf(uv[q].w, xv.w, d);
                    d = dpp_sum16(d);
                    const int s = s8 + q;
                    if (s < 16) res0 = (i16 == (s & 15)) ? d : res0; else res1 = (i16 == (s & 15)) ? d : res1;
                }
            }
            float* pp = PART + ((size_t)slice * NTOK + tok) * 128 + 32 * grp + i16;
            pp[0] = res0; pp[16] = res1;
        }
    }
}

__device__ __forceinline__ void p6c_phase(LAS unsigned char* lds, int tid, int wave, int lane) {
    const bf16_t* VB = (const bf16_t*)(A_WS + WS_VB);
    const int* SELE = (const int*)(A_WS + WS_SELE); const float* SELG = (const float*)(A_WS + WS_SELG); const float* PART = (const float*)(A_WS + WS_PART);
    unsigned* cnt = (unsigned*)(A_WS + WS_CTL) + CT_V;
    float* out = A_OUT;
    const int i16 = lane & 15, grp = lane >> 4, home = (int)(xcc_id() & 7u);
    LAS int* eb = (LAS int*)(lds + P6_E + wave * 1024);
    LAS float* cb = (LAS float*)(lds + P6_C + wave * 512);
    int ring = 0, slice, item;
    while (p6_claim(lds, cnt, tid, ring, home, slice, item)) {
        const int tok0 = item * P6_TOKB + wave * 8;
        for (int ti = 0; ti < 8; ++ti) {
            const int tok = tok0 + ti;
            float a0 = 0.f, a1 = 0.f;
#pragma unroll
            for (int j = 0; j < 8; ++j) { const float* pp = PART + ((size_t)j * NTOK + tok) * 128; a0 += pp[lane]; a1 += pp[64 + lane]; }
            eb[lane] = SELE[(size_t)tok * 128 + lane]; eb[64 + lane] = SELE[(size_t)tok * 128 + 64 + lane];
            cb[lane] = SELG[(size_t)tok * 128 + lane] * gelu_tanh(a0); cb[64 + lane] = SELG[(size_t)tok * 128 + 64 + lane] * gelu_tanh(a1);
            const bf16_t* vb = VB + slice * 128 + i16 * 8;
            asm volatile("s_waitcnt lgkmcnt(0)" ::: "memory");
            float acc[8];
#pragma unroll
            for (int r = 0; r < 8; ++r) acc[r] = 0.f;
#pragma unroll
            for (int s8 = 0; s8 < 32; s8 += 8) {
                u32x4 vv[8]; float cf[8];
#pragma unroll
                for (int q = 0; q < 8; ++q) { const int e = eb[32 * grp + s8 + q]; cf[q] = cb[32 * grp + s8 + q]; vv[q] = *(const u32x4*)(vb + (size_t)e * DM); }
#pragma unroll
                for (int q = 0; q < 8; ++q) {
                    acc[0] += cf[q] * bflo(vv[q].x); acc[1] += cf[q] * bfhi(vv[q].x); acc[2] += cf[q] * bflo(vv[q].y); acc[3] += cf[q] * bfhi(vv[q].y);
                    acc[4] += cf[q] * bflo(vv[q].z); acc[5] += cf[q] * bfhi(vv[q].z); acc[6] += cf[q] * bflo(vv[q].w); acc[7] += cf[q] * bfhi(vv[q].w);
                }
            }
#pragma unroll
            for (int r = 0; r < 8; ++r) { acc[r] += __shfl_xor(acc[r], 16); acc[r] += __shfl_xor(acc[r], 32); }
            if (lane < 16) {
                float* yr = ((tok < NTP) ? out + O_YP + (size_t)tok * DM : out + O_YS + (size_t)(tok - NTP) * DM) + slice * 128 + i16 * 8;
                f32x4 z0 = *(const f32x4*)yr, z1 = *(const f32x4*)(yr + 4);
                z0 += (f32x4){acc[0], acc[1], acc[2], acc[3]}; z1 += (f32x4){acc[4], acc[5], acc[6], acc[7]};
                *(f32x4*)yr = z0; *(f32x4*)(yr + 4) = z1;
            }
            asm volatile("s_waitcnt lgkmcnt(0)" ::: "memory");
        }
    }
}

__device__ __forceinline__ void p6d_phase(int G, int wave, int lane) {
    const int gw = blockIdx.x * 8 + wave, NGW = G * 8;
    const float* gf = A_IN(25); float* out = A_OUT;
    for (int m = gw; m < NTOK; m += NGW) {
        float* yr = (m < NTP) ? out + O_YP + (size_t)m * DM : out + O_YS + (size_t)(m - NTP) * DM;
        f32x4 v[4]; float s = 0.f;
#pragma unroll
        for (int j = 0; j < 4; ++j) { v[j] = *(const f32x4*)(yr + j * 256 + lane * 4); s += (v[j][0] * v[j][0] + v[j][1] * v[j][1]) + (v[j][2] * v[j][2] + v[j][3] * v[j][3]); }
        const float inv = 1.0f / sqrtf(wave_sum(s) * (1.0f / DM) + EPS);
#pragma unroll
        for (int j = 0; j < 4; ++j) { const f32x4 gg = *(const f32x4*)(gf + j * 256 + lane * 4); *(f32x4*)(yr + j * 256 + lane * 4) = v[j] * inv * gg; }
    }
}

#define XB_TMO      128
#define XB_XCNT(j)  (256  + 64 * (j))
#define XB_XSUB(j)  (1280 + 64 * (j))
#define XB_XGEN(j)  (2304 + 64 * (j))
#define XB_TOP      3328
#define XB_TOPGEN   3392
#define XB_SPIN_CAP (1u << 22)
constexpr int CW_BAR = 2048;
constexpr int LDS_MISC = 131072 + 64;
__device__ __forceinline__ unsigned xb_ld(unsigned* p)              { return __hip_atomic_load(p, __ATOMIC_RELAXED, __HIP_MEMORY_SCOPE_AGENT); }
__device__ __forceinline__ unsigned xb_add(unsigned* p, unsigned v) { return __hip_atomic_fetch_add(p, v, __ATOMIC_RELAXED, __HIP_MEMORY_SCOPE_AGENT); }
#define XB_SPIN(cond, bar) do { unsigned _sp = 0; while (cond) { __builtin_amdgcn_s_sleep(1); \
    if ((++_sp & 255u) == 0u) { if (xb_ld(&(bar)[XB_TMO])) break; if (_sp > XB_SPIN_CAP) { atomicAdd(&(bar)[XB_TMO], 1u); break; } } } } while (0)
struct XcdBarrier { unsigned* bar; unsigned x; volatile LAS unsigned* st; };
__device__ __forceinline__ XcdBarrier xcd_barrier_post(unsigned* bar, volatile LAS unsigned* st) {
    XcdBarrier b; b.bar = bar; b.x = (unsigned)__builtin_amdgcn_s_getreg((3 << 11) | 20) & 0xFu; b.st = st;
    if (threadIdx.x == 0) (void)xb_add(&bar[XB_XCNT(b.x)], 1u);
    return b;
}
__device__ __forceinline__ void xcd_barrier_complete(unsigned* bar, unsigned x, unsigned& nloc, unsigned& nx) {
    const unsigned G = gridDim.x * gridDim.y * gridDim.z;
    unsigned sum, cnt, mine, sp = 0u;
    for (;;) {
        sum = 0u; cnt = 0u; mine = 0u;
#pragma unroll
        for (unsigned j = 0; j < 16; ++j) { const unsigned c = xb_ld(&bar[XB_XCNT(j)]); sum += c; cnt += (c > 0u) ? 1u : 0u; mine = (j == x) ? c : mine; }
        if (sum == G) break;
        __builtin_amdgcn_s_sleep(1);
        if ((++sp & 255u) == 0u) { if (xb_ld(&bar[XB_TMO])) break; if (sp > XB_SPIN_CAP) { atomicAdd(&bar[XB_TMO], 1u); break; } }
    }
    nloc = mine > 0u ? mine : 1u; nx = cnt > 0u ? cnt : 1u;
}
__device__ __forceinline__ void xcd_barrier(const XcdBarrier& b) {
    asm volatile("s_waitcnt vmcnt(0)" ::: "memory");
    __syncthreads();
    if (threadIdx.x == 0) {
        unsigned* bar = b.bar;
        __builtin_amdgcn_s_waitcnt(0);
        unsigned nloc = b.st[0], nx = b.st[1];
        if (nloc == 0u) { xcd_barrier_complete(bar, b.x, nloc, nx); b.st[0] = nloc; b.st[1] = nx; }
        const unsigned old = xb_add(&bar[XB_XSUB(b.x)], 1u);
        const unsigned gen = old / nloc;
        if (old + 1u == (gen + 1u) * nloc) {
            __builtin_amdgcn_fence(__ATOMIC_RELEASE, "agent");
            asm volatile("s_waitcnt vmcnt(0)" ::: "memory");
            const unsigned og = xb_add(&bar[XB_TOP], 1u);
            const unsigned tg = og / nx;
            if (og + 1u == (tg + 1u) * nx) xb_add(&bar[XB_TOPGEN], 1u);
            else XB_SPIN(xb_ld(&bar[XB_TOPGEN]) == tg, bar);
            __builtin_amdgcn_fence(__ATOMIC_ACQUIRE, "agent");
            xb_add(&bar[XB_XGEN(b.x)], 1u);
            asm volatile("s_waitcnt vmcnt(0)" ::: "memory");
        } else {
            XB_SPIN(xb_ld(&bar[XB_XGEN(b.x)]) == gen, bar);
            __builtin_amdgcn_fence(__ATOMIC_ACQUIRE, "agent");
            asm volatile("s_waitcnt vmcnt(0)" ::: "memory");
        }
    }
    __syncthreads();
}

__global__ void __launch_bounds__(512, 2) hybrid_fwd(Args a) {
    extern __shared__ __attribute__((aligned(16))) unsigned char lds_raw[];
    LAS unsigned char* lds = (LAS unsigned char*)lds_raw;
    const int tid = threadIdx.x, lane = tid & 63, wave = __builtin_amdgcn_readfirstlane(tid >> 6), G = gridDim.x;
    cg::grid_group grid = cg::this_grid();
    unsigned char* ws = A_WS;
    if (tid < 2) ((volatile LAS unsigned*)(lds + LDS_MISC))[tid] = 0u;
    __syncthreads();
    XcdBarrier xbar; xbar.bar = (unsigned*)(ws + WS_CTL) + CW_BAR; xbar.x = 0; xbar.st = nullptr;
    if (KA->use_sync) xbar = xcd_barrier_post((unsigned*)(ws + WS_CTL) + CW_BAR, (volatile LAS unsigned*)(lds + LDS_MISC));
#define IN(k) (KA->ph_lo <= (k) && (k) < KA->ph_hi)
#define SEAM(k) do { if (KA->use_sync && IN(k) && IN((k) + 1)) { if ((k) == 0) grid.sync(); else xcd_barrier(xbar); } } while (0)
    if (IN(0)) { p0_prologue(lds, G, wave, lane); }
    SEAM(0);
    if (IN(1)) {
        pg8::Gemm g{(const bf16_t*)(ws + WS_XN), (const bf16_t*)(ws + WS_WIN), (const bf16_t*)(ws + WS_WIN) + (size_t)2048 * DM, (const bf16_t*)(ws + WS_XN), DM};
        SchedG1 S; S.init(G, blockIdx.x); EpiG1 E;
        pg8::gemm_phase(lds, g, S, E);
    }
    SEAM(1);
    if (IN(2)) { p2_phase(lds, G, tid, wave, lane); }
    SEAM(2);
    if (IN(3)) {
        pg8::Gemm g{(const bf16_t*)(ws + WS_XN), (const bf16_t*)(ws + WS_WBA), (const bf16_t*)(ws + WS_G), (const bf16_t*)(ws + WS_WBL), DM};
        SchedPair S; S.init(4, G, blockIdx.x); EpiP3 E;
        pg8::gemm_phase(lds, g, S, E);
    }
    SEAM(3);
    if (IN(4)) {
        pg8::Gemm g{(const bf16_t*)(ws + WS_XR), (const bf16_t*)(ws + WS_WO), (const bf16_t*)(ws + WS_XR), (const bf16_t*)(ws + WS_WO), DM};
        SchedOne S; S.init(4, G, blockIdx.x); EpiP4 E;
        pg8::gemm_phase(lds, g, S, E);
    }
    SEAM(4);
    if (IN(5)) { p4b_phase(G, wave, lane); }
    SEAM(5);
    if (IN(6)) {
        pg8::Gemm g{(const bf16_t*)(ws + WS_Q), (const bf16_t*)(ws + WS_WS), (const bf16_t*)(ws + WS_Q), (const bf16_t*)(ws + WS_WS), DM};
        SchedOne S; S.init(8, G, blockIdx.x); EpiP5 E;
        pg8::gemm_phase(lds, g, S, E);
    }
    SEAM(6);
    if (IN(7)) { p6a_phase(lds, G, wave, lane); }
    SEAM(7);
    if (IN(8)) { p6b_phase(lds, tid, wave, lane); }
    SEAM(8);
    if (IN(9)) { p6c_phase(lds, tid, wave, lane); }
    SEAM(9);
    if (IN(10)) { p6d_phase(G, wave, lane); }
#undef IN
#undef SEAM
}

#ifndef N_LAUNCH_MODE
#define N_LAUNCH_MODE 1
#endif
constexpr int NPH = 11;
extern "C" void kernel_launch(void* const* d_in, const int* in_sizes, int n_in, void* d_out, int out_size, void* d_ws, size_t ws_size, hipStream_t stream) {
    static int grid = 0;
    if (grid == 0) {
        if (n_in != 26 || (size_t)out_size != O_END || ws_size < WS_END) { fprintf(stderr, "kernel_launch: unexpected sizes n_in %d out %d ws %zu (need %zu)\n", n_in, out_size, ws_size, (size_t)WS_END); grid = -1; return; }
        int dev = 0, cus = 0, per_cu = 0;
        (void)hipGetDevice(&dev); (void)hipDeviceGetAttribute(&cus, hipDeviceAttributeMultiprocessorCount, dev);
        (void)hipFuncSetAttribute((const void*)hybrid_fwd, hipFuncAttributeMaxDynamicSharedMemorySize, LDS_BYTES);
        (void)hipOccupancyMaxActiveBlocksPerMultiprocessor(&per_cu, (const void*)hybrid_fwd, 512, LDS_BYTES);
        if (per_cu < 1) { fprintf(stderr, "kernel_launch: occupancy query says %d blocks per CU\n", per_cu); per_cu = 1; }
        grid = cus;
        (void)hipGetLastError();
    }
    if (grid < 0) return;
    (void)hipMemsetAsync((char*)d_ws + WS_CTL, 0, 32768, stream);
    Args a{};
    for (int i = 0; i < 26; ++i) a.in[i] = (const float*)d_in[i];
    a.out = (float*)d_out; a.ws = (unsigned char*)d_ws;
    if (N_LAUNCH_MODE == 1) {
        a.ph_lo = 0; a.ph_hi = NPH; a.use_sync = 1;
        void* args[] = {&a};
        hipError_t e = hipLaunchCooperativeKernel((const void*)hybrid_fwd, dim3(grid), dim3(512), args, LDS_BYTES, stream);
        if (e != hipSuccess) fprintf(stderr, "cooperative launch failed: %s (grid %d)\n", hipGetErrorString(e), grid);
    } else {
        for (int p = 0; p < NPH; ++p) { a.ph_lo = p; a.ph_hi = p + 1; a.use_sync = 0; hipLaunchKernelGGL(hybrid_fwd, dim3(grid), dim3(512), LDS_BYTES, stream, a); }
    }
}
```

```cpp
#include <hip/hip_runtime.h>
#include <hip/hip_cooperative_groups.h>
#include <cstdint>
#include <cstdio>
namespace cg = cooperative_groups;

#define LAS __attribute__((address_space(3)))
typedef unsigned short bf16_t;
typedef short bf16x8 __attribute__((ext_vector_type(8)));
typedef float f32x4 __attribute__((ext_vector_type(4)));
typedef float f32x2 __attribute__((ext_vector_type(2)));
typedef float f32x16 __attribute__((ext_vector_type(16)));
typedef unsigned u32x4 __attribute__((ext_vector_type(4)));
typedef unsigned u32x2 __attribute__((ext_vector_type(2)));
typedef __bf16 bf16x2_t __attribute__((ext_vector_type(2)));

constexpr int DM = 1024, SEQ = 4096, NB = 16, NTP = NB * SEQ, NSB = 8, NST = 16, NTS = NSB * NST, NTOK = NTP + NTS;
constexpr int ROWS = 65792, NMT = 257;
constexpr int INC = 7168, NEXP = 16384;
constexpr float EPS = 1e-6f, LOG2E = 1.4426950408889634f;
constexpr float QSCALE = 0.125f * LOG2E;

constexpr size_t MiB = 1u << 20;
constexpr size_t BUF = (size_t)ROWS * DM * 2;
constexpr size_t WS_CTL = 0;
constexpr size_t WS_WIN = 1 * MiB;
constexpr size_t WS_WBA = 16 * MiB, WS_WBL = 18 * MiB, WS_WO = 20 * MiB, WS_WS = 22 * MiB;
constexpr size_t WS_LRUW = 26 * MiB;
constexpr size_t WS_SGA = 27 * MiB, WS_SGR = 27 * MiB + 512 * 1024;
constexpr size_t WS_SU = 26 * MiB + 512 * 1024, WS_SV = 26 * MiB + 640 * 1024;
constexpr size_t WS_SX = 26 * MiB + 704 * 1024;
constexpr size_t WS_UB = 28 * MiB, WS_VB = 60 * MiB;
constexpr size_t WS_Q = 92 * MiB;
constexpr size_t WS_XN = WS_Q + BUF;
constexpr size_t WS_K = WS_XN + BUF;
constexpr size_t WS_VT = WS_K + BUF;
constexpr size_t WS_XR = WS_VT + BUF;
constexpr size_t WS_G = WS_XR + BUF;
constexpr size_t WS_END = WS_G + BUF;
constexpr size_t WS_SELE = WS_G, WS_SELG = WS_G + (size_t)NTOK * 512, WS_XQ = WS_G + (size_t)NTOK * 1024;

constexpr size_t O_YP = 0, O_YS = O_YP + (size_t)NTP * DM, O_KP = O_YS + (size_t)NTS * DM, O_VP = O_KP + (size_t)NB * 512 * DM,
                 O_CP = O_VP + (size_t)NB * 512 * DM, O_LP = O_CP + (size_t)NB * 3 * DM, O_KS = O_LP + (size_t)NB * DM, O_VS = O_KS + (size_t)NTS * DM,
                 O_CS = O_VS + (size_t)NTS * DM, O_LS = O_CS + (size_t)NSB * 3 * DM, O_END = O_LS + (size_t)NSB * DM;

constexpr int LDS_BYTES = 135168;

__device__ __forceinline__ unsigned cvtpk(float lo, float hi) { f32x2 v = {lo, hi}; bf16x2_t b = __builtin_convertvector(v, bf16x2_t); return __builtin_bit_cast(unsigned, b); }
__device__ __forceinline__ float bflo(unsigned u) { return __uint_as_float(u << 16); }
__device__ __forceinline__ float bfhi(unsigned u) { return __uint_as_float(u & 0xffff0000u); }
__device__ __forceinline__ float fast_exp2(float x) { return __builtin_amdgcn_exp2f(x); }
__device__ __forceinline__ float fast_rcp(float x) { return __builtin_amdgcn_rcpf(x); }
__device__ __forceinline__ float sigmoidf_(float z) { return fast_rcp(1.0f + fast_exp2(-z * LOG2E)); }
__device__ __forceinline__ float gelu_tanh(float x) { const float u = x + 0.044715f * x * x * x; return x * fast_rcp(1.0f + fast_exp2(-1.5957691216f * LOG2E * u)); }
__device__ __forceinline__ float wave_sum(float v) {
#pragma unroll
    for (int o = 1; o < 64; o <<= 1) v += __shfl_xor(v, o);
    return v;
}
__device__ __forceinline__ int swap23(int i) { return (i & ~12) | ((i & 4) << 1) | ((i & 8) >> 1); }
__device__ __forceinline__ float plswap_max(float m) { auto rr = __builtin_amdgcn_permlane32_swap(__float_as_uint(m), __float_as_uint(m), false, false); return fmaxf(__uint_as_float(rr[0]), __uint_as_float(rr[1])); }
__device__ __forceinline__ float plswap_add(float m) { auto rr = __builtin_amdgcn_permlane32_swap(__float_as_uint(m), __float_as_uint(m), false, false); return __uint_as_float(rr[0]) + __uint_as_float(rr[1]); }

namespace pg8 {
constexpr int BM = 256, BK = 64, HALF = 128, HTB = HALF * BK * 2, STAGE_BYTES = 8 * HTB, NXCD = 8, WGM = 8;
__host__ __device__ __forceinline__ int lds_byte(int r, int c) { const int st = (r >> 4) * 2 + (c >> 5), rr = r & 15, cc = c & 31, ob = rr * 64 + cc * 2; return st * 1024 + (ob ^ (((ob >> 9) & 1) << 5)); }
__host__ __device__ __forceinline__ void stage_rc(int b, int& R, int& C) { const int st = b / 1024, sb = b % 1024, swz = sb ^ (((sb >> 9) & 1) << 5); R = (st >> 1) * 16 + swz / 64; C = (st & 1) * 32 + (swz % 64) / 2; }
__host__ __device__ __forceinline__ int perm32(int rho) { const int n = rho >> 4, i = rho & 15; return 8 * (i >> 2) + 4 * n + (i & 3); }

struct Unit { int pm, pn, kind; };
struct Gemm { const bf16_t* A0; const bf16_t* B0; const bf16_t* A1; const bf16_t* B1; int K; };

struct TileMap {
    int nM, nN, nwg;
    __device__ __forceinline__ void init(int nM_, int nN_) { nM = nM_; nN = nN_; nwg = nM * nN; }
    __device__ __forceinline__ void map(int L, int& pm, int& pn) const {
        int wgid = L; { const int q = nwg / NXCD, r = nwg % NXCD, xcd = wgid % NXCD, off = wgid / NXCD; wgid = (xcd < r ? xcd * (q + 1) : r * (q + 1) + (xcd - r) * q) + off; }
        const int nig = WGM * nN, gid = wgid / nig, fm = gid * WGM, gsz = (nM - fm) < WGM ? (nM - fm) : WGM;
        pm = fm + ((wgid % nig) % gsz); pn = (wgid % nig) / gsz;
    }
};

template <class Epi, class Sched>
__device__ __forceinline__ void gemm_phase(LAS unsigned char* lds, const Gemm g, const Sched& S, const Epi& E) {
    const int tid = threadIdx.x, wid = __builtin_amdgcn_readfirstlane(tid >> 6), lane = tid & 63, wr = wid >> 2, wc = wid & 3, fr = lane & 15, fq = lane >> 4;
    const int K = g.K, nt = K / BK;
    unsigned voffA[2], voffB[2];
#pragma unroll
    for (int i = 0; i < 2; ++i) { int R, C; stage_rc(tid * 16 + i * 8192, R, C); const int Rb = (R & ~31) + perm32(R & 31);
        voffA[i] = (unsigned)(R * K + C) * 2u; voffB[i] = (unsigned)(Rb * K + C) * 2u; }
    const size_t kstep = (size_t)(BK * 2);
    const size_t hstep = (size_t)HALF * K * 2;
    const size_t tstep = 2 * hstep;
    const unsigned ldsw = (unsigned)wid * 1024u;
    const int aoff = lds_byte(wr * 64 + fr, fq * 8), boff = lds_byte(wc * 32 + fr, fq * 8);
#define PG8_SA(b, h) (((b) * 2 + (h)) * HTB)
#define PG8_SB(b, h) ((4 + (b) * 2 + (h)) * HTB)
#define PG8_STAGE(bufoff, gbase, voff) do { _Pragma("unroll") for (int _i = 0; _i < 2; ++_i) \
        __builtin_amdgcn_global_load_lds((const unsigned*)((const char*)(gbase) + (voff)[_i]), (LAS unsigned*)(lds + (bufoff) + ldsw + _i * 8192), 16, 0, 0); } while (0)
#define PG8_LDA(dst, b, h) do { _Pragma("unroll") for (int m = 0; m < 4; ++m) _Pragma("unroll") for (int k = 0; k < 2; ++k) dst[m][k] = *(const LAS bf16x8*)(lds + PG8_SA(b, h) + aoff + m * 2048 + k * 1024); } while (0)
#define PG8_LDB(dst, b, h) do { _Pragma("unroll") for (int n = 0; n < 2; ++n) _Pragma("unroll") for (int k = 0; k < 2; ++k) dst[n][k] = *(const LAS bf16x8*)(lds + PG8_SB(b, h) + boff + n * 2048 + k * 1024); } while (0)
#define PG8_MMA(ai, bj, At, Bt) do { __builtin_amdgcn_s_setprio(1); _Pragma("unroll") for (int m = 0; m < 4; ++m) _Pragma("unroll") for (int n = 0; n < 2; ++n) _Pragma("unroll") for (int k = 0; k < 2; ++k) \
        acc[ai][bj][m][n] = __builtin_amdgcn_mfma_f32_16x16x32_bf16(Bt[n][k], At[m][k], acc[ai][bj][m][n], 0, 0, 0); __builtin_amdgcn_s_setprio(0); } while (0)
#define PG8_WAIT_V(n) asm volatile("s_waitcnt vmcnt(" #n ")" ::: "memory")
#define PG8_WAIT_L(n) asm volatile("s_waitcnt lgkmcnt(" #n ")" ::: "memory")
#define PG8_BAR __builtin_amdgcn_s_barrier()
#define PG8_SCHED __builtin_amdgcn_sched_barrier(0)
    Unit cur, nxt; int ui = 0;
    if (!S.next(0, cur)) return;
    f32x4 acc[2][2][4][2];
#pragma unroll
    for (int a = 0; a < 2; ++a)
#pragma unroll
        for (int b = 0; b < 2; ++b)
#pragma unroll
            for (int m = 0; m < 4; ++m)
#pragma unroll
                for (int n = 0; n < 2; ++n) acc[a][b][m][n] = (f32x4){0.f, 0.f, 0.f, 0.f};
    bf16x8 At[4][2], B0[2][2], B1[2][2];
    const char* cA = (const char*)(cur.kind ? g.A1 : g.A0) + (size_t)cur.pm * tstep; const char* cB = (const char*)(cur.kind ? g.B1 : g.B0) + (size_t)cur.pn * tstep;
    PG8_STAGE(PG8_SB(0, 0), cB, voffB); PG8_STAGE(PG8_SB(0, 1), cB + hstep, voffB); PG8_STAGE(PG8_SA(0, 0), cA, voffA); PG8_STAGE(PG8_SA(0, 1), cA + hstep, voffA);
    if (wr == 1) PG8_BAR;
    PG8_WAIT_V(2); PG8_BAR;
    PG8_STAGE(PG8_SB(1, 0), cB + kstep, voffB); PG8_STAGE(PG8_SA(1, 0), cA + kstep, voffA); PG8_STAGE(PG8_SB(1, 1), cB + hstep + kstep, voffB);
    PG8_WAIT_V(6); PG8_BAR;
    for (;;) {
        const bool has_next = S.next(ui + 1, nxt);
        const char* nA = has_next ? (const char*)(nxt.kind ? g.A1 : g.A0) + (size_t)nxt.pm * tstep : cA; const char* nB = has_next ? (const char*)(nxt.kind ? g.B1 : g.B0) + (size_t)nxt.pn * tstep : cB;
        for (int t = 0; t < nt; t += 2) {
            const bool last = (t == nt - 2);
            const char* a1 = cA + (size_t)(t + 1) * kstep;
            const char* a2 = last ? nA : cA + (size_t)(t + 2) * kstep; const char* b2 = last ? nB : cB + (size_t)(t + 2) * kstep;
            const char* a3 = a2 + kstep; const char* b3 = b2 + kstep;
            PG8_LDB(B0, 0, 0); PG8_LDB(B1, 0, 1); PG8_SCHED; PG8_LDA(At, 0, 0); PG8_STAGE(PG8_SA(1, 1), a1 + hstep, voffA);
            PG8_WAIT_V(8); PG8_WAIT_L(0); PG8_BAR; PG8_MMA(0, 0, At, B0); PG8_MMA(0, 1, At, B1); PG8_BAR; PG8_SCHED;
            PG8_LDA(At, 0, 1); PG8_STAGE(PG8_SB(0, 0), b2, voffB); PG8_STAGE(PG8_SB(0, 1), b2 + hstep, voffB); PG8_STAGE(PG8_SA(0, 0), a2, voffA);
            PG8_WAIT_V(8); PG8_WAIT_L(0); PG8_BAR; PG8_MMA(1, 0, At, B0); PG8_MMA(1, 1, At, B1); PG8_BAR; PG8_SCHED;
            PG8_LDB(B0, 1, 0); PG8_LDB(B1, 1, 1); PG8_SCHED; PG8_LDA(At, 1, 0); PG8_STAGE(PG8_SA(0, 1), a2 + hstep, voffA);
            PG8_WAIT_V(8); PG8_WAIT_L(0); PG8_BAR; PG8_MMA(0, 0, At, B0); PG8_MMA(0, 1, At, B1); PG8_BAR; PG8_SCHED;
            PG8_LDA(At, 1, 1); PG8_STAGE(PG8_SB(1, 0), b3, voffB); PG8_STAGE(PG8_SB(1, 1), b3 + hstep, voffB); PG8_STAGE(PG8_SA(1, 0), a3, voffA);
            PG8_WAIT_V(8); PG8_WAIT_L(0); PG8_BAR; PG8_MMA(1, 0, At, B0); PG8_MMA(1, 1, At, B1); PG8_BAR; PG8_SCHED;
        }
        if (wr == 0) PG8_BAR;
        E(acc, cur, wr, wc, fr, fq);
        if (!has_next) break;
#pragma unroll
        for (int a = 0; a < 2; ++a)
#pragma unroll
            for (int b = 0; b < 2; ++b)
#pragma unroll
                for (int m = 0; m < 4; ++m)
#pragma unroll
                    for (int n = 0; n < 2; ++n) acc[a][b][m][n] = (f32x4){0.f, 0.f, 0.f, 0.f};
        cur = nxt; cA = nA; cB = nB; ++ui;
        if (wr == 1) PG8_BAR;
    }
    PG8_WAIT_V(0);
    PG8_BAR;
#undef PG8_SA
#undef PG8_SB
#undef PG8_STAGE
#undef PG8_LDA
#undef PG8_LDB
#undef PG8_MMA
#undef PG8_WAIT_V
#undef PG8_WAIT_L
#undef PG8_BAR
#undef PG8_SCHED
}
}
using pg8::Unit;

struct Args {
    const float* in[26];
    float* out; unsigned char* ws;
    int ph_lo, ph_hi, use_sync, pad;
};

typedef const __attribute__((address_space(4))) Args* ArgsP;
#define KA ((ArgsP)__builtin_amdgcn_kernarg_segment_ptr())
#define A_IN(k) (KA->in[k])
#define A_OUT (KA->out)
#define A_WS (KA->ws)

struct SchedG1 {
    pg8::TileMap m0, m1; int G, c;
    __device__ __forceinline__ void init(int G_, int c_) { m0.init(NMT, 24); m1.init(4, NMT); G = G_; c = c_; }
    __device__ __forceinline__ bool next(int i, Unit& u) const {
        int L = i * G + c;
        if (L < m0.nwg) { m0.map(L, u.pm, u.pn); u.pn = (u.pn < 8) ? u.pn : u.pn + 4; u.kind = 0; return true; }
        L -= m0.nwg; if (L >= m1.nwg) return false;
        m1.map(L, u.pm, u.pn); u.kind = 1; return true;
    }
};
struct SchedPair {
    pg8::TileMap m0; int G, c;
    __device__ __forceinline__ void init(int nN, int G_, int c_) { m0.init(NMT, nN); G = G_; c = c_; }
    __device__ __forceinline__ bool next(int i, Unit& u) const { const int L = (i >> 1) * G + c; if (L >= m0.nwg) return false; m0.map(L, u.pm, u.pn); u.kind = i & 1; return true; }
};
struct SchedOne {
    pg8::TileMap m0; int G, c;
    __device__ __forceinline__ void init(int nN, int G_, int c_) { m0.init(NMT, nN); G = G_; c = c_; }
    __device__ __forceinline__ bool next(int i, Unit& u) const { const int L = i * G + c; if (L >= m0.nwg) return false; m0.map(L, u.pm, u.pn); u.kind = 0; return true; }
};

#define EPI_PREP int fr_ = fr, fq_ = fq; asm volatile("" : "+v"(fr_), "+v"(fq_)); const int rl_ = wr * 64 + fr_, cl_ = wc * 32 + 8 * fq_;
#define EPI_LOOP_BEGIN \
    _Pragma("unroll") for (int ai = 0; ai < 2; ++ai) _Pragma("unroll") for (int m = 0; m < 4; ++m) { const int rit = ai * 128 + m * 16 + rl_; \
    _Pragma("unroll") for (int bj = 0; bj < 2; ++bj) { const int cit = bj * 128 + cl_; f32x4 v0 = acc[ai][bj][m][0], v1 = acc[ai][bj][m][1];
#define EPI_LOOP_END } }

struct EpiG1 {
    __device__ __forceinline__ void operator()(const f32x4 (&acc)[2][2][4][2], const Unit& u, int wr, int wc, int fr, int fq) const {
        EPI_PREP unsigned char* ws = A_WS; float* out = A_OUT;
        if (u.kind == 0) {
            const int t = u.pn >> 2, ct = (u.pn & 3) * 256;
            bf16_t* base;
            if (t == 0) base = (bf16_t*)(ws + WS_Q); else if (t == 1) base = (bf16_t*)(ws + WS_K); else if (t == 3) base = (bf16_t*)(ws + WS_XR); else if (t == 4) base = (bf16_t*)(ws + WS_G);
            else if (t == 5) base = (u.pm < 256) ? (bf16_t*)(out + O_YP) : (bf16_t*)(ws + WS_SGA) - (size_t)NTP * DM;
            else base = (u.pm < 256) ? (bf16_t*)(out + O_YP) + (size_t)NTP * DM : (bf16_t*)(ws + WS_SGR) - (size_t)NTP * DM;
            base += (size_t)u.pm * 256 * DM + ct;
            EPI_LOOP_BEGIN
                u32x4 w; w.x = cvtpk(v0[0], v0[1]); w.y = cvtpk(v0[2], v0[3]); w.z = cvtpk(v1[0], v1[1]); w.w = cvtpk(v1[2], v1[3]);
                *(u32x4*)(base + (size_t)rit * DM + cit) = w;
            EPI_LOOP_END
            if (t == 1 && u.pm < 256 && (u.pm & 15) >= 14) { float* p0 = out + O_KP + ((size_t)(u.pm >> 4) * 512 + ((u.pm & 15) - 14) * 256) * DM + ct;
                EPI_LOOP_BEGIN float* p = p0 + (size_t)rit * DM + cit; *(f32x4*)p = v0; *(f32x4*)(p + 4) = v1; EPI_LOOP_END }
            if (t == 1 && u.pm == 256) { float* p0 = out + O_KS + ct;
                EPI_LOOP_BEGIN if (rit < NTS) { float* p = p0 + (size_t)rit * DM + cit; *(f32x4*)p = v0; *(f32x4*)(p + 4) = v1; } EPI_LOOP_END }
            if (t == 3 && u.pm < 256 && (u.pm & 15) == 15) { float* p0 = out + O_CP + ((size_t)(u.pm >> 4) * 3) * DM + ct;
                EPI_LOOP_BEGIN if (rit >= 253) { float* p = p0 + (size_t)(rit - 253) * DM + cit; *(f32x4*)p = v0; *(f32x4*)(p + 4) = v1; } EPI_LOOP_END }
            if (t == 3 && u.pm == 256) { float* p0 = out + O_CS + ct;
                EPI_LOOP_BEGIN if (rit < NTS && (rit & 15) >= 13) { float* p = p0 + ((size_t)(rit >> 4) * 3 + ((rit & 15) - 13)) * DM + cit; *(f32x4*)p = v0; *(f32x4*)(p + 4) = v1; } EPI_LOOP_END }
        } else {
            bf16_t* VT = (bf16_t*)(ws + WS_VT) + (size_t)u.pm * 256 * ROWS + (size_t)u.pn * 256;
            EPI_LOOP_BEGIN
                u32x4 w; w.x = cvtpk(v0[0], v0[1]); w.y = cvtpk(v0[2], v0[3]); w.z = cvtpk(v1[0], v1[1]); w.w = cvtpk(v1[2], v1[3]);
                *(u32x4*)(VT + (size_t)rit * ROWS + cit) = w;
            EPI_LOOP_END
            if (u.pn < 256 && (u.pn & 15) >= 14) { float* p0 = out + O_VP + ((size_t)(u.pn >> 4) * 512 + ((u.pn & 15) - 14) * 256) * DM + u.pm * 256;
                EPI_LOOP_BEGIN float* p = p0 + (size_t)cit * DM + rit;
                    p[0] = v0[0]; p[DM] = v0[1]; p[2 * DM] = v0[2]; p[3 * DM] = v0[3]; p[4 * DM] = v1[0]; p[5 * DM] = v1[1]; p[6 * DM] = v1[2]; p[7 * DM] = v1[3]; EPI_LOOP_END }
            if (u.pn == 256) { float* p0 = out + O_VS + u.pm * 256;
                EPI_LOOP_BEGIN if (cit < NTS) { float* p = p0 + (size_t)cit * DM + rit;
                    p[0] = v0[0]; p[DM] = v0[1]; p[2 * DM] = v0[2]; p[3 * DM] = v0[3]; p[4 * DM] = v1[0]; p[5 * DM] = v1[1]; p[6 * DM] = v1[2]; p[7 * DM] = v1[3]; } EPI_LOOP_END }
        }
    }
};

struct EpiP3 {
    __device__ __forceinline__ void operator()(const f32x4 (&acc)[2][2][4][2], const Unit& u, int wr, int wc, int fr, int fq) const {
        EPI_PREP unsigned char* ws = A_WS; float* out = A_OUT;
        const bf16_t* gb = (u.pm < 256) ? (const bf16_t*)(out + O_YP) + (u.kind ? (size_t)NTP * DM : 0) : (const bf16_t*)(ws + (u.kind ? WS_SGR : WS_SGA)) - (size_t)NTP * DM;
        const size_t off0 = (size_t)u.pm * 256 * DM + u.pn * 256;
        gb += off0; float* T1 = (float*)(ws + WS_K) + off0; bf16_t* MG = (bf16_t*)(ws + WS_XR) + off0;
        EPI_LOOP_BEGIN
            const size_t off = (size_t)rit * DM + cit;
            const u32x4 gw = *(const u32x4*)(gb + off);
            f32x4 s0, s1;
            s0[0] = sigmoidf_(bflo(gw.x)); s0[1] = sigmoidf_(bfhi(gw.x)); s0[2] = sigmoidf_(bflo(gw.y)); s0[3] = sigmoidf_(bfhi(gw.y));
            s1[0] = sigmoidf_(bflo(gw.z)); s1[1] = sigmoidf_(bfhi(gw.z)); s1[2] = sigmoidf_(bflo(gw.w)); s1[3] = sigmoidf_(bfhi(gw.w));
            if (u.kind == 0) { *(f32x4*)(T1 + off) = s0 * v0; *(f32x4*)(T1 + off + 4) = s1 * v1; }
            else { const f32x4 a0 = *(const f32x4*)(T1 + off) + s0 * v0, a1 = *(const f32x4*)(T1 + off + 4) + s1 * v1;
                u32x4 w; w.x = cvtpk(a0[0], a0[1]); w.y = cvtpk(a0[2], a0[3]); w.z = cvtpk(a1[0], a1[1]); w.w = cvtpk(a1[2], a1[3]);
                *(u32x4*)(MG + off) = w; }
        EPI_LOOP_END
    }
};

struct EpiP4 {
    __device__ __forceinline__ void operator()(const f32x4 (&acc)[2][2][4][2], const Unit& u, int wr, int wc, int fr, int fq) const {
        EPI_PREP float* out = A_OUT;
        if (u.pm < 256) { const size_t off0 = (size_t)u.pm * 256 * DM + u.pn * 256; const float* xp = A_IN(0) + off0; float* yo = out + O_YP + off0;
            EPI_LOOP_BEGIN const size_t off = (size_t)rit * DM + cit;
                *(f32x4*)(yo + off) = *(const f32x4*)(xp + off) + v0; *(f32x4*)(yo + off + 4) = *(const f32x4*)(xp + off + 4) + v1; EPI_LOOP_END }
        else { const float* xs = A_IN(1) + u.pn * 256; float* yo = out + O_YS + u.pn * 256;
            EPI_LOOP_BEGIN if (rit < NTS) { const size_t off = (size_t)rit * DM + cit;
                *(f32x4*)(yo + off) = *(const f32x4*)(xs + off) + v0; *(f32x4*)(yo + off + 4) = *(const f32x4*)(xs + off + 4) + v1; } EPI_LOOP_END }
    }
};

struct EpiP5 {
    __device__ __forceinline__ void operator()(const f32x4 (&acc)[2][2][4][2], const Unit& u, int wr, int wc, int fr, int fq) const {
        EPI_PREP float* SC = (float*)(A_WS + WS_XN) + (size_t)u.pm * 256 * 2048 + u.pn * 256;
        EPI_LOOP_BEGIN
            float* p = SC + (size_t)rit * 2048 + cit; *(f32x4*)p = v0; *(f32x4*)(p + 4) = v1;
        EPI_LOOP_END
    }
};

__device__ __forceinline__ void p0_transpose_item(const float* W, int K, int N, bf16_t* WT, LAS float* scr, int item, int lane, int nscale = 0) {
    const int nblk = N / 32, kb = item / nblk, nb = item % nblk, k0 = 64 * kb, n0 = 32 * nb;
#pragma unroll 8
    for (int i = 0; i < 32; ++i) { const int kk = 2 * i + (lane >> 5); scr[kk * 33 + (lane & 31)] = W[(size_t)(k0 + kk) * N + n0 + (lane & 31)] * (n0 < nscale ? QSCALE : 1.0f); }
    asm volatile("s_waitcnt lgkmcnt(0)" ::: "memory");
    const int c = lane & 7;
#pragma unroll
    for (int j = 0; j < 4; ++j) { const int n = (lane >> 3) + 8 * j; const LAS float* s = scr + (8 * c) * 33 + n;
        u32x4 o; o.x = cvtpk(s[0 * 33], s[1 * 33]); o.y = cvtpk(s[2 * 33], s[3 * 33]); o.z = cvtpk(s[4 * 33], s[5 * 33]); o.w = cvtpk(s[6 * 33], s[7 * 33]);
        *(u32x4*)(WT + (size_t)(n0 + n) * K + k0 + 8 * c) = o; }
    asm volatile("s_waitcnt lgkmcnt(0)" ::: "memory");
}

__device__ __forceinline__ void p0_prologue(LAS unsigned char* lds, int G, int wave, int lane) {
    unsigned char* ws = A_WS;
    const int gw = blockIdx.x * 8 + wave, NGW = G * 8;
    LAS float* scr = (LAS float*)(lds + wave * 16384);
    constexpr int I_IN = 16 * (INC / 32), I_SQ = 16 * 32, NTR = I_IN + 3 * I_SQ;
    for (int it = gw; it < NTR; it += NGW) {
        int r = it;
        if (r < I_IN) { p0_transpose_item(A_IN(7), DM, INC, (bf16_t*)(ws + WS_WIN), scr, r, lane, 1024); continue; } r -= I_IN;
        if (r < I_SQ) { p0_transpose_item(A_IN(16), DM, DM, (bf16_t*)(ws + WS_WBA), scr, r, lane); continue; } r -= I_SQ;
        if (r < I_SQ) { p0_transpose_item(A_IN(17), DM, DM, (bf16_t*)(ws + WS_WBL), scr, r, lane); continue; } r -= I_SQ;
        p0_transpose_item(A_IN(18), DM, DM, (bf16_t*)(ws + WS_WO), scr, r, lane);
    }
    {
        const float* wq = A_IN(20); bf16_t* wst = (bf16_t*)(ws + WS_WS);
        const int r32 = lane & 31, hi = lane >> 5;
        for (int it = gw; it < 2048; it += NGW) {
            const int hj = it >> 7, kt = (it >> 5) & 3, ct = it & 31, h = hj >> 1, j = hj & 1;
            const float* ap = (j ? A_IN(22) : A_IN(21)) + ((size_t)(h * 128 + kt * 32 + r32)) * 128 + 64 * hi;
            const float* bp = wq + (size_t)(ct * 32 + r32) * 2048 + hj * 128 + 64 * hi;
            f32x16 acc = {};
#pragma unroll
            for (int s4 = 0; s4 < 16; ++s4) { const f32x4 av = *(const f32x4*)(ap + 4 * s4), bv = *(const f32x4*)(bp + 4 * s4);
                acc = __builtin_amdgcn_mfma_f32_32x32x2f32(av[0], bv[0], acc, 0, 0, 0); acc = __builtin_amdgcn_mfma_f32_32x32x2f32(av[1], bv[1], acc, 0, 0, 0);
                acc = __builtin_amdgcn_mfma_f32_32x32x2f32(av[2], bv[2], acc, 0, 0, 0); acc = __builtin_amdgcn_mfma_f32_32x32x2f32(av[3], bv[3], acc, 0, 0, 0); }
#pragma unroll
            for (int r = 0; r < 16; ++r) { const int key = kt * 32 + (r & 3) + 8 * (r >> 2) + 4 * hi;
                wst[(size_t)(hj * 128 + key) * DM + ct * 32 + r32] = (bf16_t)(cvtpk(acc[r], 0.f) & 0xffffu); }
        }
    }
    for (int it = gw; it < 2 * NEXP; it += NGW) {
        const int tb = it >= NEXP, e = it - tb * NEXP;
        const float* src = (tb ? A_IN(24) : A_IN(23)) + (size_t)e * DM + lane * 16;
        unsigned char* dst = ws + (tb ? WS_VB : WS_UB) + (size_t)e * DM + lane * 16;
        f32x4 p[4]; float mx = 0.f;
#pragma unroll
        for (int q = 0; q < 4; ++q) { p[q] = *(const f32x4*)(src + 4 * q); mx = fmaxf(mx, fmaxf(fmaxf(fabsf(p[q][0]), fabsf(p[q][1])), fmaxf(fabsf(p[q][2]), fabsf(p[q][3])))); }
#pragma unroll
        for (int o = 1; o < 64; o <<= 1) mx = fmaxf(mx, __shfl_xor(mx, o));
        const float step = fmaxf(mx, 1e-30f) * (1.0f / 127.0f), inv = 1.0f / step;
        u32x4 w;
#pragma unroll
        for (int q = 0; q < 4; ++q) {
            const int ob = tb ? 128 : 0;
            const unsigned b0 = (unsigned)((int)rintf(p[q][0] * inv) + ob) & 0xffu, b1 = (unsigned)((int)rintf(p[q][1] * inv) + ob) & 0xffu, b2 = (unsigned)((int)rintf(p[q][2] * inv) + ob) & 0xffu, b3 = (unsigned)((int)rintf(p[q][3] * inv) + ob) & 0xffu;
            w[q] = b0 | (b1 << 8) | (b2 << 16) | (b3 << 24); }
        *(u32x4*)dst = w;
        if (lane == 0) ((float*)(ws + (tb ? WS_SV : WS_SU)))[e] = step;
    }
    {
        const float* gm = A_IN(6); bf16_t* XN = (bf16_t*)(ws + WS_XN);
        for (int m = gw; m < ROWS; m += NGW) {
            bf16_t* orow = XN + (size_t)m * DM;
            if (m >= NTOK) {
#pragma unroll
                for (int j = 0; j < 2; ++j) *(u32x4*)(orow + j * 512 + lane * 8) = (u32x4){0u, 0u, 0u, 0u};
                continue; }
            const float* xr = (m < NTP) ? A_IN(0) + (size_t)m * DM : A_IN(1) + (size_t)(m - NTP) * DM;
            f32x4 v[4]; float s = 0.f;
#pragma unroll
            for (int j = 0; j < 4; ++j) { v[j] = *(const f32x4*)(xr + j * 256 + lane * 4); s += (v[j][0] * v[j][0] + v[j][1] * v[j][1]) + (v[j][2] * v[j][2] + v[j][3] * v[j][3]); }
            const float inv = 1.0f / sqrtf(wave_sum(s) * (1.0f / DM) + EPS);
#pragma unroll
            for (int j = 0; j < 4; ++j) { const f32x4 gg = *(const f32x4*)(gm + j * 256 + lane * 4); const f32x4 y = v[j] * inv * gg;
                u32x2 w; w.x = cvtpk(y[0], y[1]); w.y = cvtpk(y[2], y[3]); *(u32x2*)(orow + j * 256 + lane * 4) = w; }
        }
    }
    {
        bf16_t* fw = (bf16_t*)(ws + WS_LRUW);
        for (int f = gw; f < 256; f += NGW) {
            const int ks = f & 3, T = (f >> 2) & 1, gate = (f >> 3) & 1, g = f >> 4, i = lane & 31, hi = lane >> 5;
            const int outc = 32 * T + swap23(i);
            const float* W = (gate ? A_IN(13) : A_IN(11)) + (size_t)g * 4096;
            float x[8];
#pragma unroll
            for (int j = 0; j < 8; ++j) x[j] = W[(16 * ks + 8 * hi + j) * 64 + outc];
            u32x4 w; w.x = cvtpk(x[0], x[1]); w.y = cvtpk(x[2], x[3]); w.z = cvtpk(x[4], x[5]); w.w = cvtpk(x[6], x[7]);
            *(u32x4*)(fw + (size_t)f * 512 + lane * 8) = w;
        }
    }
}

constexpr int LR_WF = 0, LR_CW = 16384, LR_CB = LR_CW + 1024, LR_BR = LR_CB + 256, LR_BI = LR_BR + 256, LR_CS = LR_BI + 256, LR_CARRY = LR_CS + 256, LR_SEQ = LR_CARRY + 2048, LR_END = LR_SEQ + 64;

__device__ __forceinline__ void lru_load_consts(LAS unsigned char* lds, int g, int tid) {
    const u32x4* src = (const u32x4*)(A_WS + WS_LRUW + (size_t)g * 16384);
    for (int i = tid; i < 1024; i += 512) ((LAS u32x4*)(lds + LR_WF))[i] = src[i];
    if (tid < 256) ((LAS float*)(lds + LR_CW))[tid] = A_IN(9)[(tid >> 6) * DM + g * 64 + (tid & 63)];
    if (tid < 64) {
        const int c = g * 64 + tid;
        ((LAS float*)(lds + LR_CB))[tid] = A_IN(10)[c]; ((LAS float*)(lds + LR_BR))[tid] = A_IN(12)[c]; ((LAS float*)(lds + LR_BI))[tid] = A_IN(14)[c];
        ((LAS float*)(lds + LR_CS))[tid] = 8.0f * log1pf(expf(-A_IN(15)[c]));
    }
    if (tid < 8) ((LAS unsigned*)(lds + LR_SEQ))[tid] = 0xffffffffu;
}

template <bool SAMPLE>
__device__ __forceinline__ void lru_tile(LAS unsigned char* lds, int lane, int g, size_t rowbase, int tile, int bidx) {
    asm volatile("" : "+v"(lane));
    const int tl = lane & 31, hi = lane >> 5, t = tile * 32 + tl;
    const bf16_t* XR = (const bf16_t*)(A_WS + WS_XR); bf16_t* Gb = (bf16_t*)(A_WS + WS_G);
    const int cbase = g * 64 + 8 * hi;
    float xc[4][8];
    bf16x8 xf[4];
#pragma unroll
    for (int ks = 0; ks < 4; ++ks) {
        const f32x4 b0 = *(const LAS f32x4*)(lds + LR_CB + (16 * ks + 8 * hi) * 4), b1 = *(const LAS f32x4*)(lds + LR_CB + (16 * ks + 8 * hi) * 4 + 16);
#pragma unroll
        for (int j = 0; j < 4; ++j) { xc[ks][j] = b0[j]; xc[ks][4 + j] = b1[j]; }
#pragma unroll
        for (int tap = 0; tap < 4; ++tap) {
            const int rr = t - 3 + tap;
            float xv[8];
            {
                u32x4 w = *(const u32x4*)(XR + (rowbase + (rr < 0 ? 0 : rr)) * DM + cbase + 16 * ks);
                if (rr < 0) w = (u32x4){0u, 0u, 0u, 0u};
                xv[0] = bflo(w.x); xv[1] = bfhi(w.x); xv[2] = bflo(w.y); xv[3] = bfhi(w.y); xv[4] = bflo(w.z); xv[5] = bfhi(w.z); xv[6] = bflo(w.w); xv[7] = bfhi(w.w);
            }
            if (SAMPLE) {
                const float* sp = A_IN(4) + ((size_t)bidx * 3 + (rr < 0 ? 3 + rr : 0)) * DM + cbase + 16 * ks;
                const f32x4 p = *(const f32x4*)sp, q = *(const f32x4*)(sp + 4);
#pragma unroll
                for (int j = 0; j < 4; ++j) { xv[j] = rr < 0 ? p[j] : xv[j]; xv[4 + j] = rr < 0 ? q[j] : xv[4 + j]; }
            }
            const f32x4 w0 = *(const LAS f32x4*)(lds + LR_CW + (tap * 64 + 16 * ks + 8 * hi) * 4), w1 = *(const LAS f32x4*)(lds + LR_CW + (tap * 64 + 16 * ks + 8 * hi) * 4 + 16);
#pragma unroll
            for (int j = 0; j < 4; ++j) { xc[ks][j] += w0[j] * xv[j]; xc[ks][4 + j] += w1[j] * xv[4 + j]; }
        }
        u32x4 w; w.x = cvtpk(xc[ks][0], xc[ks][1]); w.y = cvtpk(xc[ks][2], xc[ks][3]); w.z = cvtpk(xc[ks][4], xc[ks][5]); w.w = cvtpk(xc[ks][6], xc[ks][7]);
        xf[ks] = __builtin_bit_cast(bf16x8, w);
        asm volatile("" ::: "memory");
    }
    float A[32], B[32];
#pragma unroll
    for (int T = 0; T < 2; ++T) {
        f32x16 ar = f32x16{}, ai = f32x16{};
#pragma unroll
        for (int ks = 0; ks < 4; ++ks) {
            const bf16x8 wr_ = *(const LAS bf16x8*)(lds + LR_WF + ((0 * 2 + T) * 4 + ks) * 1024 + lane * 16);
            const bf16x8 wi_ = *(const LAS bf16x8*)(lds + LR_WF + ((1 * 2 + T) * 4 + ks) * 1024 + lane * 16);
            ar = __builtin_amdgcn_mfma_f32_32x32x16_bf16(wr_, xf[ks], ar, 0, 0, 0);
            ai = __builtin_amdgcn_mfma_f32_32x32x16_bf16(wi_, xf[ks], ai, 0, 0, 0);
        }
#pragma unroll
        for (int q = 0; q < 2; ++q) {
            const int ks = 2 * T + q, lo = (16 * ks + 8 * hi) * 4;
            const f32x4 br0 = *(const LAS f32x4*)(lds + LR_BR + lo), br1 = *(const LAS f32x4*)(lds + LR_BR + lo + 16);
            const f32x4 bi0 = *(const LAS f32x4*)(lds + LR_BI + lo), bi1 = *(const LAS f32x4*)(lds + LR_BI + lo + 16);
            const f32x4 cs0 = *(const LAS f32x4*)(lds + LR_CS + lo), cs1 = *(const LAS f32x4*)(lds + LR_CS + lo + 16);
#pragma unroll
            for (int j = 0; j < 8; ++j) {
                const int r = 8 * q + j;
                const float brv = j < 4 ? br0[j & 3] : br1[j & 3], biv = j < 4 ? bi0[j & 3] : bi1[j & 3], csv = j < 4 ? cs0[j & 3] : cs1[j & 3];
                const float rg = sigmoidf_(ar[r] + brv), ig = sigmoidf_(ai[r] + biv);
                const float la = -csv * rg, av = fast_exp2(la * LOG2E);
                const float x2 = 2.0f * la;
                const float em = (x2 > -0.03f) ? -x2 * (1.0f + x2 * (0.5f + x2 * (0.16666667f + x2 * 0.041666668f))) : 1.0f - fast_exp2(x2 * LOG2E);
                A[16 * T + r] = av; B[16 * T + r] = sqrtf(em) * ig * xc[ks][j];
            }
        }
        asm volatile("" ::: "memory");
    }
#define LRU_STEP(CTRL, RM) _Pragma("unroll") for (int c = 0; c < 32; ++c) { \
        const float as_ = __builtin_bit_cast(float, __builtin_amdgcn_update_dpp(__builtin_bit_cast(int, 1.0f), __builtin_bit_cast(int, A[c]), CTRL, RM, 0xF, false)); \
        const float bs_ = __builtin_bit_cast(float, __builtin_amdgcn_update_dpp(0, __builtin_bit_cast(int, B[c]), CTRL, RM, 0xF, false)); \
        B[c] = A[c] * bs_ + B[c]; A[c] = A[c] * as_; }
    LRU_STEP(0x111, 0xF) LRU_STEP(0x112, 0xF) LRU_STEP(0x114, 0xF) LRU_STEP(0x118, 0xF) LRU_STEP(0x142, 0xA)
#undef LRU_STEP
    float hin[32];
    if (SAMPLE) {
        const float* hp = A_IN(5) + (size_t)bidx * DM + cbase;
#pragma unroll
        for (int ks = 0; ks < 4; ++ks) { const f32x4 p = *(const f32x4*)(hp + 16 * ks), q = *(const f32x4*)(hp + 16 * ks + 4);
#pragma unroll
            for (int j = 0; j < 4; ++j) { hin[8 * ks + j] = p[j]; hin[8 * ks + 4 + j] = q[j]; } }
    } else if (tile == 0) {
#pragma unroll
        for (int c = 0; c < 32; ++c) hin[c] = 0.f;
    } else {
        volatile LAS unsigned* sq = (volatile LAS unsigned*)(lds + LR_SEQ) + (tile & 7);
        while (*sq != (unsigned)tile) __builtin_amdgcn_s_sleep(1);
        asm volatile("" ::: "memory");
        const LAS float* cp = (const LAS float*)(lds + LR_CARRY) + (tile & 7) * 64 + 8 * hi;
#pragma unroll
        for (int ks = 0; ks < 4; ++ks) { const f32x4 p = *(const LAS f32x4*)(cp + 16 * ks), q = *(const LAS f32x4*)(cp + 16 * ks + 4);
#pragma unroll
            for (int j = 0; j < 4; ++j) { hin[8 * ks + j] = p[j]; hin[8 * ks + 4 + j] = q[j]; } }
    }
#pragma unroll
    for (int c = 0; c < 32; ++c) B[c] = B[c] + A[c] * hin[c];
    if (!SAMPLE) {
        if (tl == 31) {
            if (tile < 127) {
                LAS float* cp = (LAS float*)(lds + LR_CARRY) + ((tile + 1) & 7) * 64 + 8 * hi;
#pragma unroll
                for (int ks = 0; ks < 4; ++ks) { *(LAS f32x4*)(cp + 16 * ks) = (f32x4){B[8 * ks], B[8 * ks + 1], B[8 * ks + 2], B[8 * ks + 3]};
                    *(LAS f32x4*)(cp + 16 * ks + 4) = (f32x4){B[8 * ks + 4], B[8 * ks + 5], B[8 * ks + 6], B[8 * ks + 7]}; }
            } else {
                float* lp = A_OUT + O_LP + (size_t)bidx * DM + cbase;
#pragma unroll
                for (int ks = 0; ks < 4; ++ks) { *(f32x4*)(lp + 16 * ks) = (f32x4){B[8 * ks], B[8 * ks + 1], B[8 * ks + 2], B[8 * ks + 3]};
                    *(f32x4*)(lp + 16 * ks + 4) = (f32x4){B[8 * ks + 4], B[8 * ks + 5], B[8 * ks + 6], B[8 * ks + 7]}; }
            }
        }
        if (tile < 127) {
            asm volatile("s_waitcnt lgkmcnt(0)" ::: "memory");
            if (lane == 63) *((volatile LAS unsigned*)(lds + LR_SEQ) + ((tile + 1) & 7)) = (unsigned)(tile + 1);
        }
    } else if (tl == 15) {
        float* lp = A_OUT + O_LS + (size_t)bidx * DM + cbase;
#pragma unroll
        for (int ks = 0; ks < 4; ++ks) { *(f32x4*)(lp + 16 * ks) = (f32x4){B[8 * ks], B[8 * ks + 1], B[8 * ks + 2], B[8 * ks + 3]};
            *(f32x4*)(lp + 16 * ks + 4) = (f32x4){B[8 * ks + 4], B[8 * ks + 5], B[8 * ks + 6], B[8 * ks + 7]}; }
    }
    if (!SAMPLE || tl < NST) {
        bf16_t* gp = Gb + (rowbase + t) * DM + cbase;
#pragma unroll
        for (int ks = 0; ks < 4; ++ks) {
            const u32x4 w = *(const u32x4*)(gp + 16 * ks);
            float gv[8]; gv[0] = bflo(w.x); gv[1] = bfhi(w.x); gv[2] = bflo(w.y); gv[3] = bfhi(w.y); gv[4] = bflo(w.z); gv[5] = bfhi(w.z); gv[6] = bflo(w.w); gv[7] = bfhi(w.w);
            float o[8];
#pragma unroll
            for (int j = 0; j < 8; ++j) o[j] = B[8 * ks + j] * gelu_tanh(gv[j]);
            u32x4 ow; ow.x = cvtpk(o[0], o[1]); ow.y = cvtpk(o[2], o[3]); ow.z = cvtpk(o[4], o[5]); ow.w = cvtpk(o[6], o[7]);
            *(u32x4*)(gp + 16 * ks) = ow;
        }
    }
}

constexpr int AT_TAB = 24576;
__device__ __forceinline__ void attn_unit(LAS unsigned char* lds, int lane, int b, int c, int h) {
    const int r32 = lane & 31, hi = lane >> 5, kr = swap23(r32);
    const bf16_t* Q = (const bf16_t*)(A_WS + WS_Q); const bf16_t* Kb = (const bf16_t*)(A_WS + WS_K); const bf16_t* VT = (const bf16_t*)(A_WS + WS_VT); bf16_t* O = (bf16_t*)(A_WS + WS_XN);
    const size_t row0 = (size_t)b * SEQ + (size_t)c * 64;
    bf16x8 qf[2][4];
#pragma unroll
    for (int qb = 0; qb < 2; ++qb)
#pragma unroll
        for (int ks = 0; ks < 4; ++ks) qf[qb][ks] = *(const bf16x8*)(Q + (row0 + qb * 32 + r32) * DM + h * 64 + ks * 16 + hi * 8);
    f32x16 o[2][2];
#pragma unroll
    for (int i = 0; i < 2; ++i)
#pragma unroll
        for (int j = 0; j < 2; ++j) o[i][j] = f32x16{};
    float mrow[2] = {-1e30f, -1e30f}, lrow[2] = {0.f, 0.f};
    const LAS float* tab = (const LAS float*)(lds + AT_TAB) + h * 320;
    const float cfar = tab[256];
    const int sb0 = (c >= 8 ? c - 8 : 0) * 2, sb1 = c * 2 + 1;
    const bf16_t* kbase = Kb + ((size_t)b * SEQ + kr) * DM + h * 64 + hi * 8;
    const bf16_t* vbase = VT + (size_t)(h * 64 + kr) * ROWS + (size_t)b * SEQ + hi * 8;
    bf16x8 kf[4], vf[2][2];
#pragma unroll
    for (int ks = 0; ks < 4; ++ks) kf[ks] = *(const bf16x8*)(kbase + (size_t)sb0 * 32 * DM + ks * 16);
#pragma unroll
    for (int db = 0; db < 2; ++db)
#pragma unroll
        for (int s = 0; s < 2; ++s) vf[db][s] = *(const bf16x8*)(vbase + (size_t)db * 32 * ROWS + sb0 * 32 + s * 16);
    for (int sb = sb0; sb <= sb1; ++sb) {
        const int sbn = sb < sb1 ? sb + 1 : sb;
        f32x16 S[2];
#pragma unroll
        for (int qb = 0; qb < 2; ++qb) { S[qb] = f32x16{};
#pragma unroll
            for (int ks = 0; ks < 4; ++ks) S[qb] = __builtin_amdgcn_mfma_f32_32x32x16_bf16(kf[ks], qf[qb][ks], S[qb], 0, 0, 0); }
        asm volatile("" ::: "memory");
#pragma unroll
        for (int ks = 0; ks < 4; ++ks) kf[ks] = *(const bf16x8*)(kbase + (size_t)sbn * 32 * DM + ks * 16);
        const int delta = c - (sb >> 1), rb = sb & 1;
        if (delta >= 3) {
#pragma unroll
            for (int qb = 0; qb < 2; ++qb)
#pragma unroll
                for (int r = 0; r < 16; ++r) S[qb][r] += cfar;
        } else {
#pragma unroll
            for (int qb = 0; qb < 2; ++qb) {
                const LAS float* tp = tab + (64 * delta + 32 * qb + r32 + 128 - 32 * rb - 8 * hi - 23);
#pragma unroll
                for (int r = 0; r < 16; ++r) S[qb][r] += tp[23 - (16 * (r >> 3) + (r & 7))];
            }
        }
        float rm[2];
#pragma unroll
        for (int qb = 0; qb < 2; ++qb) { float mx = S[qb][0];
#pragma unroll
            for (int r = 1; r < 16; ++r) mx = fmaxf(mx, S[qb][r]);
            rm[qb] = plswap_max(mx); }
        if (__any((rm[0] > mrow[0] + 8.0f) || (rm[1] > mrow[1] + 8.0f))) {
#pragma unroll
            for (int qb = 0; qb < 2; ++qb) { const float mn = fmaxf(mrow[qb], rm[qb]); const float al = fast_exp2(mrow[qb] - mn); lrow[qb] *= al; mrow[qb] = mn;
#pragma unroll
                for (int r = 0; r < 16; ++r) { o[0][qb][r] *= al; o[1][qb][r] *= al; } }
        }
        bf16x8 pf[2][2];
#pragma unroll
        for (int qb = 0; qb < 2; ++qb) { float sum = 0.f;
#pragma unroll
            for (int r = 0; r < 16; ++r) { S[qb][r] = fast_exp2(S[qb][r] - mrow[qb]); sum += S[qb][r]; }
            lrow[qb] += sum;
#pragma unroll
            for (int s = 0; s < 2; ++s) { u32x4 w; w.x = cvtpk(S[qb][8 * s], S[qb][8 * s + 1]); w.y = cvtpk(S[qb][8 * s + 2], S[qb][8 * s + 3]); w.z = cvtpk(S[qb][8 * s + 4], S[qb][8 * s + 5]); w.w = cvtpk(S[qb][8 * s + 6], S[qb][8 * s + 7]);
                pf[qb][s] = __builtin_bit_cast(bf16x8, w); } }
#pragma unroll
        for (int db = 0; db < 2; ++db)
#pragma unroll
            for (int qb = 0; qb < 2; ++qb)
#pragma unroll
                for (int s = 0; s < 2; ++s) o[db][qb] = __builtin_amdgcn_mfma_f32_32x32x16_bf16(vf[db][s], pf[qb][s], o[db][qb], 0, 0, 0);
        asm volatile("" ::: "memory");
#pragma unroll
        for (int db = 0; db < 2; ++db)
#pragma unroll
            for (int s = 0; s < 2; ++s) vf[db][s] = *(const bf16x8*)(vbase + (size_t)db * 32 * ROWS + sbn * 32 + s * 16);
    }
#pragma unroll
    for (int qb = 0; qb < 2; ++qb) { const float inv = fast_rcp(plswap_add(lrow[qb]));
        bf16_t* op = O + (row0 + qb * 32 + r32) * DM + h * 64 + 8 * hi;
#pragma unroll
        for (int db = 0; db < 2; ++db)
#pragma unroll
            for (int s = 0; s < 2; ++s) { u32x4 w;
                w.x = cvtpk(o[db][qb][8 * s] * inv, o[db][qb][8 * s + 1] * inv); w.y = cvtpk(o[db][qb][8 * s + 2] * inv, o[db][qb][8 * s + 3] * inv);
                w.z = cvtpk(o[db][qb][8 * s + 4] * inv, o[db][qb][8 * s + 5] * inv); w.w = cvtpk(o[db][qb][8 * s + 6] * inv, o[db][qb][8 * s + 7] * inv);
                *(u32x4*)(op + 32 * db + 16 * s) = w; } }
}

constexpr int AS_P = 45056;
__device__ __forceinline__ void attn_sample_task(LAS unsigned char* lds, int wave, int lane, int task) {
    const int bs = task >> 6, h = (task >> 2) & 15, qg = task & 3;
    const bf16_t* Q = (const bf16_t*)(A_WS + WS_Q); bf16_t* O = (bf16_t*)(A_WS + WS_XN);
    const float* ck = A_IN(2); const float* cv = A_IN(3); const float* kn = A_OUT + O_KS; const float* vn = A_OUT + O_VS;
    LAS float* pb = (LAS float*)(lds + AS_P + wave * 9472);
    LAS float* qs = pb + 4 * 528;
    const LAS float* tab = (const LAS float*)(lds + AT_TAB) + h * 320;
#pragma unroll
    for (int i = 0; i < 4; ++i) qs[i * 64 + lane] = bflo((unsigned)Q[((size_t)NTP + bs * 16 + qg * 4 + i) * DM + h * 64 + lane]);
    asm volatile("s_waitcnt lgkmcnt(0)" ::: "memory");
#pragma unroll 1
    for (int it = 0; it < 9; ++it) {
        const int key = it * 64 + lane; const bool valid = key < 528;
        const float* kp = !valid ? ck : (key < 512 ? ck + (((size_t)bs * 512 + key) * 16 + h) * 64 : kn + ((size_t)bs * 16 + (key - 512)) * DM + h * 64);
        float d[4] = {0.f, 0.f, 0.f, 0.f};
#pragma unroll 4
        for (int d4 = 0; d4 < 16; ++d4) { const f32x4 kv = *(const f32x4*)(kp + 4 * d4);
#pragma unroll
            for (int i = 0; i < 4; ++i) { const f32x4 qq = *(const LAS f32x4*)(qs + i * 64 + 4 * d4); d[i] += (kv[0] * qq[0] + kv[1] * qq[1]) + (kv[2] * qq[2] + kv[3] * qq[3]); } }
        int rel = 512 + qg * 4 - key;
        if (valid) {
#pragma unroll
            for (int i = 0; i < 4; ++i) { int r = rel + i; r = r > 128 ? 128 : r; pb[i * 528 + key] = d[i] + tab[r + 128]; } }
    }
    asm volatile("s_waitcnt lgkmcnt(0)" ::: "memory");
#pragma unroll 1
    for (int i = 0; i < 4; ++i) {
        float mx = -1e30f;
#pragma unroll 1
        for (int key = lane; key < 528; key += 64) mx = fmaxf(mx, pb[i * 528 + key]);
#pragma unroll
        for (int o = 1; o < 64; o <<= 1) mx = fmaxf(mx, __shfl_xor(mx, o));
        float sum = 0.f;
#pragma unroll 1
        for (int key = lane; key < 528; key += 64) { const float pv = fast_exp2(pb[i * 528 + key] - mx); pb[i * 528 + key] = pv; sum += pv; }
        sum = wave_sum(sum); const float inv = 1.0f / sum;
#pragma unroll 1
        for (int key = lane; key < 528; key += 64) pb[i * 528 + key] *= inv;
    }
    asm volatile("s_waitcnt lgkmcnt(0)" ::: "memory");
    float acc[4] = {0.f, 0.f, 0.f, 0.f};
#pragma unroll 4
    for (int key = 0; key < 528; ++key) {
        const float v = key < 512 ? cv[(((size_t)bs * 512 + key) * 16 + h) * 64 + lane] : vn[((size_t)bs * 16 + (key - 512)) * DM + h * 64 + lane];
#pragma unroll
        for (int i = 0; i < 4; ++i) acc[i] += pb[i * 528 + key] * v;
    }
#pragma unroll
    for (int i = 0; i < 4; ++i) O[((size_t)NTP + bs * 16 + qg * 4 + i) * DM + h * 64 + lane] = (bf16_t)(cvtpk(acc[i], 0.f) & 0xffffu);
    asm volatile("s_waitcnt lgkmcnt(0)" ::: "memory");
}

__device__ __forceinline__ void p2_phase(LAS unsigned char* lds, int G, int tid, int wave, int lane) {
    for (int i = tid; i < 16 * 320; i += 512) { const int h = i / 320, j = i % 320; ((LAS float*)(lds + AT_TAB))[i] = A_IN(8)[h * 257 + (j > 256 ? 256 : j)] * LOG2E; }
    for (int u = blockIdx.x; u < 256 + 16; u += G) {
        __syncthreads();
        if (u < 256) {
            const int b = u >> 4, g = u & 15;
            lru_load_consts(lds, g, tid);
            __syncthreads();
            for (int tile = wave; tile < 128; tile += 8) lru_tile<false>(lds, lane, g, (size_t)b * SEQ, tile, b);
        } else {
            const int g = u - 256;
            lru_load_consts(lds, g, tid);
            __syncthreads();
            lru_tile<true>(lds, lane, g, (size_t)NTP + wave * 16, 0, wave);
        }
    }
    __syncthreads();
    const int gw = blockIdx.x * 8 + wave, NGW = G * 8;
    for (int u = gw; u < NB * 64 * 16; u += NGW) {
        const int c = u & 63, h = (u >> 6) & 15, b = u >> 10;
        attn_unit(lds, lane, b, c, h);
    }
    for (int t = gw; t < 512; t += NGW) attn_sample_task(lds, wave, lane, t);
}

__device__ __forceinline__ void p4b_phase(int G, int wave, int lane) {
    const int gw = blockIdx.x * 8 + wave, NGW = G * 8;
    const float* gm = A_IN(19); bf16_t* XT = (bf16_t*)(A_WS + WS_Q); unsigned char* XQ = A_WS + WS_XQ; float* SX = (float*)(A_WS + WS_SX);
    for (int m = gw; m < NTOK; m += NGW) {
        const float* xr = (m < NTP) ? A_OUT + O_YP + (size_t)m * DM : A_OUT + O_YS + (size_t)(m - NTP) * DM;
        bf16_t* orow = XT + (size_t)m * DM;
        f32x4 v[4]; float s = 0.f;
#pragma unroll
        for (int j = 0; j < 4; ++j) { v[j] = *(const f32x4*)(xr + j * 256 + lane * 4); s += (v[j][0] * v[j][0] + v[j][1] * v[j][1]) + (v[j][2] * v[j][2] + v[j][3] * v[j][3]); }
        const float inv = 1.0f / sqrtf(wave_sum(s) * (1.0f / DM) + EPS);
        float mx = 0.f;
#pragma unroll
        for (int j = 0; j < 4; ++j) { const f32x4 gg = *(const f32x4*)(gm + j * 256 + lane * 4); v[j] = v[j] * inv * gg;
            u32x2 w; w.x = cvtpk(v[j][0], v[j][1]); w.y = cvtpk(v[j][2], v[j][3]); *(u32x2*)(orow + j * 256 + lane * 4) = w;
            mx = fmaxf(mx, fmaxf(fmaxf(fabsf(v[j][0]), fabsf(v[j][1])), fmaxf(fabsf(v[j][2]), fabsf(v[j][3])))); }
#pragma unroll
        for (int o = 1; o < 64; o <<= 1) mx = fmaxf(mx, __shfl_xor(mx, o));
        const float step = fmaxf(mx, 1e-30f) * (1.0f / 127.0f), qi = 1.0f / step;
#pragma unroll
        for (int j = 0; j < 4; ++j) {
            const unsigned b0 = (unsigned)(int)rintf(v[j][0] * qi) & 0xffu, b1 = (unsigned)(int)rintf(v[j][1] * qi) & 0xffu, b2 = (unsigned)(int)rintf(v[j][2] * qi) & 0xffu, b3 = (unsigned)(int)rintf(v[j][3] * qi) & 0xffu;
            *(unsigned*)(XQ + (size_t)m * DM + j * 256 + lane * 4) = b0 | (b1 << 8) | (b2 << 16) | (b3 << 24); }
        if (lane == 0) SX[m] = step;
    }
}

__device__ __forceinline__ int f2key(float f) { const int b = __float_as_int(f); return b ^ ((b >> 31) & 0x7fffffff); }
__device__ __forceinline__ float key2f(int k) { return __int_as_float(k ^ ((k >> 31) & 0x7fffffff)); }
#define INS16(L, x) do { int x_ = (x); _Pragma("unroll") for (int j_ = 0; j_ < 16; ++j_) { const int hi_ = max(L[j_], x_); x_ = min(L[j_], x_); L[j_] = hi_; } } while (0)

constexpr size_t WS_PART = WS_XN;
constexpr int CT_U = 64, CT_V = 64 + 8 * 64;
constexpr int P6_TOKB = 64, P6_NITEM = NTOK / P6_TOKB;
constexpr int P6_IDX = 0;
constexpr int P6_E = 0, P6_C = 8192, P6_ITEM = 16384;

__device__ __forceinline__ void p6a_phase(LAS unsigned char* lds, int G, int wave, int lane) {
    const int gw = blockIdx.x * 8 + wave, NGW = G * 8;
    const float* SC = (const float*)(A_WS + WS_XN);
    int* SELE = (int*)(A_WS + WS_SELE); float* SELG = (float*)(A_WS + WS_SELG);
    LAS int* idxb = (LAS int*)(lds + P6_IDX + wave * 4096);
    const int tl = lane >> 4, hh = (lane >> 1) & 7, half = lane & 1;
    for (int grp = gw; grp < NTOK / 4; grp += NGW) {
        const int tok = grp * 4 + tl;
        const float* sp = SC + (size_t)tok * 2048 + hh * 256 + half * 128;
        int L[16];
#pragma unroll
        for (int j = 0; j < 16; ++j) L[j] = (int)0x80000000;
        for (int c4 = 0; c4 < 32; c4 += 2) {
            const f32x4 v0 = *(const f32x4*)(sp + 4 * c4), v1 = *(const f32x4*)(sp + 4 * c4 + 4);
#pragma unroll
            for (int e = 0; e < 4; ++e) INS16(L, (f2key(v0[e]) & ~127) | (4 * c4 + e));
#pragma unroll
            for (int e = 0; e < 4; ++e) INS16(L, (f2key(v1[e]) & ~127) | (4 * c4 + 4 + e));
        }
#pragma unroll
        for (int j = 0; j < 16; ++j) idxb[lane * 16 + j] = L[j] & 127;
        float va[16], vb[16];
#pragma unroll
        for (int j = 0; j < 16; ++j) { const int own = L[j] & ~127, oth = __shfl_xor(own, 1); va[j] = key2f(half ? oth : own); vb[j] = key2f(half ? own : oth); }
        int C[16];
#pragma unroll
        for (int j = 0; j < 16; ++j) C[j] = (int)0x80000000;
#pragma unroll
        for (int i = 0; i < 16; ++i)
#pragma unroll
            for (int j = 0; j < 16; ++j) if ((i + 1) * (j + 1) <= 16) INS16(C, (f2key(va[i] + vb[j]) & ~255) | (i * 16 + j));
        const float mx = key2f(C[0] & ~255);
        float ev[16], sum = 0.f;
#pragma unroll
        for (int j = 0; j < 16; ++j) { ev[j] = __expf(key2f(C[j] & ~255) - mx); sum += ev[j]; }
        const float inv = 1.0f / sum;
        asm volatile("s_waitcnt lgkmcnt(0)" ::: "memory");
        int eo[8]; float go[8];
#pragma unroll
        for (int s = 0; s < 8; ++s) {
            int c_lo = C[s], c_hi = C[8 + s]; float e_lo = ev[s], e_hi = ev[8 + s];
            asm volatile("" : "+v"(c_lo), "+v"(c_hi), "+v"(e_lo), "+v"(e_hi));
            const int cc = half ? c_hi : c_lo; go[s] = (half ? e_hi : e_lo) * inv;
            const int ij = cc & 255, i1 = idxb[(lane & ~1) * 16 + (ij >> 4)], i2 = idxb[(lane | 1) * 16 + (ij & 15)];
            eo[s] = i1 * 128 + i2;
        }
        int* ep = SELE + (size_t)tok * 128 + hh * 16 + half * 8; float* gp = SELG + (size_t)tok * 128 + hh * 16 + half * 8;
        *(u32x4*)ep = (u32x4){(unsigned)eo[0], (unsigned)eo[1], (unsigned)eo[2], (unsigned)eo[3]}; *(u32x4*)(ep + 4) = (u32x4){(unsigned)eo[4], (unsigned)eo[5], (unsigned)eo[6], (unsigned)eo[7]};
        *(f32x4*)gp = (f32x4){go[0], go[1], go[2], go[3]}; *(f32x4*)(gp + 4) = (f32x4){go[4], go[5], go[6], go[7]};
        asm volatile("s_waitcnt lgkmcnt(0)" ::: "memory");
    }
}

__device__ __forceinline__ float dot2bf(unsigned a, unsigned b, float c) { return __builtin_amdgcn_fdot2_f32_bf16(__builtin_bit_cast(bf16x2_t, a), __builtin_bit_cast(bf16x2_t, b), c, false); }
__device__ __forceinline__ unsigned xcc_id() { return (unsigned)__builtin_amdgcn_s_getreg((3 << 11) | 20) & 0xFu; }
__device__ __forceinline__ float dpp_sum16(float v) {
    v += __builtin_bit_cast(float, __builtin_amdgcn_update_dpp(0, __builtin_bit_cast(int, v), 0xB1, 0xF, 0xF, true));
    v += __builtin_bit_cast(float, __builtin_amdgcn_update_dpp(0, __builtin_bit_cast(int, v), 0x4E, 0xF, 0xF, true));
    v += __builtin_bit_cast(float, __builtin_amdgcn_update_dpp(0, __builtin_bit_cast(int, v), 0x141, 0xF, 0xF, true));
    v += __builtin_bit_cast(float, __builtin_amdgcn_update_dpp(0, __builtin_bit_cast(int, v), 0x140, 0xF, 0xF, true));
    return v;
}
__device__ __forceinline__ bool p6_claim(LAS unsigned char* lds, unsigned* cnt, int tid, int& ring, int home, int& slice, int& item) {
    for (;;) {
        if (ring >= 8) return false;
        slice = (home + ring) & 7;
        __syncthreads();
        if (tid == 0) *(volatile LAS int*)(lds + P6_ITEM) = (int)__hip_atomic_fetch_add(cnt + 64 * slice, 1u, __ATOMIC_RELAXED, __HIP_MEMORY_SCOPE_AGENT);
        __syncthreads();
        item = *(volatile LAS int*)(lds + P6_ITEM);
        if (item < P6_NITEM) return true;
        ++ring;
    }
}

__device__ __forceinline__ float ub0(unsigned w) { return (float)(w & 0xffu); }
__device__ __forceinline__ float ub1(unsigned w) { return (float)((w >> 8) & 0xffu); }
__device__ __forceinline__ float ub2(unsigned w) { return (float)((w >> 16) & 0xffu); }
__device__ __forceinline__ float ub3(unsigned w) { return (float)(w >> 24); }
__device__ __forceinline__ float dpp_sum8(float v) {
    v += __builtin_bit_cast(float, __builtin_amdgcn_update_dpp(0, __builtin_bit_cast(int, v), 0xB1, 0xF, 0xF, true));
    v += __builtin_bit_cast(float, __builtin_amdgcn_update_dpp(0, __builtin_bit_cast(int, v), 0x4E, 0xF, 0xF, true));
    v += __builtin_bit_cast(float, __builtin_amdgcn_update_dpp(0, __builtin_bit_cast(int, v), 0x141, 0xF, 0xF, true));
    return v;
}
__device__ __forceinline__ int dpp_isum8(int v) {
    v += __builtin_amdgcn_update_dpp(0, v, 0xB1, 0xF, 0xF, true);
    v += __builtin_amdgcn_update_dpp(0, v, 0x4E, 0xF, 0xF, true);
    v += __builtin_amdgcn_update_dpp(0, v, 0x141, 0xF, 0xF, true);
    return v;
}
__device__ __forceinline__ void p6b_phase(LAS unsigned char* lds, int tid, int wave, int lane) {
    const unsigned char* XQ = A_WS + WS_XQ; const unsigned char* UB = A_WS + WS_UB; const float* SX = (const float*)(A_WS + WS_SX);
    const int* SELE = (const int*)(A_WS + WS_SELE); float* PART = (float*)(A_WS + WS_PART);
    unsigned* cnt = (unsigned*)(A_WS + WS_CTL) + CT_U;
    const int i8 = lane & 7, grp = lane >> 3, home = (int)(xcc_id() & 7u);
    LAS int* eb = (LAS int*)(lds + P6_E + wave * 1024);
    int ring = 0, slice, item;
    while (p6_claim(lds, cnt, tid, ring, home, slice, item)) {
        const int tok0 = item * P6_TOKB + wave * 8;
        int e0 = SELE[(size_t)tok0 * 128 + lane], e1 = SELE[(size_t)tok0 * 128 + 64 + lane];
        for (int ti = 0; ti < 8; ++ti) {
            const int tok = tok0 + ti;
            LAS int* ebt = eb + (ti & 1) * 128;
            ebt[lane] = e0; ebt[64 + lane] = e1;
            if (ti < 7) { e0 = SELE[(size_t)(tok + 1) * 128 + lane]; e1 = SELE[(size_t)(tok + 1) * 128 + 64 + lane]; }
            const u32x4 xq = *(const u32x4*)(XQ + (size_t)tok * DM + slice * 128 + i8 * 16);
            const int x0 = (int)xq.x, x1 = (int)xq.y, x2 = (int)xq.z, x3 = (int)xq.w;
            const float sx = SX[tok];
            const unsigned char* ub = UB + slice * 128 + i8 * 16;
            asm volatile("s_waitcnt lgkmcnt(0)" ::: "memory");
            u32x4 uv[16];
#pragma unroll
            for (int q = 0; q < 16; ++q) { const int e = ebt[16 * grp + q]; uv[q] = *(const u32x4*)(ub + (size_t)e * DM); }
            int res0 = 0, res1 = 0;
#pragma unroll
            for (int q = 0; q < 16; ++q) {
                const int a0 = (int)uv[q].x, a1 = (int)uv[q].y, a2 = (int)uv[q].z, a3 = (int)uv[q].w;
                int d = __builtin_amdgcn_sdot4(a0, x0, 0, false); d = __builtin_amdgcn_sdot4(a1, x1, d, false); d = __builtin_amdgcn_sdot4(a2, x2, d, false); d = __builtin_amdgcn_sdot4(a3, x3, d, false);
                d = dpp_isum8(d);
                if (q < 8) res0 = (i8 == q) ? d : res0; else res1 = (i8 == (q - 8)) ? d : res1;
            }
            float* pp = PART + ((size_t)slice * NTOK + tok) * 128 + 16 * grp + i8;
            pp[0] = (float)res0 * sx; pp[8] = (float)res1 * sx;
        }
    }
}

__device__ __forceinline__ void p6c_phase(LAS unsigned char* lds, int tid, int wave, int lane) {
    const unsigned char* VB = A_WS + WS_VB; const float* SU = (const float*)(A_WS + WS_SU); const float* SV = (const float*)(A_WS + WS_SV);
    const int* SELE = (const int*)(A_WS + WS_SELE); const float* SELG = (const float*)(A_WS + WS_SELG); const float* PART = (const float*)(A_WS + WS_PART);
    unsigned* cnt = (unsigned*)(A_WS + WS_CTL) + CT_V;
    float* out = A_OUT;
    const int i8 = lane & 7, grp = lane >> 3, home = (int)(xcc_id() & 7u);
    LAS int* eb = (LAS int*)(lds + P6_E + wave * 1024);
    LAS float* cb = (LAS float*)(lds + P6_C + wave * 512);
    int ring = 0, slice, item;
    while (p6_claim(lds, cnt, tid, ring, home, slice, item)) {
        const int tok0 = item * P6_TOKB + wave * 8;
        for (int ti = 0; ti < 8; ++ti) {
            const int tok = tok0 + ti;
            float a0 = 0.f, a1 = 0.f;
#pragma unroll
            for (int j = 0; j < 8; ++j) { const float* pp = PART + ((size_t)j * NTOK + tok) * 128; a0 += pp[lane]; a1 += pp[64 + lane]; }
            const int e0 = SELE[(size_t)tok * 128 + lane], e1 = SELE[(size_t)tok * 128 + 64 + lane];
            const float c0 = SELG[(size_t)tok * 128 + lane] * gelu_tanh(a0 * SU[e0]) * SV[e0], c1 = SELG[(size_t)tok * 128 + 64 + lane] * gelu_tanh(a1 * SU[e1]) * SV[e1];
            eb[lane] = e0; eb[64 + lane] = e1; cb[lane] = c0; cb[64 + lane] = c1;
            const float off = -128.0f * wave_sum(c0 + c1);
            const unsigned char* vb = VB + slice * 128 + i8 * 16;
            asm volatile("s_waitcnt lgkmcnt(0)" ::: "memory");
            float acc[16];
#pragma unroll
            for (int r = 0; r < 16; ++r) acc[r] = 0.f;
#pragma unroll
            for (int s8 = 0; s8 < 16; s8 += 8) {
                u32x4 vv[8]; float cf[8];
#pragma unroll
                for (int q = 0; q < 8; ++q) { const int e = eb[16 * grp + s8 + q]; cf[q] = cb[16 * grp + s8 + q]; vv[q] = *(const u32x4*)(vb + (size_t)e * DM); }
#pragma unroll
                for (int q = 0; q < 8; ++q) {
                    acc[0] += cf[q] * ub0(vv[q].x); acc[1] += cf[q] * ub1(vv[q].x); acc[2] += cf[q] * ub2(vv[q].x); acc[3] += cf[q] * ub3(vv[q].x);
                    acc[4] += cf[q] * ub0(vv[q].y); acc[5] += cf[q] * ub1(vv[q].y); acc[6] += cf[q] * ub2(vv[q].y); acc[7] += cf[q] * ub3(vv[q].y);
                    acc[8] += cf[q] * ub0(vv[q].z); acc[9] += cf[q] * ub1(vv[q].z); acc[10] += cf[q] * ub2(vv[q].z); acc[11] += cf[q] * ub3(vv[q].z);
                    acc[12] += cf[q] * ub0(vv[q].w); acc[13] += cf[q] * ub1(vv[q].w); acc[14] += cf[q] * ub2(vv[q].w); acc[15] += cf[q] * ub3(vv[q].w);
                }
            }
#pragma unroll
            for (int r = 0; r < 16; ++r) { acc[r] += __shfl_xor(acc[r], 8); acc[r] += __shfl_xor(acc[r], 16); acc[r] += __shfl_xor(acc[r], 32); }
            if (lane < 8) {
                float* yr = ((tok < NTP) ? out + O_YP + (size_t)tok * DM : out + O_YS + (size_t)(tok - NTP) * DM) + slice * 128 + i8 * 16;
#pragma unroll
                for (int q = 0; q < 4; ++q) { f32x4 z = *(const f32x4*)(yr + 4 * q); z += (f32x4){acc[4 * q] + off, acc[4 * q + 1] + off, acc[4 * q + 2] + off, acc[4 * q + 3] + off}; *(f32x4*)(yr + 4 * q) = z; }
            }
            asm volatile("s_waitcnt lgkmcnt(0)" ::: "memory");
        }
    }
}

__device__ __forceinline__ void p6d_phase(int G, int wave, int lane) {
    const int gw = blockIdx.x * 8 + wave, NGW = G * 8;
    const float* gf = A_IN(25); float* out = A_OUT;
    for (int m = gw; m < NTOK; m += NGW) {
        float* yr = (m < NTP) ? out + O_YP + (size_t)m * DM : out + O_YS + (size_t)(m - NTP) * DM;
        f32x4 v[4]; float s = 0.f;
#pragma unroll
        for (int j = 0; j < 4; ++j) { v[j] = *(const f32x4*)(yr + j * 256 + lane * 4); s += (v[j][0] * v[j][0] + v[j][1] * v[j][1]) + (v[j][2] * v[j][2] + v[j][3] * v[j][3]); }
        const float inv = 1.0f / sqrtf(wave_sum(s) * (1.0f / DM) + EPS);
#pragma unroll
        for (int j = 0; j < 4; ++j) { const f32x4 gg = *(const f32x4*)(gf + j * 256 + lane * 4); *(f32x4*)(yr + j * 256 + lane * 4) = v[j] * inv * gg; }
    }
}

#define XB_TMO      128
#define XB_XCNT(j)  (256  + 64 * (j))
#define XB_XSUB(j)  (1280 + 64 * (j))
#define XB_XGEN(j)  (2304 + 64 * (j))
#define XB_TOP      3328
#define XB_TOPGEN   3392
#define XB_SPIN_CAP (1u << 22)
constexpr int CW_BAR = 2048;
constexpr int LDS_MISC = 131072 + 64;
__device__ __forceinline__ unsigned xb_ld(unsigned* p)              { return __hip_atomic_load(p, __ATOMIC_RELAXED, __HIP_MEMORY_SCOPE_AGENT); }
__device__ __forceinline__ unsigned xb_add(unsigned* p, unsigned v) { return __hip_atomic_fetch_add(p, v, __ATOMIC_RELAXED, __HIP_MEMORY_SCOPE_AGENT); }
#define XB_SPIN(cond, bar) do { unsigned _sp = 0; while (cond) { __builtin_amdgcn_s_sleep(1); \
    if ((++_sp & 255u) == 0u) { if (xb_ld(&(bar)[XB_TMO])) break; if (_sp > XB_SPIN_CAP) { atomicAdd(&(bar)[XB_TMO], 1u); break; } } } } while (0)
struct XcdBarrier { unsigned* bar; unsigned x; volatile LAS unsigned* st; };
__device__ __forceinline__ XcdBarrier xcd_barrier_post(unsigned* bar, volatile LAS unsigned* st) {
    XcdBarrier b; b.bar = bar; b.x = (unsigned)__builtin_amdgcn_s_getreg((3 << 11) | 20) & 0xFu; b.st = st;
    if (threadIdx.x == 0) (void)xb_add(&bar[XB_XCNT(b.x)], 1u);
    return b;
}
__device__ __forceinline__ void xcd_barrier_complete(unsigned* bar, unsigned x, unsigned& nloc, unsigned& nx) {
    const unsigned G = gridDim.x * gridDim.y * gridDim.z;
    unsigned sum, cnt, mine, sp = 0u;
    for (;;) {
        sum = 0u; cnt = 0u; mine = 0u;
#pragma unroll
        for (unsigned j = 0; j < 16; ++j) { const unsigned c = xb_ld(&bar[XB_XCNT(j)]); sum += c; cnt += (c > 0u) ? 1u : 0u; mine = (j == x) ? c : mine; }
        if (sum == G) break;
        __builtin_amdgcn_s_sleep(1);
        if ((++sp & 255u) == 0u) { if (xb_ld(&bar[XB_TMO])) break; if (sp > XB_SPIN_CAP) { atomicAdd(&bar[XB_TMO], 1u); break; } }
    }
    nloc = mine > 0u ? mine : 1u; nx = cnt > 0u ? cnt : 1u;
}
__device__ __forceinline__ void xcd_barrier(const XcdBarrier& b) {
    asm volatile("s_waitcnt vmcnt(0)" ::: "memory");
    __syncthreads();
    if (threadIdx.x == 0) {
        unsigned* bar = b.bar;
        __builtin_amdgcn_s_waitcnt(0);
        unsigned nloc = b.st[0], nx = b.st[1];
        if (nloc == 0u) { xcd_barrier_complete(bar, b.x, nloc, nx); b.st[0] = nloc; b.st[1] = nx; }
        const unsigned old = xb_add(&bar[XB_XSUB(b.x)], 1u);
        const unsigned gen = old / nloc;
        if (old + 1u == (gen + 1u) * nloc) {
            __builtin_amdgcn_fence(__ATOMIC_RELEASE, "agent");
            asm volatile("s_waitcnt vmcnt(0)" ::: "memory");
            const unsigned og = xb_add(&bar[XB_TOP], 1u);
            const unsigned tg = og / nx;
            if (og + 1u == (tg + 1u) * nx) xb_add(&bar[XB_TOPGEN], 1u);
            else XB_SPIN(xb_ld(&bar[XB_TOPGEN]) == tg, bar);
            __builtin_amdgcn_fence(__ATOMIC_ACQUIRE, "agent");
            xb_add(&bar[XB_XGEN(b.x)], 1u);
            asm volatile("s_waitcnt vmcnt(0)" ::: "memory");
        } else {
            XB_SPIN(xb_ld(&bar[XB_XGEN(b.x)]) == gen, bar);
            __builtin_amdgcn_fence(__ATOMIC_ACQUIRE, "agent");
            asm volatile("s_waitcnt vmcnt(0)" ::: "memory");
        }
    }
    __syncthreads();
}

__global__ void __launch_bounds__(512, 2) hybrid_fwd(Args a) {
    extern __shared__ __attribute__((aligned(16))) unsigned char lds_raw[];
    LAS unsigned char* lds = (LAS unsigned char*)lds_raw;
    const int tid = threadIdx.x, lane = tid & 63, wave = __builtin_amdgcn_readfirstlane(tid >> 6), G = gridDim.x;
    cg::grid_group grid = cg::this_grid();
    unsigned char* ws = A_WS;
    if (tid < 2) ((volatile LAS unsigned*)(lds + LDS_MISC))[tid] = 0u;
    __syncthreads();
    XcdBarrier xbar; xbar.bar = (unsigned*)(ws + WS_CTL) + CW_BAR; xbar.x = 0; xbar.st = nullptr;
    if (KA->use_sync) xbar = xcd_barrier_post((unsigned*)(ws + WS_CTL) + CW_BAR, (volatile LAS unsigned*)(lds + LDS_MISC));
#define IN(k) (KA->ph_lo <= (k) && (k) < KA->ph_hi)
#define SEAM(k) do { if (KA->use_sync && IN(k) && IN((k) + 1)) { if ((k) == 0) grid.sync(); else xcd_barrier(xbar); } } while (0)
    if (IN(0)) { p0_prologue(lds, G, wave, lane); }
    SEAM(0);
    if (IN(1)) {
        pg8::Gemm g{(const bf16_t*)(ws + WS_XN), (const bf16_t*)(ws + WS_WIN), (const bf16_t*)(ws + WS_WIN) + (size_t)2048 * DM, (const bf16_t*)(ws + WS_XN), DM};
        SchedG1 S; S.init(G, blockIdx.x); EpiG1 E;
        pg8::gemm_phase(lds, g, S, E);
    }
    SEAM(1);
    if (IN(2)) { p2_phase(lds, G, tid, wave, lane); }
    SEAM(2);
    if (IN(3)) {
        pg8::Gemm g{(const bf16_t*)(ws + WS_XN), (const bf16_t*)(ws + WS_WBA), (const bf16_t*)(ws + WS_G), (const bf16_t*)(ws + WS_WBL), DM};
        SchedPair S; S.init(4, G, blockIdx.x); EpiP3 E;
        pg8::gemm_phase(lds, g, S, E);
    }
    SEAM(3);
    if (IN(4)) {
        pg8::Gemm g{(const bf16_t*)(ws + WS_XR), (const bf16_t*)(ws + WS_WO), (const bf16_t*)(ws + WS_XR), (const bf16_t*)(ws + WS_WO), DM};
        SchedOne S; S.init(4, G, blockIdx.x); EpiP4 E;
        pg8::gemm_phase(lds, g, S, E);
    }
    SEAM(4);
    if (IN(5)) { p4b_phase(G, wave, lane); }
    SEAM(5);
    if (IN(6)) {
        pg8::Gemm g{(const bf16_t*)(ws + WS_Q), (const bf16_t*)(ws + WS_WS), (const bf16_t*)(ws + WS_Q), (const bf16_t*)(ws + WS_WS), DM};
        SchedOne S; S.init(8, G, blockIdx.x); EpiP5 E;
        pg8::gemm_phase(lds, g, S, E);
    }
    SEAM(6);
    if (IN(7)) { p6a_phase(lds, G, wave, lane); }
    SEAM(7);
    if (IN(8)) { p6b_phase(lds, tid, wave, lane); }
    SEAM(8);
    if (IN(9)) { p6c_phase(lds, tid, wave, lane); }
    SEAM(9);
    if (IN(10)) { p6d_phase(G, wave, lane); }
#undef IN
#undef SEAM
}

#ifndef N_LAUNCH_MODE
#define N_LAUNCH_MODE 1
#endif
constexpr int NPH = 11;
extern "C" void kernel_launch(void* const* d_in, const int* in_sizes, int n_in, void* d_out, int out_size, void* d_ws, size_t ws_size, hipStream_t stream) {
    static int grid = 0;
    if (grid == 0) {
        if (n_in != 26 || (size_t)out_size != O_END || ws_size < WS_END) { fprintf(stderr, "kernel_launch: unexpected sizes n_in %d out %d ws %zu (need %zu)\n", n_in, out_size, ws_size, (size_t)WS_END); grid = -1; return; }
        int dev = 0, cus = 0, per_cu = 0;
        (void)hipGetDevice(&dev); (void)hipDeviceGetAttribute(&cus, hipDeviceAttributeMultiprocessorCount, dev);
        (void)hipFuncSetAttribute((const void*)hybrid_fwd, hipFuncAttributeMaxDynamicSharedMemorySize, LDS_BYTES);
        (void)hipOccupancyMaxActiveBlocksPerMultiprocessor(&per_cu, (const void*)hybrid_fwd, 512, LDS_BYTES);
        if (per_cu < 1) { fprintf(stderr, "kernel_launch: occupancy query says %d blocks per CU\n", per_cu); per_cu = 1; }
        grid = cus;
        (void)hipGetLastError();
    }
    if (grid < 0) return;
    (void)hipMemsetAsync((char*)d_ws + WS_CTL, 0, 32768, stream);
    Args a{};
    for (int i = 0; i < 26; ++i) a.in[i] = (const float*)d_in[i];
    a.out = (float*)d_out; a.ws = (unsigned char*)d_ws;
    if (N_LAUNCH_MODE == 1) {
        a.ph_lo = 0; a.ph_hi = NPH; a.use_sync = 1;
        void* args[] = {&a};
        hipError_t e = hipLaunchCooperativeKernel((const void*)hybrid_fwd, dim3(grid), dim3(512), args, LDS_BYTES, stream);
        if (e != hipSuccess) fprintf(stderr, "cooperative launch failed: %s (grid %d)\n", hipGetErrorString(e), grid);
    } else {
        for (int p = 0; p < NPH; ++p) { a.ph_lo = p; a.ph_hi = p + 1; a.use_sync = 0; hipLaunchKernelGGL(hybrid_fwd, dim3(grid), dim3(512), LDS_BYTES, stream, a); }
    }
}
```

```cpp
#include <hip/hip_runtime.h>
#include <hip/hip_cooperative_groups.h>
#include <cstdint>
#include <cstdio>
namespace cg = cooperative_groups;

#define LAS __attribute__((address_space(3)))
typedef unsigned short bf16_t;
typedef short bf16x8 __attribute__((ext_vector_type(8)));
typedef float f32x4 __attribute__((ext_vector_type(4)));
typedef float f32x2 __attribute__((ext_vector_type(2)));
typedef float f32x16 __attribute__((ext_vector_type(16)));
typedef unsigned u32x4 __attribute__((ext_vector_type(4)));
typedef unsigned u32x2 __attribute__((ext_vector_type(2)));
typedef __bf16 bf16x2_t __attribute__((ext_vector_type(2)));

constexpr int DM = 1024, SEQ = 4096, NB = 16, NTP = NB * SEQ, NSB = 8, NST = 16, NTS = NSB * NST, NTOK = NTP + NTS;
constexpr int ROWS = 65792, NMT = 257;
constexpr int INC = 7168, NEXP = 16384;
constexpr float EPS = 1e-6f, LOG2E = 1.4426950408889634f;
constexpr float QSCALE = 0.125f * LOG2E;

constexpr size_t MiB = 1u << 20;
constexpr size_t BUF = (size_t)ROWS * DM * 2;
constexpr size_t WS_CTL = 0;
constexpr size_t WS_WIN = 1 * MiB;
constexpr size_t WS_WBA = 16 * MiB, WS_WBL = 18 * MiB, WS_WO = 20 * MiB, WS_WS = 22 * MiB;
constexpr size_t WS_LRUW = 26 * MiB;
constexpr size_t WS_SGA = 27 * MiB, WS_SGR = 27 * MiB + 512 * 1024;
constexpr size_t WS_SU = 26 * MiB + 512 * 1024, WS_SV = 26 * MiB + 640 * 1024;
constexpr size_t WS_SX = 26 * MiB + 704 * 1024;
constexpr size_t WS_UB = 28 * MiB, WS_VB = 60 * MiB;
constexpr size_t WS_Q = 92 * MiB;
constexpr size_t WS_XN = WS_Q + BUF;
constexpr size_t WS_K = WS_XN + BUF;
constexpr size_t WS_VT = WS_K + BUF;
constexpr size_t WS_XR = WS_VT + BUF;
constexpr size_t WS_G = WS_XR + BUF;
constexpr size_t WS_END = WS_G + BUF;
constexpr size_t WS_SELE = WS_G, WS_SELG = WS_G + (size_t)NTOK * 512, WS_XQ = WS_G + (size_t)NTOK * 1024;

constexpr size_t O_YP = 0, O_YS = O_YP + (size_t)NTP * DM, O_KP = O_YS + (size_t)NTS * DM, O_VP = O_KP + (size_t)NB * 512 * DM,
                 O_CP = O_VP + (size_t)NB * 512 * DM, O_LP = O_CP + (size_t)NB * 3 * DM, O_KS = O_LP + (size_t)NB * DM, O_VS = O_KS + (size_t)NTS * DM,
                 O_CS = O_VS + (size_t)NTS * DM, O_LS = O_CS + (size_t)NSB * 3 * DM, O_END = O_LS + (size_t)NSB * DM;

constexpr int LDS_BYTES = 135168;

__device__ __forceinline__ unsigned cvtpk(float lo, float hi) { f32x2 v = {lo, hi}; bf16x2_t b = __builtin_convertvector(v, bf16x2_t); return __builtin_bit_cast(unsigned, b); }
__device__ __forceinline__ float bflo(unsigned u) { return __uint_as_float(u << 16); }
__device__ __forceinline__ float bfhi(unsigned u) { return __uint_as_float(u & 0xffff0000u); }
__device__ __forceinline__ float fast_exp2(float x) { return __builtin_amdgcn_exp2f(x); }
__device__ __forceinline__ float fast_rcp(float x) { return __builtin_amdgcn_rcpf(x); }
__device__ __forceinline__ float sigmoidf_(float z) { return fast_rcp(1.0f + fast_exp2(-z * LOG2E)); }
__device__ __forceinline__ float gelu_tanh(float x) { const float u = x + 0.044715f * x * x * x; return x * fast_rcp(1.0f + fast_exp2(-1.5957691216f * LOG2E * u)); }
__device__ __forceinline__ float wave_sum(float v) {
#pragma unroll
    for (int o = 1; o < 64; o <<= 1) v += __shfl_xor(v, o);
    return v;
}
__device__ __forceinline__ int swap23(int i) { return (i & ~12) | ((i & 4) << 1) | ((i & 8) >> 1); }
__device__ __forceinline__ float plswap_max(float m) { auto rr = __builtin_amdgcn_permlane32_swap(__float_as_uint(m), __float_as_uint(m), false, false); return fmaxf(__uint_as_float(rr[0]), __uint_as_float(rr[1])); }
__device__ __forceinline__ float plswap_add(float m) { auto rr = __builtin_amdgcn_permlane32_swap(__float_as_uint(m), __float_as_uint(m), false, false); return __uint_as_float(rr[0]) + __uint_as_float(rr[1]); }

namespace pg8 {
constexpr int BM = 256, BK = 64, HALF = 128, HTB = HALF * BK * 2, STAGE_BYTES = 8 * HTB, NXCD = 8, WGM = 8;
__host__ __device__ __forceinline__ int lds_byte(int r, int c) { const int st = (r >> 4) * 2 + (c >> 5), rr = r & 15, cc = c & 31, ob = rr * 64 + cc * 2; return st * 1024 + (ob ^ (((ob >> 9) & 1) << 5)); }
__host__ __device__ __forceinline__ void stage_rc(int b, int& R, int& C) { const int st = b / 1024, sb = b % 1024, swz = sb ^ (((sb >> 9) & 1) << 5); R = (st >> 1) * 16 + swz / 64; C = (st & 1) * 32 + (swz % 64) / 2; }
__host__ __device__ __forceinline__ int perm32(int rho) { const int n = rho >> 4, i = rho & 15; return 8 * (i >> 2) + 4 * n + (i & 3); }

struct Unit { int pm, pn, kind; };
struct Gemm { const bf16_t* A0; const bf16_t* B0; const bf16_t* A1; const bf16_t* B1; int K; };

struct TileMap {
    int nM, nN, nwg;
    __device__ __forceinline__ void init(int nM_, int nN_) { nM = nM_; nN = nN_; nwg = nM * nN; }
    __device__ __forceinline__ void map(int L, int& pm, int& pn) const {
        int wgid = L; { const int q = nwg / NXCD, r = nwg % NXCD, xcd = wgid % NXCD, off = wgid / NXCD; wgid = (xcd < r ? xcd * (q + 1) : r * (q + 1) + (xcd - r) * q) + off; }
        const int nig = WGM * nN, gid = wgid / nig, fm = gid * WGM, gsz = (nM - fm) < WGM ? (nM - fm) : WGM;
        pm = fm + ((wgid % nig) % gsz); pn = (wgid % nig) / gsz;
    }
};

template <class Epi, class Sched>
__device__ __forceinline__ void gemm_phase(LAS unsigned char* lds, const Gemm g, const Sched& S, const Epi& E) {
    const int tid = threadIdx.x, wid = __builtin_amdgcn_readfirstlane(tid >> 6), lane = tid & 63, wr = wid >> 2, wc = wid & 3, fr = lane & 15, fq = lane >> 4;
    const int K = g.K, nt = K / BK;
    unsigned voffA[2], voffB[2];
#pragma unroll
    for (int i = 0; i < 2; ++i) { int R, C; stage_rc(tid * 16 + i * 8192, R, C); const int Rb = (R & ~31) + perm32(R & 31);
        voffA[i] = (unsigned)(R * K + C) * 2u; voffB[i] = (unsigned)(Rb * K + C) * 2u; }
    const size_t kstep = (size_t)(BK * 2);
    const size_t hstep = (size_t)HALF * K * 2;
    const size_t tstep = 2 * hstep;
    const unsigned ldsw = (unsigned)wid * 1024u;
    const int aoff = lds_byte(wr * 64 + fr, fq * 8), boff = lds_byte(wc * 32 + fr, fq * 8);
#define PG8_SA(b, h) (((b) * 2 + (h)) * HTB)
#define PG8_SB(b, h) ((4 + (b) * 2 + (h)) * HTB)
#define PG8_STAGE(bufoff, gbase, voff) do { _Pragma("unroll") for (int _i = 0; _i < 2; ++_i) \
        __builtin_amdgcn_global_load_lds((const unsigned*)((const char*)(gbase) + (voff)[_i]), (LAS unsigned*)(lds + (bufoff) + ldsw + _i * 8192), 16, 0, 0); } while (0)
#define PG8_LDA(dst, b, h) do { _Pragma("unroll") for (int m = 0; m < 4; ++m) _Pragma("unroll") for (int k = 0; k < 2; ++k) dst[m][k] = *(const LAS bf16x8*)(lds + PG8_SA(b, h) + aoff + m * 2048 + k * 1024); } while (0)
#define PG8_LDB(dst, b, h) do { _Pragma("unroll") for (int n = 0; n < 2; ++n) _Pragma("unroll") for (int k = 0; k < 2; ++k) dst[n][k] = *(const LAS bf16x8*)(lds + PG8_SB(b, h) + boff + n * 2048 + k * 1024); } while (0)
#define PG8_MMA(ai, bj, At, Bt) do { __builtin_amdgcn_s_setprio(1); _Pragma("unroll") for (int m = 0; m < 4; ++m) _Pragma("unroll") for (int n = 0; n < 2; ++n) _Pragma("unroll") for (int k = 0; k < 2; ++k) \
        acc[ai][bj][m][n] = __builtin_amdgcn_mfma_f32_16x16x32_bf16(Bt[n][k], At[m][k], acc[ai][bj][m][n], 0, 0, 0); __builtin_amdgcn_s_setprio(0); } while (0)
#define PG8_WAIT_V(n) asm volatile("s_waitcnt vmcnt(" #n ")" ::: "memory")
#define PG8_WAIT_L(n) asm volatile("s_waitcnt lgkmcnt(" #n ")" ::: "memory")
#define PG8_BAR __builtin_amdgcn_s_barrier()
#define PG8_SCHED __builtin_amdgcn_sched_barrier(0)
    Unit cur, nxt; int ui = 0;
    if (!S.next(0, cur)) return;
    f32x4 acc[2][2][4][2];
#pragma unroll
    for (int a = 0; a < 2; ++a)
#pragma unroll
        for (int b = 0; b < 2; ++b)
#pragma unroll
            for (int m = 0; m < 4; ++m)
#pragma unroll
                for (int n = 0; n < 2; ++n) acc[a][b][m][n] = (f32x4){0.f, 0.f, 0.f, 0.f};
    bf16x8 At[4][2], B0[2][2], B1[2][2];
    const char* cA = (const char*)(cur.kind ? g.A1 : g.A0) + (size_t)cur.pm * tstep; const char* cB = (const char*)(cur.kind ? g.B1 : g.B0) + (size_t)cur.pn * tstep;
    PG8_STAGE(PG8_SB(0, 0), cB, voffB); PG8_STAGE(PG8_SB(0, 1), cB + hstep, voffB); PG8_STAGE(PG8_SA(0, 0), cA, voffA); PG8_STAGE(PG8_SA(0, 1), cA + hstep, voffA);
    if (wr == 1) PG8_BAR;
    PG8_WAIT_V(2); PG8_BAR;
    PG8_STAGE(PG8_SB(1, 0), cB + kstep, voffB); PG8_STAGE(PG8_SA(1, 0), cA + kstep, voffA); PG8_STAGE(PG8_SB(1, 1), cB + hstep + kstep, voffB);
    PG8_WAIT_V(6); PG8_BAR;
    for (;;) {
        const bool has_next = S.next(ui + 1, nxt);
        const char* nA = has_next ? (const char*)(nxt.kind ? g.A1 : g.A0) + (size_t)nxt.pm * tstep : cA; const char* nB = has_next ? (const char*)(nxt.kind ? g.B1 : g.B0) + (size_t)nxt.pn * tstep : cB;
        for (int t = 0; t < nt; t += 2) {
            const bool last = (t == nt - 2);
            const char* a1 = cA + (size_t)(t + 1) * kstep;
            const char* a2 = last ? nA : cA + (size_t)(t + 2) * kstep; const char* b2 = last ? nB : cB + (size_t)(t + 2) * kstep;
            const char* a3 = a2 + kstep; const char* b3 = b2 + kstep;
            PG8_LDB(B0, 0, 0); PG8_LDB(B1, 0, 1); PG8_SCHED; PG8_LDA(At, 0, 0); PG8_STAGE(PG8_SA(1, 1), a1 + hstep, voffA);
            PG8_WAIT_V(8); PG8_WAIT_L(0); PG8_BAR; PG8_MMA(0, 0, At, B0); PG8_MMA(0, 1, At, B1); PG8_BAR; PG8_SCHED;
            PG8_LDA(At, 0, 1); PG8_STAGE(PG8_SB(0, 0), b2, voffB); PG8_STAGE(PG8_SB(0, 1), b2 + hstep, voffB); PG8_STAGE(PG8_SA(0, 0), a2, voffA);
            PG8_WAIT_V(8); PG8_WAIT_L(0); PG8_BAR; PG8_MMA(1, 0, At, B0); PG8_MMA(1, 1, At, B1); PG8_BAR; PG8_SCHED;
            PG8_LDB(B0, 1, 0); PG8_LDB(B1, 1, 1); PG8_SCHED; PG8_LDA(At, 1, 0); PG8_STAGE(PG8_SA(0, 1), a2 + hstep, voffA);
            PG8_WAIT_V(8); PG8_WAIT_L(0); PG8_BAR; PG8_MMA(0, 0, At, B0); PG8_MMA(0, 1, At, B1); PG8_BAR; PG8_SCHED;
            PG8_LDA(At, 1, 1); PG8_STAGE(PG8_SB(1, 0), b3, voffB); PG8_STAGE(PG8_SB(1, 1), b3 + hstep, voffB); PG8_STAGE(PG8_SA(1, 0), a3, voffA);
            PG8_WAIT_V(8); PG8_WAIT_L(0); PG8_BAR; PG8_MMA(1, 0, At, B0); PG8_MMA(1, 1, At, B1); PG8_BAR; PG8_SCHED;
        }
        if (wr == 0) PG8_BAR;
        E(acc, cur, wr, wc, fr, fq);
        if (!has_next) break;
#pragma unroll
        for (int a = 0; a < 2; ++a)
#pragma unroll
            for (int b = 0; b < 2; ++b)
#pragma unroll
                for (int m = 0; m < 4; ++m)
#pragma unroll
                    for (int n = 0; n < 2; ++n) acc[a][b][m][n] = (f32x4){0.f, 0.f, 0.f, 0.f};
        cur = nxt; cA = nA; cB = nB; ++ui;
        if (wr == 1) PG8_BAR;
    }
    PG8_WAIT_V(0);
    PG8_BAR;
#undef PG8_SA
#undef PG8_SB
#undef PG8_STAGE
#undef PG8_LDA
#undef PG8_LDB
#undef PG8_MMA
#undef PG8_WAIT_V
#undef PG8_WAIT_L
#undef PG8_BAR
#undef PG8_SCHED
}
}
using pg8::Unit;

struct Args {
    const float* in[26];
    float* out; unsigned char* ws;
    int ph_lo, ph_hi, use_sync, pad;
};

typedef const __attribute__((address_space(4))) Args* ArgsP;
#define KA ((ArgsP)__builtin_amdgcn_kernarg_segment_ptr())
#define A_IN(k) (KA->in[k])
#define A_OUT (KA->out)
#define A_WS (KA->ws)

struct SchedG1 {
    pg8::TileMap m0, m1; int G, c;
    __device__ __forceinline__ void init(int G_, int c_) { m0.init(NMT, 24); m1.init(4, NMT); G = G_; c = c_; }
    __device__ __forceinline__ bool next(int i, Unit& u) const {
        int L = i * G + c;
        if (L < m0.nwg) { m0.map(L, u.pm, u.pn); u.pn = (u.pn < 8) ? u.pn : u.pn + 4; u.kind = 0; return true; }
        L -= m0.nwg; if (L >= m1.nwg) return false;
        m1.map(L, u.pm, u.pn); u.kind = 1; return true;
    }
};
struct SchedPair {
    pg8::TileMap m0; int G, c;
    __device__ __forceinline__ void init(int nN, int G_, int c_) { m0.init(NMT, nN); G = G_; c = c_; }
    __device__ __forceinline__ bool next(int i, Unit& u) const { const int L = (i >> 1) * G + c; if (L >= m0.nwg) return false; m0.map(L, u.pm, u.pn); u.kind = i & 1; return true; }
};
struct SchedOne {
    pg8::TileMap m0; int G, c;
    __device__ __forceinline__ void init(int nN, int G_, int c_) { m0.init(NMT, nN); G = G_; c = c_; }
    __device__ __forceinline__ bool next(int i, Unit& u) const { const int L = i * G + c; if (L >= m0.nwg) return false; m0.map(L, u.pm, u.pn); u.kind = 0; return true; }
};

#define EPI_PREP int fr_ = fr, fq_ = fq; asm volatile("" : "+v"(fr_), "+v"(fq_)); const int rl_ = wr * 64 + fr_, cl_ = wc * 32 + 8 * fq_;
#define EPI_LOOP_BEGIN \
    _Pragma("unroll") for (int ai = 0; ai < 2; ++ai) _Pragma("unroll") for (int m = 0; m < 4; ++m) { const int rit = ai * 128 + m * 16 + rl_; \
    _Pragma("unroll") for (int bj = 0; bj < 2; ++bj) { const int cit = bj * 128 + cl_; f32x4 v0 = acc[ai][bj][m][0], v1 = acc[ai][bj][m][1];
#define EPI_LOOP_END } }

struct EpiG1 {
    __device__ __forceinline__ void operator()(const f32x4 (&acc)[2][2][4][2], const Unit& u, int wr, int wc, int fr, int fq) const {
        EPI_PREP unsigned char* ws = A_WS; float* out = A_OUT;
        if (u.kind == 0) {
            const int t = u.pn >> 2, ct = (u.pn & 3) * 256;
            bf16_t* base;
            if (t == 0) base = (bf16_t*)(ws + WS_Q); else if (t == 1) base = (bf16_t*)(ws + WS_K); else if (t == 3) base = (bf16_t*)(ws + WS_XR); else if (t == 4) base = (bf16_t*)(ws + WS_G);
            else if (t == 5) base = (u.pm < 256) ? (bf16_t*)(out + O_YP) : (bf16_t*)(ws + WS_SGA) - (size_t)NTP * DM;
            else base = (u.pm < 256) ? (bf16_t*)(out + O_YP) + (size_t)NTP * DM : (bf16_t*)(ws + WS_SGR) - (size_t)NTP * DM;
            base += (size_t)u.pm * 256 * DM + ct;
            EPI_LOOP_BEGIN
                u32x4 w; w.x = cvtpk(v0[0], v0[1]); w.y = cvtpk(v0[2], v0[3]); w.z = cvtpk(v1[0], v1[1]); w.w = cvtpk(v1[2], v1[3]);
                *(u32x4*)(base + (size_t)rit * DM + cit) = w;
            EPI_LOOP_END
            if (t == 1 && u.pm < 256 && (u.pm & 15) >= 14) { float* p0 = out + O_KP + ((size_t)(u.pm >> 4) * 512 + ((u.pm & 15) - 14) * 256) * DM + ct;
                EPI_LOOP_BEGIN float* p = p0 + (size_t)rit * DM + cit; *(f32x4*)p = v0; *(f32x4*)(p + 4) = v1; EPI_LOOP_END }
            if (t == 1 && u.pm == 256) { float* p0 = out + O_KS + ct;
                EPI_LOOP_BEGIN if (rit < NTS) { float* p = p0 + (size_t)rit * DM + cit; *(f32x4*)p = v0; *(f32x4*)(p + 4) = v1; } EPI_LOOP_END }
            if (t == 3 && u.pm < 256 && (u.pm & 15) == 15) { float* p0 = out + O_CP + ((size_t)(u.pm >> 4) * 3) * DM + ct;
                EPI_LOOP_BEGIN if (rit >= 253) { float* p = p0 + (size_t)(rit - 253) * DM + cit; *(f32x4*)p = v0; *(f32x4*)(p + 4) = v1; } EPI_LOOP_END }
            if (t == 3 && u.pm == 256) { float* p0 = out + O_CS + ct;
                EPI_LOOP_BEGIN if (rit < NTS && (rit & 15) >= 13) { float* p = p0 + ((size_t)(rit >> 4) * 3 + ((rit & 15) - 13)) * DM + cit; *(f32x4*)p = v0; *(f32x4*)(p + 4) = v1; } EPI_LOOP_END }
        } else {
            bf16_t* VT = (bf16_t*)(ws + WS_VT) + (size_t)u.pm * 256 * ROWS + (size_t)u.pn * 256;
            EPI_LOOP_BEGIN
                u32x4 w; w.x = cvtpk(v0[0], v0[1]); w.y = cvtpk(v0[2], v0[3]); w.z = cvtpk(v1[0], v1[1]); w.w = cvtpk(v1[2], v1[3]);
                *(u32x4*)(VT + (size_t)rit * ROWS + cit) = w;
            EPI_LOOP_END
            if (u.pn < 256 && (u.pn & 15) >= 14) { float* p0 = out + O_VP + ((size_t)(u.pn >> 4) * 512 + ((u.pn & 15) - 14) * 256) * DM + u.pm * 256;
                EPI_LOOP_BEGIN float* p = p0 + (size_t)cit * DM + rit;
                    p[0] = v0[0]; p[DM] = v0[1]; p[2 * DM] = v0[2]; p[3 * DM] = v0[3]; p[4 * DM] = v1[0]; p[5 * DM] = v1[1]; p[6 * DM] = v1[2]; p[7 * DM] = v1[3]; EPI_LOOP_END }
            if (u.pn == 256) { float* p0 = out + O_VS + u.pm * 256;
                EPI_LOOP_BEGIN if (cit < NTS) { float* p = p0 + (size_t)cit * DM + rit;
                    p[0] = v0[0]; p[DM] = v0[1]; p[2 * DM] = v0[2]; p[3 * DM] = v0[3]; p[4 * DM] = v1[0]; p[5 * DM] = v1[1]; p[6 * DM] = v1[2]; p[7 * DM] = v1[3]; } EPI_LOOP_END }
        }
    }
};

struct EpiP3 {
    __device__ __forceinline__ void operator()(const f32x4 (&acc)[2][2][4][2], const Unit& u, int wr, int wc, int fr, int fq) const {
        EPI_PREP unsigned char* ws = A_WS; float* out = A_OUT;
        const bf16_t* gb = (u.pm < 256) ? (const bf16_t*)(out + O_YP) + (u.kind ? (size_t)NTP * DM : 0) : (const bf16_t*)(ws + (u.kind ? WS_SGR : WS_SGA)) - (size_t)NTP * DM;
        const size_t off0 = (size_t)u.pm * 256 * DM + u.pn * 256;
        gb += off0; float* T1 = (float*)(ws + WS_K) + off0; bf16_t* MG = (bf16_t*)(ws + WS_XR) + off0;
        EPI_LOOP_BEGIN
            const size_t off = (size_t)rit * DM + cit;
            const u32x4 gw = *(const u32x4*)(gb + off);
            f32x4 s0, s1;
            s0[0] = sigmoidf_(bflo(gw.x)); s0[1] = sigmoidf_(bfhi(gw.x)); s0[2] = sigmoidf_(bflo(gw.y)); s0[3] = sigmoidf_(bfhi(gw.y));
            s1[0] = sigmoidf_(bflo(gw.z)); s1[1] = sigmoidf_(bfhi(gw.z)); s1[2] = sigmoidf_(bflo(gw.w)); s1[3] = sigmoidf_(bfhi(gw.w));
            if (u.kind == 0) { *(f32x4*)(T1 + off) = s0 * v0; *(f32x4*)(T1 + off + 4) = s1 * v1; }
            else { const f32x4 a0 = *(const f32x4*)(T1 + off) + s0 * v0, a1 = *(const f32x4*)(T1 + off + 4) + s1 * v1;
                u32x4 w; w.x = cvtpk(a0[0], a0[1]); w.y = cvtpk(a0[2], a0[3]); w.z = cvtpk(a1[0], a1[1]); w.w = cvtpk(a1[2], a1[3]);
                *(u32x4*)(MG + off) = w; }
        EPI_LOOP_END
    }
};

struct EpiP4 {
    __device__ __forceinline__ void operator()(const f32x4 (&acc)[2][2][4][2], const Unit& u, int wr, int wc, int fr, int fq) const {
        EPI_PREP float* out = A_OUT;
        if (u.pm < 256) { const size_t off0 = (size_t)u.pm * 256 * DM + u.pn * 256; const float* xp = A_IN(0) + off0; float* yo = out + O_YP + off0;
            EPI_LOOP_BEGIN const size_t off = (size_t)rit * DM + cit;
                *(f32x4*)(yo + off) = *(const f32x4*)(xp + off) + v0; *(f32x4*)(yo + off + 4) = *(const f32x4*)(xp + off + 4) + v1; EPI_LOOP_END }
        else { const float* xs = A_IN(1) + u.pn * 256; float* yo = out + O_YS + u.pn * 256;
            EPI_LOOP_BEGIN if (rit < NTS) { const size_t off = (size_t)rit * DM + cit;
                *(f32x4*)(yo + off) = *(const f32x4*)(xs + off) + v0; *(f32x4*)(yo + off + 4) = *(const f32x4*)(xs + off + 4) + v1; } EPI_LOOP_END }
    }
};

struct EpiP5 {
    __device__ __forceinline__ void operator()(const f32x4 (&acc)[2][2][4][2], const Unit& u, int wr, int wc, int fr, int fq) const {
        EPI_PREP float* SC = (float*)(A_WS + WS_XN) + (size_t)u.pm * 256 * 2048 + u.pn * 256;
        EPI_LOOP_BEGIN
            float* p = SC + (size_t)rit * 2048 + cit; *(f32x4*)p = v0; *(f32x4*)(p + 4) = v1;
        EPI_LOOP_END
    }
};

__device__ __forceinline__ void p0_transpose_item(const float* W, int K, int N, bf16_t* WT, LAS float* scr, int item, int lane, int nscale = 0) {
    const int nblk = N / 32, kb = item / nblk, nb = item % nblk, k0 = 64 * kb, n0 = 32 * nb;
#pragma unroll 8
    for (int i = 0; i < 32; ++i) { const int kk = 2 * i + (lane >> 5); scr[kk * 33 + (lane & 31)] = W[(size_t)(k0 + kk) * N + n0 + (lane & 31)] * (n0 < nscale ? QSCALE : 1.0f); }
    asm volatile("s_waitcnt lgkmcnt(0)" ::: "memory");
    const int c = lane & 7;
#pragma unroll
    for (int j = 0; j < 4; ++j) { const int n = (lane >> 3) + 8 * j; const LAS float* s = scr + (8 * c) * 33 + n;
        u32x4 o; o.x = cvtpk(s[0 * 33], s[1 * 33]); o.y = cvtpk(s[2 * 33], s[3 * 33]); o.z = cvtpk(s[4 * 33], s[5 * 33]); o.w = cvtpk(s[6 * 33], s[7 * 33]);
        *(u32x4*)(WT + (size_t)(n0 + n) * K + k0 + 8 * c) = o; }
    asm volatile("s_waitcnt lgkmcnt(0)" ::: "memory");
}

__device__ __forceinline__ void p0_prologue(LAS unsigned char* lds, int G, int wave, int lane) {
    unsigned char* ws = A_WS;
    const int gw = blockIdx.x * 8 + wave, NGW = G * 8;
    LAS float* scr = (LAS float*)(lds + wave * 16384);
    constexpr int I_IN = 16 * (INC / 32), I_SQ = 16 * 32, NTR = I_IN + 3 * I_SQ;
    for (int it = gw; it < NTR; it += NGW) {
        int r = it;
        if (r < I_IN) { p0_transpose_item(A_IN(7), DM, INC, (bf16_t*)(ws + WS_WIN), scr, r, lane, 1024); continue; } r -= I_IN;
        if (r < I_SQ) { p0_transpose_item(A_IN(16), DM, DM, (bf16_t*)(ws + WS_WBA), scr, r, lane); continue; } r -= I_SQ;
        if (r < I_SQ) { p0_transpose_item(A_IN(17), DM, DM, (bf16_t*)(ws + WS_WBL), scr, r, lane); continue; } r -= I_SQ;
        p0_transpose_item(A_IN(18), DM, DM, (bf16_t*)(ws + WS_WO), scr, r, lane);
    }
    {
        const float* wq = A_IN(20); bf16_t* wst = (bf16_t*)(ws + WS_WS);
        const int r32 = lane & 31, hi = lane >> 5;
        for (int it = gw; it < 2048; it += NGW) {
            const int hj = it >> 7, kt = (it >> 5) & 3, ct = it & 31, h = hj >> 1, j = hj & 1;
            const float* ap = (j ? A_IN(22) : A_IN(21)) + ((size_t)(h * 128 + kt * 32 + r32)) * 128 + 64 * hi;
            const float* bp = wq + (size_t)(ct * 32 + r32) * 2048 + hj * 128 + 64 * hi;
            f32x16 acc = {};
#pragma unroll
            for (int s4 = 0; s4 < 16; ++s4) { const f32x4 av = *(const f32x4*)(ap + 4 * s4), bv = *(const f32x4*)(bp + 4 * s4);
                acc = __builtin_amdgcn_mfma_f32_32x32x2f32(av[0], bv[0], acc, 0, 0, 0); acc = __builtin_amdgcn_mfma_f32_32x32x2f32(av[1], bv[1], acc, 0, 0, 0);
                acc = __builtin_amdgcn_mfma_f32_32x32x2f32(av[2], bv[2], acc, 0, 0, 0); acc = __builtin_amdgcn_mfma_f32_32x32x2f32(av[3], bv[3], acc, 0, 0, 0); }
#pragma unroll
            for (int r = 0; r < 16; ++r) { const int key = kt * 32 + (r & 3) + 8 * (r >> 2) + 4 * hi;
                wst[(size_t)(hj * 128 + key) * DM + ct * 32 + r32] = (bf16_t)(cvtpk(acc[r], 0.f) & 0xffffu); }
        }
    }
    for (int it = gw; it < 2 * NEXP; it += NGW) {
        const int tb = it >= NEXP, e = it - tb * NEXP;
        const float* src = (tb ? A_IN(24) : A_IN(23)) + (size_t)e * DM + lane * 16;
        unsigned char* dst = ws + (tb ? WS_VB : WS_UB) + (size_t)e * DM + lane * 16;
        f32x4 p[4]; float mx = 0.f;
#pragma unroll
        for (int q = 0; q < 4; ++q) { p[q] = *(const f32x4*)(src + 4 * q); mx = fmaxf(mx, fmaxf(fmaxf(fabsf(p[q][0]), fabsf(p[q][1])), fmaxf(fabsf(p[q][2]), fabsf(p[q][3])))); }
#pragma unroll
        for (int o = 1; o < 64; o <<= 1) mx = fmaxf(mx, __shfl_xor(mx, o));
        const float step = fmaxf(mx, 1e-30f) * (1.0f / 127.0f), inv = 1.0f / step;
        u32x4 w;
#pragma unroll
        for (int q = 0; q < 4; ++q) {
            const int ob = 0;
            const unsigned b0 = (unsigned)((int)rintf(p[q][0] * inv) + ob) & 0xffu, b1 = (unsigned)((int)rintf(p[q][1] * inv) + ob) & 0xffu, b2 = (unsigned)((int)rintf(p[q][2] * inv) + ob) & 0xffu, b3 = (unsigned)((int)rintf(p[q][3] * inv) + ob) & 0xffu;
            w[q] = b0 | (b1 << 8) | (b2 << 16) | (b3 << 24); }
        *(u32x4*)dst = w;
        if (lane == 0) ((float*)(ws + (tb ? WS_SV : WS_SU)))[e] = step;
    }
    {
        const float* gm = A_IN(6); bf16_t* XN = (bf16_t*)(ws + WS_XN);
        for (int m = gw; m < ROWS; m += NGW) {
            bf16_t* orow = XN + (size_t)m * DM;
            if (m >= NTOK) {
#pragma unroll
                for (int j = 0; j < 2; ++j) *(u32x4*)(orow + j * 512 + lane * 8) = (u32x4){0u, 0u, 0u, 0u};
                continue; }
            const float* xr = (m < NTP) ? A_IN(0) + (size_t)m * DM : A_IN(1) + (size_t)(m - NTP) * DM;
            f32x4 v[4]; float s = 0.f;
#pragma unroll
            for (int j = 0; j < 4; ++j) { v[j] = *(const f32x4*)(xr + j * 256 + lane * 4); s += (v[j][0] * v[j][0] + v[j][1] * v[j][1]) + (v[j][2] * v[j][2] + v[j][3] * v[j][3]); }
            const float inv = 1.0f / sqrtf(wave_sum(s) * (1.0f / DM) + EPS);
#pragma unroll
            for (int j = 0; j < 4; ++j) { const f32x4 gg = *(const f32x4*)(gm + j * 256 + lane * 4); const f32x4 y = v[j] * inv * gg;
                u32x2 w; w.x = cvtpk(y[0], y[1]); w.y = cvtpk(y[2], y[3]); *(u32x2*)(orow + j * 256 + lane * 4) = w; }
        }
    }
    {
        bf16_t* fw = (bf16_t*)(ws + WS_LRUW);
        for (int f = gw; f < 256; f += NGW) {
            const int ks = f & 3, T = (f >> 2) & 1, gate = (f >> 3) & 1, g = f >> 4, i = lane & 31, hi = lane >> 5;
            const int outc = 32 * T + swap23(i);
            const float* W = (gate ? A_IN(13) : A_IN(11)) + (size_t)g * 4096;
            float x[8];
#pragma unroll
            for (int j = 0; j < 8; ++j) x[j] = W[(16 * ks + 8 * hi + j) * 64 + outc];
            u32x4 w; w.x = cvtpk(x[0], x[1]); w.y = cvtpk(x[2], x[3]); w.z = cvtpk(x[4], x[5]); w.w = cvtpk(x[6], x[7]);
            *(u32x4*)(fw + (size_t)f * 512 + lane * 8) = w;
        }
    }
}

constexpr int LR_WF = 0, LR_CW = 16384, LR_CB = LR_CW + 1024, LR_BR = LR_CB + 256, LR_BI = LR_BR + 256, LR_CS = LR_BI + 256, LR_CARRY = LR_CS + 256, LR_SEQ = LR_CARRY + 2048, LR_END = LR_SEQ + 64;

__device__ __forceinline__ void lru_load_consts(LAS unsigned char* lds, int g, int tid) {
    const u32x4* src = (const u32x4*)(A_WS + WS_LRUW + (size_t)g * 16384);
    for (int i = tid; i < 1024; i += 512) ((LAS u32x4*)(lds + LR_WF))[i] = src[i];
    if (tid < 256) ((LAS float*)(lds + LR_CW))[tid] = A_IN(9)[(tid >> 6) * DM + g * 64 + (tid & 63)];
    if (tid < 64) {
        const int c = g * 64 + tid;
        ((LAS float*)(lds + LR_CB))[tid] = A_IN(10)[c]; ((LAS float*)(lds + LR_BR))[tid] = A_IN(12)[c]; ((LAS float*)(lds + LR_BI))[tid] = A_IN(14)[c];
        ((LAS float*)(lds + LR_CS))[tid] = 8.0f * log1pf(expf(-A_IN(15)[c]));
    }
    if (tid < 8) ((LAS unsigned*)(lds + LR_SEQ))[tid] = 0xffffffffu;
}

template <bool SAMPLE>
__device__ __forceinline__ void lru_tile(LAS unsigned char* lds, int lane, int g, size_t rowbase, int tile, int bidx) {
    asm volatile("" : "+v"(lane));
    const int tl = lane & 31, hi = lane >> 5, t = tile * 32 + tl;
    const bf16_t* XR = (const bf16_t*)(A_WS + WS_XR); bf16_t* Gb = (bf16_t*)(A_WS + WS_G);
    const int cbase = g * 64 + 8 * hi;
    float xc[4][8];
    bf16x8 xf[4];
#pragma unroll
    for (int ks = 0; ks < 4; ++ks) {
        const f32x4 b0 = *(const LAS f32x4*)(lds + LR_CB + (16 * ks + 8 * hi) * 4), b1 = *(const LAS f32x4*)(lds + LR_CB + (16 * ks + 8 * hi) * 4 + 16);
#pragma unroll
        for (int j = 0; j < 4; ++j) { xc[ks][j] = b0[j]; xc[ks][4 + j] = b1[j]; }
#pragma unroll
        for (int tap = 0; tap < 4; ++tap) {
            const int rr = t - 3 + tap;
            float xv[8];
            {
                u32x4 w = *(const u32x4*)(XR + (rowbase + (rr < 0 ? 0 : rr)) * DM + cbase + 16 * ks);
                if (rr < 0) w = (u32x4){0u, 0u, 0u, 0u};
                xv[0] = bflo(w.x); xv[1] = bfhi(w.x); xv[2] = bflo(w.y); xv[3] = bfhi(w.y); xv[4] = bflo(w.z); xv[5] = bfhi(w.z); xv[6] = bflo(w.w); xv[7] = bfhi(w.w);
            }
            if (SAMPLE) {
                const float* sp = A_IN(4) + ((size_t)bidx * 3 + (rr < 0 ? 3 + rr : 0)) * DM + cbase + 16 * ks;
                const f32x4 p = *(const f32x4*)sp, q = *(const f32x4*)(sp + 4);
#pragma unroll
                for (int j = 0; j < 4; ++j) { xv[j] = rr < 0 ? p[j] : xv[j]; xv[4 + j] = rr < 0 ? q[j] : xv[4 + j]; }
            }
            const f32x4 w0 = *(const LAS f32x4*)(lds + LR_CW + (tap * 64 + 16 * ks + 8 * hi) * 4), w1 = *(const LAS f32x4*)(lds + LR_CW + (tap * 64 + 16 * ks + 8 * hi) * 4 + 16);
#pragma unroll
            for (int j = 0; j < 4; ++j) { xc[ks][j] += w0[j] * xv[j]; xc[ks][4 + j] += w1[j] * xv[4 + j]; }
        }
        u32x4 w; w.x = cvtpk(xc[ks][0], xc[ks][1]); w.y = cvtpk(xc[ks][2], xc[ks][3]); w.z = cvtpk(xc[ks][4], xc[ks][5]); w.w = cvtpk(xc[ks][6], xc[ks][7]);
        xf[ks] = __builtin_bit_cast(bf16x8, w);
        asm volatile("" ::: "memory");
    }
    float A[32], B[32];
#pragma unroll
    for (int T = 0; T < 2; ++T) {
        f32x16 ar = f32x16{}, ai = f32x16{};
#pragma unroll
        for (int ks = 0; ks < 4; ++ks) {
            const bf16x8 wr_ = *(const LAS bf16x8*)(lds + LR_WF + ((0 * 2 + T) * 4 + ks) * 1024 + lane * 16);
            const bf16x8 wi_ = *(const LAS bf16x8*)(lds + LR_WF + ((1 * 2 + T) * 4 + ks) * 1024 + lane * 16);
            ar = __builtin_amdgcn_mfma_f32_32x32x16_bf16(wr_, xf[ks], ar, 0, 0, 0);
            ai = __builtin_amdgcn_mfma_f32_32x32x16_bf16(wi_, xf[ks], ai, 0, 0, 0);
        }
#pragma unroll
        for (int q = 0; q < 2; ++q) {
            const int ks = 2 * T + q, lo = (16 * ks + 8 * hi) * 4;
            const f32x4 br0 = *(const LAS f32x4*)(lds + LR_BR + lo), br1 = *(const LAS f32x4*)(lds + LR_BR + lo + 16);
            const f32x4 bi0 = *(const LAS f32x4*)(lds + LR_BI + lo), bi1 = *(const LAS f32x4*)(lds + LR_BI + lo + 16);
            const f32x4 cs0 = *(const LAS f32x4*)(lds + LR_CS + lo), cs1 = *(const LAS f32x4*)(lds + LR_CS + lo + 16);
#pragma unroll
            for (int j = 0; j < 8; ++j) {
                const int r = 8 * q + j;
                const float brv = j < 4 ? br0[j & 3] : br1[j & 3], biv = j < 4 ? bi0[j & 3] : bi1[j & 3], csv = j < 4 ? cs0[j & 3] : cs1[j & 3];
                const float rg = sigmoidf_(ar[r] + brv), ig = sigmoidf_(ai[r] + biv);
                const float la = -csv * rg, av = fast_exp2(la * LOG2E);
                const float x2 = 2.0f * la;
                const float em = (x2 > -0.03f) ? -x2 * (1.0f + x2 * (0.5f + x2 * (0.16666667f + x2 * 0.041666668f))) : 1.0f - fast_exp2(x2 * LOG2E);
                A[16 * T + r] = av; B[16 * T + r] = sqrtf(em) * ig * xc[ks][j];
            }
        }
        asm volatile("" ::: "memory");
    }
#define LRU_STEP(CTRL, RM) _Pragma("unroll") for (int c = 0; c < 32; ++c) { \
        const float as_ = __builtin_bit_cast(float, __builtin_amdgcn_update_dpp(__builtin_bit_cast(int, 1.0f), __builtin_bit_cast(int, A[c]), CTRL, RM, 0xF, false)); \
        const float bs_ = __builtin_bit_cast(float, __builtin_amdgcn_update_dpp(0, __builtin_bit_cast(int, B[c]), CTRL, RM, 0xF, false)); \
        B[c] = A[c] * bs_ + B[c]; A[c] = A[c] * as_; }
    LRU_STEP(0x111, 0xF) LRU_STEP(0x112, 0xF) LRU_STEP(0x114, 0xF) LRU_STEP(0x118, 0xF) LRU_STEP(0x142, 0xA)
#undef LRU_STEP
    float hin[32];
    if (SAMPLE) {
        const float* hp = A_IN(5) + (size_t)bidx * DM + cbase;
#pragma unroll
        for (int ks = 0; ks < 4; ++ks) { const f32x4 p = *(const f32x4*)(hp + 16 * ks), q = *(const f32x4*)(hp + 16 * ks + 4);
#pragma unroll
            for (int j = 0; j < 4; ++j) { hin[8 * ks + j] = p[j]; hin[8 * ks + 4 + j] = q[j]; } }
    } else if (tile == 0) {
#pragma unroll
        for (int c = 0; c < 32; ++c) hin[c] = 0.f;
    } else {
        volatile LAS unsigned* sq = (volatile LAS unsigned*)(lds + LR_SEQ) + (tile & 7);
        while (*sq != (unsigned)tile) __builtin_amdgcn_s_sleep(1);
        asm volatile("" ::: "memory");
        const LAS float* cp = (const LAS float*)(lds + LR_CARRY) + (tile & 7) * 64 + 8 * hi;
#pragma unroll
        for (int ks = 0; ks < 4; ++ks) { const f32x4 p = *(const LAS f32x4*)(cp + 16 * ks), q = *(const LAS f32x4*)(cp + 16 * ks + 4);
#pragma unroll
            for (int j = 0; j < 4; ++j) { hin[8 * ks + j] = p[j]; hin[8 * ks + 4 + j] = q[j]; } }
    }
#pragma unroll
    for (int c = 0; c < 32; ++c) B[c] = B[c] + A[c] * hin[c];
    if (!SAMPLE) {
        if (tl == 31) {
            if (tile < 127) {
                LAS float* cp = (LAS float*)(lds + LR_CARRY) + ((tile + 1) & 7) * 64 + 8 * hi;
#pragma unroll
                for (int ks = 0; ks < 4; ++ks) { *(LAS f32x4*)(cp + 16 * ks) = (f32x4){B[8 * ks], B[8 * ks + 1], B[8 * ks + 2], B[8 * ks + 3]};
                    *(LAS f32x4*)(cp + 16 * ks + 4) = (f32x4){B[8 * ks + 4], B[8 * ks + 5], B[8 * ks + 6], B[8 * ks + 7]}; }
            } else {
                float* lp = A_OUT + O_LP + (size_t)bidx * DM + cbase;
#pragma unroll
                for (int ks = 0; ks < 4; ++ks) { *(f32x4*)(lp + 16 * ks) = (f32x4){B[8 * ks], B[8 * ks + 1], B[8 * ks + 2], B[8 * ks + 3]};
                    *(f32x4*)(lp + 16 * ks + 4) = (f32x4){B[8 * ks + 4], B[8 * ks + 5], B[8 * ks + 6], B[8 * ks + 7]}; }
            }
        }
        if (tile < 127) {
            asm volatile("s_waitcnt lgkmcnt(0)" ::: "memory");
            if (lane == 63) *((volatile LAS unsigned*)(lds + LR_SEQ) + ((tile + 1) & 7)) = (unsigned)(tile + 1);
        }
    } else if (tl == 15) {
        float* lp = A_OUT + O_LS + (size_t)bidx * DM + cbase;
#pragma unroll
        for (int ks = 0; ks < 4; ++ks) { *(f32x4*)(lp + 16 * ks) = (f32x4){B[8 * ks], B[8 * ks + 1], B[8 * ks + 2], B[8 * ks + 3]};
            *(f32x4*)(lp + 16 * ks + 4) = (f32x4){B[8 * ks + 4], B[8 * ks + 5], B[8 * ks + 6], B[8 * ks + 7]}; }
    }
    if (!SAMPLE || tl < NST) {
        bf16_t* gp = Gb + (rowbase + t) * DM + cbase;
#pragma unroll
        for (int ks = 0; ks < 4; ++ks) {
            const u32x4 w = *(const u32x4*)(gp + 16 * ks);
            float gv[8]; gv[0] = bflo(w.x); gv[1] = bfhi(w.x); gv[2] = bflo(w.y); gv[3] = bfhi(w.y); gv[4] = bflo(w.z); gv[5] = bfhi(w.z); gv[6] = bflo(w.w); gv[7] = bfhi(w.w);
            float o[8];
#pragma unroll
            for (int j = 0; j < 8; ++j) o[j] = B[8 * ks + j] * gelu_tanh(gv[j]);
            u32x4 ow; ow.x = cvtpk(o[0], o[1]); ow.y = cvtpk(o[2], o[3]); ow.z = cvtpk(o[4], o[5]); ow.w = cvtpk(o[6], o[7]);
            *(u32x4*)(gp + 16 * ks) = ow;
        }
    }
}

constexpr int AT_TAB = 24576;
__device__ __forceinline__ void attn_unit(LAS unsigned char* lds, int lane, int b, int c, int h) {
    const int r32 = lane & 31, hi = lane >> 5, kr = swap23(r32);
    const bf16_t* Q = (const bf16_t*)(A_WS + WS_Q); const bf16_t* Kb = (const bf16_t*)(A_WS + WS_K); const bf16_t* VT = (const bf16_t*)(A_WS + WS_VT); bf16_t* O = (bf16_t*)(A_WS + WS_XN);
    const size_t row0 = (size_t)b * SEQ + (size_t)c * 64;
    bf16x8 qf[2][4];
#pragma unroll
    for (int qb = 0; qb < 2; ++qb)
#pragma unroll
        for (int ks = 0; ks < 4; ++ks) qf[qb][ks] = *(const bf16x8*)(Q + (row0 + qb * 32 + r32) * DM + h * 64 + ks * 16 + hi * 8);
    f32x16 o[2][2];
#pragma unroll
    for (int i = 0; i < 2; ++i)
#pragma unroll
        for (int j = 0; j < 2; ++j) o[i][j] = f32x16{};
    float mrow[2] = {-1e30f, -1e30f}, lrow[2] = {0.f, 0.f};
    const LAS float* tab = (const LAS float*)(lds + AT_TAB) + h * 320;
    const float cfar = tab[256];
    const int sb0 = (c >= 8 ? c - 8 : 0) * 2, sb1 = c * 2 + 1;
    const bf16_t* kbase = Kb + ((size_t)b * SEQ + kr) * DM + h * 64 + hi * 8;
    const bf16_t* vbase = VT + (size_t)(h * 64 + kr) * ROWS + (size_t)b * SEQ + hi * 8;
    bf16x8 kf[4], vf[2][2];
#pragma unroll
    for (int ks = 0; ks < 4; ++ks) kf[ks] = *(const bf16x8*)(kbase + (size_t)sb0 * 32 * DM + ks * 16);
#pragma unroll
    for (int db = 0; db < 2; ++db)
#pragma unroll
        for (int s = 0; s < 2; ++s) vf[db][s] = *(const bf16x8*)(vbase + (size_t)db * 32 * ROWS + sb0 * 32 + s * 16);
    for (int sb = sb0; sb <= sb1; ++sb) {
        const int sbn = sb < sb1 ? sb + 1 : sb;
        f32x16 S[2];
#pragma unroll
        for (int qb = 0; qb < 2; ++qb) { S[qb] = f32x16{};
#pragma unroll
            for (int ks = 0; ks < 4; ++ks) S[qb] = __builtin_amdgcn_mfma_f32_32x32x16_bf16(kf[ks], qf[qb][ks], S[qb], 0, 0, 0); }
        asm volatile("" ::: "memory");
#pragma unroll
        for (int ks = 0; ks < 4; ++ks) kf[ks] = *(const bf16x8*)(kbase + (size_t)sbn * 32 * DM + ks * 16);
        const int delta = c - (sb >> 1), rb = sb & 1;
        if (delta >= 3) {
#pragma unroll
            for (int qb = 0; qb < 2; ++qb)
#pragma unroll
                for (int r = 0; r < 16; ++r) S[qb][r] += cfar;
        } else {
#pragma unroll
            for (int qb = 0; qb < 2; ++qb) {
                const LAS float* tp = tab + (64 * delta + 32 * qb + r32 + 128 - 32 * rb - 8 * hi - 23);
#pragma unroll
                for (int r = 0; r < 16; ++r) S[qb][r] += tp[23 - (16 * (r >> 3) + (r & 7))];
            }
        }
        float rm[2];
#pragma unroll
        for (int qb = 0; qb < 2; ++qb) { float mx = S[qb][0];
#pragma unroll
            for (int r = 1; r < 16; ++r) mx = fmaxf(mx, S[qb][r]);
            rm[qb] = plswap_max(mx); }
        if (__any((rm[0] > mrow[0] + 8.0f) || (rm[1] > mrow[1] + 8.0f))) {
#pragma unroll
            for (int qb = 0; qb < 2; ++qb) { const float mn = fmaxf(mrow[qb], rm[qb]); const float al = fast_exp2(mrow[qb] - mn); lrow[qb] *= al; mrow[qb] = mn;
#pragma unroll
                for (int r = 0; r < 16; ++r) { o[0][qb][r] *= al; o[1][qb][r] *= al; } }
        }
        bf16x8 pf[2][2];
#pragma unroll
        for (int qb = 0; qb < 2; ++qb) { float sum = 0.f;
#pragma unroll
            for (int r = 0; r < 16; ++r) { S[qb][r] = fast_exp2(S[qb][r] - mrow[qb]); sum += S[qb][r]; }
            lrow[qb] += sum;
#pragma unroll
            for (int s = 0; s < 2; ++s) { u32x4 w; w.x = cvtpk(S[qb][8 * s], S[qb][8 * s + 1]); w.y = cvtpk(S[qb][8 * s + 2], S[qb][8 * s + 3]); w.z = cvtpk(S[qb][8 * s + 4], S[qb][8 * s + 5]); w.w = cvtpk(S[qb][8 * s + 6], S[qb][8 * s + 7]);
                pf[qb][s] = __builtin_bit_cast(bf16x8, w); } }
#pragma unroll
        for (int db = 0; db < 2; ++db)
#pragma unroll
            for (int qb = 0; qb < 2; ++qb)
#pragma unroll
                for (int s = 0; s < 2; ++s) o[db][qb] = __builtin_amdgcn_mfma_f32_32x32x16_bf16(vf[db][s], pf[qb][s], o[db][qb], 0, 0, 0);
        asm volatile("" ::: "memory");
#pragma unroll
        for (int db = 0; db < 2; ++db)
#pragma unroll
            for (int s = 0; s < 2; ++s) vf[db][s] = *(const bf16x8*)(vbase + (size_t)db * 32 * ROWS + sbn * 32 + s * 16);
    }
#pragma unroll
    for (int qb = 0; qb < 2; ++qb) { const float inv = fast_rcp(plswap_add(lrow[qb]));
        bf16_t* op = O + (row0 + qb * 32 + r32) * DM + h * 64 + 8 * hi;
#pragma unroll
        for (int db = 0; db < 2; ++db)
#pragma unroll
            for (int s = 0; s < 2; ++s) { u32x4 w;
                w.x = cvtpk(o[db][qb][8 * s] * inv, o[db][qb][8 * s + 1] * inv); w.y = cvtpk(o[db][qb][8 * s + 2] * inv, o[db][qb][8 * s + 3] * inv);
                w.z = cvtpk(o[db][qb][8 * s + 4] * inv, o[db][qb][8 * s + 5] * inv); w.w = cvtpk(o[db][qb][8 * s + 6] * inv, o[db][qb][8 * s + 7] * inv);
                *(u32x4*)(op + 32 * db + 16 * s) = w; } }
}

constexpr int AS_P = 45056;
__device__ __forceinline__ void attn_sample_task(LAS unsigned char* lds, int wave, int lane, int task) {
    const int bs = task >> 6, h = (task >> 2) & 15, qg = task & 3;
    const bf16_t* Q = (const bf16_t*)(A_WS + WS_Q); bf16_t* O = (bf16_t*)(A_WS + WS_XN);
    const float* ck = A_IN(2); const float* cv = A_IN(3); const float* kn = A_OUT + O_KS; const float* vn = A_OUT + O_VS;
    LAS float* pb = (LAS float*)(lds + AS_P + wave * 9472);
    LAS float* qs = pb + 4 * 528;
    const LAS float* tab = (const LAS float*)(lds + AT_TAB) + h * 320;
#pragma unroll
    for (int i = 0; i < 4; ++i) qs[i * 64 + lane] = bflo((unsigned)Q[((size_t)NTP + bs * 16 + qg * 4 + i) * DM + h * 64 + lane]);
    asm volatile("s_waitcnt lgkmcnt(0)" ::: "memory");
#pragma unroll 1
    for (int it = 0; it < 9; ++it) {
        const int key = it * 64 + lane; const bool valid = key < 528;
        const float* kp = !valid ? ck : (key < 512 ? ck + (((size_t)bs * 512 + key) * 16 + h) * 64 : kn + ((size_t)bs * 16 + (key - 512)) * DM + h * 64);
        float d[4] = {0.f, 0.f, 0.f, 0.f};
#pragma unroll 4
        for (int d4 = 0; d4 < 16; ++d4) { const f32x4 kv = *(const f32x4*)(kp + 4 * d4);
#pragma unroll
            for (int i = 0; i < 4; ++i) { const f32x4 qq = *(const LAS f32x4*)(qs + i * 64 + 4 * d4); d[i] += (kv[0] * qq[0] + kv[1] * qq[1]) + (kv[2] * qq[2] + kv[3] * qq[3]); } }
        int rel = 512 + qg * 4 - key;
        if (valid) {
#pragma unroll
            for (int i = 0; i < 4; ++i) { int r = rel + i; r = r > 128 ? 128 : r; pb[i * 528 + key] = d[i] + tab[r + 128]; } }
    }
    asm volatile("s_waitcnt lgkmcnt(0)" ::: "memory");
#pragma unroll 1
    for (int i = 0; i < 4; ++i) {
        float mx = -1e30f;
#pragma unroll 1
        for (int key = lane; key < 528; key += 64) mx = fmaxf(mx, pb[i * 528 + key]);
#pragma unroll
        for (int o = 1; o < 64; o <<= 1) mx = fmaxf(mx, __shfl_xor(mx, o));
        float sum = 0.f;
#pragma unroll 1
        for (int key = lane; key < 528; key += 64) { const float pv = fast_exp2(pb[i * 528 + key] - mx); pb[i * 528 + key] = pv; sum += pv; }
        sum = wave_sum(sum); const float inv = 1.0f / sum;
#pragma unroll 1
        for (int key = lane; key < 528; key += 64) pb[i * 528 + key] *= inv;
    }
    asm volatile("s_waitcnt lgkmcnt(0)" ::: "memory");
    float acc[4] = {0.f, 0.f, 0.f, 0.f};
#pragma unroll 4
    for (int key = 0; key < 528; ++key) {
        const float v = key < 512 ? cv[(((size_t)bs * 512 + key) * 16 + h) * 64 + lane] : vn[((size_t)bs * 16 + (key - 512)) * DM + h * 64 + lane];
#pragma unroll
        for (int i = 0; i < 4; ++i) acc[i] += pb[i * 528 + key] * v;
    }
#pragma unroll
    for (int i = 0; i < 4; ++i) O[((size_t)NTP + bs * 16 + qg * 4 + i) * DM + h * 64 + lane] = (bf16_t)(cvtpk(acc[i], 0.f) & 0xffffu);
    asm volatile("s_waitcnt lgkmcnt(0)" ::: "memory");
}

__device__ __forceinline__ void p2_phase(LAS unsigned char* lds, int G, int tid, int wave, int lane) {
    for (int i = tid; i < 16 * 320; i += 512) { const int h = i / 320, j = i % 320; ((LAS float*)(lds + AT_TAB))[i] = A_IN(8)[h * 257 + (j > 256 ? 256 : j)] * LOG2E; }
    for (int u = blockIdx.x; u < 256 + 16; u += G) {
        __syncthreads();
        if (u < 256) {
            const int b = u >> 4, g = u & 15;
            lru_load_consts(lds, g, tid);
            __syncthreads();
            for (int tile = wave; tile < 128; tile += 8) lru_tile<false>(lds, lane, g, (size_t)b * SEQ, tile, b);
        } else {
            const int g = u - 256;
            lru_load_consts(lds, g, tid);
            __syncthreads();
            lru_tile<true>(lds, lane, g, (size_t)NTP + wave * 16, 0, wave);
        }
    }
    __syncthreads();
    const int gw = blockIdx.x * 8 + wave, NGW = G * 8;
    for (int u = gw; u < NB * 64 * 16; u += NGW) {
        const int c = u & 63, h = (u >> 6) & 15, b = u >> 10;
        attn_unit(lds, lane, b, c, h);
    }
    for (int t = gw; t < 512; t += NGW) attn_sample_task(lds, wave, lane, t);
}

__device__ __forceinline__ void p4b_phase(int G, int wave, int lane) {
    const int gw = blockIdx.x * 8 + wave, NGW = G * 8;
    const float* gm = A_IN(19); bf16_t* XT = (bf16_t*)(A_WS + WS_Q); unsigned char* XQ = A_WS + WS_XQ; float* SX = (float*)(A_WS + WS_SX);
    for (int m = gw; m < NTOK; m += NGW) {
        const float* xr = (m < NTP) ? A_OUT + O_YP + (size_t)m * DM : A_OUT + O_YS + (size_t)(m - NTP) * DM;
        bf16_t* orow = XT + (size_t)m * DM;
        f32x4 v[4]; float s = 0.f;
#pragma unroll
        for (int j = 0; j < 4; ++j) { v[j] = *(const f32x4*)(xr + j * 256 + lane * 4); s += (v[j][0] * v[j][0] + v[j][1] * v[j][1]) + (v[j][2] * v[j][2] + v[j][3] * v[j][3]); }
        const float inv = 1.0f / sqrtf(wave_sum(s) * (1.0f / DM) + EPS);
        float mx = 0.f;
#pragma unroll
        for (int j = 0; j < 4; ++j) { const f32x4 gg = *(const f32x4*)(gm + j * 256 + lane * 4); v[j] = v[j] * inv * gg;
            u32x2 w; w.x = cvtpk(v[j][0], v[j][1]); w.y = cvtpk(v[j][2], v[j][3]); *(u32x2*)(orow + j * 256 + lane * 4) = w;
            mx = fmaxf(mx, fmaxf(fmaxf(fabsf(v[j][0]), fabsf(v[j][1])), fmaxf(fabsf(v[j][2]), fabsf(v[j][3])))); }
#pragma unroll
        for (int o = 1; o < 64; o <<= 1) mx = fmaxf(mx, __shfl_xor(mx, o));
        const float step = fmaxf(mx, 1e-30f) * (1.0f / 127.0f), qi = 1.0f / step;
#pragma unroll
        for (int j = 0; j < 4; ++j) {
            const unsigned b0 = (unsigned)(int)rintf(v[j][0] * qi) & 0xffu, b1 = (unsigned)(int)rintf(v[j][1] * qi) & 0xffu, b2 = (unsigned)(int)rintf(v[j][2] * qi) & 0xffu, b3 = (unsigned)(int)rintf(v[j][3] * qi) & 0xffu;
            *(unsigned*)(XQ + (size_t)m * DM + j * 256 + lane * 4) = b0 | (b1 << 8) | (b2 << 16) | (b3 << 24); }
        if (lane == 0) SX[m] = step;
    }
}

__device__ __forceinline__ int f2key(float f) { const int b = __float_as_int(f); return b ^ ((b >> 31) & 0x7fffffff); }
__device__ __forceinline__ float key2f(int k) { return __int_as_float(k ^ ((k >> 31) & 0x7fffffff)); }
#define INS16(L, x) do { int x_ = (x); _Pragma("unroll") for (int j_ = 0; j_ < 16; ++j_) { const int hi_ = max(L[j_], x_); x_ = min(L[j_], x_); L[j_] = hi_; } } while (0)

constexpr size_t WS_PART = WS_XN;
constexpr int CT_U = 64, CT_V = 64 + 8 * 64;
constexpr int P6_TOKB = 128, P6_NITEM = NTOK / P6_TOKB, P6_TPW = P6_TOKB / 8;
constexpr size_t WS_CQ = WS_VT, WS_CS = WS_VT + 16 * MiB;
constexpr int P6_IDX = 0;
constexpr int P6_E = 0, P6_C = 8192, P6_ITEM = 16384;

__device__ __forceinline__ void p6a_phase(LAS unsigned char* lds, int G, int wave, int lane) {
    const int gw = blockIdx.x * 8 + wave, NGW = G * 8;
    const float* SC = (const float*)(A_WS + WS_XN);
    int* SELE = (int*)(A_WS + WS_SELE); float* SELG = (float*)(A_WS + WS_SELG);
    LAS int* idxb = (LAS int*)(lds + P6_IDX + wave * 4096);
    const int tl = lane >> 4, hh = (lane >> 1) & 7, half = lane & 1;
    for (int grp = gw; grp < NTOK / 4; grp += NGW) {
        const int tok = grp * 4 + tl;
        const float* sp = SC + (size_t)tok * 2048 + hh * 256 + half * 128;
        int L[16];
#pragma unroll
        for (int j = 0; j < 16; ++j) L[j] = (int)0x80000000;
        for (int c4 = 0; c4 < 32; c4 += 2) {
            const f32x4 v0 = *(const f32x4*)(sp + 4 * c4), v1 = *(const f32x4*)(sp + 4 * c4 + 4);
#pragma unroll
            for (int e = 0; e < 4; ++e) INS16(L, (f2key(v0[e]) & ~127) | (4 * c4 + e));
#pragma unroll
            for (int e = 0; e < 4; ++e) INS16(L, (f2key(v1[e]) & ~127) | (4 * c4 + 4 + e));
        }
#pragma unroll
        for (int j = 0; j < 16; ++j) idxb[lane * 16 + j] = L[j] & 127;
        float va[16], vb[16];
#pragma unroll
        for (int j = 0; j < 16; ++j) { const int own = L[j] & ~127, oth = __shfl_xor(own, 1); va[j] = key2f(half ? oth : own); vb[j] = key2f(half ? own : oth); }
        int C[16];
#pragma unroll
        for (int j = 0; j < 16; ++j) C[j] = (int)0x80000000;
#pragma unroll
        for (int i = 0; i < 16; ++i)
#pragma unroll
            for (int j = 0; j < 16; ++j) if ((i + 1) * (j + 1) <= 16) INS16(C, (f2key(va[i] + vb[j]) & ~255) | (i * 16 + j));
        const float mx = key2f(C[0] & ~255);
        float ev[16], sum = 0.f;
#pragma unroll
        for (int j = 0; j < 16; ++j) { ev[j] = __expf(key2f(C[j] & ~255) - mx); sum += ev[j]; }
        const float inv = 1.0f / sum;
        asm volatile("s_waitcnt lgkmcnt(0)" ::: "memory");
        int eo[8]; float go[8];
#pragma unroll
        for (int s = 0; s < 8; ++s) {
            int c_lo = C[s], c_hi = C[8 + s]; float e_lo = ev[s], e_hi = ev[8 + s];
            asm volatile("" : "+v"(c_lo), "+v"(c_hi), "+v"(e_lo), "+v"(e_hi));
            const int cc = half ? c_hi : c_lo; go[s] = (half ? e_hi : e_lo) * inv;
            const int ij = cc & 255, i1 = idxb[(lane & ~1) * 16 + (ij >> 4)], i2 = idxb[(lane | 1) * 16 + (ij & 15)];
            eo[s] = i1 * 128 + i2;
        }
        int* ep = SELE + (size_t)tok * 128 + hh * 16 + half * 8; float* gp = SELG + (size_t)tok * 128 + hh * 16 + half * 8;
        *(u32x4*)ep = (u32x4){(unsigned)eo[0], (unsigned)eo[1], (unsigned)eo[2], (unsigned)eo[3]}; *(u32x4*)(ep + 4) = (u32x4){(unsigned)eo[4], (unsigned)eo[5], (unsigned)eo[6], (unsigned)eo[7]};
        *(f32x4*)gp = (f32x4){go[0], go[1], go[2], go[3]}; *(f32x4*)(gp + 4) = (f32x4){go[4], go[5], go[6], go[7]};
        asm volatile("s_waitcnt lgkmcnt(0)" ::: "memory");
    }
}

__device__ __forceinline__ float dot2bf(unsigned a, unsigned b, float c) { return __builtin_amdgcn_fdot2_f32_bf16(__builtin_bit_cast(bf16x2_t, a), __builtin_bit_cast(bf16x2_t, b), c, false); }
__device__ __forceinline__ unsigned xcc_id() { return (unsigned)__builtin_amdgcn_s_getreg((3 << 11) | 20) & 0xFu; }
__device__ __forceinline__ float dpp_sum16(float v) {
    v += __builtin_bit_cast(float, __builtin_amdgcn_update_dpp(0, __builtin_bit_cast(int, v), 0xB1, 0xF, 0xF, true));
    v += __builtin_bit_cast(float, __builtin_amdgcn_update_dpp(0, __builtin_bit_cast(int, v), 0x4E, 0xF, 0xF, true));
    v += __builtin_bit_cast(float, __builtin_amdgcn_update_dpp(0, __builtin_bit_cast(int, v), 0x141, 0xF, 0xF, true));
    v += __builtin_bit_cast(float, __builtin_amdgcn_update_dpp(0, __builtin_bit_cast(int, v), 0x140, 0xF, 0xF, true));
    return v;
}
__device__ __forceinline__ bool p6_claim(LAS unsigned char* lds, unsigned* cnt, int tid, int& ring, int home, int& slice, int& item) {
    for (;;) {
        if (ring >= 8) return false;
        slice = (home + ring) & 7;
        __syncthreads();
        if (tid == 0) *(volatile LAS int*)(lds + P6_ITEM) = (int)__hip_atomic_fetch_add(cnt + 64 * slice, 1u, __ATOMIC_RELAXED, __HIP_MEMORY_SCOPE_AGENT);
        __syncthreads();
        item = *(volatile LAS int*)(lds + P6_ITEM);
        if (item < P6_NITEM) return true;
        ++ring;
    }
}

__device__ __forceinline__ float ub0(unsigned w) { return (float)(w & 0xffu); }
__device__ __forceinline__ float ub1(unsigned w) { return (float)((w >> 8) & 0xffu); }
__device__ __forceinline__ float ub2(unsigned w) { return (float)((w >> 16) & 0xffu); }
__device__ __forceinline__ float ub3(unsigned w) { return (float)(w >> 24); }
__device__ __forceinline__ float dpp_sum8(float v) {
    v += __builtin_bit_cast(float, __builtin_amdgcn_update_dpp(0, __builtin_bit_cast(int, v), 0xB1, 0xF, 0xF, true));
    v += __builtin_bit_cast(float, __builtin_amdgcn_update_dpp(0, __builtin_bit_cast(int, v), 0x4E, 0xF, 0xF, true));
    v += __builtin_bit_cast(float, __builtin_amdgcn_update_dpp(0, __builtin_bit_cast(int, v), 0x141, 0xF, 0xF, true));
    return v;
}
__device__ __forceinline__ int dpp_isum8(int v) {
    v += __builtin_amdgcn_update_dpp(0, v, 0xB1, 0xF, 0xF, true);
    v += __builtin_amdgcn_update_dpp(0, v, 0x4E, 0xF, 0xF, true);
    v += __builtin_amdgcn_update_dpp(0, v, 0x141, 0xF, 0xF, true);
    return v;
}
__device__ __forceinline__ void p6b_phase(LAS unsigned char* lds, int tid, int wave, int lane) {
    const unsigned char* XQ = A_WS + WS_XQ; const unsigned char* UB = A_WS + WS_UB; const float* SX = (const float*)(A_WS + WS_SX);
    const int* SELE = (const int*)(A_WS + WS_SELE); float* PART = (float*)(A_WS + WS_PART);
    unsigned* cnt = (unsigned*)(A_WS + WS_CTL) + CT_U;
    const int i8 = lane & 7, grp = lane >> 3, home = (int)(xcc_id() & 7u);
    LAS int* eb = (LAS int*)(lds + P6_E + wave * 1024);
    int ring = 0, slice, item;
    while (p6_claim(lds, cnt, tid, ring, home, slice, item)) {
        const int tok0 = item * P6_TOKB + wave * P6_TPW;
        int e0 = SELE[(size_t)tok0 * 128 + lane], e1 = SELE[(size_t)tok0 * 128 + 64 + lane];
#pragma unroll 2
        for (int ti = 0; ti < P6_TPW; ++ti) {
            const int tok = tok0 + ti;
            LAS int* ebt = eb + (ti & 1) * 128;
            ebt[lane] = e0; ebt[64 + lane] = e1;
            if (ti < P6_TPW - 1) { e0 = SELE[(size_t)(tok + 1) * 128 + lane]; e1 = SELE[(size_t)(tok + 1) * 128 + 64 + lane]; }
            const u32x4 xq = *(const u32x4*)(XQ + (size_t)tok * DM + slice * 128 + i8 * 16);
            const int x0 = (int)xq.x, x1 = (int)xq.y, x2 = (int)xq.z, x3 = (int)xq.w;
            const float sx = SX[tok];
            const unsigned char* ub = UB + slice * 128 + i8 * 16;
            asm volatile("s_waitcnt lgkmcnt(0)" ::: "memory");
            u32x4 uv[16];
#pragma unroll
            for (int q = 0; q < 16; ++q) { const int e = ebt[16 * grp + q]; uv[q] = *(const u32x4*)(ub + (size_t)e * DM); }
            int res0 = 0, res1 = 0;
#pragma unroll
            for (int q = 0; q < 16; ++q) {
                const int a0 = (int)uv[q].x, a1 = (int)uv[q].y, a2 = (int)uv[q].z, a3 = (int)uv[q].w;
                int d = __builtin_amdgcn_sdot4(a0, x0, 0, false); d = __builtin_amdgcn_sdot4(a1, x1, d, false); d = __builtin_amdgcn_sdot4(a2, x2, d, false); d = __builtin_amdgcn_sdot4(a3, x3, d, false);
                d = dpp_isum8(d);
                if (q < 8) res0 = (i8 == q) ? d : res0; else res1 = (i8 == (q - 8)) ? d : res1;
            }
            float* pp = PART + ((size_t)slice * NTOK + tok) * 128 + 16 * grp + i8;
            pp[0] = (float)res0 * sx; pp[8] = (float)res1 * sx;
        }
    }
}

__device__ __forceinline__ void p6m_phase(int G, int wave, int lane) {
    const int gw = blockIdx.x * 8 + wave, NGW = G * 8;
    const float* SU = (const float*)(A_WS + WS_SU); const float* SV = (const float*)(A_WS + WS_SV);
    const int* SELE = (const int*)(A_WS + WS_SELE); const float* SELG = (const float*)(A_WS + WS_SELG); const float* PART = (const float*)(A_WS + WS_PART);
    unsigned char* CQ = A_WS + WS_CQ; float* CS = (float*)(A_WS + WS_CS);
    for (int tok = gw; tok < NTOK; tok += NGW) {
        float a0 = 0.f, a1 = 0.f;
#pragma unroll
        for (int j = 0; j < 8; ++j) { const float* pp = PART + ((size_t)j * NTOK + tok) * 128; a0 += pp[lane]; a1 += pp[64 + lane]; }
        const int e0 = SELE[(size_t)tok * 128 + lane], e1 = SELE[(size_t)tok * 128 + 64 + lane];
        const float c0 = SELG[(size_t)tok * 128 + lane] * gelu_tanh(a0 * SU[e0]) * SV[e0], c1 = SELG[(size_t)tok * 128 + 64 + lane] * gelu_tanh(a1 * SU[e1]) * SV[e1];
        float mx = fmaxf(fabsf(c0), fabsf(c1));
#pragma unroll
        for (int o = 1; o < 64; o <<= 1) mx = fmaxf(mx, __shfl_xor(mx, o));
        const float cstep = fmaxf(mx, 1e-30f) * (1.0f / 127.0f), cinv = 1.0f / cstep;
        CQ[(size_t)tok * 128 + lane] = (unsigned char)((int)rintf(c0 * cinv) & 0xff); CQ[(size_t)tok * 128 + 64 + lane] = (unsigned char)((int)rintf(c1 * cinv) & 0xff);
        if (lane == 0) CS[tok] = cstep;
    }
}

__device__ __forceinline__ void p6c_phase(LAS unsigned char* lds, int tid, int wave, int lane) {
    const unsigned char* VB = A_WS + WS_VB; const int* SELE = (const int*)(A_WS + WS_SELE);
    const unsigned char* CQ = A_WS + WS_CQ; const float* CS = (const float*)(A_WS + WS_CS);
    unsigned* cnt = (unsigned*)(A_WS + WS_CTL) + CT_V;
    float* out = A_OUT;
    const int i8 = lane & 7, grp = lane >> 3, home = (int)(xcc_id() & 7u);
    LAS int* eb = (LAS int*)(lds + P6_E + wave * 1024);
    LAS int* cbb = (LAS int*)(lds + P6_C + wave * 512);
    int ring = 0, slice, item;
    while (p6_claim(lds, cnt, tid, ring, home, slice, item)) {
        const int tok0 = item * P6_TOKB + wave * P6_TPW;
        int e0 = SELE[(size_t)tok0 * 128 + lane], e1 = SELE[(size_t)tok0 * 128 + 64 + lane];
        int cw = ((const int*)(CQ + (size_t)tok0 * 128))[lane & 31];
        float cstep = CS[tok0];
#pragma unroll 2
        for (int ti = 0; ti < P6_TPW; ++ti) {
            const int tok = tok0 + ti;
            LAS int* ebt = eb + (ti & 1) * 128; LAS int* cbt = cbb + (ti & 1) * 32;
            ebt[lane] = e0; ebt[64 + lane] = e1; if (lane < 32) cbt[lane] = cw;
            const float cs = cstep;
            if (ti < P6_TPW - 1) { e0 = SELE[(size_t)(tok + 1) * 128 + lane]; e1 = SELE[(size_t)(tok + 1) * 128 + 64 + lane]; cw = ((const int*)(CQ + (size_t)(tok + 1) * 128))[lane & 31]; cstep = CS[tok + 1]; }
            float* yr = ((tok < NTP) ? out + O_YP + (size_t)tok * DM : out + O_YS + (size_t)(tok - NTP) * DM) + slice * 128 + i8 * 16;
            f32x4 z[4];
            if (lane < 8) {
#pragma unroll
                for (int q = 0; q < 4; ++q) z[q] = *(const f32x4*)(yr + 4 * q);
            }
            const unsigned char* vb = VB + slice * 128 + i8 * 16;
            asm volatile("s_waitcnt lgkmcnt(0)" ::: "memory");
            u32x4 vv[16];
#pragma unroll
            for (int q = 0; q < 16; ++q) { const int e = ebt[16 * grp + q]; vv[q] = *(const u32x4*)(vb + (size_t)e * DM); }
            int acc[16];
#pragma unroll
            for (int r = 0; r < 16; ++r) acc[r] = 0;
#pragma unroll
            for (int a4 = 0; a4 < 4; ++a4) {
                const int cq = cbt[4 * grp + a4];
#pragma unroll
                for (int d = 0; d < 4; ++d) {
                    const unsigned ra = vv[4 * a4][d], rb = vv[4 * a4 + 1][d], rc = vv[4 * a4 + 2][d], rd = vv[4 * a4 + 3][d];
                    const unsigned lo = __builtin_amdgcn_perm(rb, ra, 0x05010400u), hi = __builtin_amdgcn_perm(rb, ra, 0x07030602u);
                    const unsigned lo2 = __builtin_amdgcn_perm(rd, rc, 0x05010400u), hi2 = __builtin_amdgcn_perm(rd, rc, 0x07030602u);
                    const unsigned t0 = __builtin_amdgcn_perm(lo2, lo, 0x05040100u), t1 = __builtin_amdgcn_perm(lo2, lo, 0x07060302u);
                    const unsigned t2 = __builtin_amdgcn_perm(hi2, hi, 0x05040100u), t3 = __builtin_amdgcn_perm(hi2, hi, 0x07060302u);
                    acc[4 * d + 0] = __builtin_amdgcn_sdot4((int)t0, cq, acc[4 * d + 0], false); acc[4 * d + 1] = __builtin_amdgcn_sdot4((int)t1, cq, acc[4 * d + 1], false);
                    acc[4 * d + 2] = __builtin_amdgcn_sdot4((int)t2, cq, acc[4 * d + 2], false); acc[4 * d + 3] = __builtin_amdgcn_sdot4((int)t3, cq, acc[4 * d + 3], false);
                }
            }
#pragma unroll
            for (int r = 0; r < 16; ++r) { acc[r] += __shfl_xor(acc[r], 8); acc[r] += __shfl_xor(acc[r], 16); acc[r] += __shfl_xor(acc[r], 32); }
            if (lane < 8) {
#pragma unroll
                for (int q = 0; q < 4; ++q) { z[q] += (f32x4){(float)acc[4 * q] * cs, (float)acc[4 * q + 1] * cs, (float)acc[4 * q + 2] * cs, (float)acc[4 * q + 3] * cs}; *(f32x4*)(yr + 4 * q) = z[q]; }
            }
        }
    }
}

__device__ __forceinline__ void p6d_phase(int G, int wave, int lane) {
    const int gw = blockIdx.x * 8 + wave, NGW = G * 8;
    const float* gf = A_IN(25); float* out = A_OUT;
    for (int m = gw; m < NTOK; m += NGW) {
        float* yr = (m < NTP) ? out + O_YP + (size_t)m * DM : out + O_YS + (size_t)(m - NTP) * DM;
        f32x4 v[4]; float s = 0.f;
#pragma unroll
        for (int j = 0; j < 4; ++j) { v[j] = *(const f32x4*)(yr + j * 256 + lane * 4); s += (v[j][0] * v[j][0] + v[j][1] * v[j][1]) + (v[j][2] * v[j][2] + v[j][3] * v[j][3]); }
        const float inv = 1.0f / sqrtf(wave_sum(s) * (1.0f / DM) + EPS);
#pragma unroll
        for (int j = 0; j < 4; ++j) { const f32x4 gg = *(const f32x4*)(gf + j * 256 + lane * 4); *(f32x4*)(yr + j * 256 + lane * 4) = v[j] * inv * gg; }
    }
}

#define XB_TMO      128
#define XB_XCNT(j)  (256  + 64 * (j))
#define XB_XSUB(j)  (1280 + 64 * (j))
#define XB_XGEN(j)  (2304 + 64 * (j))
#define XB_TOP      3328
#define XB_TOPGEN   3392
#define XB_SPIN_CAP (1u << 22)
constexpr int CW_BAR = 2048;
constexpr int LDS_MISC = 131072 + 64;
__device__ __forceinline__ unsigned xb_ld(unsigned* p)              { return __hip_atomic_load(p, __ATOMIC_RELAXED, __HIP_MEMORY_SCOPE_AGENT); }
__device__ __forceinline__ unsigned xb_add(unsigned* p, unsigned v) { return __hip_atomic_fetch_add(p, v, __ATOMIC_RELAXED, __HIP_MEMORY_SCOPE_AGENT); }
#define XB_SPIN(cond, bar) do { unsigned _sp = 0; while (cond) { __builtin_amdgcn_s_sleep(1); \
    if ((++_sp & 255u) == 0u) { if (xb_ld(&(bar)[XB_TMO])) break; if (_sp > XB_SPIN_CAP) { atomicAdd(&(bar)[XB_TMO], 1u); break; } } } } while (0)
struct XcdBarrier { unsigned* bar; unsigned x; volatile LAS unsigned* st; };
__device__ __forceinline__ XcdBarrier xcd_barrier_post(unsigned* bar, volatile LAS unsigned* st) {
    XcdBarrier b; b.bar = bar; b.x = (unsigned)__builtin_amdgcn_s_getreg((3 << 11) | 20) & 0xFu; b.st = st;
    if (threadIdx.x == 0) (void)xb_add(&bar[XB_XCNT(b.x)], 1u);
    return b;
}
__device__ __forceinline__ void xcd_barrier_complete(unsigned* bar, unsigned x, unsigned& nloc, unsigned& nx) {
    const unsigned G = gridDim.x * gridDim.y * gridDim.z;
    unsigned sum, cnt, mine, sp = 0u;
    for (;;) {
        sum = 0u; cnt = 0u; mine = 0u;
#pragma unroll
        for (unsigned j = 0; j < 16; ++j) { const unsigned c = xb_ld(&bar[XB_XCNT(j)]); sum += c; cnt += (c > 0u) ? 1u : 0u; mine = (j == x) ? c : mine; }
        if (sum == G) break;
        __builtin_amdgcn_s_sleep(1);
        if ((++sp & 255u) == 0u) { if (xb_ld(&bar[XB_TMO])) break; if (sp > XB_SPIN_CAP) { atomicAdd(&bar[XB_TMO], 1u); break; } }
    }
    nloc = mine > 0u ? mine : 1u; nx = cnt > 0u ? cnt : 1u;
}
__device__ __forceinline__ void xcd_barrier(const XcdBarrier& b) {
    asm volatile("s_waitcnt vmcnt(0)" ::: "memory");
    __syncthreads();
    if (threadIdx.x == 0) {
        unsigned* bar = b.bar;
        __builtin_amdgcn_s_waitcnt(0);
        unsigned nloc = b.st[0], nx = b.st[1];
        if (nloc == 0u) { xcd_barrier_complete(bar, b.x, nloc, nx); b.st[0] = nloc; b.st[1] = nx; }
        const unsigned old = xb_add(&bar[XB_XSUB(b.x)], 1u);
        const unsigned gen = old / nloc;
        if (old + 1u == (gen + 1u) * nloc) {
            __builtin_amdgcn_fence(__ATOMIC_RELEASE, "agent");
            asm volatile("s_waitcnt vmcnt(0)" ::: "memory");
            const unsigned og = xb_add(&bar[XB_TOP], 1u);
            const unsigned tg = og / nx;
            if (og + 1u == (tg + 1u) * nx) xb_add(&bar[XB_TOPGEN], 1u);
            else XB_SPIN(xb_ld(&bar[XB_TOPGEN]) == tg, bar);
            __builtin_amdgcn_fence(__ATOMIC_ACQUIRE, "agent");
            xb_add(&bar[XB_XGEN(b.x)], 1u);
            asm volatile("s_waitcnt vmcnt(0)" ::: "memory");
        } else {
            XB_SPIN(xb_ld(&bar[XB_XGEN(b.x)]) == gen, bar);
            __builtin_amdgcn_fence(__ATOMIC_ACQUIRE, "agent");
            asm volatile("s_waitcnt vmcnt(0)" ::: "memory");
        }
    }
    __syncthreads();
}

__global__ void __launch_bounds__(512, 2) hybrid_fwd(Args a) {
    extern __shared__ __attribute__((aligned(16))) unsigned char lds_raw[];
    LAS unsigned char* lds = (LAS unsigned char*)lds_raw;
    const int tid = threadIdx.x, lane = tid & 63, wave = __builtin_amdgcn_readfirstlane(tid >> 6), G = gridDim.x;
    cg::grid_group grid = cg::this_grid();
    unsigned char* ws = A_WS;
    if (tid < 2) ((volatile LAS unsigned*)(lds + LDS_MISC))[tid] = 0u;
    __syncthreads();
    XcdBarrier xbar; xbar.bar = (unsigned*)(ws + WS_CTL) + CW_BAR; xbar.x = 0; xbar.st = nullptr;
    if (KA->use_sync) xbar = xcd_barrier_post((unsigned*)(ws + WS_CTL) + CW_BAR, (volatile LAS unsigned*)(lds + LDS_MISC));
#define IN(k) (KA->ph_lo <= (k) && (k) < KA->ph_hi)
#define SEAM(k) do { if (KA->use_sync && IN(k) && IN((k) + 1)) { if ((k) == 0) grid.sync(); else xcd_barrier(xbar); } } while (0)
    if (IN(0)) { p0_prologue(lds, G, wave, lane); }
    SEAM(0);
    if (IN(1)) {
        pg8::Gemm g{(const bf16_t*)(ws + WS_XN), (const bf16_t*)(ws + WS_WIN), (const bf16_t*)(ws + WS_WIN) + (size_t)2048 * DM, (const bf16_t*)(ws + WS_XN), DM};
        SchedG1 S; S.init(G, blockIdx.x); EpiG1 E;
        pg8::gemm_phase(lds, g, S, E);
    }
    SEAM(1);
    if (IN(2)) { p2_phase(lds, G, tid, wave, lane); }
    SEAM(2);
    if (IN(3)) {
        pg8::Gemm g{(const bf16_t*)(ws + WS_XN), (const bf16_t*)(ws + WS_WBA), (const bf16_t*)(ws + WS_G), (const bf16_t*)(ws + WS_WBL), DM};
        SchedPair S; S.init(4, G, blockIdx.x); EpiP3 E;
        pg8::gemm_phase(lds, g, S, E);
    }
    SEAM(3);
    if (IN(4)) {
        pg8::Gemm g{(const bf16_t*)(ws + WS_XR), (const bf16_t*)(ws + WS_WO), (const bf16_t*)(ws + WS_XR), (const bf16_t*)(ws + WS_WO), DM};
        SchedOne S; S.init(4, G, blockIdx.x); EpiP4 E;
        pg8::gemm_phase(lds, g, S, E);
    }
    SEAM(4);
    if (IN(5)) { p4b_phase(G, wave, lane); }
    SEAM(5);
    if (IN(6)) {
        pg8::Gemm g{(const bf16_t*)(ws + WS_Q), (const bf16_t*)(ws + WS_WS), (const bf16_t*)(ws + WS_Q), (const bf16_t*)(ws + WS_WS), DM};
        SchedOne S; S.init(8, G, blockIdx.x); EpiP5 E;
        pg8::gemm_phase(lds, g, S, E);
    }
    SEAM(6);
    if (IN(7)) { p6a_phase(lds, G, wave, lane); }
    SEAM(7);
    if (IN(8)) { p6b_phase(lds, tid, wave, lane); }
    SEAM(8);
    if (IN(9)) { p6m_phase(G, wave, lane); }
    SEAM(9);
    if (IN(10)) { p6c_phase(lds, tid, wave, lane); }
    SEAM(10);
    if (IN(11)) { p6d_phase(G, wave, lane); }
#undef IN
#undef SEAM
}

#ifndef N_LAUNCH_MODE
#define N_LAUNCH_MODE 1
#endif
constexpr int NPH = 12;
extern "C" void kernel_launch(void* const* d_in, const int* in_sizes, int n_in, void* d_out, int out_size, void* d_ws, size_t ws_size, hipStream_t stream) {
    static int grid = 0;
    if (grid == 0) {
        if (n_in != 26 || (size_t)out_size != O_END || ws_size < WS_END) { fprintf(stderr, "kernel_launch: unexpected sizes n_in %d out %d ws %zu (need %zu)\n", n_in, out_size, ws_size, (size_t)WS_END); grid = -1; return; }
        int dev = 0, cus = 0, per_cu = 0;
        (void)hipGetDevice(&dev); (void)hipDeviceGetAttribute(&cus, hipDeviceAttributeMultiprocessorCount, dev);
        (void)hipFuncSetAttribute((const void*)hybrid_fwd, hipFuncAttributeMaxDynamicSharedMemorySize, LDS_BYTES);
        (void)hipOccupancyMaxActiveBlocksPerMultiprocessor(&per_cu, (const void*)hybrid_fwd, 512, LDS_BYTES);
        if (per_cu < 1) { fprintf(stderr, "kernel_launch: occupancy query says %d blocks per CU\n", per_cu); per_cu = 1; }
        grid = cus;
        (void)hipGetLastError();
    }
    if (grid < 0) return;
    (void)hipMemsetAsync((char*)d_ws + WS_CTL, 0, 32768, stream);
    Args a{};
    for (int i = 0; i < 26; ++i) a.in[i] = (const float*)d_in[i];
    a.out = (float*)d_out; a.ws = (unsigned char*)d_ws;
    if (N_LAUNCH_MODE == 1) {
        a.ph_lo = 0; a.ph_hi = NPH; a.use_sync = 1;
        void* args[] = {&a};
        hipError_t e = hipLaunchCooperativeKernel((const void*)hybrid_fwd, dim3(grid), dim3(512), args, LDS_BYTES, stream);
        if (e != hipSuccess) fprintf(stderr, "cooperative launch failed: %s (grid %d)\n", hipGetErrorString(e), grid);
    } else {
        for (int p = 0; p < NPH; ++p) { a.ph_lo = p; a.ph_hi = p + 1; a.use_sync = 0; hipLaunchKernelGGL(hybrid_fwd, dim3(grid), dim3(512), LDS_BYTES, stream, a); }
    }
}
```

```cpp
#include <hip/hip_runtime.h>
#include <hip/hip_cooperative_groups.h>
#include <cstdint>
#include <cstdio>
namespace cg = cooperative_groups;

#define LAS __attribute__((address_space(3)))
typedef unsigned short bf16_t;
typedef short bf16x8 __attribute__((ext_vector_type(8)));
typedef float f32x4 __attribute__((ext_vector_type(4)));
typedef float f32x2 __attribute__((ext_vector_type(2)));
typedef float f32x16 __attribute__((ext_vector_type(16)));
typedef unsigned u32x4 __attribute__((ext_vector_type(4)));
typedef unsigned u32x2 __attribute__((ext_vector_type(2)));
typedef __bf16 bf16x2_t __attribute__((ext_vector_type(2)));

constexpr int DM = 1024, SEQ = 4096, NB = 16, NTP = NB * SEQ, NSB = 8, NST = 16, NTS = NSB * NST, NTOK = NTP + NTS;
constexpr int ROWS = 65792, NMT = 257;
constexpr int INC = 7168, NEXP = 16384;
constexpr float EPS = 1e-6f, LOG2E = 1.4426950408889634f;
constexpr float QSCALE = 0.125f * LOG2E;

constexpr size_t MiB = 1u << 20;
constexpr size_t BUF = (size_t)ROWS * DM * 2;
constexpr size_t WS_CTL = 0;
constexpr size_t WS_WIN = 1 * MiB;
constexpr size_t WS_WBA = 16 * MiB, WS_WBL = 18 * MiB, WS_WO = 20 * MiB, WS_WS = 22 * MiB;
constexpr size_t WS_LRUW = 26 * MiB;
constexpr size_t WS_SGA = 27 * MiB, WS_SGR = 27 * MiB + 512 * 1024;
constexpr size_t WS_SU = 26 * MiB + 512 * 1024, WS_SV = 26 * MiB + 640 * 1024;
constexpr size_t WS_SX = 26 * MiB + 704 * 1024;
constexpr size_t WS_UB = 28 * MiB, WS_VB = 60 * MiB;
constexpr size_t WS_Q = 92 * MiB;
constexpr size_t WS_XN = WS_Q + BUF;
constexpr size_t WS_K = WS_XN + BUF;
constexpr size_t WS_VT = WS_K + BUF;
constexpr size_t WS_XR = WS_VT + BUF;
constexpr size_t WS_G = WS_XR + BUF;
constexpr size_t WS_END = WS_G + BUF;
constexpr size_t WS_SELE = WS_G, WS_SELG = WS_G + (size_t)NTOK * 512, WS_XQ = WS_G + (size_t)NTOK * 1024;

constexpr size_t O_YP = 0, O_YS = O_YP + (size_t)NTP * DM, O_KP = O_YS + (size_t)NTS * DM, O_VP = O_KP + (size_t)NB * 512 * DM,
                 O_CP = O_VP + (size_t)NB * 512 * DM, O_LP = O_CP + (size_t)NB * 3 * DM, O_KS = O_LP + (size_t)NB * DM, O_VS = O_KS + (size_t)NTS * DM,
                 O_CS = O_VS + (size_t)NTS * DM, O_LS = O_CS + (size_t)NSB * 3 * DM, O_END = O_LS + (size_t)NSB * DM;

constexpr int LDS_BYTES = 135168;

__device__ __forceinline__ unsigned cvtpk(float lo, float hi) { f32x2 v = {lo, hi}; bf16x2_t b = __builtin_convertvector(v, bf16x2_t); return __builtin_bit_cast(unsigned, b); }
__device__ __forceinline__ float bflo(unsigned u) { return __uint_as_float(u << 16); }
__device__ __forceinline__ float bfhi(unsigned u) { return __uint_as_float(u & 0xffff0000u); }
__device__ __forceinline__ float fast_exp2(float x) { return __builtin_amdgcn_exp2f(x); }
__device__ __forceinline__ float fast_rcp(float x) { return __builtin_amdgcn_rcpf(x); }
__device__ __forceinline__ float sigmoidf_(float z) { return fast_rcp(1.0f + fast_exp2(-z * LOG2E)); }
__device__ __forceinline__ float gelu_tanh(float x) { const float u = x + 0.044715f * x * x * x; return x * fast_rcp(1.0f + fast_exp2(-1.5957691216f * LOG2E * u)); }
__device__ __forceinline__ float wave_sum(float v) {
#pragma unroll
    for (int o = 1; o < 64; o <<= 1) v += __shfl_xor(v, o);
    return v;
}
__device__ __forceinline__ int swap23(int i) { return (i & ~12) | ((i & 4) << 1) | ((i & 8) >> 1); }
__device__ __forceinline__ float plswap_max(float m) { auto rr = __builtin_amdgcn_permlane32_swap(__float_as_uint(m), __float_as_uint(m), false, false); return fmaxf(__uint_as_float(rr[0]), __uint_as_float(rr[1])); }
__device__ __forceinline__ float plswap_add(float m) { auto rr = __builtin_amdgcn_permlane32_swap(__float_as_uint(m), __float_as_uint(m), false, false); return __uint_as_float(rr[0]) + __uint_as_float(rr[1]); }

namespace pg8 {
constexpr int BM = 256, BK = 64, HALF = 128, HTB = HALF * BK * 2, STAGE_BYTES = 8 * HTB, NXCD = 8, WGM = 8;
__host__ __device__ __forceinline__ int lds_byte(int r, int c) { const int st = (r >> 4) * 2 + (c >> 5), rr = r & 15, cc = c & 31, ob = rr * 64 + cc * 2; return st * 1024 + (ob ^ (((ob >> 9) & 1) << 5)); }
__host__ __device__ __forceinline__ void stage_rc(int b, int& R, int& C) { const int st = b / 1024, sb = b % 1024, swz = sb ^ (((sb >> 9) & 1) << 5); R = (st >> 1) * 16 + swz / 64; C = (st & 1) * 32 + (swz % 64) / 2; }
__host__ __device__ __forceinline__ int perm32(int rho) { const int n = rho >> 4, i = rho & 15; return 8 * (i >> 2) + 4 * n + (i & 3); }

struct Unit { int pm, pn, kind; };
struct Gemm { const bf16_t* A0; const bf16_t* B0; const bf16_t* A1; const bf16_t* B1; int K; };

struct TileMap {
    int nM, nN, nwg;
    __device__ __forceinline__ void init(int nM_, int nN_) { nM = nM_; nN = nN_; nwg = nM * nN; }
    __device__ __forceinline__ void map(int L, int& pm, int& pn) const {
        int wgid = L; { const int q = nwg / NXCD, r = nwg % NXCD, xcd = wgid % NXCD, off = wgid / NXCD; wgid = (xcd < r ? xcd * (q + 1) : r * (q + 1) + (xcd - r) * q) + off; }
        const int nig = WGM * nN, gid = wgid / nig, fm = gid * WGM, gsz = (nM - fm) < WGM ? (nM - fm) : WGM;
        pm = fm + ((wgid % nig) % gsz); pn = (wgid % nig) / gsz;
    }
};

template <class Epi, class Sched>
__device__ __forceinline__ void gemm_phase(LAS unsigned char* lds, const Gemm g, const Sched& S, const Epi& E) {
    const int tid = threadIdx.x, wid = __builtin_amdgcn_readfirstlane(tid >> 6), lane = tid & 63, wr = wid >> 2, wc = wid & 3, fr = lane & 15, fq = lane >> 4;
    const int K = g.K, nt = K / BK;
    unsigned voffA[2], voffB[2];
#pragma unroll
    for (int i = 0; i < 2; ++i) { int R, C; stage_rc(tid * 16 + i * 8192, R, C); const int Rb = (R & ~31) + perm32(R & 31);
        voffA[i] = (unsigned)(R * K + C) * 2u; voffB[i] = (unsigned)(Rb * K + C) * 2u; }
    const size_t kstep = (size_t)(BK * 2);
    const size_t hstep = (size_t)HALF * K * 2;
    const size_t tstep = 2 * hstep;
    const unsigned ldsw = (unsigned)wid * 1024u;
    const int aoff = lds_byte(wr * 64 + fr, fq * 8), boff = lds_byte(wc * 32 + fr, fq * 8);
#define PG8_SA(b, h) (((b) * 2 + (h)) * HTB)
#define PG8_SB(b, h) ((4 + (b) * 2 + (h)) * HTB)
#define PG8_STAGE(bufoff, gbase, voff) do { _Pragma("unroll") for (int _i = 0; _i < 2; ++_i) \
        __builtin_amdgcn_global_load_lds((const unsigned*)((const char*)(gbase) + (voff)[_i]), (LAS unsigned*)(lds + (bufoff) + ldsw + _i * 8192), 16, 0, 0); } while (0)
#define PG8_LDA(dst, b, h) do { _Pragma("unroll") for (int m = 0; m < 4; ++m) _Pragma("unroll") for (int k = 0; k < 2; ++k) dst[m][k] = *(const LAS bf16x8*)(lds + PG8_SA(b, h) + aoff + m * 2048 + k * 1024); } while (0)
#define PG8_LDB(dst, b, h) do { _Pragma("unroll") for (int n = 0; n < 2; ++n) _Pragma("unroll") for (int k = 0; k < 2; ++k) dst[n][k] = *(const LAS bf16x8*)(lds + PG8_SB(b, h) + boff + n * 2048 + k * 1024); } while (0)
#define PG8_MMA(ai, bj, At, Bt) do { __builtin_amdgcn_s_setprio(1); _Pragma("unroll") for (int m = 0; m < 4; ++m) _Pragma("unroll") for (int n = 0; n < 2; ++n) _Pragma("unroll") for (int k = 0; k < 2; ++k) \
        acc[ai][bj][m][n] = __builtin_amdgcn_mfma_f32_16x16x32_bf16(Bt[n][k], At[m][k], acc[ai][bj][m][n], 0, 0, 0); __builtin_amdgcn_s_setprio(0); } while (0)
#define PG8_WAIT_V(n) asm volatile("s_waitcnt vmcnt(" #n ")" ::: "memory")
#define PG8_WAIT_L(n) asm volatile("s_waitcnt lgkmcnt(" #n ")" ::: "memory")
#define PG8_BAR __builtin_amdgcn_s_barrier()
#define PG8_SCHED __builtin_amdgcn_sched_barrier(0)
    Unit cur, nxt; int ui = 0;
    if (!S.next(0, cur)) return;
    f32x4 acc[2][2][4][2];
#pragma unroll
    for (int a = 0; a < 2; ++a)
#pragma unroll
        for (int b = 0; b < 2; ++b)
#pragma unroll
            for (int m = 0; m < 4; ++m)
#pragma unroll
                for (int n = 0; n < 2; ++n) acc[a][b][m][n] = (f32x4){0.f, 0.f, 0.f, 0.f};
    bf16x8 At[4][2], B0[2][2], B1[2][2];
    const char* cA = (const char*)(cur.kind ? g.A1 : g.A0) + (size_t)cur.pm * tstep; const char* cB = (const char*)(cur.kind ? g.B1 : g.B0) + (size_t)cur.pn * tstep;
    PG8_STAGE(PG8_SB(0, 0), cB, voffB); PG8_STAGE(PG8_SB(0, 1), cB + hstep, voffB); PG8_STAGE(PG8_SA(0, 0), cA, voffA); PG8_STAGE(PG8_SA(0, 1), cA + hstep, voffA);
    if (wr == 1) PG8_BAR;
    PG8_WAIT_V(2); PG8_BAR;
    PG8_STAGE(PG8_SB(1, 0), cB + kstep, voffB); PG8_STAGE(PG8_SA(1, 0), cA + kstep, voffA); PG8_STAGE(PG8_SB(1, 1), cB + hstep + kstep, voffB);
    PG8_WAIT_V(6); PG8_BAR;
    for (;;) {
        const bool has_next = S.next(ui + 1, nxt);
        const char* nA = has_next ? (const char*)(nxt.kind ? g.A1 : g.A0) + (size_t)nxt.pm * tstep : cA; const char* nB = has_next ? (const char*)(nxt.kind ? g.B1 : g.B0) + (size_t)nxt.pn * tstep : cB;
        for (int t = 0; t < nt; t += 2) {
            const bool last = (t == nt - 2);
            const char* a1 = cA + (size_t)(t + 1) * kstep;
            const char* a2 = last ? nA : cA + (size_t)(t + 2) * kstep; const char* b2 = last ? nB : cB + (size_t)(t + 2) * kstep;
            const char* a3 = a2 + kstep; const char* b3 = b2 + kstep;
            PG8_LDB(B0, 0, 0); PG8_LDB(B1, 0, 1); PG8_SCHED; PG8_LDA(At, 0, 0); PG8_STAGE(PG8_SA(1, 1), a1 + hstep, voffA);
            PG8_WAIT_V(8); PG8_WAIT_L(0); PG8_BAR; PG8_MMA(0, 0, At, B0); PG8_MMA(0, 1, At, B1); PG8_BAR; PG8_SCHED;
            PG8_LDA(At, 0, 1); PG8_STAGE(PG8_SB(0, 0), b2, voffB); PG8_STAGE(PG8_SB(0, 1), b2 + hstep, voffB); PG8_STAGE(PG8_SA(0, 0), a2, voffA);
            PG8_WAIT_V(8); PG8_WAIT_L(0); PG8_BAR; PG8_MMA(1, 0, At, B0); PG8_MMA(1, 1, At, B1); PG8_BAR; PG8_SCHED;
            PG8_LDB(B0, 1, 0); PG8_LDB(B1, 1, 1); PG8_SCHED; PG8_LDA(At, 1, 0); PG8_STAGE(PG8_SA(0, 1), a2 + hstep, voffA);
            PG8_WAIT_V(8); PG8_WAIT_L(0); PG8_BAR; PG8_MMA(0, 0, At, B0); PG8_MMA(0, 1, At, B1); PG8_BAR; PG8_SCHED;
            PG8_LDA(At, 1, 1); PG8_STAGE(PG8_SB(1, 0), b3, voffB); PG8_STAGE(PG8_SB(1, 1), b3 + hstep, voffB); PG8_STAGE(PG8_SA(1, 0), a3, voffA);
            PG8_WAIT_V(8); PG8_WAIT_L(0); PG8_BAR; PG8_MMA(1, 0, At, B0); PG8_MMA(1, 1, At, B1); PG8_BAR; PG8_SCHED;
        }
        if (wr == 0) PG8_BAR;
        E(acc, cur, wr, wc, fr, fq);
        if (!has_next) break;
#pragma unroll
        for (int a = 0; a < 2; ++a)
#pragma unroll
            for (int b = 0; b < 2; ++b)
#pragma unroll
                for (int m = 0; m < 4; ++m)
#pragma unroll
                    for (int n = 0; n < 2; ++n) acc[a][b][m][n] = (f32x4){0.f, 0.f, 0.f, 0.f};
        cur = nxt; cA = nA; cB = nB; ++ui;
        if (wr == 1) PG8_BAR;
    }
    PG8_WAIT_V(0);
    PG8_BAR;
#undef PG8_SA
#undef PG8_SB
#undef PG8_STAGE
#undef PG8_LDA
#undef PG8_LDB
#undef PG8_MMA
#undef PG8_WAIT_V
#undef PG8_WAIT_L
#undef PG8_BAR
#undef PG8_SCHED
}
}
using pg8::Unit;

struct Args {
    const float* in[26];
    float* out; unsigned char* ws;
    int ph_lo, ph_hi, use_sync, pad;
};

typedef const __attribute__((address_space(4))) Args* ArgsP;
#define KA ((ArgsP)__builtin_amdgcn_kernarg_segment_ptr())
#define A_IN(k) (KA->in[k])
#define A_OUT (KA->out)
#define A_WS (KA->ws)

struct SchedG1 {
    pg8::TileMap m0, m1; int G, c;
    __device__ __forceinline__ void init(int G_, int c_) { m0.init(NMT, 24); m1.init(4, NMT); G = G_; c = c_; }
    __device__ __forceinline__ bool next(int i, Unit& u) const {
        int L = i * G + c;
        if (L < m0.nwg) { m0.map(L, u.pm, u.pn); u.pn = (u.pn < 8) ? u.pn : u.pn + 4; u.kind = 0; return true; }
        L -= m0.nwg; if (L >= m1.nwg) return false;
        m1.map(L, u.pm, u.pn); u.kind = 1; return true;
    }
};
struct SchedPair {
    pg8::TileMap m0; int G, c;
    __device__ __forceinline__ void init(int nN, int G_, int c_) { m0.init(NMT, nN); G = G_; c = c_; }
    __device__ __forceinline__ bool next(int i, Unit& u) const { const int L = (i >> 1) * G + c; if (L >= m0.nwg) return false; m0.map(L, u.pm, u.pn); u.kind = i & 1; return true; }
};
struct SchedOne {
    pg8::TileMap m0; int G, c;
    __device__ __forceinline__ void init(int nN, int G_, int c_) { m0.init(NMT, nN); G = G_; c = c_; }
    __device__ __forceinline__ bool next(int i, Unit& u) const { const int L = i * G + c; if (L >= m0.nwg) return false; m0.map(L, u.pm, u.pn); u.kind = 0; return true; }
};

#define EPI_PREP int fr_ = fr, fq_ = fq; asm volatile("" : "+v"(fr_), "+v"(fq_)); const int rl_ = wr * 64 + fr_, cl_ = wc * 32 + 8 * fq_;
#define EPI_LOOP_BEGIN \
    _Pragma("unroll") for (int ai = 0; ai < 2; ++ai) _Pragma("unroll") for (int m = 0; m < 4; ++m) { const int rit = ai * 128 + m * 16 + rl_; \
    _Pragma("unroll") for (int bj = 0; bj < 2; ++bj) { const int cit = bj * 128 + cl_; f32x4 v0 = acc[ai][bj][m][0], v1 = acc[ai][bj][m][1];
#define EPI_LOOP_END } }

struct EpiG1 {
    __device__ __forceinline__ void operator()(const f32x4 (&acc)[2][2][4][2], const Unit& u, int wr, int wc, int fr, int fq) const {
        EPI_PREP unsigned char* ws = A_WS; float* out = A_OUT;
        if (u.kind == 0) {
            const int t = u.pn >> 2, ct = (u.pn & 3) * 256;
            bf16_t* base;
            if (t == 0) base = (bf16_t*)(ws + WS_Q); else if (t == 1) base = (bf16_t*)(ws + WS_K); else if (t == 3) base = (bf16_t*)(ws + WS_XR); else if (t == 4) base = (bf16_t*)(ws + WS_G);
            else if (t == 5) base = (u.pm < 256) ? (bf16_t*)(out + O_YP) : (bf16_t*)(ws + WS_SGA) - (size_t)NTP * DM;
            else base = (u.pm < 256) ? (bf16_t*)(out + O_YP) + (size_t)NTP * DM : (bf16_t*)(ws + WS_SGR) - (size_t)NTP * DM;
            base += (size_t)u.pm * 256 * DM + ct;
            EPI_LOOP_BEGIN
                u32x4 w; w.x = cvtpk(v0[0], v0[1]); w.y = cvtpk(v0[2], v0[3]); w.z = cvtpk(v1[0], v1[1]); w.w = cvtpk(v1[2], v1[3]);
                *(u32x4*)(base + (size_t)rit * DM + cit) = w;
            EPI_LOOP_END
            if (t == 1 && u.pm < 256 && (u.pm & 15) >= 14) { float* p0 = out + O_KP + ((size_t)(u.pm >> 4) * 512 + ((u.pm & 15) - 14) * 256) * DM + ct;
                EPI_LOOP_BEGIN float* p = p0 + (size_t)rit * DM + cit; *(f32x4*)p = v0; *(f32x4*)(p + 4) = v1; EPI_LOOP_END }
            if (t == 1 && u.pm == 256) { float* p0 = out + O_KS + ct;
                EPI_LOOP_BEGIN if (rit < NTS) { float* p = p0 + (size_t)rit * DM + cit; *(f32x4*)p = v0; *(f32x4*)(p + 4) = v1; } EPI_LOOP_END }
            if (t == 3 && u.pm < 256 && (u.pm & 15) == 15) { float* p0 = out + O_CP + ((size_t)(u.pm >> 4) * 3) * DM + ct;
                EPI_LOOP_BEGIN if (rit >= 253) { float* p = p0 + (size_t)(rit - 253) * DM + cit; *(f32x4*)p = v0; *(f32x4*)(p + 4) = v1; } EPI_LOOP_END }
            if (t == 3 && u.pm == 256) { float* p0 = out + O_CS + ct;
                EPI_LOOP_BEGIN if (rit < NTS && (rit & 15) >= 13) { float* p = p0 + ((size_t)(rit >> 4) * 3 + ((rit & 15) - 13)) * DM + cit; *(f32x4*)p = v0; *(f32x4*)(p + 4) = v1; } EPI_LOOP_END }
        } else {
            bf16_t* VT = (bf16_t*)(ws + WS_VT) + (size_t)u.pm * 256 * ROWS + (size_t)u.pn * 256;
            EPI_LOOP_BEGIN
                u32x4 w; w.x = cvtpk(v0[0], v0[1]); w.y = cvtpk(v0[2], v0[3]); w.z = cvtpk(v1[0], v1[1]); w.w = cvtpk(v1[2], v1[3]);
                *(u32x4*)(VT + (size_t)rit * ROWS + cit) = w;
            EPI_LOOP_END
            if (u.pn < 256 && (u.pn & 15) >= 14) { float* p0 = out + O_VP + ((size_t)(u.pn >> 4) * 512 + ((u.pn & 15) - 14) * 256) * DM + u.pm * 256;
                EPI_LOOP_BEGIN float* p = p0 + (size_t)cit * DM + rit;
                    p[0] = v0[0]; p[DM] = v0[1]; p[2 * DM] = v0[2]; p[3 * DM] = v0[3]; p[4 * DM] = v1[0]; p[5 * DM] = v1[1]; p[6 * DM] = v1[2]; p[7 * DM] = v1[3]; EPI_LOOP_END }
            if (u.pn == 256) { float* p0 = out + O_VS + u.pm * 256;
                EPI_LOOP_BEGIN if (cit < NTS) { float* p = p0 + (size_t)cit * DM + rit;
                    p[0] = v0[0]; p[DM] = v0[1]; p[2 * DM] = v0[2]; p[3 * DM] = v0[3]; p[4 * DM] = v1[0]; p[5 * DM] = v1[1]; p[6 * DM] = v1[2]; p[7 * DM] = v1[3]; } EPI_LOOP_END }
        }
    }
};

struct EpiP3 {
    __device__ __forceinline__ void operator()(const f32x4 (&acc)[2][2][4][2], const Unit& u, int wr, int wc, int fr, int fq) const {
        EPI_PREP unsigned char* ws = A_WS; float* out = A_OUT;
        const bf16_t* gb = (u.pm < 256) ? (const bf16_t*)(out + O_YP) + (u.kind ? (size_t)NTP * DM : 0) : (const bf16_t*)(ws + (u.kind ? WS_SGR : WS_SGA)) - (size_t)NTP * DM;
        const size_t off0 = (size_t)u.pm * 256 * DM + u.pn * 256;
        gb += off0; float* T1 = (float*)(ws + WS_K) + off0; bf16_t* MG = (bf16_t*)(ws + WS_XR) + off0;
        EPI_LOOP_BEGIN
            const size_t off = (size_t)rit * DM + cit;
            const u32x4 gw = *(const u32x4*)(gb + off);
            f32x4 s0, s1;
            s0[0] = sigmoidf_(bflo(gw.x)); s0[1] = sigmoidf_(bfhi(gw.x)); s0[2] = sigmoidf_(bflo(gw.y)); s0[3] = sigmoidf_(bfhi(gw.y));
            s1[0] = sigmoidf_(bflo(gw.z)); s1[1] = sigmoidf_(bfhi(gw.z)); s1[2] = sigmoidf_(bflo(gw.w)); s1[3] = sigmoidf_(bfhi(gw.w));
            if (u.kind == 0) { *(f32x4*)(T1 + off) = s0 * v0; *(f32x4*)(T1 + off + 4) = s1 * v1; }
            else { const f32x4 a0 = *(const f32x4*)(T1 + off) + s0 * v0, a1 = *(const f32x4*)(T1 + off + 4) + s1 * v1;
                u32x4 w; w.x = cvtpk(a0[0], a0[1]); w.y = cvtpk(a0[2], a0[3]); w.z = cvtpk(a1[0], a1[1]); w.w = cvtpk(a1[2], a1[3]);
                *(u32x4*)(MG + off) = w; }
        EPI_LOOP_END
    }
};

struct EpiP4 {
    __device__ __forceinline__ void operator()(const f32x4 (&acc)[2][2][4][2], const Unit& u, int wr, int wc, int fr, int fq) const {
        EPI_PREP float* out = A_OUT;
        if (u.pm < 256) { const size_t off0 = (size_t)u.pm * 256 * DM + u.pn * 256; const float* xp = A_IN(0) + off0; float* yo = out + O_YP + off0;
            EPI_LOOP_BEGIN const size_t off = (size_t)rit * DM + cit;
                *(f32x4*)(yo + off) = *(const f32x4*)(xp + off) + v0; *(f32x4*)(yo + off + 4) = *(const f32x4*)(xp + off + 4) + v1; EPI_LOOP_END }
        else { const float* xs = A_IN(1) + u.pn * 256; float* yo = out + O_YS + u.pn * 256;
            EPI_LOOP_BEGIN if (rit < NTS) { const size_t off = (size_t)rit * DM + cit;
                *(f32x4*)(yo + off) = *(const f32x4*)(xs + off) + v0; *(f32x4*)(yo + off + 4) = *(const f32x4*)(xs + off + 4) + v1; } EPI_LOOP_END }
    }
};

struct EpiP5 {
    __device__ __forceinline__ void operator()(const f32x4 (&acc)[2][2][4][2], const Unit& u, int wr, int wc, int fr, int fq) const {
        EPI_PREP float* SC = (float*)(A_WS + WS_XN) + (size_t)u.pm * 256 * 2048 + u.pn * 256;
        EPI_LOOP_BEGIN
            float* p = SC + (size_t)rit * 2048 + cit; *(f32x4*)p = v0; *(f32x4*)(p + 4) = v1;
        EPI_LOOP_END
    }
};

__device__ __forceinline__ void p0_transpose_item(const float* W, int K, int N, bf16_t* WT, LAS float* scr, int item, int lane, int nscale = 0) {
    const int nblk = N / 32, kb = item / nblk, nb = item % nblk, k0 = 64 * kb, n0 = 32 * nb;
#pragma unroll 8
    for (int i = 0; i < 32; ++i) { const int kk = 2 * i + (lane >> 5); scr[kk * 33 + (lane & 31)] = W[(size_t)(k0 + kk) * N + n0 + (lane & 31)] * (n0 < nscale ? QSCALE : 1.0f); }
    asm volatile("s_waitcnt lgkmcnt(0)" ::: "memory");
    const int c = lane & 7;
#pragma unroll
    for (int j = 0; j < 4; ++j) { const int n = (lane >> 3) + 8 * j; const LAS float* s = scr + (8 * c) * 33 + n;
        u32x4 o; o.x = cvtpk(s[0 * 33], s[1 * 33]); o.y = cvtpk(s[2 * 33], s[3 * 33]); o.z = cvtpk(s[4 * 33], s[5 * 33]); o.w = cvtpk(s[6 * 33], s[7 * 33]);
        *(u32x4*)(WT + (size_t)(n0 + n) * K + k0 + 8 * c) = o; }
    asm volatile("s_waitcnt lgkmcnt(0)" ::: "memory");
}

__device__ __forceinline__ void p0_prologue(LAS unsigned char* lds, int G, int wave, int lane) {
    unsigned char* ws = A_WS;
    const int gw = blockIdx.x * 8 + wave, NGW = G * 8;
    LAS float* scr = (LAS float*)(lds + wave * 16384);
    constexpr int I_IN = 16 * (INC / 32), I_SQ = 16 * 32, NTR = I_IN + 3 * I_SQ;
    for (int it = gw; it < NTR; it += NGW) {
        int r = it;
        if (r < I_IN) { p0_transpose_item(A_IN(7), DM, INC, (bf16_t*)(ws + WS_WIN), scr, r, lane, 1024); continue; } r -= I_IN;
        if (r < I_SQ) { p0_transpose_item(A_IN(16), DM, DM, (bf16_t*)(ws + WS_WBA), scr, r, lane); continue; } r -= I_SQ;
        if (r < I_SQ) { p0_transpose_item(A_IN(17), DM, DM, (bf16_t*)(ws + WS_WBL), scr, r, lane); continue; } r -= I_SQ;
        p0_transpose_item(A_IN(18), DM, DM, (bf16_t*)(ws + WS_WO), scr, r, lane);
    }
    {
        const float* wq = A_IN(20); bf16_t* wst = (bf16_t*)(ws + WS_WS);
        const int r32 = lane & 31, hi = lane >> 5;
        for (int it = gw; it < 2048; it += NGW) {
            const int hj = it >> 7, kt = (it >> 5) & 3, ct = it & 31, h = hj >> 1, j = hj & 1;
            const float* ap = (j ? A_IN(22) : A_IN(21)) + ((size_t)(h * 128 + kt * 32 + r32)) * 128 + 64 * hi;
            const float* bp = wq + (size_t)(ct * 32 + r32) * 2048 + hj * 128 + 64 * hi;
            f32x16 acc = {};
#pragma unroll
            for (int s4 = 0; s4 < 16; ++s4) { const f32x4 av = *(const f32x4*)(ap + 4 * s4), bv = *(const f32x4*)(bp + 4 * s4);
                acc = __builtin_amdgcn_mfma_f32_32x32x2f32(av[0], bv[0], acc, 0, 0, 0); acc = __builtin_amdgcn_mfma_f32_32x32x2f32(av[1], bv[1], acc, 0, 0, 0);
                acc = __builtin_amdgcn_mfma_f32_32x32x2f32(av[2], bv[2], acc, 0, 0, 0); acc = __builtin_amdgcn_mfma_f32_32x32x2f32(av[3], bv[3], acc, 0, 0, 0); }
#pragma unroll
            for (int r = 0; r < 16; ++r) { const int key = kt * 32 + (r & 3) + 8 * (r >> 2) + 4 * hi;
                wst[(size_t)(hj * 128 + key) * DM + ct * 32 + r32] = (bf16_t)(cvtpk(acc[r], 0.f) & 0xffffu); }
        }
    }
    for (int it = gw; it < 2 * NEXP; it += NGW) {
        const int tb = it >= NEXP, e = it - tb * NEXP;
        const float* src = (tb ? A_IN(24) : A_IN(23)) + (size_t)e * DM + lane * 16;
        unsigned char* dst = ws + (tb ? WS_VB : WS_UB) + (size_t)e * DM + lane * 16;
        f32x4 p[4]; float mx = 0.f;
#pragma unroll
        for (int q = 0; q < 4; ++q) { p[q] = *(const f32x4*)(src + 4 * q); mx = fmaxf(mx, fmaxf(fmaxf(fabsf(p[q][0]), fabsf(p[q][1])), fmaxf(fabsf(p[q][2]), fabsf(p[q][3])))); }
#pragma unroll
        for (int o = 1; o < 64; o <<= 1) mx = fmaxf(mx, __shfl_xor(mx, o));
        const float step = fmaxf(mx, 1e-30f) * (1.0f / 127.0f), inv = 1.0f / step;
        u32x4 w;
#pragma unroll
        for (int q = 0; q < 4; ++q) {
            const int ob = 0;
            const unsigned b0 = (unsigned)((int)rintf(p[q][0] * inv) + ob) & 0xffu, b1 = (unsigned)((int)rintf(p[q][1] * inv) + ob) & 0xffu, b2 = (unsigned)((int)rintf(p[q][2] * inv) + ob) & 0xffu, b3 = (unsigned)((int)rintf(p[q][3] * inv) + ob) & 0xffu;
            w[q] = b0 | (b1 << 8) | (b2 << 16) | (b3 << 24); }
        *(u32x4*)dst = w;
        if (lane == 0) ((float*)(ws + (tb ? WS_SV : WS_SU)))[e] = step;
    }
    {
        const float* gm = A_IN(6); bf16_t* XN = (bf16_t*)(ws + WS_XN);
        for (int m = gw; m < ROWS; m += NGW) {
            bf16_t* orow = XN + (size_t)m * DM;
            if (m >= NTOK) {
#pragma unroll
                for (int j = 0; j < 2; ++j) *(u32x4*)(orow + j * 512 + lane * 8) = (u32x4){0u, 0u, 0u, 0u};
                continue; }
            const float* xr = (m < NTP) ? A_IN(0) + (size_t)m * DM : A_IN(1) + (size_t)(m - NTP) * DM;
            f32x4 v[4]; float s = 0.f;
#pragma unroll
            for (int j = 0; j < 4; ++j) { v[j] = *(const f32x4*)(xr + j * 256 + lane * 4); s += (v[j][0] * v[j][0] + v[j][1] * v[j][1]) + (v[j][2] * v[j][2] + v[j][3] * v[j][3]); }
            const float inv = 1.0f / sqrtf(wave_sum(s) * (1.0f / DM) + EPS);
#pragma unroll
            for (int j = 0; j < 4; ++j) { const f32x4 gg = *(const f32x4*)(gm + j * 256 + lane * 4); const f32x4 y = v[j] * inv * gg;
                u32x2 w; w.x = cvtpk(y[0], y[1]); w.y = cvtpk(y[2], y[3]); *(u32x2*)(orow + j * 256 + lane * 4) = w; }
        }
    }
    {
        bf16_t* fw = (bf16_t*)(ws + WS_LRUW);
        for (int f = gw; f < 256; f += NGW) {
            const int ks = f & 3, T = (f >> 2) & 1, gate = (f >> 3) & 1, g = f >> 4, i = lane & 31, hi = lane >> 5;
            const int outc = 32 * T + swap23(i);
            const float* W = (gate ? A_IN(13) : A_IN(11)) + (size_t)g * 4096;
            float x[8];
#pragma unroll
            for (int j = 0; j < 8; ++j) x[j] = W[(16 * ks + 8 * hi + j) * 64 + outc];
            u32x4 w; w.x = cvtpk(x[0], x[1]); w.y = cvtpk(x[2], x[3]); w.z = cvtpk(x[4], x[5]); w.w = cvtpk(x[6], x[7]);
            *(u32x4*)(fw + (size_t)f * 512 + lane * 8) = w;
        }
    }
}

constexpr int LR_WF = 0, LR_CW = 16384, LR_CB = LR_CW + 1024, LR_BR = LR_CB + 256, LR_BI = LR_BR + 256, LR_CS = LR_BI + 256, LR_CARRY = LR_CS + 256, LR_SEQ = LR_CARRY + 2048, LR_END = LR_SEQ + 64;

__device__ __forceinline__ void lru_load_consts(LAS unsigned char* lds, int g, int tid) {
    const u32x4* src = (const u32x4*)(A_WS + WS_LRUW + (size_t)g * 16384);
    for (int i = tid; i < 1024; i += 512) ((LAS u32x4*)(lds + LR_WF))[i] = src[i];
    if (tid < 256) ((LAS float*)(lds + LR_CW))[tid] = A_IN(9)[(tid >> 6) * DM + g * 64 + (tid & 63)];
    if (tid < 64) {
        const int c = g * 64 + tid;
        ((LAS float*)(lds + LR_CB))[tid] = A_IN(10)[c]; ((LAS float*)(lds + LR_BR))[tid] = A_IN(12)[c]; ((LAS float*)(lds + LR_BI))[tid] = A_IN(14)[c];
        ((LAS float*)(lds + LR_CS))[tid] = 8.0f * log1pf(expf(-A_IN(15)[c]));
    }
    if (tid < 8) ((LAS unsigned*)(lds + LR_SEQ))[tid] = 0xffffffffu;
}

template <bool SAMPLE>
__device__ __forceinline__ void lru_tile(LAS unsigned char* lds, int lane, int g, size_t rowbase, int tile, int bidx) {
    asm volatile("" : "+v"(lane));
    const int tl = lane & 31, hi = lane >> 5, t = tile * 32 + tl;
    const bf16_t* XR = (const bf16_t*)(A_WS + WS_XR); bf16_t* Gb = (bf16_t*)(A_WS + WS_G);
    const int cbase = g * 64 + 8 * hi;
    float xc[4][8];
    bf16x8 xf[4];
#pragma unroll
    for (int ks = 0; ks < 4; ++ks) {
        const f32x4 b0 = *(const LAS f32x4*)(lds + LR_CB + (16 * ks + 8 * hi) * 4), b1 = *(const LAS f32x4*)(lds + LR_CB + (16 * ks + 8 * hi) * 4 + 16);
#pragma unroll
        for (int j = 0; j < 4; ++j) { xc[ks][j] = b0[j]; xc[ks][4 + j] = b1[j]; }
#pragma unroll
        for (int tap = 0; tap < 4; ++tap) {
            const int rr = t - 3 + tap;
            float xv[8];
            {
                u32x4 w = *(const u32x4*)(XR + (rowbase + (rr < 0 ? 0 : rr)) * DM + cbase + 16 * ks);
                if (rr < 0) w = (u32x4){0u, 0u, 0u, 0u};
                xv[0] = bflo(w.x); xv[1] = bfhi(w.x); xv[2] = bflo(w.y); xv[3] = bfhi(w.y); xv[4] = bflo(w.z); xv[5] = bfhi(w.z); xv[6] = bflo(w.w); xv[7] = bfhi(w.w);
            }
            if (SAMPLE) {
                const float* sp = A_IN(4) + ((size_t)bidx * 3 + (rr < 0 ? 3 + rr : 0)) * DM + cbase + 16 * ks;
                const f32x4 p = *(const f32x4*)sp, q = *(const f32x4*)(sp + 4);
#pragma unroll
                for (int j = 0; j < 4; ++j) { xv[j] = rr < 0 ? p[j] : xv[j]; xv[4 + j] = rr < 0 ? q[j] : xv[4 + j]; }
            }
            const f32x4 w0 = *(const LAS f32x4*)(lds + LR_CW + (tap * 64 + 16 * ks + 8 * hi) * 4), w1 = *(const LAS f32x4*)(lds + LR_CW + (tap * 64 + 16 * ks + 8 * hi) * 4 + 16);
#pragma unroll
            for (int j = 0; j < 4; ++j) { xc[ks][j] += w0[j] * xv[j]; xc[ks][4 + j] += w1[j] * xv[4 + j]; }
        }
        u32x4 w; w.x = cvtpk(xc[ks][0], xc[ks][1]); w.y = cvtpk(xc[ks][2], xc[ks][3]); w.z = cvtpk(xc[ks][4], xc[ks][5]); w.w = cvtpk(xc[ks][6], xc[ks][7]);
        xf[ks] = __builtin_bit_cast(bf16x8, w);
        asm volatile("" ::: "memory");
    }
    float A[32], B[32];
#pragma unroll
    for (int T = 0; T < 2; ++T) {
        f32x16 ar = f32x16{}, ai = f32x16{};
#pragma unroll
        for (int ks = 0; ks < 4; ++ks) {
            const bf16x8 wr_ = *(const LAS bf16x8*)(lds + LR_WF + ((0 * 2 + T) * 4 + ks) * 1024 + lane * 16);
            const bf16x8 wi_ = *(const LAS bf16x8*)(lds + LR_WF + ((1 * 2 + T) * 4 + ks) * 1024 + lane * 16);
            ar = __builtin_amdgcn_mfma_f32_32x32x16_bf16(wr_, xf[ks], ar, 0, 0, 0);
            ai = __builtin_amdgcn_mfma_f32_32x32x16_bf16(wi_, xf[ks], ai, 0, 0, 0);
        }
#pragma unroll
        for (int q = 0; q < 2; ++q) {
            const int ks = 2 * T + q, lo = (16 * ks + 8 * hi) * 4;
            const f32x4 br0 = *(const LAS f32x4*)(lds + LR_BR + lo), br1 = *(const LAS f32x4*)(lds + LR_BR + lo + 16);
            const f32x4 bi0 = *(const LAS f32x4*)(lds + LR_BI + lo), bi1 = *(const LAS f32x4*)(lds + LR_BI + lo + 16);
            const f32x4 cs0 = *(const LAS f32x4*)(lds + LR_CS + lo), cs1 = *(const LAS f32x4*)(lds + LR_CS + lo + 16);
#pragma unroll
            for (int j = 0; j < 8; ++j) {
                const int r = 8 * q + j;
                const float brv = j < 4 ? br0[j & 3] : br1[j & 3], biv = j < 4 ? bi0[j & 3] : bi1[j & 3], csv = j < 4 ? cs0[j & 3] : cs1[j & 3];
                const float rg = sigmoidf_(ar[r] + brv), ig = sigmoidf_(ai[r] + biv);
                const float la = -csv * rg, av = fast_exp2(la * LOG2E);
                const float x2 = 2.0f * la;
                const float em = (x2 > -0.03f) ? -x2 * (1.0f + x2 * (0.5f + x2 * (0.16666667f + x2 * 0.041666668f))) : 1.0f - fast_exp2(x2 * LOG2E);
                A[16 * T + r] = av; B[16 * T + r] = sqrtf(em) * ig * xc[ks][j];
            }
        }
        asm volatile("" ::: "memory");
    }
#define LRU_STEP(CTRL, RM) _Pragma("unroll") for (int c = 0; c < 32; ++c) { \
        const float as_ = __builtin_bit_cast(float, __builtin_amdgcn_update_dpp(__builtin_bit_cast(int, 1.0f), __builtin_bit_cast(int, A[c]), CTRL, RM, 0xF, false)); \
        const float bs_ = __builtin_bit_cast(float, __builtin_amdgcn_update_dpp(0, __builtin_bit_cast(int, B[c]), CTRL, RM, 0xF, false)); \
        B[c] = A[c] * bs_ + B[c]; A[c] = A[c] * as_; }
    LRU_STEP(0x111, 0xF) LRU_STEP(0x112, 0xF) LRU_STEP(0x114, 0xF) LRU_STEP(0x118, 0xF) LRU_STEP(0x142, 0xA)
#undef LRU_STEP
    float hin[32];
    if (SAMPLE) {
        const float* hp = A_IN(5) + (size_t)bidx * DM + cbase;
#pragma unroll
        for (int ks = 0; ks < 4; ++ks) { const f32x4 p = *(const f32x4*)(hp + 16 * ks), q = *(const f32x4*)(hp + 16 * ks + 4);
#pragma unroll
            for (int j = 0; j < 4; ++j) { hin[8 * ks + j] = p[j]; hin[8 * ks + 4 + j] = q[j]; } }
    } else if (tile == 0) {
#pragma unroll
        for (int c = 0; c < 32; ++c) hin[c] = 0.f;
    } else {
        volatile LAS unsigned* sq = (volatile LAS unsigned*)(lds + LR_SEQ) + (tile & 7);
        while (*sq != (unsigned)tile) __builtin_amdgcn_s_sleep(1);
        asm volatile("" ::: "memory");
        const LAS float* cp = (const LAS float*)(lds + LR_CARRY) + (tile & 7) * 64 + 8 * hi;
#pragma unroll
        for (int ks = 0; ks < 4; ++ks) { const f32x4 p = *(const LAS f32x4*)(cp + 16 * ks), q = *(const LAS f32x4*)(cp + 16 * ks + 4);
#pragma unroll
            for (int j = 0; j < 4; ++j) { hin[8 * ks + j] = p[j]; hin[8 * ks + 4 + j] = q[j]; } }
    }
#pragma unroll
    for (int c = 0; c < 32; ++c) B[c] = B[c] + A[c] * hin[c];
    if (!SAMPLE) {
        if (tl == 31) {
            if (tile < 127) {
                LAS float* cp = (LAS float*)(lds + LR_CARRY) + ((tile + 1) & 7) * 64 + 8 * hi;
#pragma unroll
                for (int ks = 0; ks < 4; ++ks) { *(LAS f32x4*)(cp + 16 * ks) = (f32x4){B[8 * ks], B[8 * ks + 1], B[8 * ks + 2], B[8 * ks + 3]};
                    *(LAS f32x4*)(cp + 16 * ks + 4) = (f32x4){B[8 * ks + 4], B[8 * ks + 5], B[8 * ks + 6], B[8 * ks + 7]}; }
            } else {
                float* lp = A_OUT + O_LP + (size_t)bidx * DM + cbase;
#pragma unroll
                for (int ks = 0; ks < 4; ++ks) { *(f32x4*)(lp + 16 * ks) = (f32x4){B[8 * ks], B[8 * ks + 1], B[8 * ks + 2], B[8 * ks + 3]};
                    *(f32x4*)(lp + 16 * ks + 4) = (f32x4){B[8 * ks + 4], B[8 * ks + 5], B[8 * ks + 6], B[8 * ks + 7]}; }
            }
        }
        if (tile < 127) {
            asm volatile("s_waitcnt lgkmcnt(0)" ::: "memory");
            if (lane == 63) *((volatile LAS unsigned*)(lds + LR_SEQ) + ((tile + 1) & 7)) = (unsigned)(tile + 1);
        }
    } else if (tl == 15) {
        float* lp = A_OUT + O_LS + (size_t)bidx * DM + cbase;
#pragma unroll
        for (int ks = 0; ks < 4; ++ks) { *(f32x4*)(lp + 16 * ks) = (f32x4){B[8 * ks], B[8 * ks + 1], B[8 * ks + 2], B[8 * ks + 3]};
            *(f32x4*)(lp + 16 * ks + 4) = (f32x4){B[8 * ks + 4], B[8 * ks + 5], B[8 * ks + 6], B[8 * ks + 7]}; }
    }
    if (!SAMPLE || tl < NST) {
        bf16_t* gp = Gb + (rowbase + t) * DM + cbase;
#pragma unroll
        for (int ks = 0; ks < 4; ++ks) {
            const u32x4 w = *(const u32x4*)(gp + 16 * ks);
            float gv[8]; gv[0] = bflo(w.x); gv[1] = bfhi(w.x); gv[2] = bflo(w.y); gv[3] = bfhi(w.y); gv[4] = bflo(w.z); gv[5] = bfhi(w.z); gv[6] = bflo(w.w); gv[7] = bfhi(w.w);
            float o[8];
#pragma unroll
            for (int j = 0; j < 8; ++j) o[j] = B[8 * ks + j] * gelu_tanh(gv[j]);
            u32x4 ow; ow.x = cvtpk(o[0], o[1]); ow.y = cvtpk(o[2], o[3]); ow.z = cvtpk(o[4], o[5]); ow.w = cvtpk(o[6], o[7]);
            *(u32x4*)(gp + 16 * ks) = ow;
        }
    }
}

constexpr int P2_Q = 20608;
constexpr int AT_TAB = 24576;
__device__ __forceinline__ void attn_unit(LAS unsigned char* lds, int lane, int b, int c, int h) {
    const int r32 = lane & 31, hi = lane >> 5, kr = swap23(r32);
    const bf16_t* Q = (const bf16_t*)(A_WS + WS_Q); const bf16_t* Kb = (const bf16_t*)(A_WS + WS_K); const bf16_t* VT = (const bf16_t*)(A_WS + WS_VT); bf16_t* O = (bf16_t*)(A_WS + WS_XN);
    const size_t row0 = (size_t)b * SEQ + (size_t)c * 64;
    bf16x8 qf[2][4];
#pragma unroll
    for (int qb = 0; qb < 2; ++qb)
#pragma unroll
        for (int ks = 0; ks < 4; ++ks) qf[qb][ks] = *(const bf16x8*)(Q + (row0 + qb * 32 + r32) * DM + h * 64 + ks * 16 + hi * 8);
    f32x16 o[2][2];
#pragma unroll
    for (int i = 0; i < 2; ++i)
#pragma unroll
        for (int j = 0; j < 2; ++j) o[i][j] = f32x16{};
    float mrow[2] = {-1e30f, -1e30f}, lrow[2] = {0.f, 0.f};
    const LAS float* tab = (const LAS float*)(lds + AT_TAB) + h * 320;
    const float cfar = tab[256];
    const int sb0 = (c >= 8 ? c - 8 : 0) * 2, sb1 = c * 2 + 1;
    const bf16_t* kbase = Kb + ((size_t)b * SEQ + kr) * DM + h * 64 + hi * 8;
    const bf16_t* vbase = VT + (size_t)(h * 64 + kr) * ROWS + (size_t)b * SEQ + hi * 8;
    bf16x8 kf[4], vf[2][2];
#pragma unroll
    for (int ks = 0; ks < 4; ++ks) kf[ks] = *(const bf16x8*)(kbase + (size_t)sb0 * 32 * DM + ks * 16);
#pragma unroll
    for (int db = 0; db < 2; ++db)
#pragma unroll
        for (int s = 0; s < 2; ++s) vf[db][s] = *(const bf16x8*)(vbase + (size_t)db * 32 * ROWS + sb0 * 32 + s * 16);
    for (int sb = sb0; sb <= sb1; ++sb) {
        const int sbn = sb < sb1 ? sb + 1 : sb;
        f32x16 S[2];
#pragma unroll
        for (int qb = 0; qb < 2; ++qb) { S[qb] = f32x16{};
#pragma unroll
            for (int ks = 0; ks < 4; ++ks) S[qb] = __builtin_amdgcn_mfma_f32_32x32x16_bf16(kf[ks], qf[qb][ks], S[qb], 0, 0, 0); }
        asm volatile("" ::: "memory");
#pragma unroll
        for (int ks = 0; ks < 4; ++ks) kf[ks] = *(const bf16x8*)(kbase + (size_t)sbn * 32 * DM + ks * 16);
        const int delta = c - (sb >> 1), rb = sb & 1;
        if (delta >= 3) {
#pragma unroll
            for (int qb = 0; qb < 2; ++qb)
#pragma unroll
                for (int r = 0; r < 16; ++r) S[qb][r] += cfar;
        } else {
#pragma unroll
            for (int qb = 0; qb < 2; ++qb) {
                const LAS float* tp = tab + (64 * delta + 32 * qb + r32 + 128 - 32 * rb - 8 * hi - 23);
#pragma unroll
                for (int r = 0; r < 16; ++r) S[qb][r] += tp[23 - (16 * (r >> 3) + (r & 7))];
            }
        }
        float rm[2];
#pragma unroll
        for (int qb = 0; qb < 2; ++qb) { float mx = S[qb][0];
#pragma unroll
            for (int r = 1; r < 16; ++r) mx = fmaxf(mx, S[qb][r]);
            rm[qb] = plswap_max(mx); }
        if (__any((rm[0] > mrow[0] + 8.0f) || (rm[1] > mrow[1] + 8.0f))) {
#pragma unroll
            for (int qb = 0; qb < 2; ++qb) { const float mn = fmaxf(mrow[qb], rm[qb]); const float al = fast_exp2(mrow[qb] - mn); lrow[qb] *= al; mrow[qb] = mn;
#pragma unroll
                for (int r = 0; r < 16; ++r) { o[0][qb][r] *= al; o[1][qb][r] *= al; } }
        }
        bf16x8 pf[2][2];
#pragma unroll
        for (int qb = 0; qb < 2; ++qb) { float sum = 0.f;
#pragma unroll
            for (int r = 0; r < 16; ++r) { S[qb][r] = fast_exp2(S[qb][r] - mrow[qb]); sum += S[qb][r]; }
            lrow[qb] += sum;
#pragma unroll
            for (int s = 0; s < 2; ++s) { u32x4 w; w.x = cvtpk(S[qb][8 * s], S[qb][8 * s + 1]); w.y = cvtpk(S[qb][8 * s + 2], S[qb][8 * s + 3]); w.z = cvtpk(S[qb][8 * s + 4], S[qb][8 * s + 5]); w.w = cvtpk(S[qb][8 * s + 6], S[qb][8 * s + 7]);
                pf[qb][s] = __builtin_bit_cast(bf16x8, w); } }
#pragma unroll
        for (int db = 0; db < 2; ++db)
#pragma unroll
            for (int qb = 0; qb < 2; ++qb)
#pragma unroll
                for (int s = 0; s < 2; ++s) o[db][qb] = __builtin_amdgcn_mfma_f32_32x32x16_bf16(vf[db][s], pf[qb][s], o[db][qb], 0, 0, 0);
        asm volatile("" ::: "memory");
#pragma unroll
        for (int db = 0; db < 2; ++db)
#pragma unroll
            for (int s = 0; s < 2; ++s) vf[db][s] = *(const bf16x8*)(vbase + (size_t)db * 32 * ROWS + sbn * 32 + s * 16);
    }
#pragma unroll
    for (int qb = 0; qb < 2; ++qb) { const float inv = fast_rcp(plswap_add(lrow[qb]));
        bf16_t* op = O + (row0 + qb * 32 + r32) * DM + h * 64 + 8 * hi;
#pragma unroll
        for (int db = 0; db < 2; ++db)
#pragma unroll
            for (int s = 0; s < 2; ++s) { u32x4 w;
                w.x = cvtpk(o[db][qb][8 * s] * inv, o[db][qb][8 * s + 1] * inv); w.y = cvtpk(o[db][qb][8 * s + 2] * inv, o[db][qb][8 * s + 3] * inv);
                w.z = cvtpk(o[db][qb][8 * s + 4] * inv, o[db][qb][8 * s + 5] * inv); w.w = cvtpk(o[db][qb][8 * s + 6] * inv, o[db][qb][8 * s + 7] * inv);
                *(u32x4*)(op + 32 * db + 16 * s) = w; } }
}

constexpr int AS_P = 45056;
__device__ __forceinline__ void attn_sample_task(LAS unsigned char* lds, int wave, int lane, int task) {
    const int bs = task >> 6, h = (task >> 2) & 15, qg = task & 3;
    const bf16_t* Q = (const bf16_t*)(A_WS + WS_Q); bf16_t* O = (bf16_t*)(A_WS + WS_XN);
    const float* ck = A_IN(2); const float* cv = A_IN(3); const float* kn = A_OUT + O_KS; const float* vn = A_OUT + O_VS;
    LAS float* pb = (LAS float*)(lds + AS_P + wave * 9472);
    LAS float* qs = pb + 4 * 528;
    const LAS float* tab = (const LAS float*)(lds + AT_TAB) + h * 320;
#pragma unroll
    for (int i = 0; i < 4; ++i) qs[i * 64 + lane] = bflo((unsigned)Q[((size_t)NTP + bs * 16 + qg * 4 + i) * DM + h * 64 + lane]);
    asm volatile("s_waitcnt lgkmcnt(0)" ::: "memory");
#pragma unroll 1
    for (int it = 0; it < 9; ++it) {
        const int key = it * 64 + lane; const bool valid = key < 528;
        const float* kp = !valid ? ck : (key < 512 ? ck + (((size_t)bs * 512 + key) * 16 + h) * 64 : kn + ((size_t)bs * 16 + (key - 512)) * DM + h * 64);
        float d[4] = {0.f, 0.f, 0.f, 0.f};
        f32x4 kv[16];
#pragma unroll
        for (int d4 = 0; d4 < 16; ++d4) kv[d4] = *(const f32x4*)(kp + 4 * d4);
#pragma unroll
        for (int d4 = 0; d4 < 16; ++d4) {
#pragma unroll
            for (int i = 0; i < 4; ++i) { const f32x4 qq = *(const LAS f32x4*)(qs + i * 64 + 4 * d4); d[i] += (kv[d4][0] * qq[0] + kv[d4][1] * qq[1]) + (kv[d4][2] * qq[2] + kv[d4][3] * qq[3]); } }
        int rel = 512 + qg * 4 - key;
        if (valid) {
#pragma unroll
            for (int i = 0; i < 4; ++i) { int r = rel + i; r = r > 128 ? 128 : r; pb[i * 528 + key] = d[i] + tab[r + 128]; } }
    }
    asm volatile("s_waitcnt lgkmcnt(0)" ::: "memory");
#pragma unroll 1
    for (int i = 0; i < 4; ++i) {
        float mx = -1e30f;
#pragma unroll 1
        for (int key = lane; key < 528; key += 64) mx = fmaxf(mx, pb[i * 528 + key]);
#pragma unroll
        for (int o = 1; o < 64; o <<= 1) mx = fmaxf(mx, __shfl_xor(mx, o));
        float sum = 0.f;
#pragma unroll 1
        for (int key = lane; key < 528; key += 64) { const float pv = fast_exp2(pb[i * 528 + key] - mx); pb[i * 528 + key] = pv; sum += pv; }
        sum = wave_sum(sum); const float inv = 1.0f / sum;
#pragma unroll 1
        for (int key = lane; key < 528; key += 64) pb[i * 528 + key] *= inv;
    }
    asm volatile("s_waitcnt lgkmcnt(0)" ::: "memory");
    float acc[4] = {0.f, 0.f, 0.f, 0.f};
#pragma unroll 1
    for (int k0 = 0; k0 < 528; k0 += 16) {
        float vv[16];
#pragma unroll
        for (int kk = 0; kk < 16; ++kk) { const int key = k0 + kk; vv[kk] = k0 < 512 ? cv[(((size_t)bs * 512 + key) * 16 + h) * 64 + lane] : vn[((size_t)bs * 16 + (key - 512)) * DM + h * 64 + lane]; }
#pragma unroll
        for (int kk = 0; kk < 16; ++kk) {
#pragma unroll
            for (int i = 0; i < 4; ++i) acc[i] += pb[i * 528 + k0 + kk] * vv[kk]; }
    }
#pragma unroll
    for (int i = 0; i < 4; ++i) O[((size_t)NTP + bs * 16 + qg * 4 + i) * DM + h * 64 + lane] = (bf16_t)(cvtpk(acc[i], 0.f) & 0xffffu);
    asm volatile("s_waitcnt lgkmcnt(0)" ::: "memory");
}

__device__ __forceinline__ void p2_phase(LAS unsigned char* lds, int G, int tid, int wave, int lane) {
    for (int i = tid; i < 16 * 320; i += 512) { const int h = i / 320, j = i % 320; ((LAS float*)(lds + AT_TAB))[i] = A_IN(8)[h * 257 + (j > 256 ? 256 : j)] * LOG2E; }
    for (int u = blockIdx.x; u < 256 + 16; u += G) {
        __syncthreads();
        if (u < 256) {
            const int b = u >> 4, g = u & 15;
            lru_load_consts(lds, g, tid);
            __syncthreads();
            for (int tile = wave; tile < 128; tile += 8) lru_tile<false>(lds, lane, g, (size_t)b * SEQ, tile, b);
        } else {
            const int g = u - 256;
            lru_load_consts(lds, g, tid);
            __syncthreads();
            lru_tile<true>(lds, lane, g, (size_t)NTP + wave * 16, 0, wave);
        }
    }
    if (tid == 0) *(volatile LAS int*)(lds + P2_Q) = 0;
    __syncthreads();
    const int NGW = G * 8;
    int nS = 0; for (int t = blockIdx.x; t < 512; t += G) ++nS;
    for (;;) {
        int j = 0;
        if (lane == 0) j = __hip_atomic_fetch_add((LAS int*)(lds + P2_Q), 1, __ATOMIC_RELAXED, __HIP_MEMORY_SCOPE_WORKGROUP);
        j = __builtin_amdgcn_readfirstlane(j);
        if (j < nS) { attn_sample_task(lds, wave, lane, blockIdx.x + G * j); continue; }
        j -= nS;
        const int u = blockIdx.x * 8 + (j & 7) + NGW * (j >> 3);
        if (u >= NB * 64 * 16) break;
        const int c = u & 63, h = (u >> 6) & 15, b = u >> 10;
        attn_unit(lds, lane, b, c, h);
    }
}

__device__ __forceinline__ void p4b_phase(int G, int wave, int lane) {
    const int gw = blockIdx.x * 8 + wave, NGW = G * 8;
    const float* gm = A_IN(19); bf16_t* XT = (bf16_t*)(A_WS + WS_Q); unsigned char* XQ = A_WS + WS_XQ; float* SX = (float*)(A_WS + WS_SX);
    for (int m = gw; m < NTOK; m += NGW) {
        const float* xr = (m < NTP) ? A_OUT + O_YP + (size_t)m * DM : A_OUT + O_YS + (size_t)(m - NTP) * DM;
        bf16_t* orow = XT + (size_t)m * DM;
        f32x4 v[4]; float s = 0.f;
#pragma unroll
        for (int j = 0; j < 4; ++j) { v[j] = *(const f32x4*)(xr + j * 256 + lane * 4); s += (v[j][0] * v[j][0] + v[j][1] * v[j][1]) + (v[j][2] * v[j][2] + v[j][3] * v[j][3]); }
        const float inv = 1.0f / sqrtf(wave_sum(s) * (1.0f / DM) + EPS);
        float mx = 0.f;
#pragma unroll
        for (int j = 0; j < 4; ++j) { const f32x4 gg = *(const f32x4*)(gm + j * 256 + lane * 4); v[j] = v[j] * inv * gg;
            u32x2 w; w.x = cvtpk(v[j][0], v[j][1]); w.y = cvtpk(v[j][2], v[j][3]); *(u32x2*)(orow + j * 256 + lane * 4) = w;
            mx = fmaxf(mx, fmaxf(fmaxf(fabsf(v[j][0]), fabsf(v[j][1])), fmaxf(fabsf(v[j][2]), fabsf(v[j][3])))); }
#pragma unroll
        for (int o = 1; o < 64; o <<= 1) mx = fmaxf(mx, __shfl_xor(mx, o));
        const float step = fmaxf(mx, 1e-30f) * (1.0f / 127.0f), qi = 1.0f / step;
#pragma unroll
        for (int j = 0; j < 4; ++j) {
            const unsigned b0 = (unsigned)(int)rintf(v[j][0] * qi) & 0xffu, b1 = (unsigned)(int)rintf(v[j][1] * qi) & 0xffu, b2 = (unsigned)(int)rintf(v[j][2] * qi) & 0xffu, b3 = (unsigned)(int)rintf(v[j][3] * qi) & 0xffu;
            *(unsigned*)(XQ + (size_t)m * DM + j * 256 + lane * 4) = b0 | (b1 << 8) | (b2 << 16) | (b3 << 24); }
        if (lane == 0) SX[m] = step;
    }
}

__device__ __forceinline__ int f2key(float f) { const int b = __float_as_int(f); return b ^ ((b >> 31) & 0x7fffffff); }
__device__ __forceinline__ float key2f(int k) { return __int_as_float(k ^ ((k >> 31) & 0x7fffffff)); }
#define INS16(L, x) do { int x_ = (x); _Pragma("unroll") for (int j_ = 0; j_ < 16; ++j_) { const int hi_ = max(L[j_], x_); x_ = min(L[j_], x_); L[j_] = hi_; } } while (0)

constexpr size_t WS_PART = WS_XN;
constexpr int CT_U = 64, CT_V = 64 + 8 * 64;
constexpr int P6_TOKB = 128, P6_NITEM = NTOK / P6_TOKB, P6_TPW = P6_TOKB / 8;
constexpr size_t WS_CQ = WS_VT, WS_CS = WS_VT + 16 * MiB;
constexpr int P6_IDX = 0;
constexpr int P6_E = 0, P6_C = 8192, P6_ITEM = 16384;

__device__ __forceinline__ void p6a_phase(LAS unsigned char* lds, int G, int wave, int lane) {
    const int gw = blockIdx.x * 8 + wave, NGW = G * 8;
    const float* SC = (const float*)(A_WS + WS_XN);
    int* SELE = (int*)(A_WS + WS_SELE); float* SELG = (float*)(A_WS + WS_SELG);
    LAS int* idxb = (LAS int*)(lds + P6_IDX + wave * 4096);
    const int tl = lane >> 4, hh = (lane >> 1) & 7, half = lane & 1;
    for (int grp = gw; grp < NTOK / 4; grp += NGW) {
        const int tok = grp * 4 + tl;
        const float* sp = SC + (size_t)tok * 2048 + hh * 256 + half * 128;
        int L[16];
#pragma unroll
        for (int j = 0; j < 16; ++j) L[j] = (int)0x80000000;
        for (int c4 = 0; c4 < 32; c4 += 2) {
            const f32x4 v0 = *(const f32x4*)(sp + 4 * c4), v1 = *(const f32x4*)(sp + 4 * c4 + 4);
#pragma unroll
            for (int e = 0; e < 4; ++e) INS16(L, (f2key(v0[e]) & ~127) | (4 * c4 + e));
#pragma unroll
            for (int e = 0; e < 4; ++e) INS16(L, (f2key(v1[e]) & ~127) | (4 * c4 + 4 + e));
        }
#pragma unroll
        for (int j = 0; j < 16; ++j) idxb[lane * 16 + j] = L[j] & 127;
        float va[16], vb[16];
#pragma unroll
        for (int j = 0; j < 16; ++j) { const int own = L[j] & ~127, oth = __shfl_xor(own, 1); va[j] = key2f(half ? oth : own); vb[j] = key2f(half ? own : oth); }
        int C[16];
#pragma unroll
        for (int j = 0; j < 16; ++j) C[j] = (int)0x80000000;
#pragma unroll
        for (int i = 0; i < 16; ++i)
#pragma unroll
            for (int j = 0; j < 16; ++j) if ((i + 1) * (j + 1) <= 16) INS16(C, (f2key(va[i] + vb[j]) & ~255) | (i * 16 + j));
        const float mx = key2f(C[0] & ~255);
        float ev[16], sum = 0.f;
#pragma unroll
        for (int j = 0; j < 16; ++j) { ev[j] = __expf(key2f(C[j] & ~255) - mx); sum += ev[j]; }
        const float inv = 1.0f / sum;
        asm volatile("s_waitcnt lgkmcnt(0)" ::: "memory");
        int eo[8]; float go[8];
#pragma unroll
        for (int s = 0; s < 8; ++s) {
            int c_lo = C[s], c_hi = C[8 + s]; float e_lo = ev[s], e_hi = ev[8 + s];
            asm volatile("" : "+v"(c_lo), "+v"(c_hi), "+v"(e_lo), "+v"(e_hi));
            const int cc = half ? c_hi : c_lo; go[s] = (half ? e_hi : e_lo) * inv;
            const int ij = cc & 255, i1 = idxb[(lane & ~1) * 16 + (ij >> 4)], i2 = idxb[(lane | 1) * 16 + (ij & 15)];
            eo[s] = i1 * 128 + i2;
        }
        int* ep = SELE + (size_t)tok * 128 + hh * 16 + half * 8; float* gp = SELG + (size_t)tok * 128 + hh * 16 + half * 8;
        *(u32x4*)ep = (u32x4){(unsigned)eo[0], (unsigned)eo[1], (unsigned)eo[2], (unsigned)eo[3]}; *(u32x4*)(ep + 4) = (u32x4){(unsigned)eo[4], (unsigned)eo[5], (unsigned)eo[6], (unsigned)eo[7]};
        *(f32x4*)gp = (f32x4){go[0], go[1], go[2], go[3]}; *(f32x4*)(gp + 4) = (f32x4){go[4], go[5], go[6], go[7]};
        asm volatile("s_waitcnt lgkmcnt(0)" ::: "memory");
    }
}

__device__ __forceinline__ float dot2bf(unsigned a, unsigned b, float c) { return __builtin_amdgcn_fdot2_f32_bf16(__builtin_bit_cast(bf16x2_t, a), __builtin_bit_cast(bf16x2_t, b), c, false); }
__device__ __forceinline__ unsigned xcc_id() { return (unsigned)__builtin_amdgcn_s_getreg((3 << 11) | 20) & 0xFu; }
__device__ __forceinline__ float dpp_sum16(float v) {
    v += __builtin_bit_cast(float, __builtin_amdgcn_update_dpp(0, __builtin_bit_cast(int, v), 0xB1, 0xF, 0xF, true));
    v += __builtin_bit_cast(float, __builtin_amdgcn_update_dpp(0, __builtin_bit_cast(int, v), 0x4E, 0xF, 0xF, true));
    v += __builtin_bit_cast(float, __builtin_amdgcn_update_dpp(0, __builtin_bit_cast(int, v), 0x141, 0xF, 0xF, true));
    v += __builtin_bit_cast(float, __builtin_amdgcn_update_dpp(0, __builtin_bit_cast(int, v), 0x140, 0xF, 0xF, true));
    return v;
}
__device__ __forceinline__ bool p6_claim(LAS unsigned char* lds, unsigned* cnt, int tid, int& ring, int home, int& slice, int& item) {
    for (;;) {
        if (ring >= 8) return false;
        slice = (home + ring) & 7;
        __syncthreads();
        if (tid == 0) *(volatile LAS int*)(lds + P6_ITEM) = (int)__hip_atomic_fetch_add(cnt + 64 * slice, 1u, __ATOMIC_RELAXED, __HIP_MEMORY_SCOPE_AGENT);
        __syncthreads();
        item = *(volatile LAS int*)(lds + P6_ITEM);
        if (item < P6_NITEM) return true;
        ++ring;
    }
}

__device__ __forceinline__ float ub0(unsigned w) { return (float)(w & 0xffu); }
__device__ __forceinline__ float ub1(unsigned w) { return (float)((w >> 8) & 0xffu); }
__device__ __forceinline__ float ub2(unsigned w) { return (float)((w >> 16) & 0xffu); }
__device__ __forceinline__ float ub3(unsigned w) { return (float)(w >> 24); }
__device__ __forceinline__ float dpp_sum8(float v) {
    v += __builtin_bit_cast(float, __builtin_amdgcn_update_dpp(0, __builtin_bit_cast(int, v), 0xB1, 0xF, 0xF, true));
    v += __builtin_bit_cast(float, __builtin_amdgcn_update_dpp(0, __builtin_bit_cast(int, v), 0x4E, 0xF, 0xF, true));
    v += __builtin_bit_cast(float, __builtin_amdgcn_update_dpp(0, __builtin_bit_cast(int, v), 0x141, 0xF, 0xF, true));
    return v;
}
__device__ __forceinline__ int dpp_isum8(int v) {
    v += __builtin_amdgcn_update_dpp(0, v, 0xB1, 0xF, 0xF, true);
    v += __builtin_amdgcn_update_dpp(0, v, 0x4E, 0xF, 0xF, true);
    v += __builtin_amdgcn_update_dpp(0, v, 0x141, 0xF, 0xF, true);
    return v;
}
__device__ __forceinline__ void p6b_phase(LAS unsigned char* lds, int tid, int wave, int lane) {
    const unsigned char* XQ = A_WS + WS_XQ; const unsigned char* UB = A_WS + WS_UB; const float* SX = (const float*)(A_WS + WS_SX);
    const int* SELE = (const int*)(A_WS + WS_SELE); float* PART = (float*)(A_WS + WS_PART);
    unsigned* cnt = (unsigned*)(A_WS + WS_CTL) + CT_U;
    const int i8 = lane & 7, grp = lane >> 3, home = (int)(xcc_id() & 7u);
    LAS int* eb = (LAS int*)(lds + P6_E + wave * 1024);
    int ring = 0, slice, item;
    while (p6_claim(lds, cnt, tid, ring, home, slice, item)) {
        const int tok0 = item * P6_TOKB + wave * P6_TPW;
        int e0 = SELE[(size_t)tok0 * 128 + lane], e1 = SELE[(size_t)tok0 * 128 + 64 + lane];
#pragma unroll 2
        for (int ti = 0; ti < P6_TPW; ++ti) {
            const int tok = tok0 + ti;
            LAS int* ebt = eb + (ti & 1) * 128;
            ebt[lane] = e0; ebt[64 + lane] = e1;
            if (ti < P6_TPW - 1) { e0 = SELE[(size_t)(tok + 1) * 128 + lane]; e1 = SELE[(size_t)(tok + 1) * 128 + 64 + lane]; }
            const u32x4 xq = *(const u32x4*)(XQ + (size_t)tok * DM + slice * 128 + i8 * 16);
            const int x0 = (int)xq.x, x1 = (int)xq.y, x2 = (int)xq.z, x3 = (int)xq.w;
            const float sx = SX[tok];
            const unsigned char* ub = UB + slice * 128 + i8 * 16;
            asm volatile("s_waitcnt lgkmcnt(0)" ::: "memory");
            u32x4 uv[16];
#pragma unroll
            for (int q = 0; q < 16; ++q) { const int e = ebt[16 * grp + q]; uv[q] = *(const u32x4*)(ub + (size_t)e * DM); }
            int res0 = 0, res1 = 0;
#pragma unroll
            for (int q = 0; q < 16; ++q) {
                const int a0 = (int)uv[q].x, a1 = (int)uv[q].y, a2 = (int)uv[q].z, a3 = (int)uv[q].w;
                int d = __builtin_amdgcn_sdot4(a0, x0, 0, false); d = __builtin_amdgcn_sdot4(a1, x1, d, false); d = __builtin_amdgcn_sdot4(a2, x2, d, false); d = __builtin_amdgcn_sdot4(a3, x3, d, false);
                d = dpp_isum8(d);
                if (q < 8) res0 = (i8 == q) ? d : res0; else res1 = (i8 == (q - 8)) ? d : res1;
            }
            float* pp = PART + ((size_t)slice * NTOK + tok) * 128 + 16 * grp + i8;
            pp[0] = (float)res0 * sx; pp[8] = (float)res1 * sx;
        }
    }
}

__device__ __forceinline__ void p6m_phase(int G, int wave, int lane) {
    const int gw = blockIdx.x * 8 + wave, NGW = G * 8;
    const float* SU = (const float*)(A_WS + WS_SU); const float* SV = (const float*)(A_WS + WS_SV);
    const int* SELE = (const int*)(A_WS + WS_SELE); const float* SELG = (const float*)(A_WS + WS_SELG); const float* PART = (const float*)(A_WS + WS_PART);
    unsigned char* CQ = A_WS + WS_CQ; float* CS = (float*)(A_WS + WS_CS);
    for (int tok = gw; tok < NTOK; tok += NGW) {
        float a0 = 0.f, a1 = 0.f;
#pragma unroll
        for (int j = 0; j < 8; ++j) { const float* pp = PART + ((size_t)j * NTOK + tok) * 128; a0 += pp[lane]; a1 += pp[64 + lane]; }
        const int e0 = SELE[(size_t)tok * 128 + lane], e1 = SELE[(size_t)tok * 128 + 64 + lane];
        const float c0 = SELG[(size_t)tok * 128 + lane] * gelu_tanh(a0 * SU[e0]) * SV[e0], c1 = SELG[(size_t)tok * 128 + 64 + lane] * gelu_tanh(a1 * SU[e1]) * SV[e1];
        float mx = fmaxf(fabsf(c0), fabsf(c1));
#pragma unroll
        for (int o = 1; o < 64; o <<= 1) mx = fmaxf(mx, __shfl_xor(mx, o));
        const float cstep = fmaxf(mx, 1e-30f) * (1.0f / 127.0f), cinv = 1.0f / cstep;
        CQ[(size_t)tok * 128 + lane] = (unsigned char)((int)rintf(c0 * cinv) & 0xff); CQ[(size_t)tok * 128 + 64 + lane] = (unsigned char)((int)rintf(c1 * cinv) & 0xff);
        if (lane == 0) CS[tok] = cstep;
    }
}

__device__ __forceinline__ void p6c_phase(LAS unsigned char* lds, int tid, int wave, int lane) {
    const unsigned char* VB = A_WS + WS_VB; const int* SELE = (const int*)(A_WS + WS_SELE);
    const unsigned char* CQ = A_WS + WS_CQ; const float* CS = (const float*)(A_WS + WS_CS);
    unsigned* cnt = (unsigned*)(A_WS + WS_CTL) + CT_V;
    float* out = A_OUT;
    const int i8 = lane & 7, grp = lane >> 3, home = (int)(xcc_id() & 7u);
    LAS int* eb = (LAS int*)(lds + P6_E + wave * 1024);
    LAS int* cbb = (LAS int*)(lds + P6_C + wave * 512);
    int ring = 0, slice, item;
    while (p6_claim(lds, cnt, tid, ring, home, slice, item)) {
        const int tok0 = item * P6_TOKB + wave * P6_TPW;
        int e0 = SELE[(size_t)tok0 * 128 + lane], e1 = SELE[(size_t)tok0 * 128 + 64 + lane];
        int cw = ((const int*)(CQ + (size_t)tok0 * 128))[lane & 31];
        float cstep = CS[tok0];
#pragma unroll 2
        for (int ti = 0; ti < P6_TPW; ++ti) {
            const int tok = tok0 + ti;
            LAS int* ebt = eb + (ti & 1) * 128; LAS int* cbt = cbb + (ti & 1) * 32;
            ebt[lane] = e0; ebt[64 + lane] = e1; if (lane < 32) cbt[lane] = cw;
            const float cs = cstep;
            if (ti < P6_TPW - 1) { e0 = SELE[(size_t)(tok + 1) * 128 + lane]; e1 = SELE[(size_t)(tok + 1) * 128 + 64 + lane]; cw = ((const int*)(CQ + (size_t)(tok + 1) * 128))[lane & 31]; cstep = CS[tok + 1]; }
            float* yr = ((tok < NTP) ? out + O_YP + (size_t)tok * DM : out + O_YS + (size_t)(tok - NTP) * DM) + slice * 128 + i8 * 16;
            f32x4 z[4];
            if (lane < 8) {
#pragma unroll
                for (int q = 0; q < 4; ++q) z[q] = *(const f32x4*)(yr + 4 * q);
            }
            const unsigned char* vb = VB + slice * 128 + i8 * 16;
            asm volatile("s_waitcnt lgkmcnt(0)" ::: "memory");
            u32x4 vv[16];
#pragma unroll
            for (int q = 0; q < 16; ++q) { const int e = ebt[16 * grp + q]; vv[q] = *(const u32x4*)(vb + (size_t)e * DM); }
            int acc[16];
#pragma unroll
            for (int r = 0; r < 16; ++r) acc[r] = 0;
#pragma unroll
            for (int a4 = 0; a4 < 4; ++a4) {
                const int cq = cbt[4 * grp + a4];
#pragma unroll
                for (int d = 0; d < 4; ++d) {
                    const unsigned ra = vv[4 * a4][d], rb = vv[4 * a4 + 1][d], rc = vv[4 * a4 + 2][d], rd = vv[4 * a4 + 3][d];
                    const unsigned lo = __builtin_amdgcn_perm(rb, ra, 0x05010400u), hi = __builtin_amdgcn_perm(rb, ra, 0x07030602u);
                    const unsigned lo2 = __builtin_amdgcn_perm(rd, rc, 0x05010400u), hi2 = __builtin_amdgcn_perm(rd, rc, 0x07030602u);
                    const unsigned t0 = __builtin_amdgcn_perm(lo2, lo, 0x05040100u), t1 = __builtin_amdgcn_perm(lo2, lo, 0x07060302u);
                    const unsigned t2 = __builtin_amdgcn_perm(hi2, hi, 0x05040100u), t3 = __builtin_amdgcn_perm(hi2, hi, 0x07060302u);
                    acc[4 * d + 0] = __builtin_amdgcn_sdot4((int)t0, cq, acc[4 * d + 0], false); acc[4 * d + 1] = __builtin_amdgcn_sdot4((int)t1, cq, acc[4 * d + 1], false);
                    acc[4 * d + 2] = __builtin_amdgcn_sdot4((int)t2, cq, acc[4 * d + 2], false); acc[4 * d + 3] = __builtin_amdgcn_sdot4((int)t3, cq, acc[4 * d + 3], false);
                }
            }
#pragma unroll
            for (int r = 0; r < 16; ++r) { acc[r] += __shfl_xor(acc[r], 8); acc[r] += __shfl_xor(acc[r], 16); acc[r] += __shfl_xor(acc[r], 32); }
            if (lane < 8) {
#pragma unroll
                for (int q = 0; q < 4; ++q) { z[q] += (f32x4){(float)acc[4 * q] * cs, (float)acc[4 * q + 1] * cs, (float)acc[4 * q + 2] * cs, (float)acc[4 * q + 3] * cs}; *(f32x4*)(yr + 4 * q) = z[q]; }
            }
        }
    }
}

__device__ __forceinline__ void p6d_phase(int G, int wave, int lane) {
    const int gw = blockIdx.x * 8 + wave, NGW = G * 8;
    const float* gf = A_IN(25); float* out = A_OUT;
    for (int m = gw; m < NTOK; m += NGW) {
        float* yr = (m < NTP) ? out + O_YP + (size_t)m * DM : out + O_YS + (size_t)(m - NTP) * DM;
        f32x4 v[4]; float s = 0.f;
#pragma unroll
        for (int j = 0; j < 4; ++j) { v[j] = *(const f32x4*)(yr + j * 256 + lane * 4); s += (v[j][0] * v[j][0] + v[j][1] * v[j][1]) + (v[j][2] * v[j][2] + v[j][3] * v[j][3]); }
        const float inv = 1.0f / sqrtf(wave_sum(s) * (1.0f / DM) + EPS);
#pragma unroll
        for (int j = 0; j < 4; ++j) { const f32x4 gg = *(const f32x4*)(gf + j * 256 + lane * 4); *(f32x4*)(yr + j * 256 + lane * 4) = v[j] * inv * gg; }
    }
}

#define XB_TMO      128
#define XB_XCNT(j)  (256  + 64 * (j))
#define XB_XSUB(j)  (1280 + 64 * (j))
#define XB_XGEN(j)  (2304 + 64 * (j))
#define XB_TOP      3328
#define XB_TOPGEN   3392
#define XB_SPIN_CAP (1u << 22)
constexpr int CW_BAR = 2048;
constexpr int LDS_MISC = 131072 + 64;
__device__ __forceinline__ unsigned xb_ld(unsigned* p)              { return __hip_atomic_load(p, __ATOMIC_RELAXED, __HIP_MEMORY_SCOPE_AGENT); }
__device__ __forceinline__ unsigned xb_add(unsigned* p, unsigned v) { return __hip_atomic_fetch_add(p, v, __ATOMIC_RELAXED, __HIP_MEMORY_SCOPE_AGENT); }
#define XB_SPIN(cond, bar) do { unsigned _sp = 0; while (cond) { __builtin_amdgcn_s_sleep(1); \
    if ((++_sp & 255u) == 0u) { if (xb_ld(&(bar)[XB_TMO])) break; if (_sp > XB_SPIN_CAP) { atomicAdd(&(bar)[XB_TMO], 1u); break; } } } } while (0)
struct XcdBarrier { unsigned* bar; unsigned x; volatile LAS unsigned* st; };
__device__ __forceinline__ XcdBarrier xcd_barrier_post(unsigned* bar, volatile LAS unsigned* st) {
    XcdBarrier b; b.bar = bar; b.x = (unsigned)__builtin_amdgcn_s_getreg((3 << 11) | 20) & 0xFu; b.st = st;
    if (threadIdx.x == 0) (void)xb_add(&bar[XB_XCNT(b.x)], 1u);
    return b;
}
__device__ __forceinline__ void xcd_barrier_complete(unsigned* bar, unsigned x, unsigned& nloc, unsigned& nx) {
    const unsigned G = gridDim.x * gridDim.y * gridDim.z;
    unsigned sum, cnt, mine, sp = 0u;
    for (;;) {
        sum = 0u; cnt = 0u; mine = 0u;
#pragma unroll
        for (unsigned j = 0; j < 16; ++j) { const unsigned c = xb_ld(&bar[XB_XCNT(j)]); sum += c; cnt += (c > 0u) ? 1u : 0u; mine = (j == x) ? c : mine; }
        if (sum == G) break;
        __builtin_amdgcn_s_sleep(1);
        if ((++sp & 255u) == 0u) { if (xb_ld(&bar[XB_TMO])) break; if (sp > XB_SPIN_CAP) { atomicAdd(&bar[XB_TMO], 1u); break; } }
    }
    nloc = mine > 0u ? mine : 1u; nx = cnt > 0u ? cnt : 1u;
}
__device__ __forceinline__ void xcd_barrier(const XcdBarrier& b) {
    asm volatile("s_waitcnt vmcnt(0)" ::: "memory");
    __syncthreads();
    if (threadIdx.x == 0) {
        unsigned* bar = b.bar;
        __builtin_amdgcn_s_waitcnt(0);
        unsigned nloc = b.st[0], nx = b.st[1];
        if (nloc == 0u) { xcd_barrier_complete(bar, b.x, nloc, nx); b.st[0] = nloc; b.st[1] = nx; }
        const unsigned old = xb_add(&bar[XB_XSUB(b.x)], 1u);
        const unsigned gen = old / nloc;
        if (old + 1u == (gen + 1u) * nloc) {
            __builtin_amdgcn_fence(__ATOMIC_RELEASE, "agent");
            asm volatile("s_waitcnt vmcnt(0)" ::: "memory");
            const unsigned og = xb_add(&bar[XB_TOP], 1u);
            const unsigned tg = og / nx;
            if (og + 1u == (tg + 1u) * nx) xb_add(&bar[XB_TOPGEN], 1u);
            else XB_SPIN(xb_ld(&bar[XB_TOPGEN]) == tg, bar);
            __builtin_amdgcn_fence(__ATOMIC_ACQUIRE, "agent");
            xb_add(&bar[XB_XGEN(b.x)], 1u);
            asm volatile("s_waitcnt vmcnt(0)" ::: "memory");
        } else {
            XB_SPIN(xb_ld(&bar[XB_XGEN(b.x)]) == gen, bar);
            __builtin_amdgcn_fence(__ATOMIC_ACQUIRE, "agent");
            asm volatile("s_waitcnt vmcnt(0)" ::: "memory");
        }
    }
    __syncthreads();
}

__global__ void __launch_bounds__(512, 2) hybrid_fwd(Args a) {
    extern __shared__ __attribute__((aligned(16))) unsigned char lds_raw[];
    LAS unsigned char* lds = (LAS unsigned char*)lds_raw;
    const int tid = threadIdx.x, lane = tid & 63, wave = __builtin_amdgcn_readfirstlane(tid >> 6), G = gridDim.x;
    cg::grid_group grid = cg::this_grid();
    unsigned char* ws = A_WS;
    if (tid < 2) ((volatile LAS unsigned*)(lds + LDS_MISC))[tid] = 0u;
    __syncthreads();
    XcdBarrier xbar; xbar.bar = (unsigned*)(ws + WS_CTL) + CW_BAR; xbar.x = 0; xbar.st = nullptr;
    if (KA->use_sync) xbar = xcd_barrier_post((unsigned*)(ws + WS_CTL) + CW_BAR, (volatile LAS unsigned*)(lds + LDS_MISC));
#define IN(k) (KA->ph_lo <= (k) && (k) < KA->ph_hi)
#define SEAM(k) do { if (KA->use_sync && IN(k) && IN((k) + 1)) { if ((k) == 0) grid.sync(); else xcd_barrier(xbar); } } while (0)
    if (IN(0)) { p0_prologue(lds, G, wave, lane); }
    SEAM(0);
    if (IN(1)) {
        pg8::Gemm g{(const bf16_t*)(ws + WS_XN), (const bf16_t*)(ws + WS_WIN), (const bf16_t*)(ws + WS_WIN) + (size_t)2048 * DM, (const bf16_t*)(ws + WS_XN), DM};
        SchedG1 S; S.init(G, blockIdx.x); EpiG1 E;
        pg8::gemm_phase(lds, g, S, E);
    }
    SEAM(1);
    if (IN(2)) { p2_phase(lds, G, tid, wave, lane); }
    SEAM(2);
    if (IN(3)) {
        pg8::Gemm g{(const bf16_t*)(ws + WS_XN), (const bf16_t*)(ws + WS_WBA), (const bf16_t*)(ws + WS_G), (const bf16_t*)(ws + WS_WBL), DM};
        SchedPair S; S.init(4, G, blockIdx.x); EpiP3 E;
        pg8::gemm_phase(lds, g, S, E);
    }
    SEAM(3);
    if (IN(4)) {
        pg8::Gemm g{(const bf16_t*)(ws + WS_XR), (const bf16_t*)(ws + WS_WO), (const bf16_t*)(ws + WS_XR), (const bf16_t*)(ws + WS_WO), DM};
        SchedOne S; S.init(4, G, blockIdx.x); EpiP4 E;
        pg8::gemm_phase(lds, g, S, E);
    }
    SEAM(4);
    if (IN(5)) { p4b_phase(G, wave, lane); }
    SEAM(5);
    if (IN(6)) {
        pg8::Gemm g{(const bf16_t*)(ws + WS_Q), (const bf16_t*)(ws + WS_WS), (const bf16_t*)(ws + WS_Q), (const bf16_t*)(ws + WS_WS), DM};
        SchedOne S; S.init(8, G, blockIdx.x); EpiP5 E;
        pg8::gemm_phase(lds, g, S, E);
    }
    SEAM(6);
    if (IN(7)) { p6a_phase(lds, G, wave, lane); }
    SEAM(7);
    if (IN(8)) { p6b_phase(lds, tid, wave, lane); }
    SEAM(8);
    if (IN(9)) { p6m_phase(G, wave, lane); }
    SEAM(9);
    if (IN(10)) { p6c_phase(lds, tid, wave, lane); }
    SEAM(10);
    if (IN(11)) { p6d_phase(G, wave, lane); }
#undef IN
#undef SEAM
}

#ifndef N_LAUNCH_MODE
#define N_LAUNCH_MODE 1
#endif
constexpr int NPH = 12;
extern "C" void kernel_launch(void* const* d_in, const int* in_sizes, int n_in, void* d_out, int out_size, void* d_ws, size_t ws_size, hipStream_t stream) {
    static int grid = 0;
    if (grid == 0) {
        if (n_in != 26 || (size_t)out_size != O_END || ws_size < WS_END) { fprintf(stderr, "kernel_launch: unexpected sizes n_in %d out %d ws %zu (need %zu)\n", n_in, out_size, ws_size, (size_t)WS_END); grid = -1; return; }
        int dev = 0, cus = 0, per_cu = 0;
        (void)hipGetDevice(&dev); (void)hipDeviceGetAttribute(&cus, hipDeviceAttributeMultiprocessorCount, dev);
        (void)hipFuncSetAttribute((const void*)hybrid_fwd, hipFuncAttributeMaxDynamicSharedMemorySize, LDS_BYTES);
        (void)hipOccupancyMaxActiveBlocksPerMultiprocessor(&per_cu, (const void*)hybrid_fwd, 512, LDS_BYTES);
        if (per_cu < 1) { fprintf(stderr, "kernel_launch: occupancy query says %d blocks per CU\n", per_cu); per_cu = 1; }
        grid = cus;
        (void)hipGetLastError();
    }
    if (grid < 0) return;
    (void)hipMemsetAsync((char*)d_ws + WS_CTL, 0, 32768, stream);
    Args a{};
    for (int i = 0; i < 26; ++i) a.in[i] = (const float*)d_in[i];
    a.out = (float*)d_out; a.ws = (unsigned char*)d_ws;
    if (N_LAUNCH_MODE == 1) {
        a.ph_lo = 0; a.ph_hi = NPH; a.use_sync = 1;
        void* args[] = {&a};
        hipError_t e = hipLaunchCooperativeKernel((const void*)hybrid_fwd, dim3(grid), dim3(512), args, LDS_BYTES, stream);
        if (e != hipSuccess) fprintf(stderr, "cooperative launch failed: %s (grid %d)\n", hipGetErrorString(e), grid);
    } else {
        for (int p = 0; p < NPH; ++p) { a.ph_lo = p; a.ph_hi = p + 1; a.use_sync = 0; hipLaunchKernelGGL(hybrid_fwd, dim3(grid), dim3(512), LDS_BYTES, stream, a); }
    }
}
```

```cpp
#include <hip/hip_runtime.h>
#include <hip/hip_cooperative_groups.h>
#include <cstdint>
#include <cstdio>
namespace cg = cooperative_groups;

#define LAS __attribute__((address_space(3)))
typedef unsigned short bf16_t;
typedef short bf16x8 __attribute__((ext_vector_type(8)));
typedef float f32x4 __attribute__((ext_vector_type(4)));
typedef float f32x2 __attribute__((ext_vector_type(2)));
typedef float f32x16 __attribute__((ext_vector_type(16)));
typedef unsigned u32x4 __attribute__((ext_vector_type(4)));
typedef unsigned u32x2 __attribute__((ext_vector_type(2)));
typedef __bf16 bf16x2_t __attribute__((ext_vector_type(2)));

constexpr int DM = 1024, SEQ = 4096, NB = 16, NTP = NB * SEQ, NSB = 8, NST = 16, NTS = NSB * NST, NTOK = NTP + NTS;
constexpr int ROWS = 65792, NMT = 257;
constexpr int INC = 7168, NEXP = 16384;
constexpr float EPS = 1e-6f, LOG2E = 1.4426950408889634f;
constexpr float QSCALE = 0.125f * LOG2E;

constexpr size_t MiB = 1u << 20;
constexpr size_t BUF = (size_t)ROWS * DM * 2;
constexpr size_t WS_CTL = 0;
constexpr size_t WS_WIN = 1 * MiB;
constexpr size_t WS_WBA = 16 * MiB, WS_WBL = 18 * MiB, WS_WO = 20 * MiB, WS_WS = 22 * MiB;
constexpr size_t WS_LRUW = 26 * MiB;
constexpr size_t WS_SGA = 27 * MiB, WS_SGR = 27 * MiB + 512 * 1024;
constexpr size_t WS_SU = 26 * MiB + 512 * 1024, WS_SV = 26 * MiB + 640 * 1024;
constexpr size_t WS_SX = 26 * MiB + 704 * 1024;
constexpr size_t WS_UB = 28 * MiB, WS_VB = 60 * MiB;
constexpr size_t WS_Q = 92 * MiB;
constexpr size_t WS_XN = WS_Q + BUF;
constexpr size_t WS_K = WS_XN + BUF;
constexpr size_t WS_VT = WS_K + BUF;
constexpr size_t WS_XR = WS_VT + BUF;
constexpr size_t WS_G = WS_XR + BUF;
constexpr size_t WS_END = WS_G + BUF;
constexpr size_t WS_SELE = WS_G, WS_SELG = WS_G + (size_t)NTOK * 512, WS_XQ = WS_G + (size_t)NTOK * 1024;

constexpr size_t O_YP = 0, O_YS = O_YP + (size_t)NTP * DM, O_KP = O_YS + (size_t)NTS * DM, O_VP = O_KP + (size_t)NB * 512 * DM,
                 O_CP = O_VP + (size_t)NB * 512 * DM, O_LP = O_CP + (size_t)NB * 3 * DM, O_KS = O_LP + (size_t)NB * DM, O_VS = O_KS + (size_t)NTS * DM,
                 O_CS = O_VS + (size_t)NTS * DM, O_LS = O_CS + (size_t)NSB * 3 * DM, O_END = O_LS + (size_t)NSB * DM;

constexpr int LDS_BYTES = 135168;

__device__ __forceinline__ unsigned cvtpk(float lo, float hi) { f32x2 v = {lo, hi}; bf16x2_t b = __builtin_convertvector(v, bf16x2_t); return __builtin_bit_cast(unsigned, b); }
__device__ __forceinline__ float bflo(unsigned u) { return __uint_as_float(u << 16); }
__device__ __forceinline__ float bfhi(unsigned u) { return __uint_as_float(u & 0xffff0000u); }
__device__ __forceinline__ float fast_exp2(float x) { return __builtin_amdgcn_exp2f(x); }
__device__ __forceinline__ float fast_rcp(float x) { return __builtin_amdgcn_rcpf(x); }
__device__ __forceinline__ float sigmoidf_(float z) { return fast_rcp(1.0f + fast_exp2(-z * LOG2E)); }
__device__ __forceinline__ float gelu_tanh(float x) { const float u = x + 0.044715f * x * x * x; return x * fast_rcp(1.0f + fast_exp2(-1.5957691216f * LOG2E * u)); }
__device__ __forceinline__ float wave_sum(float v) {
#pragma unroll
    for (int o = 1; o < 64; o <<= 1) v += __shfl_xor(v, o);
    return v;
}
__device__ __forceinline__ int swap23(int i) { return (i & ~12) | ((i & 4) << 1) | ((i & 8) >> 1); }
__device__ __forceinline__ float plswap_max(float m) { auto rr = __builtin_amdgcn_permlane32_swap(__float_as_uint(m), __float_as_uint(m), false, false); return fmaxf(__uint_as_float(rr[0]), __uint_as_float(rr[1])); }
__device__ __forceinline__ float plswap_add(float m) { auto rr = __builtin_amdgcn_permlane32_swap(__float_as_uint(m), __float_as_uint(m), false, false); return __uint_as_float(rr[0]) + __uint_as_float(rr[1]); }

namespace pg8 {
constexpr int BM = 256, BK = 64, HALF = 128, HTB = HALF * BK * 2, STAGE_BYTES = 8 * HTB, NXCD = 8, WGM = 8;
__host__ __device__ __forceinline__ int lds_byte(int r, int c) { const int st = (r >> 4) * 2 + (c >> 5), rr = r & 15, cc = c & 31, ob = rr * 64 + cc * 2; return st * 1024 + (ob ^ (((ob >> 9) & 1) << 5)); }
__host__ __device__ __forceinline__ void stage_rc(int b, int& R, int& C) { const int st = b / 1024, sb = b % 1024, swz = sb ^ (((sb >> 9) & 1) << 5); R = (st >> 1) * 16 + swz / 64; C = (st & 1) * 32 + (swz % 64) / 2; }
__host__ __device__ __forceinline__ int perm32(int rho) { const int n = rho >> 4, i = rho & 15; return 8 * (i >> 2) + 4 * n + (i & 3); }

struct Unit { int pm, pn, kind; };
struct Gemm { const bf16_t* A0; const bf16_t* B0; const bf16_t* A1; const bf16_t* B1; int K; };

struct TileMap {
    int nM, nN, nwg;
    __device__ __forceinline__ void init(int nM_, int nN_) { nM = nM_; nN = nN_; nwg = nM * nN; }
    __device__ __forceinline__ void map(int L, int& pm, int& pn) const {
        int wgid = L; { const int q = nwg / NXCD, r = nwg % NXCD, xcd = wgid % NXCD, off = wgid / NXCD; wgid = (xcd < r ? xcd * (q + 1) : r * (q + 1) + (xcd - r) * q) + off; }
        const int nig = WGM * nN, gid = wgid / nig, fm = gid * WGM, gsz = (nM - fm) < WGM ? (nM - fm) : WGM;
        pm = fm + ((wgid % nig) % gsz); pn = (wgid % nig) / gsz;
    }
};

template <class Epi, class Sched>
__device__ __forceinline__ void gemm_phase(LAS unsigned char* lds, const Gemm g, const Sched& S, const Epi& E) {
    const int tid = threadIdx.x, wid = __builtin_amdgcn_readfirstlane(tid >> 6), lane = tid & 63, wr = wid >> 2, wc = wid & 3, fr = lane & 15, fq = lane >> 4;
    const int K = g.K, nt = K / BK;
    unsigned voffA[2], voffB[2];
#pragma unroll
    for (int i = 0; i < 2; ++i) { int R, C; stage_rc(tid * 16 + i * 8192, R, C); const int Rb = (R & ~31) + perm32(R & 31);
        voffA[i] = (unsigned)(R * K + C) * 2u; voffB[i] = (unsigned)(Rb * K + C) * 2u; }
    const size_t kstep = (size_t)(BK * 2);
    const size_t hstep = (size_t)HALF * K * 2;
    const size_t tstep = 2 * hstep;
    const unsigned ldsw = (unsigned)wid * 1024u;
    const int aoff = lds_byte(wr * 64 + fr, fq * 8), boff = lds_byte(wc * 32 + fr, fq * 8);
#define PG8_SA(b, h) (((b) * 2 + (h)) * HTB)
#define PG8_SB(b, h) ((4 + (b) * 2 + (h)) * HTB)
#define PG8_STAGE(bufoff, gbase, voff) do { _Pragma("unroll") for (int _i = 0; _i < 2; ++_i) \
        __builtin_amdgcn_global_load_lds((const unsigned*)((const char*)(gbase) + (voff)[_i]), (LAS unsigned*)(lds + (bufoff) + ldsw + _i * 8192), 16, 0, 0); } while (0)
#define PG8_LDA(dst, b, h) do { _Pragma("unroll") for (int m = 0; m < 4; ++m) _Pragma("unroll") for (int k = 0; k < 2; ++k) dst[m][k] = *(const LAS bf16x8*)(lds + PG8_SA(b, h) + aoff + m * 2048 + k * 1024); } while (0)
#define PG8_LDB(dst, b, h) do { _Pragma("unroll") for (int n = 0; n < 2; ++n) _Pragma("unroll") for (int k = 0; k < 2; ++k) dst[n][k] = *(const LAS bf16x8*)(lds + PG8_SB(b, h) + boff + n * 2048 + k * 1024); } while (0)
#define PG8_MMA(ai, bj, At, Bt) do { __builtin_amdgcn_s_setprio(1); _Pragma("unroll") for (int m = 0; m < 4; ++m) _Pragma("unroll") for (int n = 0; n < 2; ++n) _Pragma("unroll") for (int k = 0; k < 2; ++k) \
        acc[ai][bj][m][n] = __builtin_amdgcn_mfma_f32_16x16x32_bf16(Bt[n][k], At[m][k], acc[ai][bj][m][n], 0, 0, 0); __builtin_amdgcn_s_setprio(0); } while (0)
#define PG8_WAIT_V(n) asm volatile("s_waitcnt vmcnt(" #n ")" ::: "memory")
#define PG8_WAIT_L(n) asm volatile("s_waitcnt lgkmcnt(" #n ")" ::: "memory")
#define PG8_BAR __builtin_amdgcn_s_barrier()
#define PG8_SCHED __builtin_amdgcn_sched_barrier(0)
    Unit cur, nxt; int ui = 0;
    if (!S.next(0, cur)) return;
    f32x4 acc[2][2][4][2];
#pragma unroll
    for (int a = 0; a < 2; ++a)
#pragma unroll
        for (int b = 0; b < 2; ++b)
#pragma unroll
            for (int m = 0; m < 4; ++m)
#pragma unroll
                for (int n = 0; n < 2; ++n) acc[a][b][m][n] = (f32x4){0.f, 0.f, 0.f, 0.f};
    bf16x8 At[4][2], B0[2][2], B1[2][2];
    const char* cA = (const char*)(cur.kind ? g.A1 : g.A0) + (size_t)cur.pm * tstep; const char* cB = (const char*)(cur.kind ? g.B1 : g.B0) + (size_t)cur.pn * tstep;
    PG8_STAGE(PG8_SB(0, 0), cB, voffB); PG8_STAGE(PG8_SB(0, 1), cB + hstep, voffB); PG8_STAGE(PG8_SA(0, 0), cA, voffA); PG8_STAGE(PG8_SA(0, 1), cA + hstep, voffA);
    if (wr == 1) PG8_BAR;
    PG8_WAIT_V(2); PG8_BAR;
    PG8_STAGE(PG8_SB(1, 0), cB + kstep, voffB); PG8_STAGE(PG8_SA(1, 0), cA + kstep, voffA); PG8_STAGE(PG8_SB(1, 1), cB + hstep + kstep, voffB);
    PG8_WAIT_V(6); PG8_BAR;
    for (;;) {
        const bool has_next = S.next(ui + 1, nxt);
        const char* nA = has_next ? (const char*)(nxt.kind ? g.A1 : g.A0) + (size_t)nxt.pm * tstep : cA; const char* nB = has_next ? (const char*)(nxt.kind ? g.B1 : g.B0) + (size_t)nxt.pn * tstep : cB;
        for (int t = 0; t < nt; t += 2) {
            const bool last = (t == nt - 2);
            const char* a1 = cA + (size_t)(t + 1) * kstep;
            const char* a2 = last ? nA : cA + (size_t)(t + 2) * kstep; const char* b2 = last ? nB : cB + (size_t)(t + 2) * kstep;
            const char* a3 = a2 + kstep; const char* b3 = b2 + kstep;
            PG8_LDB(B0, 0, 0); PG8_LDB(B1, 0, 1); PG8_SCHED; PG8_LDA(At, 0, 0); PG8_STAGE(PG8_SA(1, 1), a1 + hstep, voffA);
            PG8_WAIT_V(8); PG8_WAIT_L(0); PG8_BAR; PG8_MMA(0, 0, At, B0); PG8_MMA(0, 1, At, B1); PG8_BAR; PG8_SCHED;
            PG8_LDA(At, 0, 1); PG8_STAGE(PG8_SB(0, 0), b2, voffB); PG8_STAGE(PG8_SB(0, 1), b2 + hstep, voffB); PG8_STAGE(PG8_SA(0, 0), a2, voffA);
            PG8_WAIT_V(8); PG8_WAIT_L(0); PG8_BAR; PG8_MMA(1, 0, At, B0); PG8_MMA(1, 1, At, B1); PG8_BAR; PG8_SCHED;
            PG8_LDB(B0, 1, 0); PG8_LDB(B1, 1, 1); PG8_SCHED; PG8_LDA(At, 1, 0); PG8_STAGE(PG8_SA(0, 1), a2 + hstep, voffA);
            PG8_WAIT_V(8); PG8_WAIT_L(0); PG8_BAR; PG8_MMA(0, 0, At, B0); PG8_MMA(0, 1, At, B1); PG8_BAR; PG8_SCHED;
            PG8_LDA(At, 1, 1); PG8_STAGE(PG8_SB(1, 0), b3, voffB); PG8_STAGE(PG8_SB(1, 1), b3 + hstep, voffB); PG8_STAGE(PG8_SA(1, 0), a3, voffA);
            PG8_WAIT_V(8); PG8_WAIT_L(0); PG8_BAR; PG8_MMA(1, 0, At, B0); PG8_MMA(1, 1, At, B1); PG8_BAR; PG8_SCHED;
        }
        if (wr == 0) PG8_BAR;
        E(acc, cur, wr, wc, fr, fq);
        if (!has_next) break;
#pragma unroll
        for (int a = 0; a < 2; ++a)
#pragma unroll
            for (int b = 0; b < 2; ++b)
#pragma unroll
                for (int m = 0; m < 4; ++m)
#pragma unroll
                    for (int n = 0; n < 2; ++n) acc[a][b][m][n] = (f32x4){0.f, 0.f, 0.f, 0.f};
        cur = nxt; cA = nA; cB = nB; ++ui;
        if (wr == 1) PG8_BAR;
    }
    PG8_WAIT_V(0);
    PG8_BAR;
#undef PG8_SA
#undef PG8_SB
#undef PG8_STAGE
#undef PG8_LDA
#undef PG8_LDB
#undef PG8_MMA
#undef PG8_WAIT_V
#undef PG8_WAIT_L
#undef PG8_BAR
#undef PG8_SCHED
}
}
using pg8::Unit;

struct Args {
    const float* in[26];
    float* out; unsigned char* ws;
    int ph_lo, ph_hi, use_sync, pad;
};

typedef const __attribute__((address_space(4))) Args* ArgsP;
#define KA ((ArgsP)__builtin_amdgcn_kernarg_segment_ptr())
#define A_IN(k) (KA->in[k])
#define A_OUT (KA->out)
#define A_WS (KA->ws)

struct SchedG1 {
    pg8::TileMap m0, m1; int G, c;
    __device__ __forceinline__ void init(int G_, int c_) { m0.init(NMT, 24); m1.init(4, NMT); G = G_; c = c_; }
    __device__ __forceinline__ bool next(int i, Unit& u) const {
        int L = i * G + c;
        if (L < m0.nwg) { m0.map(L, u.pm, u.pn); u.pn = (u.pn < 8) ? u.pn : u.pn + 4; u.kind = 0; return true; }
        L -= m0.nwg; if (L >= m1.nwg) return false;
        m1.map(L, u.pm, u.pn); u.kind = 1; return true;
    }
};
struct SchedPair {
    pg8::TileMap m0; int G, c;
    __device__ __forceinline__ void init(int nN, int G_, int c_) { m0.init(NMT, nN); G = G_; c = c_; }
    __device__ __forceinline__ bool next(int i, Unit& u) const { const int L = (i >> 1) * G + c; if (L >= m0.nwg) return false; m0.map(L, u.pm, u.pn); u.kind = i & 1; return true; }
};
struct SchedOne {
    pg8::TileMap m0; int G, c;
    __device__ __forceinline__ void init(int nN, int G_, int c_) { m0.init(NMT, nN); G = G_; c = c_; }
    __device__ __forceinline__ bool next(int i, Unit& u) const { const int L = i * G + c; if (L >= m0.nwg) return false; m0.map(L, u.pm, u.pn); u.kind = 0; return true; }
};

#define EPI_PREP int fr_ = fr, fq_ = fq; asm volatile("" : "+v"(fr_), "+v"(fq_)); const int rl_ = wr * 64 + fr_, cl_ = wc * 32 + 8 * fq_;
#define EPI_LOOP_BEGIN \
    _Pragma("unroll") for (int ai = 0; ai < 2; ++ai) _Pragma("unroll") for (int m = 0; m < 4; ++m) { const int rit = ai * 128 + m * 16 + rl_; \
    _Pragma("unroll") for (int bj = 0; bj < 2; ++bj) { const int cit = bj * 128 + cl_; f32x4 v0 = acc[ai][bj][m][0], v1 = acc[ai][bj][m][1];
#define EPI_LOOP_END } }

__device__ __forceinline__ size_t kfrag_off(int row, int col) {
    return ((((size_t)(row >> 5) * 16 + (col >> 6)) * 4 + ((col >> 4) & 3)) * 64 + ((col >> 3) & 1) * 32 + swap23(row & 31)) * 8;
}
__device__ __forceinline__ size_t vfrag_off(int vc, int tok) {
    return (((((size_t)(tok >> 5) * 16 + (vc >> 6)) * 2 + ((vc >> 5) & 1)) * 2 + ((tok >> 4) & 1)) * 64 + ((tok >> 3) & 1) * 32 + swap23(vc & 31)) * 8;
}
struct EpiG1 {
    __device__ __forceinline__ void operator()(const f32x4 (&acc)[2][2][4][2], const Unit& u, int wr, int wc, int fr, int fq) const {
        EPI_PREP unsigned char* ws = A_WS; float* out = A_OUT;
        if (u.kind == 0) {
            const int t = u.pn >> 2, ct = (u.pn & 3) * 256;
            bf16_t* base;
            if (t == 0) base = (bf16_t*)(ws + WS_Q); else if (t == 1) base = (bf16_t*)(ws + WS_K); else if (t == 3) base = (bf16_t*)(ws + WS_XR); else if (t == 4) base = (bf16_t*)(ws + WS_G);
            else if (t == 5) base = (u.pm < 256) ? (bf16_t*)(out + O_YP) : (bf16_t*)(ws + WS_SGA) - (size_t)NTP * DM;
            else base = (u.pm < 256) ? (bf16_t*)(out + O_YP) + (size_t)NTP * DM : (bf16_t*)(ws + WS_SGR) - (size_t)NTP * DM;
            if (t == 1) {
                EPI_LOOP_BEGIN
                    u32x4 w; w.x = cvtpk(v0[0], v0[1]); w.y = cvtpk(v0[2], v0[3]); w.z = cvtpk(v1[0], v1[1]); w.w = cvtpk(v1[2], v1[3]);
                    *(u32x4*)(base + kfrag_off(u.pm * 256 + rit, ct + cit)) = w;
                EPI_LOOP_END
            } else {
            base += (size_t)u.pm * 256 * DM + ct;
            EPI_LOOP_BEGIN
                u32x4 w; w.x = cvtpk(v0[0], v0[1]); w.y = cvtpk(v0[2], v0[3]); w.z = cvtpk(v1[0], v1[1]); w.w = cvtpk(v1[2], v1[3]);
                *(u32x4*)(base + (size_t)rit * DM + cit) = w;
            EPI_LOOP_END
            }
            if (t == 1 && u.pm < 256 && (u.pm & 15) >= 14) { float* p0 = out + O_KP + ((size_t)(u.pm >> 4) * 512 + ((u.pm & 15) - 14) * 256) * DM + ct;
                EPI_LOOP_BEGIN float* p = p0 + (size_t)rit * DM + cit; *(f32x4*)p = v0; *(f32x4*)(p + 4) = v1; EPI_LOOP_END }
            if (t == 1 && u.pm == 256) { float* p0 = out + O_KS + ct;
                EPI_LOOP_BEGIN if (rit < NTS) { float* p = p0 + (size_t)rit * DM + cit; *(f32x4*)p = v0; *(f32x4*)(p + 4) = v1; } EPI_LOOP_END }
            if (t == 3 && u.pm < 256 && (u.pm & 15) == 15) { float* p0 = out + O_CP + ((size_t)(u.pm >> 4) * 3) * DM + ct;
                EPI_LOOP_BEGIN if (rit >= 253) { float* p = p0 + (size_t)(rit - 253) * DM + cit; *(f32x4*)p = v0; *(f32x4*)(p + 4) = v1; } EPI_LOOP_END }
            if (t == 3 && u.pm == 256) { float* p0 = out + O_CS + ct;
                EPI_LOOP_BEGIN if (rit < NTS && (rit & 15) >= 13) { float* p = p0 + ((size_t)(rit >> 4) * 3 + ((rit & 15) - 13)) * DM + cit; *(f32x4*)p = v0; *(f32x4*)(p + 4) = v1; } EPI_LOOP_END }
        } else {
            bf16_t* VT = (bf16_t*)(ws + WS_VT);
            EPI_LOOP_BEGIN
                u32x4 w; w.x = cvtpk(v0[0], v0[1]); w.y = cvtpk(v0[2], v0[3]); w.z = cvtpk(v1[0], v1[1]); w.w = cvtpk(v1[2], v1[3]);
                *(u32x4*)(VT + vfrag_off(u.pm * 256 + rit, u.pn * 256 + cit)) = w;
            EPI_LOOP_END
            if (u.pn < 256 && (u.pn & 15) >= 14) { float* p0 = out + O_VP + ((size_t)(u.pn >> 4) * 512 + ((u.pn & 15) - 14) * 256) * DM + u.pm * 256;
                EPI_LOOP_BEGIN float* p = p0 + (size_t)cit * DM + rit;
                    p[0] = v0[0]; p[DM] = v0[1]; p[2 * DM] = v0[2]; p[3 * DM] = v0[3]; p[4 * DM] = v1[0]; p[5 * DM] = v1[1]; p[6 * DM] = v1[2]; p[7 * DM] = v1[3]; EPI_LOOP_END }
            if (u.pn == 256) { float* p0 = out + O_VS + u.pm * 256;
                EPI_LOOP_BEGIN if (cit < NTS) { float* p = p0 + (size_t)cit * DM + rit;
                    p[0] = v0[0]; p[DM] = v0[1]; p[2 * DM] = v0[2]; p[3 * DM] = v0[3]; p[4 * DM] = v1[0]; p[5 * DM] = v1[1]; p[6 * DM] = v1[2]; p[7 * DM] = v1[3]; } EPI_LOOP_END }
        }
    }
};

struct EpiP3 {
    __device__ __forceinline__ void operator()(const f32x4 (&acc)[2][2][4][2], const Unit& u, int wr, int wc, int fr, int fq) const {
        EPI_PREP unsigned char* ws = A_WS; float* out = A_OUT;
        const bf16_t* gb = (u.pm < 256) ? (const bf16_t*)(out + O_YP) + (u.kind ? (size_t)NTP * DM : 0) : (const bf16_t*)(ws + (u.kind ? WS_SGR : WS_SGA)) - (size_t)NTP * DM;
        const size_t off0 = (size_t)u.pm * 256 * DM + u.pn * 256;
        gb += off0; float* T1 = (float*)(ws + WS_K) + off0; bf16_t* MG = (bf16_t*)(ws + WS_XR) + off0;
        EPI_LOOP_BEGIN
            const size_t off = (size_t)rit * DM + cit;
            const u32x4 gw = *(const u32x4*)(gb + off);
            f32x4 s0, s1;
            s0[0] = sigmoidf_(bflo(gw.x)); s0[1] = sigmoidf_(bfhi(gw.x)); s0[2] = sigmoidf_(bflo(gw.y)); s0[3] = sigmoidf_(bfhi(gw.y));
            s1[0] = sigmoidf_(bflo(gw.z)); s1[1] = sigmoidf_(bfhi(gw.z)); s1[2] = sigmoidf_(bflo(gw.w)); s1[3] = sigmoidf_(bfhi(gw.w));
            if (u.kind == 0) { *(f32x4*)(T1 + off) = s0 * v0; *(f32x4*)(T1 + off + 4) = s1 * v1; }
            else { const f32x4 a0 = *(const f32x4*)(T1 + off) + s0 * v0, a1 = *(const f32x4*)(T1 + off + 4) + s1 * v1;
                u32x4 w; w.x = cvtpk(a0[0], a0[1]); w.y = cvtpk(a0[2], a0[3]); w.z = cvtpk(a1[0], a1[1]); w.w = cvtpk(a1[2], a1[3]);
                *(u32x4*)(MG + off) = w; }
        EPI_LOOP_END
    }
};

struct EpiP4 {
    __device__ __forceinline__ void operator()(const f32x4 (&acc)[2][2][4][2], const Unit& u, int wr, int wc, int fr, int fq) const {
        EPI_PREP float* out = A_OUT;
        if (u.pm < 256) { const size_t off0 = (size_t)u.pm * 256 * DM + u.pn * 256; const float* xp = A_IN(0) + off0; float* yo = out + O_YP + off0;
            EPI_LOOP_BEGIN const size_t off = (size_t)rit * DM + cit;
                *(f32x4*)(yo + off) = *(const f32x4*)(xp + off) + v0; *(f32x4*)(yo + off + 4) = *(const f32x4*)(xp + off + 4) + v1; EPI_LOOP_END }
        else { const float* xs = A_IN(1) + u.pn * 256; float* yo = out + O_YS + u.pn * 256;
            EPI_LOOP_BEGIN if (rit < NTS) { const size_t off = (size_t)rit * DM + cit;
                *(f32x4*)(yo + off) = *(const f32x4*)(xs + off) + v0; *(f32x4*)(yo + off + 4) = *(const f32x4*)(xs + off + 4) + v1; } EPI_LOOP_END }
    }
};

struct EpiP5 {
    __device__ __forceinline__ void operator()(const f32x4 (&acc)[2][2][4][2], const Unit& u, int wr, int wc, int fr, int fq) const {
        EPI_PREP float* SC = (float*)(A_WS + WS_XN) + (size_t)u.pm * 256 * 2048 + u.pn * 256;
        EPI_LOOP_BEGIN
            float* p = SC + (size_t)rit * 2048 + cit; *(f32x4*)p = v0; *(f32x4*)(p + 4) = v1;
        EPI_LOOP_END
    }
};

__device__ __forceinline__ void p0_transpose_item(const float* W, int K, int N, bf16_t* WT, LAS float* scr, int item, int lane, int nscale = 0) {
    const int nblk = N / 32, kb = item / nblk, nb = item % nblk, k0 = 64 * kb, n0 = 32 * nb;
#pragma unroll 8
    for (int i = 0; i < 32; ++i) { const int kk = 2 * i + (lane >> 5); scr[kk * 33 + (lane & 31)] = W[(size_t)(k0 + kk) * N + n0 + (lane & 31)] * (n0 < nscale ? QSCALE : 1.0f); }
    asm volatile("s_waitcnt lgkmcnt(0)" ::: "memory");
    const int c = lane & 7;
#pragma unroll
    for (int j = 0; j < 4; ++j) { const int n = (lane >> 3) + 8 * j; const LAS float* s = scr + (8 * c) * 33 + n;
        u32x4 o; o.x = cvtpk(s[0 * 33], s[1 * 33]); o.y = cvtpk(s[2 * 33], s[3 * 33]); o.z = cvtpk(s[4 * 33], s[5 * 33]); o.w = cvtpk(s[6 * 33], s[7 * 33]);
        *(u32x4*)(WT + (size_t)(n0 + n) * K + k0 + 8 * c) = o; }
    asm volatile("s_waitcnt lgkmcnt(0)" ::: "memory");
}

__device__ __forceinline__ void p0_prologue(LAS unsigned char* lds, int G, int wave, int lane) {
    unsigned char* ws = A_WS;
    const int gw = blockIdx.x * 8 + wave, NGW = G * 8;
    LAS float* scr = (LAS float*)(lds + wave * 16384);
    constexpr int I_IN = 16 * (INC / 32), I_SQ = 16 * 32, NTR = I_IN + 3 * I_SQ;
    for (int it = gw; it < NTR; it += NGW) {
        int r = it;
        if (r < I_IN) { p0_transpose_item(A_IN(7), DM, INC, (bf16_t*)(ws + WS_WIN), scr, r, lane, 1024); continue; } r -= I_IN;
        if (r < I_SQ) { p0_transpose_item(A_IN(16), DM, DM, (bf16_t*)(ws + WS_WBA), scr, r, lane); continue; } r -= I_SQ;
        if (r < I_SQ) { p0_transpose_item(A_IN(17), DM, DM, (bf16_t*)(ws + WS_WBL), scr, r, lane); continue; } r -= I_SQ;
        p0_transpose_item(A_IN(18), DM, DM, (bf16_t*)(ws + WS_WO), scr, r, lane);
    }
    {
        const float* wq = A_IN(20); bf16_t* wst = (bf16_t*)(ws + WS_WS);
        const int r32 = lane & 31, hi = lane >> 5;
        for (int it = gw; it < 2048; it += NGW) {
            const int hj = it >> 7, kt = (it >> 5) & 3, ct = it & 31, h = hj >> 1, j = hj & 1;
            const float* ap = (j ? A_IN(22) : A_IN(21)) + ((size_t)(h * 128 + kt * 32 + r32)) * 128 + 64 * hi;
            const float* bp = wq + (size_t)(ct * 32 + r32) * 2048 + hj * 128 + 64 * hi;
            f32x16 acc = {};
#pragma unroll
            for (int s4 = 0; s4 < 16; ++s4) { const f32x4 av = *(const f32x4*)(ap + 4 * s4), bv = *(const f32x4*)(bp + 4 * s4);
                acc = __builtin_amdgcn_mfma_f32_32x32x2f32(av[0], bv[0], acc, 0, 0, 0); acc = __builtin_amdgcn_mfma_f32_32x32x2f32(av[1], bv[1], acc, 0, 0, 0);
                acc = __builtin_amdgcn_mfma_f32_32x32x2f32(av[2], bv[2], acc, 0, 0, 0); acc = __builtin_amdgcn_mfma_f32_32x32x2f32(av[3], bv[3], acc, 0, 0, 0); }
#pragma unroll
            for (int r = 0; r < 16; ++r) { const int key = kt * 32 + (r & 3) + 8 * (r >> 2) + 4 * hi;
                wst[(size_t)(hj * 128 + key) * DM + ct * 32 + r32] = (bf16_t)(cvtpk(acc[r], 0.f) & 0xffffu); }
        }
    }
    for (int it = gw; it < 2 * NEXP; it += NGW) {
        const int tb = it >= NEXP, e = it - tb * NEXP;
        const float* src = (tb ? A_IN(24) : A_IN(23)) + (size_t)e * DM + lane * 16;
        unsigned char* dst = ws + (tb ? WS_VB : WS_UB) + (size_t)e * DM + lane * 16;
        f32x4 p[4]; float mx = 0.f;
#pragma unroll
        for (int q = 0; q < 4; ++q) { p[q] = *(const f32x4*)(src + 4 * q); mx = fmaxf(mx, fmaxf(fmaxf(fabsf(p[q][0]), fabsf(p[q][1])), fmaxf(fabsf(p[q][2]), fabsf(p[q][3])))); }
#pragma unroll
        for (int o = 1; o < 64; o <<= 1) mx = fmaxf(mx, __shfl_xor(mx, o));
        const float step = fmaxf(mx, 1e-30f) * (1.0f / 127.0f), inv = 1.0f / step;
        u32x4 w;
#pragma unroll
        for (int q = 0; q < 4; ++q) {
            const int ob = 0;
            const unsigned b0 = (unsigned)((int)rintf(p[q][0] * inv) + ob) & 0xffu, b1 = (unsigned)((int)rintf(p[q][1] * inv) + ob) & 0xffu, b2 = (unsigned)((int)rintf(p[q][2] * inv) + ob) & 0xffu, b3 = (unsigned)((int)rintf(p[q][3] * inv) + ob) & 0xffu;
            w[q] = b0 | (b1 << 8) | (b2 << 16) | (b3 << 24); }
        *(u32x4*)dst = w;
        if (lane == 0) ((float*)(ws + (tb ? WS_SV : WS_SU)))[e] = step;
    }
    {
        const float* gm = A_IN(6); bf16_t* XN = (bf16_t*)(ws + WS_XN);
        for (int m = gw; m < ROWS; m += NGW) {
            bf16_t* orow = XN + (size_t)m * DM;
            if (m >= NTOK) {
#pragma unroll
                for (int j = 0; j < 2; ++j) *(u32x4*)(orow + j * 512 + lane * 8) = (u32x4){0u, 0u, 0u, 0u};
                continue; }
            const float* xr = (m < NTP) ? A_IN(0) + (size_t)m * DM : A_IN(1) + (size_t)(m - NTP) * DM;
            f32x4 v[4]; float s = 0.f;
#pragma unroll
            for (int j = 0; j < 4; ++j) { v[j] = *(const f32x4*)(xr + j * 256 + lane * 4); s += (v[j][0] * v[j][0] + v[j][1] * v[j][1]) + (v[j][2] * v[j][2] + v[j][3] * v[j][3]); }
            const float inv = 1.0f / sqrtf(wave_sum(s) * (1.0f / DM) + EPS);
#pragma unroll
            for (int j = 0; j < 4; ++j) { const f32x4 gg = *(const f32x4*)(gm + j * 256 + lane * 4); const f32x4 y = v[j] * inv * gg;
                u32x2 w; w.x = cvtpk(y[0], y[1]); w.y = cvtpk(y[2], y[3]); *(u32x2*)(orow + j * 256 + lane * 4) = w; }
        }
    }
    {
        bf16_t* fw = (bf16_t*)(ws + WS_LRUW);
        for (int f = gw; f < 256; f += NGW) {
            const int ks = f & 3, T = (f >> 2) & 1, gate = (f >> 3) & 1, g = f >> 4, i = lane & 31, hi = lane >> 5;
            const int outc = 32 * T + swap23(i);
            const float* W = (gate ? A_IN(13) : A_IN(11)) + (size_t)g * 4096;
            float x[8];
#pragma unroll
            for (int j = 0; j < 8; ++j) x[j] = W[(16 * ks + 8 * hi + j) * 64 + outc];
            u32x4 w; w.x = cvtpk(x[0], x[1]); w.y = cvtpk(x[2], x[3]); w.z = cvtpk(x[4], x[5]); w.w = cvtpk(x[6], x[7]);
            *(u32x4*)(fw + (size_t)f * 512 + lane * 8) = w;
        }
    }
}

constexpr int LR_WF = 0, LR_CW = 16384, LR_CB = LR_CW + 1024, LR_BR = LR_CB + 256, LR_BI = LR_BR + 256, LR_CS = LR_BI + 256, LR_CARRY = LR_CS + 256, LR_SEQ = LR_CARRY + 2048, LR_END = LR_SEQ + 64;

__device__ __forceinline__ void lru_load_consts(LAS unsigned char* lds, int g, int tid) {
    const u32x4* src = (const u32x4*)(A_WS + WS_LRUW + (size_t)g * 16384);
    for (int i = tid; i < 1024; i += 512) ((LAS u32x4*)(lds + LR_WF))[i] = src[i];
    if (tid < 256) ((LAS float*)(lds + LR_CW))[tid] = A_IN(9)[(tid >> 6) * DM + g * 64 + (tid & 63)];
    if (tid < 64) {
        const int c = g * 64 + tid;
        ((LAS float*)(lds + LR_CB))[tid] = A_IN(10)[c]; ((LAS float*)(lds + LR_BR))[tid] = A_IN(12)[c]; ((LAS float*)(lds + LR_BI))[tid] = A_IN(14)[c];
        ((LAS float*)(lds + LR_CS))[tid] = 8.0f * log1pf(expf(-A_IN(15)[c]));
    }
    if (tid < 8) ((LAS unsigned*)(lds + LR_SEQ))[tid] = 0xffffffffu;
}

template <bool SAMPLE>
__device__ __forceinline__ void lru_tile(LAS unsigned char* lds, int lane, int g, size_t rowbase, int tile, int bidx) {
    asm volatile("" : "+v"(lane));
    const int tl = lane & 31, hi = lane >> 5, t = tile * 32 + tl;
    const bf16_t* XR = (const bf16_t*)(A_WS + WS_XR); bf16_t* Gb = (bf16_t*)(A_WS + WS_G);
    const int cbase = g * 64 + 8 * hi;
    float xc[4][8];
    bf16x8 xf[4];
#pragma unroll
    for (int ks = 0; ks < 4; ++ks) {
        const f32x4 b0 = *(const LAS f32x4*)(lds + LR_CB + (16 * ks + 8 * hi) * 4), b1 = *(const LAS f32x4*)(lds + LR_CB + (16 * ks + 8 * hi) * 4 + 16);
#pragma unroll
        for (int j = 0; j < 4; ++j) { xc[ks][j] = b0[j]; xc[ks][4 + j] = b1[j]; }
#pragma unroll
        for (int tap = 0; tap < 4; ++tap) {
            const int rr = t - 3 + tap;
            float xv[8];
            {
                u32x4 w = *(const u32x4*)(XR + (rowbase + (rr < 0 ? 0 : rr)) * DM + cbase + 16 * ks);
                if (rr < 0) w = (u32x4){0u, 0u, 0u, 0u};
                xv[0] = bflo(w.x); xv[1] = bfhi(w.x); xv[2] = bflo(w.y); xv[3] = bfhi(w.y); xv[4] = bflo(w.z); xv[5] = bfhi(w.z); xv[6] = bflo(w.w); xv[7] = bfhi(w.w);
            }
            if (SAMPLE) {
                const float* sp = A_IN(4) + ((size_t)bidx * 3 + (rr < 0 ? 3 + rr : 0)) * DM + cbase + 16 * ks;
                const f32x4 p = *(const f32x4*)sp, q = *(const f32x4*)(sp + 4);
#pragma unroll
                for (int j = 0; j < 4; ++j) { xv[j] = rr < 0 ? p[j] : xv[j]; xv[4 + j] = rr < 0 ? q[j] : xv[4 + j]; }
            }
            const f32x4 w0 = *(const LAS f32x4*)(lds + LR_CW + (tap * 64 + 16 * ks + 8 * hi) * 4), w1 = *(const LAS f32x4*)(lds + LR_CW + (tap * 64 + 16 * ks + 8 * hi) * 4 + 16);
#pragma unroll
            for (int j = 0; j < 4; ++j) { xc[ks][j] += w0[j] * xv[j]; xc[ks][4 + j] += w1[j] * xv[4 + j]; }
        }
        u32x4 w; w.x = cvtpk(xc[ks][0], xc[ks][1]); w.y = cvtpk(xc[ks][2], xc[ks][3]); w.z = cvtpk(xc[ks][4], xc[ks][5]); w.w = cvtpk(xc[ks][6], xc[ks][7]);
        xf[ks] = __builtin_bit_cast(bf16x8, w);
        asm volatile("" ::: "memory");
    }
    float A[32], B[32];
#pragma unroll
    for (int T = 0; T < 2; ++T) {
        f32x16 ar = f32x16{}, ai = f32x16{};
#pragma unroll
        for (int ks = 0; ks < 4; ++ks) {
            const bf16x8 wr_ = *(const LAS bf16x8*)(lds + LR_WF + ((0 * 2 + T) * 4 + ks) * 1024 + lane * 16);
            const bf16x8 wi_ = *(const LAS bf16x8*)(lds + LR_WF + ((1 * 2 + T) * 4 + ks) * 1024 + lane * 16);
            ar = __builtin_amdgcn_mfma_f32_32x32x16_bf16(wr_, xf[ks], ar, 0, 0, 0);
            ai = __builtin_amdgcn_mfma_f32_32x32x16_bf16(wi_, xf[ks], ai, 0, 0, 0);
        }
#pragma unroll
        for (int q = 0; q < 2; ++q) {
            const int ks = 2 * T + q, lo = (16 * ks + 8 * hi) * 4;
            const f32x4 br0 = *(const LAS f32x4*)(lds + LR_BR + lo), br1 = *(const LAS f32x4*)(lds + LR_BR + lo + 16);
            const f32x4 bi0 = *(const LAS f32x4*)(lds + LR_BI + lo), bi1 = *(const LAS f32x4*)(lds + LR_BI + lo + 16);
            const f32x4 cs0 = *(const LAS f32x4*)(lds + LR_CS + lo), cs1 = *(const LAS f32x4*)(lds + LR_CS + lo + 16);
#pragma unroll
            for (int j = 0; j < 8; ++j) {
                const int r = 8 * q + j;
                const float brv = j < 4 ? br0[j & 3] : br1[j & 3], biv = j < 4 ? bi0[j & 3] : bi1[j & 3], csv = j < 4 ? cs0[j & 3] : cs1[j & 3];
                const float rg = sigmoidf_(ar[r] + brv), ig = sigmoidf_(ai[r] + biv);
                const float la = -csv * rg, av = fast_exp2(la * LOG2E);
                const float x2 = 2.0f * la;
                const float em = (x2 > -0.03f) ? -x2 * (1.0f + x2 * (0.5f + x2 * (0.16666667f + x2 * 0.041666668f))) : 1.0f - fast_exp2(x2 * LOG2E);
                A[16 * T + r] = av; B[16 * T + r] = sqrtf(em) * ig * xc[ks][j];
            }
        }
        asm volatile("" ::: "memory");
    }
#define LRU_STEP(CTRL, RM) _Pragma("unroll") for (int c = 0; c < 32; ++c) { \
        const float as_ = __builtin_bit_cast(float, __builtin_amdgcn_update_dpp(__builtin_bit_cast(int, 1.0f), __builtin_bit_cast(int, A[c]), CTRL, RM, 0xF, false)); \
        const float bs_ = __builtin_bit_cast(float, __builtin_amdgcn_update_dpp(0, __builtin_bit_cast(int, B[c]), CTRL, RM, 0xF, false)); \
        B[c] = A[c] * bs_ + B[c]; A[c] = A[c] * as_; }
    LRU_STEP(0x111, 0xF) LRU_STEP(0x112, 0xF) LRU_STEP(0x114, 0xF) LRU_STEP(0x118, 0xF) LRU_STEP(0x142, 0xA)
#undef LRU_STEP
    float hin[32];
    if (SAMPLE) {
        const float* hp = A_IN(5) + (size_t)bidx * DM + cbase;
#pragma unroll
        for (int ks = 0; ks < 4; ++ks) { const f32x4 p = *(const f32x4*)(hp + 16 * ks), q = *(const f32x4*)(hp + 16 * ks + 4);
#pragma unroll
            for (int j = 0; j < 4; ++j) { hin[8 * ks + j] = p[j]; hin[8 * ks + 4 + j] = q[j]; } }
    } else if (tile == 0) {
#pragma unroll
        for (int c = 0; c < 32; ++c) hin[c] = 0.f;
    } else {
        volatile LAS unsigned* sq = (volatile LAS unsigned*)(lds + LR_SEQ) + (tile & 7);
        while (*sq != (unsigned)tile) __builtin_amdgcn_s_sleep(1);
        asm volatile("" ::: "memory");
        const LAS float* cp = (const LAS float*)(lds + LR_CARRY) + (tile & 7) * 64 + 8 * hi;
#pragma unroll
        for (int ks = 0; ks < 4; ++ks) { const f32x4 p = *(const LAS f32x4*)(cp + 16 * ks), q = *(const LAS f32x4*)(cp + 16 * ks + 4);
#pragma unroll
            for (int j = 0; j < 4; ++j) { hin[8 * ks + j] = p[j]; hin[8 * ks + 4 + j] = q[j]; } }
    }
#pragma unroll
    for (int c = 0; c < 32; ++c) B[c] = B[c] + A[c] * hin[c];
    if (!SAMPLE) {
        if (tl == 31) {
            if (tile < 127) {
                LAS float* cp = (LAS float*)(lds + LR_CARRY) + ((tile + 1) & 7) * 64 + 8 * hi;
#pragma unroll
                for (int ks = 0; ks < 4; ++ks) { *(LAS f32x4*)(cp + 16 * ks) = (f32x4){B[8 * ks], B[8 * ks + 1], B[8 * ks + 2], B[8 * ks + 3]};
                    *(LAS f32x4*)(cp + 16 * ks + 4) = (f32x4){B[8 * ks + 4], B[8 * ks + 5], B[8 * ks + 6], B[8 * ks + 7]}; }
            } else {
                float* lp = A_OUT + O_LP + (size_t)bidx * DM + cbase;
#pragma unroll
                for (int ks = 0; ks < 4; ++ks) { *(f32x4*)(lp + 16 * ks) = (f32x4){B[8 * ks], B[8 * ks + 1], B[8 * ks + 2], B[8 * ks + 3]};
                    *(f32x4*)(lp + 16 * ks + 4) = (f32x4){B[8 * ks + 4], B[8 * ks + 5], B[8 * ks + 6], B[8 * ks + 7]}; }
            }
        }
        if (tile < 127) {
            asm volatile("s_waitcnt lgkmcnt(0)" ::: "memory");
            if (lane == 63) *((volatile LAS unsigned*)(lds + LR_SEQ) + ((tile + 1) & 7)) = (unsigned)(tile + 1);
        }
    } else if (tl == 15) {
        float* lp = A_OUT + O_LS + (size_t)bidx * DM + cbase;
#pragma unroll
        for (int ks = 0; ks < 4; ++ks) { *(f32x4*)(lp + 16 * ks) = (f32x4){B[8 * ks], B[8 * ks + 1], B[8 * ks + 2], B[8 * ks + 3]};
            *(f32x4*)(lp + 16 * ks + 4) = (f32x4){B[8 * ks + 4], B[8 * ks + 5], B[8 * ks + 6], B[8 * ks + 7]}; }
    }
    if (!SAMPLE || tl < NST) {
        bf16_t* gp = Gb + (rowbase + t) * DM + cbase;
#pragma unroll
        for (int ks = 0; ks < 4; ++ks) {
            const u32x4 w = *(const u32x4*)(gp + 16 * ks);
            float gv[8]; gv[0] = bflo(w.x); gv[1] = bfhi(w.x); gv[2] = bflo(w.y); gv[3] = bfhi(w.y); gv[4] = bflo(w.z); gv[5] = bfhi(w.z); gv[6] = bflo(w.w); gv[7] = bfhi(w.w);
            float o[8];
#pragma unroll
            for (int j = 0; j < 8; ++j) o[j] = B[8 * ks + j] * gelu_tanh(gv[j]);
            u32x4 ow; ow.x = cvtpk(o[0], o[1]); ow.y = cvtpk(o[2], o[3]); ow.z = cvtpk(o[4], o[5]); ow.w = cvtpk(o[6], o[7]);
            *(u32x4*)(gp + 16 * ks) = ow;
        }
    }
}

constexpr int P2_Q = 20608;
constexpr int AT_TAB = 24576;
__device__ __forceinline__ void attn_unit(LAS unsigned char* lds, int lane, int b, int c, int h) {
    const int r32 = lane & 31, hi = lane >> 5, kr = swap23(r32);
    const bf16_t* Q = (const bf16_t*)(A_WS + WS_Q); const bf16_t* Kb = (const bf16_t*)(A_WS + WS_K); const bf16_t* VT = (const bf16_t*)(A_WS + WS_VT); bf16_t* O = (bf16_t*)(A_WS + WS_XN);
    const size_t row0 = (size_t)b * SEQ + (size_t)c * 64;
    bf16x8 qf[2][4];
#pragma unroll
    for (int qb = 0; qb < 2; ++qb)
#pragma unroll
        for (int ks = 0; ks < 4; ++ks) qf[qb][ks] = *(const bf16x8*)(Q + (row0 + qb * 32 + r32) * DM + h * 64 + ks * 16 + hi * 8);
    f32x16 o[2][2];
#pragma unroll
    for (int i = 0; i < 2; ++i)
#pragma unroll
        for (int j = 0; j < 2; ++j) o[i][j] = f32x16{};
    float mrow[2] = {-1e30f, -1e30f}, lrow[2] = {0.f, 0.f};
    const LAS float* tab = (const LAS float*)(lds + AT_TAB) + h * 320;
    const float cfar = tab[256];
    const int sb0 = (c >= 8 ? c - 8 : 0) * 2, sb1 = c * 2 + 1;
    const bf16_t* kbase = Kb + ((size_t)b * 128 * 16 + h) * 4 * 512 + lane * 8;
    const bf16_t* vbase = VT + ((size_t)b * 128 * 16 + h) * 4 * 512 + lane * 8;
    bf16x8 kf[4], vf[2][2];
#pragma unroll
    for (int ks = 0; ks < 4; ++ks) kf[ks] = *(const bf16x8*)(kbase + (size_t)sb0 * 32768 + ks * 512);
#pragma unroll
    for (int db = 0; db < 2; ++db)
#pragma unroll
        for (int s = 0; s < 2; ++s) vf[db][s] = *(const bf16x8*)(vbase + (size_t)sb0 * 32768 + (db * 2 + s) * 512);
    for (int sb = sb0; sb <= sb1; ++sb) {
        const int sbn = sb < sb1 ? sb + 1 : sb;
        f32x16 S[2];
#pragma unroll
        for (int qb = 0; qb < 2; ++qb) { S[qb] = f32x16{};
#pragma unroll
            for (int ks = 0; ks < 4; ++ks) S[qb] = __builtin_amdgcn_mfma_f32_32x32x16_bf16(kf[ks], qf[qb][ks], S[qb], 0, 0, 0); }
        asm volatile("" ::: "memory");
#pragma unroll
        for (int ks = 0; ks < 4; ++ks) kf[ks] = *(const bf16x8*)(kbase + (size_t)sbn * 32768 + ks * 512);
        const int delta = c - (sb >> 1), rb = sb & 1;
        if (delta >= 3) {
#pragma unroll
            for (int qb = 0; qb < 2; ++qb)
#pragma unroll
                for (int r = 0; r < 16; ++r) S[qb][r] += cfar;
        } else {
#pragma unroll
            for (int qb = 0; qb < 2; ++qb) {
                const LAS float* tp = tab + (64 * delta + 32 * qb + r32 + 128 - 32 * rb - 8 * hi - 23);
#pragma unroll
                for (int r = 0; r < 16; ++r) S[qb][r] += tp[23 - (16 * (r >> 3) + (r & 7))];
            }
        }
        float rm[2];
#pragma unroll
        for (int qb = 0; qb < 2; ++qb) { float mx = S[qb][0];
#pragma unroll
            for (int r = 1; r < 16; ++r) mx = fmaxf(mx, S[qb][r]);
            rm[qb] = plswap_max(mx); }
        if (__any((rm[0] > mrow[0] + 8.0f) || (rm[1] > mrow[1] + 8.0f))) {
#pragma unroll
            for (int qb = 0; qb < 2; ++qb) { const float mn = fmaxf(mrow[qb], rm[qb]); const float al = fast_exp2(mrow[qb] - mn); lrow[qb] *= al; mrow[qb] = mn;
#pragma unroll
                for (int r = 0; r < 16; ++r) { o[0][qb][r] *= al; o[1][qb][r] *= al; } }
        }
        bf16x8 pf[2][2];
#pragma unroll
        for (int qb = 0; qb < 2; ++qb) { float sum = 0.f;
#pragma unroll
            for (int r = 0; r < 16; ++r) { S[qb][r] = fast_exp2(S[qb][r] - mrow[qb]); sum += S[qb][r]; }
            lrow[qb] += sum;
#pragma unroll
            for (int s = 0; s < 2; ++s) { u32x4 w; w.x = cvtpk(S[qb][8 * s], S[qb][8 * s + 1]); w.y = cvtpk(S[qb][8 * s + 2], S[qb][8 * s + 3]); w.z = cvtpk(S[qb][8 * s + 4], S[qb][8 * s + 5]); w.w = cvtpk(S[qb][8 * s + 6], S[qb][8 * s + 7]);
                pf[qb][s] = __builtin_bit_cast(bf16x8, w); } }
#pragma unroll
        for (int db = 0; db < 2; ++db)
#pragma unroll
            for (int qb = 0; qb < 2; ++qb)
#pragma unroll
                for (int s = 0; s < 2; ++s) o[db][qb] = __builtin_amdgcn_mfma_f32_32x32x16_bf16(vf[db][s], pf[qb][s], o[db][qb], 0, 0, 0);
        asm volatile("" ::: "memory");
#pragma unroll
        for (int db = 0; db < 2; ++db)
#pragma unroll
            for (int s = 0; s < 2; ++s) vf[db][s] = *(const bf16x8*)(vbase + (size_t)sbn * 32768 + (db * 2 + s) * 512);
    }
#pragma unroll
    for (int qb = 0; qb < 2; ++qb) { const float inv = fast_rcp(plswap_add(lrow[qb]));
        bf16_t* op = O + (row0 + qb * 32 + r32) * DM + h * 64 + 8 * hi;
#pragma unroll
        for (int db = 0; db < 2; ++db)
#pragma unroll
            for (int s = 0; s < 2; ++s) { u32x4 w;
                w.x = cvtpk(o[db][qb][8 * s] * inv, o[db][qb][8 * s + 1] * inv); w.y = cvtpk(o[db][qb][8 * s + 2] * inv, o[db][qb][8 * s + 3] * inv);
                w.z = cvtpk(o[db][qb][8 * s + 4] * inv, o[db][qb][8 * s + 5] * inv); w.w = cvtpk(o[db][qb][8 * s + 6] * inv, o[db][qb][8 * s + 7] * inv);
                *(u32x4*)(op + 32 * db + 16 * s) = w; } }
}

constexpr int AS_P = 45056;
__device__ __forceinline__ void attn_sample_task(LAS unsigned char* lds, int wave, int lane, int task) {
    const int bs = task >> 6, h = (task >> 2) & 15, qg = task & 3;
    const bf16_t* Q = (const bf16_t*)(A_WS + WS_Q); bf16_t* O = (bf16_t*)(A_WS + WS_XN);
    const float* ck = A_IN(2); const float* cv = A_IN(3); const float* kn = A_OUT + O_KS; const float* vn = A_OUT + O_VS;
    LAS float* pb = (LAS float*)(lds + AS_P + wave * 9472);
    LAS float* qs = pb + 4 * 528;
    const LAS float* tab = (const LAS float*)(lds + AT_TAB) + h * 320;
#pragma unroll
    for (int i = 0; i < 4; ++i) qs[i * 64 + lane] = bflo((unsigned)Q[((size_t)NTP + bs * 16 + qg * 4 + i) * DM + h * 64 + lane]);
    asm volatile("s_waitcnt lgkmcnt(0)" ::: "memory");
#pragma unroll 1
    for (int it = 0; it < 9; ++it) {
        const int key = it * 64 + lane; const bool valid = key < 528;
        const float* kp = !valid ? ck : (key < 512 ? ck + (((size_t)bs * 512 + key) * 16 + h) * 64 : kn + ((size_t)bs * 16 + (key - 512)) * DM + h * 64);
        float d[4] = {0.f, 0.f, 0.f, 0.f};
        f32x4 kv[16];
#pragma unroll
        for (int d4 = 0; d4 < 16; ++d4) kv[d4] = *(const f32x4*)(kp + 4 * d4);
#pragma unroll
        for (int d4 = 0; d4 < 16; ++d4) {
#pragma unroll
            for (int i = 0; i < 4; ++i) { const f32x4 qq = *(const LAS f32x4*)(qs + i * 64 + 4 * d4); d[i] += (kv[d4][0] * qq[0] + kv[d4][1] * qq[1]) + (kv[d4][2] * qq[2] + kv[d4][3] * qq[3]); } }
        int rel = 512 + qg * 4 - key;
        if (valid) {
#pragma unroll
            for (int i = 0; i < 4; ++i) { int r = rel + i; r = r > 128 ? 128 : r; pb[i * 528 + key] = d[i] + tab[r + 128]; } }
    }
    asm volatile("s_waitcnt lgkmcnt(0)" ::: "memory");
#pragma unroll 1
    for (int i = 0; i < 4; ++i) {
        float mx = -1e30f;
#pragma unroll 1
        for (int key = lane; key < 528; key += 64) mx = fmaxf(mx, pb[i * 528 + key]);
#pragma unroll
        for (int o = 1; o < 64; o <<= 1) mx = fmaxf(mx, __shfl_xor(mx, o));
        float sum = 0.f;
#pragma unroll 1
        for (int key = lane; key < 528; key += 64) { const float pv = fast_exp2(pb[i * 528 + key] - mx); pb[i * 528 + key] = pv; sum += pv; }
        sum = wave_sum(sum); const float inv = 1.0f / sum;
#pragma unroll 1
        for (int key = lane; key < 528; key += 64) pb[i * 528 + key] *= inv;
    }
    asm volatile("s_waitcnt lgkmcnt(0)" ::: "memory");
    float acc[4] = {0.f, 0.f, 0.f, 0.f};
#pragma unroll 1
    for (int k0 = 0; k0 < 528; k0 += 16) {
        float vv[16];
#pragma unroll
        for (int kk = 0; kk < 16; ++kk) { const int key = k0 + kk; vv[kk] = k0 < 512 ? cv[(((size_t)bs * 512 + key) * 16 + h) * 64 + lane] : vn[((size_t)bs * 16 + (key - 512)) * DM + h * 64 + lane]; }
#pragma unroll
        for (int kk = 0; kk < 16; ++kk) {
#pragma unroll
            for (int i = 0; i < 4; ++i) acc[i] += pb[i * 528 + k0 + kk] * vv[kk]; }
    }
#pragma unroll
    for (int i = 0; i < 4; ++i) O[((size_t)NTP + bs * 16 + qg * 4 + i) * DM + h * 64 + lane] = (bf16_t)(cvtpk(acc[i], 0.f) & 0xffffu);
    asm volatile("s_waitcnt lgkmcnt(0)" ::: "memory");
}

__device__ __forceinline__ void p2_phase(LAS unsigned char* lds, int G, int tid, int wave, int lane) {
    for (int i = tid; i < 16 * 320; i += 512) { const int h = i / 320, j = i % 320; ((LAS float*)(lds + AT_TAB))[i] = A_IN(8)[h * 257 + (j > 256 ? 256 : j)] * LOG2E; }
    for (int u = blockIdx.x; u < 256 + 16; u += G) {
        __syncthreads();
        if (u < 256) {
            const int b = u >> 4, g = u & 15;
            lru_load_consts(lds, g, tid);
            __syncthreads();
            for (int tile = wave; tile < 128; tile += 8) lru_tile<false>(lds, lane, g, (size_t)b * SEQ, tile, b);
        } else {
            const int g = u - 256;
            lru_load_consts(lds, g, tid);
            __syncthreads();
            lru_tile<true>(lds, lane, g, (size_t)NTP + wave * 16, 0, wave);
        }
    }
    if (tid == 0) *(volatile LAS int*)(lds + P2_Q) = 0;
    __syncthreads();
    const int NGW = G * 8;
    int nS = 0; for (int t = blockIdx.x; t < 512; t += G) ++nS;
    for (;;) {
        int j = 0;
        if (lane == 0) j = __hip_atomic_fetch_add((LAS int*)(lds + P2_Q), 1, __ATOMIC_RELAXED, __HIP_MEMORY_SCOPE_WORKGROUP);
        j = __builtin_amdgcn_readfirstlane(j);
        if (j < nS) { attn_sample_task(lds, wave, lane, blockIdx.x + G * j); continue; }
        j -= nS;
        const int u = blockIdx.x * 8 + (j & 7) + NGW * (j >> 3);
        if (u >= NB * 64 * 16) break;
        const int c = u & 63, h = (u >> 6) & 15, b = u >> 10;
        attn_unit(lds, lane, b, c, h);
    }
}

__device__ __forceinline__ void p4b_phase(int G, int wave, int lane) {
    const int gw = blockIdx.x * 8 + wave, NGW = G * 8;
    const float* gm = A_IN(19); bf16_t* XT = (bf16_t*)(A_WS + WS_Q); unsigned char* XQ = A_WS + WS_XQ; float* SX = (float*)(A_WS + WS_SX);
    for (int m = gw; m < NTOK; m += NGW) {
        const float* xr = (m < NTP) ? A_OUT + O_YP + (size_t)m * DM : A_OUT + O_YS + (size_t)(m - NTP) * DM;
        bf16_t* orow = XT + (size_t)m * DM;
        f32x4 v[4]; float s = 0.f;
#pragma unroll
        for (int j = 0; j < 4; ++j) { v[j] = *(const f32x4*)(xr + j * 256 + lane * 4); s += (v[j][0] * v[j][0] + v[j][1] * v[j][1]) + (v[j][2] * v[j][2] + v[j][3] * v[j][3]); }
        const float inv = 1.0f / sqrtf(wave_sum(s) * (1.0f / DM) + EPS);
        float mx = 0.f;
#pragma unroll
        for (int j = 0; j < 4; ++j) { const f32x4 gg = *(const f32x4*)(gm + j * 256 + lane * 4); v[j] = v[j] * inv * gg;
            u32x2 w; w.x = cvtpk(v[j][0], v[j][1]); w.y = cvtpk(v[j][2], v[j][3]); *(u32x2*)(orow + j * 256 + lane * 4) = w;
            mx = fmaxf(mx, fmaxf(fmaxf(fabsf(v[j][0]), fabsf(v[j][1])), fmaxf(fabsf(v[j][2]), fabsf(v[j][3])))); }
#pragma unroll
        for (int o = 1; o < 64; o <<= 1) mx = fmaxf(mx, __shfl_xor(mx, o));
        const float step = fmaxf(mx, 1e-30f) * (1.0f / 127.0f), qi = 1.0f / step;
#pragma unroll
        for (int j = 0; j < 4; ++j) {
            const unsigned b0 = (unsigned)(int)rintf(v[j][0] * qi) & 0xffu, b1 = (unsigned)(int)rintf(v[j][1] * qi) & 0xffu, b2 = (unsigned)(int)rintf(v[j][2] * qi) & 0xffu, b3 = (unsigned)(int)rintf(v[j][3] * qi) & 0xffu;
            *(unsigned*)(XQ + (size_t)m * DM + j * 256 + lane * 4) = b0 | (b1 << 8) | (b2 << 16) | (b3 << 24); }
        if (lane == 0) SX[m] = step;
    }
}

__device__ __forceinline__ int f2key(float f) { const int b = __float_as_int(f); return b ^ ((b >> 31) & 0x7fffffff); }
__device__ __forceinline__ float key2f(int k) { return __int_as_float(k ^ ((k >> 31) & 0x7fffffff)); }
#define INS16(L, x) do { int x_ = (x); _Pragma("unroll") for (int j_ = 0; j_ < 16; ++j_) { const int hi_ = max(L[j_], x_); x_ = min(L[j_], x_); L[j_] = hi_; } } while (0)

constexpr size_t WS_PART = WS_XN;
constexpr int CT_U = 64, CT_V = 64 + 8 * 64;
constexpr int P6_TOKB = 128, P6_NITEM = NTOK / P6_TOKB, P6_TPW = P6_TOKB / 8;
constexpr size_t WS_CQ = WS_VT, WS_CS = WS_VT + 16 * MiB;
constexpr int P6_IDX = 0;
constexpr int P6_E = 0, P6_C = 8192, P6_ITEM = 16384;

__device__ __forceinline__ void p6a_phase(LAS unsigned char* lds, int G, int wave, int lane) {
    const int gw = blockIdx.x * 8 + wave, NGW = G * 8;
    const float* SC = (const float*)(A_WS + WS_XN);
    int* SELE = (int*)(A_WS + WS_SELE); float* SELG = (float*)(A_WS + WS_SELG);
    LAS int* idxb = (LAS int*)(lds + P6_IDX + wave * 4096);
    const int tl = lane >> 4, hh = (lane >> 1) & 7, half = lane & 1;
    for (int grp = gw; grp < NTOK / 4; grp += NGW) {
        const int tok = grp * 4 + tl;
        const float* sp = SC + (size_t)tok * 2048 + hh * 256 + half * 128;
        int L[16];
#pragma unroll
        for (int j = 0; j < 16; ++j) L[j] = (int)0x80000000;
        for (int c4 = 0; c4 < 32; c4 += 2) {
            const f32x4 v0 = *(const f32x4*)(sp + 4 * c4), v1 = *(const f32x4*)(sp + 4 * c4 + 4);
#pragma unroll
            for (int e = 0; e < 4; ++e) INS16(L, (f2key(v0[e]) & ~127) | (4 * c4 + e));
#pragma unroll
            for (int e = 0; e < 4; ++e) INS16(L, (f2key(v1[e]) & ~127) | (4 * c4 + 4 + e));
        }
#pragma unroll
        for (int j = 0; j < 16; ++j) idxb[lane * 16 + j] = L[j] & 127;
        float va[16], vb[16];
#pragma unroll
        for (int j = 0; j < 16; ++j) { const int own = L[j] & ~127, oth = __shfl_xor(own, 1); va[j] = key2f(half ? oth : own); vb[j] = key2f(half ? own : oth); }
        int C[16];
#pragma unroll
        for (int j = 0; j < 16; ++j) C[j] = (int)0x80000000;
#pragma unroll
        for (int i = 0; i < 16; ++i)
#pragma unroll
            for (int j = 0; j < 16; ++j) if ((i + 1) * (j + 1) <= 16) INS16(C, (f2key(va[i] + vb[j]) & ~255) | (i * 16 + j));
        const float mx = key2f(C[0] & ~255);
        float ev[16], sum = 0.f;
#pragma unroll
        for (int j = 0; j < 16; ++j) { ev[j] = __expf(key2f(C[j] & ~255) - mx); sum += ev[j]; }
        const float inv = 1.0f / sum;
        asm volatile("s_waitcnt lgkmcnt(0)" ::: "memory");
        int eo[8]; float go[8];
#pragma unroll
        for (int s = 0; s < 8; ++s) {
            int c_lo = C[s], c_hi = C[8 + s]; float e_lo = ev[s], e_hi = ev[8 + s];
            asm volatile("" : "+v"(c_lo), "+v"(c_hi), "+v"(e_lo), "+v"(e_hi));
            const int cc = half ? c_hi : c_lo; go[s] = (half ? e_hi : e_lo) * inv;
            const int ij = cc & 255, i1 = idxb[(lane & ~1) * 16 + (ij >> 4)], i2 = idxb[(lane | 1) * 16 + (ij & 15)];
            eo[s] = i1 * 128 + i2;
        }
        int* ep = SELE + (size_t)tok * 128 + hh * 16 + half * 8; float* gp = SELG + (size_t)tok * 128 + hh * 16 + half * 8;
        *(u32x4*)ep = (u32x4){(unsigned)eo[0], (unsigned)eo[1], (unsigned)eo[2], (unsigned)eo[3]}; *(u32x4*)(ep + 4) = (u32x4){(unsigned)eo[4], (unsigned)eo[5], (unsigned)eo[6], (unsigned)eo[7]};
        *(f32x4*)gp = (f32x4){go[0], go[1], go[2], go[3]}; *(f32x4*)(gp + 4) = (f32x4){go[4], go[5], go[6], go[7]};
        asm volatile("s_waitcnt lgkmcnt(0)" ::: "memory");
    }
}

__device__ __forceinline__ float dot2bf(unsigned a, unsigned b, float c) { return __builtin_amdgcn_fdot2_f32_bf16(__builtin_bit_cast(bf16x2_t, a), __builtin_bit_cast(bf16x2_t, b), c, false); }
__device__ __forceinline__ unsigned xcc_id() { return (unsigned)__builtin_amdgcn_s_getreg((3 << 11) | 20) & 0xFu; }
__device__ __forceinline__ float dpp_sum16(float v) {
    v += __builtin_bit_cast(float, __builtin_amdgcn_update_dpp(0, __builtin_bit_cast(int, v), 0xB1, 0xF, 0xF, true));
    v += __builtin_bit_cast(float, __builtin_amdgcn_update_dpp(0, __builtin_bit_cast(int, v), 0x4E, 0xF, 0xF, true));
    v += __builtin_bit_cast(float, __builtin_amdgcn_update_dpp(0, __builtin_bit_cast(int, v), 0x141, 0xF, 0xF, true));
    v += __builtin_bit_cast(float, __builtin_amdgcn_update_dpp(0, __builtin_bit_cast(int, v), 0x140, 0xF, 0xF, true));
    return v;
}
__device__ __forceinline__ bool p6_claim(LAS unsigned char* lds, unsigned* cnt, int tid, int& ring, int home, int& slice, int& item) {
    for (;;) {
        if (ring >= 8) return false;
        slice = (home + ring) & 7;
        __syncthreads();
        if (tid == 0) *(volatile LAS int*)(lds + P6_ITEM) = (int)__hip_atomic_fetch_add(cnt + 64 * slice, 1u, __ATOMIC_RELAXED, __HIP_MEMORY_SCOPE_AGENT);
        __syncthreads();
        item = *(volatile LAS int*)(lds + P6_ITEM);
        if (item < P6_NITEM) return true;
        ++ring;
    }
}

__device__ __forceinline__ float ub0(unsigned w) { return (float)(w & 0xffu); }
__device__ __forceinline__ float ub1(unsigned w) { return (float)((w >> 8) & 0xffu); }
__device__ __forceinline__ float ub2(unsigned w) { return (float)((w >> 16) & 0xffu); }
__device__ __forceinline__ float ub3(unsigned w) { return (float)(w >> 24); }
__device__ __forceinline__ float dpp_sum8(float v) {
    v += __builtin_bit_cast(float, __builtin_amdgcn_update_dpp(0, __builtin_bit_cast(int, v), 0xB1, 0xF, 0xF, true));
    v += __builtin_bit_cast(float, __builtin_amdgcn_update_dpp(0, __builtin_bit_cast(int, v), 0x4E, 0xF, 0xF, true));
    v += __builtin_bit_cast(float, __builtin_amdgcn_update_dpp(0, __builtin_bit_cast(int, v), 0x141, 0xF, 0xF, true));
    return v;
}
__device__ __forceinline__ int dpp_isum8(int v) {
    v += __builtin_amdgcn_update_dpp(0, v, 0xB1, 0xF, 0xF, true);
    v += __builtin_amdgcn_update_dpp(0, v, 0x4E, 0xF, 0xF, true);
    v += __builtin_amdgcn_update_dpp(0, v, 0x141, 0xF, 0xF, true);
    return v;
}
__device__ __forceinline__ void p6b_phase(LAS unsigned char* lds, int tid, int wave, int lane) {
    const unsigned char* XQ = A_WS + WS_XQ; const unsigned char* UB = A_WS + WS_UB; const float* SX = (const float*)(A_WS + WS_SX);
    const int* SELE = (const int*)(A_WS + WS_SELE); float* PART = (float*)(A_WS + WS_PART);
    unsigned* cnt = (unsigned*)(A_WS + WS_CTL) + CT_U;
    const int i8 = lane & 7, grp = lane >> 3, home = (int)(xcc_id() & 7u);
    LAS int* eb = (LAS int*)(lds + P6_E + wave * 1024);
    int ring = 0, slice, item;
    while (p6_claim(lds, cnt, tid, ring, home, slice, item)) {
        const int tok0 = item * P6_TOKB + wave * P6_TPW;
        int e0 = SELE[(size_t)tok0 * 128 + lane], e1 = SELE[(size_t)tok0 * 128 + 64 + lane];
#pragma unroll 2
        for (int ti = 0; ti < P6_TPW; ++ti) {
            const int tok = tok0 + ti;
            LAS int* ebt = eb + (ti & 1) * 128;
            ebt[lane] = e0; ebt[64 + lane] = e1;
            if (ti < P6_TPW - 1) { e0 = SELE[(size_t)(tok + 1) * 128 + lane]; e1 = SELE[(size_t)(tok + 1) * 128 + 64 + lane]; }
            const u32x4 xq = *(const u32x4*)(XQ + (size_t)tok * DM + slice * 128 + i8 * 16);
            const int x0 = (int)xq.x, x1 = (int)xq.y, x2 = (int)xq.z, x3 = (int)xq.w;
            const float sx = SX[tok];
            const unsigned char* ub = UB + slice * 128 + i8 * 16;
            asm volatile("s_waitcnt lgkmcnt(0)" ::: "memory");
            u32x4 uv[16];
#pragma unroll
            for (int q = 0; q < 16; ++q) { const int e = ebt[16 * grp + q]; uv[q] = *(const u32x4*)(ub + (size_t)e * DM); }
            int res0 = 0, res1 = 0;
#pragma unroll
            for (int q = 0; q < 16; ++q) {
                const int a0 = (int)uv[q].x, a1 = (int)uv[q].y, a2 = (int)uv[q].z, a3 = (int)uv[q].w;
                int d = __builtin_amdgcn_sdot4(a0, x0, 0, false); d = __builtin_amdgcn_sdot4(a1, x1, d, false); d = __builtin_amdgcn_sdot4(a2, x2, d, false); d = __builtin_amdgcn_sdot4(a3, x3, d, false);
                d = dpp_isum8(d);
                if (q < 8) res0 = (i8 == q) ? d : res0; else res1 = (i8 == (q - 8)) ? d : res1;
            }
            float* pp = PART + ((size_t)slice * NTOK + tok) * 128 + 16 * grp + i8;
            pp[0] = (float)res0 * sx; pp[8] = (float)res1 * sx;
        }
    }
}

__device__ __forceinline__ void p6m_phase(int G, int wave, int lane) {
    const int gw = blockIdx.x * 8 + wave, NGW = G * 8;
    const float* SU = (const float*)(A_WS + WS_SU); const float* SV = (const float*)(A_WS + WS_SV);
    const int* SELE = (const int*)(A_WS + WS_SELE); const float* SELG = (const float*)(A_WS + WS_SELG); const float* PART = (const float*)(A_WS + WS_PART);
    unsigned char* CQ = A_WS + WS_CQ; float* CS = (float*)(A_WS + WS_CS);
    for (int tok = gw; tok < NTOK; tok += NGW) {
        float a0 = 0.f, a1 = 0.f;
#pragma unroll
        for (int j = 0; j < 8; ++j) { const float* pp = PART + ((size_t)j * NTOK + tok) * 128; a0 += pp[lane]; a1 += pp[64 + lane]; }
        const int e0 = SELE[(size_t)tok * 128 + lane], e1 = SELE[(size_t)tok * 128 + 64 + lane];
        const float c0 = SELG[(size_t)tok * 128 + lane] * gelu_tanh(a0 * SU[e0]) * SV[e0], c1 = SELG[(size_t)tok * 128 + 64 + lane] * gelu_tanh(a1 * SU[e1]) * SV[e1];
        float mx = fmaxf(fabsf(c0), fabsf(c1));
#pragma unroll
        for (int o = 1; o < 64; o <<= 1) mx = fmaxf(mx, __shfl_xor(mx, o));
        const float cstep = fmaxf(mx, 1e-30f) * (1.0f / 127.0f), cinv = 1.0f / cstep;
        CQ[(size_t)tok * 128 + lane] = (unsigned char)((int)rintf(c0 * cinv) & 0xff); CQ[(size_t)tok * 128 + 64 + lane] = (unsigned char)((int)rintf(c1 * cinv) & 0xff);
        if (lane == 0) CS[tok] = cstep;
    }
}

__device__ __forceinline__ void p6c_phase(LAS unsigned char* lds, int tid, int wave, int lane) {
    const unsigned char* VB = A_WS + WS_VB; const int* SELE = (const int*)(A_WS + WS_SELE);
    const unsigned char* CQ = A_WS + WS_CQ; const float* CS = (const float*)(A_WS + WS_CS);
    unsigned* cnt = (unsigned*)(A_WS + WS_CTL) + CT_V;
    float* out = A_OUT;
    const int i8 = lane & 7, grp = lane >> 3, home = (int)(xcc_id() & 7u);
    LAS int* eb = (LAS int*)(lds + P6_E + wave * 1024);
    LAS int* cbb = (LAS int*)(lds + P6_C + wave * 512);
    int ring = 0, slice, item;
    while (p6_claim(lds, cnt, tid, ring, home, slice, item)) {
        const int tok0 = item * P6_TOKB + wave * P6_TPW;
        int e0 = SELE[(size_t)tok0 * 128 + lane], e1 = SELE[(size_t)tok0 * 128 + 64 + lane];
        int cw = ((const int*)(CQ + (size_t)tok0 * 128))[lane & 31];
        float cstep = CS[tok0];
#pragma unroll 2
        for (int ti = 0; ti < P6_TPW; ++ti) {
            const int tok = tok0 + ti;
            LAS int* ebt = eb + (ti & 1) * 128; LAS int* cbt = cbb + (ti & 1) * 32;
            ebt[lane] = e0; ebt[64 + lane] = e1; if (lane < 32) cbt[lane] = cw;
            const float cs = cstep;
            if (ti < P6_TPW - 1) { e0 = SELE[(size_t)(tok + 1) * 128 + lane]; e1 = SELE[(size_t)(tok + 1) * 128 + 64 + lane]; cw = ((const int*)(CQ + (size_t)(tok + 1) * 128))[lane & 31]; cstep = CS[tok + 1]; }
            float* yr = ((tok < NTP) ? out + O_YP + (size_t)tok * DM : out + O_YS + (size_t)(tok - NTP) * DM) + slice * 128 + i8 * 16;
            f32x4 z[4];
            if (lane < 8) {
#pragma unroll
                for (int q = 0; q < 4; ++q) z[q] = *(const f32x4*)(yr + 4 * q);
            }
            const unsigned char* vb = VB + slice * 128 + i8 * 16;
            asm volatile("s_waitcnt lgkmcnt(0)" ::: "memory");
            u32x4 vv[16];
#pragma unroll
            for (int q = 0; q < 16; ++q) { const int e = ebt[16 * grp + q]; vv[q] = *(const u32x4*)(vb + (size_t)e * DM); }
            int acc[16];
#pragma unroll
            for (int r = 0; r < 16; ++r) acc[r] = 0;
#pragma unroll
            for (int a4 = 0; a4 < 4; ++a4) {
                const int cq = cbt[4 * grp + a4];
#pragma unroll
                for (int d = 0; d < 4; ++d) {
                    const unsigned ra = vv[4 * a4][d], rb = vv[4 * a4 + 1][d], rc = vv[4 * a4 + 2][d], rd = vv[4 * a4 + 3][d];
                    const unsigned lo = __builtin_amdgcn_perm(rb, ra, 0x05010400u), hi = __builtin_amdgcn_perm(rb, ra, 0x07030602u);
                    const unsigned lo2 = __builtin_amdgcn_perm(rd, rc, 0x05010400u), hi2 = __builtin_amdgcn_perm(rd, rc, 0x07030602u);
                    const unsigned t0 = __builtin_amdgcn_perm(lo2, lo, 0x05040100u), t1 = __builtin_amdgcn_perm(lo2, lo, 0x07060302u);
                    const unsigned t2 = __builtin_amdgcn_perm(hi2, hi, 0x05040100u), t3 = __builtin_amdgcn_perm(hi2, hi, 0x07060302u);
                    acc[4 * d + 0] = __builtin_amdgcn_sdot4((int)t0, cq, acc[4 * d + 0], false); acc[4 * d + 1] = __builtin_amdgcn_sdot4((int)t1, cq, acc[4 * d + 1], false);
                    acc[4 * d + 2] = __builtin_amdgcn_sdot4((int)t2, cq, acc[4 * d + 2], false); acc[4 * d + 3] = __builtin_amdgcn_sdot4((int)t3, cq, acc[4 * d + 3], false);
                }
            }
#pragma unroll
            for (int r = 0; r < 16; ++r) { acc[r] += __shfl_xor(acc[r], 8); acc[r] += __shfl_xor(acc[r], 16); acc[r] += __shfl_xor(acc[r], 32); }
            if (lane < 8) {
#pragma unroll
                for (int q = 0; q < 4; ++q) { z[q] += (f32x4){(float)acc[4 * q] * cs, (float)acc[4 * q + 1] * cs, (float)acc[4 * q + 2] * cs, (float)acc[4 * q + 3] * cs}; *(f32x4*)(yr + 4 * q) = z[q]; }
            }
        }
    }
}

__device__ __forceinline__ void p6d_phase(int G, int wave, int lane) {
    const int gw = blockIdx.x * 8 + wave, NGW = G * 8;
    const float* gf = A_IN(25); float* out = A_OUT;
    for (int m = gw; m < NTOK; m += NGW) {
        float* yr = (m < NTP) ? out + O_YP + (size_t)m * DM : out + O_YS + (size_t)(m - NTP) * DM;
        f32x4 v[4]; float s = 0.f;
#pragma unroll
        for (int j = 0; j < 4; ++j) { v[j] = *(const f32x4*)(yr + j * 256 + lane * 4); s += (v[j][0] * v[j][0] + v[j][1] * v[j][1]) + (v[j][2] * v[j][2] + v[j][3] * v[j][3]); }
        const float inv = 1.0f / sqrtf(wave_sum(s) * (1.0f / DM) + EPS);
#pragma unroll
        for (int j = 0; j < 4; ++j) { const f32x4 gg = *(const f32x4*)(gf + j * 256 + lane * 4); *(f32x4*)(yr + j * 256 + lane * 4) = v[j] * inv * gg; }
    }
}

#define XB_TMO      128
#define XB_XCNT(j)  (256  + 64 * (j))
#define XB_XSUB(j)  (1280 + 64 * (j))
#define XB_XGEN(j)  (2304 + 64 * (j))
#define XB_TOP      3328
#define XB_TOPGEN   3392
#define XB_SPIN_CAP (1u << 22)
constexpr int CW_BAR = 2048;
constexpr int LDS_MISC = 131072 + 64;
__device__ __forceinline__ unsigned xb_ld(unsigned* p)              { return __hip_atomic_load(p, __ATOMIC_RELAXED, __HIP_MEMORY_SCOPE_AGENT); }
__device__ __forceinline__ unsigned xb_add(unsigned* p, unsigned v) { return __hip_atomic_fetch_add(p, v, __ATOMIC_RELAXED, __HIP_MEMORY_SCOPE_AGENT); }
#define XB_SPIN(cond, bar) do { unsigned _sp = 0; while (cond) { __builtin_amdgcn_s_sleep(1); \
    if ((++_sp & 255u) == 0u) { if (xb_ld(&(bar)[XB_TMO])) break; if (_sp > XB_SPIN_CAP) { atomicAdd(&(bar)[XB_TMO], 1u); break; } } } } while (0)
struct XcdBarrier { unsigned* bar; unsigned x; volatile LAS unsigned* st; };
__device__ __forceinline__ XcdBarrier xcd_barrier_post(unsigned* bar, volatile LAS unsigned* st) {
    XcdBarrier b; b.bar = bar; b.x = (unsigned)__builtin_amdgcn_s_getreg((3 << 11) | 20) & 0xFu; b.st = st;
    if (threadIdx.x == 0) (void)xb_add(&bar[XB_XCNT(b.x)], 1u);
    return b;
}
__device__ __forceinline__ void xcd_barrier_complete(unsigned* bar, unsigned x, unsigned& nloc, unsigned& nx) {
    const unsigned G = gridDim.x * gridDim.y * gridDim.z;
    unsigned sum, cnt, mine, sp = 0u;
    for (;;) {
        sum = 0u; cnt = 0u; mine = 0u;
#pragma unroll
        for (unsigned j = 0; j < 16; ++j) { const unsigned c = xb_ld(&bar[XB_XCNT(j)]); sum += c; cnt += (c > 0u) ? 1u : 0u; mine = (j == x) ? c : mine; }
        if (sum == G) break;
        __builtin_amdgcn_s_sleep(1);
        if ((++sp & 255u) == 0u) { if (xb_ld(&bar[XB_TMO])) break; if (sp > XB_SPIN_CAP) { atomicAdd(&bar[XB_TMO], 1u); break; } }
    }
    nloc = mine > 0u ? mine : 1u; nx = cnt > 0u ? cnt : 1u;
}
__device__ __forceinline__ void xcd_barrier(const XcdBarrier& b) {
    asm volatile("s_waitcnt vmcnt(0)" ::: "memory");
    __syncthreads();
    if (threadIdx.x == 0) {
        unsigned* bar = b.bar;
        __builtin_amdgcn_s_waitcnt(0);
        unsigned nloc = b.st[0], nx = b.st[1];
        if (nloc == 0u) { xcd_barrier_complete(bar, b.x, nloc, nx); b.st[0] = nloc; b.st[1] = nx; }
        const unsigned old = xb_add(&bar[XB_XSUB(b.x)], 1u);
        const unsigned gen = old / nloc;
        if (old + 1u == (gen + 1u) * nloc) {
            __builtin_amdgcn_fence(__ATOMIC_RELEASE, "agent");
            asm volatile("s_waitcnt vmcnt(0)" ::: "memory");
            const unsigned og = xb_add(&bar[XB_TOP], 1u);
            const unsigned tg = og / nx;
            if (og + 1u == (tg + 1u) * nx) xb_add(&bar[XB_TOPGEN], 1u);
            else XB_SPIN(xb_ld(&bar[XB_TOPGEN]) == tg, bar);
            __builtin_amdgcn_fence(__ATOMIC_ACQUIRE, "agent");
            xb_add(&bar[XB_XGEN(b.x)], 1u);
            asm volatile("s_waitcnt vmcnt(0)" ::: "memory");
        } else {
            XB_SPIN(xb_ld(&bar[XB_XGEN(b.x)]) == gen, bar);
            __builtin_amdgcn_fence(__ATOMIC_ACQUIRE, "agent");
            asm volatile("s_waitcnt vmcnt(0)" ::: "memory");
        }
    }
    __syncthreads();
}

__global__ void __launch_bounds__(512, 2) hybrid_fwd(Args a) {
    extern __shared__ __attribute__((aligned(16))) unsigned char lds_raw[];
    LAS unsigned char* lds = (LAS unsigned char*)lds_raw;
    const int tid = threadIdx.x, lane = tid & 63, wave = __builtin_amdgcn_readfirstlane(tid >> 6), G = gridDim.x;
    cg::grid_group grid = cg::this_grid();
    unsigned char* ws = A_WS;
    if (tid < 2) ((volatile LAS unsigned*)(lds + LDS_MISC))[tid] = 0u;
    __syncthreads();
    XcdBarrier xbar; xbar.bar = (unsigned*)(ws + WS_CTL) + CW_BAR; xbar.x = 0; xbar.st = nullptr;
    if (KA->use_sync) xbar = xcd_barrier_post((unsigned*)(ws + WS_CTL) + CW_BAR, (volatile LAS unsigned*)(lds + LDS_MISC));
#define IN(k) (KA->ph_lo <= (k) && (k) < KA->ph_hi)
#define SEAM(k) do { if (KA->use_sync && IN(k) && IN((k) + 1)) { if ((k) == 0) grid.sync(); else xcd_barrier(xbar); } } while (0)
    if (IN(0)) { p0_prologue(lds, G, wave, lane); }
    SEAM(0);
    if (IN(1)) {
        pg8::Gemm g{(const bf16_t*)(ws + WS_XN), (const bf16_t*)(ws + WS_WIN), (const bf16_t*)(ws + WS_WIN) + (size_t)2048 * DM, (const bf16_t*)(ws + WS_XN), DM};
        SchedG1 S; S.init(G, blockIdx.x); EpiG1 E;
        pg8::gemm_phase(lds, g, S, E);
    }
    SEAM(1);
    if (IN(2)) { p2_phase(lds, G, tid, wave, lane); }
    SEAM(2);
    if (IN(3)) {
        pg8::Gemm g{(const bf16_t*)(ws + WS_XN), (const bf16_t*)(ws + WS_WBA), (const bf16_t*)(ws + WS_G), (const bf16_t*)(ws + WS_WBL), DM};
        SchedPair S; S.init(4, G, blockIdx.x); EpiP3 E;
        pg8::gemm_phase(lds, g, S, E);
    }
    SEAM(3);
    if (IN(4)) {
        pg8::Gemm g{(const bf16_t*)(ws + WS_XR), (const bf16_t*)(ws + WS_WO), (const bf16_t*)(ws + WS_XR), (const bf16_t*)(ws + WS_WO), DM};
        SchedOne S; S.init(4, G, blockIdx.x); EpiP4 E;
        pg8::gemm_phase(lds, g, S, E);
    }
    SEAM(4);
    if (IN(5)) { p4b_phase(G, wave, lane); }
    SEAM(5);
    if (IN(6)) {
        pg8::Gemm g{(const bf16_t*)(ws + WS_Q), (const bf16_t*)(ws + WS_WS), (const bf16_t*)(ws + WS_Q), (const bf16_t*)(ws + WS_WS), DM};
        SchedOne S; S.init(8, G, blockIdx.x); EpiP5 E;
        pg8::gemm_phase(lds, g, S, E);
    }
    SEAM(6);
    if (IN(7)) { p6a_phase(lds, G, wave, lane); }
    SEAM(7);
    if (IN(8)) { p6b_phase(lds, tid, wave, lane); }
    SEAM(8);
    if (IN(9)) { p6m_phase(G, wave, lane); }
    SEAM(9);
    if (IN(10)) { p6c_phase(lds, tid, wave, lane); }
    SEAM(10);
    if (IN(11)) { p6d_phase(G, wave, lane); }
#undef IN
#undef SEAM
}

#ifndef N_LAUNCH_MODE
#define N_LAUNCH_MODE 1
#endif
constexpr int NPH = 12;
extern "C" void kernel_launch(void* const* d_in, const int* in_sizes, int n_in, void* d_out, int out_size, void* d_ws, size_t ws_size, hipStream_t stream) {
    static int grid = 0;
    if (grid == 0) {
        if (n_in != 26 || (size_t)out_size != O_END || ws_size < WS_END) { fprintf(stderr, "kernel_launch: unexpected sizes n_in %d out %d ws %zu (need %zu)\n", n_in, out_size, ws_size, (size_t)WS_END); grid = -1; return; }
        int dev = 0, cus = 0, per_cu = 0;
        (void)hipGetDevice(&dev); (void)hipDeviceGetAttribute(&cus, hipDeviceAttributeMultiprocessorCount, dev);
        (void)hipFuncSetAttribute((const void*)hybrid_fwd, hipFuncAttributeMaxDynamicSharedMemorySize, LDS_BYTES);
        (void)hipOccupancyMaxActiveBlocksPerMultiprocessor(&per_cu, (const void*)hybrid_fwd, 512, LDS_BYTES);
        if (per_cu < 1) { fprintf(stderr, "kernel_launch: occupancy query says %d blocks per CU\n", per_cu); per_cu = 1; }
        grid = cus;
        (void)hipGetLastError();
    }
    if (grid < 0) return;
    (void)hipMemsetAsync((char*)d_ws + WS_CTL, 0, 32768, stream);
    Args a{};
    for (int i = 0; i < 26; ++i) a.in[i] = (const float*)d_in[i];
    a.out = (float*)d_out; a.ws = (unsigned char*)d_ws;
    if (N_LAUNCH_MODE == 1) {
        a.ph_lo = 0; a.ph_hi = NPH; a.use_sync = 1;
        void* args[] = {&a};
        hipError_t e = hipLaunchCooperativeKernel((const void*)hybrid_fwd, dim3(grid), dim3(512), args, LDS_BYTES, stream);
        if (e != hipSuccess) fprintf(stderr, "cooperative launch failed: %s (grid %d)\n", hipGetErrorString(e), grid);
    } else {
        for (int p = 0; p < NPH; ++p) { a.ph_lo = p; a.ph_hi = p + 1; a.use_sync = 0; hipLaunchKernelGGL(hybrid_fwd, dim3(grid), dim3(512), LDS_BYTES, stream, a); }
    }
}
```

```cpp
#include <hip/hip_runtime.h>
#include <hip/hip_cooperative_groups.h>
#include <cstdint>
#include <cstdio>
namespace cg = cooperative_groups;

#define LAS __attribute__((address_space(3)))
typedef unsigned short bf16_t;
typedef short bf16x8 __attribute__((ext_vector_type(8)));
typedef float f32x4 __attribute__((ext_vector_type(4)));
typedef float f32x2 __attribute__((ext_vector_type(2)));
typedef float f32x16 __attribute__((ext_vector_type(16)));
typedef unsigned u32x4 __attribute__((ext_vector_type(4)));
typedef unsigned u32x2 __attribute__((ext_vector_type(2)));
typedef __bf16 bf16x2_t __attribute__((ext_vector_type(2)));

constexpr int DM = 1024, SEQ = 4096, NB = 16, NTP = NB * SEQ, NSB = 8, NST = 16, NTS = NSB * NST, NTOK = NTP + NTS;
constexpr int ROWS = 65792, NMT = 257;
constexpr int INC = 7168, NEXP = 16384;
constexpr float EPS = 1e-6f, LOG2E = 1.4426950408889634f;
constexpr float QSCALE = 0.125f * LOG2E;

constexpr size_t MiB = 1u << 20;
constexpr size_t BUF = (size_t)ROWS * DM * 2;
constexpr size_t WS_CTL = 0;
constexpr size_t WS_WIN = 1 * MiB;
constexpr size_t WS_WBA = 16 * MiB, WS_WBL = 18 * MiB, WS_WO = 20 * MiB, WS_WS = 22 * MiB;
constexpr size_t WS_LRUW = 26 * MiB;
constexpr size_t WS_SGA = 27 * MiB, WS_SGR = 27 * MiB + 512 * 1024;
constexpr size_t WS_SU = 26 * MiB + 512 * 1024, WS_SV = 26 * MiB + 640 * 1024;
constexpr size_t WS_SX = 26 * MiB + 704 * 1024;
constexpr size_t WS_UB = 28 * MiB, WS_VB = 60 * MiB;
constexpr size_t WS_Q = 92 * MiB;
constexpr size_t WS_XN = WS_Q + BUF;
constexpr size_t WS_K = WS_XN + BUF;
constexpr size_t WS_VT = WS_K + BUF;
constexpr size_t WS_XR = WS_VT + BUF;
constexpr size_t WS_G = WS_XR + BUF;
constexpr size_t WS_END = WS_G + BUF;
constexpr size_t WS_SELE = WS_G, WS_SELG = WS_G + (size_t)NTOK * 512, WS_XQ = WS_G + (size_t)NTOK * 1024;

constexpr size_t O_YP = 0, O_YS = O_YP + (size_t)NTP * DM, O_KP = O_YS + (size_t)NTS * DM, O_VP = O_KP + (size_t)NB * 512 * DM,
                 O_CP = O_VP + (size_t)NB * 512 * DM, O_LP = O_CP + (size_t)NB * 3 * DM, O_KS = O_LP + (size_t)NB * DM, O_VS = O_KS + (size_t)NTS * DM,
                 O_CS = O_VS + (size_t)NTS * DM, O_LS = O_CS + (size_t)NSB * 3 * DM, O_END = O_LS + (size_t)NSB * DM;

constexpr int LDS_BYTES = 135168;

__device__ __forceinline__ unsigned cvtpk(float lo, float hi) { f32x2 v = {lo, hi}; bf16x2_t b = __builtin_convertvector(v, bf16x2_t); return __builtin_bit_cast(unsigned, b); }
__device__ __forceinline__ float bflo(unsigned u) { return __uint_as_float(u << 16); }
__device__ __forceinline__ float bfhi(unsigned u) { return __uint_as_float(u & 0xffff0000u); }
__device__ __forceinline__ float fast_exp2(float x) { return __builtin_amdgcn_exp2f(x); }
__device__ __forceinline__ float fast_rcp(float x) { return __builtin_amdgcn_rcpf(x); }
__device__ __forceinline__ float sigmoidf_(float z) { return fast_rcp(1.0f + fast_exp2(-z * LOG2E)); }
__device__ __forceinline__ float gelu_tanh(float x) { const float u = x + 0.044715f * x * x * x; return x * fast_rcp(1.0f + fast_exp2(-1.5957691216f * LOG2E * u)); }
__device__ __forceinline__ float wave_sum(float v) {
#pragma unroll
    for (int o = 1; o < 64; o <<= 1) v += __shfl_xor(v, o);
    return v;
}
__device__ __forceinline__ int swap23(int i) { return (i & ~12) | ((i & 4) << 1) | ((i & 8) >> 1); }
__device__ __forceinline__ float plswap_max(float m) { auto rr = __builtin_amdgcn_permlane32_swap(__float_as_uint(m), __float_as_uint(m), false, false); return fmaxf(__uint_as_float(rr[0]), __uint_as_float(rr[1])); }
__device__ __forceinline__ float plswap_add(float m) { auto rr = __builtin_amdgcn_permlane32_swap(__float_as_uint(m), __float_as_uint(m), false, false); return __uint_as_float(rr[0]) + __uint_as_float(rr[1]); }

namespace pg8 {
constexpr int BM = 256, BK = 64, HALF = 128, HTB = HALF * BK * 2, STAGE_BYTES = 8 * HTB, NXCD = 8, WGM = 8;
__host__ __device__ __forceinline__ int lds_byte(int r, int c) { const int st = (r >> 4) * 2 + (c >> 5), rr = r & 15, cc = c & 31, ob = rr * 64 + cc * 2; return st * 1024 + (ob ^ (((ob >> 9) & 1) << 5)); }
__host__ __device__ __forceinline__ void stage_rc(int b, int& R, int& C) { const int st = b / 1024, sb = b % 1024, swz = sb ^ (((sb >> 9) & 1) << 5); R = (st >> 1) * 16 + swz / 64; C = (st & 1) * 32 + (swz % 64) / 2; }
__host__ __device__ __forceinline__ int perm32(int rho) { const int n = rho >> 4, i = rho & 15; return 8 * (i >> 2) + 4 * n + (i & 3); }

struct Unit { int pm, pn, kind; };
struct Gemm { const bf16_t* A0; const bf16_t* B0; const bf16_t* A1; const bf16_t* B1; int K; };

struct TileMap {
    int nM, nN, nwg;
    __device__ __forceinline__ void init(int nM_, int nN_) { nM = nM_; nN = nN_; nwg = nM * nN; }
    __device__ __forceinline__ void map(int L, int& pm, int& pn) const {
        int wgid = L; { const int q = nwg / NXCD, r = nwg % NXCD, xcd = wgid % NXCD, off = wgid / NXCD; wgid = (xcd < r ? xcd * (q + 1) : r * (q + 1) + (xcd - r) * q) + off; }
        const int nig = WGM * nN, gid = wgid / nig, fm = gid * WGM, gsz = (nM - fm) < WGM ? (nM - fm) : WGM;
        pm = fm + ((wgid % nig) % gsz); pn = (wgid % nig) / gsz;
    }
};

template <class Epi, class Sched>
__device__ __forceinline__ void gemm_phase(LAS unsigned char* lds, const Gemm g, const Sched& S, const Epi& E) {
    const int tid = threadIdx.x, wid = __builtin_amdgcn_readfirstlane(tid >> 6), lane = tid & 63, wr = wid >> 2, wc = wid & 3, fr = lane & 15, fq = lane >> 4;
    const int K = g.K, nt = K / BK;
    unsigned voffA[2], voffB[2];
#pragma unroll
    for (int i = 0; i < 2; ++i) { int R, C; stage_rc(tid * 16 + i * 8192, R, C); const int Rb = (R & ~31) + perm32(R & 31);
        voffA[i] = (unsigned)(R * K + C) * 2u; voffB[i] = (unsigned)(Rb * K + C) * 2u; }
    const size_t kstep = (size_t)(BK * 2);
    const size_t hstep = (size_t)HALF * K * 2;
    const size_t tstep = 2 * hstep;
    const unsigned ldsw = (unsigned)wid * 1024u;
    const int aoff = lds_byte(wr * 64 + fr, fq * 8), boff = lds_byte(wc * 32 + fr, fq * 8);
#define PG8_SA(b, h) (((b) * 2 + (h)) * HTB)
#define PG8_SB(b, h) ((4 + (b) * 2 + (h)) * HTB)
#define PG8_STAGE(bufoff, gbase, voff) do { _Pragma("unroll") for (int _i = 0; _i < 2; ++_i) \
        __builtin_amdgcn_global_load_lds((const unsigned*)((const char*)(gbase) + (voff)[_i]), (LAS unsigned*)(lds + (bufoff) + ldsw + _i * 8192), 16, 0, 0); } while (0)
#define PG8_LDA(dst, b, h) do { _Pragma("unroll") for (int m = 0; m < 4; ++m) _Pragma("unroll") for (int k = 0; k < 2; ++k) dst[m][k] = *(const LAS bf16x8*)(lds + PG8_SA(b, h) + aoff + m * 2048 + k * 1024); } while (0)
#define PG8_LDB(dst, b, h) do { _Pragma("unroll") for (int n = 0; n < 2; ++n) _Pragma("unroll") for (int k = 0; k < 2; ++k) dst[n][k] = *(const LAS bf16x8*)(lds + PG8_SB(b, h) + boff + n * 2048 + k * 1024); } while (0)
#define PG8_MMA(ai, bj, At, Bt) do { __builtin_amdgcn_s_setprio(1); _Pragma("unroll") for (int m = 0; m < 4; ++m) _Pragma("unroll") for (int n = 0; n < 2; ++n) _Pragma("unroll") for (int k = 0; k < 2; ++k) \
        acc[ai][bj][m][n] = __builtin_amdgcn_mfma_f32_16x16x32_bf16(Bt[n][k], At[m][k], acc[ai][bj][m][n], 0, 0, 0); __builtin_amdgcn_s_setprio(0); } while (0)
#define PG8_WAIT_V(n) asm volatile("s_waitcnt vmcnt(" #n ")" ::: "memory")
#define PG8_WAIT_L(n) asm volatile("s_waitcnt lgkmcnt(" #n ")" ::: "memory")
#define PG8_BAR __builtin_amdgcn_s_barrier()
#define PG8_SCHED __builtin_amdgcn_sched_barrier(0)
    Unit cur, nxt; int ui = 0;
    if (!S.next(0, cur)) return;
    f32x4 acc[2][2][4][2];
#pragma unroll
    for (int a = 0; a < 2; ++a)
#pragma unroll
        for (int b = 0; b < 2; ++b)
#pragma unroll
            for (int m = 0; m < 4; ++m)
#pragma unroll
                for (int n = 0; n < 2; ++n) acc[a][b][m][n] = (f32x4){0.f, 0.f, 0.f, 0.f};
    bf16x8 At[4][2], B0[2][2], B1[2][2];
    const char* cA = (const char*)(cur.kind ? g.A1 : g.A0) + (size_t)cur.pm * tstep; const char* cB = (const char*)(cur.kind ? g.B1 : g.B0) + (size_t)cur.pn * tstep;
    PG8_STAGE(PG8_SB(0, 0), cB, voffB); PG8_STAGE(PG8_SB(0, 1), cB + hstep, voffB); PG8_STAGE(PG8_SA(0, 0), cA, voffA); PG8_STAGE(PG8_SA(0, 1), cA + hstep, voffA);
    if (wr == 1) PG8_BAR;
    PG8_WAIT_V(2); PG8_BAR;
    PG8_STAGE(PG8_SB(1, 0), cB + kstep, voffB); PG8_STAGE(PG8_SA(1, 0), cA + kstep, voffA); PG8_STAGE(PG8_SB(1, 1), cB + hstep + kstep, voffB);
    PG8_WAIT_V(6); PG8_BAR;
    for (;;) {
        const bool has_next = S.next(ui + 1, nxt);
        const char* nA = has_next ? (const char*)(nxt.kind ? g.A1 : g.A0) + (size_t)nxt.pm * tstep : cA; const char* nB = has_next ? (const char*)(nxt.kind ? g.B1 : g.B0) + (size_t)nxt.pn * tstep : cB;
        for (int t = 0; t < nt; t += 2) {
            const bool last = (t == nt - 2);
            const char* a1 = cA + (size_t)(t + 1) * kstep;
            const char* a2 = last ? nA : cA + (size_t)(t + 2) * kstep; const char* b2 = last ? nB : cB + (size_t)(t + 2) * kstep;
            const char* a3 = a2 + kstep; const char* b3 = b2 + kstep;
            PG8_LDB(B0, 0, 0); PG8_LDB(B1, 0, 1); PG8_SCHED; PG8_LDA(At, 0, 0); PG8_STAGE(PG8_SA(1, 1), a1 + hstep, voffA);
            PG8_WAIT_V(8); PG8_WAIT_L(0); PG8_BAR; PG8_MMA(0, 0, At, B0); PG8_MMA(0, 1, At, B1); PG8_BAR; PG8_SCHED;
            PG8_LDA(At, 0, 1); PG8_STAGE(PG8_SB(0, 0), b2, voffB); PG8_STAGE(PG8_SB(0, 1), b2 + hstep, voffB); PG8_STAGE(PG8_SA(0, 0), a2, voffA);
            PG8_WAIT_V(8); PG8_WAIT_L(0); PG8_BAR; PG8_MMA(1, 0, At, B0); PG8_MMA(1, 1, At, B1); PG8_BAR; PG8_SCHED;
            PG8_LDB(B0, 1, 0); PG8_LDB(B1, 1, 1); PG8_SCHED; PG8_LDA(At, 1, 0); PG8_STAGE(PG8_SA(0, 1), a2 + hstep, voffA);
            PG8_WAIT_V(8); PG8_WAIT_L(0); PG8_BAR; PG8_MMA(0, 0, At, B0); PG8_MMA(0, 1, At, B1); PG8_BAR; PG8_SCHED;
            PG8_LDA(At, 1, 1); PG8_STAGE(PG8_SB(1, 0), b3, voffB); PG8_STAGE(PG8_SB(1, 1), b3 + hstep, voffB); PG8_STAGE(PG8_SA(1, 0), a3, voffA);
            PG8_WAIT_V(8); PG8_WAIT_L(0); PG8_BAR; PG8_MMA(1, 0, At, B0); PG8_MMA(1, 1, At, B1); PG8_BAR; PG8_SCHED;
        }
        if (wr == 0) PG8_BAR;
        E(acc, cur, wr, wc, fr, fq);
        if (!has_next) break;
#pragma unroll
        for (int a = 0; a < 2; ++a)
#pragma unroll
            for (int b = 0; b < 2; ++b)
#pragma unroll
                for (int m = 0; m < 4; ++m)
#pragma unroll
                    for (int n = 0; n < 2; ++n) acc[a][b][m][n] = (f32x4){0.f, 0.f, 0.f, 0.f};
        cur = nxt; cA = nA; cB = nB; ++ui;
        if (wr == 1) PG8_BAR;
    }
    PG8_WAIT_V(0);
    PG8_BAR;
#undef PG8_SA
#undef PG8_SB
#undef PG8_STAGE
#undef PG8_LDA
#undef PG8_LDB
#undef PG8_MMA
#undef PG8_WAIT_V
#undef PG8_WAIT_L
#undef PG8_BAR
#undef PG8_SCHED
}
}
using pg8::Unit;

struct Args {
    const float* in[26];
    float* out; unsigned char* ws;
    int ph_lo, ph_hi, use_sync, pad;
};

typedef const __attribute__((address_space(4))) Args* ArgsP;
#define KA ((ArgsP)__builtin_amdgcn_kernarg_segment_ptr())
#define A_IN(k) (KA->in[k])
#define A_OUT (KA->out)
#define A_WS (KA->ws)

struct SchedG1 {
    pg8::TileMap m0, m1; int G, c;
    __device__ __forceinline__ void init(int G_, int c_) { m0.init(NMT, 24); m1.init(4, NMT); G = G_; c = c_; }
    __device__ __forceinline__ bool next(int i, Unit& u) const {
        int L = i * G + c;
        if (L < m0.nwg) { m0.map(L, u.pm, u.pn); u.pn = (u.pn < 8) ? u.pn : u.pn + 4; u.kind = 0; return true; }
        L -= m0.nwg; if (L >= m1.nwg) return false;
        m1.map(L, u.pm, u.pn); u.kind = 1; return true;
    }
};
struct SchedPair {
    pg8::TileMap m0; int G, c;
    __device__ __forceinline__ void init(int nN, int G_, int c_) { m0.init(NMT, nN); G = G_; c = c_; }
    __device__ __forceinline__ bool next(int i, Unit& u) const { const int L = (i >> 1) * G + c; if (L >= m0.nwg) return false; m0.map(L, u.pm, u.pn); u.kind = i & 1; return true; }
};
struct SchedOne {
    pg8::TileMap m0; int G, c;
    __device__ __forceinline__ void init(int nN, int G_, int c_) { m0.init(NMT, nN); G = G_; c = c_; }
    __device__ __forceinline__ bool next(int i, Unit& u) const { const int L = i * G + c; if (L >= m0.nwg) return false; m0.map(L, u.pm, u.pn); u.kind = 0; return true; }
};

#define EPI_PREP int fr_ = fr, fq_ = fq; asm volatile("" : "+v"(fr_), "+v"(fq_)); const int rl_ = wr * 64 + fr_, cl_ = wc * 32 + 8 * fq_;
#define EPI_LOOP_BEGIN \
    _Pragma("unroll") for (int ai = 0; ai < 2; ++ai) _Pragma("unroll") for (int m = 0; m < 4; ++m) { const int rit = ai * 128 + m * 16 + rl_; \
    _Pragma("unroll") for (int bj = 0; bj < 2; ++bj) { const int cit = bj * 128 + cl_; f32x4 v0 = acc[ai][bj][m][0], v1 = acc[ai][bj][m][1];
#define EPI_LOOP_END } }

__device__ __forceinline__ size_t kfrag_off(int row, int col) {
    return ((((size_t)(row >> 5) * 16 + (col >> 6)) * 4 + ((col >> 4) & 3)) * 64 + ((col >> 3) & 1) * 32 + swap23(row & 31)) * 8;
}
__device__ __forceinline__ size_t vfrag_off(int vc, int tok) {
    return (((((size_t)(tok >> 5) * 16 + (vc >> 6)) * 2 + ((vc >> 5) & 1)) * 2 + ((tok >> 4) & 1)) * 64 + ((tok >> 3) & 1) * 32 + swap23(vc & 31)) * 8;
}
struct EpiG1 {
    __device__ __forceinline__ void operator()(const f32x4 (&acc)[2][2][4][2], const Unit& u, int wr, int wc, int fr, int fq) const {
        EPI_PREP unsigned char* ws = A_WS; float* out = A_OUT;
        if (u.kind == 0) {
            const int t = u.pn >> 2, ct = (u.pn & 3) * 256;
            bf16_t* base;
            if (t == 0) base = (bf16_t*)(ws + WS_Q); else if (t == 1) base = (bf16_t*)(ws + WS_K); else if (t == 3) base = (bf16_t*)(ws + WS_XR); else if (t == 4) base = (bf16_t*)(ws + WS_G);
            else if (t == 5) base = (u.pm < 256) ? (bf16_t*)(out + O_YP) : (bf16_t*)(ws + WS_SGA) - (size_t)NTP * DM;
            else base = (u.pm < 256) ? (bf16_t*)(out + O_YP) + (size_t)NTP * DM : (bf16_t*)(ws + WS_SGR) - (size_t)NTP * DM;
            if (t == 1) {
                EPI_LOOP_BEGIN
                    u32x4 w; w.x = cvtpk(v0[0], v0[1]); w.y = cvtpk(v0[2], v0[3]); w.z = cvtpk(v1[0], v1[1]); w.w = cvtpk(v1[2], v1[3]);
                    *(u32x4*)(base + kfrag_off(u.pm * 256 + rit, ct + cit)) = w;
                EPI_LOOP_END
            } else {
            base += (size_t)u.pm * 256 * DM + ct;
            EPI_LOOP_BEGIN
                u32x4 w; w.x = cvtpk(v0[0], v0[1]); w.y = cvtpk(v0[2], v0[3]); w.z = cvtpk(v1[0], v1[1]); w.w = cvtpk(v1[2], v1[3]);
                *(u32x4*)(base + (size_t)rit * DM + cit) = w;
            EPI_LOOP_END
            }
            if (t == 1 && u.pm < 256 && (u.pm & 15) >= 14) { float* p0 = out + O_KP + ((size_t)(u.pm >> 4) * 512 + ((u.pm & 15) - 14) * 256) * DM + ct;
                EPI_LOOP_BEGIN float* p = p0 + (size_t)rit * DM + cit; *(f32x4*)p = v0; *(f32x4*)(p + 4) = v1; EPI_LOOP_END }
            if (t == 1 && u.pm == 256) { float* p0 = out + O_KS + ct;
                EPI_LOOP_BEGIN if (rit < NTS) { float* p = p0 + (size_t)rit * DM + cit; *(f32x4*)p = v0; *(f32x4*)(p + 4) = v1; } EPI_LOOP_END }
            if (t == 3 && u.pm < 256 && (u.pm & 15) == 15) { float* p0 = out + O_CP + ((size_t)(u.pm >> 4) * 3) * DM + ct;
                EPI_LOOP_BEGIN if (rit >= 253) { float* p = p0 + (size_t)(rit - 253) * DM + cit; *(f32x4*)p = v0; *(f32x4*)(p + 4) = v1; } EPI_LOOP_END }
            if (t == 3 && u.pm == 256) { float* p0 = out + O_CS + ct;
                EPI_LOOP_BEGIN if (rit < NTS && (rit & 15) >= 13) { float* p = p0 + ((size_t)(rit >> 4) * 3 + ((rit & 15) - 13)) * DM + cit; *(f32x4*)p = v0; *(f32x4*)(p + 4) = v1; } EPI_LOOP_END }
        } else {
            bf16_t* VT = (bf16_t*)(ws + WS_VT);
            EPI_LOOP_BEGIN
                u32x4 w; w.x = cvtpk(v0[0], v0[1]); w.y = cvtpk(v0[2], v0[3]); w.z = cvtpk(v1[0], v1[1]); w.w = cvtpk(v1[2], v1[3]);
                *(u32x4*)(VT + vfrag_off(u.pm * 256 + rit, u.pn * 256 + cit)) = w;
            EPI_LOOP_END
            if (u.pn < 256 && (u.pn & 15) >= 14) { float* p0 = out + O_VP + ((size_t)(u.pn >> 4) * 512 + ((u.pn & 15) - 14) * 256) * DM + u.pm * 256;
                EPI_LOOP_BEGIN float* p = p0 + (size_t)cit * DM + rit;
                    p[0] = v0[0]; p[DM] = v0[1]; p[2 * DM] = v0[2]; p[3 * DM] = v0[3]; p[4 * DM] = v1[0]; p[5 * DM] = v1[1]; p[6 * DM] = v1[2]; p[7 * DM] = v1[3]; EPI_LOOP_END }
            if (u.pn == 256) { float* p0 = out + O_VS + u.pm * 256;
                EPI_LOOP_BEGIN if (cit < NTS) { float* p = p0 + (size_t)cit * DM + rit;
                    p[0] = v0[0]; p[DM] = v0[1]; p[2 * DM] = v0[2]; p[3 * DM] = v0[3]; p[4 * DM] = v1[0]; p[5 * DM] = v1[1]; p[6 * DM] = v1[2]; p[7 * DM] = v1[3]; } EPI_LOOP_END }
        }
    }
};

struct EpiP3 {
    __device__ __forceinline__ void operator()(const f32x4 (&acc)[2][2][4][2], const Unit& u, int wr, int wc, int fr, int fq) const {
        EPI_PREP unsigned char* ws = A_WS; float* out = A_OUT;
        const bf16_t* gb = (u.pm < 256) ? (const bf16_t*)(out + O_YP) + (u.kind ? (size_t)NTP * DM : 0) : (const bf16_t*)(ws + (u.kind ? WS_SGR : WS_SGA)) - (size_t)NTP * DM;
        const size_t off0 = (size_t)u.pm * 256 * DM + u.pn * 256;
        gb += off0; float* T1 = (float*)(ws + WS_K) + off0; bf16_t* MG = (bf16_t*)(ws + WS_XR) + off0;
        EPI_LOOP_BEGIN
            const size_t off = (size_t)rit * DM + cit;
            const u32x4 gw = *(const u32x4*)(gb + off);
            f32x4 s0, s1;
            s0[0] = sigmoidf_(bflo(gw.x)); s0[1] = sigmoidf_(bfhi(gw.x)); s0[2] = sigmoidf_(bflo(gw.y)); s0[3] = sigmoidf_(bfhi(gw.y));
            s1[0] = sigmoidf_(bflo(gw.z)); s1[1] = sigmoidf_(bfhi(gw.z)); s1[2] = sigmoidf_(bflo(gw.w)); s1[3] = sigmoidf_(bfhi(gw.w));
            if (u.kind == 0) { *(f32x4*)(T1 + off) = s0 * v0; *(f32x4*)(T1 + off + 4) = s1 * v1; }
            else { const f32x4 a0 = *(const f32x4*)(T1 + off) + s0 * v0, a1 = *(const f32x4*)(T1 + off + 4) + s1 * v1;
                u32x4 w; w.x = cvtpk(a0[0], a0[1]); w.y = cvtpk(a0[2], a0[3]); w.z = cvtpk(a1[0], a1[1]); w.w = cvtpk(a1[2], a1[3]);
                *(u32x4*)(MG + off) = w; }
        EPI_LOOP_END
    }
};

struct EpiP4 {
    __device__ __forceinline__ void operator()(const f32x4 (&acc)[2][2][4][2], const Unit& u, int wr, int wc, int fr, int fq) const {
        EPI_PREP float* out = A_OUT;
        if (u.pm < 256) { const size_t off0 = (size_t)u.pm * 256 * DM + u.pn * 256; const float* xp = A_IN(0) + off0; float* yo = out + O_YP + off0;
            EPI_LOOP_BEGIN const size_t off = (size_t)rit * DM + cit;
                *(f32x4*)(yo + off) = *(const f32x4*)(xp + off) + v0; *(f32x4*)(yo + off + 4) = *(const f32x4*)(xp + off + 4) + v1; EPI_LOOP_END }
        else { const float* xs = A_IN(1) + u.pn * 256; float* yo = out + O_YS + u.pn * 256;
            EPI_LOOP_BEGIN if (rit < NTS) { const size_t off = (size_t)rit * DM + cit;
                *(f32x4*)(yo + off) = *(const f32x4*)(xs + off) + v0; *(f32x4*)(yo + off + 4) = *(const f32x4*)(xs + off + 4) + v1; } EPI_LOOP_END }
    }
};

struct EpiP5 {
    __device__ __forceinline__ void operator()(const f32x4 (&acc)[2][2][4][2], const Unit& u, int wr, int wc, int fr, int fq) const {
        EPI_PREP float* SC = (float*)(A_WS + WS_XN) + (size_t)u.pm * 256 * 2048 + u.pn * 256;
        EPI_LOOP_BEGIN
            float* p = SC + (size_t)rit * 2048 + cit; *(f32x4*)p = v0; *(f32x4*)(p + 4) = v1;
        EPI_LOOP_END
    }
};

__device__ __forceinline__ void row_ld(const float* p, f32x4 (&v)[4], int lane) {
#pragma unroll
    for (int j = 0; j < 4; ++j) v[j] = *(const f32x4*)(p + j * 256 + lane * 4);
}
__device__ __forceinline__ float row_ss(const f32x4 (&v)[4]) { float s = 0.f;
#pragma unroll
    for (int j = 0; j < 4; ++j) s += (v[j][0] * v[j][0] + v[j][1] * v[j][1]) + (v[j][2] * v[j][2] + v[j][3] * v[j][3]);
    return s; }
__device__ __forceinline__ const float* xrow_ptr(int m) { return (m < NTP) ? A_IN(0) + (size_t)m * DM : A_IN(1) + (size_t)(m - NTP) * DM; }
__device__ __forceinline__ float* yrow_ptr(int m) { return (m < NTP) ? A_OUT + O_YP + (size_t)m * DM : A_OUT + O_YS + (size_t)(m - NTP) * DM; }

__device__ __forceinline__ void p0_transpose_item(const float* W, int K, int N, bf16_t* WT, LAS float* scr, int item, int lane, int nscale = 0) {
    const int nblk = N / 32, kb = item / nblk, nb = item % nblk, k0 = 64 * kb, n0 = 32 * nb;
#pragma unroll 8
    for (int i = 0; i < 32; ++i) { const int kk = 2 * i + (lane >> 5); scr[kk * 33 + (lane & 31)] = W[(size_t)(k0 + kk) * N + n0 + (lane & 31)] * (n0 < nscale ? QSCALE : 1.0f); }
    asm volatile("s_waitcnt lgkmcnt(0)" ::: "memory");
    const int c = lane & 7;
#pragma unroll
    for (int j = 0; j < 4; ++j) { const int n = (lane >> 3) + 8 * j; const LAS float* s = scr + (8 * c) * 33 + n;
        u32x4 o; o.x = cvtpk(s[0 * 33], s[1 * 33]); o.y = cvtpk(s[2 * 33], s[3 * 33]); o.z = cvtpk(s[4 * 33], s[5 * 33]); o.w = cvtpk(s[6 * 33], s[7 * 33]);
        *(u32x4*)(WT + (size_t)(n0 + n) * K + k0 + 8 * c) = o; }
    asm volatile("s_waitcnt lgkmcnt(0)" ::: "memory");
}

__device__ __forceinline__ void p0_prologue(LAS unsigned char* lds, int G, int wave, int lane) {
    unsigned char* ws = A_WS;
    const int gw = blockIdx.x * 8 + wave, NGW = G * 8;
    LAS float* scr = (LAS float*)(lds + wave * 16384);
    constexpr int I_IN = 16 * (INC / 32), I_SQ = 16 * 32, NTR = I_IN + 3 * I_SQ;
    for (int it = gw; it < NTR; it += NGW) {
        int r = it;
        if (r < I_IN) { p0_transpose_item(A_IN(7), DM, INC, (bf16_t*)(ws + WS_WIN), scr, r, lane, 1024); continue; } r -= I_IN;
        if (r < I_SQ) { p0_transpose_item(A_IN(16), DM, DM, (bf16_t*)(ws + WS_WBA), scr, r, lane); continue; } r -= I_SQ;
        if (r < I_SQ) { p0_transpose_item(A_IN(17), DM, DM, (bf16_t*)(ws + WS_WBL), scr, r, lane); continue; } r -= I_SQ;
        p0_transpose_item(A_IN(18), DM, DM, (bf16_t*)(ws + WS_WO), scr, r, lane);
    }
    {
        const float* wq = A_IN(20); bf16_t* wst = (bf16_t*)(ws + WS_WS);
        const int r32 = lane & 31, hi = lane >> 5;
        for (int it = gw; it < 2048; it += NGW) {
            const int hj = it >> 7, kt = (it >> 5) & 3, ct = it & 31, h = hj >> 1, j = hj & 1;
            const float* ap = (j ? A_IN(22) : A_IN(21)) + ((size_t)(h * 128 + kt * 32 + r32)) * 128 + 64 * hi;
            const float* bp = wq + (size_t)(ct * 32 + r32) * 2048 + hj * 128 + 64 * hi;
            f32x16 acc = {};
#pragma unroll
            for (int s4 = 0; s4 < 16; ++s4) { const f32x4 av = *(const f32x4*)(ap + 4 * s4), bv = *(const f32x4*)(bp + 4 * s4);
                acc = __builtin_amdgcn_mfma_f32_32x32x2f32(av[0], bv[0], acc, 0, 0, 0); acc = __builtin_amdgcn_mfma_f32_32x32x2f32(av[1], bv[1], acc, 0, 0, 0);
                acc = __builtin_amdgcn_mfma_f32_32x32x2f32(av[2], bv[2], acc, 0, 0, 0); acc = __builtin_amdgcn_mfma_f32_32x32x2f32(av[3], bv[3], acc, 0, 0, 0); }
#pragma unroll
            for (int r = 0; r < 16; ++r) { const int key = kt * 32 + (r & 3) + 8 * (r >> 2) + 4 * hi;
                wst[(size_t)(key * 16 + hj) * DM + ct * 32 + r32] = (bf16_t)(cvtpk(acc[r], 0.f) & 0xffffu); }
        }
    }
    {
        f32x4 p[4], pn[4];
        if (gw < 2 * NEXP) {
#pragma unroll
            for (int q = 0; q < 4; ++q) p[q] = *(const f32x4*)(((gw >= NEXP) ? A_IN(24) + (size_t)(gw - NEXP) * DM : A_IN(23) + (size_t)gw * DM) + lane * 16 + 4 * q); }
        for (int it = gw; it < 2 * NEXP; it += NGW) {
            const int tb = it >= NEXP, e = it - tb * NEXP, itn = it + NGW;
            if (itn < 2 * NEXP) {
#pragma unroll
                for (int q = 0; q < 4; ++q) pn[q] = *(const f32x4*)(((itn >= NEXP) ? A_IN(24) + (size_t)(itn - NEXP) * DM : A_IN(23) + (size_t)itn * DM) + lane * 16 + 4 * q); }
            unsigned char* dst = ws + (tb ? WS_VB : WS_UB) + (size_t)e * DM + lane * 16;
            float mx = 0.f;
#pragma unroll
            for (int q = 0; q < 4; ++q) mx = fmaxf(mx, fmaxf(fmaxf(fabsf(p[q][0]), fabsf(p[q][1])), fmaxf(fabsf(p[q][2]), fabsf(p[q][3]))));
#pragma unroll
            for (int o = 1; o < 64; o <<= 1) mx = fmaxf(mx, __shfl_xor(mx, o));
            const float step = fmaxf(mx, 1e-30f) * (1.0f / 127.0f), inv = 1.0f / step;
            u32x4 w;
#pragma unroll
            for (int q = 0; q < 4; ++q) {
                const unsigned b0 = (unsigned)(int)rintf(p[q][0] * inv) & 0xffu, b1 = (unsigned)(int)rintf(p[q][1] * inv) & 0xffu, b2 = (unsigned)(int)rintf(p[q][2] * inv) & 0xffu, b3 = (unsigned)(int)rintf(p[q][3] * inv) & 0xffu;
                w[q] = b0 | (b1 << 8) | (b2 << 16) | (b3 << 24); }
            *(u32x4*)dst = w;
            if (lane == 0) ((float*)(ws + (tb ? WS_SV : WS_SU)))[e] = step;
#pragma unroll
            for (int q = 0; q < 4; ++q) p[q] = pn[q];
        }
    }
    {
        const float* gm = A_IN(6); bf16_t* XN = (bf16_t*)(ws + WS_XN);
        for (int m = NTOK + gw; m < ROWS; m += NGW) {
#pragma unroll
            for (int j = 0; j < 2; ++j) *(u32x4*)(XN + (size_t)m * DM + j * 512 + lane * 8) = (u32x4){0u, 0u, 0u, 0u}; }
        f32x4 v[4], vn[4];
        if (gw < NTOK) row_ld(xrow_ptr(gw), v, lane);
        for (int m = gw; m < NTOK; m += NGW) {
            const int mn = m + NGW;
            if (mn < NTOK) row_ld(xrow_ptr(mn), vn, lane);
            bf16_t* orow = XN + (size_t)m * DM;
            const float inv = 1.0f / sqrtf(wave_sum(row_ss(v)) * (1.0f / DM) + EPS);
#pragma unroll
            for (int j = 0; j < 4; ++j) { const f32x4 gg = *(const f32x4*)(gm + j * 256 + lane * 4); const f32x4 y = v[j] * inv * gg;
                u32x2 w; w.x = cvtpk(y[0], y[1]); w.y = cvtpk(y[2], y[3]); *(u32x2*)(orow + j * 256 + lane * 4) = w; }
#pragma unroll
            for (int j = 0; j < 4; ++j) v[j] = vn[j];
        }
    }
    {
        bf16_t* fw = (bf16_t*)(ws + WS_LRUW);
        for (int f = gw; f < 256; f += NGW) {
            const int ks = f & 3, T = (f >> 2) & 1, gate = (f >> 3) & 1, g = f >> 4, i = lane & 31, hi = lane >> 5;
            const int outc = 32 * T + swap23(i);
            const float* W = (gate ? A_IN(13) : A_IN(11)) + (size_t)g * 4096;
            float x[8];
#pragma unroll
            for (int j = 0; j < 8; ++j) x[j] = W[(16 * ks + 8 * hi + j) * 64 + outc];
            u32x4 w; w.x = cvtpk(x[0], x[1]); w.y = cvtpk(x[2], x[3]); w.z = cvtpk(x[4], x[5]); w.w = cvtpk(x[6], x[7]);
            *(u32x4*)(fw + (size_t)f * 512 + lane * 8) = w;
        }
    }
}

constexpr int LR_WF = 0, LR_CW = 16384, LR_CB = LR_CW + 1024, LR_BR = LR_CB + 256, LR_BI = LR_BR + 256, LR_CS = LR_BI + 256, LR_CARRY = LR_CS + 256, LR_SEQ = LR_CARRY + 2048, LR_END = LR_SEQ + 64;

__device__ __forceinline__ void lru_load_consts(LAS unsigned char* lds, int g, int tid) {
    const u32x4* src = (const u32x4*)(A_WS + WS_LRUW + (size_t)g * 16384);
    for (int i = tid; i < 1024; i += 512) ((LAS u32x4*)(lds + LR_WF))[i] = src[i];
    if (tid < 256) ((LAS float*)(lds + LR_CW))[tid] = A_IN(9)[(tid >> 6) * DM + g * 64 + (tid & 63)];
    if (tid < 64) {
        const int c = g * 64 + tid;
        ((LAS float*)(lds + LR_CB))[tid] = A_IN(10)[c]; ((LAS float*)(lds + LR_BR))[tid] = A_IN(12)[c]; ((LAS float*)(lds + LR_BI))[tid] = A_IN(14)[c];
        ((LAS float*)(lds + LR_CS))[tid] = 8.0f * log1pf(expf(-A_IN(15)[c]));
    }
    if (tid < 8) ((LAS unsigned*)(lds + LR_SEQ))[tid] = 0xffffffffu;
}

template <bool SAMPLE>
__device__ __forceinline__ void lru_tile(LAS unsigned char* lds, int lane, int g, size_t rowbase, int tile, int bidx) {
    asm volatile("" : "+v"(lane));
    const int tl = lane & 31, hi = lane >> 5, t = tile * 32 + tl;
    const bf16_t* XR = (const bf16_t*)(A_WS + WS_XR); bf16_t* Gb = (bf16_t*)(A_WS + WS_G);
    const int cbase = g * 64 + 8 * hi;
    float xc[4][8];
    bf16x8 xf[4];
#pragma unroll
    for (int ks = 0; ks < 4; ++ks) {
        const f32x4 b0 = *(const LAS f32x4*)(lds + LR_CB + (16 * ks + 8 * hi) * 4), b1 = *(const LAS f32x4*)(lds + LR_CB + (16 * ks + 8 * hi) * 4 + 16);
#pragma unroll
        for (int j = 0; j < 4; ++j) { xc[ks][j] = b0[j]; xc[ks][4 + j] = b1[j]; }
#pragma unroll
        for (int tap = 0; tap < 4; ++tap) {
            const int rr = t - 3 + tap;
            float xv[8];
            {
                u32x4 w = *(const u32x4*)(XR + (rowbase + (rr < 0 ? 0 : rr)) * DM + cbase + 16 * ks);
                if (rr < 0) w = (u32x4){0u, 0u, 0u, 0u};
                xv[0] = bflo(w.x); xv[1] = bfhi(w.x); xv[2] = bflo(w.y); xv[3] = bfhi(w.y); xv[4] = bflo(w.z); xv[5] = bfhi(w.z); xv[6] = bflo(w.w); xv[7] = bfhi(w.w);
            }
            if (SAMPLE) {
                const float* sp = A_IN(4) + ((size_t)bidx * 3 + (rr < 0 ? 3 + rr : 0)) * DM + cbase + 16 * ks;
                const f32x4 p = *(const f32x4*)sp, q = *(const f32x4*)(sp + 4);
#pragma unroll
                for (int j = 0; j < 4; ++j) { xv[j] = rr < 0 ? p[j] : xv[j]; xv[4 + j] = rr < 0 ? q[j] : xv[4 + j]; }
            }
            const f32x4 w0 = *(const LAS f32x4*)(lds + LR_CW + (tap * 64 + 16 * ks + 8 * hi) * 4), w1 = *(const LAS f32x4*)(lds + LR_CW + (tap * 64 + 16 * ks + 8 * hi) * 4 + 16);
#pragma unroll
            for (int j = 0; j < 4; ++j) { xc[ks][j] += w0[j] * xv[j]; xc[ks][4 + j] += w1[j] * xv[4 + j]; }
        }
        u32x4 w; w.x = cvtpk(xc[ks][0], xc[ks][1]); w.y = cvtpk(xc[ks][2], xc[ks][3]); w.z = cvtpk(xc[ks][4], xc[ks][5]); w.w = cvtpk(xc[ks][6], xc[ks][7]);
        xf[ks] = __builtin_bit_cast(bf16x8, w);
        asm volatile("" ::: "memory");
    }
    float A[32], B[32];
#pragma unroll
    for (int T = 0; T < 2; ++T) {
        f32x16 ar = f32x16{}, ai = f32x16{};
#pragma unroll
        for (int ks = 0; ks < 4; ++ks) {
            const bf16x8 wr_ = *(const LAS bf16x8*)(lds + LR_WF + ((0 * 2 + T) * 4 + ks) * 1024 + lane * 16);
            const bf16x8 wi_ = *(const LAS bf16x8*)(lds + LR_WF + ((1 * 2 + T) * 4 + ks) * 1024 + lane * 16);
            ar = __builtin_amdgcn_mfma_f32_32x32x16_bf16(wr_, xf[ks], ar, 0, 0, 0);
            ai = __builtin_amdgcn_mfma_f32_32x32x16_bf16(wi_, xf[ks], ai, 0, 0, 0);
        }
#pragma unroll
        for (int q = 0; q < 2; ++q) {
            const int ks = 2 * T + q, lo = (16 * ks + 8 * hi) * 4;
            const f32x4 br0 = *(const LAS f32x4*)(lds + LR_BR + lo), br1 = *(const LAS f32x4*)(lds + LR_BR + lo + 16);
            const f32x4 bi0 = *(const LAS f32x4*)(lds + LR_BI + lo), bi1 = *(const LAS f32x4*)(lds + LR_BI + lo + 16);
            const f32x4 cs0 = *(const LAS f32x4*)(lds + LR_CS + lo), cs1 = *(const LAS f32x4*)(lds + LR_CS + lo + 16);
#pragma unroll
            for (int j = 0; j < 8; ++j) {
                const int r = 8 * q + j;
                const float brv = j < 4 ? br0[j & 3] : br1[j & 3], biv = j < 4 ? bi0[j & 3] : bi1[j & 3], csv = j < 4 ? cs0[j & 3] : cs1[j & 3];
                const float rg = sigmoidf_(ar[r] + brv), ig = sigmoidf_(ai[r] + biv);
                const float la = -csv * rg, av = fast_exp2(la * LOG2E);
                const float x2 = 2.0f * la;
                const float em = (x2 > -0.03f) ? -x2 * (1.0f + x2 * (0.5f + x2 * (0.16666667f + x2 * 0.041666668f))) : 1.0f - fast_exp2(x2 * LOG2E);
                A[16 * T + r] = av; B[16 * T + r] = sqrtf(em) * ig * xc[ks][j];
            }
        }
        asm volatile("" ::: "memory");
    }
#define LRU_STEP(CTRL, RM) _Pragma("unroll") for (int c = 0; c < 32; ++c) { \
        const float as_ = __builtin_bit_cast(float, __builtin_amdgcn_update_dpp(__builtin_bit_cast(int, 1.0f), __builtin_bit_cast(int, A[c]), CTRL, RM, 0xF, false)); \
        const float bs_ = __builtin_bit_cast(float, __builtin_amdgcn_update_dpp(0, __builtin_bit_cast(int, B[c]), CTRL, RM, 0xF, false)); \
        B[c] = A[c] * bs_ + B[c]; A[c] = A[c] * as_; }
    LRU_STEP(0x111, 0xF) LRU_STEP(0x112, 0xF) LRU_STEP(0x114, 0xF) LRU_STEP(0x118, 0xF) LRU_STEP(0x142, 0xA)
#undef LRU_STEP
    float hin[32];
    if (SAMPLE) {
        const float* hp = A_IN(5) + (size_t)bidx * DM + cbase;
#pragma unroll
        for (int ks = 0; ks < 4; ++ks) { const f32x4 p = *(const f32x4*)(hp + 16 * ks), q = *(const f32x4*)(hp + 16 * ks + 4);
#pragma unroll
            for (int j = 0; j < 4; ++j) { hin[8 * ks + j] = p[j]; hin[8 * ks + 4 + j] = q[j]; } }
    } else if (tile == 0) {
#pragma unroll
        for (int c = 0; c < 32; ++c) hin[c] = 0.f;
    } else {
        volatile LAS unsigned* sq = (volatile LAS unsigned*)(lds + LR_SEQ) + (tile & 7);
        while (*sq != (unsigned)tile) __builtin_amdgcn_s_sleep(1);
        asm volatile("" ::: "memory");
        const LAS float* cp = (const LAS float*)(lds + LR_CARRY) + (tile & 7) * 64 + 8 * hi;
#pragma unroll
        for (int ks = 0; ks < 4; ++ks) { const f32x4 p = *(const LAS f32x4*)(cp + 16 * ks), q = *(const LAS f32x4*)(cp + 16 * ks + 4);
#pragma unroll
            for (int j = 0; j < 4; ++j) { hin[8 * ks + j] = p[j]; hin[8 * ks + 4 + j] = q[j]; } }
    }
#pragma unroll
    for (int c = 0; c < 32; ++c) B[c] = B[c] + A[c] * hin[c];
    if (!SAMPLE) {
        if (tl == 31) {
            if (tile < 127) {
                LAS float* cp = (LAS float*)(lds + LR_CARRY) + ((tile + 1) & 7) * 64 + 8 * hi;
#pragma unroll
                for (int ks = 0; ks < 4; ++ks) { *(LAS f32x4*)(cp + 16 * ks) = (f32x4){B[8 * ks], B[8 * ks + 1], B[8 * ks + 2], B[8 * ks + 3]};
                    *(LAS f32x4*)(cp + 16 * ks + 4) = (f32x4){B[8 * ks + 4], B[8 * ks + 5], B[8 * ks + 6], B[8 * ks + 7]}; }
            } else {
                float* lp = A_OUT + O_LP + (size_t)bidx * DM + cbase;
#pragma unroll
                for (int ks = 0; ks < 4; ++ks) { *(f32x4*)(lp + 16 * ks) = (f32x4){B[8 * ks], B[8 * ks + 1], B[8 * ks + 2], B[8 * ks + 3]};
                    *(f32x4*)(lp + 16 * ks + 4) = (f32x4){B[8 * ks + 4], B[8 * ks + 5], B[8 * ks + 6], B[8 * ks + 7]}; }
            }
        }
        if (tile < 127) {
            asm volatile("s_waitcnt lgkmcnt(0)" ::: "memory");
            if (lane == 63) *((volatile LAS unsigned*)(lds + LR_SEQ) + ((tile + 1) & 7)) = (unsigned)(tile + 1);
        }
    } else if (tl == 15) {
        float* lp = A_OUT + O_LS + (size_t)bidx * DM + cbase;
#pragma unroll
        for (int ks = 0; ks < 4; ++ks) { *(f32x4*)(lp + 16 * ks) = (f32x4){B[8 * ks], B[8 * ks + 1], B[8 * ks + 2], B[8 * ks + 3]};
            *(f32x4*)(lp + 16 * ks + 4) = (f32x4){B[8 * ks + 4], B[8 * ks + 5], B[8 * ks + 6], B[8 * ks + 7]}; }
    }
    if (!SAMPLE || tl < NST) {
        bf16_t* gp = Gb + (rowbase + t) * DM + cbase;
#pragma unroll
        for (int ks = 0; ks < 4; ++ks) {
            const u32x4 w = *(const u32x4*)(gp + 16 * ks);
            float gv[8]; gv[0] = bflo(w.x); gv[1] = bfhi(w.x); gv[2] = bflo(w.y); gv[3] = bfhi(w.y); gv[4] = bflo(w.z); gv[5] = bfhi(w.z); gv[6] = bflo(w.w); gv[7] = bfhi(w.w);
            float o[8];
#pragma unroll
            for (int j = 0; j < 8; ++j) o[j] = B[8 * ks + j] * gelu_tanh(gv[j]);
            u32x4 ow; ow.x = cvtpk(o[0], o[1]); ow.y = cvtpk(o[2], o[3]); ow.z = cvtpk(o[4], o[5]); ow.w = cvtpk(o[6], o[7]);
            *(u32x4*)(gp + 16 * ks) = ow;
        }
    }
}

constexpr int P2_Q = 20608;
constexpr int AT_TAB = 24576;
__device__ __forceinline__ void attn_unit(LAS unsigned char* lds, int lane, int b, int c, int h) {
    const int r32 = lane & 31, hi = lane >> 5, kr = swap23(r32);
    const bf16_t* Q = (const bf16_t*)(A_WS + WS_Q); const bf16_t* Kb = (const bf16_t*)(A_WS + WS_K); const bf16_t* VT = (const bf16_t*)(A_WS + WS_VT); bf16_t* O = (bf16_t*)(A_WS + WS_XN);
    const size_t row0 = (size_t)b * SEQ + (size_t)c * 64;
    bf16x8 qf[2][4];
#pragma unroll
    for (int qb = 0; qb < 2; ++qb)
#pragma unroll
        for (int ks = 0; ks < 4; ++ks) qf[qb][ks] = *(const bf16x8*)(Q + (row0 + qb * 32 + r32) * DM + h * 64 + ks * 16 + hi * 8);
    f32x16 o[2][2];
#pragma unroll
    for (int i = 0; i < 2; ++i)
#pragma unroll
        for (int j = 0; j < 2; ++j) o[i][j] = f32x16{};
    float mrow[2] = {-1e30f, -1e30f}, lrow[2] = {0.f, 0.f};
    const LAS float* tab = (const LAS float*)(lds + AT_TAB) + h * 320;
    const float cfar = tab[256];
    const int sb0 = (c >= 8 ? c - 8 : 0) * 2, sb1 = c * 2 + 1;
    const bf16_t* kbase = Kb + ((size_t)b * 128 * 16 + h) * 4 * 512 + lane * 8;
    const bf16_t* vbase = VT + ((size_t)b * 128 * 16 + h) * 4 * 512 + lane * 8;
    bf16x8 kf[4], vf[2][2];
#pragma unroll
    for (int ks = 0; ks < 4; ++ks) kf[ks] = *(const bf16x8*)(kbase + (size_t)sb0 * 32768 + ks * 512);
#pragma unroll
    for (int db = 0; db < 2; ++db)
#pragma unroll
        for (int s = 0; s < 2; ++s) vf[db][s] = *(const bf16x8*)(vbase + (size_t)sb0 * 32768 + (db * 2 + s) * 512);
    for (int sb = sb0; sb <= sb1; ++sb) {
        const int sbn = sb < sb1 ? sb + 1 : sb;
        f32x16 S[2];
#pragma unroll
        for (int qb = 0; qb < 2; ++qb) { S[qb] = f32x16{};
#pragma unroll
            for (int ks = 0; ks < 4; ++ks) S[qb] = __builtin_amdgcn_mfma_f32_32x32x16_bf16(kf[ks], qf[qb][ks], S[qb], 0, 0, 0); }
        asm volatile("" ::: "memory");
#pragma unroll
        for (int ks = 0; ks < 4; ++ks) kf[ks] = *(const bf16x8*)(kbase + (size_t)sbn * 32768 + ks * 512);
        const int delta = c - (sb >> 1), rb = sb & 1;
        if (delta >= 3) {
#pragma unroll
            for (int qb = 0; qb < 2; ++qb)
#pragma unroll
                for (int r = 0; r < 16; ++r) S[qb][r] += cfar;
        } else {
#pragma unroll
            for (int qb = 0; qb < 2; ++qb) {
                const LAS float* tp = tab + (64 * delta + 32 * qb + r32 + 128 - 32 * rb - 8 * hi - 23);
#pragma unroll
                for (int r = 0; r < 16; ++r) S[qb][r] += tp[23 - (16 * (r >> 3) + (r & 7))];
            }
        }
        float rm[2];
#pragma unroll
        for (int qb = 0; qb < 2; ++qb) { float mx = S[qb][0];
#pragma unroll
            for (int r = 1; r < 16; ++r) mx = fmaxf(mx, S[qb][r]);
            rm[qb] = plswap_max(mx); }
        if (__any((rm[0] > mrow[0] + 8.0f) || (rm[1] > mrow[1] + 8.0f))) {
#pragma unroll
            for (int qb = 0; qb < 2; ++qb) { const float mn = fmaxf(mrow[qb], rm[qb]); const float al = fast_exp2(mrow[qb] - mn); lrow[qb] *= al; mrow[qb] = mn;
#pragma unroll
                for (int r = 0; r < 16; ++r) { o[0][qb][r] *= al; o[1][qb][r] *= al; } }
        }
        bf16x8 pf[2][2];
#pragma unroll
        for (int qb = 0; qb < 2; ++qb) { float sum = 0.f;
#pragma unroll
            for (int r = 0; r < 16; ++r) { S[qb][r] = fast_exp2(S[qb][r] - mrow[qb]); sum += S[qb][r]; }
            lrow[qb] += sum;
#pragma unroll
            for (int s = 0; s < 2; ++s) { u32x4 w; w.x = cvtpk(S[qb][8 * s], S[qb][8 * s + 1]); w.y = cvtpk(S[qb][8 * s + 2], S[qb][8 * s + 3]); w.z = cvtpk(S[qb][8 * s + 4], S[qb][8 * s + 5]); w.w = cvtpk(S[qb][8 * s + 6], S[qb][8 * s + 7]);
                pf[qb][s] = __builtin_bit_cast(bf16x8, w); } }
#pragma unroll
        for (int db = 0; db < 2; ++db)
#pragma unroll
            for (int qb = 0; qb < 2; ++qb)
#pragma unroll
                for (int s = 0; s < 2; ++s) o[db][qb] = __builtin_amdgcn_mfma_f32_32x32x16_bf16(vf[db][s], pf[qb][s], o[db][qb], 0, 0, 0);
        asm volatile("" ::: "memory");
#pragma unroll
        for (int db = 0; db < 2; ++db)
#pragma unroll
            for (int s = 0; s < 2; ++s) vf[db][s] = *(const bf16x8*)(vbase + (size_t)sbn * 32768 + (db * 2 + s) * 512);
    }
#pragma unroll
    for (int qb = 0; qb < 2; ++qb) { const float inv = fast_rcp(plswap_add(lrow[qb]));
        bf16_t* op = O + (row0 + qb * 32 + r32) * DM + h * 64 + 8 * hi;
#pragma unroll
        for (int db = 0; db < 2; ++db)
#pragma unroll
            for (int s = 0; s < 2; ++s) { u32x4 w;
                w.x = cvtpk(o[db][qb][8 * s] * inv, o[db][qb][8 * s + 1] * inv); w.y = cvtpk(o[db][qb][8 * s + 2] * inv, o[db][qb][8 * s + 3] * inv);
                w.z = cvtpk(o[db][qb][8 * s + 4] * inv, o[db][qb][8 * s + 5] * inv); w.w = cvtpk(o[db][qb][8 * s + 6] * inv, o[db][qb][8 * s + 7] * inv);
                *(u32x4*)(op + 32 * db + 16 * s) = w; } }
}

constexpr int AS_P = 45056;
__device__ __forceinline__ void attn_sample_task(LAS unsigned char* lds, int wave, int lane, int task) {
    const int bs = task >> 6, h = (task >> 2) & 15, qg = task & 3;
    const bf16_t* Q = (const bf16_t*)(A_WS + WS_Q); bf16_t* O = (bf16_t*)(A_WS + WS_XN);
    const float* ck = A_IN(2); const float* cv = A_IN(3); const float* kn = A_OUT + O_KS; const float* vn = A_OUT + O_VS;
    LAS float* pb = (LAS float*)(lds + AS_P + wave * 9472);
    LAS float* qs = pb + 4 * 528;
    const LAS float* tab = (const LAS float*)(lds + AT_TAB) + h * 320;
#pragma unroll
    for (int i = 0; i < 4; ++i) qs[i * 64 + lane] = bflo((unsigned)Q[((size_t)NTP + bs * 16 + qg * 4 + i) * DM + h * 64 + lane]);
    asm volatile("s_waitcnt lgkmcnt(0)" ::: "memory");
#pragma unroll 1
    for (int it = 0; it < 9; ++it) {
        const int key = it * 64 + lane; const bool valid = key < 528;
        const float* kp = !valid ? ck : (key < 512 ? ck + (((size_t)bs * 512 + key) * 16 + h) * 64 : kn + ((size_t)bs * 16 + (key - 512)) * DM + h * 64);
        float d[4] = {0.f, 0.f, 0.f, 0.f};
        f32x4 kv[16];
#pragma unroll
        for (int d4 = 0; d4 < 16; ++d4) kv[d4] = *(const f32x4*)(kp + 4 * d4);
#pragma unroll
        for (int d4 = 0; d4 < 16; ++d4) {
#pragma unroll
            for (int i = 0; i < 4; ++i) { const f32x4 qq = *(const LAS f32x4*)(qs + i * 64 + 4 * d4); d[i] += (kv[d4][0] * qq[0] + kv[d4][1] * qq[1]) + (kv[d4][2] * qq[2] + kv[d4][3] * qq[3]); } }
        int rel = 512 + qg * 4 - key;
        if (valid) {
#pragma unroll
            for (int i = 0; i < 4; ++i) { int r = rel + i; r = r > 128 ? 128 : r; pb[i * 528 + key] = d[i] + tab[r + 128]; } }
    }
    asm volatile("s_waitcnt lgkmcnt(0)" ::: "memory");
#pragma unroll 1
    for (int i = 0; i < 4; ++i) {
        float mx = -1e30f;
#pragma unroll 1
        for (int key = lane; key < 528; key += 64) mx = fmaxf(mx, pb[i * 528 + key]);
#pragma unroll
        for (int o = 1; o < 64; o <<= 1) mx = fmaxf(mx, __shfl_xor(mx, o));
        float sum = 0.f;
#pragma unroll 1
        for (int key = lane; key < 528; key += 64) { const float pv = fast_exp2(pb[i * 528 + key] - mx); pb[i * 528 + key] = pv; sum += pv; }
        sum = wave_sum(sum); const float inv = 1.0f / sum;
#pragma unroll 1
        for (int key = lane; key < 528; key += 64) pb[i * 528 + key] *= inv;
    }
    asm volatile("s_waitcnt lgkmcnt(0)" ::: "memory");
    float acc[4] = {0.f, 0.f, 0.f, 0.f};
#pragma unroll 1
    for (int k0 = 0; k0 < 528; k0 += 16) {
        float vv[16];
#pragma unroll
        for (int kk = 0; kk < 16; ++kk) { const int key = k0 + kk; vv[kk] = k0 < 512 ? cv[(((size_t)bs * 512 + key) * 16 + h) * 64 + lane] : vn[((size_t)bs * 16 + (key - 512)) * DM + h * 64 + lane]; }
#pragma unroll
        for (int kk = 0; kk < 16; ++kk) {
#pragma unroll
            for (int i = 0; i < 4; ++i) acc[i] += pb[i * 528 + k0 + kk] * vv[kk]; }
    }
#pragma unroll
    for (int i = 0; i < 4; ++i) O[((size_t)NTP + bs * 16 + qg * 4 + i) * DM + h * 64 + lane] = (bf16_t)(cvtpk(acc[i], 0.f) & 0xffffu);
    asm volatile("s_waitcnt lgkmcnt(0)" ::: "memory");
}

__device__ __forceinline__ void p2_phase(LAS unsigned char* lds, int G, int tid, int wave, int lane) {
    for (int i = tid; i < 16 * 320; i += 512) { const int h = i / 320, j = i % 320; ((LAS float*)(lds + AT_TAB))[i] = A_IN(8)[h * 257 + (j > 256 ? 256 : j)] * LOG2E; }
    for (int u = blockIdx.x; u < 256 + 16; u += G) {
        __syncthreads();
        if (u < 256) {
            const int b = u >> 4, g = u & 15;
            lru_load_consts(lds, g, tid);
            __syncthreads();
            for (int tile = wave; tile < 128; tile += 8) lru_tile<false>(lds, lane, g, (size_t)b * SEQ, tile, b);
        } else {
            const int g = u - 256;
            lru_load_consts(lds, g, tid);
            __syncthreads();
            lru_tile<true>(lds, lane, g, (size_t)NTP + wave * 16, 0, wave);
        }
    }
    if (tid == 0) *(volatile LAS int*)(lds + P2_Q) = 0;
    __syncthreads();
    const int NGW = G * 8;
    int nS = 0; for (int t = blockIdx.x; t < 512; t += G) ++nS;
    for (;;) {
        int j = 0;
        if (lane == 0) j = __hip_atomic_fetch_add((LAS int*)(lds + P2_Q), 1, __ATOMIC_RELAXED, __HIP_MEMORY_SCOPE_WORKGROUP);
        j = __builtin_amdgcn_readfirstlane(j);
        if (j < nS) { attn_sample_task(lds, wave, lane, blockIdx.x + G * j); continue; }
        j -= nS;
        const int u = blockIdx.x * 8 + (j & 7) + NGW * (j >> 3);
        if (u >= NB * 64 * 16) break;
        const int c = u & 63, h = (u >> 6) & 15, b = u >> 10;
        attn_unit(lds, lane, b, c, h);
    }
}

__device__ __forceinline__ void p4b_phase(int G, int wave, int lane) {
    const int gw = blockIdx.x * 8 + wave, NGW = G * 8;
    const float* gm = A_IN(19); bf16_t* XT = (bf16_t*)(A_WS + WS_Q); unsigned char* XQ = A_WS + WS_XQ; float* SX = (float*)(A_WS + WS_SX);
    f32x4 v[4], vn[4];
    if (gw < NTOK) row_ld(yrow_ptr(gw), v, lane);
    for (int m = gw; m < NTOK; m += NGW) {
        const int mn = m + NGW;
        if (mn < NTOK) row_ld(yrow_ptr(mn), vn, lane);
        bf16_t* orow = XT + (size_t)m * DM;
        const float inv = 1.0f / sqrtf(wave_sum(row_ss(v)) * (1.0f / DM) + EPS);
        float mx = 0.f;
#pragma unroll
        for (int j = 0; j < 4; ++j) { const f32x4 gg = *(const f32x4*)(gm + j * 256 + lane * 4); v[j] = v[j] * inv * gg;
            u32x2 w; w.x = cvtpk(v[j][0], v[j][1]); w.y = cvtpk(v[j][2], v[j][3]); *(u32x2*)(orow + j * 256 + lane * 4) = w;
            mx = fmaxf(mx, fmaxf(fmaxf(fabsf(v[j][0]), fabsf(v[j][1])), fmaxf(fabsf(v[j][2]), fabsf(v[j][3])))); }
#pragma unroll
        for (int o = 1; o < 64; o <<= 1) mx = fmaxf(mx, __shfl_xor(mx, o));
        const float step = fmaxf(mx, 1e-30f) * (1.0f / 127.0f), qi = 1.0f / step;
#pragma unroll
        for (int j = 0; j < 4; ++j) {
            const unsigned b0 = (unsigned)(int)rintf(v[j][0] * qi) & 0xffu, b1 = (unsigned)(int)rintf(v[j][1] * qi) & 0xffu, b2 = (unsigned)(int)rintf(v[j][2] * qi) & 0xffu, b3 = (unsigned)(int)rintf(v[j][3] * qi) & 0xffu;
            *(unsigned*)(XQ + (size_t)m * DM + j * 256 + lane * 4) = b0 | (b1 << 8) | (b2 << 16) | (b3 << 24); }
        if (lane == 0) SX[m] = step;
#pragma unroll
        for (int j = 0; j < 4; ++j) v[j] = vn[j];
    }
}

__device__ __forceinline__ int f2key(float f) { const int b = __float_as_int(f); return b ^ ((b >> 31) & 0x7fffffff); }
__device__ __forceinline__ float key2f(int k) { return __int_as_float(k ^ ((k >> 31) & 0x7fffffff)); }
#define CE_DESC(x, y) do { const int hi_ = max(x, y); y = min(x, y); x = hi_; } while (0)
#define CE_ASC(x, y)  do { const int lo_ = min(x, y); y = max(x, y); x = lo_; } while (0)
__device__ __forceinline__ void bitonic_sort16_desc(int (&a)[16]) {
#pragma unroll
    for (int k = 2; k <= 16; k <<= 1)
#pragma unroll
        for (int j = k >> 1; j > 0; j >>= 1)
#pragma unroll
            for (int i = 0; i < 16; ++i) { const int l = i ^ j; if (l > i) { if ((i & k) == 0) CE_DESC(a[i], a[l]); else CE_ASC(a[i], a[l]); } }
}
__device__ __forceinline__ void bitonic_merge16_desc(int (&a)[16]) {
#pragma unroll
    for (int j = 8; j > 0; j >>= 1)
#pragma unroll
        for (int i = 0; i < 16; ++i) { const int l = i ^ j; if (l > i) CE_DESC(a[i], a[l]); }
}
__device__ __forceinline__ void top16_merge(int (&T)[16], const int (&S)[16]) {
#pragma unroll
    for (int i = 0; i < 16; ++i) T[i] = max(T[i], S[15 - i]);
    bitonic_merge16_desc(T);
}
#define INS16(L, x) do { int x_ = (x); _Pragma("unroll") for (int j_ = 0; j_ < 16; ++j_) { const int hi_ = max(L[j_], x_); x_ = min(L[j_], x_); L[j_] = hi_; } } while (0)

constexpr size_t WS_PART = WS_XN;
constexpr int CT_U = 64, CT_V = 64 + 8 * 64;
constexpr int P6_TOKB = 128, P6_NITEM = NTOK / P6_TOKB, P6_TPW = P6_TOKB / 8;
constexpr size_t WS_CQ = WS_VT, WS_CS = WS_VT + 16 * MiB;
constexpr int P6_IDX = 0;
constexpr int P6_E = 0, P6_C = 8192, P6_ITEM = 16384;

__device__ __forceinline__ void p6a_phase(LAS unsigned char* lds, int G, int wave, int lane) {
    const int gw = blockIdx.x * 8 + wave, NGW = G * 8;
    const float* SC = (const float*)(A_WS + WS_XN);
    int* SELE = (int*)(A_WS + WS_SELE); float* SELG = (float*)(A_WS + WS_SELG);
    LAS int* idxb = (LAS int*)(lds + P6_IDX + wave * 4096);
    const int tl = lane >> 4, hh = (lane >> 1) & 7, half = lane & 1;
    for (int grp = gw; grp < NTOK / 4; grp += NGW) {
        const int tok = grp * 4 + tl;
        const float* sp = SC + (size_t)tok * 2048 + (lane & 15);
        int L[16];
#pragma unroll
        for (int j = 0; j < 16; ++j) L[j] = (int)0x80000000;
        {
            float sa[16], sb_[16];
#pragma unroll
            for (int e = 0; e < 16; ++e) sa[e] = sp[16 * e];
#pragma unroll
            for (int c0 = 0; c0 < 128; c0 += 32) {
#pragma unroll
                for (int e = 0; e < 16; ++e) sb_[e] = sp[16 * (c0 + 16 + e)];
                { int S[16];
#pragma unroll
                  for (int e = 0; e < 16; ++e) S[e] = (f2key(sa[e]) & ~127) | (c0 + e);
                  bitonic_sort16_desc(S);
                  if (c0 == 0) {
#pragma unroll
                      for (int e = 0; e < 16; ++e) L[e] = S[e]; } else top16_merge(L, S); }
                if (c0 + 32 < 128) {
#pragma unroll
                    for (int e = 0; e < 16; ++e) sa[e] = sp[16 * (c0 + 32 + e)]; }
                { int S[16];
#pragma unroll
                  for (int e = 0; e < 16; ++e) S[e] = (f2key(sb_[e]) & ~127) | (c0 + 16 + e);
                  bitonic_sort16_desc(S);
                  top16_merge(L, S); }
            }
        }
#pragma unroll
        for (int j = 0; j < 16; ++j) idxb[lane * 16 + j] = L[j] & 127;
        float va[16], vb[16];
#pragma unroll
        for (int j = 0; j < 16; ++j) { const int own = L[j] & ~127, oth = __shfl_xor(own, 1); va[j] = key2f(half ? oth : own); vb[j] = key2f(half ? own : oth); }
        int C[16];
#pragma unroll
        for (int j = 0; j < 16; ++j) C[j] = (int)0x80000000;
        {   int S[16];
            S[0] = (f2key(va[0] + vb[0]) & ~255) | 0;
            S[1] = (f2key(va[0] + vb[1]) & ~255) | 1;
            S[2] = (f2key(va[0] + vb[2]) & ~255) | 2;
            S[3] = (f2key(va[0] + vb[3]) & ~255) | 3;
            S[4] = (f2key(va[0] + vb[4]) & ~255) | 4;
            S[5] = (f2key(va[0] + vb[5]) & ~255) | 5;
            S[6] = (f2key(va[0] + vb[6]) & ~255) | 6;
            S[7] = (f2key(va[0] + vb[7]) & ~255) | 7;
            S[8] = (f2key(va[0] + vb[8]) & ~255) | 8;
            S[9] = (f2key(va[0] + vb[9]) & ~255) | 9;
            S[10] = (f2key(va[0] + vb[10]) & ~255) | 10;
            S[11] = (f2key(va[0] + vb[11]) & ~255) | 11;
            S[12] = (f2key(va[0] + vb[12]) & ~255) | 12;
            S[13] = (f2key(va[0] + vb[13]) & ~255) | 13;
            S[14] = (f2key(va[0] + vb[14]) & ~255) | 14;
            S[15] = (f2key(va[0] + vb[15]) & ~255) | 15;
            bitonic_sort16_desc(S);
#pragma unroll
            for (int q = 0; q < 16; ++q) C[q] = S[q]; }
        {   int S[16];
            S[0] = (f2key(va[1] + vb[0]) & ~255) | 16;
            S[1] = (f2key(va[1] + vb[1]) & ~255) | 17;
            S[2] = (f2key(va[1] + vb[2]) & ~255) | 18;
            S[3] = (f2key(va[1] + vb[3]) & ~255) | 19;
            S[4] = (f2key(va[1] + vb[4]) & ~255) | 20;
            S[5] = (f2key(va[1] + vb[5]) & ~255) | 21;
            S[6] = (f2key(va[1] + vb[6]) & ~255) | 22;
            S[7] = (f2key(va[1] + vb[7]) & ~255) | 23;
            S[8] = (f2key(va[2] + vb[0]) & ~255) | 32;
            S[9] = (f2key(va[2] + vb[1]) & ~255) | 33;
            S[10] = (f2key(va[2] + vb[2]) & ~255) | 34;
            S[11] = (f2key(va[2] + vb[3]) & ~255) | 35;
            S[12] = (f2key(va[2] + vb[4]) & ~255) | 36;
            S[13] = (f2key(va[3] + vb[0]) & ~255) | 48;
            S[14] = (f2key(va[3] + vb[1]) & ~255) | 49;
            S[15] = (f2key(va[3] + vb[2]) & ~255) | 50;
            bitonic_sort16_desc(S);
            top16_merge(C, S); }
        {   int S[16];
            S[0] = (f2key(va[3] + vb[3]) & ~255) | 51;
            S[1] = (f2key(va[4] + vb[0]) & ~255) | 64;
            S[2] = (f2key(va[4] + vb[1]) & ~255) | 65;
            S[3] = (f2key(va[4] + vb[2]) & ~255) | 66;
            S[4] = (f2key(va[5] + vb[0]) & ~255) | 80;
            S[5] = (f2key(va[5] + vb[1]) & ~255) | 81;
            S[6] = (f2key(va[6] + vb[0]) & ~255) | 96;
            S[7] = (f2key(va[6] + vb[1]) & ~255) | 97;
            S[8] = (f2key(va[7] + vb[0]) & ~255) | 112;
            S[9] = (f2key(va[7] + vb[1]) & ~255) | 113;
            S[10] = (f2key(va[8] + vb[0]) & ~255) | 128;
            S[11] = (f2key(va[9] + vb[0]) & ~255) | 144;
            S[12] = (f2key(va[10] + vb[0]) & ~255) | 160;
            S[13] = (f2key(va[11] + vb[0]) & ~255) | 176;
            S[14] = (f2key(va[12] + vb[0]) & ~255) | 192;
            S[15] = (f2key(va[13] + vb[0]) & ~255) | 208;
            bitonic_sort16_desc(S);
            top16_merge(C, S); }
        {   int S[16];
            S[0] = (f2key(va[14] + vb[0]) & ~255) | 224;
            S[1] = (f2key(va[15] + vb[0]) & ~255) | 240;
            S[2] = (int)0x80000000;
            S[3] = (int)0x80000000;
            S[4] = (int)0x80000000;
            S[5] = (int)0x80000000;
            S[6] = (int)0x80000000;
            S[7] = (int)0x80000000;
            S[8] = (int)0x80000000;
            S[9] = (int)0x80000000;
            S[10] = (int)0x80000000;
            S[11] = (int)0x80000000;
            S[12] = (int)0x80000000;
            S[13] = (int)0x80000000;
            S[14] = (int)0x80000000;
            S[15] = (int)0x80000000;
            bitonic_sort16_desc(S);
            top16_merge(C, S); }
        const float mx = key2f(C[0] & ~255);
        float ev[16], sum = 0.f;
#pragma unroll
        for (int j = 0; j < 16; ++j) { ev[j] = __expf(key2f(C[j] & ~255) - mx); sum += ev[j]; }
        const float inv = 1.0f / sum;
        asm volatile("s_waitcnt lgkmcnt(0)" ::: "memory");
        int eo[8]; float go[8];
#pragma unroll
        for (int s = 0; s < 8; ++s) {
            int c_lo = C[s], c_hi = C[8 + s]; float e_lo = ev[s], e_hi = ev[8 + s];
            asm volatile("" : "+v"(c_lo), "+v"(c_hi), "+v"(e_lo), "+v"(e_hi));
            const int cc = half ? c_hi : c_lo; go[s] = (half ? e_hi : e_lo) * inv;
            const int ij = cc & 255, i1 = idxb[(lane & ~1) * 16 + (ij >> 4)], i2 = idxb[(lane | 1) * 16 + (ij & 15)];
            eo[s] = i1 * 128 + i2;
        }
        int* ep = SELE + (size_t)tok * 128 + hh * 16 + half * 8; float* gp = SELG + (size_t)tok * 128 + hh * 16 + half * 8;
        *(u32x4*)ep = (u32x4){(unsigned)eo[0], (unsigned)eo[1], (unsigned)eo[2], (unsigned)eo[3]}; *(u32x4*)(ep + 4) = (u32x4){(unsigned)eo[4], (unsigned)eo[5], (unsigned)eo[6], (unsigned)eo[7]};
        *(f32x4*)gp = (f32x4){go[0], go[1], go[2], go[3]}; *(f32x4*)(gp + 4) = (f32x4){go[4], go[5], go[6], go[7]};
        asm volatile("s_waitcnt lgkmcnt(0)" ::: "memory");
    }
}

__device__ __forceinline__ float dot2bf(unsigned a, unsigned b, float c) { return __builtin_amdgcn_fdot2_f32_bf16(__builtin_bit_cast(bf16x2_t, a), __builtin_bit_cast(bf16x2_t, b), c, false); }
__device__ __forceinline__ unsigned xcc_id() { return (unsigned)__builtin_amdgcn_s_getreg((3 << 11) | 20) & 0xFu; }
__device__ __forceinline__ float dpp_sum16(float v) {
    v += __builtin_bit_cast(float, __builtin_amdgcn_update_dpp(0, __builtin_bit_cast(int, v), 0xB1, 0xF, 0xF, true));
    v += __builtin_bit_cast(float, __builtin_amdgcn_update_dpp(0, __builtin_bit_cast(int, v), 0x4E, 0xF, 0xF, true));
    v += __builtin_bit_cast(float, __builtin_amdgcn_update_dpp(0, __builtin_bit_cast(int, v), 0x141, 0xF, 0xF, true));
    v += __builtin_bit_cast(float, __builtin_amdgcn_update_dpp(0, __builtin_bit_cast(int, v), 0x140, 0xF, 0xF, true));
    return v;
}
__device__ __forceinline__ bool p6_claim(LAS unsigned char* lds, unsigned* cnt, int tid, int& ring, int home, int& slice, int& item) {
    for (;;) {
        if (ring >= 8) return false;
        slice = (home + ring) & 7;
        __syncthreads();
        if (tid == 0) *(volatile LAS int*)(lds + P6_ITEM) = (int)__hip_atomic_fetch_add(cnt + 64 * slice, 1u, __ATOMIC_RELAXED, __HIP_MEMORY_SCOPE_AGENT);
        __syncthreads();
        item = *(volatile LAS int*)(lds + P6_ITEM);
        if (item < P6_NITEM) return true;
        ++ring;
    }
}

__device__ __forceinline__ float ub0(unsigned w) { return (float)(w & 0xffu); }
__device__ __forceinline__ float ub1(unsigned w) { return (float)((w >> 8) & 0xffu); }
__device__ __forceinline__ float ub2(unsigned w) { return (float)((w >> 16) & 0xffu); }
__device__ __forceinline__ float ub3(unsigned w) { return (float)(w >> 24); }
__device__ __forceinline__ float dpp_sum8(float v) {
    v += __builtin_bit_cast(float, __builtin_amdgcn_update_dpp(0, __builtin_bit_cast(int, v), 0xB1, 0xF, 0xF, true));
    v += __builtin_bit_cast(float, __builtin_amdgcn_update_dpp(0, __builtin_bit_cast(int, v), 0x4E, 0xF, 0xF, true));
    v += __builtin_bit_cast(float, __builtin_amdgcn_update_dpp(0, __builtin_bit_cast(int, v), 0x141, 0xF, 0xF, true));
    return v;
}
__device__ __forceinline__ int dpp_isum8(int v) {
    v += __builtin_amdgcn_update_dpp(0, v, 0xB1, 0xF, 0xF, true);
    v += __builtin_amdgcn_update_dpp(0, v, 0x4E, 0xF, 0xF, true);
    v += __builtin_amdgcn_update_dpp(0, v, 0x141, 0xF, 0xF, true);
    return v;
}
__device__ __forceinline__ void p6b_phase(LAS unsigned char* lds, int tid, int wave, int lane) {
    const unsigned char* XQ = A_WS + WS_XQ; const unsigned char* UB = A_WS + WS_UB; const float* SX = (const float*)(A_WS + WS_SX);
    const int* SELE = (const int*)(A_WS + WS_SELE); float* PART = (float*)(A_WS + WS_PART);
    unsigned* cnt = (unsigned*)(A_WS + WS_CTL) + CT_U;
    const int i8 = lane & 7, grp = lane >> 3, home = (int)(xcc_id() & 7u);
    LAS int* eb = (LAS int*)(lds + P6_E + wave * 1024);
    int ring = 0, slice, item;
    while (p6_claim(lds, cnt, tid, ring, home, slice, item)) {
        const int tok0 = item * P6_TOKB + wave * P6_TPW;
        int e0 = SELE[(size_t)tok0 * 128 + lane], e1 = SELE[(size_t)tok0 * 128 + 64 + lane];
#pragma unroll 2
        for (int ti = 0; ti < P6_TPW; ++ti) {
            const int tok = tok0 + ti;
            LAS int* ebt = eb + (ti & 1) * 128;
            ebt[lane] = e0; ebt[64 + lane] = e1;
            if (ti < P6_TPW - 1) { e0 = SELE[(size_t)(tok + 1) * 128 + lane]; e1 = SELE[(size_t)(tok + 1) * 128 + 64 + lane]; }
            const u32x4 xq = *(const u32x4*)(XQ + (size_t)tok * DM + slice * 128 + i8 * 16);
            const int x0 = (int)xq.x, x1 = (int)xq.y, x2 = (int)xq.z, x3 = (int)xq.w;
            const float sx = SX[tok];
            const unsigned char* ub = UB + slice * 128 + i8 * 16;
            asm volatile("s_waitcnt lgkmcnt(0)" ::: "memory");
            u32x4 uv[16];
#pragma unroll
            for (int q = 0; q < 16; ++q) { const int e = ebt[16 * grp + q]; uv[q] = *(const u32x4*)(ub + (size_t)e * DM); }
            int res0 = 0, res1 = 0;
#pragma unroll
            for (int q = 0; q < 16; ++q) {
                const int a0 = (int)uv[q].x, a1 = (int)uv[q].y, a2 = (int)uv[q].z, a3 = (int)uv[q].w;
                int d = __builtin_amdgcn_sdot4(a0, x0, 0, false); d = __builtin_amdgcn_sdot4(a1, x1, d, false); d = __builtin_amdgcn_sdot4(a2, x2, d, false); d = __builtin_amdgcn_sdot4(a3, x3, d, false);
                d = dpp_isum8(d);
                if (q < 8) res0 = (i8 == q) ? d : res0; else res1 = (i8 == (q - 8)) ? d : res1;
            }
            float* pp = PART + ((size_t)slice * NTOK + tok) * 128 + 16 * grp + i8;
            pp[0] = (float)res0 * sx; pp[8] = (float)res1 * sx;
        }
    }
}

__device__ __forceinline__ void p6m_phase(int G, int wave, int lane) {
    const int gw = blockIdx.x * 8 + wave, NGW = G * 8;
    const float* SU = (const float*)(A_WS + WS_SU); const float* SV = (const float*)(A_WS + WS_SV);
    const int* SELE = (const int*)(A_WS + WS_SELE); const float* SELG = (const float*)(A_WS + WS_SELG); const float* PART = (const float*)(A_WS + WS_PART);
    unsigned char* CQ = A_WS + WS_CQ; float* CS = (float*)(A_WS + WS_CS);
    for (int tok = gw; tok < NTOK; tok += NGW) {
        float a0 = 0.f, a1 = 0.f;
#pragma unroll
        for (int j = 0; j < 8; ++j) { const float* pp = PART + ((size_t)j * NTOK + tok) * 128; a0 += pp[lane]; a1 += pp[64 + lane]; }
        const int e0 = SELE[(size_t)tok * 128 + lane], e1 = SELE[(size_t)tok * 128 + 64 + lane];
        const float c0 = SELG[(size_t)tok * 128 + lane] * gelu_tanh(a0 * SU[e0]) * SV[e0], c1 = SELG[(size_t)tok * 128 + 64 + lane] * gelu_tanh(a1 * SU[e1]) * SV[e1];
        float mx = fmaxf(fabsf(c0), fabsf(c1));
#pragma unroll
        for (int o = 1; o < 64; o <<= 1) mx = fmaxf(mx, __shfl_xor(mx, o));
        const float cstep = fmaxf(mx, 1e-30f) * (1.0f / 127.0f), cinv = 1.0f / cstep;
        CQ[(size_t)tok * 128 + lane] = (unsigned char)((int)rintf(c0 * cinv) & 0xff); CQ[(size_t)tok * 128 + 64 + lane] = (unsigned char)((int)rintf(c1 * cinv) & 0xff);
        if (lane == 0) CS[tok] = cstep;
    }
}

__device__ __forceinline__ void p6c_phase(LAS unsigned char* lds, int tid, int wave, int lane) {
    const unsigned char* VB = A_WS + WS_VB; const int* SELE = (const int*)(A_WS + WS_SELE);
    const unsigned char* CQ = A_WS + WS_CQ; const float* CS = (const float*)(A_WS + WS_CS);
    unsigned* cnt = (unsigned*)(A_WS + WS_CTL) + CT_V;
    float* out = A_OUT;
    const int i8 = lane & 7, grp = lane >> 3, home = (int)(xcc_id() & 7u);
    LAS int* eb = (LAS int*)(lds + P6_E + wave * 1024);
    LAS int* cbb = (LAS int*)(lds + P6_C + wave * 512);
    int ring = 0, slice, item;
    while (p6_claim(lds, cnt, tid, ring, home, slice, item)) {
        const int tok0 = item * P6_TOKB + wave * P6_TPW;
        int e0 = SELE[(size_t)tok0 * 128 + lane], e1 = SELE[(size_t)tok0 * 128 + 64 + lane];
        int cw = ((const int*)(CQ + (size_t)tok0 * 128))[lane & 31];
        float cstep = CS[tok0];
#pragma unroll 2
        for (int ti = 0; ti < P6_TPW; ++ti) {
            const int tok = tok0 + ti;
            LAS int* ebt = eb + (ti & 1) * 128; LAS int* cbt = cbb + (ti & 1) * 32;
            ebt[lane] = e0; ebt[64 + lane] = e1; if (lane < 32) cbt[lane] = cw;
            const float cs = cstep;
            if (ti < P6_TPW - 1) { e0 = SELE[(size_t)(tok + 1) * 128 + lane]; e1 = SELE[(size_t)(tok + 1) * 128 + 64 + lane]; cw = ((const int*)(CQ + (size_t)(tok + 1) * 128))[lane & 31]; cstep = CS[tok + 1]; }
            float* yr = ((tok < NTP) ? out + O_YP + (size_t)tok * DM : out + O_YS + (size_t)(tok - NTP) * DM) + slice * 128 + i8 * 16;
            f32x4 z[4];
            if (lane < 8) {
#pragma unroll
                for (int q = 0; q < 4; ++q) z[q] = *(const f32x4*)(yr + 4 * q);
            }
            const unsigned char* vb = VB + slice * 128 + i8 * 16;
            asm volatile("s_waitcnt lgkmcnt(0)" ::: "memory");
            u32x4 vv[16];
#pragma unroll
            for (int q = 0; q < 16; ++q) { const int e = ebt[16 * grp + q]; vv[q] = *(const u32x4*)(vb + (size_t)e * DM); }
            int acc[16];
#pragma unroll
            for (int r = 0; r < 16; ++r) acc[r] = 0;
#pragma unroll
            for (int a4 = 0; a4 < 4; ++a4) {
                const int cq = cbt[4 * grp + a4];
#pragma unroll
                for (int d = 0; d < 4; ++d) {
                    const unsigned ra = vv[4 * a4][d], rb = vv[4 * a4 + 1][d], rc = vv[4 * a4 + 2][d], rd = vv[4 * a4 + 3][d];
                    const unsigned lo = __builtin_amdgcn_perm(rb, ra, 0x05010400u), hi = __builtin_amdgcn_perm(rb, ra, 0x07030602u);
                    const unsigned lo2 = __builtin_amdgcn_perm(rd, rc, 0x05010400u), hi2 = __builtin_amdgcn_perm(rd, rc, 0x07030602u);
                    const unsigned t0 = __builtin_amdgcn_perm(lo2, lo, 0x05040100u), t1 = __builtin_amdgcn_perm(lo2, lo, 0x07060302u);
                    const unsigned t2 = __builtin_amdgcn_perm(hi2, hi, 0x05040100u), t3 = __builtin_amdgcn_perm(hi2, hi, 0x07060302u);
                    acc[4 * d + 0] = __builtin_amdgcn_sdot4((int)t0, cq, acc[4 * d + 0], false); acc[4 * d + 1] = __builtin_amdgcn_sdot4((int)t1, cq, acc[4 * d + 1], false);
                    acc[4 * d + 2] = __builtin_amdgcn_sdot4((int)t2, cq, acc[4 * d + 2], false); acc[4 * d + 3] = __builtin_amdgcn_sdot4((int)t3, cq, acc[4 * d + 3], false);
                }
            }
#pragma unroll
            for (int r = 0; r < 16; ++r) { acc[r] += __shfl_xor(acc[r], 8); acc[r] += __shfl_xor(acc[r], 16); acc[r] += __shfl_xor(acc[r], 32); }
            if (lane < 8) {
#pragma unroll
                for (int q = 0; q < 4; ++q) { z[q] += (f32x4){(float)acc[4 * q] * cs, (float)acc[4 * q + 1] * cs, (float)acc[4 * q + 2] * cs, (float)acc[4 * q + 3] * cs}; *(f32x4*)(yr + 4 * q) = z[q]; }
            }
        }
    }
}

__device__ __forceinline__ void p6d_phase(int G, int wave, int lane) {
    const int gw = blockIdx.x * 8 + wave, NGW = G * 8;
    const float* gf = A_IN(25); float* out = A_OUT;
    f32x4 v[4], vn[4];
    if (gw < NTOK) row_ld(yrow_ptr(gw), v, lane);
    for (int m = gw; m < NTOK; m += NGW) {
        const int mn = m + NGW;
        if (mn < NTOK) row_ld(yrow_ptr(mn), vn, lane);
        float* yr = yrow_ptr(m);
        const float inv = 1.0f / sqrtf(wave_sum(row_ss(v)) * (1.0f / DM) + EPS);
#pragma unroll
        for (int j = 0; j < 4; ++j) { const f32x4 gg = *(const f32x4*)(gf + j * 256 + lane * 4); *(f32x4*)(yr + j * 256 + lane * 4) = v[j] * inv * gg; }
#pragma unroll
        for (int j = 0; j < 4; ++j) v[j] = vn[j];
    }
}

#define XB_TMO      128
#define XB_XCNT(j)  (256  + 64 * (j))
#define XB_XSUB(j)  (1280 + 64 * (j))
#define XB_XGEN(j)  (2304 + 64 * (j))
#define XB_TOP      3328
#define XB_TOPGEN   3392
#define XB_SPIN_CAP (1u << 22)
constexpr int CW_BAR = 2048;
constexpr int LDS_MISC = 131072 + 64;
__device__ __forceinline__ unsigned xb_ld(unsigned* p)              { return __hip_atomic_load(p, __ATOMIC_RELAXED, __HIP_MEMORY_SCOPE_AGENT); }
__device__ __forceinline__ unsigned xb_add(unsigned* p, unsigned v) { return __hip_atomic_fetch_add(p, v, __ATOMIC_RELAXED, __HIP_MEMORY_SCOPE_AGENT); }
#define XB_SPIN(cond, bar) do { unsigned _sp = 0; while (cond) { __builtin_amdgcn_s_sleep(1); \
    if ((++_sp & 255u) == 0u) { if (xb_ld(&(bar)[XB_TMO])) break; if (_sp > XB_SPIN_CAP) { atomicAdd(&(bar)[XB_TMO], 1u); break; } } } } while (0)
struct XcdBarrier { unsigned* bar; unsigned x; volatile LAS unsigned* st; };
__device__ __forceinline__ XcdBarrier xcd_barrier_post(unsigned* bar, volatile LAS unsigned* st) {
    XcdBarrier b; b.bar = bar; b.x = (unsigned)__builtin_amdgcn_s_getreg((3 << 11) | 20) & 0xFu; b.st = st;
    if (threadIdx.x == 0) (void)xb_add(&bar[XB_XCNT(b.x)], 1u);
    return b;
}
__device__ __forceinline__ void xcd_barrier_complete(unsigned* bar, unsigned x, unsigned& nloc, unsigned& nx) {
    const unsigned G = gridDim.x * gridDim.y * gridDim.z;
    unsigned sum, cnt, mine, sp = 0u;
    for (;;) {
        sum = 0u; cnt = 0u; mine = 0u;
#pragma unroll
        for (unsigned j = 0; j < 16; ++j) { const unsigned c = xb_ld(&bar[XB_XCNT(j)]); sum += c; cnt += (c > 0u) ? 1u : 0u; mine = (j == x) ? c : mine; }
        if (sum == G) break;
        __builtin_amdgcn_s_sleep(1);
        if ((++sp & 255u) == 0u) { if (xb_ld(&bar[XB_TMO])) break; if (sp > XB_SPIN_CAP) { atomicAdd(&bar[XB_TMO], 1u); break; } }
    }
    nloc = mine > 0u ? mine : 1u; nx = cnt > 0u ? cnt : 1u;
}
__device__ __forceinline__ void xcd_barrier(const XcdBarrier& b) {
    asm volatile("s_waitcnt vmcnt(0)" ::: "memory");
    __syncthreads();
    if (threadIdx.x == 0) {
        unsigned* bar = b.bar;
        __builtin_amdgcn_s_waitcnt(0);
        unsigned nloc = b.st[0], nx = b.st[1];
        if (nloc == 0u) { xcd_barrier_complete(bar, b.x, nloc, nx); b.st[0] = nloc; b.st[1] = nx; }
        const unsigned old = xb_add(&bar[XB_XSUB(b.x)], 1u);
        const unsigned gen = old / nloc;
        if (old + 1u == (gen + 1u) * nloc) {
            __builtin_amdgcn_fence(__ATOMIC_RELEASE, "agent");
            asm volatile("s_waitcnt vmcnt(0)" ::: "memory");
            const unsigned og = xb_add(&bar[XB_TOP], 1u);
            const unsigned tg = og / nx;
            if (og + 1u == (tg + 1u) * nx) xb_add(&bar[XB_TOPGEN], 1u);
            else XB_SPIN(xb_ld(&bar[XB_TOPGEN]) == tg, bar);
            __builtin_amdgcn_fence(__ATOMIC_ACQUIRE, "agent");
            xb_add(&bar[XB_XGEN(b.x)], 1u);
            asm volatile("s_waitcnt vmcnt(0)" ::: "memory");
        } else {
            XB_SPIN(xb_ld(&bar[XB_XGEN(b.x)]) == gen, bar);
            __builtin_amdgcn_fence(__ATOMIC_ACQUIRE, "agent");
            asm volatile("s_waitcnt vmcnt(0)" ::: "memory");
        }
    }
    __syncthreads();
}

__global__ void __launch_bounds__(512, 2) hybrid_fwd(Args a) {
    extern __shared__ __attribute__((aligned(16))) unsigned char lds_raw[];
    LAS unsigned char* lds = (LAS unsigned char*)lds_raw;
    const int tid = threadIdx.x, lane = tid & 63, wave = __builtin_amdgcn_readfirstlane(tid >> 6), G = gridDim.x;
    cg::grid_group grid = cg::this_grid();
    unsigned char* ws = A_WS;
    if (tid < 2) ((volatile LAS unsigned*)(lds + LDS_MISC))[tid] = 0u;
    __syncthreads();
    XcdBarrier xbar; xbar.bar = (unsigned*)(ws + WS_CTL) + CW_BAR; xbar.x = 0; xbar.st = nullptr;
    if (KA->use_sync) xbar = xcd_barrier_post((unsigned*)(ws + WS_CTL) + CW_BAR, (volatile LAS unsigned*)(lds + LDS_MISC));
#define IN(k) (KA->ph_lo <= (k) && (k) < KA->ph_hi)
#define SEAM(k) do { if (KA->use_sync && IN(k) && IN((k) + 1)) { if ((k) == 0) grid.sync(); else xcd_barrier(xbar); } } while (0)
    if (IN(0)) { p0_prologue(lds, G, wave, lane); }
    SEAM(0);
    if (IN(1)) {
        pg8::Gemm g{(const bf16_t*)(ws + WS_XN), (const bf16_t*)(ws + WS_WIN), (const bf16_t*)(ws + WS_WIN) + (size_t)2048 * DM, (const bf16_t*)(ws + WS_XN), DM};
        SchedG1 S; S.init(G, blockIdx.x); EpiG1 E;
        pg8::gemm_phase(lds, g, S, E);
    }
    SEAM(1);
    if (IN(2)) { p2_phase(lds, G, tid, wave, lane); }
    SEAM(2);
    if (IN(3)) {
        pg8::Gemm g{(const bf16_t*)(ws + WS_XN), (const bf16_t*)(ws + WS_WBA), (const bf16_t*)(ws + WS_G), (const bf16_t*)(ws + WS_WBL), DM};
        SchedPair S; S.init(4, G, blockIdx.x); EpiP3 E;
        pg8::gemm_phase(lds, g, S, E);
    }
    SEAM(3);
    if (IN(4)) {
        pg8::Gemm g{(const bf16_t*)(ws + WS_XR), (const bf16_t*)(ws + WS_WO), (const bf16_t*)(ws + WS_XR), (const bf16_t*)(ws + WS_WO), DM};
        SchedOne S; S.init(4, G, blockIdx.x); EpiP4 E;
        pg8::gemm_phase(lds, g, S, E);
    }
    SEAM(4);
    if (IN(5)) { p4b_phase(G, wave, lane); }
    SEAM(5);
    if (IN(6)) {
        pg8::Gemm g{(const bf16_t*)(ws + WS_Q), (const bf16_t*)(ws + WS_WS), (const bf16_t*)(ws + WS_Q), (const bf16_t*)(ws + WS_WS), DM};
        SchedOne S; S.init(8, G, blockIdx.x); EpiP5 E;
        pg8::gemm_phase(lds, g, S, E);
    }
    SEAM(6);
    if (IN(7)) { p6a_phase(lds, G, wave, lane); }
    SEAM(7);
    if (IN(8)) { p6b_phase(lds, tid, wave, lane); }
    SEAM(8);
    if (IN(9)) { p6m_phase(G, wave, lane); }
    SEAM(9);
    if (IN(10)) { p6c_phase(lds, tid, wave, lane); }
    SEAM(10);
    if (IN(11)) { p6d_phase(G, wave, lane); }
#undef IN
#undef SEAM
}

#ifndef N_LAUNCH_MODE
#define N_LAUNCH_MODE 1
#endif
constexpr int NPH = 12;
extern "C" void kernel_launch(void* const* d_in, const int* in_sizes, int n_in, void* d_out, int out_size, void* d_ws, size_t ws_size, hipStream_t stream) {
    static int grid = 0;
    if (grid == 0) {
        if (n_in != 26 || (size_t)out_size != O_END || ws_size < WS_END) { fprintf(stderr, "kernel_launch: unexpected sizes n_in %d out %d ws %zu (need %zu)\n", n_in, out_size, ws_size, (size_t)WS_END); grid = -1; return; }
        int dev = 0, cus = 0, per_cu = 0;
        (void)hipGetDevice(&dev); (void)hipDeviceGetAttribute(&cus, hipDeviceAttributeMultiprocessorCount, dev);
        (void)hipFuncSetAttribute((const void*)hybrid_fwd, hipFuncAttributeMaxDynamicSharedMemorySize, LDS_BYTES);
        (void)hipOccupancyMaxActiveBlocksPerMultiprocessor(&per_cu, (const void*)hybrid_fwd, 512, LDS_BYTES);
        if (per_cu < 1) { fprintf(stderr, "kernel_launch: occupancy query says %d blocks per CU\n", per_cu); per_cu = 1; }
        grid = cus;
        (void)hipGetLastError();
    }
    if (grid < 0) return;
    (void)hipMemsetAsync((char*)d_ws + WS_CTL, 0, 32768, stream);
    Args a{};
    for (int i = 0; i < 26; ++i) a.in[i] = (const float*)d_in[i];
    a.out = (float*)d_out; a.ws = (unsigned char*)d_ws;
    if (N_LAUNCH_MODE == 1) {
        a.ph_lo = 0; a.ph_hi = NPH; a.use_sync = 1;
        void* args[] = {&a};
        hipError_t e = hipLaunchCooperativeKernel((const void*)hybrid_fwd, dim3(grid), dim3(512), args, LDS_BYTES, stream);
        if (e != hipSuccess) fprintf(stderr, "cooperative launch failed: %s (grid %d)\n", hipGetErrorString(e), grid);
    } else {
        for (int p = 0; p < NPH; ++p) { a.ph_lo = p; a.ph_hi = p + 1; a.use_sync = 0; hipLaunchKernelGGL(hybrid_fwd, dim3(grid), dim3(512), LDS_BYTES, stream, a); }
    }
}
```

```cpp
#include <hip/hip_runtime.h>
#include <hip/hip_cooperative_groups.h>
#include <cstdint>
#include <cstdio>
namespace cg = cooperative_groups;

#define LAS __attribute__((address_space(3)))
typedef unsigned short bf16_t;
typedef short bf16x8 __attribute__((ext_vector_type(8)));
typedef float f32x4 __attribute__((ext_vector_type(4)));
typedef float f32x2 __attribute__((ext_vector_type(2)));
typedef float f32x16 __attribute__((ext_vector_type(16)));
typedef unsigned u32x4 __attribute__((ext_vector_type(4)));
typedef unsigned u32x2 __attribute__((ext_vector_type(2)));
typedef __bf16 bf16x2_t __attribute__((ext_vector_type(2)));

constexpr int DM = 1024, SEQ = 4096, NB = 16, NTP = NB * SEQ, NSB = 8, NST = 16, NTS = NSB * NST, NTOK = NTP + NTS;
constexpr int ROWS = 65792, NMT = 257;
constexpr int INC = 7168, NEXP = 16384;
constexpr float EPS = 1e-6f, LOG2E = 1.4426950408889634f;
constexpr float QSCALE = 0.125f * LOG2E;

constexpr size_t MiB = 1u << 20;
constexpr size_t BUF = (size_t)ROWS * DM * 2;
constexpr size_t WS_CTL = 0;
constexpr size_t WS_WIN = 1 * MiB;
constexpr size_t WS_WBA = 16 * MiB, WS_WBL = 18 * MiB, WS_WO = 20 * MiB, WS_WS = 22 * MiB;
constexpr size_t WS_LRUW = 26 * MiB;
constexpr size_t WS_SGA = 27 * MiB, WS_SGR = 27 * MiB + 512 * 1024;
constexpr size_t WS_SU = 26 * MiB + 512 * 1024, WS_SV = 26 * MiB + 640 * 1024;
constexpr size_t WS_SX = 26 * MiB + 704 * 1024;
constexpr size_t WS_UB = 28 * MiB, WS_VB = 60 * MiB;
constexpr size_t WS_Q = 92 * MiB;
constexpr size_t WS_XN = WS_Q + BUF;
constexpr size_t WS_K = WS_XN + BUF;
constexpr size_t WS_VT = WS_K + BUF;
constexpr size_t WS_XR = WS_VT + BUF;
constexpr size_t WS_G = WS_XR + BUF;
constexpr size_t WS_END = WS_G + BUF;
constexpr size_t WS_DELTA = WS_VT;
constexpr size_t WS_PEER = WS_Q;
constexpr size_t WS_SELE = WS_G, WS_SELG = WS_G + (size_t)NTOK * 512, WS_XQ = WS_G + (size_t)NTOK * 1024;

constexpr size_t O_YP = 0, O_YS = O_YP + (size_t)NTP * DM, O_KP = O_YS + (size_t)NTS * DM, O_VP = O_KP + (size_t)NB * 512 * DM,
                 O_CP = O_VP + (size_t)NB * 512 * DM, O_LP = O_CP + (size_t)NB * 3 * DM, O_KS = O_LP + (size_t)NB * DM, O_VS = O_KS + (size_t)NTS * DM,
                 O_CS = O_VS + (size_t)NTS * DM, O_LS = O_CS + (size_t)NSB * 3 * DM, O_END = O_LS + (size_t)NSB * DM;

constexpr int LDS_BYTES = 135168;

__device__ __forceinline__ unsigned cvtpk(float lo, float hi) { f32x2 v = {lo, hi}; bf16x2_t b = __builtin_convertvector(v, bf16x2_t); return __builtin_bit_cast(unsigned, b); }
__device__ __forceinline__ float bflo(unsigned u) { return __uint_as_float(u << 16); }
__device__ __forceinline__ float bfhi(unsigned u) { return __uint_as_float(u & 0xffff0000u); }
__device__ __forceinline__ float fast_exp2(float x) { return __builtin_amdgcn_exp2f(x); }
__device__ __forceinline__ float fast_rcp(float x) { return __builtin_amdgcn_rcpf(x); }
__device__ __forceinline__ float sigmoidf_(float z) { return fast_rcp(1.0f + fast_exp2(-z * LOG2E)); }
__device__ __forceinline__ float gelu_tanh(float x) { const float u = x + 0.044715f * x * x * x; return x * fast_rcp(1.0f + fast_exp2(-1.5957691216f * LOG2E * u)); }
__device__ __forceinline__ float wave_sum(float v) {
#pragma unroll
    for (int o = 1; o < 64; o <<= 1) v += __shfl_xor(v, o);
    return v;
}
__device__ __forceinline__ int swap23(int i) { return (i & ~12) | ((i & 4) << 1) | ((i & 8) >> 1); }
__device__ __forceinline__ float plswap_max(float m) { auto rr = __builtin_amdgcn_permlane32_swap(__float_as_uint(m), __float_as_uint(m), false, false); return fmaxf(__uint_as_float(rr[0]), __uint_as_float(rr[1])); }
__device__ __forceinline__ float plswap_add(float m) { auto rr = __builtin_amdgcn_permlane32_swap(__float_as_uint(m), __float_as_uint(m), false, false); return __uint_as_float(rr[0]) + __uint_as_float(rr[1]); }

namespace pg8 {
constexpr int BM = 256, BK = 64, HALF = 128, HTB = HALF * BK * 2, STAGE_BYTES = 8 * HTB, NXCD = 8, WGM = 8;
__host__ __device__ __forceinline__ int lds_byte(int r, int c) { const int st = (r >> 4) * 2 + (c >> 5), rr = r & 15, cc = c & 31, ob = rr * 64 + cc * 2; return st * 1024 + (ob ^ (((ob >> 9) & 1) << 5)); }
__host__ __device__ __forceinline__ void stage_rc(int b, int& R, int& C) { const int st = b / 1024, sb = b % 1024, swz = sb ^ (((sb >> 9) & 1) << 5); R = (st >> 1) * 16 + swz / 64; C = (st & 1) * 32 + (swz % 64) / 2; }
__host__ __device__ __forceinline__ int perm32(int rho) { const int n = rho >> 4, i = rho & 15; return 8 * (i >> 2) + 4 * n + (i & 3); }

struct Unit { int pm, pn, kind; };
struct Gemm { const bf16_t* A0; const bf16_t* B0; const bf16_t* A1; const bf16_t* B1; int K; };

struct TileMap {
    int nM, nN, nwg;
    __device__ __forceinline__ void init(int nM_, int nN_) { nM = nM_; nN = nN_; nwg = nM * nN; }
    __device__ __forceinline__ void map(int L, int& pm, int& pn) const {
        int wgid = L; { const int q = nwg / NXCD, r = nwg % NXCD, xcd = wgid % NXCD, off = wgid / NXCD; wgid = (xcd < r ? xcd * (q + 1) : r * (q + 1) + (xcd - r) * q) + off; }
        const int nig = WGM * nN, gid = wgid / nig, fm = gid * WGM, gsz = (nM - fm) < WGM ? (nM - fm) : WGM;
        pm = fm + ((wgid % nig) % gsz); pn = (wgid % nig) / gsz;
    }
};

template <class Epi, class Sched>
__device__ __forceinline__ void gemm_phase(LAS unsigned char* lds, const Gemm g, const Sched& S, const Epi& E) {
    const int tid = threadIdx.x, wid = __builtin_amdgcn_readfirstlane(tid >> 6), lane = tid & 63, wr = wid >> 2, wc = wid & 3, fr = lane & 15, fq = lane >> 4;
    const int K = g.K, nt = K / BK;
    unsigned voffA[2], voffB[2];
#pragma unroll
    for (int i = 0; i < 2; ++i) { int R, C; stage_rc(tid * 16 + i * 8192, R, C); const int Rb = (R & ~31) + perm32(R & 31);
        voffA[i] = (unsigned)(R * K + C) * 2u; voffB[i] = (unsigned)(Rb * K + C) * 2u; }
    const size_t kstep = (size_t)(BK * 2);
    const size_t hstep = (size_t)HALF * K * 2;
    const size_t tstep = 2 * hstep;
    const unsigned ldsw = (unsigned)wid * 1024u;
    const int aoff = lds_byte(wr * 64 + fr, fq * 8), boff = lds_byte(wc * 32 + fr, fq * 8);
#define PG8_SA(b, h) (((b) * 2 + (h)) * HTB)
#define PG8_SB(b, h) ((4 + (b) * 2 + (h)) * HTB)
#define PG8_STAGE(bufoff, gbase, voff) do { _Pragma("unroll") for (int _i = 0; _i < 2; ++_i) \
        __builtin_amdgcn_global_load_lds((const unsigned*)((const char*)(gbase) + (voff)[_i]), (LAS unsigned*)(lds + (bufoff) + ldsw + _i * 8192), 16, 0, 0); } while (0)
#define PG8_LDA(dst, b, h) do { _Pragma("unroll") for (int m = 0; m < 4; ++m) _Pragma("unroll") for (int k = 0; k < 2; ++k) dst[m][k] = *(const LAS bf16x8*)(lds + PG8_SA(b, h) + aoff + m * 2048 + k * 1024); } while (0)
#define PG8_LDB(dst, b, h) do { _Pragma("unroll") for (int n = 0; n < 2; ++n) _Pragma("unroll") for (int k = 0; k < 2; ++k) dst[n][k] = *(const LAS bf16x8*)(lds + PG8_SB(b, h) + boff + n * 2048 + k * 1024); } while (0)
#define PG8_MMA(ai, bj, At, Bt) do { __builtin_amdgcn_s_setprio(1); _Pragma("unroll") for (int m = 0; m < 4; ++m) _Pragma("unroll") for (int n = 0; n < 2; ++n) _Pragma("unroll") for (int k = 0; k < 2; ++k) \
        acc[ai][bj][m][n] = __builtin_amdgcn_mfma_f32_16x16x32_bf16(Bt[n][k], At[m][k], acc[ai][bj][m][n], 0, 0, 0); __builtin_amdgcn_s_setprio(0); } while (0)
#define PG8_WAIT_V(n) asm volatile("s_waitcnt vmcnt(" #n ")" ::: "memory")
#define PG8_WAIT_L(n) asm volatile("s_waitcnt lgkmcnt(" #n ")" ::: "memory")
#define PG8_BAR __builtin_amdgcn_s_barrier()
#define PG8_SCHED __builtin_amdgcn_sched_barrier(0)
    Unit cur, nxt; int ui = 0;
    if (!S.next(0, cur)) return;
    f32x4 acc[2][2][4][2];
#pragma unroll
    for (int a = 0; a < 2; ++a)
#pragma unroll
        for (int b = 0; b < 2; ++b)
#pragma unroll
            for (int m = 0; m < 4; ++m)
#pragma unroll
                for (int n = 0; n < 2; ++n) acc[a][b][m][n] = (f32x4){0.f, 0.f, 0.f, 0.f};
    bf16x8 At[4][2], B0[2][2], B1[2][2];
    const char* cA = (const char*)(cur.kind ? g.A1 : g.A0) + (size_t)cur.pm * tstep; const char* cB = (const char*)(cur.kind ? g.B1 : g.B0) + (size_t)cur.pn * tstep;
    PG8_STAGE(PG8_SB(0, 0), cB, voffB); PG8_STAGE(PG8_SB(0, 1), cB + hstep, voffB); PG8_STAGE(PG8_SA(0, 0), cA, voffA); PG8_STAGE(PG8_SA(0, 1), cA + hstep, voffA);
    if (wr == 1) PG8_BAR;
    PG8_WAIT_V(2); PG8_BAR;
    PG8_STAGE(PG8_SB(1, 0), cB + kstep, voffB); PG8_STAGE(PG8_SA(1, 0), cA + kstep, voffA); PG8_STAGE(PG8_SB(1, 1), cB + hstep + kstep, voffB);
    PG8_WAIT_V(6); PG8_BAR;
    for (;;) {
        const bool has_next = S.next(ui + 1, nxt);
        E.prefetch(cur, lds + STAGE_BYTES + 512 + wid * 256, tid);
        const char* nA = has_next ? (const char*)(nxt.kind ? g.A1 : g.A0) + (size_t)nxt.pm * tstep : cA; const char* nB = has_next ? (const char*)(nxt.kind ? g.B1 : g.B0) + (size_t)nxt.pn * tstep : cB;
        for (int t = 0; t < nt; t += 2) {
            const bool last = (t == nt - 2);
            const char* a1 = cA + (size_t)(t + 1) * kstep;
            const char* a2 = last ? nA : cA + (size_t)(t + 2) * kstep; const char* b2 = last ? nB : cB + (size_t)(t + 2) * kstep;
            const char* a3 = a2 + kstep; const char* b3 = b2 + kstep;
            PG8_LDB(B0, 0, 0); PG8_LDB(B1, 0, 1); PG8_SCHED; PG8_LDA(At, 0, 0); PG8_STAGE(PG8_SA(1, 1), a1 + hstep, voffA);
            PG8_WAIT_V(8); PG8_WAIT_L(0); PG8_BAR; PG8_MMA(0, 0, At, B0); PG8_MMA(0, 1, At, B1); PG8_BAR; PG8_SCHED;
            PG8_LDA(At, 0, 1); PG8_STAGE(PG8_SB(0, 0), b2, voffB); PG8_STAGE(PG8_SB(0, 1), b2 + hstep, voffB); PG8_STAGE(PG8_SA(0, 0), a2, voffA);
            PG8_WAIT_V(8); PG8_WAIT_L(0); PG8_BAR; PG8_MMA(1, 0, At, B0); PG8_MMA(1, 1, At, B1); PG8_BAR; PG8_SCHED;
            PG8_LDB(B0, 1, 0); PG8_LDB(B1, 1, 1); PG8_SCHED; PG8_LDA(At, 1, 0); PG8_STAGE(PG8_SA(0, 1), a2 + hstep, voffA);
            PG8_WAIT_V(8); PG8_WAIT_L(0); PG8_BAR; PG8_MMA(0, 0, At, B0); PG8_MMA(0, 1, At, B1); PG8_BAR; PG8_SCHED;
            PG8_LDA(At, 1, 1); PG8_STAGE(PG8_SB(1, 0), b3, voffB); PG8_STAGE(PG8_SB(1, 1), b3 + hstep, voffB); PG8_STAGE(PG8_SA(1, 0), a3, voffA);
            PG8_WAIT_V(8); PG8_WAIT_L(0); PG8_BAR; PG8_MMA(1, 0, At, B0); PG8_MMA(1, 1, At, B1); PG8_BAR; PG8_SCHED;
        }
        if (wr == 0) PG8_BAR;
        E(acc, cur, wr, wc, fr, fq);
        if (!has_next) break;
#pragma unroll
        for (int a = 0; a < 2; ++a)
#pragma unroll
            for (int b = 0; b < 2; ++b)
#pragma unroll
                for (int m = 0; m < 4; ++m)
#pragma unroll
                    for (int n = 0; n < 2; ++n) acc[a][b][m][n] = (f32x4){0.f, 0.f, 0.f, 0.f};
        cur = nxt; cA = nA; cB = nB; ++ui;
        if (wr == 1) PG8_BAR;
    }
    PG8_WAIT_V(0);
    PG8_BAR;
#undef PG8_SA
#undef PG8_SB
#undef PG8_STAGE
#undef PG8_LDA
#undef PG8_LDB
#undef PG8_MMA
#undef PG8_WAIT_V
#undef PG8_WAIT_L
#undef PG8_BAR
#undef PG8_SCHED
}
}
using pg8::Unit;

struct Args {
    const float* in[26];
    float* out; unsigned char* ws;
    int ph_lo, ph_hi, use_sync, pad;
};

typedef const __attribute__((address_space(4))) Args* ArgsP;
#define KA ((ArgsP)__builtin_amdgcn_kernarg_segment_ptr())
#define A_IN(k) (KA->in[k])
#define A_OUT (KA->out)
#define A_WS (KA->ws)

struct SchedG1 {
    pg8::TileMap m0, m1; int G, c;
    __device__ __forceinline__ void init(int G_, int c_) { m0.init(NMT, 24); m1.init(4, NMT); G = G_; c = c_; }
    __device__ __forceinline__ bool next(int i, Unit& u) const {
        int L = i * G + c;
        if (L < m0.nwg) { m0.map(L, u.pm, u.pn); u.pn = (u.pn < 8) ? u.pn : u.pn + 4; u.kind = 0; return true; }
        L -= m0.nwg; if (L >= m1.nwg) return false;
        m1.map(L, u.pm, u.pn); u.kind = 1; return true;
    }
};
struct SchedPair {
    pg8::TileMap m0; int G, c;
    __device__ __forceinline__ void init(int nN, int G_, int c_) { m0.init(NMT, nN); G = G_; c = c_; }
    __device__ __forceinline__ bool next(int i, Unit& u) const { const int L = (i >> 1) * G + c; if (L >= m0.nwg) return false; m0.map(L, u.pm, u.pn); u.kind = i & 1; return true; }
};
struct SchedOne {
    pg8::TileMap m0; int G, c;
    __device__ __forceinline__ void init(int nN, int G_, int c_) { m0.init(NMT, nN); G = G_; c = c_; }
    __device__ __forceinline__ bool next(int i, Unit& u) const { const int L = i * G + c; if (L >= m0.nwg) return false; m0.map(L, u.pm, u.pn); u.kind = 0; return true; }
};

#define EPI_PREP int fr_ = fr, fq_ = fq; asm volatile("" : "+v"(fr_), "+v"(fq_)); const int rl_ = wr * 64 + fr_, cl_ = wc * 32 + 8 * fq_;
#define EPI_LOOP_BEGIN \
    _Pragma("unroll") for (int ai = 0; ai < 2; ++ai) _Pragma("unroll") for (int m = 0; m < 4; ++m) { const int rit = ai * 128 + m * 16 + rl_; \
    _Pragma("unroll") for (int bj = 0; bj < 2; ++bj) { const int cit = bj * 128 + cl_; f32x4 v0 = acc[ai][bj][m][0], v1 = acc[ai][bj][m][1];
#define EPI_LOOP_END } }

__device__ __forceinline__ size_t kfrag_off(int row, int col) {
    return ((((size_t)(row >> 5) * 16 + (col >> 6)) * 4 + ((col >> 4) & 3)) * 64 + ((col >> 3) & 1) * 32 + swap23(row & 31)) * 8;
}
__device__ __forceinline__ size_t vfrag_off(int vc, int tok) {
    return (((((size_t)(tok >> 5) * 16 + (vc >> 6)) * 2 + ((vc >> 5) & 1)) * 2 + ((tok >> 4) & 1)) * 64 + ((tok >> 3) & 1) * 32 + swap23(vc & 31)) * 8;
}
struct EpiG1 {
    __device__ __forceinline__ void prefetch(const Unit&, LAS unsigned char*, int) const {}
    __device__ __forceinline__ void operator()(const f32x4 (&acc)[2][2][4][2], const Unit& u, int wr, int wc, int fr, int fq) const {
        EPI_PREP unsigned char* ws = A_WS; float* out = A_OUT;
        if (u.kind == 0) {
            const int t = u.pn >> 2, ct = (u.pn & 3) * 256;
            bf16_t* base;
            if (t == 0) base = (bf16_t*)(ws + WS_Q); else if (t == 1) base = (bf16_t*)(ws + WS_K); else if (t == 3) base = (bf16_t*)(ws + WS_XR); else if (t == 4) base = (bf16_t*)(ws + WS_G);
            else if (t == 5) base = (u.pm < 256) ? (bf16_t*)(out + O_YP) : (bf16_t*)(ws + WS_SGA) - (size_t)NTP * DM;
            else base = (u.pm < 256) ? (bf16_t*)(out + O_YP) + (size_t)NTP * DM : (bf16_t*)(ws + WS_SGR) - (size_t)NTP * DM;
            if (t == 1) {
                EPI_LOOP_BEGIN
                    u32x4 w; w.x = cvtpk(v0[0], v0[1]); w.y = cvtpk(v0[2], v0[3]); w.z = cvtpk(v1[0], v1[1]); w.w = cvtpk(v1[2], v1[3]);
                    *(u32x4*)(base + kfrag_off(u.pm * 256 + rit, ct + cit)) = w;
                EPI_LOOP_END
            } else {
            base += (size_t)u.pm * 256 * DM + ct;
            EPI_LOOP_BEGIN
                u32x4 w; w.x = cvtpk(v0[0], v0[1]); w.y = cvtpk(v0[2], v0[3]); w.z = cvtpk(v1[0], v1[1]); w.w = cvtpk(v1[2], v1[3]);
                *(u32x4*)(base + (size_t)rit * DM + cit) = w;
            EPI_LOOP_END
            }
            if (t == 1 && u.pm < 256 && (u.pm & 15) >= 14) { float* p0 = out + O_KP + ((size_t)(u.pm >> 4) * 512 + ((u.pm & 15) - 14) * 256) * DM + ct;
                EPI_LOOP_BEGIN float* p = p0 + (size_t)rit * DM + cit; *(f32x4*)p = v0; *(f32x4*)(p + 4) = v1; EPI_LOOP_END }
            if (t == 1 && u.pm == 256) { float* p0 = out + O_KS + ct;
                EPI_LOOP_BEGIN if (rit < NTS) { float* p = p0 + (size_t)rit * DM + cit; *(f32x4*)p = v0; *(f32x4*)(p + 4) = v1; } EPI_LOOP_END }
            if (t == 3 && u.pm < 256 && (u.pm & 15) == 15) { float* p0 = out + O_CP + ((size_t)(u.pm >> 4) * 3) * DM + ct;
                EPI_LOOP_BEGIN if (rit >= 253) { float* p = p0 + (size_t)(rit - 253) * DM + cit; *(f32x4*)p = v0; *(f32x4*)(p + 4) = v1; } EPI_LOOP_END }
            if (t == 3 && u.pm == 256) { float* p0 = out + O_CS + ct;
                EPI_LOOP_BEGIN if (rit < NTS && (rit & 15) >= 13) { float* p = p0 + ((size_t)(rit >> 4) * 3 + ((rit & 15) - 13)) * DM + cit; *(f32x4*)p = v0; *(f32x4*)(p + 4) = v1; } EPI_LOOP_END }
        } else {
            bf16_t* VT = (bf16_t*)(ws + WS_VT);
            EPI_LOOP_BEGIN
                u32x4 w; w.x = cvtpk(v0[0], v0[1]); w.y = cvtpk(v0[2], v0[3]); w.z = cvtpk(v1[0], v1[1]); w.w = cvtpk(v1[2], v1[3]);
                *(u32x4*)(VT + vfrag_off(u.pm * 256 + rit, u.pn * 256 + cit)) = w;
            EPI_LOOP_END
            if (u.pn < 256 && (u.pn & 15) >= 14) { float* p0 = out + O_VP + ((size_t)(u.pn >> 4) * 512 + ((u.pn & 15) - 14) * 256) * DM + u.pm * 256;
                EPI_LOOP_BEGIN float* p = p0 + (size_t)cit * DM + rit;
                    p[0] = v0[0]; p[DM] = v0[1]; p[2 * DM] = v0[2]; p[3 * DM] = v0[3]; p[4 * DM] = v1[0]; p[5 * DM] = v1[1]; p[6 * DM] = v1[2]; p[7 * DM] = v1[3]; EPI_LOOP_END }
            if (u.pn == 256) { float* p0 = out + O_VS + u.pm * 256;
                EPI_LOOP_BEGIN if (cit < NTS) { float* p = p0 + (size_t)cit * DM + rit;
                    p[0] = v0[0]; p[DM] = v0[1]; p[2 * DM] = v0[2]; p[3 * DM] = v0[3]; p[4 * DM] = v1[0]; p[5 * DM] = v1[1]; p[6 * DM] = v1[2]; p[7 * DM] = v1[3]; } EPI_LOOP_END }
        }
    }
};

struct EpiP3 {
    __device__ __forceinline__ void prefetch(const Unit& u, LAS unsigned char* dummy, int tid) const {
        const bf16_t* gb = (u.pm < 256) ? (const bf16_t*)(A_OUT + O_YP) + (u.kind ? (size_t)NTP * DM : 0) : (const bf16_t*)(A_WS + (u.kind ? WS_SGR : WS_SGA)) - (size_t)NTP * DM;
        const char* base = (const char*)(gb + (size_t)u.pm * 256 * DM + u.pn * 256);
        asm volatile("" : "+v"(tid));
#pragma unroll
        for (int q = 0; q < 2; ++q) { const int li = tid * 2 + q; __builtin_amdgcn_global_load_lds((const unsigned*)(base + (size_t)(li >> 2) * (DM * 2) + (li & 3) * 128), (LAS unsigned*)dummy, 4, 0, 0); }
    }
    __device__ __forceinline__ void operator()(const f32x4 (&acc)[2][2][4][2], const Unit& u, int wr, int wc, int fr, int fq) const {
        EPI_PREP unsigned char* ws = A_WS; float* out = A_OUT;
        const bf16_t* gb = (u.pm < 256) ? (const bf16_t*)(out + O_YP) + (u.kind ? (size_t)NTP * DM : 0) : (const bf16_t*)(ws + (u.kind ? WS_SGR : WS_SGA)) - (size_t)NTP * DM;
        const size_t off0 = (size_t)u.pm * 256 * DM + u.pn * 256;
        gb += off0; bf16_t* MG = (bf16_t*)(ws + WS_XR) + off0;
#pragma unroll
        for (int ai = 0; ai < 2; ++ai) {
            u32x4 gw[4][2], pw[4][2];
#pragma unroll
            for (int m = 0; m < 4; ++m)
#pragma unroll
                for (int bj = 0; bj < 2; ++bj) { const size_t off = (size_t)(ai * 128 + m * 16 + rl_) * DM + bj * 128 + cl_;
                    gw[m][bj] = *(const u32x4*)(gb + off); if (u.kind) pw[m][bj] = *(const u32x4*)(MG + off); }
#pragma unroll
            for (int m = 0; m < 4; ++m)
#pragma unroll
                for (int bj = 0; bj < 2; ++bj) { const size_t off = (size_t)(ai * 128 + m * 16 + rl_) * DM + bj * 128 + cl_;
                    const f32x4 v0 = acc[ai][bj][m][0], v1 = acc[ai][bj][m][1]; const u32x4 g4 = gw[m][bj];
                    f32x4 a0, a1;
                    a0[0] = sigmoidf_(bflo(g4.x)) * v0[0]; a0[1] = sigmoidf_(bfhi(g4.x)) * v0[1]; a0[2] = sigmoidf_(bflo(g4.y)) * v0[2]; a0[3] = sigmoidf_(bfhi(g4.y)) * v0[3];
                    a1[0] = sigmoidf_(bflo(g4.z)) * v1[0]; a1[1] = sigmoidf_(bfhi(g4.z)) * v1[1]; a1[2] = sigmoidf_(bflo(g4.w)) * v1[2]; a1[3] = sigmoidf_(bfhi(g4.w)) * v1[3];
                    if (u.kind) { const u32x4 p4 = pw[m][bj];
                        a0[0] += bflo(p4.x); a0[1] += bfhi(p4.x); a0[2] += bflo(p4.y); a0[3] += bfhi(p4.y); a1[0] += bflo(p4.z); a1[1] += bfhi(p4.z); a1[2] += bflo(p4.w); a1[3] += bfhi(p4.w); }
                    u32x4 w; w.x = cvtpk(a0[0], a0[1]); w.y = cvtpk(a0[2], a0[3]); w.z = cvtpk(a1[0], a1[1]); w.w = cvtpk(a1[2], a1[3]);
                    *(u32x4*)(MG + off) = w; }
        }
    }
};

struct EpiP4 {
    __device__ __forceinline__ void prefetch(const Unit&, LAS unsigned char*, int) const {}
    __device__ __forceinline__ void operator()(const f32x4 (&acc)[2][2][4][2], const Unit& u, int wr, int wc, int fr, int fq) const {
        EPI_PREP bf16_t* base = (bf16_t*)(A_WS + WS_DELTA) + (size_t)u.pm * 256 * DM + u.pn * 256;
        EPI_LOOP_BEGIN
            u32x4 w; w.x = cvtpk(v0[0], v0[1]); w.y = cvtpk(v0[2], v0[3]); w.z = cvtpk(v1[0], v1[1]); w.w = cvtpk(v1[2], v1[3]);
            *(u32x4*)(base + (size_t)rit * DM + cit) = w;
        EPI_LOOP_END
    }
};

struct EpiP5 {
    __device__ __forceinline__ void prefetch(const Unit&, LAS unsigned char*, int) const {}
    __device__ __forceinline__ void operator()(const f32x4 (&acc)[2][2][4][2], const Unit& u, int wr, int wc, int fr, int fq) const {
        EPI_PREP bf16_t* SC = (bf16_t*)(A_WS + WS_XN) + (size_t)u.pm * 256 * 2048 + u.pn * 256;
        EPI_LOOP_BEGIN
            u32x4 w; w.x = cvtpk(v0[0], v0[1]); w.y = cvtpk(v0[2], v0[3]); w.z = cvtpk(v1[0], v1[1]); w.w = cvtpk(v1[2], v1[3]);
            *(u32x4*)(SC + (size_t)rit * 2048 + cit) = w;
        EPI_LOOP_END
    }
};

__device__ __forceinline__ void row_ld(const float* p, f32x4 (&v)[4], int lane) {
#pragma unroll
    for (int j = 0; j < 4; ++j) v[j] = *(const f32x4*)(p + j * 256 + lane * 4);
}
__device__ __forceinline__ float row_ss(const f32x4 (&v)[4]) { float s = 0.f;
#pragma unroll
    for (int j = 0; j < 4; ++j) s += (v[j][0] * v[j][0] + v[j][1] * v[j][1]) + (v[j][2] * v[j][2] + v[j][3] * v[j][3]);
    return s; }
__device__ __forceinline__ void row_add_bf16(const bf16_t* p, f32x4 (&v)[4], int lane) {
#pragma unroll
    for (int j = 0; j < 4; ++j) { const u32x2 w = *(const u32x2*)(p + j * 256 + lane * 4); v[j][0] += bflo(w.x); v[j][1] += bfhi(w.x); v[j][2] += bflo(w.y); v[j][3] += bfhi(w.y); }
}
__device__ __forceinline__ const float* xrow_ptr(int m) { return (m < NTP) ? A_IN(0) + (size_t)m * DM : A_IN(1) + (size_t)(m - NTP) * DM; }
__device__ __forceinline__ float* yrow_ptr(int m) { return (m < NTP) ? A_OUT + O_YP + (size_t)m * DM : A_OUT + O_YS + (size_t)(m - NTP) * DM; }

__device__ __forceinline__ void p0_transpose_item(const float* W, int K, int N, bf16_t* WT, LAS float* scr, int item, int lane, int nscale = 0) {
    const int nblk = N / 32, kb = item / nblk, nb = item % nblk, k0 = 64 * kb, n0 = 32 * nb;
#pragma unroll 8
    for (int i = 0; i < 32; ++i) { const int kk = 2 * i + (lane >> 5); scr[kk * 33 + (lane & 31)] = W[(size_t)(k0 + kk) * N + n0 + (lane & 31)] * (n0 < nscale ? QSCALE : 1.0f); }
    asm volatile("s_waitcnt lgkmcnt(0)" ::: "memory");
    const int c = lane & 7;
#pragma unroll
    for (int j = 0; j < 4; ++j) { const int n = (lane >> 3) + 8 * j; const LAS float* s = scr + (8 * c) * 33 + n;
        u32x4 o; o.x = cvtpk(s[0 * 33], s[1 * 33]); o.y = cvtpk(s[2 * 33], s[3 * 33]); o.z = cvtpk(s[4 * 33], s[5 * 33]); o.w = cvtpk(s[6 * 33], s[7 * 33]);
        *(u32x4*)(WT + (size_t)(n0 + n) * K + k0 + 8 * c) = o; }
    asm volatile("s_waitcnt lgkmcnt(0)" ::: "memory");
}

__device__ __forceinline__ void p0_prologue(LAS unsigned char* lds, int G, int wave, int lane) {
    unsigned char* ws = A_WS;
    const int gw = blockIdx.x * 8 + wave, NGW = G * 8;
    LAS float* scr = (LAS float*)(lds + wave * 16384);
    constexpr int I_IN = 16 * (INC / 32), I_SQ = 16 * 32, NTR = I_IN + 3 * I_SQ;
    for (int it = gw; it < NTR; it += NGW) {
        int r = it;
        if (r < I_IN) { p0_transpose_item(A_IN(7), DM, INC, (bf16_t*)(ws + WS_WIN), scr, r, lane, 1024); continue; } r -= I_IN;
        if (r < I_SQ) { p0_transpose_item(A_IN(16), DM, DM, (bf16_t*)(ws + WS_WBA), scr, r, lane); continue; } r -= I_SQ;
        if (r < I_SQ) { p0_transpose_item(A_IN(17), DM, DM, (bf16_t*)(ws + WS_WBL), scr, r, lane); continue; } r -= I_SQ;
        p0_transpose_item(A_IN(18), DM, DM, (bf16_t*)(ws + WS_WO), scr, r, lane);
    }
    {
        const float* wq = A_IN(20); bf16_t* wst = (bf16_t*)(ws + WS_WS);
        const int r32 = lane & 31, hi = lane >> 5;
        for (int it = gw; it < 2048; it += NGW) {
            const int hj = it >> 7, kt = (it >> 5) & 3, ct = it & 31, h = hj >> 1, j = hj & 1;
            const float* ap = (j ? A_IN(22) : A_IN(21)) + ((size_t)(h * 128 + kt * 32 + r32)) * 128 + 64 * hi;
            const float* bp = wq + (size_t)(ct * 32 + r32) * 2048 + hj * 128 + 64 * hi;
            f32x16 acc = {};
#pragma unroll
            for (int s4 = 0; s4 < 16; ++s4) { const f32x4 av = *(const f32x4*)(ap + 4 * s4), bv = *(const f32x4*)(bp + 4 * s4);
                acc = __builtin_amdgcn_mfma_f32_32x32x2f32(av[0], bv[0], acc, 0, 0, 0); acc = __builtin_amdgcn_mfma_f32_32x32x2f32(av[1], bv[1], acc, 0, 0, 0);
                acc = __builtin_amdgcn_mfma_f32_32x32x2f32(av[2], bv[2], acc, 0, 0, 0); acc = __builtin_amdgcn_mfma_f32_32x32x2f32(av[3], bv[3], acc, 0, 0, 0); }
#pragma unroll
            for (int r = 0; r < 16; ++r) { const int key = kt * 32 + (r & 3) + 8 * (r >> 2) + 4 * hi;
                wst[(size_t)(key * 16 + hj) * DM + ct * 32 + r32] = (bf16_t)(cvtpk(acc[r], 0.f) & 0xffffu); }
        }
    }
    {
        f32x4 p[4], pn[4];
        if (gw < 2 * NEXP) {
#pragma unroll
            for (int q = 0; q < 4; ++q) p[q] = *(const f32x4*)(((gw >= NEXP) ? A_IN(24) + (size_t)(gw - NEXP) * DM : A_IN(23) + (size_t)gw * DM) + lane * 16 + 4 * q); }
        for (int it = gw; it < 2 * NEXP; it += NGW) {
            const int tb = it >= NEXP, e = it - tb * NEXP, itn = it + NGW;
            if (itn < 2 * NEXP) {
#pragma unroll
                for (int q = 0; q < 4; ++q) pn[q] = *(const f32x4*)(((itn >= NEXP) ? A_IN(24) + (size_t)(itn - NEXP) * DM : A_IN(23) + (size_t)itn * DM) + lane * 16 + 4 * q); }
            unsigned char* dst = ws + (tb ? WS_VB : WS_UB) + (size_t)e * DM + lane * 16;
            float mx = 0.f;
#pragma unroll
            for (int q = 0; q < 4; ++q) mx = fmaxf(mx, fmaxf(fmaxf(fabsf(p[q][0]), fabsf(p[q][1])), fmaxf(fabsf(p[q][2]), fabsf(p[q][3]))));
#pragma unroll
            for (int o = 1; o < 64; o <<= 1) mx = fmaxf(mx, __shfl_xor(mx, o));
            const float step = fmaxf(mx, 1e-30f) * (1.0f / 127.0f), inv = 1.0f / step;
            u32x4 w;
#pragma unroll
            for (int q = 0; q < 4; ++q) {
                const unsigned b0 = (unsigned)(int)rintf(p[q][0] * inv) & 0xffu, b1 = (unsigned)(int)rintf(p[q][1] * inv) & 0xffu, b2 = (unsigned)(int)rintf(p[q][2] * inv) & 0xffu, b3 = (unsigned)(int)rintf(p[q][3] * inv) & 0xffu;
                w[q] = b0 | (b1 << 8) | (b2 << 16) | (b3 << 24); }
            *(u32x4*)dst = w;
            if (lane == 0) ((float*)(ws + (tb ? WS_SV : WS_SU)))[e] = step;
#pragma unroll
            for (int q = 0; q < 4; ++q) p[q] = pn[q];
        }
    }
    {
        const float* gm = A_IN(6); bf16_t* XN = (bf16_t*)(ws + WS_XN);
        for (int m = NTOK + gw; m < ROWS; m += NGW) {
#pragma unroll
            for (int j = 0; j < 2; ++j) *(u32x4*)(XN + (size_t)m * DM + j * 512 + lane * 8) = (u32x4){0u, 0u, 0u, 0u}; }
        f32x4 v[4], vn[4];
        if (gw < NTOK) row_ld(xrow_ptr(gw), v, lane);
        for (int m = gw; m < NTOK; m += NGW) {
            const int mn = m + NGW;
            if (mn < NTOK) row_ld(xrow_ptr(mn), vn, lane);
            bf16_t* orow = XN + (size_t)m * DM;
            const float inv = 1.0f / sqrtf(wave_sum(row_ss(v)) * (1.0f / DM) + EPS);
#pragma unroll
            for (int j = 0; j < 4; ++j) { const f32x4 gg = *(const f32x4*)(gm + j * 256 + lane * 4); const f32x4 y = v[j] * inv * gg;
                u32x2 w; w.x = cvtpk(y[0], y[1]); w.y = cvtpk(y[2], y[3]); *(u32x2*)(orow + j * 256 + lane * 4) = w; }
#pragma unroll
            for (int j = 0; j < 4; ++j) v[j] = vn[j];
        }
    }
    {
        bf16_t* fw = (bf16_t*)(ws + WS_LRUW);
        for (int f = gw; f < 256; f += NGW) {
            const int ks = f & 3, T = (f >> 2) & 1, gate = (f >> 3) & 1, g = f >> 4, i = lane & 31, hi = lane >> 5;
            const int outc = 32 * T + swap23(i);
            const float* W = (gate ? A_IN(13) : A_IN(11)) + (size_t)g * 4096;
            float x[8];
#pragma unroll
            for (int j = 0; j < 8; ++j) x[j] = W[(16 * ks + 8 * hi + j) * 64 + outc];
            u32x4 w; w.x = cvtpk(x[0], x[1]); w.y = cvtpk(x[2], x[3]); w.z = cvtpk(x[4], x[5]); w.w = cvtpk(x[6], x[7]);
            *(u32x4*)(fw + (size_t)f * 512 + lane * 8) = w;
        }
    }
}

constexpr int LR_WF = 0, LR_CW = 16384, LR_CB = LR_CW + 1024, LR_BR = LR_CB + 256, LR_BI = LR_BR + 256, LR_CS = LR_BI + 256, LR_CARRY = LR_CS + 256, LR_SEQ = LR_CARRY + 2048, LR_END = LR_SEQ + 64;

__device__ __forceinline__ void lru_load_consts(LAS unsigned char* lds, int g, int tid) {
    const u32x4* src = (const u32x4*)(A_WS + WS_LRUW + (size_t)g * 16384);
    for (int i = tid; i < 1024; i += 512) ((LAS u32x4*)(lds + LR_WF))[i] = src[i];
    if (tid < 256) ((LAS float*)(lds + LR_CW))[tid] = A_IN(9)[(tid >> 6) * DM + g * 64 + (tid & 63)];
    if (tid < 64) {
        const int c = g * 64 + tid;
        ((LAS float*)(lds + LR_CB))[tid] = A_IN(10)[c]; ((LAS float*)(lds + LR_BR))[tid] = A_IN(12)[c]; ((LAS float*)(lds + LR_BI))[tid] = A_IN(14)[c];
        ((LAS float*)(lds + LR_CS))[tid] = 8.0f * log1pf(expf(-A_IN(15)[c]));
    }
    if (tid < 8) ((LAS unsigned*)(lds + LR_SEQ))[tid] = 0xffffffffu;
}

template <bool SAMPLE>
__device__ __forceinline__ void lru_tile(LAS unsigned char* lds, int lane, int g, size_t rowbase, int tile, int bidx) {
    asm volatile("" : "+v"(lane));
    const int tl = lane & 31, hi = lane >> 5, t = tile * 32 + tl;
    const bf16_t* XR = (const bf16_t*)(A_WS + WS_XR); bf16_t* Gb = (bf16_t*)(A_WS + WS_G);
    const int cbase = g * 64 + 8 * hi;
    float xc[4][8];
    bf16x8 xf[4];
#pragma unroll
    for (int ks = 0; ks < 4; ++ks) {
        const f32x4 b0 = *(const LAS f32x4*)(lds + LR_CB + (16 * ks + 8 * hi) * 4), b1 = *(const LAS f32x4*)(lds + LR_CB + (16 * ks + 8 * hi) * 4 + 16);
#pragma unroll
        for (int j = 0; j < 4; ++j) { xc[ks][j] = b0[j]; xc[ks][4 + j] = b1[j]; }
#pragma unroll
        for (int tap = 0; tap < 4; ++tap) {
            const int rr = t - 3 + tap;
            float xv[8];
            {
                u32x4 w = *(const u32x4*)(XR + (rowbase + (rr < 0 ? 0 : rr)) * DM + cbase + 16 * ks);
                if (rr < 0) w = (u32x4){0u, 0u, 0u, 0u};
                xv[0] = bflo(w.x); xv[1] = bfhi(w.x); xv[2] = bflo(w.y); xv[3] = bfhi(w.y); xv[4] = bflo(w.z); xv[5] = bfhi(w.z); xv[6] = bflo(w.w); xv[7] = bfhi(w.w);
            }
            if (SAMPLE) {
                const float* sp = A_IN(4) + ((size_t)bidx * 3 + (rr < 0 ? 3 + rr : 0)) * DM + cbase + 16 * ks;
                const f32x4 p = *(const f32x4*)sp, q = *(const f32x4*)(sp + 4);
#pragma unroll
                for (int j = 0; j < 4; ++j) { xv[j] = rr < 0 ? p[j] : xv[j]; xv[4 + j] = rr < 0 ? q[j] : xv[4 + j]; }
            }
            const f32x4 w0 = *(const LAS f32x4*)(lds + LR_CW + (tap * 64 + 16 * ks + 8 * hi) * 4), w1 = *(const LAS f32x4*)(lds + LR_CW + (tap * 64 + 16 * ks + 8 * hi) * 4 + 16);
#pragma unroll
            for (int j = 0; j < 4; ++j) { xc[ks][j] += w0[j] * xv[j]; xc[ks][4 + j] += w1[j] * xv[4 + j]; }
        }
        u32x4 w; w.x = cvtpk(xc[ks][0], xc[ks][1]); w.y = cvtpk(xc[ks][2], xc[ks][3]); w.z = cvtpk(xc[ks][4], xc[ks][5]); w.w = cvtpk(xc[ks][6], xc[ks][7]);
        xf[ks] = __builtin_bit_cast(bf16x8, w);
        asm volatile("" ::: "memory");
    }
    float A[32], B[32];
#pragma unroll
    for (int T = 0; T < 2; ++T) {
        f32x16 ar = f32x16{}, ai = f32x16{};
#pragma unroll
        for (int ks = 0; ks < 4; ++ks) {
            const bf16x8 wr_ = *(const LAS bf16x8*)(lds + LR_WF + ((0 * 2 + T) * 4 + ks) * 1024 + lane * 16);
            const bf16x8 wi_ = *(const LAS bf16x8*)(lds + LR_WF + ((1 * 2 + T) * 4 + ks) * 1024 + lane * 16);
            ar = __builtin_amdgcn_mfma_f32_32x32x16_bf16(wr_, xf[ks], ar, 0, 0, 0);
            ai = __builtin_amdgcn_mfma_f32_32x32x16_bf16(wi_, xf[ks], ai, 0, 0, 0);
        }
#pragma unroll
        for (int q = 0; q < 2; ++q) {
            const int ks = 2 * T + q, lo = (16 * ks + 8 * hi) * 4;
            const f32x4 br0 = *(const LAS f32x4*)(lds + LR_BR + lo), br1 = *(const LAS f32x4*)(lds + LR_BR + lo + 16);
            const f32x4 bi0 = *(const LAS f32x4*)(lds + LR_BI + lo), bi1 = *(const LAS f32x4*)(lds + LR_BI + lo + 16);
            const f32x4 cs0 = *(const LAS f32x4*)(lds + LR_CS + lo), cs1 = *(const LAS f32x4*)(lds + LR_CS + lo + 16);
#pragma unroll
            for (int j = 0; j < 8; ++j) {
                const int r = 8 * q + j;
                const float brv = j < 4 ? br0[j & 3] : br1[j & 3], biv = j < 4 ? bi0[j & 3] : bi1[j & 3], csv = j < 4 ? cs0[j & 3] : cs1[j & 3];
                const float rg = sigmoidf_(ar[r] + brv), ig = sigmoidf_(ai[r] + biv);
                const float la = -csv * rg, av = fast_exp2(la * LOG2E);
                const float x2 = 2.0f * la;
                const float em = (x2 > -0.03f) ? -x2 * (1.0f + x2 * (0.5f + x2 * (0.16666667f + x2 * 0.041666668f))) : 1.0f - fast_exp2(x2 * LOG2E);
                A[16 * T + r] = av; B[16 * T + r] = sqrtf(em) * ig * xc[ks][j];
            }
        }
        asm volatile("" ::: "memory");
    }
#define LRU_STEP(CTRL, RM) _Pragma("unroll") for (int c = 0; c < 32; ++c) { \
        const float as_ = __builtin_bit_cast(float, __builtin_amdgcn_update_dpp(__builtin_bit_cast(int, 1.0f), __builtin_bit_cast(int, A[c]), CTRL, RM, 0xF, false)); \
        const float bs_ = __builtin_bit_cast(float, __builtin_amdgcn_update_dpp(0, __builtin_bit_cast(int, B[c]), CTRL, RM, 0xF, false)); \
        B[c] = A[c] * bs_ + B[c]; A[c] = A[c] * as_; }
    LRU_STEP(0x111, 0xF) LRU_STEP(0x112, 0xF) LRU_STEP(0x114, 0xF) LRU_STEP(0x118, 0xF) LRU_STEP(0x142, 0xA)
#undef LRU_STEP
    float hin[32];
    if (SAMPLE) {
        const float* hp = A_IN(5) + (size_t)bidx * DM + cbase;
#pragma unroll
        for (int ks = 0; ks < 4; ++ks) { const f32x4 p = *(const f32x4*)(hp + 16 * ks), q = *(const f32x4*)(hp + 16 * ks + 4);
#pragma unroll
            for (int j = 0; j < 4; ++j) { hin[8 * ks + j] = p[j]; hin[8 * ks + 4 + j] = q[j]; } }
    } else if (tile == 0) {
#pragma unroll
        for (int c = 0; c < 32; ++c) hin[c] = 0.f;
    } else {
        volatile LAS unsigned* sq = (volatile LAS unsigned*)(lds + LR_SEQ) + (tile & 7);
        while (*sq != (unsigned)tile) __builtin_amdgcn_s_sleep(1);
        asm volatile("" ::: "memory");
        const LAS float* cp = (const LAS float*)(lds + LR_CARRY) + (tile & 7) * 64 + 8 * hi;
#pragma unroll
        for (int ks = 0; ks < 4; ++ks) { const f32x4 p = *(const LAS f32x4*)(cp + 16 * ks), q = *(const LAS f32x4*)(cp + 16 * ks + 4);
#pragma unroll
            for (int j = 0; j < 4; ++j) { hin[8 * ks + j] = p[j]; hin[8 * ks + 4 + j] = q[j]; } }
    }
#pragma unroll
    for (int c = 0; c < 32; ++c) B[c] = B[c] + A[c] * hin[c];
    if (!SAMPLE) {
        if (tl == 31) {
            if (tile < 127) {
                LAS float* cp = (LAS float*)(lds + LR_CARRY) + ((tile + 1) & 7) * 64 + 8 * hi;
#pragma unroll
                for (int ks = 0; ks < 4; ++ks) { *(LAS f32x4*)(cp + 16 * ks) = (f32x4){B[8 * ks], B[8 * ks + 1], B[8 * ks + 2], B[8 * ks + 3]};
                    *(LAS f32x4*)(cp + 16 * ks + 4) = (f32x4){B[8 * ks + 4], B[8 * ks + 5], B[8 * ks + 6], B[8 * ks + 7]}; }
            } else {
                float* lp = A_OUT + O_LP + (size_t)bidx * DM + cbase;
#pragma unroll
                for (int ks = 0; ks < 4; ++ks) { *(f32x4*)(lp + 16 * ks) = (f32x4){B[8 * ks], B[8 * ks + 1], B[8 * ks + 2], B[8 * ks + 3]};
                    *(f32x4*)(lp + 16 * ks + 4) = (f32x4){B[8 * ks + 4], B[8 * ks + 5], B[8 * ks + 6], B[8 * ks + 7]}; }
            }
        }
        if (tile < 127) {
            asm volatile("s_waitcnt lgkmcnt(0)" ::: "memory");
            if (lane == 63) *((volatile LAS unsigned*)(lds + LR_SEQ) + ((tile + 1) & 7)) = (unsigned)(tile + 1);
        }
    } else if (tl == 15) {
        float* lp = A_OUT + O_LS + (size_t)bidx * DM + cbase;
#pragma unroll
        for (int ks = 0; ks < 4; ++ks) { *(f32x4*)(lp + 16 * ks) = (f32x4){B[8 * ks], B[8 * ks + 1], B[8 * ks + 2], B[8 * ks + 3]};
            *(f32x4*)(lp + 16 * ks + 4) = (f32x4){B[8 * ks + 4], B[8 * ks + 5], B[8 * ks + 6], B[8 * ks + 7]}; }
    }
    if (!SAMPLE || tl < NST) {
        bf16_t* gp = Gb + (rowbase + t) * DM + cbase;
#pragma unroll
        for (int ks = 0; ks < 4; ++ks) {
            const u32x4 w = *(const u32x4*)(gp + 16 * ks);
            float gv[8]; gv[0] = bflo(w.x); gv[1] = bfhi(w.x); gv[2] = bflo(w.y); gv[3] = bfhi(w.y); gv[4] = bflo(w.z); gv[5] = bfhi(w.z); gv[6] = bflo(w.w); gv[7] = bfhi(w.w);
            float o[8];
#pragma unroll
            for (int j = 0; j < 8; ++j) o[j] = B[8 * ks + j] * gelu_tanh(gv[j]);
            u32x4 ow; ow.x = cvtpk(o[0], o[1]); ow.y = cvtpk(o[2], o[3]); ow.z = cvtpk(o[4], o[5]); ow.w = cvtpk(o[6], o[7]);
            *(u32x4*)(gp + 16 * ks) = ow;
        }
    }
}

constexpr int P2_Q = 20608;
constexpr int AT_TAB = 24576;
__device__ __forceinline__ void attn_unit(LAS unsigned char* lds, int lane, int b, int c, int h) {
    const int r32 = lane & 31, hi = lane >> 5, kr = swap23(r32);
    const bf16_t* Q = (const bf16_t*)(A_WS + WS_Q); const bf16_t* Kb = (const bf16_t*)(A_WS + WS_K); const bf16_t* VT = (const bf16_t*)(A_WS + WS_VT); bf16_t* O = (bf16_t*)(A_WS + WS_XN);
    const size_t row0 = (size_t)b * SEQ + (size_t)c * 64;
    bf16x8 qf[2][4];
#pragma unroll
    for (int qb = 0; qb < 2; ++qb)
#pragma unroll
        for (int ks = 0; ks < 4; ++ks) qf[qb][ks] = *(const bf16x8*)(Q + (row0 + qb * 32 + r32) * DM + h * 64 + ks * 16 + hi * 8);
    f32x16 o[2][2];
#pragma unroll
    for (int i = 0; i < 2; ++i)
#pragma unroll
        for (int j = 0; j < 2; ++j) o[i][j] = f32x16{};
    float mrow[2] = {-1e30f, -1e30f}, lrow[2] = {0.f, 0.f};
    const LAS float* tab = (const LAS float*)(lds + AT_TAB) + h * 320;
    const float cfar = tab[256];
    const int sb0 = (c >= 8 ? c - 8 : 0) * 2, sb1 = c * 2 + 1;
    const bf16_t* kbase = Kb + ((size_t)b * 128 * 16 + h) * 4 * 512 + lane * 8;
    const bf16_t* vbase = VT + ((size_t)b * 128 * 16 + h) * 4 * 512 + lane * 8;
    bf16x8 kf[4], vf[2][2];
#pragma unroll
    for (int ks = 0; ks < 4; ++ks) kf[ks] = *(const bf16x8*)(kbase + (size_t)sb0 * 32768 + ks * 512);
#pragma unroll
    for (int db = 0; db < 2; ++db)
#pragma unroll
        for (int s = 0; s < 2; ++s) vf[db][s] = *(const bf16x8*)(vbase + (size_t)sb0 * 32768 + (db * 2 + s) * 512);
    for (int sb = sb0; sb <= sb1; ++sb) {
        const int sbn = sb < sb1 ? sb + 1 : sb;
        f32x16 S[2];
#pragma unroll
        for (int qb = 0; qb < 2; ++qb) { S[qb] = f32x16{};
#pragma unroll
            for (int ks = 0; ks < 4; ++ks) S[qb] = __builtin_amdgcn_mfma_f32_32x32x16_bf16(kf[ks], qf[qb][ks], S[qb], 0, 0, 0); }
        asm volatile("" ::: "memory");
#pragma unroll
        for (int ks = 0; ks < 4; ++ks) kf[ks] = *(const bf16x8*)(kbase + (size_t)sbn * 32768 + ks * 512);
        const int delta = c - (sb >> 1), rb = sb & 1;
        if (delta >= 3) {
#pragma unroll
            for (int qb = 0; qb < 2; ++qb)
#pragma unroll
                for (int r = 0; r < 16; ++r) S[qb][r] += cfar;
        } else {
#pragma unroll
            for (int qb = 0; qb < 2; ++qb) {
                const LAS float* tp = tab + (64 * delta + 32 * qb + r32 + 128 - 32 * rb - 8 * hi - 23);
#pragma unroll
                for (int r = 0; r < 16; ++r) S[qb][r] += tp[23 - (16 * (r >> 3) + (r & 7))];
            }
        }
        float rm[2];
#pragma unroll
        for (int qb = 0; qb < 2; ++qb) { float mx = S[qb][0];
#pragma unroll
            for (int r = 1; r < 16; ++r) mx = fmaxf(mx, S[qb][r]);
            rm[qb] = plswap_max(mx); }
        if (__any((rm[0] > mrow[0] + 8.0f) || (rm[1] > mrow[1] + 8.0f))) {
#pragma unroll
            for (int qb = 0; qb < 2; ++qb) { const float mn = fmaxf(mrow[qb], rm[qb]); const float al = fast_exp2(mrow[qb] - mn); lrow[qb] *= al; mrow[qb] = mn;
#pragma unroll
                for (int r = 0; r < 16; ++r) { o[0][qb][r] *= al; o[1][qb][r] *= al; } }
        }
        bf16x8 pf[2][2];
#pragma unroll
        for (int qb = 0; qb < 2; ++qb) { float sum = 0.f;
#pragma unroll
            for (int r = 0; r < 16; ++r) { S[qb][r] = fast_exp2(S[qb][r] - mrow[qb]); sum += S[qb][r]; }
            lrow[qb] += sum;
#pragma unroll
            for (int s = 0; s < 2; ++s) { u32x4 w; w.x = cvtpk(S[qb][8 * s], S[qb][8 * s + 1]); w.y = cvtpk(S[qb][8 * s + 2], S[qb][8 * s + 3]); w.z = cvtpk(S[qb][8 * s + 4], S[qb][8 * s + 5]); w.w = cvtpk(S[qb][8 * s + 6], S[qb][8 * s + 7]);
                pf[qb][s] = __builtin_bit_cast(bf16x8, w); } }
#pragma unroll
        for (int db = 0; db < 2; ++db)
#pragma unroll
            for (int qb = 0; qb < 2; ++qb)
#pragma unroll
                for (int s = 0; s < 2; ++s) o[db][qb] = __builtin_amdgcn_mfma_f32_32x32x16_bf16(vf[db][s], pf[qb][s], o[db][qb], 0, 0, 0);
        asm volatile("" ::: "memory");
#pragma unroll
        for (int db = 0; db < 2; ++db)
#pragma unroll
            for (int s = 0; s < 2; ++s) vf[db][s] = *(const bf16x8*)(vbase + (size_t)sbn * 32768 + (db * 2 + s) * 512);
    }
#pragma unroll
    for (int qb = 0; qb < 2; ++qb) { const float inv = fast_rcp(plswap_add(lrow[qb]));
        bf16_t* op = O + (row0 + qb * 32 + r32) * DM + h * 64 + 8 * hi;
#pragma unroll
        for (int db = 0; db < 2; ++db)
#pragma unroll
            for (int s = 0; s < 2; ++s) { u32x4 w;
                w.x = cvtpk(o[db][qb][8 * s] * inv, o[db][qb][8 * s + 1] * inv); w.y = cvtpk(o[db][qb][8 * s + 2] * inv, o[db][qb][8 * s + 3] * inv);
                w.z = cvtpk(o[db][qb][8 * s + 4] * inv, o[db][qb][8 * s + 5] * inv); w.w = cvtpk(o[db][qb][8 * s + 6] * inv, o[db][qb][8 * s + 7] * inv);
                *(u32x4*)(op + 32 * db + 16 * s) = w; } }
}

constexpr int AS_P = 45056;
__device__ __forceinline__ void attn_sample_task(LAS unsigned char* lds, int wave, int lane, int task) {
    const int bs = task >> 6, h = (task >> 2) & 15, qg = task & 3;
    const bf16_t* Q = (const bf16_t*)(A_WS + WS_Q); bf16_t* O = (bf16_t*)(A_WS + WS_XN);
    const float* ck = A_IN(2); const float* cv = A_IN(3); const float* kn = A_OUT + O_KS; const float* vn = A_OUT + O_VS;
    LAS float* pb = (LAS float*)(lds + AS_P + wave * 9472);
    LAS float* qs = pb + 4 * 528;
    const LAS float* tab = (const LAS float*)(lds + AT_TAB) + h * 320;
#pragma unroll
    for (int i = 0; i < 4; ++i) qs[i * 64 + lane] = bflo((unsigned)Q[((size_t)NTP + bs * 16 + qg * 4 + i) * DM + h * 64 + lane]);
    asm volatile("s_waitcnt lgkmcnt(0)" ::: "memory");
#pragma unroll 1
    for (int it = 0; it < 9; ++it) {
        const int key = it * 64 + lane; const bool valid = key < 528;
        const float* kp = !valid ? ck : (key < 512 ? ck + (((size_t)bs * 512 + key) * 16 + h) * 64 : kn + ((size_t)bs * 16 + (key - 512)) * DM + h * 64);
        float d[4] = {0.f, 0.f, 0.f, 0.f};
        f32x4 kv[16];
#pragma unroll
        for (int d4 = 0; d4 < 16; ++d4) kv[d4] = *(const f32x4*)(kp + 4 * d4);
#pragma unroll
        for (int d4 = 0; d4 < 16; ++d4) {
#pragma unroll
            for (int i = 0; i < 4; ++i) { const f32x4 qq = *(const LAS f32x4*)(qs + i * 64 + 4 * d4); d[i] += (kv[d4][0] * qq[0] + kv[d4][1] * qq[1]) + (kv[d4][2] * qq[2] + kv[d4][3] * qq[3]); } }
        int rel = 512 + qg * 4 - key;
        if (valid) {
#pragma unroll
            for (int i = 0; i < 4; ++i) { int r = rel + i; r = r > 128 ? 128 : r; pb[i * 528 + key] = d[i] + tab[r + 128]; } }
    }
    asm volatile("s_waitcnt lgkmcnt(0)" ::: "memory");
#pragma unroll 1
    for (int i = 0; i < 4; ++i) {
        float mx = -1e30f;
#pragma unroll 1
        for (int key = lane; key < 528; key += 64) mx = fmaxf(mx, pb[i * 528 + key]);
#pragma unroll
        for (int o = 1; o < 64; o <<= 1) mx = fmaxf(mx, __shfl_xor(mx, o));
        float sum = 0.f;
#pragma unroll 1
        for (int key = lane; key < 528; key += 64) { const float pv = fast_exp2(pb[i * 528 + key] - mx); pb[i * 528 + key] = pv; sum += pv; }
        sum = wave_sum(sum); const float inv = 1.0f / sum;
#pragma unroll 1
        for (int key = lane; key < 528; key += 64) pb[i * 528 + key] *= inv;
    }
    asm volatile("s_waitcnt lgkmcnt(0)" ::: "memory");
    float acc[4] = {0.f, 0.f, 0.f, 0.f};
#pragma unroll 1
    for (int k0 = 0; k0 < 528; k0 += 16) {
        float vv[16];
#pragma unroll
        for (int kk = 0; kk < 16; ++kk) { const int key = k0 + kk; vv[kk] = k0 < 512 ? cv[(((size_t)bs * 512 + key) * 16 + h) * 64 + lane] : vn[((size_t)bs * 16 + (key - 512)) * DM + h * 64 + lane]; }
#pragma unroll
        for (int kk = 0; kk < 16; ++kk) {
#pragma unroll
            for (int i = 0; i < 4; ++i) acc[i] += pb[i * 528 + k0 + kk] * vv[kk]; }
    }
#pragma unroll
    for (int i = 0; i < 4; ++i) O[((size_t)NTP + bs * 16 + qg * 4 + i) * DM + h * 64 + lane] = (bf16_t)(cvtpk(acc[i], 0.f) & 0xffffu);
    asm volatile("s_waitcnt lgkmcnt(0)" ::: "memory");
}

__device__ __forceinline__ void p2_phase(LAS unsigned char* lds, int G, int tid, int wave, int lane) {
    for (int i = tid; i < 16 * 320; i += 512) { const int h = i / 320, j = i % 320; ((LAS float*)(lds + AT_TAB))[i] = A_IN(8)[h * 257 + (j > 256 ? 256 : j)] * LOG2E; }
    for (int u = blockIdx.x; u < 256 + 16; u += G) {
        __syncthreads();
        if (u < 256) {
            const int b = u >> 4, g = u & 15;
            lru_load_consts(lds, g, tid);
            __syncthreads();
            for (int tile = wave; tile < 128; tile += 8) lru_tile<false>(lds, lane, g, (size_t)b * SEQ, tile, b);
        } else {
            const int g = u - 256;
            lru_load_consts(lds, g, tid);
            __syncthreads();
            lru_tile<true>(lds, lane, g, (size_t)NTP + wave * 16, 0, wave);
        }
    }
    if (tid == 0) *(volatile LAS int*)(lds + P2_Q) = 0;
    __syncthreads();
    const int NGW = G * 8;
    int nS = 0; for (int t = blockIdx.x; t < 512; t += G) ++nS;
    for (;;) {
        int j = 0;
        if (lane == 0) j = __hip_atomic_fetch_add((LAS int*)(lds + P2_Q), 1, __ATOMIC_RELAXED, __HIP_MEMORY_SCOPE_WORKGROUP);
        j = __builtin_amdgcn_readfirstlane(j);
        if (j < nS) { attn_sample_task(lds, wave, lane, blockIdx.x + G * j); continue; }
        j -= nS;
        const int u = blockIdx.x * 8 + (j & 7) + NGW * (j >> 3);
        if (u >= NB * 64 * 16) break;
        const int c = u & 63, h = (u >> 6) & 15, b = u >> 10;
        attn_unit(lds, lane, b, c, h);
    }
}

__device__ __forceinline__ void p4b_phase(int G, int wave, int lane) {
    const int gw = blockIdx.x * 8 + wave, NGW = G * 8;
    const float* gm = A_IN(19); bf16_t* XT = (bf16_t*)(A_WS + WS_Q); unsigned char* XQ = A_WS + WS_XQ; float* SX = (float*)(A_WS + WS_SX);
    const bf16_t* DL = (const bf16_t*)(A_WS + WS_DELTA);
    f32x4 v[4], vn[4];
    if (gw < NTOK) { row_ld(xrow_ptr(gw), v, lane); row_add_bf16(DL + (size_t)gw * DM, v, lane); }
    for (int m = gw; m < NTOK; m += NGW) {
        const int mn = m + NGW;
        if (mn < NTOK) { row_ld(xrow_ptr(mn), vn, lane); row_add_bf16(DL + (size_t)mn * DM, vn, lane); }
        bf16_t* orow = XT + (size_t)m * DM;
        const float inv = 1.0f / sqrtf(wave_sum(row_ss(v)) * (1.0f / DM) + EPS);
        float mx = 0.f;
#pragma unroll
        for (int j = 0; j < 4; ++j) { const f32x4 gg = *(const f32x4*)(gm + j * 256 + lane * 4); v[j] = v[j] * inv * gg;
            u32x2 w; w.x = cvtpk(v[j][0], v[j][1]); w.y = cvtpk(v[j][2], v[j][3]); *(u32x2*)(orow + j * 256 + lane * 4) = w;
            mx = fmaxf(mx, fmaxf(fmaxf(fabsf(v[j][0]), fabsf(v[j][1])), fmaxf(fabsf(v[j][2]), fabsf(v[j][3])))); }
#pragma unroll
        for (int o = 1; o < 64; o <<= 1) mx = fmaxf(mx, __shfl_xor(mx, o));
        const float step = fmaxf(mx, 1e-30f) * (1.0f / 127.0f), qi = 1.0f / step;
#pragma unroll
        for (int j = 0; j < 4; ++j) {
            const unsigned b0 = (unsigned)(int)rintf(v[j][0] * qi) & 0xffu, b1 = (unsigned)(int)rintf(v[j][1] * qi) & 0xffu, b2 = (unsigned)(int)rintf(v[j][2] * qi) & 0xffu, b3 = (unsigned)(int)rintf(v[j][3] * qi) & 0xffu;
            *(unsigned*)(XQ + (size_t)m * DM + j * 256 + lane * 4) = b0 | (b1 << 8) | (b2 << 16) | (b3 << 24); }
        if (lane == 0) SX[m] = step;
#pragma unroll
        for (int j = 0; j < 4; ++j) v[j] = vn[j];
    }
}

__device__ __forceinline__ int f2key(float f) { const int b = __float_as_int(f); return b ^ ((b >> 31) & 0x7fffffff); }
__device__ __forceinline__ float key2f(int k) { return __int_as_float(k ^ ((k >> 31) & 0x7fffffff)); }
#define CE_DESC(x, y) do { const int hi_ = max(x, y); y = min(x, y); x = hi_; } while (0)
#define CE_ASC(x, y)  do { const int lo_ = min(x, y); y = max(x, y); x = lo_; } while (0)
__device__ __forceinline__ void bitonic_sort16_desc(int (&a)[16]) {
#pragma unroll
    for (int k = 2; k <= 16; k <<= 1)
#pragma unroll
        for (int j = k >> 1; j > 0; j >>= 1)
#pragma unroll
            for (int i = 0; i < 16; ++i) { const int l = i ^ j; if (l > i) { if ((i & k) == 0) CE_DESC(a[i], a[l]); else CE_ASC(a[i], a[l]); } }
}
__device__ __forceinline__ void bitonic_merge16_desc(int (&a)[16]) {
#pragma unroll
    for (int j = 8; j > 0; j >>= 1)
#pragma unroll
        for (int i = 0; i < 16; ++i) { const int l = i ^ j; if (l > i) CE_DESC(a[i], a[l]); }
}
__device__ __forceinline__ void top16_merge(int (&T)[16], const int (&S)[16]) {
#pragma unroll
    for (int i = 0; i < 16; ++i) T[i] = max(T[i], S[15 - i]);
    bitonic_merge16_desc(T);
}
#define INS16(L, x) do { int x_ = (x); _Pragma("unroll") for (int j_ = 0; j_ < 16; ++j_) { const int hi_ = max(L[j_], x_); x_ = min(L[j_], x_); L[j_] = hi_; } } while (0)

constexpr size_t WS_PART = WS_XN;
constexpr int CT_U = 64, CT_V = 64 + 8 * 64;
constexpr int P6_TOKB = 128, P6_NITEM = NTOK / P6_TOKB, P6_TPW = P6_TOKB / 8;
constexpr size_t WS_CQ = WS_XR, WS_CS = WS_XR + 16 * MiB;
constexpr int P6_IDX = 0;
constexpr int P6_E = 0, P6_C = 8192, P6_ITEM = 16384;

__device__ __forceinline__ void p6a_phase(LAS unsigned char* lds, int G, int wave, int lane) {
    const int gw = blockIdx.x * 8 + wave, NGW = G * 8;
    const bf16_t* SC = (const bf16_t*)(A_WS + WS_XN);
    int* SELE = (int*)(A_WS + WS_SELE); float* SELG = (float*)(A_WS + WS_SELG);
    LAS int* idxb = (LAS int*)(lds + P6_IDX + wave * 4096);
    const int tl = lane >> 4, hh = (lane >> 1) & 7, half = lane & 1;
    for (int grp = gw; grp < NTOK / 4; grp += NGW) {
        const int tok = grp * 4 + tl;
        const bf16_t* sp = SC + (size_t)tok * 2048 + (lane & 15);
        int L[16];
#pragma unroll
        for (int j = 0; j < 16; ++j) L[j] = (int)0x80000000;
        {
            float sa[16], sb_[16];
#pragma unroll
            for (int e = 0; e < 16; ++e) sa[e] = bflo((unsigned)sp[16 * e]);
#pragma unroll
            for (int c0 = 0; c0 < 128; c0 += 32) {
#pragma unroll
                for (int e = 0; e < 16; ++e) sb_[e] = bflo((unsigned)sp[16 * (c0 + 16 + e)]);
                { int S[16];
#pragma unroll
                  for (int e = 0; e < 16; ++e) S[e] = (f2key(sa[e]) & ~127) | (c0 + e);
                  bitonic_sort16_desc(S);
                  if (c0 == 0) {
#pragma unroll
                      for (int e = 0; e < 16; ++e) L[e] = S[e]; } else top16_merge(L, S); }
                if (c0 + 32 < 128) {
#pragma unroll
                    for (int e = 0; e < 16; ++e) sa[e] = bflo((unsigned)sp[16 * (c0 + 32 + e)]); }
                { int S[16];
#pragma unroll
                  for (int e = 0; e < 16; ++e) S[e] = (f2key(sb_[e]) & ~127) | (c0 + 16 + e);
                  bitonic_sort16_desc(S);
                  top16_merge(L, S); }
            }
        }
#pragma unroll
        for (int j = 0; j < 16; ++j) idxb[lane * 16 + j] = L[j] & 127;
        float va[16], vb[16];
#pragma unroll
        for (int j = 0; j < 16; ++j) { const int own = L[j] & ~127, oth = __shfl_xor(own, 1); va[j] = key2f(half ? oth : own); vb[j] = key2f(half ? own : oth); }
        int C[16];
#pragma unroll
        for (int j = 0; j < 16; ++j) C[j] = (int)0x80000000;
        {   int S[16];
            S[0] = (f2key(va[0] + vb[0]) & ~255) | 0;
            S[1] = (f2key(va[0] + vb[1]) & ~255) | 1;
            S[2] = (f2key(va[0] + vb[2]) & ~255) | 2;
            S[3] = (f2key(va[0] + vb[3]) & ~255) | 3;
            S[4] = (f2key(va[0] + vb[4]) & ~255) | 4;
            S[5] = (f2key(va[0] + vb[5]) & ~255) | 5;
            S[6] = (f2key(va[0] + vb[6]) & ~255) | 6;
            S[7] = (f2key(va[0] + vb[7]) & ~255) | 7;
            S[8] = (f2key(va[0] + vb[8]) & ~255) | 8;
            S[9] = (f2key(va[0] + vb[9]) & ~255) | 9;
            S[10] = (f2key(va[0] + vb[10]) & ~255) | 10;
            S[11] = (f2key(va[0] + vb[11]) & ~255) | 11;
            S[12] = (f2key(va[0] + vb[12]) & ~255) | 12;
            S[13] = (f2key(va[0] + vb[13]) & ~255) | 13;
            S[14] = (f2key(va[0] + vb[14]) & ~255) | 14;
            S[15] = (f2key(va[0] + vb[15]) & ~255) | 15;
            bitonic_sort16_desc(S);
#pragma unroll
            for (int q = 0; q < 16; ++q) C[q] = S[q]; }
        {   int S[16];
            S[0] = (f2key(va[1] + vb[0]) & ~255) | 16;
            S[1] = (f2key(va[1] + vb[1]) & ~255) | 17;
            S[2] = (f2key(va[1] + vb[2]) & ~255) | 18;
            S[3] = (f2key(va[1] + vb[3]) & ~255) | 19;
            S[4] = (f2key(va[1] + vb[4]) & ~255) | 20;
            S[5] = (f2key(va[1] + vb[5]) & ~255) | 21;
            S[6] = (f2key(va[1] + vb[6]) & ~255) | 22;
            S[7] = (f2key(va[1] + vb[7]) & ~255) | 23;
            S[8] = (f2key(va[2] + vb[0]) & ~255) | 32;
            S[9] = (f2key(va[2] + vb[1]) & ~255) | 33;
            S[10] = (f2key(va[2] + vb[2]) & ~255) | 34;
            S[11] = (f2key(va[2] + vb[3]) & ~255) | 35;
            S[12] = (f2key(va[2] + vb[4]) & ~255) | 36;
            S[13] = (f2key(va[3] + vb[0]) & ~255) | 48;
            S[14] = (f2key(va[3] + vb[1]) & ~255) | 49;
            S[15] = (f2key(va[3] + vb[2]) & ~255) | 50;
            bitonic_sort16_desc(S);
            top16_merge(C, S); }
        {   int S[16];
            S[0] = (f2key(va[3] + vb[3]) & ~255) | 51;
            S[1] = (f2key(va[4] + vb[0]) & ~255) | 64;
            S[2] = (f2key(va[4] + vb[1]) & ~255) | 65;
            S[3] = (f2key(va[4] + vb[2]) & ~255) | 66;
            S[4] = (f2key(va[5] + vb[0]) & ~255) | 80;
            S[5] = (f2key(va[5] + vb[1]) & ~255) | 81;
            S[6] = (f2key(va[6] + vb[0]) & ~255) | 96;
            S[7] = (f2key(va[6] + vb[1]) & ~255) | 97;
            S[8] = (f2key(va[7] + vb[0]) & ~255) | 112;
            S[9] = (f2key(va[7] + vb[1]) & ~255) | 113;
            S[10] = (f2key(va[8] + vb[0]) & ~255) | 128;
            S[11] = (f2key(va[9] + vb[0]) & ~255) | 144;
            S[12] = (f2key(va[10] + vb[0]) & ~255) | 160;
            S[13] = (f2key(va[11] + vb[0]) & ~255) | 176;
            S[14] = (f2key(va[12] + vb[0]) & ~255) | 192;
            S[15] = (f2key(va[13] + vb[0]) & ~255) | 208;
            bitonic_sort16_desc(S);
            top16_merge(C, S); }
        {   int S[16];
            S[0] = (f2key(va[14] + vb[0]) & ~255) | 224;
            S[1] = (f2key(va[15] + vb[0]) & ~255) | 240;
            S[2] = (int)0x80000000;
            S[3] = (int)0x80000000;
            S[4] = (int)0x80000000;
            S[5] = (int)0x80000000;
            S[6] = (int)0x80000000;
            S[7] = (int)0x80000000;
            S[8] = (int)0x80000000;
            S[9] = (int)0x80000000;
            S[10] = (int)0x80000000;
            S[11] = (int)0x80000000;
            S[12] = (int)0x80000000;
            S[13] = (int)0x80000000;
            S[14] = (int)0x80000000;
            S[15] = (int)0x80000000;
            bitonic_sort16_desc(S);
            top16_merge(C, S); }
        const float mx = key2f(C[0] & ~255);
        float ev[16], sum = 0.f;
#pragma unroll
        for (int j = 0; j < 16; ++j) { ev[j] = __expf(key2f(C[j] & ~255) - mx); sum += ev[j]; }
        const float inv = 1.0f / sum;
        asm volatile("s_waitcnt lgkmcnt(0)" ::: "memory");
        int eo[8]; float go[8];
#pragma unroll
        for (int s = 0; s < 8; ++s) {
            int c_lo = C[s], c_hi = C[8 + s]; float e_lo = ev[s], e_hi = ev[8 + s];
            asm volatile("" : "+v"(c_lo), "+v"(c_hi), "+v"(e_lo), "+v"(e_hi));
            const int cc = half ? c_hi : c_lo; go[s] = (half ? e_hi : e_lo) * inv;
            const int ij = cc & 255, i1 = idxb[(lane & ~1) * 16 + (ij >> 4)], i2 = idxb[(lane | 1) * 16 + (ij & 15)];
            eo[s] = i1 * 128 + i2;
        }
        int* ep = SELE + (size_t)tok * 128 + hh * 16 + half * 8; float* gp = SELG + (size_t)tok * 128 + hh * 16 + half * 8;
        *(u32x4*)ep = (u32x4){(unsigned)eo[0], (unsigned)eo[1], (unsigned)eo[2], (unsigned)eo[3]}; *(u32x4*)(ep + 4) = (u32x4){(unsigned)eo[4], (unsigned)eo[5], (unsigned)eo[6], (unsigned)eo[7]};
        *(f32x4*)gp = (f32x4){go[0], go[1], go[2], go[3]}; *(f32x4*)(gp + 4) = (f32x4){go[4], go[5], go[6], go[7]};
        asm volatile("s_waitcnt lgkmcnt(0)" ::: "memory");
    }
}

__device__ __forceinline__ float dot2bf(unsigned a, unsigned b, float c) { return __builtin_amdgcn_fdot2_f32_bf16(__builtin_bit_cast(bf16x2_t, a), __builtin_bit_cast(bf16x2_t, b), c, false); }
__device__ __forceinline__ unsigned xcc_id() { return (unsigned)__builtin_amdgcn_s_getreg((3 << 11) | 20) & 0xFu; }
__device__ __forceinline__ float dpp_sum16(float v) {
    v += __builtin_bit_cast(float, __builtin_amdgcn_update_dpp(0, __builtin_bit_cast(int, v), 0xB1, 0xF, 0xF, true));
    v += __builtin_bit_cast(float, __builtin_amdgcn_update_dpp(0, __builtin_bit_cast(int, v), 0x4E, 0xF, 0xF, true));
    v += __builtin_bit_cast(float, __builtin_amdgcn_update_dpp(0, __builtin_bit_cast(int, v), 0x141, 0xF, 0xF, true));
    v += __builtin_bit_cast(float, __builtin_amdgcn_update_dpp(0, __builtin_bit_cast(int, v), 0x140, 0xF, 0xF, true));
    return v;
}
__device__ __forceinline__ bool p6_claim(LAS unsigned char* lds, unsigned* cnt, int tid, int& ring, int home, int& slice, int& item) {
    for (;;) {
        if (ring >= 8) return false;
        slice = (home + ring) & 7;
        __syncthreads();
        if (tid == 0) *(volatile LAS int*)(lds + P6_ITEM) = (int)__hip_atomic_fetch_add(cnt + 64 * slice, 1u, __ATOMIC_RELAXED, __HIP_MEMORY_SCOPE_AGENT);
        __syncthreads();
        item = *(volatile LAS int*)(lds + P6_ITEM);
        if (item < P6_NITEM) return true;
        ++ring;
    }
}

__device__ __forceinline__ float ub0(unsigned w) { return (float)(w & 0xffu); }
__device__ __forceinline__ float ub1(unsigned w) { return (float)((w >> 8) & 0xffu); }
__device__ __forceinline__ float ub2(unsigned w) { return (float)((w >> 16) & 0xffu); }
__device__ __forceinline__ float ub3(unsigned w) { return (float)(w >> 24); }
__device__ __forceinline__ float dpp_sum8(float v) {
    v += __builtin_bit_cast(float, __builtin_amdgcn_update_dpp(0, __builtin_bit_cast(int, v), 0xB1, 0xF, 0xF, true));
    v += __builtin_bit_cast(float, __builtin_amdgcn_update_dpp(0, __builtin_bit_cast(int, v), 0x4E, 0xF, 0xF, true));
    v += __builtin_bit_cast(float, __builtin_amdgcn_update_dpp(0, __builtin_bit_cast(int, v), 0x141, 0xF, 0xF, true));
    return v;
}
__device__ __forceinline__ int dpp_isum8(int v) {
    v += __builtin_amdgcn_update_dpp(0, v, 0xB1, 0xF, 0xF, true);
    v += __builtin_amdgcn_update_dpp(0, v, 0x4E, 0xF, 0xF, true);
    v += __builtin_amdgcn_update_dpp(0, v, 0x141, 0xF, 0xF, true);
    return v;
}
__device__ __forceinline__ void p6b_phase(LAS unsigned char* lds, int tid, int wave, int lane) {
    const unsigned char* XQ = A_WS + WS_XQ; const unsigned char* UB = A_WS + WS_UB; const float* SX = (const float*)(A_WS + WS_SX);
    const int* SELE = (const int*)(A_WS + WS_SELE); float* PART = (float*)(A_WS + WS_PART);
    unsigned* cnt = (unsigned*)(A_WS + WS_CTL) + CT_U;
    const int i8 = lane & 7, grp = lane >> 3, home = (int)(xcc_id() & 7u);
    LAS int* eb = (LAS int*)(lds + P6_E + wave * 1024);
    int ring = 0, slice, item;
    while (p6_claim(lds, cnt, tid, ring, home, slice, item)) {
        const int tok0 = item * P6_TOKB + wave * P6_TPW;
        int e0 = SELE[(size_t)tok0 * 128 + lane], e1 = SELE[(size_t)tok0 * 128 + 64 + lane];
#pragma unroll 2
        for (int ti = 0; ti < P6_TPW; ++ti) {
            const int tok = tok0 + ti;
            LAS int* ebt = eb + (ti & 1) * 128;
            ebt[lane] = e0; ebt[64 + lane] = e1;
            if (ti < P6_TPW - 1) { e0 = SELE[(size_t)(tok + 1) * 128 + lane]; e1 = SELE[(size_t)(tok + 1) * 128 + 64 + lane]; }
            const u32x4 xq = *(const u32x4*)(XQ + (size_t)tok * DM + slice * 128 + i8 * 16);
            const int x0 = (int)xq.x, x1 = (int)xq.y, x2 = (int)xq.z, x3 = (int)xq.w;
            const float sx = SX[tok];
            const unsigned char* ub = UB + slice * 128 + i8 * 16;
            asm volatile("s_waitcnt lgkmcnt(0)" ::: "memory");
            u32x4 uv[16];
#pragma unroll
            for (int q = 0; q < 16; ++q) { const int e = ebt[16 * grp + q]; uv[q] = *(const u32x4*)(ub + (size_t)e * DM); }
            int res0 = 0, res1 = 0;
#pragma unroll
            for (int q = 0; q < 16; ++q) {
                const int a0 = (int)uv[q].x, a1 = (int)uv[q].y, a2 = (int)uv[q].z, a3 = (int)uv[q].w;
                int d = __builtin_amdgcn_sdot4(a0, x0, 0, false); d = __builtin_amdgcn_sdot4(a1, x1, d, false); d = __builtin_amdgcn_sdot4(a2, x2, d, false); d = __builtin_amdgcn_sdot4(a3, x3, d, false);
                d = dpp_isum8(d);
                if (q < 8) res0 = (i8 == q) ? d : res0; else res1 = (i8 == (q - 8)) ? d : res1;
            }
            float* pp = PART + ((size_t)slice * NTOK + tok) * 128 + 16 * grp + i8;
            pp[0] = (float)res0 * sx; pp[8] = (float)res1 * sx;
        }
    }
}

__device__ __forceinline__ void p6m_phase(int G, int wave, int lane) {
    const int gw = blockIdx.x * 8 + wave, NGW = G * 8;
    const float* SU = (const float*)(A_WS + WS_SU); const float* SV = (const float*)(A_WS + WS_SV);
    const int* SELE = (const int*)(A_WS + WS_SELE); const float* SELG = (const float*)(A_WS + WS_SELG); const float* PART = (const float*)(A_WS + WS_PART);
    unsigned char* CQ = A_WS + WS_CQ; float* CS = (float*)(A_WS + WS_CS);
    for (int tok = gw; tok < NTOK; tok += NGW) {
        float a0 = 0.f, a1 = 0.f;
#pragma unroll
        for (int j = 0; j < 8; ++j) { const float* pp = PART + ((size_t)j * NTOK + tok) * 128; a0 += pp[lane]; a1 += pp[64 + lane]; }
        const int e0 = SELE[(size_t)tok * 128 + lane], e1 = SELE[(size_t)tok * 128 + 64 + lane];
        const float c0 = SELG[(size_t)tok * 128 + lane] * gelu_tanh(a0 * SU[e0]) * SV[e0], c1 = SELG[(size_t)tok * 128 + 64 + lane] * gelu_tanh(a1 * SU[e1]) * SV[e1];
        float mx = fmaxf(fabsf(c0), fabsf(c1));
#pragma unroll
        for (int o = 1; o < 64; o <<= 1) mx = fmaxf(mx, __shfl_xor(mx, o));
        const float cstep = fmaxf(mx, 1e-30f) * (1.0f / 127.0f), cinv = 1.0f / cstep;
        CQ[(size_t)tok * 128 + lane] = (unsigned char)((int)rintf(c0 * cinv) & 0xff); CQ[(size_t)tok * 128 + 64 + lane] = (unsigned char)((int)rintf(c1 * cinv) & 0xff);
        if (lane == 0) CS[tok] = cstep;
    }
}

__device__ __forceinline__ void p6c_phase(LAS unsigned char* lds, int tid, int wave, int lane) {
    const unsigned char* VB = A_WS + WS_VB; const int* SELE = (const int*)(A_WS + WS_SELE);
    const unsigned char* CQ = A_WS + WS_CQ; const float* CS = (const float*)(A_WS + WS_CS);
    unsigned* cnt = (unsigned*)(A_WS + WS_CTL) + CT_V;
    const int i8 = lane & 7, grp = lane >> 3, home = (int)(xcc_id() & 7u);
    LAS int* eb = (LAS int*)(lds + P6_E + wave * 1024);
    LAS int* cbb = (LAS int*)(lds + P6_C + wave * 512);
    int ring = 0, slice, item;
    while (p6_claim(lds, cnt, tid, ring, home, slice, item)) {
        const int tok0 = item * P6_TOKB + wave * P6_TPW;
        int e0 = SELE[(size_t)tok0 * 128 + lane], e1 = SELE[(size_t)tok0 * 128 + 64 + lane];
        int cw = ((const int*)(CQ + (size_t)tok0 * 128))[lane & 31];
        float cstep = CS[tok0];
#pragma unroll 2
        for (int ti = 0; ti < P6_TPW; ++ti) {
            const int tok = tok0 + ti;
            LAS int* ebt = eb + (ti & 1) * 128; LAS int* cbt = cbb + (ti & 1) * 32;
            ebt[lane] = e0; ebt[64 + lane] = e1; if (lane < 32) cbt[lane] = cw;
            const float cs = cstep;
            if (ti < P6_TPW - 1) { e0 = SELE[(size_t)(tok + 1) * 128 + lane]; e1 = SELE[(size_t)(tok + 1) * 128 + 64 + lane]; cw = ((const int*)(CQ + (size_t)(tok + 1) * 128))[lane & 31]; cstep = CS[tok + 1]; }
            bf16_t* pr = (bf16_t*)(A_WS + WS_PEER) + (size_t)tok * DM + slice * 128 + i8 * 16;
            const unsigned char* vb = VB + slice * 128 + i8 * 16;
            asm volatile("s_waitcnt lgkmcnt(0)" ::: "memory");
            u32x4 vv[16];
#pragma unroll
            for (int q = 0; q < 16; ++q) { const int e = ebt[16 * grp + q]; vv[q] = *(const u32x4*)(vb + (size_t)e * DM); }
            int acc[16];
#pragma unroll
            for (int r = 0; r < 16; ++r) acc[r] = 0;
#pragma unroll
            for (int a4 = 0; a4 < 4; ++a4) {
                const int cq = cbt[4 * grp + a4];
#pragma unroll
                for (int d = 0; d < 4; ++d) {
                    const unsigned ra = vv[4 * a4][d], rb = vv[4 * a4 + 1][d], rc = vv[4 * a4 + 2][d], rd = vv[4 * a4 + 3][d];
                    const unsigned lo = __builtin_amdgcn_perm(rb, ra, 0x05010400u), hi = __builtin_amdgcn_perm(rb, ra, 0x07030602u);
                    const unsigned lo2 = __builtin_amdgcn_perm(rd, rc, 0x05010400u), hi2 = __builtin_amdgcn_perm(rd, rc, 0x07030602u);
                    const unsigned t0 = __builtin_amdgcn_perm(lo2, lo, 0x05040100u), t1 = __builtin_amdgcn_perm(lo2, lo, 0x07060302u);
                    const unsigned t2 = __builtin_amdgcn_perm(hi2, hi, 0x05040100u), t3 = __builtin_amdgcn_perm(hi2, hi, 0x07060302u);
                    acc[4 * d + 0] = __builtin_amdgcn_sdot4((int)t0, cq, acc[4 * d + 0], false); acc[4 * d + 1] = __builtin_amdgcn_sdot4((int)t1, cq, acc[4 * d + 1], false);
                    acc[4 * d + 2] = __builtin_amdgcn_sdot4((int)t2, cq, acc[4 * d + 2], false); acc[4 * d + 3] = __builtin_amdgcn_sdot4((int)t3, cq, acc[4 * d + 3], false);
                }
            }
#pragma unroll
            for (int r = 0; r < 16; ++r) {
                acc[r] += __builtin_amdgcn_update_dpp(0, acc[r], 0x128, 0xF, 0xF, true);
                acc[r] += __shfl_xor(acc[r], 16);
                { auto rr = __builtin_amdgcn_permlane32_swap((unsigned)acc[r], (unsigned)acc[r], false, false); acc[r] = (int)rr[0] + (int)rr[1]; }
            }
            if (lane < 8) {
                u32x4 w0, w1;
                w0.x = cvtpk((float)acc[0] * cs, (float)acc[1] * cs); w0.y = cvtpk((float)acc[2] * cs, (float)acc[3] * cs); w0.z = cvtpk((float)acc[4] * cs, (float)acc[5] * cs); w0.w = cvtpk((float)acc[6] * cs, (float)acc[7] * cs);
                w1.x = cvtpk((float)acc[8] * cs, (float)acc[9] * cs); w1.y = cvtpk((float)acc[10] * cs, (float)acc[11] * cs); w1.z = cvtpk((float)acc[12] * cs, (float)acc[13] * cs); w1.w = cvtpk((float)acc[14] * cs, (float)acc[15] * cs);
                *(u32x4*)pr = w0; *(u32x4*)(pr + 8) = w1;
            }
        }
    }
}

__device__ __forceinline__ void p6d_phase(int G, int wave, int lane) {
    const int gw = blockIdx.x * 8 + wave, NGW = G * 8;
    const float* gf = A_IN(25);
    const bf16_t* DL = (const bf16_t*)(A_WS + WS_DELTA); const bf16_t* PR = (const bf16_t*)(A_WS + WS_PEER);
    f32x4 v[4], vn[4];
    if (gw < NTOK) { row_ld(xrow_ptr(gw), v, lane); row_add_bf16(DL + (size_t)gw * DM, v, lane); row_add_bf16(PR + (size_t)gw * DM, v, lane); }
    for (int m = gw; m < NTOK; m += NGW) {
        const int mn = m + NGW;
        if (mn < NTOK) { row_ld(xrow_ptr(mn), vn, lane); row_add_bf16(DL + (size_t)mn * DM, vn, lane); row_add_bf16(PR + (size_t)mn * DM, vn, lane); }
        float* yr = yrow_ptr(m);
        const float inv = 1.0f / sqrtf(wave_sum(row_ss(v)) * (1.0f / DM) + EPS);
#pragma unroll
        for (int j = 0; j < 4; ++j) { const f32x4 gg = *(const f32x4*)(gf + j * 256 + lane * 4); *(f32x4*)(yr + j * 256 + lane * 4) = v[j] * inv * gg; }
#pragma unroll
        for (int j = 0; j < 4; ++j) v[j] = vn[j];
    }
}

#define XB_TMO      128
#define XB_XCNT(j)  (256  + 64 * (j))
#define XB_XSUB(j)  (1280 + 64 * (j))
#define XB_XGEN(j)  (2304 + 64 * (j))
#define XB_TOP      3328
#define XB_TOPGEN   3392
#define XB_SPIN_CAP (1u << 22)
constexpr int CW_BAR = 2048;
constexpr int LDS_MISC = 131072 + 64;
__device__ __forceinline__ unsigned xb_ld(unsigned* p)              { return __hip_atomic_load(p, __ATOMIC_RELAXED, __HIP_MEMORY_SCOPE_AGENT); }
__device__ __forceinline__ unsigned xb_add(unsigned* p, unsigned v) { return __hip_atomic_fetch_add(p, v, __ATOMIC_RELAXED, __HIP_MEMORY_SCOPE_AGENT); }
#define XB_SPIN(cond, bar) do { unsigned _sp = 0; while (cond) { __builtin_amdgcn_s_sleep(1); \
    if ((++_sp & 255u) == 0u) { if (xb_ld(&(bar)[XB_TMO])) break; if (_sp > XB_SPIN_CAP) { atomicAdd(&(bar)[XB_TMO], 1u); break; } } } } while (0)
struct XcdBarrier { unsigned* bar; unsigned x; volatile LAS unsigned* st; };
__device__ __forceinline__ XcdBarrier xcd_barrier_post(unsigned* bar, volatile LAS unsigned* st) {
    XcdBarrier b; b.bar = bar; b.x = (unsigned)__builtin_amdgcn_s_getreg((3 << 11) | 20) & 0xFu; b.st = st;
    if (threadIdx.x == 0) (void)xb_add(&bar[XB_XCNT(b.x)], 1u);
    return b;
}
__device__ __forceinline__ void xcd_barrier_complete(unsigned* bar, unsigned x, unsigned& nloc, unsigned& nx) {
    const unsigned G = gridDim.x * gridDim.y * gridDim.z;
    unsigned sum, cnt, mine, sp = 0u;
    for (;;) {
        sum = 0u; cnt = 0u; mine = 0u;
#pragma unroll
        for (unsigned j = 0; j < 16; ++j) { const unsigned c = xb_ld(&bar[XB_XCNT(j)]); sum += c; cnt += (c > 0u) ? 1u : 0u; mine = (j == x) ? c : mine; }
        if (sum == G) break;
        __builtin_amdgcn_s_sleep(1);
        if ((++sp & 255u) == 0u) { if (xb_ld(&bar[XB_TMO])) break; if (sp > XB_SPIN_CAP) { atomicAdd(&bar[XB_TMO], 1u); break; } }
    }
    nloc = mine > 0u ? mine : 1u; nx = cnt > 0u ? cnt : 1u;
}
__device__ __forceinline__ void xcd_barrier(const XcdBarrier& b) {
    asm volatile("s_waitcnt vmcnt(0)" ::: "memory");
    __syncthreads();
    if (threadIdx.x == 0) {
        unsigned* bar = b.bar;
        __builtin_amdgcn_s_waitcnt(0);
        unsigned nloc = b.st[0], nx = b.st[1];
        if (nloc == 0u) { xcd_barrier_complete(bar, b.x, nloc, nx); b.st[0] = nloc; b.st[1] = nx; }
        const unsigned old = xb_add(&bar[XB_XSUB(b.x)], 1u);
        const unsigned gen = old / nloc;
        if (old + 1u == (gen + 1u) * nloc) {
            __builtin_amdgcn_fence(__ATOMIC_RELEASE, "agent");
            asm volatile("s_waitcnt vmcnt(0)" ::: "memory");
            const unsigned og = xb_add(&bar[XB_TOP], 1u);
            const unsigned tg = og / nx;
            if (og + 1u == (tg + 1u) * nx) xb_add(&bar[XB_TOPGEN], 1u);
            else XB_SPIN(xb_ld(&bar[XB_TOPGEN]) == tg, bar);
            __builtin_amdgcn_fence(__ATOMIC_ACQUIRE, "agent");
            xb_add(&bar[XB_XGEN(b.x)], 1u);
            asm volatile("s_waitcnt vmcnt(0)" ::: "memory");
        } else {
            XB_SPIN(xb_ld(&bar[XB_XGEN(b.x)]) == gen, bar);
            __builtin_amdgcn_fence(__ATOMIC_ACQUIRE, "agent");
            asm volatile("s_waitcnt vmcnt(0)" ::: "memory");
        }
    }
    __syncthreads();
}

__global__ void __launch_bounds__(512, 2) hybrid_fwd(Args a) {
    extern __shared__ __attribute__((aligned(16))) unsigned char lds_raw[];
    LAS unsigned char* lds = (LAS unsigned char*)lds_raw;
    const int tid = threadIdx.x, lane = tid & 63, wave = __builtin_amdgcn_readfirstlane(tid >> 6), G = gridDim.x;
    cg::grid_group grid = cg::this_grid();
    unsigned char* ws = A_WS;
    if (tid < 2) ((volatile LAS unsigned*)(lds + LDS_MISC))[tid] = 0u;
    __syncthreads();
    XcdBarrier xbar; xbar.bar = (unsigned*)(ws + WS_CTL) + CW_BAR; xbar.x = 0; xbar.st = nullptr;
    if (KA->use_sync) xbar = xcd_barrier_post((unsigned*)(ws + WS_CTL) + CW_BAR, (volatile LAS unsigned*)(lds + LDS_MISC));
#define IN(k) (KA->ph_lo <= (k) && (k) < KA->ph_hi)
#define SEAM(k) do { if (KA->use_sync && IN(k) && IN((k) + 1)) { if ((k) == 0) grid.sync(); else xcd_barrier(xbar); } } while (0)
    if (IN(0)) { p0_prologue(lds, G, wave, lane); }
    SEAM(0);
    if (IN(1)) {
        pg8::Gemm g{(const bf16_t*)(ws + WS_XN), (const bf16_t*)(ws + WS_WIN), (const bf16_t*)(ws + WS_WIN) + (size_t)2048 * DM, (const bf16_t*)(ws + WS_XN), DM};
        SchedG1 S; S.init(G, blockIdx.x); EpiG1 E;
        pg8::gemm_phase(lds, g, S, E);
    }
    SEAM(1);
    if (IN(2)) { p2_phase(lds, G, tid, wave, lane); }
    SEAM(2);
    if (IN(3)) {
        pg8::Gemm g{(const bf16_t*)(ws + WS_XN), (const bf16_t*)(ws + WS_WBA), (const bf16_t*)(ws + WS_G), (const bf16_t*)(ws + WS_WBL), DM};
        SchedPair S; S.init(4, G, blockIdx.x); EpiP3 E;
        pg8::gemm_phase(lds, g, S, E);
    }
    SEAM(3);
    if (IN(4)) {
        pg8::Gemm g{(const bf16_t*)(ws + WS_XR), (const bf16_t*)(ws + WS_WO), (const bf16_t*)(ws + WS_XR), (const bf16_t*)(ws + WS_WO), DM};
        SchedOne S; S.init(4, G, blockIdx.x); EpiP4 E;
        pg8::gemm_phase(lds, g, S, E);
    }
    SEAM(4);
    if (IN(5)) { p4b_phase(G, wave, lane); }
    SEAM(5);
    if (IN(6)) {
        pg8::Gemm g{(const bf16_t*)(ws + WS_Q), (const bf16_t*)(ws + WS_WS), (const bf16_t*)(ws + WS_Q), (const bf16_t*)(ws + WS_WS), DM};
        SchedOne S; S.init(8, G, blockIdx.x); EpiP5 E;
        pg8::gemm_phase(lds, g, S, E);
    }
    SEAM(6);
    if (IN(7)) { p6a_phase(lds, G, wave, lane); }
    SEAM(7);
    if (IN(8)) { p6b_phase(lds, tid, wave, lane); }
    SEAM(8);
    if (IN(9)) { p6m_phase(G, wave, lane); }
    SEAM(9);
    if (IN(10)) { p6c_phase(lds, tid, wave, lane); }
    SEAM(10);
    if (IN(11)) { p6d_phase(G, wave, lane); }
#undef IN
#undef SEAM
}

#ifndef N_LAUNCH_MODE
#define N_LAUNCH_MODE 1
#endif
constexpr int NPH = 12;
extern "C" void kernel_launch(void* const* d_in, const int* in_sizes, int n_in, void* d_out, int out_size, void* d_ws, size_t ws_size, hipStream_t stream) {
    static int grid = 0;
    if (grid == 0) {
        if (n_in != 26 || (size_t)out_size != O_END || ws_size < WS_END) { fprintf(stderr, "kernel_launch: unexpected sizes n_in %d out %d ws %zu (need %zu)\n", n_in, out_size, ws_size, (size_t)WS_END); grid = -1; return; }
        int dev = 0, cus = 0, per_cu = 0;
        (void)hipGetDevice(&dev); (void)hipDeviceGetAttribute(&cus, hipDeviceAttributeMultiprocessorCount, dev);
        (void)hipFuncSetAttribute((const void*)hybrid_fwd, hipFuncAttributeMaxDynamicSharedMemorySize, LDS_BYTES);
        (void)hipOccupancyMaxActiveBlocksPerMultiprocessor(&per_cu, (const void*)hybrid_fwd, 512, LDS_BYTES);
        if (per_cu < 1) { fprintf(stderr, "kernel_launch: occupancy query says %d blocks per CU\n", per_cu); per_cu = 1; }
        grid = cus;
        (void)hipGetLastError();
    }
    if (grid < 0) return;
    (void)hipMemsetAsync((char*)d_ws + WS_CTL, 0, 32768, stream);
    Args a{};
    for (int i = 0; i < 26; ++i) a.in[i] = (const float*)d_in[i];
    a.out = (float*)d_out; a.ws = (unsigned char*)d_ws;
    if (N_LAUNCH_MODE == 1) {
        a.ph_lo = 0; a.ph_hi = NPH; a.use_sync = 1;
        void* args[] = {&a};
        hipError_t e = hipLaunchCooperativeKernel((const void*)hybrid_fwd, dim3(grid), dim3(512), args, LDS_BYTES, stream);
        if (e != hipSuccess) fprintf(stderr, "cooperative launch failed: %s (grid %d)\n", hipGetErrorString(e), grid);
    } else {
        for (int p = 0; p < NPH; ++p) { a.ph_lo = p; a.ph_hi = p + 1; a.use_sync = 0; hipLaunchKernelGGL(hybrid_fwd, dim3(grid), dim3(512), LDS_BYTES, stream, a); }
    }
}
```

```cpp
#include <hip/hip_runtime.h>
#include <hip/hip_cooperative_groups.h>
#include <cstdint>
#include <cstdio>
namespace cg = cooperative_groups;

#define LAS __attribute__((address_space(3)))
typedef unsigned short bf16_t;
typedef short bf16x8 __attribute__((ext_vector_type(8)));
typedef float f32x4 __attribute__((ext_vector_type(4)));
typedef float f32x2 __attribute__((ext_vector_type(2)));
typedef float f32x16 __attribute__((ext_vector_type(16)));
typedef unsigned u32x4 __attribute__((ext_vector_type(4)));
typedef unsigned u32x2 __attribute__((ext_vector_type(2)));
typedef __bf16 bf16x2_t __attribute__((ext_vector_type(2)));

constexpr int DM = 1024, SEQ = 4096, NB = 16, NTP = NB * SEQ, NSB = 8, NST = 16, NTS = NSB * NST, NTOK = NTP + NTS;
constexpr int ROWS = 65792, NMT = 257;
constexpr int INC = 7168, NEXP = 16384;
constexpr float EPS = 1e-6f, LOG2E = 1.4426950408889634f;
constexpr float QSCALE = 0.125f * LOG2E;

constexpr size_t MiB = 1u << 20;
constexpr size_t BUF = (size_t)ROWS * DM * 2;
constexpr size_t WS_CTL = 0;
constexpr size_t WS_WIN = 1 * MiB;
constexpr size_t WS_WBA = 16 * MiB, WS_WBL = 18 * MiB, WS_WO = 20 * MiB, WS_WS = 22 * MiB;
constexpr size_t WS_LRUW = 26 * MiB;
constexpr size_t WS_SGA = 27 * MiB, WS_SGR = 27 * MiB + 512 * 1024;
constexpr size_t WS_SU = 26 * MiB + 512 * 1024, WS_SV = 26 * MiB + 640 * 1024;
constexpr size_t WS_SX = 26 * MiB + 704 * 1024;
constexpr size_t WS_UB = 28 * MiB, WS_VB = 60 * MiB;
constexpr size_t WS_Q = 92 * MiB;
constexpr size_t WS_XN = WS_Q + BUF;
constexpr size_t WS_K = WS_XN + BUF;
constexpr size_t WS_VT = WS_K + BUF;
constexpr size_t WS_XR = WS_VT + BUF;
constexpr size_t WS_G = WS_XR + BUF;
constexpr size_t WS_END = WS_G + BUF;
constexpr size_t WS_DELTA = WS_VT;
constexpr size_t WS_PEER = WS_Q;
constexpr size_t WS_SELE = WS_G, WS_SELG = WS_G + (size_t)NTOK * 512, WS_XQ = WS_G + (size_t)NTOK * 1024;

constexpr size_t O_YP = 0, O_YS = O_YP + (size_t)NTP * DM, O_KP = O_YS + (size_t)NTS * DM, O_VP = O_KP + (size_t)NB * 512 * DM,
                 O_CP = O_VP + (size_t)NB * 512 * DM, O_LP = O_CP + (size_t)NB * 3 * DM, O_KS = O_LP + (size_t)NB * DM, O_VS = O_KS + (size_t)NTS * DM,
                 O_CS = O_VS + (size_t)NTS * DM, O_LS = O_CS + (size_t)NSB * 3 * DM, O_END = O_LS + (size_t)NSB * DM;

constexpr int LDS_BYTES = 135168;

__device__ __forceinline__ unsigned cvtpk(float lo, float hi) { f32x2 v = {lo, hi}; bf16x2_t b = __builtin_convertvector(v, bf16x2_t); return __builtin_bit_cast(unsigned, b); }
__device__ __forceinline__ float bflo(unsigned u) { return __uint_as_float(u << 16); }
__device__ __forceinline__ float bfhi(unsigned u) { return __uint_as_float(u & 0xffff0000u); }
__device__ __forceinline__ float fast_exp2(float x) { return __builtin_amdgcn_exp2f(x); }
__device__ __forceinline__ float fast_rcp(float x) { return __builtin_amdgcn_rcpf(x); }
__device__ __forceinline__ float sigmoidf_(float z) { return fast_rcp(1.0f + fast_exp2(-z * LOG2E)); }
__device__ __forceinline__ float gelu_tanh(float x) { const float u = x + 0.044715f * x * x * x; return x * fast_rcp(1.0f + fast_exp2(-1.5957691216f * LOG2E * u)); }
__device__ __forceinline__ float wave_sum(float v) {
#pragma unroll
    for (int o = 1; o < 64; o <<= 1) v += __shfl_xor(v, o);
    return v;
}
__device__ __forceinline__ int swap23(int i) { return (i & ~12) | ((i & 4) << 1) | ((i & 8) >> 1); }
__device__ __forceinline__ float plswap_max(float m) { auto rr = __builtin_amdgcn_permlane32_swap(__float_as_uint(m), __float_as_uint(m), false, false); return fmaxf(__uint_as_float(rr[0]), __uint_as_float(rr[1])); }
__device__ __forceinline__ float plswap_add(float m) { auto rr = __builtin_amdgcn_permlane32_swap(__float_as_uint(m), __float_as_uint(m), false, false); return __uint_as_float(rr[0]) + __uint_as_float(rr[1]); }

namespace pg8 {
constexpr int BM = 256, BK = 64, HALF = 128, HTB = HALF * BK * 2, STAGE_BYTES = 8 * HTB, NXCD = 8, WGM = 8;
__host__ __device__ __forceinline__ int lds_byte(int r, int c) { const int st = (r >> 4) * 2 + (c >> 5), rr = r & 15, cc = c & 31, ob = rr * 64 + cc * 2; return st * 1024 + (ob ^ (((ob >> 9) & 1) << 5)); }
__host__ __device__ __forceinline__ void stage_rc(int b, int& R, int& C) { const int st = b / 1024, sb = b % 1024, swz = sb ^ (((sb >> 9) & 1) << 5); R = (st >> 1) * 16 + swz / 64; C = (st & 1) * 32 + (swz % 64) / 2; }
__host__ __device__ __forceinline__ int perm32(int rho) { const int n = rho >> 4, i = rho & 15; return 8 * (i >> 2) + 4 * n + (i & 3); }

struct Unit { int pm, pn, kind; };
struct Gemm { const bf16_t* A0; const bf16_t* B0; const bf16_t* A1; const bf16_t* B1; int K; };

struct TileMap {
    int nM, nN, nwg;
    __device__ __forceinline__ void init(int nM_, int nN_) { nM = nM_; nN = nN_; nwg = nM * nN; }
    __device__ __forceinline__ void map(int L, int& pm, int& pn) const {
        int wgid = L; { const int q = nwg / NXCD, r = nwg % NXCD, xcd = wgid % NXCD, off = wgid / NXCD; wgid = (xcd < r ? xcd * (q + 1) : r * (q + 1) + (xcd - r) * q) + off; }
        const int nig = WGM * nN, gid = wgid / nig, fm = gid * WGM, gsz = (nM - fm) < WGM ? (nM - fm) : WGM;
        pm = fm + ((wgid % nig) % gsz); pn = (wgid % nig) / gsz;
    }
};

template <class Epi, class Sched>
__device__ __forceinline__ void gemm_phase(LAS unsigned char* lds, const Gemm g, const Sched& S, const Epi& E) {
    const int tid = threadIdx.x, wid = __builtin_amdgcn_readfirstlane(tid >> 6), lane = tid & 63, wr = wid >> 2, wc = wid & 3, fr = lane & 15, fq = lane >> 4;
    const int K = g.K, nt = K / BK;
    unsigned voffA[2], voffB[2];
#pragma unroll
    for (int i = 0; i < 2; ++i) { int R, C; stage_rc(tid * 16 + i * 8192, R, C); const int Rb = (R & ~31) + perm32(R & 31);
        voffA[i] = (unsigned)(R * K + C) * 2u; voffB[i] = (unsigned)(Rb * K + C) * 2u; }
    const size_t kstep = (size_t)(BK * 2);
    const size_t hstep = (size_t)HALF * K * 2;
    const size_t tstep = 2 * hstep;
    const unsigned ldsw = (unsigned)wid * 1024u;
    const int aoff = lds_byte(wr * 64 + fr, fq * 8), boff = lds_byte(wc * 32 + fr, fq * 8);
#define PG8_SA(b, h) (((b) * 2 + (h)) * HTB)
#define PG8_SB(b, h) ((4 + (b) * 2 + (h)) * HTB)
#define PG8_STAGE(bufoff, gbase, voff) do { _Pragma("unroll") for (int _i = 0; _i < 2; ++_i) \
        __builtin_amdgcn_global_load_lds((const unsigned*)((const char*)(gbase) + (voff)[_i]), (LAS unsigned*)(lds + (bufoff) + ldsw + _i * 8192), 16, 0, 0); } while (0)
#define PG8_LDA(dst, b, h) do { _Pragma("unroll") for (int m = 0; m < 4; ++m) _Pragma("unroll") for (int k = 0; k < 2; ++k) dst[m][k] = *(const LAS bf16x8*)(lds + PG8_SA(b, h) + aoff + m * 2048 + k * 1024); } while (0)
#define PG8_LDB(dst, b, h) do { _Pragma("unroll") for (int n = 0; n < 2; ++n) _Pragma("unroll") for (int k = 0; k < 2; ++k) dst[n][k] = *(const LAS bf16x8*)(lds + PG8_SB(b, h) + boff + n * 2048 + k * 1024); } while (0)
#define PG8_MMA(ai, bj, At, Bt) do { __builtin_amdgcn_s_setprio(1); _Pragma("unroll") for (int m = 0; m < 4; ++m) _Pragma("unroll") for (int n = 0; n < 2; ++n) _Pragma("unroll") for (int k = 0; k < 2; ++k) \
        acc[ai][bj][m][n] = __builtin_amdgcn_mfma_f32_16x16x32_bf16(Bt[n][k], At[m][k], acc[ai][bj][m][n], 0, 0, 0); __builtin_amdgcn_s_setprio(0); } while (0)
#define PG8_WAIT_V(n) asm volatile("s_waitcnt vmcnt(" #n ")" ::: "memory")
#define PG8_WAIT_L(n) asm volatile("s_waitcnt lgkmcnt(" #n ")" ::: "memory")
#define PG8_BAR __builtin_amdgcn_s_barrier()
#define PG8_SCHED __builtin_amdgcn_sched_barrier(0)
    Unit cur, nxt; int ui = 0;
    if (!S.next(0, cur)) return;
    f32x4 acc[2][2][4][2];
#pragma unroll
    for (int a = 0; a < 2; ++a)
#pragma unroll
        for (int b = 0; b < 2; ++b)
#pragma unroll
            for (int m = 0; m < 4; ++m)
#pragma unroll
                for (int n = 0; n < 2; ++n) acc[a][b][m][n] = (f32x4){0.f, 0.f, 0.f, 0.f};
    bf16x8 At[4][2], B0[2][2], B1[2][2];
    const char* cA = (const char*)(cur.kind ? g.A1 : g.A0) + (size_t)cur.pm * tstep; const char* cB = (const char*)(cur.kind ? g.B1 : g.B0) + (size_t)cur.pn * tstep;
    PG8_STAGE(PG8_SB(0, 0), cB, voffB); PG8_STAGE(PG8_SB(0, 1), cB + hstep, voffB); PG8_STAGE(PG8_SA(0, 0), cA, voffA); PG8_STAGE(PG8_SA(0, 1), cA + hstep, voffA);
    if (wr == 1) PG8_BAR;
    PG8_WAIT_V(2); PG8_BAR;
    PG8_STAGE(PG8_SB(1, 0), cB + kstep, voffB); PG8_STAGE(PG8_SA(1, 0), cA + kstep, voffA); PG8_STAGE(PG8_SB(1, 1), cB + hstep + kstep, voffB);
    PG8_WAIT_V(6); PG8_BAR;
    for (;;) {
        const bool has_next = S.next(ui + 1, nxt);
        E.prefetch(cur, lds + STAGE_BYTES + 512 + wid * 256, tid);
        const char* nA = has_next ? (const char*)(nxt.kind ? g.A1 : g.A0) + (size_t)nxt.pm * tstep : cA; const char* nB = has_next ? (const char*)(nxt.kind ? g.B1 : g.B0) + (size_t)nxt.pn * tstep : cB;
        for (int t = 0; t < nt; t += 2) {
            const bool last = (t == nt - 2);
            const char* a1 = cA + (size_t)(t + 1) * kstep;
            const char* a2 = last ? nA : cA + (size_t)(t + 2) * kstep; const char* b2 = last ? nB : cB + (size_t)(t + 2) * kstep;
            const char* a3 = a2 + kstep; const char* b3 = b2 + kstep;
            PG8_LDB(B0, 0, 0); PG8_LDB(B1, 0, 1); PG8_SCHED; PG8_LDA(At, 0, 0); PG8_STAGE(PG8_SA(1, 1), a1 + hstep, voffA);
            PG8_WAIT_V(8); PG8_WAIT_L(0); PG8_BAR; PG8_MMA(0, 0, At, B0); PG8_MMA(0, 1, At, B1); PG8_BAR; PG8_SCHED;
            PG8_LDA(At, 0, 1); PG8_STAGE(PG8_SB(0, 0), b2, voffB); PG8_STAGE(PG8_SB(0, 1), b2 + hstep, voffB); PG8_STAGE(PG8_SA(0, 0), a2, voffA);
            PG8_WAIT_V(8); PG8_WAIT_L(0); PG8_BAR; PG8_MMA(1, 0, At, B0); PG8_MMA(1, 1, At, B1); PG8_BAR; PG8_SCHED;
            PG8_LDB(B0, 1, 0); PG8_LDB(B1, 1, 1); PG8_SCHED; PG8_LDA(At, 1, 0); PG8_STAGE(PG8_SA(0, 1), a2 + hstep, voffA);
            PG8_WAIT_V(8); PG8_WAIT_L(0); PG8_BAR; PG8_MMA(0, 0, At, B0); PG8_MMA(0, 1, At, B1); PG8_BAR; PG8_SCHED;
            PG8_LDA(At, 1, 1); PG8_STAGE(PG8_SB(1, 0), b3, voffB); PG8_STAGE(PG8_SB(1, 1), b3 + hstep, voffB); PG8_STAGE(PG8_SA(1, 0), a3, voffA);
            PG8_WAIT_V(8); PG8_WAIT_L(0); PG8_BAR; PG8_MMA(1, 0, At, B0); PG8_MMA(1, 1, At, B1); PG8_BAR; PG8_SCHED;
        }
        if (wr == 0) PG8_BAR;
        E(acc, cur, wr, wc, fr, fq);
        if (!has_next) break;
#pragma unroll
        for (int a = 0; a < 2; ++a)
#pragma unroll
            for (int b = 0; b < 2; ++b)
#pragma unroll
                for (int m = 0; m < 4; ++m)
#pragma unroll
                    for (int n = 0; n < 2; ++n) acc[a][b][m][n] = (f32x4){0.f, 0.f, 0.f, 0.f};
        cur = nxt; cA = nA; cB = nB; ++ui;
        if (wr == 1) PG8_BAR;
    }
    PG8_WAIT_V(0);
    PG8_BAR;
#undef PG8_SA
#undef PG8_SB
#undef PG8_STAGE
#undef PG8_LDA
#undef PG8_LDB
#undef PG8_MMA
#undef PG8_WAIT_V
#undef PG8_WAIT_L
#undef PG8_BAR
#undef PG8_SCHED
}
}
using pg8::Unit;

struct Args {
    const float* in[26];
    float* out; unsigned char* ws;
    int ph_lo, ph_hi, use_sync, pad;
};

typedef const __attribute__((address_space(4))) Args* ArgsP;
#define KA ((ArgsP)__builtin_amdgcn_kernarg_segment_ptr())
#define A_IN(k) (KA->in[k])
#define A_OUT (KA->out)
#define A_WS (KA->ws)

struct SchedG1 {
    pg8::TileMap m0, m1; int G, c;
    __device__ __forceinline__ void init(int G_, int c_) { m0.init(256, 24); m1.init(4, 256); G = G_; c = c_; }
    __device__ __forceinline__ bool next(int i, Unit& u) const {
        int L = i * G + c;
        if (L < m0.nwg) { m0.map(L, u.pm, u.pn); u.pn = (u.pn < 8) ? u.pn : u.pn + 4; u.kind = 0; return true; }
        L -= m0.nwg; if (L >= m1.nwg) return false;
        m1.map(L, u.pm, u.pn); u.kind = 1; return true;
    }
};
struct SchedPair {
    pg8::TileMap m0; int G, c;
    __device__ __forceinline__ void init(int nN, int G_, int c_) { m0.init(256, nN); G = G_; c = c_; }
    __device__ __forceinline__ bool next(int i, Unit& u) const { const int L = (i >> 1) * G + c; if (L >= m0.nwg) return false; m0.map(L, u.pm, u.pn); u.kind = i & 1; return true; }
};
struct SchedOne {
    pg8::TileMap m0; int G, c;
    __device__ __forceinline__ void init(int nN, int G_, int c_) { m0.init(256, nN); G = G_; c = c_; }
    __device__ __forceinline__ bool next(int i, Unit& u) const { const int L = i * G + c; if (L >= m0.nwg) return false; m0.map(L, u.pm, u.pn); u.kind = 0; return true; }
};

#define EPI_PREP int fr_ = fr, fq_ = fq; asm volatile("" : "+v"(fr_), "+v"(fq_)); const int rl_ = wr * 64 + fr_, cl_ = wc * 32 + 8 * fq_;
#define EPI_LOOP_BEGIN \
    _Pragma("unroll") for (int ai = 0; ai < 2; ++ai) _Pragma("unroll") for (int m = 0; m < 4; ++m) { const int rit = ai * 128 + m * 16 + rl_; \
    _Pragma("unroll") for (int bj = 0; bj < 2; ++bj) { const int cit = bj * 128 + cl_; f32x4 v0 = acc[ai][bj][m][0], v1 = acc[ai][bj][m][1];
#define EPI_LOOP_END } }

__device__ __forceinline__ size_t kfrag_off(int row, int col) {
    return ((((size_t)(row >> 5) * 16 + (col >> 6)) * 4 + ((col >> 4) & 3)) * 64 + ((col >> 3) & 1) * 32 + swap23(row & 31)) * 8;
}
__device__ __forceinline__ size_t vfrag_off(int vc, int tok) {
    return (((((size_t)(tok >> 5) * 16 + (vc >> 6)) * 2 + ((vc >> 5) & 1)) * 2 + ((tok >> 4) & 1)) * 64 + ((tok >> 3) & 1) * 32 + swap23(vc & 31)) * 8;
}
struct EpiG1 {
    __device__ __forceinline__ void prefetch(const Unit&, LAS unsigned char*, int) const {}
    __device__ __forceinline__ void operator()(const f32x4 (&acc)[2][2][4][2], const Unit& u, int wr, int wc, int fr, int fq) const {
        EPI_PREP unsigned char* ws = A_WS; float* out = A_OUT;
        if (u.kind == 0) {
            const int t = u.pn >> 2, ct = (u.pn & 3) * 256;
            bf16_t* base;
            if (t == 0) base = (bf16_t*)(ws + WS_Q); else if (t == 1) base = (bf16_t*)(ws + WS_K); else if (t == 3) base = (bf16_t*)(ws + WS_XR); else if (t == 4) base = (bf16_t*)(ws + WS_G);
            else if (t == 5) base = (u.pm < 256) ? (bf16_t*)(out + O_YP) : (bf16_t*)(ws + WS_SGA) - (size_t)NTP * DM;
            else base = (u.pm < 256) ? (bf16_t*)(out + O_YP) + (size_t)NTP * DM : (bf16_t*)(ws + WS_SGR) - (size_t)NTP * DM;
            if (t == 1) {
                EPI_LOOP_BEGIN
                    u32x4 w; w.x = cvtpk(v0[0], v0[1]); w.y = cvtpk(v0[2], v0[3]); w.z = cvtpk(v1[0], v1[1]); w.w = cvtpk(v1[2], v1[3]);
                    *(u32x4*)(base + kfrag_off(u.pm * 256 + rit, ct + cit)) = w;
                EPI_LOOP_END
            } else {
            base += (size_t)u.pm * 256 * DM + ct;
            EPI_LOOP_BEGIN
                u32x4 w; w.x = cvtpk(v0[0], v0[1]); w.y = cvtpk(v0[2], v0[3]); w.z = cvtpk(v1[0], v1[1]); w.w = cvtpk(v1[2], v1[3]);
                *(u32x4*)(base + (size_t)rit * DM + cit) = w;
            EPI_LOOP_END
            }
            if (t == 1 && u.pm < 256 && (u.pm & 15) >= 14) { float* p0 = out + O_KP + ((size_t)(u.pm >> 4) * 512 + ((u.pm & 15) - 14) * 256) * DM + ct;
                EPI_LOOP_BEGIN float* p = p0 + (size_t)rit * DM + cit; *(f32x4*)p = v0; *(f32x4*)(p + 4) = v1; EPI_LOOP_END }
            if (t == 1 && u.pm == 256) { float* p0 = out + O_KS + ct;
                EPI_LOOP_BEGIN if (rit < NTS) { float* p = p0 + (size_t)rit * DM + cit; *(f32x4*)p = v0; *(f32x4*)(p + 4) = v1; } EPI_LOOP_END }
            if (t == 3 && u.pm < 256 && (u.pm & 15) == 15) { float* p0 = out + O_CP + ((size_t)(u.pm >> 4) * 3) * DM + ct;
                EPI_LOOP_BEGIN if (rit >= 253) { float* p = p0 + (size_t)(rit - 253) * DM + cit; *(f32x4*)p = v0; *(f32x4*)(p + 4) = v1; } EPI_LOOP_END }
            if (t == 3 && u.pm == 256) { float* p0 = out + O_CS + ct;
                EPI_LOOP_BEGIN if (rit < NTS && (rit & 15) >= 13) { float* p = p0 + ((size_t)(rit >> 4) * 3 + ((rit & 15) - 13)) * DM + cit; *(f32x4*)p = v0; *(f32x4*)(p + 4) = v1; } EPI_LOOP_END }
        } else {
            bf16_t* VT = (bf16_t*)(ws + WS_VT);
            EPI_LOOP_BEGIN
                u32x4 w; w.x = cvtpk(v0[0], v0[1]); w.y = cvtpk(v0[2], v0[3]); w.z = cvtpk(v1[0], v1[1]); w.w = cvtpk(v1[2], v1[3]);
                *(u32x4*)(VT + vfrag_off(u.pm * 256 + rit, u.pn * 256 + cit)) = w;
            EPI_LOOP_END
            if (u.pn < 256 && (u.pn & 15) >= 14) { float* p0 = out + O_VP + ((size_t)(u.pn >> 4) * 512 + ((u.pn & 15) - 14) * 256) * DM + u.pm * 256;
                EPI_LOOP_BEGIN float* p = p0 + (size_t)cit * DM + rit;
                    p[0] = v0[0]; p[DM] = v0[1]; p[2 * DM] = v0[2]; p[3 * DM] = v0[3]; p[4 * DM] = v1[0]; p[5 * DM] = v1[1]; p[6 * DM] = v1[2]; p[7 * DM] = v1[3]; EPI_LOOP_END }
            if (u.pn == 256) { float* p0 = out + O_VS + u.pm * 256;
                EPI_LOOP_BEGIN if (cit < NTS) { float* p = p0 + (size_t)cit * DM + rit;
                    p[0] = v0[0]; p[DM] = v0[1]; p[2 * DM] = v0[2]; p[3 * DM] = v0[3]; p[4 * DM] = v1[0]; p[5 * DM] = v1[1]; p[6 * DM] = v1[2]; p[7 * DM] = v1[3]; } EPI_LOOP_END }
        }
    }
};

struct EpiP3 {
    __device__ __forceinline__ void prefetch(const Unit& u, LAS unsigned char* dummy, int tid) const {
        const bf16_t* gb = (u.pm < 256) ? (const bf16_t*)(A_OUT + O_YP) + (u.kind ? (size_t)NTP * DM : 0) : (const bf16_t*)(A_WS + (u.kind ? WS_SGR : WS_SGA)) - (size_t)NTP * DM;
        const char* base = (const char*)(gb + (size_t)u.pm * 256 * DM + u.pn * 256);
        asm volatile("" : "+v"(tid));
#pragma unroll
        for (int q = 0; q < 2; ++q) { const int li = tid * 2 + q; __builtin_amdgcn_global_load_lds((const unsigned*)(base + (size_t)(li >> 2) * (DM * 2) + (li & 3) * 128), (LAS unsigned*)dummy, 4, 0, 0); }
    }
    __device__ __forceinline__ void operator()(const f32x4 (&acc)[2][2][4][2], const Unit& u, int wr, int wc, int fr, int fq) const {
        EPI_PREP unsigned char* ws = A_WS; float* out = A_OUT;
        const bf16_t* gb = (u.pm < 256) ? (const bf16_t*)(out + O_YP) + (u.kind ? (size_t)NTP * DM : 0) : (const bf16_t*)(ws + (u.kind ? WS_SGR : WS_SGA)) - (size_t)NTP * DM;
        const size_t off0 = (size_t)u.pm * 256 * DM + u.pn * 256;
        gb += off0; bf16_t* MG = (bf16_t*)(ws + WS_XR) + off0;
#pragma unroll
        for (int ai = 0; ai < 2; ++ai) {
            u32x4 gw[4][2], pw[4][2];
#pragma unroll
            for (int m = 0; m < 4; ++m)
#pragma unroll
                for (int bj = 0; bj < 2; ++bj) { const size_t off = (size_t)(ai * 128 + m * 16 + rl_) * DM + bj * 128 + cl_;
                    gw[m][bj] = *(const u32x4*)(gb + off); if (u.kind) pw[m][bj] = *(const u32x4*)(MG + off); }
#pragma unroll
            for (int m = 0; m < 4; ++m)
#pragma unroll
                for (int bj = 0; bj < 2; ++bj) { const size_t off = (size_t)(ai * 128 + m * 16 + rl_) * DM + bj * 128 + cl_;
                    const f32x4 v0 = acc[ai][bj][m][0], v1 = acc[ai][bj][m][1]; const u32x4 g4 = gw[m][bj];
                    f32x4 a0, a1;
                    a0[0] = sigmoidf_(bflo(g4.x)) * v0[0]; a0[1] = sigmoidf_(bfhi(g4.x)) * v0[1]; a0[2] = sigmoidf_(bflo(g4.y)) * v0[2]; a0[3] = sigmoidf_(bfhi(g4.y)) * v0[3];
                    a1[0] = sigmoidf_(bflo(g4.z)) * v1[0]; a1[1] = sigmoidf_(bfhi(g4.z)) * v1[1]; a1[2] = sigmoidf_(bflo(g4.w)) * v1[2]; a1[3] = sigmoidf_(bfhi(g4.w)) * v1[3];
                    if (u.kind) { const u32x4 p4 = pw[m][bj];
                        a0[0] += bflo(p4.x); a0[1] += bfhi(p4.x); a0[2] += bflo(p4.y); a0[3] += bfhi(p4.y); a1[0] += bflo(p4.z); a1[1] += bfhi(p4.z); a1[2] += bflo(p4.w); a1[3] += bfhi(p4.w); }
                    u32x4 w; w.x = cvtpk(a0[0], a0[1]); w.y = cvtpk(a0[2], a0[3]); w.z = cvtpk(a1[0], a1[1]); w.w = cvtpk(a1[2], a1[3]);
                    *(u32x4*)(MG + off) = w; }
        }
    }
};

struct EpiP4 {
    __device__ __forceinline__ void prefetch(const Unit&, LAS unsigned char*, int) const {}
    __device__ __forceinline__ void operator()(const f32x4 (&acc)[2][2][4][2], const Unit& u, int wr, int wc, int fr, int fq) const {
        EPI_PREP bf16_t* base = (bf16_t*)(A_WS + WS_DELTA) + (size_t)u.pm * 256 * DM + u.pn * 256;
        EPI_LOOP_BEGIN
            u32x4 w; w.x = cvtpk(v0[0], v0[1]); w.y = cvtpk(v0[2], v0[3]); w.z = cvtpk(v1[0], v1[1]); w.w = cvtpk(v1[2], v1[3]);
            *(u32x4*)(base + (size_t)rit * DM + cit) = w;
        EPI_LOOP_END
    }
};

struct EpiP5 {
    __device__ __forceinline__ void prefetch(const Unit&, LAS unsigned char*, int) const {}
    __device__ __forceinline__ void operator()(const f32x4 (&acc)[2][2][4][2], const Unit& u, int wr, int wc, int fr, int fq) const {
        EPI_PREP bf16_t* SC = (bf16_t*)(A_WS + WS_XN) + (size_t)u.pm * 256 * 2048 + u.pn * 256;
        EPI_LOOP_BEGIN
            u32x4 w; w.x = cvtpk(v0[0], v0[1]); w.y = cvtpk(v0[2], v0[3]); w.z = cvtpk(v1[0], v1[1]); w.w = cvtpk(v1[2], v1[3]);
            *(u32x4*)(SC + (size_t)rit * 2048 + cit) = w;
        EPI_LOOP_END
    }
};

__device__ __forceinline__ void row_ld(const float* p, f32x4 (&v)[4], int lane) {
#pragma unroll
    for (int j = 0; j < 4; ++j) v[j] = *(const f32x4*)(p + j * 256 + lane * 4);
}
__device__ __forceinline__ float row_ss(const f32x4 (&v)[4]) { float s = 0.f;
#pragma unroll
    for (int j = 0; j < 4; ++j) s += (v[j][0] * v[j][0] + v[j][1] * v[j][1]) + (v[j][2] * v[j][2] + v[j][3] * v[j][3]);
    return s; }
__device__ __forceinline__ void row_add_bf16(const bf16_t* p, f32x4 (&v)[4], int lane) {
#pragma unroll
    for (int j = 0; j < 4; ++j) { const u32x2 w = *(const u32x2*)(p + j * 256 + lane * 4); v[j][0] += bflo(w.x); v[j][1] += bfhi(w.x); v[j][2] += bflo(w.y); v[j][3] += bfhi(w.y); }
}
__device__ __forceinline__ const float* xrow_ptr(int m) { return (m < NTP) ? A_IN(0) + (size_t)m * DM : A_IN(1) + (size_t)(m - NTP) * DM; }
__device__ __forceinline__ float* yrow_ptr(int m) { return (m < NTP) ? A_OUT + O_YP + (size_t)m * DM : A_OUT + O_YS + (size_t)(m - NTP) * DM; }

__device__ __forceinline__ void p0_transpose_item(const float* W, int K, int N, bf16_t* WT, LAS float* scr, int item, int lane, int nscale = 0) {
    const int nblk = N / 32, kb = item / nblk, nb = item % nblk, k0 = 64 * kb, n0 = 32 * nb;
#pragma unroll 8
    for (int i = 0; i < 32; ++i) { const int kk = 2 * i + (lane >> 5); scr[kk * 33 + (lane & 31)] = W[(size_t)(k0 + kk) * N + n0 + (lane & 31)] * (n0 < nscale ? QSCALE : 1.0f); }
    asm volatile("s_waitcnt lgkmcnt(0)" ::: "memory");
    const int c = lane & 7;
#pragma unroll
    for (int j = 0; j < 4; ++j) { const int n = (lane >> 3) + 8 * j; const LAS float* s = scr + (8 * c) * 33 + n;
        u32x4 o; o.x = cvtpk(s[0 * 33], s[1 * 33]); o.y = cvtpk(s[2 * 33], s[3 * 33]); o.z = cvtpk(s[4 * 33], s[5 * 33]); o.w = cvtpk(s[6 * 33], s[7 * 33]);
        *(u32x4*)(WT + (size_t)(n0 + n) * K + k0 + 8 * c) = o; }
    asm volatile("s_waitcnt lgkmcnt(0)" ::: "memory");
}

__device__ __forceinline__ void p0_prologue(LAS unsigned char* lds, int G, int wave, int lane) {
    unsigned char* ws = A_WS;
    const int gw = blockIdx.x * 8 + wave, NGW = G * 8;
    LAS float* scr = (LAS float*)(lds + wave * 16384);
    constexpr int I_IN = 16 * (INC / 32), I_SQ = 16 * 32, NTR = I_IN + 3 * I_SQ;
    for (int it = gw; it < NTR; it += NGW) {
        int r = it;
        if (r < I_IN) { p0_transpose_item(A_IN(7), DM, INC, (bf16_t*)(ws + WS_WIN), scr, r, lane, 1024); continue; } r -= I_IN;
        if (r < I_SQ) { p0_transpose_item(A_IN(16), DM, DM, (bf16_t*)(ws + WS_WBA), scr, r, lane); continue; } r -= I_SQ;
        if (r < I_SQ) { p0_transpose_item(A_IN(17), DM, DM, (bf16_t*)(ws + WS_WBL), scr, r, lane); continue; } r -= I_SQ;
        p0_transpose_item(A_IN(18), DM, DM, (bf16_t*)(ws + WS_WO), scr, r, lane);
    }
    {
        const float* wq = A_IN(20); bf16_t* wst = (bf16_t*)(ws + WS_WS);
        const int r32 = lane & 31, hi = lane >> 5;
        for (int it = gw; it < 2048; it += NGW) {
            const int hj = it >> 7, kt = (it >> 5) & 3, ct = it & 31, h = hj >> 1, j = hj & 1;
            const float* ap = (j ? A_IN(22) : A_IN(21)) + ((size_t)(h * 128 + kt * 32 + r32)) * 128 + 64 * hi;
            const float* bp = wq + (size_t)(ct * 32 + r32) * 2048 + hj * 128 + 64 * hi;
            f32x16 acc = {};
#pragma unroll
            for (int s4 = 0; s4 < 16; ++s4) { const f32x4 av = *(const f32x4*)(ap + 4 * s4), bv = *(const f32x4*)(bp + 4 * s4);
                acc = __builtin_amdgcn_mfma_f32_32x32x2f32(av[0], bv[0], acc, 0, 0, 0); acc = __builtin_amdgcn_mfma_f32_32x32x2f32(av[1], bv[1], acc, 0, 0, 0);
                acc = __builtin_amdgcn_mfma_f32_32x32x2f32(av[2], bv[2], acc, 0, 0, 0); acc = __builtin_amdgcn_mfma_f32_32x32x2f32(av[3], bv[3], acc, 0, 0, 0); }
#pragma unroll
            for (int r = 0; r < 16; ++r) { const int key = kt * 32 + (r & 3) + 8 * (r >> 2) + 4 * hi;
                wst[(size_t)(key * 16 + hj) * DM + ct * 32 + r32] = (bf16_t)(cvtpk(acc[r], 0.f) & 0xffffu); }
        }
    }
    {
        f32x4 p[4], pn[4];
        if (gw < 2 * NEXP) {
#pragma unroll
            for (int q = 0; q < 4; ++q) p[q] = *(const f32x4*)(((gw >= NEXP) ? A_IN(24) + (size_t)(gw - NEXP) * DM : A_IN(23) + (size_t)gw * DM) + lane * 16 + 4 * q); }
        for (int it = gw; it < 2 * NEXP; it += NGW) {
            const int tb = it >= NEXP, e = it - tb * NEXP, itn = it + NGW;
            if (itn < 2 * NEXP) {
#pragma unroll
                for (int q = 0; q < 4; ++q) pn[q] = *(const f32x4*)(((itn >= NEXP) ? A_IN(24) + (size_t)(itn - NEXP) * DM : A_IN(23) + (size_t)itn * DM) + lane * 16 + 4 * q); }
            unsigned char* dst = ws + (tb ? WS_VB : WS_UB) + (size_t)e * DM + lane * 16;
            float mx = 0.f;
#pragma unroll
            for (int q = 0; q < 4; ++q) mx = fmaxf(mx, fmaxf(fmaxf(fabsf(p[q][0]), fabsf(p[q][1])), fmaxf(fabsf(p[q][2]), fabsf(p[q][3]))));
#pragma unroll
            for (int o = 1; o < 64; o <<= 1) mx = fmaxf(mx, __shfl_xor(mx, o));
            const float step = fmaxf(mx, 1e-30f) * (1.0f / 127.0f), inv = 1.0f / step;
            u32x4 w;
#pragma unroll
            for (int q = 0; q < 4; ++q) {
                const unsigned b0 = (unsigned)(int)rintf(p[q][0] * inv) & 0xffu, b1 = (unsigned)(int)rintf(p[q][1] * inv) & 0xffu, b2 = (unsigned)(int)rintf(p[q][2] * inv) & 0xffu, b3 = (unsigned)(int)rintf(p[q][3] * inv) & 0xffu;
                w[q] = b0 | (b1 << 8) | (b2 << 16) | (b3 << 24); }
            *(u32x4*)dst = w;
            if (lane == 0) ((float*)(ws + (tb ? WS_SV : WS_SU)))[e] = step;
#pragma unroll
            for (int q = 0; q < 4; ++q) p[q] = pn[q];
        }
    }
    {
        const float* gm = A_IN(6); bf16_t* XN = (bf16_t*)(ws + WS_XN);
        for (int m = NTOK + gw; m < ROWS; m += NGW) {
#pragma unroll
            for (int j = 0; j < 2; ++j) *(u32x4*)(XN + (size_t)m * DM + j * 512 + lane * 8) = (u32x4){0u, 0u, 0u, 0u}; }
        f32x4 v[4], vn[4];
        if (gw < NTOK) row_ld(xrow_ptr(gw), v, lane);
        for (int m = gw; m < NTOK; m += NGW) {
            const int mn = m + NGW;
            if (mn < NTOK) row_ld(xrow_ptr(mn), vn, lane);
            bf16_t* orow = XN + (size_t)m * DM;
            const float inv = 1.0f / sqrtf(wave_sum(row_ss(v)) * (1.0f / DM) + EPS);
#pragma unroll
            for (int j = 0; j < 4; ++j) { const f32x4 gg = *(const f32x4*)(gm + j * 256 + lane * 4); const f32x4 y = v[j] * inv * gg;
                u32x2 w; w.x = cvtpk(y[0], y[1]); w.y = cvtpk(y[2], y[3]); *(u32x2*)(orow + j * 256 + lane * 4) = w; }
#pragma unroll
            for (int j = 0; j < 4; ++j) v[j] = vn[j];
        }
    }
    {
        bf16_t* fw = (bf16_t*)(ws + WS_LRUW);
        for (int f = gw; f < 256; f += NGW) {
            const int ks = f & 3, T = (f >> 2) & 1, gate = (f >> 3) & 1, g = f >> 4, i = lane & 31, hi = lane >> 5;
            const int outc = 32 * T + swap23(i);
            const float* W = (gate ? A_IN(13) : A_IN(11)) + (size_t)g * 4096;
            float x[8];
#pragma unroll
            for (int j = 0; j < 8; ++j) x[j] = W[(16 * ks + 8 * hi + j) * 64 + outc];
            u32x4 w; w.x = cvtpk(x[0], x[1]); w.y = cvtpk(x[2], x[3]); w.z = cvtpk(x[4], x[5]); w.w = cvtpk(x[6], x[7]);
            *(u32x4*)(fw + (size_t)f * 512 + lane * 8) = w;
        }
    }
}

constexpr int LR_WF = 0, LR_CW = 16384, LR_CB = LR_CW + 1024, LR_BR = LR_CB + 256, LR_BI = LR_BR + 256, LR_CS = LR_BI + 256, LR_CARRY = LR_CS + 256, LR_SEQ = LR_CARRY + 2048, LR_END = LR_SEQ + 64;

__device__ __forceinline__ void lru_load_consts(LAS unsigned char* lds, int g, int tid) {
    const u32x4* src = (const u32x4*)(A_WS + WS_LRUW + (size_t)g * 16384);
    for (int i = tid; i < 1024; i += 512) ((LAS u32x4*)(lds + LR_WF))[i] = src[i];
    if (tid < 256) ((LAS float*)(lds + LR_CW))[tid] = A_IN(9)[(tid >> 6) * DM + g * 64 + (tid & 63)];
    if (tid < 64) {
        const int c = g * 64 + tid;
        ((LAS float*)(lds + LR_CB))[tid] = A_IN(10)[c]; ((LAS float*)(lds + LR_BR))[tid] = A_IN(12)[c]; ((LAS float*)(lds + LR_BI))[tid] = A_IN(14)[c];
        ((LAS float*)(lds + LR_CS))[tid] = 8.0f * log1pf(expf(-A_IN(15)[c]));
    }
    if (tid < 8) ((LAS unsigned*)(lds + LR_SEQ))[tid] = 0xffffffffu;
}

template <bool SAMPLE>
__device__ __forceinline__ void lru_tile(LAS unsigned char* lds, int lane, int g, size_t rowbase, int tile, int bidx) {
    asm volatile("" : "+v"(lane));
    const int tl = lane & 31, hi = lane >> 5, t = tile * 32 + tl;
    const bf16_t* XR = (const bf16_t*)(A_WS + WS_XR); bf16_t* Gb = (bf16_t*)(A_WS + WS_G);
    const int cbase = g * 64 + 8 * hi;
    float xc[4][8];
    bf16x8 xf[4];
#pragma unroll
    for (int ks = 0; ks < 4; ++ks) {
        const f32x4 b0 = *(const LAS f32x4*)(lds + LR_CB + (16 * ks + 8 * hi) * 4), b1 = *(const LAS f32x4*)(lds + LR_CB + (16 * ks + 8 * hi) * 4 + 16);
#pragma unroll
        for (int j = 0; j < 4; ++j) { xc[ks][j] = b0[j]; xc[ks][4 + j] = b1[j]; }
#pragma unroll
        for (int tap = 0; tap < 4; ++tap) {
            const int rr = t - 3 + tap;
            float xv[8];
            {
                u32x4 w = *(const u32x4*)(XR + (rowbase + (rr < 0 ? 0 : rr)) * DM + cbase + 16 * ks);
                if (rr < 0) w = (u32x4){0u, 0u, 0u, 0u};
                xv[0] = bflo(w.x); xv[1] = bfhi(w.x); xv[2] = bflo(w.y); xv[3] = bfhi(w.y); xv[4] = bflo(w.z); xv[5] = bfhi(w.z); xv[6] = bflo(w.w); xv[7] = bfhi(w.w);
            }
            if (SAMPLE) {
                const float* sp = A_IN(4) + ((size_t)bidx * 3 + (rr < 0 ? 3 + rr : 0)) * DM + cbase + 16 * ks;
                const f32x4 p = *(const f32x4*)sp, q = *(const f32x4*)(sp + 4);
#pragma unroll
                for (int j = 0; j < 4; ++j) { xv[j] = rr < 0 ? p[j] : xv[j]; xv[4 + j] = rr < 0 ? q[j] : xv[4 + j]; }
            }
            const f32x4 w0 = *(const LAS f32x4*)(lds + LR_CW + (tap * 64 + 16 * ks + 8 * hi) * 4), w1 = *(const LAS f32x4*)(lds + LR_CW + (tap * 64 + 16 * ks + 8 * hi) * 4 + 16);
#pragma unroll
            for (int j = 0; j < 4; ++j) { xc[ks][j] += w0[j] * xv[j]; xc[ks][4 + j] += w1[j] * xv[4 + j]; }
        }
        u32x4 w; w.x = cvtpk(xc[ks][0], xc[ks][1]); w.y = cvtpk(xc[ks][2], xc[ks][3]); w.z = cvtpk(xc[ks][4], xc[ks][5]); w.w = cvtpk(xc[ks][6], xc[ks][7]);
        xf[ks] = __builtin_bit_cast(bf16x8, w);
        asm volatile("" ::: "memory");
    }
    float A[32], B[32];
#pragma unroll
    for (int T = 0; T < 2; ++T) {
        f32x16 ar = f32x16{}, ai = f32x16{};
#pragma unroll
        for (int ks = 0; ks < 4; ++ks) {
            const bf16x8 wr_ = *(const LAS bf16x8*)(lds + LR_WF + ((0 * 2 + T) * 4 + ks) * 1024 + lane * 16);
            const bf16x8 wi_ = *(const LAS bf16x8*)(lds + LR_WF + ((1 * 2 + T) * 4 + ks) * 1024 + lane * 16);
            ar = __builtin_amdgcn_mfma_f32_32x32x16_bf16(wr_, xf[ks], ar, 0, 0, 0);
            ai = __builtin_amdgcn_mfma_f32_32x32x16_bf16(wi_, xf[ks], ai, 0, 0, 0);
        }
#pragma unroll
        for (int q = 0; q < 2; ++q) {
            const int ks = 2 * T + q, lo = (16 * ks + 8 * hi) * 4;
            const f32x4 br0 = *(const LAS f32x4*)(lds + LR_BR + lo), br1 = *(const LAS f32x4*)(lds + LR_BR + lo + 16);
            const f32x4 bi0 = *(const LAS f32x4*)(lds + LR_BI + lo), bi1 = *(const LAS f32x4*)(lds + LR_BI + lo + 16);
            const f32x4 cs0 = *(const LAS f32x4*)(lds + LR_CS + lo), cs1 = *(const LAS f32x4*)(lds + LR_CS + lo + 16);
#pragma unroll
            for (int j = 0; j < 8; ++j) {
                const int r = 8 * q + j;
                const float brv = j < 4 ? br0[j & 3] : br1[j & 3], biv = j < 4 ? bi0[j & 3] : bi1[j & 3], csv = j < 4 ? cs0[j & 3] : cs1[j & 3];
                const float rg = sigmoidf_(ar[r] + brv), ig = sigmoidf_(ai[r] + biv);
                const float la = -csv * rg, av = fast_exp2(la * LOG2E);
                const float x2 = 2.0f * la;
                const float em = (x2 > -0.03f) ? -x2 * (1.0f + x2 * (0.5f + x2 * (0.16666667f + x2 * 0.041666668f))) : 1.0f - fast_exp2(x2 * LOG2E);
                A[16 * T + r] = av; B[16 * T + r] = sqrtf(em) * ig * xc[ks][j];
            }
        }
        asm volatile("" ::: "memory");
    }
#define LRU_STEP(CTRL, RM) _Pragma("unroll") for (int c = 0; c < 32; ++c) { \
        const float as_ = __builtin_bit_cast(float, __builtin_amdgcn_update_dpp(__builtin_bit_cast(int, 1.0f), __builtin_bit_cast(int, A[c]), CTRL, RM, 0xF, false)); \
        const float bs_ = __builtin_bit_cast(float, __builtin_amdgcn_update_dpp(0, __builtin_bit_cast(int, B[c]), CTRL, RM, 0xF, false)); \
        B[c] = A[c] * bs_ + B[c]; A[c] = A[c] * as_; }
    LRU_STEP(0x111, 0xF) LRU_STEP(0x112, 0xF) LRU_STEP(0x114, 0xF) LRU_STEP(0x118, 0xF) LRU_STEP(0x142, 0xA)
#undef LRU_STEP
    float hin[32];
    if (SAMPLE) {
        const float* hp = A_IN(5) + (size_t)bidx * DM + cbase;
#pragma unroll
        for (int ks = 0; ks < 4; ++ks) { const f32x4 p = *(const f32x4*)(hp + 16 * ks), q = *(const f32x4*)(hp + 16 * ks + 4);
#pragma unroll
            for (int j = 0; j < 4; ++j) { hin[8 * ks + j] = p[j]; hin[8 * ks + 4 + j] = q[j]; } }
    } else if (tile == 0) {
#pragma unroll
        for (int c = 0; c < 32; ++c) hin[c] = 0.f;
    } else {
        volatile LAS unsigned* sq = (volatile LAS unsigned*)(lds + LR_SEQ) + (tile & 7);
        while (*sq != (unsigned)tile) __builtin_amdgcn_s_sleep(1);
        asm volatile("" ::: "memory");
        const LAS float* cp = (const LAS float*)(lds + LR_CARRY) + (tile & 7) * 64 + 8 * hi;
#pragma unroll
        for (int ks = 0; ks < 4; ++ks) { const f32x4 p = *(const LAS f32x4*)(cp + 16 * ks), q = *(const LAS f32x4*)(cp + 16 * ks + 4);
#pragma unroll
            for (int j = 0; j < 4; ++j) { hin[8 * ks + j] = p[j]; hin[8 * ks + 4 + j] = q[j]; } }
    }
#pragma unroll
    for (int c = 0; c < 32; ++c) B[c] = B[c] + A[c] * hin[c];
    if (!SAMPLE) {
        if (tl == 31) {
            if (tile < 127) {
                LAS float* cp = (LAS float*)(lds + LR_CARRY) + ((tile + 1) & 7) * 64 + 8 * hi;
#pragma unroll
                for (int ks = 0; ks < 4; ++ks) { *(LAS f32x4*)(cp + 16 * ks) = (f32x4){B[8 * ks], B[8 * ks + 1], B[8 * ks + 2], B[8 * ks + 3]};
                    *(LAS f32x4*)(cp + 16 * ks + 4) = (f32x4){B[8 * ks + 4], B[8 * ks + 5], B[8 * ks + 6], B[8 * ks + 7]}; }
            } else {
                float* lp = A_OUT + O_LP + (size_t)bidx * DM + cbase;
#pragma unroll
                for (int ks = 0; ks < 4; ++ks) { *(f32x4*)(lp + 16 * ks) = (f32x4){B[8 * ks], B[8 * ks + 1], B[8 * ks + 2], B[8 * ks + 3]};
                    *(f32x4*)(lp + 16 * ks + 4) = (f32x4){B[8 * ks + 4], B[8 * ks + 5], B[8 * ks + 6], B[8 * ks + 7]}; }
            }
        }
        if (tile < 127) {
            asm volatile("s_waitcnt lgkmcnt(0)" ::: "memory");
            if (lane == 63) *((volatile LAS unsigned*)(lds + LR_SEQ) + ((tile + 1) & 7)) = (unsigned)(tile + 1);
        }
    } else if (tl == 15) {
        float* lp = A_OUT + O_LS + (size_t)bidx * DM + cbase;
#pragma unroll
        for (int ks = 0; ks < 4; ++ks) { *(f32x4*)(lp + 16 * ks) = (f32x4){B[8 * ks], B[8 * ks + 1], B[8 * ks + 2], B[8 * ks + 3]};
            *(f32x4*)(lp + 16 * ks + 4) = (f32x4){B[8 * ks + 4], B[8 * ks + 5], B[8 * ks + 6], B[8 * ks + 7]}; }
    }
    if (!SAMPLE || tl < NST) {
        bf16_t* gp = Gb + (rowbase + t) * DM + cbase;
#pragma unroll
        for (int ks = 0; ks < 4; ++ks) {
            const u32x4 w = *(const u32x4*)(gp + 16 * ks);
            float gv[8]; gv[0] = bflo(w.x); gv[1] = bfhi(w.x); gv[2] = bflo(w.y); gv[3] = bfhi(w.y); gv[4] = bflo(w.z); gv[5] = bfhi(w.z); gv[6] = bflo(w.w); gv[7] = bfhi(w.w);
            float o[8];
#pragma unroll
            for (int j = 0; j < 8; ++j) o[j] = B[8 * ks + j] * gelu_tanh(gv[j]);
            u32x4 ow; ow.x = cvtpk(o[0], o[1]); ow.y = cvtpk(o[2], o[3]); ow.z = cvtpk(o[4], o[5]); ow.w = cvtpk(o[6], o[7]);
            *(u32x4*)(gp + 16 * ks) = ow;
        }
    }
}

constexpr int P2_Q = 20608;
constexpr int AT_TAB = 24576;
__device__ __forceinline__ void attn_unit(LAS unsigned char* lds, int lane, int b, int c, int h) {
    const int r32 = lane & 31, hi = lane >> 5, kr = swap23(r32);
    const bf16_t* Q = (const bf16_t*)(A_WS + WS_Q); const bf16_t* Kb = (const bf16_t*)(A_WS + WS_K); const bf16_t* VT = (const bf16_t*)(A_WS + WS_VT); bf16_t* O = (bf16_t*)(A_WS + WS_XN);
    const size_t row0 = (size_t)b * SEQ + (size_t)c * 64;
    bf16x8 qf[2][4];
#pragma unroll
    for (int qb = 0; qb < 2; ++qb)
#pragma unroll
        for (int ks = 0; ks < 4; ++ks) qf[qb][ks] = *(const bf16x8*)(Q + (row0 + qb * 32 + r32) * DM + h * 64 + ks * 16 + hi * 8);
    f32x16 o[2][2];
#pragma unroll
    for (int i = 0; i < 2; ++i)
#pragma unroll
        for (int j = 0; j < 2; ++j) o[i][j] = f32x16{};
    float mrow[2] = {-1e30f, -1e30f}, lrow[2] = {0.f, 0.f};
    const LAS float* tab = (const LAS float*)(lds + AT_TAB) + h * 320;
    const float cfar = tab[256];
    const int sb0 = (c >= 8 ? c - 8 : 0) * 2, sb1 = c * 2 + 1;
    const bf16_t* kbase = Kb + ((size_t)b * 128 * 16 + h) * 4 * 512 + lane * 8;
    const bf16_t* vbase = VT + ((size_t)b * 128 * 16 + h) * 4 * 512 + lane * 8;
    bf16x8 kf[4], vf[2][2];
#pragma unroll
    for (int ks = 0; ks < 4; ++ks) kf[ks] = *(const bf16x8*)(kbase + (size_t)sb0 * 32768 + ks * 512);
#pragma unroll
    for (int db = 0; db < 2; ++db)
#pragma unroll
        for (int s = 0; s < 2; ++s) vf[db][s] = *(const bf16x8*)(vbase + (size_t)sb0 * 32768 + (db * 2 + s) * 512);
    for (int sb = sb0; sb <= sb1; ++sb) {
        const int sbn = sb < sb1 ? sb + 1 : sb;
        f32x16 S[2];
#pragma unroll
        for (int qb = 0; qb < 2; ++qb) { S[qb] = f32x16{};
#pragma unroll
            for (int ks = 0; ks < 4; ++ks) S[qb] = __builtin_amdgcn_mfma_f32_32x32x16_bf16(kf[ks], qf[qb][ks], S[qb], 0, 0, 0); }
        asm volatile("" ::: "memory");
#pragma unroll
        for (int ks = 0; ks < 4; ++ks) kf[ks] = *(const bf16x8*)(kbase + (size_t)sbn * 32768 + ks * 512);
        const int delta = c - (sb >> 1), rb = sb & 1;
        if (delta >= 3) {
#pragma unroll
            for (int qb = 0; qb < 2; ++qb)
#pragma unroll
                for (int r = 0; r < 16; ++r) S[qb][r] += cfar;
        } else {
#pragma unroll
            for (int qb = 0; qb < 2; ++qb) {
                const LAS float* tp = tab + (64 * delta + 32 * qb + r32 + 128 - 32 * rb - 8 * hi - 23);
#pragma unroll
                for (int r = 0; r < 16; ++r) S[qb][r] += tp[23 - (16 * (r >> 3) + (r & 7))];
            }
        }
        float rm[2];
#pragma unroll
        for (int qb = 0; qb < 2; ++qb) { float mx = S[qb][0];
#pragma unroll
            for (int r = 1; r < 16; ++r) mx = fmaxf(mx, S[qb][r]);
            rm[qb] = plswap_max(mx); }
        if (__any((rm[0] > mrow[0] + 8.0f) || (rm[1] > mrow[1] + 8.0f))) {
#pragma unroll
            for (int qb = 0; qb < 2; ++qb) { const float mn = fmaxf(mrow[qb], rm[qb]); const float al = fast_exp2(mrow[qb] - mn); lrow[qb] *= al; mrow[qb] = mn;
#pragma unroll
                for (int r = 0; r < 16; ++r) { o[0][qb][r] *= al; o[1][qb][r] *= al; } }
        }
        bf16x8 pf[2][2];
#pragma unroll
        for (int qb = 0; qb < 2; ++qb) { float sum = 0.f;
#pragma unroll
            for (int r = 0; r < 16; ++r) { S[qb][r] = fast_exp2(S[qb][r] - mrow[qb]); sum += S[qb][r]; }
            lrow[qb] += sum;
#pragma unroll
            for (int s = 0; s < 2; ++s) { u32x4 w; w.x = cvtpk(S[qb][8 * s], S[qb][8 * s + 1]); w.y = cvtpk(S[qb][8 * s + 2], S[qb][8 * s + 3]); w.z = cvtpk(S[qb][8 * s + 4], S[qb][8 * s + 5]); w.w = cvtpk(S[qb][8 * s + 6], S[qb][8 * s + 7]);
                pf[qb][s] = __builtin_bit_cast(bf16x8, w); } }
#pragma unroll
        for (int db = 0; db < 2; ++db)
#pragma unroll
            for (int qb = 0; qb < 2; ++qb)
#pragma unroll
                for (int s = 0; s < 2; ++s) o[db][qb] = __builtin_amdgcn_mfma_f32_32x32x16_bf16(vf[db][s], pf[qb][s], o[db][qb], 0, 0, 0);
        asm volatile("" ::: "memory");
#pragma unroll
        for (int db = 0; db < 2; ++db)
#pragma unroll
            for (int s = 0; s < 2; ++s) vf[db][s] = *(const bf16x8*)(vbase + (size_t)sbn * 32768 + (db * 2 + s) * 512);
    }
#pragma unroll
    for (int qb = 0; qb < 2; ++qb) { const float inv = fast_rcp(plswap_add(lrow[qb]));
        bf16_t* op = O + (row0 + qb * 32 + r32) * DM + h * 64 + 8 * hi;
#pragma unroll
        for (int db = 0; db < 2; ++db)
#pragma unroll
            for (int s = 0; s < 2; ++s) { u32x4 w;
                w.x = cvtpk(o[db][qb][8 * s] * inv, o[db][qb][8 * s + 1] * inv); w.y = cvtpk(o[db][qb][8 * s + 2] * inv, o[db][qb][8 * s + 3] * inv);
                w.z = cvtpk(o[db][qb][8 * s + 4] * inv, o[db][qb][8 * s + 5] * inv); w.w = cvtpk(o[db][qb][8 * s + 6] * inv, o[db][qb][8 * s + 7] * inv);
                *(u32x4*)(op + 32 * db + 16 * s) = w; } }
}

constexpr int AS_P = 45056;
__device__ __forceinline__ void attn_sample_task(LAS unsigned char* lds, int wave, int lane, int task) {
    const int bs = task >> 6, h = (task >> 2) & 15, qg = task & 3;
    const bf16_t* Q = (const bf16_t*)(A_WS + WS_Q); bf16_t* O = (bf16_t*)(A_WS + WS_XN);
    const float* ck = A_IN(2); const float* cv = A_IN(3); const float* kn = A_OUT + O_KS; const float* vn = A_OUT + O_VS;
    LAS float* pb = (LAS float*)(lds + AS_P + wave * 9472);
    LAS float* qs = pb + 4 * 528;
    const LAS float* tab = (const LAS float*)(lds + AT_TAB) + h * 320;
#pragma unroll
    for (int i = 0; i < 4; ++i) qs[i * 64 + lane] = bflo((unsigned)Q[((size_t)NTP + bs * 16 + qg * 4 + i) * DM + h * 64 + lane]);
    asm volatile("s_waitcnt lgkmcnt(0)" ::: "memory");
#pragma unroll 1
    for (int it = 0; it < 9; ++it) {
        const int key = it * 64 + lane; const bool valid = key < 528;
        const float* kp = !valid ? ck : (key < 512 ? ck + (((size_t)bs * 512 + key) * 16 + h) * 64 : kn + ((size_t)bs * 16 + (key - 512)) * DM + h * 64);
        float d[4] = {0.f, 0.f, 0.f, 0.f};
        f32x4 kv[16];
#pragma unroll
        for (int d4 = 0; d4 < 16; ++d4) kv[d4] = *(const f32x4*)(kp + 4 * d4);
#pragma unroll
        for (int d4 = 0; d4 < 16; ++d4) {
#pragma unroll
            for (int i = 0; i < 4; ++i) { const f32x4 qq = *(const LAS f32x4*)(qs + i * 64 + 4 * d4); d[i] += (kv[d4][0] * qq[0] + kv[d4][1] * qq[1]) + (kv[d4][2] * qq[2] + kv[d4][3] * qq[3]); } }
        int rel = 512 + qg * 4 - key;
        if (valid) {
#pragma unroll
            for (int i = 0; i < 4; ++i) { int r = rel + i; r = r > 128 ? 128 : r; pb[i * 528 + key] = d[i] + tab[r + 128]; } }
    }
    asm volatile("s_waitcnt lgkmcnt(0)" ::: "memory");
#pragma unroll 1
    for (int i = 0; i < 4; ++i) {
        float mx = -1e30f;
#pragma unroll 1
        for (int key = lane; key < 528; key += 64) mx = fmaxf(mx, pb[i * 528 + key]);
#pragma unroll
        for (int o = 1; o < 64; o <<= 1) mx = fmaxf(mx, __shfl_xor(mx, o));
        float sum = 0.f;
#pragma unroll 1
        for (int key = lane; key < 528; key += 64) { const float pv = fast_exp2(pb[i * 528 + key] - mx); pb[i * 528 + key] = pv; sum += pv; }
        sum = wave_sum(sum); const float inv = 1.0f / sum;
#pragma unroll 1
        for (int key = lane; key < 528; key += 64) pb[i * 528 + key] *= inv;
    }
    asm volatile("s_waitcnt lgkmcnt(0)" ::: "memory");
    float acc[4] = {0.f, 0.f, 0.f, 0.f};
#pragma unroll 1
    for (int k0 = 0; k0 < 528; k0 += 16) {
        float vv[16];
#pragma unroll
        for (int kk = 0; kk < 16; ++kk) { const int key = k0 + kk; vv[kk] = k0 < 512 ? cv[(((size_t)bs * 512 + key) * 16 + h) * 64 + lane] : vn[((size_t)bs * 16 + (key - 512)) * DM + h * 64 + lane]; }
#pragma unroll
        for (int kk = 0; kk < 16; ++kk) {
#pragma unroll
            for (int i = 0; i < 4; ++i) acc[i] += pb[i * 528 + k0 + kk] * vv[kk]; }
    }
#pragma unroll
    for (int i = 0; i < 4; ++i) O[((size_t)NTP + bs * 16 + qg * 4 + i) * DM + h * 64 + lane] = (bf16_t)(cvtpk(acc[i], 0.f) & 0xffffu);
    asm volatile("s_waitcnt lgkmcnt(0)" ::: "memory");
}

__device__ __forceinline__ void p2_phase(LAS unsigned char* lds, int G, int tid, int wave, int lane) {
    for (int i = tid; i < 16 * 320; i += 512) { const int h = i / 320, j = i % 320; ((LAS float*)(lds + AT_TAB))[i] = A_IN(8)[h * 257 + (j > 256 ? 256 : j)] * LOG2E; }
    for (int u = blockIdx.x; u < 256 + 16; u += G) {
        __syncthreads();
        if (u < 256) {
            const int b = u >> 4, g = u & 15;
            lru_load_consts(lds, g, tid);
            __syncthreads();
            for (int tile = wave; tile < 128; tile += 8) lru_tile<false>(lds, lane, g, (size_t)b * SEQ, tile, b);
        } else {
            const int g = u - 256;
            lru_load_consts(lds, g, tid);
            __syncthreads();
            lru_tile<true>(lds, lane, g, (size_t)NTP + wave * 16, 0, wave);
        }
    }
    if (tid == 0) *(volatile LAS int*)(lds + P2_Q) = 0;
    __syncthreads();
    const int NGW = G * 8;
    int nS = 0; for (int t = blockIdx.x; t < 512; t += G) ++nS;
    for (;;) {
        int j = 0;
        if (lane == 0) j = __hip_atomic_fetch_add((LAS int*)(lds + P2_Q), 1, __ATOMIC_RELAXED, __HIP_MEMORY_SCOPE_WORKGROUP);
        j = __builtin_amdgcn_readfirstlane(j);
        if (j < nS) { attn_sample_task(lds, wave, lane, blockIdx.x + G * j); continue; }
        j -= nS;
        const int u = blockIdx.x * 8 + (j & 7) + NGW * (j >> 3);
        if (u >= NB * 64 * 16) break;
        const int c = u & 63, h = (u >> 6) & 15, b = u >> 10;
        attn_unit(lds, lane, b, c, h);
    }
}

__device__ __forceinline__ void p4b_phase(int G, int wave, int lane) {
    const int gw = blockIdx.x * 8 + wave, NGW = G * 8;
    const float* gm = A_IN(19); bf16_t* XT = (bf16_t*)(A_WS + WS_Q); unsigned char* XQ = A_WS + WS_XQ; float* SX = (float*)(A_WS + WS_SX);
    const bf16_t* DL = (const bf16_t*)(A_WS + WS_DELTA);
    f32x4 v[4], vn[4];
    if (gw < NTOK) { row_ld(xrow_ptr(gw), v, lane); row_add_bf16(DL + (size_t)gw * DM, v, lane); }
    for (int m = gw; m < NTOK; m += NGW) {
        const int mn = m + NGW;
        if (mn < NTOK) { row_ld(xrow_ptr(mn), vn, lane); row_add_bf16(DL + (size_t)mn * DM, vn, lane); }
        bf16_t* orow = XT + (size_t)m * DM;
        const float inv = 1.0f / sqrtf(wave_sum(row_ss(v)) * (1.0f / DM) + EPS);
        float mx = 0.f;
#pragma unroll
        for (int j = 0; j < 4; ++j) { const f32x4 gg = *(const f32x4*)(gm + j * 256 + lane * 4); v[j] = v[j] * inv * gg;
            u32x2 w; w.x = cvtpk(v[j][0], v[j][1]); w.y = cvtpk(v[j][2], v[j][3]); *(u32x2*)(orow + j * 256 + lane * 4) = w;
            mx = fmaxf(mx, fmaxf(fmaxf(fabsf(v[j][0]), fabsf(v[j][1])), fmaxf(fabsf(v[j][2]), fabsf(v[j][3])))); }
#pragma unroll
        for (int o = 1; o < 64; o <<= 1) mx = fmaxf(mx, __shfl_xor(mx, o));
        const float step = fmaxf(mx, 1e-30f) * (1.0f / 127.0f), qi = 1.0f / step;
#pragma unroll
        for (int j = 0; j < 4; ++j) {
            const unsigned b0 = (unsigned)(int)rintf(v[j][0] * qi) & 0xffu, b1 = (unsigned)(int)rintf(v[j][1] * qi) & 0xffu, b2 = (unsigned)(int)rintf(v[j][2] * qi) & 0xffu, b3 = (unsigned)(int)rintf(v[j][3] * qi) & 0xffu;
            *(unsigned*)(XQ + (size_t)m * DM + j * 256 + lane * 4) = b0 | (b1 << 8) | (b2 << 16) | (b3 << 24); }
        if (lane == 0) SX[m] = step;
#pragma unroll
        for (int j = 0; j < 4; ++j) v[j] = vn[j];
    }
}

__device__ __forceinline__ int f2key(float f) { const int b = __float_as_int(f); return b ^ ((b >> 31) & 0x7fffffff); }
__device__ __forceinline__ float key2f(int k) { return __int_as_float(k ^ ((k >> 31) & 0x7fffffff)); }
#define CE_DESC(x, y) do { const int hi_ = max(x, y); y = min(x, y); x = hi_; } while (0)
#define CE_ASC(x, y)  do { const int lo_ = min(x, y); y = max(x, y); x = lo_; } while (0)
__device__ __forceinline__ void bitonic_sort16_desc(int (&a)[16]) {
#pragma unroll
    for (int k = 2; k <= 16; k <<= 1)
#pragma unroll
        for (int j = k >> 1; j > 0; j >>= 1)
#pragma unroll
            for (int i = 0; i < 16; ++i) { const int l = i ^ j; if (l > i) { if ((i & k) == 0) CE_DESC(a[i], a[l]); else CE_ASC(a[i], a[l]); } }
}
__device__ __forceinline__ void bitonic_merge16_desc(int (&a)[16]) {
#pragma unroll
    for (int j = 8; j > 0; j >>= 1)
#pragma unroll
        for (int i = 0; i < 16; ++i) { const int l = i ^ j; if (l > i) CE_DESC(a[i], a[l]); }
}
__device__ __forceinline__ void top16_merge(int (&T)[16], const int (&S)[16]) {
#pragma unroll
    for (int i = 0; i < 16; ++i) T[i] = max(T[i], S[15 - i]);
    bitonic_merge16_desc(T);
}
#define INS16(L, x) do { int x_ = (x); _Pragma("unroll") for (int j_ = 0; j_ < 16; ++j_) { const int hi_ = max(L[j_], x_); x_ = min(L[j_], x_); L[j_] = hi_; } } while (0)

constexpr size_t WS_PART = WS_XN;
constexpr int CT_U = 64, CT_V = 64 + 8 * 64;
constexpr int P6_TOKB = 128, P6_NITEM = NTOK / P6_TOKB, P6_TPW = P6_TOKB / 8;
constexpr size_t WS_CQ = WS_XR, WS_CS = WS_XR + 16 * MiB;
constexpr int P6_IDX = 0;
constexpr int P6_E = 0, P6_C = 8192, P6_ITEM = 16384;

__device__ __forceinline__ void p6a_phase(LAS unsigned char* lds, int G, int wave, int lane) {
    const int gw = blockIdx.x * 8 + wave, NGW = G * 8;
    const bf16_t* SC = (const bf16_t*)(A_WS + WS_XN);
    int* SELE = (int*)(A_WS + WS_SELE); float* SELG = (float*)(A_WS + WS_SELG);
    LAS int* idxb = (LAS int*)(lds + P6_IDX + wave * 4096);
    const int tl = lane >> 4, hh = (lane >> 1) & 7, half = lane & 1;
    for (int grp = gw; grp < NTOK / 4; grp += NGW) {
        const int tok = grp * 4 + tl;
        const bf16_t* sp = SC + (size_t)tok * 2048 + (lane & 15);
        int L[16];
#pragma unroll
        for (int j = 0; j < 16; ++j) L[j] = (int)0x80000000;
        {
            float sa[16], sb_[16];
#pragma unroll
            for (int e = 0; e < 16; ++e) sa[e] = bflo((unsigned)sp[16 * e]);
#pragma unroll
            for (int c0 = 0; c0 < 128; c0 += 32) {
#pragma unroll
                for (int e = 0; e < 16; ++e) sb_[e] = bflo((unsigned)sp[16 * (c0 + 16 + e)]);
                { int S[16];
#pragma unroll
                  for (int e = 0; e < 16; ++e) S[e] = (f2key(sa[e]) & ~127) | (c0 + e);
                  bitonic_sort16_desc(S);
                  if (c0 == 0) {
#pragma unroll
                      for (int e = 0; e < 16; ++e) L[e] = S[e]; } else top16_merge(L, S); }
                if (c0 + 32 < 128) {
#pragma unroll
                    for (int e = 0; e < 16; ++e) sa[e] = bflo((unsigned)sp[16 * (c0 + 32 + e)]); }
                { int S[16];
#pragma unroll
                  for (int e = 0; e < 16; ++e) S[e] = (f2key(sb_[e]) & ~127) | (c0 + 16 + e);
                  bitonic_sort16_desc(S);
                  top16_merge(L, S); }
            }
        }
#pragma unroll
        for (int j = 0; j < 16; ++j) idxb[lane * 16 + j] = L[j] & 127;
        float va[16], vb[16];
#pragma unroll
        for (int j = 0; j < 16; ++j) { const int own = L[j] & ~127, oth = __shfl_xor(own, 1); va[j] = key2f(half ? oth : own); vb[j] = key2f(half ? own : oth); }
        int C[16];
#pragma unroll
        for (int j = 0; j < 16; ++j) C[j] = (int)0x80000000;
        {   int S[16];
            S[0] = (f2key(va[0] + vb[0]) & ~255) | 0;
            S[1] = (f2key(va[0] + vb[1]) & ~255) | 1;
            S[2] = (f2key(va[0] + vb[2]) & ~255) | 2;
            S[3] = (f2key(va[0] + vb[3]) & ~255) | 3;
            S[4] = (f2key(va[0] + vb[4]) & ~255) | 4;
            S[5] = (f2key(va[0] + vb[5]) & ~255) | 5;
            S[6] = (f2key(va[0] + vb[6]) & ~255) | 6;
            S[7] = (f2key(va[0] + vb[7]) & ~255) | 7;
            S[8] = (f2key(va[0] + vb[8]) & ~255) | 8;
            S[9] = (f2key(va[0] + vb[9]) & ~255) | 9;
            S[10] = (f2key(va[0] + vb[10]) & ~255) | 10;
            S[11] = (f2key(va[0] + vb[11]) & ~255) | 11;
            S[12] = (f2key(va[0] + vb[12]) & ~255) | 12;
            S[13] = (f2key(va[0] + vb[13]) & ~255) | 13;
            S[14] = (f2key(va[0] + vb[14]) & ~255) | 14;
            S[15] = (f2key(va[0] + vb[15]) & ~255) | 15;
            bitonic_sort16_desc(S);
#pragma unroll
            for (int q = 0; q < 16; ++q) C[q] = S[q]; }
        {   int S[16];
            S[0] = (f2key(va[1] + vb[0]) & ~255) | 16;
            S[1] = (f2key(va[1] + vb[1]) & ~255) | 17;
            S[2] = (f2key(va[1] + vb[2]) & ~255) | 18;
            S[3] = (f2key(va[1] + vb[3]) & ~255) | 19;
            S[4] = (f2key(va[1] + vb[4]) & ~255) | 20;
            S[5] = (f2key(va[1] + vb[5]) & ~255) | 21;
            S[6] = (f2key(va[1] + vb[6]) & ~255) | 22;
            S[7] = (f2key(va[1] + vb[7]) & ~255) | 23;
            S[8] = (f2key(va[2] + vb[0]) & ~255) | 32;
            S[9] = (f2key(va[2] + vb[1]) & ~255) | 33;
            S[10] = (f2key(va[2] + vb[2]) & ~255) | 34;
            S[11] = (f2key(va[2] + vb[3]) & ~255) | 35;
            S[12] = (f2key(va[2] + vb[4]) & ~255) | 36;
            S[13] = (f2key(va[3] + vb[0]) & ~255) | 48;
            S[14] = (f2key(va[3] + vb[1]) & ~255) | 49;
            S[15] = (f2key(va[3] + vb[2]) & ~255) | 50;
            bitonic_sort16_desc(S);
            top16_merge(C, S); }
        {   int S[16];
            S[0] = (f2key(va[3] + vb[3]) & ~255) | 51;
            S[1] = (f2key(va[4] + vb[0]) & ~255) | 64;
            S[2] = (f2key(va[4] + vb[1]) & ~255) | 65;
            S[3] = (f2key(va[4] + vb[2]) & ~255) | 66;
            S[4] = (f2key(va[5] + vb[0]) & ~255) | 80;
            S[5] = (f2key(va[5] + vb[1]) & ~255) | 81;
            S[6] = (f2key(va[6] + vb[0]) & ~255) | 96;
            S[7] = (f2key(va[6] + vb[1]) & ~255) | 97;
            S[8] = (f2key(va[7] + vb[0]) & ~255) | 112;
            S[9] = (f2key(va[7] + vb[1]) & ~255) | 113;
            S[10] = (f2key(va[8] + vb[0]) & ~255) | 128;
            S[11] = (f2key(va[9] + vb[0]) & ~255) | 144;
            S[12] = (f2key(va[10] + vb[0]) & ~255) | 160;
            S[13] = (f2key(va[11] + vb[0]) & ~255) | 176;
            S[14] = (f2key(va[12] + vb[0]) & ~255) | 192;
            S[15] = (f2key(va[13] + vb[0]) & ~255) | 208;
            bitonic_sort16_desc(S);
            top16_merge(C, S); }
        {   int S[16];
            S[0] = (f2key(va[14] + vb[0]) & ~255) | 224;
            S[1] = (f2key(va[15] + vb[0]) & ~255) | 240;
            S[2] = (int)0x80000000;
            S[3] = (int)0x80000000;
            S[4] = (int)0x80000000;
            S[5] = (int)0x80000000;
            S[6] = (int)0x80000000;
            S[7] = (int)0x80000000;
            S[8] = (int)0x80000000;
            S[9] = (int)0x80000000;
            S[10] = (int)0x80000000;
            S[11] = (int)0x80000000;
            S[12] = (int)0x80000000;
            S[13] = (int)0x80000000;
            S[14] = (int)0x80000000;
            S[15] = (int)0x80000000;
            bitonic_sort16_desc(S);
            top16_merge(C, S); }
        const float mx = key2f(C[0] & ~255);
        float ev[16], sum = 0.f;
#pragma unroll
        for (int j = 0; j < 16; ++j) { ev[j] = __expf(key2f(C[j] & ~255) - mx); sum += ev[j]; }
        const float inv = 1.0f / sum;
        asm volatile("s_waitcnt lgkmcnt(0)" ::: "memory");
        int eo[8]; float go[8];
#pragma unroll
        for (int s = 0; s < 8; ++s) {
            int c_lo = C[s], c_hi = C[8 + s]; float e_lo = ev[s], e_hi = ev[8 + s];
            asm volatile("" : "+v"(c_lo), "+v"(c_hi), "+v"(e_lo), "+v"(e_hi));
            const int cc = half ? c_hi : c_lo; go[s] = (half ? e_hi : e_lo) * inv;
            const int ij = cc & 255, i1 = idxb[(lane & ~1) * 16 + (ij >> 4)], i2 = idxb[(lane | 1) * 16 + (ij & 15)];
            eo[s] = i1 * 128 + i2;
        }
        int* ep = SELE + (size_t)tok * 128 + hh * 16 + half * 8; float* gp = SELG + (size_t)tok * 128 + hh * 16 + half * 8;
        *(u32x4*)ep = (u32x4){(unsigned)eo[0], (unsigned)eo[1], (unsigned)eo[2], (unsigned)eo[3]}; *(u32x4*)(ep + 4) = (u32x4){(unsigned)eo[4], (unsigned)eo[5], (unsigned)eo[6], (unsigned)eo[7]};
        *(f32x4*)gp = (f32x4){go[0], go[1], go[2], go[3]}; *(f32x4*)(gp + 4) = (f32x4){go[4], go[5], go[6], go[7]};
        asm volatile("s_waitcnt lgkmcnt(0)" ::: "memory");
    }
}

__device__ __forceinline__ float dot2bf(unsigned a, unsigned b, float c) { return __builtin_amdgcn_fdot2_f32_bf16(__builtin_bit_cast(bf16x2_t, a), __builtin_bit_cast(bf16x2_t, b), c, false); }
__device__ __forceinline__ unsigned xcc_id() { return (unsigned)__builtin_amdgcn_s_getreg((3 << 11) | 20) & 0xFu; }
__device__ __forceinline__ float dpp_sum16(float v) {
    v += __builtin_bit_cast(float, __builtin_amdgcn_update_dpp(0, __builtin_bit_cast(int, v), 0xB1, 0xF, 0xF, true));
    v += __builtin_bit_cast(float, __builtin_amdgcn_update_dpp(0, __builtin_bit_cast(int, v), 0x4E, 0xF, 0xF, true));
    v += __builtin_bit_cast(float, __builtin_amdgcn_update_dpp(0, __builtin_bit_cast(int, v), 0x141, 0xF, 0xF, true));
    v += __builtin_bit_cast(float, __builtin_amdgcn_update_dpp(0, __builtin_bit_cast(int, v), 0x140, 0xF, 0xF, true));
    return v;
}
__device__ __forceinline__ bool p6_claim(LAS unsigned char* lds, unsigned* cnt, int tid, int& ring, int home, int& slice, int& item) {
    for (;;) {
        if (ring >= 8) return false;
        slice = (home + ring) & 7;
        __syncthreads();
        if (tid == 0) *(volatile LAS int*)(lds + P6_ITEM) = (int)__hip_atomic_fetch_add(cnt + 64 * slice, 1u, __ATOMIC_RELAXED, __HIP_MEMORY_SCOPE_AGENT);
        __syncthreads();
        item = *(volatile LAS int*)(lds + P6_ITEM);
        if (item < P6_NITEM) return true;
        ++ring;
    }
}

__device__ __forceinline__ float ub0(unsigned w) { return (float)(w & 0xffu); }
__device__ __forceinline__ float ub1(unsigned w) { return (float)((w >> 8) & 0xffu); }
__device__ __forceinline__ float ub2(unsigned w) { return (float)((w >> 16) & 0xffu); }
__device__ __forceinline__ float ub3(unsigned w) { return (float)(w >> 24); }
__device__ __forceinline__ float dpp_sum8(float v) {
    v += __builtin_bit_cast(float, __builtin_amdgcn_update_dpp(0, __builtin_bit_cast(int, v), 0xB1, 0xF, 0xF, true));
    v += __builtin_bit_cast(float, __builtin_amdgcn_update_dpp(0, __builtin_bit_cast(int, v), 0x4E, 0xF, 0xF, true));
    v += __builtin_bit_cast(float, __builtin_amdgcn_update_dpp(0, __builtin_bit_cast(int, v), 0x141, 0xF, 0xF, true));
    return v;
}
__device__ __forceinline__ int dpp_isum8(int v) {
    v += __builtin_amdgcn_update_dpp(0, v, 0xB1, 0xF, 0xF, true);
    v += __builtin_amdgcn_update_dpp(0, v, 0x4E, 0xF, 0xF, true);
    v += __builtin_amdgcn_update_dpp(0, v, 0x141, 0xF, 0xF, true);
    return v;
}
__device__ __forceinline__ void p6b_phase(LAS unsigned char* lds, int tid, int wave, int lane) {
    const unsigned char* XQ = A_WS + WS_XQ; const unsigned char* UB = A_WS + WS_UB; const float* SX = (const float*)(A_WS + WS_SX);
    const int* SELE = (const int*)(A_WS + WS_SELE); float* PART = (float*)(A_WS + WS_PART);
    unsigned* cnt = (unsigned*)(A_WS + WS_CTL) + CT_U;
    const int i8 = lane & 7, grp = lane >> 3, home = (int)(xcc_id() & 7u);
    LAS int* eb = (LAS int*)(lds + P6_E + wave * 1024);
    int ring = 0, slice, item;
    while (p6_claim(lds, cnt, tid, ring, home, slice, item)) {
        const int tok0 = item * P6_TOKB + wave * P6_TPW;
        int e0 = SELE[(size_t)tok0 * 128 + lane], e1 = SELE[(size_t)tok0 * 128 + 64 + lane];
#pragma unroll 2
        for (int ti = 0; ti < P6_TPW; ++ti) {
            const int tok = tok0 + ti;
            LAS int* ebt = eb + (ti & 1) * 128;
            ebt[lane] = e0; ebt[64 + lane] = e1;
            if (ti < P6_TPW - 1) { e0 = SELE[(size_t)(tok + 1) * 128 + lane]; e1 = SELE[(size_t)(tok + 1) * 128 + 64 + lane]; }
            const u32x4 xq = *(const u32x4*)(XQ + (size_t)tok * DM + slice * 128 + i8 * 16);
            const int x0 = (int)xq.x, x1 = (int)xq.y, x2 = (int)xq.z, x3 = (int)xq.w;
            const float sx = SX[tok];
            const unsigned char* ub = UB + slice * 128 + i8 * 16;
            asm volatile("s_waitcnt lgkmcnt(0)" ::: "memory");
            u32x4 uv[16];
#pragma unroll
            for (int q = 0; q < 16; ++q) { const int e = ebt[16 * grp + q]; uv[q] = *(const u32x4*)(ub + (size_t)e * DM); }
            int res0 = 0, res1 = 0;
#pragma unroll
            for (int q = 0; q < 16; ++q) {
                const int a0 = (int)uv[q].x, a1 = (int)uv[q].y, a2 = (int)uv[q].z, a3 = (int)uv[q].w;
                int d = __builtin_amdgcn_sdot4(a0, x0, 0, false); d = __builtin_amdgcn_sdot4(a1, x1, d, false); d = __builtin_amdgcn_sdot4(a2, x2, d, false); d = __builtin_amdgcn_sdot4(a3, x3, d, false);
                d = dpp_isum8(d);
                if (q < 8) res0 = (i8 == q) ? d : res0; else res1 = (i8 == (q - 8)) ? d : res1;
            }
            float* pp = PART + ((size_t)slice * NTOK + tok) * 128 + 16 * grp + i8;
            pp[0] = (float)res0 * sx; pp[8] = (float)res1 * sx;
        }
    }
}

__device__ __forceinline__ void p6m_phase(int G, int wave, int lane) {
    const int gw = blockIdx.x * 8 + wave, NGW = G * 8;
    const float* SU = (const float*)(A_WS + WS_SU); const float* SV = (const float*)(A_WS + WS_SV);
    const int* SELE = (const int*)(A_WS + WS_SELE); const float* SELG = (const float*)(A_WS + WS_SELG); const float* PART = (const float*)(A_WS + WS_PART);
    unsigned char* CQ = A_WS + WS_CQ; float* CS = (float*)(A_WS + WS_CS);
    for (int tok = gw; tok < NTOK; tok += NGW) {
        float a0 = 0.f, a1 = 0.f;
#pragma unroll
        for (int j = 0; j < 8; ++j) { const float* pp = PART + ((size_t)j * NTOK + tok) * 128; a0 += pp[lane]; a1 += pp[64 + lane]; }
        const int e0 = SELE[(size_t)tok * 128 + lane], e1 = SELE[(size_t)tok * 128 + 64 + lane];
        const float c0 = SELG[(size_t)tok * 128 + lane] * gelu_tanh(a0 * SU[e0]) * SV[e0], c1 = SELG[(size_t)tok * 128 + 64 + lane] * gelu_tanh(a1 * SU[e1]) * SV[e1];
        float mx = fmaxf(fabsf(c0), fabsf(c1));
#pragma unroll
        for (int o = 1; o < 64; o <<= 1) mx = fmaxf(mx, __shfl_xor(mx, o));
        const float cstep = fmaxf(mx, 1e-30f) * (1.0f / 127.0f), cinv = 1.0f / cstep;
        CQ[(size_t)tok * 128 + lane] = (unsigned char)((int)rintf(c0 * cinv) & 0xff); CQ[(size_t)tok * 128 + 64 + lane] = (unsigned char)((int)rintf(c1 * cinv) & 0xff);
        if (lane == 0) CS[tok] = cstep;
    }
}

__device__ __forceinline__ void p6c_phase(LAS unsigned char* lds, int tid, int wave, int lane) {
    const unsigned char* VB = A_WS + WS_VB; const int* SELE = (const int*)(A_WS + WS_SELE);
    const unsigned char* CQ = A_WS + WS_CQ; const float* CS = (const float*)(A_WS + WS_CS);
    unsigned* cnt = (unsigned*)(A_WS + WS_CTL) + CT_V;
    const int i8 = lane & 7, grp = lane >> 3, home = (int)(xcc_id() & 7u);
    LAS int* eb = (LAS int*)(lds + P6_E + wave * 1024);
    LAS int* cbb = (LAS int*)(lds + P6_C + wave * 512);
    int ring = 0, slice, item;
    while (p6_claim(lds, cnt, tid, ring, home, slice, item)) {
        const int tok0 = item * P6_TOKB + wave * P6_TPW;
        int e0 = SELE[(size_t)tok0 * 128 + lane], e1 = SELE[(size_t)tok0 * 128 + 64 + lane];
        int cw = ((const int*)(CQ + (size_t)tok0 * 128))[lane & 31];
        float cstep = CS[tok0];
#pragma unroll 2
        for (int ti = 0; ti < P6_TPW; ++ti) {
            const int tok = tok0 + ti;
            LAS int* ebt = eb + (ti & 1) * 128; LAS int* cbt = cbb + (ti & 1) * 32;
            ebt[lane] = e0; ebt[64 + lane] = e1; if (lane < 32) cbt[lane] = cw;
            const float cs = cstep;
            if (ti < P6_TPW - 1) { e0 = SELE[(size_t)(tok + 1) * 128 + lane]; e1 = SELE[(size_t)(tok + 1) * 128 + 64 + lane]; cw = ((const int*)(CQ + (size_t)(tok + 1) * 128))[lane & 31]; cstep = CS[tok + 1]; }
            bf16_t* pr = (bf16_t*)(A_WS + WS_PEER) + (size_t)tok * DM + slice * 128 + i8 * 16;
            const unsigned char* vb = VB + slice * 128 + i8 * 16;
            asm volatile("s_waitcnt lgkmcnt(0)" ::: "memory");
            u32x4 vv[16];
#pragma unroll
            for (int q = 0; q < 16; ++q) { const int e = ebt[16 * grp + q]; vv[q] = *(const u32x4*)(vb + (size_t)e * DM); }
            int acc[16];
#pragma unroll
            for (int r = 0; r < 16; ++r) acc[r] = 0;
#pragma unroll
            for (int a4 = 0; a4 < 4; ++a4) {
                const int cq = cbt[4 * grp + a4];
#pragma unroll
                for (int d = 0; d < 4; ++d) {
                    const unsigned ra = vv[4 * a4][d], rb = vv[4 * a4 + 1][d], rc = vv[4 * a4 + 2][d], rd = vv[4 * a4 + 3][d];
                    const unsigned lo = __builtin_amdgcn_perm(rb, ra, 0x05010400u), hi = __builtin_amdgcn_perm(rb, ra, 0x07030602u);
                    const unsigned lo2 = __builtin_amdgcn_perm(rd, rc, 0x05010400u), hi2 = __builtin_amdgcn_perm(rd, rc, 0x07030602u);
                    const unsigned t0 = __builtin_amdgcn_perm(lo2, lo, 0x05040100u), t1 = __builtin_amdgcn_perm(lo2, lo, 0x07060302u);
                    const unsigned t2 = __builtin_amdgcn_perm(hi2, hi, 0x05040100u), t3 = __builtin_amdgcn_perm(hi2, hi, 0x07060302u);
                    acc[4 * d + 0] = __builtin_amdgcn_sdot4((int)t0, cq, acc[4 * d + 0], false); acc[4 * d + 1] = __builtin_amdgcn_sdot4((int)t1, cq, acc[4 * d + 1], false);
                    acc[4 * d + 2] = __builtin_amdgcn_sdot4((int)t2, cq, acc[4 * d + 2], false); acc[4 * d + 3] = __builtin_amdgcn_sdot4((int)t3, cq, acc[4 * d + 3], false);
                }
            }
#pragma unroll
            for (int r = 0; r < 16; ++r) {
                acc[r] += __builtin_amdgcn_update_dpp(0, acc[r], 0x128, 0xF, 0xF, true);
                acc[r] += __shfl_xor(acc[r], 16);
                { auto rr = __builtin_amdgcn_permlane32_swap((unsigned)acc[r], (unsigned)acc[r], false, false); acc[r] = (int)rr[0] + (int)rr[1]; }
            }
            if (lane < 8) {
                u32x4 w0, w1;
                w0.x = cvtpk((float)acc[0] * cs, (float)acc[1] * cs); w0.y = cvtpk((float)acc[2] * cs, (float)acc[3] * cs); w0.z = cvtpk((float)acc[4] * cs, (float)acc[5] * cs); w0.w = cvtpk((float)acc[6] * cs, (float)acc[7] * cs);
                w1.x = cvtpk((float)acc[8] * cs, (float)acc[9] * cs); w1.y = cvtpk((float)acc[10] * cs, (float)acc[11] * cs); w1.z = cvtpk((float)acc[12] * cs, (float)acc[13] * cs); w1.w = cvtpk((float)acc[14] * cs, (float)acc[15] * cs);
                *(u32x4*)pr = w0; *(u32x4*)(pr + 8) = w1;
            }
        }
    }
}

__device__ __forceinline__ void p6d_phase(int G, int wave, int lane) {
    const int gw = blockIdx.x * 8 + wave, NGW = G * 8;
    const float* gf = A_IN(25);
    const bf16_t* DL = (const bf16_t*)(A_WS + WS_DELTA); const bf16_t* PR = (const bf16_t*)(A_WS + WS_PEER);
    f32x4 v[4], vn[4];
    if (gw < NTOK) { row_ld(xrow_ptr(gw), v, lane); row_add_bf16(DL + (size_t)gw * DM, v, lane); row_add_bf16(PR + (size_t)gw * DM, v, lane); }
    for (int m = gw; m < NTOK; m += NGW) {
        const int mn = m + NGW;
        if (mn < NTOK) { row_ld(xrow_ptr(mn), vn, lane); row_add_bf16(DL + (size_t)mn * DM, vn, lane); row_add_bf16(PR + (size_t)mn * DM, vn, lane); }
        float* yr = yrow_ptr(m);
        const float inv = 1.0f / sqrtf(wave_sum(row_ss(v)) * (1.0f / DM) + EPS);
#pragma unroll
        for (int j = 0; j < 4; ++j) { const f32x4 gg = *(const f32x4*)(gf + j * 256 + lane * 4); *(f32x4*)(yr + j * 256 + lane * 4) = v[j] * inv * gg; }
#pragma unroll
        for (int j = 0; j < 4; ++j) v[j] = vn[j];
    }
}

#define XB_TMO      128
#define XB_XCNT(j)  (256  + 64 * (j))
#define XB_XSUB(j)  (1280 + 64 * (j))
#define XB_XGEN(j)  (2304 + 64 * (j))
#define XB_TOP      3328
#define XB_TOPGEN   3392
#define XB_SPIN_CAP (1u << 22)
constexpr int CW_BAR = 2048;
constexpr int LDS_MISC = 131072 + 64;
__device__ __forceinline__ unsigned xb_ld(unsigned* p)              { return __hip_atomic_load(p, __ATOMIC_RELAXED, __HIP_MEMORY_SCOPE_AGENT); }
__device__ __forceinline__ unsigned xb_add(unsigned* p, unsigned v) { return __hip_atomic_fetch_add(p, v, __ATOMIC_RELAXED, __HIP_MEMORY_SCOPE_AGENT); }
#define XB_SPIN(cond, bar) do { unsigned _sp = 0; while (cond) { __builtin_amdgcn_s_sleep(1); \
    if ((++_sp & 255u) == 0u) { if (xb_ld(&(bar)[XB_TMO])) break; if (_sp > XB_SPIN_CAP) { atomicAdd(&(bar)[XB_TMO], 1u); break; } } } } while (0)
struct XcdBarrier { unsigned* bar; unsigned x; volatile LAS unsigned* st; };
__device__ __forceinline__ XcdBarrier xcd_barrier_post(unsigned* bar, volatile LAS unsigned* st) {
    XcdBarrier b; b.bar = bar; b.x = (unsigned)__builtin_amdgcn_s_getreg((3 << 11) | 20) & 0xFu; b.st = st;
    if (threadIdx.x == 0) (void)xb_add(&bar[XB_XCNT(b.x)], 1u);
    return b;
}
__device__ __forceinline__ void xcd_barrier_complete(unsigned* bar, unsigned x, unsigned& nloc, unsigned& nx) {
    const unsigned G = gridDim.x * gridDim.y * gridDim.z;
    unsigned sum, cnt, mine, sp = 0u;
    for (;;) {
        sum = 0u; cnt = 0u; mine = 0u;
#pragma unroll
        for (unsigned j = 0; j < 16; ++j) { const unsigned c = xb_ld(&bar[XB_XCNT(j)]); sum += c; cnt += (c > 0u) ? 1u : 0u; mine = (j == x) ? c : mine; }
        if (sum == G) break;
        __builtin_amdgcn_s_sleep(1);
        if ((++sp & 255u) == 0u) { if (xb_ld(&bar[XB_TMO])) break; if (sp > XB_SPIN_CAP) { atomicAdd(&bar[XB_TMO], 1u); break; } }
    }
    nloc = mine > 0u ? mine : 1u; nx = cnt > 0u ? cnt : 1u;
}
__device__ __forceinline__ void xcd_barrier(const XcdBarrier& b) {
    asm volatile("s_waitcnt vmcnt(0)" ::: "memory");
    __syncthreads();
    if (threadIdx.x == 0) {
        unsigned* bar = b.bar;
        __builtin_amdgcn_s_waitcnt(0);
        unsigned nloc = b.st[0], nx = b.st[1];
        if (nloc == 0u) { xcd_barrier_complete(bar, b.x, nloc, nx); b.st[0] = nloc; b.st[1] = nx; }
        const unsigned old = xb_add(&bar[XB_XSUB(b.x)], 1u);
        const unsigned gen = old / nloc;
        if (old + 1u == (gen + 1u) * nloc) {
            __builtin_amdgcn_fence(__ATOMIC_RELEASE, "agent");
            asm volatile("s_waitcnt vmcnt(0)" ::: "memory");
            const unsigned og = xb_add(&bar[XB_TOP], 1u);
            const unsigned tg = og / nx;
            if (og + 1u == (tg + 1u) * nx) xb_add(&bar[XB_TOPGEN], 1u);
            else XB_SPIN(xb_ld(&bar[XB_TOPGEN]) == tg, bar);
            __builtin_amdgcn_fence(__ATOMIC_ACQUIRE, "agent");
            xb_add(&bar[XB_XGEN(b.x)], 1u);
            asm volatile("s_waitcnt vmcnt(0)" ::: "memory");
        } else {
            XB_SPIN(xb_ld(&bar[XB_XGEN(b.x)]) == gen, bar);
            __builtin_amdgcn_fence(__ATOMIC_ACQUIRE, "agent");
            asm volatile("s_waitcnt vmcnt(0)" ::: "memory");
        }
    }
    __syncthreads();
}

template <int NACC, class Epi>
__device__ __forceinline__ void small_gemm(LAS unsigned char* lds, const bf16_t* X0, const bf16_t* W0, const bf16_t* X1, const bf16_t* W1, int N, int G, int wave, int lane, const Epi& epi) {
    const int r32 = lane & 31, hi = lane >> 5;
    LAS float* part = (LAS float*)lds;
    for (int task = blockIdx.x; task < 4 * (N / 32); task += G) {
        const int rb = task & 3, cb = task >> 2;
#pragma unroll
        for (int a = 0; a < NACC; ++a) {
            const bf16_t* xp = (a ? X1 : X0) + (size_t)(rb * 32 + r32) * DM + hi * 8 + wave * 128;
            const bf16_t* wp = (a ? W1 : W0) + (size_t)(cb * 32 + r32) * DM + hi * 8 + wave * 128;
            bf16x8 xa[8], wa[8];
#pragma unroll
            for (int q = 0; q < 8; ++q) { xa[q] = *(const bf16x8*)(xp + q * 16); wa[q] = *(const bf16x8*)(wp + q * 16); }
            f32x16 acc = f32x16{};
#pragma unroll
            for (int q = 0; q < 8; ++q) acc = __builtin_amdgcn_mfma_f32_32x32x16_bf16(wa[q], xa[q], acc, 0, 0, 0);
#pragma unroll
            for (int r = 0; r < 16; ++r) part[((a * 8 + wave) * 16 + r) * 64 + lane] = acc[r];
        }
        __syncthreads();
        if (wave < 4) {
            const int g4 = wave, t = rb * 32 + r32, n0 = cb * 32 + 8 * g4 + 4 * hi;
            f32x4 v[NACC];
#pragma unroll
            for (int a = 0; a < NACC; ++a) { v[a] = (f32x4){0.f, 0.f, 0.f, 0.f};
#pragma unroll
                for (int w = 0; w < 8; ++w)
#pragma unroll
                    for (int i = 0; i < 4; ++i) v[a][i] += part[((a * 8 + w) * 16 + 4 * g4 + i) * 64 + lane]; }
            epi(t, n0, v[0], v[NACC - 1]);
        }
        __syncthreads();
    }
}
__device__ __forceinline__ u32x2 pack4(f32x4 v) { u32x2 w; w.x = cvtpk(v[0], v[1]); w.y = cvtpk(v[2], v[3]); return w; }
struct SEpiG1 {
    __device__ __forceinline__ void operator()(int t, int n0, f32x4 v, f32x4) const {
        unsigned char* ws = A_WS; float* out = A_OUT;
        const int ts = n0 >> 10, c = n0 & 1023; const size_t ro = (size_t)(NTP + t) * DM + c;
        if (ts == 0) *(u32x2*)((bf16_t*)(ws + WS_Q) + ro) = pack4(v);
        else if (ts == 1) *(f32x4*)(out + O_KS + (size_t)t * DM + c) = v;
        else if (ts == 2) *(f32x4*)(out + O_VS + (size_t)t * DM + c) = v;
        else if (ts == 3) { *(u32x2*)((bf16_t*)(ws + WS_XR) + ro) = pack4(v);
            if ((t & 15) >= 13) *(f32x4*)(out + O_CS + ((size_t)(t >> 4) * 3 + ((t & 15) - 13)) * DM + c) = v; }
        else if (ts == 4) *(u32x2*)((bf16_t*)(ws + WS_G) + ro) = pack4(v);
        else if (ts == 5) *(u32x2*)((bf16_t*)(ws + WS_SGA) + (size_t)t * DM + c) = pack4(v);
        else *(u32x2*)((bf16_t*)(ws + WS_SGR) + (size_t)t * DM + c) = pack4(v);
    }
};
struct SEpiP3 {
    __device__ __forceinline__ void operator()(int t, int n0, f32x4 va, f32x4 vr) const {
        unsigned char* ws = A_WS;
        const u32x2 ga = *(const u32x2*)((const bf16_t*)(ws + WS_SGA) + (size_t)t * DM + n0), gr = *(const u32x2*)((const bf16_t*)(ws + WS_SGR) + (size_t)t * DM + n0);
        f32x4 m;
        m[0] = sigmoidf_(bflo(ga.x)) * va[0] + sigmoidf_(bflo(gr.x)) * vr[0]; m[1] = sigmoidf_(bfhi(ga.x)) * va[1] + sigmoidf_(bfhi(gr.x)) * vr[1];
        m[2] = sigmoidf_(bflo(ga.y)) * va[2] + sigmoidf_(bflo(gr.y)) * vr[2]; m[3] = sigmoidf_(bfhi(ga.y)) * va[3] + sigmoidf_(bfhi(gr.y)) * vr[3];
        *(u32x2*)((bf16_t*)(ws + WS_XR) + (size_t)(NTP + t) * DM + n0) = pack4(m);
    }
};
struct SEpiBf16 {
    size_t wsoff; int ld;
    __device__ __forceinline__ void operator()(int t, int n0, f32x4 v, f32x4) const { *(u32x2*)((bf16_t*)(A_WS + wsoff) + (size_t)(NTP + t) * ld + n0) = pack4(v); }
};

__global__ void __launch_bounds__(512, 2) hybrid_fwd(Args a) {
    extern __shared__ __attribute__((aligned(16))) unsigned char lds_raw[];
    LAS unsigned char* lds = (LAS unsigned char*)lds_raw;
    const int tid = threadIdx.x, lane = tid & 63, wave = __builtin_amdgcn_readfirstlane(tid >> 6), G = gridDim.x;
    cg::grid_group grid = cg::this_grid();
    unsigned char* ws = A_WS;
    if (tid < 2) ((volatile LAS unsigned*)(lds + LDS_MISC))[tid] = 0u;
    __syncthreads();
    XcdBarrier xbar; xbar.bar = (unsigned*)(ws + WS_CTL) + CW_BAR; xbar.x = 0; xbar.st = nullptr;
    if (KA->use_sync) xbar = xcd_barrier_post((unsigned*)(ws + WS_CTL) + CW_BAR, (volatile LAS unsigned*)(lds + LDS_MISC));
#define IN(k) (KA->ph_lo <= (k) && (k) < KA->ph_hi)
#define SEAM(k) do { if (KA->use_sync && IN(k) && IN((k) + 1)) { if ((k) == 0) grid.sync(); else xcd_barrier(xbar); } } while (0)
    if (IN(0)) { p0_prologue(lds, G, wave, lane); }
    SEAM(0);
    if (IN(1)) {
        pg8::Gemm g{(const bf16_t*)(ws + WS_XN), (const bf16_t*)(ws + WS_WIN), (const bf16_t*)(ws + WS_WIN) + (size_t)2048 * DM, (const bf16_t*)(ws + WS_XN), DM};
        SchedG1 S; S.init(G, blockIdx.x); EpiG1 E;
        pg8::gemm_phase(lds, g, S, E);
        { const bf16_t* xs = (const bf16_t*)(ws + WS_XN) + (size_t)NTP * DM; const bf16_t* w = (const bf16_t*)(ws + WS_WIN); SEpiG1 SE; small_gemm<1>(lds, xs, w, xs, w, INC, G, wave, lane, SE); }
    }
    SEAM(1);
    if (IN(2)) { p2_phase(lds, G, tid, wave, lane); }
    SEAM(2);
    if (IN(3)) {
        pg8::Gemm g{(const bf16_t*)(ws + WS_XN), (const bf16_t*)(ws + WS_WBA), (const bf16_t*)(ws + WS_G), (const bf16_t*)(ws + WS_WBL), DM};
        SchedPair S; S.init(4, G, blockIdx.x); EpiP3 E;
        pg8::gemm_phase(lds, g, S, E);
        { SEpiP3 SE; small_gemm<2>(lds, (const bf16_t*)(ws + WS_XN) + (size_t)NTP * DM, (const bf16_t*)(ws + WS_WBA), (const bf16_t*)(ws + WS_G) + (size_t)NTP * DM, (const bf16_t*)(ws + WS_WBL), DM, G, wave, lane, SE); }
    }
    SEAM(3);
    if (IN(4)) {
        pg8::Gemm g{(const bf16_t*)(ws + WS_XR), (const bf16_t*)(ws + WS_WO), (const bf16_t*)(ws + WS_XR), (const bf16_t*)(ws + WS_WO), DM};
        SchedOne S; S.init(4, G, blockIdx.x); EpiP4 E;
        pg8::gemm_phase(lds, g, S, E);
        { const bf16_t* xs = (const bf16_t*)(ws + WS_XR) + (size_t)NTP * DM; const bf16_t* w = (const bf16_t*)(ws + WS_WO); SEpiBf16 SE{WS_DELTA, DM}; small_gemm<1>(lds, xs, w, xs, w, DM, G, wave, lane, SE); }
    }
    SEAM(4);
    if (IN(5)) { p4b_phase(G, wave, lane); }
    SEAM(5);
    if (IN(6)) {
        pg8::Gemm g{(const bf16_t*)(ws + WS_Q), (const bf16_t*)(ws + WS_WS), (const bf16_t*)(ws + WS_Q), (const bf16_t*)(ws + WS_WS), DM};
        SchedOne S; S.init(8, G, blockIdx.x); EpiP5 E;
        pg8::gemm_phase(lds, g, S, E);
        { const bf16_t* xs = (const bf16_t*)(ws + WS_Q) + (size_t)NTP * DM; const bf16_t* w = (const bf16_t*)(ws + WS_WS); SEpiBf16 SE{WS_XN, 2048}; small_gemm<1>(lds, xs, w, xs, w, 2048, G, wave, lane, SE); }
    }
    SEAM(6);
    if (IN(7)) { p6a_phase(lds, G, wave, lane); }
    SEAM(7);
    if (IN(8)) { p6b_phase(lds, tid, wave, lane); }
    SEAM(8);
    if (IN(9)) { p6m_phase(G, wave, lane); }
    SEAM(9);
    if (IN(10)) { p6c_phase(lds, tid, wave, lane); }
    SEAM(10);
    if (IN(11)) { p6d_phase(G, wave, lane); }
#undef IN
#undef SEAM
}

#ifndef N_LAUNCH_MODE
#define N_LAUNCH_MODE 1
#endif
constexpr int NPH = 12;
extern "C" void kernel_launch(void* const* d_in, const int* in_sizes, int n_in, void* d_out, int out_size, void* d_ws, size_t ws_size, hipStream_t stream) {
    static int grid = 0;
    if (grid == 0) {
        if (n_in != 26 || (size_t)out_size != O_END || ws_size < WS_END) { fprintf(stderr, "kernel_launch: unexpected sizes n_in %d out %d ws %zu (need %zu)\n", n_in, out_size, ws_size, (size_t)WS_END); grid = -1; return; }
        int dev = 0, cus = 0, per_cu = 0;
        (void)hipGetDevice(&dev); (void)hipDeviceGetAttribute(&cus, hipDeviceAttributeMultiprocessorCount, dev);
        (void)hipFuncSetAttribute((const void*)hybrid_fwd, hipFuncAttributeMaxDynamicSharedMemorySize, LDS_BYTES);
        (void)hipOccupancyMaxActiveBlocksPerMultiprocessor(&per_cu, (const void*)hybrid_fwd, 512, LDS_BYTES);
        if (per_cu < 1) { fprintf(stderr, "kernel_launch: occupancy query says %d blocks per CU\n", per_cu); per_cu = 1; }
        grid = cus;
        (void)hipGetLastError();
    }
    if (grid < 0) return;
    (void)hipMemsetAsync((char*)d_ws + WS_CTL, 0, 32768, stream);
    Args a{};
    for (int i = 0; i < 26; ++i) a.in[i] = (const float*)d_in[i];
    a.out = (float*)d_out; a.ws = (unsigned char*)d_ws;
    if (N_LAUNCH_MODE == 1) {
        a.ph_lo = 0; a.ph_hi = NPH; a.use_sync = 1;
        void* args[] = {&a};
        hipError_t e = hipLaunchCooperativeKernel((const void*)hybrid_fwd, dim3(grid), dim3(512), args, LDS_BYTES, stream);
        if (e != hipSuccess) fprintf(stderr, "cooperative launch failed: %s (grid %d)\n", hipGetErrorString(e), grid);
    } else {
        for (int p = 0; p < NPH; ++p) { a.ph_lo = p; a.ph_hi = p + 1; a.use_sync = 0; hipLaunchKernelGGL(hybrid_fwd, dim3(grid), dim3(512), LDS_BYTES, stream, a); }
    }
}
```

```cpp
#include <hip/hip_runtime.h>
#include <hip/hip_cooperative_groups.h>
#include <cstdint>
#include <cstdio>
namespace cg = cooperative_groups;

#define LAS __attribute__((address_space(3)))
typedef unsigned short bf16_t;
typedef short bf16x8 __attribute__((ext_vector_type(8)));
typedef float f32x4 __attribute__((ext_vector_type(4)));
typedef float f32x2 __attribute__((ext_vector_type(2)));
typedef float f32x16 __attribute__((ext_vector_type(16)));
typedef unsigned u32x4 __attribute__((ext_vector_type(4)));
typedef unsigned u32x2 __attribute__((ext_vector_type(2)));
typedef __bf16 bf16x2_t __attribute__((ext_vector_type(2)));

constexpr int DM = 1024, SEQ = 4096, NB = 16, NTP = NB * SEQ, NSB = 8, NST = 16, NTS = NSB * NST, NTOK = NTP + NTS;
constexpr int ROWS = 65792, NMT = 257;
constexpr int INC = 7168, NEXP = 16384;
constexpr float EPS = 1e-6f, LOG2E = 1.4426950408889634f;
constexpr float QSCALE = 0.125f * LOG2E;

constexpr size_t MiB = 1u << 20;
constexpr size_t BUF = (size_t)ROWS * DM * 2;
constexpr size_t WS_CTL = 0;
constexpr size_t WS_WIN = 1 * MiB;
constexpr size_t WS_WBA = 16 * MiB, WS_WBL = 18 * MiB, WS_WO = 20 * MiB, WS_WS = 22 * MiB;
constexpr size_t WS_LRUW = 26 * MiB;
constexpr size_t WS_SGA = 27 * MiB, WS_SGR = 27 * MiB + 512 * 1024;
constexpr size_t WS_SU = 26 * MiB + 512 * 1024, WS_SV = 26 * MiB + 640 * 1024;
constexpr size_t WS_SX = 26 * MiB + 704 * 1024;
constexpr size_t WS_UB = 28 * MiB, WS_VB = 60 * MiB;
constexpr size_t WS_Q = 92 * MiB;
constexpr size_t WS_XN = WS_Q + BUF;
constexpr size_t WS_K = WS_XN + BUF;
constexpr size_t WS_VT = WS_K + BUF;
constexpr size_t WS_XR = WS_VT + BUF;
constexpr size_t WS_G = WS_XR + BUF;
constexpr size_t WS_END = WS_G + BUF;
constexpr size_t WS_DELTA = WS_VT;
constexpr size_t WS_PEER = WS_Q;
constexpr size_t WS_SELE = WS_G, WS_SELG = WS_G + (size_t)NTOK * 512, WS_XQ = WS_G + (size_t)NTOK * 1024;

constexpr size_t O_YP = 0, O_YS = O_YP + (size_t)NTP * DM, O_KP = O_YS + (size_t)NTS * DM, O_VP = O_KP + (size_t)NB * 512 * DM,
                 O_CP = O_VP + (size_t)NB * 512 * DM, O_LP = O_CP + (size_t)NB * 3 * DM, O_KS = O_LP + (size_t)NB * DM, O_VS = O_KS + (size_t)NTS * DM,
                 O_CS = O_VS + (size_t)NTS * DM, O_LS = O_CS + (size_t)NSB * 3 * DM, O_END = O_LS + (size_t)NSB * DM;

constexpr int LDS_BYTES = 135168;

__device__ __forceinline__ unsigned cvtpk(float lo, float hi) { f32x2 v = {lo, hi}; bf16x2_t b = __builtin_convertvector(v, bf16x2_t); return __builtin_bit_cast(unsigned, b); }
__device__ __forceinline__ float bflo(unsigned u) { return __uint_as_float(u << 16); }
__device__ __forceinline__ float bfhi(unsigned u) { return __uint_as_float(u & 0xffff0000u); }
__device__ __forceinline__ float fast_exp2(float x) { return __builtin_amdgcn_exp2f(x); }
__device__ __forceinline__ float fast_rcp(float x) { return __builtin_amdgcn_rcpf(x); }
__device__ __forceinline__ float sigmoidf_(float z) { return fast_rcp(1.0f + fast_exp2(-z * LOG2E)); }
__device__ __forceinline__ float gelu_tanh(float x) { const float u = x + 0.044715f * x * x * x; return x * fast_rcp(1.0f + fast_exp2(-1.5957691216f * LOG2E * u)); }
__device__ __forceinline__ float wave_sum(float v) {
#pragma unroll
    for (int o = 1; o < 64; o <<= 1) v += __shfl_xor(v, o);
    return v;
}
__device__ __forceinline__ int swap23(int i) { return (i & ~12) | ((i & 4) << 1) | ((i & 8) >> 1); }
__device__ __forceinline__ float plswap_max(float m) { auto rr = __builtin_amdgcn_permlane32_swap(__float_as_uint(m), __float_as_uint(m), false, false); return fmaxf(__uint_as_float(rr[0]), __uint_as_float(rr[1])); }
__device__ __forceinline__ float plswap_add(float m) { auto rr = __builtin_amdgcn_permlane32_swap(__float_as_uint(m), __float_as_uint(m), false, false); return __uint_as_float(rr[0]) + __uint_as_float(rr[1]); }

namespace pg8 {
constexpr int BM = 256, BK = 64, HALF = 128, HTB = HALF * BK * 2, STAGE_BYTES = 8 * HTB, NXCD = 8, WGM = 8;
__host__ __device__ __forceinline__ int lds_byte(int r, int c) { const int st = (r >> 4) * 2 + (c >> 5), rr = r & 15, cc = c & 31, ob = rr * 64 + cc * 2; return st * 1024 + (ob ^ (((ob >> 9) & 1) << 5)); }
__host__ __device__ __forceinline__ void stage_rc(int b, int& R, int& C) { const int st = b / 1024, sb = b % 1024, swz = sb ^ (((sb >> 9) & 1) << 5); R = (st >> 1) * 16 + swz / 64; C = (st & 1) * 32 + (swz % 64) / 2; }
__host__ __device__ __forceinline__ int perm32(int rho) { const int n = rho >> 4, i = rho & 15; return 8 * (i >> 2) + 4 * n + (i & 3); }

struct Unit { int pm, pn, kind; };
struct Gemm { const bf16_t* A0; const bf16_t* B0; const bf16_t* A1; const bf16_t* B1; int K; };

struct TileMap {
    int nM, nN, nwg;
    __device__ __forceinline__ void init(int nM_, int nN_) { nM = nM_; nN = nN_; nwg = nM * nN; }
    __device__ __forceinline__ void map(int L, int& pm, int& pn) const {
        int wgid = L; { const int q = nwg / NXCD, r = nwg % NXCD, xcd = wgid % NXCD, off = wgid / NXCD; wgid = (xcd < r ? xcd * (q + 1) : r * (q + 1) + (xcd - r) * q) + off; }
        const int nig = WGM * nN, gid = wgid / nig, fm = gid * WGM, gsz = (nM - fm) < WGM ? (nM - fm) : WGM;
        pm = fm + ((wgid % nig) % gsz); pn = (wgid % nig) / gsz;
    }
};

template <class Epi, class Sched>
__device__ __forceinline__ void gemm_phase(LAS unsigned char* lds, const Gemm g, const Sched& S, const Epi& E) {
    const int tid = threadIdx.x, wid = __builtin_amdgcn_readfirstlane(tid >> 6), lane = tid & 63, wr = wid >> 2, wc = wid & 3, fr = lane & 15, fq = lane >> 4;
    const int K = g.K, nt = K / BK;
    unsigned voffA[2], voffB[2];
#pragma unroll
    for (int i = 0; i < 2; ++i) { int R, C; stage_rc(tid * 16 + i * 8192, R, C); const int Rb = (R & ~31) + perm32(R & 31);
        voffA[i] = (unsigned)(R * K + C) * 2u; voffB[i] = (unsigned)(Rb * K + C) * 2u; }
    const size_t kstep = (size_t)(BK * 2);
    const size_t hstep = (size_t)HALF * K * 2;
    const size_t tstep = 2 * hstep;
    const unsigned ldsw = (unsigned)wid * 1024u;
    const int aoff = lds_byte(wr * 64 + fr, fq * 8), boff = lds_byte(wc * 32 + fr, fq * 8);
#define PG8_SA(b, h) (((b) * 2 + (h)) * HTB)
#define PG8_SB(b, h) ((4 + (b) * 2 + (h)) * HTB)
#define PG8_STAGE(bufoff, gbase, voff) do { _Pragma("unroll") for (int _i = 0; _i < 2; ++_i) \
        __builtin_amdgcn_global_load_lds((const unsigned*)((const char*)(gbase) + (voff)[_i]), (LAS unsigned*)(lds + (bufoff) + ldsw + _i * 8192), 16, 0, 0); } while (0)
#define PG8_LDA(dst, b, h) do { _Pragma("unroll") for (int m = 0; m < 4; ++m) _Pragma("unroll") for (int k = 0; k < 2; ++k) dst[m][k] = *(const LAS bf16x8*)(lds + PG8_SA(b, h) + aoff + m * 2048 + k * 1024); } while (0)
#define PG8_LDB(dst, b, h) do { _Pragma("unroll") for (int n = 0; n < 2; ++n) _Pragma("unroll") for (int k = 0; k < 2; ++k) dst[n][k] = *(const LAS bf16x8*)(lds + PG8_SB(b, h) + boff + n * 2048 + k * 1024); } while (0)
#define PG8_MMA(ai, bj, At, Bt) do { __builtin_amdgcn_s_setprio(1); _Pragma("unroll") for (int m = 0; m < 4; ++m) _Pragma("unroll") for (int n = 0; n < 2; ++n) _Pragma("unroll") for (int k = 0; k < 2; ++k) \
        acc[ai][bj][m][n] = __builtin_amdgcn_mfma_f32_16x16x32_bf16(Bt[n][k], At[m][k], acc[ai][bj][m][n], 0, 0, 0); __builtin_amdgcn_s_setprio(0); } while (0)
#define PG8_WAIT_V(n) asm volatile("s_waitcnt vmcnt(" #n ")" ::: "memory")
#define PG8_WAIT_L(n) asm volatile("s_waitcnt lgkmcnt(" #n ")" ::: "memory")
#define PG8_BAR __builtin_amdgcn_s_barrier()
#define PG8_SCHED __builtin_amdgcn_sched_barrier(0)
    Unit cur, nxt; int ui = 0;
    if (!S.next(0, cur)) return;
    f32x4 acc[2][2][4][2];
#pragma unroll
    for (int a = 0; a < 2; ++a)
#pragma unroll
        for (int b = 0; b < 2; ++b)
#pragma unroll
            for (int m = 0; m < 4; ++m)
#pragma unroll
                for (int n = 0; n < 2; ++n) acc[a][b][m][n] = (f32x4){0.f, 0.f, 0.f, 0.f};
    bf16x8 At[4][2], B0[2][2], B1[2][2];
    const char* cA = (const char*)(cur.kind ? g.A1 : g.A0) + (size_t)cur.pm * tstep; const char* cB = (const char*)(cur.kind ? g.B1 : g.B0) + (size_t)cur.pn * tstep;
    PG8_STAGE(PG8_SB(0, 0), cB, voffB); PG8_STAGE(PG8_SB(0, 1), cB + hstep, voffB); PG8_STAGE(PG8_SA(0, 0), cA, voffA); PG8_STAGE(PG8_SA(0, 1), cA + hstep, voffA);
    if (wr == 1) PG8_BAR;
    PG8_WAIT_V(2); PG8_BAR;
    PG8_STAGE(PG8_SB(1, 0), cB + kstep, voffB); PG8_STAGE(PG8_SA(1, 0), cA + kstep, voffA); PG8_STAGE(PG8_SB(1, 1), cB + hstep + kstep, voffB);
    PG8_WAIT_V(6); PG8_BAR;
    for (;;) {
        const bool has_next = S.next(ui + 1, nxt);
        E.prefetch(cur, lds + STAGE_BYTES + 512 + wid * 256, tid);
        const char* nA = has_next ? (const char*)(nxt.kind ? g.A1 : g.A0) + (size_t)nxt.pm * tstep : cA; const char* nB = has_next ? (const char*)(nxt.kind ? g.B1 : g.B0) + (size_t)nxt.pn * tstep : cB;
        for (int t = 0; t < nt; t += 2) {
            const bool last = (t == nt - 2);
            const char* a1 = cA + (size_t)(t + 1) * kstep;
            const char* a2 = last ? nA : cA + (size_t)(t + 2) * kstep; const char* b2 = last ? nB : cB + (size_t)(t + 2) * kstep;
            const char* a3 = a2 + kstep; const char* b3 = b2 + kstep;
            PG8_LDB(B0, 0, 0); PG8_LDB(B1, 0, 1); PG8_SCHED; PG8_LDA(At, 0, 0); PG8_STAGE(PG8_SA(1, 1), a1 + hstep, voffA);
            PG8_WAIT_V(8); PG8_WAIT_L(0); PG8_BAR; PG8_MMA(0, 0, At, B0); PG8_MMA(0, 1, At, B1); PG8_BAR; PG8_SCHED;
            PG8_LDA(At, 0, 1); PG8_STAGE(PG8_SB(0, 0), b2, voffB); PG8_STAGE(PG8_SB(0, 1), b2 + hstep, voffB); PG8_STAGE(PG8_SA(0, 0), a2, voffA);
            PG8_WAIT_V(8); PG8_WAIT_L(0); PG8_BAR; PG8_MMA(1, 0, At, B0); PG8_MMA(1, 1, At, B1); PG8_BAR; PG8_SCHED;
            PG8_LDB(B0, 1, 0); PG8_LDB(B1, 1, 1); PG8_SCHED; PG8_LDA(At, 1, 0); PG8_STAGE(PG8_SA(0, 1), a2 + hstep, voffA);
            PG8_WAIT_V(8); PG8_WAIT_L(0); PG8_BAR; PG8_MMA(0, 0, At, B0); PG8_MMA(0, 1, At, B1); PG8_BAR; PG8_SCHED;
            PG8_LDA(At, 1, 1); PG8_STAGE(PG8_SB(1, 0), b3, voffB); PG8_STAGE(PG8_SB(1, 1), b3 + hstep, voffB); PG8_STAGE(PG8_SA(1, 0), a3, voffA);
            PG8_WAIT_V(8); PG8_WAIT_L(0); PG8_BAR; PG8_MMA(1, 0, At, B0); PG8_MMA(1, 1, At, B1); PG8_BAR; PG8_SCHED;
        }
        if (wr == 0) PG8_BAR;
        E(acc, cur, wr, wc, fr, fq);
        if (!has_next) break;
#pragma unroll
        for (int a = 0; a < 2; ++a)
#pragma unroll
            for (int b = 0; b < 2; ++b)
#pragma unroll
                for (int m = 0; m < 4; ++m)
#pragma unroll
                    for (int n = 0; n < 2; ++n) acc[a][b][m][n] = (f32x4){0.f, 0.f, 0.f, 0.f};
        cur = nxt; cA = nA; cB = nB; ++ui;
        if (wr == 1) PG8_BAR;
    }
    PG8_WAIT_V(0);
    PG8_BAR;
#undef PG8_SA
#undef PG8_SB
#undef PG8_STAGE
#undef PG8_LDA
#undef PG8_LDB
#undef PG8_MMA
#undef PG8_WAIT_V
#undef PG8_WAIT_L
#undef PG8_BAR
#undef PG8_SCHED
}
}
using pg8::Unit;

struct Args {
    const float* in[26];
    float* out; unsigned char* ws;
    int ph_lo, ph_hi, use_sync, pad;
};

typedef const __attribute__((address_space(4))) Args* ArgsP;
#define KA ((ArgsP)__builtin_amdgcn_kernarg_segment_ptr())
#define A_IN(k) (KA->in[k])
#define A_OUT (KA->out)
#define A_WS (KA->ws)

struct SchedG1 {
    pg8::TileMap m0, m1; int G, c;
    __device__ __forceinline__ void init(int G_, int c_) { m0.init(256, 24); m1.init(4, 256); G = G_; c = c_; }
    __device__ __forceinline__ bool next(int i, Unit& u) const {
        int L = i * G + c;
        if (L < m0.nwg) { m0.map(L, u.pm, u.pn); u.pn = (u.pn < 8) ? u.pn : u.pn + 4; u.kind = 0; return true; }
        L -= m0.nwg; if (L >= m1.nwg) return false;
        m1.map(L, u.pm, u.pn); u.kind = 1; return true;
    }
};
struct SchedPair {
    pg8::TileMap m0; int G, c;
    __device__ __forceinline__ void init(int nN, int G_, int c_) { m0.init(256, nN); G = G_; c = c_; }
    __device__ __forceinline__ bool next(int i, Unit& u) const { const int L = (i >> 1) * G + c; if (L >= m0.nwg) return false; m0.map(L, u.pm, u.pn); u.kind = i & 1; return true; }
};
struct SchedOne {
    pg8::TileMap m0; int G, c;
    __device__ __forceinline__ void init(int nN, int G_, int c_) { m0.init(256, nN); G = G_; c = c_; }
    __device__ __forceinline__ bool next(int i, Unit& u) const { const int L = i * G + c; if (L >= m0.nwg) return false; m0.map(L, u.pm, u.pn); u.kind = 0; return true; }
};

#define EPI_PREP int fr_ = fr, fq_ = fq; asm volatile("" : "+v"(fr_), "+v"(fq_)); const int rl_ = wr * 64 + fr_, cl_ = wc * 32 + 8 * fq_;
#define EPI_LOOP_BEGIN \
    _Pragma("unroll") for (int ai = 0; ai < 2; ++ai) _Pragma("unroll") for (int m = 0; m < 4; ++m) { const int rit = ai * 128 + m * 16 + rl_; \
    _Pragma("unroll") for (int bj = 0; bj < 2; ++bj) { const int cit = bj * 128 + cl_; f32x4 v0 = acc[ai][bj][m][0], v1 = acc[ai][bj][m][1];
#define EPI_LOOP_END } }

__device__ __forceinline__ size_t kfrag_off(int row, int col) {
    return ((((size_t)(row >> 5) * 16 + (col >> 6)) * 4 + ((col >> 4) & 3)) * 64 + ((col >> 3) & 1) * 32 + swap23(row & 31)) * 8;
}
__device__ __forceinline__ size_t vfrag_off(int vc, int tok) {
    return (((((size_t)(tok >> 5) * 16 + (vc >> 6)) * 2 + ((vc >> 5) & 1)) * 2 + ((tok >> 4) & 1)) * 64 + ((tok >> 3) & 1) * 32 + swap23(vc & 31)) * 8;
}
struct EpiG1 {
    __device__ __forceinline__ void prefetch(const Unit&, LAS unsigned char*, int) const {}
    __device__ __forceinline__ void operator()(const f32x4 (&acc)[2][2][4][2], const Unit& u, int wr, int wc, int fr, int fq) const {
        EPI_PREP unsigned char* ws = A_WS; float* out = A_OUT;
        if (u.kind == 0) {
            const int t = u.pn >> 2, ct = (u.pn & 3) * 256;
            bf16_t* base;
            if (t == 0) base = (bf16_t*)(ws + WS_Q); else if (t == 1) base = (bf16_t*)(ws + WS_K); else if (t == 3) base = (bf16_t*)(ws + WS_XR); else if (t == 4) base = (bf16_t*)(ws + WS_G);
            else if (t == 5) base = (u.pm < 256) ? (bf16_t*)(out + O_YP) : (bf16_t*)(ws + WS_SGA) - (size_t)NTP * DM;
            else base = (u.pm < 256) ? (bf16_t*)(out + O_YP) + (size_t)NTP * DM : (bf16_t*)(ws + WS_SGR) - (size_t)NTP * DM;
            if (t == 1) {
                EPI_LOOP_BEGIN
                    u32x4 w; w.x = cvtpk(v0[0], v0[1]); w.y = cvtpk(v0[2], v0[3]); w.z = cvtpk(v1[0], v1[1]); w.w = cvtpk(v1[2], v1[3]);
                    *(u32x4*)(base + kfrag_off(u.pm * 256 + rit, ct + cit)) = w;
                EPI_LOOP_END
            } else {
            base += (size_t)u.pm * 256 * DM + ct;
            EPI_LOOP_BEGIN
                u32x4 w; w.x = cvtpk(v0[0], v0[1]); w.y = cvtpk(v0[2], v0[3]); w.z = cvtpk(v1[0], v1[1]); w.w = cvtpk(v1[2], v1[3]);
                *(u32x4*)(base + (size_t)rit * DM + cit) = w;
            EPI_LOOP_END
            }
            if (t == 1 && u.pm < 256 && (u.pm & 15) >= 14) { float* p0 = out + O_KP + ((size_t)(u.pm >> 4) * 512 + ((u.pm & 15) - 14) * 256) * DM + ct;
                EPI_LOOP_BEGIN float* p = p0 + (size_t)rit * DM + cit; *(f32x4*)p = v0; *(f32x4*)(p + 4) = v1; EPI_LOOP_END }
            if (t == 1 && u.pm == 256) { float* p0 = out + O_KS + ct;
                EPI_LOOP_BEGIN if (rit < NTS) { float* p = p0 + (size_t)rit * DM + cit; *(f32x4*)p = v0; *(f32x4*)(p + 4) = v1; } EPI_LOOP_END }
            if (t == 3 && u.pm < 256 && (u.pm & 15) == 15) { float* p0 = out + O_CP + ((size_t)(u.pm >> 4) * 3) * DM + ct;
                EPI_LOOP_BEGIN if (rit >= 253) { float* p = p0 + (size_t)(rit - 253) * DM + cit; *(f32x4*)p = v0; *(f32x4*)(p + 4) = v1; } EPI_LOOP_END }
            if (t == 3 && u.pm == 256) { float* p0 = out + O_CS + ct;
                EPI_LOOP_BEGIN if (rit < NTS && (rit & 15) >= 13) { float* p = p0 + ((size_t)(rit >> 4) * 3 + ((rit & 15) - 13)) * DM + cit; *(f32x4*)p = v0; *(f32x4*)(p + 4) = v1; } EPI_LOOP_END }
        } else {
            bf16_t* VT = (bf16_t*)(ws + WS_VT);
            EPI_LOOP_BEGIN
                u32x4 w; w.x = cvtpk(v0[0], v0[1]); w.y = cvtpk(v0[2], v0[3]); w.z = cvtpk(v1[0], v1[1]); w.w = cvtpk(v1[2], v1[3]);
                *(u32x4*)(VT + vfrag_off(u.pm * 256 + rit, u.pn * 256 + cit)) = w;
            EPI_LOOP_END
            if (u.pn < 256 && (u.pn & 15) >= 14) { float* p0 = out + O_VP + ((size_t)(u.pn >> 4) * 512 + ((u.pn & 15) - 14) * 256) * DM + u.pm * 256;
                EPI_LOOP_BEGIN float* p = p0 + (size_t)cit * DM + rit;
                    p[0] = v0[0]; p[DM] = v0[1]; p[2 * DM] = v0[2]; p[3 * DM] = v0[3]; p[4 * DM] = v1[0]; p[5 * DM] = v1[1]; p[6 * DM] = v1[2]; p[7 * DM] = v1[3]; EPI_LOOP_END }
            if (u.pn == 256) { float* p0 = out + O_VS + u.pm * 256;
                EPI_LOOP_BEGIN if (cit < NTS) { float* p = p0 + (size_t)cit * DM + rit;
                    p[0] = v0[0]; p[DM] = v0[1]; p[2 * DM] = v0[2]; p[3 * DM] = v0[3]; p[4 * DM] = v1[0]; p[5 * DM] = v1[1]; p[6 * DM] = v1[2]; p[7 * DM] = v1[3]; } EPI_LOOP_END }
        }
    }
};

struct EpiP3 {
    __device__ __forceinline__ void prefetch(const Unit& u, LAS unsigned char* dummy, int tid) const {
        const bf16_t* gb = (u.pm < 256) ? (const bf16_t*)(A_OUT + O_YP) + (u.kind ? (size_t)NTP * DM : 0) : (const bf16_t*)(A_WS + (u.kind ? WS_SGR : WS_SGA)) - (size_t)NTP * DM;
        const char* base = (const char*)(gb + (size_t)u.pm * 256 * DM + u.pn * 256);
        asm volatile("" : "+v"(tid));
#pragma unroll
        for (int q = 0; q < 2; ++q) { const int li = tid * 2 + q; __builtin_amdgcn_global_load_lds((const unsigned*)(base + (size_t)(li >> 2) * (DM * 2) + (li & 3) * 128), (LAS unsigned*)dummy, 4, 0, 0); }
    }
    __device__ __forceinline__ void operator()(const f32x4 (&acc)[2][2][4][2], const Unit& u, int wr, int wc, int fr, int fq) const {
        EPI_PREP unsigned char* ws = A_WS; float* out = A_OUT;
        const bf16_t* gb = (u.pm < 256) ? (const bf16_t*)(out + O_YP) + (u.kind ? (size_t)NTP * DM : 0) : (const bf16_t*)(ws + (u.kind ? WS_SGR : WS_SGA)) - (size_t)NTP * DM;
        const size_t off0 = (size_t)u.pm * 256 * DM + u.pn * 256;
        gb += off0; bf16_t* MG = (bf16_t*)(ws + WS_XR) + off0;
#pragma unroll
        for (int ai = 0; ai < 2; ++ai) {
            u32x4 gw[4][2], pw[4][2];
#pragma unroll
            for (int m = 0; m < 4; ++m)
#pragma unroll
                for (int bj = 0; bj < 2; ++bj) { const size_t off = (size_t)(ai * 128 + m * 16 + rl_) * DM + bj * 128 + cl_;
                    gw[m][bj] = *(const u32x4*)(gb + off); if (u.kind) pw[m][bj] = *(const u32x4*)(MG + off); }
#pragma unroll
            for (int m = 0; m < 4; ++m)
#pragma unroll
                for (int bj = 0; bj < 2; ++bj) { const size_t off = (size_t)(ai * 128 + m * 16 + rl_) * DM + bj * 128 + cl_;
                    const f32x4 v0 = acc[ai][bj][m][0], v1 = acc[ai][bj][m][1]; const u32x4 g4 = gw[m][bj];
                    f32x4 a0, a1;
                    a0[0] = sigmoidf_(bflo(g4.x)) * v0[0]; a0[1] = sigmoidf_(bfhi(g4.x)) * v0[1]; a0[2] = sigmoidf_(bflo(g4.y)) * v0[2]; a0[3] = sigmoidf_(bfhi(g4.y)) * v0[3];
                    a1[0] = sigmoidf_(bflo(g4.z)) * v1[0]; a1[1] = sigmoidf_(bfhi(g4.z)) * v1[1]; a1[2] = sigmoidf_(bflo(g4.w)) * v1[2]; a1[3] = sigmoidf_(bfhi(g4.w)) * v1[3];
                    if (u.kind) { const u32x4 p4 = pw[m][bj];
                        a0[0] += bflo(p4.x); a0[1] += bfhi(p4.x); a0[2] += bflo(p4.y); a0[3] += bfhi(p4.y); a1[0] += bflo(p4.z); a1[1] += bfhi(p4.z); a1[2] += bflo(p4.w); a1[3] += bfhi(p4.w); }
                    u32x4 w; w.x = cvtpk(a0[0], a0[1]); w.y = cvtpk(a0[2], a0[3]); w.z = cvtpk(a1[0], a1[1]); w.w = cvtpk(a1[2], a1[3]);
                    *(u32x4*)(MG + off) = w; }
        }
    }
};

struct EpiP4 {
    __device__ __forceinline__ void prefetch(const Unit&, LAS unsigned char*, int) const {}
    __device__ __forceinline__ void operator()(const f32x4 (&acc)[2][2][4][2], const Unit& u, int wr, int wc, int fr, int fq) const {
        EPI_PREP bf16_t* base = (bf16_t*)(A_WS + WS_DELTA) + (size_t)u.pm * 256 * DM + u.pn * 256;
        EPI_LOOP_BEGIN
            u32x4 w; w.x = cvtpk(v0[0], v0[1]); w.y = cvtpk(v0[2], v0[3]); w.z = cvtpk(v1[0], v1[1]); w.w = cvtpk(v1[2], v1[3]);
            *(u32x4*)(base + (size_t)rit * DM + cit) = w;
        EPI_LOOP_END
    }
};

struct EpiP5 {
    __device__ __forceinline__ void prefetch(const Unit&, LAS unsigned char*, int) const {}
    __device__ __forceinline__ void operator()(const f32x4 (&acc)[2][2][4][2], const Unit& u, int wr, int wc, int fr, int fq) const {
        EPI_PREP bf16_t* SC = (bf16_t*)(A_WS + WS_XN) + (size_t)u.pm * 256 * 2048 + u.pn * 256;
        EPI_LOOP_BEGIN
            u32x4 w; w.x = cvtpk(v0[0], v0[1]); w.y = cvtpk(v0[2], v0[3]); w.z = cvtpk(v1[0], v1[1]); w.w = cvtpk(v1[2], v1[3]);
            *(u32x4*)(SC + (size_t)rit * 2048 + cit) = w;
        EPI_LOOP_END
    }
};

__device__ __forceinline__ void row_ld(const float* p, f32x4 (&v)[4], int lane) {
#pragma unroll
    for (int j = 0; j < 4; ++j) v[j] = *(const f32x4*)(p + j * 256 + lane * 4);
}
__device__ __forceinline__ float row_ss(const f32x4 (&v)[4]) { float s = 0.f;
#pragma unroll
    for (int j = 0; j < 4; ++j) s += (v[j][0] * v[j][0] + v[j][1] * v[j][1]) + (v[j][2] * v[j][2] + v[j][3] * v[j][3]);
    return s; }
__device__ __forceinline__ void row_add_bf16(const bf16_t* p, f32x4 (&v)[4], int lane) {
#pragma unroll
    for (int j = 0; j < 4; ++j) { const u32x2 w = *(const u32x2*)(p + j * 256 + lane * 4); v[j][0] += bflo(w.x); v[j][1] += bfhi(w.x); v[j][2] += bflo(w.y); v[j][3] += bfhi(w.y); }
}
__device__ __forceinline__ const float* xrow_ptr(int m) { return (m < NTP) ? A_IN(0) + (size_t)m * DM : A_IN(1) + (size_t)(m - NTP) * DM; }
__device__ __forceinline__ float* yrow_ptr(int m) { return (m < NTP) ? A_OUT + O_YP + (size_t)m * DM : A_OUT + O_YS + (size_t)(m - NTP) * DM; }

__device__ __forceinline__ void p0_transpose_item(const float* W, int K, int N, bf16_t* WT, LAS float* scr, int item, int lane, int nscale = 0) {
    const int nblk = N / 32, kb = item / nblk, nb = item % nblk, k0 = 64 * kb, n0 = 32 * nb;
#pragma unroll 8
    for (int i = 0; i < 32; ++i) { const int kk = 2 * i + (lane >> 5); scr[kk * 33 + (lane & 31)] = W[(size_t)(k0 + kk) * N + n0 + (lane & 31)] * (n0 < nscale ? QSCALE : 1.0f); }
    asm volatile("s_waitcnt lgkmcnt(0)" ::: "memory");
    const int c = lane & 7;
#pragma unroll
    for (int j = 0; j < 4; ++j) { const int n = (lane >> 3) + 8 * j; const LAS float* s = scr + (8 * c) * 33 + n;
        u32x4 o; o.x = cvtpk(s[0 * 33], s[1 * 33]); o.y = cvtpk(s[2 * 33], s[3 * 33]); o.z = cvtpk(s[4 * 33], s[5 * 33]); o.w = cvtpk(s[6 * 33], s[7 * 33]);
        *(u32x4*)(WT + (size_t)(n0 + n) * K + k0 + 8 * c) = o; }
    asm volatile("s_waitcnt lgkmcnt(0)" ::: "memory");
}

__device__ __forceinline__ void p0_prologue(LAS unsigned char* lds, int G, int wave, int lane) {
    unsigned char* ws = A_WS;
    const int gw = blockIdx.x * 8 + wave, NGW = G * 8;
    LAS float* scr = (LAS float*)(lds + wave * 16384);
    constexpr int I_IN = 16 * (INC / 32), I_SQ = 16 * 32, NTR = I_IN + 3 * I_SQ;
    for (int it = gw; it < NTR; it += NGW) {
        int r = it;
        if (r < I_IN) { p0_transpose_item(A_IN(7), DM, INC, (bf16_t*)(ws + WS_WIN), scr, r, lane, 1024); continue; } r -= I_IN;
        if (r < I_SQ) { p0_transpose_item(A_IN(16), DM, DM, (bf16_t*)(ws + WS_WBA), scr, r, lane); continue; } r -= I_SQ;
        if (r < I_SQ) { p0_transpose_item(A_IN(17), DM, DM, (bf16_t*)(ws + WS_WBL), scr, r, lane); continue; } r -= I_SQ;
        p0_transpose_item(A_IN(18), DM, DM, (bf16_t*)(ws + WS_WO), scr, r, lane);
    }
    {
        const float* wq = A_IN(20); bf16_t* wst = (bf16_t*)(ws + WS_WS);
        const int r32 = lane & 31, hi = lane >> 5;
        for (int it = gw; it < 2048; it += NGW) {
            const int hj = it >> 7, kt = (it >> 5) & 3, ct = it & 31, h = hj >> 1, j = hj & 1;
            const float* ap = (j ? A_IN(22) : A_IN(21)) + ((size_t)(h * 128 + kt * 32 + r32)) * 128 + 64 * hi;
            const float* bp = wq + (size_t)(ct * 32 + r32) * 2048 + hj * 128 + 64 * hi;
            f32x16 acc = {};
#pragma unroll
            for (int s4 = 0; s4 < 16; ++s4) { const f32x4 av = *(const f32x4*)(ap + 4 * s4), bv = *(const f32x4*)(bp + 4 * s4);
                acc = __builtin_amdgcn_mfma_f32_32x32x2f32(av[0], bv[0], acc, 0, 0, 0); acc = __builtin_amdgcn_mfma_f32_32x32x2f32(av[1], bv[1], acc, 0, 0, 0);
                acc = __builtin_amdgcn_mfma_f32_32x32x2f32(av[2], bv[2], acc, 0, 0, 0); acc = __builtin_amdgcn_mfma_f32_32x32x2f32(av[3], bv[3], acc, 0, 0, 0); }
#pragma unroll
            for (int r = 0; r < 16; ++r) { const int key = kt * 32 + (r & 3) + 8 * (r >> 2) + 4 * hi;
                wst[(size_t)(key * 16 + hj) * DM + ct * 32 + r32] = (bf16_t)(cvtpk(acc[r], 0.f) & 0xffffu); }
        }
    }
    {
        f32x4 p[4], pn[4];
        if (gw < 2 * NEXP) {
#pragma unroll
            for (int q = 0; q < 4; ++q) p[q] = *(const f32x4*)(((gw >= NEXP) ? A_IN(24) + (size_t)(gw - NEXP) * DM : A_IN(23) + (size_t)gw * DM) + lane * 16 + 4 * q); }
        for (int it = gw; it < 2 * NEXP; it += NGW) {
            const int tb = it >= NEXP, e = it - tb * NEXP, itn = it + NGW;
            if (itn < 2 * NEXP) {
#pragma unroll
                for (int q = 0; q < 4; ++q) pn[q] = *(const f32x4*)(((itn >= NEXP) ? A_IN(24) + (size_t)(itn - NEXP) * DM : A_IN(23) + (size_t)itn * DM) + lane * 16 + 4 * q); }
            unsigned char* dst = ws + (tb ? WS_VB : WS_UB) + (size_t)e * DM + lane * 16;
            float mx = 0.f;
#pragma unroll
            for (int q = 0; q < 4; ++q) mx = fmaxf(mx, fmaxf(fmaxf(fabsf(p[q][0]), fabsf(p[q][1])), fmaxf(fabsf(p[q][2]), fabsf(p[q][3]))));
#pragma unroll
            for (int o = 1; o < 64; o <<= 1) mx = fmaxf(mx, __shfl_xor(mx, o));
            const float step = fmaxf(mx, 1e-30f) * (1.0f / 127.0f), inv = 1.0f / step;
            u32x4 w;
#pragma unroll
            for (int q = 0; q < 4; ++q) {
                const unsigned b0 = (unsigned)(int)rintf(p[q][0] * inv) & 0xffu, b1 = (unsigned)(int)rintf(p[q][1] * inv) & 0xffu, b2 = (unsigned)(int)rintf(p[q][2] * inv) & 0xffu, b3 = (unsigned)(int)rintf(p[q][3] * inv) & 0xffu;
                w[q] = b0 | (b1 << 8) | (b2 << 16) | (b3 << 24); }
            *(u32x4*)dst = w;
            if (lane == 0) ((float*)(ws + (tb ? WS_SV : WS_SU)))[e] = step;
#pragma unroll
            for (int q = 0; q < 4; ++q) p[q] = pn[q];
        }
    }
    {
        const float* gm = A_IN(6); bf16_t* XN = (bf16_t*)(ws + WS_XN);
        for (int m = NTOK + gw; m < ROWS; m += NGW) {
#pragma unroll
            for (int j = 0; j < 2; ++j) *(u32x4*)(XN + (size_t)m * DM + j * 512 + lane * 8) = (u32x4){0u, 0u, 0u, 0u}; }
        f32x4 v[4], vn[4];
        if (gw < NTOK) row_ld(xrow_ptr(gw), v, lane);
        for (int m = gw; m < NTOK; m += NGW) {
            const int mn = m + NGW;
            if (mn < NTOK) row_ld(xrow_ptr(mn), vn, lane);
            bf16_t* orow = XN + (size_t)m * DM;
            const float inv = 1.0f / sqrtf(wave_sum(row_ss(v)) * (1.0f / DM) + EPS);
#pragma unroll
            for (int j = 0; j < 4; ++j) { const f32x4 gg = *(const f32x4*)(gm + j * 256 + lane * 4); const f32x4 y = v[j] * inv * gg;
                u32x2 w; w.x = cvtpk(y[0], y[1]); w.y = cvtpk(y[2], y[3]); *(u32x2*)(orow + j * 256 + lane * 4) = w; }
#pragma unroll
            for (int j = 0; j < 4; ++j) v[j] = vn[j];
        }
    }
    {
        bf16_t* fw = (bf16_t*)(ws + WS_LRUW);
        for (int f = gw; f < 256; f += NGW) {
            const int ks = f & 3, T = (f >> 2) & 1, gate = (f >> 3) & 1, g = f >> 4, i = lane & 31, hi = lane >> 5;
            const int outc = 32 * T + swap23(i);
            const float* W = (gate ? A_IN(13) : A_IN(11)) + (size_t)g * 4096;
            float x[8];
#pragma unroll
            for (int j = 0; j < 8; ++j) x[j] = W[(16 * ks + 8 * hi + j) * 64 + outc];
            u32x4 w; w.x = cvtpk(x[0], x[1]); w.y = cvtpk(x[2], x[3]); w.z = cvtpk(x[4], x[5]); w.w = cvtpk(x[6], x[7]);
            *(u32x4*)(fw + (size_t)f * 512 + lane * 8) = w;
        }
    }
}

constexpr int LR_WF = 0, LR_CW = 16384, LR_CB = LR_CW + 1024, LR_BR = LR_CB + 256, LR_BI = LR_BR + 256, LR_CS = LR_BI + 256, LR_CARRY = LR_CS + 256, LR_SEQ = LR_CARRY + 2048, LR_END = LR_SEQ + 64;

__device__ __forceinline__ void lru_load_consts(LAS unsigned char* lds, int g, int tid) {
    const u32x4* src = (const u32x4*)(A_WS + WS_LRUW + (size_t)g * 16384);
    for (int i = tid; i < 1024; i += 512) ((LAS u32x4*)(lds + LR_WF))[i] = src[i];
    if (tid < 256) ((LAS float*)(lds + LR_CW))[tid] = A_IN(9)[(tid >> 6) * DM + g * 64 + (tid & 63)];
    if (tid < 64) {
        const int c = g * 64 + tid;
        ((LAS float*)(lds + LR_CB))[tid] = A_IN(10)[c]; ((LAS float*)(lds + LR_BR))[tid] = A_IN(12)[c]; ((LAS float*)(lds + LR_BI))[tid] = A_IN(14)[c];
        ((LAS float*)(lds + LR_CS))[tid] = 8.0f * log1pf(expf(-A_IN(15)[c]));
    }
    if (tid < 8) ((LAS unsigned*)(lds + LR_SEQ))[tid] = 0xffffffffu;
}

template <bool SAMPLE>
__device__ __forceinline__ void lru_tile(LAS unsigned char* lds, int lane, int g, size_t rowbase, int tile, int bidx) {
    asm volatile("" : "+v"(lane));
    const int tl = lane & 31, hi = lane >> 5, t = tile * 32 + tl;
    const bf16_t* XR = (const bf16_t*)(A_WS + WS_XR); bf16_t* Gb = (bf16_t*)(A_WS + WS_G);
    const int cbase = g * 64 + 8 * hi;
    float xc[4][8];
    bf16x8 xf[4];
#pragma unroll
    for (int ks = 0; ks < 4; ++ks) {
        const f32x4 b0 = *(const LAS f32x4*)(lds + LR_CB + (16 * ks + 8 * hi) * 4), b1 = *(const LAS f32x4*)(lds + LR_CB + (16 * ks + 8 * hi) * 4 + 16);
#pragma unroll
        for (int j = 0; j < 4; ++j) { xc[ks][j] = b0[j]; xc[ks][4 + j] = b1[j]; }
#pragma unroll
        for (int tap = 0; tap < 4; ++tap) {
            const int rr = t - 3 + tap;
            float xv[8];
            {
                u32x4 w = *(const u32x4*)(XR + (rowbase + (rr < 0 ? 0 : rr)) * DM + cbase + 16 * ks);
                if (rr < 0) w = (u32x4){0u, 0u, 0u, 0u};
                xv[0] = bflo(w.x); xv[1] = bfhi(w.x); xv[2] = bflo(w.y); xv[3] = bfhi(w.y); xv[4] = bflo(w.z); xv[5] = bfhi(w.z); xv[6] = bflo(w.w); xv[7] = bfhi(w.w);
            }
            if (SAMPLE) {
                const float* sp = A_IN(4) + ((size_t)bidx * 3 + (rr < 0 ? 3 + rr : 0)) * DM + cbase + 16 * ks;
                const f32x4 p = *(const f32x4*)sp, q = *(const f32x4*)(sp + 4);
#pragma unroll
                for (int j = 0; j < 4; ++j) { xv[j] = rr < 0 ? p[j] : xv[j]; xv[4 + j] = rr < 0 ? q[j] : xv[4 + j]; }
            }
            const f32x4 w0 = *(const LAS f32x4*)(lds + LR_CW + (tap * 64 + 16 * ks + 8 * hi) * 4), w1 = *(const LAS f32x4*)(lds + LR_CW + (tap * 64 + 16 * ks + 8 * hi) * 4 + 16);
#pragma unroll
            for (int j = 0; j < 4; ++j) { xc[ks][j] += w0[j] * xv[j]; xc[ks][4 + j] += w1[j] * xv[4 + j]; }
        }
        u32x4 w; w.x = cvtpk(xc[ks][0], xc[ks][1]); w.y = cvtpk(xc[ks][2], xc[ks][3]); w.z = cvtpk(xc[ks][4], xc[ks][5]); w.w = cvtpk(xc[ks][6], xc[ks][7]);
        xf[ks] = __builtin_bit_cast(bf16x8, w);
        asm volatile("" ::: "memory");
    }
    float A[32], B[32];
#pragma unroll
    for (int T = 0; T < 2; ++T) {
        f32x16 ar = f32x16{}, ai = f32x16{};
#pragma unroll
        for (int ks = 0; ks < 4; ++ks) {
            const bf16x8 wr_ = *(const LAS bf16x8*)(lds + LR_WF + ((0 * 2 + T) * 4 + ks) * 1024 + lane * 16);
            const bf16x8 wi_ = *(const LAS bf16x8*)(lds + LR_WF + ((1 * 2 + T) * 4 + ks) * 1024 + lane * 16);
            ar = __builtin_amdgcn_mfma_f32_32x32x16_bf16(wr_, xf[ks], ar, 0, 0, 0);
            ai = __builtin_amdgcn_mfma_f32_32x32x16_bf16(wi_, xf[ks], ai, 0, 0, 0);
        }
#pragma unroll
        for (int q = 0; q < 2; ++q) {
            const int ks = 2 * T + q, lo = (16 * ks + 8 * hi) * 4;
            const f32x4 br0 = *(const LAS f32x4*)(lds + LR_BR + lo), br1 = *(const LAS f32x4*)(lds + LR_BR + lo + 16);
            const f32x4 bi0 = *(const LAS f32x4*)(lds + LR_BI + lo), bi1 = *(const LAS f32x4*)(lds + LR_BI + lo + 16);
            const f32x4 cs0 = *(const LAS f32x4*)(lds + LR_CS + lo), cs1 = *(const LAS f32x4*)(lds + LR_CS + lo + 16);
#pragma unroll
            for (int j = 0; j < 8; ++j) {
                const int r = 8 * q + j;
                const float brv = j < 4 ? br0[j & 3] : br1[j & 3], biv = j < 4 ? bi0[j & 3] : bi1[j & 3], csv = j < 4 ? cs0[j & 3] : cs1[j & 3];
                const float rg = sigmoidf_(ar[r] + brv), ig = sigmoidf_(ai[r] + biv);
                const float la = -csv * rg, av = fast_exp2(la * LOG2E);
                const float x2 = 2.0f * la;
                const float em = (x2 > -0.03f) ? -x2 * (1.0f + x2 * (0.5f + x2 * (0.16666667f + x2 * 0.041666668f))) : 1.0f - fast_exp2(x2 * LOG2E);
                A[16 * T + r] = av; B[16 * T + r] = sqrtf(em) * ig * xc[ks][j];
            }
        }
        asm volatile("" ::: "memory");
    }
#define LRU_STEP(CTRL, RM) _Pragma("unroll") for (int c = 0; c < 32; ++c) { \
        const float as_ = __builtin_bit_cast(float, __builtin_amdgcn_update_dpp(__builtin_bit_cast(int, 1.0f), __builtin_bit_cast(int, A[c]), CTRL, RM, 0xF, false)); \
        const float bs_ = __builtin_bit_cast(float, __builtin_amdgcn_update_dpp(0, __builtin_bit_cast(int, B[c]), CTRL, RM, 0xF, false)); \
        B[c] = A[c] * bs_ + B[c]; A[c] = A[c] * as_; }
    LRU_STEP(0x111, 0xF) LRU_STEP(0x112, 0xF) LRU_STEP(0x114, 0xF) LRU_STEP(0x118, 0xF) LRU_STEP(0x142, 0xA)
#undef LRU_STEP
    float hin[32];
    if (SAMPLE) {
        const float* hp = A_IN(5) + (size_t)bidx * DM + cbase;
#pragma unroll
        for (int ks = 0; ks < 4; ++ks) { const f32x4 p = *(const f32x4*)(hp + 16 * ks), q = *(const f32x4*)(hp + 16 * ks + 4);
#pragma unroll
            for (int j = 0; j < 4; ++j) { hin[8 * ks + j] = p[j]; hin[8 * ks + 4 + j] = q[j]; } }
    } else if (tile == 0) {
#pragma unroll
        for (int c = 0; c < 32; ++c) hin[c] = 0.f;
    } else {
        volatile LAS unsigned* sq = (volatile LAS unsigned*)(lds + LR_SEQ) + (tile & 7);
        while (*sq != (unsigned)tile) __builtin_amdgcn_s_sleep(1);
        asm volatile("" ::: "memory");
        const LAS float* cp = (const LAS float*)(lds + LR_CARRY) + (tile & 7) * 64 + 8 * hi;
#pragma unroll
        for (int ks = 0; ks < 4; ++ks) { const f32x4 p = *(const LAS f32x4*)(cp + 16 * ks), q = *(const LAS f32x4*)(cp + 16 * ks + 4);
#pragma unroll
            for (int j = 0; j < 4; ++j) { hin[8 * ks + j] = p[j]; hin[8 * ks + 4 + j] = q[j]; } }
    }
#pragma unroll
    for (int c = 0; c < 32; ++c) B[c] = B[c] + A[c] * hin[c];
    if (!SAMPLE) {
        if (tl == 31) {
            if (tile < 127) {
                LAS float* cp = (LAS float*)(lds + LR_CARRY) + ((tile + 1) & 7) * 64 + 8 * hi;
#pragma unroll
                for (int ks = 0; ks < 4; ++ks) { *(LAS f32x4*)(cp + 16 * ks) = (f32x4){B[8 * ks], B[8 * ks + 1], B[8 * ks + 2], B[8 * ks + 3]};
                    *(LAS f32x4*)(cp + 16 * ks + 4) = (f32x4){B[8 * ks + 4], B[8 * ks + 5], B[8 * ks + 6], B[8 * ks + 7]}; }
            } else {
                float* lp = A_OUT + O_LP + (size_t)bidx * DM + cbase;
#pragma unroll
                for (int ks = 0; ks < 4; ++ks) { *(f32x4*)(lp + 16 * ks) = (f32x4){B[8 * ks], B[8 * ks + 1], B[8 * ks + 2], B[8 * ks + 3]};
                    *(f32x4*)(lp + 16 * ks + 4) = (f32x4){B[8 * ks + 4], B[8 * ks + 5], B[8 * ks + 6], B[8 * ks + 7]}; }
            }
        }
        if (tile < 127) {
            asm volatile("s_waitcnt lgkmcnt(0)" ::: "memory");
            if (lane == 63) *((volatile LAS unsigned*)(lds + LR_SEQ) + ((tile + 1) & 7)) = (unsigned)(tile + 1);
        }
    } else if (tl == 15) {
        float* lp = A_OUT + O_LS + (size_t)bidx * DM + cbase;
#pragma unroll
        for (int ks = 0; ks < 4; ++ks) { *(f32x4*)(lp + 16 * ks) = (f32x4){B[8 * ks], B[8 * ks + 1], B[8 * ks + 2], B[8 * ks + 3]};
            *(f32x4*)(lp + 16 * ks + 4) = (f32x4){B[8 * ks + 4], B[8 * ks + 5], B[8 * ks + 6], B[8 * ks + 7]}; }
    }
    if (!SAMPLE || tl < NST) {
        bf16_t* gp = Gb + (rowbase + t) * DM + cbase;
#pragma unroll
        for (int ks = 0; ks < 4; ++ks) {
            const u32x4 w = *(const u32x4*)(gp + 16 * ks);
            float gv[8]; gv[0] = bflo(w.x); gv[1] = bfhi(w.x); gv[2] = bflo(w.y); gv[3] = bfhi(w.y); gv[4] = bflo(w.z); gv[5] = bfhi(w.z); gv[6] = bflo(w.w); gv[7] = bfhi(w.w);
            float o[8];
#pragma unroll
            for (int j = 0; j < 8; ++j) o[j] = B[8 * ks + j] * gelu_tanh(gv[j]);
            u32x4 ow; ow.x = cvtpk(o[0], o[1]); ow.y = cvtpk(o[2], o[3]); ow.z = cvtpk(o[4], o[5]); ow.w = cvtpk(o[6], o[7]);
            *(u32x4*)(gp + 16 * ks) = ow;
        }
    }
}

constexpr int P2_Q = 20608;
constexpr int AT_TAB = 24576;
__device__ __forceinline__ void attn_unit(LAS unsigned char* lds, int lane, int b, int c, int h) {
    const int r32 = lane & 31, hi = lane >> 5, kr = swap23(r32);
    const bf16_t* Q = (const bf16_t*)(A_WS + WS_Q); const bf16_t* Kb = (const bf16_t*)(A_WS + WS_K); const bf16_t* VT = (const bf16_t*)(A_WS + WS_VT); bf16_t* O = (bf16_t*)(A_WS + WS_XN);
    const size_t row0 = (size_t)b * SEQ + (size_t)c * 64;
    bf16x8 qf[2][4];
#pragma unroll
    for (int qb = 0; qb < 2; ++qb)
#pragma unroll
        for (int ks = 0; ks < 4; ++ks) qf[qb][ks] = *(const bf16x8*)(Q + (row0 + qb * 32 + r32) * DM + h * 64 + ks * 16 + hi * 8);
    f32x16 o[2][2];
#pragma unroll
    for (int i = 0; i < 2; ++i)
#pragma unroll
        for (int j = 0; j < 2; ++j) o[i][j] = f32x16{};
    float mrow[2] = {-1e30f, -1e30f}, lrow[2] = {0.f, 0.f};
    const LAS float* tab = (const LAS float*)(lds + AT_TAB) + h * 320;
    const float cfar = tab[256];
    const int sb0 = (c >= 8 ? c - 8 : 0) * 2, sb1 = c * 2 + 1;
    const bf16_t* kbase = Kb + ((size_t)b * 128 * 16 + h) * 4 * 512 + lane * 8;
    const bf16_t* vbase = VT + ((size_t)b * 128 * 16 + h) * 4 * 512 + lane * 8;
    bf16x8 kf[4], vf[2][2];
#pragma unroll
    for (int ks = 0; ks < 4; ++ks) kf[ks] = *(const bf16x8*)(kbase + (size_t)sb0 * 32768 + ks * 512);
#pragma unroll
    for (int db = 0; db < 2; ++db)
#pragma unroll
        for (int s = 0; s < 2; ++s) vf[db][s] = *(const bf16x8*)(vbase + (size_t)sb0 * 32768 + (db * 2 + s) * 512);
    for (int sb = sb0; sb <= sb1; ++sb) {
        const int sbn = sb < sb1 ? sb + 1 : sb;
        f32x16 S[2];
#pragma unroll
        for (int qb = 0; qb < 2; ++qb) { S[qb] = f32x16{};
#pragma unroll
            for (int ks = 0; ks < 4; ++ks) S[qb] = __builtin_amdgcn_mfma_f32_32x32x16_bf16(kf[ks], qf[qb][ks], S[qb], 0, 0, 0); }
        asm volatile("" ::: "memory");
#pragma unroll
        for (int ks = 0; ks < 4; ++ks) kf[ks] = *(const bf16x8*)(kbase + (size_t)sbn * 32768 + ks * 512);
        const int delta = c - (sb >> 1), rb = sb & 1;
        if (delta >= 3) {
#pragma unroll
            for (int qb = 0; qb < 2; ++qb)
#pragma unroll
                for (int r = 0; r < 16; ++r) S[qb][r] += cfar;
        } else {
#pragma unroll
            for (int qb = 0; qb < 2; ++qb) {
                const LAS float* tp = tab + (64 * delta + 32 * qb + r32 + 128 - 32 * rb - 8 * hi - 23);
#pragma unroll
                for (int r = 0; r < 16; ++r) S[qb][r] += tp[23 - (16 * (r >> 3) + (r & 7))];
            }
        }
        float rm[2];
#pragma unroll
        for (int qb = 0; qb < 2; ++qb) { float mx = S[qb][0];
#pragma unroll
            for (int r = 1; r < 16; ++r) mx = fmaxf(mx, S[qb][r]);
            rm[qb] = plswap_max(mx); }
        if (__any((rm[0] > mrow[0] + 8.0f) || (rm[1] > mrow[1] + 8.0f))) {
#pragma unroll
            for (int qb = 0; qb < 2; ++qb) { const float mn = fmaxf(mrow[qb], rm[qb]); const float al = fast_exp2(mrow[qb] - mn); lrow[qb] *= al; mrow[qb] = mn;
#pragma unroll
                for (int r = 0; r < 16; ++r) { o[0][qb][r] *= al; o[1][qb][r] *= al; } }
        }
        bf16x8 pf[2][2];
#pragma unroll
        for (int qb = 0; qb < 2; ++qb) { float sum = 0.f;
#pragma unroll
            for (int r = 0; r < 16; ++r) { S[qb][r] = fast_exp2(S[qb][r] - mrow[qb]); sum += S[qb][r]; }
            lrow[qb] += sum;
#pragma unroll
            for (int s = 0; s < 2; ++s) { u32x4 w; w.x = cvtpk(S[qb][8 * s], S[qb][8 * s + 1]); w.y = cvtpk(S[qb][8 * s + 2], S[qb][8 * s + 3]); w.z = cvtpk(S[qb][8 * s + 4], S[qb][8 * s + 5]); w.w = cvtpk(S[qb][8 * s + 6], S[qb][8 * s + 7]);
                pf[qb][s] = __builtin_bit_cast(bf16x8, w); } }
#pragma unroll
        for (int db = 0; db < 2; ++db)
#pragma unroll
            for (int qb = 0; qb < 2; ++qb)
#pragma unroll
                for (int s = 0; s < 2; ++s) o[db][qb] = __builtin_amdgcn_mfma_f32_32x32x16_bf16(vf[db][s], pf[qb][s], o[db][qb], 0, 0, 0);
        asm volatile("" ::: "memory");
#pragma unroll
        for (int db = 0; db < 2; ++db)
#pragma unroll
            for (int s = 0; s < 2; ++s) vf[db][s] = *(const bf16x8*)(vbase + (size_t)sbn * 32768 + (db * 2 + s) * 512);
    }
#pragma unroll
    for (int qb = 0; qb < 2; ++qb) { const float inv = fast_rcp(plswap_add(lrow[qb]));
        bf16_t* op = O + (row0 + qb * 32 + r32) * DM + h * 64 + 8 * hi;
#pragma unroll
        for (int db = 0; db < 2; ++db)
#pragma unroll
            for (int s = 0; s < 2; ++s) { u32x4 w;
                w.x = cvtpk(o[db][qb][8 * s] * inv, o[db][qb][8 * s + 1] * inv); w.y = cvtpk(o[db][qb][8 * s + 2] * inv, o[db][qb][8 * s + 3] * inv);
                w.z = cvtpk(o[db][qb][8 * s + 4] * inv, o[db][qb][8 * s + 5] * inv); w.w = cvtpk(o[db][qb][8 * s + 6] * inv, o[db][qb][8 * s + 7] * inv);
                *(u32x4*)(op + 32 * db + 16 * s) = w; } }
}

constexpr int AS_P = 45056;
__device__ __forceinline__ void attn_sample_task(LAS unsigned char* lds, int wave, int lane, int task) {
    const int bs = task >> 6, h = (task >> 2) & 15, qg = task & 3;
    const bf16_t* Q = (const bf16_t*)(A_WS + WS_Q); bf16_t* O = (bf16_t*)(A_WS + WS_XN);
    const float* ck = A_IN(2); const float* cv = A_IN(3); const float* kn = A_OUT + O_KS; const float* vn = A_OUT + O_VS;
    LAS float* pb = (LAS float*)(lds + AS_P + wave * 9472);
    LAS float* qs = pb + 4 * 528;
    const LAS float* tab = (const LAS float*)(lds + AT_TAB) + h * 320;
#pragma unroll
    for (int i = 0; i < 4; ++i) qs[i * 64 + lane] = bflo((unsigned)Q[((size_t)NTP + bs * 16 + qg * 4 + i) * DM + h * 64 + lane]);
    asm volatile("s_waitcnt lgkmcnt(0)" ::: "memory");
#pragma unroll 1
    for (int it = 0; it < 9; ++it) {
        const int key = it * 64 + lane; const bool valid = key < 528;
        const float* kp = !valid ? ck : (key < 512 ? ck + (((size_t)bs * 512 + key) * 16 + h) * 64 : kn + ((size_t)bs * 16 + (key - 512)) * DM + h * 64);
        float d[4] = {0.f, 0.f, 0.f, 0.f};
        f32x4 kv[16];
#pragma unroll
        for (int d4 = 0; d4 < 16; ++d4) kv[d4] = *(const f32x4*)(kp + 4 * d4);
#pragma unroll
        for (int d4 = 0; d4 < 16; ++d4) {
#pragma unroll
            for (int i = 0; i < 4; ++i) { const f32x4 qq = *(const LAS f32x4*)(qs + i * 64 + 4 * d4); d[i] += (kv[d4][0] * qq[0] + kv[d4][1] * qq[1]) + (kv[d4][2] * qq[2] + kv[d4][3] * qq[3]); } }
        int rel = 512 + qg * 4 - key;
        if (valid) {
#pragma unroll
            for (int i = 0; i < 4; ++i) { int r = rel + i; r = r > 128 ? 128 : r; pb[i * 528 + key] = d[i] + tab[r + 128]; } }
    }
    asm volatile("s_waitcnt lgkmcnt(0)" ::: "memory");
#pragma unroll 1
    for (int i = 0; i < 4; ++i) {
        float mx = -1e30f;
#pragma unroll 1
        for (int key = lane; key < 528; key += 64) mx = fmaxf(mx, pb[i * 528 + key]);
#pragma unroll
        for (int o = 1; o < 64; o <<= 1) mx = fmaxf(mx, __shfl_xor(mx, o));
        float sum = 0.f;
#pragma unroll 1
        for (int key = lane; key < 528; key += 64) { const float pv = fast_exp2(pb[i * 528 + key] - mx); pb[i * 528 + key] = pv; sum += pv; }
        sum = wave_sum(sum); const float inv = 1.0f / sum;
#pragma unroll 1
        for (int key = lane; key < 528; key += 64) pb[i * 528 + key] *= inv;
    }
    asm volatile("s_waitcnt lgkmcnt(0)" ::: "memory");
    float acc[4] = {0.f, 0.f, 0.f, 0.f};
#pragma unroll 1
    for (int k0 = 0; k0 < 528; k0 += 16) {
        float vv[16];
#pragma unroll
        for (int kk = 0; kk < 16; ++kk) { const int key = k0 + kk; vv[kk] = k0 < 512 ? cv[(((size_t)bs * 512 + key) * 16 + h) * 64 + lane] : vn[((size_t)bs * 16 + (key - 512)) * DM + h * 64 + lane]; }
#pragma unroll
        for (int kk = 0; kk < 16; ++kk) {
#pragma unroll
            for (int i = 0; i < 4; ++i) acc[i] += pb[i * 528 + k0 + kk] * vv[kk]; }
    }
#pragma unroll
    for (int i = 0; i < 4; ++i) O[((size_t)NTP + bs * 16 + qg * 4 + i) * DM + h * 64 + lane] = (bf16_t)(cvtpk(acc[i], 0.f) & 0xffffu);
    asm volatile("s_waitcnt lgkmcnt(0)" ::: "memory");
}

__device__ __forceinline__ void p2_phase(LAS unsigned char* lds, int G, int tid, int wave, int lane) {
    for (int i = tid; i < 16 * 320; i += 512) { const int h = i / 320, j = i % 320; ((LAS float*)(lds + AT_TAB))[i] = A_IN(8)[h * 257 + (j > 256 ? 256 : j)] * LOG2E; }
    for (int u = blockIdx.x; u < 256 + 16; u += G) {
        __syncthreads();
        if (u < 256) {
            const int b = u >> 4, g = u & 15;
            lru_load_consts(lds, g, tid);
            __syncthreads();
            for (int tile = wave; tile < 128; tile += 8) lru_tile<false>(lds, lane, g, (size_t)b * SEQ, tile, b);
        } else {
            const int g = u - 256;
            lru_load_consts(lds, g, tid);
            __syncthreads();
            lru_tile<true>(lds, lane, g, (size_t)NTP + wave * 16, 0, wave);
        }
    }
    if (tid == 0) *(volatile LAS int*)(lds + P2_Q) = 0;
    __syncthreads();
    const int NGW = G * 8;
    int nS = 0; for (int t = blockIdx.x; t < 512; t += G) ++nS;
    for (;;) {
        int j = 0;
        if (lane == 0) j = __hip_atomic_fetch_add((LAS int*)(lds + P2_Q), 1, __ATOMIC_RELAXED, __HIP_MEMORY_SCOPE_WORKGROUP);
        j = __builtin_amdgcn_readfirstlane(j);
        if (j < nS) { attn_sample_task(lds, wave, lane, blockIdx.x + G * j); continue; }
        j -= nS;
        const int u = blockIdx.x * 8 + (j & 7) + NGW * (j >> 3);
        if (u >= NB * 64 * 16) break;
        const int c = u & 63, h = (u >> 6) & 15, b = u >> 10;
        attn_unit(lds, lane, b, c, h);
    }
}

__device__ __forceinline__ void p4b_phase(int G, int wave, int lane) {
    const int gw = blockIdx.x * 8 + wave, NGW = G * 8;
    const float* gm = A_IN(19); bf16_t* XT = (bf16_t*)(A_WS + WS_Q); unsigned char* XQ = A_WS + WS_XQ; float* SX = (float*)(A_WS + WS_SX);
    const bf16_t* DL = (const bf16_t*)(A_WS + WS_DELTA);
    f32x4 v[4], vn[4];
    if (gw < NTOK) { row_ld(xrow_ptr(gw), v, lane); row_add_bf16(DL + (size_t)gw * DM, v, lane); }
    for (int m = gw; m < NTOK; m += NGW) {
        const int mn = m + NGW;
        if (mn < NTOK) { row_ld(xrow_ptr(mn), vn, lane); row_add_bf16(DL + (size_t)mn * DM, vn, lane); }
        bf16_t* orow = XT + (size_t)m * DM;
        const float inv = 1.0f / sqrtf(wave_sum(row_ss(v)) * (1.0f / DM) + EPS);
        float mx = 0.f;
#pragma unroll
        for (int j = 0; j < 4; ++j) { const f32x4 gg = *(const f32x4*)(gm + j * 256 + lane * 4); v[j] = v[j] * inv * gg;
            u32x2 w; w.x = cvtpk(v[j][0], v[j][1]); w.y = cvtpk(v[j][2], v[j][3]); *(u32x2*)(orow + j * 256 + lane * 4) = w;
            mx = fmaxf(mx, fmaxf(fmaxf(fabsf(v[j][0]), fabsf(v[j][1])), fmaxf(fabsf(v[j][2]), fabsf(v[j][3])))); }
#pragma unroll
        for (int o = 1; o < 64; o <<= 1) mx = fmaxf(mx, __shfl_xor(mx, o));
        const float step = fmaxf(mx, 1e-30f) * (1.0f / 127.0f), qi = 1.0f / step;
#pragma unroll
        for (int j = 0; j < 4; ++j) {
            const unsigned b0 = (unsigned)(int)rintf(v[j][0] * qi) & 0xffu, b1 = (unsigned)(int)rintf(v[j][1] * qi) & 0xffu, b2 = (unsigned)(int)rintf(v[j][2] * qi) & 0xffu, b3 = (unsigned)(int)rintf(v[j][3] * qi) & 0xffu;
            *(unsigned*)(XQ + (size_t)m * DM + j * 256 + lane * 4) = b0 | (b1 << 8) | (b2 << 16) | (b3 << 24); }
        if (lane == 0) SX[m] = step;
#pragma unroll
        for (int j = 0; j < 4; ++j) v[j] = vn[j];
    }
}

__device__ __forceinline__ int f2key(float f) { const int b = __float_as_int(f); return b ^ ((b >> 31) & 0x7fffffff); }
__device__ __forceinline__ float key2f(int k) { return __int_as_float(k ^ ((k >> 31) & 0x7fffffff)); }
#define CE_DESC(x, y) do { const int hi_ = max(x, y); y = min(x, y); x = hi_; } while (0)
#define CE_ASC(x, y)  do { const int lo_ = min(x, y); y = max(x, y); x = lo_; } while (0)
__device__ __forceinline__ void bitonic_sort16_desc(int (&a)[16]) {
#pragma unroll
    for (int k = 2; k <= 16; k <<= 1)
#pragma unroll
        for (int j = k >> 1; j > 0; j >>= 1)
#pragma unroll
            for (int i = 0; i < 16; ++i) { const int l = i ^ j; if (l > i) { if ((i & k) == 0) CE_DESC(a[i], a[l]); else CE_ASC(a[i], a[l]); } }
}
__device__ __forceinline__ void bitonic_merge16_desc(int (&a)[16]) {
#pragma unroll
    for (int j = 8; j > 0; j >>= 1)
#pragma unroll
        for (int i = 0; i < 16; ++i) { const int l = i ^ j; if (l > i) CE_DESC(a[i], a[l]); }
}
__device__ __forceinline__ void top16_merge(int (&T)[16], const int (&S)[16]) {
#pragma unroll
    for (int i = 0; i < 16; ++i) T[i] = max(T[i], S[15 - i]);
    bitonic_merge16_desc(T);
}
#define INS16(L, x) do { int x_ = (x); _Pragma("unroll") for (int j_ = 0; j_ < 16; ++j_) { const int hi_ = max(L[j_], x_); x_ = min(L[j_], x_); L[j_] = hi_; } } while (0)

constexpr size_t WS_PART = WS_XN;
constexpr int CT_U = 64, CT_V = 64 + 8 * 64;
constexpr int P6_TOKB = 128, P6_NITEM = NTOK / P6_TOKB, P6_TPW = P6_TOKB / 8;
constexpr size_t WS_CQ = WS_XR, WS_CS = WS_XR + 16 * MiB;
constexpr int P6_IDX = 0;
constexpr int P6_E = 0, P6_C = 8192, P6_ITEM = 49152, P6_E8 = 0, P6_C8 = 32768;

__device__ __forceinline__ void p6a_phase(LAS unsigned char* lds, int G, int wave, int lane) {
    const int gw = blockIdx.x * 8 + wave, NGW = G * 8;
    const bf16_t* SC = (const bf16_t*)(A_WS + WS_XN);
    int* SELE = (int*)(A_WS + WS_SELE); float* SELG = (float*)(A_WS + WS_SELG);
    LAS int* idxb = (LAS int*)(lds + P6_IDX + wave * 4096);
    const int tl = lane >> 4, hh = (lane >> 1) & 7, half = lane & 1;
    for (int grp = gw; grp < NTOK / 4; grp += NGW) {
        const int tok = grp * 4 + tl;
        const bf16_t* sp = SC + (size_t)tok * 2048 + (lane & 15);
        int L[16];
#pragma unroll
        for (int j = 0; j < 16; ++j) L[j] = (int)0x80000000;
        {
            float sa[16], sb_[16];
#pragma unroll
            for (int e = 0; e < 16; ++e) sa[e] = bflo((unsigned)sp[16 * e]);
#pragma unroll
            for (int c0 = 0; c0 < 128; c0 += 32) {
#pragma unroll
                for (int e = 0; e < 16; ++e) sb_[e] = bflo((unsigned)sp[16 * (c0 + 16 + e)]);
                { int S[16];
#pragma unroll
                  for (int e = 0; e < 16; ++e) S[e] = (f2key(sa[e]) & ~127) | (c0 + e);
                  bitonic_sort16_desc(S);
                  if (c0 == 0) {
#pragma unroll
                      for (int e = 0; e < 16; ++e) L[e] = S[e]; } else top16_merge(L, S); }
                if (c0 + 32 < 128) {
#pragma unroll
                    for (int e = 0; e < 16; ++e) sa[e] = bflo((unsigned)sp[16 * (c0 + 32 + e)]); }
                { int S[16];
#pragma unroll
                  for (int e = 0; e < 16; ++e) S[e] = (f2key(sb_[e]) & ~127) | (c0 + 16 + e);
                  bitonic_sort16_desc(S);
                  top16_merge(L, S); }
            }
        }
#pragma unroll
        for (int j = 0; j < 16; ++j) idxb[lane * 16 + j] = L[j] & 127;
        float va[16], vb[16];
#pragma unroll
        for (int j = 0; j < 16; ++j) { const int own = L[j] & ~127, oth = __shfl_xor(own, 1); va[j] = key2f(half ? oth : own); vb[j] = key2f(half ? own : oth); }
        int C[16];
#pragma unroll
        for (int j = 0; j < 16; ++j) C[j] = (int)0x80000000;
        {   int S[16];
            S[0] = (f2key(va[0] + vb[0]) & ~255) | 0;
            S[1] = (f2key(va[0] + vb[1]) & ~255) | 1;
            S[2] = (f2key(va[0] + vb[2]) & ~255) | 2;
            S[3] = (f2key(va[0] + vb[3]) & ~255) | 3;
            S[4] = (f2key(va[0] + vb[4]) & ~255) | 4;
            S[5] = (f2key(va[0] + vb[5]) & ~255) | 5;
            S[6] = (f2key(va[0] + vb[6]) & ~255) | 6;
            S[7] = (f2key(va[0] + vb[7]) & ~255) | 7;
            S[8] = (f2key(va[0] + vb[8]) & ~255) | 8;
            S[9] = (f2key(va[0] + vb[9]) & ~255) | 9;
            S[10] = (f2key(va[0] + vb[10]) & ~255) | 10;
            S[11] = (f2key(va[0] + vb[11]) & ~255) | 11;
            S[12] = (f2key(va[0] + vb[12]) & ~255) | 12;
            S[13] = (f2key(va[0] + vb[13]) & ~255) | 13;
            S[14] = (f2key(va[0] + vb[14]) & ~255) | 14;
            S[15] = (f2key(va[0] + vb[15]) & ~255) | 15;
            bitonic_sort16_desc(S);
#pragma unroll
            for (int q = 0; q < 16; ++q) C[q] = S[q]; }
        {   int S[16];
            S[0] = (f2key(va[1] + vb[0]) & ~255) | 16;
            S[1] = (f2key(va[1] + vb[1]) & ~255) | 17;
            S[2] = (f2key(va[1] + vb[2]) & ~255) | 18;
            S[3] = (f2key(va[1] + vb[3]) & ~255) | 19;
            S[4] = (f2key(va[1] + vb[4]) & ~255) | 20;
            S[5] = (f2key(va[1] + vb[5]) & ~255) | 21;
            S[6] = (f2key(va[1] + vb[6]) & ~255) | 22;
            S[7] = (f2key(va[1] + vb[7]) & ~255) | 23;
            S[8] = (f2key(va[2] + vb[0]) & ~255) | 32;
            S[9] = (f2key(va[2] + vb[1]) & ~255) | 33;
            S[10] = (f2key(va[2] + vb[2]) & ~255) | 34;
            S[11] = (f2key(va[2] + vb[3]) & ~255) | 35;
            S[12] = (f2key(va[2] + vb[4]) & ~255) | 36;
            S[13] = (f2key(va[3] + vb[0]) & ~255) | 48;
            S[14] = (f2key(va[3] + vb[1]) & ~255) | 49;
            S[15] = (f2key(va[3] + vb[2]) & ~255) | 50;
            bitonic_sort16_desc(S);
            top16_merge(C, S); }
        {   int S[16];
            S[0] = (f2key(va[3] + vb[3]) & ~255) | 51;
            S[1] = (f2key(va[4] + vb[0]) & ~255) | 64;
            S[2] = (f2key(va[4] + vb[1]) & ~255) | 65;
            S[3] = (f2key(va[4] + vb[2]) & ~255) | 66;
            S[4] = (f2key(va[5] + vb[0]) & ~255) | 80;
            S[5] = (f2key(va[5] + vb[1]) & ~255) | 81;
            S[6] = (f2key(va[6] + vb[0]) & ~255) | 96;
            S[7] = (f2key(va[6] + vb[1]) & ~255) | 97;
            S[8] = (f2key(va[7] + vb[0]) & ~255) | 112;
            S[9] = (f2key(va[7] + vb[1]) & ~255) | 113;
            S[10] = (f2key(va[8] + vb[0]) & ~255) | 128;
            S[11] = (f2key(va[9] + vb[0]) & ~255) | 144;
            S[12] = (f2key(va[10] + vb[0]) & ~255) | 160;
            S[13] = (f2key(va[11] + vb[0]) & ~255) | 176;
            S[14] = (f2key(va[12] + vb[0]) & ~255) | 192;
            S[15] = (f2key(va[13] + vb[0]) & ~255) | 208;
            bitonic_sort16_desc(S);
            top16_merge(C, S); }
        {   int S[16];
            S[0] = (f2key(va[14] + vb[0]) & ~255) | 224;
            S[1] = (f2key(va[15] + vb[0]) & ~255) | 240;
            S[2] = (int)0x80000000;
            S[3] = (int)0x80000000;
            S[4] = (int)0x80000000;
            S[5] = (int)0x80000000;
            S[6] = (int)0x80000000;
            S[7] = (int)0x80000000;
            S[8] = (int)0x80000000;
            S[9] = (int)0x80000000;
            S[10] = (int)0x80000000;
            S[11] = (int)0x80000000;
            S[12] = (int)0x80000000;
            S[13] = (int)0x80000000;
            S[14] = (int)0x80000000;
            S[15] = (int)0x80000000;
            bitonic_sort16_desc(S);
            top16_merge(C, S); }
        const float mx = key2f(C[0] & ~255);
        float ev[16], sum = 0.f;
#pragma unroll
        for (int j = 0; j < 16; ++j) { ev[j] = __expf(key2f(C[j] & ~255) - mx); sum += ev[j]; }
        const float inv = 1.0f / sum;
        asm volatile("s_waitcnt lgkmcnt(0)" ::: "memory");
        int eo[8]; float go[8];
#pragma unroll
        for (int s = 0; s < 8; ++s) {
            int c_lo = C[s], c_hi = C[8 + s]; float e_lo = ev[s], e_hi = ev[8 + s];
            asm volatile("" : "+v"(c_lo), "+v"(c_hi), "+v"(e_lo), "+v"(e_hi));
            const int cc = half ? c_hi : c_lo; go[s] = (half ? e_hi : e_lo) * inv;
            const int ij = cc & 255, i1 = idxb[(lane & ~1) * 16 + (ij >> 4)], i2 = idxb[(lane | 1) * 16 + (ij & 15)];
            eo[s] = i1 * 128 + i2;
        }
        int* ep = SELE + (size_t)tok * 128 + hh * 16 + half * 8; float* gp = SELG + (size_t)tok * 128 + hh * 16 + half * 8;
        *(u32x4*)ep = (u32x4){(unsigned)eo[0], (unsigned)eo[1], (unsigned)eo[2], (unsigned)eo[3]}; *(u32x4*)(ep + 4) = (u32x4){(unsigned)eo[4], (unsigned)eo[5], (unsigned)eo[6], (unsigned)eo[7]};
        *(f32x4*)gp = (f32x4){go[0], go[1], go[2], go[3]}; *(f32x4*)(gp + 4) = (f32x4){go[4], go[5], go[6], go[7]};
        asm volatile("s_waitcnt lgkmcnt(0)" ::: "memory");
    }
}

__device__ __forceinline__ float dot2bf(unsigned a, unsigned b, float c) { return __builtin_amdgcn_fdot2_f32_bf16(__builtin_bit_cast(bf16x2_t, a), __builtin_bit_cast(bf16x2_t, b), c, false); }
__device__ __forceinline__ unsigned xcc_id() { return (unsigned)__builtin_amdgcn_s_getreg((3 << 11) | 20) & 0xFu; }
__device__ __forceinline__ float dpp_sum16(float v) {
    v += __builtin_bit_cast(float, __builtin_amdgcn_update_dpp(0, __builtin_bit_cast(int, v), 0xB1, 0xF, 0xF, true));
    v += __builtin_bit_cast(float, __builtin_amdgcn_update_dpp(0, __builtin_bit_cast(int, v), 0x4E, 0xF, 0xF, true));
    v += __builtin_bit_cast(float, __builtin_amdgcn_update_dpp(0, __builtin_bit_cast(int, v), 0x141, 0xF, 0xF, true));
    v += __builtin_bit_cast(float, __builtin_amdgcn_update_dpp(0, __builtin_bit_cast(int, v), 0x140, 0xF, 0xF, true));
    return v;
}
__device__ __forceinline__ bool p6_claim(LAS unsigned char* lds, unsigned* cnt, int tid, int& ring, int home, int& slice, int& item) {
    for (;;) {
        if (ring >= 8) return false;
        slice = (home + ring) & 7;
        __syncthreads();
        if (tid == 0) *(volatile LAS int*)(lds + P6_ITEM) = (int)__hip_atomic_fetch_add(cnt + 64 * slice, 1u, __ATOMIC_RELAXED, __HIP_MEMORY_SCOPE_AGENT);
        __syncthreads();
        item = *(volatile LAS int*)(lds + P6_ITEM);
        if (item < P6_NITEM) return true;
        ++ring;
    }
}

__device__ __forceinline__ float ub0(unsigned w) { return (float)(w & 0xffu); }
__device__ __forceinline__ float ub1(unsigned w) { return (float)((w >> 8) & 0xffu); }
__device__ __forceinline__ float ub2(unsigned w) { return (float)((w >> 16) & 0xffu); }
__device__ __forceinline__ float ub3(unsigned w) { return (float)(w >> 24); }
__device__ __forceinline__ float dpp_sum8(float v) {
    v += __builtin_bit_cast(float, __builtin_amdgcn_update_dpp(0, __builtin_bit_cast(int, v), 0xB1, 0xF, 0xF, true));
    v += __builtin_bit_cast(float, __builtin_amdgcn_update_dpp(0, __builtin_bit_cast(int, v), 0x4E, 0xF, 0xF, true));
    v += __builtin_bit_cast(float, __builtin_amdgcn_update_dpp(0, __builtin_bit_cast(int, v), 0x141, 0xF, 0xF, true));
    return v;
}
__device__ __forceinline__ int dpp_isum8(int v) {
    v += __builtin_amdgcn_update_dpp(0, v, 0xB1, 0xF, 0xF, true);
    v += __builtin_amdgcn_update_dpp(0, v, 0x4E, 0xF, 0xF, true);
    v += __builtin_amdgcn_update_dpp(0, v, 0x141, 0xF, 0xF, true);
    return v;
}
__device__ __forceinline__ void p6b_phase(LAS unsigned char* lds, int tid, int wave, int lane) {
    const unsigned char* XQ = A_WS + WS_XQ; const unsigned char* UB = A_WS + WS_UB; const float* SX = (const float*)(A_WS + WS_SX);
    const int* SELE = (const int*)(A_WS + WS_SELE); float* PART = (float*)(A_WS + WS_PART);
    unsigned* cnt = (unsigned*)(A_WS + WS_CTL) + CT_U;
    const int i8 = lane & 7, grp = lane >> 3, home = (int)(xcc_id() & 7u);
    LAS int* eb = (LAS int*)(lds + P6_E8 + wave * 4096);
    int ring = 0, slice, item;
    while (p6_claim(lds, cnt, tid, ring, home, slice, item)) {
        const int tok0 = item * P6_TOKB + wave * P6_TPW;
        u32x4 le[4], xqn; float sxn;
        { const int tk = tok0 + grp;
#pragma unroll
          for (int q = 0; q < 4; ++q) le[q] = *(const u32x4*)(SELE + (size_t)tk * 128 + i8 * 16 + 4 * q);
          xqn = *(const u32x4*)(XQ + (size_t)tk * DM + slice * 128 + i8 * 16); sxn = SX[tk]; }
#pragma unroll 1
        for (int tb = 0; tb < P6_TPW; tb += 8) {
            const int tok = tok0 + tb + grp;
#pragma unroll
            for (int q = 0; q < 4; ++q) *(LAS u32x4*)(eb + grp * 128 + i8 * 16 + 4 * q) = le[q];
            const int x0 = (int)xqn.x, x1 = (int)xqn.y, x2 = (int)xqn.z, x3 = (int)xqn.w; const float sx = sxn;
            if (tb + 8 < P6_TPW) { const int tk = tok + 8;
#pragma unroll
                for (int q = 0; q < 4; ++q) le[q] = *(const u32x4*)(SELE + (size_t)tk * 128 + i8 * 16 + 4 * q);
                xqn = *(const u32x4*)(XQ + (size_t)tk * DM + slice * 128 + i8 * 16); sxn = SX[tk]; }
            const unsigned char* ub = UB + slice * 128 + i8 * 16;
            asm volatile("s_waitcnt lgkmcnt(0)" ::: "memory");
            int res[16];
#pragma unroll
            for (int j = 0; j < 16; ++j) res[j] = 0;
#pragma unroll
            for (int s16 = 0; s16 < 128; s16 += 16) {
                u32x4 uv[16]; u32x4 e4[4];
#pragma unroll
                for (int a4 = 0; a4 < 4; ++a4) e4[a4] = *(const LAS u32x4*)(eb + grp * 128 + s16 + 4 * a4);
#pragma unroll
                for (int a4 = 0; a4 < 4; ++a4)
#pragma unroll
                    for (int j = 0; j < 4; ++j) uv[4 * a4 + j] = *(const u32x4*)(ub + (size_t)e4[a4][j] * DM);
#pragma unroll
                for (int q = 0; q < 16; ++q) {
                    const int a0 = (int)uv[q].x, a1 = (int)uv[q].y, a2 = (int)uv[q].z, a3 = (int)uv[q].w;
                    int d = __builtin_amdgcn_sdot4(a0, x0, 0, false); d = __builtin_amdgcn_sdot4(a1, x1, d, false); d = __builtin_amdgcn_sdot4(a2, x2, d, false); d = __builtin_amdgcn_sdot4(a3, x3, d, false);
                    d = dpp_isum8(d);
                    const int sidx = s16 + q;
                    res[sidx >> 3] = (i8 == (sidx & 7)) ? d : res[sidx >> 3];
                }
            }
            float* pp = PART + ((size_t)slice * NTOK + tok) * 128 + 16 * i8;
#pragma unroll
            for (int q = 0; q < 4; ++q) *(f32x4*)(pp + 4 * q) = (f32x4){(float)res[4 * q] * sx, (float)res[4 * q + 1] * sx, (float)res[4 * q + 2] * sx, (float)res[4 * q + 3] * sx};
            asm volatile("s_waitcnt lgkmcnt(0)" ::: "memory");
        }
    }
}

__device__ __forceinline__ void p6m_phase(int G, int wave, int lane) {
    const int gw = blockIdx.x * 8 + wave, NGW = G * 8;
    const float* SU = (const float*)(A_WS + WS_SU); const float* SV = (const float*)(A_WS + WS_SV);
    const int* SELE = (const int*)(A_WS + WS_SELE); const float* SELG = (const float*)(A_WS + WS_SELG); const float* PART = (const float*)(A_WS + WS_PART);
    unsigned char* CQ = A_WS + WS_CQ; float* CS = (float*)(A_WS + WS_CS);
    for (int tok = gw; tok < NTOK; tok += NGW) {
        float a0 = 0.f, a1 = 0.f;
#pragma unroll
        for (int j = 0; j < 8; ++j) { const float* pp = PART + ((size_t)j * NTOK + tok) * 128; a0 += pp[lane]; a1 += pp[64 + lane]; }
        const int k0 = 8 * (lane & 15) + (lane >> 4), k1 = k0 + 4;
        const int e0 = SELE[(size_t)tok * 128 + k0], e1 = SELE[(size_t)tok * 128 + k1];
        const float c0 = SELG[(size_t)tok * 128 + k0] * gelu_tanh(a0 * SU[e0]) * SV[e0], c1 = SELG[(size_t)tok * 128 + k1] * gelu_tanh(a1 * SU[e1]) * SV[e1];
        float mx = fmaxf(fabsf(c0), fabsf(c1));
#pragma unroll
        for (int o = 1; o < 64; o <<= 1) mx = fmaxf(mx, __shfl_xor(mx, o));
        const float cstep = fmaxf(mx, 1e-30f) * (1.0f / 127.0f), cinv = 1.0f / cstep;
        CQ[(size_t)tok * 128 + k0] = (unsigned char)((int)rintf(c0 * cinv) & 0xff); CQ[(size_t)tok * 128 + k1] = (unsigned char)((int)rintf(c1 * cinv) & 0xff);
        if (lane == 0) CS[tok] = cstep;
    }
}

__device__ __forceinline__ void p6c_phase(LAS unsigned char* lds, int tid, int wave, int lane) {
    const unsigned char* VB = A_WS + WS_VB; const int* SELE = (const int*)(A_WS + WS_SELE);
    const unsigned char* CQ = A_WS + WS_CQ; const float* CS = (const float*)(A_WS + WS_CS);
    unsigned* cnt = (unsigned*)(A_WS + WS_CTL) + CT_V;
    const int i8 = lane & 7, grp = lane >> 3, home = (int)(xcc_id() & 7u);
    LAS int* eb = (LAS int*)(lds + P6_E8 + wave * 4096);
    LAS int* cbb = (LAS int*)(lds + P6_C8 + wave * 1024);
    int ring = 0, slice, item;
    while (p6_claim(lds, cnt, tid, ring, home, slice, item)) {
        const int tok0 = item * P6_TOKB + wave * P6_TPW;
        u32x4 le[4], lc; float cstep;
        { const int tk = tok0 + grp;
#pragma unroll
          for (int q = 0; q < 4; ++q) le[q] = *(const u32x4*)(SELE + (size_t)tk * 128 + i8 * 16 + 4 * q);
          lc = *(const u32x4*)(CQ + (size_t)tk * 128 + i8 * 16); cstep = CS[tk]; }
#pragma unroll 1
        for (int tb = 0; tb < P6_TPW; tb += 8) {
            const int tok = tok0 + tb + grp;
#pragma unroll
            for (int q = 0; q < 4; ++q) *(LAS u32x4*)(eb + grp * 128 + i8 * 16 + 4 * q) = le[q];
            *(LAS u32x4*)(cbb + grp * 32 + i8 * 4) = lc;
            const float cs = cstep;
            if (tb + 8 < P6_TPW) { const int tk = tok + 8;
#pragma unroll
                for (int q = 0; q < 4; ++q) le[q] = *(const u32x4*)(SELE + (size_t)tk * 128 + i8 * 16 + 4 * q);
                lc = *(const u32x4*)(CQ + (size_t)tk * 128 + i8 * 16); cstep = CS[tk]; }
            const unsigned char* vb = VB + slice * 128 + i8 * 16;
            asm volatile("s_waitcnt lgkmcnt(0)" ::: "memory");
            int acc[16];
#pragma unroll
            for (int r = 0; r < 16; ++r) acc[r] = 0;
#pragma unroll 1
            for (int s16 = 0; s16 < 128; s16 += 16) {
                u32x4 vv[16]; u32x4 e4[4];
#pragma unroll
                for (int a4 = 0; a4 < 4; ++a4) e4[a4] = *(const LAS u32x4*)(eb + grp * 128 + s16 + 4 * a4);
                const u32x4 cq4 = *(const LAS u32x4*)(cbb + grp * 32 + (s16 >> 2));
#pragma unroll
                for (int a4 = 0; a4 < 4; ++a4)
#pragma unroll
                    for (int j = 0; j < 4; ++j) vv[4 * a4 + j] = *(const u32x4*)(vb + (size_t)e4[a4][j] * DM);
#pragma unroll
                for (int a4 = 0; a4 < 4; ++a4) {
                    const int cq = (int)cq4[a4];
#pragma unroll
                    for (int d = 0; d < 4; ++d) {
                        const unsigned ra = vv[4 * a4][d], rb = vv[4 * a4 + 1][d], rc = vv[4 * a4 + 2][d], rd = vv[4 * a4 + 3][d];
                        const unsigned lo = __builtin_amdgcn_perm(rb, ra, 0x05010400u), hi = __builtin_amdgcn_perm(rb, ra, 0x07030602u);
                        const unsigned lo2 = __builtin_amdgcn_perm(rd, rc, 0x05010400u), hi2 = __builtin_amdgcn_perm(rd, rc, 0x07030602u);
                        const unsigned t0 = __builtin_amdgcn_perm(lo2, lo, 0x05040100u), t1 = __builtin_amdgcn_perm(lo2, lo, 0x07060302u);
                        const unsigned t2 = __builtin_amdgcn_perm(hi2, hi, 0x05040100u), t3 = __builtin_amdgcn_perm(hi2, hi, 0x07060302u);
                        acc[4 * d + 0] = __builtin_amdgcn_sdot4((int)t0, cq, acc[4 * d + 0], false); acc[4 * d + 1] = __builtin_amdgcn_sdot4((int)t1, cq, acc[4 * d + 1], false);
                        acc[4 * d + 2] = __builtin_amdgcn_sdot4((int)t2, cq, acc[4 * d + 2], false); acc[4 * d + 3] = __builtin_amdgcn_sdot4((int)t3, cq, acc[4 * d + 3], false);
                    }
                }
            }
            bf16_t* pr = (bf16_t*)(A_WS + WS_PEER) + (size_t)tok * DM + slice * 128 + i8 * 16;
            u32x4 w0, w1;
            w0.x = cvtpk((float)acc[0] * cs, (float)acc[1] * cs); w0.y = cvtpk((float)acc[2] * cs, (float)acc[3] * cs); w0.z = cvtpk((float)acc[4] * cs, (float)acc[5] * cs); w0.w = cvtpk((float)acc[6] * cs, (float)acc[7] * cs);
            w1.x = cvtpk((float)acc[8] * cs, (float)acc[9] * cs); w1.y = cvtpk((float)acc[10] * cs, (float)acc[11] * cs); w1.z = cvtpk((float)acc[12] * cs, (float)acc[13] * cs); w1.w = cvtpk((float)acc[14] * cs, (float)acc[15] * cs);
            *(u32x4*)pr = w0; *(u32x4*)(pr + 8) = w1;
            asm volatile("s_waitcnt lgkmcnt(0)" ::: "memory");
        }
    }
}

__device__ __forceinline__ void p6d_phase(int G, int wave, int lane) {
    const int gw = blockIdx.x * 8 + wave, NGW = G * 8;
    const float* gf = A_IN(25);
    const bf16_t* DL = (const bf16_t*)(A_WS + WS_DELTA); const bf16_t* PR = (const bf16_t*)(A_WS + WS_PEER);
    f32x4 v[4], vn[4];
    if (gw < NTOK) { row_ld(xrow_ptr(gw), v, lane); row_add_bf16(DL + (size_t)gw * DM, v, lane); row_add_bf16(PR + (size_t)gw * DM, v, lane); }
    for (int m = gw; m < NTOK; m += NGW) {
        const int mn = m + NGW;
        if (mn < NTOK) { row_ld(xrow_ptr(mn), vn, lane); row_add_bf16(DL + (size_t)mn * DM, vn, lane); row_add_bf16(PR + (size_t)mn * DM, vn, lane); }
        float* yr = yrow_ptr(m);
        const float inv = 1.0f / sqrtf(wave_sum(row_ss(v)) * (1.0f / DM) + EPS);
#pragma unroll
        for (int j = 0; j < 4; ++j) { const f32x4 gg = *(const f32x4*)(gf + j * 256 + lane * 4); *(f32x4*)(yr + j * 256 + lane * 4) = v[j] * inv * gg; }
#pragma unroll
        for (int j = 0; j < 4; ++j) v[j] = vn[j];
    }
}

#define XB_TMO      128
#define XB_XCNT(j)  (256  + 64 * (j))
#define XB_XSUB(j)  (1280 + 64 * (j))
#define XB_XGEN(j)  (2304 + 64 * (j))
#define XB_TOP      3328
#define XB_TOPGEN   3392
#define XB_SPIN_CAP (1u << 22)
constexpr int CW_BAR = 2048;
constexpr int LDS_MISC = 131072 + 64;
__device__ __forceinline__ unsigned xb_ld(unsigned* p)              { return __hip_atomic_load(p, __ATOMIC_RELAXED, __HIP_MEMORY_SCOPE_AGENT); }
__device__ __forceinline__ unsigned xb_add(unsigned* p, unsigned v) { return __hip_atomic_fetch_add(p, v, __ATOMIC_RELAXED, __HIP_MEMORY_SCOPE_AGENT); }
#define XB_SPIN(cond, bar) do { unsigned _sp = 0; while (cond) { __builtin_amdgcn_s_sleep(1); \
    if ((++_sp & 255u) == 0u) { if (xb_ld(&(bar)[XB_TMO])) break; if (_sp > XB_SPIN_CAP) { atomicAdd(&(bar)[XB_TMO], 1u); break; } } } } while (0)
struct XcdBarrier { unsigned* bar; unsigned x; volatile LAS unsigned* st; };
__device__ __forceinline__ XcdBarrier xcd_barrier_post(unsigned* bar, volatile LAS unsigned* st) {
    XcdBarrier b; b.bar = bar; b.x = (unsigned)__builtin_amdgcn_s_getreg((3 << 11) | 20) & 0xFu; b.st = st;
    if (threadIdx.x == 0) (void)xb_add(&bar[XB_XCNT(b.x)], 1u);
    return b;
}
__device__ __forceinline__ void xcd_barrier_complete(unsigned* bar, unsigned x, unsigned& nloc, unsigned& nx) {
    const unsigned G = gridDim.x * gridDim.y * gridDim.z;
    unsigned sum, cnt, mine, sp = 0u;
    for (;;) {
        sum = 0u; cnt = 0u; mine = 0u;
#pragma unroll
        for (unsigned j = 0; j < 16; ++j) { const unsigned c = xb_ld(&bar[XB_XCNT(j)]); sum += c; cnt += (c > 0u) ? 1u : 0u; mine = (j == x) ? c : mine; }
        if (sum == G) break;
        __builtin_amdgcn_s_sleep(1);
        if ((++sp & 255u) == 0u) { if (xb_ld(&bar[XB_TMO])) break; if (sp > XB_SPIN_CAP) { atomicAdd(&bar[XB_TMO], 1u); break; } }
    }
    nloc = mine > 0u ? mine : 1u; nx = cnt > 0u ? cnt : 1u;
}
__device__ __forceinline__ void xcd_barrier(const XcdBarrier& b) {
    asm volatile("s_waitcnt vmcnt(0)" ::: "memory");
    __syncthreads();
    if (threadIdx.x == 0) {
        unsigned* bar = b.bar;
        __builtin_amdgcn_s_waitcnt(0);
        unsigned nloc = b.st[0], nx = b.st[1];
        if (nloc == 0u) { xcd_barrier_complete(bar, b.x, nloc, nx); b.st[0] = nloc; b.st[1] = nx; }
        const unsigned old = xb_add(&bar[XB_XSUB(b.x)], 1u);
        const unsigned gen = old / nloc;
        if (old + 1u == (gen + 1u) * nloc) {
            __builtin_amdgcn_fence(__ATOMIC_RELEASE, "agent");
            asm volatile("s_waitcnt vmcnt(0)" ::: "memory");
            const unsigned og = xb_add(&bar[XB_TOP], 1u);
            const unsigned tg = og / nx;
            if (og + 1u == (tg + 1u) * nx) xb_add(&bar[XB_TOPGEN], 1u);
            else XB_SPIN(xb_ld(&bar[XB_TOPGEN]) == tg, bar);
            __builtin_amdgcn_fence(__ATOMIC_ACQUIRE, "agent");
            xb_add(&bar[XB_XGEN(b.x)], 1u);
            asm volatile("s_waitcnt vmcnt(0)" ::: "memory");
        } else {
            XB_SPIN(xb_ld(&bar[XB_XGEN(b.x)]) == gen, bar);
            __builtin_amdgcn_fence(__ATOMIC_ACQUIRE, "agent");
            asm volatile("s_waitcnt vmcnt(0)" ::: "memory");
        }
    }
    __syncthreads();
}

template <int NACC, class Epi>
__device__ __forceinline__ void small_gemm(LAS unsigned char* lds, const bf16_t* X0, const bf16_t* W0, const bf16_t* X1, const bf16_t* W1, int N, int G, int wave, int lane, const Epi& epi) {
    const int r32 = lane & 31, hi = lane >> 5;
    LAS float* part = (LAS float*)lds;
    for (int task = blockIdx.x; task < 4 * (N / 32); task += G) {
        const int rb = task & 3, cb = task >> 2;
#pragma unroll
        for (int a = 0; a < NACC; ++a) {
            const bf16_t* xp = (a ? X1 : X0) + (size_t)(rb * 32 + r32) * DM + hi * 8 + wave * 128;
            const bf16_t* wp = (a ? W1 : W0) + (size_t)(cb * 32 + r32) * DM + hi * 8 + wave * 128;
            bf16x8 xa[8], wa[8];
#pragma unroll
            for (int q = 0; q < 8; ++q) { xa[q] = *(const bf16x8*)(xp + q * 16); wa[q] = *(const bf16x8*)(wp + q * 16); }
            f32x16 acc = f32x16{};
#pragma unroll
            for (int q = 0; q < 8; ++q) acc = __builtin_amdgcn_mfma_f32_32x32x16_bf16(wa[q], xa[q], acc, 0, 0, 0);
#pragma unroll
            for (int r = 0; r < 16; ++r) part[((a * 8 + wave) * 16 + r) * 64 + lane] = acc[r];
        }
        __syncthreads();
        if (wave < 4) {
            const int g4 = wave, t = rb * 32 + r32, n0 = cb * 32 + 8 * g4 + 4 * hi;
            f32x4 v[NACC];
#pragma unroll
            for (int a = 0; a < NACC; ++a) { v[a] = (f32x4){0.f, 0.f, 0.f, 0.f};
#pragma unroll
                for (int w = 0; w < 8; ++w)
#pragma unroll
                    for (int i = 0; i < 4; ++i) v[a][i] += part[((a * 8 + w) * 16 + 4 * g4 + i) * 64 + lane]; }
            epi(t, n0, v[0], v[NACC - 1]);
        }
        __syncthreads();
    }
}
__device__ __forceinline__ u32x2 pack4(f32x4 v) { u32x2 w; w.x = cvtpk(v[0], v[1]); w.y = cvtpk(v[2], v[3]); return w; }
struct SEpiG1 {
    __device__ __forceinline__ void operator()(int t, int n0, f32x4 v, f32x4) const {
        unsigned char* ws = A_WS; float* out = A_OUT;
        const int ts = n0 >> 10, c = n0 & 1023; const size_t ro = (size_t)(NTP + t) * DM + c;
        if (ts == 0) *(u32x2*)((bf16_t*)(ws + WS_Q) + ro) = pack4(v);
        else if (ts == 1) *(f32x4*)(out + O_KS + (size_t)t * DM + c) = v;
        else if (ts == 2) *(f32x4*)(out + O_VS + (size_t)t * DM + c) = v;
        else if (ts == 3) { *(u32x2*)((bf16_t*)(ws + WS_XR) + ro) = pack4(v);
            if ((t & 15) >= 13) *(f32x4*)(out + O_CS + ((size_t)(t >> 4) * 3 + ((t & 15) - 13)) * DM + c) = v; }
        else if (ts == 4) *(u32x2*)((bf16_t*)(ws + WS_G) + ro) = pack4(v);
        else if (ts == 5) *(u32x2*)((bf16_t*)(ws + WS_SGA) + (size_t)t * DM + c) = pack4(v);
        else *(u32x2*)((bf16_t*)(ws + WS_SGR) + (size_t)t * DM + c) = pack4(v);
    }
};
struct SEpiP3 {
    __device__ __forceinline__ void operator()(int t, int n0, f32x4 va, f32x4 vr) const {
        unsigned char* ws = A_WS;
        const u32x2 ga = *(const u32x2*)((const bf16_t*)(ws + WS_SGA) + (size_t)t * DM + n0), gr = *(const u32x2*)((const bf16_t*)(ws + WS_SGR) + (size_t)t * DM + n0);
        f32x4 m;
        m[0] = sigmoidf_(bflo(ga.x)) * va[0] + sigmoidf_(bflo(gr.x)) * vr[0]; m[1] = sigmoidf_(bfhi(ga.x)) * va[1] + sigmoidf_(bfhi(gr.x)) * vr[1];
        m[2] = sigmoidf_(bflo(ga.y)) * va[2] + sigmoidf_(bflo(gr.y)) * vr[2]; m[3] = sigmoidf_(bfhi(ga.y)) * va[3] + sigmoidf_(bfhi(gr.y)) * vr[3];
        *(u32x2*)((bf16_t*)(ws + WS_XR) + (size_t)(NTP + t) * DM + n0) = pack4(m);
    }
};
struct SEpiBf16 {
    size_t wsoff; int ld;
    __device__ __forceinline__ void operator()(int t, int n0, f32x4 v, f32x4) const { *(u32x2*)((bf16_t*)(A_WS + wsoff) + (size_t)(NTP + t) * ld + n0) = pack4(v); }
};

__global__ void __launch_bounds__(512, 2) hybrid_fwd(Args a) {
    extern __shared__ __attribute__((aligned(16))) unsigned char lds_raw[];
    LAS unsigned char* lds = (LAS unsigned char*)lds_raw;
    const int tid = threadIdx.x, lane = tid & 63, wave = __builtin_amdgcn_readfirstlane(tid >> 6), G = gridDim.x;
    cg::grid_group grid = cg::this_grid();
    unsigned char* ws = A_WS;
    if (tid < 2) ((volatile LAS unsigned*)(lds + LDS_MISC))[tid] = 0u;
    __syncthreads();
    XcdBarrier xbar; xbar.bar = (unsigned*)(ws + WS_CTL) + CW_BAR; xbar.x = 0; xbar.st = nullptr;
    if (KA->use_sync) xbar = xcd_barrier_post((unsigned*)(ws + WS_CTL) + CW_BAR, (volatile LAS unsigned*)(lds + LDS_MISC));
#define IN(k) (KA->ph_lo <= (k) && (k) < KA->ph_hi)
#define SEAM(k) do { if (KA->use_sync && IN(k) && IN((k) + 1)) { if ((k) == 0) grid.sync(); else xcd_barrier(xbar); } } while (0)
    if (IN(0)) { p0_prologue(lds, G, wave, lane); }
    SEAM(0);
    if (IN(1)) {
        pg8::Gemm g{(const bf16_t*)(ws + WS_XN), (const bf16_t*)(ws + WS_WIN), (const bf16_t*)(ws + WS_WIN) + (size_t)2048 * DM, (const bf16_t*)(ws + WS_XN), DM};
        SchedG1 S; S.init(G, blockIdx.x); EpiG1 E;
        pg8::gemm_phase(lds, g, S, E);
        { const bf16_t* xs = (const bf16_t*)(ws + WS_XN) + (size_t)NTP * DM; const bf16_t* w = (const bf16_t*)(ws + WS_WIN); SEpiG1 SE; small_gemm<1>(lds, xs, w, xs, w, INC, G, wave, lane, SE); }
    }
    SEAM(1);
    if (IN(2)) { p2_phase(lds, G, tid, wave, lane); }
    SEAM(2);
    if (IN(3)) {
        pg8::Gemm g{(const bf16_t*)(ws + WS_XN), (const bf16_t*)(ws + WS_WBA), (const bf16_t*)(ws + WS_G), (const bf16_t*)(ws + WS_WBL), DM};
        SchedPair S; S.init(4, G, blockIdx.x); EpiP3 E;
        pg8::gemm_phase(lds, g, S, E);
        { SEpiP3 SE; small_gemm<2>(lds, (const bf16_t*)(ws + WS_XN) + (size_t)NTP * DM, (const bf16_t*)(ws + WS_WBA), (const bf16_t*)(ws + WS_G) + (size_t)NTP * DM, (const bf16_t*)(ws + WS_WBL), DM, G, wave, lane, SE); }
    }
    SEAM(3);
    if (IN(4)) {
        pg8::Gemm g{(const bf16_t*)(ws + WS_XR), (const bf16_t*)(ws + WS_WO), (const bf16_t*)(ws + WS_XR), (const bf16_t*)(ws + WS_WO), DM};
        SchedOne S; S.init(4, G, blockIdx.x); EpiP4 E;
        pg8::gemm_phase(lds, g, S, E);
        { const bf16_t* xs = (const bf16_t*)(ws + WS_XR) + (size_t)NTP * DM; const bf16_t* w = (const bf16_t*)(ws + WS_WO); SEpiBf16 SE{WS_DELTA, DM}; small_gemm<1>(lds, xs, w, xs, w, DM, G, wave, lane, SE); }
    }
    SEAM(4);
    if (IN(5)) { p4b_phase(G, wave, lane); }
    SEAM(5);
    if (IN(6)) {
        pg8::Gemm g{(const bf16_t*)(ws + WS_Q), (const bf16_t*)(ws + WS_WS), (const bf16_t*)(ws + WS_Q), (const bf16_t*)(ws + WS_WS), DM};
        SchedOne S; S.init(8, G, blockIdx.x); EpiP5 E;
        pg8::gemm_phase(lds, g, S, E);
        { const bf16_t* xs = (const bf16_t*)(ws + WS_Q) + (size_t)NTP * DM; const bf16_t* w = (const bf16_t*)(ws + WS_WS); SEpiBf16 SE{WS_XN, 2048}; small_gemm<1>(lds, xs, w, xs, w, 2048, G, wave, lane, SE); }
    }
    SEAM(6);
    if (IN(7)) { p6a_phase(lds, G, wave, lane); }
    SEAM(7);
    if (IN(8)) { p6b_phase(lds, tid, wave, lane); }
    SEAM(8);
    if (IN(9)) { p6m_phase(G, wave, lane); }
    SEAM(9);
    if (IN(10)) { p6c_phase(lds, tid, wave, lane); }
    SEAM(10);
    if (IN(11)) { p6d_phase(G, wave, lane); }
#undef IN
#undef SEAM
}

#ifndef N_LAUNCH_MODE
#define N_LAUNCH_MODE 1
#endif
constexpr int NPH = 12;
extern "C" void kernel_launch(void* const* d_in, const int* in_sizes, int n_in, void* d_out, int out_size, void* d_ws, size_t ws_size, hipStream_t stream) {
    static int grid = 0;
    if (grid == 0) {
        if (n_in != 26 || (size_t)out_size != O_END || ws_size < WS_END) { fprintf(stderr, "kernel_launch: unexpected sizes n_in %d out %d ws %zu (need %zu)\n", n_in, out_size, ws_size, (size_t)WS_END); grid = -1; return; }
        int dev = 0, cus = 0, per_cu = 0;
        (void)hipGetDevice(&dev); (void)hipDeviceGetAttribute(&cus, hipDeviceAttributeMultiprocessorCount, dev);
        (void)hipFuncSetAttribute((const void*)hybrid_fwd, hipFuncAttributeMaxDynamicSharedMemorySize, LDS_BYTES);
        (void)hipOccupancyMaxActiveBlocksPerMultiprocessor(&per_cu, (const void*)hybrid_fwd, 512, LDS_BYTES);
        if (per_cu < 1) { fprintf(stderr, "kernel_launch: occupancy query says %d blocks per CU\n", per_cu); per_cu = 1; }
        grid = cus;
        (void)hipGetLastError();
    }
    if (grid < 0) return;
    (void)hipMemsetAsync((char*)d_ws + WS_CTL, 0, 32768, stream);
    Args a{};
    for (int i = 0; i < 26; ++i) a.in[i] = (const float*)d_in[i];
    a.out = (float*)d_out; a.ws = (unsigned char*)d_ws;
    if (N_LAUNCH_MODE == 1) {
        a.ph_lo = 0; a.ph_hi = NPH; a.use_sync = 1;
        void* args[] = {&a};
        hipError_t e = hipLaunchCooperativeKernel((const void*)hybrid_fwd, dim3(grid), dim3(512), args, LDS_BYTES, stream);
        if (e != hipSuccess) fprintf(stderr, "cooperative launch failed: %s (grid %d)\n", hipGetErrorString(e), grid);
    } else {
        for (int p = 0; p < NPH; ++p) { a.ph_lo = p; a.ph_hi = p + 1; a.use_sync = 0; hipLaunchKernelGGL(hybrid_fwd, dim3(grid), dim3(512), LDS_BYTES, stream, a); }
    }
}
```

```cpp
#include <hip/hip_runtime.h>
#include <hip/hip_cooperative_groups.h>
#include <cstdint>
#include <cstdio>
namespace cg = cooperative_groups;

#define LAS __attribute__((address_space(3)))
typedef unsigned short bf16_t;
typedef short bf16x8 __attribute__((ext_vector_type(8)));
typedef float f32x4 __attribute__((ext_vector_type(4)));
typedef float f32x2 __attribute__((ext_vector_type(2)));
typedef float f32x16 __attribute__((ext_vector_type(16)));
typedef unsigned u32x4 __attribute__((ext_vector_type(4)));
typedef unsigned u32x2 __attribute__((ext_vector_type(2)));
typedef __bf16 bf16x2_t __attribute__((ext_vector_type(2)));
typedef int i32x4_t __attribute__((ext_vector_type(4)));

constexpr int DM = 1024, SEQ = 4096, NB = 16, NTP = NB * SEQ, NSB = 8, NST = 16, NTS = NSB * NST, NTOK = NTP + NTS;
constexpr int ROWS = 65792, NMT = 257;
constexpr int INC = 7168, NEXP = 16384;
constexpr float EPS = 1e-6f, LOG2E = 1.4426950408889634f;
constexpr float QSCALE = 0.125f * LOG2E;

constexpr size_t MiB = 1u << 20;
constexpr size_t BUF = (size_t)ROWS * DM * 2;
constexpr size_t WS_CTL = 0;
constexpr size_t WS_WIN = 1 * MiB;
constexpr size_t WS_WBA = 16 * MiB, WS_WBL = 18 * MiB, WS_WO = 20 * MiB, WS_WS = 22 * MiB;
constexpr size_t WS_LRUW = 26 * MiB;
constexpr size_t WS_SGA = 27 * MiB, WS_SGR = 27 * MiB + 512 * 1024;
constexpr size_t WS_SU = 26 * MiB + 512 * 1024, WS_SV = 26 * MiB + 640 * 1024;
constexpr size_t WS_SW = 26 * MiB + 256 * 1024;
constexpr size_t WS_WSQ = 44 * MiB;
constexpr size_t WS_SX = 26 * MiB + 704 * 1024;
constexpr size_t WS_UB = 28 * MiB, WS_VB = 60 * MiB;
constexpr size_t WS_Q = 92 * MiB;
constexpr size_t WS_XN = WS_Q + BUF;
constexpr size_t WS_K = WS_XN + BUF;
constexpr size_t WS_VT = WS_K + BUF;
constexpr size_t WS_XR = WS_VT + BUF;
constexpr size_t WS_G = WS_XR + BUF;
constexpr size_t WS_END = WS_G + BUF;
constexpr size_t WS_DELTA = WS_VT;
constexpr size_t WS_PEER = WS_Q;
constexpr size_t WS_SELE = WS_G, WS_SELG = WS_G + (size_t)NTOK * 512, WS_XQ = WS_G + (size_t)NTOK * 1024;

constexpr size_t O_YP = 0, O_YS = O_YP + (size_t)NTP * DM, O_KP = O_YS + (size_t)NTS * DM, O_VP = O_KP + (size_t)NB * 512 * DM,
                 O_CP = O_VP + (size_t)NB * 512 * DM, O_LP = O_CP + (size_t)NB * 3 * DM, O_KS = O_LP + (size_t)NB * DM, O_VS = O_KS + (size_t)NTS * DM,
                 O_CS = O_VS + (size_t)NTS * DM, O_LS = O_CS + (size_t)NSB * 3 * DM, O_END = O_LS + (size_t)NSB * DM;

constexpr int LDS_BYTES = 135168;

__device__ __forceinline__ unsigned cvtpk(float lo, float hi) { f32x2 v = {lo, hi}; bf16x2_t b = __builtin_convertvector(v, bf16x2_t); return __builtin_bit_cast(unsigned, b); }
__device__ __forceinline__ float bflo(unsigned u) { return __uint_as_float(u << 16); }
__device__ __forceinline__ float bfhi(unsigned u) { return __uint_as_float(u & 0xffff0000u); }
__device__ __forceinline__ float fast_exp2(float x) { return __builtin_amdgcn_exp2f(x); }
__device__ __forceinline__ float fast_rcp(float x) { return __builtin_amdgcn_rcpf(x); }
__device__ __forceinline__ float sigmoidf_(float z) { return fast_rcp(1.0f + fast_exp2(-z * LOG2E)); }
__device__ __forceinline__ float gelu_tanh(float x) { const float u = x + 0.044715f * x * x * x; return x * fast_rcp(1.0f + fast_exp2(-1.5957691216f * LOG2E * u)); }
__device__ __forceinline__ float wave_sum(float v) {
#pragma unroll
    for (int o = 1; o < 64; o <<= 1) v += __shfl_xor(v, o);
    return v;
}
__device__ __forceinline__ int swap23(int i) { return (i & ~12) | ((i & 4) << 1) | ((i & 8) >> 1); }
__device__ __forceinline__ float plswap_max(float m) { auto rr = __builtin_amdgcn_permlane32_swap(__float_as_uint(m), __float_as_uint(m), false, false); return fmaxf(__uint_as_float(rr[0]), __uint_as_float(rr[1])); }
__device__ __forceinline__ float plswap_add(float m) { auto rr = __builtin_amdgcn_permlane32_swap(__float_as_uint(m), __float_as_uint(m), false, false); return __uint_as_float(rr[0]) + __uint_as_float(rr[1]); }

namespace pg8 {
constexpr int BM = 256, BK = 64, HALF = 128, HTB = HALF * BK * 2, STAGE_BYTES = 8 * HTB, NXCD = 8, WGM = 8;
__host__ __device__ __forceinline__ int lds_byte(int r, int c) { const int st = (r >> 4) * 2 + (c >> 5), rr = r & 15, cc = c & 31, ob = rr * 64 + cc * 2; return st * 1024 + (ob ^ (((ob >> 9) & 1) << 5)); }
__host__ __device__ __forceinline__ void stage_rc(int b, int& R, int& C) { const int st = b / 1024, sb = b % 1024, swz = sb ^ (((sb >> 9) & 1) << 5); R = (st >> 1) * 16 + swz / 64; C = (st & 1) * 32 + (swz % 64) / 2; }
__host__ __device__ __forceinline__ int perm32(int rho) { const int n = rho >> 4, i = rho & 15; return 8 * (i >> 2) + 4 * n + (i & 3); }

struct Unit { int pm, pn, kind; };
struct Gemm { const bf16_t* A0; const bf16_t* B0; const bf16_t* A1; const bf16_t* B1; int K; };

struct TileMap {
    int nM, nN, nwg;
    __device__ __forceinline__ void init(int nM_, int nN_) { nM = nM_; nN = nN_; nwg = nM * nN; }
    __device__ __forceinline__ void map(int L, int& pm, int& pn) const {
        int wgid = L; { const int q = nwg / NXCD, r = nwg % NXCD, xcd = wgid % NXCD, off = wgid / NXCD; wgid = (xcd < r ? xcd * (q + 1) : r * (q + 1) + (xcd - r) * q) + off; }
        const int nig = WGM * nN, gid = wgid / nig, fm = gid * WGM, gsz = (nM - fm) < WGM ? (nM - fm) : WGM;
        pm = fm + ((wgid % nig) % gsz); pn = (wgid % nig) / gsz;
    }
};

template <class Epi, class Sched, bool I8 = false>
__device__ __forceinline__ void gemm_phase(LAS unsigned char* lds, const Gemm g, const Sched& S, const Epi& E) {
    const int tid = threadIdx.x, wid = __builtin_amdgcn_readfirstlane(tid >> 6), lane = tid & 63, wr = wid >> 2, wc = wid & 3, fr = lane & 15, fq = lane >> 4;
    const int K = g.K, nt = K / BK;
    unsigned voffA[2], voffB[2];
#pragma unroll
    for (int i = 0; i < 2; ++i) { int R, C; stage_rc(tid * 16 + i * 8192, R, C); const int Rb = (R & ~31) + perm32(R & 31);
        voffA[i] = (unsigned)(R * K + C) * 2u; voffB[i] = (unsigned)(Rb * K + C) * 2u; }
    const size_t kstep = (size_t)(BK * 2);
    const size_t hstep = (size_t)HALF * K * 2;
    const size_t tstep = 2 * hstep;
    const unsigned ldsw = (unsigned)wid * 1024u;
    const int aoff = lds_byte(wr * 64 + fr, fq * 8), boff = lds_byte(wc * 32 + fr, fq * 8);
#define PG8_SA(b, h) (((b) * 2 + (h)) * HTB)
#define PG8_SB(b, h) ((4 + (b) * 2 + (h)) * HTB)
#define PG8_STAGE(bufoff, gbase, voff) do { _Pragma("unroll") for (int _i = 0; _i < 2; ++_i) \
        __builtin_amdgcn_global_load_lds((const unsigned*)((const char*)(gbase) + (voff)[_i]), (LAS unsigned*)(lds + (bufoff) + ldsw + _i * 8192), 16, 0, 0); } while (0)
#define PG8_LDA(dst, b, h) do { _Pragma("unroll") for (int m = 0; m < 4; ++m) _Pragma("unroll") for (int k = 0; k < 2; ++k) dst[m][k] = *(const LAS bf16x8*)(lds + PG8_SA(b, h) + aoff + m * 2048 + k * 1024); } while (0)
#define PG8_LDB(dst, b, h) do { _Pragma("unroll") for (int n = 0; n < 2; ++n) _Pragma("unroll") for (int k = 0; k < 2; ++k) dst[n][k] = *(const LAS bf16x8*)(lds + PG8_SB(b, h) + boff + n * 2048 + k * 1024); } while (0)
#define PG8_MMA(ai, bj, At, Bt) do { __builtin_amdgcn_s_setprio(1); _Pragma("unroll") for (int m = 0; m < 4; ++m) _Pragma("unroll") for (int n = 0; n < 2; ++n) _Pragma("unroll") for (int k = 0; k < 2; ++k) { \
        if constexpr (I8) acc[ai][bj][m][n] = __builtin_bit_cast(acc_t, __builtin_amdgcn_mfma_i32_16x16x64_i8(__builtin_bit_cast(i32x4_t, Bt[n][k]), __builtin_bit_cast(i32x4_t, At[m][k]), __builtin_bit_cast(i32x4_t, acc[ai][bj][m][n]), 0, 0, 0)); \
        else acc[ai][bj][m][n] = __builtin_bit_cast(acc_t, __builtin_amdgcn_mfma_f32_16x16x32_bf16(Bt[n][k], At[m][k], __builtin_bit_cast(f32x4, acc[ai][bj][m][n]), 0, 0, 0)); } __builtin_amdgcn_s_setprio(0); } while (0)
#define PG8_WAIT_V(n) asm volatile("s_waitcnt vmcnt(" #n ")" ::: "memory")
#define PG8_WAIT_L(n) asm volatile("s_waitcnt lgkmcnt(" #n ")" ::: "memory")
#define PG8_BAR __builtin_amdgcn_s_barrier()
#define PG8_SCHED __builtin_amdgcn_sched_barrier(0)
    Unit cur, nxt; int ui = 0;
    if (!S.next(0, cur)) return;
    typedef typename Epi::acc_t acc_t;
    acc_t acc[2][2][4][2];
#pragma unroll
    for (int a = 0; a < 2; ++a)
#pragma unroll
        for (int b = 0; b < 2; ++b)
#pragma unroll
            for (int m = 0; m < 4; ++m)
#pragma unroll
                for (int n = 0; n < 2; ++n) acc[a][b][m][n] = acc_t{};
    bf16x8 At[4][2], B0[2][2], B1[2][2];
    const char* cA = (const char*)(cur.kind ? g.A1 : g.A0) + (size_t)cur.pm * tstep; const char* cB = (const char*)(cur.kind ? g.B1 : g.B0) + (size_t)cur.pn * tstep;
    PG8_STAGE(PG8_SB(0, 0), cB, voffB); PG8_STAGE(PG8_SB(0, 1), cB + hstep, voffB); PG8_STAGE(PG8_SA(0, 0), cA, voffA); PG8_STAGE(PG8_SA(0, 1), cA + hstep, voffA);
    if (wr == 1) PG8_BAR;
    PG8_WAIT_V(2); PG8_BAR;
    PG8_STAGE(PG8_SB(1, 0), cB + kstep, voffB); PG8_STAGE(PG8_SA(1, 0), cA + kstep, voffA); PG8_STAGE(PG8_SB(1, 1), cB + hstep + kstep, voffB);
    PG8_WAIT_V(6); PG8_BAR;
    for (;;) {
        const bool has_next = S.next(ui + 1, nxt);
        E.prefetch(cur, lds + STAGE_BYTES + 512 + wid * 256, tid);
        const char* nA = has_next ? (const char*)(nxt.kind ? g.A1 : g.A0) + (size_t)nxt.pm * tstep : cA; const char* nB = has_next ? (const char*)(nxt.kind ? g.B1 : g.B0) + (size_t)nxt.pn * tstep : cB;
        for (int t = 0; t < nt; t += 2) {
            const bool last = (t == nt - 2);
            const char* a1 = cA + (size_t)(t + 1) * kstep;
            const char* a2 = last ? nA : cA + (size_t)(t + 2) * kstep; const char* b2 = last ? nB : cB + (size_t)(t + 2) * kstep;
            const char* a3 = a2 + kstep; const char* b3 = b2 + kstep;
            PG8_LDB(B0, 0, 0); PG8_LDB(B1, 0, 1); PG8_SCHED; PG8_LDA(At, 0, 0); PG8_STAGE(PG8_SA(1, 1), a1 + hstep, voffA);
            PG8_WAIT_V(8); PG8_WAIT_L(0); PG8_BAR; PG8_MMA(0, 0, At, B0); PG8_MMA(0, 1, At, B1); PG8_BAR; PG8_SCHED;
            PG8_LDA(At, 0, 1); PG8_STAGE(PG8_SB(0, 0), b2, voffB); PG8_STAGE(PG8_SB(0, 1), b2 + hstep, voffB); PG8_STAGE(PG8_SA(0, 0), a2, voffA);
            PG8_WAIT_V(8); PG8_WAIT_L(0); PG8_BAR; PG8_MMA(1, 0, At, B0); PG8_MMA(1, 1, At, B1); PG8_BAR; PG8_SCHED;
            PG8_LDB(B0, 1, 0); PG8_LDB(B1, 1, 1); PG8_SCHED; PG8_LDA(At, 1, 0); PG8_STAGE(PG8_SA(0, 1), a2 + hstep, voffA);
            PG8_WAIT_V(8); PG8_WAIT_L(0); PG8_BAR; PG8_MMA(0, 0, At, B0); PG8_MMA(0, 1, At, B1); PG8_BAR; PG8_SCHED;
            PG8_LDA(At, 1, 1); PG8_STAGE(PG8_SB(1, 0), b3, voffB); PG8_STAGE(PG8_SB(1, 1), b3 + hstep, voffB); PG8_STAGE(PG8_SA(1, 0), a3, voffA);
            PG8_WAIT_V(8); PG8_WAIT_L(0); PG8_BAR; PG8_MMA(1, 0, At, B0); PG8_MMA(1, 1, At, B1); PG8_BAR; PG8_SCHED;
        }
        if (wr == 0) PG8_BAR;
        E(acc, cur, wr, wc, fr, fq);
        if (!has_next) break;
#pragma unroll
        for (int a = 0; a < 2; ++a)
#pragma unroll
            for (int b = 0; b < 2; ++b)
#pragma unroll
                for (int m = 0; m < 4; ++m)
#pragma unroll
                    for (int n = 0; n < 2; ++n) acc[a][b][m][n] = acc_t{};
        cur = nxt; cA = nA; cB = nB; ++ui;
        if (wr == 1) PG8_BAR;
    }
    PG8_WAIT_V(0);
    PG8_BAR;
#undef PG8_SA
#undef PG8_SB
#undef PG8_STAGE
#undef PG8_LDA
#undef PG8_LDB
#undef PG8_MMA
#undef PG8_WAIT_V
#undef PG8_WAIT_L
#undef PG8_BAR
#undef PG8_SCHED
}
}
using pg8::Unit;

struct Args {
    const float* in[26];
    float* out; unsigned char* ws;
    int ph_lo, ph_hi, use_sync, pad;
};

typedef const __attribute__((address_space(4))) Args* ArgsP;
#define KA ((ArgsP)__builtin_amdgcn_kernarg_segment_ptr())
#define A_IN(k) (KA->in[k])
#define A_OUT (KA->out)
#define A_WS (KA->ws)

struct SchedG1 {
    pg8::TileMap m0, m1; int G, c;
    __device__ __forceinline__ void init(int G_, int c_) { m0.init(256, 24); m1.init(4, 256); G = G_; c = c_; }
    __device__ __forceinline__ bool next(int i, Unit& u) const {
        int L = i * G + c;
        if (L < m0.nwg) { m0.map(L, u.pm, u.pn); u.pn = (u.pn < 8) ? u.pn : u.pn + 4; u.kind = 0; return true; }
        L -= m0.nwg; if (L >= m1.nwg) return false;
        m1.map(L, u.pm, u.pn); u.kind = 1; return true;
    }
};
struct SchedPair {
    pg8::TileMap m0; int G, c;
    __device__ __forceinline__ void init(int nN, int G_, int c_) { m0.init(256, nN); G = G_; c = c_; }
    __device__ __forceinline__ bool next(int i, Unit& u) const { const int L = (i >> 1) * G + c; if (L >= m0.nwg) return false; m0.map(L, u.pm, u.pn); u.kind = i & 1; return true; }
};
struct SchedOne {
    pg8::TileMap m0; int G, c;
    __device__ __forceinline__ void init(int nN, int G_, int c_) { m0.init(256, nN); G = G_; c = c_; }
    __device__ __forceinline__ bool next(int i, Unit& u) const { const int L = i * G + c; if (L >= m0.nwg) return false; m0.map(L, u.pm, u.pn); u.kind = 0; return true; }
};

#define EPI_PREP int fr_ = fr, fq_ = fq; asm volatile("" : "+v"(fr_), "+v"(fq_)); const int rl_ = wr * 64 + fr_, cl_ = wc * 32 + 8 * fq_;
#define EPI_LOOP_BEGIN \
    _Pragma("unroll") for (int ai = 0; ai < 2; ++ai) _Pragma("unroll") for (int m = 0; m < 4; ++m) { const int rit = ai * 128 + m * 16 + rl_; \
    _Pragma("unroll") for (int bj = 0; bj < 2; ++bj) { const int cit = bj * 128 + cl_; const auto v0 = acc[ai][bj][m][0], v1 = acc[ai][bj][m][1];
#define EPI_LOOP_END } }

__device__ __forceinline__ size_t kfrag_off(int row, int col) {
    return ((((size_t)(row >> 5) * 16 + (col >> 6)) * 4 + ((col >> 4) & 3)) * 64 + ((col >> 3) & 1) * 32 + swap23(row & 31)) * 8;
}
__device__ __forceinline__ size_t vfrag_off(int vc, int tok) {
    return (((((size_t)(tok >> 5) * 16 + (vc >> 6)) * 2 + ((vc >> 5) & 1)) * 2 + ((tok >> 4) & 1)) * 64 + ((tok >> 3) & 1) * 32 + swap23(vc & 31)) * 8;
}
struct EpiG1 {
    typedef f32x4 acc_t;
    __device__ __forceinline__ void prefetch(const Unit&, LAS unsigned char*, int) const {}
    __device__ __forceinline__ void operator()(const f32x4 (&acc)[2][2][4][2], const Unit& u, int wr, int wc, int fr, int fq) const {
        EPI_PREP unsigned char* ws = A_WS; float* out = A_OUT;
        if (u.kind == 0) {
            const int t = u.pn >> 2, ct = (u.pn & 3) * 256;
            bf16_t* base;
            if (t == 0) base = (bf16_t*)(ws + WS_Q); else if (t == 1) base = (bf16_t*)(ws + WS_K); else if (t == 3) base = (bf16_t*)(ws + WS_XR); else if (t == 4) base = (bf16_t*)(ws + WS_G);
            else if (t == 5) base = (u.pm < 256) ? (bf16_t*)(out + O_YP) : (bf16_t*)(ws + WS_SGA) - (size_t)NTP * DM;
            else base = (u.pm < 256) ? (bf16_t*)(out + O_YP) + (size_t)NTP * DM : (bf16_t*)(ws + WS_SGR) - (size_t)NTP * DM;
            if (t == 1) {
                EPI_LOOP_BEGIN
                    u32x4 w; w.x = cvtpk(v0[0], v0[1]); w.y = cvtpk(v0[2], v0[3]); w.z = cvtpk(v1[0], v1[1]); w.w = cvtpk(v1[2], v1[3]);
                    *(u32x4*)(base + kfrag_off(u.pm * 256 + rit, ct + cit)) = w;
                EPI_LOOP_END
            } else if (t >= 5) {
                unsigned char* g8 = (unsigned char*)(out + O_YP) + (t == 6 ? (size_t)NTP * DM : 0) + (size_t)u.pm * 256 * DM + ct;
                EPI_LOOP_BEGIN
                    u32x2 w;
                    w.x = (unsigned)(int)rintf(sigmoidf_(v0[0]) * 255.0f) | ((unsigned)(int)rintf(sigmoidf_(v0[1]) * 255.0f) << 8) | ((unsigned)(int)rintf(sigmoidf_(v0[2]) * 255.0f) << 16) | ((unsigned)(int)rintf(sigmoidf_(v0[3]) * 255.0f) << 24);
                    w.y = (unsigned)(int)rintf(sigmoidf_(v1[0]) * 255.0f) | ((unsigned)(int)rintf(sigmoidf_(v1[1]) * 255.0f) << 8) | ((unsigned)(int)rintf(sigmoidf_(v1[2]) * 255.0f) << 16) | ((unsigned)(int)rintf(sigmoidf_(v1[3]) * 255.0f) << 24);
                    *(u32x2*)(g8 + (size_t)rit * DM + cit) = w;
                EPI_LOOP_END
            } else {
            base += (size_t)u.pm * 256 * DM + ct;
            EPI_LOOP_BEGIN
                u32x4 w; w.x = cvtpk(v0[0], v0[1]); w.y = cvtpk(v0[2], v0[3]); w.z = cvtpk(v1[0], v1[1]); w.w = cvtpk(v1[2], v1[3]);
                *(u32x4*)(base + (size_t)rit * DM + cit) = w;
            EPI_LOOP_END
            }
            if (t == 1 && u.pm < 256 && (u.pm & 15) >= 14) { float* p0 = out + O_KP + ((size_t)(u.pm >> 4) * 512 + ((u.pm & 15) - 14) * 256) * DM + ct;
                EPI_LOOP_BEGIN float* p = p0 + (size_t)rit * DM + cit; *(f32x4*)p = v0; *(f32x4*)(p + 4) = v1; EPI_LOOP_END }
            if (t == 1 && u.pm == 256) { float* p0 = out + O_KS + ct;
                EPI_LOOP_BEGIN if (rit < NTS) { float* p = p0 + (size_t)rit * DM + cit; *(f32x4*)p = v0; *(f32x4*)(p + 4) = v1; } EPI_LOOP_END }
            if (t == 3 && u.pm < 256 && (u.pm & 15) == 15) { float* p0 = out + O_CP + ((size_t)(u.pm >> 4) * 3) * DM + ct;
                EPI_LOOP_BEGIN if (rit >= 253) { float* p = p0 + (size_t)(rit - 253) * DM + cit; *(f32x4*)p = v0; *(f32x4*)(p + 4) = v1; } EPI_LOOP_END }
            if (t == 3 && u.pm == 256) { float* p0 = out + O_CS + ct;
                EPI_LOOP_BEGIN if (rit < NTS && (rit & 15) >= 13) { float* p = p0 + ((size_t)(rit >> 4) * 3 + ((rit & 15) - 13)) * DM + cit; *(f32x4*)p = v0; *(f32x4*)(p + 4) = v1; } EPI_LOOP_END }
        } else {
            bf16_t* VT = (bf16_t*)(ws + WS_VT);
            EPI_LOOP_BEGIN
                u32x4 w; w.x = cvtpk(v0[0], v0[1]); w.y = cvtpk(v0[2], v0[3]); w.z = cvtpk(v1[0], v1[1]); w.w = cvtpk(v1[2], v1[3]);
                *(u32x4*)(VT + vfrag_off(u.pm * 256 + rit, u.pn * 256 + cit)) = w;
            EPI_LOOP_END
            if (u.pn < 256 && (u.pn & 15) >= 14) { float* p0 = out + O_VP + ((size_t)(u.pn >> 4) * 512 + ((u.pn & 15) - 14) * 256) * DM + u.pm * 256;
                EPI_LOOP_BEGIN float* p = p0 + (size_t)cit * DM + rit;
                    p[0] = v0[0]; p[DM] = v0[1]; p[2 * DM] = v0[2]; p[3 * DM] = v0[3]; p[4 * DM] = v1[0]; p[5 * DM] = v1[1]; p[6 * DM] = v1[2]; p[7 * DM] = v1[3]; EPI_LOOP_END }
            if (u.pn == 256) { float* p0 = out + O_VS + u.pm * 256;
                EPI_LOOP_BEGIN if (cit < NTS) { float* p = p0 + (size_t)cit * DM + rit;
                    p[0] = v0[0]; p[DM] = v0[1]; p[2 * DM] = v0[2]; p[3 * DM] = v0[3]; p[4 * DM] = v1[0]; p[5 * DM] = v1[1]; p[6 * DM] = v1[2]; p[7 * DM] = v1[3]; } EPI_LOOP_END }
        }
    }
};

struct EpiP3 {
    typedef f32x4 acc_t;
    __device__ __forceinline__ void prefetch(const Unit& u, LAS unsigned char* dummy, int tid) const {
        const char* base = (const char*)(A_OUT + O_YP) + (u.kind ? (size_t)NTP * DM : 0) + (size_t)u.pm * 256 * DM + u.pn * 256;
        asm volatile("" : "+v"(tid));
        __builtin_amdgcn_global_load_lds((const unsigned*)(base + (size_t)(tid >> 1) * DM + (tid & 1) * 128), (LAS unsigned*)dummy, 4, 0, 0);
    }
    __device__ __forceinline__ void operator()(const f32x4 (&acc)[2][2][4][2], const Unit& u, int wr, int wc, int fr, int fq) const {
        EPI_PREP unsigned char* ws = A_WS; float* out = A_OUT;
        const size_t off0 = (size_t)u.pm * 256 * DM + u.pn * 256;
        const unsigned char* gb = (const unsigned char*)(out + O_YP) + (u.kind ? (size_t)NTP * DM : 0) + off0; bf16_t* MG = (bf16_t*)(ws + WS_XR) + off0;
        const float k255 = 1.0f / 255.0f;
#pragma unroll
        for (int ai = 0; ai < 2; ++ai) {
            u32x2 gw[4][2]; u32x4 pw[4][2];
#pragma unroll
            for (int m = 0; m < 4; ++m)
#pragma unroll
                for (int bj = 0; bj < 2; ++bj) { const size_t off = (size_t)(ai * 128 + m * 16 + rl_) * DM + bj * 128 + cl_;
                    gw[m][bj] = *(const u32x2*)(gb + off); if (u.kind) pw[m][bj] = *(const u32x4*)(MG + off); }
#pragma unroll
            for (int m = 0; m < 4; ++m)
#pragma unroll
                for (int bj = 0; bj < 2; ++bj) { const size_t off = (size_t)(ai * 128 + m * 16 + rl_) * DM + bj * 128 + cl_;
                    const f32x4 v0 = acc[ai][bj][m][0] * k255, v1 = acc[ai][bj][m][1] * k255; const unsigned g0 = gw[m][bj].x, g1 = gw[m][bj].y;
                    f32x4 a0, a1;
                    a0[0] = (float)(g0 & 0xffu) * v0[0]; a0[1] = (float)((g0 >> 8) & 0xffu) * v0[1]; a0[2] = (float)((g0 >> 16) & 0xffu) * v0[2]; a0[3] = (float)(g0 >> 24) * v0[3];
                    a1[0] = (float)(g1 & 0xffu) * v1[0]; a1[1] = (float)((g1 >> 8) & 0xffu) * v1[1]; a1[2] = (float)((g1 >> 16) & 0xffu) * v1[2]; a1[3] = (float)(g1 >> 24) * v1[3];
                    if (u.kind) { const u32x4 p4 = pw[m][bj];
                        a0[0] += bflo(p4.x); a0[1] += bfhi(p4.x); a0[2] += bflo(p4.y); a0[3] += bfhi(p4.y); a1[0] += bflo(p4.z); a1[1] += bfhi(p4.z); a1[2] += bflo(p4.w); a1[3] += bfhi(p4.w); }
                    u32x4 w; w.x = cvtpk(a0[0], a0[1]); w.y = cvtpk(a0[2], a0[3]); w.z = cvtpk(a1[0], a1[1]); w.w = cvtpk(a1[2], a1[3]);
                    *(u32x4*)(MG + off) = w; }
        }
    }
};

struct EpiP4 {
    typedef f32x4 acc_t;
    __device__ __forceinline__ void prefetch(const Unit&, LAS unsigned char*, int) const {}
    __device__ __forceinline__ void operator()(const f32x4 (&acc)[2][2][4][2], const Unit& u, int wr, int wc, int fr, int fq) const {
        EPI_PREP bf16_t* base = (bf16_t*)(A_WS + WS_DELTA) + (size_t)u.pm * 256 * DM + u.pn * 256;
        EPI_LOOP_BEGIN
            u32x4 w; w.x = cvtpk(v0[0], v0[1]); w.y = cvtpk(v0[2], v0[3]); w.z = cvtpk(v1[0], v1[1]); w.w = cvtpk(v1[2], v1[3]);
            *(u32x4*)(base + (size_t)rit * DM + cit) = w;
        EPI_LOOP_END
    }
};

struct EpiP5 {
    typedef i32x4_t acc_t;
    __device__ __forceinline__ void prefetch(const Unit&, LAS unsigned char*, int) const {}
    __device__ __forceinline__ void operator()(const i32x4_t (&acc)[2][2][4][2], const Unit& u, int wr, int wc, int fr, int fq) const {
        EPI_PREP bf16_t* SC = (bf16_t*)(A_WS + WS_XN) + (size_t)u.pm * 256 * 2048 + u.pn * 256;
        const float* SXp = (const float*)(A_WS + WS_SX) + u.pm * 256; const float* SWp = (const float*)(A_WS + WS_SW) + u.pn * 256;
        EPI_LOOP_BEGIN
            const float sx = SXp[rit]; const f32x4 w0 = *(const f32x4*)(SWp + cit), w1 = *(const f32x4*)(SWp + cit + 4);
            u32x4 w; w.x = cvtpk((float)v0[0] * sx * w0[0], (float)v0[1] * sx * w0[1]); w.y = cvtpk((float)v0[2] * sx * w0[2], (float)v0[3] * sx * w0[3]);
            w.z = cvtpk((float)v1[0] * sx * w1[0], (float)v1[1] * sx * w1[1]); w.w = cvtpk((float)v1[2] * sx * w1[2], (float)v1[3] * sx * w1[3]);
            *(u32x4*)(SC + (size_t)rit * 2048 + cit) = w;
        EPI_LOOP_END
    }
};

__device__ __forceinline__ void row_ld(const float* p, f32x4 (&v)[4], int lane) {
#pragma unroll
    for (int j = 0; j < 4; ++j) v[j] = *(const f32x4*)(p + j * 256 + lane * 4);
}
__device__ __forceinline__ float row_ss(const f32x4 (&v)[4]) { float s = 0.f;
#pragma unroll
    for (int j = 0; j < 4; ++j) s += (v[j][0] * v[j][0] + v[j][1] * v[j][1]) + (v[j][2] * v[j][2] + v[j][3] * v[j][3]);
    return s; }
__device__ __forceinline__ void row_add_bf16(const bf16_t* p, f32x4 (&v)[4], int lane) {
#pragma unroll
    for (int j = 0; j < 4; ++j) { const u32x2 w = *(const u32x2*)(p + j * 256 + lane * 4); v[j][0] += bflo(w.x); v[j][1] += bfhi(w.x); v[j][2] += bflo(w.y); v[j][3] += bfhi(w.y); }
}
__device__ __forceinline__ const float* xrow_ptr(int m) { return (m < NTP) ? A_IN(0) + (size_t)m * DM : A_IN(1) + (size_t)(m - NTP) * DM; }
__device__ __forceinline__ float* yrow_ptr(int m) { return (m < NTP) ? A_OUT + O_YP + (size_t)m * DM : A_OUT + O_YS + (size_t)(m - NTP) * DM; }

__device__ __forceinline__ void p0_transpose_item(const float* W, int K, int N, bf16_t* WT, LAS float* scr, int item, int lane, int nscale = 0) {
    const int nblk = N / 32, kb = item / nblk, nb = item % nblk, k0 = 64 * kb, n0 = 32 * nb;
#pragma unroll 8
    for (int i = 0; i < 32; ++i) { const int kk = 2 * i + (lane >> 5); scr[kk * 33 + (lane & 31)] = W[(size_t)(k0 + kk) * N + n0 + (lane & 31)] * (n0 < nscale ? QSCALE : 1.0f); }
    asm volatile("s_waitcnt lgkmcnt(0)" ::: "memory");
    const int c = lane & 7;
#pragma unroll
    for (int j = 0; j < 4; ++j) { const int n = (lane >> 3) + 8 * j; const LAS float* s = scr + (8 * c) * 33 + n;
        u32x4 o; o.x = cvtpk(s[0 * 33], s[1 * 33]); o.y = cvtpk(s[2 * 33], s[3 * 33]); o.z = cvtpk(s[4 * 33], s[5 * 33]); o.w = cvtpk(s[6 * 33], s[7 * 33]);
        *(u32x4*)(WT + (size_t)(n0 + n) * K + k0 + 8 * c) = o; }
    asm volatile("s_waitcnt lgkmcnt(0)" ::: "memory");
}

__device__ __forceinline__ void p0_prologue(LAS unsigned char* lds, int G, int wave, int lane) {
    unsigned char* ws = A_WS;
    const int gw = blockIdx.x * 8 + wave, NGW = G * 8;
    LAS float* scr = (LAS float*)(lds + wave * 16384);
    constexpr int I_IN = 16 * (INC / 32), I_SQ = 16 * 32, NTR = I_IN + 3 * I_SQ;
    for (int it = gw; it < NTR; it += NGW) {
        int r = it;
        if (r < I_IN) { p0_transpose_item(A_IN(7), DM, INC, (bf16_t*)(ws + WS_WIN), scr, r, lane, 1024); continue; } r -= I_IN;
        if (r < I_SQ) { p0_transpose_item(A_IN(16), DM, DM, (bf16_t*)(ws + WS_WBA), scr, r, lane); continue; } r -= I_SQ;
        if (r < I_SQ) { p0_transpose_item(A_IN(17), DM, DM, (bf16_t*)(ws + WS_WBL), scr, r, lane); continue; } r -= I_SQ;
        p0_transpose_item(A_IN(18), DM, DM, (bf16_t*)(ws + WS_WO), scr, r, lane);
    }
    {
        const float* wq = A_IN(20); bf16_t* wst = (bf16_t*)(ws + WS_WS);
        const int r32 = lane & 31, hi = lane >> 5;
        for (int it = gw; it < 2048; it += NGW) {
            const int hj = it >> 7, kt = (it >> 5) & 3, ct = it & 31, h = hj >> 1, j = hj & 1;
            const float* ap = (j ? A_IN(22) : A_IN(21)) + ((size_t)(h * 128 + kt * 32 + r32)) * 128 + 64 * hi;
            const float* bp = wq + (size_t)(ct * 32 + r32) * 2048 + hj * 128 + 64 * hi;
            f32x16 acc = {};
#pragma unroll
            for (int s4 = 0; s4 < 16; ++s4) { const f32x4 av = *(const f32x4*)(ap + 4 * s4), bv = *(const f32x4*)(bp + 4 * s4);
                acc = __builtin_amdgcn_mfma_f32_32x32x2f32(av[0], bv[0], acc, 0, 0, 0); acc = __builtin_amdgcn_mfma_f32_32x32x2f32(av[1], bv[1], acc, 0, 0, 0);
                acc = __builtin_amdgcn_mfma_f32_32x32x2f32(av[2], bv[2], acc, 0, 0, 0); acc = __builtin_amdgcn_mfma_f32_32x32x2f32(av[3], bv[3], acc, 0, 0, 0); }
#pragma unroll
            for (int r = 0; r < 16; ++r) { const int key = kt * 32 + (r & 3) + 8 * (r >> 2) + 4 * hi;
                wst[(size_t)(key * 16 + hj) * DM + ct * 32 + r32] = (bf16_t)(cvtpk(acc[r], 0.f) & 0xffffu); }
        }
    }
    {
        f32x4 p[4], pn[4];
        if (gw < 2 * NEXP) {
#pragma unroll
            for (int q = 0; q < 4; ++q) p[q] = *(const f32x4*)(((gw >= NEXP) ? A_IN(24) + (size_t)(gw - NEXP) * DM : A_IN(23) + (size_t)gw * DM) + lane * 16 + 4 * q); }
        for (int it = gw; it < 2 * NEXP; it += NGW) {
            const int tb = it >= NEXP, e = it - tb * NEXP, itn = it + NGW;
            if (itn < 2 * NEXP) {
#pragma unroll
                for (int q = 0; q < 4; ++q) pn[q] = *(const f32x4*)(((itn >= NEXP) ? A_IN(24) + (size_t)(itn - NEXP) * DM : A_IN(23) + (size_t)itn * DM) + lane * 16 + 4 * q); }
            unsigned char* dst = ws + (tb ? WS_VB : WS_UB) + (size_t)e * DM + lane * 16;
            float mx = 0.f;
#pragma unroll
            for (int q = 0; q < 4; ++q) mx = fmaxf(mx, fmaxf(fmaxf(fabsf(p[q][0]), fabsf(p[q][1])), fmaxf(fabsf(p[q][2]), fabsf(p[q][3]))));
#pragma unroll
            for (int o = 1; o < 64; o <<= 1) mx = fmaxf(mx, __shfl_xor(mx, o));
            const float step = fmaxf(mx, 1e-30f) * (1.0f / 127.0f), inv = 1.0f / step;
            u32x4 w;
#pragma unroll
            for (int q = 0; q < 4; ++q) {
                const unsigned b0 = (unsigned)(int)rintf(p[q][0] * inv) & 0xffu, b1 = (unsigned)(int)rintf(p[q][1] * inv) & 0xffu, b2 = (unsigned)(int)rintf(p[q][2] * inv) & 0xffu, b3 = (unsigned)(int)rintf(p[q][3] * inv) & 0xffu;
                w[q] = b0 | (b1 << 8) | (b2 << 16) | (b3 << 24); }
            *(u32x4*)dst = w;
            if (lane == 0) ((float*)(ws + (tb ? WS_SV : WS_SU)))[e] = step;
#pragma unroll
            for (int q = 0; q < 4; ++q) p[q] = pn[q];
        }
    }
    {
        const float* gm = A_IN(6); bf16_t* XN = (bf16_t*)(ws + WS_XN);
        for (int m = NTOK + gw; m < ROWS; m += NGW) {
#pragma unroll
            for (int j = 0; j < 2; ++j) *(u32x4*)(XN + (size_t)m * DM + j * 512 + lane * 8) = (u32x4){0u, 0u, 0u, 0u}; }
        f32x4 v[4], vn[4];
        if (gw < NTOK) row_ld(xrow_ptr(gw), v, lane);
        for (int m = gw; m < NTOK; m += NGW) {
            const int mn = m + NGW;
            if (mn < NTOK) row_ld(xrow_ptr(mn), vn, lane);
            bf16_t* orow = XN + (size_t)m * DM;
            const float inv = 1.0f / sqrtf(wave_sum(row_ss(v)) * (1.0f / DM) + EPS);
#pragma unroll
            for (int j = 0; j < 4; ++j) { const f32x4 gg = *(const f32x4*)(gm + j * 256 + lane * 4); const f32x4 y = v[j] * inv * gg;
                u32x2 w; w.x = cvtpk(y[0], y[1]); w.y = cvtpk(y[2], y[3]); *(u32x2*)(orow + j * 256 + lane * 4) = w; }
#pragma unroll
            for (int j = 0; j < 4; ++j) v[j] = vn[j];
        }
    }
    {
        bf16_t* fw = (bf16_t*)(ws + WS_LRUW);
        for (int f = gw; f < 256; f += NGW) {
            const int ks = f & 3, T = (f >> 2) & 1, gate = (f >> 3) & 1, g = f >> 4, i = lane & 31, hi = lane >> 5;
            const int outc = 32 * T + swap23(i);
            const float* W = (gate ? A_IN(13) : A_IN(11)) + (size_t)g * 4096;
            float x[8];
#pragma unroll
            for (int j = 0; j < 8; ++j) x[j] = W[(16 * ks + 8 * hi + j) * 64 + outc];
            u32x4 w; w.x = cvtpk(x[0], x[1]); w.y = cvtpk(x[2], x[3]); w.z = cvtpk(x[4], x[5]); w.w = cvtpk(x[6], x[7]);
            *(u32x4*)(fw + (size_t)f * 512 + lane * 8) = w;
        }
    }
}

constexpr int LR_WF = 0, LR_CW = 16384, LR_CB = LR_CW + 1024, LR_BR = LR_CB + 256, LR_BI = LR_BR + 256, LR_CS = LR_BI + 256, LR_CARRY = LR_CS + 256, LR_SEQ = LR_CARRY + 2048, LR_END = LR_SEQ + 64, LR_DUMMY = 21504;

__device__ __forceinline__ void lru_load_consts(LAS unsigned char* lds, int g, int tid) {
    const u32x4* src = (const u32x4*)(A_WS + WS_LRUW + (size_t)g * 16384);
    for (int i = tid; i < 1024; i += 512) ((LAS u32x4*)(lds + LR_WF))[i] = src[i];
    if (tid < 256) ((LAS float*)(lds + LR_CW))[tid] = A_IN(9)[(tid >> 6) * DM + g * 64 + (tid & 63)];
    if (tid < 64) {
        const int c = g * 64 + tid;
        ((LAS float*)(lds + LR_CB))[tid] = A_IN(10)[c]; ((LAS float*)(lds + LR_BR))[tid] = A_IN(12)[c]; ((LAS float*)(lds + LR_BI))[tid] = A_IN(14)[c];
        ((LAS float*)(lds + LR_CS))[tid] = 8.0f * log1pf(expf(-A_IN(15)[c]));
    }
    if (tid < 8) ((LAS unsigned*)(lds + LR_SEQ))[tid] = 0xffffffffu;
}

template <bool SAMPLE>
__device__ __forceinline__ void lru_tile(LAS unsigned char* lds, int lane, int g, size_t rowbase, int tile, int bidx) {
    asm volatile("" : "+v"(lane));
    const int tl = lane & 31, hi = lane >> 5, t = tile * 32 + tl;
    const bf16_t* XR = (const bf16_t*)(A_WS + WS_XR); bf16_t* Gb = (bf16_t*)(A_WS + WS_G);
    const int cbase = g * 64 + 8 * hi;
    u32x4 gw4[4];
    {   const bf16_t* gp0 = Gb + (rowbase + (SAMPLE ? (tl < NST ? t : 0) : t)) * DM + cbase;
#pragma unroll
        for (int ks = 0; ks < 4; ++ks) gw4[ks] = *(const u32x4*)(gp0 + 16 * ks); }
    float xc[4][8];
    bf16x8 xf[4];
#pragma unroll
    for (int ks = 0; ks < 4; ++ks) {
        const f32x4 b0 = *(const LAS f32x4*)(lds + LR_CB + (16 * ks + 8 * hi) * 4), b1 = *(const LAS f32x4*)(lds + LR_CB + (16 * ks + 8 * hi) * 4 + 16);
#pragma unroll
        for (int j = 0; j < 4; ++j) { xc[ks][j] = b0[j]; xc[ks][4 + j] = b1[j]; }
#pragma unroll
        for (int tap = 0; tap < 4; ++tap) {
            const int rr = t - 3 + tap;
            float xv[8];
            {
                u32x4 w = *(const u32x4*)(XR + (rowbase + (rr < 0 ? 0 : rr)) * DM + cbase + 16 * ks);
                if (rr < 0) w = (u32x4){0u, 0u, 0u, 0u};
                xv[0] = bflo(w.x); xv[1] = bfhi(w.x); xv[2] = bflo(w.y); xv[3] = bfhi(w.y); xv[4] = bflo(w.z); xv[5] = bfhi(w.z); xv[6] = bflo(w.w); xv[7] = bfhi(w.w);
            }
            if (SAMPLE) {
                const float* sp = A_IN(4) + ((size_t)bidx * 3 + (rr < 0 ? 3 + rr : 0)) * DM + cbase + 16 * ks;
                const f32x4 p = *(const f32x4*)sp, q = *(const f32x4*)(sp + 4);
#pragma unroll
                for (int j = 0; j < 4; ++j) { xv[j] = rr < 0 ? p[j] : xv[j]; xv[4 + j] = rr < 0 ? q[j] : xv[4 + j]; }
            }
            const f32x4 w0 = *(const LAS f32x4*)(lds + LR_CW + (tap * 64 + 16 * ks + 8 * hi) * 4), w1 = *(const LAS f32x4*)(lds + LR_CW + (tap * 64 + 16 * ks + 8 * hi) * 4 + 16);
#pragma unroll
            for (int j = 0; j < 4; ++j) { xc[ks][j] += w0[j] * xv[j]; xc[ks][4 + j] += w1[j] * xv[4 + j]; }
        }
        u32x4 w; w.x = cvtpk(xc[ks][0], xc[ks][1]); w.y = cvtpk(xc[ks][2], xc[ks][3]); w.z = cvtpk(xc[ks][4], xc[ks][5]); w.w = cvtpk(xc[ks][6], xc[ks][7]);
        xf[ks] = __builtin_bit_cast(bf16x8, w);
        asm volatile("" ::: "memory");
    }
    float A[32], B[32];
#pragma unroll
    for (int T = 0; T < 2; ++T) {
        f32x16 ar = f32x16{}, ai = f32x16{};
#pragma unroll
        for (int ks = 0; ks < 4; ++ks) {
            const bf16x8 wr_ = *(const LAS bf16x8*)(lds + LR_WF + ((0 * 2 + T) * 4 + ks) * 1024 + lane * 16);
            const bf16x8 wi_ = *(const LAS bf16x8*)(lds + LR_WF + ((1 * 2 + T) * 4 + ks) * 1024 + lane * 16);
            ar = __builtin_amdgcn_mfma_f32_32x32x16_bf16(wr_, xf[ks], ar, 0, 0, 0);
            ai = __builtin_amdgcn_mfma_f32_32x32x16_bf16(wi_, xf[ks], ai, 0, 0, 0);
        }
#pragma unroll
        for (int q = 0; q < 2; ++q) {
            const int ks = 2 * T + q, lo = (16 * ks + 8 * hi) * 4;
            const f32x4 br0 = *(const LAS f32x4*)(lds + LR_BR + lo), br1 = *(const LAS f32x4*)(lds + LR_BR + lo + 16);
            const f32x4 bi0 = *(const LAS f32x4*)(lds + LR_BI + lo), bi1 = *(const LAS f32x4*)(lds + LR_BI + lo + 16);
            const f32x4 cs0 = *(const LAS f32x4*)(lds + LR_CS + lo), cs1 = *(const LAS f32x4*)(lds + LR_CS + lo + 16);
#pragma unroll
            for (int j = 0; j < 8; ++j) {
                const int r = 8 * q + j;
                const float brv = j < 4 ? br0[j & 3] : br1[j & 3], biv = j < 4 ? bi0[j & 3] : bi1[j & 3], csv = j < 4 ? cs0[j & 3] : cs1[j & 3];
                const float rg = sigmoidf_(ar[r] + brv), ig = sigmoidf_(ai[r] + biv);
                const float la = -csv * rg, av = fast_exp2(la * LOG2E);
                const float x2 = 2.0f * la;
                const float em = (x2 > -0.03f) ? -x2 * (1.0f + x2 * (0.5f + x2 * (0.16666667f + x2 * 0.041666668f))) : 1.0f - fast_exp2(x2 * LOG2E);
                A[16 * T + r] = av; B[16 * T + r] = sqrtf(em) * ig * xc[ks][j];
            }
        }
        asm volatile("" ::: "memory");
    }
#define LRU_STEP(CTRL, RM) _Pragma("unroll") for (int c = 0; c < 32; ++c) { \
        const float as_ = __builtin_bit_cast(float, __builtin_amdgcn_update_dpp(__builtin_bit_cast(int, 1.0f), __builtin_bit_cast(int, A[c]), CTRL, RM, 0xF, false)); \
        const float bs_ = __builtin_bit_cast(float, __builtin_amdgcn_update_dpp(0, __builtin_bit_cast(int, B[c]), CTRL, RM, 0xF, false)); \
        B[c] = A[c] * bs_ + B[c]; A[c] = A[c] * as_; }
    LRU_STEP(0x111, 0xF) LRU_STEP(0x112, 0xF) LRU_STEP(0x114, 0xF) LRU_STEP(0x118, 0xF) LRU_STEP(0x142, 0xA)
#undef LRU_STEP
    float hin[32];
    if (SAMPLE) {
        const float* hp = A_IN(5) + (size_t)bidx * DM + cbase;
#pragma unroll
        for (int ks = 0; ks < 4; ++ks) { const f32x4 p = *(const f32x4*)(hp + 16 * ks), q = *(const f32x4*)(hp + 16 * ks + 4);
#pragma unroll
            for (int j = 0; j < 4; ++j) { hin[8 * ks + j] = p[j]; hin[8 * ks + 4 + j] = q[j]; } }
    } else if (tile == 0) {
#pragma unroll
        for (int c = 0; c < 32; ++c) hin[c] = 0.f;
    } else {
        volatile LAS unsigned* sq = (volatile LAS unsigned*)(lds + LR_SEQ) + (tile & 7);
        while (*sq != (unsigned)tile) __builtin_amdgcn_s_sleep(1);
        asm volatile("" ::: "memory");
        const LAS float* cp = (const LAS float*)(lds + LR_CARRY) + (tile & 7) * 64 + 8 * hi;
#pragma unroll
        for (int ks = 0; ks < 4; ++ks) { const f32x4 p = *(const LAS f32x4*)(cp + 16 * ks), q = *(const LAS f32x4*)(cp + 16 * ks + 4);
#pragma unroll
            for (int j = 0; j < 4; ++j) { hin[8 * ks + j] = p[j]; hin[8 * ks + 4 + j] = q[j]; } }
    }
#pragma unroll
    for (int c = 0; c < 32; ++c) B[c] = B[c] + A[c] * hin[c];
    if (!SAMPLE) {
        if (tl == 31) {
            if (tile < 127) {
                LAS float* cp = (LAS float*)(lds + LR_CARRY) + ((tile + 1) & 7) * 64 + 8 * hi;
#pragma unroll
                for (int ks = 0; ks < 4; ++ks) { *(LAS f32x4*)(cp + 16 * ks) = (f32x4){B[8 * ks], B[8 * ks + 1], B[8 * ks + 2], B[8 * ks + 3]};
                    *(LAS f32x4*)(cp + 16 * ks + 4) = (f32x4){B[8 * ks + 4], B[8 * ks + 5], B[8 * ks + 6], B[8 * ks + 7]}; }
            } else {
                float* lp = A_OUT + O_LP + (size_t)bidx * DM + cbase;
#pragma unroll
                for (int ks = 0; ks < 4; ++ks) { *(f32x4*)(lp + 16 * ks) = (f32x4){B[8 * ks], B[8 * ks + 1], B[8 * ks + 2], B[8 * ks + 3]};
                    *(f32x4*)(lp + 16 * ks + 4) = (f32x4){B[8 * ks + 4], B[8 * ks + 5], B[8 * ks + 6], B[8 * ks + 7]}; }
            }
        }
        if (tile < 127) {
            asm volatile("s_waitcnt lgkmcnt(0)" ::: "memory");
            if (lane == 63) *((volatile LAS unsigned*)(lds + LR_SEQ) + ((tile + 1) & 7)) = (unsigned)(tile + 1);
        }
    } else if (tl == 15) {
        float* lp = A_OUT + O_LS + (size_t)bidx * DM + cbase;
#pragma unroll
        for (int ks = 0; ks < 4; ++ks) { *(f32x4*)(lp + 16 * ks) = (f32x4){B[8 * ks], B[8 * ks + 1], B[8 * ks + 2], B[8 * ks + 3]};
            *(f32x4*)(lp + 16 * ks + 4) = (f32x4){B[8 * ks + 4], B[8 * ks + 5], B[8 * ks + 6], B[8 * ks + 7]}; }
    }
    if (!SAMPLE || tl < NST) {
        bf16_t* gp = Gb + (rowbase + t) * DM + cbase;
#pragma unroll
        for (int ks = 0; ks < 4; ++ks) {
            const u32x4 w = gw4[ks];
            float gv[8]; gv[0] = bflo(w.x); gv[1] = bfhi(w.x); gv[2] = bflo(w.y); gv[3] = bfhi(w.y); gv[4] = bflo(w.z); gv[5] = bfhi(w.z); gv[6] = bflo(w.w); gv[7] = bfhi(w.w);
            float o[8];
#pragma unroll
            for (int j = 0; j < 8; ++j) o[j] = B[8 * ks + j] * gelu_tanh(gv[j]);
            u32x4 ow; ow.x = cvtpk(o[0], o[1]); ow.y = cvtpk(o[2], o[3]); ow.z = cvtpk(o[4], o[5]); ow.w = cvtpk(o[6], o[7]);
            *(u32x4*)(gp + 16 * ks) = ow;
        }
    }
    if (!SAMPLE && tile + 16 < 128) {
        const size_t r2 = (rowbase + (size_t)(tile + 16) * 32 + (lane >> 1)) * DM + g * 64 + (lane & 1) * 32;
        __builtin_amdgcn_global_load_lds((const unsigned*)(XR + r2), (LAS unsigned*)(lds + LR_DUMMY + (tile & 7) * 256), 4, 0, 0);
        __builtin_amdgcn_global_load_lds((const unsigned*)(Gb + r2), (LAS unsigned*)(lds + LR_DUMMY + (tile & 7) * 256), 4, 0, 0);
    }
}

constexpr int P2_Q = 20608;
constexpr int AT_TAB = 24576;
__device__ __forceinline__ void attn_unit(LAS unsigned char* lds, int lane, int b, int c, int h) {
    const int r32 = lane & 31, hi = lane >> 5, kr = swap23(r32);
    const bf16_t* Q = (const bf16_t*)(A_WS + WS_Q); const bf16_t* Kb = (const bf16_t*)(A_WS + WS_K); const bf16_t* VT = (const bf16_t*)(A_WS + WS_VT); bf16_t* O = (bf16_t*)(A_WS + WS_XN);
    const size_t row0 = (size_t)b * SEQ + (size_t)c * 64;
    bf16x8 qf[2][4];
#pragma unroll
    for (int qb = 0; qb < 2; ++qb)
#pragma unroll
        for (int ks = 0; ks < 4; ++ks) qf[qb][ks] = *(const bf16x8*)(Q + (row0 + qb * 32 + r32) * DM + h * 64 + ks * 16 + hi * 8);
    f32x16 o[2][2];
#pragma unroll
    for (int i = 0; i < 2; ++i)
#pragma unroll
        for (int j = 0; j < 2; ++j) o[i][j] = f32x16{};
    float mrow[2] = {-1e30f, -1e30f}, lrow[2] = {0.f, 0.f};
    const LAS float* tab = (const LAS float*)(lds + AT_TAB) + h * 320;
    const float cfar = tab[256];
    const int sb0 = (c >= 8 ? c - 8 : 0) * 2, sb1 = c * 2 + 1;
    const bf16_t* kbase = Kb + ((size_t)b * 128 * 16 + h) * 4 * 512 + lane * 8;
    const bf16_t* vbase = VT + ((size_t)b * 128 * 16 + h) * 4 * 512 + lane * 8;
    bf16x8 kf[4], vf[2][2];
#pragma unroll
    for (int ks = 0; ks < 4; ++ks) kf[ks] = *(const bf16x8*)(kbase + (size_t)sb0 * 32768 + ks * 512);
#pragma unroll
    for (int db = 0; db < 2; ++db)
#pragma unroll
        for (int s = 0; s < 2; ++s) vf[db][s] = *(const bf16x8*)(vbase + (size_t)sb0 * 32768 + (db * 2 + s) * 512);
    for (int sb = sb0; sb <= sb1; ++sb) {
        const int sbn = sb < sb1 ? sb + 1 : sb;
        f32x16 S[2];
#pragma unroll
        for (int qb = 0; qb < 2; ++qb) { S[qb] = f32x16{};
#pragma unroll
            for (int ks = 0; ks < 4; ++ks) S[qb] = __builtin_amdgcn_mfma_f32_32x32x16_bf16(kf[ks], qf[qb][ks], S[qb], 0, 0, 0); }
        asm volatile("" ::: "memory");
#pragma unroll
        for (int ks = 0; ks < 4; ++ks) kf[ks] = *(const bf16x8*)(kbase + (size_t)sbn * 32768 + ks * 512);
        const int delta = c - (sb >> 1), rb = sb & 1;
        if (delta >= 3) {
#pragma unroll
            for (int qb = 0; qb < 2; ++qb)
#pragma unroll
                for (int r = 0; r < 16; ++r) S[qb][r] += cfar;
        } else {
#pragma unroll
            for (int qb = 0; qb < 2; ++qb) {
                const LAS float* tp = tab + (64 * delta + 32 * qb + r32 + 128 - 32 * rb - 8 * hi - 23);
#pragma unroll
                for (int r = 0; r < 16; ++r) S[qb][r] += tp[23 - (16 * (r >> 3) + (r & 7))];
            }
        }
        float rm[2];
#pragma unroll
        for (int qb = 0; qb < 2; ++qb) { float mx = S[qb][0];
#pragma unroll
            for (int r = 1; r < 16; ++r) mx = fmaxf(mx, S[qb][r]);
            rm[qb] = plswap_max(mx); }
        if (__any((rm[0] > mrow[0] + 8.0f) || (rm[1] > mrow[1] + 8.0f))) {
#pragma unroll
            for (int qb = 0; qb < 2; ++qb) { const float mn = fmaxf(mrow[qb], rm[qb]); const float al = fast_exp2(mrow[qb] - mn); lrow[qb] *= al; mrow[qb] = mn;
#pragma unroll
                for (int r = 0; r < 16; ++r) { o[0][qb][r] *= al; o[1][qb][r] *= al; } }
        }
        bf16x8 pf[2][2];
#pragma unroll
        for (int qb = 0; qb < 2; ++qb) { float sum = 0.f;
#pragma unroll
            for (int r = 0; r < 16; ++r) { S[qb][r] = fast_exp2(S[qb][r] - mrow[qb]); sum += S[qb][r]; }
            lrow[qb] += sum;
#pragma unroll
            for (int s = 0; s < 2; ++s) { u32x4 w; w.x = cvtpk(S[qb][8 * s], S[qb][8 * s + 1]); w.y = cvtpk(S[qb][8 * s + 2], S[qb][8 * s + 3]); w.z = cvtpk(S[qb][8 * s + 4], S[qb][8 * s + 5]); w.w = cvtpk(S[qb][8 * s + 6], S[qb][8 * s + 7]);
                pf[qb][s] = __builtin_bit_cast(bf16x8, w); } }
#pragma unroll
        for (int db = 0; db < 2; ++db)
#pragma unroll
            for (int qb = 0; qb < 2; ++qb)
#pragma unroll
                for (int s = 0; s < 2; ++s) o[db][qb] = __builtin_amdgcn_mfma_f32_32x32x16_bf16(vf[db][s], pf[qb][s], o[db][qb], 0, 0, 0);
        asm volatile("" ::: "memory");
#pragma unroll
        for (int db = 0; db < 2; ++db)
#pragma unroll
            for (int s = 0; s < 2; ++s) vf[db][s] = *(const bf16x8*)(vbase + (size_t)sbn * 32768 + (db * 2 + s) * 512);
    }
#pragma unroll
    for (int qb = 0; qb < 2; ++qb) { const float inv = fast_rcp(plswap_add(lrow[qb]));
        bf16_t* op = O + (row0 + qb * 32 + r32) * DM + h * 64 + 8 * hi;
#pragma unroll
        for (int db = 0; db < 2; ++db)
#pragma unroll
            for (int s = 0; s < 2; ++s) { u32x4 w;
                w.x = cvtpk(o[db][qb][8 * s] * inv, o[db][qb][8 * s + 1] * inv); w.y = cvtpk(o[db][qb][8 * s + 2] * inv, o[db][qb][8 * s + 3] * inv);
                w.z = cvtpk(o[db][qb][8 * s + 4] * inv, o[db][qb][8 * s + 5] * inv); w.w = cvtpk(o[db][qb][8 * s + 6] * inv, o[db][qb][8 * s + 7] * inv);
                *(u32x4*)(op + 32 * db + 16 * s) = w; } }
}

constexpr int AS_P = 45056;
__device__ __forceinline__ void attn_sample_task(LAS unsigned char* lds, int wave, int lane, int task) {
    const int bs = task >> 6, h = (task >> 2) & 15, qg = task & 3;
    const bf16_t* Q = (const bf16_t*)(A_WS + WS_Q); bf16_t* O = (bf16_t*)(A_WS + WS_XN);
    const float* ck = A_IN(2); const float* cv = A_IN(3); const float* kn = A_OUT + O_KS; const float* vn = A_OUT + O_VS;
    LAS float* pb = (LAS float*)(lds + AS_P + wave * 9472);
    LAS float* qs = pb + 4 * 528;
    const LAS float* tab = (const LAS float*)(lds + AT_TAB) + h * 320;
#pragma unroll
    for (int i = 0; i < 4; ++i) qs[i * 64 + lane] = bflo((unsigned)Q[((size_t)NTP + bs * 16 + qg * 4 + i) * DM + h * 64 + lane]);
    asm volatile("s_waitcnt lgkmcnt(0)" ::: "memory");
#pragma unroll 1
    for (int it = 0; it < 9; ++it) {
        const int key = it * 64 + lane; const bool valid = key < 528;
        const float* kp = !valid ? ck : (key < 512 ? ck + (((size_t)bs * 512 + key) * 16 + h) * 64 : kn + ((size_t)bs * 16 + (key - 512)) * DM + h * 64);
        float d[4] = {0.f, 0.f, 0.f, 0.f};
        f32x4 kv[16];
#pragma unroll
        for (int d4 = 0; d4 < 16; ++d4) kv[d4] = *(const f32x4*)(kp + 4 * d4);
#pragma unroll
        for (int d4 = 0; d4 < 16; ++d4) {
#pragma unroll
            for (int i = 0; i < 4; ++i) { const f32x4 qq = *(const LAS f32x4*)(qs + i * 64 + 4 * d4); d[i] += (kv[d4][0] * qq[0] + kv[d4][1] * qq[1]) + (kv[d4][2] * qq[2] + kv[d4][3] * qq[3]); } }
        int rel = 512 + qg * 4 - key;
        if (valid) {
#pragma unroll
            for (int i = 0; i < 4; ++i) { int r = rel + i; r = r > 128 ? 128 : r; pb[i * 528 + key] = d[i] + tab[r + 128]; } }
    }
    asm volatile("s_waitcnt lgkmcnt(0)" ::: "memory");
#pragma unroll 1
    for (int i = 0; i < 4; ++i) {
        float mx = -1e30f;
#pragma unroll 1
        for (int key = lane; key < 528; key += 64) mx = fmaxf(mx, pb[i * 528 + key]);
#pragma unroll
        for (int o = 1; o < 64; o <<= 1) mx = fmaxf(mx, __shfl_xor(mx, o));
        float sum = 0.f;
#pragma unroll 1
        for (int key = lane; key < 528; key += 64) { const float pv = fast_exp2(pb[i * 528 + key] - mx); pb[i * 528 + key] = pv; sum += pv; }
        sum = wave_sum(sum); const float inv = 1.0f / sum;
#pragma unroll 1
        for (int key = lane; key < 528; key += 64) pb[i * 528 + key] *= inv;
    }
    asm volatile("s_waitcnt lgkmcnt(0)" ::: "memory");
    float acc[4] = {0.f, 0.f, 0.f, 0.f};
#pragma unroll 1
    for (int k0 = 0; k0 < 528; k0 += 16) {
        float vv[16];
#pragma unroll
        for (int kk = 0; kk < 16; ++kk) { const int key = k0 + kk; vv[kk] = k0 < 512 ? cv[(((size_t)bs * 512 + key) * 16 + h) * 64 + lane] : vn[((size_t)bs * 16 + (key - 512)) * DM + h * 64 + lane]; }
#pragma unroll
        for (int kk = 0; kk < 16; ++kk) {
#pragma unroll
            for (int i = 0; i < 4; ++i) acc[i] += pb[i * 528 + k0 + kk] * vv[kk]; }
    }
#pragma unroll
    for (int i = 0; i < 4; ++i) O[((size_t)NTP + bs * 16 + qg * 4 + i) * DM + h * 64 + lane] = (bf16_t)(cvtpk(acc[i], 0.f) & 0xffffu);
    asm volatile("s_waitcnt lgkmcnt(0)" ::: "memory");
}

__device__ __forceinline__ void p2_phase(LAS unsigned char* lds, int G, int tid, int wave, int lane) {
    for (int i = tid; i < 16 * 320; i += 512) { const int h = i / 320, j = i % 320; ((LAS float*)(lds + AT_TAB))[i] = A_IN(8)[h * 257 + (j > 256 ? 256 : j)] * LOG2E; }
    for (int u = blockIdx.x; u < 256 + 16; u += G) {
        __syncthreads();
        if (u < 256) {
            const int b = u >> 4, g = u & 15;
            lru_load_consts(lds, g, tid);
            __syncthreads();
            for (int tile = wave; tile < 128; tile += 8) lru_tile<false>(lds, lane, g, (size_t)b * SEQ, tile, b);
        } else {
            const int g = u - 256;
            lru_load_consts(lds, g, tid);
            __syncthreads();
            lru_tile<true>(lds, lane, g, (size_t)NTP + wave * 16, 0, wave);
        }
    }
    if (tid == 0) *(volatile LAS int*)(lds + P2_Q) = 0;
    __syncthreads();
    const int NGW = G * 8;
    int nS = 0; for (int t = blockIdx.x; t < 512; t += G) ++nS;
    for (;;) {
        int j = 0;
        if (lane == 0) j = __hip_atomic_fetch_add((LAS int*)(lds + P2_Q), 1, __ATOMIC_RELAXED, __HIP_MEMORY_SCOPE_WORKGROUP);
        j = __builtin_amdgcn_readfirstlane(j);
        if (j < nS) { attn_sample_task(lds, wave, lane, blockIdx.x + G * j); continue; }
        j -= nS;
        const int u = blockIdx.x * 8 + (j & 7) + NGW * (j >> 3);
        if (u >= NB * 64 * 16) break;
        const int c = u & 63, h = (u >> 6) & 15, b = u >> 10;
        attn_unit(lds, lane, b, c, h);
    }
}

__device__ __forceinline__ void p4b_phase(int G, int wave, int lane) {
    const int gw = blockIdx.x * 8 + wave, NGW = G * 8;
    for (int n = gw; n < 2048; n += NGW) {
        const bf16_t* wr_ = (const bf16_t*)(A_WS + WS_WS) + (size_t)n * DM + lane * 16;
        const u32x4 a = *(const u32x4*)wr_, b = *(const u32x4*)(wr_ + 8);
        float f[16]; f[0] = bflo(a.x); f[1] = bfhi(a.x); f[2] = bflo(a.y); f[3] = bfhi(a.y); f[4] = bflo(a.z); f[5] = bfhi(a.z); f[6] = bflo(a.w); f[7] = bfhi(a.w);
        f[8] = bflo(b.x); f[9] = bfhi(b.x); f[10] = bflo(b.y); f[11] = bfhi(b.y); f[12] = bflo(b.z); f[13] = bfhi(b.z); f[14] = bflo(b.w); f[15] = bfhi(b.w);
        float mx = 0.f;
#pragma unroll
        for (int j = 0; j < 16; ++j) mx = fmaxf(mx, fabsf(f[j]));
#pragma unroll
        for (int o = 1; o < 64; o <<= 1) mx = fmaxf(mx, __shfl_xor(mx, o));
        const float step = fmaxf(mx, 1e-30f) * (1.0f / 127.0f), qi = 1.0f / step;
        u32x4 w;
#pragma unroll
        for (int q = 0; q < 4; ++q) w[q] = ((unsigned)(int)rintf(f[4 * q] * qi) & 0xffu) | (((unsigned)(int)rintf(f[4 * q + 1] * qi) & 0xffu) << 8) | (((unsigned)(int)rintf(f[4 * q + 2] * qi) & 0xffu) << 16) | (((unsigned)(int)rintf(f[4 * q + 3] * qi) & 0xffu) << 24);
        *(u32x4*)(A_WS + WS_WSQ + (size_t)n * DM + lane * 16) = w;
        if (lane == 0) ((float*)(A_WS + WS_SW))[n] = step;
    }
    const float* gm = A_IN(19); bf16_t* XT = (bf16_t*)(A_WS + WS_Q); unsigned char* XQ = A_WS + WS_XQ; float* SX = (float*)(A_WS + WS_SX);
    const bf16_t* DL = (const bf16_t*)(A_WS + WS_DELTA);
    f32x4 v[4], vn[4];
    if (gw < NTOK) { row_ld(xrow_ptr(gw), v, lane); row_add_bf16(DL + (size_t)gw * DM, v, lane); }
    for (int m = gw; m < NTOK; m += NGW) {
        const int mn = m + NGW;
        if (mn < NTOK) { row_ld(xrow_ptr(mn), vn, lane); row_add_bf16(DL + (size_t)mn * DM, vn, lane); }
        bf16_t* orow = XT + (size_t)m * DM;
        const float inv = 1.0f / sqrtf(wave_sum(row_ss(v)) * (1.0f / DM) + EPS);
        float mx = 0.f;
#pragma unroll
        for (int j = 0; j < 4; ++j) { const f32x4 gg = *(const f32x4*)(gm + j * 256 + lane * 4); v[j] = v[j] * inv * gg;
            if (m >= NTP) { u32x2 w; w.x = cvtpk(v[j][0], v[j][1]); w.y = cvtpk(v[j][2], v[j][3]); *(u32x2*)(orow + j * 256 + lane * 4) = w; }
            mx = fmaxf(mx, fmaxf(fmaxf(fabsf(v[j][0]), fabsf(v[j][1])), fmaxf(fabsf(v[j][2]), fabsf(v[j][3])))); }
#pragma unroll
        for (int o = 1; o < 64; o <<= 1) mx = fmaxf(mx, __shfl_xor(mx, o));
        const float step = fmaxf(mx, 1e-30f) * (1.0f / 127.0f), qi = 1.0f / step;
#pragma unroll
        for (int j = 0; j < 4; ++j) {
            const unsigned b0 = (unsigned)(int)rintf(v[j][0] * qi) & 0xffu, b1 = (unsigned)(int)rintf(v[j][1] * qi) & 0xffu, b2 = (unsigned)(int)rintf(v[j][2] * qi) & 0xffu, b3 = (unsigned)(int)rintf(v[j][3] * qi) & 0xffu;
            *(unsigned*)(XQ + (size_t)m * DM + j * 256 + lane * 4) = b0 | (b1 << 8) | (b2 << 16) | (b3 << 24); }
        if (lane == 0) SX[m] = step;
#pragma unroll
        for (int j = 0; j < 4; ++j) v[j] = vn[j];
    }
}

__device__ __forceinline__ int f2key(float f) { const int b = __float_as_int(f); return b ^ ((b >> 31) & 0x7fffffff); }
__device__ __forceinline__ float key2f(int k) { return __int_as_float(k ^ ((k >> 31) & 0x7fffffff)); }
#define CE_DESC(x, y) do { const int hi_ = max(x, y); y = min(x, y); x = hi_; } while (0)
#define CE_ASC(x, y)  do { const int lo_ = min(x, y); y = max(x, y); x = lo_; } while (0)
__device__ __forceinline__ void bitonic_sort16_desc(int (&a)[16]) {
#pragma unroll
    for (int k = 2; k <= 16; k <<= 1)
#pragma unroll
        for (int j = k >> 1; j > 0; j >>= 1)
#pragma unroll
            for (int i = 0; i < 16; ++i) { const int l = i ^ j; if (l > i) { if ((i & k) == 0) CE_DESC(a[i], a[l]); else CE_ASC(a[i], a[l]); } }
}
__device__ __forceinline__ void bitonic_merge16_desc(int (&a)[16]) {
#pragma unroll
    for (int j = 8; j > 0; j >>= 1)
#pragma unroll
        for (int i = 0; i < 16; ++i) { const int l = i ^ j; if (l > i) CE_DESC(a[i], a[l]); }
}
__device__ __forceinline__ void top16_merge(int (&T)[16], const int (&S)[16]) {
#pragma unroll
    for (int i = 0; i < 16; ++i) T[i] = max(T[i], S[15 - i]);
    bitonic_merge16_desc(T);
}
#define INS16(L, x) do { int x_ = (x); _Pragma("unroll") for (int j_ = 0; j_ < 16; ++j_) { const int hi_ = max(L[j_], x_); x_ = min(L[j_], x_); L[j_] = hi_; } } while (0)

constexpr size_t WS_PART = WS_XN;
constexpr int CT_U = 64, CT_V = 64 + 8 * 64;
constexpr int P6_TOKB = 128, P6_NITEM = NTOK / P6_TOKB, P6_TPW = P6_TOKB / 8;
constexpr size_t WS_CQ = WS_XR, WS_CS = WS_XR + 16 * MiB;
constexpr int P6_IDX = 0;
constexpr int P6_E = 0, P6_C = 8192, P6_ITEM = 49152, P6_E8 = 0, P6_C8 = 32768;

__device__ __forceinline__ void p6a_phase(LAS unsigned char* lds, int G, int wave, int lane) {
    const int gw = blockIdx.x * 8 + wave, NGW = G * 8;
    const bf16_t* SC = (const bf16_t*)(A_WS + WS_XN);
    unsigned short* SELE = (unsigned short*)(A_WS + WS_SELE); float* SELG = (float*)(A_WS + WS_SELG);
    LAS int* idxb = (LAS int*)(lds + P6_IDX + wave * 4096);
    const int tl = lane >> 4, hh = (lane >> 1) & 7, half = lane & 1;
    for (int grp = gw; grp < NTOK / 4; grp += NGW) {
        const int tok = grp * 4 + tl;
        const bf16_t* sp = SC + (size_t)tok * 2048 + (lane & 15);
        int L[16];
#pragma unroll
        for (int j = 0; j < 16; ++j) L[j] = (int)0x80000000;
        {
            float sa[16], sb_[16];
#pragma unroll
            for (int e = 0; e < 16; ++e) sa[e] = bflo((unsigned)sp[16 * e]);
#pragma unroll
            for (int c0 = 0; c0 < 128; c0 += 32) {
#pragma unroll
                for (int e = 0; e < 16; ++e) sb_[e] = bflo((unsigned)sp[16 * (c0 + 16 + e)]);
                { int S[16];
#pragma unroll
                  for (int e = 0; e < 16; ++e) S[e] = (f2key(sa[e]) & ~127) | (c0 + e);
                  bitonic_sort16_desc(S);
                  if (c0 == 0) {
#pragma unroll
                      for (int e = 0; e < 16; ++e) L[e] = S[e]; } else top16_merge(L, S); }
                if (c0 + 32 < 128) {
#pragma unroll
                    for (int e = 0; e < 16; ++e) sa[e] = bflo((unsigned)sp[16 * (c0 + 32 + e)]); }
                { int S[16];
#pragma unroll
                  for (int e = 0; e < 16; ++e) S[e] = (f2key(sb_[e]) & ~127) | (c0 + 16 + e);
                  bitonic_sort16_desc(S);
                  top16_merge(L, S); }
            }
        }
#pragma unroll
        for (int j = 0; j < 16; ++j) idxb[lane * 16 + j] = L[j] & 127;
        float va[16], vb[16];
#pragma unroll
        for (int j = 0; j < 16; ++j) { const int own = L[j] & ~127, oth = __shfl_xor(own, 1); va[j] = key2f(half ? oth : own); vb[j] = key2f(half ? own : oth); }
        int C[16];
#pragma unroll
        for (int j = 0; j < 16; ++j) C[j] = (int)0x80000000;
        {   int S[16];
            S[0] = (f2key(va[0] + vb[0]) & ~255) | 0;
            S[1] = (f2key(va[0] + vb[1]) & ~255) | 1;
            S[2] = (f2key(va[0] + vb[2]) & ~255) | 2;
            S[3] = (f2key(va[0] + vb[3]) & ~255) | 3;
            S[4] = (f2key(va[0] + vb[4]) & ~255) | 4;
            S[5] = (f2key(va[0] + vb[5]) & ~255) | 5;
            S[6] = (f2key(va[0] + vb[6]) & ~255) | 6;
            S[7] = (f2key(va[0] + vb[7]) & ~255) | 7;
            S[8] = (f2key(va[0] + vb[8]) & ~255) | 8;
            S[9] = (f2key(va[0] + vb[9]) & ~255) | 9;
            S[10] = (f2key(va[0] + vb[10]) & ~255) | 10;
            S[11] = (f2key(va[0] + vb[11]) & ~255) | 11;
            S[12] = (f2key(va[0] + vb[12]) & ~255) | 12;
            S[13] = (f2key(va[0] + vb[13]) & ~255) | 13;
            S[14] = (f2key(va[0] + vb[14]) & ~255) | 14;
            S[15] = (f2key(va[0] + vb[15]) & ~255) | 15;
            bitonic_sort16_desc(S);
#pragma unroll
            for (int q = 0; q < 16; ++q) C[q] = S[q]; }
        {   int S[16];
            S[0] = (f2key(va[1] + vb[0]) & ~255) | 16;
            S[1] = (f2key(va[1] + vb[1]) & ~255) | 17;
            S[2] = (f2key(va[1] + vb[2]) & ~255) | 18;
            S[3] = (f2key(va[1] + vb[3]) & ~255) | 19;
            S[4] = (f2key(va[1] + vb[4]) & ~255) | 20;
            S[5] = (f2key(va[1] + vb[5]) & ~255) | 21;
            S[6] = (f2key(va[1] + vb[6]) & ~255) | 22;
            S[7] = (f2key(va[1] + vb[7]) & ~255) | 23;
            S[8] = (f2key(va[2] + vb[0]) & ~255) | 32;
            S[9] = (f2key(va[2] + vb[1]) & ~255) | 33;
            S[10] = (f2key(va[2] + vb[2]) & ~255) | 34;
            S[11] = (f2key(va[2] + vb[3]) & ~255) | 35;
            S[12] = (f2key(va[2] + vb[4]) & ~255) | 36;
            S[13] = (f2key(va[3] + vb[0]) & ~255) | 48;
            S[14] = (f2key(va[3] + vb[1]) & ~255) | 49;
            S[15] = (f2key(va[3] + vb[2]) & ~255) | 50;
            bitonic_sort16_desc(S);
            top16_merge(C, S); }
        {   int S[16];
            S[0] = (f2key(va[3] + vb[3]) & ~255) | 51;
            S[1] = (f2key(va[4] + vb[0]) & ~255) | 64;
            S[2] = (f2key(va[4] + vb[1]) & ~255) | 65;
            S[3] = (f2key(va[4] + vb[2]) & ~255) | 66;
            S[4] = (f2key(va[5] + vb[0]) & ~255) | 80;
            S[5] = (f2key(va[5] + vb[1]) & ~255) | 81;
            S[6] = (f2key(va[6] + vb[0]) & ~255) | 96;
            S[7] = (f2key(va[6] + vb[1]) & ~255) | 97;
            S[8] = (f2key(va[7] + vb[0]) & ~255) | 112;
            S[9] = (f2key(va[7] + vb[1]) & ~255) | 113;
            S[10] = (f2key(va[8] + vb[0]) & ~255) | 128;
            S[11] = (f2key(va[9] + vb[0]) & ~255) | 144;
            S[12] = (f2key(va[10] + vb[0]) & ~255) | 160;
            S[13] = (f2key(va[11] + vb[0]) & ~255) | 176;
            S[14] = (f2key(va[12] + vb[0]) & ~255) | 192;
            S[15] = (f2key(va[13] + vb[0]) & ~255) | 208;
            bitonic_sort16_desc(S);
            top16_merge(C, S); }
        {   int S[16];
            S[0] = (f2key(va[14] + vb[0]) & ~255) | 224;
            S[1] = (f2key(va[15] + vb[0]) & ~255) | 240;
            S[2] = (int)0x80000000;
            S[3] = (int)0x80000000;
            S[4] = (int)0x80000000;
            S[5] = (int)0x80000000;
            S[6] = (int)0x80000000;
            S[7] = (int)0x80000000;
            S[8] = (int)0x80000000;
            S[9] = (int)0x80000000;
            S[10] = (int)0x80000000;
            S[11] = (int)0x80000000;
            S[12] = (int)0x80000000;
            S[13] = (int)0x80000000;
            S[14] = (int)0x80000000;
            S[15] = (int)0x80000000;
            bitonic_sort16_desc(S);
            top16_merge(C, S); }
        const float mx = key2f(C[0] & ~255);
        float ev[16], sum = 0.f;
#pragma unroll
        for (int j = 0; j < 16; ++j) { ev[j] = __expf(key2f(C[j] & ~255) - mx); sum += ev[j]; }
        const float inv = 1.0f / sum;
        asm volatile("s_waitcnt lgkmcnt(0)" ::: "memory");
        int eo[8]; float go[8];
#pragma unroll
        for (int s = 0; s < 8; ++s) {
            int c_lo = C[s], c_hi = C[8 + s]; float e_lo = ev[s], e_hi = ev[8 + s];
            asm volatile("" : "+v"(c_lo), "+v"(c_hi), "+v"(e_lo), "+v"(e_hi));
            const int cc = half ? c_hi : c_lo; go[s] = (half ? e_hi : e_lo) * inv;
            const int ij = cc & 255, i1 = idxb[(lane & ~1) * 16 + (ij >> 4)], i2 = idxb[(lane | 1) * 16 + (ij & 15)];
            eo[s] = i1 * 128 + i2;
        }
        unsigned short* ep = SELE + (size_t)tok * 128 + hh * 16 + half * 8; float* gp = SELG + (size_t)tok * 128 + hh * 16 + half * 8;
        *(u32x4*)ep = (u32x4){(unsigned)eo[0] | ((unsigned)eo[1] << 16), (unsigned)eo[2] | ((unsigned)eo[3] << 16), (unsigned)eo[4] | ((unsigned)eo[5] << 16), (unsigned)eo[6] | ((unsigned)eo[7] << 16)};
        *(f32x4*)gp = (f32x4){go[0], go[1], go[2], go[3]}; *(f32x4*)(gp + 4) = (f32x4){go[4], go[5], go[6], go[7]};
        asm volatile("s_waitcnt lgkmcnt(0)" ::: "memory");
    }
}

__device__ __forceinline__ float dot2bf(unsigned a, unsigned b, float c) { return __builtin_amdgcn_fdot2_f32_bf16(__builtin_bit_cast(bf16x2_t, a), __builtin_bit_cast(bf16x2_t, b), c, false); }
__device__ __forceinline__ unsigned xcc_id() { return (unsigned)__builtin_amdgcn_s_getreg((3 << 11) | 20) & 0xFu; }
__device__ __forceinline__ float dpp_sum16(float v) {
    v += __builtin_bit_cast(float, __builtin_amdgcn_update_dpp(0, __builtin_bit_cast(int, v), 0xB1, 0xF, 0xF, true));
    v += __builtin_bit_cast(float, __builtin_amdgcn_update_dpp(0, __builtin_bit_cast(int, v), 0x4E, 0xF, 0xF, true));
    v += __builtin_bit_cast(float, __builtin_amdgcn_update_dpp(0, __builtin_bit_cast(int, v), 0x141, 0xF, 0xF, true));
    v += __builtin_bit_cast(float, __builtin_amdgcn_update_dpp(0, __builtin_bit_cast(int, v), 0x140, 0xF, 0xF, true));
    return v;
}
__device__ __forceinline__ bool p6_claim(LAS unsigned char* lds, unsigned* cnt, int tid, int& ring, int home, int& slice, int& item) {
    for (;;) {
        if (ring >= 8) return false;
        slice = (home + ring) & 7;
        __syncthreads();
        if (tid == 0) *(volatile LAS int*)(lds + P6_ITEM) = (int)__hip_atomic_fetch_add(cnt + 64 * slice, 1u, __ATOMIC_RELAXED, __HIP_MEMORY_SCOPE_AGENT);
        __syncthreads();
        item = *(volatile LAS int*)(lds + P6_ITEM);
        if (item < P6_NITEM) return true;
        ++ring;
    }
}

__device__ __forceinline__ float ub0(unsigned w) { return (float)(w & 0xffu); }
__device__ __forceinline__ float ub1(unsigned w) { return (float)((w >> 8) & 0xffu); }
__device__ __forceinline__ float ub2(unsigned w) { return (float)((w >> 16) & 0xffu); }
__device__ __forceinline__ float ub3(unsigned w) { return (float)(w >> 24); }
__device__ __forceinline__ float dpp_sum8(float v) {
    v += __builtin_bit_cast(float, __builtin_amdgcn_update_dpp(0, __builtin_bit_cast(int, v), 0xB1, 0xF, 0xF, true));
    v += __builtin_bit_cast(float, __builtin_amdgcn_update_dpp(0, __builtin_bit_cast(int, v), 0x4E, 0xF, 0xF, true));
    v += __builtin_bit_cast(float, __builtin_amdgcn_update_dpp(0, __builtin_bit_cast(int, v), 0x141, 0xF, 0xF, true));
    return v;
}
__device__ __forceinline__ int dpp_isum8(int v) {
    v += __builtin_amdgcn_update_dpp(0, v, 0xB1, 0xF, 0xF, true);
    v += __builtin_amdgcn_update_dpp(0, v, 0x4E, 0xF, 0xF, true);
    v += __builtin_amdgcn_update_dpp(0, v, 0x141, 0xF, 0xF, true);
    return v;
}
__device__ __forceinline__ void p6b_phase(LAS unsigned char* lds, int tid, int wave, int lane) {
    const unsigned char* XQ = A_WS + WS_XQ; const unsigned char* UB = A_WS + WS_UB; const float* SX = (const float*)(A_WS + WS_SX);
    const unsigned short* SELE = (const unsigned short*)(A_WS + WS_SELE); bf16_t* PART = (bf16_t*)(A_WS + WS_PART);
    unsigned* cnt = (unsigned*)(A_WS + WS_CTL) + CT_U;
    const int i8 = lane & 7, grp = lane >> 3, home = (int)(xcc_id() & 7u);
    LAS int* eb = (LAS int*)(lds + P6_E8 + wave * 4096);
    int ring = 0, slice, item;
    while (p6_claim(lds, cnt, tid, ring, home, slice, item)) {
        const int tok0 = item * P6_TOKB + wave * P6_TPW;
        u32x4 le[2], xqn; float sxn;
        { const int tk = tok0 + grp;
#pragma unroll
          for (int q = 0; q < 2; ++q) le[q] = *(const u32x4*)(SELE + (size_t)tk * 128 + i8 * 16 + 8 * q);
          xqn = *(const u32x4*)(XQ + (size_t)tk * DM + slice * 128 + i8 * 16); sxn = SX[tk]; }
#pragma unroll 1
        for (int tb = 0; tb < P6_TPW; tb += 8) {
            const int tok = tok0 + tb + grp;
#pragma unroll
            for (int q = 0; q < 2; ++q) *(LAS u32x4*)(eb + grp * 64 + i8 * 8 + 4 * q) = le[q];
            const int x0 = (int)xqn.x, x1 = (int)xqn.y, x2 = (int)xqn.z, x3 = (int)xqn.w; const float sx = sxn;
            if (tb + 8 < P6_TPW) { const int tk = tok + 8;
#pragma unroll
                for (int q = 0; q < 2; ++q) le[q] = *(const u32x4*)(SELE + (size_t)tk * 128 + i8 * 16 + 8 * q);
                xqn = *(const u32x4*)(XQ + (size_t)tk * DM + slice * 128 + i8 * 16); sxn = SX[tk]; }
            const unsigned char* ub = UB + slice * 128 + i8 * 16;
            asm volatile("s_waitcnt lgkmcnt(0)" ::: "memory");
            int res[16];
#pragma unroll
            for (int j = 0; j < 16; ++j) res[j] = 0;
#pragma unroll
            for (int s16 = 0; s16 < 128; s16 += 16) {
                u32x4 uv[16]; u32x4 e4[2];
#pragma unroll
                for (int a4 = 0; a4 < 2; ++a4) e4[a4] = *(const LAS u32x4*)(eb + grp * 64 + (s16 >> 1) + 4 * a4);
#pragma unroll
                for (int a4 = 0; a4 < 2; ++a4)
#pragma unroll
                    for (int j = 0; j < 4; ++j) { const unsigned w = e4[a4][j];
                        uv[8 * a4 + 2 * j] = *(const u32x4*)(ub + (size_t)(w & 0xffffu) * DM); uv[8 * a4 + 2 * j + 1] = *(const u32x4*)(ub + (size_t)(w >> 16) * DM); }
#pragma unroll
                for (int q = 0; q < 16; ++q) {
                    const int a0 = (int)uv[q].x, a1 = (int)uv[q].y, a2 = (int)uv[q].z, a3 = (int)uv[q].w;
                    int d = __builtin_amdgcn_sdot4(a0, x0, 0, false); d = __builtin_amdgcn_sdot4(a1, x1, d, false); d = __builtin_amdgcn_sdot4(a2, x2, d, false); d = __builtin_amdgcn_sdot4(a3, x3, d, false);
                    d = dpp_isum8(d);
                    const int sidx = s16 + q;
                    res[sidx >> 3] = (i8 == (sidx & 7)) ? d : res[sidx >> 3];
                }
            }
            bf16_t* pp = PART + ((size_t)slice * NTOK + tok) * 128 + 16 * i8;
#pragma unroll
            for (int q = 0; q < 2; ++q) { u32x4 w;
                w.x = cvtpk((float)res[8 * q] * sx, (float)res[8 * q + 1] * sx); w.y = cvtpk((float)res[8 * q + 2] * sx, (float)res[8 * q + 3] * sx);
                w.z = cvtpk((float)res[8 * q + 4] * sx, (float)res[8 * q + 5] * sx); w.w = cvtpk((float)res[8 * q + 6] * sx, (float)res[8 * q + 7] * sx);
                *(u32x4*)(pp + 8 * q) = w; }
            asm volatile("s_waitcnt lgkmcnt(0)" ::: "memory");
        }
    }
}

__device__ __forceinline__ void p6m_phase(int G, int wave, int lane) {
    const int gw = blockIdx.x * 8 + wave, NGW = G * 8;
    const float* SU = (const float*)(A_WS + WS_SU); const float* SV = (const float*)(A_WS + WS_SV);
    const unsigned short* SELE = (const unsigned short*)(A_WS + WS_SELE); const float* SELG = (const float*)(A_WS + WS_SELG); const bf16_t* PART = (const bf16_t*)(A_WS + WS_PART);
    unsigned char* CQ = A_WS + WS_CQ; float* CS = (float*)(A_WS + WS_CS);
    const int k0 = 8 * ((2 * lane) & 15) + (lane >> 3), k1 = k0 + 8;
    for (int tok = gw; tok < NTOK; tok += NGW) {
        float a0 = 0.f, a1 = 0.f;
#pragma unroll
        for (int j = 0; j < 8; ++j) { const unsigned w = ((const unsigned*)(PART + ((size_t)j * NTOK + tok) * 128))[lane]; a0 += bflo(w); a1 += bfhi(w); }
        const int e0 = SELE[(size_t)tok * 128 + k0], e1 = SELE[(size_t)tok * 128 + k1];
        const float c0 = SELG[(size_t)tok * 128 + k0] * gelu_tanh(a0 * SU[e0]) * SV[e0], c1 = SELG[(size_t)tok * 128 + k1] * gelu_tanh(a1 * SU[e1]) * SV[e1];
        float mx = fmaxf(fabsf(c0), fabsf(c1));
#pragma unroll
        for (int o = 1; o < 64; o <<= 1) mx = fmaxf(mx, __shfl_xor(mx, o));
        const float cstep = fmaxf(mx, 1e-30f) * (1.0f / 127.0f), cinv = 1.0f / cstep;
        CQ[(size_t)tok * 128 + k0] = (unsigned char)((int)rintf(c0 * cinv) & 0xff); CQ[(size_t)tok * 128 + k1] = (unsigned char)((int)rintf(c1 * cinv) & 0xff);
        if (lane == 0) CS[tok] = cstep;
    }
}

__device__ __forceinline__ void p6c_phase(LAS unsigned char* lds, int tid, int wave, int lane) {
    const unsigned char* VB = A_WS + WS_VB; const unsigned short* SELE = (const unsigned short*)(A_WS + WS_SELE);
    const unsigned char* CQ = A_WS + WS_CQ; const float* CS = (const float*)(A_WS + WS_CS);
    unsigned* cnt = (unsigned*)(A_WS + WS_CTL) + CT_V;
    const int i8 = lane & 7, grp = lane >> 3, home = (int)(xcc_id() & 7u);
    LAS int* eb = (LAS int*)(lds + P6_E8 + wave * 4096);
    LAS int* cbb = (LAS int*)(lds + P6_C8 + wave * 1024);
    int ring = 0, slice, item;
    while (p6_claim(lds, cnt, tid, ring, home, slice, item)) {
        const int tok0 = item * P6_TOKB + wave * P6_TPW;
        u32x4 le[2], lc; float cstep;
        { const int tk = tok0 + grp;
#pragma unroll
          for (int q = 0; q < 2; ++q) le[q] = *(const u32x4*)(SELE + (size_t)tk * 128 + i8 * 16 + 8 * q);
          lc = *(const u32x4*)(CQ + (size_t)tk * 128 + i8 * 16); cstep = CS[tk]; }
#pragma unroll 1
        for (int tb = 0; tb < P6_TPW; tb += 8) {
            const int tok = tok0 + tb + grp;
#pragma unroll
            for (int q = 0; q < 2; ++q) *(LAS u32x4*)(eb + grp * 64 + i8 * 8 + 4 * q) = le[q];
            *(LAS u32x4*)(cbb + grp * 32 + i8 * 4) = lc;
            const float cs = cstep;
            if (tb + 8 < P6_TPW) { const int tk = tok + 8;
#pragma unroll
                for (int q = 0; q < 2; ++q) le[q] = *(const u32x4*)(SELE + (size_t)tk * 128 + i8 * 16 + 8 * q);
                lc = *(const u32x4*)(CQ + (size_t)tk * 128 + i8 * 16); cstep = CS[tk]; }
            const unsigned char* vb = VB + slice * 128 + i8 * 16;
            asm volatile("s_waitcnt lgkmcnt(0)" ::: "memory");
            int acc[16];
#pragma unroll
            for (int r = 0; r < 16; ++r) acc[r] = 0;
#pragma unroll 1
            for (int s16 = 0; s16 < 128; s16 += 16) {
                u32x4 vv[16]; u32x4 e4[2];
#pragma unroll
                for (int a4 = 0; a4 < 2; ++a4) e4[a4] = *(const LAS u32x4*)(eb + grp * 64 + (s16 >> 1) + 4 * a4);
                const u32x4 cq4 = *(const LAS u32x4*)(cbb + grp * 32 + (s16 >> 2));
#pragma unroll
                for (int a4 = 0; a4 < 2; ++a4)
#pragma unroll
                    for (int j = 0; j < 4; ++j) { const unsigned w = e4[a4][j];
                        vv[8 * a4 + 2 * j] = *(const u32x4*)(vb + (size_t)(w & 0xffffu) * DM); vv[8 * a4 + 2 * j + 1] = *(const u32x4*)(vb + (size_t)(w >> 16) * DM); }
#pragma unroll
                for (int a4 = 0; a4 < 4; ++a4) {
                    const int cq = (int)cq4[a4];
#pragma unroll
                    for (int d = 0; d < 4; ++d) {
                        const unsigned ra = vv[4 * a4][d], rb = vv[4 * a4 + 1][d], rc = vv[4 * a4 + 2][d], rd = vv[4 * a4 + 3][d];
                        const unsigned lo = __builtin_amdgcn_perm(rb, ra, 0x05010400u), hi = __builtin_amdgcn_perm(rb, ra, 0x07030602u);
                        const unsigned lo2 = __builtin_amdgcn_perm(rd, rc, 0x05010400u), hi2 = __builtin_amdgcn_perm(rd, rc, 0x07030602u);
                        const unsigned t0 = __builtin_amdgcn_perm(lo2, lo, 0x05040100u), t1 = __builtin_amdgcn_perm(lo2, lo, 0x07060302u);
                        const unsigned t2 = __builtin_amdgcn_perm(hi2, hi, 0x05040100u), t3 = __builtin_amdgcn_perm(hi2, hi, 0x07060302u);
                        acc[4 * d + 0] = __builtin_amdgcn_sdot4((int)t0, cq, acc[4 * d + 0], false); acc[4 * d + 1] = __builtin_amdgcn_sdot4((int)t1, cq, acc[4 * d + 1], false);
                        acc[4 * d + 2] = __builtin_amdgcn_sdot4((int)t2, cq, acc[4 * d + 2], false); acc[4 * d + 3] = __builtin_amdgcn_sdot4((int)t3, cq, acc[4 * d + 3], false);
                    }
                }
            }
            bf16_t* pr = (bf16_t*)(A_WS + WS_PEER) + (size_t)tok * DM + slice * 128 + i8 * 16;
            u32x4 w0, w1;
            w0.x = cvtpk((float)acc[0] * cs, (float)acc[1] * cs); w0.y = cvtpk((float)acc[2] * cs, (float)acc[3] * cs); w0.z = cvtpk((float)acc[4] * cs, (float)acc[5] * cs); w0.w = cvtpk((float)acc[6] * cs, (float)acc[7] * cs);
            w1.x = cvtpk((float)acc[8] * cs, (float)acc[9] * cs); w1.y = cvtpk((float)acc[10] * cs, (float)acc[11] * cs); w1.z = cvtpk((float)acc[12] * cs, (float)acc[13] * cs); w1.w = cvtpk((float)acc[14] * cs, (float)acc[15] * cs);
            *(u32x4*)pr = w0; *(u32x4*)(pr + 8) = w1;
            asm volatile("s_waitcnt lgkmcnt(0)" ::: "memory");
        }
    }
}

__device__ __forceinline__ void p6d_phase(int G, int wave, int lane) {
    const int gw = blockIdx.x * 8 + wave, NGW = G * 8;
    const float* gf = A_IN(25);
    const bf16_t* DL = (const bf16_t*)(A_WS + WS_DELTA); const bf16_t* PR = (const bf16_t*)(A_WS + WS_PEER);
    f32x4 v[4], vn[4];
    if (gw < NTOK) { row_ld(xrow_ptr(gw), v, lane); row_add_bf16(DL + (size_t)gw * DM, v, lane); row_add_bf16(PR + (size_t)gw * DM, v, lane); }
    for (int m = gw; m < NTOK; m += NGW) {
        const int mn = m + NGW;
        if (mn < NTOK) { row_ld(xrow_ptr(mn), vn, lane); row_add_bf16(DL + (size_t)mn * DM, vn, lane); row_add_bf16(PR + (size_t)mn * DM, vn, lane); }
        float* yr = yrow_ptr(m);
        const float inv = 1.0f / sqrtf(wave_sum(row_ss(v)) * (1.0f / DM) + EPS);
#pragma unroll
        for (int j = 0; j < 4; ++j) { const f32x4 gg = *(const f32x4*)(gf + j * 256 + lane * 4); *(f32x4*)(yr + j * 256 + lane * 4) = v[j] * inv * gg; }
#pragma unroll
        for (int j = 0; j < 4; ++j) v[j] = vn[j];
    }
}

#define XB_TMO      128
#define XB_XCNT(j)  (256  + 64 * (j))
#define XB_XSUB(j)  (1280 + 64 * (j))
#define XB_XGEN(j)  (2304 + 64 * (j))
#define XB_TOP      3328
#define XB_TOPGEN   3392
#define XB_SPIN_CAP (1u << 22)
constexpr int CW_BAR = 2048;
constexpr int LDS_MISC = 131072 + 64;
__device__ __forceinline__ unsigned xb_ld(unsigned* p)              { return __hip_atomic_load(p, __ATOMIC_RELAXED, __HIP_MEMORY_SCOPE_AGENT); }
__device__ __forceinline__ unsigned xb_add(unsigned* p, unsigned v) { return __hip_atomic_fetch_add(p, v, __ATOMIC_RELAXED, __HIP_MEMORY_SCOPE_AGENT); }
#define XB_SPIN(cond, bar) do { unsigned _sp = 0; while (cond) { __builtin_amdgcn_s_sleep(1); \
    if ((++_sp & 255u) == 0u) { if (xb_ld(&(bar)[XB_TMO])) break; if (_sp > XB_SPIN_CAP) { atomicAdd(&(bar)[XB_TMO], 1u); break; } } } } while (0)
struct XcdBarrier { unsigned* bar; unsigned x; volatile LAS unsigned* st; };
__device__ __forceinline__ XcdBarrier xcd_barrier_post(unsigned* bar, volatile LAS unsigned* st) {
    XcdBarrier b; b.bar = bar; b.x = (unsigned)__builtin_amdgcn_s_getreg((3 << 11) | 20) & 0xFu; b.st = st;
    if (threadIdx.x == 0) (void)xb_add(&bar[XB_XCNT(b.x)], 1u);
    return b;
}
__device__ __forceinline__ void xcd_barrier_complete(unsigned* bar, unsigned x, unsigned& nloc, unsigned& nx) {
    const unsigned G = gridDim.x * gridDim.y * gridDim.z;
    unsigned sum, cnt, mine, sp = 0u;
    for (;;) {
        sum = 0u; cnt = 0u; mine = 0u;
#pragma unroll
        for (unsigned j = 0; j < 16; ++j) { const unsigned c = xb_ld(&bar[XB_XCNT(j)]); sum += c; cnt += (c > 0u) ? 1u : 0u; mine = (j == x) ? c : mine; }
        if (sum == G) break;
        __builtin_amdgcn_s_sleep(1);
        if ((++sp & 255u) == 0u) { if (xb_ld(&bar[XB_TMO])) break; if (sp > XB_SPIN_CAP) { atomicAdd(&bar[XB_TMO], 1u); break; } }
    }
    nloc = mine > 0u ? mine : 1u; nx = cnt > 0u ? cnt : 1u;
}
__device__ __forceinline__ void xcd_barrier(const XcdBarrier& b) {
    asm volatile("s_waitcnt vmcnt(0)" ::: "memory");
    __syncthreads();
    if (threadIdx.x == 0) {
        unsigned* bar = b.bar;
        __builtin_amdgcn_s_waitcnt(0);
        unsigned nloc = b.st[0], nx = b.st[1];
        if (nloc == 0u) { xcd_barrier_complete(bar, b.x, nloc, nx); b.st[0] = nloc; b.st[1] = nx; }
        const unsigned old = xb_add(&bar[XB_XSUB(b.x)], 1u);
        const unsigned gen = old / nloc;
        if (old + 1u == (gen + 1u) * nloc) {
            __builtin_amdgcn_fence(__ATOMIC_RELEASE, "agent");
            asm volatile("s_waitcnt vmcnt(0)" ::: "memory");
            const unsigned og = xb_add(&bar[XB_TOP], 1u);
            const unsigned tg = og / nx;
            if (og + 1u == (tg + 1u) * nx) xb_add(&bar[XB_TOPGEN], 1u);
            else XB_SPIN(xb_ld(&bar[XB_TOPGEN]) == tg, bar);
            __builtin_amdgcn_fence(__ATOMIC_ACQUIRE, "agent");
            xb_add(&bar[XB_XGEN(b.x)], 1u);
            asm volatile("s_waitcnt vmcnt(0)" ::: "memory");
        } else {
            XB_SPIN(xb_ld(&bar[XB_XGEN(b.x)]) == gen, bar);
            __builtin_amdgcn_fence(__ATOMIC_ACQUIRE, "agent");
            asm volatile("s_waitcnt vmcnt(0)" ::: "memory");
        }
    }
    __syncthreads();
}

template <int NACC, class Epi>
__device__ __forceinline__ void small_gemm(LAS unsigned char* lds, const bf16_t* X0, const bf16_t* W0, const bf16_t* X1, const bf16_t* W1, int N, int G, int wave, int lane, const Epi& epi) {
    const int r32 = lane & 31, hi = lane >> 5;
    LAS float* part = (LAS float*)lds;
    for (int task = blockIdx.x; task < 4 * (N / 32); task += G) {
        const int rb = task & 3, cb = task >> 2;
#pragma unroll
        for (int a = 0; a < NACC; ++a) {
            const bf16_t* xp = (a ? X1 : X0) + (size_t)(rb * 32 + r32) * DM + hi * 8 + wave * 128;
            const bf16_t* wp = (a ? W1 : W0) + (size_t)(cb * 32 + r32) * DM + hi * 8 + wave * 128;
            bf16x8 xa[8], wa[8];
#pragma unroll
            for (int q = 0; q < 8; ++q) { xa[q] = *(const bf16x8*)(xp + q * 16); wa[q] = *(const bf16x8*)(wp + q * 16); }
            f32x16 acc = f32x16{};
#pragma unroll
            for (int q = 0; q < 8; ++q) acc = __builtin_amdgcn_mfma_f32_32x32x16_bf16(wa[q], xa[q], acc, 0, 0, 0);
#pragma unroll
            for (int r = 0; r < 16; ++r) part[((a * 8 + wave) * 16 + r) * 64 + lane] = acc[r];
        }
        __syncthreads();
        if (wave < 4) {
            const int g4 = wave, t = rb * 32 + r32, n0 = cb * 32 + 8 * g4 + 4 * hi;
            f32x4 v[NACC];
#pragma unroll
            for (int a = 0; a < NACC; ++a) { v[a] = (f32x4){0.f, 0.f, 0.f, 0.f};
#pragma unroll
                for (int w = 0; w < 8; ++w)
#pragma unroll
                    for (int i = 0; i < 4; ++i) v[a][i] += part[((a * 8 + w) * 16 + 4 * g4 + i) * 64 + lane]; }
            epi(t, n0, v[0], v[NACC - 1]);
        }
        __syncthreads();
    }
}
__device__ __forceinline__ u32x2 pack4(f32x4 v) { u32x2 w; w.x = cvtpk(v[0], v[1]); w.y = cvtpk(v[2], v[3]); return w; }
struct SEpiG1 {
    __device__ __forceinline__ void operator()(int t, int n0, f32x4 v, f32x4) const {
        unsigned char* ws = A_WS; float* out = A_OUT;
        const int ts = n0 >> 10, c = n0 & 1023; const size_t ro = (size_t)(NTP + t) * DM + c;
        if (ts == 0) *(u32x2*)((bf16_t*)(ws + WS_Q) + ro) = pack4(v);
        else if (ts == 1) *(f32x4*)(out + O_KS + (size_t)t * DM + c) = v;
        else if (ts == 2) *(f32x4*)(out + O_VS + (size_t)t * DM + c) = v;
        else if (ts == 3) { *(u32x2*)((bf16_t*)(ws + WS_XR) + ro) = pack4(v);
            if ((t & 15) >= 13) *(f32x4*)(out + O_CS + ((size_t)(t >> 4) * 3 + ((t & 15) - 13)) * DM + c) = v; }
        else if (ts == 4) *(u32x2*)((bf16_t*)(ws + WS_G) + ro) = pack4(v);
        else if (ts == 5) *(u32x2*)((bf16_t*)(ws + WS_SGA) + (size_t)t * DM + c) = pack4(v);
        else *(u32x2*)((bf16_t*)(ws + WS_SGR) + (size_t)t * DM + c) = pack4(v);
    }
};
struct SEpiP3 {
    __device__ __forceinline__ void operator()(int t, int n0, f32x4 va, f32x4 vr) const {
        unsigned char* ws = A_WS;
        const u32x2 ga = *(const u32x2*)((const bf16_t*)(ws + WS_SGA) + (size_t)t * DM + n0), gr = *(const u32x2*)((const bf16_t*)(ws + WS_SGR) + (size_t)t * DM + n0);
        f32x4 m;
        m[0] = sigmoidf_(bflo(ga.x)) * va[0] + sigmoidf_(bflo(gr.x)) * vr[0]; m[1] = sigmoidf_(bfhi(ga.x)) * va[1] + sigmoidf_(bfhi(gr.x)) * vr[1];
        m[2] = sigmoidf_(bflo(ga.y)) * va[2] + sigmoidf_(bflo(gr.y)) * vr[2]; m[3] = sigmoidf_(bfhi(ga.y)) * va[3] + sigmoidf_(bfhi(gr.y)) * vr[3];
        *(u32x2*)((bf16_t*)(ws + WS_XR) + (size_t)(NTP + t) * DM + n0) = pack4(m);
    }
};
struct SEpiBf16 {
    size_t wsoff; int ld;
    __device__ __forceinline__ void operator()(int t, int n0, f32x4 v, f32x4) const { *(u32x2*)((bf16_t*)(A_WS + wsoff) + (size_t)(NTP + t) * ld + n0) = pack4(v); }
};

__global__ void __launch_bounds__(512, 2) hybrid_fwd(Args a) {
    extern __shared__ __attribute__((aligned(16))) unsigned char lds_raw[];
    LAS unsigned char* lds = (LAS unsigned char*)lds_raw;
    const int tid = threadIdx.x, lane = tid & 63, wave = __builtin_amdgcn_readfirstlane(tid >> 6), G = gridDim.x;
    cg::grid_group grid = cg::this_grid();
    unsigned char* ws = A_WS;
    if (tid < 2) ((volatile LAS unsigned*)(lds + LDS_MISC))[tid] = 0u;
    __syncthreads();
    XcdBarrier xbar; xbar.bar = (unsigned*)(ws + WS_CTL) + CW_BAR; xbar.x = 0; xbar.st = nullptr;
    if (KA->use_sync) xbar = xcd_barrier_post((unsigned*)(ws + WS_CTL) + CW_BAR, (volatile LAS unsigned*)(lds + LDS_MISC));
#define IN(k) (KA->ph_lo <= (k) && (k) < KA->ph_hi)
#define SEAM(k) do { if (KA->use_sync && IN(k) && IN((k) + 1)) { if ((k) == 0) grid.sync(); else xcd_barrier(xbar); } } while (0)
    if (IN(0)) { p0_prologue(lds, G, wave, lane); }
    SEAM(0);
    if (IN(1)) {
        pg8::Gemm g{(const bf16_t*)(ws + WS_XN), (const bf16_t*)(ws + WS_WIN), (const bf16_t*)(ws + WS_WIN) + (size_t)2048 * DM, (const bf16_t*)(ws + WS_XN), DM};
        SchedG1 S; S.init(G, blockIdx.x); EpiG1 E;
        pg8::gemm_phase(lds, g, S, E);
        { const bf16_t* xs = (const bf16_t*)(ws + WS_XN) + (size_t)NTP * DM; const bf16_t* w = (const bf16_t*)(ws + WS_WIN); SEpiG1 SE; small_gemm<1>(lds, xs, w, xs, w, INC, G, wave, lane, SE); }
    }
    SEAM(1);
    if (IN(2)) { p2_phase(lds, G, tid, wave, lane); }
    SEAM(2);
    if (IN(3)) {
        pg8::Gemm g{(const bf16_t*)(ws + WS_XN), (const bf16_t*)(ws + WS_WBA), (const bf16_t*)(ws + WS_G), (const bf16_t*)(ws + WS_WBL), DM};
        SchedPair S; S.init(4, G, blockIdx.x); EpiP3 E;
        pg8::gemm_phase(lds, g, S, E);
        { SEpiP3 SE; small_gemm<2>(lds, (const bf16_t*)(ws + WS_XN) + (size_t)NTP * DM, (const bf16_t*)(ws + WS_WBA), (const bf16_t*)(ws + WS_G) + (size_t)NTP * DM, (const bf16_t*)(ws + WS_WBL), DM, G, wave, lane, SE); }
    }
    SEAM(3);
    if (IN(4)) {
        pg8::Gemm g{(const bf16_t*)(ws + WS_XR), (const bf16_t*)(ws + WS_WO), (const bf16_t*)(ws + WS_XR), (const bf16_t*)(ws + WS_WO), DM};
        SchedOne S; S.init(4, G, blockIdx.x); EpiP4 E;
        pg8::gemm_phase(lds, g, S, E);
        { const bf16_t* xs = (const bf16_t*)(ws + WS_XR) + (size_t)NTP * DM; const bf16_t* w = (const bf16_t*)(ws + WS_WO); SEpiBf16 SE{WS_DELTA, DM}; small_gemm<1>(lds, xs, w, xs, w, DM, G, wave, lane, SE); }
    }
    SEAM(4);
    if (IN(5)) { p4b_phase(G, wave, lane); }
    SEAM(5);
    if (IN(6)) {
        pg8::Gemm g{(const bf16_t*)(ws + WS_XQ), (const bf16_t*)(ws + WS_WSQ), (const bf16_t*)(ws + WS_XQ), (const bf16_t*)(ws + WS_WSQ), DM / 2};
        SchedOne S; S.init(8, G, blockIdx.x); EpiP5 E;
        pg8::gemm_phase<EpiP5, SchedOne, true>(lds, g, S, E);
        { const bf16_t* xs = (const bf16_t*)(ws + WS_Q) + (size_t)NTP * DM; const bf16_t* w = (const bf16_t*)(ws + WS_WS); SEpiBf16 SE{WS_XN, 2048}; small_gemm<1>(lds, xs, w, xs, w, 2048, G, wave, lane, SE); }
    }
    SEAM(6);
    if (IN(7)) { p6a_phase(lds, G, wave, lane); }
    SEAM(7);
    if (IN(8)) { p6b_phase(lds, tid, wave, lane); }
    SEAM(8);
    if (IN(9)) { p6m_phase(G, wave, lane); }
    SEAM(9);
    if (IN(10)) { p6c_phase(lds, tid, wave, lane); }
    SEAM(10);
    if (IN(11)) { p6d_phase(G, wave, lane); }
#undef IN
#undef SEAM
}

#ifndef N_LAUNCH_MODE
#define N_LAUNCH_MODE 1
#endif
constexpr int NPH = 12;
extern "C" void kernel_launch(void* const* d_in, const int* in_sizes, int n_in, void* d_out, int out_size, void* d_ws, size_t ws_size, hipStream_t stream) {
    static int grid = 0;
    if (grid == 0) {
        if (n_in != 26 || (size_t)out_size != O_END || ws_size < WS_END) { fprintf(stderr, "kernel_launch: unexpected sizes n_in %d out %d ws %zu (need %zu)\n", n_in, out_size, ws_size, (size_t)WS_END); grid = -1; return; }
        int dev = 0, cus = 0, per_cu = 0;
        (void)hipGetDevice(&dev); (void)hipDeviceGetAttribute(&cus, hipDeviceAttributeMultiprocessorCount, dev);
        (void)hipFuncSetAttribute((const void*)hybrid_fwd, hipFuncAttributeMaxDynamicSharedMemorySize, LDS_BYTES);
        (void)hipOccupancyMaxActiveBlocksPerMultiprocessor(&per_cu, (const void*)hybrid_fwd, 512, LDS_BYTES);
        if (per_cu < 1) { fprintf(stderr, "kernel_launch: occupancy query says %d blocks per CU\n", per_cu); per_cu = 1; }
        grid = cus;
        (void)hipGetLastError();
    }
    if (grid < 0) return;
    (void)hipMemsetAsync((char*)d_ws + WS_CTL, 0, 32768, stream);
    Args a{};
    for (int i = 0; i < 26; ++i) a.in[i] = (const float*)d_in[i];
    a.out = (float*)d_out; a.ws = (unsigned char*)d_ws;
    if (N_LAUNCH_MODE == 1) {
        a.ph_lo = 0; a.ph_hi = NPH; a.use_sync = 1;
        void* args[] = {&a};
        hipError_t e = hipLaunchCooperativeKernel((const void*)hybrid_fwd, dim3(grid), dim3(512), args, LDS_BYTES, stream);
        if (e != hipSuccess) fprintf(stderr, "cooperative launch failed: %s (grid %d)\n", hipGetErrorString(e), grid);
    } else {
        for (int p = 0; p < NPH; ++p) { a.ph_lo = p; a.ph_hi = p + 1; a.use_sync = 0; hipLaunchKernelGGL(hybrid_fwd, dim3(grid), dim3(512), LDS_BYTES, stream, a); }
    }
}
```

```cpp
#include <hip/hip_runtime.h>
#include <hip/hip_cooperative_groups.h>
#include <cstdint>
#include <cstdio>
namespace cg = cooperative_groups;

#define LAS __attribute__((address_space(3)))
typedef unsigned short bf16_t;
typedef short bf16x8 __attribute__((ext_vector_type(8)));
typedef float f32x4 __attribute__((ext_vector_type(4)));
typedef float f32x2 __attribute__((ext_vector_type(2)));
typedef float f32x16 __attribute__((ext_vector_type(16)));
typedef unsigned u32x4 __attribute__((ext_vector_type(4)));
typedef unsigned u32x2 __attribute__((ext_vector_type(2)));
typedef __bf16 bf16x2_t __attribute__((ext_vector_type(2)));
typedef int i32x4_t __attribute__((ext_vector_type(4)));

constexpr int DM = 1024, SEQ = 4096, NB = 16, NTP = NB * SEQ, NSB = 8, NST = 16, NTS = NSB * NST, NTOK = NTP + NTS;
constexpr int ROWS = 65792, NMT = 257;
constexpr int INC = 7168, NEXP = 16384;
constexpr float EPS = 1e-6f, LOG2E = 1.4426950408889634f;
constexpr float QSCALE = 0.125f * LOG2E;

constexpr size_t MiB = 1u << 20;
constexpr size_t BUF = (size_t)ROWS * DM * 2;
constexpr size_t WS_CTL = 0;
constexpr size_t WS_WIN = 1 * MiB;
constexpr size_t WS_WBA = 16 * MiB, WS_WBL = 18 * MiB, WS_WO = 20 * MiB, WS_WS = 22 * MiB;
constexpr size_t WS_LRUW = 26 * MiB;
constexpr size_t WS_SGA = 27 * MiB, WS_SGR = 27 * MiB + 512 * 1024;
constexpr size_t WS_SU = 26 * MiB + 512 * 1024, WS_SV = 26 * MiB + 640 * 1024;
constexpr size_t WS_SW = 26 * MiB + 256 * 1024;
constexpr size_t WS_WSQ = 44 * MiB;
constexpr size_t WS_SX = 26 * MiB + 704 * 1024;
constexpr size_t WS_UB = 28 * MiB, WS_VB = 60 * MiB;
constexpr size_t WS_Q = 92 * MiB;
constexpr size_t WS_XN = WS_Q + BUF;
constexpr size_t WS_K = WS_XN + BUF;
constexpr size_t WS_VT = WS_K + BUF;
constexpr size_t WS_XR = WS_VT + BUF;
constexpr size_t WS_G = WS_XR + BUF;
constexpr size_t WS_END = WS_G + BUF;
constexpr size_t WS_DELTA = WS_VT;
constexpr size_t WS_PEER = WS_Q;
constexpr size_t WS_SELE = WS_G, WS_SELG = WS_G + (size_t)NTOK * 512, WS_XQ = WS_G + (size_t)NTOK * 1024;

constexpr size_t O_YP = 0, O_YS = O_YP + (size_t)NTP * DM, O_KP = O_YS + (size_t)NTS * DM, O_VP = O_KP + (size_t)NB * 512 * DM,
                 O_CP = O_VP + (size_t)NB * 512 * DM, O_LP = O_CP + (size_t)NB * 3 * DM, O_KS = O_LP + (size_t)NB * DM, O_VS = O_KS + (size_t)NTS * DM,
                 O_CS = O_VS + (size_t)NTS * DM, O_LS = O_CS + (size_t)NSB * 3 * DM, O_END = O_LS + (size_t)NSB * DM;

constexpr int LDS_BYTES = 135168;

__device__ __forceinline__ unsigned cvtpk(float lo, float hi) { f32x2 v = {lo, hi}; bf16x2_t b = __builtin_convertvector(v, bf16x2_t); return __builtin_bit_cast(unsigned, b); }
__device__ __forceinline__ float bflo(unsigned u) { return __uint_as_float(u << 16); }
__device__ __forceinline__ float bfhi(unsigned u) { return __uint_as_float(u & 0xffff0000u); }
__device__ __forceinline__ float fast_exp2(float x) { return __builtin_amdgcn_exp2f(x); }
__device__ __forceinline__ float fast_rcp(float x) { return __builtin_amdgcn_rcpf(x); }
__device__ __forceinline__ float sigmoidf_(float z) { return fast_rcp(1.0f + fast_exp2(-z * LOG2E)); }
__device__ __forceinline__ float gelu_tanh(float x) { const float u = x + 0.044715f * x * x * x; return x * fast_rcp(1.0f + fast_exp2(-1.5957691216f * LOG2E * u)); }
__device__ __forceinline__ float wave_sum(float v) {
#pragma unroll
    for (int o = 1; o < 64; o <<= 1) v += __shfl_xor(v, o);
    return v;
}
__device__ __forceinline__ int swap23(int i) { return (i & ~12) | ((i & 4) << 1) | ((i & 8) >> 1); }
__device__ __forceinline__ float plswap_max(float m) { auto rr = __builtin_amdgcn_permlane32_swap(__float_as_uint(m), __float_as_uint(m), false, false); return fmaxf(__uint_as_float(rr[0]), __uint_as_float(rr[1])); }
__device__ __forceinline__ float plswap_add(float m) { auto rr = __builtin_amdgcn_permlane32_swap(__float_as_uint(m), __float_as_uint(m), false, false); return __uint_as_float(rr[0]) + __uint_as_float(rr[1]); }

namespace pg8 {
constexpr int BM = 256, BK = 64, HALF = 128, HTB = HALF * BK * 2, STAGE_BYTES = 8 * HTB, NXCD = 8, WGM = 8;
__host__ __device__ __forceinline__ int lds_byte(int r, int c) { const int st = (r >> 4) * 2 + (c >> 5), rr = r & 15, cc = c & 31, ob = rr * 64 + cc * 2; return st * 1024 + (ob ^ (((ob >> 9) & 1) << 5)); }
__host__ __device__ __forceinline__ void stage_rc(int b, int& R, int& C) { const int st = b / 1024, sb = b % 1024, swz = sb ^ (((sb >> 9) & 1) << 5); R = (st >> 1) * 16 + swz / 64; C = (st & 1) * 32 + (swz % 64) / 2; }
__host__ __device__ __forceinline__ int perm32(int rho) { const int n = rho >> 4, i = rho & 15; return 8 * (i >> 2) + 4 * n + (i & 3); }

struct Unit { int pm, pn, kind; };
struct Gemm { const bf16_t* A0; const bf16_t* B0; const bf16_t* A1; const bf16_t* B1; int K; };

struct TileMap {
    int nM, nN, nwg;
    __device__ __forceinline__ void init(int nM_, int nN_) { nM = nM_; nN = nN_; nwg = nM * nN; }
    __device__ __forceinline__ void map(int L, int& pm, int& pn) const {
        int wgid = L; { const int q = nwg / NXCD, r = nwg % NXCD, xcd = wgid % NXCD, off = wgid / NXCD; wgid = (xcd < r ? xcd * (q + 1) : r * (q + 1) + (xcd - r) * q) + off; }
        const int nig = WGM * nN, gid = wgid / nig, fm = gid * WGM, gsz = (nM - fm) < WGM ? (nM - fm) : WGM;
        pm = fm + ((wgid % nig) % gsz); pn = (wgid % nig) / gsz;
    }
};

template <class Epi, class Sched, bool I8 = false>
__device__ __forceinline__ void gemm_phase(LAS unsigned char* lds, const Gemm g, const Sched& S, const Epi& E) {
    const int tid = threadIdx.x, wid = __builtin_amdgcn_readfirstlane(tid >> 6), lane = tid & 63, wr = wid >> 2, wc = wid & 3, fr = lane & 15, fq = lane >> 4;
    const int K = g.K, nt = K / BK;
    unsigned voffA[2], voffB[2];
#pragma unroll
    for (int i = 0; i < 2; ++i) { int R, C; stage_rc(tid * 16 + i * 8192, R, C); const int Rb = (R & ~31) + perm32(R & 31);
        voffA[i] = (unsigned)(R * K + C) * 2u; voffB[i] = (unsigned)(Rb * K + C) * 2u; }
    const size_t kstep = (size_t)(BK * 2);
    const size_t hstep = (size_t)HALF * K * 2;
    const size_t tstep = 2 * hstep;
    const unsigned ldsw = (unsigned)wid * 1024u;
    const int aoff = lds_byte(wr * 64 + fr, fq * 8), boff = lds_byte(wc * 32 + fr, fq * 8);
#define PG8_SA(b, h) (((b) * 2 + (h)) * HTB)
#define PG8_SB(b, h) ((4 + (b) * 2 + (h)) * HTB)
#define PG8_STAGE(bufoff, gbase, voff) do { _Pragma("unroll") for (int _i = 0; _i < 2; ++_i) \
        __builtin_amdgcn_global_load_lds((const unsigned*)((const char*)(gbase) + (voff)[_i]), (LAS unsigned*)(lds + (bufoff) + ldsw + _i * 8192), 16, 0, 0); } while (0)
#define PG8_LDA(dst, b, h) do { _Pragma("unroll") for (int m = 0; m < 4; ++m) _Pragma("unroll") for (int k = 0; k < 2; ++k) dst[m][k] = *(const LAS bf16x8*)(lds + PG8_SA(b, h) + aoff + m * 2048 + k * 1024); } while (0)
#define PG8_LDB(dst, b, h) do { _Pragma("unroll") for (int n = 0; n < 2; ++n) _Pragma("unroll") for (int k = 0; k < 2; ++k) dst[n][k] = *(const LAS bf16x8*)(lds + PG8_SB(b, h) + boff + n * 2048 + k * 1024); } while (0)
#define PG8_MMA(ai, bj, At, Bt) do { __builtin_amdgcn_s_setprio(1); _Pragma("unroll") for (int m = 0; m < 4; ++m) _Pragma("unroll") for (int n = 0; n < 2; ++n) _Pragma("unroll") for (int k = 0; k < 2; ++k) { \
        if constexpr (I8) acc[ai][bj][m][n] = __builtin_bit_cast(acc_t, __builtin_amdgcn_mfma_i32_16x16x64_i8(__builtin_bit_cast(i32x4_t, Bt[n][k]), __builtin_bit_cast(i32x4_t, At[m][k]), __builtin_bit_cast(i32x4_t, acc[ai][bj][m][n]), 0, 0, 0)); \
        else acc[ai][bj][m][n] = __builtin_bit_cast(acc_t, __builtin_amdgcn_mfma_f32_16x16x32_bf16(Bt[n][k], At[m][k], __builtin_bit_cast(f32x4, acc[ai][bj][m][n]), 0, 0, 0)); } __builtin_amdgcn_s_setprio(0); } while (0)
#define PG8_WAIT_V(n) asm volatile("s_waitcnt vmcnt(" #n ")" ::: "memory")
#define PG8_WAIT_L(n) asm volatile("s_waitcnt lgkmcnt(" #n ")" ::: "memory")
#define PG8_BAR __builtin_amdgcn_s_barrier()
#define PG8_SCHED __builtin_amdgcn_sched_barrier(0)
    Unit cur, nxt; int ui = 0;
    if (!S.next(0, cur)) return;
    typedef typename Epi::acc_t acc_t;
    acc_t acc[2][2][4][2];
#pragma unroll
    for (int a = 0; a < 2; ++a)
#pragma unroll
        for (int b = 0; b < 2; ++b)
#pragma unroll
            for (int m = 0; m < 4; ++m)
#pragma unroll
                for (int n = 0; n < 2; ++n) acc[a][b][m][n] = acc_t{};
    bf16x8 At[4][2], B0[2][2], B1[2][2];
    const char* cA = (const char*)(cur.kind ? g.A1 : g.A0) + (size_t)cur.pm * tstep; const char* cB = (const char*)(cur.kind ? g.B1 : g.B0) + (size_t)cur.pn * tstep;
    PG8_STAGE(PG8_SB(0, 0), cB, voffB); PG8_STAGE(PG8_SB(0, 1), cB + hstep, voffB); PG8_STAGE(PG8_SA(0, 0), cA, voffA); PG8_STAGE(PG8_SA(0, 1), cA + hstep, voffA);
    if (wr == 1) PG8_BAR;
    PG8_WAIT_V(2); PG8_BAR;
    PG8_STAGE(PG8_SB(1, 0), cB + kstep, voffB); PG8_STAGE(PG8_SA(1, 0), cA + kstep, voffA); PG8_STAGE(PG8_SB(1, 1), cB + hstep + kstep, voffB);
    PG8_WAIT_V(6); PG8_BAR;
    for (;;) {
        const bool has_next = S.next(ui + 1, nxt);
        E.prefetch(cur, lds + STAGE_BYTES + 512 + wid * 256, tid);
        const char* nA = has_next ? (const char*)(nxt.kind ? g.A1 : g.A0) + (size_t)nxt.pm * tstep : cA; const char* nB = has_next ? (const char*)(nxt.kind ? g.B1 : g.B0) + (size_t)nxt.pn * tstep : cB;
        for (int t = 0; t < nt; t += 2) {
            const bool last = (t == nt - 2);
            const char* a1 = cA + (size_t)(t + 1) * kstep;
            const char* a2 = last ? nA : cA + (size_t)(t + 2) * kstep; const char* b2 = last ? nB : cB + (size_t)(t + 2) * kstep;
            const char* a3 = a2 + kstep; const char* b3 = b2 + kstep;
            PG8_LDB(B0, 0, 0); PG8_LDB(B1, 0, 1); PG8_SCHED; PG8_LDA(At, 0, 0); PG8_STAGE(PG8_SA(1, 1), a1 + hstep, voffA);
            PG8_WAIT_V(8); PG8_WAIT_L(0); PG8_BAR; PG8_MMA(0, 0, At, B0); PG8_MMA(0, 1, At, B1); PG8_BAR; PG8_SCHED;
            PG8_LDA(At, 0, 1); PG8_STAGE(PG8_SB(0, 0), b2, voffB); PG8_STAGE(PG8_SB(0, 1), b2 + hstep, voffB); PG8_STAGE(PG8_SA(0, 0), a2, voffA);
            PG8_WAIT_V(8); PG8_WAIT_L(0); PG8_BAR; PG8_MMA(1, 0, At, B0); PG8_MMA(1, 1, At, B1); PG8_BAR; PG8_SCHED;
            PG8_LDB(B0, 1, 0); PG8_LDB(B1, 1, 1); PG8_SCHED; PG8_LDA(At, 1, 0); PG8_STAGE(PG8_SA(0, 1), a2 + hstep, voffA);
            PG8_WAIT_V(8); PG8_WAIT_L(0); PG8_BAR; PG8_MMA(0, 0, At, B0); PG8_MMA(0, 1, At, B1); PG8_BAR; PG8_SCHED;
            PG8_LDA(At, 1, 1); PG8_STAGE(PG8_SB(1, 0), b3, voffB); PG8_STAGE(PG8_SB(1, 1), b3 + hstep, voffB); PG8_STAGE(PG8_SA(1, 0), a3, voffA);
            PG8_WAIT_V(8); PG8_WAIT_L(0); PG8_BAR; PG8_MMA(1, 0, At, B0); PG8_MMA(1, 1, At, B1); PG8_BAR; PG8_SCHED;
        }
        if (wr == 0) PG8_BAR;
        const bool keep = E(acc, cur, wr, wc, fr, fq);
        if (!has_next) break;
        if (!keep) {
#pragma unroll
        for (int a = 0; a < 2; ++a)
#pragma unroll
            for (int b = 0; b < 2; ++b)
#pragma unroll
                for (int m = 0; m < 4; ++m)
#pragma unroll
                    for (int n = 0; n < 2; ++n) acc[a][b][m][n] = acc_t{};
        }
        cur = nxt; cA = nA; cB = nB; ++ui;
        if (wr == 1) PG8_BAR;
    }
    PG8_WAIT_V(0);
    PG8_BAR;
#undef PG8_SA
#undef PG8_SB
#undef PG8_STAGE
#undef PG8_LDA
#undef PG8_LDB
#undef PG8_MMA
#undef PG8_WAIT_V
#undef PG8_WAIT_L
#undef PG8_BAR
#undef PG8_SCHED
}
}
using pg8::Unit;

struct Args {
    const float* in[26];
    float* out; unsigned char* ws;
    int ph_lo, ph_hi, use_sync, pad;
};

typedef const __attribute__((address_space(4))) Args* ArgsP;
#define KA ((ArgsP)__builtin_amdgcn_kernarg_segment_ptr())
#define A_IN(k) (KA->in[k])
#define A_OUT (KA->out)
#define A_WS (KA->ws)

struct SchedG1 {
    pg8::TileMap m0, m1; int G, c;
    __device__ __forceinline__ void init(int G_, int c_) { m0.init(256, 24); m1.init(4, 256); G = G_; c = c_; }
    __device__ __forceinline__ bool next(int i, Unit& u) const {
        int L = i * G + c;
        if (L < m0.nwg) { m0.map(L, u.pm, u.pn); u.pn = (u.pn < 8) ? u.pn : u.pn + 4; u.kind = 0; return true; }
        L -= m0.nwg; if (L >= m1.nwg) return false;
        m1.map(L, u.pm, u.pn); u.kind = 1; return true;
    }
};
struct SchedPair {
    pg8::TileMap m0; int G, c;
    __device__ __forceinline__ void init(int nN, int G_, int c_) { m0.init(256, nN); G = G_; c = c_; }
    __device__ __forceinline__ bool next(int i, Unit& u) const { const int L = (i >> 1) * G + c; if (L >= m0.nwg) return false; m0.map(L, u.pm, u.pn); u.kind = i & 1; return true; }
};
struct SchedOne {
    pg8::TileMap m0; int G, c;
    __device__ __forceinline__ void init(int nN, int G_, int c_) { m0.init(256, nN); G = G_; c = c_; }
    __device__ __forceinline__ bool next(int i, Unit& u) const { const int L = i * G + c; if (L >= m0.nwg) return false; m0.map(L, u.pm, u.pn); u.kind = 0; return true; }
};

#define EPI_PREP int fr_ = fr, fq_ = fq; asm volatile("" : "+v"(fr_), "+v"(fq_)); const int rl_ = wr * 64 + fr_, cl_ = wc * 32 + 8 * fq_;
#define EPI_LOOP_BEGIN \
    _Pragma("unroll") for (int ai = 0; ai < 2; ++ai) _Pragma("unroll") for (int m = 0; m < 4; ++m) { const int rit = ai * 128 + m * 16 + rl_; \
    _Pragma("unroll") for (int bj = 0; bj < 2; ++bj) { const int cit = bj * 128 + cl_; const auto v0 = acc[ai][bj][m][0], v1 = acc[ai][bj][m][1];
#define EPI_LOOP_END } }

__device__ __forceinline__ size_t kfrag_off(int row, int col) {
    return ((((size_t)(row >> 5) * 16 + (col >> 6)) * 4 + ((col >> 4) & 3)) * 64 + ((col >> 3) & 1) * 32 + swap23(row & 31)) * 8;
}
__device__ __forceinline__ size_t vfrag_off(int vc, int tok) {
    return (((((size_t)(tok >> 5) * 16 + (vc >> 6)) * 2 + ((vc >> 5) & 1)) * 2 + ((tok >> 4) & 1)) * 64 + ((tok >> 3) & 1) * 32 + swap23(vc & 31)) * 8;
}
struct EpiG1 {
    typedef f32x4 acc_t;
    __device__ __forceinline__ void prefetch(const Unit&, LAS unsigned char*, int) const {}
    __device__ __forceinline__ bool operator()(f32x4 (&acc)[2][2][4][2], const Unit& u, int wr, int wc, int fr, int fq) const {
        EPI_PREP unsigned char* ws = A_WS; float* out = A_OUT;
        if (u.kind == 0) {
            const int t = u.pn >> 2, ct = (u.pn & 3) * 256;
            bf16_t* base;
            if (t == 0) base = (bf16_t*)(ws + WS_Q); else if (t == 1) base = (bf16_t*)(ws + WS_K); else if (t == 3) base = (bf16_t*)(ws + WS_XR); else if (t == 4) base = (bf16_t*)(ws + WS_G);
            else if (t == 5) base = (u.pm < 256) ? (bf16_t*)(out + O_YP) : (bf16_t*)(ws + WS_SGA) - (size_t)NTP * DM;
            else base = (u.pm < 256) ? (bf16_t*)(out + O_YP) + (size_t)NTP * DM : (bf16_t*)(ws + WS_SGR) - (size_t)NTP * DM;
            if (t == 1) {
                EPI_LOOP_BEGIN
                    u32x4 w; w.x = cvtpk(v0[0], v0[1]); w.y = cvtpk(v0[2], v0[3]); w.z = cvtpk(v1[0], v1[1]); w.w = cvtpk(v1[2], v1[3]);
                    *(u32x4*)(base + kfrag_off(u.pm * 256 + rit, ct + cit)) = w;
                EPI_LOOP_END
            } else if (t >= 5) {
                unsigned char* g8 = (unsigned char*)(out + O_YP) + (t == 6 ? (size_t)NTP * DM : 0) + (size_t)u.pm * 256 * DM + ct;
                EPI_LOOP_BEGIN
                    u32x2 w;
                    w.x = (unsigned)(int)rintf(sigmoidf_(v0[0]) * 255.0f) | ((unsigned)(int)rintf(sigmoidf_(v0[1]) * 255.0f) << 8) | ((unsigned)(int)rintf(sigmoidf_(v0[2]) * 255.0f) << 16) | ((unsigned)(int)rintf(sigmoidf_(v0[3]) * 255.0f) << 24);
                    w.y = (unsigned)(int)rintf(sigmoidf_(v1[0]) * 255.0f) | ((unsigned)(int)rintf(sigmoidf_(v1[1]) * 255.0f) << 8) | ((unsigned)(int)rintf(sigmoidf_(v1[2]) * 255.0f) << 16) | ((unsigned)(int)rintf(sigmoidf_(v1[3]) * 255.0f) << 24);
                    *(u32x2*)(g8 + (size_t)rit * DM + cit) = w;
                EPI_LOOP_END
            } else {
            base += (size_t)u.pm * 256 * DM + ct;
            EPI_LOOP_BEGIN
                u32x4 w; w.x = cvtpk(v0[0], v0[1]); w.y = cvtpk(v0[2], v0[3]); w.z = cvtpk(v1[0], v1[1]); w.w = cvtpk(v1[2], v1[3]);
                *(u32x4*)(base + (size_t)rit * DM + cit) = w;
            EPI_LOOP_END
            }
            if (t == 1 && u.pm < 256 && (u.pm & 15) >= 14) { float* p0 = out + O_KP + ((size_t)(u.pm >> 4) * 512 + ((u.pm & 15) - 14) * 256) * DM + ct;
                EPI_LOOP_BEGIN float* p = p0 + (size_t)rit * DM + cit; *(f32x4*)p = v0; *(f32x4*)(p + 4) = v1; EPI_LOOP_END }
            if (t == 1 && u.pm == 256) { float* p0 = out + O_KS + ct;
                EPI_LOOP_BEGIN if (rit < NTS) { float* p = p0 + (size_t)rit * DM + cit; *(f32x4*)p = v0; *(f32x4*)(p + 4) = v1; } EPI_LOOP_END }
            if (t == 3 && u.pm < 256 && (u.pm & 15) == 15) { float* p0 = out + O_CP + ((size_t)(u.pm >> 4) * 3) * DM + ct;
                EPI_LOOP_BEGIN if (rit >= 253) { float* p = p0 + (size_t)(rit - 253) * DM + cit; *(f32x4*)p = v0; *(f32x4*)(p + 4) = v1; } EPI_LOOP_END }
            if (t == 3 && u.pm == 256) { float* p0 = out + O_CS + ct;
                EPI_LOOP_BEGIN if (rit < NTS && (rit & 15) >= 13) { float* p = p0 + ((size_t)(rit >> 4) * 3 + ((rit & 15) - 13)) * DM + cit; *(f32x4*)p = v0; *(f32x4*)(p + 4) = v1; } EPI_LOOP_END }
        } else {
            bf16_t* VT = (bf16_t*)(ws + WS_VT);
            EPI_LOOP_BEGIN
                u32x4 w; w.x = cvtpk(v0[0], v0[1]); w.y = cvtpk(v0[2], v0[3]); w.z = cvtpk(v1[0], v1[1]); w.w = cvtpk(v1[2], v1[3]);
                *(u32x4*)(VT + vfrag_off(u.pm * 256 + rit, u.pn * 256 + cit)) = w;
            EPI_LOOP_END
            if (u.pn < 256 && (u.pn & 15) >= 14) { float* p0 = out + O_VP + ((size_t)(u.pn >> 4) * 512 + ((u.pn & 15) - 14) * 256) * DM + u.pm * 256;
                EPI_LOOP_BEGIN float* p = p0 + (size_t)cit * DM + rit;
                    p[0] = v0[0]; p[DM] = v0[1]; p[2 * DM] = v0[2]; p[3 * DM] = v0[3]; p[4 * DM] = v1[0]; p[5 * DM] = v1[1]; p[6 * DM] = v1[2]; p[7 * DM] = v1[3]; EPI_LOOP_END }
            if (u.pn == 256) { float* p0 = out + O_VS + u.pm * 256;
                EPI_LOOP_BEGIN if (cit < NTS) { float* p = p0 + (size_t)cit * DM + rit;
                    p[0] = v0[0]; p[DM] = v0[1]; p[2 * DM] = v0[2]; p[3 * DM] = v0[3]; p[4 * DM] = v1[0]; p[5 * DM] = v1[1]; p[6 * DM] = v1[2]; p[7 * DM] = v1[3]; } EPI_LOOP_END }
        }
        return false;
    }
};

struct EpiP3 {
    typedef f32x4 acc_t;
    __device__ __forceinline__ void prefetch(const Unit& u, LAS unsigned char* dummy, int tid) const {
        const char* base = (const char*)(A_OUT + O_YP) + (u.kind ? (size_t)NTP * DM : 0) + (size_t)u.pm * 256 * DM + u.pn * 256;
        asm volatile("" : "+v"(tid));
        __builtin_amdgcn_global_load_lds((const unsigned*)(base + (size_t)(tid >> 1) * DM + (tid & 1) * 128), (LAS unsigned*)dummy, 4, 0, 0);
    }
    __device__ __forceinline__ bool operator()(f32x4 (&acc)[2][2][4][2], const Unit& u, int wr, int wc, int fr, int fq) const {
        EPI_PREP unsigned char* ws = A_WS; float* out = A_OUT;
        const size_t off0 = (size_t)u.pm * 256 * DM + u.pn * 256;
        const unsigned char* ga = (const unsigned char*)(out + O_YP) + off0; const unsigned char* gr = ga + (size_t)NTP * DM; bf16_t* MG = (bf16_t*)(ws + WS_XR) + off0;
#pragma unroll
        for (int ai = 0; ai < 2; ++ai) {
            u32x2 wa[4][2], wr8[4][2];
#pragma unroll
            for (int m = 0; m < 4; ++m)
#pragma unroll
                for (int bj = 0; bj < 2; ++bj) { const size_t off = (size_t)(ai * 128 + m * 16 + rl_) * DM + bj * 128 + cl_;
                    wr8[m][bj] = *(const u32x2*)(gr + off); if (u.kind == 0) wa[m][bj] = *(const u32x2*)(ga + off); }
#pragma unroll
            for (int m = 0; m < 4; ++m)
#pragma unroll
                for (int bj = 0; bj < 2; ++bj) {
                    const unsigned r0 = wr8[m][bj].x, r1 = wr8[m][bj].y;
                    float sr[8]; sr[0] = (float)(r0 & 0xffu); sr[1] = (float)((r0 >> 8) & 0xffu); sr[2] = (float)((r0 >> 16) & 0xffu); sr[3] = (float)(r0 >> 24);
                    sr[4] = (float)(r1 & 0xffu); sr[5] = (float)((r1 >> 8) & 0xffu); sr[6] = (float)((r1 >> 16) & 0xffu); sr[7] = (float)(r1 >> 24);
                    if (u.kind == 0) {
                        const unsigned a0 = wa[m][bj].x, a1 = wa[m][bj].y;
                        float sa[8]; sa[0] = (float)(a0 & 0xffu); sa[1] = (float)((a0 >> 8) & 0xffu); sa[2] = (float)((a0 >> 16) & 0xffu); sa[3] = (float)(a0 >> 24);
                        sa[4] = (float)(a1 & 0xffu); sa[5] = (float)((a1 >> 8) & 0xffu); sa[6] = (float)((a1 >> 16) & 0xffu); sa[7] = (float)(a1 >> 24);
#pragma unroll
                        for (int i = 0; i < 4; ++i) { acc[ai][bj][m][0][i] *= sa[i] * fast_rcp(fmaxf(sr[i], 1.0f)); acc[ai][bj][m][1][i] *= sa[4 + i] * fast_rcp(fmaxf(sr[4 + i], 1.0f)); }
                    } else {
                        const float k255 = 1.0f / 255.0f; const size_t off = (size_t)(ai * 128 + m * 16 + rl_) * DM + bj * 128 + cl_;
                        const f32x4 v0 = acc[ai][bj][m][0] * k255, v1 = acc[ai][bj][m][1] * k255;
                        u32x4 w; w.x = cvtpk(v0[0] * fmaxf(sr[0], 1.0f), v0[1] * fmaxf(sr[1], 1.0f)); w.y = cvtpk(v0[2] * fmaxf(sr[2], 1.0f), v0[3] * fmaxf(sr[3], 1.0f));
                        w.z = cvtpk(v1[0] * fmaxf(sr[4], 1.0f), v1[1] * fmaxf(sr[5], 1.0f)); w.w = cvtpk(v1[2] * fmaxf(sr[6], 1.0f), v1[3] * fmaxf(sr[7], 1.0f));
                        *(u32x4*)(MG + off) = w; }
                }
        }
        return u.kind == 0;
    }
};

struct EpiP4 {
    typedef f32x4 acc_t;
    __device__ __forceinline__ void prefetch(const Unit&, LAS unsigned char*, int) const {}
    __device__ __forceinline__ bool operator()(f32x4 (&acc)[2][2][4][2], const Unit& u, int wr, int wc, int fr, int fq) const {
        EPI_PREP bf16_t* base = (bf16_t*)(A_WS + WS_DELTA) + (size_t)u.pm * 256 * DM + u.pn * 256;
        EPI_LOOP_BEGIN
            u32x4 w; w.x = cvtpk(v0[0], v0[1]); w.y = cvtpk(v0[2], v0[3]); w.z = cvtpk(v1[0], v1[1]); w.w = cvtpk(v1[2], v1[3]);
            *(u32x4*)(base + (size_t)rit * DM + cit) = w;
        EPI_LOOP_END
        return false;
    }
};

struct EpiP5 {
    typedef i32x4_t acc_t;
    __device__ __forceinline__ void prefetch(const Unit&, LAS unsigned char*, int) const {}
    __device__ __forceinline__ bool operator()(i32x4_t (&acc)[2][2][4][2], const Unit& u, int wr, int wc, int fr, int fq) const {
        EPI_PREP bf16_t* SC = (bf16_t*)(A_WS + WS_XN) + (size_t)u.pm * 256 * 2048 + u.pn * 256;
        const float* SXp = (const float*)(A_WS + WS_SX) + u.pm * 256; const float* SWp = (const float*)(A_WS + WS_SW) + u.pn * 256;
        EPI_LOOP_BEGIN
            const float sx = SXp[rit]; const f32x4 w0 = *(const f32x4*)(SWp + cit), w1 = *(const f32x4*)(SWp + cit + 4);
            u32x4 w; w.x = cvtpk((float)v0[0] * sx * w0[0], (float)v0[1] * sx * w0[1]); w.y = cvtpk((float)v0[2] * sx * w0[2], (float)v0[3] * sx * w0[3]);
            w.z = cvtpk((float)v1[0] * sx * w1[0], (float)v1[1] * sx * w1[1]); w.w = cvtpk((float)v1[2] * sx * w1[2], (float)v1[3] * sx * w1[3]);
            *(u32x4*)(SC + (size_t)rit * 2048 + cit) = w;
        EPI_LOOP_END
        return false;
    }
};

__device__ __forceinline__ void row_ld(const float* p, f32x4 (&v)[4], int lane) {
#pragma unroll
    for (int j = 0; j < 4; ++j) v[j] = *(const f32x4*)(p + j * 256 + lane * 4);
}
__device__ __forceinline__ float row_ss(const f32x4 (&v)[4]) { float s = 0.f;
#pragma unroll
    for (int j = 0; j < 4; ++j) s += (v[j][0] * v[j][0] + v[j][1] * v[j][1]) + (v[j][2] * v[j][2] + v[j][3] * v[j][3]);
    return s; }
__device__ __forceinline__ void row_add_bf16(const bf16_t* p, f32x4 (&v)[4], int lane) {
#pragma unroll
    for (int j = 0; j < 4; ++j) { const u32x2 w = *(const u32x2*)(p + j * 256 + lane * 4); v[j][0] += bflo(w.x); v[j][1] += bfhi(w.x); v[j][2] += bflo(w.y); v[j][3] += bfhi(w.y); }
}
__device__ __forceinline__ const float* xrow_ptr(int m) { return (m < NTP) ? A_IN(0) + (size_t)m * DM : A_IN(1) + (size_t)(m - NTP) * DM; }
__device__ __forceinline__ float* yrow_ptr(int m) { return (m < NTP) ? A_OUT + O_YP + (size_t)m * DM : A_OUT + O_YS + (size_t)(m - NTP) * DM; }

__device__ __forceinline__ void p0_transpose_item(const float* W, int K, int N, bf16_t* WT, LAS float* scr, int item, int lane, int nscale = 0) {
    const int nblk = N / 32, kb = item / nblk, nb = item % nblk, k0 = 64 * kb, n0 = 32 * nb;
#pragma unroll 8
    for (int i = 0; i < 32; ++i) { const int kk = 2 * i + (lane >> 5); scr[kk * 33 + (lane & 31)] = W[(size_t)(k0 + kk) * N + n0 + (lane & 31)] * (n0 < nscale ? QSCALE : 1.0f); }
    asm volatile("s_waitcnt lgkmcnt(0)" ::: "memory");
    const int c = lane & 7;
#pragma unroll
    for (int j = 0; j < 4; ++j) { const int n = (lane >> 3) + 8 * j; const LAS float* s = scr + (8 * c) * 33 + n;
        u32x4 o; o.x = cvtpk(s[0 * 33], s[1 * 33]); o.y = cvtpk(s[2 * 33], s[3 * 33]); o.z = cvtpk(s[4 * 33], s[5 * 33]); o.w = cvtpk(s[6 * 33], s[7 * 33]);
        *(u32x4*)(WT + (size_t)(n0 + n) * K + k0 + 8 * c) = o; }
    asm volatile("s_waitcnt lgkmcnt(0)" ::: "memory");
}

__device__ __forceinline__ void p0_prologue(LAS unsigned char* lds, int G, int wave, int lane) {
    unsigned char* ws = A_WS;
    const int gw = blockIdx.x * 8 + wave, NGW = G * 8;
    LAS float* scr = (LAS float*)(lds + wave * 16384);
    constexpr int I_IN = 16 * (INC / 32), I_SQ = 16 * 32, NTR = I_IN + 3 * I_SQ;
    for (int it = gw; it < NTR; it += NGW) {
        int r = it;
        if (r < I_IN) { p0_transpose_item(A_IN(7), DM, INC, (bf16_t*)(ws + WS_WIN), scr, r, lane, 1024); continue; } r -= I_IN;
        if (r < I_SQ) { p0_transpose_item(A_IN(16), DM, DM, (bf16_t*)(ws + WS_WBA), scr, r, lane); continue; } r -= I_SQ;
        if (r < I_SQ) { p0_transpose_item(A_IN(17), DM, DM, (bf16_t*)(ws + WS_WBL), scr, r, lane); continue; } r -= I_SQ;
        p0_transpose_item(A_IN(18), DM, DM, (bf16_t*)(ws + WS_WO), scr, r, lane);
    }
    {
        const float* wq = A_IN(20); bf16_t* wst = (bf16_t*)(ws + WS_WS);
        const int r32 = lane & 31, hi = lane >> 5;
        for (int it = gw; it < 2048; it += NGW) {
            const int hj = it >> 7, kt = (it >> 5) & 3, ct = it & 31, h = hj >> 1, j = hj & 1;
            const float* ap = (j ? A_IN(22) : A_IN(21)) + ((size_t)(h * 128 + kt * 32 + r32)) * 128 + 64 * hi;
            const float* bp = wq + (size_t)(ct * 32 + r32) * 2048 + hj * 128 + 64 * hi;
            f32x16 acc = {};
#pragma unroll
            for (int s4 = 0; s4 < 16; ++s4) { const f32x4 av = *(const f32x4*)(ap + 4 * s4), bv = *(const f32x4*)(bp + 4 * s4);
                acc = __builtin_amdgcn_mfma_f32_32x32x2f32(av[0], bv[0], acc, 0, 0, 0); acc = __builtin_amdgcn_mfma_f32_32x32x2f32(av[1], bv[1], acc, 0, 0, 0);
                acc = __builtin_amdgcn_mfma_f32_32x32x2f32(av[2], bv[2], acc, 0, 0, 0); acc = __builtin_amdgcn_mfma_f32_32x32x2f32(av[3], bv[3], acc, 0, 0, 0); }
#pragma unroll
            for (int r = 0; r < 16; ++r) { const int key = kt * 32 + (r & 3) + 8 * (r >> 2) + 4 * hi;
                wst[(size_t)(key * 16 + hj) * DM + ct * 32 + r32] = (bf16_t)(cvtpk(acc[r], 0.f) & 0xffffu); }
        }
    }
    {
        f32x4 p[4], pn[4];
        if (gw < 2 * NEXP) {
#pragma unroll
            for (int q = 0; q < 4; ++q) p[q] = *(const f32x4*)(((gw >= NEXP) ? A_IN(24) + (size_t)(gw - NEXP) * DM : A_IN(23) + (size_t)gw * DM) + lane * 16 + 4 * q); }
        for (int it = gw; it < 2 * NEXP; it += NGW) {
            const int tb = it >= NEXP, e = it - tb * NEXP, itn = it + NGW;
            if (itn < 2 * NEXP) {
#pragma unroll
                for (int q = 0; q < 4; ++q) pn[q] = *(const f32x4*)(((itn >= NEXP) ? A_IN(24) + (size_t)(itn - NEXP) * DM : A_IN(23) + (size_t)itn * DM) + lane * 16 + 4 * q); }
            unsigned char* dst = ws + (tb ? WS_VB : WS_UB) + (size_t)e * DM + lane * 16;
            float mx = 0.f;
#pragma unroll
            for (int q = 0; q < 4; ++q) mx = fmaxf(mx, fmaxf(fmaxf(fabsf(p[q][0]), fabsf(p[q][1])), fmaxf(fabsf(p[q][2]), fabsf(p[q][3]))));
#pragma unroll
            for (int o = 1; o < 64; o <<= 1) mx = fmaxf(mx, __shfl_xor(mx, o));
            const float step = fmaxf(mx, 1e-30f) * (1.0f / 127.0f), inv = 1.0f / step;
            u32x4 w;
#pragma unroll
            for (int q = 0; q < 4; ++q) {
                const unsigned b0 = (unsigned)(int)rintf(p[q][0] * inv) & 0xffu, b1 = (unsigned)(int)rintf(p[q][1] * inv) & 0xffu, b2 = (unsigned)(int)rintf(p[q][2] * inv) & 0xffu, b3 = (unsigned)(int)rintf(p[q][3] * inv) & 0xffu;
                w[q] = b0 | (b1 << 8) | (b2 << 16) | (b3 << 24); }
            *(u32x4*)dst = w;
            if (lane == 0) ((float*)(ws + (tb ? WS_SV : WS_SU)))[e] = step;
#pragma unroll
            for (int q = 0; q < 4; ++q) p[q] = pn[q];
        }
    }
    {
        const float* gm = A_IN(6); bf16_t* XN = (bf16_t*)(ws + WS_XN);
        for (int m = NTOK + gw; m < ROWS; m += NGW) {
#pragma unroll
            for (int j = 0; j < 2; ++j) *(u32x4*)(XN + (size_t)m * DM + j * 512 + lane * 8) = (u32x4){0u, 0u, 0u, 0u}; }
        f32x4 v[4], vn[4];
        if (gw < NTOK) row_ld(xrow_ptr(gw), v, lane);
        for (int m = gw; m < NTOK; m += NGW) {
            const int mn = m + NGW;
            if (mn < NTOK) row_ld(xrow_ptr(mn), vn, lane);
            bf16_t* orow = XN + (size_t)m * DM;
            const float inv = 1.0f / sqrtf(wave_sum(row_ss(v)) * (1.0f / DM) + EPS);
#pragma unroll
            for (int j = 0; j < 4; ++j) { const f32x4 gg = *(const f32x4*)(gm + j * 256 + lane * 4); const f32x4 y = v[j] * inv * gg;
                u32x2 w; w.x = cvtpk(y[0], y[1]); w.y = cvtpk(y[2], y[3]); *(u32x2*)(orow + j * 256 + lane * 4) = w; }
#pragma unroll
            for (int j = 0; j < 4; ++j) v[j] = vn[j];
        }
    }
    {
        bf16_t* fw = (bf16_t*)(ws + WS_LRUW);
        for (int f = gw; f < 256; f += NGW) {
            const int ks = f & 3, T = (f >> 2) & 1, gate = (f >> 3) & 1, g = f >> 4, i = lane & 31, hi = lane >> 5;
            const int outc = 32 * T + swap23(i);
            const float* W = (gate ? A_IN(13) : A_IN(11)) + (size_t)g * 4096;
            float x[8];
#pragma unroll
            for (int j = 0; j < 8; ++j) x[j] = W[(16 * ks + 8 * hi + j) * 64 + outc];
            u32x4 w; w.x = cvtpk(x[0], x[1]); w.y = cvtpk(x[2], x[3]); w.z = cvtpk(x[4], x[5]); w.w = cvtpk(x[6], x[7]);
            *(u32x4*)(fw + (size_t)f * 512 + lane * 8) = w;
        }
    }
}

constexpr int LR_WF = 0, LR_CW = 16384, LR_CB = LR_CW + 1024, LR_BR = LR_CB + 256, LR_BI = LR_BR + 256, LR_CS = LR_BI + 256, LR_CARRY = LR_CS + 256, LR_SEQ = LR_CARRY + 2048, LR_END = LR_SEQ + 64, LR_DUMMY = 21504;

__device__ __forceinline__ void lru_load_consts(LAS unsigned char* lds, int g, int tid) {
    const u32x4* src = (const u32x4*)(A_WS + WS_LRUW + (size_t)g * 16384);
    for (int i = tid; i < 1024; i += 512) ((LAS u32x4*)(lds + LR_WF))[i] = src[i];
    if (tid < 256) ((LAS float*)(lds + LR_CW))[tid] = A_IN(9)[(tid >> 6) * DM + g * 64 + (tid & 63)];
    if (tid < 64) {
        const int c = g * 64 + tid;
        ((LAS float*)(lds + LR_CB))[tid] = A_IN(10)[c]; ((LAS float*)(lds + LR_BR))[tid] = A_IN(12)[c]; ((LAS float*)(lds + LR_BI))[tid] = A_IN(14)[c];
        ((LAS float*)(lds + LR_CS))[tid] = 8.0f * log1pf(expf(-A_IN(15)[c]));
    }
    if (tid < 8) ((LAS unsigned*)(lds + LR_SEQ))[tid] = 0xffffffffu;
}

template <bool SAMPLE>
__device__ __forceinline__ void lru_tile(LAS unsigned char* lds, int lane, int g, size_t rowbase, int tile, int bidx) {
    asm volatile("" : "+v"(lane));
    const int tl = lane & 31, hi = lane >> 5, t = tile * 32 + tl;
    const bf16_t* XR = (const bf16_t*)(A_WS + WS_XR); bf16_t* Gb = (bf16_t*)(A_WS + WS_G);
    const int cbase = g * 64 + 8 * hi;
    u32x4 gw4[4];
    {   const bf16_t* gp0 = Gb + (rowbase + (SAMPLE ? (tl < NST ? t : 0) : t)) * DM + cbase;
#pragma unroll
        for (int ks = 0; ks < 4; ++ks) gw4[ks] = *(const u32x4*)(gp0 + 16 * ks); }
    float xc[4][8];
    bf16x8 xf[4];
#pragma unroll
    for (int ks = 0; ks < 4; ++ks) {
        const f32x4 b0 = *(const LAS f32x4*)(lds + LR_CB + (16 * ks + 8 * hi) * 4), b1 = *(const LAS f32x4*)(lds + LR_CB + (16 * ks + 8 * hi) * 4 + 16);
#pragma unroll
        for (int j = 0; j < 4; ++j) { xc[ks][j] = b0[j]; xc[ks][4 + j] = b1[j]; }
#pragma unroll
        for (int tap = 0; tap < 4; ++tap) {
            const int rr = t - 3 + tap;
            float xv[8];
            {
                u32x4 w = *(const u32x4*)(XR + (rowbase + (rr < 0 ? 0 : rr)) * DM + cbase + 16 * ks);
                if (rr < 0) w = (u32x4){0u, 0u, 0u, 0u};
                xv[0] = bflo(w.x); xv[1] = bfhi(w.x); xv[2] = bflo(w.y); xv[3] = bfhi(w.y); xv[4] = bflo(w.z); xv[5] = bfhi(w.z); xv[6] = bflo(w.w); xv[7] = bfhi(w.w);
            }
            if (SAMPLE) {
                const float* sp = A_IN(4) + ((size_t)bidx * 3 + (rr < 0 ? 3 + rr : 0)) * DM + cbase + 16 * ks;
                const f32x4 p = *(const f32x4*)sp, q = *(const f32x4*)(sp + 4);
#pragma unroll
                for (int j = 0; j < 4; ++j) { xv[j] = rr < 0 ? p[j] : xv[j]; xv[4 + j] = rr < 0 ? q[j] : xv[4 + j]; }
            }
            const f32x4 w0 = *(const LAS f32x4*)(lds + LR_CW + (tap * 64 + 16 * ks + 8 * hi) * 4), w1 = *(const LAS f32x4*)(lds + LR_CW + (tap * 64 + 16 * ks + 8 * hi) * 4 + 16);
#pragma unroll
            for (int j = 0; j < 4; ++j) { xc[ks][j] += w0[j] * xv[j]; xc[ks][4 + j] += w1[j] * xv[4 + j]; }
        }
        u32x4 w; w.x = cvtpk(xc[ks][0], xc[ks][1]); w.y = cvtpk(xc[ks][2], xc[ks][3]); w.z = cvtpk(xc[ks][4], xc[ks][5]); w.w = cvtpk(xc[ks][6], xc[ks][7]);
        xf[ks] = __builtin_bit_cast(bf16x8, w);
        asm volatile("" ::: "memory");
    }
    float A[32], B[32];
#pragma unroll
    for (int T = 0; T < 2; ++T) {
        f32x16 ar = f32x16{}, ai = f32x16{};
#pragma unroll
        for (int ks = 0; ks < 4; ++ks) {
            const bf16x8 wr_ = *(const LAS bf16x8*)(lds + LR_WF + ((0 * 2 + T) * 4 + ks) * 1024 + lane * 16);
            const bf16x8 wi_ = *(const LAS bf16x8*)(lds + LR_WF + ((1 * 2 + T) * 4 + ks) * 1024 + lane * 16);
            ar = __builtin_amdgcn_mfma_f32_32x32x16_bf16(wr_, xf[ks], ar, 0, 0, 0);
            ai = __builtin_amdgcn_mfma_f32_32x32x16_bf16(wi_, xf[ks], ai, 0, 0, 0);
        }
#pragma unroll
        for (int q = 0; q < 2; ++q) {
            const int ks = 2 * T + q, lo = (16 * ks + 8 * hi) * 4;
            const f32x4 br0 = *(const LAS f32x4*)(lds + LR_BR + lo), br1 = *(const LAS f32x4*)(lds + LR_BR + lo + 16);
            const f32x4 bi0 = *(const LAS f32x4*)(lds + LR_BI + lo), bi1 = *(const LAS f32x4*)(lds + LR_BI + lo + 16);
            const f32x4 cs0 = *(const LAS f32x4*)(lds + LR_CS + lo), cs1 = *(const LAS f32x4*)(lds + LR_CS + lo + 16);
#pragma unroll
            for (int j = 0; j < 8; ++j) {
                const int r = 8 * q + j;
                const float brv = j < 4 ? br0[j & 3] : br1[j & 3], biv = j < 4 ? bi0[j & 3] : bi1[j & 3], csv = j < 4 ? cs0[j & 3] : cs1[j & 3];
                const float rg = sigmoidf_(ar[r] + brv), ig = sigmoidf_(ai[r] + biv);
                const float la = -csv * rg, av = fast_exp2(la * LOG2E);
                const float x2 = 2.0f * la;
                const float em = (x2 > -0.03f) ? -x2 * (1.0f + x2 * (0.5f + x2 * (0.16666667f + x2 * 0.041666668f))) : 1.0f - fast_exp2(x2 * LOG2E);
                A[16 * T + r] = av; B[16 * T + r] = sqrtf(em) * ig * xc[ks][j];
            }
        }
        asm volatile("" ::: "memory");
    }
#define LRU_STEP(CTRL, RM) _Pragma("unroll") for (int c = 0; c < 32; ++c) { \
        const float as_ = __builtin_bit_cast(float, __builtin_amdgcn_update_dpp(__builtin_bit_cast(int, 1.0f), __builtin_bit_cast(int, A[c]), CTRL, RM, 0xF, false)); \
        const float bs_ = __builtin_bit_cast(float, __builtin_amdgcn_update_dpp(0, __builtin_bit_cast(int, B[c]), CTRL, RM, 0xF, false)); \
        B[c] = A[c] * bs_ + B[c]; A[c] = A[c] * as_; }
    LRU_STEP(0x111, 0xF) LRU_STEP(0x112, 0xF) LRU_STEP(0x114, 0xF) LRU_STEP(0x118, 0xF) LRU_STEP(0x142, 0xA)
#undef LRU_STEP
    float hin[32];
    if (SAMPLE) {
        const float* hp = A_IN(5) + (size_t)bidx * DM + cbase;
#pragma unroll
        for (int ks = 0; ks < 4; ++ks) { const f32x4 p = *(const f32x4*)(hp + 16 * ks), q = *(const f32x4*)(hp + 16 * ks + 4);
#pragma unroll
            for (int j = 0; j < 4; ++j) { hin[8 * ks + j] = p[j]; hin[8 * ks + 4 + j] = q[j]; } }
    } else if (tile == 0) {
#pragma unroll
        for (int c = 0; c < 32; ++c) hin[c] = 0.f;
    } else {
        volatile LAS unsigned* sq = (volatile LAS unsigned*)(lds + LR_SEQ) + (tile & 7);
        while (*sq != (unsigned)tile) __builtin_amdgcn_s_sleep(1);
        asm volatile("" ::: "memory");
        const LAS float* cp = (const LAS float*)(lds + LR_CARRY) + (tile & 7) * 64 + 8 * hi;
#pragma unroll
        for (int ks = 0; ks < 4; ++ks) { const f32x4 p = *(const LAS f32x4*)(cp + 16 * ks), q = *(const LAS f32x4*)(cp + 16 * ks + 4);
#pragma unroll
            for (int j = 0; j < 4; ++j) { hin[8 * ks + j] = p[j]; hin[8 * ks + 4 + j] = q[j]; } }
    }
#pragma unroll
    for (int c = 0; c < 32; ++c) B[c] = B[c] + A[c] * hin[c];
    if (!SAMPLE) {
        if (tl == 31) {
            if (tile < 127) {
                LAS float* cp = (LAS float*)(lds + LR_CARRY) + ((tile + 1) & 7) * 64 + 8 * hi;
#pragma unroll
                for (int ks = 0; ks < 4; ++ks) { *(LAS f32x4*)(cp + 16 * ks) = (f32x4){B[8 * ks], B[8 * ks + 1], B[8 * ks + 2], B[8 * ks + 3]};
                    *(LAS f32x4*)(cp + 16 * ks + 4) = (f32x4){B[8 * ks + 4], B[8 * ks + 5], B[8 * ks + 6], B[8 * ks + 7]}; }
            } else {
                float* lp = A_OUT + O_LP + (size_t)bidx * DM + cbase;
#pragma unroll
                for (int ks = 0; ks < 4; ++ks) { *(f32x4*)(lp + 16 * ks) = (f32x4){B[8 * ks], B[8 * ks + 1], B[8 * ks + 2], B[8 * ks + 3]};
                    *(f32x4*)(lp + 16 * ks + 4) = (f32x4){B[8 * ks + 4], B[8 * ks + 5], B[8 * ks + 6], B[8 * ks + 7]}; }
            }
        }
        if (tile < 127) {
            asm volatile("s_waitcnt lgkmcnt(0)" ::: "memory");
            if (lane == 63) *((volatile LAS unsigned*)(lds + LR_SEQ) + ((tile + 1) & 7)) = (unsigned)(tile + 1);
        }
    } else if (tl == 15) {
        float* lp = A_OUT + O_LS + (size_t)bidx * DM + cbase;
#pragma unroll
        for (int ks = 0; ks < 4; ++ks) { *(f32x4*)(lp + 16 * ks) = (f32x4){B[8 * ks], B[8 * ks + 1], B[8 * ks + 2], B[8 * ks + 3]};
            *(f32x4*)(lp + 16 * ks + 4) = (f32x4){B[8 * ks + 4], B[8 * ks + 5], B[8 * ks + 6], B[8 * ks + 7]}; }
    }
    if (!SAMPLE || tl < NST) {
        bf16_t* gp = Gb + (rowbase + t) * DM + cbase;
#pragma unroll
        for (int ks = 0; ks < 4; ++ks) {
            const u32x4 w = gw4[ks];
            float gv[8]; gv[0] = bflo(w.x); gv[1] = bfhi(w.x); gv[2] = bflo(w.y); gv[3] = bfhi(w.y); gv[4] = bflo(w.z); gv[5] = bfhi(w.z); gv[6] = bflo(w.w); gv[7] = bfhi(w.w);
            float o[8];
#pragma unroll
            for (int j = 0; j < 8; ++j) o[j] = B[8 * ks + j] * gelu_tanh(gv[j]);
            u32x4 ow; ow.x = cvtpk(o[0], o[1]); ow.y = cvtpk(o[2], o[3]); ow.z = cvtpk(o[4], o[5]); ow.w = cvtpk(o[6], o[7]);
            *(u32x4*)(gp + 16 * ks) = ow;
        }
    }
    if (!SAMPLE && tile + 16 < 128) {
        const size_t r2 = (rowbase + (size_t)(tile + 16) * 32 + (lane >> 1)) * DM + g * 64 + (lane & 1) * 32;
        __builtin_amdgcn_global_load_lds((const unsigned*)(XR + r2), (LAS unsigned*)(lds + LR_DUMMY + (tile & 7) * 256), 4, 0, 0);
        __builtin_amdgcn_global_load_lds((const unsigned*)(Gb + r2), (LAS unsigned*)(lds + LR_DUMMY + (tile & 7) * 256), 4, 0, 0);
    }
}

constexpr int P2_Q = 20608;
constexpr int AT_TAB = 24576;
__device__ __forceinline__ void attn_unit(LAS unsigned char* lds, int lane, int b, int c, int h) {
    const int r32 = lane & 31, hi = lane >> 5, kr = swap23(r32);
    const bf16_t* Q = (const bf16_t*)(A_WS + WS_Q); const bf16_t* Kb = (const bf16_t*)(A_WS + WS_K); const bf16_t* VT = (const bf16_t*)(A_WS + WS_VT); bf16_t* O = (bf16_t*)(A_WS + WS_XN);
    const size_t row0 = (size_t)b * SEQ + (size_t)c * 64;
    bf16x8 qf[2][4];
#pragma unroll
    for (int qb = 0; qb < 2; ++qb)
#pragma unroll
        for (int ks = 0; ks < 4; ++ks) qf[qb][ks] = *(const bf16x8*)(Q + (row0 + qb * 32 + r32) * DM + h * 64 + ks * 16 + hi * 8);
    f32x16 o[2][2];
#pragma unroll
    for (int i = 0; i < 2; ++i)
#pragma unroll
        for (int j = 0; j < 2; ++j) o[i][j] = f32x16{};
    float mrow[2] = {-1e30f, -1e30f}, lrow[2] = {0.f, 0.f};
    const LAS float* tab = (const LAS float*)(lds + AT_TAB) + h * 320;
    const float cfar = tab[256];
    const int sb0 = (c >= 8 ? c - 8 : 0) * 2, sb1 = c * 2 + 1;
    const bf16_t* kbase = Kb + ((size_t)b * 128 * 16 + h) * 4 * 512 + lane * 8;
    const bf16_t* vbase = VT + ((size_t)b * 128 * 16 + h) * 4 * 512 + lane * 8;
    bf16x8 kf[4], vf[2][2];
#pragma unroll
    for (int ks = 0; ks < 4; ++ks) kf[ks] = *(const bf16x8*)(kbase + (size_t)sb0 * 32768 + ks * 512);
#pragma unroll
    for (int db = 0; db < 2; ++db)
#pragma unroll
        for (int s = 0; s < 2; ++s) vf[db][s] = *(const bf16x8*)(vbase + (size_t)sb0 * 32768 + (db * 2 + s) * 512);
    for (int sb = sb0; sb <= sb1; ++sb) {
        const int sbn = sb < sb1 ? sb + 1 : sb;
        f32x16 S[2];
#pragma unroll
        for (int qb = 0; qb < 2; ++qb) { S[qb] = f32x16{};
#pragma unroll
            for (int ks = 0; ks < 4; ++ks) S[qb] = __builtin_amdgcn_mfma_f32_32x32x16_bf16(kf[ks], qf[qb][ks], S[qb], 0, 0, 0); }
        asm volatile("" ::: "memory");
#pragma unroll
        for (int ks = 0; ks < 4; ++ks) kf[ks] = *(const bf16x8*)(kbase + (size_t)sbn * 32768 + ks * 512);
        const int delta = c - (sb >> 1), rb = sb & 1;
        if (delta >= 3) {
#pragma unroll
            for (int qb = 0; qb < 2; ++qb)
#pragma unroll
                for (int r = 0; r < 16; ++r) S[qb][r] += cfar;
        } else {
#pragma unroll
            for (int qb = 0; qb < 2; ++qb) {
                const LAS float* tp = tab + (64 * delta + 32 * qb + r32 + 128 - 32 * rb - 8 * hi - 23);
#pragma unroll
                for (int r = 0; r < 16; ++r) S[qb][r] += tp[23 - (16 * (r >> 3) + (r & 7))];
            }
        }
        float rm[2];
#pragma unroll
        for (int qb = 0; qb < 2; ++qb) { float mx = S[qb][0];
#pragma unroll
            for (int r = 1; r < 16; ++r) mx = fmaxf(mx, S[qb][r]);
            rm[qb] = plswap_max(mx); }
        if (__any((rm[0] > mrow[0] + 8.0f) || (rm[1] > mrow[1] + 8.0f))) {
#pragma unroll
            for (int qb = 0; qb < 2; ++qb) { const float mn = fmaxf(mrow[qb], rm[qb]); const float al = fast_exp2(mrow[qb] - mn); lrow[qb] *= al; mrow[qb] = mn;
#pragma unroll
                for (int r = 0; r < 16; ++r) { o[0][qb][r] *= al; o[1][qb][r] *= al; } }
        }
        bf16x8 pf[2][2];
#pragma unroll
        for (int qb = 0; qb < 2; ++qb) { float sum = 0.f;
#pragma unroll
            for (int r = 0; r < 16; ++r) { S[qb][r] = fast_exp2(S[qb][r] - mrow[qb]); sum += S[qb][r]; }
            lrow[qb] += sum;
#pragma unroll
            for (int s = 0; s < 2; ++s) { u32x4 w; w.x = cvtpk(S[qb][8 * s], S[qb][8 * s + 1]); w.y = cvtpk(S[qb][8 * s + 2], S[qb][8 * s + 3]); w.z = cvtpk(S[qb][8 * s + 4], S[qb][8 * s + 5]); w.w = cvtpk(S[qb][8 * s + 6], S[qb][8 * s + 7]);
                pf[qb][s] = __builtin_bit_cast(bf16x8, w); } }
#pragma unroll
        for (int db = 0; db < 2; ++db)
#pragma unroll
            for (int qb = 0; qb < 2; ++qb)
#pragma unroll
                for (int s = 0; s < 2; ++s) o[db][qb] = __builtin_amdgcn_mfma_f32_32x32x16_bf16(vf[db][s], pf[qb][s], o[db][qb], 0, 0, 0);
        asm volatile("" ::: "memory");
#pragma unroll
        for (int db = 0; db < 2; ++db)
#pragma unroll
            for (int s = 0; s < 2; ++s) vf[db][s] = *(const bf16x8*)(vbase + (size_t)sbn * 32768 + (db * 2 + s) * 512);
    }
#pragma unroll
    for (int qb = 0; qb < 2; ++qb) { const float inv = fast_rcp(plswap_add(lrow[qb]));
        bf16_t* op = O + (row0 + qb * 32 + r32) * DM + h * 64 + 8 * hi;
#pragma unroll
        for (int db = 0; db < 2; ++db)
#pragma unroll
            for (int s = 0; s < 2; ++s) { u32x4 w;
                w.x = cvtpk(o[db][qb][8 * s] * inv, o[db][qb][8 * s + 1] * inv); w.y = cvtpk(o[db][qb][8 * s + 2] * inv, o[db][qb][8 * s + 3] * inv);
                w.z = cvtpk(o[db][qb][8 * s + 4] * inv, o[db][qb][8 * s + 5] * inv); w.w = cvtpk(o[db][qb][8 * s + 6] * inv, o[db][qb][8 * s + 7] * inv);
                *(u32x4*)(op + 32 * db + 16 * s) = w; } }
}

constexpr int AS_P = 45056;
__device__ __forceinline__ void attn_sample_task(LAS unsigned char* lds, int wave, int lane, int task) {
    const int bs = task >> 6, h = (task >> 2) & 15, qg = task & 3;
    const bf16_t* Q = (const bf16_t*)(A_WS + WS_Q); bf16_t* O = (bf16_t*)(A_WS + WS_XN);
    const float* ck = A_IN(2); const float* cv = A_IN(3); const float* kn = A_OUT + O_KS; const float* vn = A_OUT + O_VS;
    LAS float* pb = (LAS float*)(lds + AS_P + wave * 9472);
    LAS float* qs = pb + 4 * 528;
    const LAS float* tab = (const LAS float*)(lds + AT_TAB) + h * 320;
#pragma unroll
    for (int i = 0; i < 4; ++i) qs[i * 64 + lane] = bflo((unsigned)Q[((size_t)NTP + bs * 16 + qg * 4 + i) * DM + h * 64 + lane]);
    asm volatile("s_waitcnt lgkmcnt(0)" ::: "memory");
#pragma unroll 1
    for (int it = 0; it < 9; ++it) {
        const int key = it * 64 + lane; const bool valid = key < 528;
        const float* kp = !valid ? ck : (key < 512 ? ck + (((size_t)bs * 512 + key) * 16 + h) * 64 : kn + ((size_t)bs * 16 + (key - 512)) * DM + h * 64);
        float d[4] = {0.f, 0.f, 0.f, 0.f};
        f32x4 kv[16];
#pragma unroll
        for (int d4 = 0; d4 < 16; ++d4) kv[d4] = *(const f32x4*)(kp + 4 * d4);
#pragma unroll
        for (int d4 = 0; d4 < 16; ++d4) {
#pragma unroll
            for (int i = 0; i < 4; ++i) { const f32x4 qq = *(const LAS f32x4*)(qs + i * 64 + 4 * d4); d[i] += (kv[d4][0] * qq[0] + kv[d4][1] * qq[1]) + (kv[d4][2] * qq[2] + kv[d4][3] * qq[3]); } }
        int rel = 512 + qg * 4 - key;
        if (valid) {
#pragma unroll
            for (int i = 0; i < 4; ++i) { int r = rel + i; r = r > 128 ? 128 : r; pb[i * 528 + key] = d[i] + tab[r + 128]; } }
    }
    asm volatile("s_waitcnt lgkmcnt(0)" ::: "memory");
#pragma unroll 1
    for (int i = 0; i < 4; ++i) {
        float mx = -1e30f;
#pragma unroll 1
        for (int key = lane; key < 528; key += 64) mx = fmaxf(mx, pb[i * 528 + key]);
#pragma unroll
        for (int o = 1; o < 64; o <<= 1) mx = fmaxf(mx, __shfl_xor(mx, o));
        float sum = 0.f;
#pragma unroll 1
        for (int key = lane; key < 528; key += 64) { const float pv = fast_exp2(pb[i * 528 + key] - mx); pb[i * 528 + key] = pv; sum += pv; }
        sum = wave_sum(sum); const float inv = 1.0f / sum;
#pragma unroll 1
        for (int key = lane; key < 528; key += 64) pb[i * 528 + key] *= inv;
    }
    asm volatile("s_waitcnt lgkmcnt(0)" ::: "memory");
    float acc[4] = {0.f, 0.f, 0.f, 0.f};
#pragma unroll 1
    for (int k0 = 0; k0 < 528; k0 += 16) {
        float vv[16];
#pragma unroll
        for (int kk = 0; kk < 16; ++kk) { const int key = k0 + kk; vv[kk] = k0 < 512 ? cv[(((size_t)bs * 512 + key) * 16 + h) * 64 + lane] : vn[((size_t)bs * 16 + (key - 512)) * DM + h * 64 + lane]; }
#pragma unroll
        for (int kk = 0; kk < 16; ++kk) {
#pragma unroll
            for (int i = 0; i < 4; ++i) acc[i] += pb[i * 528 + k0 + kk] * vv[kk]; }
    }
#pragma unroll
    for (int i = 0; i < 4; ++i) O[((size_t)NTP + bs * 16 + qg * 4 + i) * DM + h * 64 + lane] = (bf16_t)(cvtpk(acc[i], 0.f) & 0xffffu);
    asm volatile("s_waitcnt lgkmcnt(0)" ::: "memory");
}

__device__ __forceinline__ void p2_phase(LAS unsigned char* lds, int G, int tid, int wave, int lane) {
    for (int i = tid; i < 16 * 320; i += 512) { const int h = i / 320, j = i % 320; ((LAS float*)(lds + AT_TAB))[i] = A_IN(8)[h * 257 + (j > 256 ? 256 : j)] * LOG2E; }
    for (int u = blockIdx.x; u < 256 + 16; u += G) {
        __syncthreads();
        if (u < 256) {
            const int b = u >> 4, g = u & 15;
            lru_load_consts(lds, g, tid);
            __syncthreads();
            for (int tile = wave; tile < 128; tile += 8) lru_tile<false>(lds, lane, g, (size_t)b * SEQ, tile, b);
        } else {
            const int g = u - 256;
            lru_load_consts(lds, g, tid);
            __syncthreads();
            lru_tile<true>(lds, lane, g, (size_t)NTP + wave * 16, 0, wave);
        }
    }
    if (tid == 0) *(volatile LAS int*)(lds + P2_Q) = 0;
    __syncthreads();
    const int NGW = G * 8;
    int nS = 0; for (int t = blockIdx.x; t < 512; t += G) ++nS;
    for (;;) {
        int j = 0;
        if (lane == 0) j = __hip_atomic_fetch_add((LAS int*)(lds + P2_Q), 1, __ATOMIC_RELAXED, __HIP_MEMORY_SCOPE_WORKGROUP);
        j = __builtin_amdgcn_readfirstlane(j);
        if (j < nS) { attn_sample_task(lds, wave, lane, blockIdx.x + G * j); continue; }
        j -= nS;
        const int u = blockIdx.x * 8 + (j & 7) + NGW * (j >> 3);
        if (u >= NB * 64 * 16) break;
        const int c = u & 63, h = (u >> 6) & 15, b = u >> 10;
        attn_unit(lds, lane, b, c, h);
    }
}

__device__ __forceinline__ void p4b_phase(int G, int wave, int lane) {
    const int gw = blockIdx.x * 8 + wave, NGW = G * 8;
    for (int n = gw; n < 2048; n += NGW) {
        const bf16_t* wr_ = (const bf16_t*)(A_WS + WS_WS) + (size_t)n * DM + lane * 16;
        const u32x4 a = *(const u32x4*)wr_, b = *(const u32x4*)(wr_ + 8);
        float f[16]; f[0] = bflo(a.x); f[1] = bfhi(a.x); f[2] = bflo(a.y); f[3] = bfhi(a.y); f[4] = bflo(a.z); f[5] = bfhi(a.z); f[6] = bflo(a.w); f[7] = bfhi(a.w);
        f[8] = bflo(b.x); f[9] = bfhi(b.x); f[10] = bflo(b.y); f[11] = bfhi(b.y); f[12] = bflo(b.z); f[13] = bfhi(b.z); f[14] = bflo(b.w); f[15] = bfhi(b.w);
        float mx = 0.f;
#pragma unroll
        for (int j = 0; j < 16; ++j) mx = fmaxf(mx, fabsf(f[j]));
#pragma unroll
        for (int o = 1; o < 64; o <<= 1) mx = fmaxf(mx, __shfl_xor(mx, o));
        const float step = fmaxf(mx, 1e-30f) * (1.0f / 127.0f), qi = 1.0f / step;
        u32x4 w;
#pragma unroll
        for (int q = 0; q < 4; ++q) w[q] = ((unsigned)(int)rintf(f[4 * q] * qi) & 0xffu) | (((unsigned)(int)rintf(f[4 * q + 1] * qi) & 0xffu) << 8) | (((unsigned)(int)rintf(f[4 * q + 2] * qi) & 0xffu) << 16) | (((unsigned)(int)rintf(f[4 * q + 3] * qi) & 0xffu) << 24);
        *(u32x4*)(A_WS + WS_WSQ + (size_t)n * DM + lane * 16) = w;
        if (lane == 0) ((float*)(A_WS + WS_SW))[n] = step;
    }
    const float* gm = A_IN(19); bf16_t* XT = (bf16_t*)(A_WS + WS_Q); unsigned char* XQ = A_WS + WS_XQ; float* SX = (float*)(A_WS + WS_SX);
    const bf16_t* DL = (const bf16_t*)(A_WS + WS_DELTA);
    f32x4 v[4], vn[4];
    if (gw < NTOK) { row_ld(xrow_ptr(gw), v, lane); row_add_bf16(DL + (size_t)gw * DM, v, lane); }
    for (int m = gw; m < NTOK; m += NGW) {
        const int mn = m + NGW;
        if (mn < NTOK) { row_ld(xrow_ptr(mn), vn, lane); row_add_bf16(DL + (size_t)mn * DM, vn, lane); }
        bf16_t* orow = XT + (size_t)m * DM;
        const float inv = 1.0f / sqrtf(wave_sum(row_ss(v)) * (1.0f / DM) + EPS);
        float mx = 0.f;
#pragma unroll
        for (int j = 0; j < 4; ++j) { const f32x4 gg = *(const f32x4*)(gm + j * 256 + lane * 4); v[j] = v[j] * inv * gg;
            if (m >= NTP) { u32x2 w; w.x = cvtpk(v[j][0], v[j][1]); w.y = cvtpk(v[j][2], v[j][3]); *(u32x2*)(orow + j * 256 + lane * 4) = w; }
            mx = fmaxf(mx, fmaxf(fmaxf(fabsf(v[j][0]), fabsf(v[j][1])), fmaxf(fabsf(v[j][2]), fabsf(v[j][3])))); }
#pragma unroll
        for (int o = 1; o < 64; o <<= 1) mx = fmaxf(mx, __shfl_xor(mx, o));
        const float step = fmaxf(mx, 1e-30f) * (1.0f / 127.0f), qi = 1.0f / step;
#pragma unroll
        for (int j = 0; j < 4; ++j) {
            const unsigned b0 = (unsigned)(int)rintf(v[j][0] * qi) & 0xffu, b1 = (unsigned)(int)rintf(v[j][1] * qi) & 0xffu, b2 = (unsigned)(int)rintf(v[j][2] * qi) & 0xffu, b3 = (unsigned)(int)rintf(v[j][3] * qi) & 0xffu;
            *(unsigned*)(XQ + (size_t)m * DM + j * 256 + lane * 4) = b0 | (b1 << 8) | (b2 << 16) | (b3 << 24); }
        if (lane == 0) SX[m] = step;
#pragma unroll
        for (int j = 0; j < 4; ++j) v[j] = vn[j];
    }
}

__device__ __forceinline__ int f2key(float f) { const int b = __float_as_int(f); return b ^ ((b >> 31) & 0x7fffffff); }
__device__ __forceinline__ float key2f(int k) { return __int_as_float(k ^ ((k >> 31) & 0x7fffffff)); }
#define CE_DESC(x, y) do { const int hi_ = max(x, y); y = min(x, y); x = hi_; } while (0)
#define CE_ASC(x, y)  do { const int lo_ = min(x, y); y = max(x, y); x = lo_; } while (0)
__device__ __forceinline__ void bitonic_sort16_desc(int (&a)[16]) {
#pragma unroll
    for (int k = 2; k <= 16; k <<= 1)
#pragma unroll
        for (int j = k >> 1; j > 0; j >>= 1)
#pragma unroll
            for (int i = 0; i < 16; ++i) { const int l = i ^ j; if (l > i) { if ((i & k) == 0) CE_DESC(a[i], a[l]); else CE_ASC(a[i], a[l]); } }
}
__device__ __forceinline__ void bitonic_merge16_desc(int (&a)[16]) {
#pragma unroll
    for (int j = 8; j > 0; j >>= 1)
#pragma unroll
        for (int i = 0; i < 16; ++i) { const int l = i ^ j; if (l > i) CE_DESC(a[i], a[l]); }
}
__device__ __forceinline__ void top16_merge(int (&T)[16], const int (&S)[16]) {
#pragma unroll
    for (int i = 0; i < 16; ++i) T[i] = max(T[i], S[15 - i]);
    bitonic_merge16_desc(T);
}
#define INS16(L, x) do { int x_ = (x); _Pragma("unroll") for (int j_ = 0; j_ < 16; ++j_) { const int hi_ = max(L[j_], x_); x_ = min(L[j_], x_); L[j_] = hi_; } } while (0)

constexpr size_t WS_PART = WS_XN;
constexpr int CT_U = 64, CT_V = 64 + 8 * 64;
constexpr int P6_TOKB = 128, P6_NITEM = NTOK / P6_TOKB, P6_TPW = P6_TOKB / 8;
constexpr size_t WS_CQ = WS_XR, WS_CS = WS_XR + 16 * MiB;
constexpr int P6_IDX = 0;
constexpr int P6_E = 0, P6_C = 8192, P6_ITEM = 49152, P6_E8 = 0, P6_C8 = 32768;

__device__ __forceinline__ void p6a_phase(LAS unsigned char* lds, int G, int wave, int lane) {
    const int gw = blockIdx.x * 8 + wave, NGW = G * 8;
    const bf16_t* SC = (const bf16_t*)(A_WS + WS_XN);
    unsigned short* SELE = (unsigned short*)(A_WS + WS_SELE); float* SELG = (float*)(A_WS + WS_SELG);
    LAS int* idxb = (LAS int*)(lds + P6_IDX + wave * 4096);
    const int tl = lane >> 4, hh = (lane >> 1) & 7, half = lane & 1;
    for (int grp = gw; grp < NTOK / 4; grp += NGW) {
        const int tok = grp * 4 + tl;
        const bf16_t* sp = SC + (size_t)tok * 2048 + (lane & 15);
        int L[16];
#pragma unroll
        for (int j = 0; j < 16; ++j) L[j] = (int)0x80000000;
        {
            float sa[16], sb_[16];
#pragma unroll
            for (int e = 0; e < 16; ++e) sa[e] = bflo((unsigned)sp[16 * e]);
#pragma unroll
            for (int c0 = 0; c0 < 128; c0 += 32) {
#pragma unroll
                for (int e = 0; e < 16; ++e) sb_[e] = bflo((unsigned)sp[16 * (c0 + 16 + e)]);
                { int S[16];
#pragma unroll
                  for (int e = 0; e < 16; ++e) S[e] = (f2key(sa[e]) & ~127) | (c0 + e);
                  bitonic_sort16_desc(S);
                  if (c0 == 0) {
#pragma unroll
                      for (int e = 0; e < 16; ++e) L[e] = S[e]; } else top16_merge(L, S); }
                if (c0 + 32 < 128) {
#pragma unroll
                    for (int e = 0; e < 16; ++e) sa[e] = bflo((unsigned)sp[16 * (c0 + 32 + e)]); }
                { int S[16];
#pragma unroll
                  for (int e = 0; e < 16; ++e) S[e] = (f2key(sb_[e]) & ~127) | (c0 + 16 + e);
                  bitonic_sort16_desc(S);
                  top16_merge(L, S); }
            }
        }
#pragma unroll
        for (int j = 0; j < 16; ++j) idxb[lane * 16 + j] = L[j] & 127;
        float va[16], vb[16];
#pragma unroll
        for (int j = 0; j < 16; ++j) { const int own = L[j] & ~127, oth = __shfl_xor(own, 1); va[j] = key2f(half ? oth : own); vb[j] = key2f(half ? own : oth); }
        int C[16];
#pragma unroll
        for (int j = 0; j < 16; ++j) C[j] = (int)0x80000000;
        {   int S[16];
            S[0] = (f2key(va[0] + vb[0]) & ~255) | 0;
            S[1] = (f2key(va[0] + vb[1]) & ~255) | 1;
            S[2] = (f2key(va[0] + vb[2]) & ~255) | 2;
            S[3] = (f2key(va[0] + vb[3]) & ~255) | 3;
            S[4] = (f2key(va[0] + vb[4]) & ~255) | 4;
            S[5] = (f2key(va[0] + vb[5]) & ~255) | 5;
            S[6] = (f2key(va[0] + vb[6]) & ~255) | 6;
            S[7] = (f2key(va[0] + vb[7]) & ~255) | 7;
            S[8] = (f2key(va[0] + vb[8]) & ~255) | 8;
            S[9] = (f2key(va[0] + vb[9]) & ~255) | 9;
            S[10] = (f2key(va[0] + vb[10]) & ~255) | 10;
            S[11] = (f2key(va[0] + vb[11]) & ~255) | 11;
            S[12] = (f2key(va[0] + vb[12]) & ~255) | 12;
            S[13] = (f2key(va[0] + vb[13]) & ~255) | 13;
            S[14] = (f2key(va[0] + vb[14]) & ~255) | 14;
            S[15] = (f2key(va[0] + vb[15]) & ~255) | 15;
            bitonic_sort16_desc(S);
#pragma unroll
            for (int q = 0; q < 16; ++q) C[q] = S[q]; }
        {   int S[16];
            S[0] = (f2key(va[1] + vb[0]) & ~255) | 16;
            S[1] = (f2key(va[1] + vb[1]) & ~255) | 17;
            S[2] = (f2key(va[1] + vb[2]) & ~255) | 18;
            S[3] = (f2key(va[1] + vb[3]) & ~255) | 19;
            S[4] = (f2key(va[1] + vb[4]) & ~255) | 20;
            S[5] = (f2key(va[1] + vb[5]) & ~255) | 21;
            S[6] = (f2key(va[1] + vb[6]) & ~255) | 22;
            S[7] = (f2key(va[1] + vb[7]) & ~255) | 23;
            S[8] = (f2key(va[2] + vb[0]) & ~255) | 32;
            S[9] = (f2key(va[2] + vb[1]) & ~255) | 33;
            S[10] = (f2key(va[2] + vb[2]) & ~255) | 34;
            S[11] = (f2key(va[2] + vb[3]) & ~255) | 35;
            S[12] = (f2key(va[2] + vb[4]) & ~255) | 36;
            S[13] = (f2key(va[3] + vb[0]) & ~255) | 48;
            S[14] = (f2key(va[3] + vb[1]) & ~255) | 49;
            S[15] = (f2key(va[3] + vb[2]) & ~255) | 50;
            bitonic_sort16_desc(S);
            top16_merge(C, S); }
        {   int S[16];
            S[0] = (f2key(va[3] + vb[3]) & ~255) | 51;
            S[1] = (f2key(va[4] + vb[0]) & ~255) | 64;
            S[2] = (f2key(va[4] + vb[1]) & ~255) | 65;
            S[3] = (f2key(va[4] + vb[2]) & ~255) | 66;
            S[4] = (f2key(va[5] + vb[0]) & ~255) | 80;
            S[5] = (f2key(va[5] + vb[1]) & ~255) | 81;
            S[6] = (f2key(va[6] + vb[0]) & ~255) | 96;
            S[7] = (f2key(va[6] + vb[1]) & ~255) | 97;
            S[8] = (f2key(va[7] + vb[0]) & ~255) | 112;
            S[9] = (f2key(va[7] + vb[1]) & ~255) | 113;
            S[10] = (f2key(va[8] + vb[0]) & ~255) | 128;
            S[11] = (f2key(va[9] + vb[0]) & ~255) | 144;
            S[12] = (f2key(va[10] + vb[0]) & ~255) | 160;
            S[13] = (f2key(va[11] + vb[0]) & ~255) | 176;
            S[14] = (f2key(va[12] + vb[0]) & ~255) | 192;
            S[15] = (f2key(va[13] + vb[0]) & ~255) | 208;
            bitonic_sort16_desc(S);
            top16_merge(C, S); }
        {   int S[16];
            S[0] = (f2key(va[14] + vb[0]) & ~255) | 224;
            S[1] = (f2key(va[15] + vb[0]) & ~255) | 240;
            S[2] = (int)0x80000000;
            S[3] = (int)0x80000000;
            S[4] = (int)0x80000000;
            S[5] = (int)0x80000000;
            S[6] = (int)0x80000000;
            S[7] = (int)0x80000000;
            S[8] = (int)0x80000000;
            S[9] = (int)0x80000000;
            S[10] = (int)0x80000000;
            S[11] = (int)0x80000000;
            S[12] = (int)0x80000000;
            S[13] = (int)0x80000000;
            S[14] = (int)0x80000000;
            S[15] = (int)0x80000000;
            bitonic_sort16_desc(S);
            top16_merge(C, S); }
        const float mx = key2f(C[0] & ~255);
        float ev[16], sum = 0.f;
#pragma unroll
        for (int j = 0; j < 16; ++j) { ev[j] = __expf(key2f(C[j] & ~255) - mx); sum += ev[j]; }
        const float inv = 1.0f / sum;
        asm volatile("s_waitcnt lgkmcnt(0)" ::: "memory");
        int eo[8]; float go[8];
#pragma unroll
        for (int s = 0; s < 8; ++s) {
            int c_lo = C[s], c_hi = C[8 + s]; float e_lo = ev[s], e_hi = ev[8 + s];
            asm volatile("" : "+v"(c_lo), "+v"(c_hi), "+v"(e_lo), "+v"(e_hi));
            const int cc = half ? c_hi : c_lo; go[s] = (half ? e_hi : e_lo) * inv;
            const int ij = cc & 255, i1 = idxb[(lane & ~1) * 16 + (ij >> 4)], i2 = idxb[(lane | 1) * 16 + (ij & 15)];
            eo[s] = i1 * 128 + i2;
        }
        unsigned short* ep = SELE + (size_t)tok * 128 + hh * 16 + half * 8; float* gp = SELG + (size_t)tok * 128 + hh * 16 + half * 8;
        *(u32x4*)ep = (u32x4){(unsigned)eo[0] | ((unsigned)eo[1] << 16), (unsigned)eo[2] | ((unsigned)eo[3] << 16), (unsigned)eo[4] | ((unsigned)eo[5] << 16), (unsigned)eo[6] | ((unsigned)eo[7] << 16)};
        *(f32x4*)gp = (f32x4){go[0], go[1], go[2], go[3]}; *(f32x4*)(gp + 4) = (f32x4){go[4], go[5], go[6], go[7]};
        asm volatile("s_waitcnt lgkmcnt(0)" ::: "memory");
    }
}

__device__ __forceinline__ float dot2bf(unsigned a, unsigned b, float c) { return __builtin_amdgcn_fdot2_f32_bf16(__builtin_bit_cast(bf16x2_t, a), __builtin_bit_cast(bf16x2_t, b), c, false); }
__device__ __forceinline__ unsigned xcc_id() { return (unsigned)__builtin_amdgcn_s_getreg((3 << 11) | 20) & 0xFu; }
__device__ __forceinline__ float dpp_sum16(float v) {
    v += __builtin_bit_cast(float, __builtin_amdgcn_update_dpp(0, __builtin_bit_cast(int, v), 0xB1, 0xF, 0xF, true));
    v += __builtin_bit_cast(float, __builtin_amdgcn_update_dpp(0, __builtin_bit_cast(int, v), 0x4E, 0xF, 0xF, true));
    v += __builtin_bit_cast(float, __builtin_amdgcn_update_dpp(0, __builtin_bit_cast(int, v), 0x141, 0xF, 0xF, true));
    v += __builtin_bit_cast(float, __builtin_amdgcn_update_dpp(0, __builtin_bit_cast(int, v), 0x140, 0xF, 0xF, true));
    return v;
}
__device__ __forceinline__ bool p6_claim(LAS unsigned char* lds, unsigned* cnt, int tid, int& ring, int home, int& slice, int& item) {
    for (;;) {
        if (ring >= 8) return false;
        slice = (home + ring) & 7;
        __syncthreads();
        if (tid == 0) *(volatile LAS int*)(lds + P6_ITEM) = (int)__hip_atomic_fetch_add(cnt + 64 * slice, 1u, __ATOMIC_RELAXED, __HIP_MEMORY_SCOPE_AGENT);
        __syncthreads();
        item = *(volatile LAS int*)(lds + P6_ITEM);
        if (item < P6_NITEM) return true;
        ++ring;
    }
}

__device__ __forceinline__ float ub0(unsigned w) { return (float)(w & 0xffu); }
__device__ __forceinline__ float ub1(unsigned w) { return (float)((w >> 8) & 0xffu); }
__device__ __forceinline__ float ub2(unsigned w) { return (float)((w >> 16) & 0xffu); }
__device__ __forceinline__ float ub3(unsigned w) { return (float)(w >> 24); }
__device__ __forceinline__ float dpp_sum8(float v) {
    v += __builtin_bit_cast(float, __builtin_amdgcn_update_dpp(0, __builtin_bit_cast(int, v), 0xB1, 0xF, 0xF, true));
    v += __builtin_bit_cast(float, __builtin_amdgcn_update_dpp(0, __builtin_bit_cast(int, v), 0x4E, 0xF, 0xF, true));
    v += __builtin_bit_cast(float, __builtin_amdgcn_update_dpp(0, __builtin_bit_cast(int, v), 0x141, 0xF, 0xF, true));
    return v;
}
__device__ __forceinline__ int dpp_isum8(int v) {
    v += __builtin_amdgcn_update_dpp(0, v, 0xB1, 0xF, 0xF, true);
    v += __builtin_amdgcn_update_dpp(0, v, 0x4E, 0xF, 0xF, true);
    v += __builtin_amdgcn_update_dpp(0, v, 0x141, 0xF, 0xF, true);
    return v;
}
__device__ __forceinline__ void p6b_phase(LAS unsigned char* lds, int tid, int wave, int lane) {
    const unsigned char* XQ = A_WS + WS_XQ; const unsigned char* UB = A_WS + WS_UB; const float* SX = (const float*)(A_WS + WS_SX);
    const unsigned short* SELE = (const unsigned short*)(A_WS + WS_SELE); bf16_t* PART = (bf16_t*)(A_WS + WS_PART);
    unsigned* cnt = (unsigned*)(A_WS + WS_CTL) + CT_U;
    const int i8 = lane & 7, grp = lane >> 3, home = (int)(xcc_id() & 7u);
    LAS int* eb = (LAS int*)(lds + P6_E8 + wave * 4096);
    int ring = 0, slice, item;
    while (p6_claim(lds, cnt, tid, ring, home, slice, item)) {
        const int tok0 = item * P6_TOKB + wave * P6_TPW;
        u32x4 le[2], xqn; float sxn;
        { const int tk = tok0 + grp;
#pragma unroll
          for (int q = 0; q < 2; ++q) le[q] = *(const u32x4*)(SELE + (size_t)tk * 128 + i8 * 16 + 8 * q);
          xqn = *(const u32x4*)(XQ + (size_t)tk * DM + slice * 128 + i8 * 16); sxn = SX[tk]; }
#pragma unroll 1
        for (int tb = 0; tb < P6_TPW; tb += 8) {
            const int tok = tok0 + tb + grp;
#pragma unroll
            for (int q = 0; q < 2; ++q) *(LAS u32x4*)(eb + grp * 64 + i8 * 8 + 4 * q) = le[q];
            const int x0 = (int)xqn.x, x1 = (int)xqn.y, x2 = (int)xqn.z, x3 = (int)xqn.w; const float sx = sxn;
            if (tb + 8 < P6_TPW) { const int tk = tok + 8;
#pragma unroll
                for (int q = 0; q < 2; ++q) le[q] = *(const u32x4*)(SELE + (size_t)tk * 128 + i8 * 16 + 8 * q);
                xqn = *(const u32x4*)(XQ + (size_t)tk * DM + slice * 128 + i8 * 16); sxn = SX[tk]; }
            const unsigned char* ub = UB + slice * 128 + i8 * 16;
            asm volatile("s_waitcnt lgkmcnt(0)" ::: "memory");
            int res[16];
#pragma unroll
            for (int j = 0; j < 16; ++j) res[j] = 0;
#pragma unroll
            for (int s16 = 0; s16 < 128; s16 += 16) {
                u32x4 uv[16]; u32x4 e4[2];
#pragma unroll
                for (int a4 = 0; a4 < 2; ++a4) e4[a4] = *(const LAS u32x4*)(eb + grp * 64 + (s16 >> 1) + 4 * a4);
#pragma unroll
                for (int a4 = 0; a4 < 2; ++a4)
#pragma unroll
                    for (int j = 0; j < 4; ++j) { const unsigned w = e4[a4][j];
                        uv[8 * a4 + 2 * j] = *(const u32x4*)(ub + (size_t)(w & 0xffffu) * DM); uv[8 * a4 + 2 * j + 1] = *(const u32x4*)(ub + (size_t)(w >> 16) * DM); }
#pragma unroll
                for (int q = 0; q < 16; ++q) {
                    const int a0 = (int)uv[q].x, a1 = (int)uv[q].y, a2 = (int)uv[q].z, a3 = (int)uv[q].w;
                    int d = __builtin_amdgcn_sdot4(a0, x0, 0, false); d = __builtin_amdgcn_sdot4(a1, x1, d, false); d = __builtin_amdgcn_sdot4(a2, x2, d, false); d = __builtin_amdgcn_sdot4(a3, x3, d, false);
                    d = dpp_isum8(d);
                    const int sidx = s16 + q;
                    res[sidx >> 3] = (i8 == (sidx & 7)) ? d : res[sidx >> 3];
                }
            }
            bf16_t* pp = PART + ((size_t)slice * NTOK + tok) * 128 + 16 * i8;
#pragma unroll
            for (int q = 0; q < 2; ++q) { u32x4 w;
                w.x = cvtpk((float)res[8 * q] * sx, (float)res[8 * q + 1] * sx); w.y = cvtpk((float)res[8 * q + 2] * sx, (float)res[8 * q + 3] * sx);
                w.z = cvtpk((float)res[8 * q + 4] * sx, (float)res[8 * q + 5] * sx); w.w = cvtpk((float)res[8 * q + 6] * sx, (float)res[8 * q + 7] * sx);
                *(u32x4*)(pp + 8 * q) = w; }
            asm volatile("s_waitcnt lgkmcnt(0)" ::: "memory");
        }
    }
}

__device__ __forceinline__ void p6m_phase(int G, int wave, int lane) {
    const int gw = blockIdx.x * 8 + wave, NGW = G * 8;
    const float* SU = (const float*)(A_WS + WS_SU); const float* SV = (const float*)(A_WS + WS_SV);
    const unsigned short* SELE = (const unsigned short*)(A_WS + WS_SELE); const float* SELG = (const float*)(A_WS + WS_SELG); const bf16_t* PART = (const bf16_t*)(A_WS + WS_PART);
    unsigned char* CQ = A_WS + WS_CQ; float* CS = (float*)(A_WS + WS_CS);
    const int k0 = 8 * ((2 * lane) & 15) + (lane >> 3), k1 = k0 + 8;
    for (int tok = gw; tok < NTOK; tok += NGW) {
        float a0 = 0.f, a1 = 0.f;
#pragma unroll
        for (int j = 0; j < 8; ++j) { const unsigned w = ((const unsigned*)(PART + ((size_t)j * NTOK + tok) * 128))[lane]; a0 += bflo(w); a1 += bfhi(w); }
        const int e0 = SELE[(size_t)tok * 128 + k0], e1 = SELE[(size_t)tok * 128 + k1];
        const float c0 = SELG[(size_t)tok * 128 + k0] * gelu_tanh(a0 * SU[e0]) * SV[e0], c1 = SELG[(size_t)tok * 128 + k1] * gelu_tanh(a1 * SU[e1]) * SV[e1];
        float mx = fmaxf(fabsf(c0), fabsf(c1));
#pragma unroll
        for (int o = 1; o < 64; o <<= 1) mx = fmaxf(mx, __shfl_xor(mx, o));
        const float cstep = fmaxf(mx, 1e-30f) * (1.0f / 127.0f), cinv = 1.0f / cstep;
        CQ[(size_t)tok * 128 + k0] = (unsigned char)((int)rintf(c0 * cinv) & 0xff); CQ[(size_t)tok * 128 + k1] = (unsigned char)((int)rintf(c1 * cinv) & 0xff);
        if (lane == 0) CS[tok] = cstep;
    }
}

__device__ __forceinline__ void p6c_phase(LAS unsigned char* lds, int tid, int wave, int lane) {
    const unsigned char* VB = A_WS + WS_VB; const unsigned short* SELE = (const unsigned short*)(A_WS + WS_SELE);
    const unsigned char* CQ = A_WS + WS_CQ; const float* CS = (const float*)(A_WS + WS_CS);
    unsigned* cnt = (unsigned*)(A_WS + WS_CTL) + CT_V;
    const int i8 = lane & 7, grp = lane >> 3, home = (int)(xcc_id() & 7u);
    LAS int* eb = (LAS int*)(lds + P6_E8 + wave * 4096);
    LAS int* cbb = (LAS int*)(lds + P6_C8 + wave * 1024);
    int ring = 0, slice, item;
    while (p6_claim(lds, cnt, tid, ring, home, slice, item)) {
        const int tok0 = item * P6_TOKB + wave * P6_TPW;
        u32x4 le[2], lc; float cstep;
        { const int tk = tok0 + grp;
#pragma unroll
          for (int q = 0; q < 2; ++q) le[q] = *(const u32x4*)(SELE + (size_t)tk * 128 + i8 * 16 + 8 * q);
          lc = *(const u32x4*)(CQ + (size_t)tk * 128 + i8 * 16); cstep = CS[tk]; }
#pragma unroll 1
        for (int tb = 0; tb < P6_TPW; tb += 8) {
            const int tok = tok0 + tb + grp;
#pragma unroll
            for (int q = 0; q < 2; ++q) *(LAS u32x4*)(eb + grp * 64 + i8 * 8 + 4 * q) = le[q];
            *(LAS u32x4*)(cbb + grp * 32 + i8 * 4) = lc;
            const float cs = cstep;
            if (tb + 8 < P6_TPW) { const int tk = tok + 8;
#pragma unroll
                for (int q = 0; q < 2; ++q) le[q] = *(const u32x4*)(SELE + (size_t)tk * 128 + i8 * 16 + 8 * q);
                lc = *(const u32x4*)(CQ + (size_t)tk * 128 + i8 * 16); cstep = CS[tk]; }
            const unsigned char* vb = VB + slice * 128 + i8 * 16;
            asm volatile("s_waitcnt lgkmcnt(0)" ::: "memory");
            int acc[16];
#pragma unroll
            for (int r = 0; r < 16; ++r) acc[r] = 0;
#pragma unroll 1
            for (int s16 = 0; s16 < 128; s16 += 16) {
                u32x4 vv[16]; u32x4 e4[2];
#pragma unroll
                for (int a4 = 0; a4 < 2; ++a4) e4[a4] = *(const LAS u32x4*)(eb + grp * 64 + (s16 >> 1) + 4 * a4);
                const u32x4 cq4 = *(const LAS u32x4*)(cbb + grp * 32 + (s16 >> 2));
#pragma unroll
                for (int a4 = 0; a4 < 2; ++a4)
#pragma unroll
                    for (int j = 0; j < 4; ++j) { const unsigned w = e4[a4][j];
                        vv[8 * a4 + 2 * j] = *(const u32x4*)(vb + (size_t)(w & 0xffffu) * DM); vv[8 * a4 + 2 * j + 1] = *(const u32x4*)(vb + (size_t)(w >> 16) * DM); }
#pragma unroll
                for (int a4 = 0; a4 < 4; ++a4) {
                    const int cq = (int)cq4[a4];
#pragma unroll
                    for (int d = 0; d < 4; ++d) {
                        const unsigned ra = vv[4 * a4][d], rb = vv[4 * a4 + 1][d], rc = vv[4 * a4 + 2][d], rd = vv[4 * a4 + 3][d];
                        const unsigned lo = __builtin_amdgcn_perm(rb, ra, 0x05010400u), hi = __builtin_amdgcn_perm(rb, ra, 0x07030602u);
                        const unsigned lo2 = __builtin_amdgcn_perm(rd, rc, 0x05010400u), hi2 = __builtin_amdgcn_perm(rd, rc, 0x07030602u);
                        const unsigned t0 = __builtin_amdgcn_perm(lo2, lo, 0x05040100u), t1 = __builtin_amdgcn_perm(lo2, lo, 0x07060302u);
                        const unsigned t2 = __builtin_amdgcn_perm(hi2, hi, 0x05040100u), t3 = __builtin_amdgcn_perm(hi2, hi, 0x07060302u);
                        acc[4 * d + 0] = __builtin_amdgcn_sdot4((int)t0, cq, acc[4 * d + 0], false); acc[4 * d + 1] = __builtin_amdgcn_sdot4((int)t1, cq, acc[4 * d + 1], false);
                        acc[4 * d + 2] = __builtin_amdgcn_sdot4((int)t2, cq, acc[4 * d + 2], false); acc[4 * d + 3] = __builtin_amdgcn_sdot4((int)t3, cq, acc[4 * d + 3], false);
                    }
                }
            }
            bf16_t* pr = (bf16_t*)(A_WS + WS_PEER) + (size_t)tok * DM + slice * 128 + i8 * 16;
            u32x4 w0, w1;
            w0.x = cvtpk((float)acc[0] * cs, (float)acc[1] * cs); w0.y = cvtpk((float)acc[2] * cs, (float)acc[3] * cs); w0.z = cvtpk((float)acc[4] * cs, (float)acc[5] * cs); w0.w = cvtpk((float)acc[6] * cs, (float)acc[7] * cs);
            w1.x = cvtpk((float)acc[8] * cs, (float)acc[9] * cs); w1.y = cvtpk((float)acc[10] * cs, (float)acc[11] * cs); w1.z = cvtpk((float)acc[12] * cs, (float)acc[13] * cs); w1.w = cvtpk((float)acc[14] * cs, (float)acc[15] * cs);
            *(u32x4*)pr = w0; *(u32x4*)(pr + 8) = w1;
            asm volatile("s_waitcnt lgkmcnt(0)" ::: "memory");
        }
    }
}

__device__ __forceinline__ void p6d_phase(int G, int wave, int lane) {
    const int gw = blockIdx.x * 8 + wave, NGW = G * 8;
    const float* gf = A_IN(25);
    const bf16_t* DL = (const bf16_t*)(A_WS + WS_DELTA); const bf16_t* PR = (const bf16_t*)(A_WS + WS_PEER);
    f32x4 v[4], vn[4];
    if (gw < NTOK) { row_ld(xrow_ptr(gw), v, lane); row_add_bf16(DL + (size_t)gw * DM, v, lane); row_add_bf16(PR + (size_t)gw * DM, v, lane); }
    for (int m = gw; m < NTOK; m += NGW) {
        const int mn = m + NGW;
        if (mn < NTOK) { row_ld(xrow_ptr(mn), vn, lane); row_add_bf16(DL + (size_t)mn * DM, vn, lane); row_add_bf16(PR + (size_t)mn * DM, vn, lane); }
        float* yr = yrow_ptr(m);
        const float inv = 1.0f / sqrtf(wave_sum(row_ss(v)) * (1.0f / DM) + EPS);
#pragma unroll
        for (int j = 0; j < 4; ++j) { const f32x4 gg = *(const f32x4*)(gf + j * 256 + lane * 4); *(f32x4*)(yr + j * 256 + lane * 4) = v[j] * inv * gg; }
#pragma unroll
        for (int j = 0; j < 4; ++j) v[j] = vn[j];
    }
}

#define XB_TMO      128
#define XB_XCNT(j)  (256  + 64 * (j))
#define XB_XSUB(j)  (1280 + 64 * (j))
#define XB_XGEN(j)  (2304 + 64 * (j))
#define XB_TOP      3328
#define XB_TOPGEN   3392
#define XB_SPIN_CAP (1u << 22)
constexpr int CW_BAR = 2048;
constexpr int LDS_MISC = 131072 + 64;
__device__ __forceinline__ unsigned xb_ld(unsigned* p)              { return __hip_atomic_load(p, __ATOMIC_RELAXED, __HIP_MEMORY_SCOPE_AGENT); }
__device__ __forceinline__ unsigned xb_add(unsigned* p, unsigned v) { return __hip_atomic_fetch_add(p, v, __ATOMIC_RELAXED, __HIP_MEMORY_SCOPE_AGENT); }
#define XB_SPIN(cond, bar) do { unsigned _sp = 0; while (cond) { __builtin_amdgcn_s_sleep(1); \
    if ((++_sp & 255u) == 0u) { if (xb_ld(&(bar)[XB_TMO])) break; if (_sp > XB_SPIN_CAP) { atomicAdd(&(bar)[XB_TMO], 1u); break; } } } } while (0)
struct XcdBarrier { unsigned* bar; unsigned x; volatile LAS unsigned* st; };
__device__ __forceinline__ XcdBarrier xcd_barrier_post(unsigned* bar, volatile LAS unsigned* st) {
    XcdBarrier b; b.bar = bar; b.x = (unsigned)__builtin_amdgcn_s_getreg((3 << 11) | 20) & 0xFu; b.st = st;
    if (threadIdx.x == 0) (void)xb_add(&bar[XB_XCNT(b.x)], 1u);
    return b;
}
__device__ __forceinline__ void xcd_barrier_complete(unsigned* bar, unsigned x, unsigned& nloc, unsigned& nx) {
    const unsigned G = gridDim.x * gridDim.y * gridDim.z;
    unsigned sum, cnt, mine, sp = 0u;
    for (;;) {
        sum = 0u; cnt = 0u; mine = 0u;
#pragma unroll
        for (unsigned j = 0; j < 16; ++j) { const unsigned c = xb_ld(&bar[XB_XCNT(j)]); sum += c; cnt += (c > 0u) ? 1u : 0u; mine = (j == x) ? c : mine; }
        if (sum == G) break;
        __builtin_amdgcn_s_sleep(1);
        if ((++sp & 255u) == 0u) { if (xb_ld(&bar[XB_TMO])) break; if (sp > XB_SPIN_CAP) { atomicAdd(&bar[XB_TMO], 1u); break; } }
    }
    nloc = mine > 0u ? mine : 1u; nx = cnt > 0u ? cnt : 1u;
}
__device__ __forceinline__ void xcd_barrier(const XcdBarrier& b) {
    asm volatile("s_waitcnt vmcnt(0)" ::: "memory");
    __syncthreads();
    if (threadIdx.x == 0) {
        unsigned* bar = b.bar;
        __builtin_amdgcn_s_waitcnt(0);
        unsigned nloc = b.st[0], nx = b.st[1];
        if (nloc == 0u) { xcd_barrier_complete(bar, b.x, nloc, nx); b.st[0] = nloc; b.st[1] = nx; }
        const unsigned old = xb_add(&bar[XB_XSUB(b.x)], 1u);
        const unsigned gen = old / nloc;
        if (old + 1u == (gen + 1u) * nloc) {
            __builtin_amdgcn_fence(__ATOMIC_RELEASE, "agent");
            asm volatile("s_waitcnt vmcnt(0)" ::: "memory");
            const unsigned og = xb_add(&bar[XB_TOP], 1u);
            const unsigned tg = og / nx;
            if (og + 1u == (tg + 1u) * nx) xb_add(&bar[XB_TOPGEN], 1u);
            else XB_SPIN(xb_ld(&bar[XB_TOPGEN]) == tg, bar);
            __builtin_amdgcn_fence(__ATOMIC_ACQUIRE, "agent");
            xb_add(&bar[XB_XGEN(b.x)], 1u);
            asm volatile("s_waitcnt vmcnt(0)" ::: "memory");
        } else {
            XB_SPIN(xb_ld(&bar[XB_XGEN(b.x)]) == gen, bar);
            __builtin_amdgcn_fence(__ATOMIC_ACQUIRE, "agent");
            asm volatile("s_waitcnt vmcnt(0)" ::: "memory");
        }
    }
    __syncthreads();
}

template <int NACC, class Epi>
__device__ __forceinline__ void small_gemm(LAS unsigned char* lds, const bf16_t* X0, const bf16_t* W0, const bf16_t* X1, const bf16_t* W1, int N, int G, int wave, int lane, const Epi& epi) {
    const int r32 = lane & 31, hi = lane >> 5;
    LAS float* part = (LAS float*)lds;
    for (int task = blockIdx.x; task < 4 * (N / 32); task += G) {
        const int rb = task & 3, cb = task >> 2;
#pragma unroll
        for (int a = 0; a < NACC; ++a) {
            const bf16_t* xp = (a ? X1 : X0) + (size_t)(rb * 32 + r32) * DM + hi * 8 + wave * 128;
            const bf16_t* wp = (a ? W1 : W0) + (size_t)(cb * 32 + r32) * DM + hi * 8 + wave * 128;
            bf16x8 xa[8], wa[8];
#pragma unroll
            for (int q = 0; q < 8; ++q) { xa[q] = *(const bf16x8*)(xp + q * 16); wa[q] = *(const bf16x8*)(wp + q * 16); }
            f32x16 acc = f32x16{};
#pragma unroll
            for (int q = 0; q < 8; ++q) acc = __builtin_amdgcn_mfma_f32_32x32x16_bf16(wa[q], xa[q], acc, 0, 0, 0);
#pragma unroll
            for (int r = 0; r < 16; ++r) part[((a * 8 + wave) * 16 + r) * 64 + lane] = acc[r];
        }
        __syncthreads();
        if (wave < 4) {
            const int g4 = wave, t = rb * 32 + r32, n0 = cb * 32 + 8 * g4 + 4 * hi;
            f32x4 v[NACC];
#pragma unroll
            for (int a = 0; a < NACC; ++a) { v[a] = (f32x4){0.f, 0.f, 0.f, 0.f};
#pragma unroll
                for (int w = 0; w < 8; ++w)
#pragma unroll
                    for (int i = 0; i < 4; ++i) v[a][i] += part[((a * 8 + w) * 16 + 4 * g4 + i) * 64 + lane]; }
            epi(t, n0, v[0], v[NACC - 1]);
        }
        __syncthreads();
    }
}
__device__ __forceinline__ u32x2 pack4(f32x4 v) { u32x2 w; w.x = cvtpk(v[0], v[1]); w.y = cvtpk(v[2], v[3]); return w; }
struct SEpiG1 {
    __device__ __forceinline__ void operator()(int t, int n0, f32x4 v, f32x4) const {
        unsigned char* ws = A_WS; float* out = A_OUT;
        const int ts = n0 >> 10, c = n0 & 1023; const size_t ro = (size_t)(NTP + t) * DM + c;
        if (ts == 0) *(u32x2*)((bf16_t*)(ws + WS_Q) + ro) = pack4(v);
        else if (ts == 1) *(f32x4*)(out + O_KS + (size_t)t * DM + c) = v;
        else if (ts == 2) *(f32x4*)(out + O_VS + (size_t)t * DM + c) = v;
        else if (ts == 3) { *(u32x2*)((bf16_t*)(ws + WS_XR) + ro) = pack4(v);
            if ((t & 15) >= 13) *(f32x4*)(out + O_CS + ((size_t)(t >> 4) * 3 + ((t & 15) - 13)) * DM + c) = v; }
        else if (ts == 4) *(u32x2*)((bf16_t*)(ws + WS_G) + ro) = pack4(v);
        else if (ts == 5) *(u32x2*)((bf16_t*)(ws + WS_SGA) + (size_t)t * DM + c) = pack4(v);
        else *(u32x2*)((bf16_t*)(ws + WS_SGR) + (size_t)t * DM + c) = pack4(v);
    }
};
struct SEpiP3 {
    __device__ __forceinline__ void operator()(int t, int n0, f32x4 va, f32x4 vr) const {
        unsigned char* ws = A_WS;
        const u32x2 ga = *(const u32x2*)((const bf16_t*)(ws + WS_SGA) + (size_t)t * DM + n0), gr = *(const u32x2*)((const bf16_t*)(ws + WS_SGR) + (size_t)t * DM + n0);
        f32x4 m;
        m[0] = sigmoidf_(bflo(ga.x)) * va[0] + sigmoidf_(bflo(gr.x)) * vr[0]; m[1] = sigmoidf_(bfhi(ga.x)) * va[1] + sigmoidf_(bfhi(gr.x)) * vr[1];
        m[2] = sigmoidf_(bflo(ga.y)) * va[2] + sigmoidf_(bflo(gr.y)) * vr[2]; m[3] = sigmoidf_(bfhi(ga.y)) * va[3] + sigmoidf_(bfhi(gr.y)) * vr[3];
        *(u32x2*)((bf16_t*)(ws + WS_XR) + (size_t)(NTP + t) * DM + n0) = pack4(m);
    }
};
struct SEpiBf16 {
    size_t wsoff; int ld;
    __device__ __forceinline__ void operator()(int t, int n0, f32x4 v, f32x4) const { *(u32x2*)((bf16_t*)(A_WS + wsoff) + (size_t)(NTP + t) * ld + n0) = pack4(v); }
};

__global__ void __launch_bounds__(512, 2) hybrid_fwd(Args a) {
    extern __shared__ __attribute__((aligned(16))) unsigned char lds_raw[];
    LAS unsigned char* lds = (LAS unsigned char*)lds_raw;
    const int tid = threadIdx.x, lane = tid & 63, wave = __builtin_amdgcn_readfirstlane(tid >> 6), G = gridDim.x;
    cg::grid_group grid = cg::this_grid();
    unsigned char* ws = A_WS;
    if (tid < 2) ((volatile LAS unsigned*)(lds + LDS_MISC))[tid] = 0u;
    __syncthreads();
    XcdBarrier xbar; xbar.bar = (unsigned*)(ws + WS_CTL) + CW_BAR; xbar.x = 0; xbar.st = nullptr;
    if (KA->use_sync) xbar = xcd_barrier_post((unsigned*)(ws + WS_CTL) + CW_BAR, (volatile LAS unsigned*)(lds + LDS_MISC));
#define IN(k) (KA->ph_lo <= (k) && (k) < KA->ph_hi)
#define SEAM(k) do { if (KA->use_sync && IN(k) && IN((k) + 1)) { if ((k) == 0) grid.sync(); else xcd_barrier(xbar); } } while (0)
    if (IN(0)) { p0_prologue(lds, G, wave, lane); }
    SEAM(0);
    if (IN(1)) {
        pg8::Gemm g{(const bf16_t*)(ws + WS_XN), (const bf16_t*)(ws + WS_WIN), (const bf16_t*)(ws + WS_WIN) + (size_t)2048 * DM, (const bf16_t*)(ws + WS_XN), DM};
        SchedG1 S; S.init(G, blockIdx.x); EpiG1 E;
        pg8::gemm_phase(lds, g, S, E);
        { const bf16_t* xs = (const bf16_t*)(ws + WS_XN) + (size_t)NTP * DM; const bf16_t* w = (const bf16_t*)(ws + WS_WIN); SEpiG1 SE; small_gemm<1>(lds, xs, w, xs, w, INC, G, wave, lane, SE); }
    }
    SEAM(1);
    if (IN(2)) { p2_phase(lds, G, tid, wave, lane); }
    SEAM(2);
    if (IN(3)) {
        pg8::Gemm g{(const bf16_t*)(ws + WS_XN), (const bf16_t*)(ws + WS_WBA), (const bf16_t*)(ws + WS_G), (const bf16_t*)(ws + WS_WBL), DM};
        SchedPair S; S.init(4, G, blockIdx.x); EpiP3 E;
        pg8::gemm_phase(lds, g, S, E);
        { SEpiP3 SE; small_gemm<2>(lds, (const bf16_t*)(ws + WS_XN) + (size_t)NTP * DM, (const bf16_t*)(ws + WS_WBA), (const bf16_t*)(ws + WS_G) + (size_t)NTP * DM, (const bf16_t*)(ws + WS_WBL), DM, G, wave, lane, SE); }
    }
    SEAM(3);
    if (IN(4)) {
        pg8::Gemm g{(const bf16_t*)(ws + WS_XR), (const bf16_t*)(ws + WS_WO), (const bf16_t*)(ws + WS_XR), (const bf16_t*)(ws + WS_WO), DM};
        SchedOne S; S.init(4, G, blockIdx.x); EpiP4 E;
        pg8::gemm_phase(lds, g, S, E);
        { const bf16_t* xs = (const bf16_t*)(ws + WS_XR) + (size_t)NTP * DM; const bf16_t* w = (const bf16_t*)(ws + WS_WO); SEpiBf16 SE{WS_DELTA, DM}; small_gemm<1>(lds, xs, w, xs, w, DM, G, wave, lane, SE); }
    }
    SEAM(4);
    if (IN(5)) { p4b_phase(G, wave, lane); }
    SEAM(5);
    if (IN(6)) {
        pg8::Gemm g{(const bf16_t*)(ws + WS_XQ), (const bf16_t*)(ws + WS_WSQ), (const bf16_t*)(ws + WS_XQ), (const bf16_t*)(ws + WS_WSQ), DM / 2};
        SchedOne S; S.init(8, G, blockIdx.x); EpiP5 E;
        pg8::gemm_phase<EpiP5, SchedOne, true>(lds, g, S, E);
        { const bf16_t* xs = (const bf16_t*)(ws + WS_Q) + (size_t)NTP * DM; const bf16_t* w = (const bf16_t*)(ws + WS_WS); SEpiBf16 SE{WS_XN, 2048}; small_gemm<1>(lds, xs, w, xs, w, 2048, G, wave, lane, SE); }
    }
    SEAM(6);
    if (IN(7)) { p6a_phase(lds, G, wave, lane); }
    SEAM(7);
    if (IN(8)) { p6b_phase(lds, tid, wave, lane); }
    SEAM(8);
    if (IN(9)) { p6m_phase(G, wave, lane); }
    SEAM(9);
    if (IN(10)) { p6c_phase(lds, tid, wave, lane); }
    SEAM(10);
    if (IN(11)) { p6d_phase(G, wave, lane); }
#undef IN
#undef SEAM
}

#ifndef N_LAUNCH_MODE
#define N_LAUNCH_MODE 1
#endif
constexpr int NPH = 12;
extern "C" void kernel_launch(void* const* d_in, const int* in_sizes, int n_in, void* d_out, int out_size, void* d_ws, size_t ws_size, hipStream_t stream) {
    static int grid = 0;
    if (grid == 0) {
        if (n_in != 26 || (size_t)out_size != O_END || ws_size < WS_END) { fprintf(stderr, "kernel_launch: unexpected sizes n_in %d out %d ws %zu (need %zu)\n", n_in, out_size, ws_size, (size_t)WS_END); grid = -1; return; }
        int dev = 0, cus = 0, per_cu = 0;
        (void)hipGetDevice(&dev); (void)hipDeviceGetAttribute(&cus, hipDeviceAttributeMultiprocessorCount, dev);
        (void)hipFuncSetAttribute((const void*)hybrid_fwd, hipFuncAttributeMaxDynamicSharedMemorySize, LDS_BYTES);
        (void)hipOccupancyMaxActiveBlocksPerMultiprocessor(&per_cu, (const void*)hybrid_fwd, 512, LDS_BYTES);
        if (per_cu < 1) { fprintf(stderr, "kernel_launch: occupancy query says %d blocks per CU\n", per_cu); per_cu = 1; }
        grid = cus;
        (void)hipGetLastError();
    }
    if (grid < 0) return;
    (void)hipMemsetAsync((char*)d_ws + WS_CTL, 0, 32768, stream);
    Args a{};
    for (int i = 0; i < 26; ++i) a.in[i] = (const float*)d_in[i];
    a.out = (float*)d_out; a.ws = (unsigned char*)d_ws;
    if (N_LAUNCH_MODE == 1) {
        a.ph_lo = 0; a.ph_hi = NPH; a.use_sync = 1;
        void* args[] = {&a};
        hipError_t e = hipLaunchCooperativeKernel((const void*)hybrid_fwd, dim3(grid), dim3(512), args, LDS_BYTES, stream);
        if (e != hipSuccess) fprintf(stderr, "cooperative launch failed: %s (grid %d)\n", hipGetErrorString(e), grid);
    } else {
        for (int p = 0; p < NPH; ++p) { a.ph_lo = p; a.ph_hi = p + 1; a.use_sync = 0; hipLaunchKernelGGL(hybrid_fwd, dim3(grid), dim3(512), LDS_BYTES, stream, a); }
    }
}
```

```cpp
#include <hip/hip_runtime.h>
#include <hip/hip_cooperative_groups.h>
#include <cstdint>
#include <cstdio>
namespace cg = cooperative_groups;

#define LAS __attribute__((address_space(3)))
typedef unsigned short bf16_t;
typedef short bf16x8 __attribute__((ext_vector_type(8)));
typedef float f32x4 __attribute__((ext_vector_type(4)));
typedef float f32x2 __attribute__((ext_vector_type(2)));
typedef float f32x16 __attribute__((ext_vector_type(16)));
typedef unsigned u32x4 __attribute__((ext_vector_type(4)));
typedef unsigned u32x2 __attribute__((ext_vector_type(2)));
typedef __bf16 bf16x2_t __attribute__((ext_vector_type(2)));
typedef int i32x4_t __attribute__((ext_vector_type(4)));

constexpr int DM = 1024, SEQ = 4096, NB = 16, NTP = NB * SEQ, NSB = 8, NST = 16, NTS = NSB * NST, NTOK = NTP + NTS;
constexpr int ROWS = 65792, NMT = 257;
constexpr int INC = 7168, NEXP = 16384;
constexpr float EPS = 1e-6f, LOG2E = 1.4426950408889634f;
constexpr float QSCALE = 0.125f * LOG2E;

constexpr size_t MiB = 1u << 20;
constexpr size_t BUF = (size_t)ROWS * DM * 2;
constexpr size_t WS_CTL = 0;
constexpr size_t WS_WIN = 1 * MiB;
constexpr size_t WS_WBA = 16 * MiB, WS_WBL = 18 * MiB, WS_WO = 20 * MiB, WS_WS = 22 * MiB;
constexpr size_t WS_LRUW = 26 * MiB;
constexpr size_t WS_SGA = 27 * MiB, WS_SGR = 27 * MiB + 512 * 1024;
constexpr size_t WS_SU = 26 * MiB + 512 * 1024, WS_SV = 26 * MiB + 640 * 1024;
constexpr size_t WS_SW = 26 * MiB + 256 * 1024;
constexpr size_t WS_SXN = 46 * MiB;
constexpr size_t WS_WIQ = 47 * MiB;
constexpr size_t WS_SWI = 52 * MiB;
constexpr size_t WS_WKV8 = 54 * MiB, WS_SKV = 58 * MiB;
constexpr size_t WS_WSQ = 44 * MiB;
constexpr size_t WS_SX = 26 * MiB + 704 * 1024;
constexpr size_t WS_UB = 28 * MiB, WS_VB = 60 * MiB;
constexpr size_t WS_Q = 92 * MiB;
constexpr size_t WS_XN = WS_Q + BUF;
constexpr size_t WS_K = WS_XN + BUF;
constexpr size_t WS_VT = WS_K + BUF;
constexpr size_t WS_XR = WS_VT + BUF;
constexpr size_t WS_G = WS_XR + BUF;
constexpr size_t WS_END = WS_G + BUF;
constexpr size_t WS_DELTA = WS_VT;
constexpr size_t WS_PEER = WS_Q;
constexpr size_t WS_SELE = WS_G, WS_SELG = WS_G + (size_t)NTOK * 512, WS_XQ = WS_G + (size_t)NTOK * 1024;

constexpr size_t O_YP = 0, O_YS = O_YP + (size_t)NTP * DM, O_KP = O_YS + (size_t)NTS * DM, O_VP = O_KP + (size_t)NB * 512 * DM,
                 O_CP = O_VP + (size_t)NB * 512 * DM, O_LP = O_CP + (size_t)NB * 3 * DM, O_KS = O_LP + (size_t)NB * DM, O_VS = O_KS + (size_t)NTS * DM,
                 O_CS = O_VS + (size_t)NTS * DM, O_LS = O_CS + (size_t)NSB * 3 * DM, O_END = O_LS + (size_t)NSB * DM;

constexpr int LDS_BYTES = 135168;

__device__ __forceinline__ unsigned cvtpk(float lo, float hi) { f32x2 v = {lo, hi}; bf16x2_t b = __builtin_convertvector(v, bf16x2_t); return __builtin_bit_cast(unsigned, b); }
__device__ __forceinline__ float bflo(unsigned u) { return __uint_as_float(u << 16); }
__device__ __forceinline__ float bfhi(unsigned u) { return __uint_as_float(u & 0xffff0000u); }
__device__ __forceinline__ float fast_exp2(float x) { return __builtin_amdgcn_exp2f(x); }
__device__ __forceinline__ float fast_rcp(float x) { return __builtin_amdgcn_rcpf(x); }
__device__ __forceinline__ float sigmoidf_(float z) { return fast_rcp(1.0f + fast_exp2(-z * LOG2E)); }
__device__ __forceinline__ float gelu_tanh(float x) { const float u = x + 0.044715f * x * x * x; return x * fast_rcp(1.0f + fast_exp2(-1.5957691216f * LOG2E * u)); }
__device__ __forceinline__ float wave_sum(float v) {
    v += __builtin_bit_cast(float, __builtin_amdgcn_update_dpp(0, __builtin_bit_cast(int, v), 0xB1, 0xF, 0xF, true));
    v += __builtin_bit_cast(float, __builtin_amdgcn_update_dpp(0, __builtin_bit_cast(int, v), 0x4E, 0xF, 0xF, true));
    v += __builtin_bit_cast(float, __builtin_amdgcn_update_dpp(0, __builtin_bit_cast(int, v), 0x141, 0xF, 0xF, true));
    v += __builtin_bit_cast(float, __builtin_amdgcn_update_dpp(0, __builtin_bit_cast(int, v), 0x140, 0xF, 0xF, true));
    const int b = __builtin_bit_cast(int, v);
    return (__builtin_bit_cast(float, __builtin_amdgcn_readlane(b, 0)) + __builtin_bit_cast(float, __builtin_amdgcn_readlane(b, 16)))
         + (__builtin_bit_cast(float, __builtin_amdgcn_readlane(b, 32)) + __builtin_bit_cast(float, __builtin_amdgcn_readlane(b, 48)));
}
__device__ __forceinline__ float wave_max(float v) {
    v = fmaxf(v, __builtin_bit_cast(float, __builtin_amdgcn_update_dpp(0, __builtin_bit_cast(int, v), 0xB1, 0xF, 0xF, true)));
    v = fmaxf(v, __builtin_bit_cast(float, __builtin_amdgcn_update_dpp(0, __builtin_bit_cast(int, v), 0x4E, 0xF, 0xF, true)));
    v = fmaxf(v, __builtin_bit_cast(float, __builtin_amdgcn_update_dpp(0, __builtin_bit_cast(int, v), 0x141, 0xF, 0xF, true)));
    v = fmaxf(v, __builtin_bit_cast(float, __builtin_amdgcn_update_dpp(0, __builtin_bit_cast(int, v), 0x140, 0xF, 0xF, true)));
    const int b = __builtin_bit_cast(int, v);
    return fmaxf(fmaxf(__builtin_bit_cast(float, __builtin_amdgcn_readlane(b, 0)), __builtin_bit_cast(float, __builtin_amdgcn_readlane(b, 16))),
                 fmaxf(__builtin_bit_cast(float, __builtin_amdgcn_readlane(b, 32)), __builtin_bit_cast(float, __builtin_amdgcn_readlane(b, 48))));
}
__device__ __forceinline__ int swap23(int i) { return (i & ~12) | ((i & 4) << 1) | ((i & 8) >> 1); }
__device__ __forceinline__ float plswap_max(float m) { auto rr = __builtin_amdgcn_permlane32_swap(__float_as_uint(m), __float_as_uint(m), false, false); return fmaxf(__uint_as_float(rr[0]), __uint_as_float(rr[1])); }
__device__ __forceinline__ float plswap_add(float m) { auto rr = __builtin_amdgcn_permlane32_swap(__float_as_uint(m), __float_as_uint(m), false, false); return __uint_as_float(rr[0]) + __uint_as_float(rr[1]); }

namespace pg8 {
constexpr int BM = 256, BK = 64, HALF = 128, HTB = HALF * BK * 2, STAGE_BYTES = 8 * HTB, NXCD = 8, WGM = 8;
__host__ __device__ __forceinline__ int lds_byte(int r, int c) { const int st = (r >> 4) * 2 + (c >> 5), rr = r & 15, cc = c & 31, ob = rr * 64 + cc * 2; return st * 1024 + (ob ^ (((ob >> 9) & 1) << 5)); }
__host__ __device__ __forceinline__ void stage_rc(int b, int& R, int& C) { const int st = b / 1024, sb = b % 1024, swz = sb ^ (((sb >> 9) & 1) << 5); R = (st >> 1) * 16 + swz / 64; C = (st & 1) * 32 + (swz % 64) / 2; }
__host__ __device__ __forceinline__ int perm32(int rho) { const int n = rho >> 4, i = rho & 15; return 8 * (i >> 2) + 4 * n + (i & 3); }

struct Unit { int pm, pn, kind; };
struct Gemm { const bf16_t* A0; const bf16_t* B0; const bf16_t* A1; const bf16_t* B1; int K; };

struct TileMap {
    int nM, nN, nwg;
    __device__ __forceinline__ void init(int nM_, int nN_) { nM = nM_; nN = nN_; nwg = nM * nN; }
    __device__ __forceinline__ void map(int L, int& pm, int& pn) const {
        int wgid = L; { const int q = nwg / NXCD, r = nwg % NXCD, xcd = wgid % NXCD, off = wgid / NXCD; wgid = (xcd < r ? xcd * (q + 1) : r * (q + 1) + (xcd - r) * q) + off; }
        const int nig = WGM * nN, gid = wgid / nig, fm = gid * WGM, gsz = (nM - fm) < WGM ? (nM - fm) : WGM;
        pm = fm + ((wgid % nig) % gsz); pn = (wgid % nig) / gsz;
    }
};

template <class Epi, class Sched, bool I8 = false>
__device__ __forceinline__ void gemm_phase(LAS unsigned char* lds, const Gemm g, const Sched& S, const Epi& E) {
    const int tid = threadIdx.x, wid = __builtin_amdgcn_readfirstlane(tid >> 6), lane = tid & 63, wr = wid >> 2, wc = wid & 3, fr = lane & 15, fq = lane >> 4;
    const int K = g.K, nt = K / BK;
    unsigned voffA[2], voffB[2];
#pragma unroll
    for (int i = 0; i < 2; ++i) { int R, C; stage_rc(tid * 16 + i * 8192, R, C); const int Rb = (R & ~31) + perm32(R & 31);
        voffA[i] = (unsigned)(R * K + C) * 2u; voffB[i] = (unsigned)(Rb * K + C) * 2u; }
    const size_t kstep = (size_t)(BK * 2);
    const size_t hstep = (size_t)HALF * K * 2;
    const size_t tstep = 2 * hstep;
    const unsigned ldsw = (unsigned)wid * 1024u;
    const int aoff = lds_byte(wr * 64 + fr, fq * 8), boff = lds_byte(wc * 32 + fr, fq * 8);
#define PG8_SA(b, h) (((b) * 2 + (h)) * HTB)
#define PG8_SB(b, h) ((4 + (b) * 2 + (h)) * HTB)
#define PG8_STAGE(bufoff, gbase, voff) do { _Pragma("unroll") for (int _i = 0; _i < 2; ++_i) \
        __builtin_amdgcn_global_load_lds((const unsigned*)((const char*)(gbase) + (voff)[_i]), (LAS unsigned*)(lds + (bufoff) + ldsw + _i * 8192), 16, 0, 0); } while (0)
#define PG8_LDA(dst, b, h) do { _Pragma("unroll") for (int m = 0; m < 4; ++m) _Pragma("unroll") for (int k = 0; k < 2; ++k) dst[m][k] = *(const LAS bf16x8*)(lds + PG8_SA(b, h) + aoff + m * 2048 + k * 1024); } while (0)
#define PG8_LDB(dst, b, h) do { _Pragma("unroll") for (int n = 0; n < 2; ++n) _Pragma("unroll") for (int k = 0; k < 2; ++k) dst[n][k] = *(const LAS bf16x8*)(lds + PG8_SB(b, h) + boff + n * 2048 + k * 1024); } while (0)
#define PG8_MMA(ai, bj, At, Bt) do { __builtin_amdgcn_s_setprio(1); _Pragma("unroll") for (int m = 0; m < 4; ++m) _Pragma("unroll") for (int n = 0; n < 2; ++n) _Pragma("unroll") for (int k = 0; k < 2; ++k) { \
        if constexpr (I8) acc[ai][bj][m][n] = __builtin_bit_cast(acc_t, __builtin_amdgcn_mfma_i32_16x16x64_i8(__builtin_bit_cast(i32x4_t, Bt[n][k]), __builtin_bit_cast(i32x4_t, At[m][k]), __builtin_bit_cast(i32x4_t, acc[ai][bj][m][n]), 0, 0, 0)); \
        else acc[ai][bj][m][n] = __builtin_bit_cast(acc_t, __builtin_amdgcn_mfma_f32_16x16x32_bf16(Bt[n][k], At[m][k], __builtin_bit_cast(f32x4, acc[ai][bj][m][n]), 0, 0, 0)); } __builtin_amdgcn_s_setprio(0); } while (0)
#define PG8_WAIT_V(n) asm volatile("s_waitcnt vmcnt(" #n ")" ::: "memory")
#define PG8_WAIT_L(n) asm volatile("s_waitcnt lgkmcnt(" #n ")" ::: "memory")
#define PG8_BAR __builtin_amdgcn_s_barrier()
#define PG8_SCHED __builtin_amdgcn_sched_barrier(0)
    Unit cur, nxt; int ui = 0;
    if (!S.next(0, cur)) return;
    typedef typename Epi::acc_t acc_t;
    acc_t acc[2][2][4][2];
#pragma unroll
    for (int a = 0; a < 2; ++a)
#pragma unroll
        for (int b = 0; b < 2; ++b)
#pragma unroll
            for (int m = 0; m < 4; ++m)
#pragma unroll
                for (int n = 0; n < 2; ++n) acc[a][b][m][n] = acc_t{};
    bf16x8 At[4][2], B0[2][2], B1[2][2];
    const char* cA = (const char*)(cur.kind ? g.A1 : g.A0) + (size_t)cur.pm * tstep; const char* cB = (const char*)(cur.kind ? g.B1 : g.B0) + (size_t)cur.pn * tstep;
    PG8_STAGE(PG8_SB(0, 0), cB, voffB); PG8_STAGE(PG8_SB(0, 1), cB + hstep, voffB); PG8_STAGE(PG8_SA(0, 0), cA, voffA); PG8_STAGE(PG8_SA(0, 1), cA + hstep, voffA);
    if (wr == 1) PG8_BAR;
    PG8_WAIT_V(2); PG8_BAR;
    PG8_STAGE(PG8_SB(1, 0), cB + kstep, voffB); PG8_STAGE(PG8_SA(1, 0), cA + kstep, voffA); PG8_STAGE(PG8_SB(1, 1), cB + hstep + kstep, voffB);
    PG8_WAIT_V(6); PG8_BAR;
    for (;;) {
        const bool has_next = S.next(ui + 1, nxt);
        E.prefetch(cur, lds + STAGE_BYTES + 512 + wid * 256, tid);
        const char* nA = has_next ? (const char*)(nxt.kind ? g.A1 : g.A0) + (size_t)nxt.pm * tstep : cA; const char* nB = has_next ? (const char*)(nxt.kind ? g.B1 : g.B0) + (size_t)nxt.pn * tstep : cB;
        for (int t = 0; t < nt; t += 2) {
            const bool last = (t == nt - 2);
            const char* a1 = cA + (size_t)(t + 1) * kstep;
            const char* a2 = last ? nA : cA + (size_t)(t + 2) * kstep; const char* b2 = last ? nB : cB + (size_t)(t + 2) * kstep;
            const char* a3 = a2 + kstep; const char* b3 = b2 + kstep;
            PG8_LDB(B0, 0, 0); PG8_LDB(B1, 0, 1); PG8_SCHED; PG8_LDA(At, 0, 0); PG8_STAGE(PG8_SA(1, 1), a1 + hstep, voffA);
            PG8_WAIT_V(8); PG8_WAIT_L(0); PG8_BAR; PG8_MMA(0, 0, At, B0); PG8_MMA(0, 1, At, B1); PG8_BAR; PG8_SCHED;
            PG8_LDA(At, 0, 1); PG8_STAGE(PG8_SB(0, 0), b2, voffB); PG8_STAGE(PG8_SB(0, 1), b2 + hstep, voffB); PG8_STAGE(PG8_SA(0, 0), a2, voffA);
            PG8_WAIT_V(8); PG8_WAIT_L(0); PG8_BAR; PG8_MMA(1, 0, At, B0); PG8_MMA(1, 1, At, B1); PG8_BAR; PG8_SCHED;
            PG8_LDB(B0, 1, 0); PG8_LDB(B1, 1, 1); PG8_SCHED; PG8_LDA(At, 1, 0); PG8_STAGE(PG8_SA(0, 1), a2 + hstep, voffA);
            PG8_WAIT_V(8); PG8_WAIT_L(0); PG8_BAR; PG8_MMA(0, 0, At, B0); PG8_MMA(0, 1, At, B1); PG8_BAR; PG8_SCHED;
            PG8_LDA(At, 1, 1); PG8_STAGE(PG8_SB(1, 0), b3, voffB); PG8_STAGE(PG8_SB(1, 1), b3 + hstep, voffB); PG8_STAGE(PG8_SA(1, 0), a3, voffA);
            PG8_WAIT_V(8); PG8_WAIT_L(0); PG8_BAR; PG8_MMA(1, 0, At, B0); PG8_MMA(1, 1, At, B1); PG8_BAR; PG8_SCHED;
        }
        if (wr == 0) PG8_BAR;
        const bool keep = E(acc, cur, wr, wc, fr, fq);
        if (!has_next) break;
        if (!keep) {
#pragma unroll
        for (int a = 0; a < 2; ++a)
#pragma unroll
            for (int b = 0; b < 2; ++b)
#pragma unroll
                for (int m = 0; m < 4; ++m)
#pragma unroll
                    for (int n = 0; n < 2; ++n) acc[a][b][m][n] = acc_t{};
        }
        cur = nxt; cA = nA; cB = nB; ++ui;
        if (wr == 1) PG8_BAR;
    }
    PG8_WAIT_V(0);
    PG8_BAR;
#undef PG8_SA
#undef PG8_SB
#undef PG8_STAGE
#undef PG8_LDA
#undef PG8_LDB
#undef PG8_MMA
#undef PG8_WAIT_V
#undef PG8_WAIT_L
#undef PG8_BAR
#undef PG8_SCHED
}
}
using pg8::Unit;

struct Args {
    const float* in[26];
    float* out; unsigned char* ws;
    int ph_lo, ph_hi, use_sync, pad;
};

typedef const __attribute__((address_space(4))) Args* ArgsP;
#define KA ((ArgsP)__builtin_amdgcn_kernarg_segment_ptr())
#define A_IN(k) (KA->in[k])
#define A_OUT (KA->out)
#define A_WS (KA->ws)

struct SchedG1 {
    pg8::TileMap mk, mv; int G, c;
    __device__ __forceinline__ void init(int G_, int c_) { mk.init(32, 4); mv.init(4, 32); G = G_; c = c_; }
    __device__ __forceinline__ bool next(int i, Unit& u) const {
        int L = i * G + c, t;
        if (L < 256) { const int xr = L < 128; mk.map(xr ? L : L - 128, t, u.pn); u.pm = (t >> 1) * 16 + 14 + (t & 1); u.pn += xr ? 12 : 4; u.kind = 0; return true; }
        L -= 256; if (L < 128) { mv.map(L, u.pm, t); u.pn = (t >> 1) * 16 + 14 + (t & 1); u.kind = 1; return true; }
        return false;
    }
};
struct SchedKV8 {
    pg8::TileMap mk, mv; int G, c;
    __device__ __forceinline__ void init(int G_, int c_) { mk.init(224, 4); mv.init(4, 224); G = G_; c = G_ - 1 - c_; }
    __device__ __forceinline__ bool next(int i, Unit& u) const {
        int L = i * G + c, t;
        if (L < 1792) { const int xr = L >= 896; mk.map(xr ? L - 896 : L, t, u.pn); u.pm = (t / 14) * 16 + t % 14; u.pn += xr ? 8 : 0; u.kind = 0; return true; }
        L -= 1792; if (L < 896) { mv.map(L, u.pm, t); u.pn = (t / 14) * 16 + t % 14; u.kind = 1; return true; }
        return false;
    }
};
struct SchedPair {
    pg8::TileMap m0; int G, c;
    __device__ __forceinline__ void init(int nN, int G_, int c_) { m0.init(256, nN); G = G_; c = c_; }
    __device__ __forceinline__ bool next(int i, Unit& u) const { const int L = (i >> 1) * G + c; if (L >= m0.nwg) return false; m0.map(L, u.pm, u.pn); u.kind = i & 1; return true; }
};
struct SchedGate {
    pg8::TileMap m0; int G, c;
    __device__ __forceinline__ void init(int G_, int c_) { m0.init(256, 4); G = G_; c = c_; }
    __device__ __forceinline__ bool next(int i, Unit& u) const { const int L = (i >> 1) * G + c; if (L >= m0.nwg) return false; m0.map(L, u.pm, u.pn); u.pn += 4 * (i & 1); u.kind = 0; return true; }
};
struct SchedOne {
    pg8::TileMap m0; int G, c;
    __device__ __forceinline__ void init(int nN, int G_, int c_) { m0.init(256, nN); G = G_; c = c_; }
    __device__ __forceinline__ bool next(int i, Unit& u) const { const int L = i * G + c; if (L >= m0.nwg) return false; m0.map(L, u.pm, u.pn); u.kind = 0; return true; }
};

#define EPI_PREP int fr_ = fr, fq_ = fq; asm volatile("" : "+v"(fr_), "+v"(fq_)); const int rl_ = wr * 64 + fr_, cl_ = wc * 32 + 8 * fq_;
#define EPI_LOOP_BEGIN \
    _Pragma("unroll") for (int ai = 0; ai < 2; ++ai) _Pragma("unroll") for (int m = 0; m < 4; ++m) { const int rit = ai * 128 + m * 16 + rl_; \
    _Pragma("unroll") for (int bj = 0; bj < 2; ++bj) { const int cit = bj * 128 + cl_; const auto v0 = acc[ai][bj][m][0], v1 = acc[ai][bj][m][1];
#define EPI_LOOP_END } }

__device__ __forceinline__ size_t kfrag_off(int row, int col) {
    return ((((size_t)(row >> 5) * 16 + (col >> 6)) * 4 + ((col >> 4) & 3)) * 64 + ((col >> 3) & 1) * 32 + swap23(row & 31)) * 8;
}
__device__ __forceinline__ size_t vfrag_off(int vc, int tok) {
    return (((((size_t)(tok >> 5) * 16 + (vc >> 6)) * 2 + ((vc >> 5) & 1)) * 2 + ((tok >> 4) & 1)) * 64 + ((tok >> 3) & 1) * 32 + swap23(vc & 31)) * 8;
}
struct EpiG1 {
    typedef f32x4 acc_t;
    __device__ __forceinline__ void prefetch(const Unit&, LAS unsigned char*, int) const {}
    __device__ __forceinline__ bool operator()(f32x4 (&acc)[2][2][4][2], const Unit& u, int wr, int wc, int fr, int fq) const {
        EPI_PREP unsigned char* ws = A_WS; float* out = A_OUT;
        if (u.kind == 0) {
            const int t = u.pn >> 2, ct = (u.pn & 3) * 256;
            bf16_t* base;
            if (t == 0) base = (bf16_t*)(ws + WS_Q); else if (t == 1) base = (bf16_t*)(ws + WS_K); else if (t == 3) base = (bf16_t*)(ws + WS_XR); else if (t == 4) base = (bf16_t*)(ws + WS_G);
            else if (t == 5) base = (u.pm < 256) ? (bf16_t*)(out + O_YP) : (bf16_t*)(ws + WS_SGA) - (size_t)NTP * DM;
            else base = (u.pm < 256) ? (bf16_t*)(out + O_YP) + (size_t)NTP * DM : (bf16_t*)(ws + WS_SGR) - (size_t)NTP * DM;
            if (t == 1) {
                EPI_LOOP_BEGIN
                    u32x4 w; w.x = cvtpk(v0[0], v0[1]); w.y = cvtpk(v0[2], v0[3]); w.z = cvtpk(v1[0], v1[1]); w.w = cvtpk(v1[2], v1[3]);
                    *(u32x4*)(base + kfrag_off(u.pm * 256 + rit, ct + cit)) = w;
                EPI_LOOP_END
            } else if (t >= 5) {
                unsigned char* g8 = (unsigned char*)(out + O_YP) + (t == 6 ? (size_t)NTP * DM : 0) + (size_t)u.pm * 256 * DM + ct;
                EPI_LOOP_BEGIN
                    u32x2 w;
                    w.x = (unsigned)(int)rintf(sigmoidf_(v0[0]) * 255.0f) | ((unsigned)(int)rintf(sigmoidf_(v0[1]) * 255.0f) << 8) | ((unsigned)(int)rintf(sigmoidf_(v0[2]) * 255.0f) << 16) | ((unsigned)(int)rintf(sigmoidf_(v0[3]) * 255.0f) << 24);
                    w.y = (unsigned)(int)rintf(sigmoidf_(v1[0]) * 255.0f) | ((unsigned)(int)rintf(sigmoidf_(v1[1]) * 255.0f) << 8) | ((unsigned)(int)rintf(sigmoidf_(v1[2]) * 255.0f) << 16) | ((unsigned)(int)rintf(sigmoidf_(v1[3]) * 255.0f) << 24);
                    *(u32x2*)(g8 + (size_t)rit * DM + cit) = w;
                EPI_LOOP_END
            } else {
            base += (size_t)u.pm * 256 * DM + ct;
            EPI_LOOP_BEGIN
                u32x4 w; w.x = cvtpk(v0[0], v0[1]); w.y = cvtpk(v0[2], v0[3]); w.z = cvtpk(v1[0], v1[1]); w.w = cvtpk(v1[2], v1[3]);
                *(u32x4*)(base + (size_t)rit * DM + cit) = w;
            EPI_LOOP_END
            }
            if (t == 1 && u.pm < 256 && (u.pm & 15) >= 14) { float* p0 = out + O_KP + ((size_t)(u.pm >> 4) * 512 + ((u.pm & 15) - 14) * 256) * DM + ct;
                EPI_LOOP_BEGIN float* p = p0 + (size_t)rit * DM + cit; *(f32x4*)p = v0; *(f32x4*)(p + 4) = v1; EPI_LOOP_END }
            if (t == 1 && u.pm == 256) { float* p0 = out + O_KS + ct;
                EPI_LOOP_BEGIN if (rit < NTS) { float* p = p0 + (size_t)rit * DM + cit; *(f32x4*)p = v0; *(f32x4*)(p + 4) = v1; } EPI_LOOP_END }
            if (t == 3 && u.pm < 256 && (u.pm & 15) == 15) { float* p0 = out + O_CP + ((size_t)(u.pm >> 4) * 3) * DM + ct;
                EPI_LOOP_BEGIN if (rit >= 253) { float* p = p0 + (size_t)(rit - 253) * DM + cit; *(f32x4*)p = v0; *(f32x4*)(p + 4) = v1; } EPI_LOOP_END }
            if (t == 3 && u.pm == 256) { float* p0 = out + O_CS + ct;
                EPI_LOOP_BEGIN if (rit < NTS && (rit & 15) >= 13) { float* p = p0 + ((size_t)(rit >> 4) * 3 + ((rit & 15) - 13)) * DM + cit; *(f32x4*)p = v0; *(f32x4*)(p + 4) = v1; } EPI_LOOP_END }
        } else {
            bf16_t* VT = (bf16_t*)(ws + WS_VT);
            EPI_LOOP_BEGIN
                u32x4 w; w.x = cvtpk(v0[0], v0[1]); w.y = cvtpk(v0[2], v0[3]); w.z = cvtpk(v1[0], v1[1]); w.w = cvtpk(v1[2], v1[3]);
                *(u32x4*)(VT + vfrag_off(u.pm * 256 + rit, u.pn * 256 + cit)) = w;
            EPI_LOOP_END
            if (u.pn < 256 && (u.pn & 15) >= 14) { float* p0 = out + O_VP + ((size_t)(u.pn >> 4) * 512 + ((u.pn & 15) - 14) * 256) * DM + u.pm * 256;
                EPI_LOOP_BEGIN float* p = p0 + (size_t)cit * DM + rit;
                    p[0] = v0[0]; p[DM] = v0[1]; p[2 * DM] = v0[2]; p[3 * DM] = v0[3]; p[4 * DM] = v1[0]; p[5 * DM] = v1[1]; p[6 * DM] = v1[2]; p[7 * DM] = v1[3]; EPI_LOOP_END }
            if (u.pn == 256) { float* p0 = out + O_VS + u.pm * 256;
                EPI_LOOP_BEGIN if (cit < NTS) { float* p = p0 + (size_t)cit * DM + rit;
                    p[0] = v0[0]; p[DM] = v0[1]; p[2 * DM] = v0[2]; p[3 * DM] = v0[3]; p[4 * DM] = v1[0]; p[5 * DM] = v1[1]; p[6 * DM] = v1[2]; p[7 * DM] = v1[3]; } EPI_LOOP_END }
        }
        return false;
    }
};

struct EpiP3 {
    typedef f32x4 acc_t;
    __device__ __forceinline__ void prefetch(const Unit&, LAS unsigned char*, int) const {}
    __device__ __forceinline__ bool operator()(f32x4 (&acc)[2][2][4][2], const Unit& u, int wr, int wc, int fr, int fq) const {
        EPI_PREP unsigned char* ws = A_WS; float* out = A_OUT;
        const size_t off0 = (size_t)u.pm * 256 * DM + u.pn * 256;
        const unsigned char* ga = (const unsigned char*)(out + O_YP) + off0; const unsigned char* gr = ga + (size_t)NTP * DM; bf16_t* MG = (bf16_t*)(ws + WS_XR) + off0;
#pragma unroll
        for (int ai = 0; ai < 2; ++ai) {
            u32x2 wa[4][2], wr8[4][2];
#pragma unroll
            for (int m = 0; m < 4; ++m)
#pragma unroll
                for (int bj = 0; bj < 2; ++bj) { const size_t off = (size_t)(ai * 128 + m * 16 + rl_) * DM + bj * 128 + cl_;
                    wr8[m][bj] = *(const u32x2*)(gr + off); if (u.kind == 0) wa[m][bj] = *(const u32x2*)(ga + off); }
#pragma unroll
            for (int m = 0; m < 4; ++m)
#pragma unroll
                for (int bj = 0; bj < 2; ++bj) {
                    const unsigned r0 = wr8[m][bj].x, r1 = wr8[m][bj].y;
                    float sr[8]; sr[0] = (float)(r0 & 0xffu); sr[1] = (float)((r0 >> 8) & 0xffu); sr[2] = (float)((r0 >> 16) & 0xffu); sr[3] = (float)(r0 >> 24);
                    sr[4] = (float)(r1 & 0xffu); sr[5] = (float)((r1 >> 8) & 0xffu); sr[6] = (float)((r1 >> 16) & 0xffu); sr[7] = (float)(r1 >> 24);
                    if (u.kind == 0) {
                        const unsigned a0 = wa[m][bj].x, a1 = wa[m][bj].y;
                        float sa[8]; sa[0] = (float)(a0 & 0xffu); sa[1] = (float)((a0 >> 8) & 0xffu); sa[2] = (float)((a0 >> 16) & 0xffu); sa[3] = (float)(a0 >> 24);
                        sa[4] = (float)(a1 & 0xffu); sa[5] = (float)((a1 >> 8) & 0xffu); sa[6] = (float)((a1 >> 16) & 0xffu); sa[7] = (float)(a1 >> 24);
#pragma unroll
                        for (int i = 0; i < 4; ++i) { acc[ai][bj][m][0][i] *= sa[i] * fast_rcp(fmaxf(sr[i], 1.0f)); acc[ai][bj][m][1][i] *= sa[4 + i] * fast_rcp(fmaxf(sr[4 + i], 1.0f)); }
                    } else {
                        const float k255 = 1.0f / 255.0f; const size_t off = (size_t)(ai * 128 + m * 16 + rl_) * DM + bj * 128 + cl_;
                        const f32x4 v0 = acc[ai][bj][m][0] * k255, v1 = acc[ai][bj][m][1] * k255;
                        u32x4 w; w.x = cvtpk(v0[0] * fmaxf(sr[0], 1.0f), v0[1] * fmaxf(sr[1], 1.0f)); w.y = cvtpk(v0[2] * fmaxf(sr[2], 1.0f), v0[3] * fmaxf(sr[3], 1.0f));
                        w.z = cvtpk(v1[0] * fmaxf(sr[4], 1.0f), v1[1] * fmaxf(sr[5], 1.0f)); w.w = cvtpk(v1[2] * fmaxf(sr[6], 1.0f), v1[3] * fmaxf(sr[7], 1.0f));
                        *(u32x4*)(MG + off) = w; }
                }
        }
        return u.kind == 0;
    }
};

struct EpiQG {
    typedef i32x4_t acc_t;
    __device__ __forceinline__ void prefetch(const Unit&, LAS unsigned char*, int) const {}
    __device__ __forceinline__ bool operator()(i32x4_t (&acc)[2][2][4][2], const Unit& u, int wr, int wc, int fr, int fq) const {
        EPI_PREP bf16_t* base = (bf16_t*)(A_WS + ((u.pn >> 2) ? WS_G : WS_Q)) + (size_t)u.pm * 256 * DM + (u.pn & 3) * 256;
        const float* SXp = (const float*)(A_WS + WS_SXN) + u.pm * 256; const float* SWp = (const float*)(A_WS + WS_SWI) + u.pn * 256;
        float sxr[2][4]; f32x4 swc[2][2];
#pragma unroll
        for (int ai = 0; ai < 2; ++ai)
#pragma unroll
            for (int m = 0; m < 4; ++m) sxr[ai][m] = SXp[ai * 128 + m * 16 + rl_];
#pragma unroll
        for (int bj = 0; bj < 2; ++bj) { swc[bj][0] = *(const f32x4*)(SWp + bj * 128 + cl_); swc[bj][1] = *(const f32x4*)(SWp + bj * 128 + cl_ + 4); }
        EPI_LOOP_BEGIN
            const float sx = sxr[ai][m]; const f32x4 w0 = swc[bj][0] * sx, w1 = swc[bj][1] * sx;
            u32x4 w; w.x = cvtpk((float)v0[0] * w0[0], (float)v0[1] * w0[1]); w.y = cvtpk((float)v0[2] * w0[2], (float)v0[3] * w0[3]);
            w.z = cvtpk((float)v1[0] * w1[0], (float)v1[1] * w1[1]); w.w = cvtpk((float)v1[2] * w1[2], (float)v1[3] * w1[3]);
            *(u32x4*)(base + (size_t)rit * DM + cit) = w;
        EPI_LOOP_END
        return false;
    }
};
struct EpiKV8 {
    typedef i32x4_t acc_t;
    __device__ __forceinline__ void prefetch(const Unit&, LAS unsigned char*, int) const {}
    __device__ __forceinline__ bool operator()(i32x4_t (&acc)[2][2][4][2], const Unit& u, int wr, int wc, int fr, int fq) const {
        EPI_PREP unsigned char* ws = A_WS;
        const float* SXN = (const float*)(ws + WS_SXN); const float* SKV = (const float*)(ws + WS_SKV);
        const float* rs = u.kind == 0 ? SXN + u.pm * 256 : SKV + 1024 + u.pm * 256;
        const float* cs = u.kind == 0 ? SKV + u.pn * 256 : SXN + u.pn * 256;
        const bool isx = u.kind == 0 && u.pn >= 8;
        bf16_t* dst = (bf16_t*)(ws + (u.kind == 0 ? (isx ? WS_XR : WS_K) : WS_VT));
        float sxr[2][4]; f32x4 swc[2][2];
#pragma unroll
        for (int ai = 0; ai < 2; ++ai)
#pragma unroll
            for (int m = 0; m < 4; ++m) sxr[ai][m] = rs[ai * 128 + m * 16 + rl_];
#pragma unroll
        for (int bj = 0; bj < 2; ++bj) { swc[bj][0] = *(const f32x4*)(cs + bj * 128 + cl_); swc[bj][1] = *(const f32x4*)(cs + bj * 128 + cl_ + 4); }
        EPI_LOOP_BEGIN
            const float sx = sxr[ai][m]; const f32x4 w0 = swc[bj][0] * sx, w1 = swc[bj][1] * sx;
            u32x4 w; w.x = cvtpk((float)v0[0] * w0[0], (float)v0[1] * w0[1]); w.y = cvtpk((float)v0[2] * w0[2], (float)v0[3] * w0[3]);
            w.z = cvtpk((float)v1[0] * w1[0], (float)v1[1] * w1[1]); w.w = cvtpk((float)v1[2] * w1[2], (float)v1[3] * w1[3]);
            const size_t off = isx ? (size_t)(u.pm * 256 + rit) * DM + (u.pn - 8) * 256 + cit : (u.kind == 0 ? kfrag_off(u.pm * 256 + rit, u.pn * 256 + cit) : vfrag_off(u.pm * 256 + rit, u.pn * 256 + cit));
            *(u32x4*)(dst + off) = w;
        EPI_LOOP_END
        return false;
    }
};
struct EpiGate {
    typedef i32x4_t acc_t;
    __device__ __forceinline__ void prefetch(const Unit&, LAS unsigned char*, int) const {}
    __device__ __forceinline__ bool operator()(i32x4_t (&acc)[2][2][4][2], const Unit& u, int wr, int wc, int fr, int fq) const {
        EPI_PREP unsigned char* g8 = (unsigned char*)(A_OUT + O_YP) + ((u.pn >> 2) ? (size_t)NTP * DM : 0) + (size_t)u.pm * 256 * DM + (u.pn & 3) * 256;
        const float* SXp = (const float*)(A_WS + WS_SXN) + u.pm * 256; const float* SWp = (const float*)(A_WS + WS_SWI) + 2048 + u.pn * 256;
        float sxr[2][4]; f32x4 swc[2][2];
#pragma unroll
        for (int ai = 0; ai < 2; ++ai)
#pragma unroll
            for (int m = 0; m < 4; ++m) sxr[ai][m] = SXp[ai * 128 + m * 16 + rl_];
#pragma unroll
        for (int bj = 0; bj < 2; ++bj) { swc[bj][0] = *(const f32x4*)(SWp + bj * 128 + cl_); swc[bj][1] = *(const f32x4*)(SWp + bj * 128 + cl_ + 4); }
        EPI_LOOP_BEGIN
            const float sx = sxr[ai][m]; const f32x4 w0 = swc[bj][0] * sx, w1 = swc[bj][1] * sx;
            u32x2 w;
            w.x = (unsigned)(int)rintf(sigmoidf_((float)v0[0] * w0[0]) * 255.0f) | ((unsigned)(int)rintf(sigmoidf_((float)v0[1] * w0[1]) * 255.0f) << 8) | ((unsigned)(int)rintf(sigmoidf_((float)v0[2] * w0[2]) * 255.0f) << 16) | ((unsigned)(int)rintf(sigmoidf_((float)v0[3] * w0[3]) * 255.0f) << 24);
            w.y = (unsigned)(int)rintf(sigmoidf_((float)v1[0] * w1[0]) * 255.0f) | ((unsigned)(int)rintf(sigmoidf_((float)v1[1] * w1[1]) * 255.0f) << 8) | ((unsigned)(int)rintf(sigmoidf_((float)v1[2] * w1[2]) * 255.0f) << 16) | ((unsigned)(int)rintf(sigmoidf_((float)v1[3] * w1[3]) * 255.0f) << 24);
            *(u32x2*)(g8 + (size_t)rit * DM + cit) = w;
        EPI_LOOP_END
        return false;
    }
};
struct EpiP4 {
    typedef f32x4 acc_t;
    __device__ __forceinline__ void prefetch(const Unit&, LAS unsigned char*, int) const {}
    __device__ __forceinline__ bool operator()(f32x4 (&acc)[2][2][4][2], const Unit& u, int wr, int wc, int fr, int fq) const {
        EPI_PREP bf16_t* base = (bf16_t*)(A_WS + WS_DELTA) + (size_t)u.pm * 256 * DM + u.pn * 256;
        EPI_LOOP_BEGIN
            u32x4 w; w.x = cvtpk(v0[0], v0[1]); w.y = cvtpk(v0[2], v0[3]); w.z = cvtpk(v1[0], v1[1]); w.w = cvtpk(v1[2], v1[3]);
            *(u32x4*)(base + (size_t)rit * DM + cit) = w;
        EPI_LOOP_END
        return false;
    }
};

struct EpiP5 {
    typedef i32x4_t acc_t;
    __device__ __forceinline__ void prefetch(const Unit&, LAS unsigned char*, int) const {}
    __device__ __forceinline__ bool operator()(i32x4_t (&acc)[2][2][4][2], const Unit& u, int wr, int wc, int fr, int fq) const {
        EPI_PREP bf16_t* SC = (bf16_t*)(A_WS + WS_XN) + (size_t)u.pm * 256 * 2048 + u.pn * 256;
        const float* SXp = (const float*)(A_WS + WS_SX) + u.pm * 256; const float* SWp = (const float*)(A_WS + WS_SW) + u.pn * 256;
        float sxr[2][4]; f32x4 swc[2][2];
#pragma unroll
        for (int ai = 0; ai < 2; ++ai)
#pragma unroll
            for (int m = 0; m < 4; ++m) sxr[ai][m] = SXp[ai * 128 + m * 16 + rl_];
#pragma unroll
        for (int bj = 0; bj < 2; ++bj) { swc[bj][0] = *(const f32x4*)(SWp + bj * 128 + cl_); swc[bj][1] = *(const f32x4*)(SWp + bj * 128 + cl_ + 4); }
        EPI_LOOP_BEGIN
            const float sx = sxr[ai][m]; const f32x4 w0 = swc[bj][0] * sx, w1 = swc[bj][1] * sx;
            u32x4 w; w.x = cvtpk((float)v0[0] * w0[0], (float)v0[1] * w0[1]); w.y = cvtpk((float)v0[2] * w0[2], (float)v0[3] * w0[3]);
            w.z = cvtpk((float)v1[0] * w1[0], (float)v1[1] * w1[1]); w.w = cvtpk((float)v1[2] * w1[2], (float)v1[3] * w1[3]);
            *(u32x4*)(SC + (size_t)rit * 2048 + cit) = w;
        EPI_LOOP_END
        return false;
    }
};

__device__ __forceinline__ void row_ld(const float* p, f32x4 (&v)[4], int lane) {
#pragma unroll
    for (int j = 0; j < 4; ++j) v[j] = *(const f32x4*)(p + j * 256 + lane * 4);
}
__device__ __forceinline__ float row_ss(const f32x4 (&v)[4]) { float s = 0.f;
#pragma unroll
    for (int j = 0; j < 4; ++j) s += (v[j][0] * v[j][0] + v[j][1] * v[j][1]) + (v[j][2] * v[j][2] + v[j][3] * v[j][3]);
    return s; }
__device__ __forceinline__ void row_add_bf16(const bf16_t* p, f32x4 (&v)[4], int lane) {
#pragma unroll
    for (int j = 0; j < 4; ++j) { const u32x2 w = *(const u32x2*)(p + j * 256 + lane * 4); v[j][0] += bflo(w.x); v[j][1] += bfhi(w.x); v[j][2] += bflo(w.y); v[j][3] += bfhi(w.y); }
}
__device__ __forceinline__ const float* xrow_ptr(int m) { return (m < NTP) ? A_IN(0) + (size_t)m * DM : A_IN(1) + (size_t)(m - NTP) * DM; }
__device__ __forceinline__ float* yrow_ptr(int m) { return (m < NTP) ? A_OUT + O_YP + (size_t)m * DM : A_OUT + O_YS + (size_t)(m - NTP) * DM; }

__device__ __forceinline__ void p0_transpose_item(const float* W, int K, int N, bf16_t* WT, LAS float* scr, int item, int lane, int nscale = 0) {
    const int nblk = N / 32, kb = item / nblk, nb = item % nblk, k0 = 64 * kb, n0 = 32 * nb;
#pragma unroll 8
    for (int i = 0; i < 32; ++i) { const int kk = 2 * i + (lane >> 5); scr[kk * 33 + (lane & 31)] = W[(size_t)(k0 + kk) * N + n0 + (lane & 31)] * (n0 < nscale ? QSCALE : 1.0f); }
    asm volatile("s_waitcnt lgkmcnt(0)" ::: "memory");
    const int c = lane & 7;
#pragma unroll
    for (int j = 0; j < 4; ++j) { const int n = (lane >> 3) + 8 * j; const LAS float* s = scr + (8 * c) * 33 + n;
        u32x4 o; o.x = cvtpk(s[0 * 33], s[1 * 33]); o.y = cvtpk(s[2 * 33], s[3 * 33]); o.z = cvtpk(s[4 * 33], s[5 * 33]); o.w = cvtpk(s[6 * 33], s[7 * 33]);
        *(u32x4*)(WT + (size_t)(n0 + n) * K + k0 + 8 * c) = o; }
    asm volatile("s_waitcnt lgkmcnt(0)" ::: "memory");
}

__device__ __forceinline__ void p0a_prologue(LAS unsigned char* lds, int G, int wave, int lane) {
    unsigned char* ws = A_WS;
    const int gw = blockIdx.x * 8 + wave, NGW = G * 8;
    LAS float* scr = (LAS float*)(lds + wave * 16384);
    constexpr int I_IN = 16 * (INC / 32), I_SQ = 16 * 32, NTR = I_IN + 3 * I_SQ;
    for (int it = gw; it < NTR; it += NGW) {
        int r = it;
        if (r < I_IN) { p0_transpose_item(A_IN(7), DM, INC, (bf16_t*)(ws + WS_WIN), scr, r, lane, 1024); continue; } r -= I_IN;
        if (r < I_SQ) { p0_transpose_item(A_IN(16), DM, DM, (bf16_t*)(ws + WS_WBA), scr, r, lane); continue; } r -= I_SQ;
        if (r < I_SQ) { p0_transpose_item(A_IN(17), DM, DM, (bf16_t*)(ws + WS_WBL), scr, r, lane); continue; } r -= I_SQ;
        p0_transpose_item(A_IN(18), DM, DM, (bf16_t*)(ws + WS_WO), scr, r, lane);
    }
    {
        const float* wq = A_IN(20); bf16_t* wst = (bf16_t*)(ws + WS_WS);
        const int r32 = lane & 31, hi = lane >> 5;
        for (int it = gw; it < 2048; it += NGW) {
            const int hj = it >> 7, kt = (it >> 5) & 3, ct = it & 31, h = hj >> 1, j = hj & 1;
            const float* ap = (j ? A_IN(22) : A_IN(21)) + ((size_t)(h * 128 + kt * 32 + r32)) * 128 + 64 * hi;
            const float* bp = wq + (size_t)(ct * 32 + r32) * 2048 + hj * 128 + 64 * hi;
            f32x16 acc = {};
#pragma unroll
            for (int s4 = 0; s4 < 16; ++s4) { const f32x4 av = *(const f32x4*)(ap + 4 * s4), bv = *(const f32x4*)(bp + 4 * s4);
                acc = __builtin_amdgcn_mfma_f32_32x32x2f32(av[0], bv[0], acc, 0, 0, 0); acc = __builtin_amdgcn_mfma_f32_32x32x2f32(av[1], bv[1], acc, 0, 0, 0);
                acc = __builtin_amdgcn_mfma_f32_32x32x2f32(av[2], bv[2], acc, 0, 0, 0); acc = __builtin_amdgcn_mfma_f32_32x32x2f32(av[3], bv[3], acc, 0, 0, 0); }
#pragma unroll
            for (int r = 0; r < 16; ++r) { const int key = kt * 32 + (r & 3) + 8 * (r >> 2) + 4 * hi;
                wst[(size_t)(key * 16 + hj) * DM + ct * 32 + r32] = (bf16_t)(cvtpk(acc[r], 0.f) & 0xffffu); }
        }
    }
    {
        bf16_t* fw = (bf16_t*)(ws + WS_LRUW);
        for (int f = gw; f < 256; f += NGW) {
            const int ks = f & 3, T = (f >> 2) & 1, gate = (f >> 3) & 1, g = f >> 4, i = lane & 31, hi = lane >> 5;
            const int outc = 32 * T + swap23(i);
            const float* W = (gate ? A_IN(13) : A_IN(11)) + (size_t)g * 4096;
            float x[8];
#pragma unroll
            for (int j = 0; j < 8; ++j) x[j] = W[(16 * ks + 8 * hi + j) * 64 + outc];
            u32x4 w; w.x = cvtpk(x[0], x[1]); w.y = cvtpk(x[2], x[3]); w.z = cvtpk(x[4], x[5]); w.w = cvtpk(x[6], x[7]);
            *(u32x4*)(fw + (size_t)f * 512 + lane * 8) = w;
        }
    }
}

__device__ __forceinline__ void p0b_prologue(LAS unsigned char* lds, int G, int wave, int lane) {
    unsigned char* ws = A_WS;
    const int gw = blockIdx.x * 8 + wave, NGW = G * 8;
    LAS float* scr = (LAS float*)(lds + wave * 16384);
    {
        f32x4 p[4], pn[4];
        if (gw < 2 * NEXP) {
#pragma unroll
            for (int q = 0; q < 4; ++q) p[q] = *(const f32x4*)(((gw >= NEXP) ? A_IN(24) + (size_t)(gw - NEXP) * DM : A_IN(23) + (size_t)gw * DM) + lane * 16 + 4 * q); }
        for (int it = gw; it < 2 * NEXP; it += NGW) {
            const int tb = it >= NEXP, e = it - tb * NEXP, itn = it + NGW;
            if (itn < 2 * NEXP) {
#pragma unroll
                for (int q = 0; q < 4; ++q) pn[q] = *(const f32x4*)(((itn >= NEXP) ? A_IN(24) + (size_t)(itn - NEXP) * DM : A_IN(23) + (size_t)itn * DM) + lane * 16 + 4 * q); }
            unsigned char* dst = ws + (tb ? WS_VB : WS_UB) + (size_t)e * DM + lane * 16;
            float mx = 0.f;
#pragma unroll
            for (int q = 0; q < 4; ++q) mx = fmaxf(mx, fmaxf(fmaxf(fabsf(p[q][0]), fabsf(p[q][1])), fmaxf(fabsf(p[q][2]), fabsf(p[q][3]))));
            mx = wave_max(mx);
            const float step = fmaxf(mx, 1e-30f) * (1.0f / 127.0f), inv = 1.0f / step;
            u32x4 w;
#pragma unroll
            for (int q = 0; q < 4; ++q) {
                const unsigned b0 = (unsigned)(int)rintf(p[q][0] * inv) & 0xffu, b1 = (unsigned)(int)rintf(p[q][1] * inv) & 0xffu, b2 = (unsigned)(int)rintf(p[q][2] * inv) & 0xffu, b3 = (unsigned)(int)rintf(p[q][3] * inv) & 0xffu;
                w[q] = b0 | (b1 << 8) | (b2 << 16) | (b3 << 24); }
            *(u32x4*)dst = w;
            if (lane == 0) ((float*)(ws + (tb ? WS_SV : WS_SU)))[e] = step;
#pragma unroll
            for (int q = 0; q < 4; ++q) p[q] = pn[q];
        }
    }
    {
        const float* gm = A_IN(6); bf16_t* XN = (bf16_t*)(ws + WS_XN);
        for (int m = NTOK + gw; m < ROWS; m += NGW) {
#pragma unroll
            for (int j = 0; j < 2; ++j) *(u32x4*)(XN + (size_t)m * DM + j * 512 + lane * 8) = (u32x4){0u, 0u, 0u, 0u}; }
        f32x4 v[4], vn[4], ggr[4];
#pragma unroll
        for (int j = 0; j < 4; ++j) ggr[j] = *(const f32x4*)(gm + j * 256 + lane * 4);
        if (gw < NTOK) row_ld(xrow_ptr(gw), v, lane);
        for (int m = gw; m < NTOK; m += NGW) {
            const int mn = m + NGW;
            if (mn < NTOK) row_ld(xrow_ptr(mn), vn, lane);
            bf16_t* orow = XN + (size_t)m * DM;
            const bool needbf = m >= NTP || (m & (SEQ - 1)) >= SEQ - 512;
            const float ss = row_ss(v);
            float mx = 0.f;
#pragma unroll
            for (int j = 0; j < 4; ++j) { v[j] = v[j] * ggr[j];
                mx = fmaxf(mx, fmaxf(fmaxf(fabsf(v[j][0]), fabsf(v[j][1])), fmaxf(fabsf(v[j][2]), fabsf(v[j][3])))); }
            const float inv = __builtin_amdgcn_rsqf(wave_sum(ss) * (1.0f / DM) + EPS);
            mx = fmaxf(wave_max(mx), 1e-30f);
            if (needbf) {
#pragma unroll
                for (int j = 0; j < 4; ++j) { const f32x4 t = v[j] * inv; u32x2 w; w.x = cvtpk(t[0], t[1]); w.y = cvtpk(t[2], t[3]); *(u32x2*)(orow + j * 256 + lane * 4) = w; } }
            if (m < NTP) {
                const float step = mx * inv * (1.0f / 127.0f), qi = 127.0f * fast_rcp(mx);
                unsigned char* xq = (unsigned char*)(A_OUT + O_YP) + (size_t)2 * NTP * DM + (size_t)m * DM;
#pragma unroll
                for (int j = 0; j < 4; ++j) {
                    const unsigned b0 = (unsigned)(int)rintf(v[j][0] * qi) & 0xffu, b1 = (unsigned)(int)rintf(v[j][1] * qi) & 0xffu, b2 = (unsigned)(int)rintf(v[j][2] * qi) & 0xffu, b3 = (unsigned)(int)rintf(v[j][3] * qi) & 0xffu;
                    *(unsigned*)(xq + j * 256 + lane * 4) = b0 | (b1 << 8) | (b2 << 16) | (b3 << 24); }
                if (lane == 0) ((float*)(ws + WS_SXN))[m] = step;
            }
#pragma unroll
            for (int j = 0; j < 4; ++j) v[j] = vn[j];
        }
    }
}

__device__ __forceinline__ void p0c_prologue(LAS unsigned char* lds, int G, int wave, int lane) {
    unsigned char* ws = A_WS;
    const int gw = blockIdx.x * 8 + wave, NGW = G * 8;
    LAS float* scr = (LAS float*)(lds + wave * 16384);
    for (int n = gw; n < 7168; n += NGW) {
        const int srow = n < 1024 ? n : (n < 2048 ? 4096 + (n - 1024) : (n < 4096 ? 5120 + (n - 2048) : n - 3072));
        const bf16_t* wr_ = (const bf16_t*)(ws + WS_WIN) + (size_t)srow * DM + lane * 16;
        const u32x4 a = *(const u32x4*)wr_, b = *(const u32x4*)(wr_ + 8);
        float f[16]; f[0] = bflo(a.x); f[1] = bfhi(a.x); f[2] = bflo(a.y); f[3] = bfhi(a.y); f[4] = bflo(a.z); f[5] = bfhi(a.z); f[6] = bflo(a.w); f[7] = bfhi(a.w);
        f[8] = bflo(b.x); f[9] = bfhi(b.x); f[10] = bflo(b.y); f[11] = bfhi(b.y); f[12] = bflo(b.z); f[13] = bfhi(b.z); f[14] = bflo(b.w); f[15] = bfhi(b.w);
        float mx = 0.f;
#pragma unroll
        for (int j = 0; j < 16; ++j) mx = fmaxf(mx, fabsf(f[j]));
        mx = wave_max(mx);
        const float step = fmaxf(mx, 1e-30f) * (1.0f / 127.0f), qi = 1.0f / step;
        u32x4 w;
#pragma unroll
        for (int q = 0; q < 4; ++q) w[q] = ((unsigned)(int)rintf(f[4 * q] * qi) & 0xffu) | (((unsigned)(int)rintf(f[4 * q + 1] * qi) & 0xffu) << 8) | (((unsigned)(int)rintf(f[4 * q + 2] * qi) & 0xffu) << 16) | (((unsigned)(int)rintf(f[4 * q + 3] * qi) & 0xffu) << 24);
        if (n < 4096) { *(u32x4*)(ws + WS_WIQ + (size_t)n * DM + lane * 16) = w; if (lane == 0) ((float*)(ws + WS_SWI))[n] = step; }
        else { *(u32x4*)(ws + WS_WKV8 + (size_t)(n - 4096) * DM + lane * 16) = w; if (lane == 0) ((float*)(ws + WS_SKV))[n - 4096] = step; }
    }
}

constexpr int LR_WF = 0, LR_CW = 16384, LR_CB = LR_CW + 1024, LR_BR = LR_CB + 256, LR_BI = LR_BR + 256, LR_CS = LR_BI + 256, LR_CARRY = LR_CS + 256, LR_SEQ = LR_CARRY + 2048, LR_END = LR_SEQ + 64, LR_DUMMY = 21504;

__device__ __forceinline__ void lru_load_consts(LAS unsigned char* lds, int g, int t, int nt) {
    const u32x4* src = (const u32x4*)(A_WS + WS_LRUW + (size_t)g * 16384);
    for (int i = t; i < 1024; i += nt) ((LAS u32x4*)(lds + LR_WF))[i] = src[i];
    for (int i = t; i < 256; i += nt) ((LAS float*)(lds + LR_CW))[i] = A_IN(9)[(i >> 6) * DM + g * 64 + (i & 63)];
    for (int i = t; i < 64; i += nt) {
        const int c = g * 64 + i;
        ((LAS float*)(lds + LR_CB))[i] = A_IN(10)[c]; ((LAS float*)(lds + LR_BR))[i] = A_IN(12)[c]; ((LAS float*)(lds + LR_BI))[i] = A_IN(14)[c];
        ((LAS float*)(lds + LR_CS))[i] = 8.0f * log1pf(expf(-A_IN(15)[c]));
    }
    if (t < 8) ((LAS unsigned*)(lds + LR_SEQ))[t] = 0xffffffffu;
}

template <bool SAMPLE>
__device__ __forceinline__ void lru_tile(LAS unsigned char* lds, int lane, int g, size_t rowbase, int tile, int bidx, int pfd) {
    asm volatile("" : "+v"(lane));
    const int tl = lane & 31, hi = lane >> 5, t = tile * 32 + tl;
    const bf16_t* XR = (const bf16_t*)(A_WS + WS_XR); bf16_t* Gb = (bf16_t*)(A_WS + WS_G);
    const int cbase = g * 64 + 8 * hi;
    u32x4 gw4[4];
    {   const bf16_t* gp0 = Gb + (rowbase + (SAMPLE ? (tl < NST ? t : 0) : t)) * DM + cbase;
#pragma unroll
        for (int ks = 0; ks < 4; ++ks) gw4[ks] = *(const u32x4*)(gp0 + 16 * ks); }
    float xc[4][8];
    bf16x8 xf[4];
#pragma unroll
    for (int ks = 0; ks < 4; ++ks) {
        const f32x4 b0 = *(const LAS f32x4*)(lds + LR_CB + (16 * ks + 8 * hi) * 4), b1 = *(const LAS f32x4*)(lds + LR_CB + (16 * ks + 8 * hi) * 4 + 16);
#pragma unroll
        for (int j = 0; j < 4; ++j) { xc[ks][j] = b0[j]; xc[ks][4 + j] = b1[j]; }
#pragma unroll
        for (int tap = 0; tap < 4; ++tap) {
            const int rr = t - 3 + tap;
            float xv[8];
            {
                u32x4 w = *(const u32x4*)(XR + (rowbase + (rr < 0 ? 0 : rr)) * DM + cbase + 16 * ks);
                if (rr < 0) w = (u32x4){0u, 0u, 0u, 0u};
                xv[0] = bflo(w.x); xv[1] = bfhi(w.x); xv[2] = bflo(w.y); xv[3] = bfhi(w.y); xv[4] = bflo(w.z); xv[5] = bfhi(w.z); xv[6] = bflo(w.w); xv[7] = bfhi(w.w);
            }
            if (SAMPLE) {
                const float* sp = A_IN(4) + ((size_t)bidx * 3 + (rr < 0 ? 3 + rr : 0)) * DM + cbase + 16 * ks;
                const f32x4 p = *(const f32x4*)sp, q = *(const f32x4*)(sp + 4);
#pragma unroll
                for (int j = 0; j < 4; ++j) { xv[j] = rr < 0 ? p[j] : xv[j]; xv[4 + j] = rr < 0 ? q[j] : xv[4 + j]; }
            }
            const f32x4 w0 = *(const LAS f32x4*)(lds + LR_CW + (tap * 64 + 16 * ks + 8 * hi) * 4), w1 = *(const LAS f32x4*)(lds + LR_CW + (tap * 64 + 16 * ks + 8 * hi) * 4 + 16);
#pragma unroll
            for (int j = 0; j < 4; ++j) { xc[ks][j] += w0[j] * xv[j]; xc[ks][4 + j] += w1[j] * xv[4 + j]; }
        }
        u32x4 w; w.x = cvtpk(xc[ks][0], xc[ks][1]); w.y = cvtpk(xc[ks][2], xc[ks][3]); w.z = cvtpk(xc[ks][4], xc[ks][5]); w.w = cvtpk(xc[ks][6], xc[ks][7]);
        xf[ks] = __builtin_bit_cast(bf16x8, w);
        asm volatile("" ::: "memory");
    }
    float A[32], B[32];
#pragma unroll
    for (int T = 0; T < 2; ++T) {
        f32x16 ar = f32x16{}, ai = f32x16{};
#pragma unroll
        for (int ks = 0; ks < 4; ++ks) {
            const bf16x8 wr_ = *(const LAS bf16x8*)(lds + LR_WF + ((0 * 2 + T) * 4 + ks) * 1024 + lane * 16);
            const bf16x8 wi_ = *(const LAS bf16x8*)(lds + LR_WF + ((1 * 2 + T) * 4 + ks) * 1024 + lane * 16);
            ar = __builtin_amdgcn_mfma_f32_32x32x16_bf16(wr_, xf[ks], ar, 0, 0, 0);
            ai = __builtin_amdgcn_mfma_f32_32x32x16_bf16(wi_, xf[ks], ai, 0, 0, 0);
        }
#pragma unroll
        for (int q = 0; q < 2; ++q) {
            const int ks = 2 * T + q, lo = (16 * ks + 8 * hi) * 4;
            const f32x4 br0 = *(const LAS f32x4*)(lds + LR_BR + lo), br1 = *(const LAS f32x4*)(lds + LR_BR + lo + 16);
            const f32x4 bi0 = *(const LAS f32x4*)(lds + LR_BI + lo), bi1 = *(const LAS f32x4*)(lds + LR_BI + lo + 16);
            const f32x4 cs0 = *(const LAS f32x4*)(lds + LR_CS + lo), cs1 = *(const LAS f32x4*)(lds + LR_CS + lo + 16);
#pragma unroll
            for (int j = 0; j < 8; ++j) {
                const int r = 8 * q + j;
                const float brv = j < 4 ? br0[j & 3] : br1[j & 3], biv = j < 4 ? bi0[j & 3] : bi1[j & 3], csv = j < 4 ? cs0[j & 3] : cs1[j & 3];
                const float rg = sigmoidf_(ar[r] + brv), ig = sigmoidf_(ai[r] + biv);
                const float la = -csv * rg, av = fast_exp2(la * LOG2E);
                const float x2 = 2.0f * la;
                const float em = (x2 > -0.03f) ? -x2 * (1.0f + x2 * (0.5f + x2 * (0.16666667f + x2 * 0.041666668f))) : 1.0f - av * av;
                A[16 * T + r] = av; B[16 * T + r] = __builtin_amdgcn_sqrtf(em) * ig * xc[ks][j];
            }
        }
        asm volatile("" ::: "memory");
    }
#define LRU_STEP(DPPSTR) do { \
    _Pragma("unroll") for (int c = 0; c < 32; ++c) asm volatile("v_fmac_f32_dpp %0, %0, %1 " DPPSTR : "+v"(B[c]) : "v"(A[c])); \
    _Pragma("unroll") for (int c = 0; c < 32; ++c) asm volatile("v_mul_f32_dpp %0, %0, %0 " DPPSTR : "+v"(A[c])); } while (0)
    asm volatile("s_nop 1");
    LRU_STEP("row_shr:1 row_mask:0xf bank_mask:0xf"); LRU_STEP("row_shr:2 row_mask:0xf bank_mask:0xf"); LRU_STEP("row_shr:4 row_mask:0xf bank_mask:0xf");
    LRU_STEP("row_shr:8 row_mask:0xf bank_mask:0xf"); LRU_STEP("row_bcast:15 row_mask:0xa bank_mask:0xf");
#undef LRU_STEP
    float hin[32];
    if (SAMPLE) {
        const float* hp = A_IN(5) + (size_t)bidx * DM + cbase;
#pragma unroll
        for (int ks = 0; ks < 4; ++ks) { const f32x4 p = *(const f32x4*)(hp + 16 * ks), q = *(const f32x4*)(hp + 16 * ks + 4);
#pragma unroll
            for (int j = 0; j < 4; ++j) { hin[8 * ks + j] = p[j]; hin[8 * ks + 4 + j] = q[j]; } }
    } else if (tile == 0) {
#pragma unroll
        for (int c = 0; c < 32; ++c) hin[c] = 0.f;
    } else {
        volatile LAS unsigned* sq = (volatile LAS unsigned*)(lds + LR_SEQ) + (tile & 7);
        while (*sq != (unsigned)tile) __builtin_amdgcn_s_sleep(1);
        asm volatile("" ::: "memory");
        const LAS float* cp = (const LAS float*)(lds + LR_CARRY) + (tile & 7) * 64 + 8 * hi;
#pragma unroll
        for (int ks = 0; ks < 4; ++ks) { const f32x4 p = *(const LAS f32x4*)(cp + 16 * ks), q = *(const LAS f32x4*)(cp + 16 * ks + 4);
#pragma unroll
            for (int j = 0; j < 4; ++j) { hin[8 * ks + j] = p[j]; hin[8 * ks + 4 + j] = q[j]; } }
    }
#pragma unroll
    for (int c = 0; c < 32; ++c) B[c] = B[c] + A[c] * hin[c];
    if (!SAMPLE) {
        if (tl == 31) {
            if (tile < 127) {
                LAS float* cp = (LAS float*)(lds + LR_CARRY) + ((tile + 1) & 7) * 64 + 8 * hi;
#pragma unroll
                for (int ks = 0; ks < 4; ++ks) { *(LAS f32x4*)(cp + 16 * ks) = (f32x4){B[8 * ks], B[8 * ks + 1], B[8 * ks + 2], B[8 * ks + 3]};
                    *(LAS f32x4*)(cp + 16 * ks + 4) = (f32x4){B[8 * ks + 4], B[8 * ks + 5], B[8 * ks + 6], B[8 * ks + 7]}; }
            } else {
                float* lp = A_OUT + O_LP + (size_t)bidx * DM + cbase;
#pragma unroll
                for (int ks = 0; ks < 4; ++ks) { *(f32x4*)(lp + 16 * ks) = (f32x4){B[8 * ks], B[8 * ks + 1], B[8 * ks + 2], B[8 * ks + 3]};
                    *(f32x4*)(lp + 16 * ks + 4) = (f32x4){B[8 * ks + 4], B[8 * ks + 5], B[8 * ks + 6], B[8 * ks + 7]}; }
            }
        }
        if (tile < 127) {
            asm volatile("s_waitcnt lgkmcnt(0)" ::: "memory");
            if (lane == 63) *((volatile LAS unsigned*)(lds + LR_SEQ) + ((tile + 1) & 7)) = (unsigned)(tile + 1);
        }
    } else if (tl == 15) {
        float* lp = A_OUT + O_LS + (size_t)bidx * DM + cbase;
#pragma unroll
        for (int ks = 0; ks < 4; ++ks) { *(f32x4*)(lp + 16 * ks) = (f32x4){B[8 * ks], B[8 * ks + 1], B[8 * ks + 2], B[8 * ks + 3]};
            *(f32x4*)(lp + 16 * ks + 4) = (f32x4){B[8 * ks + 4], B[8 * ks + 5], B[8 * ks + 6], B[8 * ks + 7]}; }
    }
    if (!SAMPLE || tl < NST) {
        bf16_t* gp = Gb + (rowbase + t) * DM + cbase;
#pragma unroll
        for (int ks = 0; ks < 4; ++ks) {
            const u32x4 w = gw4[ks];
            float gv[8]; gv[0] = bflo(w.x); gv[1] = bfhi(w.x); gv[2] = bflo(w.y); gv[3] = bfhi(w.y); gv[4] = bflo(w.z); gv[5] = bfhi(w.z); gv[6] = bflo(w.w); gv[7] = bfhi(w.w);
            float o[8];
#pragma unroll
            for (int j = 0; j < 8; ++j) o[j] = B[8 * ks + j] * gelu_tanh(gv[j]);
            u32x4 ow; ow.x = cvtpk(o[0], o[1]); ow.y = cvtpk(o[2], o[3]); ow.z = cvtpk(o[4], o[5]); ow.w = cvtpk(o[6], o[7]);
            *(u32x4*)(gp + 16 * ks) = ow;
        }
    }
    (void)pfd;
}

constexpr int P2_Q = 20608;
constexpr int AT_TAB = 24576;
__device__ __forceinline__ void attn_unit(LAS unsigned char* lds, int lane, int b, int c, int h) {
    const int r32 = lane & 31, hi = lane >> 5, kr = swap23(r32);
    const bf16_t* Q = (const bf16_t*)(A_WS + WS_Q); const bf16_t* Kb = (const bf16_t*)(A_WS + WS_K); const bf16_t* VT = (const bf16_t*)(A_WS + WS_VT); bf16_t* O = (bf16_t*)(A_WS + WS_XN);
    const size_t row0 = (size_t)b * SEQ + (size_t)c * 64;
    bf16x8 qf[2][4];
#pragma unroll
    for (int qb = 0; qb < 2; ++qb)
#pragma unroll
        for (int ks = 0; ks < 4; ++ks) qf[qb][ks] = *(const bf16x8*)(Q + (row0 + qb * 32 + r32) * DM + h * 64 + ks * 16 + hi * 8);
    f32x16 o[2][2];
#pragma unroll
    for (int i = 0; i < 2; ++i)
#pragma unroll
        for (int j = 0; j < 2; ++j) o[i][j] = f32x16{};
    float mrow[2] = {-1e30f, -1e30f}, lrow[2] = {0.f, 0.f};
    const LAS float* tab = (const LAS float*)(lds + AT_TAB) + h * 320;
    const float cfar = tab[256];
    const int sb0 = (c >= 8 ? c - 8 : 0) * 2, sb1 = c * 2 + 1;
    const bf16_t* kbase = Kb + ((size_t)b * 128 * 16 + h) * 4 * 512 + lane * 8;
    const bf16_t* vbase = VT + ((size_t)b * 128 * 16 + h) * 4 * 512 + lane * 8;
    bf16x8 kf[4], vf[2][2];
#pragma unroll
    for (int ks = 0; ks < 4; ++ks) kf[ks] = *(const bf16x8*)(kbase + (size_t)sb0 * 32768 + ks * 512);
#pragma unroll
    for (int db = 0; db < 2; ++db)
#pragma unroll
        for (int s = 0; s < 2; ++s) vf[db][s] = *(const bf16x8*)(vbase + (size_t)sb0 * 32768 + (db * 2 + s) * 512);
    for (int sb = sb0; sb <= sb1; ++sb) {
        const int sbn = sb < sb1 ? sb + 1 : sb;
        f32x16 S[2];
#pragma unroll
        for (int qb = 0; qb < 2; ++qb) { S[qb] = f32x16{};
#pragma unroll
            for (int ks = 0; ks < 4; ++ks) S[qb] = __builtin_amdgcn_mfma_f32_32x32x16_bf16(kf[ks], qf[qb][ks], S[qb], 0, 0, 0); }
        asm volatile("" ::: "memory");
#pragma unroll
        for (int ks = 0; ks < 4; ++ks) kf[ks] = *(const bf16x8*)(kbase + (size_t)sbn * 32768 + ks * 512);
        const int delta = c - (sb >> 1), rb = sb & 1;
        if (delta >= 3) {
#pragma unroll
            for (int qb = 0; qb < 2; ++qb)
#pragma unroll
                for (int r = 0; r < 16; ++r) S[qb][r] += cfar;
        } else {
#pragma unroll
            for (int qb = 0; qb < 2; ++qb) {
                const LAS float* tp = tab + (64 * delta + 32 * qb + r32 + 128 - 32 * rb - 8 * hi - 23);
#pragma unroll
                for (int r = 0; r < 16; ++r) S[qb][r] += tp[23 - (16 * (r >> 3) + (r & 7))];
            }
        }
        float rm[2];
#pragma unroll
        for (int qb = 0; qb < 2; ++qb) { float mx = S[qb][0];
#pragma unroll
            for (int r = 1; r < 16; ++r) mx = fmaxf(mx, S[qb][r]);
            rm[qb] = plswap_max(mx); }
        if (__any((rm[0] > mrow[0] + 8.0f) || (rm[1] > mrow[1] + 8.0f))) {
#pragma unroll
            for (int qb = 0; qb < 2; ++qb) { const float mn = fmaxf(mrow[qb], rm[qb]); const float al = fast_exp2(mrow[qb] - mn); lrow[qb] *= al; mrow[qb] = mn;
#pragma unroll
                for (int r = 0; r < 16; ++r) { o[0][qb][r] *= al; o[1][qb][r] *= al; } }
        }
        bf16x8 pf[2][2];
#pragma unroll
        for (int qb = 0; qb < 2; ++qb) { float sum = 0.f;
#pragma unroll
            for (int r = 0; r < 16; ++r) { S[qb][r] = fast_exp2(S[qb][r] - mrow[qb]); sum += S[qb][r]; }
            lrow[qb] += sum;
#pragma unroll
            for (int s = 0; s < 2; ++s) { u32x4 w; w.x = cvtpk(S[qb][8 * s], S[qb][8 * s + 1]); w.y = cvtpk(S[qb][8 * s + 2], S[qb][8 * s + 3]); w.z = cvtpk(S[qb][8 * s + 4], S[qb][8 * s + 5]); w.w = cvtpk(S[qb][8 * s + 6], S[qb][8 * s + 7]);
                pf[qb][s] = __builtin_bit_cast(bf16x8, w); } }
#pragma unroll
        for (int db = 0; db < 2; ++db)
#pragma unroll
            for (int qb = 0; qb < 2; ++qb)
#pragma unroll
                for (int s = 0; s < 2; ++s) o[db][qb] = __builtin_amdgcn_mfma_f32_32x32x16_bf16(vf[db][s], pf[qb][s], o[db][qb], 0, 0, 0);
        asm volatile("" ::: "memory");
#pragma unroll
        for (int db = 0; db < 2; ++db)
#pragma unroll
            for (int s = 0; s < 2; ++s) vf[db][s] = *(const bf16x8*)(vbase + (size_t)sbn * 32768 + (db * 2 + s) * 512);
    }
#pragma unroll
    for (int qb = 0; qb < 2; ++qb) { const float inv = fast_rcp(plswap_add(lrow[qb]));
        bf16_t* op = O + (row0 + qb * 32 + r32) * DM + h * 64 + 8 * hi;
#pragma unroll
        for (int db = 0; db < 2; ++db)
#pragma unroll
            for (int s = 0; s < 2; ++s) { u32x4 w;
                w.x = cvtpk(o[db][qb][8 * s] * inv, o[db][qb][8 * s + 1] * inv); w.y = cvtpk(o[db][qb][8 * s + 2] * inv, o[db][qb][8 * s + 3] * inv);
                w.z = cvtpk(o[db][qb][8 * s + 4] * inv, o[db][qb][8 * s + 5] * inv); w.w = cvtpk(o[db][qb][8 * s + 6] * inv, o[db][qb][8 * s + 7] * inv);
                *(u32x4*)(op + 32 * db + 16 * s) = w; } }
}

constexpr int AS_P = 45056;
__device__ __forceinline__ void attn_sample_task(LAS unsigned char* lds, int wave, int lane, int task) {
    const int bs = task >> 6, h = (task >> 2) & 15, qg = task & 3;
    const bf16_t* Q = (const bf16_t*)(A_WS + WS_Q); bf16_t* O = (bf16_t*)(A_WS + WS_XN);
    const float* ck = A_IN(2); const float* cv = A_IN(3); const float* kn = A_OUT + O_KS; const float* vn = A_OUT + O_VS;
    LAS float* pb = (LAS float*)(lds + AS_P + wave * 9472);
    LAS float* qs = pb + 4 * 528;
    const LAS float* tab = (const LAS float*)(lds + AT_TAB) + h * 320;
#pragma unroll
    for (int i = 0; i < 4; ++i) qs[i * 64 + lane] = bflo((unsigned)Q[((size_t)NTP + bs * 16 + qg * 4 + i) * DM + h * 64 + lane]);
    asm volatile("s_waitcnt lgkmcnt(0)" ::: "memory");
#pragma unroll 1
    for (int it = 0; it < 9; ++it) {
        const int key = it * 64 + lane; const bool valid = key < 528;
        const float* kp = !valid ? ck : (key < 512 ? ck + (((size_t)bs * 512 + key) * 16 + h) * 64 : kn + ((size_t)bs * 16 + (key - 512)) * DM + h * 64);
        float d[4] = {0.f, 0.f, 0.f, 0.f};
        f32x4 kv[16];
#pragma unroll
        for (int d4 = 0; d4 < 16; ++d4) kv[d4] = *(const f32x4*)(kp + 4 * d4);
#pragma unroll
        for (int d4 = 0; d4 < 16; ++d4) {
#pragma unroll
            for (int i = 0; i < 4; ++i) { const f32x4 qq = *(const LAS f32x4*)(qs + i * 64 + 4 * d4); d[i] += (kv[d4][0] * qq[0] + kv[d4][1] * qq[1]) + (kv[d4][2] * qq[2] + kv[d4][3] * qq[3]); } }
        int rel = 512 + qg * 4 - key;
        if (valid) {
#pragma unroll
            for (int i = 0; i < 4; ++i) { int r = rel + i; r = r > 128 ? 128 : r; pb[i * 528 + key] = d[i] + tab[r + 128]; } }
    }
    asm volatile("s_waitcnt lgkmcnt(0)" ::: "memory");
#pragma unroll 1
    for (int i = 0; i < 4; ++i) {
        float mx = -1e30f;
#pragma unroll 1
        for (int key = lane; key < 528; key += 64) mx = fmaxf(mx, pb[i * 528 + key]);
        mx = wave_max(mx);
        float sum = 0.f;
#pragma unroll 1
        for (int key = lane; key < 528; key += 64) { const float pv = fast_exp2(pb[i * 528 + key] - mx); pb[i * 528 + key] = pv; sum += pv; }
        sum = wave_sum(sum); const float inv = 1.0f / sum;
#pragma unroll 1
        for (int key = lane; key < 528; key += 64) pb[i * 528 + key] *= inv;
    }
    asm volatile("s_waitcnt lgkmcnt(0)" ::: "memory");
    float acc[4] = {0.f, 0.f, 0.f, 0.f};
#pragma unroll 1
    for (int k0 = 0; k0 < 528; k0 += 16) {
        float vv[16];
#pragma unroll
        for (int kk = 0; kk < 16; ++kk) { const int key = k0 + kk; vv[kk] = k0 < 512 ? cv[(((size_t)bs * 512 + key) * 16 + h) * 64 + lane] : vn[((size_t)bs * 16 + (key - 512)) * DM + h * 64 + lane]; }
#pragma unroll
        for (int kk = 0; kk < 16; ++kk) {
#pragma unroll
            for (int i = 0; i < 4; ++i) acc[i] += pb[i * 528 + k0 + kk] * vv[kk]; }
    }
#pragma unroll
    for (int i = 0; i < 4; ++i) O[((size_t)NTP + bs * 16 + qg * 4 + i) * DM + h * 64 + lane] = (bf16_t)(cvtpk(acc[i], 0.f) & 0xffffu);
    asm volatile("s_waitcnt lgkmcnt(0)" ::: "memory");
}

constexpr int P2_BAR = 20612, P2_SIMD = 20640;
__device__ __forceinline__ void p2_lbar(LAS unsigned char* lds, int lane, int nL, int& tgt) {
    tgt += nL;
    asm volatile("s_waitcnt lgkmcnt(0)" ::: "memory");
    if (lane == 0) (void)__hip_atomic_fetch_add((LAS int*)(lds + P2_BAR), 1, __ATOMIC_RELAXED, __HIP_MEMORY_SCOPE_WORKGROUP);
    while (*(volatile LAS int*)(lds + P2_BAR) < tgt) __builtin_amdgcn_s_sleep(1);
    asm volatile("" ::: "memory");
}
__device__ __forceinline__ void p2_phase(LAS unsigned char* lds, int G, int tid, int wave, int lane) {
    for (int i = tid; i < 16 * 320; i += 512) { const int h = i / 320, j = i % 320; ((LAS float*)(lds + AT_TAB))[i] = A_IN(8)[h * 257 + (j > 256 ? 256 : j)] * LOG2E; }
    {   const int simd = (int)__builtin_amdgcn_s_getreg((1 << 11) | (4 << 6) | 4);
        if (lane == 0) ((volatile LAS int*)(lds + P2_SIMD))[wave] = simd;
        if (tid == 0) { *(volatile LAS int*)(lds + P2_Q) = 0; *(volatile LAS int*)(lds + P2_BAR) = 0; } }
    if ((int)blockIdx.x < 256) lru_load_consts(lds, (int)blockIdx.x & 15, tid, 512);
    __syncthreads();
    int isL = 0, lw = 0, nL = 0;
    {   int sd[8];
#pragma unroll
        for (int w = 0; w < 8; ++w) sd[w] = ((const LAS int*)(lds + P2_SIMD))[w];
#pragma unroll
        for (int w = 0; w < 8; ++w) {
            int first = 1;
#pragma unroll
            for (int v = 0; v < w; ++v) first &= (sd[v] != sd[w]) ? 1 : 0;
            nL += first; lw += (w < wave) ? first : 0; isL = (w == wave) ? first : isL;
        }
        isL = __builtin_amdgcn_readfirstlane(isL); lw = __builtin_amdgcn_readfirstlane(lw); nL = __builtin_amdgcn_readfirstlane(nL); }
    if (isL) {
        int tgt = 0, gres = -1;
        for (int u = blockIdx.x; u < 256; u += G) {
            const int g = u & 15, b = u >> 4;
            if (gres >= 0) { p2_lbar(lds, lane, nL, tgt); lru_load_consts(lds, g, lw * 64 + lane, nL * 64); p2_lbar(lds, lane, nL, tgt); }
            gres = g;
            for (int tile = lw; tile < 128; tile += nL) lru_tile<false>(lds, lane, g, (size_t)b * SEQ, tile, b, 2 * nL);
        }
        for (int sidx = blockIdx.x; sidx < 128; sidx += G) {
            const int g = sidx & 15, bs = sidx >> 4;
            if (g != gres) { p2_lbar(lds, lane, nL, tgt); lru_load_consts(lds, g, lw * 64 + lane, nL * 64); p2_lbar(lds, lane, nL, tgt); gres = g; }
            if (lw == 0) lru_tile<true>(lds, lane, g, (size_t)NTP + bs * 16, 0, bs, 0);
        }
    }
    int nS = 0; for (int t = blockIdx.x; t < 512; t += G) ++nS;
    for (;;) {
        int j = 0;
        if (lane == 0) j = __hip_atomic_fetch_add((LAS int*)(lds + P2_Q), 1, __ATOMIC_RELAXED, __HIP_MEMORY_SCOPE_WORKGROUP);
        j = __builtin_amdgcn_readfirstlane(j);
        if (j < nS) { attn_sample_task(lds, wave, lane, blockIdx.x + G * j); continue; }
        j -= nS;
        const int gid = (int)blockIdx.x + G * (j >> 3);
        if (gid >= 2048) break;
        const int qq = gid >> 8, m = (gid >> 3) & 31, x = gid & 7;
        const int bh = x * 4 + (m >> 3) + 32 * qq, cg = ((m & 7) + qq) & 7;
        attn_unit(lds, lane, bh >> 4, cg * 8 + (j & 7), bh & 15);
    }
}

__device__ __forceinline__ void p4b_phase(int G, int wave, int lane) {
    const int gw = blockIdx.x * 8 + wave, NGW = G * 8;
    for (int n = gw; n < 2048; n += NGW) {
        const bf16_t* wr_ = (const bf16_t*)(A_WS + WS_WS) + (size_t)n * DM + lane * 16;
        const u32x4 a = *(const u32x4*)wr_, b = *(const u32x4*)(wr_ + 8);
        float f[16]; f[0] = bflo(a.x); f[1] = bfhi(a.x); f[2] = bflo(a.y); f[3] = bfhi(a.y); f[4] = bflo(a.z); f[5] = bfhi(a.z); f[6] = bflo(a.w); f[7] = bfhi(a.w);
        f[8] = bflo(b.x); f[9] = bfhi(b.x); f[10] = bflo(b.y); f[11] = bfhi(b.y); f[12] = bflo(b.z); f[13] = bfhi(b.z); f[14] = bflo(b.w); f[15] = bfhi(b.w);
        float mx = 0.f;
#pragma unroll
        for (int j = 0; j < 16; ++j) mx = fmaxf(mx, fabsf(f[j]));
        mx = wave_max(mx);
        const float step = fmaxf(mx, 1e-30f) * (1.0f / 127.0f), qi = 1.0f / step;
        u32x4 w;
#pragma unroll
        for (int q = 0; q < 4; ++q) w[q] = ((unsigned)(int)rintf(f[4 * q] * qi) & 0xffu) | (((unsigned)(int)rintf(f[4 * q + 1] * qi) & 0xffu) << 8) | (((unsigned)(int)rintf(f[4 * q + 2] * qi) & 0xffu) << 16) | (((unsigned)(int)rintf(f[4 * q + 3] * qi) & 0xffu) << 24);
        *(u32x4*)(A_WS + WS_WSQ + (size_t)n * DM + lane * 16) = w;
        if (lane == 0) ((float*)(A_WS + WS_SW))[n] = step;
    }
    const float* gm = A_IN(19); bf16_t* XT = (bf16_t*)(A_WS + WS_Q); unsigned char* XQ = A_WS + WS_XQ; float* SX = (float*)(A_WS + WS_SX);
    const bf16_t* DL = (const bf16_t*)(A_WS + WS_DELTA);
    f32x4 v[4], vn[4], ggr[4];
#pragma unroll
    for (int j = 0; j < 4; ++j) ggr[j] = *(const f32x4*)(gm + j * 256 + lane * 4);
    if (gw < NTOK) { row_ld(xrow_ptr(gw), v, lane); row_add_bf16(DL + (size_t)gw * DM, v, lane); }
    for (int m = gw; m < NTOK; m += NGW) {
        const int mn = m + NGW;
        if (mn < NTOK) { row_ld(xrow_ptr(mn), vn, lane); row_add_bf16(DL + (size_t)mn * DM, vn, lane); }
        bf16_t* orow = XT + (size_t)m * DM;
        const float ss = row_ss(v);
        float mx = 0.f;
#pragma unroll
        for (int j = 0; j < 4; ++j) { v[j] = v[j] * ggr[j];
            mx = fmaxf(mx, fmaxf(fmaxf(fabsf(v[j][0]), fabsf(v[j][1])), fmaxf(fabsf(v[j][2]), fabsf(v[j][3])))); }
        const float inv = __builtin_amdgcn_rsqf(wave_sum(ss) * (1.0f / DM) + EPS);
        mx = fmaxf(wave_max(mx), 1e-30f);
        if (m >= NTP) {
#pragma unroll
            for (int j = 0; j < 4; ++j) { const f32x4 t = v[j] * inv; u32x2 w; w.x = cvtpk(t[0], t[1]); w.y = cvtpk(t[2], t[3]); *(u32x2*)(orow + j * 256 + lane * 4) = w; } }
        const float step = mx * inv * (1.0f / 127.0f), qi = 127.0f * fast_rcp(mx);
#pragma unroll
        for (int j = 0; j < 4; ++j) {
            const unsigned b0 = (unsigned)(int)rintf(v[j][0] * qi) & 0xffu, b1 = (unsigned)(int)rintf(v[j][1] * qi) & 0xffu, b2 = (unsigned)(int)rintf(v[j][2] * qi) & 0xffu, b3 = (unsigned)(int)rintf(v[j][3] * qi) & 0xffu;
            *(unsigned*)(XQ + (size_t)m * DM + j * 256 + lane * 4) = b0 | (b1 << 8) | (b2 << 16) | (b3 << 24); }
        if (lane == 0) SX[m] = step;
#pragma unroll
        for (int j = 0; j < 4; ++j) v[j] = vn[j];
    }
}

__device__ __forceinline__ int f2key(float f) { const int b = __float_as_int(f); return b ^ ((b >> 31) & 0x7fffffff); }
__device__ __forceinline__ float key2f(int k) { return __int_as_float(k ^ ((k >> 31) & 0x7fffffff)); }
#define CE_DESC(x, y) do { const int hi_ = max(x, y); y = min(x, y); x = hi_; } while (0)
#define CE_ASC(x, y)  do { const int lo_ = min(x, y); y = max(x, y); x = lo_; } while (0)
__device__ __forceinline__ void bitonic_sort16_desc(int (&a)[16]) {
#pragma unroll
    for (int k = 2; k <= 16; k <<= 1)
#pragma unroll
        for (int j = k >> 1; j > 0; j >>= 1)
#pragma unroll
            for (int i = 0; i < 16; ++i) { const int l = i ^ j; if (l > i) { if ((i & k) == 0) CE_DESC(a[i], a[l]); else CE_ASC(a[i], a[l]); } }
}
__device__ __forceinline__ void bitonic_merge16_desc(int (&a)[16]) {
#pragma unroll
    for (int j = 8; j > 0; j >>= 1)
#pragma unroll
        for (int i = 0; i < 16; ++i) { const int l = i ^ j; if (l > i) CE_DESC(a[i], a[l]); }
}
__device__ __forceinline__ void top16_merge(int (&T)[16], const int (&S)[16]) {
#pragma unroll
    for (int i = 0; i < 16; ++i) T[i] = max(T[i], S[15 - i]);
    bitonic_merge16_desc(T);
}
#define INS16(L, x) do { int x_ = (x); _Pragma("unroll") for (int j_ = 0; j_ < 16; ++j_) { const int hi_ = max(L[j_], x_); x_ = min(L[j_], x_); L[j_] = hi_; } } while (0)

constexpr size_t WS_PART = WS_XN;
constexpr int CT_U = 64, CT_V = 64 + 8 * 64;
constexpr int P6_TOKB = 128, P6_NITEM = NTOK / P6_TOKB, P6_TPW = P6_TOKB / 8;
constexpr size_t WS_CQ = WS_XR, WS_CS = WS_XR + 16 * MiB;
constexpr int P6_IDX = 0;
constexpr int P6_E = 0, P6_C = 8192, P6_ITEM = 49152, P6_E8 = 0, P6_C8 = 32768;

__device__ __forceinline__ void p6a_phase(LAS unsigned char* lds, int G, int wave, int lane) {
    const int gw = blockIdx.x * 8 + wave, NGW = G * 8;
    const bf16_t* SC = (const bf16_t*)(A_WS + WS_XN);
    unsigned short* SELE = (unsigned short*)(A_WS + WS_SELE); float* SELG = (float*)(A_WS + WS_SELG);
    LAS int* idxb = (LAS int*)(lds + P6_IDX + wave * 4096);
    const int tl = lane >> 4, hh = (lane >> 1) & 7, half = lane & 1;
    for (int grp_ = gw; grp_ < NTOK / 4; grp_ += NGW) {
        const int grp = NTOK / 4 - 1 - grp_;
        const int tok = grp * 4 + tl;
        const bf16_t* sp = SC + (size_t)tok * 2048 + (lane & 15);
        int L[16];
#pragma unroll
        for (int j = 0; j < 16; ++j) L[j] = (int)0x80000000;
        {
            float sa[16], sb_[16];
#pragma unroll
            for (int e = 0; e < 16; ++e) sa[e] = bflo((unsigned)sp[16 * e]);
#pragma unroll
            for (int c0 = 0; c0 < 128; c0 += 32) {
#pragma unroll
                for (int e = 0; e < 16; ++e) sb_[e] = bflo((unsigned)sp[16 * (c0 + 16 + e)]);
                { int S[16];
#pragma unroll
                  for (int e = 0; e < 16; ++e) S[e] = (f2key(sa[e]) & ~127) | (c0 + e);
                  bitonic_sort16_desc(S);
                  if (c0 == 0) {
#pragma unroll
                      for (int e = 0; e < 16; ++e) L[e] = S[e]; } else top16_merge(L, S); }
                if (c0 + 32 < 128) {
#pragma unroll
                    for (int e = 0; e < 16; ++e) sa[e] = bflo((unsigned)sp[16 * (c0 + 32 + e)]); }
                { int S[16];
#pragma unroll
                  for (int e = 0; e < 16; ++e) S[e] = (f2key(sb_[e]) & ~127) | (c0 + 16 + e);
                  bitonic_sort16_desc(S);
                  top16_merge(L, S); }
            }
        }
#pragma unroll
        for (int j = 0; j < 16; ++j) idxb[lane * 16 + j] = L[j] & 127;
        float va[16], vb[16];
#pragma unroll
        for (int j = 0; j < 16; ++j) { const int own = L[j] & ~127, oth = __shfl_xor(own, 1); va[j] = key2f(half ? oth : own); vb[j] = key2f(half ? own : oth); }
        int C[16];
#pragma unroll
        for (int j = 0; j < 16; ++j) C[j] = (int)0x80000000;
        {   int S[16];
            S[0] = (f2key(va[0] + vb[0]) & ~255) | 0;
            S[1] = (f2key(va[0] + vb[1]) & ~255) | 1;
            S[2] = (f2key(va[0] + vb[2]) & ~255) | 2;
            S[3] = (f2key(va[0] + vb[3]) & ~255) | 3;
            S[4] = (f2key(va[0] + vb[4]) & ~255) | 4;
            S[5] = (f2key(va[0] + vb[5]) & ~255) | 5;
            S[6] = (f2key(va[0] + vb[6]) & ~255) | 6;
            S[7] = (f2key(va[0] + vb[7]) & ~255) | 7;
            S[8] = (f2key(va[0] + vb[8]) & ~255) | 8;
            S[9] = (f2key(va[0] + vb[9]) & ~255) | 9;
            S[10] = (f2key(va[0] + vb[10]) & ~255) | 10;
            S[11] = (f2key(va[0] + vb[11]) & ~255) | 11;
            S[12] = (f2key(va[0] + vb[12]) & ~255) | 12;
            S[13] = (f2key(va[0] + vb[13]) & ~255) | 13;
            S[14] = (f2key(va[0] + vb[14]) & ~255) | 14;
            S[15] = (f2key(va[0] + vb[15]) & ~255) | 15;
            bitonic_sort16_desc(S);
#pragma unroll
            for (int q = 0; q < 16; ++q) C[q] = S[q]; }
        {   int S[16];
            S[0] = (f2key(va[1] + vb[0]) & ~255) | 16;
            S[1] = (f2key(va[1] + vb[1]) & ~255) | 17;
            S[2] = (f2key(va[1] + vb[2]) & ~255) | 18;
            S[3] = (f2key(va[1] + vb[3]) & ~255) | 19;
            S[4] = (f2key(va[1] + vb[4]) & ~255) | 20;
            S[5] = (f2key(va[1] + vb[5]) & ~255) | 21;
            S[6] = (f2key(va[1] + vb[6]) & ~255) | 22;
            S[7] = (f2key(va[1] + vb[7]) & ~255) | 23;
            S[8] = (f2key(va[2] + vb[0]) & ~255) | 32;
            S[9] = (f2key(va[2] + vb[1]) & ~255) | 33;
            S[10] = (f2key(va[2] + vb[2]) & ~255) | 34;
            S[11] = (f2key(va[2] + vb[3]) & ~255) | 35;
            S[12] = (f2key(va[2] + vb[4]) & ~255) | 36;
            S[13] = (f2key(va[3] + vb[0]) & ~255) | 48;
            S[14] = (f2key(va[3] + vb[1]) & ~255) | 49;
            S[15] = (f2key(va[3] + vb[2]) & ~255) | 50;
            bitonic_sort16_desc(S);
            top16_merge(C, S); }
        {   int S[16];
            S[0] = (f2key(va[3] + vb[3]) & ~255) | 51;
            S[1] = (f2key(va[4] + vb[0]) & ~255) | 64;
            S[2] = (f2key(va[4] + vb[1]) & ~255) | 65;
            S[3] = (f2key(va[4] + vb[2]) & ~255) | 66;
            S[4] = (f2key(va[5] + vb[0]) & ~255) | 80;
            S[5] = (f2key(va[5] + vb[1]) & ~255) | 81;
            S[6] = (f2key(va[6] + vb[0]) & ~255) | 96;
            S[7] = (f2key(va[6] + vb[1]) & ~255) | 97;
            S[8] = (f2key(va[7] + vb[0]) & ~255) | 112;
            S[9] = (f2key(va[7] + vb[1]) & ~255) | 113;
            S[10] = (f2key(va[8] + vb[0]) & ~255) | 128;
            S[11] = (f2key(va[9] + vb[0]) & ~255) | 144;
            S[12] = (f2key(va[10] + vb[0]) & ~255) | 160;
            S[13] = (f2key(va[11] + vb[0]) & ~255) | 176;
            S[14] = (f2key(va[12] + vb[0]) & ~255) | 192;
            S[15] = (f2key(va[13] + vb[0]) & ~255) | 208;
            bitonic_sort16_desc(S);
            top16_merge(C, S); }
        {   int S[16];
            S[0] = (f2key(va[14] + vb[0]) & ~255) | 224;
            S[1] = (f2key(va[15] + vb[0]) & ~255) | 240;
            S[2] = (int)0x80000000;
            S[3] = (int)0x80000000;
            S[4] = (int)0x80000000;
            S[5] = (int)0x80000000;
            S[6] = (int)0x80000000;
            S[7] = (int)0x80000000;
            S[8] = (int)0x80000000;
            S[9] = (int)0x80000000;
            S[10] = (int)0x80000000;
            S[11] = (int)0x80000000;
            S[12] = (int)0x80000000;
            S[13] = (int)0x80000000;
            S[14] = (int)0x80000000;
            S[15] = (int)0x80000000;
            bitonic_sort16_desc(S);
            top16_merge(C, S); }
        const float mx = key2f(C[0] & ~255);
        float ev[16], sum = 0.f;
#pragma unroll
        for (int j = 0; j < 16; ++j) { ev[j] = __expf(key2f(C[j] & ~255) - mx); sum += ev[j]; }
        const float inv = 1.0f / sum;
        asm volatile("s_waitcnt lgkmcnt(0)" ::: "memory");
        int eo[8]; float go[8];
#pragma unroll
        for (int s = 0; s < 8; ++s) {
            int c_lo = C[s], c_hi = C[8 + s]; float e_lo = ev[s], e_hi = ev[8 + s];
            asm volatile("" : "+v"(c_lo), "+v"(c_hi), "+v"(e_lo), "+v"(e_hi));
            const int cc = half ? c_hi : c_lo; go[s] = (half ? e_hi : e_lo) * inv;
            const int ij = cc & 255, i1 = idxb[(lane & ~1) * 16 + (ij >> 4)], i2 = idxb[(lane | 1) * 16 + (ij & 15)];
            eo[s] = i1 * 128 + i2;
        }
        unsigned short* ep = SELE + (size_t)tok * 128 + hh * 16 + half * 8; float* gp = SELG + (size_t)tok * 128 + hh * 16 + half * 8;
        *(u32x4*)ep = (u32x4){(unsigned)eo[0] | ((unsigned)eo[1] << 16), (unsigned)eo[2] | ((unsigned)eo[3] << 16), (unsigned)eo[4] | ((unsigned)eo[5] << 16), (unsigned)eo[6] | ((unsigned)eo[7] << 16)};
        *(f32x4*)gp = (f32x4){go[0], go[1], go[2], go[3]}; *(f32x4*)(gp + 4) = (f32x4){go[4], go[5], go[6], go[7]};
        asm volatile("s_waitcnt lgkmcnt(0)" ::: "memory");
    }
}

__device__ __forceinline__ float dot2bf(unsigned a, unsigned b, float c) { return __builtin_amdgcn_fdot2_f32_bf16(__builtin_bit_cast(bf16x2_t, a), __builtin_bit_cast(bf16x2_t, b), c, false); }
__device__ __forceinline__ unsigned xcc_id() { return (unsigned)__builtin_amdgcn_s_getreg((3 << 11) | 20) & 0xFu; }
__device__ __forceinline__ float dpp_sum16(float v) {
    v += __builtin_bit_cast(float, __builtin_amdgcn_update_dpp(0, __builtin_bit_cast(int, v), 0xB1, 0xF, 0xF, true));
    v += __builtin_bit_cast(float, __builtin_amdgcn_update_dpp(0, __builtin_bit_cast(int, v), 0x4E, 0xF, 0xF, true));
    v += __builtin_bit_cast(float, __builtin_amdgcn_update_dpp(0, __builtin_bit_cast(int, v), 0x141, 0xF, 0xF, true));
    v += __builtin_bit_cast(float, __builtin_amdgcn_update_dpp(0, __builtin_bit_cast(int, v), 0x140, 0xF, 0xF, true));
    return v;
}
__device__ __forceinline__ bool p6_claim(LAS unsigned char* lds, unsigned* cnt, int tid, int& ring, int home, int& slice, int& item, int& pend) {
    for (;;) {
        if (ring >= 8) return false;
        slice = (home + ring) & 7;
        __syncthreads();
        if (tid == 0) {
            const int tk = pend >= 0 ? pend : (int)__hip_atomic_fetch_add(cnt + 64 * slice, 1u, __ATOMIC_RELAXED, __HIP_MEMORY_SCOPE_AGENT);
            *(volatile LAS int*)(lds + P6_ITEM) = tk;
            pend = tk < P6_NITEM ? (int)__hip_atomic_fetch_add(cnt + 64 * slice, 1u, __ATOMIC_RELAXED, __HIP_MEMORY_SCOPE_AGENT) : -1;
        }
        __syncthreads();
        item = *(volatile LAS int*)(lds + P6_ITEM);
        if (item < P6_NITEM) return true;
        ++ring;
    }
}

struct P6W { int ring, has, pv; };
__device__ __forceinline__ bool p6w_claim(unsigned* cnt, int lane, int home, int n, P6W& st, int& slice, int& item) {
    for (;;) {
        if (st.ring >= 8) return false;
        slice = (home + st.ring) & 7;
        int tk;
        if (st.has) tk = __builtin_amdgcn_readfirstlane(st.pv);
        else { int t = 0; if (lane == 0) t = (int)__hip_atomic_fetch_add(cnt + 64 * slice, 1u, __ATOMIC_RELAXED, __HIP_MEMORY_SCOPE_AGENT); tk = __builtin_amdgcn_readfirstlane(t); }
        if (tk < n) {
            int t = 0; if (lane == 0) t = (int)__hip_atomic_fetch_add(cnt + 64 * slice, 1u, __ATOMIC_RELAXED, __HIP_MEMORY_SCOPE_AGENT);
            st.pv = t; st.has = 1; item = tk; return true;
        }
        st.has = 0; ++st.ring;
    }
}

__device__ __forceinline__ float ub0(unsigned w) { return (float)(w & 0xffu); }
__device__ __forceinline__ float ub1(unsigned w) { return (float)((w >> 8) & 0xffu); }
__device__ __forceinline__ float ub2(unsigned w) { return (float)((w >> 16) & 0xffu); }
__device__ __forceinline__ float ub3(unsigned w) { return (float)(w >> 24); }
__device__ __forceinline__ float dpp_sum8(float v) {
    v += __builtin_bit_cast(float, __builtin_amdgcn_update_dpp(0, __builtin_bit_cast(int, v), 0xB1, 0xF, 0xF, true));
    v += __builtin_bit_cast(float, __builtin_amdgcn_update_dpp(0, __builtin_bit_cast(int, v), 0x4E, 0xF, 0xF, true));
    v += __builtin_bit_cast(float, __builtin_amdgcn_update_dpp(0, __builtin_bit_cast(int, v), 0x141, 0xF, 0xF, true));
    return v;
}
__device__ __forceinline__ int dpp_isum8(int v) {
    v += __builtin_amdgcn_update_dpp(0, v, 0xB1, 0xF, 0xF, true);
    v += __builtin_amdgcn_update_dpp(0, v, 0x4E, 0xF, 0xF, true);
    v += __builtin_amdgcn_update_dpp(0, v, 0x141, 0xF, 0xF, true);
    return v;
}
__device__ __forceinline__ void p6b_item(LAS unsigned char* lds, int wave, int lane, int slice, int tok0) {
    const unsigned char* XQ = A_WS + WS_XQ; const unsigned char* UB = A_WS + WS_UB; const float* SX = (const float*)(A_WS + WS_SX);
    const unsigned short* SELE = (const unsigned short*)(A_WS + WS_SELE); bf16_t* PART = (bf16_t*)(A_WS + WS_PART);
    const int i8 = lane & 7, grp = lane >> 3;
    LAS int* eb = (LAS int*)(lds + P6_E8 + wave * 4096);
    {
        u32x4 le[2], xqn; float sxn;
        { const int tk = tok0 + grp;
#pragma unroll
          for (int q = 0; q < 2; ++q) le[q] = *(const u32x4*)(SELE + (size_t)tk * 128 + i8 * 16 + 8 * q);
          xqn = *(const u32x4*)(XQ + (size_t)tk * DM + slice * 128 + i8 * 16); sxn = SX[tk]; }
#pragma unroll 1
        for (int tb = 0; tb < P6_TPW; tb += 8) {
            const int tok = tok0 + tb + grp;
#pragma unroll
            for (int q = 0; q < 2; ++q) *(LAS u32x4*)(eb + grp * 64 + i8 * 8 + 4 * q) = le[q];
            const int x0 = (int)xqn.x, x1 = (int)xqn.y, x2 = (int)xqn.z, x3 = (int)xqn.w; const float sx = sxn;
            if (tb + 8 < P6_TPW) { const int tk = tok + 8;
#pragma unroll
                for (int q = 0; q < 2; ++q) le[q] = *(const u32x4*)(SELE + (size_t)tk * 128 + i8 * 16 + 8 * q);
                xqn = *(const u32x4*)(XQ + (size_t)tk * DM + slice * 128 + i8 * 16); sxn = SX[tk]; }
            const unsigned char* ub = UB + slice * 128 + i8 * 16;
            asm volatile("s_waitcnt lgkmcnt(0)" ::: "memory");
            int res[16];
#pragma unroll
            for (int j = 0; j < 16; ++j) res[j] = 0;
#pragma unroll
            for (int s16 = 0; s16 < 128; s16 += 16) {
                u32x4 uv[16]; u32x4 e4[2];
#pragma unroll
                for (int a4 = 0; a4 < 2; ++a4) e4[a4] = *(const LAS u32x4*)(eb + grp * 64 + (s16 >> 1) + 4 * a4);
#pragma unroll
                for (int a4 = 0; a4 < 2; ++a4)
#pragma unroll
                    for (int j = 0; j < 4; ++j) { const unsigned w = e4[a4][j];
                        uv[8 * a4 + 2 * j] = *(const u32x4*)(ub + (size_t)(w & 0xffffu) * DM); uv[8 * a4 + 2 * j + 1] = *(const u32x4*)(ub + (size_t)(w >> 16) * DM); }
#pragma unroll
                for (int q = 0; q < 16; ++q) {
                    const int a0 = (int)uv[q].x, a1 = (int)uv[q].y, a2 = (int)uv[q].z, a3 = (int)uv[q].w;
                    int d = __builtin_amdgcn_sdot4(a0, x0, 0, false); d = __builtin_amdgcn_sdot4(a1, x1, d, false); d = __builtin_amdgcn_sdot4(a2, x2, d, false); d = __builtin_amdgcn_sdot4(a3, x3, d, false);
                    d = dpp_isum8(d);
                    const int sidx = s16 + q;
                    res[sidx >> 3] = (i8 == (sidx & 7)) ? d : res[sidx >> 3];
                }
            }
            bf16_t* pp = PART + ((size_t)slice * NTOK + tok) * 128 + 16 * i8;
#pragma unroll
            for (int q = 0; q < 2; ++q) { u32x4 w;
                w.x = cvtpk((float)res[8 * q] * sx, (float)res[8 * q + 1] * sx); w.y = cvtpk((float)res[8 * q + 2] * sx, (float)res[8 * q + 3] * sx);
                w.z = cvtpk((float)res[8 * q + 4] * sx, (float)res[8 * q + 5] * sx); w.w = cvtpk((float)res[8 * q + 6] * sx, (float)res[8 * q + 7] * sx);
                *(u32x4*)(pp + 8 * q) = w; }
            asm volatile("s_waitcnt lgkmcnt(0)" ::: "memory");
        }
    }
}
__device__ __forceinline__ void p6b_phase(LAS unsigned char* lds, int tid, int wave, int lane) {
    unsigned* cnt = (unsigned*)(A_WS + WS_CTL) + CT_U;
    const int home = (int)(xcc_id() & 7u);
    P6W st{0, 0, 0}; int slice, item;
    while (p6w_claim(cnt, lane, home, NTOK / 16, st, slice, item)) p6b_item(lds, wave, lane, slice, item * 16);
}

__device__ __forceinline__ void p6m_phase(int G, int wave, int lane) {
    const int gw = blockIdx.x * 8 + wave, NGW = G * 8;
    const float* SU = (const float*)(A_WS + WS_SU); const float* SV = (const float*)(A_WS + WS_SV);
    const unsigned short* SELE = (const unsigned short*)(A_WS + WS_SELE); const float* SELG = (const float*)(A_WS + WS_SELG); const bf16_t* PART = (const bf16_t*)(A_WS + WS_PART);
    unsigned char* CQ = A_WS + WS_CQ; float* CS = (float*)(A_WS + WS_CS);
    const int k0 = 8 * ((2 * lane) & 15) + (lane >> 3), k1 = k0 + 8;
    for (int tok = gw; tok < NTOK; tok += NGW) {
        float a0 = 0.f, a1 = 0.f;
#pragma unroll
        for (int j = 0; j < 8; ++j) { const unsigned w = ((const unsigned*)(PART + ((size_t)j * NTOK + tok) * 128))[lane]; a0 += bflo(w); a1 += bfhi(w); }
        const int e0 = SELE[(size_t)tok * 128 + k0], e1 = SELE[(size_t)tok * 128 + k1];
        const float c0 = SELG[(size_t)tok * 128 + k0] * gelu_tanh(a0 * SU[e0]) * SV[e0], c1 = SELG[(size_t)tok * 128 + k1] * gelu_tanh(a1 * SU[e1]) * SV[e1];
        float mx = fmaxf(fabsf(c0), fabsf(c1));
        mx = wave_max(mx);
        const float cstep = fmaxf(mx, 1e-30f) * (1.0f / 127.0f), cinv = 1.0f / cstep;
        CQ[(size_t)tok * 128 + k0] = (unsigned char)((int)rintf(c0 * cinv) & 0xff); CQ[(size_t)tok * 128 + k1] = (unsigned char)((int)rintf(c1 * cinv) & 0xff);
        if (lane == 0) CS[tok] = cstep;
    }
}

__device__ __forceinline__ void p6c_item(LAS unsigned char* lds, int wave, int lane, int slice, int tok0) {
    const unsigned char* VB = A_WS + WS_VB; const unsigned short* SELE = (const unsigned short*)(A_WS + WS_SELE);
    const unsigned char* CQ = A_WS + WS_CQ; const float* CS = (const float*)(A_WS + WS_CS);
    const int i8 = lane & 7, grp = lane >> 3;
    LAS int* eb = (LAS int*)(lds + P6_E8 + wave * 4096);
    LAS int* cbb = (LAS int*)(lds + P6_C8 + wave * 1024);
    {
        u32x4 le[2], lc; float cstep;
        { const int tk = tok0 + grp;
#pragma unroll
          for (int q = 0; q < 2; ++q) le[q] = *(const u32x4*)(SELE + (size_t)tk * 128 + i8 * 16 + 8 * q);
          lc = *(const u32x4*)(CQ + (size_t)tk * 128 + i8 * 16); cstep = CS[tk]; }
#pragma unroll 1
        for (int tb = 0; tb < P6_TPW; tb += 8) {
            const int tok = tok0 + tb + grp;
#pragma unroll
            for (int q = 0; q < 2; ++q) *(LAS u32x4*)(eb + grp * 64 + i8 * 8 + 4 * q) = le[q];
            *(LAS u32x4*)(cbb + grp * 32 + i8 * 4) = lc;
            const float cs = cstep;
            if (tb + 8 < P6_TPW) { const int tk = tok + 8;
#pragma unroll
                for (int q = 0; q < 2; ++q) le[q] = *(const u32x4*)(SELE + (size_t)tk * 128 + i8 * 16 + 8 * q);
                lc = *(const u32x4*)(CQ + (size_t)tk * 128 + i8 * 16); cstep = CS[tk]; }
            const unsigned char* vb = VB + slice * 128 + i8 * 16;
            asm volatile("s_waitcnt lgkmcnt(0)" ::: "memory");
            int acc[16];
#pragma unroll
            for (int r = 0; r < 16; ++r) acc[r] = 0;
#pragma unroll 1
            for (int s16 = 0; s16 < 128; s16 += 16) {
                u32x4 vv[16]; u32x4 e4[2];
#pragma unroll
                for (int a4 = 0; a4 < 2; ++a4) e4[a4] = *(const LAS u32x4*)(eb + grp * 64 + (s16 >> 1) + 4 * a4);
                const u32x4 cq4 = *(const LAS u32x4*)(cbb + grp * 32 + (s16 >> 2));
#pragma unroll
                for (int a4 = 0; a4 < 2; ++a4)
#pragma unroll
                    for (int j = 0; j < 4; ++j) { const unsigned w = e4[a4][j];
                        vv[8 * a4 + 2 * j] = *(const u32x4*)(vb + (size_t)(w & 0xffffu) * DM); vv[8 * a4 + 2 * j + 1] = *(const u32x4*)(vb + (size_t)(w >> 16) * DM); }
#pragma unroll
                for (int a4 = 0; a4 < 4; ++a4) {
                    const int cq = (int)cq4[a4];
#pragma unroll
                    for (int d = 0; d < 4; ++d) {
                        const unsigned ra = vv[4 * a4][d], rb = vv[4 * a4 + 1][d], rc = vv[4 * a4 + 2][d], rd = vv[4 * a4 + 3][d];
                        const unsigned lo = __builtin_amdgcn_perm(rb, ra, 0x05010400u), hi = __builtin_amdgcn_perm(rb, ra, 0x07030602u);
                        const unsigned lo2 = __builtin_amdgcn_perm(rd, rc, 0x05010400u), hi2 = __builtin_amdgcn_perm(rd, rc, 0x07030602u);
                        const unsigned t0 = __builtin_amdgcn_perm(lo2, lo, 0x05040100u), t1 = __builtin_amdgcn_perm(lo2, lo, 0x07060302u);
                        const unsigned t2 = __builtin_amdgcn_perm(hi2, hi, 0x05040100u), t3 = __builtin_amdgcn_perm(hi2, hi, 0x07060302u);
                        acc[4 * d + 0] = __builtin_amdgcn_sdot4((int)t0, cq, acc[4 * d + 0], false); acc[4 * d + 1] = __builtin_amdgcn_sdot4((int)t1, cq, acc[4 * d + 1], false);
                        acc[4 * d + 2] = __builtin_amdgcn_sdot4((int)t2, cq, acc[4 * d + 2], false); acc[4 * d + 3] = __builtin_amdgcn_sdot4((int)t3, cq, acc[4 * d + 3], false);
                    }
                }
            }
            bf16_t* pr = (bf16_t*)(A_WS + WS_PEER) + (size_t)tok * DM + slice * 128 + i8 * 16;
            u32x4 w0, w1;
            w0.x = cvtpk((float)acc[0] * cs, (float)acc[1] * cs); w0.y = cvtpk((float)acc[2] * cs, (float)acc[3] * cs); w0.z = cvtpk((float)acc[4] * cs, (float)acc[5] * cs); w0.w = cvtpk((float)acc[6] * cs, (float)acc[7] * cs);
            w1.x = cvtpk((float)acc[8] * cs, (float)acc[9] * cs); w1.y = cvtpk((float)acc[10] * cs, (float)acc[11] * cs); w1.z = cvtpk((float)acc[12] * cs, (float)acc[13] * cs); w1.w = cvtpk((float)acc[14] * cs, (float)acc[15] * cs);
            *(u32x4*)pr = w0; *(u32x4*)(pr + 8) = w1;
            asm volatile("s_waitcnt lgkmcnt(0)" ::: "memory");
        }
    }
}
__device__ __forceinline__ void p6c_phase(LAS unsigned char* lds, int tid, int wave, int lane) {
    unsigned* cnt = (unsigned*)(A_WS + WS_CTL) + CT_V;
    const int home = (int)(xcc_id() & 7u);
    P6W st{0, 0, 0}; int slice, item;
    while (p6w_claim(cnt, lane, home, NTOK / 16, st, slice, item)) p6c_item(lds, wave, lane, slice, item * 16);
}

__device__ __forceinline__ void p6d_phase(int G, int wave, int lane) {
    const int gw = blockIdx.x * 8 + wave, NGW = G * 8;
    const float* gf = A_IN(25);
    const bf16_t* DL = (const bf16_t*)(A_WS + WS_DELTA); const bf16_t* PR = (const bf16_t*)(A_WS + WS_PEER);
    f32x4 v[4], vn[4], ggr[4];
#pragma unroll
    for (int j = 0; j < 4; ++j) ggr[j] = *(const f32x4*)(gf + j * 256 + lane * 4);
    if (gw < NTOK) { row_ld(xrow_ptr(gw), v, lane); row_add_bf16(DL + (size_t)gw * DM, v, lane); row_add_bf16(PR + (size_t)gw * DM, v, lane); }
    for (int m = gw; m < NTOK; m += NGW) {
        const int mn = m + NGW;
        if (mn < NTOK) { row_ld(xrow_ptr(mn), vn, lane); row_add_bf16(DL + (size_t)mn * DM, vn, lane); row_add_bf16(PR + (size_t)mn * DM, vn, lane); }
        float* yr = yrow_ptr(m);
        const float inv = __builtin_amdgcn_rsqf(wave_sum(row_ss(v)) * (1.0f / DM) + EPS);
#pragma unroll
        for (int j = 0; j < 4; ++j) { *(f32x4*)(yr + j * 256 + lane * 4) = v[j] * inv * ggr[j]; }
#pragma unroll
        for (int j = 0; j < 4; ++j) v[j] = vn[j];
    }
}

#define XB_TMO      128
#define XB_XCNT(j)  (256  + 64 * (j))
#define XB_XSUB(j)  (1280 + 64 * (j))
#define XB_XGEN(j)  (2304 + 64 * (j))
#define XB_TOP      3328
#define XB_TOPGEN   3392
#define XB_SPIN_CAP (1u << 22)
constexpr int CW_BAR = 2048;
constexpr int LDS_MISC = 131072 + 64;
__device__ __forceinline__ unsigned xb_ld(unsigned* p)              { return __hip_atomic_load(p, __ATOMIC_RELAXED, __HIP_MEMORY_SCOPE_AGENT); }
__device__ __forceinline__ unsigned xb_add(unsigned* p, unsigned v) { return __hip_atomic_fetch_add(p, v, __ATOMIC_RELAXED, __HIP_MEMORY_SCOPE_AGENT); }
#define XB_SPIN(cond, bar) do { unsigned _sp = 0; while (cond) { __builtin_amdgcn_s_sleep(1); \
    if ((++_sp & 255u) == 0u) { if (xb_ld(&(bar)[XB_TMO])) break; if (_sp > XB_SPIN_CAP) { atomicAdd(&(bar)[XB_TMO], 1u); break; } } } } while (0)
struct XcdBarrier { unsigned* bar; unsigned x; volatile LAS unsigned* st; };
__device__ __forceinline__ XcdBarrier xcd_barrier_post(unsigned* bar, volatile LAS unsigned* st) {
    XcdBarrier b; b.bar = bar; b.x = (unsigned)__builtin_amdgcn_s_getreg((3 << 11) | 20) & 0xFu; b.st = st;
    if (threadIdx.x == 0) (void)xb_add(&bar[XB_XCNT(b.x)], 1u);
    return b;
}
__device__ __forceinline__ void xcd_barrier_complete(unsigned* bar, unsigned x, unsigned& nloc, unsigned& nx) {
    const unsigned G = gridDim.x * gridDim.y * gridDim.z;
    unsigned sum, cnt, mine, sp = 0u;
    for (;;) {
        sum = 0u; cnt = 0u; mine = 0u;
#pragma unroll
        for (unsigned j = 0; j < 16; ++j) { const unsigned c = xb_ld(&bar[XB_XCNT(j)]); sum += c; cnt += (c > 0u) ? 1u : 0u; mine = (j == x) ? c : mine; }
        if (sum == G) break;
        __builtin_amdgcn_s_sleep(1);
        if ((++sp & 255u) == 0u) { if (xb_ld(&bar[XB_TMO])) break; if (sp > XB_SPIN_CAP) { atomicAdd(&bar[XB_TMO], 1u); break; } }
    }
    nloc = mine > 0u ? mine : 1u; nx = cnt > 0u ? cnt : 1u;
}
__device__ __forceinline__ void xcd_barrier(const XcdBarrier& b) {
    asm volatile("s_waitcnt vmcnt(0)" ::: "memory");
    __syncthreads();
    if (threadIdx.x == 0) {
        unsigned* bar = b.bar;
        __builtin_amdgcn_s_waitcnt(0);
        unsigned nloc = b.st[0], nx = b.st[1];
        if (nloc == 0u) { xcd_barrier_complete(bar, b.x, nloc, nx); b.st[0] = nloc; b.st[1] = nx; }
        const unsigned old = xb_add(&bar[XB_XSUB(b.x)], 1u);
        const unsigned gen = old / nloc;
        if (old + 1u == (gen + 1u) * nloc) {
            __builtin_amdgcn_fence(__ATOMIC_RELEASE, "agent");
            asm volatile("s_waitcnt vmcnt(0)" ::: "memory");
            const unsigned og = xb_add(&bar[XB_TOP], 1u);
            const unsigned tg = og / nx;
            if (og + 1u == (tg + 1u) * nx) xb_add(&bar[XB_TOPGEN], 1u);
            else XB_SPIN(xb_ld(&bar[XB_TOPGEN]) == tg, bar);
            __builtin_amdgcn_fence(__ATOMIC_ACQUIRE, "agent");
            xb_add(&bar[XB_XGEN(b.x)], 1u);
            asm volatile("s_waitcnt vmcnt(0)" ::: "memory");
        } else {
            XB_SPIN(xb_ld(&bar[XB_XGEN(b.x)]) == gen, bar);
            __builtin_amdgcn_fence(__ATOMIC_ACQUIRE, "agent");
            asm volatile("s_waitcnt vmcnt(0)" ::: "memory");
        }
    }
    __syncthreads();
}

template <int NACC, class Epi>
__device__ __forceinline__ void small_gemm(LAS unsigned char* lds, const bf16_t* X0, const bf16_t* W0, const bf16_t* X1, const bf16_t* W1, int N, int G, int wave, int lane, const Epi& epi) {
    const int r32 = lane & 31, hi = lane >> 5;
    LAS float* part = (LAS float*)lds;
    for (int task = blockIdx.x; task < 4 * (N / 32); task += G) {
        const int rb = task & 3, cb = task >> 2;
#pragma unroll
        for (int a = 0; a < NACC; ++a) {
            const bf16_t* xp = (a ? X1 : X0) + (size_t)(rb * 32 + r32) * DM + hi * 8 + wave * 128;
            const bf16_t* wp = (a ? W1 : W0) + (size_t)(cb * 32 + r32) * DM + hi * 8 + wave * 128;
            bf16x8 xa[8], wa[8];
#pragma unroll
            for (int q = 0; q < 8; ++q) { xa[q] = *(const bf16x8*)(xp + q * 16); wa[q] = *(const bf16x8*)(wp + q * 16); }
            f32x16 acc = f32x16{};
#pragma unroll
            for (int q = 0; q < 8; ++q) acc = __builtin_amdgcn_mfma_f32_32x32x16_bf16(wa[q], xa[q], acc, 0, 0, 0);
#pragma unroll
            for (int r = 0; r < 16; ++r) part[((a * 8 + wave) * 16 + r) * 64 + lane] = acc[r];
        }
        __syncthreads();
        if (wave < 4) {
            const int g4 = wave, t = rb * 32 + r32, n0 = cb * 32 + 8 * g4 + 4 * hi;
            f32x4 v[NACC];
#pragma unroll
            for (int a = 0; a < NACC; ++a) { v[a] = (f32x4){0.f, 0.f, 0.f, 0.f};
#pragma unroll
                for (int w = 0; w < 8; ++w)
#pragma unroll
                    for (int i = 0; i < 4; ++i) v[a][i] += part[((a * 8 + w) * 16 + 4 * g4 + i) * 64 + lane]; }
            epi(t, n0, v[0], v[NACC - 1]);
        }
        __syncthreads();
    }
}
__device__ __forceinline__ u32x2 pack4(f32x4 v) { u32x2 w; w.x = cvtpk(v[0], v[1]); w.y = cvtpk(v[2], v[3]); return w; }
struct SEpiG1 {
    __device__ __forceinline__ void operator()(int t, int n0, f32x4 v, f32x4) const {
        unsigned char* ws = A_WS; float* out = A_OUT;
        const int ts = n0 >> 10, c = n0 & 1023; const size_t ro = (size_t)(NTP + t) * DM + c;
        if (ts == 0) *(u32x2*)((bf16_t*)(ws + WS_Q) + ro) = pack4(v);
        else if (ts == 1) *(f32x4*)(out + O_KS + (size_t)t * DM + c) = v;
        else if (ts == 2) *(f32x4*)(out + O_VS + (size_t)t * DM + c) = v;
        else if (ts == 3) { *(u32x2*)((bf16_t*)(ws + WS_XR) + ro) = pack4(v);
            if ((t & 15) >= 13) *(f32x4*)(out + O_CS + ((size_t)(t >> 4) * 3 + ((t & 15) - 13)) * DM + c) = v; }
        else if (ts == 4) *(u32x2*)((bf16_t*)(ws + WS_G) + ro) = pack4(v);
        else if (ts == 5) *(u32x2*)((bf16_t*)(ws + WS_SGA) + (size_t)t * DM + c) = pack4(v);
        else *(u32x2*)((bf16_t*)(ws + WS_SGR) + (size_t)t * DM + c) = pack4(v);
    }
};
struct SEpiP3 {
    __device__ __forceinline__ void operator()(int t, int n0, f32x4 va, f32x4 vr) const {
        unsigned char* ws = A_WS;
        const u32x2 ga = *(const u32x2*)((const bf16_t*)(ws + WS_SGA) + (size_t)t * DM + n0), gr = *(const u32x2*)((const bf16_t*)(ws + WS_SGR) + (size_t)t * DM + n0);
        f32x4 m;
        m[0] = sigmoidf_(bflo(ga.x)) * va[0] + sigmoidf_(bflo(gr.x)) * vr[0]; m[1] = sigmoidf_(bfhi(ga.x)) * va[1] + sigmoidf_(bfhi(gr.x)) * vr[1];
        m[2] = sigmoidf_(bflo(ga.y)) * va[2] + sigmoidf_(bflo(gr.y)) * vr[2]; m[3] = sigmoidf_(bfhi(ga.y)) * va[3] + sigmoidf_(bfhi(gr.y)) * vr[3];
        *(u32x2*)((bf16_t*)(ws + WS_XR) + (size_t)(NTP + t) * DM + n0) = pack4(m);
    }
};
struct SEpiBf16 {
    size_t wsoff; int ld;
    __device__ __forceinline__ void operator()(int t, int n0, f32x4 v, f32x4) const { *(u32x2*)((bf16_t*)(A_WS + wsoff) + (size_t)(NTP + t) * ld + n0) = pack4(v); }
};

__global__ void __launch_bounds__(512, 2) hybrid_fwd(Args a) {
    extern __shared__ __attribute__((aligned(16))) unsigned char lds_raw[];
    LAS unsigned char* lds = (LAS unsigned char*)lds_raw;
    const int tid = threadIdx.x, lane = tid & 63, wave = __builtin_amdgcn_readfirstlane(tid >> 6), G = gridDim.x;
    cg::grid_group grid = cg::this_grid();
    unsigned char* ws = A_WS;
    if (tid < 2) ((volatile LAS unsigned*)(lds + LDS_MISC))[tid] = 0u;
    __syncthreads();
    XcdBarrier xbar; xbar.bar = (unsigned*)(ws + WS_CTL) + CW_BAR; xbar.x = 0; xbar.st = nullptr;
#define IN(k) (KA->ph_lo <= (k) && (k) < KA->ph_hi)
    if (IN(0)) for (int i = (int)blockIdx.x * 512 + tid; i < 8192; i += G * 512) ((unsigned*)(ws + WS_CTL))[i] = 0u;
#define SEAM(k) do { if (KA->use_sync && IN(k) && IN((k) + 1)) xcd_barrier(xbar); } while (0)
    if (IN(0)) { p0a_prologue(lds, G, wave, lane); p0b_prologue(lds, G, wave, lane); if (KA->use_sync) grid.sync(); }
    if (KA->use_sync) xbar = xcd_barrier_post((unsigned*)(ws + WS_CTL) + CW_BAR, (volatile LAS unsigned*)(lds + LDS_MISC));
    if (IN(0)) { p0c_prologue(lds, G, wave, lane); }
    SEAM(0);
    if (IN(1)) {
        pg8::Gemm g{(const bf16_t*)(ws + WS_XN), (const bf16_t*)(ws + WS_WIN), (const bf16_t*)(ws + WS_WIN) + (size_t)2048 * DM, (const bf16_t*)(ws + WS_XN), DM};
        SchedG1 S; S.init(G, blockIdx.x); EpiG1 E;
        pg8::gemm_phase(lds, g, S, E);
        {
            const bf16_t* xnq = (const bf16_t*)((const unsigned char*)(A_OUT + O_YP) + (size_t)2 * NTP * DM);
            pg8::Gemm gq{xnq, (const bf16_t*)(ws + WS_WIQ), xnq, (const bf16_t*)(ws + WS_WIQ), DM / 2};
            SchedOne SQ; SQ.init(8, G, blockIdx.x); EpiQG EQ;
            pg8::gemm_phase<EpiQG, SchedOne, true>(lds, gq, SQ, EQ);
            pg8::Gemm gkv{xnq, (const bf16_t*)(ws + WS_WKV8), (const bf16_t*)(ws + WS_WKV8 + (size_t)1024 * DM), xnq, DM / 2};
            SchedKV8 SK; SK.init(G, blockIdx.x); EpiKV8 EK;
            pg8::gemm_phase<EpiKV8, SchedKV8, true>(lds, gkv, SK, EK);
        }
        { const bf16_t* xs = (const bf16_t*)(ws + WS_XN) + (size_t)NTP * DM; const bf16_t* w = (const bf16_t*)(ws + WS_WIN); SEpiG1 SE; small_gemm<1>(lds, xs, w, xs, w, INC, G, wave, lane, SE); }
    }
    SEAM(1);
    if (IN(2)) { p2_phase(lds, G, tid, wave, lane); }
    SEAM(2);
    if (IN(3)) {
        pg8::Gemm g{(const bf16_t*)(ws + WS_XN), (const bf16_t*)(ws + WS_WBA), (const bf16_t*)(ws + WS_G), (const bf16_t*)(ws + WS_WBL), DM};
        {
            const bf16_t* xnq = (const bf16_t*)((const unsigned char*)(A_OUT + O_YP) + (size_t)2 * NTP * DM);
            pg8::Gemm gg{xnq, (const bf16_t*)(ws + WS_WIQ + (size_t)2048 * DM), xnq, (const bf16_t*)(ws + WS_WIQ + (size_t)2048 * DM), DM / 2};
            SchedGate SG; SG.init(G, blockIdx.x); EpiGate EG;
            pg8::gemm_phase<EpiGate, SchedGate, true>(lds, gg, SG, EG);
        }
        SchedPair S; S.init(4, G, blockIdx.x); EpiP3 E;
        pg8::gemm_phase(lds, g, S, E);
        { SEpiP3 SE; small_gemm<2>(lds, (const bf16_t*)(ws + WS_XN) + (size_t)NTP * DM, (const bf16_t*)(ws + WS_WBA), (const bf16_t*)(ws + WS_G) + (size_t)NTP * DM, (const bf16_t*)(ws + WS_WBL), DM, G, wave, lane, SE); }
    }
    SEAM(3);
    if (IN(4)) {
        pg8::Gemm g{(const bf16_t*)(ws + WS_XR), (const bf16_t*)(ws + WS_WO), (const bf16_t*)(ws + WS_XR), (const bf16_t*)(ws + WS_WO), DM};
        SchedOne S; S.init(4, G, blockIdx.x); EpiP4 E;
        pg8::gemm_phase(lds, g, S, E);
        { const bf16_t* xs = (const bf16_t*)(ws + WS_XR) + (size_t)NTP * DM; const bf16_t* w = (const bf16_t*)(ws + WS_WO); SEpiBf16 SE{WS_DELTA, DM}; small_gemm<1>(lds, xs, w, xs, w, DM, G, wave, lane, SE); }
    }
    SEAM(4);
    if (IN(5)) { p4b_phase(G, wave, lane); }
    SEAM(5);
    if (IN(6)) {
        pg8::Gemm g{(const bf16_t*)(ws + WS_XQ), (const bf16_t*)(ws + WS_WSQ), (const bf16_t*)(ws + WS_XQ), (const bf16_t*)(ws + WS_WSQ), DM / 2};
        SchedOne S; S.init(8, G, blockIdx.x); EpiP5 E;
        pg8::gemm_phase<EpiP5, SchedOne, true>(lds, g, S, E);
        { const bf16_t* xs = (const bf16_t*)(ws + WS_Q) + (size_t)NTP * DM; const bf16_t* w = (const bf16_t*)(ws + WS_WS); SEpiBf16 SE{WS_XN, 2048}; small_gemm<1>(lds, xs, w, xs, w, 2048, G, wave, lane, SE); }
    }
    SEAM(6);
    if (IN(7)) { p6a_phase(lds, G, wave, lane); }
    SEAM(7);
    if (IN(8)) { p6b_phase(lds, tid, wave, lane); }
    SEAM(8);
    if (IN(9)) { p6m_phase(G, wave, lane); }
    SEAM(9);
    if (IN(10)) { p6c_phase(lds, tid, wave, lane); }
    SEAM(10);
    if (IN(11)) { p6d_phase(G, wave, lane); }
#undef IN
#undef SEAM
}

#ifndef N_LAUNCH_MODE
#define N_LAUNCH_MODE 1
#endif
constexpr int NPH = 12;
extern "C" void kernel_launch(void* const* d_in, const int* in_sizes, int n_in, void* d_out, int out_size, void* d_ws, size_t ws_size, hipStream_t stream) {
    static int grid = 0;
    if (grid == 0) {
        if (n_in != 26 || (size_t)out_size != O_END || ws_size < WS_END) { fprintf(stderr, "kernel_launch: unexpected sizes n_in %d out %d ws %zu (need %zu)\n", n_in, out_size, ws_size, (size_t)WS_END); grid = -1; return; }
        int dev = 0, cus = 0, per_cu = 0;
        (void)hipGetDevice(&dev); (void)hipDeviceGetAttribute(&cus, hipDeviceAttributeMultiprocessorCount, dev);
        (void)hipFuncSetAttribute((const void*)hybrid_fwd, hipFuncAttributeMaxDynamicSharedMemorySize, LDS_BYTES);
        (void)hipOccupancyMaxActiveBlocksPerMultiprocessor(&per_cu, (const void*)hybrid_fwd, 512, LDS_BYTES);
        if (per_cu < 1) { fprintf(stderr, "kernel_launch: occupancy query says %d blocks per CU\n", per_cu); per_cu = 1; }
        grid = cus;
        (void)hipGetLastError();
    }
    if (grid < 0) return;
    Args a{};
    for (int i = 0; i < 26; ++i) a.in[i] = (const float*)d_in[i];
    a.out = (float*)d_out; a.ws = (unsigned char*)d_ws;
    if (N_LAUNCH_MODE == 1) {
        a.ph_lo = 0; a.ph_hi = NPH; a.use_sync = 1;
        void* args[] = {&a};
        hipError_t e = hipLaunchCooperativeKernel((const void*)hybrid_fwd, dim3(grid), dim3(512), args, LDS_BYTES, stream);
        if (e != hipSuccess) fprintf(stderr, "cooperative launch failed: %s (grid %d)\n", hipGetErrorString(e), grid);
    } else {
        for (int p = 0; p < NPH; ++p) { a.ph_lo = p; a.ph_hi = p + 1; a.use_sync = 0; hipLaunchKernelGGL(hybrid_fwd, dim3(grid), dim3(512), LDS_BYTES, stream, a); }
    }
}
```

```cpp
#include <hip/hip_runtime.h>
#include <hip/hip_cooperative_groups.h>
#include <cstdint>
#include <cstdio>
namespace cg = cooperative_groups;

#define LAS __attribute__((address_space(3)))
typedef unsigned short bf16_t;
typedef short bf16x8 __attribute__((ext_vector_type(8)));
typedef float f32x4 __attribute__((ext_vector_type(4)));
typedef float f32x2 __attribute__((ext_vector_type(2)));
typedef float f32x16 __attribute__((ext_vector_type(16)));
typedef unsigned u32x4 __attribute__((ext_vector_type(4)));
typedef unsigned u32x2 __attribute__((ext_vector_type(2)));
typedef __bf16 bf16x2_t __attribute__((ext_vector_type(2)));
typedef int i32x4_t __attribute__((ext_vector_type(4)));

constexpr int DM = 1024, SEQ = 4096, NB = 16, NTP = NB * SEQ, NSB = 8, NST = 16, NTS = NSB * NST, NTOK = NTP + NTS;
constexpr int ROWS = 65792, NMT = 257;
constexpr int INC = 7168, NEXP = 16384;
constexpr float EPS = 1e-6f, LOG2E = 1.4426950408889634f;
constexpr float QSCALE = 0.125f * LOG2E;

constexpr size_t MiB = 1u << 20;
constexpr size_t BUF = (size_t)ROWS * DM * 2;
constexpr size_t WS_CTL = 0;
constexpr size_t WS_WIN = 1 * MiB;
constexpr size_t WS_WBA = 16 * MiB, WS_WBL = 18 * MiB, WS_WO = 20 * MiB, WS_WS = 22 * MiB;
constexpr size_t WS_LRUW = 26 * MiB;
constexpr size_t WS_SGA = 27 * MiB, WS_SGR = 27 * MiB + 512 * 1024;
constexpr size_t WS_SU = 26 * MiB + 512 * 1024, WS_SV = 26 * MiB + 640 * 1024;
constexpr size_t WS_SW = 26 * MiB + 256 * 1024;
constexpr size_t WS_SXN = 46 * MiB;
constexpr size_t WS_WIQ = 47 * MiB;
constexpr size_t WS_SWI = 52 * MiB;
constexpr size_t WS_WKV8 = 54 * MiB, WS_SKV = 58 * MiB;
constexpr size_t WS_WSQ = 44 * MiB;
constexpr size_t WS_SX = 26 * MiB + 704 * 1024;
constexpr size_t WS_UB = 28 * MiB, WS_VB = 60 * MiB;
constexpr size_t WS_Q = 92 * MiB;
constexpr size_t WS_XN = WS_Q + BUF;
constexpr size_t WS_K = WS_XN + BUF;
constexpr size_t WS_VT = WS_K + BUF;
constexpr size_t WS_XR = WS_VT + BUF;
constexpr size_t WS_G = WS_XR + BUF;
constexpr size_t WS_END = WS_G + BUF;
constexpr size_t WS_DELTA = WS_VT;
constexpr size_t WS_PEER = WS_Q;
constexpr size_t WS_SELU = WS_Q;
constexpr size_t WS_SELE = WS_G, WS_SELG = WS_G + (size_t)NTOK * 512, WS_XQ = WS_G + (size_t)NTOK * 1024;

constexpr size_t O_YP = 0, O_YS = O_YP + (size_t)NTP * DM, O_KP = O_YS + (size_t)NTS * DM, O_VP = O_KP + (size_t)NB * 512 * DM,
                 O_CP = O_VP + (size_t)NB * 512 * DM, O_LP = O_CP + (size_t)NB * 3 * DM, O_KS = O_LP + (size_t)NB * DM, O_VS = O_KS + (size_t)NTS * DM,
                 O_CS = O_VS + (size_t)NTS * DM, O_LS = O_CS + (size_t)NSB * 3 * DM, O_END = O_LS + (size_t)NSB * DM;

constexpr int LDS_BYTES = 135168;

__device__ __forceinline__ unsigned cvtpk(float lo, float hi) { f32x2 v = {lo, hi}; bf16x2_t b = __builtin_convertvector(v, bf16x2_t); return __builtin_bit_cast(unsigned, b); }
__device__ __forceinline__ float bflo(unsigned u) { return __uint_as_float(u << 16); }
__device__ __forceinline__ float bfhi(unsigned u) { return __uint_as_float(u & 0xffff0000u); }
__device__ __forceinline__ float fast_exp2(float x) { return __builtin_amdgcn_exp2f(x); }
__device__ __forceinline__ float fast_rcp(float x) { return __builtin_amdgcn_rcpf(x); }
__device__ __forceinline__ float sigmoidf_(float z) { return fast_rcp(1.0f + fast_exp2(-z * LOG2E)); }
__device__ __forceinline__ float gelu_tanh(float x) { const float u = x + 0.044715f * x * x * x; return x * fast_rcp(1.0f + fast_exp2(-1.5957691216f * LOG2E * u)); }
__device__ __forceinline__ float wave_sum(float v) {
    v += __builtin_bit_cast(float, __builtin_amdgcn_update_dpp(0, __builtin_bit_cast(int, v), 0xB1, 0xF, 0xF, true));
    v += __builtin_bit_cast(float, __builtin_amdgcn_update_dpp(0, __builtin_bit_cast(int, v), 0x4E, 0xF, 0xF, true));
    v += __builtin_bit_cast(float, __builtin_amdgcn_update_dpp(0, __builtin_bit_cast(int, v), 0x141, 0xF, 0xF, true));
    v += __builtin_bit_cast(float, __builtin_amdgcn_update_dpp(0, __builtin_bit_cast(int, v), 0x140, 0xF, 0xF, true));
    const int b = __builtin_bit_cast(int, v);
    return (__builtin_bit_cast(float, __builtin_amdgcn_readlane(b, 0)) + __builtin_bit_cast(float, __builtin_amdgcn_readlane(b, 16)))
         + (__builtin_bit_cast(float, __builtin_amdgcn_readlane(b, 32)) + __builtin_bit_cast(float, __builtin_amdgcn_readlane(b, 48)));
}
__device__ __forceinline__ float wave_max(float v) {
    v = fmaxf(v, __builtin_bit_cast(float, __builtin_amdgcn_update_dpp(0, __builtin_bit_cast(int, v), 0xB1, 0xF, 0xF, true)));
    v = fmaxf(v, __builtin_bit_cast(float, __builtin_amdgcn_update_dpp(0, __builtin_bit_cast(int, v), 0x4E, 0xF, 0xF, true)));
    v = fmaxf(v, __builtin_bit_cast(float, __builtin_amdgcn_update_dpp(0, __builtin_bit_cast(int, v), 0x141, 0xF, 0xF, true)));
    v = fmaxf(v, __builtin_bit_cast(float, __builtin_amdgcn_update_dpp(0, __builtin_bit_cast(int, v), 0x140, 0xF, 0xF, true)));
    const int b = __builtin_bit_cast(int, v);
    return fmaxf(fmaxf(__builtin_bit_cast(float, __builtin_amdgcn_readlane(b, 0)), __builtin_bit_cast(float, __builtin_amdgcn_readlane(b, 16))),
                 fmaxf(__builtin_bit_cast(float, __builtin_amdgcn_readlane(b, 32)), __builtin_bit_cast(float, __builtin_amdgcn_readlane(b, 48))));
}
__device__ __forceinline__ int swap23(int i) { return (i & ~12) | ((i & 4) << 1) | ((i & 8) >> 1); }
__device__ __forceinline__ float plswap_max(float m) { auto rr = __builtin_amdgcn_permlane32_swap(__float_as_uint(m), __float_as_uint(m), false, false); return fmaxf(__uint_as_float(rr[0]), __uint_as_float(rr[1])); }
__device__ __forceinline__ float plswap_add(float m) { auto rr = __builtin_amdgcn_permlane32_swap(__float_as_uint(m), __float_as_uint(m), false, false); return __uint_as_float(rr[0]) + __uint_as_float(rr[1]); }

namespace pg8 {
constexpr int BM = 256, BK = 64, HALF = 128, HTB = HALF * BK * 2, STAGE_BYTES = 8 * HTB, NXCD = 8, WGM = 8;
__host__ __device__ __forceinline__ int lds_byte(int r, int c) { const int st = (r >> 4) * 2 + (c >> 5), rr = r & 15, cc = c & 31, ob = rr * 64 + cc * 2; return st * 1024 + (ob ^ (((ob >> 9) & 1) << 5)); }
__host__ __device__ __forceinline__ void stage_rc(int b, int& R, int& C) { const int st = b / 1024, sb = b % 1024, swz = sb ^ (((sb >> 9) & 1) << 5); R = (st >> 1) * 16 + swz / 64; C = (st & 1) * 32 + (swz % 64) / 2; }
__host__ __device__ __forceinline__ int perm32(int rho) { const int n = rho >> 4, i = rho & 15; return 8 * (i >> 2) + 4 * n + (i & 3); }

struct Unit { int pm, pn, kind; };
struct Gemm { const bf16_t* A0; const bf16_t* B0; const bf16_t* A1; const bf16_t* B1; int K; };

struct TileMap {
    int nM, nN, nwg;
    __device__ __forceinline__ void init(int nM_, int nN_) { nM = nM_; nN = nN_; nwg = nM * nN; }
    __device__ __forceinline__ void map(int L, int& pm, int& pn) const {
        int wgid = L; { const int q = nwg / NXCD, r = nwg % NXCD, xcd = wgid % NXCD, off = wgid / NXCD; wgid = (xcd < r ? xcd * (q + 1) : r * (q + 1) + (xcd - r) * q) + off; }
        const int nig = WGM * nN, gid = wgid / nig, fm = gid * WGM, gsz = (nM - fm) < WGM ? (nM - fm) : WGM;
        pm = fm + ((wgid % nig) % gsz); pn = (wgid % nig) / gsz;
    }
};

template <class Epi, class Sched, bool I8 = false>
__device__ __forceinline__ void gemm_phase(LAS unsigned char* lds, const Gemm g, const Sched& S, const Epi& E) {
    const int tid = threadIdx.x, wid = __builtin_amdgcn_readfirstlane(tid >> 6), lane = tid & 63, wr = wid >> 2, wc = wid & 3, fr = lane & 15, fq = lane >> 4;
    const int K = g.K, nt = K / BK;
    unsigned voffA[2], voffB[2];
#pragma unroll
    for (int i = 0; i < 2; ++i) { int R, C; stage_rc(tid * 16 + i * 8192, R, C); const int Rb = (R & ~31) + perm32(R & 31);
        voffA[i] = (unsigned)(R * K + C) * 2u; voffB[i] = (unsigned)(Rb * K + C) * 2u; }
    const size_t kstep = (size_t)(BK * 2);
    const size_t hstep = (size_t)HALF * K * 2;
    const size_t tstep = 2 * hstep;
    const unsigned ldsw = (unsigned)wid * 1024u;
    const int aoff = lds_byte(wr * 64 + fr, fq * 8), boff = lds_byte(wc * 32 + fr, fq * 8);
#define PG8_SA(b, h) (((b) * 2 + (h)) * HTB)
#define PG8_SB(b, h) ((4 + (b) * 2 + (h)) * HTB)
#define PG8_STAGE(bufoff, gbase, voff) do { _Pragma("unroll") for (int _i = 0; _i < 2; ++_i) \
        __builtin_amdgcn_global_load_lds((const unsigned*)((const char*)(gbase) + (voff)[_i]), (LAS unsigned*)(lds + (bufoff) + ldsw + _i * 8192), 16, 0, 0); } while (0)
#define PG8_LDA(dst, b, h) do { _Pragma("unroll") for (int m = 0; m < 4; ++m) _Pragma("unroll") for (int k = 0; k < 2; ++k) dst[m][k] = *(const LAS bf16x8*)(lds + PG8_SA(b, h) + aoff + m * 2048 + k * 1024); } while (0)
#define PG8_LDB(dst, b, h) do { _Pragma("unroll") for (int n = 0; n < 2; ++n) _Pragma("unroll") for (int k = 0; k < 2; ++k) dst[n][k] = *(const LAS bf16x8*)(lds + PG8_SB(b, h) + boff + n * 2048 + k * 1024); } while (0)
#define PG8_MMA(ai, bj, At, Bt) do { __builtin_amdgcn_s_setprio(1); _Pragma("unroll") for (int m = 0; m < 4; ++m) _Pragma("unroll") for (int n = 0; n < 2; ++n) _Pragma("unroll") for (int k = 0; k < 2; ++k) { \
        if constexpr (I8) acc[ai][bj][m][n] = __builtin_bit_cast(acc_t, __builtin_amdgcn_mfma_i32_16x16x64_i8(__builtin_bit_cast(i32x4_t, Bt[n][k]), __builtin_bit_cast(i32x4_t, At[m][k]), __builtin_bit_cast(i32x4_t, acc[ai][bj][m][n]), 0, 0, 0)); \
        else acc[ai][bj][m][n] = __builtin_bit_cast(acc_t, __builtin_amdgcn_mfma_f32_16x16x32_bf16(Bt[n][k], At[m][k], __builtin_bit_cast(f32x4, acc[ai][bj][m][n]), 0, 0, 0)); } __builtin_amdgcn_s_setprio(0); } while (0)
#define PG8_WAIT_V(n) asm volatile("s_waitcnt vmcnt(" #n ")" ::: "memory")
#define PG8_WAIT_L(n) asm volatile("s_waitcnt lgkmcnt(" #n ")" ::: "memory")
#define PG8_BAR __builtin_amdgcn_s_barrier()
#define PG8_SCHED __builtin_amdgcn_sched_barrier(0)
    Unit cur, nxt; int ui = 0;
    if (!S.next(0, cur)) return;
    typedef typename Epi::acc_t acc_t;
    acc_t acc[2][2][4][2];
#pragma unroll
    for (int a = 0; a < 2; ++a)
#pragma unroll
        for (int b = 0; b < 2; ++b)
#pragma unroll
            for (int m = 0; m < 4; ++m)
#pragma unroll
                for (int n = 0; n < 2; ++n) acc[a][b][m][n] = acc_t{};
    bf16x8 At[4][2], B0[2][2], B1[2][2];
    const char* cA = (const char*)(cur.kind ? g.A1 : g.A0) + (size_t)cur.pm * tstep; const char* cB = (const char*)(cur.kind ? g.B1 : g.B0) + (size_t)cur.pn * tstep;
    PG8_STAGE(PG8_SB(0, 0), cB, voffB); PG8_STAGE(PG8_SB(0, 1), cB + hstep, voffB); PG8_STAGE(PG8_SA(0, 0), cA, voffA); PG8_STAGE(PG8_SA(0, 1), cA + hstep, voffA);
    if (wr == 1) PG8_BAR;
    PG8_WAIT_V(2); PG8_BAR;
    PG8_STAGE(PG8_SB(1, 0), cB + kstep, voffB); PG8_STAGE(PG8_SA(1, 0), cA + kstep, voffA); PG8_STAGE(PG8_SB(1, 1), cB + hstep + kstep, voffB);
    PG8_WAIT_V(6); PG8_BAR;
    for (;;) {
        const bool has_next = S.next(ui + 1, nxt);
        E.prefetch(cur, lds + STAGE_BYTES + 512 + wid * 256, tid);
        const char* nA = has_next ? (const char*)(nxt.kind ? g.A1 : g.A0) + (size_t)nxt.pm * tstep : cA; const char* nB = has_next ? (const char*)(nxt.kind ? g.B1 : g.B0) + (size_t)nxt.pn * tstep : cB;
        for (int t = 0; t < nt; t += 2) {
            const bool last = (t == nt - 2);
            const char* a1 = cA + (size_t)(t + 1) * kstep;
            const char* a2 = last ? nA : cA + (size_t)(t + 2) * kstep; const char* b2 = last ? nB : cB + (size_t)(t + 2) * kstep;
            const char* a3 = a2 + kstep; const char* b3 = b2 + kstep;
            PG8_LDB(B0, 0, 0); PG8_LDB(B1, 0, 1); PG8_SCHED; PG8_LDA(At, 0, 0); PG8_STAGE(PG8_SA(1, 1), a1 + hstep, voffA);
            PG8_WAIT_V(8); PG8_WAIT_L(0); PG8_BAR; PG8_MMA(0, 0, At, B0); PG8_MMA(0, 1, At, B1); PG8_BAR; PG8_SCHED;
            PG8_LDA(At, 0, 1); PG8_STAGE(PG8_SB(0, 0), b2, voffB); PG8_STAGE(PG8_SB(0, 1), b2 + hstep, voffB); PG8_STAGE(PG8_SA(0, 0), a2, voffA);
            PG8_WAIT_V(8); PG8_WAIT_L(0); PG8_BAR; PG8_MMA(1, 0, At, B0); PG8_MMA(1, 1, At, B1); PG8_BAR; PG8_SCHED;
            PG8_LDB(B0, 1, 0); PG8_LDB(B1, 1, 1); PG8_SCHED; PG8_LDA(At, 1, 0); PG8_STAGE(PG8_SA(0, 1), a2 + hstep, voffA);
            PG8_WAIT_V(8); PG8_WAIT_L(0); PG8_BAR; PG8_MMA(0, 0, At, B0); PG8_MMA(0, 1, At, B1); PG8_BAR; PG8_SCHED;
            PG8_LDA(At, 1, 1); PG8_STAGE(PG8_SB(1, 0), b3, voffB); PG8_STAGE(PG8_SB(1, 1), b3 + hstep, voffB); PG8_STAGE(PG8_SA(1, 0), a3, voffA);
            PG8_WAIT_V(8); PG8_WAIT_L(0); PG8_BAR; PG8_MMA(1, 0, At, B0); PG8_MMA(1, 1, At, B1); PG8_BAR; PG8_SCHED;
        }
        if (wr == 0) PG8_BAR;
        const bool keep = E(acc, cur, wr, wc, fr, fq);
        if (!has_next) break;
        if (!keep) {
#pragma unroll
        for (int a = 0; a < 2; ++a)
#pragma unroll
            for (int b = 0; b < 2; ++b)
#pragma unroll
                for (int m = 0; m < 4; ++m)
#pragma unroll
                    for (int n = 0; n < 2; ++n) acc[a][b][m][n] = acc_t{};
        }
        cur = nxt; cA = nA; cB = nB; ++ui;
        if (wr == 1) PG8_BAR;
    }
    PG8_WAIT_V(0);
    PG8_BAR;
#undef PG8_SA
#undef PG8_SB
#undef PG8_STAGE
#undef PG8_LDA
#undef PG8_LDB
#undef PG8_MMA
#undef PG8_WAIT_V
#undef PG8_WAIT_L
#undef PG8_BAR
#undef PG8_SCHED
}
}
using pg8::Unit;

struct Args {
    const float* in[26];
    float* out; unsigned char* ws;
    int ph_lo, ph_hi, use_sync, pad;
};

typedef const __attribute__((address_space(4))) Args* ArgsP;
#define KA ((ArgsP)__builtin_amdgcn_kernarg_segment_ptr())
#define A_IN(k) (KA->in[k])
#define A_OUT (KA->out)
#define A_WS (KA->ws)

struct SchedG1 {
    pg8::TileMap mk, mv; int G, c;
    __device__ __forceinline__ void init(int G_, int c_) { mk.init(32, 4); mv.init(4, 32); G = G_; c = c_; }
    __device__ __forceinline__ bool next(int i, Unit& u) const {
        int L = i * G + c, t;
        if (L < 256) { const int xr = L < 128; mk.map(xr ? L : L - 128, t, u.pn); u.pm = (t >> 1) * 16 + 14 + (t & 1); u.pn += xr ? 12 : 4; u.kind = 0; return true; }
        L -= 256; if (L < 128) { mv.map(L, u.pm, t); u.pn = (t >> 1) * 16 + 14 + (t & 1); u.kind = 1; return true; }
        return false;
    }
};
struct SchedKV8 {
    pg8::TileMap mk, mv; int G, c;
    __device__ __forceinline__ void init(int G_, int c_) { mk.init(224, 4); mv.init(4, 224); G = G_; c = G_ - 1 - c_; }
    __device__ __forceinline__ bool next(int i, Unit& u) const {
        int L = i * G + c, t;
        if (L < 1792) { const int xr = L >= 896; mk.map(xr ? L - 896 : L, t, u.pn); u.pm = (t / 14) * 16 + t % 14; u.pn += xr ? 8 : 0; u.kind = 0; return true; }
        L -= 1792; if (L < 896) { mv.map(L, u.pm, t); u.pn = (t / 14) * 16 + t % 14; u.kind = 1; return true; }
        return false;
    }
};
struct SchedPair {
    pg8::TileMap m0; int G, c;
    __device__ __forceinline__ void init(int nN, int G_, int c_) { m0.init(256, nN); G = G_; c = c_; }
    __device__ __forceinline__ bool next(int i, Unit& u) const { const int L = (i >> 1) * G + c; if (L >= m0.nwg) return false; m0.map(L, u.pm, u.pn); u.kind = i & 1; return true; }
};
struct SchedGate {
    pg8::TileMap m0; int G, c;
    __device__ __forceinline__ void init(int G_, int c_) { m0.init(256, 4); G = G_; c = c_; }
    __device__ __forceinline__ bool next(int i, Unit& u) const { const int L = (i >> 1) * G + c; if (L >= m0.nwg) return false; m0.map(L, u.pm, u.pn); u.pn += 4 * (i & 1); u.kind = 0; return true; }
};
struct SchedOne {
    pg8::TileMap m0; int G, c;
    __device__ __forceinline__ void init(int nN, int G_, int c_) { m0.init(256, nN); G = G_; c = c_; }
    __device__ __forceinline__ bool next(int i, Unit& u) const { const int L = i * G + c; if (L >= m0.nwg) return false; m0.map(L, u.pm, u.pn); u.kind = 0; return true; }
};

#define EPI_PREP int fr_ = fr, fq_ = fq; asm volatile("" : "+v"(fr_), "+v"(fq_)); const int rl_ = wr * 64 + fr_, cl_ = wc * 32 + 8 * fq_;
#define EPI_LOOP_BEGIN \
    _Pragma("unroll") for (int ai = 0; ai < 2; ++ai) _Pragma("unroll") for (int m = 0; m < 4; ++m) { const int rit = ai * 128 + m * 16 + rl_; \
    _Pragma("unroll") for (int bj = 0; bj < 2; ++bj) { const int cit = bj * 128 + cl_; const auto v0 = acc[ai][bj][m][0], v1 = acc[ai][bj][m][1];
#define EPI_LOOP_END } }

__device__ __forceinline__ size_t kfrag_off(int row, int col) {
    return ((((size_t)(row >> 5) * 16 + (col >> 6)) * 4 + ((col >> 4) & 3)) * 64 + ((col >> 3) & 1) * 32 + swap23(row & 31)) * 8;
}
__device__ __forceinline__ size_t vfrag_off(int vc, int tok) {
    return (((((size_t)(tok >> 5) * 16 + (vc >> 6)) * 2 + ((vc >> 5) & 1)) * 2 + ((tok >> 4) & 1)) * 64 + ((tok >> 3) & 1) * 32 + swap23(vc & 31)) * 8;
}
struct EpiG1 {
    typedef f32x4 acc_t;
    __device__ __forceinline__ void prefetch(const Unit&, LAS unsigned char*, int) const {}
    __device__ __forceinline__ bool operator()(f32x4 (&acc)[2][2][4][2], const Unit& u, int wr, int wc, int fr, int fq) const {
        EPI_PREP unsigned char* ws = A_WS; float* out = A_OUT;
        if (u.kind == 0) {
            const int t = u.pn >> 2, ct = (u.pn & 3) * 256;
            bf16_t* base;
            if (t == 0) base = (bf16_t*)(ws + WS_Q); else if (t == 1) base = (bf16_t*)(ws + WS_K); else if (t == 3) base = (bf16_t*)(ws + WS_XR); else if (t == 4) base = (bf16_t*)(ws + WS_G);
            else if (t == 5) base = (u.pm < 256) ? (bf16_t*)(out + O_YP) : (bf16_t*)(ws + WS_SGA) - (size_t)NTP * DM;
            else base = (u.pm < 256) ? (bf16_t*)(out + O_YP) + (size_t)NTP * DM : (bf16_t*)(ws + WS_SGR) - (size_t)NTP * DM;
            if (t == 1) {
                EPI_LOOP_BEGIN
                    u32x4 w; w.x = cvtpk(v0[0], v0[1]); w.y = cvtpk(v0[2], v0[3]); w.z = cvtpk(v1[0], v1[1]); w.w = cvtpk(v1[2], v1[3]);
                    *(u32x4*)(base + kfrag_off(u.pm * 256 + rit, ct + cit)) = w;
                EPI_LOOP_END
            } else if (t >= 5) {
                unsigned char* g8 = (unsigned char*)(out + O_YP) + (t == 6 ? (size_t)NTP * DM : 0) + (size_t)u.pm * 256 * DM + ct;
                EPI_LOOP_BEGIN
                    u32x2 w;
                    w.x = (unsigned)(int)rintf(sigmoidf_(v0[0]) * 255.0f) | ((unsigned)(int)rintf(sigmoidf_(v0[1]) * 255.0f) << 8) | ((unsigned)(int)rintf(sigmoidf_(v0[2]) * 255.0f) << 16) | ((unsigned)(int)rintf(sigmoidf_(v0[3]) * 255.0f) << 24);
                    w.y = (unsigned)(int)rintf(sigmoidf_(v1[0]) * 255.0f) | ((unsigned)(int)rintf(sigmoidf_(v1[1]) * 255.0f) << 8) | ((unsigned)(int)rintf(sigmoidf_(v1[2]) * 255.0f) << 16) | ((unsigned)(int)rintf(sigmoidf_(v1[3]) * 255.0f) << 24);
                    *(u32x2*)(g8 + (size_t)rit * DM + cit) = w;
                EPI_LOOP_END
            } else {
            base += (size_t)u.pm * 256 * DM + ct;
            EPI_LOOP_BEGIN
                u32x4 w; w.x = cvtpk(v0[0], v0[1]); w.y = cvtpk(v0[2], v0[3]); w.z = cvtpk(v1[0], v1[1]); w.w = cvtpk(v1[2], v1[3]);
                *(u32x4*)(base + (size_t)rit * DM + cit) = w;
            EPI_LOOP_END
            }
            if (t == 1 && u.pm < 256 && (u.pm & 15) >= 14) { float* p0 = out + O_KP + ((size_t)(u.pm >> 4) * 512 + ((u.pm & 15) - 14) * 256) * DM + ct;
                EPI_LOOP_BEGIN float* p = p0 + (size_t)rit * DM + cit; *(f32x4*)p = v0; *(f32x4*)(p + 4) = v1; EPI_LOOP_END }
            if (t == 1 && u.pm == 256) { float* p0 = out + O_KS + ct;
                EPI_LOOP_BEGIN if (rit < NTS) { float* p = p0 + (size_t)rit * DM + cit; *(f32x4*)p = v0; *(f32x4*)(p + 4) = v1; } EPI_LOOP_END }
            if (t == 3 && u.pm < 256 && (u.pm & 15) == 15) { float* p0 = out + O_CP + ((size_t)(u.pm >> 4) * 3) * DM + ct;
                EPI_LOOP_BEGIN if (rit >= 253) { float* p = p0 + (size_t)(rit - 253) * DM + cit; *(f32x4*)p = v0; *(f32x4*)(p + 4) = v1; } EPI_LOOP_END }
            if (t == 3 && u.pm == 256) { float* p0 = out + O_CS + ct;
                EPI_LOOP_BEGIN if (rit < NTS && (rit & 15) >= 13) { float* p = p0 + ((size_t)(rit >> 4) * 3 + ((rit & 15) - 13)) * DM + cit; *(f32x4*)p = v0; *(f32x4*)(p + 4) = v1; } EPI_LOOP_END }
        } else {
            bf16_t* VT = (bf16_t*)(ws + WS_VT);
            EPI_LOOP_BEGIN
                u32x4 w; w.x = cvtpk(v0[0], v0[1]); w.y = cvtpk(v0[2], v0[3]); w.z = cvtpk(v1[0], v1[1]); w.w = cvtpk(v1[2], v1[3]);
                *(u32x4*)(VT + vfrag_off(u.pm * 256 + rit, u.pn * 256 + cit)) = w;
            EPI_LOOP_END
            if (u.pn < 256 && (u.pn & 15) >= 14) { float* p0 = out + O_VP + ((size_t)(u.pn >> 4) * 512 + ((u.pn & 15) - 14) * 256) * DM + u.pm * 256;
                EPI_LOOP_BEGIN float* p = p0 + (size_t)cit * DM + rit;
                    p[0] = v0[0]; p[DM] = v0[1]; p[2 * DM] = v0[2]; p[3 * DM] = v0[3]; p[4 * DM] = v1[0]; p[5 * DM] = v1[1]; p[6 * DM] = v1[2]; p[7 * DM] = v1[3]; EPI_LOOP_END }
            if (u.pn == 256) { float* p0 = out + O_VS + u.pm * 256;
                EPI_LOOP_BEGIN if (cit < NTS) { float* p = p0 + (size_t)cit * DM + rit;
                    p[0] = v0[0]; p[DM] = v0[1]; p[2 * DM] = v0[2]; p[3 * DM] = v0[3]; p[4 * DM] = v1[0]; p[5 * DM] = v1[1]; p[6 * DM] = v1[2]; p[7 * DM] = v1[3]; } EPI_LOOP_END }
        }
        return false;
    }
};

struct EpiP3 {
    typedef f32x4 acc_t;
    __device__ __forceinline__ void prefetch(const Unit&, LAS unsigned char*, int) const {}
    __device__ __forceinline__ bool operator()(f32x4 (&acc)[2][2][4][2], const Unit& u, int wr, int wc, int fr, int fq) const {
        EPI_PREP unsigned char* ws = A_WS; float* out = A_OUT;
        const size_t off0 = (size_t)u.pm * 256 * DM + u.pn * 256;
        const unsigned char* ga = (const unsigned char*)(out + O_YP) + off0; const unsigned char* gr = ga + (size_t)NTP * DM; bf16_t* MG = (bf16_t*)(ws + WS_XR) + off0;
#pragma unroll
        for (int ai = 0; ai < 2; ++ai) {
            u32x2 wa[4][2], wr8[4][2];
#pragma unroll
            for (int m = 0; m < 4; ++m)
#pragma unroll
                for (int bj = 0; bj < 2; ++bj) { const size_t off = (size_t)(ai * 128 + m * 16 + rl_) * DM + bj * 128 + cl_;
                    wr8[m][bj] = *(const u32x2*)(gr + off); if (u.kind == 0) wa[m][bj] = *(const u32x2*)(ga + off); }
#pragma unroll
            for (int m = 0; m < 4; ++m)
#pragma unroll
                for (int bj = 0; bj < 2; ++bj) {
                    const unsigned r0 = wr8[m][bj].x, r1 = wr8[m][bj].y;
                    float sr[8]; sr[0] = (float)(r0 & 0xffu); sr[1] = (float)((r0 >> 8) & 0xffu); sr[2] = (float)((r0 >> 16) & 0xffu); sr[3] = (float)(r0 >> 24);
                    sr[4] = (float)(r1 & 0xffu); sr[5] = (float)((r1 >> 8) & 0xffu); sr[6] = (float)((r1 >> 16) & 0xffu); sr[7] = (float)(r1 >> 24);
                    if (u.kind == 0) {
                        const unsigned a0 = wa[m][bj].x, a1 = wa[m][bj].y;
                        float sa[8]; sa[0] = (float)(a0 & 0xffu); sa[1] = (float)((a0 >> 8) & 0xffu); sa[2] = (float)((a0 >> 16) & 0xffu); sa[3] = (float)(a0 >> 24);
                        sa[4] = (float)(a1 & 0xffu); sa[5] = (float)((a1 >> 8) & 0xffu); sa[6] = (float)((a1 >> 16) & 0xffu); sa[7] = (float)(a1 >> 24);
#pragma unroll
                        for (int i = 0; i < 4; ++i) { acc[ai][bj][m][0][i] *= sa[i] * fast_rcp(fmaxf(sr[i], 1.0f)); acc[ai][bj][m][1][i] *= sa[4 + i] * fast_rcp(fmaxf(sr[4 + i], 1.0f)); }
                    } else {
                        const float k255 = 1.0f / 255.0f; const size_t off = (size_t)(ai * 128 + m * 16 + rl_) * DM + bj * 128 + cl_;
                        const f32x4 v0 = acc[ai][bj][m][0] * k255, v1 = acc[ai][bj][m][1] * k255;
                        u32x4 w; w.x = cvtpk(v0[0] * fmaxf(sr[0], 1.0f), v0[1] * fmaxf(sr[1], 1.0f)); w.y = cvtpk(v0[2] * fmaxf(sr[2], 1.0f), v0[3] * fmaxf(sr[3], 1.0f));
                        w.z = cvtpk(v1[0] * fmaxf(sr[4], 1.0f), v1[1] * fmaxf(sr[5], 1.0f)); w.w = cvtpk(v1[2] * fmaxf(sr[6], 1.0f), v1[3] * fmaxf(sr[7], 1.0f));
                        *(u32x4*)(MG + off) = w; }
                }
        }
        return u.kind == 0;
    }
};

struct EpiQG {
    typedef i32x4_t acc_t;
    __device__ __forceinline__ void prefetch(const Unit&, LAS unsigned char*, int) const {}
    __device__ __forceinline__ bool operator()(i32x4_t (&acc)[2][2][4][2], const Unit& u, int wr, int wc, int fr, int fq) const {
        EPI_PREP bf16_t* base = (bf16_t*)(A_WS + ((u.pn >> 2) ? WS_G : WS_Q)) + (size_t)u.pm * 256 * DM + (u.pn & 3) * 256;
        const float* SXp = (const float*)(A_WS + WS_SXN) + u.pm * 256; const float* SWp = (const float*)(A_WS + WS_SWI) + u.pn * 256;
        float sxr[2][4]; f32x4 swc[2][2];
#pragma unroll
        for (int ai = 0; ai < 2; ++ai)
#pragma unroll
            for (int m = 0; m < 4; ++m) sxr[ai][m] = SXp[ai * 128 + m * 16 + rl_];
#pragma unroll
        for (int bj = 0; bj < 2; ++bj) { swc[bj][0] = *(const f32x4*)(SWp + bj * 128 + cl_); swc[bj][1] = *(const f32x4*)(SWp + bj * 128 + cl_ + 4); }
        EPI_LOOP_BEGIN
            const float sx = sxr[ai][m]; const f32x4 w0 = swc[bj][0] * sx, w1 = swc[bj][1] * sx;
            u32x4 w; w.x = cvtpk((float)v0[0] * w0[0], (float)v0[1] * w0[1]); w.y = cvtpk((float)v0[2] * w0[2], (float)v0[3] * w0[3]);
            w.z = cvtpk((float)v1[0] * w1[0], (float)v1[1] * w1[1]); w.w = cvtpk((float)v1[2] * w1[2], (float)v1[3] * w1[3]);
            *(u32x4*)(base + (size_t)rit * DM + cit) = w;
        EPI_LOOP_END
        return false;
    }
};
struct EpiKV8 {
    typedef i32x4_t acc_t;
    __device__ __forceinline__ void prefetch(const Unit&, LAS unsigned char*, int) const {}
    __device__ __forceinline__ bool operator()(i32x4_t (&acc)[2][2][4][2], const Unit& u, int wr, int wc, int fr, int fq) const {
        EPI_PREP unsigned char* ws = A_WS;
        const float* SXN = (const float*)(ws + WS_SXN); const float* SKV = (const float*)(ws + WS_SKV);
        const float* rs = u.kind == 0 ? SXN + u.pm * 256 : SKV + 1024 + u.pm * 256;
        const float* cs = u.kind == 0 ? SKV + u.pn * 256 : SXN + u.pn * 256;
        const bool isx = u.kind == 0 && u.pn >= 8;
        bf16_t* dst = (bf16_t*)(ws + (u.kind == 0 ? (isx ? WS_XR : WS_K) : WS_VT));
        float sxr[2][4]; f32x4 swc[2][2];
#pragma unroll
        for (int ai = 0; ai < 2; ++ai)
#pragma unroll
            for (int m = 0; m < 4; ++m) sxr[ai][m] = rs[ai * 128 + m * 16 + rl_];
#pragma unroll
        for (int bj = 0; bj < 2; ++bj) { swc[bj][0] = *(const f32x4*)(cs + bj * 128 + cl_); swc[bj][1] = *(const f32x4*)(cs + bj * 128 + cl_ + 4); }
        EPI_LOOP_BEGIN
            const float sx = sxr[ai][m]; const f32x4 w0 = swc[bj][0] * sx, w1 = swc[bj][1] * sx;
            u32x4 w; w.x = cvtpk((float)v0[0] * w0[0], (float)v0[1] * w0[1]); w.y = cvtpk((float)v0[2] * w0[2], (float)v0[3] * w0[3]);
            w.z = cvtpk((float)v1[0] * w1[0], (float)v1[1] * w1[1]); w.w = cvtpk((float)v1[2] * w1[2], (float)v1[3] * w1[3]);
            const size_t off = isx ? (size_t)(u.pm * 256 + rit) * DM + (u.pn - 8) * 256 + cit : (u.kind == 0 ? kfrag_off(u.pm * 256 + rit, u.pn * 256 + cit) : vfrag_off(u.pm * 256 + rit, u.pn * 256 + cit));
            *(u32x4*)(dst + off) = w;
        EPI_LOOP_END
        return false;
    }
};
struct EpiGate {
    typedef i32x4_t acc_t;
    __device__ __forceinline__ void prefetch(const Unit&, LAS unsigned char*, int) const {}
    __device__ __forceinline__ bool operator()(i32x4_t (&acc)[2][2][4][2], const Unit& u, int wr, int wc, int fr, int fq) const {
        EPI_PREP unsigned char* g8 = (unsigned char*)(A_OUT + O_YP) + ((u.pn >> 2) ? (size_t)NTP * DM : 0) + (size_t)u.pm * 256 * DM + (u.pn & 3) * 256;
        const float* SXp = (const float*)(A_WS + WS_SXN) + u.pm * 256; const float* SWp = (const float*)(A_WS + WS_SWI) + 2048 + u.pn * 256;
        float sxr[2][4]; f32x4 swc[2][2];
#pragma unroll
        for (int ai = 0; ai < 2; ++ai)
#pragma unroll
            for (int m = 0; m < 4; ++m) sxr[ai][m] = SXp[ai * 128 + m * 16 + rl_];
#pragma unroll
        for (int bj = 0; bj < 2; ++bj) { swc[bj][0] = *(const f32x4*)(SWp + bj * 128 + cl_); swc[bj][1] = *(const f32x4*)(SWp + bj * 128 + cl_ + 4); }
        EPI_LOOP_BEGIN
            const float sx = sxr[ai][m]; const f32x4 w0 = swc[bj][0] * sx, w1 = swc[bj][1] * sx;
            u32x2 w;
            w.x = (unsigned)(int)rintf(sigmoidf_((float)v0[0] * w0[0]) * 255.0f) | ((unsigned)(int)rintf(sigmoidf_((float)v0[1] * w0[1]) * 255.0f) << 8) | ((unsigned)(int)rintf(sigmoidf_((float)v0[2] * w0[2]) * 255.0f) << 16) | ((unsigned)(int)rintf(sigmoidf_((float)v0[3] * w0[3]) * 255.0f) << 24);
            w.y = (unsigned)(int)rintf(sigmoidf_((float)v1[0] * w1[0]) * 255.0f) | ((unsigned)(int)rintf(sigmoidf_((float)v1[1] * w1[1]) * 255.0f) << 8) | ((unsigned)(int)rintf(sigmoidf_((float)v1[2] * w1[2]) * 255.0f) << 16) | ((unsigned)(int)rintf(sigmoidf_((float)v1[3] * w1[3]) * 255.0f) << 24);
            *(u32x2*)(g8 + (size_t)rit * DM + cit) = w;
        EPI_LOOP_END
        return false;
    }
};
struct EpiP4 {
    typedef f32x4 acc_t;
    __device__ __forceinline__ void prefetch(const Unit&, LAS unsigned char*, int) const {}
    __device__ __forceinline__ bool operator()(f32x4 (&acc)[2][2][4][2], const Unit& u, int wr, int wc, int fr, int fq) const {
        EPI_PREP bf16_t* base = (bf16_t*)(A_WS + WS_DELTA) + (size_t)u.pm * 256 * DM + u.pn * 256;
        EPI_LOOP_BEGIN
            u32x4 w; w.x = cvtpk(v0[0], v0[1]); w.y = cvtpk(v0[2], v0[3]); w.z = cvtpk(v1[0], v1[1]); w.w = cvtpk(v1[2], v1[3]);
            *(u32x4*)(base + (size_t)rit * DM + cit) = w;
        EPI_LOOP_END
        return false;
    }
};

struct EpiP5 {
    typedef i32x4_t acc_t;
    __device__ __forceinline__ void prefetch(const Unit&, LAS unsigned char*, int) const {}
    __device__ __forceinline__ bool operator()(i32x4_t (&acc)[2][2][4][2], const Unit& u, int wr, int wc, int fr, int fq) const {
        EPI_PREP bf16_t* SC = (bf16_t*)(A_WS + WS_XN) + (size_t)u.pm * 256 * 2048 + u.pn * 256;
        const float* SXp = (const float*)(A_WS + WS_SX) + u.pm * 256; const float* SWp = (const float*)(A_WS + WS_SW) + u.pn * 256;
        float sxr[2][4]; f32x4 swc[2][2];
#pragma unroll
        for (int ai = 0; ai < 2; ++ai)
#pragma unroll
            for (int m = 0; m < 4; ++m) sxr[ai][m] = SXp[ai * 128 + m * 16 + rl_];
#pragma unroll
        for (int bj = 0; bj < 2; ++bj) { swc[bj][0] = *(const f32x4*)(SWp + bj * 128 + cl_); swc[bj][1] = *(const f32x4*)(SWp + bj * 128 + cl_ + 4); }
        EPI_LOOP_BEGIN
            const float sx = sxr[ai][m]; const f32x4 w0 = swc[bj][0] * sx, w1 = swc[bj][1] * sx;
            u32x4 w; w.x = cvtpk((float)v0[0] * w0[0], (float)v0[1] * w0[1]); w.y = cvtpk((float)v0[2] * w0[2], (float)v0[3] * w0[3]);
            w.z = cvtpk((float)v1[0] * w1[0], (float)v1[1] * w1[1]); w.w = cvtpk((float)v1[2] * w1[2], (float)v1[3] * w1[3]);
            *(u32x4*)(SC + (size_t)rit * 2048 + cit) = w;
        EPI_LOOP_END
        return false;
    }
};

__device__ __forceinline__ void row_ld(const float* p, f32x4 (&v)[4], int lane) {
#pragma unroll
    for (int j = 0; j < 4; ++j) v[j] = *(const f32x4*)(p + j * 256 + lane * 4);
}
__device__ __forceinline__ float row_ss(const f32x4 (&v)[4]) { float s = 0.f;
#pragma unroll
    for (int j = 0; j < 4; ++j) s += (v[j][0] * v[j][0] + v[j][1] * v[j][1]) + (v[j][2] * v[j][2] + v[j][3] * v[j][3]);
    return s; }
__device__ __forceinline__ void row_add_bf16(const bf16_t* p, f32x4 (&v)[4], int lane) {
#pragma unroll
    for (int j = 0; j < 4; ++j) { const u32x2 w = *(const u32x2*)(p + j * 256 + lane * 4); v[j][0] += bflo(w.x); v[j][1] += bfhi(w.x); v[j][2] += bflo(w.y); v[j][3] += bfhi(w.y); }
}
__device__ __forceinline__ const float* xrow_ptr(int m) { return (m < NTP) ? A_IN(0) + (size_t)m * DM : A_IN(1) + (size_t)(m - NTP) * DM; }
__device__ __forceinline__ float* yrow_ptr(int m) { return (m < NTP) ? A_OUT + O_YP + (size_t)m * DM : A_OUT + O_YS + (size_t)(m - NTP) * DM; }

__device__ __forceinline__ void p0_transpose_item(const float* W, int K, int N, bf16_t* WT, LAS float* scr, int item, int lane, int nscale = 0) {
    const int nblk = N / 32, kb = item / nblk, nb = item % nblk, k0 = 64 * kb, n0 = 32 * nb;
#pragma unroll 8
    for (int i = 0; i < 32; ++i) { const int kk = 2 * i + (lane >> 5); scr[kk * 33 + (lane & 31)] = W[(size_t)(k0 + kk) * N + n0 + (lane & 31)] * (n0 < nscale ? QSCALE : 1.0f); }
    asm volatile("s_waitcnt lgkmcnt(0)" ::: "memory");
    const int c = lane & 7;
#pragma unroll
    for (int j = 0; j < 4; ++j) { const int n = (lane >> 3) + 8 * j; const LAS float* s = scr + (8 * c) * 33 + n;
        u32x4 o; o.x = cvtpk(s[0 * 33], s[1 * 33]); o.y = cvtpk(s[2 * 33], s[3 * 33]); o.z = cvtpk(s[4 * 33], s[5 * 33]); o.w = cvtpk(s[6 * 33], s[7 * 33]);
        *(u32x4*)(WT + (size_t)(n0 + n) * K + k0 + 8 * c) = o; }
    asm volatile("s_waitcnt lgkmcnt(0)" ::: "memory");
}

__device__ __forceinline__ void p0a_prologue(LAS unsigned char* lds, int G, int wave, int lane) {
    unsigned char* ws = A_WS;
    const int gw = blockIdx.x * 8 + wave, NGW = G * 8;
    LAS float* scr = (LAS float*)(lds + wave * 16384);
    constexpr int I_IN = 16 * (INC / 32), I_SQ = 16 * 32, NTR = I_IN + 3 * I_SQ;
    for (int it = gw; it < NTR; it += NGW) {
        int r = it;
        if (r < I_IN) { p0_transpose_item(A_IN(7), DM, INC, (bf16_t*)(ws + WS_WIN), scr, r, lane, 1024); continue; } r -= I_IN;
        if (r < I_SQ) { p0_transpose_item(A_IN(16), DM, DM, (bf16_t*)(ws + WS_WBA), scr, r, lane); continue; } r -= I_SQ;
        if (r < I_SQ) { p0_transpose_item(A_IN(17), DM, DM, (bf16_t*)(ws + WS_WBL), scr, r, lane); continue; } r -= I_SQ;
        p0_transpose_item(A_IN(18), DM, DM, (bf16_t*)(ws + WS_WO), scr, r, lane);
    }
    {
        const float* wq = A_IN(20); bf16_t* wst = (bf16_t*)(ws + WS_WS);
        const int r32 = lane & 31, hi = lane >> 5;
        for (int it = gw; it < 2048; it += NGW) {
            const int hj = it >> 7, kt = (it >> 5) & 3, ct = it & 31, h = hj >> 1, j = hj & 1;
            const float* ap = (j ? A_IN(22) : A_IN(21)) + ((size_t)(h * 128 + kt * 32 + r32)) * 128 + 64 * hi;
            const float* bp = wq + (size_t)(ct * 32 + r32) * 2048 + hj * 128 + 64 * hi;
            f32x16 acc = {};
#pragma unroll
            for (int s4 = 0; s4 < 16; ++s4) { const f32x4 av = *(const f32x4*)(ap + 4 * s4), bv = *(const f32x4*)(bp + 4 * s4);
                acc = __builtin_amdgcn_mfma_f32_32x32x2f32(av[0], bv[0], acc, 0, 0, 0); acc = __builtin_amdgcn_mfma_f32_32x32x2f32(av[1], bv[1], acc, 0, 0, 0);
                acc = __builtin_amdgcn_mfma_f32_32x32x2f32(av[2], bv[2], acc, 0, 0, 0); acc = __builtin_amdgcn_mfma_f32_32x32x2f32(av[3], bv[3], acc, 0, 0, 0); }
#pragma unroll
            for (int r = 0; r < 16; ++r) { const int key = kt * 32 + (r & 3) + 8 * (r >> 2) + 4 * hi;
                wst[(size_t)(key * 16 + hj) * DM + ct * 32 + r32] = (bf16_t)(cvtpk(acc[r], 0.f) & 0xffffu); }
        }
    }
    {
        bf16_t* fw = (bf16_t*)(ws + WS_LRUW);
        for (int f = gw; f < 256; f += NGW) {
            const int ks = f & 3, T = (f >> 2) & 1, gate = (f >> 3) & 1, g = f >> 4, i = lane & 31, hi = lane >> 5;
            const int outc = 32 * T + swap23(i);
            const float* W = (gate ? A_IN(13) : A_IN(11)) + (size_t)g * 4096;
            float x[8];
#pragma unroll
            for (int j = 0; j < 8; ++j) x[j] = W[(16 * ks + 8 * hi + j) * 64 + outc];
            u32x4 w; w.x = cvtpk(x[0], x[1]); w.y = cvtpk(x[2], x[3]); w.z = cvtpk(x[4], x[5]); w.w = cvtpk(x[6], x[7]);
            *(u32x4*)(fw + (size_t)f * 512 + lane * 8) = w;
        }
    }
}

__device__ __forceinline__ void p0b_prologue(LAS unsigned char* lds, int G, int wave, int lane) {
    unsigned char* ws = A_WS;
    const int gw = blockIdx.x * 8 + wave, NGW = G * 8;
    LAS float* scr = (LAS float*)(lds + wave * 16384);
    {
        f32x4 p[4], pn[4];
        if (gw < 2 * NEXP) {
#pragma unroll
            for (int q = 0; q < 4; ++q) p[q] = *(const f32x4*)(((gw >= NEXP) ? A_IN(24) + (size_t)(gw - NEXP) * DM : A_IN(23) + (size_t)gw * DM) + lane * 16 + 4 * q); }
        for (int it = gw; it < 2 * NEXP; it += NGW) {
            const int tb = it >= NEXP, e = it - tb * NEXP, itn = it + NGW;
            if (itn < 2 * NEXP) {
#pragma unroll
                for (int q = 0; q < 4; ++q) pn[q] = *(const f32x4*)(((itn >= NEXP) ? A_IN(24) + (size_t)(itn - NEXP) * DM : A_IN(23) + (size_t)itn * DM) + lane * 16 + 4 * q); }
            unsigned char* dst = ws + (tb ? WS_VB : WS_UB) + (size_t)e * DM + lane * 16;
            float mx = 0.f;
#pragma unroll
            for (int q = 0; q < 4; ++q) mx = fmaxf(mx, fmaxf(fmaxf(fabsf(p[q][0]), fabsf(p[q][1])), fmaxf(fabsf(p[q][2]), fabsf(p[q][3]))));
            mx = wave_max(mx);
            const float step = fmaxf(mx, 1e-30f) * (1.0f / 127.0f), inv = 1.0f / step;
            u32x4 w;
#pragma unroll
            for (int q = 0; q < 4; ++q) {
                const unsigned b0 = (unsigned)(int)rintf(p[q][0] * inv) & 0xffu, b1 = (unsigned)(int)rintf(p[q][1] * inv) & 0xffu, b2 = (unsigned)(int)rintf(p[q][2] * inv) & 0xffu, b3 = (unsigned)(int)rintf(p[q][3] * inv) & 0xffu;
                w[q] = b0 | (b1 << 8) | (b2 << 16) | (b3 << 24); }
            *(u32x4*)dst = w;
            if (lane == 0) ((float*)(ws + (tb ? WS_SV : WS_SU)))[e] = step;
#pragma unroll
            for (int q = 0; q < 4; ++q) p[q] = pn[q];
        }
    }
    {
        const float* gm = A_IN(6); bf16_t* XN = (bf16_t*)(ws + WS_XN);
        for (int m = NTOK + gw; m < ROWS; m += NGW) {
#pragma unroll
            for (int j = 0; j < 2; ++j) *(u32x4*)(XN + (size_t)m * DM + j * 512 + lane * 8) = (u32x4){0u, 0u, 0u, 0u}; }
        f32x4 v[4], vn[4], ggr[4];
#pragma unroll
        for (int j = 0; j < 4; ++j) ggr[j] = *(const f32x4*)(gm + j * 256 + lane * 4);
        if (gw < NTOK) row_ld(xrow_ptr(gw), v, lane);
        for (int m = gw; m < NTOK; m += NGW) {
            const int mn = m + NGW;
            if (mn < NTOK) row_ld(xrow_ptr(mn), vn, lane);
            bf16_t* orow = XN + (size_t)m * DM;
            const bool needbf = m >= NTP || (m & (SEQ - 1)) >= SEQ - 512;
            const float ss = row_ss(v);
            float mx = 0.f;
#pragma unroll
            for (int j = 0; j < 4; ++j) { v[j] = v[j] * ggr[j];
                mx = fmaxf(mx, fmaxf(fmaxf(fabsf(v[j][0]), fabsf(v[j][1])), fmaxf(fabsf(v[j][2]), fabsf(v[j][3])))); }
            const float inv = __builtin_amdgcn_rsqf(wave_sum(ss) * (1.0f / DM) + EPS);
            mx = fmaxf(wave_max(mx), 1e-30f);
            if (needbf) {
#pragma unroll
                for (int j = 0; j < 4; ++j) { const f32x4 t = v[j] * inv; u32x2 w; w.x = cvtpk(t[0], t[1]); w.y = cvtpk(t[2], t[3]); *(u32x2*)(orow + j * 256 + lane * 4) = w; } }
            if (m < NTP) {
                const float step = mx * inv * (1.0f / 127.0f), qi = 127.0f * fast_rcp(mx);
                unsigned char* xq = (unsigned char*)(A_OUT + O_YP) + (size_t)2 * NTP * DM + (size_t)m * DM;
#pragma unroll
                for (int j = 0; j < 4; ++j) {
                    const unsigned b0 = (unsigned)(int)rintf(v[j][0] * qi) & 0xffu, b1 = (unsigned)(int)rintf(v[j][1] * qi) & 0xffu, b2 = (unsigned)(int)rintf(v[j][2] * qi) & 0xffu, b3 = (unsigned)(int)rintf(v[j][3] * qi) & 0xffu;
                    *(unsigned*)(xq + j * 256 + lane * 4) = b0 | (b1 << 8) | (b2 << 16) | (b3 << 24); }
                if (lane == 0) ((float*)(ws + WS_SXN))[m] = step;
            }
#pragma unroll
            for (int j = 0; j < 4; ++j) v[j] = vn[j];
        }
    }
}

__device__ __forceinline__ void p0c_prologue(LAS unsigned char* lds, int G, int wave, int lane) {
    unsigned char* ws = A_WS;
    const int gw = blockIdx.x * 8 + wave, NGW = G * 8;
    LAS float* scr = (LAS float*)(lds + wave * 16384);
    for (int n = gw; n < 7168; n += NGW) {
        const int srow = n < 1024 ? n : (n < 2048 ? 4096 + (n - 1024) : (n < 4096 ? 5120 + (n - 2048) : n - 3072));
        const bf16_t* wr_ = (const bf16_t*)(ws + WS_WIN) + (size_t)srow * DM + lane * 16;
        const u32x4 a = *(const u32x4*)wr_, b = *(const u32x4*)(wr_ + 8);
        float f[16]; f[0] = bflo(a.x); f[1] = bfhi(a.x); f[2] = bflo(a.y); f[3] = bfhi(a.y); f[4] = bflo(a.z); f[5] = bfhi(a.z); f[6] = bflo(a.w); f[7] = bfhi(a.w);
        f[8] = bflo(b.x); f[9] = bfhi(b.x); f[10] = bflo(b.y); f[11] = bfhi(b.y); f[12] = bflo(b.z); f[13] = bfhi(b.z); f[14] = bflo(b.w); f[15] = bfhi(b.w);
        float mx = 0.f;
#pragma unroll
        for (int j = 0; j < 16; ++j) mx = fmaxf(mx, fabsf(f[j]));
        mx = wave_max(mx);
        const float step = fmaxf(mx, 1e-30f) * (1.0f / 127.0f), qi = 1.0f / step;
        u32x4 w;
#pragma unroll
        for (int q = 0; q < 4; ++q) w[q] = ((unsigned)(int)rintf(f[4 * q] * qi) & 0xffu) | (((unsigned)(int)rintf(f[4 * q + 1] * qi) & 0xffu) << 8) | (((unsigned)(int)rintf(f[4 * q + 2] * qi) & 0xffu) << 16) | (((unsigned)(int)rintf(f[4 * q + 3] * qi) & 0xffu) << 24);
        if (n < 4096) { *(u32x4*)(ws + WS_WIQ + (size_t)n * DM + lane * 16) = w; if (lane == 0) ((float*)(ws + WS_SWI))[n] = step; }
        else { *(u32x4*)(ws + WS_WKV8 + (size_t)(n - 4096) * DM + lane * 16) = w; if (lane == 0) ((float*)(ws + WS_SKV))[n - 4096] = step; }
    }
}

constexpr int LR_WF = 0, LR_CW = 16384, LR_CB = LR_CW + 1024, LR_BR = LR_CB + 256, LR_BI = LR_BR + 256, LR_CS = LR_BI + 256, LR_CARRY = LR_CS + 256, LR_SEQ = LR_CARRY + 2048, LR_END = LR_SEQ + 64, LR_DUMMY = 21504;

__device__ __forceinline__ void lru_load_consts(LAS unsigned char* lds, int g, int t, int nt) {
    const u32x4* src = (const u32x4*)(A_WS + WS_LRUW + (size_t)g * 16384);
    for (int i = t; i < 1024; i += nt) ((LAS u32x4*)(lds + LR_WF))[i] = src[i];
    for (int i = t; i < 256; i += nt) ((LAS float*)(lds + LR_CW))[i] = A_IN(9)[(i >> 6) * DM + g * 64 + (i & 63)];
    for (int i = t; i < 64; i += nt) {
        const int c = g * 64 + i;
        ((LAS float*)(lds + LR_CB))[i] = A_IN(10)[c]; ((LAS float*)(lds + LR_BR))[i] = A_IN(12)[c]; ((LAS float*)(lds + LR_BI))[i] = A_IN(14)[c];
        ((LAS float*)(lds + LR_CS))[i] = 8.0f * log1pf(expf(-A_IN(15)[c]));
    }
    if (t < 8) ((LAS unsigned*)(lds + LR_SEQ))[t] = 0xffffffffu;
}

template <bool SAMPLE>
__device__ __forceinline__ void lru_tile(LAS unsigned char* lds, int lane, int g, size_t rowbase, int tile, int bidx, int pfd) {
    asm volatile("" : "+v"(lane));
    const int tl = lane & 31, hi = lane >> 5, t = tile * 32 + tl;
    const bf16_t* XR = (const bf16_t*)(A_WS + WS_XR); bf16_t* Gb = (bf16_t*)(A_WS + WS_G);
    const int cbase = g * 64 + 8 * hi;
    u32x4 gw4[4];
    {   const bf16_t* gp0 = Gb + (rowbase + (SAMPLE ? (tl < NST ? t : 0) : t)) * DM + cbase;
#pragma unroll
        for (int ks = 0; ks < 4; ++ks) gw4[ks] = *(const u32x4*)(gp0 + 16 * ks); }
    float xc[4][8];
    bf16x8 xf[4];
#pragma unroll
    for (int ks = 0; ks < 4; ++ks) {
        const f32x4 b0 = *(const LAS f32x4*)(lds + LR_CB + (16 * ks + 8 * hi) * 4), b1 = *(const LAS f32x4*)(lds + LR_CB + (16 * ks + 8 * hi) * 4 + 16);
#pragma unroll
        for (int j = 0; j < 4; ++j) { xc[ks][j] = b0[j]; xc[ks][4 + j] = b1[j]; }
#pragma unroll
        for (int tap = 0; tap < 4; ++tap) {
            const int rr = t - 3 + tap;
            float xv[8];
            {
                u32x4 w = *(const u32x4*)(XR + (rowbase + (rr < 0 ? 0 : rr)) * DM + cbase + 16 * ks);
                if (rr < 0) w = (u32x4){0u, 0u, 0u, 0u};
                xv[0] = bflo(w.x); xv[1] = bfhi(w.x); xv[2] = bflo(w.y); xv[3] = bfhi(w.y); xv[4] = bflo(w.z); xv[5] = bfhi(w.z); xv[6] = bflo(w.w); xv[7] = bfhi(w.w);
            }
            if (SAMPLE) {
                const float* sp = A_IN(4) + ((size_t)bidx * 3 + (rr < 0 ? 3 + rr : 0)) * DM + cbase + 16 * ks;
                const f32x4 p = *(const f32x4*)sp, q = *(const f32x4*)(sp + 4);
#pragma unroll
                for (int j = 0; j < 4; ++j) { xv[j] = rr < 0 ? p[j] : xv[j]; xv[4 + j] = rr < 0 ? q[j] : xv[4 + j]; }
            }
            const f32x4 w0 = *(const LAS f32x4*)(lds + LR_CW + (tap * 64 + 16 * ks + 8 * hi) * 4), w1 = *(const LAS f32x4*)(lds + LR_CW + (tap * 64 + 16 * ks + 8 * hi) * 4 + 16);
#pragma unroll
            for (int j = 0; j < 4; ++j) { xc[ks][j] += w0[j] * xv[j]; xc[ks][4 + j] += w1[j] * xv[4 + j]; }
        }
        u32x4 w; w.x = cvtpk(xc[ks][0], xc[ks][1]); w.y = cvtpk(xc[ks][2], xc[ks][3]); w.z = cvtpk(xc[ks][4], xc[ks][5]); w.w = cvtpk(xc[ks][6], xc[ks][7]);
        xf[ks] = __builtin_bit_cast(bf16x8, w);
        asm volatile("" ::: "memory");
    }
    float A[32], B[32];
#pragma unroll
    for (int T = 0; T < 2; ++T) {
        f32x16 ar = f32x16{}, ai = f32x16{};
#pragma unroll
        for (int ks = 0; ks < 4; ++ks) {
            const bf16x8 wr_ = *(const LAS bf16x8*)(lds + LR_WF + ((0 * 2 + T) * 4 + ks) * 1024 + lane * 16);
            const bf16x8 wi_ = *(const LAS bf16x8*)(lds + LR_WF + ((1 * 2 + T) * 4 + ks) * 1024 + lane * 16);
            ar = __builtin_amdgcn_mfma_f32_32x32x16_bf16(wr_, xf[ks], ar, 0, 0, 0);
            ai = __builtin_amdgcn_mfma_f32_32x32x16_bf16(wi_, xf[ks], ai, 0, 0, 0);
        }
#pragma unroll
        for (int q = 0; q < 2; ++q) {
            const int ks = 2 * T + q, lo = (16 * ks + 8 * hi) * 4;
            const f32x4 br0 = *(const LAS f32x4*)(lds + LR_BR + lo), br1 = *(const LAS f32x4*)(lds + LR_BR + lo + 16);
            const f32x4 bi0 = *(const LAS f32x4*)(lds + LR_BI + lo), bi1 = *(const LAS f32x4*)(lds + LR_BI + lo + 16);
            const f32x4 cs0 = *(const LAS f32x4*)(lds + LR_CS + lo), cs1 = *(const LAS f32x4*)(lds + LR_CS + lo + 16);
#pragma unroll
            for (int j = 0; j < 8; ++j) {
                const int r = 8 * q + j;
                const float brv = j < 4 ? br0[j & 3] : br1[j & 3], biv = j < 4 ? bi0[j & 3] : bi1[j & 3], csv = j < 4 ? cs0[j & 3] : cs1[j & 3];
                const float rg = sigmoidf_(ar[r] + brv), ig = sigmoidf_(ai[r] + biv);
                const float la = -csv * rg, av = fast_exp2(la * LOG2E);
                const float x2 = 2.0f * la;
                const float em = (x2 > -0.03f) ? -x2 * (1.0f + x2 * (0.5f + x2 * (0.16666667f + x2 * 0.041666668f))) : 1.0f - av * av;
                A[16 * T + r] = av; B[16 * T + r] = __builtin_amdgcn_sqrtf(em) * ig * xc[ks][j];
            }
        }
        asm volatile("" ::: "memory");
    }
#define LRU_STEP(DPPSTR) do { \
    _Pragma("unroll") for (int c = 0; c < 32; ++c) asm volatile("v_fmac_f32_dpp %0, %0, %1 " DPPSTR : "+v"(B[c]) : "v"(A[c])); \
    _Pragma("unroll") for (int c = 0; c < 32; ++c) asm volatile("v_mul_f32_dpp %0, %0, %0 " DPPSTR : "+v"(A[c])); } while (0)
    asm volatile("s_nop 1");
    LRU_STEP("row_shr:1 row_mask:0xf bank_mask:0xf"); LRU_STEP("row_shr:2 row_mask:0xf bank_mask:0xf"); LRU_STEP("row_shr:4 row_mask:0xf bank_mask:0xf");
    LRU_STEP("row_shr:8 row_mask:0xf bank_mask:0xf"); LRU_STEP("row_bcast:15 row_mask:0xa bank_mask:0xf");
#undef LRU_STEP
    float hin[32];
    if (SAMPLE) {
        const float* hp = A_IN(5) + (size_t)bidx * DM + cbase;
#pragma unroll
        for (int ks = 0; ks < 4; ++ks) { const f32x4 p = *(const f32x4*)(hp + 16 * ks), q = *(const f32x4*)(hp + 16 * ks + 4);
#pragma unroll
            for (int j = 0; j < 4; ++j) { hin[8 * ks + j] = p[j]; hin[8 * ks + 4 + j] = q[j]; } }
    } else if (tile == 0) {
#pragma unroll
        for (int c = 0; c < 32; ++c) hin[c] = 0.f;
    } else {
        volatile LAS unsigned* sq = (volatile LAS unsigned*)(lds + LR_SEQ) + (tile & 7);
        while (*sq != (unsigned)tile) __builtin_amdgcn_s_sleep(1);
        asm volatile("" ::: "memory");
        const LAS float* cp = (const LAS float*)(lds + LR_CARRY) + (tile & 7) * 64 + 8 * hi;
#pragma unroll
        for (int ks = 0; ks < 4; ++ks) { const f32x4 p = *(const LAS f32x4*)(cp + 16 * ks), q = *(const LAS f32x4*)(cp + 16 * ks + 4);
#pragma unroll
            for (int j = 0; j < 4; ++j) { hin[8 * ks + j] = p[j]; hin[8 * ks + 4 + j] = q[j]; } }
    }
#pragma unroll
    for (int c = 0; c < 32; ++c) B[c] = B[c] + A[c] * hin[c];
    if (!SAMPLE) {
        if (tl == 31) {
            if (tile < 127) {
                LAS float* cp = (LAS float*)(lds + LR_CARRY) + ((tile + 1) & 7) * 64 + 8 * hi;
#pragma unroll
                for (int ks = 0; ks < 4; ++ks) { *(LAS f32x4*)(cp + 16 * ks) = (f32x4){B[8 * ks], B[8 * ks + 1], B[8 * ks + 2], B[8 * ks + 3]};
                    *(LAS f32x4*)(cp + 16 * ks + 4) = (f32x4){B[8 * ks + 4], B[8 * ks + 5], B[8 * ks + 6], B[8 * ks + 7]}; }
            } else {
                float* lp = A_OUT + O_LP + (size_t)bidx * DM + cbase;
#pragma unroll
                for (int ks = 0; ks < 4; ++ks) { *(f32x4*)(lp + 16 * ks) = (f32x4){B[8 * ks], B[8 * ks + 1], B[8 * ks + 2], B[8 * ks + 3]};
                    *(f32x4*)(lp + 16 * ks + 4) = (f32x4){B[8 * ks + 4], B[8 * ks + 5], B[8 * ks + 6], B[8 * ks + 7]}; }
            }
        }
        if (tile < 127) {
            asm volatile("s_waitcnt lgkmcnt(0)" ::: "memory");
            if (lane == 63) *((volatile LAS unsigned*)(lds + LR_SEQ) + ((tile + 1) & 7)) = (unsigned)(tile + 1);
        }
    } else if (tl == 15) {
        float* lp = A_OUT + O_LS + (size_t)bidx * DM + cbase;
#pragma unroll
        for (int ks = 0; ks < 4; ++ks) { *(f32x4*)(lp + 16 * ks) = (f32x4){B[8 * ks], B[8 * ks + 1], B[8 * ks + 2], B[8 * ks + 3]};
            *(f32x4*)(lp + 16 * ks + 4) = (f32x4){B[8 * ks + 4], B[8 * ks + 5], B[8 * ks + 6], B[8 * ks + 7]}; }
    }
    if (!SAMPLE || tl < NST) {
        bf16_t* gp = Gb + (rowbase + t) * DM + cbase;
#pragma unroll
        for (int ks = 0; ks < 4; ++ks) {
            const u32x4 w = gw4[ks];
            float gv[8]; gv[0] = bflo(w.x); gv[1] = bfhi(w.x); gv[2] = bflo(w.y); gv[3] = bfhi(w.y); gv[4] = bflo(w.z); gv[5] = bfhi(w.z); gv[6] = bflo(w.w); gv[7] = bfhi(w.w);
            float o[8];
#pragma unroll
            for (int j = 0; j < 8; ++j) o[j] = B[8 * ks + j] * gelu_tanh(gv[j]);
            u32x4 ow; ow.x = cvtpk(o[0], o[1]); ow.y = cvtpk(o[2], o[3]); ow.z = cvtpk(o[4], o[5]); ow.w = cvtpk(o[6], o[7]);
            *(u32x4*)(gp + 16 * ks) = ow;
        }
    }
    (void)pfd;
}

constexpr int P2_Q = 20608;
constexpr int AT_TAB = 24576;
__device__ __forceinline__ void attn_unit(LAS unsigned char* lds, int lane, int b, int c, int h) {
    const int r32 = lane & 31, hi = lane >> 5, kr = swap23(r32);
    const bf16_t* Q = (const bf16_t*)(A_WS + WS_Q); const bf16_t* Kb = (const bf16_t*)(A_WS + WS_K); const bf16_t* VT = (const bf16_t*)(A_WS + WS_VT); bf16_t* O = (bf16_t*)(A_WS + WS_XN);
    const size_t row0 = (size_t)b * SEQ + (size_t)c * 64;
    bf16x8 qf[2][4];
#pragma unroll
    for (int qb = 0; qb < 2; ++qb)
#pragma unroll
        for (int ks = 0; ks < 4; ++ks) qf[qb][ks] = *(const bf16x8*)(Q + (row0 + qb * 32 + r32) * DM + h * 64 + ks * 16 + hi * 8);
    f32x16 o[2][2];
#pragma unroll
    for (int i = 0; i < 2; ++i)
#pragma unroll
        for (int j = 0; j < 2; ++j) o[i][j] = f32x16{};
    float mrow[2] = {-1e30f, -1e30f}, lrow[2] = {0.f, 0.f};
    const LAS float* tab = (const LAS float*)(lds + AT_TAB) + h * 320;
    const float cfar = tab[256];
    const int sb0 = (c >= 8 ? c - 8 : 0) * 2, sb1 = c * 2 + 1;
    const bf16_t* kbase = Kb + ((size_t)b * 128 * 16 + h) * 4 * 512 + lane * 8;
    const bf16_t* vbase = VT + ((size_t)b * 128 * 16 + h) * 4 * 512 + lane * 8;
    bf16x8 kf[4], vf[2][2];
#pragma unroll
    for (int ks = 0; ks < 4; ++ks) kf[ks] = *(const bf16x8*)(kbase + (size_t)sb0 * 32768 + ks * 512);
#pragma unroll
    for (int db = 0; db < 2; ++db)
#pragma unroll
        for (int s = 0; s < 2; ++s) vf[db][s] = *(const bf16x8*)(vbase + (size_t)sb0 * 32768 + (db * 2 + s) * 512);
    for (int sb = sb0; sb <= sb1; ++sb) {
        const int sbn = sb < sb1 ? sb + 1 : sb;
        f32x16 S[2];
#pragma unroll
        for (int qb = 0; qb < 2; ++qb) { S[qb] = f32x16{};
#pragma unroll
            for (int ks = 0; ks < 4; ++ks) S[qb] = __builtin_amdgcn_mfma_f32_32x32x16_bf16(kf[ks], qf[qb][ks], S[qb], 0, 0, 0); }
        asm volatile("" ::: "memory");
#pragma unroll
        for (int ks = 0; ks < 4; ++ks) kf[ks] = *(const bf16x8*)(kbase + (size_t)sbn * 32768 + ks * 512);
        const int delta = c - (sb >> 1), rb = sb & 1;
        if (delta >= 3) {
#pragma unroll
            for (int qb = 0; qb < 2; ++qb)
#pragma unroll
                for (int r = 0; r < 16; ++r) S[qb][r] += cfar;
        } else {
#pragma unroll
            for (int qb = 0; qb < 2; ++qb) {
                const LAS float* tp = tab + (64 * delta + 32 * qb + r32 + 128 - 32 * rb - 8 * hi - 23);
#pragma unroll
                for (int r = 0; r < 16; ++r) S[qb][r] += tp[23 - (16 * (r >> 3) + (r & 7))];
            }
        }
        float rm[2];
#pragma unroll
        for (int qb = 0; qb < 2; ++qb) { float mx = S[qb][0];
#pragma unroll
            for (int r = 1; r < 16; ++r) mx = fmaxf(mx, S[qb][r]);
            rm[qb] = plswap_max(mx); }
        if (__any((rm[0] > mrow[0] + 8.0f) || (rm[1] > mrow[1] + 8.0f))) {
#pragma unroll
            for (int qb = 0; qb < 2; ++qb) { const float mn = fmaxf(mrow[qb], rm[qb]); const float al = fast_exp2(mrow[qb] - mn); lrow[qb] *= al; mrow[qb] = mn;
#pragma unroll
                for (int r = 0; r < 16; ++r) { o[0][qb][r] *= al; o[1][qb][r] *= al; } }
        }
        bf16x8 pf[2][2];
#pragma unroll
        for (int qb = 0; qb < 2; ++qb) { float sum = 0.f;
#pragma unroll
            for (int r = 0; r < 16; ++r) { S[qb][r] = fast_exp2(S[qb][r] - mrow[qb]); sum += S[qb][r]; }
            lrow[qb] += sum;
#pragma unroll
            for (int s = 0; s < 2; ++s) { u32x4 w; w.x = cvtpk(S[qb][8 * s], S[qb][8 * s + 1]); w.y = cvtpk(S[qb][8 * s + 2], S[qb][8 * s + 3]); w.z = cvtpk(S[qb][8 * s + 4], S[qb][8 * s + 5]); w.w = cvtpk(S[qb][8 * s + 6], S[qb][8 * s + 7]);
                pf[qb][s] = __builtin_bit_cast(bf16x8, w); } }
#pragma unroll
        for (int db = 0; db < 2; ++db)
#pragma unroll
            for (int qb = 0; qb < 2; ++qb)
#pragma unroll
                for (int s = 0; s < 2; ++s) o[db][qb] = __builtin_amdgcn_mfma_f32_32x32x16_bf16(vf[db][s], pf[qb][s], o[db][qb], 0, 0, 0);
        asm volatile("" ::: "memory");
#pragma unroll
        for (int db = 0; db < 2; ++db)
#pragma unroll
            for (int s = 0; s < 2; ++s) vf[db][s] = *(const bf16x8*)(vbase + (size_t)sbn * 32768 + (db * 2 + s) * 512);
    }
#pragma unroll
    for (int qb = 0; qb < 2; ++qb) { const float inv = fast_rcp(plswap_add(lrow[qb]));
        bf16_t* op = O + (row0 + qb * 32 + r32) * DM + h * 64 + 8 * hi;
#pragma unroll
        for (int db = 0; db < 2; ++db)
#pragma unroll
            for (int s = 0; s < 2; ++s) { u32x4 w;
                w.x = cvtpk(o[db][qb][8 * s] * inv, o[db][qb][8 * s + 1] * inv); w.y = cvtpk(o[db][qb][8 * s + 2] * inv, o[db][qb][8 * s + 3] * inv);
                w.z = cvtpk(o[db][qb][8 * s + 4] * inv, o[db][qb][8 * s + 5] * inv); w.w = cvtpk(o[db][qb][8 * s + 6] * inv, o[db][qb][8 * s + 7] * inv);
                *(u32x4*)(op + 32 * db + 16 * s) = w; } }
}

constexpr int AS_P = 45056;
__device__ __forceinline__ void attn_sample_task(LAS unsigned char* lds, int wave, int lane, int task) {
    const int bs = task >> 6, h = (task >> 2) & 15, qg = task & 3;
    const bf16_t* Q = (const bf16_t*)(A_WS + WS_Q); bf16_t* O = (bf16_t*)(A_WS + WS_XN);
    const float* ck = A_IN(2); const float* cv = A_IN(3); const float* kn = A_OUT + O_KS; const float* vn = A_OUT + O_VS;
    LAS float* pb = (LAS float*)(lds + AS_P + wave * 9472);
    LAS float* qs = pb + 4 * 528;
    const LAS float* tab = (const LAS float*)(lds + AT_TAB) + h * 320;
#pragma unroll
    for (int i = 0; i < 4; ++i) qs[i * 64 + lane] = bflo((unsigned)Q[((size_t)NTP + bs * 16 + qg * 4 + i) * DM + h * 64 + lane]);
    asm volatile("s_waitcnt lgkmcnt(0)" ::: "memory");
#pragma unroll 1
    for (int it = 0; it < 9; ++it) {
        const int key = it * 64 + lane; const bool valid = key < 528;
        const float* kp = !valid ? ck : (key < 512 ? ck + (((size_t)bs * 512 + key) * 16 + h) * 64 : kn + ((size_t)bs * 16 + (key - 512)) * DM + h * 64);
        float d[4] = {0.f, 0.f, 0.f, 0.f};
        f32x4 kv[16];
#pragma unroll
        for (int d4 = 0; d4 < 16; ++d4) kv[d4] = *(const f32x4*)(kp + 4 * d4);
#pragma unroll
        for (int d4 = 0; d4 < 16; ++d4) {
#pragma unroll
            for (int i = 0; i < 4; ++i) { const f32x4 qq = *(const LAS f32x4*)(qs + i * 64 + 4 * d4); d[i] += (kv[d4][0] * qq[0] + kv[d4][1] * qq[1]) + (kv[d4][2] * qq[2] + kv[d4][3] * qq[3]); } }
        int rel = 512 + qg * 4 - key;
        if (valid) {
#pragma unroll
            for (int i = 0; i < 4; ++i) { int r = rel + i; r = r > 128 ? 128 : r; pb[i * 528 + key] = d[i] + tab[r + 128]; } }
    }
    asm volatile("s_waitcnt lgkmcnt(0)" ::: "memory");
#pragma unroll 1
    for (int i = 0; i < 4; ++i) {
        float mx = -1e30f;
#pragma unroll 1
        for (int key = lane; key < 528; key += 64) mx = fmaxf(mx, pb[i * 528 + key]);
        mx = wave_max(mx);
        float sum = 0.f;
#pragma unroll 1
        for (int key = lane; key < 528; key += 64) { const float pv = fast_exp2(pb[i * 528 + key] - mx); pb[i * 528 + key] = pv; sum += pv; }
        sum = wave_sum(sum); const float inv = 1.0f / sum;
#pragma unroll 1
        for (int key = lane; key < 528; key += 64) pb[i * 528 + key] *= inv;
    }
    asm volatile("s_waitcnt lgkmcnt(0)" ::: "memory");
    float acc[4] = {0.f, 0.f, 0.f, 0.f};
#pragma unroll 1
    for (int k0 = 0; k0 < 528; k0 += 16) {
        float vv[16];
#pragma unroll
        for (int kk = 0; kk < 16; ++kk) { const int key = k0 + kk; vv[kk] = k0 < 512 ? cv[(((size_t)bs * 512 + key) * 16 + h) * 64 + lane] : vn[((size_t)bs * 16 + (key - 512)) * DM + h * 64 + lane]; }
#pragma unroll
        for (int kk = 0; kk < 16; ++kk) {
#pragma unroll
            for (int i = 0; i < 4; ++i) acc[i] += pb[i * 528 + k0 + kk] * vv[kk]; }
    }
#pragma unroll
    for (int i = 0; i < 4; ++i) O[((size_t)NTP + bs * 16 + qg * 4 + i) * DM + h * 64 + lane] = (bf16_t)(cvtpk(acc[i], 0.f) & 0xffffu);
    asm volatile("s_waitcnt lgkmcnt(0)" ::: "memory");
}

constexpr int P2_BAR = 20612, P2_SIMD = 20640;
__device__ __forceinline__ void p2_lbar(LAS unsigned char* lds, int lane, int nL, int& tgt) {
    tgt += nL;
    asm volatile("s_waitcnt lgkmcnt(0)" ::: "memory");
    if (lane == 0) (void)__hip_atomic_fetch_add((LAS int*)(lds + P2_BAR), 1, __ATOMIC_RELAXED, __HIP_MEMORY_SCOPE_WORKGROUP);
    while (*(volatile LAS int*)(lds + P2_BAR) < tgt) __builtin_amdgcn_s_sleep(1);
    asm volatile("" ::: "memory");
}
__device__ __forceinline__ void p2_phase(LAS unsigned char* lds, int G, int tid, int wave, int lane) {
    for (int i = tid; i < 16 * 320; i += 512) { const int h = i / 320, j = i % 320; ((LAS float*)(lds + AT_TAB))[i] = A_IN(8)[h * 257 + (j > 256 ? 256 : j)] * LOG2E; }
    {   const int simd = (int)__builtin_amdgcn_s_getreg((1 << 11) | (4 << 6) | 4);
        if (lane == 0) ((volatile LAS int*)(lds + P2_SIMD))[wave] = simd;
        if (tid == 0) { *(volatile LAS int*)(lds + P2_Q) = 0; *(volatile LAS int*)(lds + P2_BAR) = 0; } }
    if ((int)blockIdx.x < 256) lru_load_consts(lds, (int)blockIdx.x & 15, tid, 512);
    __syncthreads();
    int isL = 0, lw = 0, nL = 0;
    {   int sd[8];
#pragma unroll
        for (int w = 0; w < 8; ++w) sd[w] = ((const LAS int*)(lds + P2_SIMD))[w];
#pragma unroll
        for (int w = 0; w < 8; ++w) {
            int first = 1;
#pragma unroll
            for (int v = 0; v < w; ++v) first &= (sd[v] != sd[w]) ? 1 : 0;
            nL += first; lw += (w < wave) ? first : 0; isL = (w == wave) ? first : isL;
        }
        isL = __builtin_amdgcn_readfirstlane(isL); lw = __builtin_amdgcn_readfirstlane(lw); nL = __builtin_amdgcn_readfirstlane(nL); }
    if (isL) {
        int tgt = 0, gres = -1;
        for (int u = blockIdx.x; u < 256; u += G) {
            const int g = u & 15, b = u >> 4;
            if (gres >= 0) { p2_lbar(lds, lane, nL, tgt); lru_load_consts(lds, g, lw * 64 + lane, nL * 64); p2_lbar(lds, lane, nL, tgt); }
            gres = g;
            for (int tile = lw; tile < 128; tile += nL) lru_tile<false>(lds, lane, g, (size_t)b * SEQ, tile, b, 2 * nL);
        }
        for (int sidx = blockIdx.x; sidx < 128; sidx += G) {
            const int g = sidx & 15, bs = sidx >> 4;
            if (g != gres) { p2_lbar(lds, lane, nL, tgt); lru_load_consts(lds, g, lw * 64 + lane, nL * 64); p2_lbar(lds, lane, nL, tgt); gres = g; }
            if (lw == 0) lru_tile<true>(lds, lane, g, (size_t)NTP + bs * 16, 0, bs, 0);
        }
    }
    int nS = 0; for (int t = blockIdx.x; t < 512; t += G) ++nS;
    for (;;) {
        int j = 0;
        if (lane == 0) j = __hip_atomic_fetch_add((LAS int*)(lds + P2_Q), 1, __ATOMIC_RELAXED, __HIP_MEMORY_SCOPE_WORKGROUP);
        j = __builtin_amdgcn_readfirstlane(j);
        if (j < nS) { attn_sample_task(lds, wave, lane, blockIdx.x + G * j); continue; }
        j -= nS;
        const int gid = (int)blockIdx.x + G * (j >> 3);
        if (gid >= 2048) break;
        const int qq = gid >> 8, m = (gid >> 3) & 31, x = gid & 7;
        const int bh = x * 4 + (m >> 3) + 32 * qq, cg = ((m & 7) + qq) & 7;
        attn_unit(lds, lane, bh >> 4, cg * 8 + (j & 7), bh & 15);
    }
}

__device__ __forceinline__ void p4b_phase(int G, int wave, int lane) {
    const int gw = blockIdx.x * 8 + wave, NGW = G * 8;
    for (int n = gw; n < 2048; n += NGW) {
        const bf16_t* wr_ = (const bf16_t*)(A_WS + WS_WS) + (size_t)n * DM + lane * 16;
        const u32x4 a = *(const u32x4*)wr_, b = *(const u32x4*)(wr_ + 8);
        float f[16]; f[0] = bflo(a.x); f[1] = bfhi(a.x); f[2] = bflo(a.y); f[3] = bfhi(a.y); f[4] = bflo(a.z); f[5] = bfhi(a.z); f[6] = bflo(a.w); f[7] = bfhi(a.w);
        f[8] = bflo(b.x); f[9] = bfhi(b.x); f[10] = bflo(b.y); f[11] = bfhi(b.y); f[12] = bflo(b.z); f[13] = bfhi(b.z); f[14] = bflo(b.w); f[15] = bfhi(b.w);
        float mx = 0.f;
#pragma unroll
        for (int j = 0; j < 16; ++j) mx = fmaxf(mx, fabsf(f[j]));
        mx = wave_max(mx);
        const float step = fmaxf(mx, 1e-30f) * (1.0f / 127.0f), qi = 1.0f / step;
        u32x4 w;
#pragma unroll
        for (int q = 0; q < 4; ++q) w[q] = ((unsigned)(int)rintf(f[4 * q] * qi) & 0xffu) | (((unsigned)(int)rintf(f[4 * q + 1] * qi) & 0xffu) << 8) | (((unsigned)(int)rintf(f[4 * q + 2] * qi) & 0xffu) << 16) | (((unsigned)(int)rintf(f[4 * q + 3] * qi) & 0xffu) << 24);
        *(u32x4*)(A_WS + WS_WSQ + (size_t)n * DM + lane * 16) = w;
        if (lane == 0) ((float*)(A_WS + WS_SW))[n] = step;
    }
    const float* gm = A_IN(19); bf16_t* XT = (bf16_t*)(A_WS + WS_Q); unsigned char* XQ = A_WS + WS_XQ; float* SX = (float*)(A_WS + WS_SX);
    const bf16_t* DL = (const bf16_t*)(A_WS + WS_DELTA);
    f32x4 v[4], vn[4], ggr[4];
#pragma unroll
    for (int j = 0; j < 4; ++j) ggr[j] = *(const f32x4*)(gm + j * 256 + lane * 4);
    if (gw < NTOK) { row_ld(xrow_ptr(gw), v, lane); row_add_bf16(DL + (size_t)gw * DM, v, lane); }
    for (int m = gw; m < NTOK; m += NGW) {
        const int mn = m + NGW;
        if (mn < NTOK) { row_ld(xrow_ptr(mn), vn, lane); row_add_bf16(DL + (size_t)mn * DM, vn, lane); }
        bf16_t* orow = XT + (size_t)m * DM;
        const float ss = row_ss(v);
        float mx = 0.f;
#pragma unroll
        for (int j = 0; j < 4; ++j) { v[j] = v[j] * ggr[j];
            mx = fmaxf(mx, fmaxf(fmaxf(fabsf(v[j][0]), fabsf(v[j][1])), fmaxf(fabsf(v[j][2]), fabsf(v[j][3])))); }
        const float inv = __builtin_amdgcn_rsqf(wave_sum(ss) * (1.0f / DM) + EPS);
        mx = fmaxf(wave_max(mx), 1e-30f);
        if (m >= NTP) {
#pragma unroll
            for (int j = 0; j < 4; ++j) { const f32x4 t = v[j] * inv; u32x2 w; w.x = cvtpk(t[0], t[1]); w.y = cvtpk(t[2], t[3]); *(u32x2*)(orow + j * 256 + lane * 4) = w; } }
        const float step = mx * inv * (1.0f / 127.0f), qi = 127.0f * fast_rcp(mx);
#pragma unroll
        for (int j = 0; j < 4; ++j) {
            const unsigned b0 = (unsigned)(int)rintf(v[j][0] * qi) & 0xffu, b1 = (unsigned)(int)rintf(v[j][1] * qi) & 0xffu, b2 = (unsigned)(int)rintf(v[j][2] * qi) & 0xffu, b3 = (unsigned)(int)rintf(v[j][3] * qi) & 0xffu;
            *(unsigned*)(XQ + (size_t)m * DM + j * 256 + lane * 4) = b0 | (b1 << 8) | (b2 << 16) | (b3 << 24); }
        if (lane == 0) SX[m] = step;
#pragma unroll
        for (int j = 0; j < 4; ++j) v[j] = vn[j];
    }
}

__device__ __forceinline__ int f2key(float f) { const int b = __float_as_int(f); return b ^ ((b >> 31) & 0x7fffffff); }
__device__ __forceinline__ float key2f(int k) { return __int_as_float(k ^ ((k >> 31) & 0x7fffffff)); }
#define CE_DESC(x, y) do { const int hi_ = max(x, y); y = min(x, y); x = hi_; } while (0)
#define CE_ASC(x, y)  do { const int lo_ = min(x, y); y = max(x, y); x = lo_; } while (0)
__device__ __forceinline__ void bitonic_sort16_desc(int (&a)[16]) {
#pragma unroll
    for (int k = 2; k <= 16; k <<= 1)
#pragma unroll
        for (int j = k >> 1; j > 0; j >>= 1)
#pragma unroll
            for (int i = 0; i < 16; ++i) { const int l = i ^ j; if (l > i) { if ((i & k) == 0) CE_DESC(a[i], a[l]); else CE_ASC(a[i], a[l]); } }
}
__device__ __forceinline__ void bitonic_merge16_desc(int (&a)[16]) {
#pragma unroll
    for (int j = 8; j > 0; j >>= 1)
#pragma unroll
        for (int i = 0; i < 16; ++i) { const int l = i ^ j; if (l > i) CE_DESC(a[i], a[l]); }
}
__device__ __forceinline__ void top16_merge(int (&T)[16], const int (&S)[16]) {
#pragma unroll
    for (int i = 0; i < 16; ++i) T[i] = max(T[i], S[15 - i]);
    bitonic_merge16_desc(T);
}
#define INS16(L, x) do { int x_ = (x); _Pragma("unroll") for (int j_ = 0; j_ < 16; ++j_) { const int hi_ = max(L[j_], x_); x_ = min(L[j_], x_); L[j_] = hi_; } } while (0)

constexpr size_t WS_PART = WS_XN;
constexpr int CT_U = 64, CT_V = 64 + 8 * 64;
constexpr int P6_TOKB = 128, P6_NITEM = NTOK / P6_TOKB, P6_TPW = P6_TOKB / 8;
constexpr size_t WS_CQ = WS_XR, WS_CS = WS_XR + 16 * MiB;
constexpr int P6_IDX = 0;
constexpr int P6_E = 0, P6_C = 8192, P6_ITEM = 49152, P6_E8 = 0, P6_C8 = 32768;

__device__ __forceinline__ void p6a_phase(LAS unsigned char* lds, int G, int wave, int lane) {
    const int gw = blockIdx.x * 8 + wave, NGW = G * 8;
    const bf16_t* SC = (const bf16_t*)(A_WS + WS_XN);
    unsigned short* SELE = (unsigned short*)(A_WS + WS_SELE); float* SELG = (float*)(A_WS + WS_SELG);
    LAS int* idxb = (LAS int*)(lds + P6_IDX + wave * 4096);
    const int tl = lane >> 4, hh = (lane >> 1) & 7, half = lane & 1;
    for (int grp_ = gw; grp_ < NTOK / 4; grp_ += NGW) {
        const int grp = NTOK / 4 - 1 - grp_;
        const int tok = grp * 4 + tl;
        const bf16_t* sp = SC + (size_t)tok * 2048 + (lane & 15);
        int L[16];
#pragma unroll
        for (int j = 0; j < 16; ++j) L[j] = (int)0x80000000;
        {
            float sa[16], sb_[16];
#pragma unroll
            for (int e = 0; e < 16; ++e) sa[e] = bflo((unsigned)sp[16 * e]);
#pragma unroll
            for (int c0 = 0; c0 < 128; c0 += 32) {
#pragma unroll
                for (int e = 0; e < 16; ++e) sb_[e] = bflo((unsigned)sp[16 * (c0 + 16 + e)]);
                { int S[16];
#pragma unroll
                  for (int e = 0; e < 16; ++e) S[e] = (f2key(sa[e]) & ~127) | (c0 + e);
                  bitonic_sort16_desc(S);
                  if (c0 == 0) {
#pragma unroll
                      for (int e = 0; e < 16; ++e) L[e] = S[e]; } else top16_merge(L, S); }
                if (c0 + 32 < 128) {
#pragma unroll
                    for (int e = 0; e < 16; ++e) sa[e] = bflo((unsigned)sp[16 * (c0 + 32 + e)]); }
                { int S[16];
#pragma unroll
                  for (int e = 0; e < 16; ++e) S[e] = (f2key(sb_[e]) & ~127) | (c0 + 16 + e);
                  bitonic_sort16_desc(S);
                  top16_merge(L, S); }
            }
        }
#pragma unroll
        for (int j = 0; j < 16; ++j) idxb[lane * 16 + j] = L[j] & 127;
        float va[16], vb[16];
#pragma unroll
        for (int j = 0; j < 16; ++j) { const int own = L[j] & ~127, oth = __shfl_xor(own, 1); va[j] = key2f(half ? oth : own); vb[j] = key2f(half ? own : oth); }
        int C[16];
#pragma unroll
        for (int j = 0; j < 16; ++j) C[j] = (int)0x80000000;
        {   int S[16];
            S[0] = (f2key(va[0] + vb[0]) & ~255) | 0;
            S[1] = (f2key(va[0] + vb[1]) & ~255) | 1;
            S[2] = (f2key(va[0] + vb[2]) & ~255) | 2;
            S[3] = (f2key(va[0] + vb[3]) & ~255) | 3;
            S[4] = (f2key(va[0] + vb[4]) & ~255) | 4;
            S[5] = (f2key(va[0] + vb[5]) & ~255) | 5;
            S[6] = (f2key(va[0] + vb[6]) & ~255) | 6;
            S[7] = (f2key(va[0] + vb[7]) & ~255) | 7;
            S[8] = (f2key(va[0] + vb[8]) & ~255) | 8;
            S[9] = (f2key(va[0] + vb[9]) & ~255) | 9;
            S[10] = (f2key(va[0] + vb[10]) & ~255) | 10;
            S[11] = (f2key(va[0] + vb[11]) & ~255) | 11;
            S[12] = (f2key(va[0] + vb[12]) & ~255) | 12;
            S[13] = (f2key(va[0] + vb[13]) & ~255) | 13;
            S[14] = (f2key(va[0] + vb[14]) & ~255) | 14;
            S[15] = (f2key(va[0] + vb[15]) & ~255) | 15;
            bitonic_sort16_desc(S);
#pragma unroll
            for (int q = 0; q < 16; ++q) C[q] = S[q]; }
        {   int S[16];
            S[0] = (f2key(va[1] + vb[0]) & ~255) | 16;
            S[1] = (f2key(va[1] + vb[1]) & ~255) | 17;
            S[2] = (f2key(va[1] + vb[2]) & ~255) | 18;
            S[3] = (f2key(va[1] + vb[3]) & ~255) | 19;
            S[4] = (f2key(va[1] + vb[4]) & ~255) | 20;
            S[5] = (f2key(va[1] + vb[5]) & ~255) | 21;
            S[6] = (f2key(va[1] + vb[6]) & ~255) | 22;
            S[7] = (f2key(va[1] + vb[7]) & ~255) | 23;
            S[8] = (f2key(va[2] + vb[0]) & ~255) | 32;
            S[9] = (f2key(va[2] + vb[1]) & ~255) | 33;
            S[10] = (f2key(va[2] + vb[2]) & ~255) | 34;
            S[11] = (f2key(va[2] + vb[3]) & ~255) | 35;
            S[12] = (f2key(va[2] + vb[4]) & ~255) | 36;
            S[13] = (f2key(va[3] + vb[0]) & ~255) | 48;
            S[14] = (f2key(va[3] + vb[1]) & ~255) | 49;
            S[15] = (f2key(va[3] + vb[2]) & ~255) | 50;
            bitonic_sort16_desc(S);
            top16_merge(C, S); }
        {   int S[16];
            S[0] = (f2key(va[3] + vb[3]) & ~255) | 51;
            S[1] = (f2key(va[4] + vb[0]) & ~255) | 64;
            S[2] = (f2key(va[4] + vb[1]) & ~255) | 65;
            S[3] = (f2key(va[4] + vb[2]) & ~255) | 66;
            S[4] = (f2key(va[5] + vb[0]) & ~255) | 80;
            S[5] = (f2key(va[5] + vb[1]) & ~255) | 81;
            S[6] = (f2key(va[6] + vb[0]) & ~255) | 96;
            S[7] = (f2key(va[6] + vb[1]) & ~255) | 97;
            S[8] = (f2key(va[7] + vb[0]) & ~255) | 112;
            S[9] = (f2key(va[7] + vb[1]) & ~255) | 113;
            S[10] = (f2key(va[8] + vb[0]) & ~255) | 128;
            S[11] = (f2key(va[9] + vb[0]) & ~255) | 144;
            S[12] = (f2key(va[10] + vb[0]) & ~255) | 160;
            S[13] = (f2key(va[11] + vb[0]) & ~255) | 176;
            S[14] = (f2key(va[12] + vb[0]) & ~255) | 192;
            S[15] = (f2key(va[13] + vb[0]) & ~255) | 208;
            bitonic_sort16_desc(S);
            top16_merge(C, S); }
        {   int S[16];
            S[0] = (f2key(va[14] + vb[0]) & ~255) | 224;
            S[1] = (f2key(va[15] + vb[0]) & ~255) | 240;
            S[2] = (int)0x80000000;
            S[3] = (int)0x80000000;
            S[4] = (int)0x80000000;
            S[5] = (int)0x80000000;
            S[6] = (int)0x80000000;
            S[7] = (int)0x80000000;
            S[8] = (int)0x80000000;
            S[9] = (int)0x80000000;
            S[10] = (int)0x80000000;
            S[11] = (int)0x80000000;
            S[12] = (int)0x80000000;
            S[13] = (int)0x80000000;
            S[14] = (int)0x80000000;
            S[15] = (int)0x80000000;
            bitonic_sort16_desc(S);
            top16_merge(C, S); }
        const float mx = key2f(C[0] & ~255);
        float ev[16], sum = 0.f;
#pragma unroll
        for (int j = 0; j < 16; ++j) { ev[j] = __expf(key2f(C[j] & ~255) - mx); sum += ev[j]; }
        const float inv = 1.0f / sum;
        asm volatile("s_waitcnt lgkmcnt(0)" ::: "memory");
        int eo[8]; float go[8];
#pragma unroll
        for (int s = 0; s < 8; ++s) {
            int c_lo = C[s], c_hi = C[8 + s]; float e_lo = ev[s], e_hi = ev[8 + s];
            asm volatile("" : "+v"(c_lo), "+v"(c_hi), "+v"(e_lo), "+v"(e_hi));
            const int cc = half ? c_hi : c_lo; go[s] = (half ? e_hi : e_lo) * inv;
            const int ij = cc & 255, i1 = idxb[(lane & ~1) * 16 + (ij >> 4)], i2 = idxb[(lane | 1) * 16 + (ij & 15)];
            eo[s] = i1 * 128 + i2;
        }
        {
            const float* SU = (const float*)(A_WS + WS_SU); const float* SV = (const float*)(A_WS + WS_SV);
            float su[8];
#pragma unroll
            for (int s = 0; s < 8; ++s) { su[s] = SU[eo[s]]; go[s] *= SV[eo[s]]; }
            float* up = (float*)(A_WS + WS_SELU) + (size_t)tok * 128 + hh * 16 + half * 8;
            *(f32x4*)up = (f32x4){su[0], su[1], su[2], su[3]}; *(f32x4*)(up + 4) = (f32x4){su[4], su[5], su[6], su[7]};
        }
        unsigned short* ep = SELE + (size_t)tok * 128 + hh * 16 + half * 8; float* gp = SELG + (size_t)tok * 128 + hh * 16 + half * 8;
        *(u32x4*)ep = (u32x4){(unsigned)eo[0] | ((unsigned)eo[1] << 16), (unsigned)eo[2] | ((unsigned)eo[3] << 16), (unsigned)eo[4] | ((unsigned)eo[5] << 16), (unsigned)eo[6] | ((unsigned)eo[7] << 16)};
        *(f32x4*)gp = (f32x4){go[0], go[1], go[2], go[3]}; *(f32x4*)(gp + 4) = (f32x4){go[4], go[5], go[6], go[7]};
        asm volatile("s_waitcnt lgkmcnt(0)" ::: "memory");
    }
}

__device__ __forceinline__ float dot2bf(unsigned a, unsigned b, float c) { return __builtin_amdgcn_fdot2_f32_bf16(__builtin_bit_cast(bf16x2_t, a), __builtin_bit_cast(bf16x2_t, b), c, false); }
__device__ __forceinline__ unsigned xcc_id() { return (unsigned)__builtin_amdgcn_s_getreg((3 << 11) | 20) & 0xFu; }
__device__ __forceinline__ float dpp_sum16(float v) {
    v += __builtin_bit_cast(float, __builtin_amdgcn_update_dpp(0, __builtin_bit_cast(int, v), 0xB1, 0xF, 0xF, true));
    v += __builtin_bit_cast(float, __builtin_amdgcn_update_dpp(0, __builtin_bit_cast(int, v), 0x4E, 0xF, 0xF, true));
    v += __builtin_bit_cast(float, __builtin_amdgcn_update_dpp(0, __builtin_bit_cast(int, v), 0x141, 0xF, 0xF, true));
    v += __builtin_bit_cast(float, __builtin_amdgcn_update_dpp(0, __builtin_bit_cast(int, v), 0x140, 0xF, 0xF, true));
    return v;
}
__device__ __forceinline__ bool p6_claim(LAS unsigned char* lds, unsigned* cnt, int tid, int& ring, int home, int& slice, int& item, int& pend) {
    for (;;) {
        if (ring >= 8) return false;
        slice = (home + ring) & 7;
        __syncthreads();
        if (tid == 0) {
            const int tk = pend >= 0 ? pend : (int)__hip_atomic_fetch_add(cnt + 64 * slice, 1u, __ATOMIC_RELAXED, __HIP_MEMORY_SCOPE_AGENT);
            *(volatile LAS int*)(lds + P6_ITEM) = tk;
            pend = tk < P6_NITEM ? (int)__hip_atomic_fetch_add(cnt + 64 * slice, 1u, __ATOMIC_RELAXED, __HIP_MEMORY_SCOPE_AGENT) : -1;
        }
        __syncthreads();
        item = *(volatile LAS int*)(lds + P6_ITEM);
        if (item < P6_NITEM) return true;
        ++ring;
    }
}

struct P6W { int ring, has, pv; };
__device__ __forceinline__ bool p6w_claim(unsigned* cnt, int lane, int home, int n, P6W& st, int& slice, int& item) {
    for (;;) {
        if (st.ring >= 8) return false;
        slice = (home + st.ring) & 7;
        int tk;
        if (st.has) tk = __builtin_amdgcn_readfirstlane(st.pv);
        else { int t = 0; if (lane == 0) t = (int)__hip_atomic_fetch_add(cnt + 64 * slice, 1u, __ATOMIC_RELAXED, __HIP_MEMORY_SCOPE_AGENT); tk = __builtin_amdgcn_readfirstlane(t); }
        if (tk < n) {
            int t = 0; if (lane == 0) t = (int)__hip_atomic_fetch_add(cnt + 64 * slice, 1u, __ATOMIC_RELAXED, __HIP_MEMORY_SCOPE_AGENT);
            st.pv = t; st.has = 1; item = tk; return true;
        }
        st.has = 0; ++st.ring;
    }
}

__device__ __forceinline__ float ub0(unsigned w) { return (float)(w & 0xffu); }
__device__ __forceinline__ float ub1(unsigned w) { return (float)((w >> 8) & 0xffu); }
__device__ __forceinline__ float ub2(unsigned w) { return (float)((w >> 16) & 0xffu); }
__device__ __forceinline__ float ub3(unsigned w) { return (float)(w >> 24); }
__device__ __forceinline__ float dpp_sum8(float v) {
    v += __builtin_bit_cast(float, __builtin_amdgcn_update_dpp(0, __builtin_bit_cast(int, v), 0xB1, 0xF, 0xF, true));
    v += __builtin_bit_cast(float, __builtin_amdgcn_update_dpp(0, __builtin_bit_cast(int, v), 0x4E, 0xF, 0xF, true));
    v += __builtin_bit_cast(float, __builtin_amdgcn_update_dpp(0, __builtin_bit_cast(int, v), 0x141, 0xF, 0xF, true));
    return v;
}
__device__ __forceinline__ int dpp_isum8(int v) {
    v += __builtin_amdgcn_update_dpp(0, v, 0xB1, 0xF, 0xF, true);
    v += __builtin_amdgcn_update_dpp(0, v, 0x4E, 0xF, 0xF, true);
    v += __builtin_amdgcn_update_dpp(0, v, 0x141, 0xF, 0xF, true);
    return v;
}
__device__ __forceinline__ void p6b_item(LAS unsigned char* lds, int wave, int lane, int slice, int tok0) {
    const unsigned char* XQ = A_WS + WS_XQ; const unsigned char* UB = A_WS + WS_UB; const float* SX = (const float*)(A_WS + WS_SX);
    const unsigned short* SELE = (const unsigned short*)(A_WS + WS_SELE); bf16_t* PART = (bf16_t*)(A_WS + WS_PART);
    const int i8 = lane & 7, grp = lane >> 3;
    LAS int* eb = (LAS int*)(lds + P6_E8 + wave * 4096);
    {
        u32x4 le[2], xqn; float sxn;
        { const int tk = tok0 + grp;
#pragma unroll
          for (int q = 0; q < 2; ++q) le[q] = *(const u32x4*)(SELE + (size_t)tk * 128 + i8 * 16 + 8 * q);
          xqn = *(const u32x4*)(XQ + (size_t)tk * DM + slice * 128 + i8 * 16); sxn = SX[tk]; }
#pragma unroll 1
        for (int tb = 0; tb < P6_TPW; tb += 8) {
            const int tok = tok0 + tb + grp;
#pragma unroll
            for (int q = 0; q < 2; ++q) *(LAS u32x4*)(eb + grp * 64 + i8 * 8 + 4 * q) = le[q];
            const int x0 = (int)xqn.x, x1 = (int)xqn.y, x2 = (int)xqn.z, x3 = (int)xqn.w; const float sx = sxn;
            if (tb + 8 < P6_TPW) { const int tk = tok + 8;
#pragma unroll
                for (int q = 0; q < 2; ++q) le[q] = *(const u32x4*)(SELE + (size_t)tk * 128 + i8 * 16 + 8 * q);
                xqn = *(const u32x4*)(XQ + (size_t)tk * DM + slice * 128 + i8 * 16); sxn = SX[tk]; }
            const unsigned char* ub = UB + slice * 128 + i8 * 16;
            asm volatile("s_waitcnt lgkmcnt(0)" ::: "memory");
            int res[16];
#pragma unroll
            for (int j = 0; j < 16; ++j) res[j] = 0;
#pragma unroll
            for (int s16 = 0; s16 < 128; s16 += 16) {
                u32x4 uv[16]; u32x4 e4[2];
#pragma unroll
                for (int a4 = 0; a4 < 2; ++a4) e4[a4] = *(const LAS u32x4*)(eb + grp * 64 + (s16 >> 1) + 4 * a4);
#pragma unroll
                for (int a4 = 0; a4 < 2; ++a4)
#pragma unroll
                    for (int j = 0; j < 4; ++j) { const unsigned w = e4[a4][j];
                        uv[8 * a4 + 2 * j] = *(const u32x4*)(ub + (size_t)(w & 0xffffu) * DM); uv[8 * a4 + 2 * j + 1] = *(const u32x4*)(ub + (size_t)(w >> 16) * DM); }
#pragma unroll
                for (int q = 0; q < 16; ++q) {
                    const int a0 = (int)uv[q].x, a1 = (int)uv[q].y, a2 = (int)uv[q].z, a3 = (int)uv[q].w;
                    int d = __builtin_amdgcn_sdot4(a0, x0, 0, false); d = __builtin_amdgcn_sdot4(a1, x1, d, false); d = __builtin_amdgcn_sdot4(a2, x2, d, false); d = __builtin_amdgcn_sdot4(a3, x3, d, false);
                    d = dpp_isum8(d);
                    const int sidx = s16 + q;
                    res[sidx >> 3] = (i8 == (sidx & 7)) ? d : res[sidx >> 3];
                }
            }
            bf16_t* pp = PART + ((size_t)slice * NTOK + tok) * 128 + 16 * i8;
#pragma unroll
            for (int q = 0; q < 2; ++q) { u32x4 w;
                w.x = cvtpk((float)res[8 * q] * sx, (float)res[8 * q + 1] * sx); w.y = cvtpk((float)res[8 * q + 2] * sx, (float)res[8 * q + 3] * sx);
                w.z = cvtpk((float)res[8 * q + 4] * sx, (float)res[8 * q + 5] * sx); w.w = cvtpk((float)res[8 * q + 6] * sx, (float)res[8 * q + 7] * sx);
                *(u32x4*)(pp + 8 * q) = w; }
            asm volatile("s_waitcnt lgkmcnt(0)" ::: "memory");
        }
    }
}
__device__ __forceinline__ void p6b_phase(LAS unsigned char* lds, int tid, int wave, int lane) {
    unsigned* cnt = (unsigned*)(A_WS + WS_CTL) + CT_U;
    const int home = (int)(xcc_id() & 7u);
    P6W st{0, 0, 0}; int slice, item;
    while (p6w_claim(cnt, lane, home, NTOK / 16, st, slice, item)) p6b_item(lds, wave, lane, slice, item * 16);
}

__device__ __forceinline__ void p6m_phase(int G, int wave, int lane) {
    const int gw = blockIdx.x * 8 + wave, NGW = G * 8;
    const float* SELU = (const float*)(A_WS + WS_SELU); const float* SELG = (const float*)(A_WS + WS_SELG); const bf16_t* PART = (const bf16_t*)(A_WS + WS_PART);
    unsigned char* CQ = A_WS + WS_CQ; float* CS = (float*)(A_WS + WS_CS);
    const int k0 = 8 * ((2 * lane) & 15) + (lane >> 3), k1 = k0 + 8;
    for (int tok = gw; tok < NTOK; tok += NGW) {
        float a0 = 0.f, a1 = 0.f;
#pragma unroll
        for (int j = 0; j < 8; ++j) { const unsigned w = ((const unsigned*)(PART + ((size_t)j * NTOK + tok) * 128))[lane]; a0 += bflo(w); a1 += bfhi(w); }
        const float c0 = SELG[(size_t)tok * 128 + k0] * gelu_tanh(a0 * SELU[(size_t)tok * 128 + k0]), c1 = SELG[(size_t)tok * 128 + k1] * gelu_tanh(a1 * SELU[(size_t)tok * 128 + k1]);
        float mx = fmaxf(fabsf(c0), fabsf(c1));
        mx = wave_max(mx);
        const float cstep = fmaxf(mx, 1e-30f) * (1.0f / 127.0f), cinv = fast_rcp(cstep);
        CQ[(size_t)tok * 128 + k0] = (unsigned char)((int)rintf(c0 * cinv) & 0xff); CQ[(size_t)tok * 128 + k1] = (unsigned char)((int)rintf(c1 * cinv) & 0xff);
        if (lane == 0) CS[tok] = cstep;
    }
}

__device__ __forceinline__ void p6c_item(LAS unsigned char* lds, int wave, int lane, int slice, int tok0) {
    const unsigned char* VB = A_WS + WS_VB; const unsigned short* SELE = (const unsigned short*)(A_WS + WS_SELE);
    const unsigned char* CQ = A_WS + WS_CQ; const float* CS = (const float*)(A_WS + WS_CS);
    const int i8 = lane & 7, grp = lane >> 3;
    LAS int* eb = (LAS int*)(lds + P6_E8 + wave * 4096);
    LAS int* cbb = (LAS int*)(lds + P6_C8 + wave * 1024);
    {
        u32x4 le[2], lc; float cstep;
        { const int tk = tok0 + grp;
#pragma unroll
          for (int q = 0; q < 2; ++q) le[q] = *(const u32x4*)(SELE + (size_t)tk * 128 + i8 * 16 + 8 * q);
          lc = *(const u32x4*)(CQ + (size_t)tk * 128 + i8 * 16); cstep = CS[tk]; }
#pragma unroll 1
        for (int tb = 0; tb < P6_TPW; tb += 8) {
            const int tok = tok0 + tb + grp;
#pragma unroll
            for (int q = 0; q < 2; ++q) *(LAS u32x4*)(eb + grp * 64 + i8 * 8 + 4 * q) = le[q];
            *(LAS u32x4*)(cbb + grp * 32 + i8 * 4) = lc;
            const float cs = cstep;
            if (tb + 8 < P6_TPW) { const int tk = tok + 8;
#pragma unroll
                for (int q = 0; q < 2; ++q) le[q] = *(const u32x4*)(SELE + (size_t)tk * 128 + i8 * 16 + 8 * q);
                lc = *(const u32x4*)(CQ + (size_t)tk * 128 + i8 * 16); cstep = CS[tk]; }
            const unsigned char* vb = VB + slice * 128 + i8 * 16;
            asm volatile("s_waitcnt lgkmcnt(0)" ::: "memory");
            int acc[16];
#pragma unroll
            for (int r = 0; r < 16; ++r) acc[r] = 0;
#pragma unroll 1
            for (int s16 = 0; s16 < 128; s16 += 16) {
                u32x4 vv[16]; u32x4 e4[2];
#pragma unroll
                for (int a4 = 0; a4 < 2; ++a4) e4[a4] = *(const LAS u32x4*)(eb + grp * 64 + (s16 >> 1) + 4 * a4);
                const u32x4 cq4 = *(const LAS u32x4*)(cbb + grp * 32 + (s16 >> 2));
#pragma unroll
                for (int a4 = 0; a4 < 2; ++a4)
#pragma unroll
                    for (int j = 0; j < 4; ++j) { const unsigned w = e4[a4][j];
                        vv[8 * a4 + 2 * j] = *(const u32x4*)(vb + (size_t)(w & 0xffffu) * DM); vv[8 * a4 + 2 * j + 1] = *(const u32x4*)(vb + (size_t)(w >> 16) * DM); }
#pragma unroll
                for (int a4 = 0; a4 < 4; ++a4) {
                    const int cq = (int)cq4[a4];
#pragma unroll
                    for (int d = 0; d < 4; ++d) {
                        const unsigned ra = vv[4 * a4][d], rb = vv[4 * a4 + 1][d], rc = vv[4 * a4 + 2][d], rd = vv[4 * a4 + 3][d];
                        const unsigned lo = __builtin_amdgcn_perm(rb, ra, 0x05010400u), hi = __builtin_amdgcn_perm(rb, ra, 0x07030602u);
                        const unsigned lo2 = __builtin_amdgcn_perm(rd, rc, 0x05010400u), hi2 = __builtin_amdgcn_perm(rd, rc, 0x07030602u);
                        const unsigned t0 = __builtin_amdgcn_perm(lo2, lo, 0x05040100u), t1 = __builtin_amdgcn_perm(lo2, lo, 0x07060302u);
                        const unsigned t2 = __builtin_amdgcn_perm(hi2, hi, 0x05040100u), t3 = __builtin_amdgcn_perm(hi2, hi, 0x07060302u);
                        acc[4 * d + 0] = __builtin_amdgcn_sdot4((int)t0, cq, acc[4 * d + 0], false); acc[4 * d + 1] = __builtin_amdgcn_sdot4((int)t1, cq, acc[4 * d + 1], false);
                        acc[4 * d + 2] = __builtin_amdgcn_sdot4((int)t2, cq, acc[4 * d + 2], false); acc[4 * d + 3] = __builtin_amdgcn_sdot4((int)t3, cq, acc[4 * d + 3], false);
                    }
                }
            }
            bf16_t* pr = (bf16_t*)(A_WS + WS_PEER) + (size_t)tok * DM + slice * 128 + i8 * 16;
            u32x4 w0, w1;
            w0.x = cvtpk((float)acc[0] * cs, (float)acc[1] * cs); w0.y = cvtpk((float)acc[2] * cs, (float)acc[3] * cs); w0.z = cvtpk((float)acc[4] * cs, (float)acc[5] * cs); w0.w = cvtpk((float)acc[6] * cs, (float)acc[7] * cs);
            w1.x = cvtpk((float)acc[8] * cs, (float)acc[9] * cs); w1.y = cvtpk((float)acc[10] * cs, (float)acc[11] * cs); w1.z = cvtpk((float)acc[12] * cs, (float)acc[13] * cs); w1.w = cvtpk((float)acc[14] * cs, (float)acc[15] * cs);
            *(u32x4*)pr = w0; *(u32x4*)(pr + 8) = w1;
            asm volatile("s_waitcnt lgkmcnt(0)" ::: "memory");
        }
    }
}
__device__ __forceinline__ void p6c_phase(LAS unsigned char* lds, int tid, int wave, int lane) {
    unsigned* cnt = (unsigned*)(A_WS + WS_CTL) + CT_V;
    const int home = (int)(xcc_id() & 7u);
    P6W st{0, 0, 0}; int slice, item;
    while (p6w_claim(cnt, lane, home, NTOK / 16, st, slice, item)) p6c_item(lds, wave, lane, slice, item * 16);
}

__device__ __forceinline__ void p6d_phase(int G, int wave, int lane) {
    const int gw = blockIdx.x * 8 + wave, NGW = G * 8;
    const float* gf = A_IN(25);
    const bf16_t* DL = (const bf16_t*)(A_WS + WS_DELTA); const bf16_t* PR = (const bf16_t*)(A_WS + WS_PEER);
    f32x4 v[4], vn[4], ggr[4];
#pragma unroll
    for (int j = 0; j < 4; ++j) ggr[j] = *(const f32x4*)(gf + j * 256 + lane * 4);
    if (gw < NTOK) { row_ld(xrow_ptr(gw), v, lane); row_add_bf16(DL + (size_t)gw * DM, v, lane); row_add_bf16(PR + (size_t)gw * DM, v, lane); }
    for (int m = gw; m < NTOK; m += NGW) {
        const int mn = m + NGW;
        if (mn < NTOK) { row_ld(xrow_ptr(mn), vn, lane); row_add_bf16(DL + (size_t)mn * DM, vn, lane); row_add_bf16(PR + (size_t)mn * DM, vn, lane); }
        float* yr = yrow_ptr(m);
        const float inv = __builtin_amdgcn_rsqf(wave_sum(row_ss(v)) * (1.0f / DM) + EPS);
#pragma unroll
        for (int j = 0; j < 4; ++j) { *(f32x4*)(yr + j * 256 + lane * 4) = v[j] * inv * ggr[j]; }
#pragma unroll
        for (int j = 0; j < 4; ++j) v[j] = vn[j];
    }
}

#define XB_TMO      128
#define XB_XCNT(j)  (256  + 64 * (j))
#define XB_XSUB(j)  (1280 + 64 * (j))
#define XB_XGEN(j)  (2304 + 64 * (j))
#define XB_TOP      3328
#define XB_TOPGEN   3392
#define XB_SPIN_CAP (1u << 22)
constexpr int CW_BAR = 2048;
constexpr int LDS_MISC = 131072 + 64;
__device__ __forceinline__ unsigned xb_ld(unsigned* p)              { return __hip_atomic_load(p, __ATOMIC_RELAXED, __HIP_MEMORY_SCOPE_AGENT); }
__device__ __forceinline__ unsigned xb_add(unsigned* p, unsigned v) { return __hip_atomic_fetch_add(p, v, __ATOMIC_RELAXED, __HIP_MEMORY_SCOPE_AGENT); }
#define XB_SPIN(cond, bar) do { unsigned _sp = 0; while (cond) { __builtin_amdgcn_s_sleep(1); \
    if ((++_sp & 255u) == 0u) { if (xb_ld(&(bar)[XB_TMO])) break; if (_sp > XB_SPIN_CAP) { atomicAdd(&(bar)[XB_TMO], 1u); break; } } } } while (0)
struct XcdBarrier { unsigned* bar; unsigned x; volatile LAS unsigned* st; };
__device__ __forceinline__ XcdBarrier xcd_barrier_post(unsigned* bar, volatile LAS unsigned* st) {
    XcdBarrier b; b.bar = bar; b.x = (unsigned)__builtin_amdgcn_s_getreg((3 << 11) | 20) & 0xFu; b.st = st;
    if (threadIdx.x == 0) (void)xb_add(&bar[XB_XCNT(b.x)], 1u);
    return b;
}
__device__ __forceinline__ void xcd_barrier_complete(unsigned* bar, unsigned x, unsigned& nloc, unsigned& nx) {
    const unsigned G = gridDim.x * gridDim.y * gridDim.z;
    unsigned sum, cnt, mine, sp = 0u;
    for (;;) {
        sum = 0u; cnt = 0u; mine = 0u;
#pragma unroll
        for (unsigned j = 0; j < 16; ++j) { const unsigned c = xb_ld(&bar[XB_XCNT(j)]); sum += c; cnt += (c > 0u) ? 1u : 0u; mine = (j == x) ? c : mine; }
        if (sum == G) break;
        __builtin_amdgcn_s_sleep(1);
        if ((++sp & 255u) == 0u) { if (xb_ld(&bar[XB_TMO])) break; if (sp > XB_SPIN_CAP) { atomicAdd(&bar[XB_TMO], 1u); break; } }
    }
    nloc = mine > 0u ? mine : 1u; nx = cnt > 0u ? cnt : 1u;
}
__device__ __forceinline__ void xcd_barrier(const XcdBarrier& b) {
    asm volatile("s_waitcnt vmcnt(0)" ::: "memory");
    __syncthreads();
    if (threadIdx.x == 0) {
        unsigned* bar = b.bar;
        __builtin_amdgcn_s_waitcnt(0);
        unsigned nloc = b.st[0], nx = b.st[1];
        if (nloc == 0u) { xcd_barrier_complete(bar, b.x, nloc, nx); b.st[0] = nloc; b.st[1] = nx; }
        const unsigned old = xb_add(&bar[XB_XSUB(b.x)], 1u);
        const unsigned gen = old / nloc;
        if (old + 1u == (gen + 1u) * nloc) {
            __builtin_amdgcn_fence(__ATOMIC_RELEASE, "agent");
            asm volatile("s_waitcnt vmcnt(0)" ::: "memory");
            const unsigned og = xb_add(&bar[XB_TOP], 1u);
            const unsigned tg = og / nx;
            if (og + 1u == (tg + 1u) * nx) xb_add(&bar[XB_TOPGEN], 1u);
            else XB_SPIN(xb_ld(&bar[XB_TOPGEN]) == tg, bar);
            __builtin_amdgcn_fence(__ATOMIC_ACQUIRE, "agent");
            xb_add(&bar[XB_XGEN(b.x)], 1u);
            asm volatile("s_waitcnt vmcnt(0)" ::: "memory");
        } else {
            XB_SPIN(xb_ld(&bar[XB_XGEN(b.x)]) == gen, bar);
            __builtin_amdgcn_fence(__ATOMIC_ACQUIRE, "agent");
            asm volatile("s_waitcnt vmcnt(0)" ::: "memory");
        }
    }
    __syncthreads();
}

template <int NACC, class Epi>
__device__ __forceinline__ void small_gemm(LAS unsigned char* lds, const bf16_t* X0, const bf16_t* W0, const bf16_t* X1, const bf16_t* W1, int N, int G, int wave, int lane, const Epi& epi) {
    const int r32 = lane & 31, hi = lane >> 5;
    LAS float* part = (LAS float*)lds;
    for (int task = blockIdx.x; task < 4 * (N / 32); task += G) {
        const int rb = task & 3, cb = task >> 2;
#pragma unroll
        for (int a = 0; a < NACC; ++a) {
            const bf16_t* xp = (a ? X1 : X0) + (size_t)(rb * 32 + r32) * DM + hi * 8 + wave * 128;
            const bf16_t* wp = (a ? W1 : W0) + (size_t)(cb * 32 + r32) * DM + hi * 8 + wave * 128;
            bf16x8 xa[8], wa[8];
#pragma unroll
            for (int q = 0; q < 8; ++q) { xa[q] = *(const bf16x8*)(xp + q * 16); wa[q] = *(const bf16x8*)(wp + q * 16); }
            f32x16 acc = f32x16{};
#pragma unroll
            for (int q = 0; q < 8; ++q) acc = __builtin_amdgcn_mfma_f32_32x32x16_bf16(wa[q], xa[q], acc, 0, 0, 0);
#pragma unroll
            for (int r = 0; r < 16; ++r) part[((a * 8 + wave) * 16 + r) * 64 + lane] = acc[r];
        }
        __syncthreads();
        if (wave < 4) {
            const int g4 = wave, t = rb * 32 + r32, n0 = cb * 32 + 8 * g4 + 4 * hi;
            f32x4 v[NACC];
#pragma unroll
            for (int a = 0; a < NACC; ++a) { v[a] = (f32x4){0.f, 0.f, 0.f, 0.f};
#pragma unroll
                for (int w = 0; w < 8; ++w)
#pragma unroll
                    for (int i = 0; i < 4; ++i) v[a][i] += part[((a * 8 + w) * 16 + 4 * g4 + i) * 64 + lane]; }
            epi(t, n0, v[0], v[NACC - 1]);
        }
        __syncthreads();
    }
}
__device__ __forceinline__ u32x2 pack4(f32x4 v) { u32x2 w; w.x = cvtpk(v[0], v[1]); w.y = cvtpk(v[2], v[3]); return w; }
struct SEpiG1 {
    __device__ __forceinline__ void operator()(int t, int n0, f32x4 v, f32x4) const {
        unsigned char* ws = A_WS; float* out = A_OUT;
        const int ts = n0 >> 10, c = n0 & 1023; const size_t ro = (size_t)(NTP + t) * DM + c;
        if (ts == 0) *(u32x2*)((bf16_t*)(ws + WS_Q) + ro) = pack4(v);
        else if (ts == 1) *(f32x4*)(out + O_KS + (size_t)t * DM + c) = v;
        else if (ts == 2) *(f32x4*)(out + O_VS + (size_t)t * DM + c) = v;
        else if (ts == 3) { *(u32x2*)((bf16_t*)(ws + WS_XR) + ro) = pack4(v);
            if ((t & 15) >= 13) *(f32x4*)(out + O_CS + ((size_t)(t >> 4) * 3 + ((t & 15) - 13)) * DM + c) = v; }
        else if (ts == 4) *(u32x2*)((bf16_t*)(ws + WS_G) + ro) = pack4(v);
        else if (ts == 5) *(u32x2*)((bf16_t*)(ws + WS_SGA) + (size_t)t * DM + c) = pack4(v);
        else *(u32x2*)((bf16_t*)(ws + WS_SGR) + (size_t)t * DM + c) = pack4(v);
    }
};
struct SEpiP3 {
    __device__ __forceinline__ void operator()(int t, int n0, f32x4 va, f32x4 vr) const {
        unsigned char* ws = A_WS;
        const u32x2 ga = *(const u32x2*)((const bf16_t*)(ws + WS_SGA) + (size_t)t * DM + n0), gr = *(const u32x2*)((const bf16_t*)(ws + WS_SGR) + (size_t)t * DM + n0);
        f32x4 m;
        m[0] = sigmoidf_(bflo(ga.x)) * va[0] + sigmoidf_(bflo(gr.x)) * vr[0]; m[1] = sigmoidf_(bfhi(ga.x)) * va[1] + sigmoidf_(bfhi(gr.x)) * vr[1];
        m[2] = sigmoidf_(bflo(ga.y)) * va[2] + sigmoidf_(bflo(gr.y)) * vr[2]; m[3] = sigmoidf_(bfhi(ga.y)) * va[3] + sigmoidf_(bfhi(gr.y)) * vr[3];
        *(u32x2*)((bf16_t*)(ws + WS_XR) + (size_t)(NTP + t) * DM + n0) = pack4(m);
    }
};
struct SEpiBf16 {
    size_t wsoff; int ld;
    __device__ __forceinline__ void operator()(int t, int n0, f32x4 v, f32x4) const { *(u32x2*)((bf16_t*)(A_WS + wsoff) + (size_t)(NTP + t) * ld + n0) = pack4(v); }
};

__global__ void __launch_bounds__(512, 2) hybrid_fwd(Args a) {
    extern __shared__ __attribute__((aligned(16))) unsigned char lds_raw[];
    LAS unsigned char* lds = (LAS unsigned char*)lds_raw;
    const int tid = threadIdx.x, lane = tid & 63, wave = __builtin_amdgcn_readfirstlane(tid >> 6), G = gridDim.x;
    cg::grid_group grid = cg::this_grid();
    unsigned char* ws = A_WS;
    if (tid < 2) ((volatile LAS unsigned*)(lds + LDS_MISC))[tid] = 0u;
    __syncthreads();
    XcdBarrier xbar; xbar.bar = (unsigned*)(ws + WS_CTL) + CW_BAR; xbar.x = 0; xbar.st = nullptr;
#define IN(k) (KA->ph_lo <= (k) && (k) < KA->ph_hi)
    if (IN(0)) for (int i = (int)blockIdx.x * 512 + tid; i < 8192; i += G * 512) ((unsigned*)(ws + WS_CTL))[i] = 0u;
#define SEAM(k) do { if (KA->use_sync && IN(k) && IN((k) + 1)) xcd_barrier(xbar); } while (0)
    if (IN(0)) { p0a_prologue(lds, G, wave, lane); p0b_prologue(lds, G, wave, lane); if (KA->use_sync) grid.sync(); }
    if (KA->use_sync) xbar = xcd_barrier_post((unsigned*)(ws + WS_CTL) + CW_BAR, (volatile LAS unsigned*)(lds + LDS_MISC));
    if (IN(0)) { p0c_prologue(lds, G, wave, lane); }
    SEAM(0);
    if (IN(1)) {
        pg8::Gemm g{(const bf16_t*)(ws + WS_XN), (const bf16_t*)(ws + WS_WIN), (const bf16_t*)(ws + WS_WIN) + (size_t)2048 * DM, (const bf16_t*)(ws + WS_XN), DM};
        SchedG1 S; S.init(G, blockIdx.x); EpiG1 E;
        pg8::gemm_phase(lds, g, S, E);
        {
            const bf16_t* xnq = (const bf16_t*)((const unsigned char*)(A_OUT + O_YP) + (size_t)2 * NTP * DM);
            pg8::Gemm gq{xnq, (const bf16_t*)(ws + WS_WIQ), xnq, (const bf16_t*)(ws + WS_WIQ), DM / 2};
            SchedOne SQ; SQ.init(8, G, blockIdx.x); EpiQG EQ;
            pg8::gemm_phase<EpiQG, SchedOne, true>(lds, gq, SQ, EQ);
            pg8::Gemm gkv{xnq, (const bf16_t*)(ws + WS_WKV8), (const bf16_t*)(ws + WS_WKV8 + (size_t)1024 * DM), xnq, DM / 2};
            SchedKV8 SK; SK.init(G, blockIdx.x); EpiKV8 EK;
            pg8::gemm_phase<EpiKV8, SchedKV8, true>(lds, gkv, SK, EK);
        }
        { const bf16_t* xs = (const bf16_t*)(ws + WS_XN) + (size_t)NTP * DM; const bf16_t* w = (const bf16_t*)(ws + WS_WIN); SEpiG1 SE; small_gemm<1>(lds, xs, w, xs, w, INC, G, wave, lane, SE); }
    }
    SEAM(1);
    if (IN(2)) { p2_phase(lds, G, tid, wave, lane); }
    SEAM(2);
    if (IN(3)) {
        pg8::Gemm g{(const bf16_t*)(ws + WS_XN), (const bf16_t*)(ws + WS_WBA), (const bf16_t*)(ws + WS_G), (const bf16_t*)(ws + WS_WBL), DM};
        {
            const bf16_t* xnq = (const bf16_t*)((const unsigned char*)(A_OUT + O_YP) + (size_t)2 * NTP * DM);
            pg8::Gemm gg{xnq, (const bf16_t*)(ws + WS_WIQ + (size_t)2048 * DM), xnq, (const bf16_t*)(ws + WS_WIQ + (size_t)2048 * DM), DM / 2};
            SchedGate SG; SG.init(G, blockIdx.x); EpiGate EG;
            pg8::gemm_phase<EpiGate, SchedGate, true>(lds, gg, SG, EG);
        }
        SchedPair S; S.init(4, G, blockIdx.x); EpiP3 E;
        pg8::gemm_phase(lds, g, S, E);
        { SEpiP3 SE; small_gemm<2>(lds, (const bf16_t*)(ws + WS_XN) + (size_t)NTP * DM, (const bf16_t*)(ws + WS_WBA), (const bf16_t*)(ws + WS_G) + (size_t)NTP * DM, (const bf16_t*)(ws + WS_WBL), DM, G, wave, lane, SE); }
    }
    SEAM(3);
    if (IN(4)) {
        pg8::Gemm g{(const bf16_t*)(ws + WS_XR), (const bf16_t*)(ws + WS_WO), (const bf16_t*)(ws + WS_XR), (const bf16_t*)(ws + WS_WO), DM};
        SchedOne S; S.init(4, G, blockIdx.x); EpiP4 E;
        pg8::gemm_phase(lds, g, S, E);
        { const bf16_t* xs = (const bf16_t*)(ws + WS_XR) + (size_t)NTP * DM; const bf16_t* w = (const bf16_t*)(ws + WS_WO); SEpiBf16 SE{WS_DELTA, DM}; small_gemm<1>(lds, xs, w, xs, w, DM, G, wave, lane, SE); }
    }
    SEAM(4);
    if (IN(5)) { p4b_phase(G, wave, lane); }
    SEAM(5);
    if (IN(6)) {
        pg8::Gemm g{(const bf16_t*)(ws + WS_XQ), (const bf16_t*)(ws + WS_WSQ), (const bf16_t*)(ws + WS_XQ), (const bf16_t*)(ws + WS_WSQ), DM / 2};
        SchedOne S; S.init(8, G, blockIdx.x); EpiP5 E;
        pg8::gemm_phase<EpiP5, SchedOne, true>(lds, g, S, E);
        { const bf16_t* xs = (const bf16_t*)(ws + WS_Q) + (size_t)NTP * DM; const bf16_t* w = (const bf16_t*)(ws + WS_WS); SEpiBf16 SE{WS_XN, 2048}; small_gemm<1>(lds, xs, w, xs, w, 2048, G, wave, lane, SE); }
    }
    SEAM(6);
    if (IN(7)) { p6a_phase(lds, G, wave, lane); }
    SEAM(7);
    if (IN(8)) { p6b_phase(lds, tid, wave, lane); }
    SEAM(8);
    if (IN(9)) { p6m_phase(G, wave, lane); }
    SEAM(9);
    if (IN(10)) { p6c_phase(lds, tid, wave, lane); }
    SEAM(10);
    if (IN(11)) { p6d_phase(G, wave, lane); }
#undef IN
#undef SEAM
}

#ifndef N_LAUNCH_MODE
#define N_LAUNCH_MODE 1
#endif
constexpr int NPH = 12;
extern "C" void kernel_launch(void* const* d_in, const int* in_sizes, int n_in, void* d_out, int out_size, void* d_ws, size_t ws_size, hipStream_t stream) {
    static int grid = 0;
    if (grid == 0) {
        if (n_in != 26 || (size_t)out_size != O_END || ws_size < WS_END) { fprintf(stderr, "kernel_launch: unexpected sizes n_in %d out %d ws %zu (need %zu)\n", n_in, out_size, ws_size, (size_t)WS_END); grid = -1; return; }
        int dev = 0, cus = 0, per_cu = 0;
        (void)hipGetDevice(&dev); (void)hipDeviceGetAttribute(&cus, hipDeviceAttributeMultiprocessorCount, dev);
        (void)hipFuncSetAttribute((const void*)hybrid_fwd, hipFuncAttributeMaxDynamicSharedMemorySize, LDS_BYTES);
        (void)hipOccupancyMaxActiveBlocksPerMultiprocessor(&per_cu, (const void*)hybrid_fwd, 512, LDS_BYTES);
        if (per_cu < 1) { fprintf(stderr, "kernel_launch: occupancy query says %d blocks per CU\n", per_cu); per_cu = 1; }
        grid = cus;
        (void)hipGetLastError();
    }
    if (grid < 0) return;
    Args a{};
    for (int i = 0; i < 26; ++i) a.in[i] = (const float*)d_in[i];
    a.out = (float*)d_out; a.ws = (unsigned char*)d_ws;
    if (N_LAUNCH_MODE == 1) {
        a.ph_lo = 0; a.ph_hi = NPH; a.use_sync = 1;
        void* args[] = {&a};
        hipError_t e = hipLaunchCooperativeKernel((const void*)hybrid_fwd, dim3(grid), dim3(512), args, LDS_BYTES, stream);
        if (e != hipSuccess) fprintf(stderr, "cooperative launch failed: %s (grid %d)\n", hipGetErrorString(e), grid);
    } else {
        for (int p = 0; p < NPH; ++p) { a.ph_lo = p; a.ph_hi = p + 1; a.use_sync = 0; hipLaunchKernelGGL(hybrid_fwd, dim3(grid), dim3(512), LDS_BYTES, stream, a); }
    }
}
```

```cpp
#include <hip/hip_runtime.h>
#include <hip/hip_cooperative_groups.h>
#include <cstdint>
#include <cstdio>
namespace cg = cooperative_groups;

#define LAS __attribute__((address_space(3)))
typedef unsigned short bf16_t;
typedef short bf16x8 __attribute__((ext_vector_type(8)));
typedef float f32x4 __attribute__((ext_vector_type(4)));
typedef float f32x2 __attribute__((ext_vector_type(2)));
typedef float f32x16 __attribute__((ext_vector_type(16)));
typedef unsigned u32x4 __attribute__((ext_vector_type(4)));
typedef unsigned u32x2 __attribute__((ext_vector_type(2)));
typedef __bf16 bf16x2_t __attribute__((ext_vector_type(2)));
typedef int i32x4_t __attribute__((ext_vector_type(4)));

constexpr int DM = 1024, SEQ = 4096, NB = 16, NTP = NB * SEQ, NSB = 8, NST = 16, NTS = NSB * NST, NTOK = NTP + NTS;
constexpr int ROWS = 65792, NMT = 257;
constexpr int INC = 7168, NEXP = 16384;
constexpr float EPS = 1e-6f, LOG2E = 1.4426950408889634f;
constexpr float QSCALE = 0.125f * LOG2E;

constexpr size_t MiB = 1u << 20;
constexpr size_t BUF = (size_t)ROWS * DM * 2;
constexpr size_t WS_CTL = 0;
constexpr size_t WS_WIN = 1 * MiB;
constexpr size_t WS_WBA = 16 * MiB, WS_WBL = 18 * MiB, WS_WO = 20 * MiB, WS_WS = 22 * MiB;
constexpr size_t WS_LRUW = 26 * MiB;
constexpr size_t WS_SGA = 27 * MiB, WS_SGR = 27 * MiB + 512 * 1024;
constexpr size_t WS_SU = 26 * MiB + 512 * 1024, WS_SV = 26 * MiB + 640 * 1024;
constexpr size_t WS_SW = 26 * MiB + 256 * 1024;
constexpr size_t WS_SXN = 46 * MiB;
constexpr size_t WS_WIQ = 47 * MiB;
constexpr size_t WS_SWI = 52 * MiB;
constexpr size_t WS_WKV8 = 54 * MiB, WS_SKV = 58 * MiB;
constexpr size_t WS_WSQ = 44 * MiB;
constexpr size_t WS_SX = 26 * MiB + 704 * 1024;
constexpr size_t WS_UB = 28 * MiB, WS_VB = 60 * MiB;
constexpr size_t WS_Q = 92 * MiB;
constexpr size_t WS_XN = WS_Q + BUF;
constexpr size_t WS_K = WS_XN + BUF;
constexpr size_t WS_VT = WS_K + BUF;
constexpr size_t WS_XR = WS_VT + BUF;
constexpr size_t WS_G = WS_XR + BUF;
constexpr size_t WS_END = WS_G + BUF;
constexpr size_t WS_DELTA = WS_VT;
constexpr size_t WS_PEER = WS_Q;
constexpr size_t WS_SELU = WS_Q;
constexpr size_t WS_SELE = WS_G, WS_SELG = WS_G + (size_t)NTOK * 512, WS_XQ = WS_G + (size_t)NTOK * 1024;

constexpr size_t O_YP = 0, O_YS = O_YP + (size_t)NTP * DM, O_KP = O_YS + (size_t)NTS * DM, O_VP = O_KP + (size_t)NB * 512 * DM,
                 O_CP = O_VP + (size_t)NB * 512 * DM, O_LP = O_CP + (size_t)NB * 3 * DM, O_KS = O_LP + (size_t)NB * DM, O_VS = O_KS + (size_t)NTS * DM,
                 O_CS = O_VS + (size_t)NTS * DM, O_LS = O_CS + (size_t)NSB * 3 * DM, O_END = O_LS + (size_t)NSB * DM;

constexpr int LDS_BYTES = 135168;

__device__ __forceinline__ unsigned cvtpk(float lo, float hi) { f32x2 v = {lo, hi}; bf16x2_t b = __builtin_convertvector(v, bf16x2_t); return __builtin_bit_cast(unsigned, b); }
__device__ __forceinline__ float bflo(unsigned u) { return __uint_as_float(u << 16); }
__device__ __forceinline__ float bfhi(unsigned u) { return __uint_as_float(u & 0xffff0000u); }
__device__ __forceinline__ float fast_exp2(float x) { return __builtin_amdgcn_exp2f(x); }
__device__ __forceinline__ float fast_rcp(float x) { return __builtin_amdgcn_rcpf(x); }
__device__ __forceinline__ float sigmoidf_(float z) { return fast_rcp(1.0f + fast_exp2(-z * LOG2E)); }
__device__ __forceinline__ float gelu_tanh(float x) { const float u = x + 0.044715f * x * x * x; return x * fast_rcp(1.0f + fast_exp2(-1.5957691216f * LOG2E * u)); }
__device__ __forceinline__ float wave_sum(float v) {
    v += __builtin_bit_cast(float, __builtin_amdgcn_update_dpp(0, __builtin_bit_cast(int, v), 0xB1, 0xF, 0xF, true));
    v += __builtin_bit_cast(float, __builtin_amdgcn_update_dpp(0, __builtin_bit_cast(int, v), 0x4E, 0xF, 0xF, true));
    v += __builtin_bit_cast(float, __builtin_amdgcn_update_dpp(0, __builtin_bit_cast(int, v), 0x141, 0xF, 0xF, true));
    v += __builtin_bit_cast(float, __builtin_amdgcn_update_dpp(0, __builtin_bit_cast(int, v), 0x140, 0xF, 0xF, true));
    const int b = __builtin_bit_cast(int, v);
    return (__builtin_bit_cast(float, __builtin_amdgcn_readlane(b, 0)) + __builtin_bit_cast(float, __builtin_amdgcn_readlane(b, 16)))
         + (__builtin_bit_cast(float, __builtin_amdgcn_readlane(b, 32)) + __builtin_bit_cast(float, __builtin_amdgcn_readlane(b, 48)));
}
__device__ __forceinline__ float wave_max(float v) {
    v = fmaxf(v, __builtin_bit_cast(float, __builtin_amdgcn_update_dpp(0, __builtin_bit_cast(int, v), 0xB1, 0xF, 0xF, true)));
    v = fmaxf(v, __builtin_bit_cast(float, __builtin_amdgcn_update_dpp(0, __builtin_bit_cast(int, v), 0x4E, 0xF, 0xF, true)));
    v = fmaxf(v, __builtin_bit_cast(float, __builtin_amdgcn_update_dpp(0, __builtin_bit_cast(int, v), 0x141, 0xF, 0xF, true)));
    v = fmaxf(v, __builtin_bit_cast(float, __builtin_amdgcn_update_dpp(0, __builtin_bit_cast(int, v), 0x140, 0xF, 0xF, true)));
    const int b = __builtin_bit_cast(int, v);
    return fmaxf(fmaxf(__builtin_bit_cast(float, __builtin_amdgcn_readlane(b, 0)), __builtin_bit_cast(float, __builtin_amdgcn_readlane(b, 16))),
                 fmaxf(__builtin_bit_cast(float, __builtin_amdgcn_readlane(b, 32)), __builtin_bit_cast(float, __builtin_amdgcn_readlane(b, 48))));
}
__device__ __forceinline__ int swap23(int i) { return (i & ~12) | ((i & 4) << 1) | ((i & 8) >> 1); }
__device__ __forceinline__ float plswap_max(float m) { auto rr = __builtin_amdgcn_permlane32_swap(__float_as_uint(m), __float_as_uint(m), false, false); return fmaxf(__uint_as_float(rr[0]), __uint_as_float(rr[1])); }
__device__ __forceinline__ float plswap_add(float m) { auto rr = __builtin_amdgcn_permlane32_swap(__float_as_uint(m), __float_as_uint(m), false, false); return __uint_as_float(rr[0]) + __uint_as_float(rr[1]); }

namespace pg8 {
constexpr int BM = 256, BK = 64, HALF = 128, HTB = HALF * BK * 2, STAGE_BYTES = 8 * HTB, NXCD = 8, WGM = 8;
__host__ __device__ __forceinline__ int lds_byte(int r, int c) { const int st = (r >> 4) * 2 + (c >> 5), rr = r & 15, cc = c & 31, ob = rr * 64 + cc * 2; return st * 1024 + (ob ^ (((ob >> 9) & 1) << 5)); }
__host__ __device__ __forceinline__ void stage_rc(int b, int& R, int& C) { const int st = b / 1024, sb = b % 1024, swz = sb ^ (((sb >> 9) & 1) << 5); R = (st >> 1) * 16 + swz / 64; C = (st & 1) * 32 + (swz % 64) / 2; }
__host__ __device__ __forceinline__ int perm32(int rho) { const int n = rho >> 4, i = rho & 15; return 8 * (i >> 2) + 4 * n + (i & 3); }

struct Unit { int pm, pn, kind; };
struct Gemm { const bf16_t* A0; const bf16_t* B0; const bf16_t* A1; const bf16_t* B1; int K; };

struct TileMap {
    int nM, nN, nwg;
    __device__ __forceinline__ void init(int nM_, int nN_) { nM = nM_; nN = nN_; nwg = nM * nN; }
    __device__ __forceinline__ void map(int L, int& pm, int& pn) const {
        int wgid = L; { const int q = nwg / NXCD, r = nwg % NXCD, xcd = wgid % NXCD, off = wgid / NXCD; wgid = (xcd < r ? xcd * (q + 1) : r * (q + 1) + (xcd - r) * q) + off; }
        const int nig = WGM * nN, gid = wgid / nig, fm = gid * WGM, gsz = (nM - fm) < WGM ? (nM - fm) : WGM;
        pm = fm + ((wgid % nig) % gsz); pn = (wgid % nig) / gsz;
    }
};

template <class Epi, class Sched, bool I8 = false>
__device__ __forceinline__ void gemm_phase(LAS unsigned char* lds, const Gemm g, const Sched& S, const Epi& E) {
    const int tid = threadIdx.x, wid = __builtin_amdgcn_readfirstlane(tid >> 6), lane = tid & 63, wr = wid >> 2, wc = wid & 3, fr = lane & 15, fq = lane >> 4;
    const int K = g.K, nt = K / BK;
    unsigned voffA[2], voffB[2];
#pragma unroll
    for (int i = 0; i < 2; ++i) { int R, C; stage_rc(tid * 16 + i * 8192, R, C); const int Rb = (R & ~31) + perm32(R & 31);
        voffA[i] = (unsigned)(R * K + C) * 2u; voffB[i] = (unsigned)(Rb * K + C) * 2u; }
    const size_t kstep = (size_t)(BK * 2);
    const size_t hstep = (size_t)HALF * K * 2;
    const size_t tstep = 2 * hstep;
    const unsigned ldsw = (unsigned)wid * 1024u;
    const int aoff = lds_byte(wr * 64 + fr, fq * 8), boff = lds_byte(wc * 32 + fr, fq * 8);
#define PG8_SA(b, h) (((b) * 2 + (h)) * HTB)
#define PG8_SB(b, h) ((4 + (b) * 2 + (h)) * HTB)
#define PG8_STAGE(bufoff, gbase, voff) do { _Pragma("unroll") for (int _i = 0; _i < 2; ++_i) \
        __builtin_amdgcn_global_load_lds((const unsigned*)((const char*)(gbase) + (voff)[_i]), (LAS unsigned*)(lds + (bufoff) + ldsw + _i * 8192), 16, 0, 0); } while (0)
#define PG8_LDA(dst, b, h) do { _Pragma("unroll") for (int m = 0; m < 4; ++m) _Pragma("unroll") for (int k = 0; k < 2; ++k) dst[m][k] = *(const LAS bf16x8*)(lds + PG8_SA(b, h) + aoff + m * 2048 + k * 1024); } while (0)
#define PG8_LDB(dst, b, h) do { _Pragma("unroll") for (int n = 0; n < 2; ++n) _Pragma("unroll") for (int k = 0; k < 2; ++k) dst[n][k] = *(const LAS bf16x8*)(lds + PG8_SB(b, h) + boff + n * 2048 + k * 1024); } while (0)
#define PG8_MMA(ai, bj, At, Bt) do { __builtin_amdgcn_s_setprio(1); _Pragma("unroll") for (int m = 0; m < 4; ++m) _Pragma("unroll") for (int n = 0; n < 2; ++n) _Pragma("unroll") for (int k = 0; k < 2; ++k) { \
        if constexpr (I8) acc[ai][bj][m][n] = __builtin_bit_cast(acc_t, __builtin_amdgcn_mfma_i32_16x16x64_i8(__builtin_bit_cast(i32x4_t, Bt[n][k]), __builtin_bit_cast(i32x4_t, At[m][k]), __builtin_bit_cast(i32x4_t, acc[ai][bj][m][n]), 0, 0, 0)); \
        else acc[ai][bj][m][n] = __builtin_bit_cast(acc_t, __builtin_amdgcn_mfma_f32_16x16x32_bf16(Bt[n][k], At[m][k], __builtin_bit_cast(f32x4, acc[ai][bj][m][n]), 0, 0, 0)); } __builtin_amdgcn_s_setprio(0); } while (0)
#define PG8_WAIT_V(n) asm volatile("s_waitcnt vmcnt(" #n ")" ::: "memory")
#define PG8_WAIT_L(n) asm volatile("s_waitcnt lgkmcnt(" #n ")" ::: "memory")
#define PG8_BAR __builtin_amdgcn_s_barrier()
#define PG8_SCHED __builtin_amdgcn_sched_barrier(0)
    Unit cur, nxt; int ui = 0;
    if (!S.next(0, cur)) return;
    typedef typename Epi::acc_t acc_t;
    acc_t acc[2][2][4][2];
#pragma unroll
    for (int a = 0; a < 2; ++a)
#pragma unroll
        for (int b = 0; b < 2; ++b)
#pragma unroll
            for (int m = 0; m < 4; ++m)
#pragma unroll
                for (int n = 0; n < 2; ++n) acc[a][b][m][n] = acc_t{};
    bf16x8 At[4][2], B0[2][2], B1[2][2];
    const char* cA = (const char*)(cur.kind ? g.A1 : g.A0) + (size_t)cur.pm * tstep; const char* cB = (const char*)(cur.kind ? g.B1 : g.B0) + (size_t)cur.pn * tstep;
    PG8_STAGE(PG8_SB(0, 0), cB, voffB); PG8_STAGE(PG8_SB(0, 1), cB + hstep, voffB); PG8_STAGE(PG8_SA(0, 0), cA, voffA); PG8_STAGE(PG8_SA(0, 1), cA + hstep, voffA);
    if (wr == 1) PG8_BAR;
    PG8_WAIT_V(2); PG8_BAR;
    PG8_STAGE(PG8_SB(1, 0), cB + kstep, voffB); PG8_STAGE(PG8_SA(1, 0), cA + kstep, voffA); PG8_STAGE(PG8_SB(1, 1), cB + hstep + kstep, voffB);
    PG8_WAIT_V(6); PG8_BAR;
    for (;;) {
        const bool has_next = S.next(ui + 1, nxt);
        E.prefetch(cur, lds + STAGE_BYTES + 512 + wid * 256, tid);
        const char* nA = has_next ? (const char*)(nxt.kind ? g.A1 : g.A0) + (size_t)nxt.pm * tstep : cA; const char* nB = has_next ? (const char*)(nxt.kind ? g.B1 : g.B0) + (size_t)nxt.pn * tstep : cB;
        for (int t = 0; t < nt; t += 2) {
            const bool last = (t == nt - 2);
            const char* a1 = cA + (size_t)(t + 1) * kstep;
            const char* a2 = last ? nA : cA + (size_t)(t + 2) * kstep; const char* b2 = last ? nB : cB + (size_t)(t + 2) * kstep;
            const char* a3 = a2 + kstep; const char* b3 = b2 + kstep;
            PG8_LDB(B0, 0, 0); PG8_LDB(B1, 0, 1); PG8_SCHED; PG8_LDA(At, 0, 0); PG8_STAGE(PG8_SA(1, 1), a1 + hstep, voffA);
            PG8_WAIT_V(8); PG8_WAIT_L(0); PG8_BAR; PG8_MMA(0, 0, At, B0); PG8_MMA(0, 1, At, B1); PG8_BAR; PG8_SCHED;
            PG8_LDA(At, 0, 1); PG8_STAGE(PG8_SB(0, 0), b2, voffB); PG8_STAGE(PG8_SB(0, 1), b2 + hstep, voffB); PG8_STAGE(PG8_SA(0, 0), a2, voffA);
            PG8_WAIT_V(8); PG8_WAIT_L(0); PG8_BAR; PG8_MMA(1, 0, At, B0); PG8_MMA(1, 1, At, B1); PG8_BAR; PG8_SCHED;
            PG8_LDB(B0, 1, 0); PG8_LDB(B1, 1, 1); PG8_SCHED; PG8_LDA(At, 1, 0); PG8_STAGE(PG8_SA(0, 1), a2 + hstep, voffA);
            PG8_WAIT_V(8); PG8_WAIT_L(0); PG8_BAR; PG8_MMA(0, 0, At, B0); PG8_MMA(0, 1, At, B1); PG8_BAR; PG8_SCHED;
            PG8_LDA(At, 1, 1); PG8_STAGE(PG8_SB(1, 0), b3, voffB); PG8_STAGE(PG8_SB(1, 1), b3 + hstep, voffB); PG8_STAGE(PG8_SA(1, 0), a3, voffA);
            PG8_WAIT_V(8); PG8_WAIT_L(0); PG8_BAR; PG8_MMA(1, 0, At, B0); PG8_MMA(1, 1, At, B1); PG8_BAR; PG8_SCHED;
        }
        if (wr == 0) PG8_BAR;
        const bool keep = E(acc, cur, wr, wc, fr, fq);
        if (!has_next) break;
        if (!keep) {
#pragma unroll
        for (int a = 0; a < 2; ++a)
#pragma unroll
            for (int b = 0; b < 2; ++b)
#pragma unroll
                for (int m = 0; m < 4; ++m)
#pragma unroll
                    for (int n = 0; n < 2; ++n) acc[a][b][m][n] = acc_t{};
        }
        cur = nxt; cA = nA; cB = nB; ++ui;
        if (wr == 1) PG8_BAR;
    }
    PG8_WAIT_V(0);
    PG8_BAR;
#undef PG8_SA
#undef PG8_SB
#undef PG8_STAGE
#undef PG8_LDA
#undef PG8_LDB
#undef PG8_MMA
#undef PG8_WAIT_V
#undef PG8_WAIT_L
#undef PG8_BAR
#undef PG8_SCHED
}
}
using pg8::Unit;

struct Args {
    const float* in[26];
    float* out; unsigned char* ws;
    int ph_lo, ph_hi, use_sync, pad;
};

typedef const __attribute__((address_space(4))) Args* ArgsP;
#define KA ((ArgsP)__builtin_amdgcn_kernarg_segment_ptr())
#define A_IN(k) (KA->in[k])
#define A_OUT (KA->out)
#define A_WS (KA->ws)

struct SchedG1 {
    pg8::TileMap mk, mv; int G, c;
    __device__ __forceinline__ void init(int G_, int c_) { mk.init(32, 4); mv.init(4, 32); G = G_; c = c_; }
    __device__ __forceinline__ bool next(int i, Unit& u) const {
        int L = i * G + c, t;
        if (L < 256) { const int xr = L < 128; mk.map(xr ? L : L - 128, t, u.pn); u.pm = (t >> 1) * 16 + 14 + (t & 1); u.pn += xr ? 12 : 4; u.kind = 0; return true; }
        L -= 256; if (L < 128) { mv.map(L, u.pm, t); u.pn = (t >> 1) * 16 + 14 + (t & 1); u.kind = 1; return true; }
        return false;
    }
};
struct SchedKV8 {
    pg8::TileMap mk, mv; int G, c;
    __device__ __forceinline__ void init(int G_, int c_) { mk.init(224, 4); mv.init(4, 224); G = G_; c = G_ - 1 - c_; }
    __device__ __forceinline__ bool next(int i, Unit& u) const {
        int L = i * G + c, t;
        if (L < 1792) { const int xr = L >= 896; mk.map(xr ? L - 896 : L, t, u.pn); u.pm = (t / 14) * 16 + t % 14; u.pn += xr ? 8 : 0; u.kind = 0; return true; }
        L -= 1792; if (L < 896) { mv.map(L, u.pm, t); u.pn = (t / 14) * 16 + t % 14; u.kind = 1; return true; }
        return false;
    }
};
struct SchedPair {
    pg8::TileMap m0; int G, c;
    __device__ __forceinline__ void init(int nN, int G_, int c_) { m0.init(256, nN); G = G_; c = c_; }
    __device__ __forceinline__ bool next(int i, Unit& u) const { const int L = (i >> 1) * G + c; if (L >= m0.nwg) return false; m0.map(L, u.pm, u.pn); u.kind = i & 1; return true; }
};
struct SchedGate {
    pg8::TileMap m0; int G, c;
    __device__ __forceinline__ void init(int G_, int c_) { m0.init(256, 4); G = G_; c = c_; }
    __device__ __forceinline__ bool next(int i, Unit& u) const { const int L = (i >> 1) * G + c; if (L >= m0.nwg) return false; m0.map(L, u.pm, u.pn); u.pn += 4 * (i & 1); u.kind = 0; return true; }
};
struct SchedOne {
    pg8::TileMap m0; int G, c;
    __device__ __forceinline__ void init(int nN, int G_, int c_) { m0.init(256, nN); G = G_; c = c_; }
    __device__ __forceinline__ bool next(int i, Unit& u) const { const int L = i * G + c; if (L >= m0.nwg) return false; m0.map(L, u.pm, u.pn); u.kind = 0; return true; }
};

#define EPI_PREP int fr_ = fr, fq_ = fq; asm volatile("" : "+v"(fr_), "+v"(fq_)); const int rl_ = wr * 64 + fr_, cl_ = wc * 32 + 8 * fq_;
#define EPI_LOOP_BEGIN \
    _Pragma("unroll") for (int ai = 0; ai < 2; ++ai) _Pragma("unroll") for (int m = 0; m < 4; ++m) { const int rit = ai * 128 + m * 16 + rl_; \
    _Pragma("unroll") for (int bj = 0; bj < 2; ++bj) { const int cit = bj * 128 + cl_; const auto v0 = acc[ai][bj][m][0], v1 = acc[ai][bj][m][1];
#define EPI_LOOP_END } }

__device__ __forceinline__ size_t kfrag_off(int row, int col) {
    return ((((size_t)(row >> 5) * 16 + (col >> 6)) * 4 + ((col >> 4) & 3)) * 64 + ((col >> 3) & 1) * 32 + swap23(row & 31)) * 8;
}
__device__ __forceinline__ size_t vfrag_off(int vc, int tok) {
    return (((((size_t)(tok >> 5) * 16 + (vc >> 6)) * 2 + ((vc >> 5) & 1)) * 2 + ((tok >> 4) & 1)) * 64 + ((tok >> 3) & 1) * 32 + swap23(vc & 31)) * 8;
}
struct EpiG1 {
    typedef f32x4 acc_t;
    __device__ __forceinline__ void prefetch(const Unit&, LAS unsigned char*, int) const {}
    __device__ __forceinline__ bool operator()(f32x4 (&acc)[2][2][4][2], const Unit& u, int wr, int wc, int fr, int fq) const {
        EPI_PREP unsigned char* ws = A_WS; float* out = A_OUT;
        if (u.kind == 0) {
            const int t = u.pn >> 2, ct = (u.pn & 3) * 256;
            bf16_t* base;
            if (t == 0) base = (bf16_t*)(ws + WS_Q); else if (t == 1) base = (bf16_t*)(ws + WS_K); else if (t == 3) base = (bf16_t*)(ws + WS_XR); else if (t == 4) base = (bf16_t*)(ws + WS_G);
            else if (t == 5) base = (u.pm < 256) ? (bf16_t*)(out + O_YP) : (bf16_t*)(ws + WS_SGA) - (size_t)NTP * DM;
            else base = (u.pm < 256) ? (bf16_t*)(out + O_YP) + (size_t)NTP * DM : (bf16_t*)(ws + WS_SGR) - (size_t)NTP * DM;
            if (t == 1) {
                EPI_LOOP_BEGIN
                    u32x4 w; w.x = cvtpk(v0[0], v0[1]); w.y = cvtpk(v0[2], v0[3]); w.z = cvtpk(v1[0], v1[1]); w.w = cvtpk(v1[2], v1[3]);
                    *(u32x4*)(base + kfrag_off(u.pm * 256 + rit, ct + cit)) = w;
                EPI_LOOP_END
            } else if (t >= 5) {
                unsigned char* g8 = (unsigned char*)(out + O_YP) + (t == 6 ? (size_t)NTP * DM : 0) + (size_t)u.pm * 256 * DM + ct;
                EPI_LOOP_BEGIN
                    u32x2 w;
                    w.x = (unsigned)(int)rintf(sigmoidf_(v0[0]) * 255.0f) | ((unsigned)(int)rintf(sigmoidf_(v0[1]) * 255.0f) << 8) | ((unsigned)(int)rintf(sigmoidf_(v0[2]) * 255.0f) << 16) | ((unsigned)(int)rintf(sigmoidf_(v0[3]) * 255.0f) << 24);
                    w.y = (unsigned)(int)rintf(sigmoidf_(v1[0]) * 255.0f) | ((unsigned)(int)rintf(sigmoidf_(v1[1]) * 255.0f) << 8) | ((unsigned)(int)rintf(sigmoidf_(v1[2]) * 255.0f) << 16) | ((unsigned)(int)rintf(sigmoidf_(v1[3]) * 255.0f) << 24);
                    *(u32x2*)(g8 + (size_t)rit * DM + cit) = w;
                EPI_LOOP_END
            } else {
            base += (size_t)u.pm * 256 * DM + ct;
            EPI_LOOP_BEGIN
                u32x4 w; w.x = cvtpk(v0[0], v0[1]); w.y = cvtpk(v0[2], v0[3]); w.z = cvtpk(v1[0], v1[1]); w.w = cvtpk(v1[2], v1[3]);
                *(u32x4*)(base + (size_t)rit * DM + cit) = w;
            EPI_LOOP_END
            }
            if (t == 1 && u.pm < 256 && (u.pm & 15) >= 14) { float* p0 = out + O_KP + ((size_t)(u.pm >> 4) * 512 + ((u.pm & 15) - 14) * 256) * DM + ct;
                EPI_LOOP_BEGIN float* p = p0 + (size_t)rit * DM + cit; *(f32x4*)p = v0; *(f32x4*)(p + 4) = v1; EPI_LOOP_END }
            if (t == 1 && u.pm == 256) { float* p0 = out + O_KS + ct;
                EPI_LOOP_BEGIN if (rit < NTS) { float* p = p0 + (size_t)rit * DM + cit; *(f32x4*)p = v0; *(f32x4*)(p + 4) = v1; } EPI_LOOP_END }
            if (t == 3 && u.pm < 256 && (u.pm & 15) == 15) { float* p0 = out + O_CP + ((size_t)(u.pm >> 4) * 3) * DM + ct;
                EPI_LOOP_BEGIN if (rit >= 253) { float* p = p0 + (size_t)(rit - 253) * DM + cit; *(f32x4*)p = v0; *(f32x4*)(p + 4) = v1; } EPI_LOOP_END }
            if (t == 3 && u.pm == 256) { float* p0 = out + O_CS + ct;
                EPI_LOOP_BEGIN if (rit < NTS && (rit & 15) >= 13) { float* p = p0 + ((size_t)(rit >> 4) * 3 + ((rit & 15) - 13)) * DM + cit; *(f32x4*)p = v0; *(f32x4*)(p + 4) = v1; } EPI_LOOP_END }
        } else {
            bf16_t* VT = (bf16_t*)(ws + WS_VT);
            EPI_LOOP_BEGIN
                u32x4 w; w.x = cvtpk(v0[0], v0[1]); w.y = cvtpk(v0[2], v0[3]); w.z = cvtpk(v1[0], v1[1]); w.w = cvtpk(v1[2], v1[3]);
                *(u32x4*)(VT + vfrag_off(u.pm * 256 + rit, u.pn * 256 + cit)) = w;
            EPI_LOOP_END
            if (u.pn < 256 && (u.pn & 15) >= 14) { float* p0 = out + O_VP + ((size_t)(u.pn >> 4) * 512 + ((u.pn & 15) - 14) * 256) * DM + u.pm * 256;
                EPI_LOOP_BEGIN float* p = p0 + (size_t)cit * DM + rit;
                    p[0] = v0[0]; p[DM] = v0[1]; p[2 * DM] = v0[2]; p[3 * DM] = v0[3]; p[4 * DM] = v1[0]; p[5 * DM] = v1[1]; p[6 * DM] = v1[2]; p[7 * DM] = v1[3]; EPI_LOOP_END }
            if (u.pn == 256) { float* p0 = out + O_VS + u.pm * 256;
                EPI_LOOP_BEGIN if (cit < NTS) { float* p = p0 + (size_t)cit * DM + rit;
                    p[0] = v0[0]; p[DM] = v0[1]; p[2 * DM] = v0[2]; p[3 * DM] = v0[3]; p[4 * DM] = v1[0]; p[5 * DM] = v1[1]; p[6 * DM] = v1[2]; p[7 * DM] = v1[3]; } EPI_LOOP_END }
        }
        return false;
    }
};

struct EpiP3 {
    typedef f32x4 acc_t;
    __device__ __forceinline__ void prefetch(const Unit&, LAS unsigned char*, int) const {}
    __device__ __forceinline__ bool operator()(f32x4 (&acc)[2][2][4][2], const Unit& u, int wr, int wc, int fr, int fq) const {
        EPI_PREP unsigned char* ws = A_WS; float* out = A_OUT;
        const size_t off0 = (size_t)u.pm * 256 * DM + u.pn * 256;
        const unsigned char* ga = (const unsigned char*)(out + O_YP) + off0; const unsigned char* gr = ga + (size_t)NTP * DM; bf16_t* MG = (bf16_t*)(ws + WS_XR) + off0;
#pragma unroll
        for (int ai = 0; ai < 2; ++ai) {
            u32x2 wa[4][2], wr8[4][2];
#pragma unroll
            for (int m = 0; m < 4; ++m)
#pragma unroll
                for (int bj = 0; bj < 2; ++bj) { const size_t off = (size_t)(ai * 128 + m * 16 + rl_) * DM + bj * 128 + cl_;
                    wr8[m][bj] = *(const u32x2*)(gr + off); if (u.kind == 0) wa[m][bj] = *(const u32x2*)(ga + off); }
#pragma unroll
            for (int m = 0; m < 4; ++m)
#pragma unroll
                for (int bj = 0; bj < 2; ++bj) {
                    const unsigned r0 = wr8[m][bj].x, r1 = wr8[m][bj].y;
                    float sr[8]; sr[0] = (float)(r0 & 0xffu); sr[1] = (float)((r0 >> 8) & 0xffu); sr[2] = (float)((r0 >> 16) & 0xffu); sr[3] = (float)(r0 >> 24);
                    sr[4] = (float)(r1 & 0xffu); sr[5] = (float)((r1 >> 8) & 0xffu); sr[6] = (float)((r1 >> 16) & 0xffu); sr[7] = (float)(r1 >> 24);
                    if (u.kind == 0) {
                        const unsigned a0 = wa[m][bj].x, a1 = wa[m][bj].y;
                        float sa[8]; sa[0] = (float)(a0 & 0xffu); sa[1] = (float)((a0 >> 8) & 0xffu); sa[2] = (float)((a0 >> 16) & 0xffu); sa[3] = (float)(a0 >> 24);
                        sa[4] = (float)(a1 & 0xffu); sa[5] = (float)((a1 >> 8) & 0xffu); sa[6] = (float)((a1 >> 16) & 0xffu); sa[7] = (float)(a1 >> 24);
#pragma unroll
                        for (int i = 0; i < 4; ++i) { acc[ai][bj][m][0][i] *= sa[i] * fast_rcp(fmaxf(sr[i], 1.0f)); acc[ai][bj][m][1][i] *= sa[4 + i] * fast_rcp(fmaxf(sr[4 + i], 1.0f)); }
                    } else {
                        const float k255 = 1.0f / 255.0f; const size_t off = (size_t)(ai * 128 + m * 16 + rl_) * DM + bj * 128 + cl_;
                        const f32x4 v0 = acc[ai][bj][m][0] * k255, v1 = acc[ai][bj][m][1] * k255;
                        u32x4 w; w.x = cvtpk(v0[0] * fmaxf(sr[0], 1.0f), v0[1] * fmaxf(sr[1], 1.0f)); w.y = cvtpk(v0[2] * fmaxf(sr[2], 1.0f), v0[3] * fmaxf(sr[3], 1.0f));
                        w.z = cvtpk(v1[0] * fmaxf(sr[4], 1.0f), v1[1] * fmaxf(sr[5], 1.0f)); w.w = cvtpk(v1[2] * fmaxf(sr[6], 1.0f), v1[3] * fmaxf(sr[7], 1.0f));
                        *(u32x4*)(MG + off) = w; }
                }
        }
        return u.kind == 0;
    }
};

struct EpiQG {
    typedef i32x4_t acc_t;
    __device__ __forceinline__ void prefetch(const Unit&, LAS unsigned char*, int) const {}
    __device__ __forceinline__ bool operator()(i32x4_t (&acc)[2][2][4][2], const Unit& u, int wr, int wc, int fr, int fq) const {
        EPI_PREP bf16_t* base = (bf16_t*)(A_WS + ((u.pn >> 2) ? WS_G : WS_Q)) + (size_t)u.pm * 256 * DM + (u.pn & 3) * 256;
        const float* SXp = (const float*)(A_WS + WS_SXN) + u.pm * 256; const float* SWp = (const float*)(A_WS + WS_SWI) + u.pn * 256;
        float sxr[2][4]; f32x4 swc[2][2];
#pragma unroll
        for (int ai = 0; ai < 2; ++ai)
#pragma unroll
            for (int m = 0; m < 4; ++m) sxr[ai][m] = SXp[ai * 128 + m * 16 + rl_];
#pragma unroll
        for (int bj = 0; bj < 2; ++bj) { swc[bj][0] = *(const f32x4*)(SWp + bj * 128 + cl_); swc[bj][1] = *(const f32x4*)(SWp + bj * 128 + cl_ + 4); }
        EPI_LOOP_BEGIN
            const float sx = sxr[ai][m]; const f32x4 w0 = swc[bj][0] * sx, w1 = swc[bj][1] * sx;
            u32x4 w; w.x = cvtpk((float)v0[0] * w0[0], (float)v0[1] * w0[1]); w.y = cvtpk((float)v0[2] * w0[2], (float)v0[3] * w0[3]);
            w.z = cvtpk((float)v1[0] * w1[0], (float)v1[1] * w1[1]); w.w = cvtpk((float)v1[2] * w1[2], (float)v1[3] * w1[3]);
            *(u32x4*)(base + (size_t)rit * DM + cit) = w;
        EPI_LOOP_END
        return false;
    }
};
struct EpiKV8 {
    typedef i32x4_t acc_t;
    __device__ __forceinline__ void prefetch(const Unit&, LAS unsigned char*, int) const {}
    __device__ __forceinline__ bool operator()(i32x4_t (&acc)[2][2][4][2], const Unit& u, int wr, int wc, int fr, int fq) const {
        EPI_PREP unsigned char* ws = A_WS;
        const float* SXN = (const float*)(ws + WS_SXN); const float* SKV = (const float*)(ws + WS_SKV);
        const float* rs = u.kind == 0 ? SXN + u.pm * 256 : SKV + 1024 + u.pm * 256;
        const float* cs = u.kind == 0 ? SKV + u.pn * 256 : SXN + u.pn * 256;
        const bool isx = u.kind == 0 && u.pn >= 8;
        bf16_t* dst = (bf16_t*)(ws + (u.kind == 0 ? (isx ? WS_XR : WS_K) : WS_VT));
        float sxr[2][4]; f32x4 swc[2][2];
#pragma unroll
        for (int ai = 0; ai < 2; ++ai)
#pragma unroll
            for (int m = 0; m < 4; ++m) sxr[ai][m] = rs[ai * 128 + m * 16 + rl_];
#pragma unroll
        for (int bj = 0; bj < 2; ++bj) { swc[bj][0] = *(const f32x4*)(cs + bj * 128 + cl_); swc[bj][1] = *(const f32x4*)(cs + bj * 128 + cl_ + 4); }
        EPI_LOOP_BEGIN
            const float sx = sxr[ai][m]; const f32x4 w0 = swc[bj][0] * sx, w1 = swc[bj][1] * sx;
            u32x4 w; w.x = cvtpk((float)v0[0] * w0[0], (float)v0[1] * w0[1]); w.y = cvtpk((float)v0[2] * w0[2], (float)v0[3] * w0[3]);
            w.z = cvtpk((float)v1[0] * w1[0], (float)v1[1] * w1[1]); w.w = cvtpk((float)v1[2] * w1[2], (float)v1[3] * w1[3]);
            const size_t off = isx ? (size_t)(u.pm * 256 + rit) * DM + (u.pn - 8) * 256 + cit : (u.kind == 0 ? kfrag_off(u.pm * 256 + rit, u.pn * 256 + cit) : vfrag_off(u.pm * 256 + rit, u.pn * 256 + cit));
            *(u32x4*)(dst + off) = w;
        EPI_LOOP_END
        return false;
    }
};
struct EpiGate {
    typedef i32x4_t acc_t;
    __device__ __forceinline__ void prefetch(const Unit&, LAS unsigned char*, int) const {}
    __device__ __forceinline__ bool operator()(i32x4_t (&acc)[2][2][4][2], const Unit& u, int wr, int wc, int fr, int fq) const {
        EPI_PREP unsigned char* g8 = (unsigned char*)(A_OUT + O_YP) + ((u.pn >> 2) ? (size_t)NTP * DM : 0) + (size_t)u.pm * 256 * DM + (u.pn & 3) * 256;
        const float* SXp = (const float*)(A_WS + WS_SXN) + u.pm * 256; const float* SWp = (const float*)(A_WS + WS_SWI) + 2048 + u.pn * 256;
        float sxr[2][4]; f32x4 swc[2][2];
#pragma unroll
        for (int ai = 0; ai < 2; ++ai)
#pragma unroll
            for (int m = 0; m < 4; ++m) sxr[ai][m] = SXp[ai * 128 + m * 16 + rl_];
#pragma unroll
        for (int bj = 0; bj < 2; ++bj) { swc[bj][0] = *(const f32x4*)(SWp + bj * 128 + cl_); swc[bj][1] = *(const f32x4*)(SWp + bj * 128 + cl_ + 4); }
        EPI_LOOP_BEGIN
            const float sx = sxr[ai][m]; const f32x4 w0 = swc[bj][0] * sx, w1 = swc[bj][1] * sx;
            u32x2 w;
            w.x = (unsigned)(int)rintf(sigmoidf_((float)v0[0] * w0[0]) * 255.0f) | ((unsigned)(int)rintf(sigmoidf_((float)v0[1] * w0[1]) * 255.0f) << 8) | ((unsigned)(int)rintf(sigmoidf_((float)v0[2] * w0[2]) * 255.0f) << 16) | ((unsigned)(int)rintf(sigmoidf_((float)v0[3] * w0[3]) * 255.0f) << 24);
            w.y = (unsigned)(int)rintf(sigmoidf_((float)v1[0] * w1[0]) * 255.0f) | ((unsigned)(int)rintf(sigmoidf_((float)v1[1] * w1[1]) * 255.0f) << 8) | ((unsigned)(int)rintf(sigmoidf_((float)v1[2] * w1[2]) * 255.0f) << 16) | ((unsigned)(int)rintf(sigmoidf_((float)v1[3] * w1[3]) * 255.0f) << 24);
            *(u32x2*)(g8 + (size_t)rit * DM + cit) = w;
        EPI_LOOP_END
        return false;
    }
};
struct EpiP4 {
    typedef f32x4 acc_t;
    __device__ __forceinline__ void prefetch(const Unit&, LAS unsigned char*, int) const {}
    __device__ __forceinline__ bool operator()(f32x4 (&acc)[2][2][4][2], const Unit& u, int wr, int wc, int fr, int fq) const {
        EPI_PREP bf16_t* base = (bf16_t*)(A_WS + WS_DELTA) + (size_t)u.pm * 256 * DM + u.pn * 256;
        EPI_LOOP_BEGIN
            u32x4 w; w.x = cvtpk(v0[0], v0[1]); w.y = cvtpk(v0[2], v0[3]); w.z = cvtpk(v1[0], v1[1]); w.w = cvtpk(v1[2], v1[3]);
            *(u32x4*)(base + (size_t)rit * DM + cit) = w;
        EPI_LOOP_END
        return false;
    }
};

struct EpiP5 {
    typedef i32x4_t acc_t;
    __device__ __forceinline__ void prefetch(const Unit&, LAS unsigned char*, int) const {}
    __device__ __forceinline__ bool operator()(i32x4_t (&acc)[2][2][4][2], const Unit& u, int wr, int wc, int fr, int fq) const {
        EPI_PREP bf16_t* SC = (bf16_t*)(A_WS + WS_XN) + (size_t)u.pm * 256 * 2048 + u.pn * 256;
        const float* SXp = (const float*)(A_WS + WS_SX) + u.pm * 256; const float* SWp = (const float*)(A_WS + WS_SW) + u.pn * 256;
        float sxr[2][4]; f32x4 swc[2][2];
#pragma unroll
        for (int ai = 0; ai < 2; ++ai)
#pragma unroll
            for (int m = 0; m < 4; ++m) sxr[ai][m] = SXp[ai * 128 + m * 16 + rl_];
#pragma unroll
        for (int bj = 0; bj < 2; ++bj) { swc[bj][0] = *(const f32x4*)(SWp + bj * 128 + cl_); swc[bj][1] = *(const f32x4*)(SWp + bj * 128 + cl_ + 4); }
        EPI_LOOP_BEGIN
            const float sx = sxr[ai][m]; const f32x4 w0 = swc[bj][0] * sx, w1 = swc[bj][1] * sx;
            u32x4 w; w.x = cvtpk((float)v0[0] * w0[0], (float)v0[1] * w0[1]); w.y = cvtpk((float)v0[2] * w0[2], (float)v0[3] * w0[3]);
            w.z = cvtpk((float)v1[0] * w1[0], (float)v1[1] * w1[1]); w.w = cvtpk((float)v1[2] * w1[2], (float)v1[3] * w1[3]);
            *(u32x4*)(SC + (size_t)rit * 2048 + cit) = w;
        EPI_LOOP_END
        return false;
    }
};

__device__ __forceinline__ void row_ld(const float* p, f32x4 (&v)[4], int lane) {
#pragma unroll
    for (int j = 0; j < 4; ++j) v[j] = *(const f32x4*)(p + j * 256 + lane * 4);
}
__device__ __forceinline__ float row_ss(const f32x4 (&v)[4]) { float s = 0.f;
#pragma unroll
    for (int j = 0; j < 4; ++j) s += (v[j][0] * v[j][0] + v[j][1] * v[j][1]) + (v[j][2] * v[j][2] + v[j][3] * v[j][3]);
    return s; }
__device__ __forceinline__ void row_add_bf16(const bf16_t* p, f32x4 (&v)[4], int lane) {
#pragma unroll
    for (int j = 0; j < 4; ++j) { const u32x2 w = *(const u32x2*)(p + j * 256 + lane * 4); v[j][0] += bflo(w.x); v[j][1] += bfhi(w.x); v[j][2] += bflo(w.y); v[j][3] += bfhi(w.y); }
}
__device__ __forceinline__ const float* xrow_ptr(int m) { return (m < NTP) ? A_IN(0) + (size_t)m * DM : A_IN(1) + (size_t)(m - NTP) * DM; }
__device__ __forceinline__ float* yrow_ptr(int m) { return (m < NTP) ? A_OUT + O_YP + (size_t)m * DM : A_OUT + O_YS + (size_t)(m - NTP) * DM; }

__device__ __forceinline__ void p0_transpose_item(const float* W, int K, int N, bf16_t* WT, LAS float* scr, int item, int lane, int nscale = 0) {
    const int nblk = N / 32, kb = item / nblk, nb = item % nblk, k0 = 64 * kb, n0 = 32 * nb;
#pragma unroll 8
    for (int i = 0; i < 32; ++i) { const int kk = 2 * i + (lane >> 5); scr[kk * 33 + (lane & 31)] = W[(size_t)(k0 + kk) * N + n0 + (lane & 31)] * (n0 < nscale ? QSCALE : 1.0f); }
    asm volatile("s_waitcnt lgkmcnt(0)" ::: "memory");
    const int c = lane & 7;
#pragma unroll
    for (int j = 0; j < 4; ++j) { const int n = (lane >> 3) + 8 * j; const LAS float* s = scr + (8 * c) * 33 + n;
        u32x4 o; o.x = cvtpk(s[0 * 33], s[1 * 33]); o.y = cvtpk(s[2 * 33], s[3 * 33]); o.z = cvtpk(s[4 * 33], s[5 * 33]); o.w = cvtpk(s[6 * 33], s[7 * 33]);
        *(u32x4*)(WT + (size_t)(n0 + n) * K + k0 + 8 * c) = o; }
    asm volatile("s_waitcnt lgkmcnt(0)" ::: "memory");
}

__device__ __forceinline__ void p0a_prologue(LAS unsigned char* lds, int G, int wave, int lane) {
    unsigned char* ws = A_WS;
    const int gw = blockIdx.x * 8 + wave, NGW = G * 8;
    LAS float* scr = (LAS float*)(lds + wave * 16384);
    constexpr int I_IN = 16 * (INC / 32), I_SQ = 16 * 32, NTR = I_IN + 3 * I_SQ;
    for (int it = gw; it < NTR; it += NGW) {
        int r = it;
        if (r < I_IN) { p0_transpose_item(A_IN(7), DM, INC, (bf16_t*)(ws + WS_WIN), scr, r, lane, 1024); continue; } r -= I_IN;
        if (r < I_SQ) { p0_transpose_item(A_IN(16), DM, DM, (bf16_t*)(ws + WS_WBA), scr, r, lane); continue; } r -= I_SQ;
        if (r < I_SQ) { p0_transpose_item(A_IN(17), DM, DM, (bf16_t*)(ws + WS_WBL), scr, r, lane); continue; } r -= I_SQ;
        p0_transpose_item(A_IN(18), DM, DM, (bf16_t*)(ws + WS_WO), scr, r, lane);
    }
    {
        const float* wq = A_IN(20); bf16_t* wst = (bf16_t*)(ws + WS_WS);
        const int r32 = lane & 31, hi = lane >> 5;
        for (int it = gw; it < 2048; it += NGW) {
            const int hj = it >> 7, kt = (it >> 5) & 3, ct = it & 31, h = hj >> 1, j = hj & 1;
            const float* ap = (j ? A_IN(22) : A_IN(21)) + ((size_t)(h * 128 + kt * 32 + r32)) * 128 + 64 * hi;
            const float* bp = wq + (size_t)(ct * 32 + r32) * 2048 + hj * 128 + 64 * hi;
            f32x16 acc = {};
#pragma unroll
            for (int s4 = 0; s4 < 16; ++s4) { const f32x4 av = *(const f32x4*)(ap + 4 * s4), bv = *(const f32x4*)(bp + 4 * s4);
                acc = __builtin_amdgcn_mfma_f32_32x32x2f32(av[0], bv[0], acc, 0, 0, 0); acc = __builtin_amdgcn_mfma_f32_32x32x2f32(av[1], bv[1], acc, 0, 0, 0);
                acc = __builtin_amdgcn_mfma_f32_32x32x2f32(av[2], bv[2], acc, 0, 0, 0); acc = __builtin_amdgcn_mfma_f32_32x32x2f32(av[3], bv[3], acc, 0, 0, 0); }
#pragma unroll
            for (int r = 0; r < 16; ++r) { const int key = kt * 32 + (r & 3) + 8 * (r >> 2) + 4 * hi;
                wst[(size_t)(key * 16 + hj) * DM + ct * 32 + r32] = (bf16_t)(cvtpk(acc[r], 0.f) & 0xffffu); }
        }
    }
    {
        bf16_t* fw = (bf16_t*)(ws + WS_LRUW);
        for (int f = gw; f < 256; f += NGW) {
            const int ks = f & 3, T = (f >> 2) & 1, gate = (f >> 3) & 1, g = f >> 4, i = lane & 31, hi = lane >> 5;
            const int outc = 32 * T + swap23(i);
            const float* W = (gate ? A_IN(13) : A_IN(11)) + (size_t)g * 4096;
            float x[8];
#pragma unroll
            for (int j = 0; j < 8; ++j) x[j] = W[(16 * ks + 8 * hi + j) * 64 + outc];
            u32x4 w; w.x = cvtpk(x[0], x[1]); w.y = cvtpk(x[2], x[3]); w.z = cvtpk(x[4], x[5]); w.w = cvtpk(x[6], x[7]);
            *(u32x4*)(fw + (size_t)f * 512 + lane * 8) = w;
        }
    }
}

__device__ __forceinline__ void p0b_prologue(LAS unsigned char* lds, int G, int wave, int lane) {
    unsigned char* ws = A_WS;
    const int gw = blockIdx.x * 8 + wave, NGW = G * 8;
    LAS float* scr = (LAS float*)(lds + wave * 16384);
    {
        f32x4 p[4], pn[4];
        if (gw < 2 * NEXP) {
#pragma unroll
            for (int q = 0; q < 4; ++q) p[q] = *(const f32x4*)(((gw >= NEXP) ? A_IN(24) + (size_t)(gw - NEXP) * DM : A_IN(23) + (size_t)gw * DM) + lane * 16 + 4 * q); }
        for (int it = gw; it < 2 * NEXP; it += NGW) {
            const int tb = it >= NEXP, e = it - tb * NEXP, itn = it + NGW;
            if (itn < 2 * NEXP) {
#pragma unroll
                for (int q = 0; q < 4; ++q) pn[q] = *(const f32x4*)(((itn >= NEXP) ? A_IN(24) + (size_t)(itn - NEXP) * DM : A_IN(23) + (size_t)itn * DM) + lane * 16 + 4 * q); }
            unsigned char* dst = ws + (tb ? WS_VB : WS_UB) + (size_t)e * DM + lane * 16;
            float mx = 0.f;
#pragma unroll
            for (int q = 0; q < 4; ++q) mx = fmaxf(mx, fmaxf(fmaxf(fabsf(p[q][0]), fabsf(p[q][1])), fmaxf(fabsf(p[q][2]), fabsf(p[q][3]))));
            mx = wave_max(mx);
            const float step = fmaxf(mx, 1e-30f) * (1.0f / 127.0f), inv = 1.0f / step;
            u32x4 w;
#pragma unroll
            for (int q = 0; q < 4; ++q) {
                const unsigned b0 = (unsigned)(int)rintf(p[q][0] * inv) & 0xffu, b1 = (unsigned)(int)rintf(p[q][1] * inv) & 0xffu, b2 = (unsigned)(int)rintf(p[q][2] * inv) & 0xffu, b3 = (unsigned)(int)rintf(p[q][3] * inv) & 0xffu;
                w[q] = b0 | (b1 << 8) | (b2 << 16) | (b3 << 24); }
            *(u32x4*)dst = w;
            if (lane == 0) ((float*)(ws + (tb ? WS_SV : WS_SU)))[e] = step;
#pragma unroll
            for (int q = 0; q < 4; ++q) p[q] = pn[q];
        }
    }
    {
        const float* gm = A_IN(6); bf16_t* XN = (bf16_t*)(ws + WS_XN);
        for (int m = NTOK + gw; m < ROWS; m += NGW) {
#pragma unroll
            for (int j = 0; j < 2; ++j) *(u32x4*)(XN + (size_t)m * DM + j * 512 + lane * 8) = (u32x4){0u, 0u, 0u, 0u}; }
        f32x4 v[4], vn[4], ggr[4];
#pragma unroll
        for (int j = 0; j < 4; ++j) ggr[j] = *(const f32x4*)(gm + j * 256 + lane * 4);
        if (gw < NTOK) row_ld(xrow_ptr(gw), v, lane);
        for (int m = gw; m < NTOK; m += NGW) {
            const int mn = m + NGW;
            if (mn < NTOK) row_ld(xrow_ptr(mn), vn, lane);
            bf16_t* orow = XN + (size_t)m * DM;
            const bool needbf = m >= NTP || (m & (SEQ - 1)) >= SEQ - 512;
            const float ss = row_ss(v);
            float mx = 0.f;
#pragma unroll
            for (int j = 0; j < 4; ++j) { v[j] = v[j] * ggr[j];
                mx = fmaxf(mx, fmaxf(fmaxf(fabsf(v[j][0]), fabsf(v[j][1])), fmaxf(fabsf(v[j][2]), fabsf(v[j][3])))); }
            const float inv = __builtin_amdgcn_rsqf(wave_sum(ss) * (1.0f / DM) + EPS);
            mx = fmaxf(wave_max(mx), 1e-30f);
            if (needbf) {
#pragma unroll
                for (int j = 0; j < 4; ++j) { const f32x4 t = v[j] * inv; u32x2 w; w.x = cvtpk(t[0], t[1]); w.y = cvtpk(t[2], t[3]); *(u32x2*)(orow + j * 256 + lane * 4) = w; } }
            if (m < NTP) {
                const float step = mx * inv * (1.0f / 127.0f), qi = 127.0f * fast_rcp(mx);
                unsigned char* xq = (unsigned char*)(A_OUT + O_YP) + (size_t)2 * NTP * DM + (size_t)m * DM;
#pragma unroll
                for (int j = 0; j < 4; ++j) {
                    const unsigned b0 = (unsigned)(int)rintf(v[j][0] * qi) & 0xffu, b1 = (unsigned)(int)rintf(v[j][1] * qi) & 0xffu, b2 = (unsigned)(int)rintf(v[j][2] * qi) & 0xffu, b3 = (unsigned)(int)rintf(v[j][3] * qi) & 0xffu;
                    *(unsigned*)(xq + j * 256 + lane * 4) = b0 | (b1 << 8) | (b2 << 16) | (b3 << 24); }
                if (lane == 0) ((float*)(ws + WS_SXN))[m] = step;
            }
#pragma unroll
            for (int j = 0; j < 4; ++j) v[j] = vn[j];
        }
    }
}

__device__ __forceinline__ void p0c_prologue(LAS unsigned char* lds, int G, int wave, int lane) {
    unsigned char* ws = A_WS;
    const int gw = blockIdx.x * 8 + wave, NGW = G * 8;
    LAS float* scr = (LAS float*)(lds + wave * 16384);
    for (int n = gw; n < 7168; n += NGW) {
        const int srow = n < 1024 ? n : (n < 2048 ? 4096 + (n - 1024) : (n < 4096 ? 5120 + (n - 2048) : n - 3072));
        const bf16_t* wr_ = (const bf16_t*)(ws + WS_WIN) + (size_t)srow * DM + lane * 16;
        const u32x4 a = *(const u32x4*)wr_, b = *(const u32x4*)(wr_ + 8);
        float f[16]; f[0] = bflo(a.x); f[1] = bfhi(a.x); f[2] = bflo(a.y); f[3] = bfhi(a.y); f[4] = bflo(a.z); f[5] = bfhi(a.z); f[6] = bflo(a.w); f[7] = bfhi(a.w);
        f[8] = bflo(b.x); f[9] = bfhi(b.x); f[10] = bflo(b.y); f[11] = bfhi(b.y); f[12] = bflo(b.z); f[13] = bfhi(b.z); f[14] = bflo(b.w); f[15] = bfhi(b.w);
        float mx = 0.f;
#pragma unroll
        for (int j = 0; j < 16; ++j) mx = fmaxf(mx, fabsf(f[j]));
        mx = wave_max(mx);
        const float step = fmaxf(mx, 1e-30f) * (1.0f / 127.0f), qi = 1.0f / step;
        u32x4 w;
#pragma unroll
        for (int q = 0; q < 4; ++q) w[q] = ((unsigned)(int)rintf(f[4 * q] * qi) & 0xffu) | (((unsigned)(int)rintf(f[4 * q + 1] * qi) & 0xffu) << 8) | (((unsigned)(int)rintf(f[4 * q + 2] * qi) & 0xffu) << 16) | (((unsigned)(int)rintf(f[4 * q + 3] * qi) & 0xffu) << 24);
        if (n < 4096) { *(u32x4*)(ws + WS_WIQ + (size_t)n * DM + lane * 16) = w; if (lane == 0) ((float*)(ws + WS_SWI))[n] = step; }
        else { *(u32x4*)(ws + WS_WKV8 + (size_t)(n - 4096) * DM + lane * 16) = w; if (lane == 0) ((float*)(ws + WS_SKV))[n - 4096] = step; }
    }
}

constexpr int LR_WF = 0, LR_CW = 16384, LR_CB = LR_CW + 1024, LR_BR = LR_CB + 256, LR_BI = LR_BR + 256, LR_CS = LR_BI + 256, LR_CARRY = LR_CS + 256, LR_SEQ = LR_CARRY + 2048, LR_END = LR_SEQ + 64, LR_DUMMY = 21504;

__device__ __forceinline__ void lru_load_consts(LAS unsigned char* lds, int g, int t, int nt) {
    const u32x4* src = (const u32x4*)(A_WS + WS_LRUW + (size_t)g * 16384);
    for (int i = t; i < 1024; i += nt) ((LAS u32x4*)(lds + LR_WF))[i] = src[i];
    for (int i = t; i < 256; i += nt) ((LAS float*)(lds + LR_CW))[i] = A_IN(9)[(i >> 6) * DM + g * 64 + (i & 63)];
    for (int i = t; i < 64; i += nt) {
        const int c = g * 64 + i;
        ((LAS float*)(lds + LR_CB))[i] = A_IN(10)[c]; ((LAS float*)(lds + LR_BR))[i] = A_IN(12)[c]; ((LAS float*)(lds + LR_BI))[i] = A_IN(14)[c];
        ((LAS float*)(lds + LR_CS))[i] = 8.0f * log1pf(expf(-A_IN(15)[c]));
    }
    if (t < 8) ((LAS unsigned*)(lds + LR_SEQ))[t] = 0xffffffffu;
}

template <bool SAMPLE>
__device__ __forceinline__ void lru_tile(LAS unsigned char* lds, int lane, int g, size_t rowbase, int tile, int bidx, int pfd) {
    asm volatile("" : "+v"(lane));
    const int tl = lane & 31, hi = lane >> 5, t = tile * 32 + tl;
    const bf16_t* XR = (const bf16_t*)(A_WS + WS_XR); bf16_t* Gb = (bf16_t*)(A_WS + WS_G);
    const int cbase = g * 64 + 8 * hi;
    u32x4 gw4[4];
    {   const bf16_t* gp0 = Gb + (rowbase + (SAMPLE ? (tl < NST ? t : 0) : t)) * DM + cbase;
#pragma unroll
        for (int ks = 0; ks < 4; ++ks) gw4[ks] = *(const u32x4*)(gp0 + 16 * ks); }
    float xc[4][8];
    bf16x8 xf[4];
#pragma unroll
    for (int ks = 0; ks < 4; ++ks) {
        const f32x4 b0 = *(const LAS f32x4*)(lds + LR_CB + (16 * ks + 8 * hi) * 4), b1 = *(const LAS f32x4*)(lds + LR_CB + (16 * ks + 8 * hi) * 4 + 16);
#pragma unroll
        for (int j = 0; j < 4; ++j) { xc[ks][j] = b0[j]; xc[ks][4 + j] = b1[j]; }
#pragma unroll
        for (int tap = 0; tap < 4; ++tap) {
            const int rr = t - 3 + tap;
            float xv[8];
            {
                u32x4 w = *(const u32x4*)(XR + (rowbase + (rr < 0 ? 0 : rr)) * DM + cbase + 16 * ks);
                if (rr < 0) w = (u32x4){0u, 0u, 0u, 0u};
                xv[0] = bflo(w.x); xv[1] = bfhi(w.x); xv[2] = bflo(w.y); xv[3] = bfhi(w.y); xv[4] = bflo(w.z); xv[5] = bfhi(w.z); xv[6] = bflo(w.w); xv[7] = bfhi(w.w);
            }
            if (SAMPLE) {
                const float* sp = A_IN(4) + ((size_t)bidx * 3 + (rr < 0 ? 3 + rr : 0)) * DM + cbase + 16 * ks;
                const f32x4 p = *(const f32x4*)sp, q = *(const f32x4*)(sp + 4);
#pragma unroll
                for (int j = 0; j < 4; ++j) { xv[j] = rr < 0 ? p[j] : xv[j]; xv[4 + j] = rr < 0 ? q[j] : xv[4 + j]; }
            }
            const f32x4 w0 = *(const LAS f32x4*)(lds + LR_CW + (tap * 64 + 16 * ks + 8 * hi) * 4), w1 = *(const LAS f32x4*)(lds + LR_CW + (tap * 64 + 16 * ks + 8 * hi) * 4 + 16);
#pragma unroll
            for (int j = 0; j < 4; ++j) { xc[ks][j] += w0[j] * xv[j]; xc[ks][4 + j] += w1[j] * xv[4 + j]; }
        }
        u32x4 w; w.x = cvtpk(xc[ks][0], xc[ks][1]); w.y = cvtpk(xc[ks][2], xc[ks][3]); w.z = cvtpk(xc[ks][4], xc[ks][5]); w.w = cvtpk(xc[ks][6], xc[ks][7]);
        xf[ks] = __builtin_bit_cast(bf16x8, w);
        asm volatile("" ::: "memory");
    }
    float A[32], B[32];
#pragma unroll
    for (int T = 0; T < 2; ++T) {
        f32x16 ar = f32x16{}, ai = f32x16{};
#pragma unroll
        for (int ks = 0; ks < 4; ++ks) {
            const bf16x8 wr_ = *(const LAS bf16x8*)(lds + LR_WF + ((0 * 2 + T) * 4 + ks) * 1024 + lane * 16);
            const bf16x8 wi_ = *(const LAS bf16x8*)(lds + LR_WF + ((1 * 2 + T) * 4 + ks) * 1024 + lane * 16);
            ar = __builtin_amdgcn_mfma_f32_32x32x16_bf16(wr_, xf[ks], ar, 0, 0, 0);
            ai = __builtin_amdgcn_mfma_f32_32x32x16_bf16(wi_, xf[ks], ai, 0, 0, 0);
        }
#pragma unroll
        for (int q = 0; q < 2; ++q) {
            const int ks = 2 * T + q, lo = (16 * ks + 8 * hi) * 4;
            const f32x4 br0 = *(const LAS f32x4*)(lds + LR_BR + lo), br1 = *(const LAS f32x4*)(lds + LR_BR + lo + 16);
            const f32x4 bi0 = *(const LAS f32x4*)(lds + LR_BI + lo), bi1 = *(const LAS f32x4*)(lds + LR_BI + lo + 16);
            const f32x4 cs0 = *(const LAS f32x4*)(lds + LR_CS + lo), cs1 = *(const LAS f32x4*)(lds + LR_CS + lo + 16);
#pragma unroll
            for (int j = 0; j < 8; ++j) {
                const int r = 8 * q + j;
                const float brv = j < 4 ? br0[j & 3] : br1[j & 3], biv = j < 4 ? bi0[j & 3] : bi1[j & 3], csv = j < 4 ? cs0[j & 3] : cs1[j & 3];
                const float rg = sigmoidf_(ar[r] + brv), ig = sigmoidf_(ai[r] + biv);
                const float la = -csv * rg, av = fast_exp2(la * LOG2E);
                const float x2 = 2.0f * la;
                const float em = (x2 > -0.03f) ? -x2 * (1.0f + x2 * (0.5f + x2 * (0.16666667f + x2 * 0.041666668f))) : 1.0f - av * av;
                A[16 * T + r] = av; B[16 * T + r] = __builtin_amdgcn_sqrtf(em) * ig * xc[ks][j];
            }
        }
        asm volatile("" ::: "memory");
    }
#define LRU_STEP(DPPSTR) do { \
    _Pragma("unroll") for (int c = 0; c < 32; ++c) asm volatile("v_fmac_f32_dpp %0, %0, %1 " DPPSTR : "+v"(B[c]) : "v"(A[c])); \
    _Pragma("unroll") for (int c = 0; c < 32; ++c) asm volatile("v_mul_f32_dpp %0, %0, %0 " DPPSTR : "+v"(A[c])); } while (0)
    asm volatile("s_nop 1");
    LRU_STEP("row_shr:1 row_mask:0xf bank_mask:0xf"); LRU_STEP("row_shr:2 row_mask:0xf bank_mask:0xf"); LRU_STEP("row_shr:4 row_mask:0xf bank_mask:0xf");
    LRU_STEP("row_shr:8 row_mask:0xf bank_mask:0xf"); LRU_STEP("row_bcast:15 row_mask:0xa bank_mask:0xf");
#undef LRU_STEP
    float hin[32];
    if (SAMPLE) {
        const float* hp = A_IN(5) + (size_t)bidx * DM + cbase;
#pragma unroll
        for (int ks = 0; ks < 4; ++ks) { const f32x4 p = *(const f32x4*)(hp + 16 * ks), q = *(const f32x4*)(hp + 16 * ks + 4);
#pragma unroll
            for (int j = 0; j < 4; ++j) { hin[8 * ks + j] = p[j]; hin[8 * ks + 4 + j] = q[j]; } }
    } else if (tile == 0) {
#pragma unroll
        for (int c = 0; c < 32; ++c) hin[c] = 0.f;
    } else {
        volatile LAS unsigned* sq = (volatile LAS unsigned*)(lds + LR_SEQ) + (tile & 7);
        while (*sq != (unsigned)tile) __builtin_amdgcn_s_sleep(1);
        asm volatile("" ::: "memory");
        const LAS float* cp = (const LAS float*)(lds + LR_CARRY) + (tile & 7) * 64 + 8 * hi;
#pragma unroll
        for (int ks = 0; ks < 4; ++ks) { const f32x4 p = *(const LAS f32x4*)(cp + 16 * ks), q = *(const LAS f32x4*)(cp + 16 * ks + 4);
#pragma unroll
            for (int j = 0; j < 4; ++j) { hin[8 * ks + j] = p[j]; hin[8 * ks + 4 + j] = q[j]; } }
    }
#pragma unroll
    for (int c = 0; c < 32; ++c) B[c] = B[c] + A[c] * hin[c];
    if (!SAMPLE) {
        if (tl == 31) {
            if (tile < 127) {
                LAS float* cp = (LAS float*)(lds + LR_CARRY) + ((tile + 1) & 7) * 64 + 8 * hi;
#pragma unroll
                for (int ks = 0; ks < 4; ++ks) { *(LAS f32x4*)(cp + 16 * ks) = (f32x4){B[8 * ks], B[8 * ks + 1], B[8 * ks + 2], B[8 * ks + 3]};
                    *(LAS f32x4*)(cp + 16 * ks + 4) = (f32x4){B[8 * ks + 4], B[8 * ks + 5], B[8 * ks + 6], B[8 * ks + 7]}; }
            } else {
                float* lp = A_OUT + O_LP + (size_t)bidx * DM + cbase;
#pragma unroll
                for (int ks = 0; ks < 4; ++ks) { *(f32x4*)(lp + 16 * ks) = (f32x4){B[8 * ks], B[8 * ks + 1], B[8 * ks + 2], B[8 * ks + 3]};
                    *(f32x4*)(lp + 16 * ks + 4) = (f32x4){B[8 * ks + 4], B[8 * ks + 5], B[8 * ks + 6], B[8 * ks + 7]}; }
            }
        }
        if (tile < 127) {
            asm volatile("s_waitcnt lgkmcnt(0)" ::: "memory");
            if (lane == 63) *((volatile LAS unsigned*)(lds + LR_SEQ) + ((tile + 1) & 7)) = (unsigned)(tile + 1);
        }
    } else if (tl == 15) {
        float* lp = A_OUT + O_LS + (size_t)bidx * DM + cbase;
#pragma unroll
        for (int ks = 0; ks < 4; ++ks) { *(f32x4*)(lp + 16 * ks) = (f32x4){B[8 * ks], B[8 * ks + 1], B[8 * ks + 2], B[8 * ks + 3]};
            *(f32x4*)(lp + 16 * ks + 4) = (f32x4){B[8 * ks + 4], B[8 * ks + 5], B[8 * ks + 6], B[8 * ks + 7]}; }
    }
    if (!SAMPLE || tl < NST) {
        bf16_t* gp = Gb + (rowbase + t) * DM + cbase;
#pragma unroll
        for (int ks = 0; ks < 4; ++ks) {
            const u32x4 w = gw4[ks];
            float gv[8]; gv[0] = bflo(w.x); gv[1] = bfhi(w.x); gv[2] = bflo(w.y); gv[3] = bfhi(w.y); gv[4] = bflo(w.z); gv[5] = bfhi(w.z); gv[6] = bflo(w.w); gv[7] = bfhi(w.w);
            float o[8];
#pragma unroll
            for (int j = 0; j < 8; ++j) o[j] = B[8 * ks + j] * gelu_tanh(gv[j]);
            u32x4 ow; ow.x = cvtpk(o[0], o[1]); ow.y = cvtpk(o[2], o[3]); ow.z = cvtpk(o[4], o[5]); ow.w = cvtpk(o[6], o[7]);
            *(u32x4*)(gp + 16 * ks) = ow;
        }
    }
    (void)pfd;
}

constexpr int P2_Q = 20608;
constexpr int AT_TAB = 24576;
__device__ __forceinline__ void attn_unit(LAS unsigned char* lds, int lane, int b, int c, int h) {
    const int r32 = lane & 31, hi = lane >> 5, kr = swap23(r32);
    const bf16_t* Q = (const bf16_t*)(A_WS + WS_Q); const bf16_t* Kb = (const bf16_t*)(A_WS + WS_K); const bf16_t* VT = (const bf16_t*)(A_WS + WS_VT); bf16_t* O = (bf16_t*)(A_WS + WS_XN);
    const size_t row0 = (size_t)b * SEQ + (size_t)c * 64;
    bf16x8 qf[2][4];
#pragma unroll
    for (int qb = 0; qb < 2; ++qb)
#pragma unroll
        for (int ks = 0; ks < 4; ++ks) qf[qb][ks] = *(const bf16x8*)(Q + (row0 + qb * 32 + r32) * DM + h * 64 + ks * 16 + hi * 8);
    f32x16 o[2][2];
#pragma unroll
    for (int i = 0; i < 2; ++i)
#pragma unroll
        for (int j = 0; j < 2; ++j) o[i][j] = f32x16{};
    float mrow[2] = {-1e30f, -1e30f}, lrow[2] = {0.f, 0.f};
    const LAS float* tab = (const LAS float*)(lds + AT_TAB) + h * 320;
    const float cfar = tab[256];
    const int sb0 = (c >= 8 ? c - 8 : 0) * 2, sb1 = c * 2 + 1;
    const bf16_t* kbase = Kb + ((size_t)b * 128 * 16 + h) * 4 * 512 + lane * 8;
    const bf16_t* vbase = VT + ((size_t)b * 128 * 16 + h) * 4 * 512 + lane * 8;
    bf16x8 kf[4], vf[2][2];
#pragma unroll
    for (int ks = 0; ks < 4; ++ks) kf[ks] = *(const bf16x8*)(kbase + (size_t)sb0 * 32768 + ks * 512);
#pragma unroll
    for (int db = 0; db < 2; ++db)
#pragma unroll
        for (int s = 0; s < 2; ++s) vf[db][s] = *(const bf16x8*)(vbase + (size_t)sb0 * 32768 + (db * 2 + s) * 512);
    for (int sb = sb0; sb <= sb1; ++sb) {
        const int sbn = sb < sb1 ? sb + 1 : sb;
        f32x16 S[2];
#pragma unroll
        for (int qb = 0; qb < 2; ++qb) { S[qb] = f32x16{};
#pragma unroll
            for (int ks = 0; ks < 4; ++ks) S[qb] = __builtin_amdgcn_mfma_f32_32x32x16_bf16(kf[ks], qf[qb][ks], S[qb], 0, 0, 0); }
        asm volatile("" ::: "memory");
#pragma unroll
        for (int ks = 0; ks < 4; ++ks) kf[ks] = *(const bf16x8*)(kbase + (size_t)sbn * 32768 + ks * 512);
        const int delta = c - (sb >> 1), rb = sb & 1;
        if (delta >= 3) {
#pragma unroll
            for (int qb = 0; qb < 2; ++qb)
#pragma unroll
                for (int r = 0; r < 16; ++r) S[qb][r] += cfar;
        } else {
#pragma unroll
            for (int qb = 0; qb < 2; ++qb) {
                const LAS float* tp = tab + (64 * delta + 32 * qb + r32 + 128 - 32 * rb - 8 * hi - 23);
#pragma unroll
                for (int r = 0; r < 16; ++r) S[qb][r] += tp[23 - (16 * (r >> 3) + (r & 7))];
            }
        }
        float rm[2];
#pragma unroll
        for (int qb = 0; qb < 2; ++qb) { float mx = S[qb][0];
#pragma unroll
            for (int r = 1; r < 16; ++r) mx = fmaxf(mx, S[qb][r]);
            rm[qb] = plswap_max(mx); }
        if (__any((rm[0] > mrow[0] + 8.0f) || (rm[1] > mrow[1] + 8.0f))) {
#pragma unroll
            for (int qb = 0; qb < 2; ++qb) { const float mn = fmaxf(mrow[qb], rm[qb]); const float al = fast_exp2(mrow[qb] - mn); lrow[qb] *= al; mrow[qb] = mn;
#pragma unroll
                for (int r = 0; r < 16; ++r) { o[0][qb][r] *= al; o[1][qb][r] *= al; } }
        }
        bf16x8 pf[2][2];
#pragma unroll
        for (int qb = 0; qb < 2; ++qb) { float sum = 0.f;
#pragma unroll
            for (int r = 0; r < 16; ++r) { S[qb][r] = fast_exp2(S[qb][r] - mrow[qb]); sum += S[qb][r]; }
            lrow[qb] += sum;
#pragma unroll
            for (int s = 0; s < 2; ++s) { u32x4 w; w.x = cvtpk(S[qb][8 * s], S[qb][8 * s + 1]); w.y = cvtpk(S[qb][8 * s + 2], S[qb][8 * s + 3]); w.z = cvtpk(S[qb][8 * s + 4], S[qb][8 * s + 5]); w.w = cvtpk(S[qb][8 * s + 6], S[qb][8 * s + 7]);
                pf[qb][s] = __builtin_bit_cast(bf16x8, w); } }
#pragma unroll
        for (int db = 0; db < 2; ++db)
#pragma unroll
            for (int qb = 0; qb < 2; ++qb)
#pragma unroll
                for (int s = 0; s < 2; ++s) o[db][qb] = __builtin_amdgcn_mfma_f32_32x32x16_bf16(vf[db][s], pf[qb][s], o[db][qb], 0, 0, 0);
        asm volatile("" ::: "memory");
#pragma unroll
        for (int db = 0; db < 2; ++db)
#pragma unroll
            for (int s = 0; s < 2; ++s) vf[db][s] = *(const bf16x8*)(vbase + (size_t)sbn * 32768 + (db * 2 + s) * 512);
    }
#pragma unroll
    for (int qb = 0; qb < 2; ++qb) { const float inv = fast_rcp(plswap_add(lrow[qb]));
        bf16_t* op = O + (row0 + qb * 32 + r32) * DM + h * 64 + 8 * hi;
#pragma unroll
        for (int db = 0; db < 2; ++db)
#pragma unroll
            for (int s = 0; s < 2; ++s) { u32x4 w;
                w.x = cvtpk(o[db][qb][8 * s] * inv, o[db][qb][8 * s + 1] * inv); w.y = cvtpk(o[db][qb][8 * s + 2] * inv, o[db][qb][8 * s + 3] * inv);
                w.z = cvtpk(o[db][qb][8 * s + 4] * inv, o[db][qb][8 * s + 5] * inv); w.w = cvtpk(o[db][qb][8 * s + 6] * inv, o[db][qb][8 * s + 7] * inv);
                *(u32x4*)(op + 32 * db + 16 * s) = w; } }
}

constexpr int AS_P = 45056;
__device__ __forceinline__ void attn_sample_task(LAS unsigned char* lds, int wave, int lane, int task) {
    const int bs = task >> 6, h = (task >> 2) & 15, qg = task & 3;
    const bf16_t* Q = (const bf16_t*)(A_WS + WS_Q); bf16_t* O = (bf16_t*)(A_WS + WS_XN);
    const float* ck = A_IN(2); const float* cv = A_IN(3); const float* kn = A_OUT + O_KS; const float* vn = A_OUT + O_VS;
    LAS float* pb = (LAS float*)(lds + AS_P + wave * 9472);
    LAS float* qs = pb + 4 * 528;
    const LAS float* tab = (const LAS float*)(lds + AT_TAB) + h * 320;
#pragma unroll
    for (int i = 0; i < 4; ++i) qs[i * 64 + lane] = bflo((unsigned)Q[((size_t)NTP + bs * 16 + qg * 4 + i) * DM + h * 64 + lane]);
    asm volatile("s_waitcnt lgkmcnt(0)" ::: "memory");
#pragma unroll 1
    for (int it = 0; it < 9; ++it) {
        const int key = it * 64 + lane; const bool valid = key < 528;
        const float* kp = !valid ? ck : (key < 512 ? ck + (((size_t)bs * 512 + key) * 16 + h) * 64 : kn + ((size_t)bs * 16 + (key - 512)) * DM + h * 64);
        float d[4] = {0.f, 0.f, 0.f, 0.f};
        f32x4 kv[16];
#pragma unroll
        for (int d4 = 0; d4 < 16; ++d4) kv[d4] = *(const f32x4*)(kp + 4 * d4);
#pragma unroll
        for (int d4 = 0; d4 < 16; ++d4) {
#pragma unroll
            for (int i = 0; i < 4; ++i) { const f32x4 qq = *(const LAS f32x4*)(qs + i * 64 + 4 * d4); d[i] += (kv[d4][0] * qq[0] + kv[d4][1] * qq[1]) + (kv[d4][2] * qq[2] + kv[d4][3] * qq[3]); } }
        int rel = 512 + qg * 4 - key;
        if (valid) {
#pragma unroll
            for (int i = 0; i < 4; ++i) { int r = rel + i; r = r > 128 ? 128 : r; pb[i * 528 + key] = d[i] + tab[r + 128]; } }
    }
    asm volatile("s_waitcnt lgkmcnt(0)" ::: "memory");
#pragma unroll 1
    for (int i = 0; i < 4; ++i) {
        float mx = -1e30f;
#pragma unroll 1
        for (int key = lane; key < 528; key += 64) mx = fmaxf(mx, pb[i * 528 + key]);
        mx = wave_max(mx);
        float sum = 0.f;
#pragma unroll 1
        for (int key = lane; key < 528; key += 64) { const float pv = fast_exp2(pb[i * 528 + key] - mx); pb[i * 528 + key] = pv; sum += pv; }
        sum = wave_sum(sum); const float inv = 1.0f / sum;
#pragma unroll 1
        for (int key = lane; key < 528; key += 64) pb[i * 528 + key] *= inv;
    }
    asm volatile("s_waitcnt lgkmcnt(0)" ::: "memory");
    float acc[4] = {0.f, 0.f, 0.f, 0.f};
#pragma unroll 1
    for (int k0 = 0; k0 < 528; k0 += 16) {
        float vv[16];
#pragma unroll
        for (int kk = 0; kk < 16; ++kk) { const int key = k0 + kk; vv[kk] = k0 < 512 ? cv[(((size_t)bs * 512 + key) * 16 + h) * 64 + lane] : vn[((size_t)bs * 16 + (key - 512)) * DM + h * 64 + lane]; }
#pragma unroll
        for (int kk = 0; kk < 16; ++kk) {
#pragma unroll
            for (int i = 0; i < 4; ++i) acc[i] += pb[i * 528 + k0 + kk] * vv[kk]; }
    }
#pragma unroll
    for (int i = 0; i < 4; ++i) O[((size_t)NTP + bs * 16 + qg * 4 + i) * DM + h * 64 + lane] = (bf16_t)(cvtpk(acc[i], 0.f) & 0xffffu);
    asm volatile("s_waitcnt lgkmcnt(0)" ::: "memory");
}

constexpr int P2_BAR = 20612, P2_SIMD = 20640;
__device__ __forceinline__ void p2_lbar(LAS unsigned char* lds, int lane, int nL, int& tgt) {
    tgt += nL;
    asm volatile("s_waitcnt lgkmcnt(0)" ::: "memory");
    if (lane == 0) (void)__hip_atomic_fetch_add((LAS int*)(lds + P2_BAR), 1, __ATOMIC_RELAXED, __HIP_MEMORY_SCOPE_WORKGROUP);
    while (*(volatile LAS int*)(lds + P2_BAR) < tgt) __builtin_amdgcn_s_sleep(1);
    asm volatile("" ::: "memory");
}
__device__ __forceinline__ void p2_phase(LAS unsigned char* lds, int G, int tid, int wave, int lane) {
    for (int i = tid; i < 16 * 320; i += 512) { const int h = i / 320, j = i % 320; ((LAS float*)(lds + AT_TAB))[i] = A_IN(8)[h * 257 + (j > 256 ? 256 : j)] * LOG2E; }
    {   const int simd = (int)__builtin_amdgcn_s_getreg((1 << 11) | (4 << 6) | 4);
        if (lane == 0) ((volatile LAS int*)(lds + P2_SIMD))[wave] = simd;
        if (tid == 0) { *(volatile LAS int*)(lds + P2_Q) = 0; *(volatile LAS int*)(lds + P2_BAR) = 0; } }
    if ((int)blockIdx.x < 256) lru_load_consts(lds, (int)blockIdx.x & 15, tid, 512);
    __syncthreads();
    int isL = 0, lw = 0, nL = 0;
    {   int sd[8];
#pragma unroll
        for (int w = 0; w < 8; ++w) sd[w] = ((const LAS int*)(lds + P2_SIMD))[w];
#pragma unroll
        for (int w = 0; w < 8; ++w) {
            int first = 1;
#pragma unroll
            for (int v = 0; v < w; ++v) first &= (sd[v] != sd[w]) ? 1 : 0;
            nL += first; lw += (w < wave) ? first : 0; isL = (w == wave) ? first : isL;
        }
        isL = __builtin_amdgcn_readfirstlane(isL); lw = __builtin_amdgcn_readfirstlane(lw); nL = __builtin_amdgcn_readfirstlane(nL); }
    if (isL) {
        int tgt = 0, gres = -1;
        for (int u = blockIdx.x; u < 256; u += G) {
            const int g = u & 15, b = u >> 4;
            if (gres >= 0) { p2_lbar(lds, lane, nL, tgt); lru_load_consts(lds, g, lw * 64 + lane, nL * 64); p2_lbar(lds, lane, nL, tgt); }
            gres = g;
            for (int tile = lw; tile < 128; tile += nL) lru_tile<false>(lds, lane, g, (size_t)b * SEQ, tile, b, 2 * nL);
        }
        for (int sidx = blockIdx.x; sidx < 128; sidx += G) {
            const int g = sidx & 15, bs = sidx >> 4;
            if (g != gres) { p2_lbar(lds, lane, nL, tgt); lru_load_consts(lds, g, lw * 64 + lane, nL * 64); p2_lbar(lds, lane, nL, tgt); gres = g; }
            if (lw == 0) lru_tile<true>(lds, lane, g, (size_t)NTP + bs * 16, 0, bs, 0);
        }
    }
    int nS = 0; for (int t = blockIdx.x; t < 512; t += G) ++nS;
    for (;;) {
        int j = 0;
        if (lane == 0) j = __hip_atomic_fetch_add((LAS int*)(lds + P2_Q), 1, __ATOMIC_RELAXED, __HIP_MEMORY_SCOPE_WORKGROUP);
        j = __builtin_amdgcn_readfirstlane(j);
        if (j < nS) { attn_sample_task(lds, wave, lane, blockIdx.x + G * j); continue; }
        j -= nS;
        const int gid = (int)blockIdx.x + G * (j >> 3);
        if (gid >= 2048) break;
        const int qq = gid >> 8, m = (gid >> 3) & 31, x = gid & 7;
        const int bh = x * 4 + (m >> 3) + 32 * qq, cg = ((m & 7) + qq) & 7;
        attn_unit(lds, lane, bh >> 4, cg * 8 + (j & 7), bh & 15);
    }
}

__device__ __forceinline__ void p4b_phase(int G, int wave, int lane) {
    const int gw = blockIdx.x * 8 + wave, NGW = G * 8;
    for (int n = gw; n < 2048; n += NGW) {
        const bf16_t* wr_ = (const bf16_t*)(A_WS + WS_WS) + (size_t)n * DM + lane * 16;
        const u32x4 a = *(const u32x4*)wr_, b = *(const u32x4*)(wr_ + 8);
        float f[16]; f[0] = bflo(a.x); f[1] = bfhi(a.x); f[2] = bflo(a.y); f[3] = bfhi(a.y); f[4] = bflo(a.z); f[5] = bfhi(a.z); f[6] = bflo(a.w); f[7] = bfhi(a.w);
        f[8] = bflo(b.x); f[9] = bfhi(b.x); f[10] = bflo(b.y); f[11] = bfhi(b.y); f[12] = bflo(b.z); f[13] = bfhi(b.z); f[14] = bflo(b.w); f[15] = bfhi(b.w);
        float mx = 0.f;
#pragma unroll
        for (int j = 0; j < 16; ++j) mx = fmaxf(mx, fabsf(f[j]));
        mx = wave_max(mx);
        const float step = fmaxf(mx, 1e-30f) * (1.0f / 127.0f), qi = 1.0f / step;
        u32x4 w;
#pragma unroll
        for (int q = 0; q < 4; ++q) w[q] = ((unsigned)(int)rintf(f[4 * q] * qi) & 0xffu) | (((unsigned)(int)rintf(f[4 * q + 1] * qi) & 0xffu) << 8) | (((unsigned)(int)rintf(f[4 * q + 2] * qi) & 0xffu) << 16) | (((unsigned)(int)rintf(f[4 * q + 3] * qi) & 0xffu) << 24);
        *(u32x4*)(A_WS + WS_WSQ + (size_t)n * DM + lane * 16) = w;
        if (lane == 0) ((float*)(A_WS + WS_SW))[n] = step;
    }
    const float* gm = A_IN(19); bf16_t* XT = (bf16_t*)(A_WS + WS_Q); unsigned char* XQ = A_WS + WS_XQ; float* SX = (float*)(A_WS + WS_SX);
    const bf16_t* DL = (const bf16_t*)(A_WS + WS_DELTA);
    f32x4 v[4], vn[4], ggr[4];
#pragma unroll
    for (int j = 0; j < 4; ++j) ggr[j] = *(const f32x4*)(gm + j * 256 + lane * 4);
    if (gw < NTOK) { row_ld(xrow_ptr(gw), v, lane); row_add_bf16(DL + (size_t)gw * DM, v, lane); }
    for (int m = gw; m < NTOK; m += NGW) {
        const int mn = m + NGW;
        if (mn < NTOK) { row_ld(xrow_ptr(mn), vn, lane); row_add_bf16(DL + (size_t)mn * DM, vn, lane); }
        bf16_t* orow = XT + (size_t)m * DM;
        const float ss = row_ss(v);
        float mx = 0.f;
#pragma unroll
        for (int j = 0; j < 4; ++j) { v[j] = v[j] * ggr[j];
            mx = fmaxf(mx, fmaxf(fmaxf(fabsf(v[j][0]), fabsf(v[j][1])), fmaxf(fabsf(v[j][2]), fabsf(v[j][3])))); }
        const float inv = __builtin_amdgcn_rsqf(wave_sum(ss) * (1.0f / DM) + EPS);
        mx = fmaxf(wave_max(mx), 1e-30f);
        if (m >= NTP) {
#pragma unroll
            for (int j = 0; j < 4; ++j) { const f32x4 t = v[j] * inv; u32x2 w; w.x = cvtpk(t[0], t[1]); w.y = cvtpk(t[2], t[3]); *(u32x2*)(orow + j * 256 + lane * 4) = w; } }
        const float step = mx * inv * (1.0f / 127.0f), qi = 127.0f * fast_rcp(mx);
#pragma unroll
        for (int j = 0; j < 4; ++j) {
            const unsigned b0 = (unsigned)(int)rintf(v[j][0] * qi) & 0xffu, b1 = (unsigned)(int)rintf(v[j][1] * qi) & 0xffu, b2 = (unsigned)(int)rintf(v[j][2] * qi) & 0xffu, b3 = (unsigned)(int)rintf(v[j][3] * qi) & 0xffu;
            *(unsigned*)(XQ + (size_t)m * DM + j * 256 + lane * 4) = b0 | (b1 << 8) | (b2 << 16) | (b3 << 24); }
        if (lane == 0) SX[m] = step;
#pragma unroll
        for (int j = 0; j < 4; ++j) v[j] = vn[j];
    }
}

__device__ __forceinline__ int f2key(float f) { const int b = __float_as_int(f); return b ^ ((b >> 31) & 0x7fffffff); }
__device__ __forceinline__ float key2f(int k) { return __int_as_float(k ^ ((k >> 31) & 0x7fffffff)); }
#define CE_DESC(x, y) do { const int hi_ = max(x, y); y = min(x, y); x = hi_; } while (0)
#define CE_ASC(x, y)  do { const int lo_ = min(x, y); y = max(x, y); x = lo_; } while (0)
__device__ __forceinline__ void bitonic_sort16_desc(int (&a)[16]) {
#pragma unroll
    for (int k = 2; k <= 16; k <<= 1)
#pragma unroll
        for (int j = k >> 1; j > 0; j >>= 1)
#pragma unroll
            for (int i = 0; i < 16; ++i) { const int l = i ^ j; if (l > i) { if ((i & k) == 0) CE_DESC(a[i], a[l]); else CE_ASC(a[i], a[l]); } }
}
__device__ __forceinline__ void bitonic_merge16_desc(int (&a)[16]) {
#pragma unroll
    for (int j = 8; j > 0; j >>= 1)
#pragma unroll
        for (int i = 0; i < 16; ++i) { const int l = i ^ j; if (l > i) CE_DESC(a[i], a[l]); }
}
__device__ __forceinline__ void top16_merge(int (&T)[16], const int (&S)[16]) {
#pragma unroll
    for (int i = 0; i < 16; ++i) T[i] = max(T[i], S[15 - i]);
    bitonic_merge16_desc(T);
}
#define INS16(L, x) do { int x_ = (x); _Pragma("unroll") for (int j_ = 0; j_ < 16; ++j_) { const int hi_ = max(L[j_], x_); x_ = min(L[j_], x_); L[j_] = hi_; } } while (0)

constexpr size_t WS_PART = WS_XN;
constexpr int CT_U = 64, CT_V = 64 + 8 * 64;
constexpr int P6_TOKB = 128, P6_NITEM = NTOK / P6_TOKB, P6_TPW = P6_TOKB / 8;
constexpr size_t WS_CQ = WS_XR, WS_CS = WS_XR + 16 * MiB;
constexpr int P6_IDX = 0;
constexpr int P6_E = 0, P6_C = 8192, P6_ITEM = 49152, P6_E8 = 0, P6_C8 = 32768;

__device__ __forceinline__ void p6a_phase(LAS unsigned char* lds, int G, int wave, int lane) {
    const int gw = blockIdx.x * 8 + wave, NGW = G * 8;
    const bf16_t* SC = (const bf16_t*)(A_WS + WS_XN);
    unsigned short* SELE = (unsigned short*)(A_WS + WS_SELE); float* SELG = (float*)(A_WS + WS_SELG);
    LAS int* idxb = (LAS int*)(lds + P6_IDX + wave * 4096);
    const int tl = lane >> 4, hh = (lane >> 1) & 7, half = lane & 1;
    for (int grp_ = gw; grp_ < NTOK / 4; grp_ += NGW) {
        const int grp = NTOK / 4 - 1 - grp_;
        const int tok = grp * 4 + tl;
        const bf16_t* sp = SC + (size_t)tok * 2048 + (lane & 15);
        int L[16];
#pragma unroll
        for (int j = 0; j < 16; ++j) L[j] = (int)0x80000000;
        {
            float sa[16], sb_[16];
#pragma unroll
            for (int e = 0; e < 16; ++e) sa[e] = bflo((unsigned)sp[16 * e]);
#pragma unroll
            for (int c0 = 0; c0 < 128; c0 += 32) {
#pragma unroll
                for (int e = 0; e < 16; ++e) sb_[e] = bflo((unsigned)sp[16 * (c0 + 16 + e)]);
                { int S[16];
#pragma unroll
                  for (int e = 0; e < 16; ++e) S[e] = (f2key(sa[e]) & ~127) | (c0 + e);
                  bitonic_sort16_desc(S);
                  if (c0 == 0) {
#pragma unroll
                      for (int e = 0; e < 16; ++e) L[e] = S[e]; } else top16_merge(L, S); }
                if (c0 + 32 < 128) {
#pragma unroll
                    for (int e = 0; e < 16; ++e) sa[e] = bflo((unsigned)sp[16 * (c0 + 32 + e)]); }
                { int S[16];
#pragma unroll
                  for (int e = 0; e < 16; ++e) S[e] = (f2key(sb_[e]) & ~127) | (c0 + 16 + e);
                  bitonic_sort16_desc(S);
                  top16_merge(L, S); }
            }
        }
#pragma unroll
        for (int j = 0; j < 16; ++j) idxb[lane * 16 + j] = L[j] & 127;
        float va[16], vb[16];
#pragma unroll
        for (int j = 0; j < 16; ++j) { const int own = L[j] & ~127, oth = __shfl_xor(own, 1); va[j] = key2f(half ? oth : own); vb[j] = key2f(half ? own : oth); }
        int C[16];
#pragma unroll
        for (int j = 0; j < 16; ++j) C[j] = (int)0x80000000;
        {   int S[16];
            S[0] = (f2key(va[0] + vb[0]) & ~255) | 0;
            S[1] = (f2key(va[0] + vb[1]) & ~255) | 1;
            S[2] = (f2key(va[0] + vb[2]) & ~255) | 2;
            S[3] = (f2key(va[0] + vb[3]) & ~255) | 3;
            S[4] = (f2key(va[0] + vb[4]) & ~255) | 4;
            S[5] = (f2key(va[0] + vb[5]) & ~255) | 5;
            S[6] = (f2key(va[0] + vb[6]) & ~255) | 6;
            S[7] = (f2key(va[0] + vb[7]) & ~255) | 7;
            S[8] = (f2key(va[0] + vb[8]) & ~255) | 8;
            S[9] = (f2key(va[0] + vb[9]) & ~255) | 9;
            S[10] = (f2key(va[0] + vb[10]) & ~255) | 10;
            S[11] = (f2key(va[0] + vb[11]) & ~255) | 11;
            S[12] = (f2key(va[0] + vb[12]) & ~255) | 12;
            S[13] = (f2key(va[0] + vb[13]) & ~255) | 13;
            S[14] = (f2key(va[0] + vb[14]) & ~255) | 14;
            S[15] = (f2key(va[0] + vb[15]) & ~255) | 15;
            bitonic_sort16_desc(S);
#pragma unroll
            for (int q = 0; q < 16; ++q) C[q] = S[q]; }
        {   int S[16];
            S[0] = (f2key(va[1] + vb[0]) & ~255) | 16;
            S[1] = (f2key(va[1] + vb[1]) & ~255) | 17;
            S[2] = (f2key(va[1] + vb[2]) & ~255) | 18;
            S[3] = (f2key(va[1] + vb[3]) & ~255) | 19;
            S[4] = (f2key(va[1] + vb[4]) & ~255) | 20;
            S[5] = (f2key(va[1] + vb[5]) & ~255) | 21;
            S[6] = (f2key(va[1] + vb[6]) & ~255) | 22;
            S[7] = (f2key(va[1] + vb[7]) & ~255) | 23;
            S[8] = (f2key(va[2] + vb[0]) & ~255) | 32;
            S[9] = (f2key(va[2] + vb[1]) & ~255) | 33;
            S[10] = (f2key(va[2] + vb[2]) & ~255) | 34;
            S[11] = (f2key(va[2] + vb[3]) & ~255) | 35;
            S[12] = (f2key(va[2] + vb[4]) & ~255) | 36;
            S[13] = (f2key(va[3] + vb[0]) & ~255) | 48;
            S[14] = (f2key(va[3] + vb[1]) & ~255) | 49;
            S[15] = (f2key(va[3] + vb[2]) & ~255) | 50;
            bitonic_sort16_desc(S);
            top16_merge(C, S); }
        {   int S[16];
            S[0] = (f2key(va[3] + vb[3]) & ~255) | 51;
            S[1] = (f2key(va[4] + vb[0]) & ~255) | 64;
            S[2] = (f2key(va[4] + vb[1]) & ~255) | 65;
            S[3] = (f2key(va[4] + vb[2]) & ~255) | 66;
            S[4] = (f2key(va[5] + vb[0]) & ~255) | 80;
            S[5] = (f2key(va[5] + vb[1]) & ~255) | 81;
            S[6] = (f2key(va[6] + vb[0]) & ~255) | 96;
            S[7] = (f2key(va[6] + vb[1]) & ~255) | 97;
            S[8] = (f2key(va[7] + vb[0]) & ~255) | 112;
            S[9] = (f2key(va[7] + vb[1]) & ~255) | 113;
            S[10] = (f2key(va[8] + vb[0]) & ~255) | 128;
            S[11] = (f2key(va[9] + vb[0]) & ~255) | 144;
            S[12] = (f2key(va[10] + vb[0]) & ~255) | 160;
            S[13] = (f2key(va[11] + vb[0]) & ~255) | 176;
            S[14] = (f2key(va[12] + vb[0]) & ~255) | 192;
            S[15] = (f2key(va[13] + vb[0]) & ~255) | 208;
            bitonic_sort16_desc(S);
            top16_merge(C, S); }
        {   int S[16];
            S[0] = (f2key(va[14] + vb[0]) & ~255) | 224;
            S[1] = (f2key(va[15] + vb[0]) & ~255) | 240;
            S[2] = (int)0x80000000;
            S[3] = (int)0x80000000;
            S[4] = (int)0x80000000;
            S[5] = (int)0x80000000;
            S[6] = (int)0x80000000;
            S[7] = (int)0x80000000;
            S[8] = (int)0x80000000;
            S[9] = (int)0x80000000;
            S[10] = (int)0x80000000;
            S[11] = (int)0x80000000;
            S[12] = (int)0x80000000;
            S[13] = (int)0x80000000;
            S[14] = (int)0x80000000;
            S[15] = (int)0x80000000;
            bitonic_sort16_desc(S);
            top16_merge(C, S); }
        const float mx = key2f(C[0] & ~255);
        float ev[16], sum = 0.f;
#pragma unroll
        for (int j = 0; j < 16; ++j) { ev[j] = __expf(key2f(C[j] & ~255) - mx); sum += ev[j]; }
        const float inv = 1.0f / sum;
        asm volatile("s_waitcnt lgkmcnt(0)" ::: "memory");
        int eo[8]; float go[8];
#pragma unroll
        for (int s = 0; s < 8; ++s) {
            int c_lo = C[s], c_hi = C[8 + s]; float e_lo = ev[s], e_hi = ev[8 + s];
            asm volatile("" : "+v"(c_lo), "+v"(c_hi), "+v"(e_lo), "+v"(e_hi));
            const int cc = half ? c_hi : c_lo; go[s] = (half ? e_hi : e_lo) * inv;
            const int ij = cc & 255, i1 = idxb[(lane & ~1) * 16 + (ij >> 4)], i2 = idxb[(lane | 1) * 16 + (ij & 15)];
            eo[s] = i1 * 128 + i2;
        }
        {
            const float* SU = (const float*)(A_WS + WS_SU); const float* SV = (const float*)(A_WS + WS_SV);
            float su[8];
#pragma unroll
            for (int s = 0; s < 8; ++s) { su[s] = SU[eo[s]]; go[s] *= SV[eo[s]]; }
            float* up = (float*)(A_WS + WS_SELU) + (size_t)tok * 128 + hh * 16 + half * 8;
            *(f32x4*)up = (f32x4){su[0], su[1], su[2], su[3]}; *(f32x4*)(up + 4) = (f32x4){su[4], su[5], su[6], su[7]};
        }
        unsigned short* ep = SELE + (size_t)tok * 128 + hh * 16 + half * 8; float* gp = SELG + (size_t)tok * 128 + hh * 16 + half * 8;
        *(u32x4*)ep = (u32x4){(unsigned)eo[0] | ((unsigned)eo[1] << 16), (unsigned)eo[2] | ((unsigned)eo[3] << 16), (unsigned)eo[4] | ((unsigned)eo[5] << 16), (unsigned)eo[6] | ((unsigned)eo[7] << 16)};
        *(f32x4*)gp = (f32x4){go[0], go[1], go[2], go[3]}; *(f32x4*)(gp + 4) = (f32x4){go[4], go[5], go[6], go[7]};
        asm volatile("s_waitcnt lgkmcnt(0)" ::: "memory");
    }
}

__device__ __forceinline__ float dot2bf(unsigned a, unsigned b, float c) { return __builtin_amdgcn_fdot2_f32_bf16(__builtin_bit_cast(bf16x2_t, a), __builtin_bit_cast(bf16x2_t, b), c, false); }
__device__ __forceinline__ unsigned xcc_id() { return (unsigned)__builtin_amdgcn_s_getreg((3 << 11) | 20) & 0xFu; }
__device__ __forceinline__ float dpp_sum16(float v) {
    v += __builtin_bit_cast(float, __builtin_amdgcn_update_dpp(0, __builtin_bit_cast(int, v), 0xB1, 0xF, 0xF, true));
    v += __builtin_bit_cast(float, __builtin_amdgcn_update_dpp(0, __builtin_bit_cast(int, v), 0x4E, 0xF, 0xF, true));
    v += __builtin_bit_cast(float, __builtin_amdgcn_update_dpp(0, __builtin_bit_cast(int, v), 0x141, 0xF, 0xF, true));
    v += __builtin_bit_cast(float, __builtin_amdgcn_update_dpp(0, __builtin_bit_cast(int, v), 0x140, 0xF, 0xF, true));
    return v;
}
__device__ __forceinline__ bool p6_claim(LAS unsigned char* lds, unsigned* cnt, int tid, int& ring, int home, int& slice, int& item, int& pend) {
    for (;;) {
        if (ring >= 8) return false;
        slice = (home + ring) & 7;
        __syncthreads();
        if (tid == 0) {
            const int tk = pend >= 0 ? pend : (int)__hip_atomic_fetch_add(cnt + 64 * slice, 1u, __ATOMIC_RELAXED, __HIP_MEMORY_SCOPE_AGENT);
            *(volatile LAS int*)(lds + P6_ITEM) = tk;
            pend = tk < P6_NITEM ? (int)__hip_atomic_fetch_add(cnt + 64 * slice, 1u, __ATOMIC_RELAXED, __HIP_MEMORY_SCOPE_AGENT) : -1;
        }
        __syncthreads();
        item = *(volatile LAS int*)(lds + P6_ITEM);
        if (item < P6_NITEM) return true;
        ++ring;
    }
}

struct P6W { int ring, has, pv; };
__device__ __forceinline__ bool p6w_claim(unsigned* cnt, int lane, int home, int n, P6W& st, int& slice, int& item) {
    for (;;) {
        if (st.ring >= 8) return false;
        slice = (home + st.ring) & 7;
        int tk;
        if (st.has) tk = __builtin_amdgcn_readfirstlane(st.pv);
        else { int t = 0; if (lane == 0) t = (int)__hip_atomic_fetch_add(cnt + 64 * slice, 1u, __ATOMIC_RELAXED, __HIP_MEMORY_SCOPE_AGENT); tk = __builtin_amdgcn_readfirstlane(t); }
        if (tk < n) {
            int t = 0; if (lane == 0) t = (int)__hip_atomic_fetch_add(cnt + 64 * slice, 1u, __ATOMIC_RELAXED, __HIP_MEMORY_SCOPE_AGENT);
            st.pv = t; st.has = 1; item = tk; return true;
        }
        st.has = 0; ++st.ring;
    }
}

__device__ __forceinline__ float ub0(unsigned w) { return (float)(w & 0xffu); }
__device__ __forceinline__ float ub1(unsigned w) { return (float)((w >> 8) & 0xffu); }
__device__ __forceinline__ float ub2(unsigned w) { return (float)((w >> 16) & 0xffu); }
__device__ __forceinline__ float ub3(unsigned w) { return (float)(w >> 24); }
__device__ __forceinline__ float dpp_sum8(float v) {
    v += __builtin_bit_cast(float, __builtin_amdgcn_update_dpp(0, __builtin_bit_cast(int, v), 0xB1, 0xF, 0xF, true));
    v += __builtin_bit_cast(float, __builtin_amdgcn_update_dpp(0, __builtin_bit_cast(int, v), 0x4E, 0xF, 0xF, true));
    v += __builtin_bit_cast(float, __builtin_amdgcn_update_dpp(0, __builtin_bit_cast(int, v), 0x141, 0xF, 0xF, true));
    return v;
}
__device__ __forceinline__ int dpp_isum8(int v) {
    v += __builtin_amdgcn_update_dpp(0, v, 0xB1, 0xF, 0xF, true);
    v += __builtin_amdgcn_update_dpp(0, v, 0x4E, 0xF, 0xF, true);
    v += __builtin_amdgcn_update_dpp(0, v, 0x141, 0xF, 0xF, true);
    return v;
}
__device__ __forceinline__ void p6b_item(LAS unsigned char* lds, int wave, int lane, int slice, int tok0) {
    const unsigned char* XQ = A_WS + WS_XQ; const unsigned char* UB = A_WS + WS_UB; const float* SX = (const float*)(A_WS + WS_SX);
    const unsigned short* SELE = (const unsigned short*)(A_WS + WS_SELE); bf16_t* PART = (bf16_t*)(A_WS + WS_PART);
    const int i8 = lane & 7, grp = lane >> 3;
    LAS int* eb = (LAS int*)(lds + P6_E8 + wave * 4096);
    {
        u32x4 le[2], xqn; float sxn;
        { const int tk = tok0 + grp;
#pragma unroll
          for (int q = 0; q < 2; ++q) le[q] = *(const u32x4*)(SELE + (size_t)tk * 128 + i8 * 16 + 8 * q);
          xqn = *(const u32x4*)(XQ + (size_t)tk * DM + slice * 128 + i8 * 16); sxn = SX[tk]; }
#pragma unroll 1
        for (int tb = 0; tb < P6_TPW; tb += 8) {
            const int tok = tok0 + tb + grp;
#pragma unroll
            for (int q = 0; q < 2; ++q) *(LAS u32x4*)(eb + grp * 64 + i8 * 8 + 4 * q) = le[q];
            const int x0 = (int)xqn.x, x1 = (int)xqn.y, x2 = (int)xqn.z, x3 = (int)xqn.w; const float sx = sxn;
            if (tb + 8 < P6_TPW) { const int tk = tok + 8;
#pragma unroll
                for (int q = 0; q < 2; ++q) le[q] = *(const u32x4*)(SELE + (size_t)tk * 128 + i8 * 16 + 8 * q);
                xqn = *(const u32x4*)(XQ + (size_t)tk * DM + slice * 128 + i8 * 16); sxn = SX[tk]; }
            const unsigned char* ub = UB + slice * 128 + i8 * 16;
            asm volatile("s_waitcnt lgkmcnt(0)" ::: "memory");
            int res[16];
#pragma unroll
            for (int j = 0; j < 16; ++j) res[j] = 0;
#pragma unroll
            for (int s16 = 0; s16 < 128; s16 += 16) {
                u32x4 uv[16]; u32x4 e4[2];
#pragma unroll
                for (int a4 = 0; a4 < 2; ++a4) e4[a4] = *(const LAS u32x4*)(eb + grp * 64 + (s16 >> 1) + 4 * a4);
#pragma unroll
                for (int a4 = 0; a4 < 2; ++a4)
#pragma unroll
                    for (int j = 0; j < 4; ++j) { const unsigned w = e4[a4][j];
                        uv[8 * a4 + 2 * j] = *(const u32x4*)(ub + (size_t)(w & 0xffffu) * DM); uv[8 * a4 + 2 * j + 1] = *(const u32x4*)(ub + (size_t)(w >> 16) * DM); }
#pragma unroll
                for (int q = 0; q < 16; ++q) {
                    const int a0 = (int)uv[q].x, a1 = (int)uv[q].y, a2 = (int)uv[q].z, a3 = (int)uv[q].w;
                    int d = __builtin_amdgcn_sdot4(a0, x0, 0, false); d = __builtin_amdgcn_sdot4(a1, x1, d, false); d = __builtin_amdgcn_sdot4(a2, x2, d, false); d = __builtin_amdgcn_sdot4(a3, x3, d, false);
                    d = dpp_isum8(d);
                    const int sidx = s16 + q;
                    res[sidx >> 3] = (i8 == (sidx & 7)) ? d : res[sidx >> 3];
                }
            }
            bf16_t* pp = PART + ((size_t)slice * NTOK + tok) * 128 + 16 * i8;
#pragma unroll
            for (int q = 0; q < 2; ++q) { u32x4 w;
                w.x = cvtpk((float)res[8 * q] * sx, (float)res[8 * q + 1] * sx); w.y = cvtpk((float)res[8 * q + 2] * sx, (float)res[8 * q + 3] * sx);
                w.z = cvtpk((float)res[8 * q + 4] * sx, (float)res[8 * q + 5] * sx); w.w = cvtpk((float)res[8 * q + 6] * sx, (float)res[8 * q + 7] * sx);
                *(u32x4*)(pp + 8 * q) = w; }
            asm volatile("s_waitcnt lgkmcnt(0)" ::: "memory");
        }
    }
}
__device__ __forceinline__ void p6b_phase(LAS unsigned char* lds, int tid, int wave, int lane) {
    unsigned* cnt = (unsigned*)(A_WS + WS_CTL) + CT_U;
    const int home = (int)(xcc_id() & 7u);
    P6W st{0, 0, 0}; int slice, item;
    while (p6w_claim(cnt, lane, home, NTOK / 16, st, slice, item)) p6b_item(lds, wave, lane, slice, item * 16);
}

__device__ __forceinline__ void p6m_phase(int G, int wave, int lane) {
    const int gw = blockIdx.x * 8 + wave, NGW = G * 8;
    const float* SELU = (const float*)(A_WS + WS_SELU); const float* SELG = (const float*)(A_WS + WS_SELG); const bf16_t* PART = (const bf16_t*)(A_WS + WS_PART);
    unsigned char* CQ = A_WS + WS_CQ; float* CS = (float*)(A_WS + WS_CS);
    const int k0 = 8 * ((2 * lane) & 15) + (lane >> 3), k1 = k0 + 8;
    unsigned pw[8], pwn[8]; float g0 = 0.f, g1 = 0.f, u0 = 0.f, u1 = 0.f, g0n = 0.f, g1n = 0.f, u0n = 0.f, u1n = 0.f;
#define P6M_LOAD(t, PW, G0, G1, U0, U1) do { _Pragma("unroll") for (int j = 0; j < 8; ++j) PW[j] = ((const unsigned*)(PART + ((size_t)j * NTOK + (t)) * 128))[lane]; \
        G0 = SELG[(size_t)(t) * 128 + k0]; G1 = SELG[(size_t)(t) * 128 + k1]; U0 = SELU[(size_t)(t) * 128 + k0]; U1 = SELU[(size_t)(t) * 128 + k1]; } while (0)
    if (gw < NTOK) P6M_LOAD(gw, pw, g0, g1, u0, u1);
    for (int tok = gw; tok < NTOK; tok += NGW) {
        const int tn = tok + NGW;
        if (tn < NTOK) P6M_LOAD(tn, pwn, g0n, g1n, u0n, u1n);
        float a0 = 0.f, a1 = 0.f;
#pragma unroll
        for (int j = 0; j < 8; ++j) { a0 += bflo(pw[j]); a1 += bfhi(pw[j]); }
        const float c0 = g0 * gelu_tanh(a0 * u0), c1 = g1 * gelu_tanh(a1 * u1);
        float mx = fmaxf(fabsf(c0), fabsf(c1));
        mx = wave_max(mx);
        const float cstep = fmaxf(mx, 1e-30f) * (1.0f / 127.0f), cinv = fast_rcp(cstep);
        CQ[(size_t)tok * 128 + k0] = (unsigned char)((int)rintf(c0 * cinv) & 0xff); CQ[(size_t)tok * 128 + k1] = (unsigned char)((int)rintf(c1 * cinv) & 0xff);
        if (lane == 0) CS[tok] = cstep;
#pragma unroll
        for (int j = 0; j < 8; ++j) pw[j] = pwn[j];
        g0 = g0n; g1 = g1n; u0 = u0n; u1 = u1n;
    }
#undef P6M_LOAD
}

__device__ __forceinline__ void p6c_item(LAS unsigned char* lds, int wave, int lane, int slice, int tok0) {
    const unsigned char* VB = A_WS + WS_VB; const unsigned short* SELE = (const unsigned short*)(A_WS + WS_SELE);
    const unsigned char* CQ = A_WS + WS_CQ; const float* CS = (const float*)(A_WS + WS_CS);
    const int i8 = lane & 7, grp = lane >> 3;
    LAS int* eb = (LAS int*)(lds + P6_E8 + wave * 4096);
    LAS int* cbb = (LAS int*)(lds + P6_C8 + wave * 1024);
    {
        u32x4 le[2], lc; float cstep;
        { const int tk = tok0 + grp;
#pragma unroll
          for (int q = 0; q < 2; ++q) le[q] = *(const u32x4*)(SELE + (size_t)tk * 128 + i8 * 16 + 8 * q);
          lc = *(const u32x4*)(CQ + (size_t)tk * 128 + i8 * 16); cstep = CS[tk]; }
#pragma unroll 1
        for (int tb = 0; tb < P6_TPW; tb += 8) {
            const int tok = tok0 + tb + grp;
#pragma unroll
            for (int q = 0; q < 2; ++q) *(LAS u32x4*)(eb + grp * 64 + i8 * 8 + 4 * q) = le[q];
            *(LAS u32x4*)(cbb + grp * 32 + i8 * 4) = lc;
            const float cs = cstep;
            if (tb + 8 < P6_TPW) { const int tk = tok + 8;
#pragma unroll
                for (int q = 0; q < 2; ++q) le[q] = *(const u32x4*)(SELE + (size_t)tk * 128 + i8 * 16 + 8 * q);
                lc = *(const u32x4*)(CQ + (size_t)tk * 128 + i8 * 16); cstep = CS[tk]; }
            const unsigned char* vb = VB + slice * 128 + i8 * 16;
            asm volatile("s_waitcnt lgkmcnt(0)" ::: "memory");
            int acc[16];
#pragma unroll
            for (int r = 0; r < 16; ++r) acc[r] = 0;
#pragma unroll 1
            for (int s16 = 0; s16 < 128; s16 += 16) {
                u32x4 vv[16]; u32x4 e4[2];
#pragma unroll
                for (int a4 = 0; a4 < 2; ++a4) e4[a4] = *(const LAS u32x4*)(eb + grp * 64 + (s16 >> 1) + 4 * a4);
                const u32x4 cq4 = *(const LAS u32x4*)(cbb + grp * 32 + (s16 >> 2));
#pragma unroll
                for (int a4 = 0; a4 < 2; ++a4)
#pragma unroll
                    for (int j = 0; j < 4; ++j) { const unsigned w = e4[a4][j];
                        vv[8 * a4 + 2 * j] = *(const u32x4*)(vb + (size_t)(w & 0xffffu) * DM); vv[8 * a4 + 2 * j + 1] = *(const u32x4*)(vb + (size_t)(w >> 16) * DM); }
#pragma unroll
                for (int a4 = 0; a4 < 4; ++a4) {
                    const int cq = (int)cq4[a4];
#pragma unroll
                    for (int d = 0; d < 4; ++d) {
                        const unsigned ra = vv[4 * a4][d], rb = vv[4 * a4 + 1][d], rc = vv[4 * a4 + 2][d], rd = vv[4 * a4 + 3][d];
                        const unsigned lo = __builtin_amdgcn_perm(rb, ra, 0x05010400u), hi = __builtin_amdgcn_perm(rb, ra, 0x07030602u);
                        const unsigned lo2 = __builtin_amdgcn_perm(rd, rc, 0x05010400u), hi2 = __builtin_amdgcn_perm(rd, rc, 0x07030602u);
                        const unsigned t0 = __builtin_amdgcn_perm(lo2, lo, 0x05040100u), t1 = __builtin_amdgcn_perm(lo2, lo, 0x07060302u);
                        const unsigned t2 = __builtin_amdgcn_perm(hi2, hi, 0x05040100u), t3 = __builtin_amdgcn_perm(hi2, hi, 0x07060302u);
                        acc[4 * d + 0] = __builtin_amdgcn_sdot4((int)t0, cq, acc[4 * d + 0], false); acc[4 * d + 1] = __builtin_amdgcn_sdot4((int)t1, cq, acc[4 * d + 1], false);
                        acc[4 * d + 2] = __builtin_amdgcn_sdot4((int)t2, cq, acc[4 * d + 2], false); acc[4 * d + 3] = __builtin_amdgcn_sdot4((int)t3, cq, acc[4 * d + 3], false);
                    }
                }
            }
            bf16_t* pr = (bf16_t*)(A_WS + WS_PEER) + (size_t)tok * DM + slice * 128 + i8 * 16;
            u32x4 w0, w1;
            w0.x = cvtpk((float)acc[0] * cs, (float)acc[1] * cs); w0.y = cvtpk((float)acc[2] * cs, (float)acc[3] * cs); w0.z = cvtpk((float)acc[4] * cs, (float)acc[5] * cs); w0.w = cvtpk((float)acc[6] * cs, (float)acc[7] * cs);
            w1.x = cvtpk((float)acc[8] * cs, (float)acc[9] * cs); w1.y = cvtpk((float)acc[10] * cs, (float)acc[11] * cs); w1.z = cvtpk((float)acc[12] * cs, (float)acc[13] * cs); w1.w = cvtpk((float)acc[14] * cs, (float)acc[15] * cs);
            *(u32x4*)pr = w0; *(u32x4*)(pr + 8) = w1;
            asm volatile("s_waitcnt lgkmcnt(0)" ::: "memory");
        }
    }
}
__device__ __forceinline__ void p6c_phase(LAS unsigned char* lds, int tid, int wave, int lane) {
    unsigned* cnt = (unsigned*)(A_WS + WS_CTL) + CT_V;
    const int home = (int)(xcc_id() & 7u);
    P6W st{0, 0, 0}; int slice, item;
    while (p6w_claim(cnt, lane, home, NTOK / 16, st, slice, item)) p6c_item(lds, wave, lane, slice, item * 16);
}

__device__ __forceinline__ void p6d_phase(int G, int wave, int lane) {
    const int gw = blockIdx.x * 8 + wave, NGW = G * 8;
    const float* gf = A_IN(25);
    const bf16_t* DL = (const bf16_t*)(A_WS + WS_DELTA); const bf16_t* PR = (const bf16_t*)(A_WS + WS_PEER);
    f32x4 v[4], vn[4], ggr[4];
#pragma unroll
    for (int j = 0; j < 4; ++j) ggr[j] = *(const f32x4*)(gf + j * 256 + lane * 4);
    if (gw < NTOK) { row_ld(xrow_ptr(gw), v, lane); row_add_bf16(DL + (size_t)gw * DM, v, lane); row_add_bf16(PR + (size_t)gw * DM, v, lane); }
    for (int m = gw; m < NTOK; m += NGW) {
        const int mn = m + NGW;
        if (mn < NTOK) { row_ld(xrow_ptr(mn), vn, lane); row_add_bf16(DL + (size_t)mn * DM, vn, lane); row_add_bf16(PR + (size_t)mn * DM, vn, lane); }
        float* yr = yrow_ptr(m);
        const float inv = __builtin_amdgcn_rsqf(wave_sum(row_ss(v)) * (1.0f / DM) + EPS);
#pragma unroll
        for (int j = 0; j < 4; ++j) { *(f32x4*)(yr + j * 256 + lane * 4) = v[j] * inv * ggr[j]; }
#pragma unroll
        for (int j = 0; j < 4; ++j) v[j] = vn[j];
    }
}

#define XB_TMO      128
#define XB_XCNT(j)  (256  + 64 * (j))
#define XB_XSUB(j)  (1280 + 64 * (j))
#define XB_XGEN(j)  (2304 + 64 * (j))
#define XB_TOP      3328
#define XB_TOPGEN   3392
#define XB_SPIN_CAP (1u << 22)
constexpr int CW_BAR = 2048;
constexpr int LDS_MISC = 131072 + 64;
__device__ __forceinline__ unsigned xb_ld(unsigned* p)              { return __hip_atomic_load(p, __ATOMIC_RELAXED, __HIP_MEMORY_SCOPE_AGENT); }
__device__ __forceinline__ unsigned xb_add(unsigned* p, unsigned v) { return __hip_atomic_fetch_add(p, v, __ATOMIC_RELAXED, __HIP_MEMORY_SCOPE_AGENT); }
#define XB_SPIN(cond, bar) do { unsigned _sp = 0; while (cond) { __builtin_amdgcn_s_sleep(1); \
    if ((++_sp & 255u) == 0u) { if (xb_ld(&(bar)[XB_TMO])) break; if (_sp > XB_SPIN_CAP) { atomicAdd(&(bar)[XB_TMO], 1u); break; } } } } while (0)
struct XcdBarrier { unsigned* bar; unsigned x; volatile LAS unsigned* st; };
__device__ __forceinline__ XcdBarrier xcd_barrier_post(unsigned* bar, volatile LAS unsigned* st) {
    XcdBarrier b; b.bar = bar; b.x = (unsigned)__builtin_amdgcn_s_getreg((3 << 11) | 20) & 0xFu; b.st = st;
    if (threadIdx.x == 0) (void)xb_add(&bar[XB_XCNT(b.x)], 1u);
    return b;
}
__device__ __forceinline__ void xcd_barrier_complete(unsigned* bar, unsigned x, unsigned& nloc, unsigned& nx) {
    const unsigned G = gridDim.x * gridDim.y * gridDim.z;
    unsigned sum, cnt, mine, sp = 0u;
    for (;;) {
        sum = 0u; cnt = 0u; mine = 0u;
#pragma unroll
        for (unsigned j = 0; j < 16; ++j) { const unsigned c = xb_ld(&bar[XB_XCNT(j)]); sum += c; cnt += (c > 0u) ? 1u : 0u; mine = (j == x) ? c : mine; }
        if (sum == G) break;
        __builtin_amdgcn_s_sleep(1);
        if ((++sp & 255u) == 0u) { if (xb_ld(&bar[XB_TMO])) break; if (sp > XB_SPIN_CAP) { atomicAdd(&bar[XB_TMO], 1u); break; } }
    }
    nloc = mine > 0u ? mine : 1u; nx = cnt > 0u ? cnt : 1u;
}
__device__ __forceinline__ void xcd_barrier(const XcdBarrier& b) {
    asm volatile("s_waitcnt vmcnt(0)" ::: "memory");
    __syncthreads();
    if (threadIdx.x == 0) {
        unsigned* bar = b.bar;
        __builtin_amdgcn_s_waitcnt(0);
        unsigned nloc = b.st[0], nx = b.st[1];
        if (nloc == 0u) { xcd_barrier_complete(bar, b.x, nloc, nx); b.st[0] = nloc; b.st[1] = nx; }
        const unsigned old = xb_add(&bar[XB_XSUB(b.x)], 1u);
        const unsigned gen = old / nloc;
        if (old + 1u == (gen + 1u) * nloc) {
            __builtin_amdgcn_fence(__ATOMIC_RELEASE, "agent");
            asm volatile("s_waitcnt vmcnt(0)" ::: "memory");
            const unsigned og = xb_add(&bar[XB_TOP], 1u);
            const unsigned tg = og / nx;
            if (og + 1u == (tg + 1u) * nx) xb_add(&bar[XB_TOPGEN], 1u);
            else XB_SPIN(xb_ld(&bar[XB_TOPGEN]) == tg, bar);
            __builtin_amdgcn_fence(__ATOMIC_ACQUIRE, "agent");
            xb_add(&bar[XB_XGEN(b.x)], 1u);
            asm volatile("s_waitcnt vmcnt(0)" ::: "memory");
        } else {
            XB_SPIN(xb_ld(&bar[XB_XGEN(b.x)]) == gen, bar);
            __builtin_amdgcn_fence(__ATOMIC_ACQUIRE, "agent");
            asm volatile("s_waitcnt vmcnt(0)" ::: "memory");
        }
    }
    __syncthreads();
}

template <int NACC, class Epi>
__device__ __forceinline__ void small_gemm(LAS unsigned char* lds, const bf16_t* X0, const bf16_t* W0, const bf16_t* X1, const bf16_t* W1, int N, int G, int wave, int lane, const Epi& epi) {
    const int r32 = lane & 31, hi = lane >> 5;
    LAS float* part = (LAS float*)lds;
    for (int task = blockIdx.x; task < 4 * (N / 32); task += G) {
        const int rb = task & 3, cb = task >> 2;
#pragma unroll
        for (int a = 0; a < NACC; ++a) {
            const bf16_t* xp = (a ? X1 : X0) + (size_t)(rb * 32 + r32) * DM + hi * 8 + wave * 128;
            const bf16_t* wp = (a ? W1 : W0) + (size_t)(cb * 32 + r32) * DM + hi * 8 + wave * 128;
            bf16x8 xa[8], wa[8];
#pragma unroll
            for (int q = 0; q < 8; ++q) { xa[q] = *(const bf16x8*)(xp + q * 16); wa[q] = *(const bf16x8*)(wp + q * 16); }
            f32x16 acc = f32x16{};
#pragma unroll
            for (int q = 0; q < 8; ++q) acc = __builtin_amdgcn_mfma_f32_32x32x16_bf16(wa[q], xa[q], acc, 0, 0, 0);
#pragma unroll
            for (int r = 0; r < 16; ++r) part[((a * 8 + wave) * 16 + r) * 64 + lane] = acc[r];
        }
        __syncthreads();
        if (wave < 4) {
            const int g4 = wave, t = rb * 32 + r32, n0 = cb * 32 + 8 * g4 + 4 * hi;
            f32x4 v[NACC];
#pragma unroll
            for (int a = 0; a < NACC; ++a) { v[a] = (f32x4){0.f, 0.f, 0.f, 0.f};
#pragma unroll
                for (int w = 0; w < 8; ++w)
#pragma unroll
                    for (int i = 0; i < 4; ++i) v[a][i] += part[((a * 8 + w) * 16 + 4 * g4 + i) * 64 + lane]; }
            epi(t, n0, v[0], v[NACC - 1]);
        }
        __syncthreads();
    }
}
__device__ __forceinline__ u32x2 pack4(f32x4 v) { u32x2 w; w.x = cvtpk(v[0], v[1]); w.y = cvtpk(v[2], v[3]); return w; }
struct SEpiG1 {
    __device__ __forceinline__ void operator()(int t, int n0, f32x4 v, f32x4) const {
        unsigned char* ws = A_WS; float* out = A_OUT;
        const int ts = n0 >> 10, c = n0 & 1023; const size_t ro = (size_t)(NTP + t) * DM + c;
        if (ts == 0) *(u32x2*)((bf16_t*)(ws + WS_Q) + ro) = pack4(v);
        else if (ts == 1) *(f32x4*)(out + O_KS + (size_t)t * DM + c) = v;
        else if (ts == 2) *(f32x4*)(out + O_VS + (size_t)t * DM + c) = v;
        else if (ts == 3) { *(u32x2*)((bf16_t*)(ws + WS_XR) + ro) = pack4(v);
            if ((t & 15) >= 13) *(f32x4*)(out + O_CS + ((size_t)(t >> 4) * 3 + ((t & 15) - 13)) * DM + c) = v; }
        else if (ts == 4) *(u32x2*)((bf16_t*)(ws + WS_G) + ro) = pack4(v);
        else if (ts == 5) *(u32x2*)((bf16_t*)(ws + WS_SGA) + (size_t)t * DM + c) = pack4(v);
        else *(u32x2*)((bf16_t*)(ws + WS_SGR) + (size_t)t * DM + c) = pack4(v);
    }
};
struct SEpiP3 {
    __device__ __forceinline__ void operator()(int t, int n0, f32x4 va, f32x4 vr) const {
        unsigned char* ws = A_WS;
        const u32x2 ga = *(const u32x2*)((const bf16_t*)(ws + WS_SGA) + (size_t)t * DM + n0), gr = *(const u32x2*)((const bf16_t*)(ws + WS_SGR) + (size_t)t * DM + n0);
        f32x4 m;
        m[0] = sigmoidf_(bflo(ga.x)) * va[0] + sigmoidf_(bflo(gr.x)) * vr[0]; m[1] = sigmoidf_(bfhi(ga.x)) * va[1] + sigmoidf_(bfhi(gr.x)) * vr[1];
        m[2] = sigmoidf_(bflo(ga.y)) * va[2] + sigmoidf_(bflo(gr.y)) * vr[2]; m[3] = sigmoidf_(bfhi(ga.y)) * va[3] + sigmoidf_(bfhi(gr.y)) * vr[3];
        *(u32x2*)((bf16_t*)(ws + WS_XR) + (size_t)(NTP + t) * DM + n0) = pack4(m);
    }
};
struct SEpiBf16 {
    size_t wsoff; int ld;
    __device__ __forceinline__ void operator()(int t, int n0, f32x4 v, f32x4) const { *(u32x2*)((bf16_t*)(A_WS + wsoff) + (size_t)(NTP + t) * ld + n0) = pack4(v); }
};

__global__ void __launch_bounds__(512, 2) hybrid_fwd(Args a) {
    extern __shared__ __attribute__((aligned(16))) unsigned char lds_raw[];
    LAS unsigned char* lds = (LAS unsigned char*)lds_raw;
    const int tid = threadIdx.x, lane = tid & 63, wave = __builtin_amdgcn_readfirstlane(tid >> 6), G = gridDim.x;
    cg::grid_group grid = cg::this_grid();
    unsigned char* ws = A_WS;
    if (tid < 2) ((volatile LAS unsigned*)(lds + LDS_MISC))[tid] = 0u;
    __syncthreads();
    XcdBarrier xbar; xbar.bar = (unsigned*)(ws + WS_CTL) + CW_BAR; xbar.x = 0; xbar.st = nullptr;
#define IN(k) (KA->ph_lo <= (k) && (k) < KA->ph_hi)
    if (IN(0)) for (int i = (int)blockIdx.x * 512 + tid; i < 8192; i += G * 512) ((unsigned*)(ws + WS_CTL))[i] = 0u;
#define SEAM(k) do { if (KA->use_sync && IN(k) && IN((k) + 1)) xcd_barrier(xbar); } while (0)
    if (IN(0)) { p0a_prologue(lds, G, wave, lane); p0b_prologue(lds, G, wave, lane); if (KA->use_sync) grid.sync(); }
    if (KA->use_sync) xbar = xcd_barrier_post((unsigned*)(ws + WS_CTL) + CW_BAR, (volatile LAS unsigned*)(lds + LDS_MISC));
    if (IN(0)) { p0c_prologue(lds, G, wave, lane); }
    SEAM(0);
    if (IN(1)) {
        pg8::Gemm g{(const bf16_t*)(ws + WS_XN), (const bf16_t*)(ws + WS_WIN), (const bf16_t*)(ws + WS_WIN) + (size_t)2048 * DM, (const bf16_t*)(ws + WS_XN), DM};
        SchedG1 S; S.init(G, blockIdx.x); EpiG1 E;
        pg8::gemm_phase(lds, g, S, E);
        {
            const bf16_t* xnq = (const bf16_t*)((const unsigned char*)(A_OUT + O_YP) + (size_t)2 * NTP * DM);
            pg8::Gemm gq{xnq, (const bf16_t*)(ws + WS_WIQ), xnq, (const bf16_t*)(ws + WS_WIQ), DM / 2};
            SchedOne SQ; SQ.init(8, G, blockIdx.x); EpiQG EQ;
            pg8::gemm_phase<EpiQG, SchedOne, true>(lds, gq, SQ, EQ);
            pg8::Gemm gkv{xnq, (const bf16_t*)(ws + WS_WKV8), (const bf16_t*)(ws + WS_WKV8 + (size_t)1024 * DM), xnq, DM / 2};
            SchedKV8 SK; SK.init(G, blockIdx.x); EpiKV8 EK;
            pg8::gemm_phase<EpiKV8, SchedKV8, true>(lds, gkv, SK, EK);
        }
        { const bf16_t* xs = (const bf16_t*)(ws + WS_XN) + (size_t)NTP * DM; const bf16_t* w = (const bf16_t*)(ws + WS_WIN); SEpiG1 SE; small_gemm<1>(lds, xs, w, xs, w, INC, G, wave, lane, SE); }
    }
    SEAM(1);
    if (IN(2)) { p2_phase(lds, G, tid, wave, lane); }
    SEAM(2);
    if (IN(3)) {
        pg8::Gemm g{(const bf16_t*)(ws + WS_XN), (const bf16_t*)(ws + WS_WBA), (const bf16_t*)(ws + WS_G), (const bf16_t*)(ws + WS_WBL), DM};
        {
            const bf16_t* xnq = (const bf16_t*)((const unsigned char*)(A_OUT + O_YP) + (size_t)2 * NTP * DM);
            pg8::Gemm gg{xnq, (const bf16_t*)(ws + WS_WIQ + (size_t)2048 * DM), xnq, (const bf16_t*)(ws + WS_WIQ + (size_t)2048 * DM), DM / 2};
            SchedGate SG; SG.init(G, blockIdx.x); EpiGate EG;
            pg8::gemm_phase<EpiGate, SchedGate, true>(lds, gg, SG, EG);
        }
        SchedPair S; S.init(4, G, blockIdx.x); EpiP3 E;
        pg8::gemm_phase(lds, g, S, E);
        { SEpiP3 SE; small_gemm<2>(lds, (const bf16_t*)(ws + WS_XN) + (size_t)NTP * DM, (const bf16_t*)(ws + WS_WBA), (const bf16_t*)(ws + WS_G) + (size_t)NTP * DM, (const bf16_t*)(ws + WS_WBL), DM, G, wave, lane, SE); }
    }
    SEAM(3);
    if (IN(4)) {
        pg8::Gemm g{(const bf16_t*)(ws + WS_XR), (const bf16_t*)(ws + WS_WO), (const bf16_t*)(ws + WS_XR), (const bf16_t*)(ws + WS_WO), DM};
        SchedOne S; S.init(4, G, blockIdx.x); EpiP4 E;
        pg8::gemm_phase(lds, g, S, E);
        { const bf16_t* xs = (const bf16_t*)(ws + WS_XR) + (size_t)NTP * DM; const bf16_t* w = (const bf16_t*)(ws + WS_WO); SEpiBf16 SE{WS_DELTA, DM}; small_gemm<1>(lds, xs, w, xs, w, DM, G, wave, lane, SE); }
    }
    SEAM(4);
    if (IN(5)) { p4b_phase(G, wave, lane); }
    SEAM(5);
    if (IN(6)) {
        pg8::Gemm g{(const bf16_t*)(ws + WS_XQ), (const bf16_t*)(ws + WS_WSQ), (const bf16_t*)(ws + WS_XQ), (const bf16_t*)(ws + WS_WSQ), DM / 2};
        SchedOne S; S.init(8, G, blockIdx.x); EpiP5 E;
        pg8::gemm_phase<EpiP5, SchedOne, true>(lds, g, S, E);
        { const bf16_t* xs = (const bf16_t*)(ws + WS_Q) + (size_t)NTP * DM; const bf16_t* w = (const bf16_t*)(ws + WS_WS); SEpiBf16 SE{WS_XN, 2048}; small_gemm<1>(lds, xs, w, xs, w, 2048, G, wave, lane, SE); }
    }
    SEAM(6);
    if (IN(7)) { p6a_phase(lds, G, wave, lane); }
    SEAM(7);
    if (IN(8)) { p6b_phase(lds, tid, wave, lane); }
    SEAM(8);
    if (IN(9)) { p6m_phase(G, wave, lane); }
    SEAM(9);
    if (IN(10)) { p6c_phase(lds, tid, wave, lane); }
    SEAM(10);
    if (IN(11)) { p6d_phase(G, wave, lane); }
#undef IN
#undef SEAM
}

#ifndef N_LAUNCH_MODE
#define N_LAUNCH_MODE 1
#endif
constexpr int NPH = 12;
extern "C" void kernel_launch(void* const* d_in, const int* in_sizes, int n_in, void* d_out, int out_size, void* d_ws, size_t ws_size, hipStream_t stream) {
    static int grid = 0;
    if (grid == 0) {
        if (n_in != 26 || (size_t)out_size != O_END || ws_size < WS_END) { fprintf(stderr, "kernel_launch: unexpected sizes n_in %d out %d ws %zu (need %zu)\n", n_in, out_size, ws_size, (size_t)WS_END); grid = -1; return; }
        int dev = 0, cus = 0, per_cu = 0;
        (void)hipGetDevice(&dev); (void)hipDeviceGetAttribute(&cus, hipDeviceAttributeMultiprocessorCount, dev);
        (void)hipFuncSetAttribute((const void*)hybrid_fwd, hipFuncAttributeMaxDynamicSharedMemorySize, LDS_BYTES);
        (void)hipOccupancyMaxActiveBlocksPerMultiprocessor(&per_cu, (const void*)hybrid_fwd, 512, LDS_BYTES);
        if (per_cu < 1) { fprintf(stderr, "kernel_launch: occupancy query says %d blocks per CU\n", per_cu); per_cu = 1; }
        grid = cus;
        (void)hipGetLastError();
    }
    if (grid < 0) return;
    Args a{};
    for (int i = 0; i < 26; ++i) a.in[i] = (const float*)d_in[i];
    a.out = (float*)d_out; a.ws = (unsigned char*)d_ws;
    if (N_LAUNCH_MODE == 1) {
        a.ph_lo = 0; a.ph_hi = NPH; a.use_sync = 1;
        void* args[] = {&a};
        hipError_t e = hipLaunchCooperativeKernel((const void*)hybrid_fwd, dim3(grid), dim3(512), args, LDS_BYTES, stream);
        if (e != hipSuccess) fprintf(stderr, "cooperative launch failed: %s (grid %d)\n", hipGetErrorString(e), grid);
    } else {
        for (int p = 0; p < NPH; ++p) { a.ph_lo = p; a.ph_hi = p + 1; a.use_sync = 0; hipLaunchKernelGGL(hybrid_fwd, dim3(grid), dim3(512), LDS_BYTES, stream, a); }
    }
}
```
